# Optimizing an MI355X kernel written in HIP

```python
import jax, jax.numpy as jnp
from jax import lax
import numpy as np


D_MODEL = 2048
BATCH = 8
SEQ = 2048
DEPTH = 2

CTX_LEN = 256
GRID_W = 64
NORM_EPS = 1e-6
RWKV_DIM = D_MODEL // 2
RWKV_HEAD = 64
RWKV_HEADS = RWKV_DIM // RWKV_HEAD
DECAY_LORA = 96
ICLR_LORA = 96
GATE_LORA = 256
RWKV_GN_EPS = 64e-5
GLA_HEADS = 4
GLA_KDIM = D_MODEL // 4
GLA_VDIM = D_MODEL // 2
GLA_DK = GLA_KDIM // GLA_HEADS
GLA_DV = GLA_VDIM // GLA_HEADS
GLA_GATE_LORA = 16
GLA_TAU = 16.0
GLA_CHUNK = 64
GLA_CONV = 3
N_EXPERTS = 16
N_GROUPS = 4
EXPERTS_PER_GROUP = N_EXPERTS // N_GROUPS
TOP_K = 2
D_EXPERT = 1408
RWKV_IN = 3 * RWKV_DIM + DECAY_LORA + ICLR_LORA + GATE_LORA
RWKV_SPLITS = (RWKV_DIM, 2 * RWKV_DIM, 3 * RWKV_DIM, 3 * RWKV_DIM + DECAY_LORA, 3 * RWKV_DIM + DECAY_LORA + ICLR_LORA)
GLA_QKV = 2 * GLA_KDIM + GLA_VDIM
GLA_SEQ_IN = GLA_QKV + GLA_GATE_LORA
GLA_GATE_OFF = RWKV_IN + GLA_SEQ_IN
BR_GATE_OFF = GLA_GATE_OFF + GLA_VDIM
IN_DIM = BR_GATE_OFF + 2 * D_MODEL

kernel_name = 'hybrid_rwkv7_gla_moe_prefix_dit'


def rms_norm(x, g):
    x32 = x.astype(jnp.float32)
    y = x32 * lax.rsqrt(jnp.mean(x32 * x32, -1, keepdims=True) + NORM_EPS)
    return (y * g).astype(x.dtype)


def modulate(h, shift, scale):
    return h * (1.0 + scale) + shift


def centred_shift(p, mu):
    prev = jnp.pad(p, ((0, 0), (1, 0), (0, 0)))[:, :-1]
    nxt = jnp.pad(p, ((0, 0), (0, 1), (0, 0)))[:, 1:]
    return p + mu[0] * (prev - p) + mu[1] * (nxt - p)


def depthwise_conv(u, w):
    return lax.conv_general_dilated(u, w[:, None, :].astype(u.dtype), window_strides=(1,), padding='SAME',
                                    dimension_numbers=('NWC', 'WIO', 'NWC'), feature_group_count=u.shape[-1])


def to_column_major(t, rows):
    b, l, ch = t.shape
    return t.reshape(b, rows, GRID_W, ch).transpose(0, 2, 1, 3).reshape(b, l, ch)


def to_row_major(t, rows):
    b, l, ch = t.shape
    return t.reshape(b, GRID_W, rows, ch).transpose(0, 2, 1, 3).reshape(b, l, ch)


def rwkv_scan(s0, r, w, k, v, kk, a, reverse):
    def step(s, inp):
        r_t, w_t, k_t, v_t, kk_t, a_t = inp
        sa = jnp.einsum('bhvk,bhk->bhv', s, kk_t)
        s = s * w_t[:, :, None, :] - sa[..., None] * (kk_t * a_t)[:, :, None, :] + v_t[..., None] * k_t[:, :, None, :]
        return s, jnp.einsum('bhvk,bhk->bhv', s, r_t)
    xs = tuple(jnp.moveaxis(t, 1, 0) for t in (r, w, k, v, kk, a))
    s_fin, ys = lax.scan(step, s0, xs, reverse=reverse)
    return jnp.moveaxis(ys, 0, 1), s_fin


def rwkv_stream(p, init, mu, w0, w2, a0, a2, g2, k_k, k_a, r_k, ln_g, ln_b):
    b, l, _ = p.shape
    f32 = jnp.float32
    hd = lambda t: t.astype(f32).reshape(t.shape[:-1] + (RWKV_HEADS, RWKV_HEAD))
    s = centred_shift(p, mu)
    r, k, v, xw, xa, xg = jnp.split(s, RWKV_SPLITS, axis=-1)
    r_h, k_h, v_h = hd(r), hd(k), hd(v)
    kk = hd(k * k_k)
    kk = kk / jnp.maximum(jnp.sqrt(jnp.sum(kk * kk, -1, keepdims=True)), 1e-12)
    y = jnp.zeros_like(v_h)
    finals = []
    for d in range(2):
        w_log = -jax.nn.softplus(-(w0[d] + jnp.tanh(xw) @ w2[d]).astype(f32)) - 0.5
        decay = hd(jnp.exp(-jnp.exp(w_log)))
        a = hd(jax.nn.sigmoid((a0[d] + xa @ a2[d]).astype(f32)))
        k_d = k_h * (1.0 + (a - 1.0) * hd(k_a))
        y_d, s_d = rwkv_scan(init[d], r_h, decay, k_d, v_h, kk, a, reverse=(d == 1))
        y = y + y_d
        finals.append(s_d)
    mean = jnp.mean(y, -1, keepdims=True)
    var = jnp.mean(jnp.square(y - mean), -1, keepdims=True)
    yn = ((y - mean) * lax.rsqrt(var + RWKV_GN_EPS)).reshape(b, l, RWKV_DIM) * ln_g + ln_b
    bonus = (jnp.sum(r_h * k_h * r_k, -1, keepdims=True) * v_h).reshape(b, l, RWKV_DIM)
    gate = jax.nn.sigmoid(xg) @ g2
    return (yn + bonus).astype(p.dtype) * gate, finals


def gla_chunked(q, k, v, g, s0):
    b, l, h, _ = q.shape
    dv = v.shape[-1]
    n = l // GLA_CHUNK
    blk = lambda t: t.astype(jnp.float32).reshape(b, n, GLA_CHUNK, h, t.shape[-1])
    q, k, v, g = blk(q), blk(k), blk(v), blk(g)
    gc = jnp.cumsum(g, axis=2)
    g_last = gc[:, :, -1]
    q_g = q * jnp.exp(gc)
    k_g = k * jnp.exp(-gc)
    k_end = k * jnp.exp(g_last[:, :, None] - gc)
    mask = jnp.tril(jnp.ones((GLA_CHUNK, GLA_CHUNK), jnp.float32))
    att = jnp.einsum('bnihd,bnjhd->bnhij', q_g, k_g) * mask
    o_intra = jnp.einsum('bnhij,bnjhv->bnihv', att, v)
    ds = jnp.einsum('bnjhd,bnjhv->bnhdv', k_end, v)

    def step(s, inp):
        ds_c, dec_c = inp
        return s * dec_c[..., None] + ds_c, s
    s_fin, s_prev = lax.scan(step, s0, (jnp.moveaxis(ds, 1, 0), jnp.moveaxis(jnp.exp(g_last), 1, 0)))
    o_inter = jnp.einsum('bnihd,nbhdv->bnihv', q_g, s_prev)
    return (o_intra + o_inter).reshape(b, l, h, dv), s_fin


def gla_stream(u, init, conv_w, alpha_w2, alpha_b, norm_g):
    b, l, _ = u.shape
    f32 = jnp.float32
    qkv = jax.nn.silu(depthwise_conv(u[..., :GLA_QKV], conv_w))
    q = qkv[..., :GLA_KDIM].reshape(b, l, GLA_HEADS, GLA_DK) * (GLA_DK ** -0.5)
    k = qkv[..., GLA_KDIM:2 * GLA_KDIM].reshape(b, l, GLA_HEADS, GLA_DK)
    v = qkv[..., 2 * GLA_KDIM:].reshape(b, l, GLA_HEADS, GLA_DV)
    ad = u[..., GLA_QKV:]
    o = jnp.zeros((b, l, GLA_HEADS, GLA_DV), f32)
    finals = []
    for d in range(2):
        g = (jax.nn.log_sigmoid((ad @ alpha_w2[d] + alpha_b[d]).astype(f32)) / GLA_TAU).reshape(b, l, GLA_HEADS, GLA_DK)
        if d == 0:
            o_d, s_d = gla_chunked(q, k, v, g, init[d])
        else:
            o_d, s_d = gla_chunked(*(jnp.flip(t, 1) for t in (q, k, v, g)), init[d])
            o_d = jnp.flip(o_d, 1)
        o = o + o_d
        finals.append(s_d)
    o = o * lax.rsqrt(jnp.mean(o * o, -1, keepdims=True) + NORM_EPS) * norm_g
    return o.reshape(b, l, GLA_VDIM).astype(u.dtype), finals


def hybrid_mixer(h_c, h_l, rows, need_ctx, w_in, rwkv_mu, rwkv_w0, rwkv_w2, rwkv_a0, rwkv_a2, rwkv_g2,
                 rwkv_k_k, rwkv_k_a, rwkv_r_k, rwkv_ln_g, rwkv_ln_b, gla_conv, gla_alpha_w2, gla_alpha_b,
                 gla_norm_g, w_branch_a, w_branch_b, w_out):
    b = h_l.shape[0]
    f32 = jnp.float32
    rwkv_args = (rwkv_mu, rwkv_w0, rwkv_w2, rwkv_a0, rwkv_a2, rwkv_g2, rwkv_k_k, rwkv_k_a, rwkv_r_k, rwkv_ln_g, rwkv_ln_b)
    gla_args = (gla_conv, gla_alpha_w2, gla_alpha_b, gla_norm_g)
    p_c = h_c @ w_in
    p_l = h_l @ w_in
    zr = jnp.zeros((b, RWKV_HEADS, RWKV_HEAD, RWKV_HEAD), f32)
    zg = jnp.zeros((b, GLA_HEADS, GLA_DK, GLA_DV), f32)
    ya_c, st_r = rwkv_stream(p_c[..., :RWKV_IN], (zr, zr), *rwkv_args)
    ya_l, _ = rwkv_stream(p_l[..., :RWKV_IN], st_r, *rwkv_args)
    yb_c, st_g = gla_stream(p_c[..., RWKV_IN:GLA_GATE_OFF], (zg, zg), *gla_args)
    yb_l_cm, _ = gla_stream(to_column_major(p_l[..., RWKV_IN:GLA_GATE_OFF], rows), st_g, *gla_args)
    yb_l = to_row_major(yb_l_cm, rows)

    def merge(p, ya, yb):
        yb = yb * jax.nn.silu(p[..., GLA_GATE_OFF:BR_GATE_OFF])
        ga = jax.nn.sigmoid(p[..., BR_GATE_OFF:BR_GATE_OFF + D_MODEL])
        gb = jax.nn.sigmoid(p[..., BR_GATE_OFF + D_MODEL:])
        return (ga * (ya @ w_branch_a) + gb * (yb @ w_branch_b)) @ w_out
    y_l = merge(p_l, ya_l, yb_l)
    y_c = merge(p_c, ya_c, yb_c) if need_ctx else None
    return y_c, y_l


def moe_ffn(h, router_w, router_b, w_gate, w_up, w_down):
    shp = h.shape
    t = h.reshape(-1, shp[-1])
    scores = jax.nn.sigmoid((t @ router_w).astype(jnp.float32))
    sel = scores + router_b.astype(jnp.float32)
    grp_score = jnp.sum(lax.top_k(sel.reshape(-1, N_GROUPS, EXPERTS_PER_GROUP), 2)[0], -1)
    best = jnp.argmax(grp_score, -1)
    in_grp = (jnp.arange(N_EXPERTS) // EXPERTS_PER_GROUP)[None, :] == best[:, None]
    _, idx = lax.top_k(jnp.where(in_grp, sel, -jnp.inf), TOP_K)
    wts = jnp.take_along_axis(scores, idx, -1)
    wts = wts / jnp.sum(wts, -1, keepdims=True)
    gates = jnp.sum(jax.nn.one_hot(idx, N_EXPERTS, dtype=jnp.float32) * wts[..., None], 1).astype(t.dtype)
    out = jnp.zeros_like(t)
    for e in range(N_EXPERTS):
        out = out + gates[:, e:e + 1] * ((jax.nn.silu(t @ w_gate[e]) * (t @ w_up[e])) @ w_down[e])
    return out.reshape(shp)


def ffn_sublayer(xs, norm_g, shift, scale, gate, router_w, router_b, w_gate, w_up, w_down):
    return xs + gate * moe_ffn(modulate(rms_norm(xs, norm_g), shift, scale), router_w, router_b, w_gate, w_up, w_down)


def setup_inputs(seed: int = 0) -> dict:
    key = jax.random.key(seed)
    ks = iter(jax.random.split(key, 40))
    f32 = jnp.float32
    normal = lambda shape, s: jax.random.normal(next(ks), shape, f32) * s
    unif = lambda shape, lo, hi: jax.random.uniform(next(ks), shape, f32, lo, hi)
    L = DEPTH
    return {
        'x': normal((BATCH, SEQ, D_MODEL), 1.0),
        'c': normal((BATCH, D_MODEL), 1.0),
        'ctx': normal((BATCH, CTX_LEN, D_MODEL), 1.0),
        'c_ctx': normal((D_MODEL,), 1.0),
        'w_ada': normal((L, D_MODEL, 6 * D_MODEL), 0.5 * D_MODEL ** -0.5),
        'b_ada': normal((L, 6 * D_MODEL), 0.01),
        'norm_mix_g': 1.0 + normal((L, D_MODEL), 0.05),
        'norm_ffn_g': 1.0 + normal((L, D_MODEL), 0.05),
        'w_in': normal((L, D_MODEL, IN_DIM), D_MODEL ** -0.5),
        'rwkv_mu': unif((L, 2, RWKV_IN), 0.0, 0.5),
        'rwkv_w0': unif((L, 2, RWKV_DIM), -5.0, 0.5),
        'rwkv_w2': normal((L, 2, DECAY_LORA, RWKV_DIM), 0.1 * DECAY_LORA ** -0.5),
        'rwkv_a0': normal((L, 2, RWKV_DIM), 0.5),
        'rwkv_a2': normal((L, 2, ICLR_LORA, RWKV_DIM), 0.1 * ICLR_LORA ** -0.5),
        'rwkv_g2': normal((L, GATE_LORA, RWKV_DIM), GATE_LORA ** -0.5),
        'rwkv_k_k': 0.85 + normal((L, RWKV_DIM), 0.05),
        'rwkv_k_a': 1.0 + normal((L, RWKV_DIM), 0.05),
        'rwkv_r_k': normal((L, RWKV_HEADS, RWKV_HEAD), 0.1),
        'rwkv_ln_g': 1.0 + normal((L, RWKV_DIM), 0.05),
        'rwkv_ln_b': normal((L, RWKV_DIM), 0.01),
        'gla_conv': normal((L, GLA_CONV, GLA_QKV), GLA_CONV ** -0.5),
        'gla_alpha_w2': normal((L, 2, GLA_GATE_LORA, GLA_KDIM), GLA_GATE_LORA ** -0.5),
        'gla_alpha_b': unif((L, 2, GLA_KDIM), 0.0, 4.0),
        'gla_norm_g': 1.0 + normal((L, GLA_DV), 0.05),
        'w_branch_a': normal((L, RWKV_DIM, D_MODEL), RWKV_DIM ** -0.5),
        'w_branch_b': normal((L, GLA_VDIM, D_MODEL), GLA_VDIM ** -0.5),
        'w_out': normal((L, D_MODEL, D_MODEL), D_MODEL ** -0.5),
        'router_w': normal((D_MODEL, N_EXPERTS), D_MODEL ** -0.5),
        'router_b': normal((N_EXPERTS,), 0.01),
        'exp_w_gate': normal((L, N_EXPERTS, D_MODEL, D_EXPERT), D_MODEL ** -0.5),
        'exp_w_up': normal((L, N_EXPERTS, D_MODEL, D_EXPERT), D_MODEL ** -0.5),
        'exp_w_down': normal((L, N_EXPERTS, D_EXPERT, D_MODEL), D_EXPERT ** -0.5),
        'final_norm_g': 1.0 + normal((D_MODEL,), 0.05),
    }


def reference(x, c, ctx, c_ctx, w_ada, b_ada, norm_mix_g, norm_ffn_g, w_in, rwkv_mu, rwkv_w0, rwkv_w2,
              rwkv_a0, rwkv_a2, rwkv_g2, rwkv_k_k, rwkv_k_a, rwkv_r_k, rwkv_ln_g, rwkv_ln_b, gla_conv,
              gla_alpha_w2, gla_alpha_b, gla_norm_g, w_branch_a, w_branch_b, w_out, router_w, router_b,
              exp_w_gate, exp_w_up, exp_w_down, final_norm_g):
    rows = x.shape[1] // GRID_W
    silu_c = jax.nn.silu(c)[:, None, :]
    silu_cc = jax.nn.silu(c_ctx)
    x_lat, x_ctx = x, ctx
    for l in range(DEPTH):
        last = l == DEPTH - 1
        mod_l = jnp.split(silu_c @ w_ada[l] + b_ada[l], 6, axis=-1)
        mod_c = jnp.split(silu_cc @ w_ada[l] + b_ada[l], 6, axis=-1)
        h_l = modulate(rms_norm(x_lat, norm_mix_g[l]), mod_l[0], mod_l[1])
        h_c = modulate(rms_norm(x_ctx, norm_mix_g[l]), mod_c[0], mod_c[1])
        y_c, y_l = hybrid_mixer(h_c, h_l, rows, not last, w_in[l], rwkv_mu[l], rwkv_w0[l], rwkv_w2[l],
                                rwkv_a0[l], rwkv_a2[l], rwkv_g2[l], rwkv_k_k[l], rwkv_k_a[l], rwkv_r_k[l],
                                rwkv_ln_g[l], rwkv_ln_b[l], gla_conv[l], gla_alpha_w2[l], gla_alpha_b[l],
                                gla_norm_g[l], w_branch_a[l], w_branch_b[l], w_out[l])
        x_lat = x_lat + mod_l[2] * y_l
        x_lat = ffn_sublayer(x_lat, norm_ffn_g[l], mod_l[3], mod_l[4], mod_l[5], router_w, router_b,
                             exp_w_gate[l], exp_w_up[l], exp_w_down[l])
        if not last:
            x_ctx = x_ctx + mod_c[2] * y_c
            x_ctx = ffn_sublayer(x_ctx, norm_ffn_g[l], mod_c[3], mod_c[4], mod_c[5], router_w, router_b,
                                 exp_w_gate[l], exp_w_up[l], exp_w_down[l])
    return rms_norm(x_lat, final_norm_g)
```

```cpp
#include <hip/hip_runtime.h>
#include <cstdio>
#include <cstdint>

#define LAS __attribute__((address_space(3)))
#define GAS __attribute__((address_space(1)))
typedef unsigned short bf16;
typedef float f32x4 __attribute__((ext_vector_type(4)));
typedef float f32x2 __attribute__((ext_vector_type(2)));
typedef unsigned u32x4 __attribute__((ext_vector_type(4)));
typedef unsigned u32x2 __attribute__((ext_vector_type(2)));
typedef short bf16x8 __attribute__((ext_vector_type(8)));

constexpr int DM = 2048, NBATCH = 8, SEQ = 2048, CTXL = 256, DEPTH = 2;
constexpr int TL = NBATCH * SEQ, TC = NBATCH * CTXL, TA = TL + TC;
constexpr int RD = 1024, RHEADS = 16, RHS = 64;
constexpr int RWKV_IN = 3520;
constexpr int GKD = 512, GVD = 1024, GDK = 128, GDV = 256, GHEADS = 4, GQKV = 2048;
constexpr int GLA_OFF = 3520, GLA_AD_OFF = GLA_OFF + GQKV, GLA_GATE_OFF = 5584, BR_OFF = 6608, IN_DIM = 10704, NP = 10752;
constexpr int NEXP = 16, DEXP = 1408;
constexpr int MOD_N = 6 * DM;
constexpr int MOE_ROWS = 41216;
constexpr int MOE_TILES = MOE_ROWS / 256;
constexpr int NCH = 36;
constexpr int KSPLIT = 32;

enum { I_X = 0, I_C, I_CTX, I_CCTX, I_WADA, I_BADA, I_NMG, I_NFG, I_WIN, I_MU, I_W0, I_W2, I_A0, I_A2, I_G2, I_KK, I_KA, I_RK, I_LNG, I_LNB,
       I_GCONV, I_GAW2, I_GAB, I_GNG, I_WBA, I_WBB, I_WOUT, I_RW, I_RB, I_EG, I_EU, I_ED, I_FNG, N_IN };

constexpr size_t MiB = 1u << 20;
constexpr size_t WS_CTL = 0;
constexpr size_t WS_TAB = 1 * MiB;
constexpr size_t WS_MOD = 2 * MiB;
constexpr size_t WS_X = 3 * MiB;
constexpr size_t WS_H = WS_X + 144 * MiB;
constexpr size_t WS_P = WS_H + 72 * MiB;
constexpr size_t WS_RW = WS_P + 378 * MiB;
constexpr size_t WS_GL = WS_RW + 380 * MiB;
constexpr size_t WS_WT = WS_GL + 218 * MiB;
constexpr size_t WS_END = WS_WT + 325 * MiB;
constexpr int CW_TMO = 0, CW_CNT = 64  , CW_BAR = 4096;
constexpr size_t CTL_BYTES = 1 * MiB;
constexpr size_t TAB_ROWTOK = 0;
constexpr size_t TAB_ROWTOK_BYTES = 2 * (size_t)MOE_ROWS * 4;
constexpr size_t TAB_ROWW = 384 * 1024;
constexpr size_t TAB_TILE = 768 * 1024;
constexpr size_t TAB_TOP = 800 * 1024;
static_assert(TAB_ROWTOK_BYTES <= TAB_ROWW && TAB_ROWW + 2 * (size_t)MOE_ROWS * 4 <= TAB_TILE, "tab map");
constexpr size_t WS_MODP = WS_P;
constexpr size_t WS_HP = WS_P;
constexpr size_t WS_ACT = WS_P + 162 * MiB;
constexpr size_t WS_TOPK = WS_P + 274 * MiB;
static_assert((size_t)MOE_ROWS * DM * 2 <= 162 * MiB && (size_t)MOE_ROWS * DEXP * 2 <= 112 * MiB && 274 * MiB + 3 * (size_t)TA * 8 <= 378 * MiB, "P overlay");
constexpr size_t RW_R = WS_RW;
constexpr size_t RW_KS = RW_R + 36 * MiB;
constexpr size_t RW_V = RW_KS + 36 * MiB;
constexpr size_t RW_KK = RW_V + 36 * MiB;
constexpr size_t RW_LO = RW_KK + 36 * MiB;
constexpr size_t RW_Y = RW_LO + 144 * MiB;
constexpr size_t RW_A1 = RW_Y + 72 * MiB;
constexpr size_t RW_A2 = RW_A1 + 9 * MiB;
constexpr size_t RW_BON = RW_A2 + 9 * MiB;
static_assert(RW_BON + 2 * MiB <= WS_GL, "rwkv map");
constexpr size_t GL_QG = WS_GL;
constexpr size_t GL_KG = GL_QG + 36 * MiB;
constexpr size_t GL_KE = GL_KG + 36 * MiB;
constexpr size_t GL_VS = GL_KE + 36 * MiB;
constexpr size_t GL_O = GL_VS + 36 * MiB;
constexpr size_t GL_DEC = GL_O + 72 * MiB;
static_assert(GL_DEC + 2 * MiB <= WS_WT, "gla map");
constexpr size_t WS_YF = WS_GL;
constexpr size_t WT_IN = WS_WT;
constexpr size_t WT_L1 = WT_IN + 42 * MiB;
constexpr size_t WT_G2 = WT_L1 + 2 * MiB;
constexpr size_t WT_A = WT_G2 + 1 * MiB;
constexpr size_t WT_B = WT_A + 4 * MiB;
constexpr size_t WT_O = WT_B + 4 * MiB;
constexpr size_t WT_GU = WT_O + 8 * MiB;
constexpr size_t WT_D = WT_GU + 176 * MiB;
static_assert(WT_D + 88 * MiB == WS_END, "weight map");

__device__ __forceinline__ float bf2f(unsigned v) { return __uint_as_float(v << 16); }
__device__ __forceinline__ float bflo(unsigned w) { return __uint_as_float(w << 16); }
__device__ __forceinline__ float bfhi(unsigned w) { return __uint_as_float(w & 0xffff0000u); }
__device__ __forceinline__ unsigned f2bf(float f) { unsigned u = __float_as_uint(f); return (u + 0x7fffu + ((u >> 16) & 1u)) >> 16; }
__device__ __forceinline__ unsigned pk2(float lo, float hi) { unsigned r; asm volatile("v_cvt_pk_bf16_f32 %0, %1, %2" : "=v"(r) : "v"(lo), "v"(hi)); return r; }
__device__ __forceinline__ float sigm(float x) { return 1.0f / (1.0f + __expf(-x)); }
__device__ __forceinline__ float siluf(float x) { return x * sigm(x); }
__device__ __forceinline__ float wave_sum(float v) {
#pragma unroll
    for (int o = 1; o < 64; o <<= 1) v += __shfl_xor(v, o);
    return v;
}
__device__ __forceinline__ void unpack8(const u32x4 w, float (&o)[8]) {
    o[0] = bflo(w.x); o[1] = bfhi(w.x); o[2] = bflo(w.y); o[3] = bfhi(w.y); o[4] = bflo(w.z); o[5] = bfhi(w.z); o[6] = bflo(w.w); o[7] = bfhi(w.w);
}
__device__ __forceinline__ u32x4 pack8(const float (&v)[8]) { u32x4 w; w.x = pk2(v[0], v[1]); w.y = pk2(v[2], v[3]); w.z = pk2(v[4], v[5]); w.w = pk2(v[6], v[7]); return w; }
namespace pg8 {
#define PG8_LAS __attribute__((address_space(3)))
typedef unsigned short bf16_t;
typedef short bf16x8 __attribute__((ext_vector_type(8)));
typedef float f32x4 __attribute__((ext_vector_type(4)));
typedef unsigned u32x4 __attribute__((ext_vector_type(4)));
constexpr int BM = 256, BK = 64, HALF = 128, HTB = HALF * BK * 2  , STAGE_BYTES = 8 * HTB, NXCD = 8, WGM = 8;

__host__ __device__ __forceinline__ int lds_byte(int r, int c) { const int st = (r >> 4) * 2 + (c >> 5), rr = r & 15, cc = c & 31, ob = rr * 64 + cc * 2; return st * 1024 + (ob ^ (((ob >> 9) & 1) << 5)); }
__host__ __device__ __forceinline__ void stage_rc(int b, int& R, int& C) { const int st = b / 1024, sb = b % 1024, swz = sb ^ (((sb >> 9) & 1) << 5); R = (st >> 1) * 16 + swz / 64; C = (st & 1) * 32 + (swz % 64) / 2; }
__host__ __device__ __forceinline__ int perm32(int rho) { const int n = rho >> 4, i = rho & 15; return 8 * (i >> 2) + 4 * n + (i & 3); }
struct Unit { int pm, pn, eb; };
struct Gemm { const bf16_t* A; const bf16_t* Bt; int M, N, K; size_t bstride; };

struct StaticOrder {
    int nM, nN, nwg, G, c;
    __host__ __device__ void init(int M, int N, int G_, int c_) { nM = M / BM; nN = N / BM; nwg = nM * nN; G = G_; c = c_; }
    __host__ __device__ bool next(int i, Unit& u) const {
        const long L = (long)i * G + c; if (L >= nwg) return false;
        int wgid = (int)L; { const int q = nwg / NXCD, r = nwg % NXCD, xcd = wgid % NXCD, off = wgid / NXCD; wgid = (xcd < r ? xcd * (q + 1) : r * (q + 1) + (xcd - r) * q) + off; }
        const int nig = WGM * nN, gid = wgid / nig, fm = gid * WGM, gsz = (nM - fm) < WGM ? (nM - fm) : WGM;
        u.pm = fm + ((wgid % nig) % gsz); u.pn = (wgid % nig) / gsz; u.eb = 0; return true;
    }
    __device__ __forceinline__ void a_ready(const Unit&) const {}
    __device__ __forceinline__ void done(const Unit&) const {}
};
struct MoeOrder {
    const int* tab; int nT, nN, G, c;
    __device__ void init(const int* tab_, int nN_, int G_, int c_) { tab = tab_; nT = tab_[0]; nN = nN_; G = G_; c = c_; }
    __device__ bool next(int i, Unit& u) const {
        const long L = (long)i * G + c; if (L >= (long)nT * nN) return false;
        u.pm = (int)(L / nN); u.pn = (int)(L % nN); u.eb = tab[1 + u.pm]; return true;
    }
    __device__ __forceinline__ void a_ready(const Unit&) const {}
    __device__ __forceinline__ void done(const Unit&) const {}
};

template <class F> struct Epi8 {
    static constexpr bool PERM = true, AFTER_DRAIN = false;
    F f;
    __device__ __forceinline__ void operator()(const f32x4 (&acc)[2][2][4][2], const Unit& u, int wr, int wc, int fr, int fq) const {
        const int row0 = u.pm * BM + wr * 64 + fr, col0 = u.pn * BM + wc * 32 + 8 * fq;
#pragma unroll
        for (int ai = 0; ai < 2; ++ai)
#pragma unroll
            for (int m = 0; m < 4; ++m) {
#pragma unroll
                for (int bj = 0; bj < 2; ++bj) {
                    const f32x4 a = acc[ai][bj][m][0], b = acc[ai][bj][m][1];
                    float v[8] = {a[0], a[1], a[2], a[3], b[0], b[1], b[2], b[3]};
                    f(row0 + ai * HALF + m * 16, col0 + bj * HALF, v, u);
                }
            }
    }
};
template <class F> struct EpiGU {
    static constexpr bool PERM = true, AFTER_DRAIN = false;
    F f;
    __device__ __forceinline__ void operator()(const f32x4 (&acc)[2][2][4][2], const Unit& u, int wr, int wc, int fr, int fq) const {
        const int row0 = u.pm * BM + wr * 64 + fr, col0 = u.pn * HALF + wc * 32 + 8 * fq;
#pragma unroll
        for (int ai = 0; ai < 2; ++ai)
#pragma unroll
            for (int m = 0; m < 4; ++m) {
                const f32x4 g0 = acc[ai][0][m][0], g1 = acc[ai][0][m][1], u0 = acc[ai][1][m][0], u1 = acc[ai][1][m][1];
                float g[8] = {g0[0], g0[1], g0[2], g0[3], g1[0], g1[1], g1[2], g1[3]};
                float up[8] = {u0[0], u0[1], u0[2], u0[3], u1[0], u1[1], u1[2], u1[3]};
                f(row0 + ai * HALF + m * 16, col0, g, up);
            }
    }
};
template <class F> struct Epi4 {
    static constexpr bool PERM = false, AFTER_DRAIN = false;
    F f;
    __device__ __forceinline__ void operator()(const f32x4 (&acc)[2][2][4][2], const Unit& u, int wr, int wc, int fr, int fq) const {
        const int row0 = u.pm * BM + wr * 64 + fr, col0 = u.pn * BM + wc * 32 + 4 * fq;
#pragma unroll
        for (int ai = 0; ai < 2; ++ai)
#pragma unroll
            for (int m = 0; m < 4; ++m) {
#pragma unroll
                for (int bj = 0; bj < 2; ++bj)
#pragma unroll
                    for (int n = 0; n < 2; ++n) f(row0 + ai * HALF + m * 16, col0 + bj * HALF + n * 16, acc[ai][bj][m][n], u);
            }
    }
};
template <class Epi, class Sched, bool ALIGN_EPI = false, bool SP2 = false>
__device__ __forceinline__ void gemm_phase(PG8_LAS unsigned char* lds, const Gemm g, const Sched& S, const Epi& E) {
    int tid_o = threadIdx.x; asm volatile("" : "+v"(tid_o));
    const int tid = tid_o, wid = __builtin_amdgcn_readfirstlane(tid >> 6), lane = tid & 63, wr = wid >> 2, wc = wid & 3, fr = lane & 15, fq = lane >> 4;
    const int K = g.K, nt = K / BK;
    unsigned voffA[2], voffB[2];
#pragma unroll
    for (int i = 0; i < 2; ++i) { int R, C; stage_rc(tid * 16 + i * 8192, R, C); const int Rb = Epi::PERM ? ((R & ~31) + perm32(R & 31)) : R;
        voffA[i] = (unsigned)(R * K + C) * 2u; voffB[i] = (unsigned)(Rb * K + C) * 2u; }
    const size_t kstep = (size_t)(BK * 2);
    const size_t hstep = (size_t)HALF * K * 2;
    const size_t tstep = 2 * hstep;
    const unsigned ldsw = (unsigned)wid * 1024u;
    const int aoff = lds_byte(wr * 64 + fr, fq * 8), boff = lds_byte(wc * 32 + fr, fq * 8);
#define PG8_SA(b, h) (((b) * 2 + (h)) * HTB)
#define PG8_SB(b, h) ((4 + (b) * 2 + (h)) * HTB)
#define PG8_STAGE(bufoff, gbase, voff) do { _Pragma("unroll") for (int _i = 0; _i < 2; ++_i) \
        __builtin_amdgcn_global_load_lds((const unsigned*)((const char*)(gbase) + (voff)[_i]), (PG8_LAS unsigned*)(lds + (bufoff) + ldsw + _i * 8192), 16, 0, 0); } while (0)
#define PG8_LDA(dst, b, h) do { _Pragma("unroll") for (int m = 0; m < 4; ++m) _Pragma("unroll") for (int k = 0; k < 2; ++k) dst[m][k] = *(const PG8_LAS bf16x8*)(lds + PG8_SA(b, h) + aoff + m * 2048 + k * 1024); } while (0)
#define PG8_LDB(dst, b, h) do { _Pragma("unroll") for (int n = 0; n < 2; ++n) _Pragma("unroll") for (int k = 0; k < 2; ++k) dst[n][k] = *(const PG8_LAS bf16x8*)(lds + PG8_SB(b, h) + boff + n * 2048 + k * 1024); } while (0)
#define PG8_MMA(ai, bj, At, Bt) do { __builtin_amdgcn_s_setprio(1); _Pragma("unroll") for (int m = 0; m < 4; ++m) _Pragma("unroll") for (int n = 0; n < 2; ++n) _Pragma("unroll") for (int k = 0; k < 2; ++k) \
        acc[ai][bj][m][n] = __builtin_amdgcn_mfma_f32_16x16x32_bf16(Bt[n][k], At[m][k], acc[ai][bj][m][n], 0, 0, 0); __builtin_amdgcn_s_setprio(0); } while (0)
#define PG8_WAIT_V(n) asm volatile("s_waitcnt vmcnt(" #n ")" ::: "memory")
#define PG8_WAIT_L(n) asm volatile("s_waitcnt lgkmcnt(" #n ")" ::: "memory")
#define PG8_BAR __builtin_amdgcn_s_barrier()
#define PG8_SCHED __builtin_amdgcn_sched_barrier(0)
    Unit cur, nxt; int ui = 0;
    if (!S.next(0, cur)) return;
    f32x4 acc[2][2][4][2];
#pragma unroll
    for (int a = 0; a < 2; ++a)
#pragma unroll
        for (int b = 0; b < 2; ++b)
#pragma unroll
            for (int m = 0; m < 4; ++m)
#pragma unroll
                for (int n = 0; n < 2; ++n) acc[a][b][m][n] = (f32x4){0.f, 0.f, 0.f, 0.f};
    bf16x8 At[4][2], B0[2][2], B1[2][2];
    const char* cA = (const char*)g.A + (size_t)cur.pm * tstep; const char* cB = (const char*)g.Bt + (size_t)cur.eb * g.bstride + (size_t)cur.pn * tstep;
    S.a_ready(cur);
    if constexpr (SP2) {
        PG8_STAGE(PG8_SB(0, 0), cB, voffB); PG8_STAGE(PG8_SB(0, 1), cB + hstep, voffB); PG8_STAGE(PG8_SA(0, 0), cA, voffA); PG8_STAGE(PG8_SA(0, 1), cA + hstep, voffA);
        if (wr == 1) PG8_BAR;
        PG8_WAIT_V(2); PG8_BAR;
        PG8_STAGE(PG8_SB(1, 0), cB + kstep, voffB); PG8_STAGE(PG8_SA(1, 0), cA + kstep, voffA); PG8_STAGE(PG8_SB(1, 1), cB + hstep + kstep, voffB);
        PG8_WAIT_V(6); PG8_BAR;
    } else {
        PG8_STAGE(PG8_SB(0, 0), cB, voffB); PG8_STAGE(PG8_SA(0, 0), cA, voffA); PG8_STAGE(PG8_SB(0, 1), cB + hstep, voffB); PG8_STAGE(PG8_SA(0, 1), cA + hstep, voffA);
        if (wr == 1) PG8_BAR;
        PG8_WAIT_V(4); PG8_BAR;
        PG8_STAGE(PG8_SB(1, 0), cB + kstep, voffB); PG8_STAGE(PG8_SA(1, 0), cA + kstep, voffA); PG8_STAGE(PG8_SB(1, 1), cB + hstep + kstep, voffB);
        PG8_WAIT_V(6); PG8_BAR;
    }
    for (;;) {
        const bool has_next = S.next(ui + 1, nxt);
        const char* nA = has_next ? (const char*)g.A + (size_t)nxt.pm * tstep : cA; const char* nB = has_next ? (const char*)g.Bt + (size_t)nxt.eb * g.bstride + (size_t)nxt.pn * tstep : cB;
#pragma nounroll
        for (int t = 0; t < nt; t += 2) {
            const bool last = (t == nt - 2);
            const char* a1 = cA + (size_t)(t + 1) * kstep;
            const char* a2 = last ? nA : cA + (size_t)(t + 2) * kstep; const char* b2 = last ? nB : cB + (size_t)(t + 2) * kstep;
            const char* a3 = a2 + kstep; const char* b3 = b2 + kstep;
            if (last && has_next) S.a_ready(nxt);
            if constexpr (SP2) {
            PG8_LDB(B0, 0, 0); PG8_LDB(B1, 0, 1); PG8_SCHED; PG8_LDA(At, 0, 0); PG8_STAGE(PG8_SA(1, 1), a1 + hstep, voffA);
            PG8_WAIT_V(8); PG8_WAIT_L(0); PG8_BAR; PG8_MMA(0, 0, At, B0); PG8_MMA(0, 1, At, B1); PG8_BAR; PG8_SCHED;
            PG8_LDA(At, 0, 1); PG8_STAGE(PG8_SB(0, 0), b2, voffB); PG8_STAGE(PG8_SB(0, 1), b2 + hstep, voffB); PG8_STAGE(PG8_SA(0, 0), a2, voffA);
            PG8_WAIT_V(8); PG8_WAIT_L(0); PG8_BAR; PG8_MMA(1, 0, At, B0); PG8_MMA(1, 1, At, B1); PG8_BAR; PG8_SCHED;
            PG8_LDB(B0, 1, 0); PG8_LDB(B1, 1, 1); PG8_SCHED; PG8_LDA(At, 1, 0); PG8_STAGE(PG8_SA(0, 1), a2 + hstep, voffA);
            PG8_WAIT_V(8); PG8_WAIT_L(0); PG8_BAR; PG8_MMA(0, 0, At, B0); PG8_MMA(0, 1, At, B1); PG8_BAR; PG8_SCHED;
            PG8_LDA(At, 1, 1); PG8_STAGE(PG8_SB(1, 0), b3, voffB); PG8_STAGE(PG8_SB(1, 1), b3 + hstep, voffB); PG8_STAGE(PG8_SA(1, 0), a3, voffA);
            PG8_WAIT_V(8); PG8_WAIT_L(0); PG8_BAR; PG8_MMA(1, 0, At, B0); PG8_MMA(1, 1, At, B1); PG8_BAR; PG8_SCHED;
            } else {
            PG8_LDB(B0, 0, 0); PG8_SCHED; PG8_LDA(At, 0, 0); PG8_STAGE(PG8_SA(1, 1), a1 + hstep, voffA);
            PG8_WAIT_L(8); PG8_BAR; PG8_WAIT_L(0); PG8_MMA(0, 0, At, B0); PG8_BAR; PG8_SCHED;
            PG8_LDB(B1, 0, 1); PG8_STAGE(PG8_SB(0, 0), b2, voffB);
            PG8_BAR; PG8_WAIT_L(0); PG8_MMA(0, 1, At, B1); PG8_BAR;
            PG8_LDA(At, 0, 1); PG8_STAGE(PG8_SA(0, 0), a2, voffA);
            PG8_BAR; PG8_WAIT_L(0); PG8_MMA(1, 0, At, B0); PG8_BAR; PG8_SCHED;
            PG8_STAGE(PG8_SB(0, 1), b2 + hstep, voffB);
            PG8_WAIT_V(6); PG8_BAR; PG8_MMA(1, 1, At, B1); PG8_BAR;
            PG8_LDB(B0, 1, 0); PG8_SCHED; PG8_LDA(At, 1, 0); PG8_STAGE(PG8_SA(0, 1), a2 + hstep, voffA);
            PG8_WAIT_L(8); PG8_BAR; PG8_WAIT_L(0); PG8_MMA(0, 0, At, B0); PG8_BAR; PG8_SCHED;
            PG8_LDB(B1, 1, 1); PG8_STAGE(PG8_SB(1, 0), b3, voffB);
            PG8_BAR; PG8_WAIT_L(0); PG8_MMA(0, 1, At, B1); PG8_BAR;
            PG8_LDA(At, 1, 1); PG8_STAGE(PG8_SA(1, 0), a3, voffA);
            PG8_BAR; PG8_WAIT_L(0); PG8_MMA(1, 0, At, B0); PG8_BAR; PG8_SCHED;
            PG8_STAGE(PG8_SB(1, 1), b3 + hstep, voffB);
            PG8_WAIT_V(6); PG8_BAR; PG8_MMA(1, 1, At, B1); PG8_BAR;
            }
        }
        if constexpr (ALIGN_EPI) { if (wr == 0) PG8_BAR; }
        if constexpr (!Epi::AFTER_DRAIN) { E(acc, cur, wr, wc, fr, fq); S.done(cur); }
        if (!has_next) break;
#pragma unroll
        for (int a = 0; a < 2; ++a)
#pragma unroll
            for (int b = 0; b < 2; ++b)
#pragma unroll
                for (int m = 0; m < 4; ++m)
#pragma unroll
                    for (int n = 0; n < 2; ++n) acc[a][b][m][n] = (f32x4){0.f, 0.f, 0.f, 0.f};
        cur = nxt; cA = nA; cB = nB; ++ui;
        if constexpr (ALIGN_EPI) { if (wr == 1) PG8_BAR; }
    }
    PG8_WAIT_V(0);
    if constexpr (!ALIGN_EPI) { if (wr == 0) PG8_BAR; }
    PG8_BAR;
    if constexpr (Epi::AFTER_DRAIN) { E.fused(acc, cur, wr, wc, fr, fq, lds, wid, lane); S.done(cur); }
#undef PG8_SA
#undef PG8_SB
#undef PG8_STAGE
#undef PG8_LDA
#undef PG8_LDB
#undef PG8_MMA
#undef PG8_WAIT_V
#undef PG8_WAIT_L
#undef PG8_BAR
#undef PG8_SCHED
}
}

#ifndef PG8_SP2
#define PG8_SP2 true
#endif
#ifndef PG8_ALIGN
#define PG8_ALIGN true
#endif
#define XB_TMO      128
#define XB_XCNT(j)  (256  + 64 * (j))
#define XB_XSUB(j)  (1280 + 64 * (j))
#define XB_XGEN(j)  (2304 + 64 * (j))
#define XB_TOP      3328
#define XB_TOPGEN   3392
#define XCD_BAR_WORDS 3456
#define XB_SPIN_CAP (1u << 18)

__device__ __forceinline__ unsigned xb_ld(unsigned* p)              { return __hip_atomic_load(p, __ATOMIC_RELAXED, __HIP_MEMORY_SCOPE_AGENT); }
__device__ __forceinline__ unsigned xb_add(unsigned* p, unsigned v) { return __hip_atomic_fetch_add(p, v, __ATOMIC_RELAXED, __HIP_MEMORY_SCOPE_AGENT); }
__device__ __forceinline__ unsigned xb_xcc_id() { return (unsigned)__builtin_amdgcn_s_getreg((3 << 11) | 20) & 0xFu; }
#define XB_SPIN(cond, bar) do { unsigned _sp = 0; while (cond) { __builtin_amdgcn_s_sleep(1); \
    if ((++_sp & 255u) == 0u) { if (xb_ld(&(bar)[XB_TMO])) break; if (_sp > XB_SPIN_CAP) { atomicAdd(&(bar)[XB_TMO], 1u); break; } } } } while (0)

struct XcdBarrier {
    unsigned* bar; unsigned x;
    volatile LAS unsigned* st;
};

__device__ __forceinline__ XcdBarrier xcd_barrier_post(unsigned* bar, volatile LAS unsigned* st) {
    XcdBarrier b; b.bar = bar; b.x = xb_xcc_id(); b.st = st;
    if (threadIdx.x == 0) (void)xb_add(&bar[XB_XCNT(b.x)], 1u);
    return b;
}
__device__ __forceinline__ void xcd_barrier_complete(unsigned* bar, unsigned x, unsigned& nloc, unsigned& nx) {
    const unsigned G = gridDim.x * gridDim.y * gridDim.z;
    unsigned sum, cnt, mine, sp = 0u;
    for (;;) {
        sum = 0u; cnt = 0u; mine = 0u;
#pragma unroll
        for (unsigned j = 0; j < 16; ++j) { const unsigned c = xb_ld(&bar[XB_XCNT(j)]); sum += c; cnt += (c > 0u) ? 1u : 0u; mine = (j == x) ? c : mine; }
        if (sum == G) break;
        __builtin_amdgcn_s_sleep(1);
        if ((++sp & 255u) == 0u) { if (xb_ld(&bar[XB_TMO])) break; if (sp > XB_SPIN_CAP) { atomicAdd(&bar[XB_TMO], 1u); break; } }
    }
    nloc = mine > 0u ? mine : 1u; nx = cnt > 0u ? cnt : 1u;
}

__device__ __forceinline__ void xcd_barrier(const XcdBarrier& b) {
    asm volatile("s_waitcnt vmcnt(0)" ::: "memory");
    __syncthreads();
    if (threadIdx.x == 0) {
        unsigned* bar = b.bar;
        __builtin_amdgcn_s_waitcnt(0);
        unsigned nloc = b.st[0], nx = b.st[1];
        if (nloc == 0u) { xcd_barrier_complete(bar, b.x, nloc, nx); b.st[0] = nloc; b.st[1] = nx; }
        const unsigned old = xb_add(&bar[XB_XSUB(b.x)], 1u);
        const unsigned gen = old / nloc;
        if (old + 1u == (gen + 1u) * nloc) {
            __builtin_amdgcn_fence(__ATOMIC_RELEASE, "agent");
            asm volatile("s_waitcnt vmcnt(0)" ::: "memory");
            const unsigned og = xb_add(&bar[XB_TOP], 1u);
            const unsigned tg = og / nx;
            if (og + 1u == (tg + 1u) * nx) xb_add(&bar[XB_TOPGEN], 1u);
            else XB_SPIN(xb_ld(&bar[XB_TOPGEN]) == tg, bar);
            __builtin_amdgcn_fence(__ATOMIC_ACQUIRE, "agent");
            xb_add(&bar[XB_XGEN(b.x)], 1u);
            asm volatile("s_waitcnt vmcnt(0)" ::: "memory");
        } else {
            XB_SPIN(xb_ld(&bar[XB_XGEN(b.x)]) == gen, bar);
            __builtin_amdgcn_fence(__ATOMIC_ACQUIRE, "agent");
            asm volatile("s_waitcnt vmcnt(0)" ::: "memory");
        }
    }
    __syncthreads();
}
struct KC {
    const float* const* in;
    LAS unsigned char* lds;
    unsigned char* ws;
    int tid, lane, wave, G, bid;
};
__device__ __forceinline__ const float* inp_(int i) {
    const volatile unsigned long long __attribute__((address_space(4)))* kp = (const volatile unsigned long long __attribute__((address_space(4)))*)__builtin_amdgcn_kernarg_segment_ptr();
    return (const float*)(const GAS float*)kp[i];
}
#define INP(k) (inp_(k))

__device__ __forceinline__ int mod_row(int row) { return row < TL ? (row >> 11) : 8; }

__device__ __forceinline__ void ph_adaln_partials(const KC& k, const float* c, const float* c_ctx, const float* w_ada) {
    LAS float* sc = (LAS float*)k.lds;
    for (int i = k.tid; i < 9 * DM; i += 512) { const int r = i >> 11, kk = i & 2047; const float cv = r < 8 ? c[r * DM + kk] : c_ctx[kk]; sc[i] = siluf(cv); }
    __syncthreads();
    float* modp = (float*)(k.ws + WS_MODP);
    const int cc = k.tid & 255, kh = k.tid >> 8;
    constexpr int NIT = DEPTH * 48 * 16;
    for (int it = k.bid; it < NIT; it += k.G) {
        const int l = it / 768, rem = it % 768, cb = rem >> 4, ks = rem & 15;
        const int col = cb * 256 + cc, kbeg = ks * 128 + kh * 64;
        const float* W = w_ada + ((size_t)l * DM + kbeg) * MOD_N + col;
        float acc[9];
#pragma unroll
        for (int r = 0; r < 9; ++r) acc[r] = 0.f;
#pragma unroll 8
        for (int q = 0; q < 64; ++q) {
            const float w = W[(size_t)q * MOD_N];
#pragma unroll
            for (int r = 0; r < 9; ++r) acc[r] += sc[r * DM + kbeg + q] * w;
        }
        const int s = ks * 2 + kh;
#pragma unroll
        for (int r = 0; r < 9; ++r) modp[(((size_t)s * DEPTH + l) * 9 + r) * MOD_N + col] = acc[r];
    }
    __syncthreads();
}
__device__ __forceinline__ void ph_adaln_reduce(const KC& k, const float* b_ada) {
    const float* modp = (const float*)(k.ws + WS_MODP); float* mod = (float*)(k.ws + WS_MOD);
    constexpr int TOT = DEPTH * 9 * MOD_N;
    for (int i = k.bid * 512 + k.tid; i < TOT; i += k.G * 512) {
        const int n = i % MOD_N, l = i / (9 * MOD_N);
        float s = b_ada[l * MOD_N + n];
#pragma unroll 8
        for (int q = 0; q < KSPLIT; ++q) s += modp[(size_t)q * TOT + i];
        mod[i] = s;
    }
}

struct TrItem { const float* src; bf16* dst; int srcN, Kv, Nv, k0, n0, dpitch, drow0, dk0; };
struct WSrc { const float *w_in, *w2, *a2, *g2, *wba, *wbb, *wout, *eg, *eu, *ed, *w0, *a0; };
constexpr int TI_IN = 32 * 336, TI_LO = 4 * 64, TI_G2 = 4 * 32, TI_AB = 16 * 64, TI_O = 32 * 64, TI_GU1 = 32 * 44, TI_D1 = 22 * 64;
constexpr int TI_N = TI_IN + TI_LO + TI_G2 + 2 * TI_AB + TI_O + 2 * NEXP * TI_GU1 + NEXP * TI_D1;
__device__ __forceinline__ TrItem tr_decode(const WSrc& s, unsigned char* ws, int l, int it) {
    TrItem t; int r = it;
    if (r < TI_IN) { const int kb = r / 336, nb = r % 336; t = TrItem{s.w_in + (size_t)l * DM * IN_DIM, (bf16*)(ws + WT_IN), IN_DIM, DM, IN_DIM, 64 * kb, 32 * nb, DM, 32 * nb, 0}; return t; } r -= TI_IN;
    if (r < TI_LO) {
        const int mtx = r >> 6, q = r & 63, kb = q >> 5, nb = q & 31;
        t = TrItem{(mtx < 2 ? s.w2 : s.a2) + (size_t)(l * 2 + (mtx & 1)) * 96 * RD, (bf16*)(ws + WT_L1), RD, 96, RD, 64 * kb, 32 * nb, 256, mtx * 1024 + 32 * nb, mtx < 2 ? 0 : 96}; return t; } r -= TI_LO;
    if (r < TI_G2) { const int kb = r >> 5, nb = r & 31; t = TrItem{s.g2 + (size_t)l * 256 * RD, (bf16*)(ws + WT_G2), RD, 256, RD, 64 * kb, 32 * nb, 256, 32 * nb, 0}; return t; } r -= TI_G2;
    if (r < TI_AB) { const int kb = r >> 6, nb = r & 63; t = TrItem{s.wba + (size_t)l * RD * DM, (bf16*)(ws + WT_A), DM, RD, DM, 64 * kb, 32 * nb, RD, 32 * nb, 0}; return t; } r -= TI_AB;
    if (r < TI_AB) { const int kb = r >> 6, nb = r & 63; t = TrItem{s.wbb + (size_t)l * GVD * DM, (bf16*)(ws + WT_B), DM, GVD, DM, 64 * kb, 32 * nb, GVD, 32 * nb, 0}; return t; } r -= TI_AB;
    if (r < TI_O) { const int kb = r >> 6, nb = r & 63; t = TrItem{s.wout + (size_t)l * DM * DM, (bf16*)(ws + WT_O), DM, DM, DM, 64 * kb, 32 * nb, DM, 32 * nb, 0}; return t; } r -= TI_O;
    if (r < 2 * NEXP * TI_GU1) {
        const int e = r / (2 * TI_GU1), q = r % (2 * TI_GU1), up = q / TI_GU1, q2 = q % TI_GU1, kb = q2 / 44, nb = q2 % 44;
        const int n0 = 32 * nb, drow = 256 * (n0 >> 7) + (n0 & 127) + (up ? 128 : 0);
        t = TrItem{(up ? s.eu : s.eg) + ((size_t)l * NEXP + e) * DM * DEXP, (bf16*)(ws + WT_GU) + (size_t)e * 2816 * DM, DEXP, DM, DEXP, 64 * kb, n0, DM, drow, 0}; return t; } r -= 2 * NEXP * TI_GU1;
    { const int e = r / TI_D1, q = r % TI_D1, kb = q >> 6, nb = q & 63;
      t = TrItem{s.ed + ((size_t)l * NEXP + e) * DEXP * DM, (bf16*)(ws + WT_D) + (size_t)e * DM * DEXP, DM, DEXP, DM, 64 * kb, 32 * nb, DEXP, 32 * nb, 0}; }
    return t;
}
__device__ __forceinline__ void tr_load(const TrItem& t, int lane, float (&v)[32]) {
    const int nn = lane & 31, kh = lane >> 5;
    const bool nok = t.n0 + nn < t.Nv;
    const float* p = t.src + (size_t)(t.k0 + kh) * t.srcN + t.n0 + nn;
#pragma unroll
    for (int i = 0; i < 32; ++i) { v[i] = 0.f; if (nok && t.k0 + 2 * i + kh < t.Kv) v[i] = p[(size_t)(2 * i) * t.srcN]; }
}
__device__ __forceinline__ void tr_store(const TrItem& t, int lane, const float (&v)[32], LAS float* scr) {
    const int nn = lane & 31, kh = lane >> 5;
#pragma unroll
    for (int i = 0; i < 32; ++i) scr[(2 * i + kh) * 33 + nn] = v[i];
    asm volatile("s_waitcnt lgkmcnt(0)" ::: "memory");
    const int cidx = lane & 7;
#pragma unroll
    for (int j = 0; j < 4; ++j) {
        const int n = (lane >> 3) + 8 * j; const LAS float* s = scr + (8 * cidx) * 33 + n;
        u32x4 o; o.x = pk2(s[0 * 33], s[1 * 33]); o.y = pk2(s[2 * 33], s[3 * 33]); o.z = pk2(s[4 * 33], s[5 * 33]); o.w = pk2(s[6 * 33], s[7 * 33]);
        *(u32x4*)(t.dst + (size_t)(t.drow0 + n) * t.dpitch + t.dk0 + t.k0 + 8 * cidx) = o;
    }
    asm volatile("s_waitcnt lgkmcnt(0)" ::: "memory");
}
__device__ __forceinline__ void ph_convert(const KC& k, const WSrc& s, int l) {
    LAS float* scr = (LAS float*)(k.lds + k.wave * 16384);
    const int gw = k.bid * 8 + k.wave, NGW = k.G * 8;
    unsigned char* ws = k.ws;
    { float* b1 = (float*)(ws + WS_TAB + TAB_TOP); for (int i = gw * 64 + k.lane; i < 4096; i += NGW * 64) b1[i] = i < 2048 ? s.w0[l * 2048 + i] : s.a0[l * 2048 + i - 2048]; }
    float cur[32], nxt[32];
    int it = gw;
    TrItem tc = tr_decode(s, ws, l, it < TI_N ? it : 0);
    if (it < TI_N) tr_load(tc, k.lane, cur);
    for (; it < TI_N; it += NGW) {
        const bool more = it + NGW < TI_N;
        const TrItem tn = tr_decode(s, ws, l, more ? it + NGW : it);
        if (more) tr_load(tn, k.lane, nxt);
        tr_store(tc, k.lane, cur, scr);
        tc = tn;
#pragma unroll
        for (int i = 0; i < 32; ++i) cur[i] = nxt[i];
    }
}

struct RowArgs { const float *x_in, *ctx_in, *gvec, *router_w, *router_b; float* out; };
template <int MODE>
__device__ __forceinline__ void ph_rows(const KC& k, const RowArgs& ra, int l, int nrows, bool dry = false) {
    const int gw = k.bid * 8 + k.wave, NGW = k.G * 8, lane = k.lane;
    float* X = (float*)(k.ws + WS_X); bf16* H = (bf16*)(k.ws + WS_H);
    const float* MOD = (const float*)(k.ws + WS_MOD);
    const bf16* YF = (const bf16*)(k.ws + WS_YF);
    LAS float* rwT = (LAS float*)k.lds;
    if (MODE == 1) {
        for (int i = k.tid; i < DM * NEXP; i += 512) { const int c = i >> 4, e = i & 15; rwT[e * DM + c] = ra.router_w[i]; }
        __syncthreads();
    }
    const float* gv = ra.gvec;
    for (int row = gw; row < nrows; row += NGW) {
        const int mr = mod_row(row);
        f32x4 v[8];
        if (MODE == 0 && l == 0) {
            const f32x4* src = (const f32x4*)(row < TL ? ra.x_in + (size_t)row * DM : ra.ctx_in + (size_t)(row - TL) * DM) + lane;
#pragma unroll
            for (int j = 0; j < 8; ++j) v[j] = src[64 * j];
        } else {
            const f32x4* src = (const f32x4*)(X + (size_t)row * DM) + lane;
#pragma unroll
            for (int j = 0; j < 8; ++j) v[j] = src[64 * j];
        }
        if ((MODE == 0 && l > 0) || MODE == 2) {
            const int lp = (MODE == 2) ? DEPTH - 1 : l - 1;
            const f32x4* gate = (const f32x4*)(MOD + ((size_t)lp * 9 + mr) * MOD_N + 5 * DM) + lane;
            const u32x2* y0 = (const u32x2*)(YF + (size_t)row * DM) + lane;
            const u32x2* y1 = (const u32x2*)(YF + ((size_t)TA + row) * DM) + lane;
#pragma unroll
            for (int j = 0; j < 8; ++j) {
                const f32x4 g = gate[64 * j]; const u32x2 a = y0[64 * j], b = y1[64 * j];
                v[j].x += g.x * (bflo(a.x) + bflo(b.x)); v[j].y += g.y * (bfhi(a.x) + bfhi(b.x));
                v[j].z += g.z * (bflo(a.y) + bflo(b.y)); v[j].w += g.w * (bfhi(a.y) + bfhi(b.y));
            }
        }
        if (MODE == 0) {
            f32x4* dst = (f32x4*)(X + (size_t)row * DM) + lane;
#pragma unroll
            for (int j = 0; j < 8; ++j) dst[64 * j] = v[j];
        }
        float ss = 0.f;
#pragma unroll
        for (int j = 0; j < 8; ++j) ss += (v[j].x * v[j].x + v[j].y * v[j].y) + (v[j].z * v[j].z + v[j].w * v[j].w);
        const float rinv = 1.0f / sqrtf(wave_sum(ss) * (1.0f / DM) + 1e-6f);
        if (MODE == 2) {
            f32x4* dst = (f32x4*)(ra.out + (size_t)row * DM) + lane; const f32x4* g4 = (const f32x4*)gv + lane;
#pragma unroll
            for (int j = 0; j < 8; ++j) { const f32x4 g = g4[64 * j]; dst[64 * j] = v[j] * rinv * g; }
        } else {
            const float* mrow = MOD + ((size_t)l * 9 + mr) * MOD_N + (MODE == 0 ? 0 : 3 * DM);
            const f32x4* sh4 = (const f32x4*)mrow + lane; const f32x4* sc4 = (const f32x4*)(mrow + DM) + lane; const f32x4* g4 = (const f32x4*)(gv + (size_t)l * DM) + lane;
            u32x2* dst = (u32x2*)(H + (size_t)row * DM) + lane;
#pragma unroll
            for (int j = 0; j < 8; ++j) {
                const f32x4 g = g4[64 * j], sh = sh4[64 * j], sc = sc4[64 * j];
                v[j] = v[j] * rinv * g * (1.0f + sc) + sh;
                u32x2 o; o.x = pk2(v[j].x, v[j].y); o.y = pk2(v[j].z, v[j].w); dst[64 * j] = o;
            }
        }
        if (MODE == 1) {
            float lg[NEXP];
#pragma unroll
            for (int e = 0; e < NEXP; ++e) {
                float s = 0.f;
#pragma unroll
                for (int j = 0; j < 8; ++j) { const f32x4 w = *(const LAS f32x4*)(rwT + e * DM + 4 * lane + 256 * j); s += (v[j].x * w.x + v[j].y * w.y) + (v[j].z * w.z + v[j].w * w.w); }
                lg[e] = wave_sum(s);
            }
            float sc[NEXP], sel[NEXP];
#pragma unroll
            for (int e = 0; e < NEXP; ++e) { sc[e] = 1.0f / (1.0f + expf(-lg[e])); sel[e] = sc[e] + ra.router_b[e]; }
            float gs[4], w1g[4], w2g[4]; int i1g[4], i2g[4];
#pragma unroll
            for (int g = 0; g < 4; ++g) {
                int i1 = 0; float m1 = sel[4 * g];
#pragma unroll
                for (int q = 1; q < 4; ++q) if (sel[4 * g + q] > m1) { m1 = sel[4 * g + q]; i1 = q; }
                int i2 = -1; float m2 = -3.0e38f;
#pragma unroll
                for (int q = 0; q < 4; ++q) if (q != i1 && sel[4 * g + q] > m2) { m2 = sel[4 * g + q]; i2 = q; }
                gs[g] = m1 + m2; i1g[g] = 4 * g + i1; i2g[g] = 4 * g + i2;
                float a1 = sc[4 * g], a2 = sc[4 * g];
#pragma unroll
                for (int q = 0; q < 4; ++q) { a1 = (q == i1) ? sc[4 * g + q] : a1; a2 = (q == i2) ? sc[4 * g + q] : a2; }
                w1g[g] = a1; w2g[g] = a2;
            }
            int best = 0; float bs = gs[0];
#pragma unroll
            for (int g = 1; g < 4; ++g) if (gs[g] > bs) { bs = gs[g]; best = g; }
            int e1 = i1g[0], e2 = i2g[0]; float w1 = w1g[0], w2 = w2g[0];
#pragma unroll
            for (int g = 1; g < 4; ++g) { e1 = (best == g) ? i1g[g] : e1; e2 = (best == g) ? i2g[g] : e2; w1 = (best == g) ? w1g[g] : w1; w2 = (best == g) ? w2g[g] : w2; }
            const float inv = 1.0f / (w1 + w2);
            if (lane == 0 && !dry) {
                unsigned* cnt = (unsigned*)(k.ws + WS_CTL) + CW_CNT + 64 * l;
                const int p1 = (int)atomicAdd(cnt + e1, 1u), p2 = (int)atomicAdd(cnt + e2, 1u);
                int* te = (int*)(k.ws + WS_TOPK); float* tw = (float*)(k.ws + WS_TOPK + (size_t)TA * 8); int* tp = (int*)(k.ws + WS_TOPK + 2 * (size_t)TA * 8);
                te[2 * row] = e1; te[2 * row + 1] = e2; tw[2 * row] = w1 * inv; tw[2 * row + 1] = w2 * inv; tp[2 * row] = p1; tp[2 * row + 1] = p2;
            }
        }
    }
    if (MODE == 1) __syncthreads();
}

__device__ __forceinline__ void ph_moe_scatter(const KC& k, int l, int nrows) {
    LAS int* offs = (LAS int*)k.lds;
    const unsigned* cnt = (const unsigned*)(k.ws + WS_CTL) + CW_CNT + 64 * l;
    int* tile = (int*)(k.ws + WS_TAB + TAB_TILE) + 256 * l;
    if (k.tid == 0) {
        int off = 0, nt = 0;
        for (int e = 0; e < NEXP; ++e) {
            offs[e] = off; const int c = (int)__hip_atomic_load(cnt + e, __ATOMIC_RELAXED, __HIP_MEMORY_SCOPE_AGENT); const int t = (c + 255) >> 8;
            if (k.bid == 0) for (int q = 0; q < t; ++q) tile[1 + nt + q] = e;
            nt += t; off += t * 256;
        }
        if (k.bid == 0) tile[0] = nt;
    }
    __syncthreads();
    const int gw = k.bid * 8 + k.wave, NGW = k.G * 8, lane = k.lane;
    const bf16* H = (const bf16*)(k.ws + WS_H); bf16* HP = (bf16*)(k.ws + WS_HP);
    const int* te = (const int*)(k.ws + WS_TOPK); const float* tw = (const float*)(k.ws + WS_TOPK + (size_t)TA * 8); const int* tp = (const int*)(k.ws + WS_TOPK + 2 * (size_t)TA * 8);
    int* rowtok = (int*)(k.ws + WS_TAB + TAB_ROWTOK) + (size_t)l * MOE_ROWS; float* roww = (float*)(k.ws + WS_TAB + TAB_ROWW) + (size_t)l * MOE_ROWS;
    for (int row = gw; row < nrows; row += NGW) {
        const u32x4* src = (const u32x4*)(H + (size_t)row * DM) + lane;
        u32x4 d[4];
#pragma unroll
        for (int j = 0; j < 4; ++j) d[j] = src[64 * j];
#pragma unroll
        for (int s = 0; s < 2; ++s) {
            const int e = te[2 * row + s], dest = offs[e] + tp[2 * row + s];
            u32x4* dp = (u32x4*)(HP + (size_t)dest * DM) + lane;
#pragma unroll
            for (int j = 0; j < 4; ++j) dp[64 * j] = d[j];
            if (lane == 0) { rowtok[dest] = 2 * row + s; roww[dest] = tw[2 * row + s]; }
        }
    }
    __syncthreads();
}
__device__ __forceinline__ void ld16(const bf16* p, bool ok, float (&o)[16]) {
    if (ok) { const u32x4 a = *(const u32x4*)p, b = *(const u32x4*)(p + 8); float x[8], y[8]; unpack8(a, x); unpack8(b, y);
#pragma unroll
        for (int i = 0; i < 8; ++i) { o[i] = x[i]; o[8 + i] = y[i]; } }
    else {
#pragma unroll
        for (int i = 0; i < 16; ++i) o[i] = 0.f; }
}
__device__ __forceinline__ void st16(bf16* p, const float (&v)[16]) {
    float a[8], b[8];
#pragma unroll
    for (int i = 0; i < 8; ++i) { a[i] = v[i]; b[i] = v[8 + i]; }
    *(u32x4*)p = pack8(a); *(u32x4*)(p + 8) = pack8(b);
}
__device__ __forceinline__ void shift8(const bf16* p0, bool hp, bool hn, int c, const float* mu0, const float* mu1, float (&s)[8]) {
    float x[8], xm[8], xp[8];
    unpack8(*(const u32x4*)(p0 + c), x);
    if (hp) unpack8(*(const u32x4*)(p0 - NP + c), xm); else {
#pragma unroll
        for (int i = 0; i < 8; ++i) xm[i] = 0.f; }
    if (hn) unpack8(*(const u32x4*)(p0 + NP + c), xp); else {
#pragma unroll
        for (int i = 0; i < 8; ++i) xp[i] = 0.f; }
    const f32x4 m0a = *(const f32x4*)(mu0 + c), m0b = *(const f32x4*)(mu0 + c + 4), m1a = *(const f32x4*)(mu1 + c), m1b = *(const f32x4*)(mu1 + c + 4);
    const float m0[8] = {m0a.x, m0a.y, m0a.z, m0a.w, m0b.x, m0b.y, m0b.z, m0b.w}, m1[8] = {m1a.x, m1a.y, m1a.z, m1a.w, m1b.x, m1b.y, m1b.z, m1b.w};
#pragma unroll
    for (int i = 0; i < 8; ++i) s[i] = x[i] + m0[i] * (xm[i] - x[i]) + m1[i] * (xp[i] - x[i]);
}
__device__ __forceinline__ void ph_rwkv_prep(const KC& k, int l, int nrows, const float* mu, const float* k_k, const float* r_k) {
    const int gw = k.bid * 8 + k.wave, NGW = k.G * 8, lane = k.lane;
    const bf16* P = (const bf16*)(k.ws + WS_P);
    bf16* R = (bf16*)(k.ws + RW_R); bf16* KS = (bf16*)(k.ws + RW_KS); bf16* V = (bf16*)(k.ws + RW_V); bf16* KK = (bf16*)(k.ws + RW_KK);
    bf16* A1 = (bf16*)(k.ws + RW_A1); bf16* A2 = (bf16*)(k.ws + RW_A2); float* BON = (float*)(k.ws + RW_BON);
    const float* mu0 = mu + (size_t)(l * 2 + 0) * RWKV_IN; const float* mu1 = mu + (size_t)(l * 2 + 1) * RWKV_IN;
    const int rpw = (nrows + NGW - 1) / NGW;
    for (int row = gw * rpw; row < nrows && row < (gw + 1) * rpw; ++row) {
        int t, len; if (row < TL) { t = row & (SEQ - 1); len = SEQ; } else { t = (row - TL) & (CTXL - 1); len = CTXL; }
        const bool hp = t > 0, hn = t < len - 1;
        const bf16* p0 = P + (size_t)row * NP;
#pragma unroll
        for (int half = 0; half < 2; ++half) {
            const int c = half * 512 + 8 * lane;
            float r[8], kx[8], vv[8], kk[8];
            shift8(p0, hp, hn, c, mu0, mu1, r);
            shift8(p0, hp, hn, RD + c, mu0, mu1, kx);
            shift8(p0, hp, hn, 2 * RD + c, mu0, mu1, vv);
            const f32x4 kka = *(const f32x4*)(k_k + l * RD + c), kkb = *(const f32x4*)(k_k + l * RD + c + 4), rka = *(const f32x4*)(r_k + l * RD + c), rkb = *(const f32x4*)(r_k + l * RD + c + 4);
            const float kkw[8] = {kka.x, kka.y, kka.z, kka.w, kkb.x, kkb.y, kkb.z, kkb.w}, rkw[8] = {rka.x, rka.y, rka.z, rka.w, rkb.x, rkb.y, rkb.z, rkb.w};
            float ss = 0.f, bon = 0.f;
#pragma unroll
            for (int i = 0; i < 8; ++i) { kk[i] = kx[i] * kkw[i]; ss += kk[i] * kk[i]; bon += r[i] * kx[i] * rkw[i]; }
            ss += __shfl_xor(ss, 1); ss += __shfl_xor(ss, 2); ss += __shfl_xor(ss, 4);
            bon += __shfl_xor(bon, 1); bon += __shfl_xor(bon, 2); bon += __shfl_xor(bon, 4);
            const float inv = 1.0f / fmaxf(sqrtf(ss), 1e-12f);
#pragma unroll
            for (int i = 0; i < 8; ++i) kk[i] *= inv;
            *(u32x4*)(R + (size_t)row * RD + c) = pack8(r); *(u32x4*)(KS + (size_t)row * RD + c) = pack8(kx);
            *(u32x4*)(V + (size_t)row * RD + c) = pack8(vv); *(u32x4*)(KK + (size_t)row * RD + c) = pack8(kk);
            if ((lane & 7) == 0) BON[(size_t)row * RHEADS + half * 8 + (lane >> 3)] = bon;
        }
        if (lane < 56) {
            float s8[8];
            shift8(p0, hp, hn, 3 * RD + 8 * lane, mu0, mu1, s8);
            if (lane < 12) {
#pragma unroll
                for (int i = 0; i < 8; ++i) { const float e2 = __expf(2.0f * fminf(fmaxf(s8[i], -15.f), 15.f)); s8[i] = 1.0f - 2.0f / (e2 + 1.0f); }
                *(u32x4*)(A1 + (size_t)row * 256 + 8 * lane) = pack8(s8);
            } else if (lane < 24) { *(u32x4*)(A1 + (size_t)row * 256 + 8 * lane) = pack8(s8); }
            else {
#pragma unroll
                for (int i = 0; i < 8; ++i) s8[i] = sigm(s8[i]);
                *(u32x4*)(A2 + (size_t)row * 256 + 8 * (lane - 24)) = pack8(s8);
            }
        } else { *(u32x4*)(A1 + (size_t)row * 256 + 192 + 8 * (lane - 56)) = (u32x4){0u, 0u, 0u, 0u}; }
    }
}

__device__ __forceinline__ float logsig(float x) { return fminf(x, 0.f) - __logf(1.0f + __expf(-fabsf(x))); }
__device__ __forceinline__ int gla_row(bool lat, int b, int s) { return lat ? b * SEQ + (s & 31) * 64 + (s >> 5) : TL + b * CTXL + s; }
constexpr int GQ_PITCH = 264;
constexpr int GPL_AD = 0, GPL_GS = 4096, GPL_QK = GPL_GS + 65536, GPL_END = GPL_QK + 66 * GQ_PITCH * 2;
static_assert(GPL_END <= 131072, "gla prep lds");
__device__ __forceinline__ void ph_gla_prep(const KC& k, int l, const float* conv, const float* aw2, const float* ab) {
    const bf16* P = (const bf16*)(k.ws + WS_P);
    bf16* QG = (bf16*)(k.ws + GL_QG); bf16* KG = (bf16*)(k.ws + GL_KG); bf16* KE = (bf16*)(k.ws + GL_KE); bf16* VS = (bf16*)(k.ws + GL_VS); float* DEC = (float*)(k.ws + GL_DEC);
    const float* cw = conv + (size_t)l * 3 * GQKV;
    const int tid = k.tid, lane = k.lane;
    {
        const int gw = k.bid * 8 + k.wave, NGW = k.G * 8, c = 16 * lane;
        const int rpw = (TA + NGW - 1) / NGW;
        for (int qi = gw * rpw; qi < TA && qi < (gw + 1) * rpw; ++qi) {
            const bool lat = qi < TL; int b, s, len;
            if (lat) { b = qi >> 11; s = qi & 2047; len = SEQ; } else { b = (qi - TL) >> 8; s = (qi - TL) & 255; len = CTXL; }
            const int row = gla_row(lat, b, s);
            const bool hp = s > 0, hn = s + 1 < len;
            const bf16* p0 = P + (size_t)row * NP + GLA_OFF + 2 * GKD + c;
            const bf16* pm = P + (size_t)gla_row(lat, b, hp ? s - 1 : s) * NP + GLA_OFF + 2 * GKD + c;
            const bf16* pp = P + (size_t)gla_row(lat, b, hn ? s + 1 : s) * NP + GLA_OFF + 2 * GKD + c;
            float o[16];
#pragma unroll
            for (int hf = 0; hf < 2; ++hf) {
                float x[8], xm[8], xp[8];
                unpack8(*(const u32x4*)(p0 + 8 * hf), x); unpack8(*(const u32x4*)(pm + 8 * hf), xm); unpack8(*(const u32x4*)(pp + 8 * hf), xp);
                const float* w = cw + 2 * GKD + c + 8 * hf;
#pragma unroll
                for (int q = 0; q < 2; ++q) {
                    const f32x4 w0 = *(const f32x4*)(w + 4 * q), w1 = *(const f32x4*)(w + GQKV + 4 * q), w2 = *(const f32x4*)(w + 2 * GQKV + 4 * q);
#pragma unroll
                    for (int i = 0; i < 4; ++i) o[8 * hf + 4 * q + i] = siluf(w0[i] * (hp ? xm[4 * q + i] : 0.f) + w1[i] * x[4 * q + i] + w2[i] * (hn ? xp[4 * q + i] : 0.f));
                }
            }
            st16(VS + (size_t)row * GVD + c, o);
        }
    }
    LAS float* ADs = (LAS float*)(k.lds + GPL_AD);
    LAS float* Gs = (LAS float*)(k.lds + GPL_GS);
    LAS bf16* QKs = (LAS bf16*)(k.lds + GPL_QK);
    for (int item = k.bid; item < 288 * 4; item += k.G) {
        const int sc = item >> 2, h = item & 3;
        const bool lat = sc < 256; const int b = lat ? (sc >> 5) : ((sc - 256) >> 2), cn = lat ? (sc & 31) : ((sc - 256) & 3), len = lat ? SEQ : CTXL;
        const int gch = lat ? 4 + cn : cn, s0 = 64 * cn;
        for (int i = tid; i < 1024; i += 512) { const int tau = i >> 4, j = i & 15; ADs[i] = bf2f(P[(size_t)gla_row(lat, b, s0 + tau) * NP + GLA_AD_OFF + j]); }
        for (int i = tid; i < 66 * 32; i += 512) {
            const int rr = i >> 5, ck = i & 31, s = s0 - 1 + rr;
            u32x4 v = (u32x4){0u, 0u, 0u, 0u};
            if (s >= 0 && s < len) v = *(const u32x4*)(P + (size_t)gla_row(lat, b, s) * NP + GLA_OFF + (ck >> 4) * GKD + h * GDK + (ck & 15) * 8);
            *(LAS u32x4*)(QKs + rr * GQ_PITCH + ck * 8) = v;
        }
        __syncthreads();
        {
            const int c = tid & 127, tg = tid >> 7, chl = h * GDK + c;
            float awf[16], awb[16];
#pragma unroll
            for (int j = 0; j < 16; ++j) { awf[j] = aw2[((size_t)(l * 2 + 0) * 16 + j) * GKD + chl]; awb[j] = aw2[((size_t)(l * 2 + 1) * 16 + j) * GKD + chl]; }
            const float abf = ab[(l * 2 + 0) * GKD + chl], abb = ab[(l * 2 + 1) * GKD + chl];
            for (int i = 0; i < 16; ++i) {
                const int tau = 16 * tg + i; float xf = abf, xb = abb;
#pragma unroll
                for (int j = 0; j < 16; ++j) { const float a = ADs[tau * 16 + j]; xf += a * awf[j]; xb += a * awb[j]; }
                Gs[tau * 128 + c] = logsig(xf) * (1.0f / 16.0f); Gs[(64 + tau) * 128 + c] = logsig(xb) * (1.0f / 16.0f);
            }
        }
        __syncthreads();
        if (tid < 128) { float run = 0.f; for (int tau = 0; tau < 64; ++tau) { run += Gs[tau * 128 + tid]; Gs[tau * 128 + tid] = run; } }
        else if (tid < 256) { const int c = tid - 128; float run = 0.f; for (int tau = 63; tau >= 0; --tau) { run += Gs[(64 + tau) * 128 + c]; Gs[(64 + tau) * 128 + c] = run; } }
        __syncthreads();
        {
            const int c8 = tid & 15, tg = tid >> 4, chl = h * GDK + 8 * c8;
            float wq[3][8], wk[3][8], elf[8], elb[8];
#pragma unroll
            for (int tp = 0; tp < 3; ++tp) {
                const f32x4 a0 = *(const f32x4*)(cw + tp * GQKV + chl), a1 = *(const f32x4*)(cw + tp * GQKV + chl + 4), b0 = *(const f32x4*)(cw + tp * GQKV + GKD + chl), b1 = *(const f32x4*)(cw + tp * GQKV + GKD + chl + 4);
#pragma unroll
                for (int i = 0; i < 4; ++i) { wq[tp][i] = a0[i]; wq[tp][4 + i] = a1[i]; wk[tp][i] = b0[i]; wk[tp][4 + i] = b1[i]; }
            }
            {
                const f32x4 a0 = *(const LAS f32x4*)(Gs + 63 * 128 + 8 * c8), a1 = *(const LAS f32x4*)(Gs + 63 * 128 + 8 * c8 + 4), b0 = *(const LAS f32x4*)(Gs + 64 * 128 + 8 * c8), b1 = *(const LAS f32x4*)(Gs + 64 * 128 + 8 * c8 + 4);
#pragma unroll
                for (int i = 0; i < 4; ++i) { elf[i] = __expf(a0[i]); elf[4 + i] = __expf(a1[i]); elb[i] = __expf(b0[i]); elb[4 + i] = __expf(b1[i]); }
            }
            if (tg < 8) {
                float* d0 = DEC + ((size_t)(0 * 8 + b) * NCH + gch) * GKD + chl; float* d1 = DEC + ((size_t)(1 * 8 + b) * NCH + gch) * GKD + chl;
                if (tg == 0) { *(f32x4*)d0 = (f32x4){elf[0], elf[1], elf[2], elf[3]}; *(f32x4*)(d0 + 4) = (f32x4){elf[4], elf[5], elf[6], elf[7]}; }
                if (tg == 1) { *(f32x4*)d1 = (f32x4){elb[0], elb[1], elb[2], elb[3]}; *(f32x4*)(d1 + 4) = (f32x4){elb[4], elb[5], elb[6], elb[7]}; }
            }
#pragma unroll
            for (int pass = 0; pass < 2; ++pass) {
                const int tau = tg + 32 * pass;
                float qm[8], q0[8], qp[8], km[8], k0[8], kp[8];
                unpack8(*(const LAS u32x4*)(QKs + (tau + 0) * GQ_PITCH + 8 * c8), qm); unpack8(*(const LAS u32x4*)(QKs + (tau + 1) * GQ_PITCH + 8 * c8), q0); unpack8(*(const LAS u32x4*)(QKs + (tau + 2) * GQ_PITCH + 8 * c8), qp);
                unpack8(*(const LAS u32x4*)(QKs + (tau + 0) * GQ_PITCH + 128 + 8 * c8), km); unpack8(*(const LAS u32x4*)(QKs + (tau + 1) * GQ_PITCH + 128 + 8 * c8), k0); unpack8(*(const LAS u32x4*)(QKs + (tau + 2) * GQ_PITCH + 128 + 8 * c8), kp);
                const f32x4 f0 = *(const LAS f32x4*)(Gs + tau * 128 + 8 * c8), f1 = *(const LAS f32x4*)(Gs + tau * 128 + 8 * c8 + 4), g0 = *(const LAS f32x4*)(Gs + (64 + tau) * 128 + 8 * c8), g1 = *(const LAS f32x4*)(Gs + (64 + tau) * 128 + 8 * c8 + 4);
                const float cf[8] = {f0.x, f0.y, f0.z, f0.w, f1.x, f1.y, f1.z, f1.w}, cb[8] = {g0.x, g0.y, g0.z, g0.w, g1.x, g1.y, g1.z, g1.w};
                float oqf[8], okf[8], oef[8], oqb[8], okb[8], oeb[8];
#pragma unroll
                for (int i = 0; i < 8; ++i) {
                    const float qv = siluf(wq[0][i] * qm[i] + wq[1][i] * q0[i] + wq[2][i] * qp[i]) * 0.08838834764831845f;
                    const float kv = siluf(wk[0][i] * km[i] + wk[1][i] * k0[i] + wk[2][i] * kp[i]);
                    const float ef = __expf(cf[i]), eb = __expf(cb[i]), rf = 1.0f / ef, rb = 1.0f / eb;
                    oqf[i] = qv * ef; okf[i] = kv * rf; oef[i] = kv * rf * elf[i];
                    oqb[i] = qv * eb; okb[i] = kv * rb; oeb[i] = kv * rb * elb[i];
                }
                const size_t o = (size_t)gla_row(lat, b, s0 + tau) * GKD + chl;
                *(u32x4*)(QG + o) = pack8(oqf); *(u32x4*)(KG + o) = pack8(okf); *(u32x4*)(KE + o) = pack8(oef);
                *(u32x4*)(QG + (size_t)TA * GKD + o) = pack8(oqb); *(u32x4*)(KG + (size_t)TA * GKD + o) = pack8(okb); *(u32x4*)(KE + (size_t)TA * GKD + o) = pack8(oeb);
            }
        }
        __syncthreads();
    }
}

__device__ __forceinline__ float dpp_sum16(float x) {
    x += __builtin_bit_cast(float, __builtin_amdgcn_update_dpp(0, __builtin_bit_cast(int, x), 0xB1, 0xF, 0xF, true));
    x += __builtin_bit_cast(float, __builtin_amdgcn_update_dpp(0, __builtin_bit_cast(int, x), 0x4E, 0xF, 0xF, true));
    x += __builtin_bit_cast(float, __builtin_amdgcn_update_dpp(0, __builtin_bit_cast(int, x), 0x141, 0xF, 0xF, true));
    x += __builtin_bit_cast(float, __builtin_amdgcn_update_dpp(0, __builtin_bit_cast(int, x), 0x140, 0xF, 0xF, true));
    return x;
}
constexpr int RS_TOK = 16;
constexpr int RS_TF = 6 * 64;
constexpr int RS_BUF = RS_TOK * RS_TF;
struct RwkvStage { unsigned r, we, a, ks, v, kk; };
__device__ __forceinline__ int rwkv_row(int b, int dir, int p) {
    if (p < CTXL) { const int t = dir ? CTXL - 1 - p : p; return TL + b * CTXL + t; }
    const int q = p - CTXL, t = dir ? SEQ - 1 - q : q; return b * SEQ + t;
}
__device__ __forceinline__ void ph_rwkv_scan(const KC& k, int l, int job, const float* k_a, size_t yoff = RW_Y) {
    const int b = job >> 5, h = (job >> 1) & 15, dir = job & 1;
    const int tid = k.tid;
    const bf16* R = (const bf16*)(k.ws + RW_R); const bf16* KS = (const bf16*)(k.ws + RW_KS); const bf16* V = (const bf16*)(k.ws + RW_V); const bf16* KK = (const bf16*)(k.ws + RW_KK);
    const bf16* LO = (const bf16*)(k.ws + RW_LO); bf16* Y = (bf16*)(k.ws + yoff) + (size_t)dir * TA * RD;
    LAS float* buf = (LAS float*)k.lds;
    LAS f32x2* ypart = (LAS f32x2*)(buf + 2 * RS_BUF);
    const int st = tid >> 5, cp = tid & 31, ch = h * RHS + 2 * cp;
    const float ka0 = k_a[l * RD + ch], ka1 = k_a[l * RD + ch + 1];
    const int kq = tid & 15, rp = tid >> 4, v0 = rp * 2;
    f32x2 S00 = {0.f, 0.f}, S01 = {0.f, 0.f}, S10 = {0.f, 0.f}, S11 = {0.f, 0.f};
    RwkvStage sg;
#define RW_LOAD(chunk) do { const int row_ = rwkv_row(b, dir, (chunk) * RS_TOK + st); \
        sg.r = *(const unsigned*)(R + (size_t)row_ * RD + ch); sg.ks = *(const unsigned*)(KS + (size_t)row_ * RD + ch); \
        sg.v = *(const unsigned*)(V + (size_t)row_ * RD + ch); sg.kk = *(const unsigned*)(KK + (size_t)row_ * RD + ch); \
        sg.we = *(const unsigned*)(LO + (size_t)row_ * 4096 + dir * RD + ch); sg.a = *(const unsigned*)(LO + (size_t)row_ * 4096 + 2048 + dir * RD + ch); } while (0)
#define RW_WRITE(bi) do { LAS float* tb = buf + (bi) * RS_BUF + st * RS_TF + 2 * cp; \
        const float a0 = bflo(sg.a), a1 = bfhi(sg.a), kk0 = bflo(sg.kk), kk1 = bfhi(sg.kk), ks0 = bflo(sg.ks), ks1 = bfhi(sg.ks); \
        *(LAS f32x2*)(tb + 0) = (f32x2){kk0, kk1}; \
        *(LAS f32x2*)(tb + 64) = (f32x2){__expf(-bflo(sg.we)), __expf(-bfhi(sg.we))}; \
        *(LAS f32x2*)(tb + 128) = (f32x2){-kk0 * a0, -kk1 * a1}; \
        *(LAS f32x2*)(tb + 192) = (f32x2){ks0 * (1.0f + (a0 - 1.0f) * ka0), ks1 * (1.0f + (a1 - 1.0f) * ka1)}; \
        *(LAS f32x2*)(tb + 256) = (f32x2){bflo(sg.r), bfhi(sg.r)}; \
        *(LAS f32x2*)(tb + 320) = (f32x2){bflo(sg.v), bfhi(sg.v)}; } while (0)
    constexpr int NCHUNK = (CTXL + SEQ) / RS_TOK;
    RW_LOAD(0); RW_WRITE(0);
    __syncthreads();
    for (int c = 0; c < NCHUNK; ++c) {
        if (c + 1 < NCHUNK) RW_LOAD(c + 1);
        const LAS float* cb = buf + (c & 1) * RS_BUF; LAS f32x2* yb = ypart + (c & 1) * RS_TOK * 256 + rp * 8 + (((kq >> 1) ^ (rp >> 2)) & 7);
        {
            const LAS float* tk = cb + kq * 4; const LAS float* tv = cb + 320 + v0;
#define RW_LD(T, kk4, w4, n4, d4, r4, vv) f32x4 kk4 = *(const LAS f32x4*)(tk + (T) * RS_TF), w4 = *(const LAS f32x4*)(tk + (T) * RS_TF + 64), n4 = *(const LAS f32x4*)(tk + (T) * RS_TF + 128), \
                d4 = *(const LAS f32x4*)(tk + (T) * RS_TF + 192), r4 = *(const LAS f32x4*)(tk + (T) * RS_TF + 256); f32x2 vv = *(const LAS f32x2*)(tv + (T) * RS_TF)
#define RW_STEP(T, kk4, w4, n4, d4, r4, vv) do { \
                const f32x2 kka = {kk4.x, kk4.y}, kkb = {kk4.z, kk4.w}, wa = {w4.x, w4.y}, wb = {w4.z, w4.w}, na = {n4.x, n4.y}, nb = {n4.z, n4.w}, da = {d4.x, d4.y}, db = {d4.z, d4.w}, ra = {r4.x, r4.y}, rb = {r4.z, r4.w}; \
                f32x2 p0 = S00 * kka + S01 * kkb, p1 = S10 * kka + S11 * kkb; \
                const f32x2 u00 = S00 * wa + da * vv.x, u01 = S01 * wb + db * vv.x, u10 = S10 * wa + da * vv.y, u11 = S11 * wb + db * vv.y;     \
                const float sa0 = dpp_sum16(p0.x + p0.y), sa1 = dpp_sum16(p1.x + p1.y); \
                S00 = na * sa0 + u00; S01 = nb * sa0 + u01; S10 = na * sa1 + u10; S11 = nb * sa1 + u11; \
                p0 = S00 * ra + S01 * rb; p1 = S10 * ra + S11 * rb; \
                float y0 = p0.x + p0.y, y1 = p1.x + p1.y; \
                y0 += __builtin_bit_cast(float, __builtin_amdgcn_update_dpp(0, __builtin_bit_cast(int, y0), 0xB1, 0xF, 0xF, true)); \
                y1 += __builtin_bit_cast(float, __builtin_amdgcn_update_dpp(0, __builtin_bit_cast(int, y1), 0xB1, 0xF, 0xF, true)); \
                if ((kq & 1) == 0) yb[(T) * 256] = (f32x2){y0, y1}; } while (0)
            RW_LD(0, kkA, wA, nA, dA, rA, vA);
#pragma unroll
            for (int tau = 0; tau < RS_TOK; tau += 2) {
                RW_LD(tau + 1, kkB, wB, nB, dB, rB, vB);
                RW_STEP(tau, kkA, wA, nA, dA, rA, vA);
                if (tau + 2 < RS_TOK) { RW_LD(tau + 2, kkC, wC, nC, dC, rC, vC); kkA = kkC; wA = wC; nA = nC; dA = dC; rA = rC; vA = vC; }
                RW_STEP(tau + 1, kkB, wB, nB, dB, rB, vB);
            }
#undef RW_LD
#undef RW_STEP
        }
        if (c + 1 < NCHUNK) RW_WRITE((c + 1) & 1);
        __syncthreads();
        {
            const int row = rwkv_row(b, dir, c * RS_TOK + st);
            const LAS f32x2* yq = ypart + (c & 1) * RS_TOK * 256 + st * 256 + cp * 8;
            f32x2 acc = yq[(0 ^ (cp >> 2)) & 7];
#pragma unroll
            for (int j = 1; j < 8; ++j) acc += yq[(j ^ (cp >> 2)) & 7];
            *(unsigned*)(Y + (size_t)row * RD + ch) = pk2(acc.x, acc.y);
        }
    }
    __syncthreads();
}

constexpr int GP1 = 136, GP2 = 72;
constexpr int GL_QGS = 0, GL_KGS = GL_QGS + 64 * GP1 * 2, GL_STS = GL_KGS + 64 * GP1 * 2, GL_KET = GL_STS + 64 * GP1 * 2, GL_VT = GL_KET + 128 * GP2 * 2, GL_ATT = GL_VT + 64 * GP2 * 2,
              GL_DECS = GL_ATT + 64 * GP2 * 2, GL_LDS_END = GL_DECS + 512;
static_assert(GL_LDS_END <= 131072, "gla lds");
__device__ __forceinline__ bf16x8 ldfrag(const LAS bf16* base, int row, int pitch, int kofs) { return *(const LAS bf16x8*)(base + row * pitch + kofs); }
__device__ __forceinline__ int gla_prow(int b, int dir, int cp, int tau) {
    const bool lat = cp >= 4; const int q = lat ? cp - 4 : cp, ncn = lat ? 32 : 4, cn = dir ? ncn - 1 - q : q;
    return gla_row(lat, b, dir ? 64 * cn + 63 - tau : 64 * cn + tau);
}
__device__ __forceinline__ int gla_gch(int dir, int cp) { const bool lat = cp >= 4; const int q = lat ? cp - 4 : cp, ncn = lat ? 32 : 4, cn = dir ? ncn - 1 - q : q; return lat ? 4 + cn : cn; }
__device__ __forceinline__ void ph_gla_scan(const KC& k, int job) {
    const int b = job >> 5, h = (job >> 3) & 3, dir = (job >> 2) & 1, dvq = job & 3;
    const int tid = k.tid, w = k.wave, lane = k.lane, q4 = lane >> 4, l15 = lane & 15;
    const bf16* QG = (const bf16*)(k.ws + GL_QG) + (size_t)dir * TA * GKD; const bf16* KG = (const bf16*)(k.ws + GL_KG) + (size_t)dir * TA * GKD;
    const bf16* KE = (const bf16*)(k.ws + GL_KE) + (size_t)dir * TA * GKD; const bf16* VS = (const bf16*)(k.ws + GL_VS);
    const float* DEC = (const float*)(k.ws + GL_DEC); bf16* O = (bf16*)(k.ws + GL_O) + (size_t)dir * TA * GVD;
    LAS bf16* QGs = (LAS bf16*)(k.lds + GL_QGS); LAS bf16* KGs = (LAS bf16*)(k.lds + GL_KGS); LAS bf16* STs = (LAS bf16*)(k.lds + GL_STS);
    LAS bf16* KEt = (LAS bf16*)(k.lds + GL_KET); LAS bf16* Vt = (LAS bf16*)(k.lds + GL_VT); LAS bf16* ATT = (LAS bf16*)(k.lds + GL_ATT); LAS float* decs = (LAS float*)(k.lds + GL_DECS);
    f32x4 accS[4];
#pragma unroll
    for (int t = 0; t < 4; ++t) accS[t] = (f32x4){0.f, 0.f, 0.f, 0.f};
    const int tw = w & 3, wh = w >> 2;
    u32x4 pq[2], pk[2], pe[2], pv; float pd = 0.f;
#define GLA_PREFETCH(CP) do { _Pragma("unroll") for (int i = 0; i < 2; ++i) { const int idx = tid + 512 * i, tau = idx >> 4, ck = idx & 15; \
            const size_t go = (size_t)gla_prow(b, dir, (CP), tau) * GKD + h * GDK + ck * 8; pq[i] = *(const u32x4*)(QG + go); pk[i] = *(const u32x4*)(KG + go); pe[i] = *(const u32x4*)(KE + go); } \
        pv = *(const u32x4*)(VS + (size_t)gla_prow(b, dir, (CP), tid >> 3) * GVD + h * GDV + dvq * 64 + (tid & 7) * 8); \
        if (tid < 128) pd = DEC[((size_t)(dir * 8 + b) * NCH + gla_gch(dir, (CP))) * GKD + h * GDK + tid]; } while (0)
    GLA_PREFETCH(0);
    for (int cp = 0; cp < NCH; ++cp) {
#define GROW(tau) gla_prow(b, dir, cp, (tau))
#pragma unroll
        for (int i = 0; i < 2; ++i) {
            const int idx = tid + 512 * i, tau = idx >> 4, ck = idx & 15;
            *(LAS u32x4*)(QGs + tau * GP1 + ck * 8) = pq[i];
            *(LAS u32x4*)(KGs + tau * GP1 + ck * 8) = pk[i];
            const unsigned kw[4] = {pe[i].x, pe[i].y, pe[i].z, pe[i].w};
#pragma unroll
            for (int e = 0; e < 4; ++e) { KEt[(ck * 8 + 2 * e) * GP2 + tau] = (bf16)(kw[e] & 0xffffu); KEt[(ck * 8 + 2 * e + 1) * GP2 + tau] = (bf16)(kw[e] >> 16); }
        }
        {
            const int tau = tid >> 3, ck = tid & 7;
            const unsigned vw[4] = {pv.x, pv.y, pv.z, pv.w};
#pragma unroll
            for (int e = 0; e < 4; ++e) { Vt[(ck * 8 + 2 * e) * GP2 + tau] = (bf16)(vw[e] & 0xffffu); Vt[(ck * 8 + 2 * e + 1) * GP2 + tau] = (bf16)(vw[e] >> 16); }
        }
        if (tid < 128) decs[tid] = pd;
#pragma unroll
        for (int t = 0; t < 4; ++t) {
            const int dkt = wh * 4 + t;
#pragma unroll
            for (int r = 0; r < 4; ++r) STs[(16 * tw + 4 * q4 + r) * GP1 + 16 * dkt + l15] = (bf16)f2bf(accS[t][r]);
        }
        __syncthreads();
        if (cp + 1 < NCH) GLA_PREFETCH(cp + 1);
#pragma unroll
        for (int jj = 0; jj < 2; ++jj) {
            const int it = tw, jt = wh * 2 + jj;
            f32x4 acc = (f32x4){0.f, 0.f, 0.f, 0.f};
#pragma unroll
            for (int ks = 0; ks < 4; ++ks) acc = __builtin_amdgcn_mfma_f32_16x16x32_bf16(ldfrag(QGs, 16 * it + l15, GP1, 32 * ks + 8 * q4), ldfrag(KGs, 16 * jt + l15, GP1, 32 * ks + 8 * q4), acc, 0, 0, 0);
#pragma unroll
            for (int r = 0; r < 4; ++r) { const int i = 16 * it + 4 * q4 + r, j = 16 * jt + l15; ATT[i * GP2 + j] = (bf16)f2bf(j <= i ? acc[r] : 0.f); }
        }
        __syncthreads();
#pragma unroll
        for (int dd = 0; dd < 2; ++dd) {
            const int it = tw, dvt = wh * 2 + dd;
            f32x4 acc = (f32x4){0.f, 0.f, 0.f, 0.f};
#pragma unroll
            for (int ks = 0; ks < 4; ++ks) acc = __builtin_amdgcn_mfma_f32_16x16x32_bf16(ldfrag(QGs, 16 * it + l15, GP1, 32 * ks + 8 * q4), ldfrag(STs, 16 * dvt + l15, GP1, 32 * ks + 8 * q4), acc, 0, 0, 0);
#pragma unroll
            for (int ks = 0; ks < 2; ++ks) acc = __builtin_amdgcn_mfma_f32_16x16x32_bf16(ldfrag(ATT, 16 * it + l15, GP2, 32 * ks + 8 * q4), ldfrag(Vt, 16 * dvt + l15, GP2, 32 * ks + 8 * q4), acc, 0, 0, 0);
#pragma unroll
            for (int r = 0; r < 4; ++r) { const int i = 16 * it + 4 * q4 + r; O[(size_t)GROW(i) * GVD + h * GDV + dvq * 64 + 16 * dvt + l15] = (bf16)f2bf(acc[r]); }
        }
#pragma unroll
        for (int t = 0; t < 4; ++t) {
            const int dkt = wh * 4 + t; const float d = decs[16 * dkt + l15];
            accS[t] = accS[t] * d;
#pragma unroll
            for (int ks = 0; ks < 2; ++ks) accS[t] = __builtin_amdgcn_mfma_f32_16x16x32_bf16(ldfrag(Vt, 16 * tw + l15, GP2, 32 * ks + 8 * q4), ldfrag(KEt, 16 * dkt + l15, GP2, 32 * ks + 8 * q4), accS[t], 0, 0, 0);
        }
        __syncthreads();
#undef GROW
    }
#undef GLA_PREFETCH
}

#ifndef HB_FULL
#define HB_FULL 0
#endif
#ifndef GLA4_LEVEL
#define GLA4_LEVEL 0
#endif
#ifndef GLA4_NOSTORE
#define GLA4_NOSTORE 0
#endif
#ifndef SWAP_HALVES
#define SWAP_HALVES 0
#endif
#ifndef SPLIT_SCAN
#define SPLIT_SCAN 0
#endif
constexpr int RS4_TOK = 8, RS4_BUF = RS4_TOK * RS_TF;
constexpr int SC_GL = 0;
constexpr int SC_RW = 96 * 1024;
constexpr int SC_END = SC_RW + 2 * RS4_BUF * 4 + 2 * RS4_TOK * 64 * 4;
static_assert(SC_GL + GL_LDS_END <= SC_RW, "scan lds halves");
constexpr int SC_CTR = 127 * 1024;
static_assert(SC_END <= SC_CTR && SC_CTR + 128 <= 131072, "scan lds");
__device__ __forceinline__ void half_bar(LAS unsigned* ctr, unsigned& gen, int lane) {
#if HB_FULL
    (void)ctr; (void)lane; gen += 4u; __syncthreads(); return;
#endif
    gen += 4u;
    __builtin_amdgcn_fence(__ATOMIC_RELEASE, "workgroup");
    if (lane == 0) __hip_atomic_fetch_add(ctr, 1u, __ATOMIC_RELAXED, __HIP_MEMORY_SCOPE_WORKGROUP);
    unsigned spins = 0;
    while (__hip_atomic_load(ctr, __ATOMIC_RELAXED, __HIP_MEMORY_SCOPE_WORKGROUP) < gen) { __builtin_amdgcn_s_sleep(1); if (++spins > (1u << 26)) break; }
    __builtin_amdgcn_fence(__ATOMIC_ACQUIRE, "workgroup");
}
#ifndef RW4_SHFL
#define RW4_SHFL 0
#endif
__device__ __forceinline__ float shfl_sum16(float x) { x += __shfl_xor(x, 1); x += __shfl_xor(x, 2); x += __shfl_xor(x, 4); x += __shfl_xor(x, 8); return x; }
#if RW4_SHFL
#define RW4_SUM16(x) shfl_sum16(x)
#else
#define RW4_SUM16(x) dpp_sum16(x)
#endif
__device__ __forceinline__ void rwkv_scan_4w(const KC& k, int l, int job, const float* k_a, LAS unsigned* ctr) {
    const int b = job >> 5, h = (job >> 1) & 15, dir = job & 1;
    const int tid = k.tid, lane = k.lane;
    const bf16* R = (const bf16*)(k.ws + RW_R); const bf16* KS = (const bf16*)(k.ws + RW_KS); const bf16* V = (const bf16*)(k.ws + RW_V); const bf16* KK = (const bf16*)(k.ws + RW_KK);
    const bf16* LO = (const bf16*)(k.ws + RW_LO); bf16* Y = (bf16*)(k.ws + RW_Y) + (size_t)dir * TA * RD;
    LAS float* buf = (LAS float*)(k.lds + SC_RW);
    LAS float* ybuf = buf + 2 * RS4_BUF;
    const int st = tid >> 5, cp = tid & 31, ch = h * RHS + 2 * cp;
    const float ka0 = k_a[l * RD + ch], ka1 = k_a[l * RD + ch + 1];
    const int kq = tid & 15, v0 = (tid >> 4) * 4;
    f32x2 S[4][2];
#pragma unroll
    for (int i = 0; i < 4; ++i) { S[i][0] = (f32x2){0.f, 0.f}; S[i][1] = (f32x2){0.f, 0.f}; }
    RwkvStage sg[1];
    unsigned gen = 0;
#define RW4_LOAD(chunk) do { _Pragma("unroll") for (int q_ = 0; q_ < 1; ++q_) { const int row_ = rwkv_row(b, dir, (chunk) * RS4_TOK + st); \
        sg[q_].r = *(const unsigned*)(R + (size_t)row_ * RD + ch); sg[q_].ks = *(const unsigned*)(KS + (size_t)row_ * RD + ch); \
        sg[q_].v = *(const unsigned*)(V + (size_t)row_ * RD + ch); sg[q_].kk = *(const unsigned*)(KK + (size_t)row_ * RD + ch); \
        sg[q_].we = *(const unsigned*)(LO + (size_t)row_ * 4096 + dir * RD + ch); sg[q_].a = *(const unsigned*)(LO + (size_t)row_ * 4096 + 2048 + dir * RD + ch); } } while (0)
#define RW4_WRITE(bi) do { _Pragma("unroll") for (int q_ = 0; q_ < 1; ++q_) { LAS float* tb = buf + (bi) * RS4_BUF + st * RS_TF + 2 * cp; \
        const float a0 = bflo(sg[q_].a), a1 = bfhi(sg[q_].a), kk0 = bflo(sg[q_].kk), kk1 = bfhi(sg[q_].kk), ks0 = bflo(sg[q_].ks), ks1 = bfhi(sg[q_].ks); \
        *(LAS f32x2*)(tb + 0) = (f32x2){kk0, kk1}; \
        *(LAS f32x2*)(tb + 64) = (f32x2){__expf(-bflo(sg[q_].we)), __expf(-bfhi(sg[q_].we))}; \
        *(LAS f32x2*)(tb + 128) = (f32x2){-kk0 * a0, -kk1 * a1}; \
        *(LAS f32x2*)(tb + 192) = (f32x2){ks0 * (1.0f + (a0 - 1.0f) * ka0), ks1 * (1.0f + (a1 - 1.0f) * ka1)}; \
        *(LAS f32x2*)(tb + 256) = (f32x2){bflo(sg[q_].r), bfhi(sg[q_].r)}; \
        *(LAS f32x2*)(tb + 320) = (f32x2){bflo(sg[q_].v), bfhi(sg[q_].v)}; } } while (0)
    constexpr int NCHUNK = (CTXL + SEQ) / RS4_TOK;
    RW4_LOAD(0); RW4_WRITE(0);
    half_bar(ctr, gen, lane);
    for (int c = 0; c < NCHUNK; ++c) {
        if (c + 1 < NCHUNK) RW4_LOAD(c + 1);
        const LAS float* cb = buf + (c & 1) * RS4_BUF; LAS float* yb = ybuf + (c & 1) * RS4_TOK * 64;
        {
            const LAS float* tk = cb + kq * 4; const LAS float* tv = cb + 320 + v0;
#define RW4_LD(T, kk4, w4, n4, d4, r4, vv) f32x4 kk4 = *(const LAS f32x4*)(tk + (T) * RS_TF), w4 = *(const LAS f32x4*)(tk + (T) * RS_TF + 64), n4 = *(const LAS f32x4*)(tk + (T) * RS_TF + 128), \
                d4 = *(const LAS f32x4*)(tk + (T) * RS_TF + 192), r4 = *(const LAS f32x4*)(tk + (T) * RS_TF + 256), vv = *(const LAS f32x4*)(tv + (T) * RS_TF)
#define RW4_STEP(T, kk4, w4, n4, d4, r4, vv) do { \
                const f32x2 kka = {kk4.x, kk4.y}, kkb = {kk4.z, kk4.w}, wa = {w4.x, w4.y}, wb = {w4.z, w4.w}, na = {n4.x, n4.y}, nb = {n4.z, n4.w}, da = {d4.x, d4.y}, db = {d4.z, d4.w}, ra = {r4.x, r4.y}, rb = {r4.z, r4.w}; \
                float sa[4], yy[4]; f32x2 u0[4], u1[4]; \
                _Pragma("unroll") for (int i = 0; i < 4; ++i) { const f32x2 p = S[i][0] * kka + S[i][1] * kkb; sa[i] = p.x + p.y; u0[i] = S[i][0] * wa + da * vv[i]; u1[i] = S[i][1] * wb + db * vv[i]; } \
                _Pragma("unroll") for (int i = 0; i < 4; ++i) sa[i] = RW4_SUM16(sa[i]); \
                _Pragma("unroll") for (int i = 0; i < 4; ++i) { S[i][0] = na * sa[i] + u0[i]; S[i][1] = nb * sa[i] + u1[i]; const f32x2 q = S[i][0] * ra + S[i][1] * rb; yy[i] = q.x + q.y; } \
                _Pragma("unroll") for (int i = 0; i < 4; ++i) yy[i] = RW4_SUM16(yy[i]); \
                if (kq == 0) *(LAS f32x4*)(yb + (T) * 64 + v0) = (f32x4){yy[0], yy[1], yy[2], yy[3]}; } while (0)
            RW4_LD(0, kkA, wA, nA, dA, rA, vA);
#pragma unroll
            for (int tau = 0; tau < RS4_TOK; tau += 2) {
                RW4_LD(tau + 1, kkB, wB, nB, dB, rB, vB);
                RW4_STEP(tau, kkA, wA, nA, dA, rA, vA);
                if (tau + 2 < RS4_TOK) { RW4_LD(tau + 2, kkC, wC, nC, dC, rC, vC); kkA = kkC; wA = wC; nA = nC; dA = dC; rA = rC; vA = vC; }
                RW4_STEP(tau + 1, kkB, wB, nB, dB, rB, vB);
            }
#undef RW4_LD
#undef RW4_STEP
        }
        if (c + 1 < NCHUNK) RW4_WRITE((c + 1) & 1);
        half_bar(ctr, gen, lane);
        {
            const int row = rwkv_row(b, dir, c * RS4_TOK + st);
            const f32x2 yy = *(const LAS f32x2*)(yb + st * 64 + 2 * cp);
            *(unsigned*)(Y + (size_t)row * RD + ch) = pk2(yy.x, yy.y);
        }
    }
#undef RW4_LOAD
#undef RW4_WRITE
}
__device__ __forceinline__ void gla_scan_4w(const KC& k, int job, LAS unsigned* ctr) {
    const int b = job >> 5, h = (job >> 3) & 3, dir = (job >> 2) & 1, dvq = job & 3;
    const int tid = k.tid - 256, w = k.wave - 4, lane = k.lane, q4 = lane >> 4, l15 = lane & 15;
    const bf16* QG = (const bf16*)(k.ws + GL_QG) + (size_t)dir * TA * GKD; const bf16* KG = (const bf16*)(k.ws + GL_KG) + (size_t)dir * TA * GKD;
    const bf16* KE = (const bf16*)(k.ws + GL_KE) + (size_t)dir * TA * GKD; const bf16* VS = (const bf16*)(k.ws + GL_VS);
    const float* DEC = (const float*)(k.ws + GL_DEC); bf16* O = (bf16*)(k.ws + GL_O) + (size_t)dir * TA * GVD;
    LAS unsigned char* gl = k.lds + SC_GL;
    LAS bf16* QGs = (LAS bf16*)(gl + GL_QGS); LAS bf16* KGs = (LAS bf16*)(gl + GL_KGS); LAS bf16* STs = (LAS bf16*)(gl + GL_STS);
    LAS bf16* KEt = (LAS bf16*)(gl + GL_KET); LAS bf16* Vt = (LAS bf16*)(gl + GL_VT); LAS bf16* ATT = (LAS bf16*)(gl + GL_ATT); LAS float* decs = (LAS float*)(gl + GL_DECS);
    f32x4 accS[8];
#pragma unroll
    for (int t = 0; t < 8; ++t) accS[t] = (f32x4){0.f, 0.f, 0.f, 0.f};
    unsigned gen = 0;
#if GLA4_LEVEL == 2
    { float x = (float)lane; for (int i = 0; i < 200000; ++i) { x = x * 1.0001f + 0.5f; asm volatile("" : "+v"(x)); } asm volatile("" :: "v"(x)); (void)ctr; (void)gen; }
    return;
#endif
#if GLA4_LEVEL == 1
    for (int cp = 0; cp < NCH; ++cp) { float x = (float)lane; for (int i = 0; i < 2000; ++i) x = x * 1.0001f + 0.5f; asm volatile("" :: "v"(x)); half_bar(ctr, gen, lane); half_bar(ctr, gen, lane); half_bar(ctr, gen, lane); }
    return;
#endif
    for (int cp = 0; cp < NCH; ++cp) {
        const bool lat = cp >= 4; const int q = lat ? cp - 4 : cp, ncn = lat ? 32 : 4, cn = dir ? ncn - 1 - q : q, gch = lat ? 4 + cn : cn;
#define GROW(tau) gla_row(lat, b, dir ? 64 * cn + 63 - (tau) : 64 * cn + (tau))
#pragma unroll
        for (int i = 0; i < 4; ++i) {
            const int idx = tid + 256 * i, tau = idx >> 4, ck = idx & 15; const size_t go = (size_t)GROW(tau) * GKD + h * GDK + ck * 8;
            *(LAS u32x4*)(QGs + tau * GP1 + ck * 8) = *(const u32x4*)(QG + go);
            *(LAS u32x4*)(KGs + tau * GP1 + ck * 8) = *(const u32x4*)(KG + go);
            const u32x4 ke = *(const u32x4*)(KE + go);
            const unsigned kw[4] = {ke.x, ke.y, ke.z, ke.w};
#pragma unroll
            for (int e = 0; e < 4; ++e) { KEt[(ck * 8 + 2 * e) * GP2 + tau] = (bf16)(kw[e] & 0xffffu); KEt[(ck * 8 + 2 * e + 1) * GP2 + tau] = (bf16)(kw[e] >> 16); }
        }
#pragma unroll
        for (int i = 0; i < 2; ++i) {
            const int idx = tid + 256 * i, tau = idx >> 3, ck = idx & 7;
            const u32x4 vv = *(const u32x4*)(VS + (size_t)GROW(tau) * GVD + h * GDV + dvq * 64 + ck * 8);
            const unsigned vw[4] = {vv.x, vv.y, vv.z, vv.w};
#pragma unroll
            for (int e = 0; e < 4; ++e) { Vt[(ck * 8 + 2 * e) * GP2 + tau] = (bf16)(vw[e] & 0xffffu); Vt[(ck * 8 + 2 * e + 1) * GP2 + tau] = (bf16)(vw[e] >> 16); }
        }
        if (tid < 128) decs[tid] = DEC[((size_t)(dir * 8 + b) * NCH + gch) * GKD + h * GDK + tid];
#pragma unroll
        for (int t = 0; t < 8; ++t) {
#pragma unroll
            for (int r = 0; r < 4; ++r) STs[(16 * w + 4 * q4 + r) * GP1 + 16 * t + l15] = (bf16)f2bf(accS[t][r]);
        }
        half_bar(ctr, gen, lane);
#pragma unroll
        for (int jt = 0; jt < 4; ++jt) {
            f32x4 acc = (f32x4){0.f, 0.f, 0.f, 0.f};
#pragma unroll
            for (int ks = 0; ks < 4; ++ks) acc = __builtin_amdgcn_mfma_f32_16x16x32_bf16(ldfrag(QGs, 16 * w + l15, GP1, 32 * ks + 8 * q4), ldfrag(KGs, 16 * jt + l15, GP1, 32 * ks + 8 * q4), acc, 0, 0, 0);
#pragma unroll
            for (int r = 0; r < 4; ++r) { const int i = 16 * w + 4 * q4 + r, j = 16 * jt + l15; ATT[i * GP2 + j] = (bf16)f2bf(j <= i ? acc[r] : 0.f); }
        }
        half_bar(ctr, gen, lane);
#pragma unroll
        for (int dvt = 0; dvt < 4; ++dvt) {
            f32x4 acc = (f32x4){0.f, 0.f, 0.f, 0.f};
#pragma unroll
            for (int ks = 0; ks < 4; ++ks) acc = __builtin_amdgcn_mfma_f32_16x16x32_bf16(ldfrag(QGs, 16 * w + l15, GP1, 32 * ks + 8 * q4), ldfrag(STs, 16 * dvt + l15, GP1, 32 * ks + 8 * q4), acc, 0, 0, 0);
#pragma unroll
            for (int ks = 0; ks < 2; ++ks) acc = __builtin_amdgcn_mfma_f32_16x16x32_bf16(ldfrag(ATT, 16 * w + l15, GP2, 32 * ks + 8 * q4), ldfrag(Vt, 16 * dvt + l15, GP2, 32 * ks + 8 * q4), acc, 0, 0, 0);
#pragma unroll
#if GLA4_NOSTORE
            asm volatile("" :: "v"(acc[0]), "v"(acc[1]), "v"(acc[2]), "v"(acc[3]));
#else
            for (int r = 0; r < 4; ++r) { const int i = 16 * w + 4 * q4 + r; O[(size_t)GROW(i) * GVD + h * GDV + dvq * 64 + 16 * dvt + l15] = (bf16)f2bf(acc[r]); }
#endif
        }
#pragma unroll
        for (int t = 0; t < 8; ++t) {
            const float d = decs[16 * t + l15];
            accS[t] = accS[t] * d;
#pragma unroll
            for (int ks = 0; ks < 2; ++ks) accS[t] = __builtin_amdgcn_mfma_f32_16x16x32_bf16(ldfrag(Vt, 16 * w + l15, GP2, 32 * ks + 8 * q4), ldfrag(KEt, 16 * t + l15, GP2, 32 * ks + 8 * q4), accS[t], 0, 0, 0);
        }
        half_bar(ctr, gen, lane);
#undef GROW
    }
#if HB_FULL
    for (int i = 0; i < (1 + (CTXL + SEQ) / RS4_TOK) - 3 * NCH; ++i) __syncthreads();
#endif
}
__device__ __forceinline__ void ph_scan_split(const KC& k, int l, const float* k_a) {
    LAS unsigned* ctr = (LAS unsigned*)(k.lds + SC_CTR);
    for (int job = k.bid; job < 256; job += k.G) {
        if (k.tid == 0) { ctr[0] = 0u; ctr[16] = 0u; }
        __syncthreads();
#if SPLIT_SCAN == 1 || SPLIT_SCAN == 4 || SPLIT_SCAN == 5 || SPLIT_SCAN == 6
#if SWAP_HALVES
        { KC k2 = k; if (k.wave >= 4) { k2.tid = k.tid - 256; k2.wave = k.wave - 4; rwkv_scan_4w(k2, l, job, k_a, ctr); } else { k2.tid = k.tid + 256; k2.wave = k.wave + 4; gla_scan_4w(k2, job, ctr + 16); } }
#else
        if (k.wave < 4) rwkv_scan_4w(k, l, job, k_a, ctr); else gla_scan_4w(k, job, ctr + 16);
#endif
        __syncthreads();
#if SPLIT_SCAN == 6
        ph_rwkv_scan(k, l, job, k_a, WS_H);
#elif SPLIT_SCAN == 4
        ph_rwkv_scan(k, l, job, k_a);
#elif SPLIT_SCAN == 5
        ph_gla_scan(k, job);
#endif
#elif SPLIT_SCAN == 2
        if (k.wave < 4) rwkv_scan_4w(k, l, job, k_a, ctr);
        __syncthreads();
        ph_gla_scan(k, job);
#else
        if (k.wave >= 4) gla_scan_4w(k, job, ctr + 16);
        __syncthreads();
        ph_rwkv_scan(k, l, job, k_a);
#endif
    }
}

__device__ __forceinline__ void ph_post(const KC& k, int l, int nrows, const float* ln_g, const float* ln_b, const float* gng) {
    const int gw = k.bid * 8 + k.wave, NGW = k.G * 8, lane = k.lane, c = 16 * lane;
    const bf16* P = (const bf16*)(k.ws + WS_P);
    const bf16* Y = (const bf16*)(k.ws + RW_Y); const bf16* V = (const bf16*)(k.ws + RW_V); const float* BON = (const float*)(k.ws + RW_BON); bf16* YNB = (bf16*)(k.ws + RW_R);
    const bf16* O = (const bf16*)(k.ws + GL_O); bf16* YB = (bf16*)(k.ws + GL_VS);
    for (int row = gw; row < nrows; row += NGW) {
        {
            float yf[16], yb[16], vv[16], y[16];
            ld16(Y + (size_t)row * RD + c, true, yf); ld16(Y + ((size_t)TA + row) * RD + c, true, yb); ld16(V + (size_t)row * RD + c, true, vv);
            float s = 0.f;
#pragma unroll
            for (int i = 0; i < 16; ++i) { y[i] = yf[i] + yb[i]; s += y[i]; }
            s += __shfl_xor(s, 1); s += __shfl_xor(s, 2);
            const float mean = s * (1.0f / 64.0f); float q = 0.f;
#pragma unroll
            for (int i = 0; i < 16; ++i) { y[i] -= mean; q += y[i] * y[i]; }
            q += __shfl_xor(q, 1); q += __shfl_xor(q, 2);
            const float rstd = 1.0f / sqrtf(q * (1.0f / 64.0f) + 64e-5f), bon = BON[(size_t)row * RHEADS + (lane >> 2)];
#pragma unroll
            for (int i = 0; i < 16; ++i) y[i] = y[i] * rstd * ln_g[l * RD + c + i] + ln_b[l * RD + c + i] + bon * vv[i];
            st16(YNB + (size_t)row * RD + c, y);
        }
        {
            float of[16], ob[16], gt[16], o[16];
            ld16(O + (size_t)row * GVD + c, true, of); ld16(O + ((size_t)TA + row) * GVD + c, true, ob); ld16(P + (size_t)row * NP + GLA_GATE_OFF + c, true, gt);
            float s = 0.f;
#pragma unroll
            for (int i = 0; i < 16; ++i) { o[i] = of[i] + ob[i]; s += o[i] * o[i]; }
            s += __shfl_xor(s, 1); s += __shfl_xor(s, 2); s += __shfl_xor(s, 4); s += __shfl_xor(s, 8);
            const float rinv = 1.0f / sqrtf(s * (1.0f / 256.0f) + 1e-6f);
#pragma unroll
            for (int i = 0; i < 16; ++i) o[i] = o[i] * rinv * gng[l * GDV + ((c + i) & 255)] * siluf(gt[i]);
            st16(YB + (size_t)row * GVD + c, o);
        }
    }
}
using pg8::Unit;
struct FP_ { bf16* P; __device__ __forceinline__ void operator()(int row, int col, float (&v)[8], const Unit&) const { *(u32x4*)(P + (size_t)row * NP + col) = pack8(v); } };
struct FL1_ { bf16* LO; const float* bias1;
    __device__ __forceinline__ void operator()(int row, int col, float (&v)[8], const Unit& u) const {
        const float* bias = bias1 + col;
        const f32x4 b0 = *(const f32x4*)bias, b1 = *(const f32x4*)(bias + 4);
        const float bb[8] = {b0.x, b0.y, b0.z, b0.w, b1.x, b1.y, b1.z, b1.w};
        const float sc = col < 2048 ? 0.6065306597126334f : 1.0f;
#pragma unroll
        for (int i = 0; i < 8; ++i) v[i] = sigm(bb[i] + v[i]) * sc;
        *(u32x4*)(LO + (size_t)row * 4096 + col) = pack8(v);
    } };
struct FL2_ { const bf16* YNB; bf16* YA;
    __device__ __forceinline__ void operator()(int row, int col, float (&v)[8], const Unit&) const {
        float y[8]; unpack8(*(const u32x4*)(YNB + (size_t)row * RD + col), y);
#pragma unroll
        for (int i = 0; i < 8; ++i) v[i] *= y[i];
        *(u32x4*)(YA + (size_t)row * RD + col) = pack8(v);
    } };
template <int SECOND> struct FM_ { const bf16* P; bf16* MA;
    __device__ __forceinline__ void operator()(int row, int col, float (&v)[8], const Unit&) const {
        float g[8]; unpack8(*(const u32x4*)(P + (size_t)row * NP + BR_OFF + SECOND * DM + col), g);
        bf16* mp = MA + (size_t)row * DM + col;
        if (SECOND) { float m[8]; unpack8(*(const u32x4*)mp, m);
#pragma unroll
            for (int i = 0; i < 8; ++i) v[i] = sigm(g[i]) * v[i] + m[i]; }
        else {
#pragma unroll
            for (int i = 0; i < 8; ++i) v[i] = sigm(g[i]) * v[i]; }
        *(u32x4*)mp = pack8(v);
    } };
struct FX_ { float* X; const float* MOD; int l;
    __device__ __forceinline__ void operator()(int row, int col, const f32x4 v, const Unit&) const {
        const f32x4 g = *(const f32x4*)(MOD + ((size_t)l * 9 + mod_row(row)) * MOD_N + 2 * DM + col);
        f32x4* xp = (f32x4*)(X + (size_t)row * DM + col);
        *xp = *xp + g * v;
    } };
struct FE1_ { bf16* ACT;
    __device__ __forceinline__ void operator()(int row, int col, float (&g)[8], float (&up)[8]) const {
#pragma unroll
        for (int i = 0; i < 8; ++i) g[i] = siluf(g[i]) * up[i];
        *(u32x4*)(ACT + (size_t)row * DEXP + col) = pack8(g);
    } };
struct FE2_ { const int* rowtok; const float* roww; bf16* YF;
    __device__ __forceinline__ void operator()(int row, int col, float (&v)[8], const Unit&) const {
        const int t2 = rowtok[row];
        if (t2 >= 0) { const float w = roww[row];
#pragma unroll
            for (int i = 0; i < 8; ++i) v[i] *= w;
            *(u32x4*)(YF + ((size_t)(t2 & 1) * TA + (t2 >> 1)) * DM + col) = pack8(v); }
    } };

#ifndef GA_
#define GA_ true
#endif
#ifndef GS_
#define GS_ true
#endif
constexpr int LDS_BYTES = 147456;
constexpr int MISC_OFF = 131072 + 4096;

constexpr int NPHASE = 2 + 14 * DEPTH + 1;
struct Args { const float* in[N_IN]; float* out; unsigned char* ws; int ph_lo, ph_hi; };
static_assert(sizeof(Args) == N_IN * 8 + 8 + 8 + 8, "Args has no padding");

__global__ void __launch_bounds__(512, 2) fwd(Args a) {
    extern __shared__ __attribute__((aligned(16))) unsigned char lds_raw[];
    KC k;
    k.lds = (LAS unsigned char*)lds_raw; k.ws = (unsigned char*)INP(N_IN + 1);
    k.tid = threadIdx.x; k.lane = k.tid & 63; k.wave = __builtin_amdgcn_readfirstlane(k.tid >> 6); k.G = gridDim.x; k.bid = blockIdx.x;
    const int lo = a.ph_lo, hi = a.ph_hi;
    volatile LAS unsigned* MISC = (volatile LAS unsigned*)(k.lds + MISC_OFF);
    if (k.tid < 32) MISC[k.tid] = 0u;
    __syncthreads();
    XcdBarrier bar; bar.bar = (unsigned*)(k.ws + WS_CTL) + CW_BAR; bar.x = 0; bar.st = nullptr;
    if (hi - lo > 1) bar = xcd_barrier_post((unsigned*)(k.ws + WS_CTL) + CW_BAR, MISC + 8);
#ifndef SITE_MASK
#define SITE_MASK 0xFFFFFFFFu
#endif
#define FRESH() do { int t_ = threadIdx.x; asm volatile("" : "+v"(t_)); k.tid = t_; k.lane = t_ & 63; k.wave = __builtin_amdgcn_readfirstlane(t_ >> 6); k.ws = (unsigned char*)INP(N_IN + 1); ws = k.ws; } while (0)
#define PH_BEGIN(p, site) if (((SITE_MASK >> (site)) & 1u) && lo <= (p) && (p) < hi) { FRESH();
#ifndef EXTRA_BARS
#define EXTRA_BARS 0
#endif
#ifndef DUP_MASK
#define DUP_MASK 0u
#endif
#define DUPRUN(n, stmt) do { stmt; if ((DUP_MASK >> (n)) & 1u) { __syncthreads(); stmt; } } while (0)
#define PH_END(p) if ((p) + 1 < hi) xcd_barrier(bar); }
    unsigned char* ws = k.ws;
    LAS unsigned char* glds = k.lds;
#define WSRC WSrc{INP(I_WIN), INP(I_W2), INP(I_A2), INP(I_G2), INP(I_WBA), INP(I_WBB), INP(I_WOUT), INP(I_EG), INP(I_EU), INP(I_ED), INP(I_W0), INP(I_A0)}

    PH_BEGIN(0, 0) DUPRUN(0, ph_adaln_partials(k, INP(I_C), INP(I_CCTX), INP(I_WADA))); DUPRUN(1, ph_convert(k, WSRC, 0)); PH_END(0)
    PH_BEGIN(1, 1) ph_adaln_reduce(k, INP(I_BADA)); PH_END(1)

#define L_ 0
    {
        constexpr int l = L_;
        const int pb = 2 + 14 * l;
        const bool last = (l == DEPTH - 1);
        const int Mpost = last ? TL : TA;
        PH_BEGIN(pb + 0, 2)
            if (l > 0) { DUPRUN(1, ph_convert(k, WSRC, l)); }
            RowArgs ra{INP(I_X), INP(I_CTX), INP(I_NMG), nullptr, nullptr, nullptr};
            ph_rows<0>(k, ra, l, TA);
            if (l == 0 && ((DUP_MASK >> 15) & 1u)) { __syncthreads(); ph_rows<0>(k, ra, l, TA); }
        PH_END(pb + 0)
        PH_BEGIN(pb + 1, 3)
            pg8::Gemm g{(const bf16*)(ws + WS_H), (const bf16*)(ws + WT_IN), TA, NP, DM, 0}; pg8::StaticOrder S; S.init(TA, NP, k.G, k.bid);
            pg8::Epi8<FP_> E{FP_{(bf16*)(ws + WS_P)}};
            DUPRUN(2, (pg8::gemm_phase<pg8::Epi8<FP_>, pg8::StaticOrder, GA_, GS_>(glds, g, S, E)));
        PH_END(pb + 1)
        PH_BEGIN(pb + 2, 4)
            DUPRUN(3, ph_rwkv_prep(k, l, TA, INP(I_MU), INP(I_KK), INP(I_RK)));
            DUPRUN(4, ph_gla_prep(k, l, INP(I_GCONV), INP(I_GAW2), INP(I_GAB)));
        PH_END(pb + 2)
        PH_BEGIN(pb + 3, 5)
            pg8::Gemm g{(const bf16*)(ws + RW_A1), (const bf16*)(ws + WT_L1), TA, 4096, 256, 0}; pg8::StaticOrder S; S.init(TA, 4096, k.G, k.bid);
            pg8::Epi8<FL1_> E{FL1_{(bf16*)(ws + RW_LO), (const float*)(ws + WS_TAB + TAB_TOP)}};
            DUPRUN(5, (pg8::gemm_phase<pg8::Epi8<FL1_>, pg8::StaticOrder, GA_, GS_>(glds, g, S, E)));
        PH_END(pb + 3)
        PH_BEGIN(pb + 4, 6)
#if SPLIT_SCAN
            DUPRUN(6, ph_scan_split(k, l, INP(I_KA)));
#else
            for (int job = k.bid; job < 256; job += k.G) { DUPRUN(6, ph_rwkv_scan(k, l, job, INP(I_KA))); DUPRUN(7, ph_gla_scan(k, job)); }
#endif
        PH_END(pb + 4)
        PH_BEGIN(pb + 5, 7)
            DUPRUN(8, ph_post(k, l, Mpost, INP(I_LNG), INP(I_LNB), INP(I_GNG)));
        PH_END(pb + 5)
        PH_BEGIN(pb + 6, 8)
            pg8::Gemm g{(const bf16*)(ws + RW_A2), (const bf16*)(ws + WT_G2), Mpost, RD, 256, 0}; pg8::StaticOrder S; S.init(Mpost, RD, k.G, k.bid);
            pg8::Epi8<FL2_> E{FL2_{(const bf16*)(ws + RW_R), (bf16*)(ws + RW_V)}};
            DUPRUN(9, (pg8::gemm_phase<pg8::Epi8<FL2_>, pg8::StaticOrder, GA_, GS_>(glds, g, S, E)));
        PH_END(pb + 6)
        PH_BEGIN(pb + 7, 9)
            pg8::Gemm g{(const bf16*)(ws + RW_V), (const bf16*)(ws + WT_A), Mpost, DM, RD, 0}; pg8::StaticOrder S; S.init(Mpost, DM, k.G, k.bid);
            pg8::Epi8<FM_<0>> E{FM_<0>{(const bf16*)(ws + WS_P), (bf16*)(ws + WS_H)}};
            DUPRUN(10, (pg8::gemm_phase<pg8::Epi8<FM_<0>>, pg8::StaticOrder, GA_, GS_>(glds, g, S, E)));
        PH_END(pb + 7)
        PH_BEGIN(pb + 8, 10)
            pg8::Gemm g{(const bf16*)(ws + GL_VS), (const bf16*)(ws + WT_B), Mpost, DM, GVD, 0}; pg8::StaticOrder S; S.init(Mpost, DM, k.G, k.bid);
            pg8::Epi8<FM_<1>> E{FM_<1>{(const bf16*)(ws + WS_P), (bf16*)(ws + WS_H)}};
            pg8::gemm_phase<pg8::Epi8<FM_<1>>, pg8::StaticOrder, GA_, GS_>(glds, g, S, E);
        PH_END(pb + 8)
        PH_BEGIN(pb + 9, 11)
            pg8::Gemm g{(const bf16*)(ws + WS_H), (const bf16*)(ws + WT_O), Mpost, DM, DM, 0}; pg8::StaticOrder S; S.init(Mpost, DM, k.G, k.bid);
            pg8::Epi4<FX_> E{FX_{(float*)(ws + WS_X), (const float*)(ws + WS_MOD), l}};
            pg8::gemm_phase<pg8::Epi4<FX_>, pg8::StaticOrder, GA_, GS_>(glds, g, S, E);
        PH_END(pb + 9)
        PH_BEGIN(pb + 10, 12)
            RowArgs ra{nullptr, nullptr, INP(I_NFG), INP(I_RW), INP(I_RB), nullptr};
            ph_rows<1>(k, ra, l, Mpost);
            if ((DUP_MASK >> 16) & 1u) { __syncthreads(); ph_rows<1>(k, ra, l, Mpost, true); }
        PH_END(pb + 10)
        PH_BEGIN(pb + 11, 13)
            DUPRUN(13, ph_moe_scatter(k, l, Mpost));
        PH_END(pb + 11)
        PH_BEGIN(pb + 12, 14)
            pg8::Gemm g{(const bf16*)(ws + WS_HP), (const bf16*)(ws + WT_GU), 0, 2816, DM, (size_t)2816 * DM * 2};
            pg8::MoeOrder S; S.init((const int*)(ws + WS_TAB + TAB_TILE) + 256 * l, 11, k.G, (k.bid & 7) * (k.G >> 3) + (k.bid >> 3));
            pg8::EpiGU<FE1_> E{FE1_{(bf16*)(ws + WS_ACT)}};
            DUPRUN(11, (pg8::gemm_phase<pg8::EpiGU<FE1_>, pg8::MoeOrder, GA_, GS_>(glds, g, S, E)));
        PH_END(pb + 12)
        PH_BEGIN(pb + 13, 15)
            pg8::Gemm g{(const bf16*)(ws + WS_ACT), (const bf16*)(ws + WT_D), 0, DM, DEXP, (size_t)DM * DEXP * 2};
            pg8::MoeOrder S; S.init((const int*)(ws + WS_TAB + TAB_TILE) + 256 * l, 8, k.G, (k.bid & 7) * (k.G >> 3) + (k.bid >> 3));
            pg8::Epi8<FE2_> E{FE2_{(const int*)(ws + WS_TAB + TAB_ROWTOK) + (size_t)l * MOE_ROWS, (const float*)(ws + WS_TAB + TAB_ROWW) + (size_t)l * MOE_ROWS, (bf16*)(ws + WS_YF)}};
            DUPRUN(12, (pg8::gemm_phase<pg8::Epi8<FE2_>, pg8::MoeOrder, GA_, GS_>(glds, g, S, E)));
        PH_END(pb + 13)
        }
#undef L_
#define L_ 1
    {
        constexpr int l = L_;
        const int pb = 2 + 14 * l;
        const bool last = (l == DEPTH - 1);
        const int Mpost = last ? TL : TA;
        PH_BEGIN(pb + 0, 2)
            if (l > 0) { DUPRUN(1, ph_convert(k, WSRC, l)); }
            RowArgs ra{INP(I_X), INP(I_CTX), INP(I_NMG), nullptr, nullptr, nullptr};
            ph_rows<0>(k, ra, l, TA);
            if (l == 0 && ((DUP_MASK >> 15) & 1u)) { __syncthreads(); ph_rows<0>(k, ra, l, TA); }
        PH_END(pb + 0)
        PH_BEGIN(pb + 1, 3)
            pg8::Gemm g{(const bf16*)(ws + WS_H), (const bf16*)(ws + WT_IN), TA, NP, DM, 0}; pg8::StaticOrder S; S.init(TA, NP, k.G, k.bid);
            pg8::Epi8<FP_> E{FP_{(bf16*)(ws + WS_P)}};
            DUPRUN(2, (pg8::gemm_phase<pg8::Epi8<FP_>, pg8::StaticOrder, GA_, GS_>(glds, g, S, E)));
        PH_END(pb + 1)
        PH_BEGIN(pb + 2, 4)
            DUPRUN(3, ph_rwkv_prep(k, l, TA, INP(I_MU), INP(I_KK), INP(I_RK)));
            DUPRUN(4, ph_gla_prep(k, l, INP(I_GCONV), INP(I_GAW2), INP(I_GAB)));
        PH_END(pb + 2)
        PH_BEGIN(pb + 3, 5)
            pg8::Gemm g{(const bf16*)(ws + RW_A1), (const bf16*)(ws + WT_L1), TA, 4096, 256, 0}; pg8::StaticOrder S; S.init(TA, 4096, k.G, k.bid);
            pg8::Epi8<FL1_> E{FL1_{(bf16*)(ws + RW_LO), (const float*)(ws + WS_TAB + TAB_TOP)}};
            DUPRUN(5, (pg8::gemm_phase<pg8::Epi8<FL1_>, pg8::StaticOrder, GA_, GS_>(glds, g, S, E)));
        PH_END(pb + 3)
        PH_BEGIN(pb + 4, 6)
#if SPLIT_SCAN
            DUPRUN(6, ph_scan_split(k, l, INP(I_KA)));
#else
            for (int job = k.bid; job < 256; job += k.G) { DUPRUN(6, ph_rwkv_scan(k, l, job, INP(I_KA))); DUPRUN(7, ph_gla_scan(k, job)); }
#endif
        PH_END(pb + 4)
        PH_BEGIN(pb + 5, 7)
            DUPRUN(8, ph_post(k, l, Mpost, INP(I_LNG), INP(I_LNB), INP(I_GNG)));
        PH_END(pb + 5)
        PH_BEGIN(pb + 6, 8)
            pg8::Gemm g{(const bf16*)(ws + RW_A2), (const bf16*)(ws + WT_G2), Mpost, RD, 256, 0}; pg8::StaticOrder S; S.init(Mpost, RD, k.G, k.bid);
            pg8::Epi8<FL2_> E{FL2_{(const bf16*)(ws + RW_R), (bf16*)(ws + RW_V)}};
            DUPRUN(9, (pg8::gemm_phase<pg8::Epi8<FL2_>, pg8::StaticOrder, GA_, GS_>(glds, g, S, E)));
        PH_END(pb + 6)
        PH_BEGIN(pb + 7, 9)
            pg8::Gemm g{(const bf16*)(ws + RW_V), (const bf16*)(ws + WT_A), Mpost, DM, RD, 0}; pg8::StaticOrder S; S.init(Mpost, DM, k.G, k.bid);
            pg8::Epi8<FM_<0>> E{FM_<0>{(const bf16*)(ws + WS_P), (bf16*)(ws + WS_H)}};
            DUPRUN(10, (pg8::gemm_phase<pg8::Epi8<FM_<0>>, pg8::StaticOrder, GA_, GS_>(glds, g, S, E)));
        PH_END(pb + 7)
        PH_BEGIN(pb + 8, 10)
            pg8::Gemm g{(const bf16*)(ws + GL_VS), (const bf16*)(ws + WT_B), Mpost, DM, GVD, 0}; pg8::StaticOrder S; S.init(Mpost, DM, k.G, k.bid);
            pg8::Epi8<FM_<1>> E{FM_<1>{(const bf16*)(ws + WS_P), (bf16*)(ws + WS_H)}};
            pg8::gemm_phase<pg8::Epi8<FM_<1>>, pg8::StaticOrder, GA_, GS_>(glds, g, S, E);
        PH_END(pb + 8)
        PH_BEGIN(pb + 9, 11)
            pg8::Gemm g{(const bf16*)(ws + WS_H), (const bf16*)(ws + WT_O), Mpost, DM, DM, 0}; pg8::StaticOrder S; S.init(Mpost, DM, k.G, k.bid);
            pg8::Epi4<FX_> E{FX_{(float*)(ws + WS_X), (const float*)(ws + WS_MOD), l}};
            pg8::gemm_phase<pg8::Epi4<FX_>, pg8::StaticOrder, GA_, GS_>(glds, g, S, E);
        PH_END(pb + 9)
        PH_BEGIN(pb + 10, 12)
            RowArgs ra{nullptr, nullptr, INP(I_NFG), INP(I_RW), INP(I_RB), nullptr};
            ph_rows<1>(k, ra, l, Mpost);
            if ((DUP_MASK >> 16) & 1u) { __syncthreads(); ph_rows<1>(k, ra, l, Mpost, true); }
        PH_END(pb + 10)
        PH_BEGIN(pb + 11, 13)
            DUPRUN(13, ph_moe_scatter(k, l, Mpost));
        PH_END(pb + 11)
        PH_BEGIN(pb + 12, 14)
            pg8::Gemm g{(const bf16*)(ws + WS_HP), (const bf16*)(ws + WT_GU), 0, 2816, DM, (size_t)2816 * DM * 2};
            pg8::MoeOrder S; S.init((const int*)(ws + WS_TAB + TAB_TILE) + 256 * l, 11, k.G, (k.bid & 7) * (k.G >> 3) + (k.bid >> 3));
            pg8::EpiGU<FE1_> E{FE1_{(bf16*)(ws + WS_ACT)}};
            DUPRUN(11, (pg8::gemm_phase<pg8::EpiGU<FE1_>, pg8::MoeOrder, GA_, GS_>(glds, g, S, E)));
        PH_END(pb + 12)
        PH_BEGIN(pb + 13, 15)
            pg8::Gemm g{(const bf16*)(ws + WS_ACT), (const bf16*)(ws + WT_D), 0, DM, DEXP, (size_t)DM * DEXP * 2};
            pg8::MoeOrder S; S.init((const int*)(ws + WS_TAB + TAB_TILE) + 256 * l, 8, k.G, (k.bid & 7) * (k.G >> 3) + (k.bid >> 3));
            pg8::Epi8<FE2_> E{FE2_{(const int*)(ws + WS_TAB + TAB_ROWTOK) + (size_t)l * MOE_ROWS, (const float*)(ws + WS_TAB + TAB_ROWW) + (size_t)l * MOE_ROWS, (bf16*)(ws + WS_YF)}};
            DUPRUN(12, (pg8::gemm_phase<pg8::Epi8<FE2_>, pg8::MoeOrder, GA_, GS_>(glds, g, S, E)));
        PH_END(pb + 13)
        }
#undef L_
#if EXTRA_BARS
    if (hi - lo > 1) { for (int i = 0; i < EXTRA_BARS; ++i) xcd_barrier(bar); }
#endif
    PH_BEGIN(NPHASE - 1, 16)
        RowArgs ra{nullptr, nullptr, INP(I_FNG), nullptr, nullptr, (float*)INP(N_IN)};
        DUPRUN(14, ph_rows<2>(k, ra, 0, TL));
    PH_END(NPHASE - 1)
}

#ifndef MK_SINGLE
#define MK_SINGLE 1
#endif
extern "C" void kernel_launch(void* const* d_in, const int* in_sizes, int n_in, void* d_out, int out_size, void* d_ws, size_t ws_size, hipStream_t stream) {
    static int grid = 0;
    if (grid == 0) {
        if (n_in != N_IN || out_size != TL * DM || ws_size < WS_END) { fprintf(stderr, "kernel_launch: unexpected problem (n_in %d out %d ws %zu need %zu)\n", n_in, out_size, ws_size, (size_t)WS_END); grid = -1; return; }
        int dev = 0, cus = 0;
        if (hipGetDevice(&dev) != hipSuccess || hipDeviceGetAttribute(&cus, hipDeviceAttributeMultiprocessorCount, dev) != hipSuccess) { grid = -1; return; }
        if (hipFuncSetAttribute((const void*)fwd, hipFuncAttributeMaxDynamicSharedMemorySize, LDS_BYTES) != hipSuccess) { grid = -1; return; }
        int per_cu = 0;
        if (hipOccupancyMaxActiveBlocksPerMultiprocessor(&per_cu, (const void*)fwd, 512, LDS_BYTES) != hipSuccess || per_cu < 1) fprintf(stderr, "kernel_launch: occupancy query says %d\n", per_cu);
        (void)hipGetLastError();
        grid = cus;
    }
    if (grid < 0) return;
    unsigned char* ws = (unsigned char*)d_ws;
    hipMemsetAsync(ws + WS_CTL, 0, CTL_BYTES, stream);
    hipMemsetAsync(ws + WS_TAB + TAB_ROWTOK, 0xFF, TAB_ROWTOK_BYTES, stream);
    hipMemsetAsync(ws + WT_L1, 0, 2 * MiB, stream);
    Args a{};
    for (int i = 0; i < N_IN; ++i) a.in[i] = (const float*)d_in[i];
    a.out = (float*)d_out; a.ws = ws;
#if MK_SINGLE
    a.ph_lo = 0; a.ph_hi = NPHASE;
    hipLaunchKernelGGL(fwd, dim3(grid), dim3(512), LDS_BYTES, stream, a);
#else
    for (int p = 0; p < NPHASE; ++p) { a.ph_lo = p; a.ph_hi = p + 1; hipLaunchKernelGGL(fwd, dim3(grid), dim3(512), LDS_BYTES, stream, a); }
#endif
}
```

```cpp
#include <hip/hip_runtime.h>
#include <cstdio>
#include <cstdint>

#define LAS __attribute__((address_space(3)))
#define GAS __attribute__((address_space(1)))
typedef unsigned short bf16;
typedef float f32x4 __attribute__((ext_vector_type(4)));
typedef float f32x2 __attribute__((ext_vector_type(2)));
typedef unsigned u32x4 __attribute__((ext_vector_type(4)));
typedef unsigned u32x2 __attribute__((ext_vector_type(2)));
typedef short bf16x8 __attribute__((ext_vector_type(8)));

constexpr int DM = 2048, NBATCH = 8, SEQ = 2048, CTXL = 256, DEPTH = 2;
constexpr int TL = NBATCH * SEQ, TC = NBATCH * CTXL, TA = TL + TC;
constexpr int RD = 1024, RHEADS = 16, RHS = 64;
constexpr int RWKV_IN = 3520;
constexpr int GKD = 512, GVD = 1024, GDK = 128, GDV = 256, GHEADS = 4, GQKV = 2048;
constexpr int GLA_OFF = 3520, GLA_AD_OFF = GLA_OFF + GQKV, GLA_GATE_OFF = 5584, BR_OFF = 6608, IN_DIM = 10704, NP = 10752;
constexpr int NEXP = 16, DEXP = 1408;
constexpr int MOD_N = 6 * DM;
constexpr int MOE_ROWS = 41216;
constexpr int MOE_TILES = MOE_ROWS / 256;
constexpr int NCH = 36;
constexpr int KSPLIT = 32;

enum { I_X = 0, I_C, I_CTX, I_CCTX, I_WADA, I_BADA, I_NMG, I_NFG, I_WIN, I_MU, I_W0, I_W2, I_A0, I_A2, I_G2, I_KK, I_KA, I_RK, I_LNG, I_LNB,
       I_GCONV, I_GAW2, I_GAB, I_GNG, I_WBA, I_WBB, I_WOUT, I_RW, I_RB, I_EG, I_EU, I_ED, I_FNG, N_IN };

constexpr size_t MiB = 1u << 20;
constexpr size_t WS_CTL = 0;
constexpr size_t WS_TAB = 1 * MiB;
constexpr size_t WS_MOD = 2 * MiB;
constexpr size_t WS_X = 3 * MiB;
constexpr size_t WS_H = WS_X + 144 * MiB;
constexpr size_t WS_P = WS_H + 72 * MiB;
constexpr size_t WS_RW = WS_P + 378 * MiB;
constexpr size_t WS_GL = WS_RW + 380 * MiB;
constexpr size_t WS_WT = WS_GL + 218 * MiB;
constexpr size_t WS_END = WS_WT + 325 * MiB;
constexpr int CW_TMO = 0, CW_CNT = 64  , CW_BAR = 4096;
constexpr size_t CTL_BYTES = 1 * MiB;
constexpr size_t TAB_ROWTOK = 0;
constexpr size_t TAB_ROWTOK_BYTES = 2 * (size_t)MOE_ROWS * 4;
constexpr size_t TAB_ROWW = 384 * 1024;
constexpr size_t TAB_TILE = 768 * 1024;
constexpr size_t TAB_TOP = 800 * 1024;
static_assert(TAB_ROWTOK_BYTES <= TAB_ROWW && TAB_ROWW + 2 * (size_t)MOE_ROWS * 4 <= TAB_TILE, "tab map");
constexpr size_t WS_MODP = WS_P;
constexpr size_t WS_HP = WS_P;
constexpr size_t WS_ACT = WS_P + 162 * MiB;
constexpr size_t WS_TOPK = WS_P + 274 * MiB;
static_assert((size_t)MOE_ROWS * DM * 2 <= 162 * MiB && (size_t)MOE_ROWS * DEXP * 2 <= 112 * MiB && 274 * MiB + 3 * (size_t)TA * 8 <= 378 * MiB, "P overlay");
constexpr size_t RW_R = WS_RW;
constexpr size_t RW_KS = RW_R + 36 * MiB;
constexpr size_t RW_V = RW_KS + 36 * MiB;
constexpr size_t RW_KK = RW_V + 36 * MiB;
constexpr size_t RW_LO = RW_KK + 36 * MiB;
constexpr size_t RW_Y = RW_LO + 144 * MiB;
constexpr size_t RW_A1 = RW_Y + 72 * MiB;
constexpr size_t RW_A2 = RW_A1 + 9 * MiB;
constexpr size_t RW_BON = RW_A2 + 9 * MiB;
static_assert(RW_BON + 2 * MiB <= WS_GL, "rwkv map");
constexpr size_t GL_QG = WS_GL;
constexpr size_t GL_KG = GL_QG + 36 * MiB;
constexpr size_t GL_KE = GL_KG + 36 * MiB;
constexpr size_t GL_VS = GL_KE + 36 * MiB;
constexpr size_t GL_O = GL_VS + 36 * MiB;
constexpr size_t GL_DEC = GL_O + 72 * MiB;
static_assert(GL_DEC + 2 * MiB <= WS_WT, "gla map");
constexpr size_t WS_YF = WS_GL;
constexpr size_t WT_IN = WS_WT;
constexpr size_t WT_L1 = WT_IN + 42 * MiB;
constexpr size_t WT_G2 = WT_L1 + 2 * MiB;
constexpr size_t WT_A = WT_G2 + 1 * MiB;
constexpr size_t WT_B = WT_A + 4 * MiB;
constexpr size_t WT_O = WT_B + 4 * MiB;
constexpr size_t WT_GU = WT_O + 8 * MiB;
constexpr size_t WT_D = WT_GU + 176 * MiB;
static_assert(WT_D + 88 * MiB == WS_END, "weight map");

__device__ __forceinline__ float bf2f(unsigned v) { return __uint_as_float(v << 16); }
__device__ __forceinline__ float bflo(unsigned w) { return __uint_as_float(w << 16); }
__device__ __forceinline__ float bfhi(unsigned w) { return __uint_as_float(w & 0xffff0000u); }
__device__ __forceinline__ unsigned f2bf(float f) { unsigned u = __float_as_uint(f); return (u + 0x7fffu + ((u >> 16) & 1u)) >> 16; }
__device__ __forceinline__ unsigned pk2(float lo, float hi) { unsigned r; asm volatile("v_cvt_pk_bf16_f32 %0, %1, %2" : "=v"(r) : "v"(lo), "v"(hi)); return r; }
__device__ __forceinline__ float sigm(float x) { return 1.0f / (1.0f + __expf(-x)); }
__device__ __forceinline__ float siluf(float x) { return x * sigm(x); }
__device__ __forceinline__ float wave_sum(float v) {
#pragma unroll
    for (int o = 1; o < 64; o <<= 1) v += __shfl_xor(v, o);
    return v;
}
__device__ __forceinline__ void unpack8(const u32x4 w, float (&o)[8]) {
    o[0] = bflo(w.x); o[1] = bfhi(w.x); o[2] = bflo(w.y); o[3] = bfhi(w.y); o[4] = bflo(w.z); o[5] = bfhi(w.z); o[6] = bflo(w.w); o[7] = bfhi(w.w);
}
__device__ __forceinline__ u32x4 pack8(const float (&v)[8]) { u32x4 w; w.x = pk2(v[0], v[1]); w.y = pk2(v[2], v[3]); w.z = pk2(v[4], v[5]); w.w = pk2(v[6], v[7]); return w; }
namespace pg8 {
#define PG8_LAS __attribute__((address_space(3)))
typedef unsigned short bf16_t;
typedef short bf16x8 __attribute__((ext_vector_type(8)));
typedef float f32x4 __attribute__((ext_vector_type(4)));
typedef unsigned u32x4 __attribute__((ext_vector_type(4)));
constexpr int BM = 256, BK = 64, HALF = 128, HTB = HALF * BK * 2  , STAGE_BYTES = 8 * HTB, NXCD = 8, WGM = 8;

__host__ __device__ __forceinline__ int lds_byte(int r, int c) { const int st = (r >> 4) * 2 + (c >> 5), rr = r & 15, cc = c & 31, ob = rr * 64 + cc * 2; return st * 1024 + (ob ^ (((ob >> 9) & 1) << 5)); }
__host__ __device__ __forceinline__ void stage_rc(int b, int& R, int& C) { const int st = b / 1024, sb = b % 1024, swz = sb ^ (((sb >> 9) & 1) << 5); R = (st >> 1) * 16 + swz / 64; C = (st & 1) * 32 + (swz % 64) / 2; }
__host__ __device__ __forceinline__ int perm32(int rho) { const int n = rho >> 4, i = rho & 15; return 8 * (i >> 2) + 4 * n + (i & 3); }
struct Unit { int pm, pn, eb; };
struct Gemm { const bf16_t* A; const bf16_t* Bt; int M, N, K; size_t bstride; };

struct StaticOrder {
    int nM, nN, nwg, G, c;
    __host__ __device__ void init(int M, int N, int G_, int c_) { nM = M / BM; nN = N / BM; nwg = nM * nN; G = G_; c = c_; }
    __host__ __device__ bool next(int i, Unit& u) const {
        const long L = (long)i * G + c; if (L >= nwg) return false;
        int wgid = (int)L; { const int q = nwg / NXCD, r = nwg % NXCD, xcd = wgid % NXCD, off = wgid / NXCD; wgid = (xcd < r ? xcd * (q + 1) : r * (q + 1) + (xcd - r) * q) + off; }
        const int nig = WGM * nN, gid = wgid / nig, fm = gid * WGM, gsz = (nM - fm) < WGM ? (nM - fm) : WGM;
        u.pm = fm + ((wgid % nig) % gsz); u.pn = (wgid % nig) / gsz; u.eb = 0; return true;
    }
    __device__ __forceinline__ void a_ready(const Unit&) const {}
    __device__ __forceinline__ void done(const Unit&) const {}
};
struct MoeOrder {
    const int* tab; int nT, nN, G, c;
    __device__ void init(const int* tab_, int nN_, int G_, int c_) { tab = tab_; nT = tab_[0]; nN = nN_; G = G_; c = c_; }
    __device__ bool next(int i, Unit& u) const {
        const long L = (long)i * G + c; if (L >= (long)nT * nN) return false;
        u.pm = (int)(L / nN); u.pn = (int)(L % nN); u.eb = tab[1 + u.pm]; return true;
    }
    __device__ __forceinline__ void a_ready(const Unit&) const {}
    __device__ __forceinline__ void done(const Unit&) const {}
};

template <class F> struct Epi8 {
    static constexpr bool PERM = true, AFTER_DRAIN = false;
    F f;
    __device__ __forceinline__ void operator()(const f32x4 (&acc)[2][2][4][2], const Unit& u, int wr, int wc, int fr, int fq) const {
        const int row0 = u.pm * BM + wr * 64 + fr, col0 = u.pn * BM + wc * 32 + 8 * fq;
#pragma unroll
        for (int ai = 0; ai < 2; ++ai)
#pragma unroll
            for (int m = 0; m < 4; ++m) {
#pragma unroll
                for (int bj = 0; bj < 2; ++bj) {
                    const f32x4 a = acc[ai][bj][m][0], b = acc[ai][bj][m][1];
                    float v[8] = {a[0], a[1], a[2], a[3], b[0], b[1], b[2], b[3]};
                    f(row0 + ai * HALF + m * 16, col0 + bj * HALF, v, u);
                }
            }
    }
};
template <class F> struct EpiGU {
    static constexpr bool PERM = true, AFTER_DRAIN = false;
    F f;
    __device__ __forceinline__ void operator()(const f32x4 (&acc)[2][2][4][2], const Unit& u, int wr, int wc, int fr, int fq) const {
        const int row0 = u.pm * BM + wr * 64 + fr, col0 = u.pn * HALF + wc * 32 + 8 * fq;
#pragma unroll
        for (int ai = 0; ai < 2; ++ai)
#pragma unroll
            for (int m = 0; m < 4; ++m) {
                const f32x4 g0 = acc[ai][0][m][0], g1 = acc[ai][0][m][1], u0 = acc[ai][1][m][0], u1 = acc[ai][1][m][1];
                float g[8] = {g0[0], g0[1], g0[2], g0[3], g1[0], g1[1], g1[2], g1[3]};
                float up[8] = {u0[0], u0[1], u0[2], u0[3], u1[0], u1[1], u1[2], u1[3]};
                f(row0 + ai * HALF + m * 16, col0, g, up);
            }
    }
};
template <class F> struct Epi4 {
    static constexpr bool PERM = false, AFTER_DRAIN = false;
    F f;
    __device__ __forceinline__ void operator()(const f32x4 (&acc)[2][2][4][2], const Unit& u, int wr, int wc, int fr, int fq) const {
        const int row0 = u.pm * BM + wr * 64 + fr, col0 = u.pn * BM + wc * 32 + 4 * fq;
#pragma unroll
        for (int ai = 0; ai < 2; ++ai)
#pragma unroll
            for (int m = 0; m < 4; ++m) {
#pragma unroll
                for (int bj = 0; bj < 2; ++bj)
#pragma unroll
                    for (int n = 0; n < 2; ++n) f(row0 + ai * HALF + m * 16, col0 + bj * HALF + n * 16, acc[ai][bj][m][n], u);
            }
    }
};
template <class Epi, class Sched, bool ALIGN_EPI = false, bool SP2 = false>
__device__ __forceinline__ void gemm_phase(PG8_LAS unsigned char* lds, const Gemm g, const Sched& S, const Epi& E) {
    int tid_o = threadIdx.x; asm volatile("" : "+v"(tid_o));
    const int tid = tid_o, wid = __builtin_amdgcn_readfirstlane(tid >> 6), lane = tid & 63, wr = wid >> 2, wc = wid & 3, fr = lane & 15, fq = lane >> 4;
    const int K = g.K, nt = K / BK;
    unsigned voffA[2], voffB[2];
#pragma unroll
    for (int i = 0; i < 2; ++i) { int R, C; stage_rc(tid * 16 + i * 8192, R, C); const int Rb = Epi::PERM ? ((R & ~31) + perm32(R & 31)) : R;
        voffA[i] = (unsigned)(R * K + C) * 2u; voffB[i] = (unsigned)(Rb * K + C) * 2u; }
    const size_t kstep = (size_t)(BK * 2);
    const size_t hstep = (size_t)HALF * K * 2;
    const size_t tstep = 2 * hstep;
    const unsigned ldsw = (unsigned)wid * 1024u;
    const int aoff = lds_byte(wr * 64 + fr, fq * 8), boff = lds_byte(wc * 32 + fr, fq * 8);
#define PG8_SA(b, h) (((b) * 2 + (h)) * HTB)
#define PG8_SB(b, h) ((4 + (b) * 2 + (h)) * HTB)
#define PG8_STAGE(bufoff, gbase, voff) do { _Pragma("unroll") for (int _i = 0; _i < 2; ++_i) \
        __builtin_amdgcn_global_load_lds((const unsigned*)((const char*)(gbase) + (voff)[_i]), (PG8_LAS unsigned*)(lds + (bufoff) + ldsw + _i * 8192), 16, 0, 0); } while (0)
#define PG8_LDA(dst, b, h) do { _Pragma("unroll") for (int m = 0; m < 4; ++m) _Pragma("unroll") for (int k = 0; k < 2; ++k) dst[m][k] = *(const PG8_LAS bf16x8*)(lds + PG8_SA(b, h) + aoff + m * 2048 + k * 1024); } while (0)
#define PG8_LDB(dst, b, h) do { _Pragma("unroll") for (int n = 0; n < 2; ++n) _Pragma("unroll") for (int k = 0; k < 2; ++k) dst[n][k] = *(const PG8_LAS bf16x8*)(lds + PG8_SB(b, h) + boff + n * 2048 + k * 1024); } while (0)
#define PG8_MMA(ai, bj, At, Bt) do { __builtin_amdgcn_s_setprio(1); _Pragma("unroll") for (int m = 0; m < 4; ++m) _Pragma("unroll") for (int n = 0; n < 2; ++n) _Pragma("unroll") for (int k = 0; k < 2; ++k) \
        acc[ai][bj][m][n] = __builtin_amdgcn_mfma_f32_16x16x32_bf16(Bt[n][k], At[m][k], acc[ai][bj][m][n], 0, 0, 0); __builtin_amdgcn_s_setprio(0); } while (0)
#define PG8_WAIT_V(n) asm volatile("s_waitcnt vmcnt(" #n ")" ::: "memory")
#define PG8_WAIT_L(n) asm volatile("s_waitcnt lgkmcnt(" #n ")" ::: "memory")
#define PG8_BAR __builtin_amdgcn_s_barrier()
#define PG8_SCHED __builtin_amdgcn_sched_barrier(0)
    Unit cur, nxt; int ui = 0;
    if (!S.next(0, cur)) return;
    f32x4 acc[2][2][4][2];
#pragma unroll
    for (int a = 0; a < 2; ++a)
#pragma unroll
        for (int b = 0; b < 2; ++b)
#pragma unroll
            for (int m = 0; m < 4; ++m)
#pragma unroll
                for (int n = 0; n < 2; ++n) acc[a][b][m][n] = (f32x4){0.f, 0.f, 0.f, 0.f};
    bf16x8 At[4][2], B0[2][2], B1[2][2];
    const char* cA = (const char*)g.A + (size_t)cur.pm * tstep; const char* cB = (const char*)g.Bt + (size_t)cur.eb * g.bstride + (size_t)cur.pn * tstep;
    S.a_ready(cur);
    if constexpr (SP2) {
        PG8_STAGE(PG8_SB(0, 0), cB, voffB); PG8_STAGE(PG8_SB(0, 1), cB + hstep, voffB); PG8_STAGE(PG8_SA(0, 0), cA, voffA); PG8_STAGE(PG8_SA(0, 1), cA + hstep, voffA);
        if (wr == 1) PG8_BAR;
        PG8_WAIT_V(2); PG8_BAR;
        PG8_STAGE(PG8_SB(1, 0), cB + kstep, voffB); PG8_STAGE(PG8_SA(1, 0), cA + kstep, voffA); PG8_STAGE(PG8_SB(1, 1), cB + hstep + kstep, voffB);
        PG8_WAIT_V(6); PG8_BAR;
    } else {
        PG8_STAGE(PG8_SB(0, 0), cB, voffB); PG8_STAGE(PG8_SA(0, 0), cA, voffA); PG8_STAGE(PG8_SB(0, 1), cB + hstep, voffB); PG8_STAGE(PG8_SA(0, 1), cA + hstep, voffA);
        if (wr == 1) PG8_BAR;
        PG8_WAIT_V(4); PG8_BAR;
        PG8_STAGE(PG8_SB(1, 0), cB + kstep, voffB); PG8_STAGE(PG8_SA(1, 0), cA + kstep, voffA); PG8_STAGE(PG8_SB(1, 1), cB + hstep + kstep, voffB);
        PG8_WAIT_V(6); PG8_BAR;
    }
    for (;;) {
        const bool has_next = S.next(ui + 1, nxt);
        const char* nA = has_next ? (const char*)g.A + (size_t)nxt.pm * tstep : cA; const char* nB = has_next ? (const char*)g.Bt + (size_t)nxt.eb * g.bstride + (size_t)nxt.pn * tstep : cB;
#pragma nounroll
        for (int t = 0; t < nt; t += 2) {
            const bool last = (t == nt - 2);
            const char* a1 = cA + (size_t)(t + 1) * kstep;
            const char* a2 = last ? nA : cA + (size_t)(t + 2) * kstep; const char* b2 = last ? nB : cB + (size_t)(t + 2) * kstep;
            const char* a3 = a2 + kstep; const char* b3 = b2 + kstep;
            if (last && has_next) S.a_ready(nxt);
            if constexpr (SP2) {
            PG8_LDB(B0, 0, 0); PG8_LDB(B1, 0, 1); PG8_SCHED; PG8_LDA(At, 0, 0); PG8_STAGE(PG8_SA(1, 1), a1 + hstep, voffA);
            PG8_WAIT_V(8); PG8_WAIT_L(0); PG8_BAR; PG8_MMA(0, 0, At, B0); PG8_MMA(0, 1, At, B1); PG8_BAR; PG8_SCHED;
            PG8_LDA(At, 0, 1); PG8_STAGE(PG8_SB(0, 0), b2, voffB); PG8_STAGE(PG8_SB(0, 1), b2 + hstep, voffB); PG8_STAGE(PG8_SA(0, 0), a2, voffA);
            PG8_WAIT_V(8); PG8_WAIT_L(0); PG8_BAR; PG8_MMA(1, 0, At, B0); PG8_MMA(1, 1, At, B1); PG8_BAR; PG8_SCHED;
            PG8_LDB(B0, 1, 0); PG8_LDB(B1, 1, 1); PG8_SCHED; PG8_LDA(At, 1, 0); PG8_STAGE(PG8_SA(0, 1), a2 + hstep, voffA);
            PG8_WAIT_V(8); PG8_WAIT_L(0); PG8_BAR; PG8_MMA(0, 0, At, B0); PG8_MMA(0, 1, At, B1); PG8_BAR; PG8_SCHED;
            PG8_LDA(At, 1, 1); PG8_STAGE(PG8_SB(1, 0), b3, voffB); PG8_STAGE(PG8_SB(1, 1), b3 + hstep, voffB); PG8_STAGE(PG8_SA(1, 0), a3, voffA);
            PG8_WAIT_V(8); PG8_WAIT_L(0); PG8_BAR; PG8_MMA(1, 0, At, B0); PG8_MMA(1, 1, At, B1); PG8_BAR; PG8_SCHED;
            } else {
            PG8_LDB(B0, 0, 0); PG8_SCHED; PG8_LDA(At, 0, 0); PG8_STAGE(PG8_SA(1, 1), a1 + hstep, voffA);
            PG8_WAIT_L(8); PG8_BAR; PG8_WAIT_L(0); PG8_MMA(0, 0, At, B0); PG8_BAR; PG8_SCHED;
            PG8_LDB(B1, 0, 1); PG8_STAGE(PG8_SB(0, 0), b2, voffB);
            PG8_BAR; PG8_WAIT_L(0); PG8_MMA(0, 1, At, B1); PG8_BAR;
            PG8_LDA(At, 0, 1); PG8_STAGE(PG8_SA(0, 0), a2, voffA);
            PG8_BAR; PG8_WAIT_L(0); PG8_MMA(1, 0, At, B0); PG8_BAR; PG8_SCHED;
            PG8_STAGE(PG8_SB(0, 1), b2 + hstep, voffB);
            PG8_WAIT_V(6); PG8_BAR; PG8_MMA(1, 1, At, B1); PG8_BAR;
            PG8_LDB(B0, 1, 0); PG8_SCHED; PG8_LDA(At, 1, 0); PG8_STAGE(PG8_SA(0, 1), a2 + hstep, voffA);
            PG8_WAIT_L(8); PG8_BAR; PG8_WAIT_L(0); PG8_MMA(0, 0, At, B0); PG8_BAR; PG8_SCHED;
            PG8_LDB(B1, 1, 1); PG8_STAGE(PG8_SB(1, 0), b3, voffB);
            PG8_BAR; PG8_WAIT_L(0); PG8_MMA(0, 1, At, B1); PG8_BAR;
            PG8_LDA(At, 1, 1); PG8_STAGE(PG8_SA(1, 0), a3, voffA);
            PG8_BAR; PG8_WAIT_L(0); PG8_MMA(1, 0, At, B0); PG8_BAR; PG8_SCHED;
            PG8_STAGE(PG8_SB(1, 1), b3 + hstep, voffB);
            PG8_WAIT_V(6); PG8_BAR; PG8_MMA(1, 1, At, B1); PG8_BAR;
            }
        }
        if constexpr (ALIGN_EPI) { if (wr == 0) PG8_BAR; }
        if constexpr (!Epi::AFTER_DRAIN) { E(acc, cur, wr, wc, fr, fq); S.done(cur); }
        if (!has_next) break;
#pragma unroll
        for (int a = 0; a < 2; ++a)
#pragma unroll
            for (int b = 0; b < 2; ++b)
#pragma unroll
                for (int m = 0; m < 4; ++m)
#pragma unroll
                    for (int n = 0; n < 2; ++n) acc[a][b][m][n] = (f32x4){0.f, 0.f, 0.f, 0.f};
        cur = nxt; cA = nA; cB = nB; ++ui;
        if constexpr (ALIGN_EPI) { if (wr == 1) PG8_BAR; }
    }
    PG8_WAIT_V(0);
    if constexpr (!ALIGN_EPI) { if (wr == 0) PG8_BAR; }
    PG8_BAR;
    if constexpr (Epi::AFTER_DRAIN) { E.fused(acc, cur, wr, wc, fr, fq, lds, wid, lane); S.done(cur); }
#undef PG8_SA
#undef PG8_SB
#undef PG8_STAGE
#undef PG8_LDA
#undef PG8_LDB
#undef PG8_MMA
#undef PG8_WAIT_V
#undef PG8_WAIT_L
#undef PG8_BAR
#undef PG8_SCHED
}
}

#ifndef PG8_SP2
#define PG8_SP2 true
#endif
#ifndef PG8_ALIGN
#define PG8_ALIGN true
#endif
#define XB_TMO      128
#define XB_XCNT(j)  (256  + 64 * (j))
#define XB_XSUB(j)  (1280 + 64 * (j))
#define XB_XGEN(j)  (2304 + 64 * (j))
#define XB_TOP      3328
#define XB_TOPGEN   3392
#define XCD_BAR_WORDS 3456
#define XB_SPIN_CAP (1u << 18)

__device__ __forceinline__ unsigned xb_ld(unsigned* p)              { return __hip_atomic_load(p, __ATOMIC_RELAXED, __HIP_MEMORY_SCOPE_AGENT); }
__device__ __forceinline__ unsigned xb_add(unsigned* p, unsigned v) { return __hip_atomic_fetch_add(p, v, __ATOMIC_RELAXED, __HIP_MEMORY_SCOPE_AGENT); }
__device__ __forceinline__ unsigned xb_xcc_id() { return (unsigned)__builtin_amdgcn_s_getreg((3 << 11) | 20) & 0xFu; }
#define XB_SPIN(cond, bar) do { unsigned _sp = 0; while (cond) { __builtin_amdgcn_s_sleep(1); \
    if ((++_sp & 255u) == 0u) { if (xb_ld(&(bar)[XB_TMO])) break; if (_sp > XB_SPIN_CAP) { atomicAdd(&(bar)[XB_TMO], 1u); break; } } } } while (0)

struct XcdBarrier {
    unsigned* bar; unsigned x;
    volatile LAS unsigned* st;
};

__device__ __forceinline__ XcdBarrier xcd_barrier_post(unsigned* bar, volatile LAS unsigned* st) {
    XcdBarrier b; b.bar = bar; b.x = xb_xcc_id(); b.st = st;
    if (threadIdx.x == 0) (void)xb_add(&bar[XB_XCNT(b.x)], 1u);
    return b;
}
__device__ __forceinline__ void xcd_barrier_complete(unsigned* bar, unsigned x, unsigned& nloc, unsigned& nx) {
    const unsigned G = gridDim.x * gridDim.y * gridDim.z;
    unsigned sum, cnt, mine, sp = 0u;
    for (;;) {
        sum = 0u; cnt = 0u; mine = 0u;
#pragma unroll
        for (unsigned j = 0; j < 16; ++j) { const unsigned c = xb_ld(&bar[XB_XCNT(j)]); sum += c; cnt += (c > 0u) ? 1u : 0u; mine = (j == x) ? c : mine; }
        if (sum == G) break;
        __builtin_amdgcn_s_sleep(1);
        if ((++sp & 255u) == 0u) { if (xb_ld(&bar[XB_TMO])) break; if (sp > XB_SPIN_CAP) { atomicAdd(&bar[XB_TMO], 1u); break; } }
    }
    nloc = mine > 0u ? mine : 1u; nx = cnt > 0u ? cnt : 1u;
}

__device__ __forceinline__ void xcd_barrier(const XcdBarrier& b) {
    asm volatile("s_waitcnt vmcnt(0)" ::: "memory");
    __syncthreads();
    if (threadIdx.x == 0) {
        unsigned* bar = b.bar;
        __builtin_amdgcn_s_waitcnt(0);
        unsigned nloc = b.st[0], nx = b.st[1];
        if (nloc == 0u) { xcd_barrier_complete(bar, b.x, nloc, nx); b.st[0] = nloc; b.st[1] = nx; }
        const unsigned old = xb_add(&bar[XB_XSUB(b.x)], 1u);
        const unsigned gen = old / nloc;
        if (old + 1u == (gen + 1u) * nloc) {
            __builtin_amdgcn_fence(__ATOMIC_RELEASE, "agent");
            asm volatile("s_waitcnt vmcnt(0)" ::: "memory");
            const unsigned og = xb_add(&bar[XB_TOP], 1u);
            const unsigned tg = og / nx;
            if (og + 1u == (tg + 1u) * nx) xb_add(&bar[XB_TOPGEN], 1u);
            else XB_SPIN(xb_ld(&bar[XB_TOPGEN]) == tg, bar);
            __builtin_amdgcn_fence(__ATOMIC_ACQUIRE, "agent");
            xb_add(&bar[XB_XGEN(b.x)], 1u);
            asm volatile("s_waitcnt vmcnt(0)" ::: "memory");
        } else {
            XB_SPIN(xb_ld(&bar[XB_XGEN(b.x)]) == gen, bar);
            __builtin_amdgcn_fence(__ATOMIC_ACQUIRE, "agent");
            asm volatile("s_waitcnt vmcnt(0)" ::: "memory");
        }
    }
    __syncthreads();
}
struct KC {
    const float* const* in;
    LAS unsigned char* lds;
    unsigned char* ws;
    int tid, lane, wave, G, bid;
};
__device__ __forceinline__ const float* inp_(int i) {
    const volatile unsigned long long __attribute__((address_space(4)))* kp = (const volatile unsigned long long __attribute__((address_space(4)))*)__builtin_amdgcn_kernarg_segment_ptr();
    return (const float*)(const GAS float*)kp[i];
}
#define INP(k) (inp_(k))

__device__ __forceinline__ int mod_row(int row) { return row < TL ? (row >> 11) : 8; }

__device__ __forceinline__ void ph_adaln_partials(const KC& k, const float* c, const float* c_ctx, const float* w_ada) {
    LAS float* sc = (LAS float*)k.lds;
    for (int i = k.tid; i < 9 * DM; i += 512) { const int r = i >> 11, kk = i & 2047; const float cv = r < 8 ? c[r * DM + kk] : c_ctx[kk]; sc[i] = siluf(cv); }
    __syncthreads();
    float* modp = (float*)(k.ws + WS_MODP);
    const int cc = k.tid & 255, kh = k.tid >> 8;
    constexpr int NIT = DEPTH * 48 * 16;
    for (int it = k.bid; it < NIT; it += k.G) {
        const int l = it / 768, rem = it % 768, cb = rem >> 4, ks = rem & 15;
        const int col = cb * 256 + cc, kbeg = ks * 128 + kh * 64;
        const float* W = w_ada + ((size_t)l * DM + kbeg) * MOD_N + col;
        float acc[9];
#pragma unroll
        for (int r = 0; r < 9; ++r) acc[r] = 0.f;
#pragma unroll 32
        for (int q = 0; q < 64; ++q) {
            const float w = W[(size_t)q * MOD_N];
#pragma unroll
            for (int r = 0; r < 9; ++r) acc[r] += sc[r * DM + kbeg + q] * w;
        }
        const int s = ks * 2 + kh;
#pragma unroll
        for (int r = 0; r < 9; ++r) modp[(((size_t)s * DEPTH + l) * 9 + r) * MOD_N + col] = acc[r];
    }
    __syncthreads();
}
__device__ __forceinline__ void ph_adaln_reduce(const KC& k, const float* b_ada) {
    const float* modp = (const float*)(k.ws + WS_MODP); float* mod = (float*)(k.ws + WS_MOD);
    constexpr int TOT = DEPTH * 9 * MOD_N;
    for (int i = k.bid * 512 + k.tid; i < TOT; i += k.G * 512) {
        const int n = i % MOD_N, l = i / (9 * MOD_N);
        float s = b_ada[l * MOD_N + n];
#pragma unroll 8
        for (int q = 0; q < KSPLIT; ++q) s += modp[(size_t)q * TOT + i];
        mod[i] = s;
    }
}

struct TrItem { const float* src; bf16* dst; int srcN, Kv, Nv, k0, n0, dpitch, drow0, dk0; };
struct WSrc { const float *w_in, *w2, *a2, *g2, *wba, *wbb, *wout, *eg, *eu, *ed, *w0, *a0; };
constexpr int TI_IN = 32 * 336, TI_LO = 4 * 64, TI_G2 = 4 * 32, TI_AB = 16 * 64, TI_O = 32 * 64, TI_GU1 = 32 * 44, TI_D1 = 22 * 64;
constexpr int TI_N = TI_IN + TI_LO + TI_G2 + 2 * TI_AB + TI_O + 2 * NEXP * TI_GU1 + NEXP * TI_D1;
__device__ __forceinline__ TrItem tr_decode(const WSrc& s, unsigned char* ws, int l, int it) {
    TrItem t; int r = it;
    if (r < TI_IN) { const int kb = r / 336, nb = r % 336; t = TrItem{s.w_in + (size_t)l * DM * IN_DIM, (bf16*)(ws + WT_IN), IN_DIM, DM, IN_DIM, 64 * kb, 32 * nb, DM, 32 * nb, 0}; return t; } r -= TI_IN;
    if (r < TI_LO) {
        const int mtx = r >> 6, q = r & 63, kb = q >> 5, nb = q & 31;
        t = TrItem{(mtx < 2 ? s.w2 : s.a2) + (size_t)(l * 2 + (mtx & 1)) * 96 * RD, (bf16*)(ws + WT_L1), RD, 96, RD, 64 * kb, 32 * nb, 256, mtx * 1024 + 32 * nb, mtx < 2 ? 0 : 96}; return t; } r -= TI_LO;
    if (r < TI_G2) { const int kb = r >> 5, nb = r & 31; t = TrItem{s.g2 + (size_t)l * 256 * RD, (bf16*)(ws + WT_G2), RD, 256, RD, 64 * kb, 32 * nb, 256, 32 * nb, 0}; return t; } r -= TI_G2;
    if (r < TI_AB) { const int kb = r >> 6, nb = r & 63; t = TrItem{s.wba + (size_t)l * RD * DM, (bf16*)(ws + WT_A), DM, RD, DM, 64 * kb, 32 * nb, RD, 32 * nb, 0}; return t; } r -= TI_AB;
    if (r < TI_AB) { const int kb = r >> 6, nb = r & 63; t = TrItem{s.wbb + (size_t)l * GVD * DM, (bf16*)(ws + WT_B), DM, GVD, DM, 64 * kb, 32 * nb, GVD, 32 * nb, 0}; return t; } r -= TI_AB;
    if (r < TI_O) { const int kb = r >> 6, nb = r & 63; t = TrItem{s.wout + (size_t)l * DM * DM, (bf16*)(ws + WT_O), DM, DM, DM, 64 * kb, 32 * nb, DM, 32 * nb, 0}; return t; } r -= TI_O;
    if (r < 2 * NEXP * TI_GU1) {
        const int e = r / (2 * TI_GU1), q = r % (2 * TI_GU1), up = q / TI_GU1, q2 = q % TI_GU1, kb = q2 / 44, nb = q2 % 44;
        const int n0 = 32 * nb, drow = 256 * (n0 >> 7) + (n0 & 127) + (up ? 128 : 0);
        t = TrItem{(up ? s.eu : s.eg) + ((size_t)l * NEXP + e) * DM * DEXP, (bf16*)(ws + WT_GU) + (size_t)e * 2816 * DM, DEXP, DM, DEXP, 64 * kb, n0, DM, drow, 0}; return t; } r -= 2 * NEXP * TI_GU1;
    { const int e = r / TI_D1, q = r % TI_D1, kb = q >> 6, nb = q & 63;
      t = TrItem{s.ed + ((size_t)l * NEXP + e) * DEXP * DM, (bf16*)(ws + WT_D) + (size_t)e * DM * DEXP, DM, DEXP, DM, 64 * kb, 32 * nb, DEXP, 32 * nb, 0}; }
    return t;
}
__device__ __forceinline__ void tr_load(const TrItem& t, int lane, float (&v)[32]) {
    const int nn = lane & 31, kh = lane >> 5;
    const bool nok = t.n0 + nn < t.Nv;
    const float* p = t.src + (size_t)(t.k0 + kh) * t.srcN + t.n0 + nn;
#pragma unroll
    for (int i = 0; i < 32; ++i) { v[i] = 0.f; if (nok && t.k0 + 2 * i + kh < t.Kv) v[i] = p[(size_t)(2 * i) * t.srcN]; }
}
__device__ __forceinline__ void tr_store(const TrItem& t, int lane, const float (&v)[32], LAS float* scr) {
    const int nn = lane & 31, kh = lane >> 5;
#pragma unroll
    for (int i = 0; i < 32; ++i) scr[(2 * i + kh) * 33 + nn] = v[i];
    asm volatile("s_waitcnt lgkmcnt(0)" ::: "memory");
    const int cidx = lane & 7;
#pragma unroll
    for (int j = 0; j < 4; ++j) {
        const int n = (lane >> 3) + 8 * j; const LAS float* s = scr + (8 * cidx) * 33 + n;
        u32x4 o; o.x = pk2(s[0 * 33], s[1 * 33]); o.y = pk2(s[2 * 33], s[3 * 33]); o.z = pk2(s[4 * 33], s[5 * 33]); o.w = pk2(s[6 * 33], s[7 * 33]);
        *(u32x4*)(t.dst + (size_t)(t.drow0 + n) * t.dpitch + t.dk0 + t.k0 + 8 * cidx) = o;
    }
    asm volatile("s_waitcnt lgkmcnt(0)" ::: "memory");
}
__device__ __forceinline__ void ph_convert(const KC& k, const WSrc& s, int l) {
    LAS float* scr = (LAS float*)(k.lds + k.wave * 16384);
    const int gw = k.bid * 8 + k.wave, NGW = k.G * 8;
    unsigned char* ws = k.ws;
    { float* b1 = (float*)(ws + WS_TAB + TAB_TOP); for (int i = gw * 64 + k.lane; i < 4096; i += NGW * 64) b1[i] = i < 2048 ? s.w0[l * 2048 + i] : s.a0[l * 2048 + i - 2048]; }
    {
        u32x4* wl = (u32x4*)(ws + WT_L1);
        for (int i = gw * 64 + k.lane; i < 4096 * 32; i += NGW * 64) { const int row = i >> 5, ck = i & 31; if (row < 2048 ? ck >= 16 : (ck < 12 || ck >= 28)) wl[i] = (u32x4){0u, 0u, 0u, 0u}; }
        if (l == 0) { int* rt = (int*)(ws + WS_TAB + TAB_ROWTOK); for (int i = gw * 64 + k.lane; i < 2 * MOE_ROWS; i += NGW * 64) rt[i] = -1; }
    }
    float cur[32], nxt[32];
    int it = gw;
    TrItem tc = tr_decode(s, ws, l, it < TI_N ? it : 0);
    if (it < TI_N) tr_load(tc, k.lane, cur);
    for (; it < TI_N; it += NGW) {
        const bool more = it + NGW < TI_N;
        const TrItem tn = tr_decode(s, ws, l, more ? it + NGW : it);
        if (more) tr_load(tn, k.lane, nxt);
        tr_store(tc, k.lane, cur, scr);
        tc = tn;
#pragma unroll
        for (int i = 0; i < 32; ++i) cur[i] = nxt[i];
    }
}

constexpr int RWP = DM + 4;
struct RowArgs { const float *x_in, *ctx_in, *gvec, *router_w, *router_b; float* out; };
template <int MODE>
__device__ __forceinline__ void ph_rows(const KC& k, const RowArgs& ra, int l, int nrows, bool dry = false) {
    const int gw = k.bid * 8 + k.wave, NGW = k.G * 8, lane = k.lane;
    float* X = (float*)(k.ws + WS_X); bf16* H = (bf16*)(k.ws + WS_H);
    const float* MOD = (const float*)(k.ws + WS_MOD);
    const bf16* YF = (const bf16*)(k.ws + WS_YF);
    LAS float* rwT = (LAS float*)k.lds;
    if (MODE == 1) {
        for (int i = k.tid; i < DM * NEXP; i += 512) { const int c = i >> 4, e = i & 15; rwT[e * RWP + c] = ra.router_w[i]; }
        __syncthreads();
    }
    const float* gv = ra.gvec;
    for (int row = gw; row < nrows; row += NGW) {
        const int mr = mod_row(row);
        f32x4 v[8];
        if (MODE == 0 && l == 0) {
            const f32x4* src = (const f32x4*)(row < TL ? ra.x_in + (size_t)row * DM : ra.ctx_in + (size_t)(row - TL) * DM) + lane;
#pragma unroll
            for (int j = 0; j < 8; ++j) v[j] = src[64 * j];
        } else {
            const f32x4* src = (const f32x4*)(X + (size_t)row * DM) + lane;
#pragma unroll
            for (int j = 0; j < 8; ++j) v[j] = src[64 * j];
        }
        if ((MODE == 0 && l > 0) || MODE == 2) {
            const int lp = (MODE == 2) ? DEPTH - 1 : l - 1;
            const f32x4* gate = (const f32x4*)(MOD + ((size_t)lp * 9 + mr) * MOD_N + 5 * DM) + lane;
            const u32x2* y0 = (const u32x2*)(YF + (size_t)row * DM) + lane;
            const u32x2* y1 = (const u32x2*)(YF + ((size_t)TA + row) * DM) + lane;
#pragma unroll
            for (int j = 0; j < 8; ++j) {
                const f32x4 g = gate[64 * j]; const u32x2 a = y0[64 * j], b = y1[64 * j];
                v[j].x += g.x * (bflo(a.x) + bflo(b.x)); v[j].y += g.y * (bfhi(a.x) + bfhi(b.x));
                v[j].z += g.z * (bflo(a.y) + bflo(b.y)); v[j].w += g.w * (bfhi(a.y) + bfhi(b.y));
            }
        }
        if (MODE == 0) {
            f32x4* dst = (f32x4*)(X + (size_t)row * DM) + lane;
#pragma unroll
            for (int j = 0; j < 8; ++j) dst[64 * j] = v[j];
        }
        float ss = 0.f;
#pragma unroll
        for (int j = 0; j < 8; ++j) ss += (v[j].x * v[j].x + v[j].y * v[j].y) + (v[j].z * v[j].z + v[j].w * v[j].w);
        const float rinv = 1.0f / sqrtf(wave_sum(ss) * (1.0f / DM) + 1e-6f);
        if (MODE == 2) {
            f32x4* dst = (f32x4*)(ra.out + (size_t)row * DM) + lane; const f32x4* g4 = (const f32x4*)gv + lane;
#pragma unroll
            for (int j = 0; j < 8; ++j) { const f32x4 g = g4[64 * j]; dst[64 * j] = v[j] * rinv * g; }
        } else {
            const float* mrow = MOD + ((size_t)l * 9 + mr) * MOD_N + (MODE == 0 ? 0 : 3 * DM);
            const f32x4* sh4 = (const f32x4*)mrow + lane; const f32x4* sc4 = (const f32x4*)(mrow + DM) + lane; const f32x4* g4 = (const f32x4*)(gv + (size_t)l * DM) + lane;
            u32x2* dst = (u32x2*)(H + (size_t)row * DM) + lane;
#pragma unroll
            for (int j = 0; j < 8; ++j) {
                const f32x4 g = g4[64 * j], sh = sh4[64 * j], sc = sc4[64 * j];
                v[j] = v[j] * rinv * g * (1.0f + sc) + sh;
                u32x2 o; o.x = pk2(v[j].x, v[j].y); o.y = pk2(v[j].z, v[j].w); dst[64 * j] = o;
            }
        }
        if (MODE == 1) {
            float lg[NEXP];
#pragma unroll
            for (int e = 0; e < NEXP; ++e) {
                float s = 0.f;
#pragma unroll
                for (int j = 0; j < 8; ++j) { const f32x4 w = *(const LAS f32x4*)(rwT + e * RWP + 4 * lane + 256 * j); s += (v[j].x * w.x + v[j].y * w.y) + (v[j].z * w.z + v[j].w * w.w); }
                lg[e] = wave_sum(s);
            }
            float sc[NEXP], sel[NEXP];
#pragma unroll
            for (int e = 0; e < NEXP; ++e) { sc[e] = 1.0f / (1.0f + expf(-lg[e])); sel[e] = sc[e] + ra.router_b[e]; }
            float gs[4], w1g[4], w2g[4]; int i1g[4], i2g[4];
#pragma unroll
            for (int g = 0; g < 4; ++g) {
                int i1 = 0; float m1 = sel[4 * g];
#pragma unroll
                for (int q = 1; q < 4; ++q) if (sel[4 * g + q] > m1) { m1 = sel[4 * g + q]; i1 = q; }
                int i2 = -1; float m2 = -3.0e38f;
#pragma unroll
                for (int q = 0; q < 4; ++q) if (q != i1 && sel[4 * g + q] > m2) { m2 = sel[4 * g + q]; i2 = q; }
                gs[g] = m1 + m2; i1g[g] = 4 * g + i1; i2g[g] = 4 * g + i2;
                float a1 = sc[4 * g], a2 = sc[4 * g];
#pragma unroll
                for (int q = 0; q < 4; ++q) { a1 = (q == i1) ? sc[4 * g + q] : a1; a2 = (q == i2) ? sc[4 * g + q] : a2; }
                w1g[g] = a1; w2g[g] = a2;
            }
            int best = 0; float bs = gs[0];
#pragma unroll
            for (int g = 1; g < 4; ++g) if (gs[g] > bs) { bs = gs[g]; best = g; }
            int e1 = i1g[0], e2 = i2g[0]; float w1 = w1g[0], w2 = w2g[0];
#pragma unroll
            for (int g = 1; g < 4; ++g) { e1 = (best == g) ? i1g[g] : e1; e2 = (best == g) ? i2g[g] : e2; w1 = (best == g) ? w1g[g] : w1; w2 = (best == g) ? w2g[g] : w2; }
            const float inv = 1.0f / (w1 + w2);
            if (lane == 0 && !dry) {
                unsigned* cnt = (unsigned*)(k.ws + WS_CTL) + CW_CNT + 64 * l;
                const int p1 = (int)atomicAdd(cnt + e1, 1u), p2 = (int)atomicAdd(cnt + e2, 1u);
                int* te = (int*)(k.ws + WS_TOPK); float* tw = (float*)(k.ws + WS_TOPK + (size_t)TA * 8); int* tp = (int*)(k.ws + WS_TOPK + 2 * (size_t)TA * 8);
                te[2 * row] = e1; te[2 * row + 1] = e2; tw[2 * row] = w1 * inv; tw[2 * row + 1] = w2 * inv; tp[2 * row] = p1; tp[2 * row + 1] = p2;
            }
        }
    }
    if (MODE == 1) __syncthreads();
}

__device__ __forceinline__ void ph_moe_scatter(const KC& k, int l, int nrows) {
    LAS int* offs = (LAS int*)k.lds;
    const unsigned* cnt = (const unsigned*)(k.ws + WS_CTL) + CW_CNT + 64 * l;
    int* tile = (int*)(k.ws + WS_TAB + TAB_TILE) + 256 * l;
    if (k.tid == 0) {
        int off = 0, nt = 0;
        for (int e = 0; e < NEXP; ++e) {
            offs[e] = off; const int c = (int)__hip_atomic_load(cnt + e, __ATOMIC_RELAXED, __HIP_MEMORY_SCOPE_AGENT); const int t = (c + 255) >> 8;
            if (k.bid == 0) for (int q = 0; q < t; ++q) tile[1 + nt + q] = e;
            nt += t; off += t * 256;
        }
        if (k.bid == 0) tile[0] = nt;
    }
    __syncthreads();
    const int gw = k.bid * 8 + k.wave, NGW = k.G * 8, lane = k.lane;
    const bf16* H = (const bf16*)(k.ws + WS_H); bf16* HP = (bf16*)(k.ws + WS_HP);
    const int* te = (const int*)(k.ws + WS_TOPK); const float* tw = (const float*)(k.ws + WS_TOPK + (size_t)TA * 8); const int* tp = (const int*)(k.ws + WS_TOPK + 2 * (size_t)TA * 8);
    int* rowtok = (int*)(k.ws + WS_TAB + TAB_ROWTOK) + (size_t)l * MOE_ROWS; float* roww = (float*)(k.ws + WS_TAB + TAB_ROWW) + (size_t)l * MOE_ROWS;
    for (int row = gw; row < nrows; row += NGW) {
        const u32x4* src = (const u32x4*)(H + (size_t)row * DM) + lane;
        u32x4 d[4];
#pragma unroll
        for (int j = 0; j < 4; ++j) d[j] = src[64 * j];
#pragma unroll
        for (int s = 0; s < 2; ++s) {
            const int e = te[2 * row + s], dest = offs[e] + tp[2 * row + s];
            u32x4* dp = (u32x4*)(HP + (size_t)dest * DM) + lane;
#pragma unroll
            for (int j = 0; j < 4; ++j) dp[64 * j] = d[j];
            if (lane == 0) { rowtok[dest] = 2 * row + s; roww[dest] = tw[2 * row + s]; }
        }
    }
    __syncthreads();
}
__device__ __forceinline__ void ld16(const bf16* p, bool ok, float (&o)[16]) {
    if (ok) { const u32x4 a = *(const u32x4*)p, b = *(const u32x4*)(p + 8); float x[8], y[8]; unpack8(a, x); unpack8(b, y);
#pragma unroll
        for (int i = 0; i < 8; ++i) { o[i] = x[i]; o[8 + i] = y[i]; } }
    else {
#pragma unroll
        for (int i = 0; i < 16; ++i) o[i] = 0.f; }
}
__device__ __forceinline__ void st16(bf16* p, const float (&v)[16]) {
    float a[8], b[8];
#pragma unroll
    for (int i = 0; i < 8; ++i) { a[i] = v[i]; b[i] = v[8 + i]; }
    *(u32x4*)p = pack8(a); *(u32x4*)(p + 8) = pack8(b);
}
__device__ __forceinline__ void shift8(const bf16* p0, bool hp, bool hn, int c, const float* mu0, const float* mu1, float (&s)[8]) {
    float x[8], xm[8], xp[8];
    unpack8(*(const u32x4*)(p0 + c), x);
    if (hp) unpack8(*(const u32x4*)(p0 - NP + c), xm); else {
#pragma unroll
        for (int i = 0; i < 8; ++i) xm[i] = 0.f; }
    if (hn) unpack8(*(const u32x4*)(p0 + NP + c), xp); else {
#pragma unroll
        for (int i = 0; i < 8; ++i) xp[i] = 0.f; }
    const f32x4 m0a = *(const f32x4*)(mu0 + c), m0b = *(const f32x4*)(mu0 + c + 4), m1a = *(const f32x4*)(mu1 + c), m1b = *(const f32x4*)(mu1 + c + 4);
    const float m0[8] = {m0a.x, m0a.y, m0a.z, m0a.w, m0b.x, m0b.y, m0b.z, m0b.w}, m1[8] = {m1a.x, m1a.y, m1a.z, m1a.w, m1b.x, m1b.y, m1b.z, m1b.w};
#pragma unroll
    for (int i = 0; i < 8; ++i) s[i] = x[i] + m0[i] * (xm[i] - x[i]) + m1[i] * (xp[i] - x[i]);
}
__device__ __forceinline__ void ph_rwkv_prep(const KC& k, int l, int nrows, const float* mu, const float* k_k, const float* r_k) {
    const int gw = k.bid * 8 + k.wave, NGW = k.G * 8, lane = k.lane;
    const bf16* P = (const bf16*)(k.ws + WS_P);
    bf16* R = (bf16*)(k.ws + RW_R); bf16* KS = (bf16*)(k.ws + RW_KS); bf16* V = (bf16*)(k.ws + RW_V); bf16* KK = (bf16*)(k.ws + RW_KK);
    bf16* A1 = (bf16*)(k.ws + RW_A1); bf16* A2 = (bf16*)(k.ws + RW_A2); float* BON = (float*)(k.ws + RW_BON);
    const float* mu0 = mu + (size_t)(l * 2 + 0) * RWKV_IN; const float* mu1 = mu + (size_t)(l * 2 + 1) * RWKV_IN;
    const int rpw = (nrows + NGW - 1) / NGW;
    for (int row = gw * rpw; row < nrows && row < (gw + 1) * rpw; ++row) {
        int t, len; if (row < TL) { t = row & (SEQ - 1); len = SEQ; } else { t = (row - TL) & (CTXL - 1); len = CTXL; }
        const bool hp = t > 0, hn = t < len - 1;
        const bf16* p0 = P + (size_t)row * NP;
#pragma unroll
        for (int half = 0; half < 2; ++half) {
            const int c = half * 512 + 8 * lane;
            float r[8], kx[8], vv[8], kk[8];
            shift8(p0, hp, hn, c, mu0, mu1, r);
            shift8(p0, hp, hn, RD + c, mu0, mu1, kx);
            shift8(p0, hp, hn, 2 * RD + c, mu0, mu1, vv);
            const f32x4 kka = *(const f32x4*)(k_k + l * RD + c), kkb = *(const f32x4*)(k_k + l * RD + c + 4), rka = *(const f32x4*)(r_k + l * RD + c), rkb = *(const f32x4*)(r_k + l * RD + c + 4);
            const float kkw[8] = {kka.x, kka.y, kka.z, kka.w, kkb.x, kkb.y, kkb.z, kkb.w}, rkw[8] = {rka.x, rka.y, rka.z, rka.w, rkb.x, rkb.y, rkb.z, rkb.w};
            float ss = 0.f, bon = 0.f;
#pragma unroll
            for (int i = 0; i < 8; ++i) { kk[i] = kx[i] * kkw[i]; ss += kk[i] * kk[i]; bon += r[i] * kx[i] * rkw[i]; }
            ss += __shfl_xor(ss, 1); ss += __shfl_xor(ss, 2); ss += __shfl_xor(ss, 4);
            bon += __shfl_xor(bon, 1); bon += __shfl_xor(bon, 2); bon += __shfl_xor(bon, 4);
            const float inv = 1.0f / fmaxf(sqrtf(ss), 1e-12f);
#pragma unroll
            for (int i = 0; i < 8; ++i) kk[i] *= inv;
            *(u32x4*)(R + (size_t)row * RD + c) = pack8(r); *(u32x4*)(KS + (size_t)row * RD + c) = pack8(kx);
            *(u32x4*)(V + (size_t)row * RD + c) = pack8(vv); *(u32x4*)(KK + (size_t)row * RD + c) = pack8(kk);
            if ((lane & 7) == 0) BON[(size_t)row * RHEADS + half * 8 + (lane >> 3)] = bon;
        }
        if (lane < 56) {
            float s8[8];
            shift8(p0, hp, hn, 3 * RD + 8 * lane, mu0, mu1, s8);
            if (lane < 12) {
#pragma unroll
                for (int i = 0; i < 8; ++i) { const float e2 = __expf(2.0f * fminf(fmaxf(s8[i], -15.f), 15.f)); s8[i] = 1.0f - 2.0f / (e2 + 1.0f); }
                *(u32x4*)(A1 + (size_t)row * 256 + 8 * lane) = pack8(s8);
            } else if (lane < 24) { *(u32x4*)(A1 + (size_t)row * 256 + 8 * lane) = pack8(s8); }
            else {
#pragma unroll
                for (int i = 0; i < 8; ++i) s8[i] = sigm(s8[i]);
                *(u32x4*)(A2 + (size_t)row * 256 + 8 * (lane - 24)) = pack8(s8);
            }
        } else { *(u32x4*)(A1 + (size_t)row * 256 + 192 + 8 * (lane - 56)) = (u32x4){0u, 0u, 0u, 0u}; }
    }
}

__device__ __forceinline__ float logsig(float x) { return fminf(x, 0.f) - __logf(1.0f + __expf(-fabsf(x))); }
__device__ __forceinline__ int gla_row(bool lat, int b, int s) { return lat ? b * SEQ + (s & 31) * 64 + (s >> 5) : TL + b * CTXL + s; }
constexpr int GQ_PITCH = 264;
constexpr int GPL_AD = 0, GPL_GS = 4096, GPL_QK = GPL_GS + 65536, GPL_END = GPL_QK + 66 * GQ_PITCH * 2;
static_assert(GPL_END <= 131072, "gla prep lds");
__device__ __forceinline__ void ph_gla_prep(const KC& k, int l, const float* conv, const float* aw2, const float* ab) {
    const bf16* P = (const bf16*)(k.ws + WS_P);
    bf16* QG = (bf16*)(k.ws + GL_QG); bf16* KG = (bf16*)(k.ws + GL_KG); bf16* KE = (bf16*)(k.ws + GL_KE); bf16* VS = (bf16*)(k.ws + GL_VS); float* DEC = (float*)(k.ws + GL_DEC);
    const float* cw = conv + (size_t)l * 3 * GQKV;
    const int tid = k.tid, lane = k.lane;
    {
        const int gw = k.bid * 8 + k.wave, NGW = k.G * 8, c = 16 * lane;
        const int rpw = (TA + NGW - 1) / NGW;
        for (int qi = gw * rpw; qi < TA && qi < (gw + 1) * rpw; ++qi) {
            const bool lat = qi < TL; int b, s, len;
            if (lat) { b = qi >> 11; s = qi & 2047; len = SEQ; } else { b = (qi - TL) >> 8; s = (qi - TL) & 255; len = CTXL; }
            const int row = gla_row(lat, b, s);
            const bool hp = s > 0, hn = s + 1 < len;
            const bf16* p0 = P + (size_t)row * NP + GLA_OFF + 2 * GKD + c;
            const bf16* pm = P + (size_t)gla_row(lat, b, hp ? s - 1 : s) * NP + GLA_OFF + 2 * GKD + c;
            const bf16* pp = P + (size_t)gla_row(lat, b, hn ? s + 1 : s) * NP + GLA_OFF + 2 * GKD + c;
            float o[16];
#pragma unroll
            for (int hf = 0; hf < 2; ++hf) {
                float x[8], xm[8], xp[8];
                unpack8(*(const u32x4*)(p0 + 8 * hf), x); unpack8(*(const u32x4*)(pm + 8 * hf), xm); unpack8(*(const u32x4*)(pp + 8 * hf), xp);
                const float* w = cw + 2 * GKD + c + 8 * hf;
#pragma unroll
                for (int q = 0; q < 2; ++q) {
                    const f32x4 w0 = *(const f32x4*)(w + 4 * q), w1 = *(const f32x4*)(w + GQKV + 4 * q), w2 = *(const f32x4*)(w + 2 * GQKV + 4 * q);
#pragma unroll
                    for (int i = 0; i < 4; ++i) o[8 * hf + 4 * q + i] = siluf(w0[i] * (hp ? xm[4 * q + i] : 0.f) + w1[i] * x[4 * q + i] + w2[i] * (hn ? xp[4 * q + i] : 0.f));
                }
            }
            st16(VS + (size_t)row * GVD + c, o);
        }
    }
    LAS float* ADs = (LAS float*)(k.lds + GPL_AD);
    LAS float* Gs = (LAS float*)(k.lds + GPL_GS);
    LAS bf16* QKs = (LAS bf16*)(k.lds + GPL_QK);
    for (int item = k.bid; item < 288 * 4; item += k.G) {
        const int sc = item >> 2, h = item & 3;
        const bool lat = sc < 256; const int b = lat ? (sc >> 5) : ((sc - 256) >> 2), cn = lat ? (sc & 31) : ((sc - 256) & 3), len = lat ? SEQ : CTXL;
        const int gch = lat ? 4 + cn : cn, s0 = 64 * cn;
        for (int i = tid; i < 1024; i += 512) { const int tau = i >> 4, j = i & 15; ADs[i] = bf2f(P[(size_t)gla_row(lat, b, s0 + tau) * NP + GLA_AD_OFF + j]); }
        for (int i = tid; i < 66 * 32; i += 512) {
            const int rr = i >> 5, ck = i & 31, s = s0 - 1 + rr;
            u32x4 v = (u32x4){0u, 0u, 0u, 0u};
            if (s >= 0 && s < len) v = *(const u32x4*)(P + (size_t)gla_row(lat, b, s) * NP + GLA_OFF + (ck >> 4) * GKD + h * GDK + (ck & 15) * 8);
            *(LAS u32x4*)(QKs + rr * GQ_PITCH + ck * 8) = v;
        }
        __syncthreads();
        {
            const int c = tid & 127, tg = tid >> 7, chl = h * GDK + c;
            float awf[16], awb[16];
#pragma unroll
            for (int j = 0; j < 16; ++j) { awf[j] = aw2[((size_t)(l * 2 + 0) * 16 + j) * GKD + chl]; awb[j] = aw2[((size_t)(l * 2 + 1) * 16 + j) * GKD + chl]; }
            const float abf = ab[(l * 2 + 0) * GKD + chl], abb = ab[(l * 2 + 1) * GKD + chl];
            for (int i = 0; i < 16; ++i) {
                const int tau = 16 * tg + i; float xf = abf, xb = abb;
#pragma unroll
                for (int j = 0; j < 16; ++j) { const float a = ADs[tau * 16 + j]; xf += a * awf[j]; xb += a * awb[j]; }
                Gs[tau * 128 + c] = logsig(xf) * (1.0f / 16.0f); Gs[(64 + tau) * 128 + c] = logsig(xb) * (1.0f / 16.0f);
            }
        }
        __syncthreads();
        if (tid < 128) { float run = 0.f; for (int tau = 0; tau < 64; ++tau) { run += Gs[tau * 128 + tid]; Gs[tau * 128 + tid] = run; } }
        else if (tid < 256) { const int c = tid - 128; float run = 0.f; for (int tau = 63; tau >= 0; --tau) { run += Gs[(64 + tau) * 128 + c]; Gs[(64 + tau) * 128 + c] = run; } }
        __syncthreads();
        {
            const int c8 = tid & 15, tg = tid >> 4, chl = h * GDK + 8 * c8;
            float wq[3][8], wk[3][8], elf[8], elb[8];
#pragma unroll
            for (int tp = 0; tp < 3; ++tp) {
                const f32x4 a0 = *(const f32x4*)(cw + tp * GQKV + chl), a1 = *(const f32x4*)(cw + tp * GQKV + chl + 4), b0 = *(const f32x4*)(cw + tp * GQKV + GKD + chl), b1 = *(const f32x4*)(cw + tp * GQKV + GKD + chl + 4);
#pragma unroll
                for (int i = 0; i < 4; ++i) { wq[tp][i] = a0[i]; wq[tp][4 + i] = a1[i]; wk[tp][i] = b0[i]; wk[tp][4 + i] = b1[i]; }
            }
            {
                const f32x4 a0 = *(const LAS f32x4*)(Gs + 63 * 128 + 8 * c8), a1 = *(const LAS f32x4*)(Gs + 63 * 128 + 8 * c8 + 4), b0 = *(const LAS f32x4*)(Gs + 64 * 128 + 8 * c8), b1 = *(const LAS f32x4*)(Gs + 64 * 128 + 8 * c8 + 4);
#pragma unroll
                for (int i = 0; i < 4; ++i) { elf[i] = __expf(a0[i]); elf[4 + i] = __expf(a1[i]); elb[i] = __expf(b0[i]); elb[4 + i] = __expf(b1[i]); }
            }
            if (tg < 8) {
                float* d0 = DEC + ((size_t)(0 * 8 + b) * NCH + gch) * GKD + chl; float* d1 = DEC + ((size_t)(1 * 8 + b) * NCH + gch) * GKD + chl;
                if (tg == 0) { *(f32x4*)d0 = (f32x4){elf[0], elf[1], elf[2], elf[3]}; *(f32x4*)(d0 + 4) = (f32x4){elf[4], elf[5], elf[6], elf[7]}; }
                if (tg == 1) { *(f32x4*)d1 = (f32x4){elb[0], elb[1], elb[2], elb[3]}; *(f32x4*)(d1 + 4) = (f32x4){elb[4], elb[5], elb[6], elb[7]}; }
            }
#pragma unroll
            for (int pass = 0; pass < 2; ++pass) {
                const int tau = tg + 32 * pass;
                float qm[8], q0[8], qp[8], km[8], k0[8], kp[8];
                unpack8(*(const LAS u32x4*)(QKs + (tau + 0) * GQ_PITCH + 8 * c8), qm); unpack8(*(const LAS u32x4*)(QKs + (tau + 1) * GQ_PITCH + 8 * c8), q0); unpack8(*(const LAS u32x4*)(QKs + (tau + 2) * GQ_PITCH + 8 * c8), qp);
                unpack8(*(const LAS u32x4*)(QKs + (tau + 0) * GQ_PITCH + 128 + 8 * c8), km); unpack8(*(const LAS u32x4*)(QKs + (tau + 1) * GQ_PITCH + 128 + 8 * c8), k0); unpack8(*(const LAS u32x4*)(QKs + (tau + 2) * GQ_PITCH + 128 + 8 * c8), kp);
                const f32x4 f0 = *(const LAS f32x4*)(Gs + tau * 128 + 8 * c8), f1 = *(const LAS f32x4*)(Gs + tau * 128 + 8 * c8 + 4), g0 = *(const LAS f32x4*)(Gs + (64 + tau) * 128 + 8 * c8), g1 = *(const LAS f32x4*)(Gs + (64 + tau) * 128 + 8 * c8 + 4);
                const float cf[8] = {f0.x, f0.y, f0.z, f0.w, f1.x, f1.y, f1.z, f1.w}, cb[8] = {g0.x, g0.y, g0.z, g0.w, g1.x, g1.y, g1.z, g1.w};
                float oqf[8], okf[8], oef[8], oqb[8], okb[8], oeb[8];
#pragma unroll
                for (int i = 0; i < 8; ++i) {
                    const float qv = siluf(wq[0][i] * qm[i] + wq[1][i] * q0[i] + wq[2][i] * qp[i]) * 0.08838834764831845f;
                    const float kv = siluf(wk[0][i] * km[i] + wk[1][i] * k0[i] + wk[2][i] * kp[i]);
                    const float ef = __expf(cf[i]), eb = __expf(cb[i]), rf = 1.0f / ef, rb = 1.0f / eb;
                    oqf[i] = qv * ef; okf[i] = kv * rf; oef[i] = kv * rf * elf[i];
                    oqb[i] = qv * eb; okb[i] = kv * rb; oeb[i] = kv * rb * elb[i];
                }
                const size_t o = (size_t)gla_row(lat, b, s0 + tau) * GKD + chl;
                *(u32x4*)(QG + o) = pack8(oqf); *(u32x4*)(KG + o) = pack8(okf); *(u32x4*)(KE + o) = pack8(oef);
                *(u32x4*)(QG + (size_t)TA * GKD + o) = pack8(oqb); *(u32x4*)(KG + (size_t)TA * GKD + o) = pack8(okb); *(u32x4*)(KE + (size_t)TA * GKD + o) = pack8(oeb);
            }
        }
        __syncthreads();
    }
}

__device__ __forceinline__ float dpp_sum16(float x) {
    x += __builtin_bit_cast(float, __builtin_amdgcn_update_dpp(0, __builtin_bit_cast(int, x), 0xB1, 0xF, 0xF, true));
    x += __builtin_bit_cast(float, __builtin_amdgcn_update_dpp(0, __builtin_bit_cast(int, x), 0x4E, 0xF, 0xF, true));
    x += __builtin_bit_cast(float, __builtin_amdgcn_update_dpp(0, __builtin_bit_cast(int, x), 0x141, 0xF, 0xF, true));
    x += __builtin_bit_cast(float, __builtin_amdgcn_update_dpp(0, __builtin_bit_cast(int, x), 0x140, 0xF, 0xF, true));
    return x;
}
constexpr int RS_TOK = 16;
constexpr int RS_TF = 6 * 64;
constexpr int RS_BUF = RS_TOK * RS_TF;
struct RwkvStage { unsigned r, we, a, ks, v, kk; };
__device__ __forceinline__ int rwkv_row(int b, int dir, int p) {
    if (p < CTXL) { const int t = dir ? CTXL - 1 - p : p; return TL + b * CTXL + t; }
    const int q = p - CTXL, t = dir ? SEQ - 1 - q : q; return b * SEQ + t;
}
__device__ __forceinline__ void ph_rwkv_scan(const KC& k, int l, int job, const float* k_a, size_t yoff = RW_Y) {
    const int b = job >> 5, h = (job >> 1) & 15, dir = job & 1;
    const int tid = k.tid;
    const bf16* R = (const bf16*)(k.ws + RW_R); const bf16* KS = (const bf16*)(k.ws + RW_KS); const bf16* V = (const bf16*)(k.ws + RW_V); const bf16* KK = (const bf16*)(k.ws + RW_KK);
    const bf16* LO = (const bf16*)(k.ws + RW_LO); bf16* Y = (bf16*)(k.ws + yoff) + (size_t)dir * TA * RD;
    LAS float* buf = (LAS float*)k.lds;
    LAS f32x2* ypart = (LAS f32x2*)(buf + 2 * RS_BUF);
    const int st = tid >> 5, cp = tid & 31, ch = h * RHS + 2 * cp;
    const float ka0 = k_a[l * RD + ch], ka1 = k_a[l * RD + ch + 1];
    const int kq = tid & 15, rp = tid >> 4, v0 = rp * 2;
    f32x2 S00 = {0.f, 0.f}, S01 = {0.f, 0.f}, S10 = {0.f, 0.f}, S11 = {0.f, 0.f};
    RwkvStage sg;
#define RW_LOAD(chunk) do { const int row_ = rwkv_row(b, dir, (chunk) * RS_TOK + st); \
        sg.r = *(const unsigned*)(R + (size_t)row_ * RD + ch); sg.ks = *(const unsigned*)(KS + (size_t)row_ * RD + ch); \
        sg.v = *(const unsigned*)(V + (size_t)row_ * RD + ch); sg.kk = *(const unsigned*)(KK + (size_t)row_ * RD + ch); \
        sg.we = *(const unsigned*)(LO + (size_t)row_ * 4096 + dir * RD + ch); sg.a = *(const unsigned*)(LO + (size_t)row_ * 4096 + 2048 + dir * RD + ch); } while (0)
#define RW_WRITE(bi) do { LAS float* tb = buf + (bi) * RS_BUF + st * RS_TF + 2 * cp; \
        const float a0 = bflo(sg.a), a1 = bfhi(sg.a), kk0 = bflo(sg.kk), kk1 = bfhi(sg.kk), ks0 = bflo(sg.ks), ks1 = bfhi(sg.ks); \
        *(LAS f32x2*)(tb + 0) = (f32x2){kk0, kk1}; \
        *(LAS f32x2*)(tb + 64) = (f32x2){__expf(-bflo(sg.we)), __expf(-bfhi(sg.we))}; \
        *(LAS f32x2*)(tb + 128) = (f32x2){-kk0 * a0, -kk1 * a1}; \
        *(LAS f32x2*)(tb + 192) = (f32x2){ks0 * (1.0f + (a0 - 1.0f) * ka0), ks1 * (1.0f + (a1 - 1.0f) * ka1)}; \
        *(LAS f32x2*)(tb + 256) = (f32x2){bflo(sg.r), bfhi(sg.r)}; \
        *(LAS f32x2*)(tb + 320) = (f32x2){bflo(sg.v), bfhi(sg.v)}; } while (0)
    constexpr int NCHUNK = (CTXL + SEQ) / RS_TOK;
    RW_LOAD(0); RW_WRITE(0);
    __syncthreads();
    for (int c = 0; c < NCHUNK; ++c) {
        if (c + 1 < NCHUNK) RW_LOAD(c + 1);
        const LAS float* cb = buf + (c & 1) * RS_BUF; LAS f32x2* yb = ypart + (c & 1) * RS_TOK * 256 + rp * 8 + (((kq >> 1) ^ (rp >> 2)) & 7);
        {
            const LAS float* tk = cb + kq * 4; const LAS float* tv = cb + 320 + v0;
#define RW_LD(T, kk4, w4, n4, d4, r4, vv) f32x4 kk4 = *(const LAS f32x4*)(tk + (T) * RS_TF), w4 = *(const LAS f32x4*)(tk + (T) * RS_TF + 64), n4 = *(const LAS f32x4*)(tk + (T) * RS_TF + 128), \
                d4 = *(const LAS f32x4*)(tk + (T) * RS_TF + 192), r4 = *(const LAS f32x4*)(tk + (T) * RS_TF + 256); f32x2 vv = *(const LAS f32x2*)(tv + (T) * RS_TF)
#define RW_STEP(T, kk4, w4, n4, d4, r4, vv) do { \
                const f32x2 kka = {kk4.x, kk4.y}, kkb = {kk4.z, kk4.w}, wa = {w4.x, w4.y}, wb = {w4.z, w4.w}, na = {n4.x, n4.y}, nb = {n4.z, n4.w}, da = {d4.x, d4.y}, db = {d4.z, d4.w}, ra = {r4.x, r4.y}, rb = {r4.z, r4.w}; \
                f32x2 p0 = S00 * kka + S01 * kkb, p1 = S10 * kka + S11 * kkb; \
                const f32x2 u00 = S00 * wa + da * vv.x, u01 = S01 * wb + db * vv.x, u10 = S10 * wa + da * vv.y, u11 = S11 * wb + db * vv.y;     \
                const float sa0 = dpp_sum16(p0.x + p0.y), sa1 = dpp_sum16(p1.x + p1.y); \
                S00 = na * sa0 + u00; S01 = nb * sa0 + u01; S10 = na * sa1 + u10; S11 = nb * sa1 + u11; \
                p0 = S00 * ra + S01 * rb; p1 = S10 * ra + S11 * rb; \
                float y0 = p0.x + p0.y, y1 = p1.x + p1.y; \
                y0 += __builtin_bit_cast(float, __builtin_amdgcn_update_dpp(0, __builtin_bit_cast(int, y0), 0xB1, 0xF, 0xF, true)); \
                y1 += __builtin_bit_cast(float, __builtin_amdgcn_update_dpp(0, __builtin_bit_cast(int, y1), 0xB1, 0xF, 0xF, true)); \
                if ((kq & 1) == 0) yb[(T) * 256] = (f32x2){y0, y1}; } while (0)
            RW_LD(0, kkA, wA, nA, dA, rA, vA);
#pragma unroll
            for (int tau = 0; tau < RS_TOK; tau += 2) {
                RW_LD(tau + 1, kkB, wB, nB, dB, rB, vB);
                RW_STEP(tau, kkA, wA, nA, dA, rA, vA);
                if (tau + 2 < RS_TOK) { RW_LD(tau + 2, kkC, wC, nC, dC, rC, vC); kkA = kkC; wA = wC; nA = nC; dA = dC; rA = rC; vA = vC; }
                RW_STEP(tau + 1, kkB, wB, nB, dB, rB, vB);
            }
#undef RW_LD
#undef RW_STEP
        }
        if (c + 1 < NCHUNK) RW_WRITE((c + 1) & 1);
        __syncthreads();
        {
            const int row = rwkv_row(b, dir, c * RS_TOK + st);
            const LAS f32x2* yq = ypart + (c & 1) * RS_TOK * 256 + st * 256 + cp * 8;
            f32x2 acc = yq[(0 ^ (cp >> 2)) & 7];
#pragma unroll
            for (int j = 1; j < 8; ++j) acc += yq[(j ^ (cp >> 2)) & 7];
            *(unsigned*)(Y + (size_t)row * RD + ch) = pk2(acc.x, acc.y);
        }
    }
    __syncthreads();
}

constexpr int GP1 = 136, GP2 = 72;
constexpr int GL_QGS = 0, GL_KGS = GL_QGS + 64 * GP1 * 2, GL_STS = GL_KGS + 64 * GP1 * 2, GL_KET = GL_STS + 64 * GP1 * 2, GL_VT = GL_KET + 128 * GP2 * 2, GL_ATT = GL_VT + 64 * GP2 * 2,
              GL_DECS = GL_ATT + 64 * GP2 * 2, GL_LDS_END = GL_DECS + 512;
static_assert(GL_LDS_END <= 131072, "gla lds");
__device__ __forceinline__ bf16x8 ldfrag(const LAS bf16* base, int row, int pitch, int kofs) { return *(const LAS bf16x8*)(base + row * pitch + kofs); }
__device__ __forceinline__ int gla_prow(int b, int dir, int cp, int tau) {
    const bool lat = cp >= 4; const int q = lat ? cp - 4 : cp, ncn = lat ? 32 : 4, cn = dir ? ncn - 1 - q : q;
    return gla_row(lat, b, dir ? 64 * cn + 63 - tau : 64 * cn + tau);
}
__device__ __forceinline__ int gla_gch(int dir, int cp) { const bool lat = cp >= 4; const int q = lat ? cp - 4 : cp, ncn = lat ? 32 : 4, cn = dir ? ncn - 1 - q : q; return lat ? 4 + cn : cn; }
__device__ __forceinline__ bf16x8 ldfrag_sw(const LAS bf16* base, int row, int g) { return *(const LAS bf16x8*)(base + row * GP2 + ((g ^ ((row >> 3) & 7)) << 3)); }
__device__ __forceinline__ void ph_gla_scan(const KC& k, int job) {
    const int b = job >> 5, h = (job >> 3) & 3, dir = (job >> 2) & 1, dvq = job & 3;
    const int tid = k.tid, w = k.wave, lane = k.lane, q4 = lane >> 4, l15 = lane & 15;
    const bf16* QG = (const bf16*)(k.ws + GL_QG) + (size_t)dir * TA * GKD; const bf16* KG = (const bf16*)(k.ws + GL_KG) + (size_t)dir * TA * GKD;
    const bf16* KE = (const bf16*)(k.ws + GL_KE) + (size_t)dir * TA * GKD; const bf16* VS = (const bf16*)(k.ws + GL_VS);
    const float* DEC = (const float*)(k.ws + GL_DEC); bf16* O = (bf16*)(k.ws + GL_O) + (size_t)dir * TA * GVD;
    LAS bf16* QGs = (LAS bf16*)(k.lds + GL_QGS); LAS bf16* KGs = (LAS bf16*)(k.lds + GL_KGS); LAS bf16* STs = (LAS bf16*)(k.lds + GL_STS);
    LAS bf16* KEt = (LAS bf16*)(k.lds + GL_KET); LAS bf16* Vt = (LAS bf16*)(k.lds + GL_VT); LAS bf16* ATT = (LAS bf16*)(k.lds + GL_ATT); LAS float* decs = (LAS float*)(k.lds + GL_DECS);
    f32x4 accS[4];
#pragma unroll
    for (int t = 0; t < 4; ++t) accS[t] = (f32x4){0.f, 0.f, 0.f, 0.f};
    const int tw = w & 3, wh = w >> 2;
    u32x4 pq[2], pk[2], pe[2], pv; float pd = 0.f;
#define GLA_PREFETCH(CP) do { _Pragma("unroll") for (int i = 0; i < 2; ++i) { const int idx = tid + 512 * i, tau = idx >> 4, ck = idx & 15; \
            const size_t go = (size_t)gla_prow(b, dir, (CP), tau) * GKD + h * GDK + ck * 8; pq[i] = *(const u32x4*)(QG + go); pk[i] = *(const u32x4*)(KG + go); pe[i] = *(const u32x4*)(KE + go); } \
        pv = *(const u32x4*)(VS + (size_t)gla_prow(b, dir, (CP), tid >> 3) * GVD + h * GDV + dvq * 64 + (tid & 7) * 8); \
        if (tid < 128) pd = DEC[((size_t)(dir * 8 + b) * NCH + gla_gch(dir, (CP))) * GKD + h * GDK + tid]; } while (0)
    GLA_PREFETCH(0);
    for (int cp = 0; cp < NCH; ++cp) {
#define GROW(tau) gla_prow(b, dir, cp, (tau))
#pragma unroll
        for (int i = 0; i < 2; ++i) {
            const int idx = tid + 512 * i, tau = idx >> 4, ck = idx & 15;
            *(LAS u32x4*)(QGs + tau * GP1 + ck * 8) = pq[i];
            *(LAS u32x4*)(KGs + tau * GP1 + ck * 8) = pk[i];
            const unsigned kw[4] = {pe[i].x, pe[i].y, pe[i].z, pe[i].w};
#pragma unroll
            for (int e = 0; e < 4; ++e) { const int ts = tau ^ ((ck & 7) << 3); KEt[(ck * 8 + 2 * e) * GP2 + ts] = (bf16)(kw[e] & 0xffffu); KEt[(ck * 8 + 2 * e + 1) * GP2 + ts] = (bf16)(kw[e] >> 16); }
        }
        {
            const int tau = tid >> 3, ck = tid & 7;
            const unsigned vw[4] = {pv.x, pv.y, pv.z, pv.w};
#pragma unroll
            for (int e = 0; e < 4; ++e) { const int ts = tau ^ (ck << 3); Vt[(ck * 8 + 2 * e) * GP2 + ts] = (bf16)(vw[e] & 0xffffu); Vt[(ck * 8 + 2 * e + 1) * GP2 + ts] = (bf16)(vw[e] >> 16); }
        }
        if (tid < 128) decs[tid] = pd;
#pragma unroll
        for (int t = 0; t < 4; ++t) {
            const int dkt = wh * 4 + t;
#pragma unroll
            for (int r = 0; r < 4; ++r) STs[(16 * tw + 4 * q4 + r) * GP1 + 16 * dkt + l15] = (bf16)f2bf(accS[t][r]);
        }
        __syncthreads();
        if (cp + 1 < NCH) GLA_PREFETCH(cp + 1);
#pragma unroll
        for (int jj = 0; jj < 2; ++jj) {
            const int it = tw, jt = wh * 2 + jj;
            f32x4 acc = (f32x4){0.f, 0.f, 0.f, 0.f};
#pragma unroll
            for (int ks = 0; ks < 4; ++ks) acc = __builtin_amdgcn_mfma_f32_16x16x32_bf16(ldfrag(QGs, 16 * it + l15, GP1, 32 * ks + 8 * q4), ldfrag(KGs, 16 * jt + l15, GP1, 32 * ks + 8 * q4), acc, 0, 0, 0);
#pragma unroll
            for (int r = 0; r < 4; ++r) { const int i = 16 * it + 4 * q4 + r, j = 16 * jt + l15; ATT[i * GP2 + j] = (bf16)f2bf(j <= i ? acc[r] : 0.f); }
        }
        __syncthreads();
#pragma unroll
        for (int dd = 0; dd < 2; ++dd) {
            const int it = tw, dvt = wh * 2 + dd;
            f32x4 acc = (f32x4){0.f, 0.f, 0.f, 0.f};
#pragma unroll
            for (int ks = 0; ks < 4; ++ks) acc = __builtin_amdgcn_mfma_f32_16x16x32_bf16(ldfrag(QGs, 16 * it + l15, GP1, 32 * ks + 8 * q4), ldfrag(STs, 16 * dvt + l15, GP1, 32 * ks + 8 * q4), acc, 0, 0, 0);
#pragma unroll
            for (int ks = 0; ks < 2; ++ks) acc = __builtin_amdgcn_mfma_f32_16x16x32_bf16(ldfrag(ATT, 16 * it + l15, GP2, 32 * ks + 8 * q4), ldfrag_sw(Vt, 16 * dvt + l15, 4 * ks + q4), acc, 0, 0, 0);
#pragma unroll
            for (int r = 0; r < 4; ++r) { const int i = 16 * it + 4 * q4 + r; O[(size_t)GROW(i) * GVD + h * GDV + dvq * 64 + 16 * dvt + l15] = (bf16)f2bf(acc[r]); }
        }
#pragma unroll
        for (int t = 0; t < 4; ++t) {
            const int dkt = wh * 4 + t; const float d = decs[16 * dkt + l15];
            accS[t] = accS[t] * d;
#pragma unroll
            for (int ks = 0; ks < 2; ++ks) accS[t] = __builtin_amdgcn_mfma_f32_16x16x32_bf16(ldfrag_sw(Vt, 16 * tw + l15, 4 * ks + q4), ldfrag_sw(KEt, 16 * dkt + l15, 4 * ks + q4), accS[t], 0, 0, 0);
        }
        __syncthreads();
#undef GROW
    }
#undef GLA_PREFETCH
}

#ifndef HB_FULL
#define HB_FULL 0
#endif
#ifndef GLA4_LEVEL
#define GLA4_LEVEL 0
#endif
#ifndef GLA4_NOSTORE
#define GLA4_NOSTORE 0
#endif
#ifndef SWAP_HALVES
#define SWAP_HALVES 0
#endif
#ifndef SPLIT_SCAN
#define SPLIT_SCAN 0
#endif
constexpr int RS4_TOK = 8, RS4_BUF = RS4_TOK * RS_TF;
constexpr int SC_GL = 0;
constexpr int SC_RW = 96 * 1024;
constexpr int SC_END = SC_RW + 2 * RS4_BUF * 4 + 2 * RS4_TOK * 64 * 4;
static_assert(SC_GL + GL_LDS_END <= SC_RW, "scan lds halves");
constexpr int SC_CTR = 127 * 1024;
static_assert(SC_END <= SC_CTR && SC_CTR + 128 <= 131072, "scan lds");
__device__ __forceinline__ void half_bar(LAS unsigned* ctr, unsigned& gen, int lane) {
#if HB_FULL
    (void)ctr; (void)lane; gen += 4u; __syncthreads(); return;
#endif
    gen += 4u;
    __builtin_amdgcn_fence(__ATOMIC_RELEASE, "workgroup");
    if (lane == 0) __hip_atomic_fetch_add(ctr, 1u, __ATOMIC_RELAXED, __HIP_MEMORY_SCOPE_WORKGROUP);
    unsigned spins = 0;
    while (__hip_atomic_load(ctr, __ATOMIC_RELAXED, __HIP_MEMORY_SCOPE_WORKGROUP) < gen) { __builtin_amdgcn_s_sleep(1); if (++spins > (1u << 26)) break; }
    __builtin_amdgcn_fence(__ATOMIC_ACQUIRE, "workgroup");
}
#ifndef RW4_SHFL
#define RW4_SHFL 0
#endif
__device__ __forceinline__ float shfl_sum16(float x) { x += __shfl_xor(x, 1); x += __shfl_xor(x, 2); x += __shfl_xor(x, 4); x += __shfl_xor(x, 8); return x; }
#if RW4_SHFL
#define RW4_SUM16(x) shfl_sum16(x)
#else
#define RW4_SUM16(x) dpp_sum16(x)
#endif
__device__ __forceinline__ void rwkv_scan_4w(const KC& k, int l, int job, const float* k_a, LAS unsigned* ctr) {
    const int b = job >> 5, h = (job >> 1) & 15, dir = job & 1;
    const int tid = k.tid, lane = k.lane;
    const bf16* R = (const bf16*)(k.ws + RW_R); const bf16* KS = (const bf16*)(k.ws + RW_KS); const bf16* V = (const bf16*)(k.ws + RW_V); const bf16* KK = (const bf16*)(k.ws + RW_KK);
    const bf16* LO = (const bf16*)(k.ws + RW_LO); bf16* Y = (bf16*)(k.ws + RW_Y) + (size_t)dir * TA * RD;
    LAS float* buf = (LAS float*)(k.lds + SC_RW);
    LAS float* ybuf = buf + 2 * RS4_BUF;
    const int st = tid >> 5, cp = tid & 31, ch = h * RHS + 2 * cp;
    const float ka0 = k_a[l * RD + ch], ka1 = k_a[l * RD + ch + 1];
    const int kq = tid & 15, v0 = (tid >> 4) * 4;
    f32x2 S[4][2];
#pragma unroll
    for (int i = 0; i < 4; ++i) { S[i][0] = (f32x2){0.f, 0.f}; S[i][1] = (f32x2){0.f, 0.f}; }
    RwkvStage sg[1];
    unsigned gen = 0;
#define RW4_LOAD(chunk) do { _Pragma("unroll") for (int q_ = 0; q_ < 1; ++q_) { const int row_ = rwkv_row(b, dir, (chunk) * RS4_TOK + st); \
        sg[q_].r = *(const unsigned*)(R + (size_t)row_ * RD + ch); sg[q_].ks = *(const unsigned*)(KS + (size_t)row_ * RD + ch); \
        sg[q_].v = *(const unsigned*)(V + (size_t)row_ * RD + ch); sg[q_].kk = *(const unsigned*)(KK + (size_t)row_ * RD + ch); \
        sg[q_].we = *(const unsigned*)(LO + (size_t)row_ * 4096 + dir * RD + ch); sg[q_].a = *(const unsigned*)(LO + (size_t)row_ * 4096 + 2048 + dir * RD + ch); } } while (0)
#define RW4_WRITE(bi) do { _Pragma("unroll") for (int q_ = 0; q_ < 1; ++q_) { LAS float* tb = buf + (bi) * RS4_BUF + st * RS_TF + 2 * cp; \
        const float a0 = bflo(sg[q_].a), a1 = bfhi(sg[q_].a), kk0 = bflo(sg[q_].kk), kk1 = bfhi(sg[q_].kk), ks0 = bflo(sg[q_].ks), ks1 = bfhi(sg[q_].ks); \
        *(LAS f32x2*)(tb + 0) = (f32x2){kk0, kk1}; \
        *(LAS f32x2*)(tb + 64) = (f32x2){__expf(-bflo(sg[q_].we)), __expf(-bfhi(sg[q_].we))}; \
        *(LAS f32x2*)(tb + 128) = (f32x2){-kk0 * a0, -kk1 * a1}; \
        *(LAS f32x2*)(tb + 192) = (f32x2){ks0 * (1.0f + (a0 - 1.0f) * ka0), ks1 * (1.0f + (a1 - 1.0f) * ka1)}; \
        *(LAS f32x2*)(tb + 256) = (f32x2){bflo(sg[q_].r), bfhi(sg[q_].r)}; \
        *(LAS f32x2*)(tb + 320) = (f32x2){bflo(sg[q_].v), bfhi(sg[q_].v)}; } } while (0)
    constexpr int NCHUNK = (CTXL + SEQ) / RS4_TOK;
    RW4_LOAD(0); RW4_WRITE(0);
    half_bar(ctr, gen, lane);
    for (int c = 0; c < NCHUNK; ++c) {
        if (c + 1 < NCHUNK) RW4_LOAD(c + 1);
        const LAS float* cb = buf + (c & 1) * RS4_BUF; LAS float* yb = ybuf + (c & 1) * RS4_TOK * 64;
        {
            const LAS float* tk = cb + kq * 4; const LAS float* tv = cb + 320 + v0;
#define RW4_LD(T, kk4, w4, n4, d4, r4, vv) f32x4 kk4 = *(const LAS f32x4*)(tk + (T) * RS_TF), w4 = *(const LAS f32x4*)(tk + (T) * RS_TF + 64), n4 = *(const LAS f32x4*)(tk + (T) * RS_TF + 128), \
                d4 = *(const LAS f32x4*)(tk + (T) * RS_TF + 192), r4 = *(const LAS f32x4*)(tk + (T) * RS_TF + 256), vv = *(const LAS f32x4*)(tv + (T) * RS_TF)
#define RW4_STEP(T, kk4, w4, n4, d4, r4, vv) do { \
                const f32x2 kka = {kk4.x, kk4.y}, kkb = {kk4.z, kk4.w}, wa = {w4.x, w4.y}, wb = {w4.z, w4.w}, na = {n4.x, n4.y}, nb = {n4.z, n4.w}, da = {d4.x, d4.y}, db = {d4.z, d4.w}, ra = {r4.x, r4.y}, rb = {r4.z, r4.w}; \
                float sa[4], yy[4]; f32x2 u0[4], u1[4]; \
                _Pragma("unroll") for (int i = 0; i < 4; ++i) { const f32x2 p = S[i][0] * kka + S[i][1] * kkb; sa[i] = p.x + p.y; u0[i] = S[i][0] * wa + da * vv[i]; u1[i] = S[i][1] * wb + db * vv[i]; } \
                _Pragma("unroll") for (int i = 0; i < 4; ++i) sa[i] = RW4_SUM16(sa[i]); \
                _Pragma("unroll") for (int i = 0; i < 4; ++i) { S[i][0] = na * sa[i] + u0[i]; S[i][1] = nb * sa[i] + u1[i]; const f32x2 q = S[i][0] * ra + S[i][1] * rb; yy[i] = q.x + q.y; } \
                _Pragma("unroll") for (int i = 0; i < 4; ++i) yy[i] = RW4_SUM16(yy[i]); \
                if (kq == 0) *(LAS f32x4*)(yb + (T) * 64 + v0) = (f32x4){yy[0], yy[1], yy[2], yy[3]}; } while (0)
            RW4_LD(0, kkA, wA, nA, dA, rA, vA);
#pragma unroll
            for (int tau = 0; tau < RS4_TOK; tau += 2) {
                RW4_LD(tau + 1, kkB, wB, nB, dB, rB, vB);
                RW4_STEP(tau, kkA, wA, nA, dA, rA, vA);
                if (tau + 2 < RS4_TOK) { RW4_LD(tau + 2, kkC, wC, nC, dC, rC, vC); kkA = kkC; wA = wC; nA = nC; dA = dC; rA = rC; vA = vC; }
                RW4_STEP(tau + 1, kkB, wB, nB, dB, rB, vB);
            }
#undef RW4_LD
#undef RW4_STEP
        }
        if (c + 1 < NCHUNK) RW4_WRITE((c + 1) & 1);
        half_bar(ctr, gen, lane);
        {
            const int row = rwkv_row(b, dir, c * RS4_TOK + st);
            const f32x2 yy = *(const LAS f32x2*)(yb + st * 64 + 2 * cp);
            *(unsigned*)(Y + (size_t)row * RD + ch) = pk2(yy.x, yy.y);
        }
    }
#undef RW4_LOAD
#undef RW4_WRITE
}
__device__ __forceinline__ void gla_scan_4w(const KC& k, int job, LAS unsigned* ctr) {
    const int b = job >> 5, h = (job >> 3) & 3, dir = (job >> 2) & 1, dvq = job & 3;
    const int tid = k.tid - 256, w = k.wave - 4, lane = k.lane, q4 = lane >> 4, l15 = lane & 15;
    const bf16* QG = (const bf16*)(k.ws + GL_QG) + (size_t)dir * TA * GKD; const bf16* KG = (const bf16*)(k.ws + GL_KG) + (size_t)dir * TA * GKD;
    const bf16* KE = (const bf16*)(k.ws + GL_KE) + (size_t)dir * TA * GKD; const bf16* VS = (const bf16*)(k.ws + GL_VS);
    const float* DEC = (const float*)(k.ws + GL_DEC); bf16* O = (bf16*)(k.ws + GL_O) + (size_t)dir * TA * GVD;
    LAS unsigned char* gl = k.lds + SC_GL;
    LAS bf16* QGs = (LAS bf16*)(gl + GL_QGS); LAS bf16* KGs = (LAS bf16*)(gl + GL_KGS); LAS bf16* STs = (LAS bf16*)(gl + GL_STS);
    LAS bf16* KEt = (LAS bf16*)(gl + GL_KET); LAS bf16* Vt = (LAS bf16*)(gl + GL_VT); LAS bf16* ATT = (LAS bf16*)(gl + GL_ATT); LAS float* decs = (LAS float*)(gl + GL_DECS);
    f32x4 accS[8];
#pragma unroll
    for (int t = 0; t < 8; ++t) accS[t] = (f32x4){0.f, 0.f, 0.f, 0.f};
    unsigned gen = 0;
#if GLA4_LEVEL == 2
    { float x = (float)lane; for (int i = 0; i < 200000; ++i) { x = x * 1.0001f + 0.5f; asm volatile("" : "+v"(x)); } asm volatile("" :: "v"(x)); (void)ctr; (void)gen; }
    return;
#endif
#if GLA4_LEVEL == 1
    for (int cp = 0; cp < NCH; ++cp) { float x = (float)lane; for (int i = 0; i < 2000; ++i) x = x * 1.0001f + 0.5f; asm volatile("" :: "v"(x)); half_bar(ctr, gen, lane); half_bar(ctr, gen, lane); half_bar(ctr, gen, lane); }
    return;
#endif
    for (int cp = 0; cp < NCH; ++cp) {
        const bool lat = cp >= 4; const int q = lat ? cp - 4 : cp, ncn = lat ? 32 : 4, cn = dir ? ncn - 1 - q : q, gch = lat ? 4 + cn : cn;
#define GROW(tau) gla_row(lat, b, dir ? 64 * cn + 63 - (tau) : 64 * cn + (tau))
#pragma unroll
        for (int i = 0; i < 4; ++i) {
            const int idx = tid + 256 * i, tau = idx >> 4, ck = idx & 15; const size_t go = (size_t)GROW(tau) * GKD + h * GDK + ck * 8;
            *(LAS u32x4*)(QGs + tau * GP1 + ck * 8) = *(const u32x4*)(QG + go);
            *(LAS u32x4*)(KGs + tau * GP1 + ck * 8) = *(const u32x4*)(KG + go);
            const u32x4 ke = *(const u32x4*)(KE + go);
            const unsigned kw[4] = {ke.x, ke.y, ke.z, ke.w};
#pragma unroll
            for (int e = 0; e < 4; ++e) { KEt[(ck * 8 + 2 * e) * GP2 + tau] = (bf16)(kw[e] & 0xffffu); KEt[(ck * 8 + 2 * e + 1) * GP2 + tau] = (bf16)(kw[e] >> 16); }
        }
#pragma unroll
        for (int i = 0; i < 2; ++i) {
            const int idx = tid + 256 * i, tau = idx >> 3, ck = idx & 7;
            const u32x4 vv = *(const u32x4*)(VS + (size_t)GROW(tau) * GVD + h * GDV + dvq * 64 + ck * 8);
            const unsigned vw[4] = {vv.x, vv.y, vv.z, vv.w};
#pragma unroll
            for (int e = 0; e < 4; ++e) { Vt[(ck * 8 + 2 * e) * GP2 + tau] = (bf16)(vw[e] & 0xffffu); Vt[(ck * 8 + 2 * e + 1) * GP2 + tau] = (bf16)(vw[e] >> 16); }
        }
        if (tid < 128) decs[tid] = DEC[((size_t)(dir * 8 + b) * NCH + gch) * GKD + h * GDK + tid];
#pragma unroll
        for (int t = 0; t < 8; ++t) {
#pragma unroll
            for (int r = 0; r < 4; ++r) STs[(16 * w + 4 * q4 + r) * GP1 + 16 * t + l15] = (bf16)f2bf(accS[t][r]);
        }
        half_bar(ctr, gen, lane);
#pragma unroll
        for (int jt = 0; jt < 4; ++jt) {
            f32x4 acc = (f32x4){0.f, 0.f, 0.f, 0.f};
#pragma unroll
            for (int ks = 0; ks < 4; ++ks) acc = __builtin_amdgcn_mfma_f32_16x16x32_bf16(ldfrag(QGs, 16 * w + l15, GP1, 32 * ks + 8 * q4), ldfrag(KGs, 16 * jt + l15, GP1, 32 * ks + 8 * q4), acc, 0, 0, 0);
#pragma unroll
            for (int r = 0; r < 4; ++r) { const int i = 16 * w + 4 * q4 + r, j = 16 * jt + l15; ATT[i * GP2 + j] = (bf16)f2bf(j <= i ? acc[r] : 0.f); }
        }
        half_bar(ctr, gen, lane);
#pragma unroll
        for (int dvt = 0; dvt < 4; ++dvt) {
            f32x4 acc = (f32x4){0.f, 0.f, 0.f, 0.f};
#pragma unroll
            for (int ks = 0; ks < 4; ++ks) acc = __builtin_amdgcn_mfma_f32_16x16x32_bf16(ldfrag(QGs, 16 * w + l15, GP1, 32 * ks + 8 * q4), ldfrag(STs, 16 * dvt + l15, GP1, 32 * ks + 8 * q4), acc, 0, 0, 0);
#pragma unroll
            for (int ks = 0; ks < 2; ++ks) acc = __builtin_amdgcn_mfma_f32_16x16x32_bf16(ldfrag(ATT, 16 * w + l15, GP2, 32 * ks + 8 * q4), ldfrag(Vt, 16 * dvt + l15, GP2, 32 * ks + 8 * q4), acc, 0, 0, 0);
#pragma unroll
#if GLA4_NOSTORE
            asm volatile("" :: "v"(acc[0]), "v"(acc[1]), "v"(acc[2]), "v"(acc[3]));
#else
            for (int r = 0; r < 4; ++r) { const int i = 16 * w + 4 * q4 + r; O[(size_t)GROW(i) * GVD + h * GDV + dvq * 64 + 16 * dvt + l15] = (bf16)f2bf(acc[r]); }
#endif
        }
#pragma unroll
        for (int t = 0; t < 8; ++t) {
            const float d = decs[16 * t + l15];
            accS[t] = accS[t] * d;
#pragma unroll
            for (int ks = 0; ks < 2; ++ks) accS[t] = __builtin_amdgcn_mfma_f32_16x16x32_bf16(ldfrag(Vt, 16 * w + l15, GP2, 32 * ks + 8 * q4), ldfrag(KEt, 16 * t + l15, GP2, 32 * ks + 8 * q4), accS[t], 0, 0, 0);
        }
        half_bar(ctr, gen, lane);
#undef GROW
    }
#if HB_FULL
    for (int i = 0; i < (1 + (CTXL + SEQ) / RS4_TOK) - 3 * NCH; ++i) __syncthreads();
#endif
}
__device__ __forceinline__ void ph_scan_split(const KC& k, int l, const float* k_a) {
    LAS unsigned* ctr = (LAS unsigned*)(k.lds + SC_CTR);
    for (int job = k.bid; job < 256; job += k.G) {
        if (k.tid == 0) { ctr[0] = 0u; ctr[16] = 0u; }
        __syncthreads();
#if SPLIT_SCAN == 1 || SPLIT_SCAN == 4 || SPLIT_SCAN == 5 || SPLIT_SCAN == 6
#if SWAP_HALVES
        { KC k2 = k; if (k.wave >= 4) { k2.tid = k.tid - 256; k2.wave = k.wave - 4; rwkv_scan_4w(k2, l, job, k_a, ctr); } else { k2.tid = k.tid + 256; k2.wave = k.wave + 4; gla_scan_4w(k2, job, ctr + 16); } }
#else
        if (k.wave < 4) rwkv_scan_4w(k, l, job, k_a, ctr); else gla_scan_4w(k, job, ctr + 16);
#endif
        __syncthreads();
#if SPLIT_SCAN == 6
        ph_rwkv_scan(k, l, job, k_a, WS_H);
#elif SPLIT_SCAN == 4
        ph_rwkv_scan(k, l, job, k_a);
#elif SPLIT_SCAN == 5
        ph_gla_scan(k, job);
#endif
#elif SPLIT_SCAN == 2
        if (k.wave < 4) rwkv_scan_4w(k, l, job, k_a, ctr);
        __syncthreads();
        ph_gla_scan(k, job);
#else
        if (k.wave >= 4) gla_scan_4w(k, job, ctr + 16);
        __syncthreads();
        ph_rwkv_scan(k, l, job, k_a);
#endif
    }
}

__device__ __forceinline__ void ph_post(const KC& k, int l, int nrows, const float* ln_g, const float* ln_b, const float* gng) {
    const int gw = k.bid * 8 + k.wave, NGW = k.G * 8, lane = k.lane, c = 16 * lane;
    const bf16* P = (const bf16*)(k.ws + WS_P);
    const bf16* Y = (const bf16*)(k.ws + RW_Y); const bf16* V = (const bf16*)(k.ws + RW_V); const float* BON = (const float*)(k.ws + RW_BON); bf16* YNB = (bf16*)(k.ws + RW_R);
    const bf16* O = (const bf16*)(k.ws + GL_O); bf16* YB = (bf16*)(k.ws + GL_VS);
    for (int row = gw; row < nrows; row += NGW) {
        {
            float yf[16], yb[16], vv[16], y[16];
            ld16(Y + (size_t)row * RD + c, true, yf); ld16(Y + ((size_t)TA + row) * RD + c, true, yb); ld16(V + (size_t)row * RD + c, true, vv);
            float s = 0.f;
#pragma unroll
            for (int i = 0; i < 16; ++i) { y[i] = yf[i] + yb[i]; s += y[i]; }
            s += __shfl_xor(s, 1); s += __shfl_xor(s, 2);
            const float mean = s * (1.0f / 64.0f); float q = 0.f;
#pragma unroll
            for (int i = 0; i < 16; ++i) { y[i] -= mean; q += y[i] * y[i]; }
            q += __shfl_xor(q, 1); q += __shfl_xor(q, 2);
            const float rstd = 1.0f / sqrtf(q * (1.0f / 64.0f) + 64e-5f), bon = BON[(size_t)row * RHEADS + (lane >> 2)];
#pragma unroll
            for (int i = 0; i < 16; ++i) y[i] = y[i] * rstd * ln_g[l * RD + c + i] + ln_b[l * RD + c + i] + bon * vv[i];
            st16(YNB + (size_t)row * RD + c, y);
        }
        {
            float of[16], ob[16], gt[16], o[16];
            ld16(O + (size_t)row * GVD + c, true, of); ld16(O + ((size_t)TA + row) * GVD + c, true, ob); ld16(P + (size_t)row * NP + GLA_GATE_OFF + c, true, gt);
            float s = 0.f;
#pragma unroll
            for (int i = 0; i < 16; ++i) { o[i] = of[i] + ob[i]; s += o[i] * o[i]; }
            s += __shfl_xor(s, 1); s += __shfl_xor(s, 2); s += __shfl_xor(s, 4); s += __shfl_xor(s, 8);
            const float rinv = 1.0f / sqrtf(s * (1.0f / 256.0f) + 1e-6f);
#pragma unroll
            for (int i = 0; i < 16; ++i) o[i] = o[i] * rinv * gng[l * GDV + ((c + i) & 255)] * siluf(gt[i]);
            st16(YB + (size_t)row * GVD + c, o);
        }
    }
}
using pg8::Unit;
struct FP_ { bf16* P; __device__ __forceinline__ void operator()(int row, int col, float (&v)[8], const Unit&) const { *(u32x4*)(P + (size_t)row * NP + col) = pack8(v); } };
struct FL1_ { bf16* LO; const float* bias1;
    __device__ __forceinline__ void operator()(int row, int col, float (&v)[8], const Unit& u) const {
        const float* bias = bias1 + col;
        const f32x4 b0 = *(const f32x4*)bias, b1 = *(const f32x4*)(bias + 4);
        const float bb[8] = {b0.x, b0.y, b0.z, b0.w, b1.x, b1.y, b1.z, b1.w};
        const float sc = col < 2048 ? 0.6065306597126334f : 1.0f;
#pragma unroll
        for (int i = 0; i < 8; ++i) v[i] = sigm(bb[i] + v[i]) * sc;
        *(u32x4*)(LO + (size_t)row * 4096 + col) = pack8(v);
    } };
struct FL2_ { const bf16* YNB; bf16* YA;
    __device__ __forceinline__ void operator()(int row, int col, float (&v)[8], const Unit&) const {
        float y[8]; unpack8(*(const u32x4*)(YNB + (size_t)row * RD + col), y);
#pragma unroll
        for (int i = 0; i < 8; ++i) v[i] *= y[i];
        *(u32x4*)(YA + (size_t)row * RD + col) = pack8(v);
    } };
template <int SECOND> struct FM_ { const bf16* P; bf16* MA;
    __device__ __forceinline__ void operator()(int row, int col, float (&v)[8], const Unit&) const {
        float g[8]; unpack8(*(const u32x4*)(P + (size_t)row * NP + BR_OFF + SECOND * DM + col), g);
        bf16* mp = MA + (size_t)row * DM + col;
        if (SECOND) { float m[8]; unpack8(*(const u32x4*)mp, m);
#pragma unroll
            for (int i = 0; i < 8; ++i) v[i] = sigm(g[i]) * v[i] + m[i]; }
        else {
#pragma unroll
            for (int i = 0; i < 8; ++i) v[i] = sigm(g[i]) * v[i]; }
        *(u32x4*)mp = pack8(v);
    } };
struct FX_ { float* X; const float* MOD; int l;
    __device__ __forceinline__ void operator()(int row, int col, const f32x4 v, const Unit&) const {
        const f32x4 g = *(const f32x4*)(MOD + ((size_t)l * 9 + mod_row(row)) * MOD_N + 2 * DM + col);
        f32x4* xp = (f32x4*)(X + (size_t)row * DM + col);
        *xp = *xp + g * v;
    } };
struct FE1_ { bf16* ACT;
    __device__ __forceinline__ void operator()(int row, int col, float (&g)[8], float (&up)[8]) const {
#pragma unroll
        for (int i = 0; i < 8; ++i) g[i] = siluf(g[i]) * up[i];
        *(u32x4*)(ACT + (size_t)row * DEXP + col) = pack8(g);
    } };
struct FE2_ { const int* rowtok; const float* roww; bf16* YF;
    __device__ __forceinline__ void operator()(int row, int col, float (&v)[8], const Unit&) const {
        const int t2 = rowtok[row];
        if (t2 >= 0) { const float w = roww[row];
#pragma unroll
            for (int i = 0; i < 8; ++i) v[i] *= w;
            *(u32x4*)(YF + ((size_t)(t2 & 1) * TA + (t2 >> 1)) * DM + col) = pack8(v); }
    } };

#ifndef GA_
#define GA_ true
#endif
#ifndef GS_
#define GS_ true
#endif
constexpr int LDS_BYTES = 147456;
constexpr int MISC_OFF = 131072 + 4096;

constexpr int NPHASE = 2 + 14 * DEPTH + 1;
struct Args { const float* in[N_IN]; float* out; unsigned char* ws; int ph_lo, ph_hi; };
static_assert(sizeof(Args) == N_IN * 8 + 8 + 8 + 8, "Args has no padding");

__global__ void __launch_bounds__(512, 2) fwd(Args a) {
    extern __shared__ __attribute__((aligned(16))) unsigned char lds_raw[];
    KC k;
    k.lds = (LAS unsigned char*)lds_raw; k.ws = (unsigned char*)INP(N_IN + 1);
    k.tid = threadIdx.x; k.lane = k.tid & 63; k.wave = __builtin_amdgcn_readfirstlane(k.tid >> 6); k.G = gridDim.x; k.bid = blockIdx.x;
    const int lo = a.ph_lo, hi = a.ph_hi;
    volatile LAS unsigned* MISC = (volatile LAS unsigned*)(k.lds + MISC_OFF);
    if (k.tid < 32) MISC[k.tid] = 0u;
    __syncthreads();
    XcdBarrier bar; bar.bar = (unsigned*)(k.ws + WS_CTL) + CW_BAR; bar.x = 0; bar.st = nullptr;
    if (hi - lo > 1) bar = xcd_barrier_post((unsigned*)(k.ws + WS_CTL) + CW_BAR, MISC + 8);
#ifndef SITE_MASK
#define SITE_MASK 0xFFFFFFFFu
#endif
#define FRESH() do { int t_ = threadIdx.x; asm volatile("" : "+v"(t_)); k.tid = t_; k.lane = t_ & 63; k.wave = __builtin_amdgcn_readfirstlane(t_ >> 6); k.ws = (unsigned char*)INP(N_IN + 1); ws = k.ws; } while (0)
#define PH_BEGIN(p, site) if (((SITE_MASK >> (site)) & 1u) && lo <= (p) && (p) < hi) { FRESH();
#ifndef EXTRA_BARS
#define EXTRA_BARS 0
#endif
#ifndef DUP_MASK
#define DUP_MASK 0u
#endif
#define DUPRUN(n, stmt) do { stmt; if ((DUP_MASK >> (n)) & 1u) { __syncthreads(); stmt; } } while (0)
#define PH_END(p) if ((p) + 1 < hi) xcd_barrier(bar); }
    unsigned char* ws = k.ws;
    LAS unsigned char* glds = k.lds;
#define WSRC WSrc{INP(I_WIN), INP(I_W2), INP(I_A2), INP(I_G2), INP(I_WBA), INP(I_WBB), INP(I_WOUT), INP(I_EG), INP(I_EU), INP(I_ED), INP(I_W0), INP(I_A0)}

    PH_BEGIN(0, 0) DUPRUN(0, ph_adaln_partials(k, INP(I_C), INP(I_CCTX), INP(I_WADA))); DUPRUN(1, ph_convert(k, WSRC, 0)); PH_END(0)
    PH_BEGIN(1, 1) ph_adaln_reduce(k, INP(I_BADA)); PH_END(1)

#define L_ 0
    {
        constexpr int l = L_;
        const int pb = 2 + 14 * l;
        const bool last = (l == DEPTH - 1);
        const int Mpost = last ? TL : TA;
        PH_BEGIN(pb + 0, 2)
            if (l > 0) { DUPRUN(1, ph_convert(k, WSRC, l)); }
            RowArgs ra{INP(I_X), INP(I_CTX), INP(I_NMG), nullptr, nullptr, nullptr};
            ph_rows<0>(k, ra, l, TA);
            if (l == 0 && ((DUP_MASK >> 15) & 1u)) { __syncthreads(); ph_rows<0>(k, ra, l, TA); }
        PH_END(pb + 0)
        PH_BEGIN(pb + 1, 3)
            pg8::Gemm g{(const bf16*)(ws + WS_H), (const bf16*)(ws + WT_IN), TA, NP, DM, 0}; pg8::StaticOrder S; S.init(TA, NP, k.G, k.bid);
            pg8::Epi8<FP_> E{FP_{(bf16*)(ws + WS_P)}};
            DUPRUN(2, (pg8::gemm_phase<pg8::Epi8<FP_>, pg8::StaticOrder, GA_, GS_>(glds, g, S, E)));
        PH_END(pb + 1)
        PH_BEGIN(pb + 2, 4)
            DUPRUN(3, ph_rwkv_prep(k, l, TA, INP(I_MU), INP(I_KK), INP(I_RK)));
            DUPRUN(4, ph_gla_prep(k, l, INP(I_GCONV), INP(I_GAW2), INP(I_GAB)));
        PH_END(pb + 2)
        PH_BEGIN(pb + 3, 5)
            pg8::Gemm g{(const bf16*)(ws + RW_A1), (const bf16*)(ws + WT_L1), TA, 4096, 256, 0}; pg8::StaticOrder S; S.init(TA, 4096, k.G, k.bid);
            pg8::Epi8<FL1_> E{FL1_{(bf16*)(ws + RW_LO), (const float*)(ws + WS_TAB + TAB_TOP)}};
            DUPRUN(5, (pg8::gemm_phase<pg8::Epi8<FL1_>, pg8::StaticOrder, GA_, GS_>(glds, g, S, E)));
        PH_END(pb + 3)
        PH_BEGIN(pb + 4, 6)
#if SPLIT_SCAN
            DUPRUN(6, ph_scan_split(k, l, INP(I_KA)));
#else
            for (int job = k.bid; job < 256; job += k.G) { DUPRUN(6, ph_rwkv_scan(k, l, job, INP(I_KA))); DUPRUN(7, ph_gla_scan(k, job)); }
#endif
        PH_END(pb + 4)
        PH_BEGIN(pb + 5, 7)
            DUPRUN(8, ph_post(k, l, Mpost, INP(I_LNG), INP(I_LNB), INP(I_GNG)));
        PH_END(pb + 5)
        PH_BEGIN(pb + 6, 8)
            pg8::Gemm g{(const bf16*)(ws + RW_A2), (const bf16*)(ws + WT_G2), Mpost, RD, 256, 0}; pg8::StaticOrder S; S.init(Mpost, RD, k.G, k.bid);
            pg8::Epi8<FL2_> E{FL2_{(const bf16*)(ws + RW_R), (bf16*)(ws + RW_V)}};
            DUPRUN(9, (pg8::gemm_phase<pg8::Epi8<FL2_>, pg8::StaticOrder, GA_, GS_>(glds, g, S, E)));
        PH_END(pb + 6)
        PH_BEGIN(pb + 7, 9)
            pg8::Gemm g{(const bf16*)(ws + RW_V), (const bf16*)(ws + WT_A), Mpost, DM, RD, 0}; pg8::StaticOrder S; S.init(Mpost, DM, k.G, k.bid);
            pg8::Epi8<FM_<0>> E{FM_<0>{(const bf16*)(ws + WS_P), (bf16*)(ws + WS_H)}};
            DUPRUN(10, (pg8::gemm_phase<pg8::Epi8<FM_<0>>, pg8::StaticOrder, GA_, GS_>(glds, g, S, E)));
        PH_END(pb + 7)
        PH_BEGIN(pb + 8, 10)
            pg8::Gemm g{(const bf16*)(ws + GL_VS), (const bf16*)(ws + WT_B), Mpost, DM, GVD, 0}; pg8::StaticOrder S; S.init(Mpost, DM, k.G, k.bid);
            pg8::Epi8<FM_<1>> E{FM_<1>{(const bf16*)(ws + WS_P), (bf16*)(ws + WS_H)}};
            pg8::gemm_phase<pg8::Epi8<FM_<1>>, pg8::StaticOrder, GA_, GS_>(glds, g, S, E);
        PH_END(pb + 8)
        PH_BEGIN(pb + 9, 11)
            pg8::Gemm g{(const bf16*)(ws + WS_H), (const bf16*)(ws + WT_O), Mpost, DM, DM, 0}; pg8::StaticOrder S; S.init(Mpost, DM, k.G, k.bid);
            pg8::Epi4<FX_> E{FX_{(float*)(ws + WS_X), (const float*)(ws + WS_MOD), l}};
            pg8::gemm_phase<pg8::Epi4<FX_>, pg8::StaticOrder, GA_, GS_>(glds, g, S, E);
        PH_END(pb + 9)
        PH_BEGIN(pb + 10, 12)
            RowArgs ra{nullptr, nullptr, INP(I_NFG), INP(I_RW), INP(I_RB), nullptr};
            ph_rows<1>(k, ra, l, Mpost);
            if ((DUP_MASK >> 16) & 1u) { __syncthreads(); ph_rows<1>(k, ra, l, Mpost, true); }
        PH_END(pb + 10)
        PH_BEGIN(pb + 11, 13)
            DUPRUN(13, ph_moe_scatter(k, l, Mpost));
        PH_END(pb + 11)
        PH_BEGIN(pb + 12, 14)
            pg8::Gemm g{(const bf16*)(ws + WS_HP), (const bf16*)(ws + WT_GU), 0, 2816, DM, (size_t)2816 * DM * 2};
            pg8::MoeOrder S; S.init((const int*)(ws + WS_TAB + TAB_TILE) + 256 * l, 11, k.G, (k.bid & 7) * (k.G >> 3) + (k.bid >> 3));
            pg8::EpiGU<FE1_> E{FE1_{(bf16*)(ws + WS_ACT)}};
            DUPRUN(11, (pg8::gemm_phase<pg8::EpiGU<FE1_>, pg8::MoeOrder, GA_, GS_>(glds, g, S, E)));
        PH_END(pb + 12)
        PH_BEGIN(pb + 13, 15)
            pg8::Gemm g{(const bf16*)(ws + WS_ACT), (const bf16*)(ws + WT_D), 0, DM, DEXP, (size_t)DM * DEXP * 2};
            pg8::MoeOrder S; S.init((const int*)(ws + WS_TAB + TAB_TILE) + 256 * l, 8, k.G, (k.bid & 7) * (k.G >> 3) + (k.bid >> 3));
            pg8::Epi8<FE2_> E{FE2_{(const int*)(ws + WS_TAB + TAB_ROWTOK) + (size_t)l * MOE_ROWS, (const float*)(ws + WS_TAB + TAB_ROWW) + (size_t)l * MOE_ROWS, (bf16*)(ws + WS_YF)}};
            DUPRUN(12, (pg8::gemm_phase<pg8::Epi8<FE2_>, pg8::MoeOrder, GA_, GS_>(glds, g, S, E)));
        PH_END(pb + 13)
        }
#undef L_
#define L_ 1
    {
        constexpr int l = L_;
        const int pb = 2 + 14 * l;
        const bool last = (l == DEPTH - 1);
        const int Mpost = last ? TL : TA;
        PH_BEGIN(pb + 0, 2)
            if (l > 0) { DUPRUN(1, ph_convert(k, WSRC, l)); }
            RowArgs ra{INP(I_X), INP(I_CTX), INP(I_NMG), nullptr, nullptr, nullptr};
            ph_rows<0>(k, ra, l, TA);
            if (l == 0 && ((DUP_MASK >> 15) & 1u)) { __syncthreads(); ph_rows<0>(k, ra, l, TA); }
        PH_END(pb + 0)
        PH_BEGIN(pb + 1, 3)
            pg8::Gemm g{(const bf16*)(ws + WS_H), (const bf16*)(ws + WT_IN), TA, NP, DM, 0}; pg8::StaticOrder S; S.init(TA, NP, k.G, k.bid);
            pg8::Epi8<FP_> E{FP_{(bf16*)(ws + WS_P)}};
            DUPRUN(2, (pg8::gemm_phase<pg8::Epi8<FP_>, pg8::StaticOrder, GA_, GS_>(glds, g, S, E)));
        PH_END(pb + 1)
        PH_BEGIN(pb + 2, 4)
            DUPRUN(3, ph_rwkv_prep(k, l, TA, INP(I_MU), INP(I_KK), INP(I_RK)));
            DUPRUN(4, ph_gla_prep(k, l, INP(I_GCONV), INP(I_GAW2), INP(I_GAB)));
        PH_END(pb + 2)
        PH_BEGIN(pb + 3, 5)
            pg8::Gemm g{(const bf16*)(ws + RW_A1), (const bf16*)(ws + WT_L1), TA, 4096, 256, 0}; pg8::StaticOrder S; S.init(TA, 4096, k.G, k.bid);
            pg8::Epi8<FL1_> E{FL1_{(bf16*)(ws + RW_LO), (const float*)(ws + WS_TAB + TAB_TOP)}};
            DUPRUN(5, (pg8::gemm_phase<pg8::Epi8<FL1_>, pg8::StaticOrder, GA_, GS_>(glds, g, S, E)));
        PH_END(pb + 3)
        PH_BEGIN(pb + 4, 6)
#if SPLIT_SCAN
            DUPRUN(6, ph_scan_split(k, l, INP(I_KA)));
#else
            for (int job = k.bid; job < 256; job += k.G) { DUPRUN(6, ph_rwkv_scan(k, l, job, INP(I_KA))); DUPRUN(7, ph_gla_scan(k, job)); }
#endif
        PH_END(pb + 4)
        PH_BEGIN(pb + 5, 7)
            DUPRUN(8, ph_post(k, l, Mpost, INP(I_LNG), INP(I_LNB), INP(I_GNG)));
        PH_END(pb + 5)
        PH_BEGIN(pb + 6, 8)
            pg8::Gemm g{(const bf16*)(ws + RW_A2), (const bf16*)(ws + WT_G2), Mpost, RD, 256, 0}; pg8::StaticOrder S; S.init(Mpost, RD, k.G, k.bid);
            pg8::Epi8<FL2_> E{FL2_{(const bf16*)(ws + RW_R), (bf16*)(ws + RW_V)}};
            DUPRUN(9, (pg8::gemm_phase<pg8::Epi8<FL2_>, pg8::StaticOrder, GA_, GS_>(glds, g, S, E)));
        PH_END(pb + 6)
        PH_BEGIN(pb + 7, 9)
            pg8::Gemm g{(const bf16*)(ws + RW_V), (const bf16*)(ws + WT_A), Mpost, DM, RD, 0}; pg8::StaticOrder S; S.init(Mpost, DM, k.G, k.bid);
            pg8::Epi8<FM_<0>> E{FM_<0>{(const bf16*)(ws + WS_P), (bf16*)(ws + WS_H)}};
            DUPRUN(10, (pg8::gemm_phase<pg8::Epi8<FM_<0>>, pg8::StaticOrder, GA_, GS_>(glds, g, S, E)));
        PH_END(pb + 7)
        PH_BEGIN(pb + 8, 10)
            pg8::Gemm g{(const bf16*)(ws + GL_VS), (const bf16*)(ws + WT_B), Mpost, DM, GVD, 0}; pg8::StaticOrder S; S.init(Mpost, DM, k.G, k.bid);
            pg8::Epi8<FM_<1>> E{FM_<1>{(const bf16*)(ws + WS_P), (bf16*)(ws + WS_H)}};
            pg8::gemm_phase<pg8::Epi8<FM_<1>>, pg8::StaticOrder, GA_, GS_>(glds, g, S, E);
        PH_END(pb + 8)
        PH_BEGIN(pb + 9, 11)
            pg8::Gemm g{(const bf16*)(ws + WS_H), (const bf16*)(ws + WT_O), Mpost, DM, DM, 0}; pg8::StaticOrder S; S.init(Mpost, DM, k.G, k.bid);
            pg8::Epi4<FX_> E{FX_{(float*)(ws + WS_X), (const float*)(ws + WS_MOD), l}};
            pg8::gemm_phase<pg8::Epi4<FX_>, pg8::StaticOrder, GA_, GS_>(glds, g, S, E);
        PH_END(pb + 9)
        PH_BEGIN(pb + 10, 12)
            RowArgs ra{nullptr, nullptr, INP(I_NFG), INP(I_RW), INP(I_RB), nullptr};
            ph_rows<1>(k, ra, l, Mpost);
            if ((DUP_MASK >> 16) & 1u) { __syncthreads(); ph_rows<1>(k, ra, l, Mpost, true); }
        PH_END(pb + 10)
        PH_BEGIN(pb + 11, 13)
            DUPRUN(13, ph_moe_scatter(k, l, Mpost));
        PH_END(pb + 11)
        PH_BEGIN(pb + 12, 14)
            pg8::Gemm g{(const bf16*)(ws + WS_HP), (const bf16*)(ws + WT_GU), 0, 2816, DM, (size_t)2816 * DM * 2};
            pg8::MoeOrder S; S.init((const int*)(ws + WS_TAB + TAB_TILE) + 256 * l, 11, k.G, (k.bid & 7) * (k.G >> 3) + (k.bid >> 3));
            pg8::EpiGU<FE1_> E{FE1_{(bf16*)(ws + WS_ACT)}};
            DUPRUN(11, (pg8::gemm_phase<pg8::EpiGU<FE1_>, pg8::MoeOrder, GA_, GS_>(glds, g, S, E)));
        PH_END(pb + 12)
        PH_BEGIN(pb + 13, 15)
            pg8::Gemm g{(const bf16*)(ws + WS_ACT), (const bf16*)(ws + WT_D), 0, DM, DEXP, (size_t)DM * DEXP * 2};
            pg8::MoeOrder S; S.init((const int*)(ws + WS_TAB + TAB_TILE) + 256 * l, 8, k.G, (k.bid & 7) * (k.G >> 3) + (k.bid >> 3));
            pg8::Epi8<FE2_> E{FE2_{(const int*)(ws + WS_TAB + TAB_ROWTOK) + (size_t)l * MOE_ROWS, (const float*)(ws + WS_TAB + TAB_ROWW) + (size_t)l * MOE_ROWS, (bf16*)(ws + WS_YF)}};
            DUPRUN(12, (pg8::gemm_phase<pg8::Epi8<FE2_>, pg8::MoeOrder, GA_, GS_>(glds, g, S, E)));
        PH_END(pb + 13)
        }
#undef L_
#if EXTRA_BARS
    if (hi - lo > 1) { for (int i = 0; i < EXTRA_BARS; ++i) xcd_barrier(bar); }
#endif
    PH_BEGIN(NPHASE - 1, 16)
        RowArgs ra{nullptr, nullptr, INP(I_FNG), nullptr, nullptr, (float*)INP(N_IN)};
        DUPRUN(14, ph_rows<2>(k, ra, 0, TL));
    PH_END(NPHASE - 1)
}

#ifndef MK_SINGLE
#define MK_SINGLE 1
#endif
extern "C" void kernel_launch(void* const* d_in, const int* in_sizes, int n_in, void* d_out, int out_size, void* d_ws, size_t ws_size, hipStream_t stream) {
    static int grid = 0;
    if (grid == 0) {
        if (n_in != N_IN || out_size != TL * DM || ws_size < WS_END) { fprintf(stderr, "kernel_launch: unexpected problem (n_in %d out %d ws %zu need %zu)\n", n_in, out_size, ws_size, (size_t)WS_END); grid = -1; return; }
        int dev = 0, cus = 0;
        if (hipGetDevice(&dev) != hipSuccess || hipDeviceGetAttribute(&cus, hipDeviceAttributeMultiprocessorCount, dev) != hipSuccess) { grid = -1; return; }
        if (hipFuncSetAttribute((const void*)fwd, hipFuncAttributeMaxDynamicSharedMemorySize, LDS_BYTES) != hipSuccess) { grid = -1; return; }
        int per_cu = 0;
        if (hipOccupancyMaxActiveBlocksPerMultiprocessor(&per_cu, (const void*)fwd, 512, LDS_BYTES) != hipSuccess || per_cu < 1) fprintf(stderr, "kernel_launch: occupancy query says %d\n", per_cu);
        (void)hipGetLastError();
        grid = cus;
    }
    if (grid < 0) return;
    unsigned char* ws = (unsigned char*)d_ws;
    (void)hipMemsetAsync(ws + WS_CTL, 0, CTL_BYTES, stream);
    Args a{};
    for (int i = 0; i < N_IN; ++i) a.in[i] = (const float*)d_in[i];
    a.out = (float*)d_out; a.ws = ws;
#if MK_SINGLE
    a.ph_lo = 0; a.ph_hi = NPHASE;
    hipLaunchKernelGGL(fwd, dim3(grid), dim3(512), LDS_BYTES, stream, a);
#else
    for (int p = 0; p < NPHASE; ++p) { a.ph_lo = p; a.ph_hi = p + 1; hipLaunchKernelGGL(fwd, dim3(grid), dim3(512), LDS_BYTES, stream, a); }
#endif
}
```

```cpp
#include <hip/hip_runtime.h>
#include <cstdio>
#include <cstdint>

#define LAS __attribute__((address_space(3)))
#define GAS __attribute__((address_space(1)))
typedef unsigned short bf16;
typedef float f32x4 __attribute__((ext_vector_type(4)));
typedef float f32x2 __attribute__((ext_vector_type(2)));
typedef unsigned u32x4 __attribute__((ext_vector_type(4)));
typedef unsigned u32x2 __attribute__((ext_vector_type(2)));
typedef short bf16x8 __attribute__((ext_vector_type(8)));

constexpr int DM = 2048, NBATCH = 8, SEQ = 2048, CTXL = 256, DEPTH = 2;
constexpr int TL = NBATCH * SEQ, TC = NBATCH * CTXL, TA = TL + TC;
constexpr int RD = 1024, RHEADS = 16, RHS = 64;
constexpr int RWKV_IN = 3520;
constexpr int GKD = 512, GVD = 1024, GDK = 128, GDV = 256, GHEADS = 4, GQKV = 2048;
constexpr int GLA_OFF = 3520, GLA_AD_OFF = GLA_OFF + GQKV, GLA_GATE_OFF = 5584, BR_OFF = 6608, IN_DIM = 10704, NP = 10752;
constexpr int NEXP = 16, DEXP = 1408;
constexpr int MOD_N = 6 * DM;
constexpr int MOE_ROWS = 41216;
constexpr int MOE_TILES = MOE_ROWS / 256;
constexpr int NCH = 36;
constexpr int KSPLIT = 32;

enum { I_X = 0, I_C, I_CTX, I_CCTX, I_WADA, I_BADA, I_NMG, I_NFG, I_WIN, I_MU, I_W0, I_W2, I_A0, I_A2, I_G2, I_KK, I_KA, I_RK, I_LNG, I_LNB,
       I_GCONV, I_GAW2, I_GAB, I_GNG, I_WBA, I_WBB, I_WOUT, I_RW, I_RB, I_EG, I_EU, I_ED, I_FNG, N_IN };

constexpr size_t MiB = 1u << 20;
constexpr size_t WS_CTL = 0;
constexpr size_t WS_TAB = 1 * MiB;
constexpr size_t WS_MOD = 2 * MiB;
constexpr size_t WS_X = 3 * MiB;
constexpr size_t WS_H = WS_X + 144 * MiB;
constexpr size_t WS_P = WS_H + 72 * MiB;
constexpr size_t WS_RW = WS_P + 378 * MiB;
constexpr size_t WS_GL = WS_RW + 380 * MiB;
constexpr size_t WS_WT = WS_GL + 218 * MiB;
constexpr size_t WS_END = WS_WT + 325 * MiB;
constexpr int CW_TMO = 0, CW_CNT = 64  , CW_BAR = 4096;
constexpr size_t CTL_BYTES = 1 * MiB;
constexpr size_t TAB_ROWTOK = 0;
constexpr size_t TAB_ROWTOK_BYTES = 2 * (size_t)MOE_ROWS * 4;
constexpr size_t TAB_ROWW = 384 * 1024;
constexpr size_t TAB_TILE = 768 * 1024;
constexpr size_t TAB_TOP = 800 * 1024;
static_assert(TAB_ROWTOK_BYTES <= TAB_ROWW && TAB_ROWW + 2 * (size_t)MOE_ROWS * 4 <= TAB_TILE, "tab map");
constexpr size_t WS_MODP = WS_P;
constexpr size_t WS_HP = WS_P;
constexpr size_t WS_ACT = WS_P + 162 * MiB;
constexpr size_t WS_TOPK = WS_P + 274 * MiB;
static_assert((size_t)MOE_ROWS * DM * 2 <= 162 * MiB && (size_t)MOE_ROWS * DEXP * 2 <= 112 * MiB && 274 * MiB + 3 * (size_t)TA * 8 <= 378 * MiB, "P overlay");
constexpr size_t RW_R = WS_RW;
constexpr size_t RW_KS = RW_R + 36 * MiB;
constexpr size_t RW_V = RW_KS + 36 * MiB;
constexpr size_t RW_KK = RW_V + 36 * MiB;
constexpr size_t RW_LO = RW_KK + 36 * MiB;
constexpr size_t RW_Y = RW_LO + 144 * MiB;
constexpr size_t RW_A1 = RW_Y + 72 * MiB;
constexpr size_t RW_A2 = RW_A1 + 9 * MiB;
constexpr size_t RW_BON = RW_A2 + 9 * MiB;
static_assert(RW_BON + 2 * MiB <= WS_GL, "rwkv map");
constexpr size_t GL_QG = WS_GL;
constexpr size_t GL_KG = GL_QG + 36 * MiB;
constexpr size_t GL_KE = GL_KG + 36 * MiB;
constexpr size_t GL_VS = GL_KE + 36 * MiB;
constexpr size_t GL_O = GL_VS + 36 * MiB;
constexpr size_t GL_DEC = GL_O + 72 * MiB;
static_assert(GL_DEC + 2 * MiB <= WS_WT, "gla map");
constexpr size_t WS_YF = WS_GL;
constexpr size_t WT_IN = WS_WT;
constexpr size_t WT_L1 = WT_IN + 42 * MiB;
constexpr size_t WT_G2 = WT_L1 + 2 * MiB;
constexpr size_t WT_A = WT_G2 + 1 * MiB;
constexpr size_t WT_B = WT_A + 4 * MiB;
constexpr size_t WT_O = WT_B + 4 * MiB;
constexpr size_t WT_GU = WT_O + 8 * MiB;
constexpr size_t WT_D = WT_GU + 176 * MiB;
static_assert(WT_D + 88 * MiB == WS_END, "weight map");

__device__ __forceinline__ float bf2f(unsigned v) { return __uint_as_float(v << 16); }
__device__ __forceinline__ float bflo(unsigned w) { return __uint_as_float(w << 16); }
__device__ __forceinline__ float bfhi(unsigned w) { return __uint_as_float(w & 0xffff0000u); }
__device__ __forceinline__ unsigned f2bf(float f) { unsigned u = __float_as_uint(f); return (u + 0x7fffu + ((u >> 16) & 1u)) >> 16; }
__device__ __forceinline__ unsigned pk2(float lo, float hi) { unsigned r; asm volatile("v_cvt_pk_bf16_f32 %0, %1, %2" : "=v"(r) : "v"(lo), "v"(hi)); return r; }
__device__ __forceinline__ float sigm(float x) { return 1.0f / (1.0f + __expf(-x)); }
__device__ __forceinline__ float siluf(float x) { return x * sigm(x); }
__device__ __forceinline__ float wave_sum(float x) {
    x += __builtin_bit_cast(float, __builtin_amdgcn_update_dpp(0, __builtin_bit_cast(int, x), 0xB1, 0xF, 0xF, true));
    x += __builtin_bit_cast(float, __builtin_amdgcn_update_dpp(0, __builtin_bit_cast(int, x), 0x4E, 0xF, 0xF, true));
    x += __builtin_bit_cast(float, __builtin_amdgcn_update_dpp(0, __builtin_bit_cast(int, x), 0x141, 0xF, 0xF, true));
    x += __builtin_bit_cast(float, __builtin_amdgcn_update_dpp(0, __builtin_bit_cast(int, x), 0x140, 0xF, 0xF, true));
    const int xi = __builtin_bit_cast(int, x);
    return (__builtin_bit_cast(float, __builtin_amdgcn_readlane(xi, 0)) + __builtin_bit_cast(float, __builtin_amdgcn_readlane(xi, 16))) +
           (__builtin_bit_cast(float, __builtin_amdgcn_readlane(xi, 32)) + __builtin_bit_cast(float, __builtin_amdgcn_readlane(xi, 48)));
}
__device__ __forceinline__ void unpack8(const u32x4 w, float (&o)[8]) {
    o[0] = bflo(w.x); o[1] = bfhi(w.x); o[2] = bflo(w.y); o[3] = bfhi(w.y); o[4] = bflo(w.z); o[5] = bfhi(w.z); o[6] = bflo(w.w); o[7] = bfhi(w.w);
}
__device__ __forceinline__ u32x4 pack8(const float (&v)[8]) { u32x4 w; w.x = pk2(v[0], v[1]); w.y = pk2(v[2], v[3]); w.z = pk2(v[4], v[5]); w.w = pk2(v[6], v[7]); return w; }
namespace pg8 {
#define PG8_LAS __attribute__((address_space(3)))
typedef unsigned short bf16_t;
typedef short bf16x8 __attribute__((ext_vector_type(8)));
typedef float f32x4 __attribute__((ext_vector_type(4)));
typedef unsigned u32x4 __attribute__((ext_vector_type(4)));
constexpr int BM = 256, BK = 64, HALF = 128, HTB = HALF * BK * 2  , STAGE_BYTES = 8 * HTB, NXCD = 8, WGM = 8;

__host__ __device__ __forceinline__ int lds_byte(int r, int c) { const int st = (r >> 4) * 2 + (c >> 5), rr = r & 15, cc = c & 31, ob = rr * 64 + cc * 2; return st * 1024 + (ob ^ (((ob >> 9) & 1) << 5)); }
__host__ __device__ __forceinline__ void stage_rc(int b, int& R, int& C) { const int st = b / 1024, sb = b % 1024, swz = sb ^ (((sb >> 9) & 1) << 5); R = (st >> 1) * 16 + swz / 64; C = (st & 1) * 32 + (swz % 64) / 2; }
__host__ __device__ __forceinline__ int perm32(int rho) { const int n = rho >> 4, i = rho & 15; return 8 * (i >> 2) + 4 * n + (i & 3); }
struct Unit { int pm, pn, eb; };
struct Gemm { const bf16_t* A; const bf16_t* Bt; int M, N, K; size_t bstride; };

struct StaticOrder {
    int nM, nN, nwg, G, c;
    __host__ __device__ void init(int M, int N, int G_, int c_) { nM = M / BM; nN = N / BM; nwg = nM * nN; G = G_; c = c_; }
    __host__ __device__ bool next(int i, Unit& u) const {
        const long L = (long)i * G + c; if (L >= nwg) return false;
        int wgid = (int)L; { const int q = nwg / NXCD, r = nwg % NXCD, xcd = wgid % NXCD, off = wgid / NXCD; wgid = (xcd < r ? xcd * (q + 1) : r * (q + 1) + (xcd - r) * q) + off; }
        const int nig = WGM * nN, gid = wgid / nig, fm = gid * WGM, gsz = (nM - fm) < WGM ? (nM - fm) : WGM;
        u.pm = fm + ((wgid % nig) % gsz); u.pn = (wgid % nig) / gsz; u.eb = 0; return true;
    }
    __device__ __forceinline__ void a_ready(const Unit&) const {}
    __device__ __forceinline__ void done(const Unit&) const {}
};
struct MoeOrder {
    const int* tab; int nT, nN, G, c;
    __device__ void init(const int* tab_, int nN_, int G_, int c_) { tab = tab_; nT = tab_[0]; nN = nN_; G = G_; c = c_; }
    __device__ bool next(int i, Unit& u) const {
        const long L = (long)i * G + c; if (L >= (long)nT * nN) return false;
        u.pm = (int)(L / nN); u.pn = (int)(L % nN); u.eb = tab[1 + u.pm]; return true;
    }
    __device__ __forceinline__ void a_ready(const Unit&) const {}
    __device__ __forceinline__ void done(const Unit&) const {}
};

template <class F> struct Epi8 {
    static constexpr bool PERM = true, AFTER_DRAIN = false;
    F f;
    __device__ __forceinline__ void operator()(const f32x4 (&acc)[2][2][4][2], const Unit& u, int wr, int wc, int fr, int fq) const {
        const int row0 = u.pm * BM + wr * 64 + fr, col0 = u.pn * BM + wc * 32 + 8 * fq;
#pragma unroll
        for (int ai = 0; ai < 2; ++ai)
#pragma unroll
            for (int m = 0; m < 4; ++m) {
#pragma unroll
                for (int bj = 0; bj < 2; ++bj) {
                    const f32x4 a = acc[ai][bj][m][0], b = acc[ai][bj][m][1];
                    float v[8] = {a[0], a[1], a[2], a[3], b[0], b[1], b[2], b[3]};
                    f(row0 + ai * HALF + m * 16, col0 + bj * HALF, v, u);
                }
            }
    }
};
template <class F> struct EpiGU {
    static constexpr bool PERM = true, AFTER_DRAIN = false;
    F f;
    __device__ __forceinline__ void operator()(const f32x4 (&acc)[2][2][4][2], const Unit& u, int wr, int wc, int fr, int fq) const {
        const int row0 = u.pm * BM + wr * 64 + fr, col0 = u.pn * HALF + wc * 32 + 8 * fq;
#pragma unroll
        for (int ai = 0; ai < 2; ++ai)
#pragma unroll
            for (int m = 0; m < 4; ++m) {
                const f32x4 g0 = acc[ai][0][m][0], g1 = acc[ai][0][m][1], u0 = acc[ai][1][m][0], u1 = acc[ai][1][m][1];
                float g[8] = {g0[0], g0[1], g0[2], g0[3], g1[0], g1[1], g1[2], g1[3]};
                float up[8] = {u0[0], u0[1], u0[2], u0[3], u1[0], u1[1], u1[2], u1[3]};
                f(row0 + ai * HALF + m * 16, col0, g, up);
            }
    }
};
template <class F> struct Epi4 {
    static constexpr bool PERM = false, AFTER_DRAIN = false;
    F f;
    __device__ __forceinline__ void operator()(const f32x4 (&acc)[2][2][4][2], const Unit& u, int wr, int wc, int fr, int fq) const {
        const int row0 = u.pm * BM + wr * 64 + fr, col0 = u.pn * BM + wc * 32 + 4 * fq;
#pragma unroll
        for (int ai = 0; ai < 2; ++ai)
#pragma unroll
            for (int m = 0; m < 4; ++m) {
#pragma unroll
                for (int bj = 0; bj < 2; ++bj)
#pragma unroll
                    for (int n = 0; n < 2; ++n) f(row0 + ai * HALF + m * 16, col0 + bj * HALF + n * 16, acc[ai][bj][m][n], u);
            }
    }
};
template <class Epi, class Sched, bool ALIGN_EPI = false, bool SP2 = false>
__device__ __forceinline__ void gemm_phase(PG8_LAS unsigned char* lds, const Gemm g, const Sched& S, const Epi& E) {
    int tid_o = threadIdx.x; asm volatile("" : "+v"(tid_o));
    const int tid = tid_o, wid = __builtin_amdgcn_readfirstlane(tid >> 6), lane = tid & 63, wr = wid >> 2, wc = wid & 3, fr = lane & 15, fq = lane >> 4;
    const int K = g.K, nt = K / BK;
    unsigned voffA[2], voffB[2];
#pragma unroll
    for (int i = 0; i < 2; ++i) { int R, C; stage_rc(tid * 16 + i * 8192, R, C); const int Rb = Epi::PERM ? ((R & ~31) + perm32(R & 31)) : R;
        voffA[i] = (unsigned)(R * K + C) * 2u; voffB[i] = (unsigned)(Rb * K + C) * 2u; }
    const size_t kstep = (size_t)(BK * 2);
    const size_t hstep = (size_t)HALF * K * 2;
    const size_t tstep = 2 * hstep;
    const unsigned ldsw = (unsigned)wid * 1024u;
    const int aoff = lds_byte(wr * 64 + fr, fq * 8), boff = lds_byte(wc * 32 + fr, fq * 8);
#define PG8_SA(b, h) (((b) * 2 + (h)) * HTB)
#define PG8_SB(b, h) ((4 + (b) * 2 + (h)) * HTB)
#define PG8_STAGE(bufoff, gbase, voff) do { _Pragma("unroll") for (int _i = 0; _i < 2; ++_i) \
        __builtin_amdgcn_global_load_lds((const unsigned*)((const char*)(gbase) + (voff)[_i]), (PG8_LAS unsigned*)(lds + (bufoff) + ldsw + _i * 8192), 16, 0, 0); } while (0)
#define PG8_LDA(dst, b, h) do { _Pragma("unroll") for (int m = 0; m < 4; ++m) _Pragma("unroll") for (int k = 0; k < 2; ++k) dst[m][k] = *(const PG8_LAS bf16x8*)(lds + PG8_SA(b, h) + aoff + m * 2048 + k * 1024); } while (0)
#define PG8_LDB(dst, b, h) do { _Pragma("unroll") for (int n = 0; n < 2; ++n) _Pragma("unroll") for (int k = 0; k < 2; ++k) dst[n][k] = *(const PG8_LAS bf16x8*)(lds + PG8_SB(b, h) + boff + n * 2048 + k * 1024); } while (0)
#define PG8_MMA(ai, bj, At, Bt) do { __builtin_amdgcn_s_setprio(1); _Pragma("unroll") for (int m = 0; m < 4; ++m) _Pragma("unroll") for (int n = 0; n < 2; ++n) _Pragma("unroll") for (int k = 0; k < 2; ++k) \
        acc[ai][bj][m][n] = __builtin_amdgcn_mfma_f32_16x16x32_bf16(Bt[n][k], At[m][k], acc[ai][bj][m][n], 0, 0, 0); __builtin_amdgcn_s_setprio(0); } while (0)
#define PG8_WAIT_V(n) asm volatile("s_waitcnt vmcnt(" #n ")" ::: "memory")
#define PG8_WAIT_L(n) asm volatile("s_waitcnt lgkmcnt(" #n ")" ::: "memory")
#define PG8_BAR __builtin_amdgcn_s_barrier()
#define PG8_SCHED __builtin_amdgcn_sched_barrier(0)
    Unit cur, nxt; int ui = 0;
    if (!S.next(0, cur)) return;
    f32x4 acc[2][2][4][2];
#pragma unroll
    for (int a = 0; a < 2; ++a)
#pragma unroll
        for (int b = 0; b < 2; ++b)
#pragma unroll
            for (int m = 0; m < 4; ++m)
#pragma unroll
                for (int n = 0; n < 2; ++n) acc[a][b][m][n] = (f32x4){0.f, 0.f, 0.f, 0.f};
    bf16x8 At[4][2], B0[2][2], B1[2][2];
    const char* cA = (const char*)g.A + (size_t)cur.pm * tstep; const char* cB = (const char*)g.Bt + (size_t)cur.eb * g.bstride + (size_t)cur.pn * tstep;
    S.a_ready(cur);
    if constexpr (SP2) {
        PG8_STAGE(PG8_SB(0, 0), cB, voffB); PG8_STAGE(PG8_SB(0, 1), cB + hstep, voffB); PG8_STAGE(PG8_SA(0, 0), cA, voffA); PG8_STAGE(PG8_SA(0, 1), cA + hstep, voffA);
        if (wr == 1) PG8_BAR;
        PG8_WAIT_V(2); PG8_BAR;
        PG8_STAGE(PG8_SB(1, 0), cB + kstep, voffB); PG8_STAGE(PG8_SA(1, 0), cA + kstep, voffA); PG8_STAGE(PG8_SB(1, 1), cB + hstep + kstep, voffB);
        PG8_WAIT_V(6); PG8_BAR;
    } else {
        PG8_STAGE(PG8_SB(0, 0), cB, voffB); PG8_STAGE(PG8_SA(0, 0), cA, voffA); PG8_STAGE(PG8_SB(0, 1), cB + hstep, voffB); PG8_STAGE(PG8_SA(0, 1), cA + hstep, voffA);
        if (wr == 1) PG8_BAR;
        PG8_WAIT_V(4); PG8_BAR;
        PG8_STAGE(PG8_SB(1, 0), cB + kstep, voffB); PG8_STAGE(PG8_SA(1, 0), cA + kstep, voffA); PG8_STAGE(PG8_SB(1, 1), cB + hstep + kstep, voffB);
        PG8_WAIT_V(6); PG8_BAR;
    }
    for (;;) {
        const bool has_next = S.next(ui + 1, nxt);
        const char* nA = has_next ? (const char*)g.A + (size_t)nxt.pm * tstep : cA; const char* nB = has_next ? (const char*)g.Bt + (size_t)nxt.eb * g.bstride + (size_t)nxt.pn * tstep : cB;
#pragma nounroll
        for (int t = 0; t < nt; t += 2) {
            const bool last = (t == nt - 2);
            const char* a1 = cA + (size_t)(t + 1) * kstep;
            const char* a2 = last ? nA : cA + (size_t)(t + 2) * kstep; const char* b2 = last ? nB : cB + (size_t)(t + 2) * kstep;
            const char* a3 = a2 + kstep; const char* b3 = b2 + kstep;
            if (last && has_next) S.a_ready(nxt);
            if constexpr (SP2) {
            PG8_LDB(B0, 0, 0); PG8_LDB(B1, 0, 1); PG8_SCHED; PG8_LDA(At, 0, 0); PG8_STAGE(PG8_SA(1, 1), a1 + hstep, voffA);
            PG8_WAIT_V(8); PG8_WAIT_L(0); PG8_BAR; PG8_MMA(0, 0, At, B0); PG8_MMA(0, 1, At, B1); PG8_BAR; PG8_SCHED;
            PG8_LDA(At, 0, 1); PG8_STAGE(PG8_SB(0, 0), b2, voffB); PG8_STAGE(PG8_SB(0, 1), b2 + hstep, voffB); PG8_STAGE(PG8_SA(0, 0), a2, voffA);
            PG8_WAIT_V(8); PG8_WAIT_L(0); PG8_BAR; PG8_MMA(1, 0, At, B0); PG8_MMA(1, 1, At, B1); PG8_BAR; PG8_SCHED;
            PG8_LDB(B0, 1, 0); PG8_LDB(B1, 1, 1); PG8_SCHED; PG8_LDA(At, 1, 0); PG8_STAGE(PG8_SA(0, 1), a2 + hstep, voffA);
            PG8_WAIT_V(8); PG8_WAIT_L(0); PG8_BAR; PG8_MMA(0, 0, At, B0); PG8_MMA(0, 1, At, B1); PG8_BAR; PG8_SCHED;
            PG8_LDA(At, 1, 1); PG8_STAGE(PG8_SB(1, 0), b3, voffB); PG8_STAGE(PG8_SB(1, 1), b3 + hstep, voffB); PG8_STAGE(PG8_SA(1, 0), a3, voffA);
            PG8_WAIT_V(8); PG8_WAIT_L(0); PG8_BAR; PG8_MMA(1, 0, At, B0); PG8_MMA(1, 1, At, B1); PG8_BAR; PG8_SCHED;
            } else {
            PG8_LDB(B0, 0, 0); PG8_SCHED; PG8_LDA(At, 0, 0); PG8_STAGE(PG8_SA(1, 1), a1 + hstep, voffA);
            PG8_WAIT_L(8); PG8_BAR; PG8_WAIT_L(0); PG8_MMA(0, 0, At, B0); PG8_BAR; PG8_SCHED;
            PG8_LDB(B1, 0, 1); PG8_STAGE(PG8_SB(0, 0), b2, voffB);
            PG8_BAR; PG8_WAIT_L(0); PG8_MMA(0, 1, At, B1); PG8_BAR;
            PG8_LDA(At, 0, 1); PG8_STAGE(PG8_SA(0, 0), a2, voffA);
            PG8_BAR; PG8_WAIT_L(0); PG8_MMA(1, 0, At, B0); PG8_BAR; PG8_SCHED;
            PG8_STAGE(PG8_SB(0, 1), b2 + hstep, voffB);
            PG8_WAIT_V(6); PG8_BAR; PG8_MMA(1, 1, At, B1); PG8_BAR;
            PG8_LDB(B0, 1, 0); PG8_SCHED; PG8_LDA(At, 1, 0); PG8_STAGE(PG8_SA(0, 1), a2 + hstep, voffA);
            PG8_WAIT_L(8); PG8_BAR; PG8_WAIT_L(0); PG8_MMA(0, 0, At, B0); PG8_BAR; PG8_SCHED;
            PG8_LDB(B1, 1, 1); PG8_STAGE(PG8_SB(1, 0), b3, voffB);
            PG8_BAR; PG8_WAIT_L(0); PG8_MMA(0, 1, At, B1); PG8_BAR;
            PG8_LDA(At, 1, 1); PG8_STAGE(PG8_SA(1, 0), a3, voffA);
            PG8_BAR; PG8_WAIT_L(0); PG8_MMA(1, 0, At, B0); PG8_BAR; PG8_SCHED;
            PG8_STAGE(PG8_SB(1, 1), b3 + hstep, voffB);
            PG8_WAIT_V(6); PG8_BAR; PG8_MMA(1, 1, At, B1); PG8_BAR;
            }
        }
        if constexpr (ALIGN_EPI) { if (wr == 0) PG8_BAR; }
        if constexpr (!Epi::AFTER_DRAIN) { E(acc, cur, wr, wc, fr, fq); S.done(cur); }
        if (!has_next) break;
#pragma unroll
        for (int a = 0; a < 2; ++a)
#pragma unroll
            for (int b = 0; b < 2; ++b)
#pragma unroll
                for (int m = 0; m < 4; ++m)
#pragma unroll
                    for (int n = 0; n < 2; ++n) acc[a][b][m][n] = (f32x4){0.f, 0.f, 0.f, 0.f};
        cur = nxt; cA = nA; cB = nB; ++ui;
        if constexpr (ALIGN_EPI) { if (wr == 1) PG8_BAR; }
    }
    PG8_WAIT_V(0);
    if constexpr (!ALIGN_EPI) { if (wr == 0) PG8_BAR; }
    PG8_BAR;
    if constexpr (Epi::AFTER_DRAIN) { E.fused(acc, cur, wr, wc, fr, fq, lds, wid, lane); S.done(cur); }
#undef PG8_SA
#undef PG8_SB
#undef PG8_STAGE
#undef PG8_LDA
#undef PG8_LDB
#undef PG8_MMA
#undef PG8_WAIT_V
#undef PG8_WAIT_L
#undef PG8_BAR
#undef PG8_SCHED
}
}

#ifndef PG8_SP2
#define PG8_SP2 true
#endif
#ifndef PG8_ALIGN
#define PG8_ALIGN true
#endif
#define XB_TMO      128
#define XB_XCNT(j)  (256  + 64 * (j))
#define XB_XSUB(j)  (1280 + 64 * (j))
#define XB_XGEN(j)  (2304 + 64 * (j))
#define XB_TOP      3328
#define XB_TOPGEN   3392
#define XCD_BAR_WORDS 3456
#define XB_SPIN_CAP (1u << 18)

__device__ __forceinline__ unsigned xb_ld(unsigned* p)              { return __hip_atomic_load(p, __ATOMIC_RELAXED, __HIP_MEMORY_SCOPE_AGENT); }
__device__ __forceinline__ unsigned xb_add(unsigned* p, unsigned v) { return __hip_atomic_fetch_add(p, v, __ATOMIC_RELAXED, __HIP_MEMORY_SCOPE_AGENT); }
__device__ __forceinline__ unsigned xb_xcc_id() { return (unsigned)__builtin_amdgcn_s_getreg((3 << 11) | 20) & 0xFu; }
#define XB_SPIN(cond, bar) do { unsigned _sp = 0; while (cond) { __builtin_amdgcn_s_sleep(1); \
    if ((++_sp & 255u) == 0u) { if (xb_ld(&(bar)[XB_TMO])) break; if (_sp > XB_SPIN_CAP) { atomicAdd(&(bar)[XB_TMO], 1u); break; } } } } while (0)

struct XcdBarrier {
    unsigned* bar; unsigned x;
    volatile LAS unsigned* st;
};

__device__ __forceinline__ XcdBarrier xcd_barrier_post(unsigned* bar, volatile LAS unsigned* st) {
    XcdBarrier b; b.bar = bar; b.x = xb_xcc_id(); b.st = st;
    if (threadIdx.x == 0) (void)xb_add(&bar[XB_XCNT(b.x)], 1u);
    return b;
}
__device__ __forceinline__ void xcd_barrier_complete(unsigned* bar, unsigned x, unsigned& nloc, unsigned& nx) {
    const unsigned G = gridDim.x * gridDim.y * gridDim.z;
    unsigned sum, cnt, mine, sp = 0u;
    for (;;) {
        sum = 0u; cnt = 0u; mine = 0u;
#pragma unroll
        for (unsigned j = 0; j < 16; ++j) { const unsigned c = xb_ld(&bar[XB_XCNT(j)]); sum += c; cnt += (c > 0u) ? 1u : 0u; mine = (j == x) ? c : mine; }
        if (sum == G) break;
        __builtin_amdgcn_s_sleep(1);
        if ((++sp & 255u) == 0u) { if (xb_ld(&bar[XB_TMO])) break; if (sp > XB_SPIN_CAP) { atomicAdd(&bar[XB_TMO], 1u); break; } }
    }
    nloc = mine > 0u ? mine : 1u; nx = cnt > 0u ? cnt : 1u;
}

__device__ __forceinline__ void xcd_barrier(const XcdBarrier& b) {
    asm volatile("s_waitcnt vmcnt(0)" ::: "memory");
    __syncthreads();
    if (threadIdx.x == 0) {
        unsigned* bar = b.bar;
        __builtin_amdgcn_s_waitcnt(0);
        unsigned nloc = b.st[0], nx = b.st[1];
        if (nloc == 0u) { xcd_barrier_complete(bar, b.x, nloc, nx); b.st[0] = nloc; b.st[1] = nx; }
        const unsigned old = xb_add(&bar[XB_XSUB(b.x)], 1u);
        const unsigned gen = old / nloc;
        if (old + 1u == (gen + 1u) * nloc) {
            __builtin_amdgcn_fence(__ATOMIC_RELEASE, "agent");
            asm volatile("s_waitcnt vmcnt(0)" ::: "memory");
            const unsigned og = xb_add(&bar[XB_TOP], 1u);
            const unsigned tg = og / nx;
            if (og + 1u == (tg + 1u) * nx) xb_add(&bar[XB_TOPGEN], 1u);
            else XB_SPIN(xb_ld(&bar[XB_TOPGEN]) == tg, bar);
            __builtin_amdgcn_fence(__ATOMIC_ACQUIRE, "agent");
            xb_add(&bar[XB_XGEN(b.x)], 1u);
            asm volatile("s_waitcnt vmcnt(0)" ::: "memory");
        } else {
            XB_SPIN(xb_ld(&bar[XB_XGEN(b.x)]) == gen, bar);
            __builtin_amdgcn_fence(__ATOMIC_ACQUIRE, "agent");
            asm volatile("s_waitcnt vmcnt(0)" ::: "memory");
        }
    }
    __syncthreads();
}
struct KC {
    const float* const* in;
    LAS unsigned char* lds;
    unsigned char* ws;
    int tid, lane, wave, G, bid;
};
__device__ __forceinline__ const float* inp_(int i) {
    const volatile unsigned long long __attribute__((address_space(4)))* kp = (const volatile unsigned long long __attribute__((address_space(4)))*)__builtin_amdgcn_kernarg_segment_ptr();
    return (const float*)(const GAS float*)kp[i];
}
#define INP(k) (inp_(k))

__device__ __forceinline__ int mod_row(int row) { return row < TL ? (row >> 11) : 8; }

__device__ __forceinline__ void ph_adaln_partials(const KC& k, const float* c, const float* c_ctx, const float* w_ada) {
    LAS float* sc = (LAS float*)k.lds;
    for (int i = k.tid; i < 9 * DM; i += 512) { const int r = i >> 11, kk = i & 2047; const float cv = r < 8 ? c[r * DM + kk] : c_ctx[kk]; sc[i] = siluf(cv); }
    __syncthreads();
    float* modp = (float*)(k.ws + WS_MODP);
    const int cc = k.tid & 255, kh = k.tid >> 8;
    constexpr int NIT = DEPTH * 48 * 16;
    for (int it = k.bid; it < NIT; it += k.G) {
        const int l = it / 768, rem = it % 768, cb = rem >> 4, ks = rem & 15;
        const int col = cb * 256 + cc, kbeg = ks * 128 + kh * 64;
        const float* W = w_ada + ((size_t)l * DM + kbeg) * MOD_N + col;
        float acc[9];
#pragma unroll
        for (int r = 0; r < 9; ++r) acc[r] = 0.f;
#pragma unroll 32
        for (int q = 0; q < 64; ++q) {
            const float w = W[(size_t)q * MOD_N];
#pragma unroll
            for (int r = 0; r < 9; ++r) acc[r] += sc[r * DM + kbeg + q] * w;
        }
        const int s = ks * 2 + kh;
#pragma unroll
        for (int r = 0; r < 9; ++r) modp[(((size_t)s * DEPTH + l) * 9 + r) * MOD_N + col] = acc[r];
    }
    __syncthreads();
}
__device__ __forceinline__ void ph_adaln_reduce(const KC& k, const float* b_ada) {
    const float* modp = (const float*)(k.ws + WS_MODP); float* mod = (float*)(k.ws + WS_MOD);
    constexpr int TOT = DEPTH * 9 * MOD_N;
    for (int i = k.bid * 512 + k.tid; i < TOT; i += k.G * 512) {
        const int n = i % MOD_N, l = i / (9 * MOD_N);
        float s = b_ada[l * MOD_N + n];
#pragma unroll 8
        for (int q = 0; q < KSPLIT; ++q) s += modp[(size_t)q * TOT + i];
        mod[i] = s;
    }
}

struct TrItem { const float* src; bf16* dst; int srcN, Kv, Nv, k0, n0, dpitch, drow0, dk0; };
struct WSrc { const float *w_in, *w2, *a2, *g2, *wba, *wbb, *wout, *eg, *eu, *ed, *w0, *a0; };
constexpr int TI_IN = 32 * 336, TI_LO = 4 * 64, TI_G2 = 4 * 32, TI_AB = 16 * 64, TI_O = 32 * 64, TI_GU1 = 32 * 44, TI_D1 = 22 * 64;
constexpr int TI_N = TI_IN + TI_LO + TI_G2 + 2 * TI_AB + TI_O + 2 * NEXP * TI_GU1 + NEXP * TI_D1;
__device__ __forceinline__ TrItem tr_decode(const WSrc& s, unsigned char* ws, int l, int it) {
    TrItem t; int r = it;
    if (r < TI_IN) { const int kb = r / 336, nb = r % 336; t = TrItem{s.w_in + (size_t)l * DM * IN_DIM, (bf16*)(ws + WT_IN), IN_DIM, DM, IN_DIM, 64 * kb, 32 * nb, DM, 32 * nb, 0}; return t; } r -= TI_IN;
    if (r < TI_LO) {
        const int mtx = r >> 6, q = r & 63, kb = q >> 5, nb = q & 31;
        t = TrItem{(mtx < 2 ? s.w2 : s.a2) + (size_t)(l * 2 + (mtx & 1)) * 96 * RD, (bf16*)(ws + WT_L1), RD, 96, RD, 64 * kb, 32 * nb, 256, mtx * 1024 + 32 * nb, mtx < 2 ? 0 : 96}; return t; } r -= TI_LO;
    if (r < TI_G2) { const int kb = r >> 5, nb = r & 31; t = TrItem{s.g2 + (size_t)l * 256 * RD, (bf16*)(ws + WT_G2), RD, 256, RD, 64 * kb, 32 * nb, 256, 32 * nb, 0}; return t; } r -= TI_G2;
    if (r < TI_AB) { const int kb = r >> 6, nb = r & 63; t = TrItem{s.wba + (size_t)l * RD * DM, (bf16*)(ws + WT_A), DM, RD, DM, 64 * kb, 32 * nb, RD, 32 * nb, 0}; return t; } r -= TI_AB;
    if (r < TI_AB) { const int kb = r >> 6, nb = r & 63; t = TrItem{s.wbb + (size_t)l * GVD * DM, (bf16*)(ws + WT_B), DM, GVD, DM, 64 * kb, 32 * nb, GVD, 32 * nb, 0}; return t; } r -= TI_AB;
    if (r < TI_O) { const int kb = r >> 6, nb = r & 63; t = TrItem{s.wout + (size_t)l * DM * DM, (bf16*)(ws + WT_O), DM, DM, DM, 64 * kb, 32 * nb, DM, 32 * nb, 0}; return t; } r -= TI_O;
    if (r < 2 * NEXP * TI_GU1) {
        const int e = r / (2 * TI_GU1), q = r % (2 * TI_GU1), up = q / TI_GU1, q2 = q % TI_GU1, kb = q2 / 44, nb = q2 % 44;
        const int n0 = 32 * nb, drow = 256 * (n0 >> 7) + (n0 & 127) + (up ? 128 : 0);
        t = TrItem{(up ? s.eu : s.eg) + ((size_t)l * NEXP + e) * DM * DEXP, (bf16*)(ws + WT_GU) + (size_t)e * 2816 * DM, DEXP, DM, DEXP, 64 * kb, n0, DM, drow, 0}; return t; } r -= 2 * NEXP * TI_GU1;
    { const int e = r / TI_D1, q = r % TI_D1, kb = q >> 6, nb = q & 63;
      t = TrItem{s.ed + ((size_t)l * NEXP + e) * DEXP * DM, (bf16*)(ws + WT_D) + (size_t)e * DM * DEXP, DM, DEXP, DM, 64 * kb, 32 * nb, DEXP, 32 * nb, 0}; }
    return t;
}
__device__ __forceinline__ void tr_load(const TrItem& t, int lane, float (&v)[32]) {
    const int nn = lane & 31, kh = lane >> 5;
    const bool nok = t.n0 + nn < t.Nv;
    const float* p = t.src + (size_t)(t.k0 + kh) * t.srcN + t.n0 + nn;
#pragma unroll
    for (int i = 0; i < 32; ++i) { v[i] = 0.f; if (nok && t.k0 + 2 * i + kh < t.Kv) v[i] = p[(size_t)(2 * i) * t.srcN]; }
}
__device__ __forceinline__ void tr_store(const TrItem& t, int lane, const float (&v)[32], LAS float* scr) {
    const int nn = lane & 31, kh = lane >> 5;
#pragma unroll
    for (int i = 0; i < 32; ++i) scr[(2 * i + kh) * 33 + nn] = v[i];
    asm volatile("s_waitcnt lgkmcnt(0)" ::: "memory");
    const int cidx = lane & 7;
#pragma unroll
    for (int j = 0; j < 4; ++j) {
        const int n = (lane >> 3) + 8 * j; const LAS float* s = scr + (8 * cidx) * 33 + n;
        u32x4 o; o.x = pk2(s[0 * 33], s[1 * 33]); o.y = pk2(s[2 * 33], s[3 * 33]); o.z = pk2(s[4 * 33], s[5 * 33]); o.w = pk2(s[6 * 33], s[7 * 33]);
        *(u32x4*)(t.dst + (size_t)(t.drow0 + n) * t.dpitch + t.dk0 + t.k0 + 8 * cidx) = o;
    }
    asm volatile("s_waitcnt lgkmcnt(0)" ::: "memory");
}
__device__ __forceinline__ void ph_convert(const KC& k, const WSrc& s, int l) {
    LAS float* scr = (LAS float*)(k.lds + k.wave * 16384);
    const int gw = k.bid * 8 + k.wave, NGW = k.G * 8;
    unsigned char* ws = k.ws;
    { float* b1 = (float*)(ws + WS_TAB + TAB_TOP); for (int i = gw * 64 + k.lane; i < 4096; i += NGW * 64) b1[i] = i < 2048 ? s.w0[l * 2048 + i] : s.a0[l * 2048 + i - 2048]; }
    {
        u32x4* wl = (u32x4*)(ws + WT_L1);
        for (int i = gw * 64 + k.lane; i < 4096 * 32; i += NGW * 64) { const int row = i >> 5, ck = i & 31; if (row < 2048 ? ck >= 16 : (ck < 12 || ck >= 28)) wl[i] = (u32x4){0u, 0u, 0u, 0u}; }
        if (l == 0) { int* rt = (int*)(ws + WS_TAB + TAB_ROWTOK); for (int i = gw * 64 + k.lane; i < 2 * MOE_ROWS; i += NGW * 64) rt[i] = -1; }
    }
    float cur[32], nxt[32];
    int it = gw;
    TrItem tc = tr_decode(s, ws, l, it < TI_N ? it : 0);
    if (it < TI_N) tr_load(tc, k.lane, cur);
    for (; it < TI_N; it += NGW) {
        const bool more = it + NGW < TI_N;
        const TrItem tn = tr_decode(s, ws, l, more ? it + NGW : it);
        if (more) tr_load(tn, k.lane, nxt);
        tr_store(tc, k.lane, cur, scr);
        tc = tn;
#pragma unroll
        for (int i = 0; i < 32; ++i) cur[i] = nxt[i];
    }
}

constexpr int RWP = DM + 4;
struct RowArgs { const float *x_in, *ctx_in, *gvec, *router_w, *router_b; float* out; };
template <int MODE>
__device__ __forceinline__ void ph_rows(const KC& k, const RowArgs& ra, int l, int nrows, bool dry = false) {
    const int gw = k.bid * 8 + k.wave, NGW = k.G * 8, lane = k.lane;
    float* X = (float*)(k.ws + WS_X); bf16* H = (bf16*)(k.ws + WS_H);
    const float* MOD = (const float*)(k.ws + WS_MOD);
    const bf16* YF = (const bf16*)(k.ws + WS_YF);
    LAS float* rwT = (LAS float*)k.lds;
    if (MODE == 1) {
        for (int i = k.tid; i < DM * NEXP; i += 512) { const int c = i >> 4, e = i & 15; rwT[e * RWP + c] = ra.router_w[i]; }
        __syncthreads();
    }
    const float* gv = ra.gvec;
    for (int row = gw; row < nrows; row += NGW) {
        const int mr = mod_row(row);
        f32x4 v[8];
        if (MODE == 0 && l == 0) {
            const f32x4* src = (const f32x4*)(row < TL ? ra.x_in + (size_t)row * DM : ra.ctx_in + (size_t)(row - TL) * DM) + lane;
#pragma unroll
            for (int j = 0; j < 8; ++j) v[j] = src[64 * j];
        } else {
            const f32x4* src = (const f32x4*)(X + (size_t)row * DM) + lane;
#pragma unroll
            for (int j = 0; j < 8; ++j) v[j] = src[64 * j];
        }
        if ((MODE == 0 && l > 0) || MODE == 2) {
            const int lp = (MODE == 2) ? DEPTH - 1 : l - 1;
            const f32x4* gate = (const f32x4*)(MOD + ((size_t)lp * 9 + mr) * MOD_N + 5 * DM) + lane;
            const u32x2* y0 = (const u32x2*)(YF + (size_t)row * DM) + lane;
            const u32x2* y1 = (const u32x2*)(YF + ((size_t)TA + row) * DM) + lane;
#pragma unroll
            for (int j = 0; j < 8; ++j) {
                const f32x4 g = gate[64 * j]; const u32x2 a = y0[64 * j], b = y1[64 * j];
                v[j].x += g.x * (bflo(a.x) + bflo(b.x)); v[j].y += g.y * (bfhi(a.x) + bfhi(b.x));
                v[j].z += g.z * (bflo(a.y) + bflo(b.y)); v[j].w += g.w * (bfhi(a.y) + bfhi(b.y));
            }
        }
        if (MODE == 0) {
            f32x4* dst = (f32x4*)(X + (size_t)row * DM) + lane;
#pragma unroll
            for (int j = 0; j < 8; ++j) dst[64 * j] = v[j];
        }
        float ss = 0.f;
#pragma unroll
        for (int j = 0; j < 8; ++j) ss += (v[j].x * v[j].x + v[j].y * v[j].y) + (v[j].z * v[j].z + v[j].w * v[j].w);
        const float rinv = 1.0f / sqrtf(wave_sum(ss) * (1.0f / DM) + 1e-6f);
        if (MODE == 2) {
            f32x4* dst = (f32x4*)(ra.out + (size_t)row * DM) + lane; const f32x4* g4 = (const f32x4*)gv + lane;
#pragma unroll
            for (int j = 0; j < 8; ++j) { const f32x4 g = g4[64 * j]; dst[64 * j] = v[j] * rinv * g; }
        } else {
            const float* mrow = MOD + ((size_t)l * 9 + mr) * MOD_N + (MODE == 0 ? 0 : 3 * DM);
            const f32x4* sh4 = (const f32x4*)mrow + lane; const f32x4* sc4 = (const f32x4*)(mrow + DM) + lane; const f32x4* g4 = (const f32x4*)(gv + (size_t)l * DM) + lane;
            u32x2* dst = (u32x2*)(H + (size_t)row * DM) + lane;
#pragma unroll
            for (int j = 0; j < 8; ++j) {
                const f32x4 g = g4[64 * j], sh = sh4[64 * j], sc = sc4[64 * j];
                v[j] = v[j] * rinv * g * (1.0f + sc) + sh;
                u32x2 o; o.x = pk2(v[j].x, v[j].y); o.y = pk2(v[j].z, v[j].w); dst[64 * j] = o;
            }
        }
        if (MODE == 1) {
            float lg[NEXP];
#pragma unroll
            for (int e = 0; e < NEXP; ++e) {
                float s = 0.f;
#pragma unroll
                for (int j = 0; j < 8; ++j) { const f32x4 w = *(const LAS f32x4*)(rwT + e * RWP + 4 * lane + 256 * j); s += (v[j].x * w.x + v[j].y * w.y) + (v[j].z * w.z + v[j].w * w.w); }
                lg[e] = wave_sum(s);
            }
            float sc[NEXP], sel[NEXP];
#pragma unroll
            for (int e = 0; e < NEXP; ++e) { sc[e] = 1.0f / (1.0f + expf(-lg[e])); sel[e] = sc[e] + ra.router_b[e]; }
            float gs[4], w1g[4], w2g[4]; int i1g[4], i2g[4];
#pragma unroll
            for (int g = 0; g < 4; ++g) {
                int i1 = 0; float m1 = sel[4 * g];
#pragma unroll
                for (int q = 1; q < 4; ++q) if (sel[4 * g + q] > m1) { m1 = sel[4 * g + q]; i1 = q; }
                int i2 = -1; float m2 = -3.0e38f;
#pragma unroll
                for (int q = 0; q < 4; ++q) if (q != i1 && sel[4 * g + q] > m2) { m2 = sel[4 * g + q]; i2 = q; }
                gs[g] = m1 + m2; i1g[g] = 4 * g + i1; i2g[g] = 4 * g + i2;
                float a1 = sc[4 * g], a2 = sc[4 * g];
#pragma unroll
                for (int q = 0; q < 4; ++q) { a1 = (q == i1) ? sc[4 * g + q] : a1; a2 = (q == i2) ? sc[4 * g + q] : a2; }
                w1g[g] = a1; w2g[g] = a2;
            }
            int best = 0; float bs = gs[0];
#pragma unroll
            for (int g = 1; g < 4; ++g) if (gs[g] > bs) { bs = gs[g]; best = g; }
            int e1 = i1g[0], e2 = i2g[0]; float w1 = w1g[0], w2 = w2g[0];
#pragma unroll
            for (int g = 1; g < 4; ++g) { e1 = (best == g) ? i1g[g] : e1; e2 = (best == g) ? i2g[g] : e2; w1 = (best == g) ? w1g[g] : w1; w2 = (best == g) ? w2g[g] : w2; }
            const float inv = 1.0f / (w1 + w2);
            if (lane == 0 && !dry) {
                unsigned* cnt = (unsigned*)(k.ws + WS_CTL) + CW_CNT + 64 * l;
                const int p1 = (int)atomicAdd(cnt + e1, 1u), p2 = (int)atomicAdd(cnt + e2, 1u);
                int* te = (int*)(k.ws + WS_TOPK); float* tw = (float*)(k.ws + WS_TOPK + (size_t)TA * 8); int* tp = (int*)(k.ws + WS_TOPK + 2 * (size_t)TA * 8);
                te[2 * row] = e1; te[2 * row + 1] = e2; tw[2 * row] = w1 * inv; tw[2 * row + 1] = w2 * inv; tp[2 * row] = p1; tp[2 * row + 1] = p2;
            }
        }
    }
    if (MODE == 1) __syncthreads();
}

__device__ __forceinline__ void ph_moe_scatter(const KC& k, int l, int nrows) {
    LAS int* offs = (LAS int*)k.lds;
    const unsigned* cnt = (const unsigned*)(k.ws + WS_CTL) + CW_CNT + 64 * l;
    int* tile = (int*)(k.ws + WS_TAB + TAB_TILE) + 256 * l;
    if (k.tid == 0) {
        int off = 0, nt = 0;
        for (int e = 0; e < NEXP; ++e) {
            offs[e] = off; const int c = (int)__hip_atomic_load(cnt + e, __ATOMIC_RELAXED, __HIP_MEMORY_SCOPE_AGENT); const int t = (c + 255) >> 8;
            if (k.bid == 0) for (int q = 0; q < t; ++q) tile[1 + nt + q] = e;
            nt += t; off += t * 256;
        }
        if (k.bid == 0) tile[0] = nt;
    }
    __syncthreads();
    const int gw = k.bid * 8 + k.wave, NGW = k.G * 8, lane = k.lane;
    const bf16* H = (const bf16*)(k.ws + WS_H); bf16* HP = (bf16*)(k.ws + WS_HP);
    const int* te = (const int*)(k.ws + WS_TOPK); const float* tw = (const float*)(k.ws + WS_TOPK + (size_t)TA * 8); const int* tp = (const int*)(k.ws + WS_TOPK + 2 * (size_t)TA * 8);
    int* rowtok = (int*)(k.ws + WS_TAB + TAB_ROWTOK) + (size_t)l * MOE_ROWS; float* roww = (float*)(k.ws + WS_TAB + TAB_ROWW) + (size_t)l * MOE_ROWS;
    for (int row = gw; row < nrows; row += NGW) {
        const u32x4* src = (const u32x4*)(H + (size_t)row * DM) + lane;
        u32x4 d[4];
#pragma unroll
        for (int j = 0; j < 4; ++j) d[j] = src[64 * j];
#pragma unroll
        for (int s = 0; s < 2; ++s) {
            const int e = te[2 * row + s], dest = offs[e] + tp[2 * row + s];
            u32x4* dp = (u32x4*)(HP + (size_t)dest * DM) + lane;
#pragma unroll
            for (int j = 0; j < 4; ++j) dp[64 * j] = d[j];
            if (lane == 0) { rowtok[dest] = 2 * row + s; roww[dest] = tw[2 * row + s]; }
        }
    }
    __syncthreads();
}
__device__ __forceinline__ void ld16(const bf16* p, bool ok, float (&o)[16]) {
    if (ok) { const u32x4 a = *(const u32x4*)p, b = *(const u32x4*)(p + 8); float x[8], y[8]; unpack8(a, x); unpack8(b, y);
#pragma unroll
        for (int i = 0; i < 8; ++i) { o[i] = x[i]; o[8 + i] = y[i]; } }
    else {
#pragma unroll
        for (int i = 0; i < 16; ++i) o[i] = 0.f; }
}
__device__ __forceinline__ void st16(bf16* p, const float (&v)[16]) {
    float a[8], b[8];
#pragma unroll
    for (int i = 0; i < 8; ++i) { a[i] = v[i]; b[i] = v[8 + i]; }
    *(u32x4*)p = pack8(a); *(u32x4*)(p + 8) = pack8(b);
}
__device__ __forceinline__ void shift8(const bf16* p0, bool hp, bool hn, int c, const float* mu0, const float* mu1, float (&s)[8]) {
    float x[8], xm[8], xp[8];
    unpack8(*(const u32x4*)(p0 + c), x);
    if (hp) unpack8(*(const u32x4*)(p0 - NP + c), xm); else {
#pragma unroll
        for (int i = 0; i < 8; ++i) xm[i] = 0.f; }
    if (hn) unpack8(*(const u32x4*)(p0 + NP + c), xp); else {
#pragma unroll
        for (int i = 0; i < 8; ++i) xp[i] = 0.f; }
    const f32x4 m0a = *(const f32x4*)(mu0 + c), m0b = *(const f32x4*)(mu0 + c + 4), m1a = *(const f32x4*)(mu1 + c), m1b = *(const f32x4*)(mu1 + c + 4);
    const float m0[8] = {m0a.x, m0a.y, m0a.z, m0a.w, m0b.x, m0b.y, m0b.z, m0b.w}, m1[8] = {m1a.x, m1a.y, m1a.z, m1a.w, m1b.x, m1b.y, m1b.z, m1b.w};
#pragma unroll
    for (int i = 0; i < 8; ++i) s[i] = x[i] + m0[i] * (xm[i] - x[i]) + m1[i] * (xp[i] - x[i]);
}
__device__ __forceinline__ void ph_rwkv_prep(const KC& k, int l, int nrows, const float* mu, const float* k_k, const float* r_k) {
    const int gw = k.bid * 8 + k.wave, NGW = k.G * 8, lane = k.lane;
    const bf16* P = (const bf16*)(k.ws + WS_P);
    bf16* R = (bf16*)(k.ws + RW_R); bf16* KS = (bf16*)(k.ws + RW_KS); bf16* V = (bf16*)(k.ws + RW_V); bf16* KK = (bf16*)(k.ws + RW_KK);
    bf16* A1 = (bf16*)(k.ws + RW_A1); bf16* A2 = (bf16*)(k.ws + RW_A2); float* BON = (float*)(k.ws + RW_BON);
    const float* mu0 = mu + (size_t)(l * 2 + 0) * RWKV_IN; const float* mu1 = mu + (size_t)(l * 2 + 1) * RWKV_IN;
    const int rpw = (nrows + NGW - 1) / NGW;
    for (int row = gw * rpw; row < nrows && row < (gw + 1) * rpw; ++row) {
        int t, len; if (row < TL) { t = row & (SEQ - 1); len = SEQ; } else { t = (row - TL) & (CTXL - 1); len = CTXL; }
        const bool hp = t > 0, hn = t < len - 1;
        const bf16* p0 = P + (size_t)row * NP;
#pragma unroll
        for (int half = 0; half < 2; ++half) {
            const int c = half * 512 + 8 * lane;
            float r[8], kx[8], vv[8], kk[8];
            shift8(p0, hp, hn, c, mu0, mu1, r);
            shift8(p0, hp, hn, RD + c, mu0, mu1, kx);
            shift8(p0, hp, hn, 2 * RD + c, mu0, mu1, vv);
            const f32x4 kka = *(const f32x4*)(k_k + l * RD + c), kkb = *(const f32x4*)(k_k + l * RD + c + 4), rka = *(const f32x4*)(r_k + l * RD + c), rkb = *(const f32x4*)(r_k + l * RD + c + 4);
            const float kkw[8] = {kka.x, kka.y, kka.z, kka.w, kkb.x, kkb.y, kkb.z, kkb.w}, rkw[8] = {rka.x, rka.y, rka.z, rka.w, rkb.x, rkb.y, rkb.z, rkb.w};
            float ss = 0.f, bon = 0.f;
#pragma unroll
            for (int i = 0; i < 8; ++i) { kk[i] = kx[i] * kkw[i]; ss += kk[i] * kk[i]; bon += r[i] * kx[i] * rkw[i]; }
            ss += __shfl_xor(ss, 1); ss += __shfl_xor(ss, 2); ss += __shfl_xor(ss, 4);
            bon += __shfl_xor(bon, 1); bon += __shfl_xor(bon, 2); bon += __shfl_xor(bon, 4);
            const float inv = 1.0f / fmaxf(sqrtf(ss), 1e-12f);
#pragma unroll
            for (int i = 0; i < 8; ++i) kk[i] *= inv;
            *(u32x4*)(R + (size_t)row * RD + c) = pack8(r); *(u32x4*)(KS + (size_t)row * RD + c) = pack8(kx);
            *(u32x4*)(V + (size_t)row * RD + c) = pack8(vv); *(u32x4*)(KK + (size_t)row * RD + c) = pack8(kk);
            if ((lane & 7) == 0) BON[(size_t)row * RHEADS + half * 8 + (lane >> 3)] = bon;
        }
        if (lane < 56) {
            float s8[8];
            shift8(p0, hp, hn, 3 * RD + 8 * lane, mu0, mu1, s8);
            if (lane < 12) {
#pragma unroll
                for (int i = 0; i < 8; ++i) { const float e2 = __expf(2.0f * fminf(fmaxf(s8[i], -15.f), 15.f)); s8[i] = 1.0f - 2.0f / (e2 + 1.0f); }
                *(u32x4*)(A1 + (size_t)row * 256 + 8 * lane) = pack8(s8);
            } else if (lane < 24) { *(u32x4*)(A1 + (size_t)row * 256 + 8 * lane) = pack8(s8); }
            else {
#pragma unroll
                for (int i = 0; i < 8; ++i) s8[i] = sigm(s8[i]);
                *(u32x4*)(A2 + (size_t)row * 256 + 8 * (lane - 24)) = pack8(s8);
            }
        } else { *(u32x4*)(A1 + (size_t)row * 256 + 192 + 8 * (lane - 56)) = (u32x4){0u, 0u, 0u, 0u}; }
    }
}

__device__ __forceinline__ float logsig(float x) { return fminf(x, 0.f) - __logf(1.0f + __expf(-fabsf(x))); }
__device__ __forceinline__ int gla_row(bool lat, int b, int s) { return lat ? b * SEQ + (s & 31) * 64 + (s >> 5) : TL + b * CTXL + s; }
constexpr int GQ_PITCH = 264;
constexpr int GPL_AD = 0, GPL_GS = 4096, GPL_QK = GPL_GS + 65536, GPL_END = GPL_QK + 66 * GQ_PITCH * 2;
static_assert(GPL_END <= 131072, "gla prep lds");
__device__ __forceinline__ void ph_gla_prep(const KC& k, int l, const float* conv, const float* aw2, const float* ab) {
    const bf16* P = (const bf16*)(k.ws + WS_P);
    bf16* QG = (bf16*)(k.ws + GL_QG); bf16* KG = (bf16*)(k.ws + GL_KG); bf16* KE = (bf16*)(k.ws + GL_KE); bf16* VS = (bf16*)(k.ws + GL_VS); float* DEC = (float*)(k.ws + GL_DEC);
    const float* cw = conv + (size_t)l * 3 * GQKV;
    const int tid = k.tid, lane = k.lane;
    {
        const int gw = k.bid * 8 + k.wave, NGW = k.G * 8, c = 16 * lane;
        const int rpw = (TA + NGW - 1) / NGW;
        for (int qi = gw * rpw; qi < TA && qi < (gw + 1) * rpw; ++qi) {
            const bool lat = qi < TL; int b, s, len;
            if (lat) { b = qi >> 11; s = qi & 2047; len = SEQ; } else { b = (qi - TL) >> 8; s = (qi - TL) & 255; len = CTXL; }
            const int row = gla_row(lat, b, s);
            const bool hp = s > 0, hn = s + 1 < len;
            const bf16* p0 = P + (size_t)row * NP + GLA_OFF + 2 * GKD + c;
            const bf16* pm = P + (size_t)gla_row(lat, b, hp ? s - 1 : s) * NP + GLA_OFF + 2 * GKD + c;
            const bf16* pp = P + (size_t)gla_row(lat, b, hn ? s + 1 : s) * NP + GLA_OFF + 2 * GKD + c;
            float o[16];
#pragma unroll
            for (int hf = 0; hf < 2; ++hf) {
                float x[8], xm[8], xp[8];
                unpack8(*(const u32x4*)(p0 + 8 * hf), x); unpack8(*(const u32x4*)(pm + 8 * hf), xm); unpack8(*(const u32x4*)(pp + 8 * hf), xp);
                const float* w = cw + 2 * GKD + c + 8 * hf;
#pragma unroll
                for (int q = 0; q < 2; ++q) {
                    const f32x4 w0 = *(const f32x4*)(w + 4 * q), w1 = *(const f32x4*)(w + GQKV + 4 * q), w2 = *(const f32x4*)(w + 2 * GQKV + 4 * q);
#pragma unroll
                    for (int i = 0; i < 4; ++i) o[8 * hf + 4 * q + i] = siluf(w0[i] * (hp ? xm[4 * q + i] : 0.f) + w1[i] * x[4 * q + i] + w2[i] * (hn ? xp[4 * q + i] : 0.f));
                }
            }
            st16(VS + (size_t)row * GVD + c, o);
        }
    }
    LAS float* ADs = (LAS float*)(k.lds + GPL_AD);
    LAS float* Gs = (LAS float*)(k.lds + GPL_GS);
    LAS bf16* QKs = (LAS bf16*)(k.lds + GPL_QK);
    for (int item = k.bid; item < 288 * 4; item += k.G) {
        const int sc = item >> 2, h = item & 3;
        const bool lat = sc < 256; const int b = lat ? (sc >> 5) : ((sc - 256) >> 2), cn = lat ? (sc & 31) : ((sc - 256) & 3), len = lat ? SEQ : CTXL;
        const int gch = lat ? 4 + cn : cn, s0 = 64 * cn;
        for (int i = tid; i < 1024; i += 512) { const int tau = i >> 4, j = i & 15; ADs[i] = bf2f(P[(size_t)gla_row(lat, b, s0 + tau) * NP + GLA_AD_OFF + j]); }
        for (int i = tid; i < 66 * 32; i += 512) {
            const int rr = i >> 5, ck = i & 31, s = s0 - 1 + rr;
            u32x4 v = (u32x4){0u, 0u, 0u, 0u};
            if (s >= 0 && s < len) v = *(const u32x4*)(P + (size_t)gla_row(lat, b, s) * NP + GLA_OFF + (ck >> 4) * GKD + h * GDK + (ck & 15) * 8);
            *(LAS u32x4*)(QKs + rr * GQ_PITCH + ck * 8) = v;
        }
        __syncthreads();
        {
            const int c = tid & 127, tg = tid >> 7, chl = h * GDK + c;
            float awf[16], awb[16];
#pragma unroll
            for (int j = 0; j < 16; ++j) { awf[j] = aw2[((size_t)(l * 2 + 0) * 16 + j) * GKD + chl]; awb[j] = aw2[((size_t)(l * 2 + 1) * 16 + j) * GKD + chl]; }
            const float abf = ab[(l * 2 + 0) * GKD + chl], abb = ab[(l * 2 + 1) * GKD + chl];
            for (int i = 0; i < 16; ++i) {
                const int tau = 16 * tg + i; float xf = abf, xb = abb;
#pragma unroll
                for (int j = 0; j < 16; ++j) { const float a = ADs[tau * 16 + j]; xf += a * awf[j]; xb += a * awb[j]; }
                Gs[tau * 128 + c] = logsig(xf) * (1.0f / 16.0f); Gs[(64 + tau) * 128 + c] = logsig(xb) * (1.0f / 16.0f);
            }
        }
        __syncthreads();
        if (tid < 128) { float run = 0.f; for (int tau = 0; tau < 64; ++tau) { run += Gs[tau * 128 + tid]; Gs[tau * 128 + tid] = run; } }
        else if (tid < 256) { const int c = tid - 128; float run = 0.f; for (int tau = 63; tau >= 0; --tau) { run += Gs[(64 + tau) * 128 + c]; Gs[(64 + tau) * 128 + c] = run; } }
        __syncthreads();
        {
            const int c8 = tid & 15, tg = tid >> 4, chl = h * GDK + 8 * c8;
            float wq[3][8], wk[3][8], elf[8], elb[8];
#pragma unroll
            for (int tp = 0; tp < 3; ++tp) {
                const f32x4 a0 = *(const f32x4*)(cw + tp * GQKV + chl), a1 = *(const f32x4*)(cw + tp * GQKV + chl + 4), b0 = *(const f32x4*)(cw + tp * GQKV + GKD + chl), b1 = *(const f32x4*)(cw + tp * GQKV + GKD + chl + 4);
#pragma unroll
                for (int i = 0; i < 4; ++i) { wq[tp][i] = a0[i]; wq[tp][4 + i] = a1[i]; wk[tp][i] = b0[i]; wk[tp][4 + i] = b1[i]; }
            }
            {
                const f32x4 a0 = *(const LAS f32x4*)(Gs + 63 * 128 + 8 * c8), a1 = *(const LAS f32x4*)(Gs + 63 * 128 + 8 * c8 + 4), b0 = *(const LAS f32x4*)(Gs + 64 * 128 + 8 * c8), b1 = *(const LAS f32x4*)(Gs + 64 * 128 + 8 * c8 + 4);
#pragma unroll
                for (int i = 0; i < 4; ++i) { elf[i] = __expf(a0[i]); elf[4 + i] = __expf(a1[i]); elb[i] = __expf(b0[i]); elb[4 + i] = __expf(b1[i]); }
            }
            if (tg < 8) {
                float* d0 = DEC + ((size_t)(0 * 8 + b) * NCH + gch) * GKD + chl; float* d1 = DEC + ((size_t)(1 * 8 + b) * NCH + gch) * GKD + chl;
                if (tg == 0) { *(f32x4*)d0 = (f32x4){elf[0], elf[1], elf[2], elf[3]}; *(f32x4*)(d0 + 4) = (f32x4){elf[4], elf[5], elf[6], elf[7]}; }
                if (tg == 1) { *(f32x4*)d1 = (f32x4){elb[0], elb[1], elb[2], elb[3]}; *(f32x4*)(d1 + 4) = (f32x4){elb[4], elb[5], elb[6], elb[7]}; }
            }
#pragma unroll
            for (int pass = 0; pass < 2; ++pass) {
                const int tau = tg + 32 * pass;
                float qm[8], q0[8], qp[8], km[8], k0[8], kp[8];
                unpack8(*(const LAS u32x4*)(QKs + (tau + 0) * GQ_PITCH + 8 * c8), qm); unpack8(*(const LAS u32x4*)(QKs + (tau + 1) * GQ_PITCH + 8 * c8), q0); unpack8(*(const LAS u32x4*)(QKs + (tau + 2) * GQ_PITCH + 8 * c8), qp);
                unpack8(*(const LAS u32x4*)(QKs + (tau + 0) * GQ_PITCH + 128 + 8 * c8), km); unpack8(*(const LAS u32x4*)(QKs + (tau + 1) * GQ_PITCH + 128 + 8 * c8), k0); unpack8(*(const LAS u32x4*)(QKs + (tau + 2) * GQ_PITCH + 128 + 8 * c8), kp);
                const f32x4 f0 = *(const LAS f32x4*)(Gs + tau * 128 + 8 * c8), f1 = *(const LAS f32x4*)(Gs + tau * 128 + 8 * c8 + 4), g0 = *(const LAS f32x4*)(Gs + (64 + tau) * 128 + 8 * c8), g1 = *(const LAS f32x4*)(Gs + (64 + tau) * 128 + 8 * c8 + 4);
                const float cf[8] = {f0.x, f0.y, f0.z, f0.w, f1.x, f1.y, f1.z, f1.w}, cb[8] = {g0.x, g0.y, g0.z, g0.w, g1.x, g1.y, g1.z, g1.w};
                float oqf[8], okf[8], oef[8], oqb[8], okb[8], oeb[8];
#pragma unroll
                for (int i = 0; i < 8; ++i) {
                    const float qv = siluf(wq[0][i] * qm[i] + wq[1][i] * q0[i] + wq[2][i] * qp[i]) * 0.08838834764831845f;
                    const float kv = siluf(wk[0][i] * km[i] + wk[1][i] * k0[i] + wk[2][i] * kp[i]);
                    const float ef = __expf(cf[i]), eb = __expf(cb[i]), rf = 1.0f / ef, rb = 1.0f / eb;
                    oqf[i] = qv * ef; okf[i] = kv * rf; oef[i] = kv * rf * elf[i];
                    oqb[i] = qv * eb; okb[i] = kv * rb; oeb[i] = kv * rb * elb[i];
                }
                const size_t o = (size_t)gla_row(lat, b, s0 + tau) * GKD + chl;
                *(u32x4*)(QG + o) = pack8(oqf); *(u32x4*)(KG + o) = pack8(okf); *(u32x4*)(KE + o) = pack8(oef);
                *(u32x4*)(QG + (size_t)TA * GKD + o) = pack8(oqb); *(u32x4*)(KG + (size_t)TA * GKD + o) = pack8(okb); *(u32x4*)(KE + (size_t)TA * GKD + o) = pack8(oeb);
            }
        }
        __syncthreads();
    }
}

__device__ __forceinline__ float dpp_sum16(float x) {
    x += __builtin_bit_cast(float, __builtin_amdgcn_update_dpp(0, __builtin_bit_cast(int, x), 0xB1, 0xF, 0xF, true));
    x += __builtin_bit_cast(float, __builtin_amdgcn_update_dpp(0, __builtin_bit_cast(int, x), 0x4E, 0xF, 0xF, true));
    x += __builtin_bit_cast(float, __builtin_amdgcn_update_dpp(0, __builtin_bit_cast(int, x), 0x141, 0xF, 0xF, true));
    x += __builtin_bit_cast(float, __builtin_amdgcn_update_dpp(0, __builtin_bit_cast(int, x), 0x140, 0xF, 0xF, true));
    return x;
}
constexpr int RS_TOK = 16;
constexpr int RS_TF = 6 * 64;
constexpr int RS_BUF = RS_TOK * RS_TF;
struct RwkvStage { unsigned r, we, a, ks, v, kk; };
__device__ __forceinline__ int rwkv_row(int b, int dir, int p) {
    if (p < CTXL) { const int t = dir ? CTXL - 1 - p : p; return TL + b * CTXL + t; }
    const int q = p - CTXL, t = dir ? SEQ - 1 - q : q; return b * SEQ + t;
}
__device__ __forceinline__ void ph_rwkv_scan(const KC& k, int l, int job, const float* k_a, size_t yoff = RW_Y) {
    const int b = job >> 5, h = (job >> 1) & 15, dir = job & 1;
    const int tid = k.tid;
    const bf16* R = (const bf16*)(k.ws + RW_R); const bf16* KS = (const bf16*)(k.ws + RW_KS); const bf16* V = (const bf16*)(k.ws + RW_V); const bf16* KK = (const bf16*)(k.ws + RW_KK);
    const bf16* LO = (const bf16*)(k.ws + RW_LO); bf16* Y = (bf16*)(k.ws + yoff) + (size_t)dir * TA * RD;
    LAS float* buf = (LAS float*)k.lds;
    LAS f32x2* ypart = (LAS f32x2*)(buf + 2 * RS_BUF);
    const int st = tid >> 5, cp = tid & 31, ch = h * RHS + 2 * cp;
    const float ka0 = k_a[l * RD + ch], ka1 = k_a[l * RD + ch + 1];
    const int kq = tid & 15, rp = tid >> 4, v0 = rp * 2;
    f32x2 S00 = {0.f, 0.f}, S01 = {0.f, 0.f}, S10 = {0.f, 0.f}, S11 = {0.f, 0.f};
    RwkvStage sg;
#define RW_LOAD(chunk) do { const int row_ = rwkv_row(b, dir, (chunk) * RS_TOK + st); \
        sg.r = *(const unsigned*)(R + (size_t)row_ * RD + ch); sg.ks = *(const unsigned*)(KS + (size_t)row_ * RD + ch); \
        sg.v = *(const unsigned*)(V + (size_t)row_ * RD + ch); sg.kk = *(const unsigned*)(KK + (size_t)row_ * RD + ch); \
        sg.we = *(const unsigned*)(LO + (size_t)row_ * 4096 + dir * RD + ch); sg.a = *(const unsigned*)(LO + (size_t)row_ * 4096 + 2048 + dir * RD + ch); } while (0)
#define RW_WRITE(bi) do { LAS float* tb = buf + (bi) * RS_BUF + st * RS_TF + 2 * cp; \
        const float a0 = bflo(sg.a), a1 = bfhi(sg.a), kk0 = bflo(sg.kk), kk1 = bfhi(sg.kk), ks0 = bflo(sg.ks), ks1 = bfhi(sg.ks); \
        *(LAS f32x2*)(tb + 0) = (f32x2){kk0, kk1}; \
        *(LAS f32x2*)(tb + 64) = (f32x2){__expf(-bflo(sg.we)), __expf(-bfhi(sg.we))}; \
        *(LAS f32x2*)(tb + 128) = (f32x2){-kk0 * a0, -kk1 * a1}; \
        *(LAS f32x2*)(tb + 192) = (f32x2){ks0 * (1.0f + (a0 - 1.0f) * ka0), ks1 * (1.0f + (a1 - 1.0f) * ka1)}; \
        *(LAS f32x2*)(tb + 256) = (f32x2){bflo(sg.r), bfhi(sg.r)}; \
        *(LAS f32x2*)(tb + 320) = (f32x2){bflo(sg.v), bfhi(sg.v)}; } while (0)
    constexpr int NCHUNK = (CTXL + SEQ) / RS_TOK;
    RW_LOAD(0); RW_WRITE(0);
    __syncthreads();
    for (int c = 0; c < NCHUNK; ++c) {
        if (c + 1 < NCHUNK) RW_LOAD(c + 1);
        const LAS float* cb = buf + (c & 1) * RS_BUF; LAS f32x2* yb = ypart + (c & 1) * RS_TOK * 256 + rp * 8 + (((kq >> 1) ^ (rp >> 2)) & 7);
        {
            const LAS float* tk = cb + kq * 4; const LAS float* tv = cb + 320 + v0;
#define RW_LD(T, kk4, w4, n4, d4, r4, vv) f32x4 kk4 = *(const LAS f32x4*)(tk + (T) * RS_TF), w4 = *(const LAS f32x4*)(tk + (T) * RS_TF + 64), n4 = *(const LAS f32x4*)(tk + (T) * RS_TF + 128), \
                d4 = *(const LAS f32x4*)(tk + (T) * RS_TF + 192), r4 = *(const LAS f32x4*)(tk + (T) * RS_TF + 256); f32x2 vv = *(const LAS f32x2*)(tv + (T) * RS_TF)
#define RW_STEP(T, kk4, w4, n4, d4, r4, vv) do { \
                const f32x2 kka = {kk4.x, kk4.y}, kkb = {kk4.z, kk4.w}, wa = {w4.x, w4.y}, wb = {w4.z, w4.w}, na = {n4.x, n4.y}, nb = {n4.z, n4.w}, da = {d4.x, d4.y}, db = {d4.z, d4.w}, ra = {r4.x, r4.y}, rb = {r4.z, r4.w}; \
                f32x2 p0 = S00 * kka + S01 * kkb, p1 = S10 * kka + S11 * kkb; \
                const f32x2 u00 = S00 * wa + da * vv.x, u01 = S01 * wb + db * vv.x, u10 = S10 * wa + da * vv.y, u11 = S11 * wb + db * vv.y;     \
                const float sa0 = dpp_sum16(p0.x + p0.y), sa1 = dpp_sum16(p1.x + p1.y); \
                S00 = na * sa0 + u00; S01 = nb * sa0 + u01; S10 = na * sa1 + u10; S11 = nb * sa1 + u11; \
                p0 = S00 * ra + S01 * rb; p1 = S10 * ra + S11 * rb; \
                float y0 = p0.x + p0.y, y1 = p1.x + p1.y; \
                y0 += __builtin_bit_cast(float, __builtin_amdgcn_update_dpp(0, __builtin_bit_cast(int, y0), 0xB1, 0xF, 0xF, true)); \
                y1 += __builtin_bit_cast(float, __builtin_amdgcn_update_dpp(0, __builtin_bit_cast(int, y1), 0xB1, 0xF, 0xF, true)); \
                if ((kq & 1) == 0) yb[(T) * 256] = (f32x2){y0, y1}; } while (0)
            RW_LD(0, kkA, wA, nA, dA, rA, vA);
#pragma unroll
            for (int tau = 0; tau < RS_TOK; tau += 2) {
                RW_LD(tau + 1, kkB, wB, nB, dB, rB, vB);
                RW_STEP(tau, kkA, wA, nA, dA, rA, vA);
                if (tau + 2 < RS_TOK) { RW_LD(tau + 2, kkC, wC, nC, dC, rC, vC); kkA = kkC; wA = wC; nA = nC; dA = dC; rA = rC; vA = vC; }
                RW_STEP(tau + 1, kkB, wB, nB, dB, rB, vB);
            }
#undef RW_LD
#undef RW_STEP
        }
        if (c + 1 < NCHUNK) RW_WRITE((c + 1) & 1);
        __syncthreads();
        {
            const int row = rwkv_row(b, dir, c * RS_TOK + st);
            const LAS f32x2* yq = ypart + (c & 1) * RS_TOK * 256 + st * 256 + cp * 8;
            f32x2 acc = yq[(0 ^ (cp >> 2)) & 7];
#pragma unroll
            for (int j = 1; j < 8; ++j) acc += yq[(j ^ (cp >> 2)) & 7];
            *(unsigned*)(Y + (size_t)row * RD + ch) = pk2(acc.x, acc.y);
        }
    }
    __syncthreads();
}

constexpr int GP1 = 136, GP2 = 72;
constexpr int GL_QGS = 0, GL_KGS = GL_QGS + 64 * GP1 * 2, GL_STS = GL_KGS + 64 * GP1 * 2, GL_KET = GL_STS + 64 * GP1 * 2, GL_VT = GL_KET + 128 * GP2 * 2, GL_ATT = GL_VT + 64 * GP2 * 2,
              GL_DECS = GL_ATT + 64 * GP2 * 2, GL_LDS_END = GL_DECS + 512;
static_assert(GL_LDS_END <= 131072, "gla lds");
__device__ __forceinline__ bf16x8 ldfrag(const LAS bf16* base, int row, int pitch, int kofs) { return *(const LAS bf16x8*)(base + row * pitch + kofs); }
__device__ __forceinline__ int gla_prow(int b, int dir, int cp, int tau) {
    const bool lat = cp >= 4; const int q = lat ? cp - 4 : cp, ncn = lat ? 32 : 4, cn = dir ? ncn - 1 - q : q;
    return gla_row(lat, b, dir ? 64 * cn + 63 - tau : 64 * cn + tau);
}
__device__ __forceinline__ int gla_gch(int dir, int cp) { const bool lat = cp >= 4; const int q = lat ? cp - 4 : cp, ncn = lat ? 32 : 4, cn = dir ? ncn - 1 - q : q; return lat ? 4 + cn : cn; }
__device__ __forceinline__ bf16x8 ldfrag_sw(const LAS bf16* base, int row, int g) { return *(const LAS bf16x8*)(base + row * GP2 + ((g ^ ((row >> 3) & 7)) << 3)); }
__device__ __forceinline__ void ph_gla_scan(const KC& k, int job) {
    const int b = job >> 5, h = (job >> 3) & 3, dir = (job >> 2) & 1, dvq = job & 3;
    const int tid = k.tid, w = k.wave, lane = k.lane, q4 = lane >> 4, l15 = lane & 15;
    const bf16* QG = (const bf16*)(k.ws + GL_QG) + (size_t)dir * TA * GKD; const bf16* KG = (const bf16*)(k.ws + GL_KG) + (size_t)dir * TA * GKD;
    const bf16* KE = (const bf16*)(k.ws + GL_KE) + (size_t)dir * TA * GKD; const bf16* VS = (const bf16*)(k.ws + GL_VS);
    const float* DEC = (const float*)(k.ws + GL_DEC); bf16* O = (bf16*)(k.ws + GL_O) + (size_t)dir * TA * GVD;
    LAS bf16* QGs = (LAS bf16*)(k.lds + GL_QGS); LAS bf16* KGs = (LAS bf16*)(k.lds + GL_KGS); LAS bf16* STs = (LAS bf16*)(k.lds + GL_STS);
    LAS bf16* KEt = (LAS bf16*)(k.lds + GL_KET); LAS bf16* Vt = (LAS bf16*)(k.lds + GL_VT); LAS bf16* ATT = (LAS bf16*)(k.lds + GL_ATT); LAS float* decs = (LAS float*)(k.lds + GL_DECS);
    f32x4 accS[4];
#pragma unroll
    for (int t = 0; t < 4; ++t) accS[t] = (f32x4){0.f, 0.f, 0.f, 0.f};
    const int tw = w & 3, wh = w >> 2;
    u32x4 pq[2], pk[2], pe[2], pv; float pd = 0.f;
#define GLA_PREFETCH(CP) do { _Pragma("unroll") for (int i = 0; i < 2; ++i) { const int idx = tid + 512 * i, tau = idx >> 4, ck = idx & 15; \
            const size_t go = (size_t)gla_prow(b, dir, (CP), tau) * GKD + h * GDK + ck * 8; pq[i] = *(const u32x4*)(QG + go); pk[i] = *(const u32x4*)(KG + go); pe[i] = *(const u32x4*)(KE + go); } \
        pv = *(const u32x4*)(VS + (size_t)gla_prow(b, dir, (CP), tid >> 3) * GVD + h * GDV + dvq * 64 + (tid & 7) * 8); \
        if (tid < 128) pd = DEC[((size_t)(dir * 8 + b) * NCH + gla_gch(dir, (CP))) * GKD + h * GDK + tid]; } while (0)
    GLA_PREFETCH(0);
    for (int cp = 0; cp < NCH; ++cp) {
#define GROW(tau) gla_prow(b, dir, cp, (tau))
#pragma unroll
        for (int i = 0; i < 2; ++i) {
            const int idx = tid + 512 * i, tau = idx >> 4, ck = idx & 15;
            *(LAS u32x4*)(QGs + tau * GP1 + ck * 8) = pq[i];
            *(LAS u32x4*)(KGs + tau * GP1 + ck * 8) = pk[i];
            const unsigned kw[4] = {pe[i].x, pe[i].y, pe[i].z, pe[i].w};
#pragma unroll
            for (int e = 0; e < 4; ++e) { const int ts = tau ^ ((ck & 7) << 3); KEt[(ck * 8 + 2 * e) * GP2 + ts] = (bf16)(kw[e] & 0xffffu); KEt[(ck * 8 + 2 * e + 1) * GP2 + ts] = (bf16)(kw[e] >> 16); }
        }
        {
            const int tau = tid >> 3, ck = tid & 7;
            const unsigned vw[4] = {pv.x, pv.y, pv.z, pv.w};
#pragma unroll
            for (int e = 0; e < 4; ++e) { const int ts = tau ^ (ck << 3); Vt[(ck * 8 + 2 * e) * GP2 + ts] = (bf16)(vw[e] & 0xffffu); Vt[(ck * 8 + 2 * e + 1) * GP2 + ts] = (bf16)(vw[e] >> 16); }
        }
        if (tid < 128) decs[tid] = pd;
#pragma unroll
        for (int t = 0; t < 4; ++t) {
            const int dkt = wh * 4 + t;
#pragma unroll
            for (int r = 0; r < 4; ++r) STs[(16 * tw + 4 * q4 + r) * GP1 + 16 * dkt + l15] = (bf16)f2bf(accS[t][r]);
        }
        __syncthreads();
        if (cp + 1 < NCH) GLA_PREFETCH(cp + 1);
#pragma unroll
        for (int jj = 0; jj < 2; ++jj) {
            const int it = tw, jt = wh * 2 + jj;
            f32x4 acc = (f32x4){0.f, 0.f, 0.f, 0.f};
#pragma unroll
            for (int ks = 0; ks < 4; ++ks) acc = __builtin_amdgcn_mfma_f32_16x16x32_bf16(ldfrag(QGs, 16 * it + l15, GP1, 32 * ks + 8 * q4), ldfrag(KGs, 16 * jt + l15, GP1, 32 * ks + 8 * q4), acc, 0, 0, 0);
#pragma unroll
            for (int r = 0; r < 4; ++r) { const int i = 16 * it + 4 * q4 + r, j = 16 * jt + l15; ATT[i * GP2 + j] = (bf16)f2bf(j <= i ? acc[r] : 0.f); }
        }
        __syncthreads();
#pragma unroll
        for (int dd = 0; dd < 2; ++dd) {
            const int it = tw, dvt = wh * 2 + dd;
            f32x4 acc = (f32x4){0.f, 0.f, 0.f, 0.f};
#pragma unroll
            for (int ks = 0; ks < 4; ++ks) acc = __builtin_amdgcn_mfma_f32_16x16x32_bf16(ldfrag(QGs, 16 * it + l15, GP1, 32 * ks + 8 * q4), ldfrag(STs, 16 * dvt + l15, GP1, 32 * ks + 8 * q4), acc, 0, 0, 0);
#pragma unroll
            for (int ks = 0; ks < 2; ++ks) acc = __builtin_amdgcn_mfma_f32_16x16x32_bf16(ldfrag(ATT, 16 * it + l15, GP2, 32 * ks + 8 * q4), ldfrag_sw(Vt, 16 * dvt + l15, 4 * ks + q4), acc, 0, 0, 0);
#pragma unroll
            for (int r = 0; r < 4; ++r) { const int i = 16 * it + 4 * q4 + r; O[(size_t)GROW(i) * GVD + h * GDV + dvq * 64 + 16 * dvt + l15] = (bf16)f2bf(acc[r]); }
        }
#pragma unroll
        for (int t = 0; t < 4; ++t) {
            const int dkt = wh * 4 + t; const float d = decs[16 * dkt + l15];
            accS[t] = accS[t] * d;
#pragma unroll
            for (int ks = 0; ks < 2; ++ks) accS[t] = __builtin_amdgcn_mfma_f32_16x16x32_bf16(ldfrag_sw(Vt, 16 * tw + l15, 4 * ks + q4), ldfrag_sw(KEt, 16 * dkt + l15, 4 * ks + q4), accS[t], 0, 0, 0);
        }
        __syncthreads();
#undef GROW
    }
#undef GLA_PREFETCH
}

#ifndef HB_FULL
#define HB_FULL 0
#endif
#ifndef GLA4_LEVEL
#define GLA4_LEVEL 0
#endif
#ifndef GLA4_NOSTORE
#define GLA4_NOSTORE 0
#endif
#ifndef SWAP_HALVES
#define SWAP_HALVES 0
#endif
#ifndef SPLIT_SCAN
#define SPLIT_SCAN 0
#endif
constexpr int RS4_TOK = 8, RS4_BUF = RS4_TOK * RS_TF;
constexpr int SC_GL = 0;
constexpr int SC_RW = 96 * 1024;
constexpr int SC_END = SC_RW + 2 * RS4_BUF * 4 + 2 * RS4_TOK * 64 * 4;
static_assert(SC_GL + GL_LDS_END <= SC_RW, "scan lds halves");
constexpr int SC_CTR = 127 * 1024;
static_assert(SC_END <= SC_CTR && SC_CTR + 128 <= 131072, "scan lds");
__device__ __forceinline__ void half_bar(LAS unsigned* ctr, unsigned& gen, int lane) {
#if HB_FULL
    (void)ctr; (void)lane; gen += 4u; __syncthreads(); return;
#endif
    gen += 4u;
    __builtin_amdgcn_fence(__ATOMIC_RELEASE, "workgroup");
    if (lane == 0) __hip_atomic_fetch_add(ctr, 1u, __ATOMIC_RELAXED, __HIP_MEMORY_SCOPE_WORKGROUP);
    unsigned spins = 0;
    while (__hip_atomic_load(ctr, __ATOMIC_RELAXED, __HIP_MEMORY_SCOPE_WORKGROUP) < gen) { __builtin_amdgcn_s_sleep(1); if (++spins > (1u << 26)) break; }
    __builtin_amdgcn_fence(__ATOMIC_ACQUIRE, "workgroup");
}
#ifndef RW4_SHFL
#define RW4_SHFL 0
#endif
__device__ __forceinline__ float shfl_sum16(float x) { x += __shfl_xor(x, 1); x += __shfl_xor(x, 2); x += __shfl_xor(x, 4); x += __shfl_xor(x, 8); return x; }
#if RW4_SHFL
#define RW4_SUM16(x) shfl_sum16(x)
#else
#define RW4_SUM16(x) dpp_sum16(x)
#endif
__device__ __forceinline__ void rwkv_scan_4w(const KC& k, int l, int job, const float* k_a, LAS unsigned* ctr) {
    const int b = job >> 5, h = (job >> 1) & 15, dir = job & 1;
    const int tid = k.tid, lane = k.lane;
    const bf16* R = (const bf16*)(k.ws + RW_R); const bf16* KS = (const bf16*)(k.ws + RW_KS); const bf16* V = (const bf16*)(k.ws + RW_V); const bf16* KK = (const bf16*)(k.ws + RW_KK);
    const bf16* LO = (const bf16*)(k.ws + RW_LO); bf16* Y = (bf16*)(k.ws + RW_Y) + (size_t)dir * TA * RD;
    LAS float* buf = (LAS float*)(k.lds + SC_RW);
    LAS float* ybuf = buf + 2 * RS4_BUF;
    const int st = tid >> 5, cp = tid & 31, ch = h * RHS + 2 * cp;
    const float ka0 = k_a[l * RD + ch], ka1 = k_a[l * RD + ch + 1];
    const int kq = tid & 15, v0 = (tid >> 4) * 4;
    f32x2 S[4][2];
#pragma unroll
    for (int i = 0; i < 4; ++i) { S[i][0] = (f32x2){0.f, 0.f}; S[i][1] = (f32x2){0.f, 0.f}; }
    RwkvStage sg[1];
    unsigned gen = 0;
#define RW4_LOAD(chunk) do { _Pragma("unroll") for (int q_ = 0; q_ < 1; ++q_) { const int row_ = rwkv_row(b, dir, (chunk) * RS4_TOK + st); \
        sg[q_].r = *(const unsigned*)(R + (size_t)row_ * RD + ch); sg[q_].ks = *(const unsigned*)(KS + (size_t)row_ * RD + ch); \
        sg[q_].v = *(const unsigned*)(V + (size_t)row_ * RD + ch); sg[q_].kk = *(const unsigned*)(KK + (size_t)row_ * RD + ch); \
        sg[q_].we = *(const unsigned*)(LO + (size_t)row_ * 4096 + dir * RD + ch); sg[q_].a = *(const unsigned*)(LO + (size_t)row_ * 4096 + 2048 + dir * RD + ch); } } while (0)
#define RW4_WRITE(bi) do { _Pragma("unroll") for (int q_ = 0; q_ < 1; ++q_) { LAS float* tb = buf + (bi) * RS4_BUF + st * RS_TF + 2 * cp; \
        const float a0 = bflo(sg[q_].a), a1 = bfhi(sg[q_].a), kk0 = bflo(sg[q_].kk), kk1 = bfhi(sg[q_].kk), ks0 = bflo(sg[q_].ks), ks1 = bfhi(sg[q_].ks); \
        *(LAS f32x2*)(tb + 0) = (f32x2){kk0, kk1}; \
        *(LAS f32x2*)(tb + 64) = (f32x2){__expf(-bflo(sg[q_].we)), __expf(-bfhi(sg[q_].we))}; \
        *(LAS f32x2*)(tb + 128) = (f32x2){-kk0 * a0, -kk1 * a1}; \
        *(LAS f32x2*)(tb + 192) = (f32x2){ks0 * (1.0f + (a0 - 1.0f) * ka0), ks1 * (1.0f + (a1 - 1.0f) * ka1)}; \
        *(LAS f32x2*)(tb + 256) = (f32x2){bflo(sg[q_].r), bfhi(sg[q_].r)}; \
        *(LAS f32x2*)(tb + 320) = (f32x2){bflo(sg[q_].v), bfhi(sg[q_].v)}; } } while (0)
    constexpr int NCHUNK = (CTXL + SEQ) / RS4_TOK;
    RW4_LOAD(0); RW4_WRITE(0);
    half_bar(ctr, gen, lane);
    for (int c = 0; c < NCHUNK; ++c) {
        if (c + 1 < NCHUNK) RW4_LOAD(c + 1);
        const LAS float* cb = buf + (c & 1) * RS4_BUF; LAS float* yb = ybuf + (c & 1) * RS4_TOK * 64;
        {
            const LAS float* tk = cb + kq * 4; const LAS float* tv = cb + 320 + v0;
#define RW4_LD(T, kk4, w4, n4, d4, r4, vv) f32x4 kk4 = *(const LAS f32x4*)(tk + (T) * RS_TF), w4 = *(const LAS f32x4*)(tk + (T) * RS_TF + 64), n4 = *(const LAS f32x4*)(tk + (T) * RS_TF + 128), \
                d4 = *(const LAS f32x4*)(tk + (T) * RS_TF + 192), r4 = *(const LAS f32x4*)(tk + (T) * RS_TF + 256), vv = *(const LAS f32x4*)(tv + (T) * RS_TF)
#define RW4_STEP(T, kk4, w4, n4, d4, r4, vv) do { \
                const f32x2 kka = {kk4.x, kk4.y}, kkb = {kk4.z, kk4.w}, wa = {w4.x, w4.y}, wb = {w4.z, w4.w}, na = {n4.x, n4.y}, nb = {n4.z, n4.w}, da = {d4.x, d4.y}, db = {d4.z, d4.w}, ra = {r4.x, r4.y}, rb = {r4.z, r4.w}; \
                float sa[4], yy[4]; f32x2 u0[4], u1[4]; \
                _Pragma("unroll") for (int i = 0; i < 4; ++i) { const f32x2 p = S[i][0] * kka + S[i][1] * kkb; sa[i] = p.x + p.y; u0[i] = S[i][0] * wa + da * vv[i]; u1[i] = S[i][1] * wb + db * vv[i]; } \
                _Pragma("unroll") for (int i = 0; i < 4; ++i) sa[i] = RW4_SUM16(sa[i]); \
                _Pragma("unroll") for (int i = 0; i < 4; ++i) { S[i][0] = na * sa[i] + u0[i]; S[i][1] = nb * sa[i] + u1[i]; const f32x2 q = S[i][0] * ra + S[i][1] * rb; yy[i] = q.x + q.y; } \
                _Pragma("unroll") for (int i = 0; i < 4; ++i) yy[i] = RW4_SUM16(yy[i]); \
                if (kq == 0) *(LAS f32x4*)(yb + (T) * 64 + v0) = (f32x4){yy[0], yy[1], yy[2], yy[3]}; } while (0)
            RW4_LD(0, kkA, wA, nA, dA, rA, vA);
#pragma unroll
            for (int tau = 0; tau < RS4_TOK; tau += 2) {
                RW4_LD(tau + 1, kkB, wB, nB, dB, rB, vB);
                RW4_STEP(tau, kkA, wA, nA, dA, rA, vA);
                if (tau + 2 < RS4_TOK) { RW4_LD(tau + 2, kkC, wC, nC, dC, rC, vC); kkA = kkC; wA = wC; nA = nC; dA = dC; rA = rC; vA = vC; }
                RW4_STEP(tau + 1, kkB, wB, nB, dB, rB, vB);
            }
#undef RW4_LD
#undef RW4_STEP
        }
        if (c + 1 < NCHUNK) RW4_WRITE((c + 1) & 1);
        half_bar(ctr, gen, lane);
        {
            const int row = rwkv_row(b, dir, c * RS4_TOK + st);
            const f32x2 yy = *(const LAS f32x2*)(yb + st * 64 + 2 * cp);
            *(unsigned*)(Y + (size_t)row * RD + ch) = pk2(yy.x, yy.y);
        }
    }
#undef RW4_LOAD
#undef RW4_WRITE
}
__device__ __forceinline__ void gla_scan_4w(const KC& k, int job, LAS unsigned* ctr) {
    const int b = job >> 5, h = (job >> 3) & 3, dir = (job >> 2) & 1, dvq = job & 3;
    const int tid = k.tid - 256, w = k.wave - 4, lane = k.lane, q4 = lane >> 4, l15 = lane & 15;
    const bf16* QG = (const bf16*)(k.ws + GL_QG) + (size_t)dir * TA * GKD; const bf16* KG = (const bf16*)(k.ws + GL_KG) + (size_t)dir * TA * GKD;
    const bf16* KE = (const bf16*)(k.ws + GL_KE) + (size_t)dir * TA * GKD; const bf16* VS = (const bf16*)(k.ws + GL_VS);
    const float* DEC = (const float*)(k.ws + GL_DEC); bf16* O = (bf16*)(k.ws + GL_O) + (size_t)dir * TA * GVD;
    LAS unsigned char* gl = k.lds + SC_GL;
    LAS bf16* QGs = (LAS bf16*)(gl + GL_QGS); LAS bf16* KGs = (LAS bf16*)(gl + GL_KGS); LAS bf16* STs = (LAS bf16*)(gl + GL_STS);
    LAS bf16* KEt = (LAS bf16*)(gl + GL_KET); LAS bf16* Vt = (LAS bf16*)(gl + GL_VT); LAS bf16* ATT = (LAS bf16*)(gl + GL_ATT); LAS float* decs = (LAS float*)(gl + GL_DECS);
    f32x4 accS[8];
#pragma unroll
    for (int t = 0; t < 8; ++t) accS[t] = (f32x4){0.f, 0.f, 0.f, 0.f};
    unsigned gen = 0;
#if GLA4_LEVEL == 2
    { float x = (float)lane; for (int i = 0; i < 200000; ++i) { x = x * 1.0001f + 0.5f; asm volatile("" : "+v"(x)); } asm volatile("" :: "v"(x)); (void)ctr; (void)gen; }
    return;
#endif
#if GLA4_LEVEL == 1
    for (int cp = 0; cp < NCH; ++cp) { float x = (float)lane; for (int i = 0; i < 2000; ++i) x = x * 1.0001f + 0.5f; asm volatile("" :: "v"(x)); half_bar(ctr, gen, lane); half_bar(ctr, gen, lane); half_bar(ctr, gen, lane); }
    return;
#endif
    for (int cp = 0; cp < NCH; ++cp) {
        const bool lat = cp >= 4; const int q = lat ? cp - 4 : cp, ncn = lat ? 32 : 4, cn = dir ? ncn - 1 - q : q, gch = lat ? 4 + cn : cn;
#define GROW(tau) gla_row(lat, b, dir ? 64 * cn + 63 - (tau) : 64 * cn + (tau))
#pragma unroll
        for (int i = 0; i < 4; ++i) {
            const int idx = tid + 256 * i, tau = idx >> 4, ck = idx & 15; const size_t go = (size_t)GROW(tau) * GKD + h * GDK + ck * 8;
            *(LAS u32x4*)(QGs + tau * GP1 + ck * 8) = *(const u32x4*)(QG + go);
            *(LAS u32x4*)(KGs + tau * GP1 + ck * 8) = *(const u32x4*)(KG + go);
            const u32x4 ke = *(const u32x4*)(KE + go);
            const unsigned kw[4] = {ke.x, ke.y, ke.z, ke.w};
#pragma unroll
            for (int e = 0; e < 4; ++e) { KEt[(ck * 8 + 2 * e) * GP2 + tau] = (bf16)(kw[e] & 0xffffu); KEt[(ck * 8 + 2 * e + 1) * GP2 + tau] = (bf16)(kw[e] >> 16); }
        }
#pragma unroll
        for (int i = 0; i < 2; ++i) {
            const int idx = tid + 256 * i, tau = idx >> 3, ck = idx & 7;
            const u32x4 vv = *(const u32x4*)(VS + (size_t)GROW(tau) * GVD + h * GDV + dvq * 64 + ck * 8);
            const unsigned vw[4] = {vv.x, vv.y, vv.z, vv.w};
#pragma unroll
            for (int e = 0; e < 4; ++e) { Vt[(ck * 8 + 2 * e) * GP2 + tau] = (bf16)(vw[e] & 0xffffu); Vt[(ck * 8 + 2 * e + 1) * GP2 + tau] = (bf16)(vw[e] >> 16); }
        }
        if (tid < 128) decs[tid] = DEC[((size_t)(dir * 8 + b) * NCH + gch) * GKD + h * GDK + tid];
#pragma unroll
        for (int t = 0; t < 8; ++t) {
#pragma unroll
            for (int r = 0; r < 4; ++r) STs[(16 * w + 4 * q4 + r) * GP1 + 16 * t + l15] = (bf16)f2bf(accS[t][r]);
        }
        half_bar(ctr, gen, lane);
#pragma unroll
        for (int jt = 0; jt < 4; ++jt) {
            f32x4 acc = (f32x4){0.f, 0.f, 0.f, 0.f};
#pragma unroll
            for (int ks = 0; ks < 4; ++ks) acc = __builtin_amdgcn_mfma_f32_16x16x32_bf16(ldfrag(QGs, 16 * w + l15, GP1, 32 * ks + 8 * q4), ldfrag(KGs, 16 * jt + l15, GP1, 32 * ks + 8 * q4), acc, 0, 0, 0);
#pragma unroll
            for (int r = 0; r < 4; ++r) { const int i = 16 * w + 4 * q4 + r, j = 16 * jt + l15; ATT[i * GP2 + j] = (bf16)f2bf(j <= i ? acc[r] : 0.f); }
        }
        half_bar(ctr, gen, lane);
#pragma unroll
        for (int dvt = 0; dvt < 4; ++dvt) {
            f32x4 acc = (f32x4){0.f, 0.f, 0.f, 0.f};
#pragma unroll
            for (int ks = 0; ks < 4; ++ks) acc = __builtin_amdgcn_mfma_f32_16x16x32_bf16(ldfrag(QGs, 16 * w + l15, GP1, 32 * ks + 8 * q4), ldfrag(STs, 16 * dvt + l15, GP1, 32 * ks + 8 * q4), acc, 0, 0, 0);
#pragma unroll
            for (int ks = 0; ks < 2; ++ks) acc = __builtin_amdgcn_mfma_f32_16x16x32_bf16(ldfrag(ATT, 16 * w + l15, GP2, 32 * ks + 8 * q4), ldfrag(Vt, 16 * dvt + l15, GP2, 32 * ks + 8 * q4), acc, 0, 0, 0);
#pragma unroll
#if GLA4_NOSTORE
            asm volatile("" :: "v"(acc[0]), "v"(acc[1]), "v"(acc[2]), "v"(acc[3]));
#else
            for (int r = 0; r < 4; ++r) { const int i = 16 * w + 4 * q4 + r; O[(size_t)GROW(i) * GVD + h * GDV + dvq * 64 + 16 * dvt + l15] = (bf16)f2bf(acc[r]); }
#endif
        }
#pragma unroll
        for (int t = 0; t < 8; ++t) {
            const float d = decs[16 * t + l15];
            accS[t] = accS[t] * d;
#pragma unroll
            for (int ks = 0; ks < 2; ++ks) accS[t] = __builtin_amdgcn_mfma_f32_16x16x32_bf16(ldfrag(Vt, 16 * w + l15, GP2, 32 * ks + 8 * q4), ldfrag(KEt, 16 * t + l15, GP2, 32 * ks + 8 * q4), accS[t], 0, 0, 0);
        }
        half_bar(ctr, gen, lane);
#undef GROW
    }
#if HB_FULL
    for (int i = 0; i < (1 + (CTXL + SEQ) / RS4_TOK) - 3 * NCH; ++i) __syncthreads();
#endif
}
__device__ __forceinline__ void ph_scan_split(const KC& k, int l, const float* k_a) {
    LAS unsigned* ctr = (LAS unsigned*)(k.lds + SC_CTR);
    for (int job = k.bid; job < 256; job += k.G) {
        if (k.tid == 0) { ctr[0] = 0u; ctr[16] = 0u; }
        __syncthreads();
#if SPLIT_SCAN == 1 || SPLIT_SCAN == 4 || SPLIT_SCAN == 5 || SPLIT_SCAN == 6
#if SWAP_HALVES
        { KC k2 = k; if (k.wave >= 4) { k2.tid = k.tid - 256; k2.wave = k.wave - 4; rwkv_scan_4w(k2, l, job, k_a, ctr); } else { k2.tid = k.tid + 256; k2.wave = k.wave + 4; gla_scan_4w(k2, job, ctr + 16); } }
#else
        if (k.wave < 4) rwkv_scan_4w(k, l, job, k_a, ctr); else gla_scan_4w(k, job, ctr + 16);
#endif
        __syncthreads();
#if SPLIT_SCAN == 6
        ph_rwkv_scan(k, l, job, k_a, WS_H);
#elif SPLIT_SCAN == 4
        ph_rwkv_scan(k, l, job, k_a);
#elif SPLIT_SCAN == 5
        ph_gla_scan(k, job);
#endif
#elif SPLIT_SCAN == 2
        if (k.wave < 4) rwkv_scan_4w(k, l, job, k_a, ctr);
        __syncthreads();
        ph_gla_scan(k, job);
#else
        if (k.wave >= 4) gla_scan_4w(k, job, ctr + 16);
        __syncthreads();
        ph_rwkv_scan(k, l, job, k_a);
#endif
    }
}

__device__ __forceinline__ void ph_post(const KC& k, int l, int nrows, const float* ln_g, const float* ln_b, const float* gng) {
    const int gw = k.bid * 8 + k.wave, NGW = k.G * 8, lane = k.lane, c = 16 * lane;
    const bf16* P = (const bf16*)(k.ws + WS_P);
    const bf16* Y = (const bf16*)(k.ws + RW_Y); const bf16* V = (const bf16*)(k.ws + RW_V); const float* BON = (const float*)(k.ws + RW_BON); bf16* YNB = (bf16*)(k.ws + RW_R);
    const bf16* O = (const bf16*)(k.ws + GL_O); bf16* YB = (bf16*)(k.ws + GL_VS);
    for (int row = gw; row < nrows; row += NGW) {
        {
            float yf[16], yb[16], vv[16], y[16];
            ld16(Y + (size_t)row * RD + c, true, yf); ld16(Y + ((size_t)TA + row) * RD + c, true, yb); ld16(V + (size_t)row * RD + c, true, vv);
            float s = 0.f;
#pragma unroll
            for (int i = 0; i < 16; ++i) { y[i] = yf[i] + yb[i]; s += y[i]; }
            s += __shfl_xor(s, 1); s += __shfl_xor(s, 2);
            const float mean = s * (1.0f / 64.0f); float q = 0.f;
#pragma unroll
            for (int i = 0; i < 16; ++i) { y[i] -= mean; q += y[i] * y[i]; }
            q += __shfl_xor(q, 1); q += __shfl_xor(q, 2);
            const float rstd = 1.0f / sqrtf(q * (1.0f / 64.0f) + 64e-5f), bon = BON[(size_t)row * RHEADS + (lane >> 2)];
#pragma unroll
            for (int i = 0; i < 16; ++i) y[i] = y[i] * rstd * ln_g[l * RD + c + i] + ln_b[l * RD + c + i] + bon * vv[i];
            st16(YNB + (size_t)row * RD + c, y);
        }
        {
            float of[16], ob[16], gt[16], o[16];
            ld16(O + (size_t)row * GVD + c, true, of); ld16(O + ((size_t)TA + row) * GVD + c, true, ob); ld16(P + (size_t)row * NP + GLA_GATE_OFF + c, true, gt);
            float s = 0.f;
#pragma unroll
            for (int i = 0; i < 16; ++i) { o[i] = of[i] + ob[i]; s += o[i] * o[i]; }
            s += __shfl_xor(s, 1); s += __shfl_xor(s, 2); s += __shfl_xor(s, 4); s += __shfl_xor(s, 8);
            const float rinv = 1.0f / sqrtf(s * (1.0f / 256.0f) + 1e-6f);
#pragma unroll
            for (int i = 0; i < 16; ++i) o[i] = o[i] * rinv * gng[l * GDV + ((c + i) & 255)] * siluf(gt[i]);
            st16(YB + (size_t)row * GVD + c, o);
        }
    }
}
using pg8::Unit;
struct FP_ { bf16* P; __device__ __forceinline__ void operator()(int row, int col, float (&v)[8], const Unit&) const { *(u32x4*)(P + (size_t)row * NP + col) = pack8(v); } };
struct FL1_ { bf16* LO; const float* bias1;
    __device__ __forceinline__ void operator()(int row, int col, float (&v)[8], const Unit& u) const {
        const float* bias = bias1 + col;
        const f32x4 b0 = *(const f32x4*)bias, b1 = *(const f32x4*)(bias + 4);
        const float bb[8] = {b0.x, b0.y, b0.z, b0.w, b1.x, b1.y, b1.z, b1.w};
        const float sc = col < 2048 ? 0.6065306597126334f : 1.0f;
#pragma unroll
        for (int i = 0; i < 8; ++i) v[i] = sigm(bb[i] + v[i]) * sc;
        *(u32x4*)(LO + (size_t)row * 4096 + col) = pack8(v);
    } };
struct FL2_ { const bf16* YNB; bf16* YA;
    __device__ __forceinline__ void operator()(int row, int col, float (&v)[8], const Unit&) const {
        float y[8]; unpack8(*(const u32x4*)(YNB + (size_t)row * RD + col), y);
#pragma unroll
        for (int i = 0; i < 8; ++i) v[i] *= y[i];
        *(u32x4*)(YA + (size_t)row * RD + col) = pack8(v);
    } };
template <int SECOND> struct FM_ { const bf16* P; bf16* MA;
    __device__ __forceinline__ void operator()(int row, int col, float (&v)[8], const Unit&) const {
        float g[8]; unpack8(*(const u32x4*)(P + (size_t)row * NP + BR_OFF + SECOND * DM + col), g);
        bf16* mp = MA + (size_t)row * DM + col;
        if (SECOND) { float m[8]; unpack8(*(const u32x4*)mp, m);
#pragma unroll
            for (int i = 0; i < 8; ++i) v[i] = sigm(g[i]) * v[i] + m[i]; }
        else {
#pragma unroll
            for (int i = 0; i < 8; ++i) v[i] = sigm(g[i]) * v[i]; }
        *(u32x4*)mp = pack8(v);
    } };
struct FX_ { float* X; const float* MOD; int l;
    __device__ __forceinline__ void operator()(int row, int col, const f32x4 v, const Unit&) const {
        const f32x4 g = *(const f32x4*)(MOD + ((size_t)l * 9 + mod_row(row)) * MOD_N + 2 * DM + col);
        f32x4* xp = (f32x4*)(X + (size_t)row * DM + col);
        *xp = *xp + g * v;
    } };
struct FE1_ { bf16* ACT;
    __device__ __forceinline__ void operator()(int row, int col, float (&g)[8], float (&up)[8]) const {
#pragma unroll
        for (int i = 0; i < 8; ++i) g[i] = siluf(g[i]) * up[i];
        *(u32x4*)(ACT + (size_t)row * DEXP + col) = pack8(g);
    } };
struct FE2_ { const int* rowtok; const float* roww; bf16* YF;
    __device__ __forceinline__ void operator()(int row, int col, float (&v)[8], const Unit&) const {
        const int t2 = rowtok[row];
        if (t2 >= 0) { const float w = roww[row];
#pragma unroll
            for (int i = 0; i < 8; ++i) v[i] *= w;
            *(u32x4*)(YF + ((size_t)(t2 & 1) * TA + (t2 >> 1)) * DM + col) = pack8(v); }
    } };

#ifndef GA_
#define GA_ true
#endif
#ifndef GS_
#define GS_ true
#endif
constexpr int LDS_BYTES = 147456;
constexpr int MISC_OFF = 131072 + 4096;

constexpr int NPHASE = 2 + 14 * DEPTH + 1;
struct Args { const float* in[N_IN]; float* out; unsigned char* ws; int ph_lo, ph_hi; };
static_assert(sizeof(Args) == N_IN * 8 + 8 + 8 + 8, "Args has no padding");

__global__ void __launch_bounds__(512, 2) fwd(Args a) {
    extern __shared__ __attribute__((aligned(16))) unsigned char lds_raw[];
    KC k;
    k.lds = (LAS unsigned char*)lds_raw; k.ws = (unsigned char*)INP(N_IN + 1);
    k.tid = threadIdx.x; k.lane = k.tid & 63; k.wave = __builtin_amdgcn_readfirstlane(k.tid >> 6); k.G = gridDim.x; k.bid = blockIdx.x;
    const int lo = a.ph_lo, hi = a.ph_hi;
    volatile LAS unsigned* MISC = (volatile LAS unsigned*)(k.lds + MISC_OFF);
    if (k.tid < 32) MISC[k.tid] = 0u;
    __syncthreads();
    XcdBarrier bar; bar.bar = (unsigned*)(k.ws + WS_CTL) + CW_BAR; bar.x = 0; bar.st = nullptr;
    if (hi - lo > 1) bar = xcd_barrier_post((unsigned*)(k.ws + WS_CTL) + CW_BAR, MISC + 8);
#ifndef SITE_MASK
#define SITE_MASK 0xFFFFFFFFu
#endif
#define FRESH() do { int t_ = threadIdx.x; asm volatile("" : "+v"(t_)); k.tid = t_; k.lane = t_ & 63; k.wave = __builtin_amdgcn_readfirstlane(t_ >> 6); k.ws = (unsigned char*)INP(N_IN + 1); ws = k.ws; } while (0)
#define PH_BEGIN(p, site) if (((SITE_MASK >> (site)) & 1u) && lo <= (p) && (p) < hi) { FRESH();
#ifndef EXTRA_BARS
#define EXTRA_BARS 0
#endif
#ifndef DUP_MASK
#define DUP_MASK 0u
#endif
#define DUPRUN(n, stmt) do { stmt; if ((DUP_MASK >> (n)) & 1u) { __syncthreads(); stmt; } } while (0)
#define PH_END(p) if ((p) + 1 < hi) xcd_barrier(bar); }
    unsigned char* ws = k.ws;
    LAS unsigned char* glds = k.lds;
#define WSRC WSrc{INP(I_WIN), INP(I_W2), INP(I_A2), INP(I_G2), INP(I_WBA), INP(I_WBB), INP(I_WOUT), INP(I_EG), INP(I_EU), INP(I_ED), INP(I_W0), INP(I_A0)}

    PH_BEGIN(0, 0) DUPRUN(0, ph_adaln_partials(k, INP(I_C), INP(I_CCTX), INP(I_WADA))); DUPRUN(1, ph_convert(k, WSRC, 0)); PH_END(0)
    PH_BEGIN(1, 1) ph_adaln_reduce(k, INP(I_BADA)); PH_END(1)

#define L_ 0
    {
        constexpr int l = L_;
        const int pb = 2 + 14 * l;
        const bool last = (l == DEPTH - 1);
        const int Mpost = last ? TL : TA;
        PH_BEGIN(pb + 0, 2)
            if (l > 0) { DUPRUN(1, ph_convert(k, WSRC, l)); }
            RowArgs ra{INP(I_X), INP(I_CTX), INP(I_NMG), nullptr, nullptr, nullptr};
            ph_rows<0>(k, ra, l, TA);
            if (l == 0 && ((DUP_MASK >> 15) & 1u)) { __syncthreads(); ph_rows<0>(k, ra, l, TA); }
        PH_END(pb + 0)
        PH_BEGIN(pb + 1, 3)
            pg8::Gemm g{(const bf16*)(ws + WS_H), (const bf16*)(ws + WT_IN), TA, NP, DM, 0}; pg8::StaticOrder S; S.init(TA, NP, k.G, k.bid);
            pg8::Epi8<FP_> E{FP_{(bf16*)(ws + WS_P)}};
            DUPRUN(2, (pg8::gemm_phase<pg8::Epi8<FP_>, pg8::StaticOrder, GA_, GS_>(glds, g, S, E)));
        PH_END(pb + 1)
        PH_BEGIN(pb + 2, 4)
            DUPRUN(3, ph_rwkv_prep(k, l, TA, INP(I_MU), INP(I_KK), INP(I_RK)));
            DUPRUN(4, ph_gla_prep(k, l, INP(I_GCONV), INP(I_GAW2), INP(I_GAB)));
        PH_END(pb + 2)
        PH_BEGIN(pb + 3, 5)
            pg8::Gemm g{(const bf16*)(ws + RW_A1), (const bf16*)(ws + WT_L1), TA, 4096, 256, 0}; pg8::StaticOrder S; S.init(TA, 4096, k.G, k.bid);
            pg8::Epi8<FL1_> E{FL1_{(bf16*)(ws + RW_LO), (const float*)(ws + WS_TAB + TAB_TOP)}};
            DUPRUN(5, (pg8::gemm_phase<pg8::Epi8<FL1_>, pg8::StaticOrder, GA_, GS_>(glds, g, S, E)));
        PH_END(pb + 3)
        PH_BEGIN(pb + 4, 6)
#if SPLIT_SCAN
            DUPRUN(6, ph_scan_split(k, l, INP(I_KA)));
#else
            for (int job = k.bid; job < 256; job += k.G) { DUPRUN(6, ph_rwkv_scan(k, l, job, INP(I_KA))); DUPRUN(7, ph_gla_scan(k, job)); }
#endif
        PH_END(pb + 4)
        PH_BEGIN(pb + 5, 7)
            DUPRUN(8, ph_post(k, l, Mpost, INP(I_LNG), INP(I_LNB), INP(I_GNG)));
        PH_END(pb + 5)
        PH_BEGIN(pb + 6, 8)
            pg8::Gemm g{(const bf16*)(ws + RW_A2), (const bf16*)(ws + WT_G2), Mpost, RD, 256, 0}; pg8::StaticOrder S; S.init(Mpost, RD, k.G, k.bid);
            pg8::Epi8<FL2_> E{FL2_{(const bf16*)(ws + RW_R), (bf16*)(ws + RW_V)}};
            DUPRUN(9, (pg8::gemm_phase<pg8::Epi8<FL2_>, pg8::StaticOrder, GA_, GS_>(glds, g, S, E)));
        PH_END(pb + 6)
        PH_BEGIN(pb + 7, 9)
            pg8::Gemm g{(const bf16*)(ws + RW_V), (const bf16*)(ws + WT_A), Mpost, DM, RD, 0}; pg8::StaticOrder S; S.init(Mpost, DM, k.G, k.bid);
            pg8::Epi8<FM_<0>> E{FM_<0>{(const bf16*)(ws + WS_P), (bf16*)(ws + WS_H)}};
            DUPRUN(10, (pg8::gemm_phase<pg8::Epi8<FM_<0>>, pg8::StaticOrder, GA_, GS_>(glds, g, S, E)));
        PH_END(pb + 7)
        PH_BEGIN(pb + 8, 10)
            pg8::Gemm g{(const bf16*)(ws + GL_VS), (const bf16*)(ws + WT_B), Mpost, DM, GVD, 0}; pg8::StaticOrder S; S.init(Mpost, DM, k.G, k.bid);
            pg8::Epi8<FM_<1>> E{FM_<1>{(const bf16*)(ws + WS_P), (bf16*)(ws + WS_H)}};
            pg8::gemm_phase<pg8::Epi8<FM_<1>>, pg8::StaticOrder, GA_, GS_>(glds, g, S, E);
        PH_END(pb + 8)
        PH_BEGIN(pb + 9, 11)
            pg8::Gemm g{(const bf16*)(ws + WS_H), (const bf16*)(ws + WT_O), Mpost, DM, DM, 0}; pg8::StaticOrder S; S.init(Mpost, DM, k.G, k.bid);
            pg8::Epi4<FX_> E{FX_{(float*)(ws + WS_X), (const float*)(ws + WS_MOD), l}};
            pg8::gemm_phase<pg8::Epi4<FX_>, pg8::StaticOrder, GA_, GS_>(glds, g, S, E);
        PH_END(pb + 9)
        PH_BEGIN(pb + 10, 12)
            RowArgs ra{nullptr, nullptr, INP(I_NFG), INP(I_RW), INP(I_RB), nullptr};
            ph_rows<1>(k, ra, l, Mpost);
            if ((DUP_MASK >> 16) & 1u) { __syncthreads(); ph_rows<1>(k, ra, l, Mpost, true); }
        PH_END(pb + 10)
        PH_BEGIN(pb + 11, 13)
            DUPRUN(13, ph_moe_scatter(k, l, Mpost));
        PH_END(pb + 11)
        PH_BEGIN(pb + 12, 14)
            pg8::Gemm g{(const bf16*)(ws + WS_HP), (const bf16*)(ws + WT_GU), 0, 2816, DM, (size_t)2816 * DM * 2};
            pg8::MoeOrder S; S.init((const int*)(ws + WS_TAB + TAB_TILE) + 256 * l, 11, k.G, (k.bid & 7) * (k.G >> 3) + (k.bid >> 3));
            pg8::EpiGU<FE1_> E{FE1_{(bf16*)(ws + WS_ACT)}};
            DUPRUN(11, (pg8::gemm_phase<pg8::EpiGU<FE1_>, pg8::MoeOrder, GA_, GS_>(glds, g, S, E)));
        PH_END(pb + 12)
        PH_BEGIN(pb + 13, 15)
            pg8::Gemm g{(const bf16*)(ws + WS_ACT), (const bf16*)(ws + WT_D), 0, DM, DEXP, (size_t)DM * DEXP * 2};
            pg8::MoeOrder S; S.init((const int*)(ws + WS_TAB + TAB_TILE) + 256 * l, 8, k.G, (k.bid & 7) * (k.G >> 3) + (k.bid >> 3));
            pg8::Epi8<FE2_> E{FE2_{(const int*)(ws + WS_TAB + TAB_ROWTOK) + (size_t)l * MOE_ROWS, (const float*)(ws + WS_TAB + TAB_ROWW) + (size_t)l * MOE_ROWS, (bf16*)(ws + WS_YF)}};
            DUPRUN(12, (pg8::gemm_phase<pg8::Epi8<FE2_>, pg8::MoeOrder, GA_, GS_>(glds, g, S, E)));
        PH_END(pb + 13)
        }
#undef L_
#define L_ 1
    {
        constexpr int l = L_;
        const int pb = 2 + 14 * l;
        const bool last = (l == DEPTH - 1);
        const int Mpost = last ? TL : TA;
        PH_BEGIN(pb + 0, 2)
            if (l > 0) { DUPRUN(1, ph_convert(k, WSRC, l)); }
            RowArgs ra{INP(I_X), INP(I_CTX), INP(I_NMG), nullptr, nullptr, nullptr};
            ph_rows<0>(k, ra, l, TA);
            if (l == 0 && ((DUP_MASK >> 15) & 1u)) { __syncthreads(); ph_rows<0>(k, ra, l, TA); }
        PH_END(pb + 0)
        PH_BEGIN(pb + 1, 3)
            pg8::Gemm g{(const bf16*)(ws + WS_H), (const bf16*)(ws + WT_IN), TA, NP, DM, 0}; pg8::StaticOrder S; S.init(TA, NP, k.G, k.bid);
            pg8::Epi8<FP_> E{FP_{(bf16*)(ws + WS_P)}};
            DUPRUN(2, (pg8::gemm_phase<pg8::Epi8<FP_>, pg8::StaticOrder, GA_, GS_>(glds, g, S, E)));
        PH_END(pb + 1)
        PH_BEGIN(pb + 2, 4)
            DUPRUN(3, ph_rwkv_prep(k, l, TA, INP(I_MU), INP(I_KK), INP(I_RK)));
            DUPRUN(4, ph_gla_prep(k, l, INP(I_GCONV), INP(I_GAW2), INP(I_GAB)));
        PH_END(pb + 2)
        PH_BEGIN(pb + 3, 5)
            pg8::Gemm g{(const bf16*)(ws + RW_A1), (const bf16*)(ws + WT_L1), TA, 4096, 256, 0}; pg8::StaticOrder S; S.init(TA, 4096, k.G, k.bid);
            pg8::Epi8<FL1_> E{FL1_{(bf16*)(ws + RW_LO), (const float*)(ws + WS_TAB + TAB_TOP)}};
            DUPRUN(5, (pg8::gemm_phase<pg8::Epi8<FL1_>, pg8::StaticOrder, GA_, GS_>(glds, g, S, E)));
        PH_END(pb + 3)
        PH_BEGIN(pb + 4, 6)
#if SPLIT_SCAN
            DUPRUN(6, ph_scan_split(k, l, INP(I_KA)));
#else
            for (int job = k.bid; job < 256; job += k.G) { DUPRUN(6, ph_rwkv_scan(k, l, job, INP(I_KA))); DUPRUN(7, ph_gla_scan(k, job)); }
#endif
        PH_END(pb + 4)
        PH_BEGIN(pb + 5, 7)
            DUPRUN(8, ph_post(k, l, Mpost, INP(I_LNG), INP(I_LNB), INP(I_GNG)));
        PH_END(pb + 5)
        PH_BEGIN(pb + 6, 8)
            pg8::Gemm g{(const bf16*)(ws + RW_A2), (const bf16*)(ws + WT_G2), Mpost, RD, 256, 0}; pg8::StaticOrder S; S.init(Mpost, RD, k.G, k.bid);
            pg8::Epi8<FL2_> E{FL2_{(const bf16*)(ws + RW_R), (bf16*)(ws + RW_V)}};
            DUPRUN(9, (pg8::gemm_phase<pg8::Epi8<FL2_>, pg8::StaticOrder, GA_, GS_>(glds, g, S, E)));
        PH_END(pb + 6)
        PH_BEGIN(pb + 7, 9)
            pg8::Gemm g{(const bf16*)(ws + RW_V), (const bf16*)(ws + WT_A), Mpost, DM, RD, 0}; pg8::StaticOrder S; S.init(Mpost, DM, k.G, k.bid);
            pg8::Epi8<FM_<0>> E{FM_<0>{(const bf16*)(ws + WS_P), (bf16*)(ws + WS_H)}};
            DUPRUN(10, (pg8::gemm_phase<pg8::Epi8<FM_<0>>, pg8::StaticOrder, GA_, GS_>(glds, g, S, E)));
        PH_END(pb + 7)
        PH_BEGIN(pb + 8, 10)
            pg8::Gemm g{(const bf16*)(ws + GL_VS), (const bf16*)(ws + WT_B), Mpost, DM, GVD, 0}; pg8::StaticOrder S; S.init(Mpost, DM, k.G, k.bid);
            pg8::Epi8<FM_<1>> E{FM_<1>{(const bf16*)(ws + WS_P), (bf16*)(ws + WS_H)}};
            pg8::gemm_phase<pg8::Epi8<FM_<1>>, pg8::StaticOrder, GA_, GS_>(glds, g, S, E);
        PH_END(pb + 8)
        PH_BEGIN(pb + 9, 11)
            pg8::Gemm g{(const bf16*)(ws + WS_H), (const bf16*)(ws + WT_O), Mpost, DM, DM, 0}; pg8::StaticOrder S; S.init(Mpost, DM, k.G, k.bid);
            pg8::Epi4<FX_> E{FX_{(float*)(ws + WS_X), (const float*)(ws + WS_MOD), l}};
            pg8::gemm_phase<pg8::Epi4<FX_>, pg8::StaticOrder, GA_, GS_>(glds, g, S, E);
        PH_END(pb + 9)
        PH_BEGIN(pb + 10, 12)
            RowArgs ra{nullptr, nullptr, INP(I_NFG), INP(I_RW), INP(I_RB), nullptr};
            ph_rows<1>(k, ra, l, Mpost);
            if ((DUP_MASK >> 16) & 1u) { __syncthreads(); ph_rows<1>(k, ra, l, Mpost, true); }
        PH_END(pb + 10)
        PH_BEGIN(pb + 11, 13)
            DUPRUN(13, ph_moe_scatter(k, l, Mpost));
        PH_END(pb + 11)
        PH_BEGIN(pb + 12, 14)
            pg8::Gemm g{(const bf16*)(ws + WS_HP), (const bf16*)(ws + WT_GU), 0, 2816, DM, (size_t)2816 * DM * 2};
            pg8::MoeOrder S; S.init((const int*)(ws + WS_TAB + TAB_TILE) + 256 * l, 11, k.G, (k.bid & 7) * (k.G >> 3) + (k.bid >> 3));
            pg8::EpiGU<FE1_> E{FE1_{(bf16*)(ws + WS_ACT)}};
            DUPRUN(11, (pg8::gemm_phase<pg8::EpiGU<FE1_>, pg8::MoeOrder, GA_, GS_>(glds, g, S, E)));
        PH_END(pb + 12)
        PH_BEGIN(pb + 13, 15)
            pg8::Gemm g{(const bf16*)(ws + WS_ACT), (const bf16*)(ws + WT_D), 0, DM, DEXP, (size_t)DM * DEXP * 2};
            pg8::MoeOrder S; S.init((const int*)(ws + WS_TAB + TAB_TILE) + 256 * l, 8, k.G, (k.bid & 7) * (k.G >> 3) + (k.bid >> 3));
            pg8::Epi8<FE2_> E{FE2_{(const int*)(ws + WS_TAB + TAB_ROWTOK) + (size_t)l * MOE_ROWS, (const float*)(ws + WS_TAB + TAB_ROWW) + (size_t)l * MOE_ROWS, (bf16*)(ws + WS_YF)}};
            DUPRUN(12, (pg8::gemm_phase<pg8::Epi8<FE2_>, pg8::MoeOrder, GA_, GS_>(glds, g, S, E)));
        PH_END(pb + 13)
        }
#undef L_
#if EXTRA_BARS
    if (hi - lo > 1) { for (int i = 0; i < EXTRA_BARS; ++i) xcd_barrier(bar); }
#endif
    PH_BEGIN(NPHASE - 1, 16)
        RowArgs ra{nullptr, nullptr, INP(I_FNG), nullptr, nullptr, (float*)INP(N_IN)};
        DUPRUN(14, ph_rows<2>(k, ra, 0, TL));
    PH_END(NPHASE - 1)
}

#ifndef MK_SINGLE
#define MK_SINGLE 1
#endif
extern "C" void kernel_launch(void* const* d_in, const int* in_sizes, int n_in, void* d_out, int out_size, void* d_ws, size_t ws_size, hipStream_t stream) {
    static int grid = 0;
    if (grid == 0) {
        if (n_in != N_IN || out_size != TL * DM || ws_size < WS_END) { fprintf(stderr, "kernel_launch: unexpected problem (n_in %d out %d ws %zu need %zu)\n", n_in, out_size, ws_size, (size_t)WS_END); grid = -1; return; }
        int dev = 0, cus = 0;
        if (hipGetDevice(&dev) != hipSuccess || hipDeviceGetAttribute(&cus, hipDeviceAttributeMultiprocessorCount, dev) != hipSuccess) { grid = -1; return; }
        if (hipFuncSetAttribute((const void*)fwd, hipFuncAttributeMaxDynamicSharedMemorySize, LDS_BYTES) != hipSuccess) { grid = -1; return; }
        int per_cu = 0;
        if (hipOccupancyMaxActiveBlocksPerMultiprocessor(&per_cu, (const void*)fwd, 512, LDS_BYTES) != hipSuccess || per_cu < 1) fprintf(stderr, "kernel_launch: occupancy query says %d\n", per_cu);
        (void)hipGetLastError();
        grid = cus;
    }
    if (grid < 0) return;
    unsigned char* ws = (unsigned char*)d_ws;
    (void)hipMemsetAsync(ws + WS_CTL, 0, CTL_BYTES, stream);
    Args a{};
    for (int i = 0; i < N_IN; ++i) a.in[i] = (const float*)d_in[i];
    a.out = (float*)d_out; a.ws = ws;
#if MK_SINGLE
    a.ph_lo = 0; a.ph_hi = NPHASE;
    hipLaunchKernelGGL(fwd, dim3(grid), dim3(512), LDS_BYTES, stream, a);
#else
    for (int p = 0; p < NPHASE; ++p) { a.ph_lo = p; a.ph_hi = p + 1; hipLaunchKernelGGL(fwd, dim3(grid), dim3(512), LDS_BYTES, stream, a); }
#endif
}
```

```cpp
#include <hip/hip_runtime.h>
#include <cstdio>
#include <cstdint>

#define LAS __attribute__((address_space(3)))
#define GAS __attribute__((address_space(1)))
typedef unsigned short bf16;
typedef float f32x4 __attribute__((ext_vector_type(4)));
typedef float f32x2 __attribute__((ext_vector_type(2)));
typedef unsigned u32x4 __attribute__((ext_vector_type(4)));
typedef unsigned u32x2 __attribute__((ext_vector_type(2)));
typedef short bf16x8 __attribute__((ext_vector_type(8)));

constexpr int DM = 2048, NBATCH = 8, SEQ = 2048, CTXL = 256, DEPTH = 2;
constexpr int TL = NBATCH * SEQ, TC = NBATCH * CTXL, TA = TL + TC;
constexpr int RD = 1024, RHEADS = 16, RHS = 64;
constexpr int RWKV_IN = 3520;
constexpr int GKD = 512, GVD = 1024, GDK = 128, GDV = 256, GHEADS = 4, GQKV = 2048;
constexpr int GLA_OFF = 3520, GLA_AD_OFF = GLA_OFF + GQKV, GLA_GATE_OFF = 5584, BR_OFF = 6608, IN_DIM = 10704, NP = 10752;
constexpr int NEXP = 16, DEXP = 1408;
constexpr int MOD_N = 6 * DM;
constexpr int MOE_ROWS = 41216;
constexpr int MOE_TILES = MOE_ROWS / 256;
constexpr int NCH = 36;
constexpr int KSPLIT = 32;

enum { I_X = 0, I_C, I_CTX, I_CCTX, I_WADA, I_BADA, I_NMG, I_NFG, I_WIN, I_MU, I_W0, I_W2, I_A0, I_A2, I_G2, I_KK, I_KA, I_RK, I_LNG, I_LNB,
       I_GCONV, I_GAW2, I_GAB, I_GNG, I_WBA, I_WBB, I_WOUT, I_RW, I_RB, I_EG, I_EU, I_ED, I_FNG, N_IN };

constexpr size_t MiB = 1u << 20;
constexpr size_t WS_CTL = 0;
constexpr size_t WS_TAB = 1 * MiB;
constexpr size_t WS_MOD = 2 * MiB;
constexpr size_t WS_X = 3 * MiB;
constexpr size_t WS_H = WS_X + 144 * MiB;
constexpr size_t WS_P = WS_H + 72 * MiB;
constexpr size_t WS_RW = WS_P + 378 * MiB;
constexpr size_t WS_GL = WS_RW + 380 * MiB;
constexpr size_t WS_WT = WS_GL + 218 * MiB;
constexpr size_t WS_END = WS_WT + 325 * MiB;
constexpr int CW_TMO = 0, CW_CNT = 64  , CW_BAR = 4096;
constexpr size_t CTL_BYTES = 1 * MiB;
constexpr size_t TAB_ROWTOK = 0;
constexpr size_t TAB_ROWTOK_BYTES = 2 * (size_t)MOE_ROWS * 4;
constexpr size_t TAB_ROWW = 384 * 1024;
constexpr size_t TAB_TILE = 768 * 1024;
constexpr size_t TAB_TOP = 800 * 1024;
static_assert(TAB_ROWTOK_BYTES <= TAB_ROWW && TAB_ROWW + 2 * (size_t)MOE_ROWS * 4 <= TAB_TILE, "tab map");
constexpr size_t WS_MODP = WS_P;
constexpr size_t WS_HP = WS_P;
constexpr size_t WS_ACT = WS_P + 162 * MiB;
constexpr size_t WS_TOPK = WS_P + 274 * MiB;
static_assert((size_t)MOE_ROWS * DM * 2 <= 162 * MiB && (size_t)MOE_ROWS * DEXP * 2 <= 112 * MiB && 274 * MiB + 3 * (size_t)TA * 8 <= 378 * MiB, "P overlay");
constexpr size_t RW_R = WS_RW;
constexpr size_t RW_KS = RW_R + 36 * MiB;
constexpr size_t RW_V = RW_KS + 36 * MiB;
constexpr size_t RW_KK = RW_V + 36 * MiB;
constexpr size_t RW_LO = RW_KK + 36 * MiB;
constexpr size_t RW_Y = RW_LO + 144 * MiB;
constexpr size_t RW_A1 = RW_Y + 72 * MiB;
constexpr size_t RW_A2 = RW_A1 + 9 * MiB;
constexpr size_t RW_BON = RW_A2 + 9 * MiB;
static_assert(RW_BON + 2 * MiB <= WS_GL, "rwkv map");
constexpr size_t GL_QG = WS_GL;
constexpr size_t GL_KG = GL_QG + 36 * MiB;
constexpr size_t GL_KE = GL_KG + 36 * MiB;
constexpr size_t GL_VS = GL_KE + 36 * MiB;
constexpr size_t GL_O = GL_VS + 36 * MiB;
constexpr size_t GL_DEC = GL_O + 72 * MiB;
static_assert(GL_DEC + 2 * MiB <= WS_WT, "gla map");
constexpr size_t WS_YF = WS_GL;
constexpr size_t WT_IN = WS_WT;
constexpr size_t WT_L1 = WT_IN + 42 * MiB;
constexpr size_t WT_G2 = WT_L1 + 2 * MiB;
constexpr size_t WT_A = WT_G2 + 1 * MiB;
constexpr size_t WT_B = WT_A + 4 * MiB;
constexpr size_t WT_O = WT_B + 4 * MiB;
constexpr size_t WT_GU = WT_O + 8 * MiB;
constexpr size_t WT_D = WT_GU + 176 * MiB;
static_assert(WT_D + 88 * MiB == WS_END, "weight map");

__device__ __forceinline__ float bf2f(unsigned v) { return __uint_as_float(v << 16); }
__device__ __forceinline__ float bflo(unsigned w) { return __uint_as_float(w << 16); }
__device__ __forceinline__ float bfhi(unsigned w) { return __uint_as_float(w & 0xffff0000u); }
__device__ __forceinline__ unsigned f2bf(float f) { unsigned u = __float_as_uint(f); return (u + 0x7fffu + ((u >> 16) & 1u)) >> 16; }
__device__ __forceinline__ unsigned pk2(float lo, float hi) { unsigned r; asm volatile("v_cvt_pk_bf16_f32 %0, %1, %2" : "=v"(r) : "v"(lo), "v"(hi)); return r; }
__device__ __forceinline__ float sigm(float x) { return 1.0f / (1.0f + __expf(-x)); }
__device__ __forceinline__ float siluf(float x) { return x * sigm(x); }
__device__ __forceinline__ float wave_sum(float x) {
    x += __builtin_bit_cast(float, __builtin_amdgcn_update_dpp(0, __builtin_bit_cast(int, x), 0xB1, 0xF, 0xF, true));
    x += __builtin_bit_cast(float, __builtin_amdgcn_update_dpp(0, __builtin_bit_cast(int, x), 0x4E, 0xF, 0xF, true));
    x += __builtin_bit_cast(float, __builtin_amdgcn_update_dpp(0, __builtin_bit_cast(int, x), 0x141, 0xF, 0xF, true));
    x += __builtin_bit_cast(float, __builtin_amdgcn_update_dpp(0, __builtin_bit_cast(int, x), 0x140, 0xF, 0xF, true));
    const int xi = __builtin_bit_cast(int, x);
    return (__builtin_bit_cast(float, __builtin_amdgcn_readlane(xi, 0)) + __builtin_bit_cast(float, __builtin_amdgcn_readlane(xi, 16))) +
           (__builtin_bit_cast(float, __builtin_amdgcn_readlane(xi, 32)) + __builtin_bit_cast(float, __builtin_amdgcn_readlane(xi, 48)));
}
__device__ __forceinline__ void unpack8(const u32x4 w, float (&o)[8]) {
    o[0] = bflo(w.x); o[1] = bfhi(w.x); o[2] = bflo(w.y); o[3] = bfhi(w.y); o[4] = bflo(w.z); o[5] = bfhi(w.z); o[6] = bflo(w.w); o[7] = bfhi(w.w);
}
__device__ __forceinline__ u32x4 pack8(const float (&v)[8]) { u32x4 w; w.x = pk2(v[0], v[1]); w.y = pk2(v[2], v[3]); w.z = pk2(v[4], v[5]); w.w = pk2(v[6], v[7]); return w; }
namespace pg8 {
#define PG8_LAS __attribute__((address_space(3)))
typedef unsigned short bf16_t;
typedef short bf16x8 __attribute__((ext_vector_type(8)));
typedef float f32x4 __attribute__((ext_vector_type(4)));
typedef unsigned u32x4 __attribute__((ext_vector_type(4)));
constexpr int BM = 256, BK = 64, HALF = 128, HTB = HALF * BK * 2  , STAGE_BYTES = 8 * HTB, NXCD = 8, WGM = 8;

__host__ __device__ __forceinline__ int lds_byte(int r, int c) { const int st = (r >> 4) * 2 + (c >> 5), rr = r & 15, cc = c & 31, ob = rr * 64 + cc * 2; return st * 1024 + (ob ^ (((ob >> 9) & 1) << 5)); }
__host__ __device__ __forceinline__ void stage_rc(int b, int& R, int& C) { const int st = b / 1024, sb = b % 1024, swz = sb ^ (((sb >> 9) & 1) << 5); R = (st >> 1) * 16 + swz / 64; C = (st & 1) * 32 + (swz % 64) / 2; }
__host__ __device__ __forceinline__ int perm32(int rho) { const int n = rho >> 4, i = rho & 15; return 8 * (i >> 2) + 4 * n + (i & 3); }
struct Unit { int pm, pn, eb; };
struct Gemm { const bf16_t* A; const bf16_t* Bt; int M, N, K; size_t bstride; };

struct StaticOrder {
    int nM, nN, nwg, G, c;
    __host__ __device__ void init(int M, int N, int G_, int c_) { nM = M / BM; nN = N / BM; nwg = nM * nN; G = G_; c = c_; }
    __host__ __device__ bool next(int i, Unit& u) const {
        const long L = (long)i * G + c; if (L >= nwg) return false;
        int wgid = (int)L; { const int q = nwg / NXCD, r = nwg % NXCD, xcd = wgid % NXCD, off = wgid / NXCD; wgid = (xcd < r ? xcd * (q + 1) : r * (q + 1) + (xcd - r) * q) + off; }
        const int nig = WGM * nN, gid = wgid / nig, fm = gid * WGM, gsz = (nM - fm) < WGM ? (nM - fm) : WGM;
        u.pm = fm + ((wgid % nig) % gsz); u.pn = (wgid % nig) / gsz; u.eb = 0; return true;
    }
    __device__ __forceinline__ void a_ready(const Unit&) const {}
    __device__ __forceinline__ void done(const Unit&) const {}
};
struct MoeOrder {
    const int* tab; int nT, nN, G, c;
    __device__ void init(const int* tab_, int nN_, int G_, int c_) { tab = tab_; nT = tab_[0]; nN = nN_; G = G_; c = c_; }
    __device__ bool next(int i, Unit& u) const {
        const long L = (long)i * G + c; if (L >= (long)nT * nN) return false;
        u.pm = (int)(L / nN); u.pn = (int)(L % nN); u.eb = tab[1 + u.pm]; return true;
    }
    __device__ __forceinline__ void a_ready(const Unit&) const {}
    __device__ __forceinline__ void done(const Unit&) const {}
};

template <class F> struct Epi8 {
    static constexpr bool PERM = true, AFTER_DRAIN = false;
    F f;
    __device__ __forceinline__ void operator()(const f32x4 (&acc)[2][2][4][2], const Unit& u, int wr, int wc, int fr, int fq) const {
        const int row0 = u.pm * BM + wr * 64 + fr, col0 = u.pn * BM + wc * 32 + 8 * fq;
#pragma unroll
        for (int ai = 0; ai < 2; ++ai)
#pragma unroll
            for (int m = 0; m < 4; ++m) {
#pragma unroll
                for (int bj = 0; bj < 2; ++bj) {
                    const f32x4 a = acc[ai][bj][m][0], b = acc[ai][bj][m][1];
                    float v[8] = {a[0], a[1], a[2], a[3], b[0], b[1], b[2], b[3]};
                    f(row0 + ai * HALF + m * 16, col0 + bj * HALF, v, u);
                }
            }
    }
};
template <class F> struct EpiGU {
    static constexpr bool PERM = true, AFTER_DRAIN = false;
    F f;
    __device__ __forceinline__ void operator()(const f32x4 (&acc)[2][2][4][2], const Unit& u, int wr, int wc, int fr, int fq) const {
        const int row0 = u.pm * BM + wr * 64 + fr, col0 = u.pn * HALF + wc * 32 + 8 * fq;
#pragma unroll
        for (int ai = 0; ai < 2; ++ai)
#pragma unroll
            for (int m = 0; m < 4; ++m) {
                const f32x4 g0 = acc[ai][0][m][0], g1 = acc[ai][0][m][1], u0 = acc[ai][1][m][0], u1 = acc[ai][1][m][1];
                float g[8] = {g0[0], g0[1], g0[2], g0[3], g1[0], g1[1], g1[2], g1[3]};
                float up[8] = {u0[0], u0[1], u0[2], u0[3], u1[0], u1[1], u1[2], u1[3]};
                f(row0 + ai * HALF + m * 16, col0, g, up);
            }
    }
};
template <class F> struct Epi4 {
    static constexpr bool PERM = false, AFTER_DRAIN = false;
    F f;
    __device__ __forceinline__ void operator()(const f32x4 (&acc)[2][2][4][2], const Unit& u, int wr, int wc, int fr, int fq) const {
        const int row0 = u.pm * BM + wr * 64 + fr, col0 = u.pn * BM + wc * 32 + 4 * fq;
#pragma unroll
        for (int ai = 0; ai < 2; ++ai)
#pragma unroll
            for (int m = 0; m < 4; ++m) {
#pragma unroll
                for (int bj = 0; bj < 2; ++bj)
#pragma unroll
                    for (int n = 0; n < 2; ++n) f(row0 + ai * HALF + m * 16, col0 + bj * HALF + n * 16, acc[ai][bj][m][n], u);
            }
    }
};
template <class Epi, class Sched, bool ALIGN_EPI = false, bool SP2 = false>
__device__ __forceinline__ void gemm_phase(PG8_LAS unsigned char* lds, const Gemm g, const Sched& S, const Epi& E) {
    int tid_o = threadIdx.x; asm volatile("" : "+v"(tid_o));
    const int tid = tid_o, wid = __builtin_amdgcn_readfirstlane(tid >> 6), lane = tid & 63, wr = wid >> 2, wc = wid & 3, fr = lane & 15, fq = lane >> 4;
    const int K = g.K, nt = K / BK;
    unsigned voffA[2], voffB[2];
#pragma unroll
    for (int i = 0; i < 2; ++i) { int R, C; stage_rc(tid * 16 + i * 8192, R, C); const int Rb = Epi::PERM ? ((R & ~31) + perm32(R & 31)) : R;
        voffA[i] = (unsigned)(R * K + C) * 2u; voffB[i] = (unsigned)(Rb * K + C) * 2u; }
    const size_t kstep = (size_t)(BK * 2);
    const size_t hstep = (size_t)HALF * K * 2;
    const size_t tstep = 2 * hstep;
    const unsigned ldsw = (unsigned)wid * 1024u;
    const int aoff = lds_byte(wr * 64 + fr, fq * 8), boff = lds_byte(wc * 32 + fr, fq * 8);
#define PG8_SA(b, h) (((b) * 2 + (h)) * HTB)
#define PG8_SB(b, h) ((4 + (b) * 2 + (h)) * HTB)
#define PG8_STAGE(bufoff, gbase, voff) do { _Pragma("unroll") for (int _i = 0; _i < 2; ++_i) \
        __builtin_amdgcn_global_load_lds((const unsigned*)((const char*)(gbase) + (voff)[_i]), (PG8_LAS unsigned*)(lds + (bufoff) + ldsw + _i * 8192), 16, 0, 0); } while (0)
#define PG8_LDA(dst, b, h) do { _Pragma("unroll") for (int m = 0; m < 4; ++m) _Pragma("unroll") for (int k = 0; k < 2; ++k) dst[m][k] = *(const PG8_LAS bf16x8*)(lds + PG8_SA(b, h) + aoff + m * 2048 + k * 1024); } while (0)
#define PG8_LDB(dst, b, h) do { _Pragma("unroll") for (int n = 0; n < 2; ++n) _Pragma("unroll") for (int k = 0; k < 2; ++k) dst[n][k] = *(const PG8_LAS bf16x8*)(lds + PG8_SB(b, h) + boff + n * 2048 + k * 1024); } while (0)
#define PG8_MMA(ai, bj, At, Bt) do { __builtin_amdgcn_s_setprio(1); _Pragma("unroll") for (int m = 0; m < 4; ++m) _Pragma("unroll") for (int n = 0; n < 2; ++n) _Pragma("unroll") for (int k = 0; k < 2; ++k) \
        acc[ai][bj][m][n] = __builtin_amdgcn_mfma_f32_16x16x32_bf16(Bt[n][k], At[m][k], acc[ai][bj][m][n], 0, 0, 0); __builtin_amdgcn_s_setprio(0); } while (0)
#define PG8_WAIT_V(n) asm volatile("s_waitcnt vmcnt(" #n ")" ::: "memory")
#define PG8_WAIT_L(n) asm volatile("s_waitcnt lgkmcnt(" #n ")" ::: "memory")
#define PG8_BAR __builtin_amdgcn_s_barrier()
#define PG8_SCHED __builtin_amdgcn_sched_barrier(0)
    Unit cur, nxt; int ui = 0;
    if (!S.next(0, cur)) return;
    f32x4 acc[2][2][4][2];
#pragma unroll
    for (int a = 0; a < 2; ++a)
#pragma unroll
        for (int b = 0; b < 2; ++b)
#pragma unroll
            for (int m = 0; m < 4; ++m)
#pragma unroll
                for (int n = 0; n < 2; ++n) acc[a][b][m][n] = (f32x4){0.f, 0.f, 0.f, 0.f};
    bf16x8 At[4][2], B0[2][2], B1[2][2];
    const char* cA = (const char*)g.A + (size_t)cur.pm * tstep; const char* cB = (const char*)g.Bt + (size_t)cur.eb * g.bstride + (size_t)cur.pn * tstep;
    S.a_ready(cur);
    if constexpr (SP2) {
        PG8_STAGE(PG8_SB(0, 0), cB, voffB); PG8_STAGE(PG8_SB(0, 1), cB + hstep, voffB); PG8_STAGE(PG8_SA(0, 0), cA, voffA); PG8_STAGE(PG8_SA(0, 1), cA + hstep, voffA);
        if (wr == 1) PG8_BAR;
        PG8_WAIT_V(2); PG8_BAR;
        PG8_STAGE(PG8_SB(1, 0), cB + kstep, voffB); PG8_STAGE(PG8_SA(1, 0), cA + kstep, voffA); PG8_STAGE(PG8_SB(1, 1), cB + hstep + kstep, voffB);
        PG8_WAIT_V(6); PG8_BAR;
    } else {
        PG8_STAGE(PG8_SB(0, 0), cB, voffB); PG8_STAGE(PG8_SA(0, 0), cA, voffA); PG8_STAGE(PG8_SB(0, 1), cB + hstep, voffB); PG8_STAGE(PG8_SA(0, 1), cA + hstep, voffA);
        if (wr == 1) PG8_BAR;
        PG8_WAIT_V(4); PG8_BAR;
        PG8_STAGE(PG8_SB(1, 0), cB + kstep, voffB); PG8_STAGE(PG8_SA(1, 0), cA + kstep, voffA); PG8_STAGE(PG8_SB(1, 1), cB + hstep + kstep, voffB);
        PG8_WAIT_V(6); PG8_BAR;
    }
    for (;;) {
        const bool has_next = S.next(ui + 1, nxt);
        const char* nA = has_next ? (const char*)g.A + (size_t)nxt.pm * tstep : cA; const char* nB = has_next ? (const char*)g.Bt + (size_t)nxt.eb * g.bstride + (size_t)nxt.pn * tstep : cB;
#pragma nounroll
        for (int t = 0; t < nt; t += 2) {
            const bool last = (t == nt - 2);
            const char* a1 = cA + (size_t)(t + 1) * kstep;
            const char* a2 = last ? nA : cA + (size_t)(t + 2) * kstep; const char* b2 = last ? nB : cB + (size_t)(t + 2) * kstep;
            const char* a3 = a2 + kstep; const char* b3 = b2 + kstep;
            if (last && has_next) S.a_ready(nxt);
            if constexpr (SP2) {
            PG8_LDB(B0, 0, 0); PG8_LDB(B1, 0, 1); PG8_SCHED; PG8_LDA(At, 0, 0); PG8_STAGE(PG8_SA(1, 1), a1 + hstep, voffA);
            PG8_WAIT_V(8); PG8_WAIT_L(0); PG8_BAR; PG8_MMA(0, 0, At, B0); PG8_MMA(0, 1, At, B1); PG8_BAR; PG8_SCHED;
            PG8_LDA(At, 0, 1); PG8_STAGE(PG8_SB(0, 0), b2, voffB); PG8_STAGE(PG8_SB(0, 1), b2 + hstep, voffB); PG8_STAGE(PG8_SA(0, 0), a2, voffA);
            PG8_WAIT_V(8); PG8_WAIT_L(0); PG8_BAR; PG8_MMA(1, 0, At, B0); PG8_MMA(1, 1, At, B1); PG8_BAR; PG8_SCHED;
            PG8_LDB(B0, 1, 0); PG8_LDB(B1, 1, 1); PG8_SCHED; PG8_LDA(At, 1, 0); PG8_STAGE(PG8_SA(0, 1), a2 + hstep, voffA);
            PG8_WAIT_V(8); PG8_WAIT_L(0); PG8_BAR; PG8_MMA(0, 0, At, B0); PG8_MMA(0, 1, At, B1); PG8_BAR; PG8_SCHED;
            PG8_LDA(At, 1, 1); PG8_STAGE(PG8_SB(1, 0), b3, voffB); PG8_STAGE(PG8_SB(1, 1), b3 + hstep, voffB); PG8_STAGE(PG8_SA(1, 0), a3, voffA);
            PG8_WAIT_V(8); PG8_WAIT_L(0); PG8_BAR; PG8_MMA(1, 0, At, B0); PG8_MMA(1, 1, At, B1); PG8_BAR; PG8_SCHED;
            } else {
            PG8_LDB(B0, 0, 0); PG8_SCHED; PG8_LDA(At, 0, 0); PG8_STAGE(PG8_SA(1, 1), a1 + hstep, voffA);
            PG8_WAIT_L(8); PG8_BAR; PG8_WAIT_L(0); PG8_MMA(0, 0, At, B0); PG8_BAR; PG8_SCHED;
            PG8_LDB(B1, 0, 1); PG8_STAGE(PG8_SB(0, 0), b2, voffB);
            PG8_BAR; PG8_WAIT_L(0); PG8_MMA(0, 1, At, B1); PG8_BAR;
            PG8_LDA(At, 0, 1); PG8_STAGE(PG8_SA(0, 0), a2, voffA);
            PG8_BAR; PG8_WAIT_L(0); PG8_MMA(1, 0, At, B0); PG8_BAR; PG8_SCHED;
            PG8_STAGE(PG8_SB(0, 1), b2 + hstep, voffB);
            PG8_WAIT_V(6); PG8_BAR; PG8_MMA(1, 1, At, B1); PG8_BAR;
            PG8_LDB(B0, 1, 0); PG8_SCHED; PG8_LDA(At, 1, 0); PG8_STAGE(PG8_SA(0, 1), a2 + hstep, voffA);
            PG8_WAIT_L(8); PG8_BAR; PG8_WAIT_L(0); PG8_MMA(0, 0, At, B0); PG8_BAR; PG8_SCHED;
            PG8_LDB(B1, 1, 1); PG8_STAGE(PG8_SB(1, 0), b3, voffB);
            PG8_BAR; PG8_WAIT_L(0); PG8_MMA(0, 1, At, B1); PG8_BAR;
            PG8_LDA(At, 1, 1); PG8_STAGE(PG8_SA(1, 0), a3, voffA);
            PG8_BAR; PG8_WAIT_L(0); PG8_MMA(1, 0, At, B0); PG8_BAR; PG8_SCHED;
            PG8_STAGE(PG8_SB(1, 1), b3 + hstep, voffB);
            PG8_WAIT_V(6); PG8_BAR; PG8_MMA(1, 1, At, B1); PG8_BAR;
            }
        }
        if constexpr (ALIGN_EPI) { if (wr == 0) PG8_BAR; }
        if constexpr (!Epi::AFTER_DRAIN) { E(acc, cur, wr, wc, fr, fq); S.done(cur); }
        if (!has_next) break;
#pragma unroll
        for (int a = 0; a < 2; ++a)
#pragma unroll
            for (int b = 0; b < 2; ++b)
#pragma unroll
                for (int m = 0; m < 4; ++m)
#pragma unroll
                    for (int n = 0; n < 2; ++n) acc[a][b][m][n] = (f32x4){0.f, 0.f, 0.f, 0.f};
        cur = nxt; cA = nA; cB = nB; ++ui;
        if constexpr (ALIGN_EPI) { if (wr == 1) PG8_BAR; }
    }
    PG8_WAIT_V(0);
    if constexpr (!ALIGN_EPI) { if (wr == 0) PG8_BAR; }
    PG8_BAR;
    if constexpr (Epi::AFTER_DRAIN) { E.fused(acc, cur, wr, wc, fr, fq, lds, wid, lane); S.done(cur); }
#undef PG8_SA
#undef PG8_SB
#undef PG8_STAGE
#undef PG8_LDA
#undef PG8_LDB
#undef PG8_MMA
#undef PG8_WAIT_V
#undef PG8_WAIT_L
#undef PG8_BAR
#undef PG8_SCHED
}
}

#ifndef PG8_SP2
#define PG8_SP2 true
#endif
#ifndef PG8_ALIGN
#define PG8_ALIGN true
#endif
#define XB_TMO      128
#define XB_XCNT(j)  (256  + 64 * (j))
#define XB_XSUB(j)  (1280 + 64 * (j))
#define XB_XGEN(j)  (2304 + 64 * (j))
#define XB_TOP      3328
#define XB_TOPGEN   3392
#define XCD_BAR_WORDS 3456
#define XB_SPIN_CAP (1u << 18)

__device__ __forceinline__ unsigned xb_ld(unsigned* p)              { return __hip_atomic_load(p, __ATOMIC_RELAXED, __HIP_MEMORY_SCOPE_AGENT); }
__device__ __forceinline__ unsigned xb_add(unsigned* p, unsigned v) { return __hip_atomic_fetch_add(p, v, __ATOMIC_RELAXED, __HIP_MEMORY_SCOPE_AGENT); }
__device__ __forceinline__ unsigned xb_xcc_id() { return (unsigned)__builtin_amdgcn_s_getreg((3 << 11) | 20) & 0xFu; }
#define XB_SPIN(cond, bar) do { unsigned _sp = 0; while (cond) { __builtin_amdgcn_s_sleep(1); \
    if ((++_sp & 255u) == 0u) { if (xb_ld(&(bar)[XB_TMO])) break; if (_sp > XB_SPIN_CAP) { atomicAdd(&(bar)[XB_TMO], 1u); break; } } } } while (0)

struct XcdBarrier {
    unsigned* bar; unsigned x;
    volatile LAS unsigned* st;
};

__device__ __forceinline__ XcdBarrier xcd_barrier_post(unsigned* bar, volatile LAS unsigned* st) {
    XcdBarrier b; b.bar = bar; b.x = xb_xcc_id(); b.st = st;
    if (threadIdx.x == 0) (void)xb_add(&bar[XB_XCNT(b.x)], 1u);
    return b;
}
__device__ __forceinline__ void xcd_barrier_complete(unsigned* bar, unsigned x, unsigned& nloc, unsigned& nx) {
    const unsigned G = gridDim.x * gridDim.y * gridDim.z;
    unsigned sum, cnt, mine, sp = 0u;
    for (;;) {
        sum = 0u; cnt = 0u; mine = 0u;
#pragma unroll
        for (unsigned j = 0; j < 16; ++j) { const unsigned c = xb_ld(&bar[XB_XCNT(j)]); sum += c; cnt += (c > 0u) ? 1u : 0u; mine = (j == x) ? c : mine; }
        if (sum == G) break;
        __builtin_amdgcn_s_sleep(1);
        if ((++sp & 255u) == 0u) { if (xb_ld(&bar[XB_TMO])) break; if (sp > XB_SPIN_CAP) { atomicAdd(&bar[XB_TMO], 1u); break; } }
    }
    nloc = mine > 0u ? mine : 1u; nx = cnt > 0u ? cnt : 1u;
}

__device__ __forceinline__ void xcd_barrier(const XcdBarrier& b) {
    asm volatile("s_waitcnt vmcnt(0)" ::: "memory");
    __syncthreads();
    if (threadIdx.x == 0) {
        unsigned* bar = b.bar;
        __builtin_amdgcn_s_waitcnt(0);
        unsigned nloc = b.st[0], nx = b.st[1];
        if (nloc == 0u) { xcd_barrier_complete(bar, b.x, nloc, nx); b.st[0] = nloc; b.st[1] = nx; }
        const unsigned old = xb_add(&bar[XB_XSUB(b.x)], 1u);
        const unsigned gen = old / nloc;
        if (old + 1u == (gen + 1u) * nloc) {
            __builtin_amdgcn_fence(__ATOMIC_RELEASE, "agent");
            asm volatile("s_waitcnt vmcnt(0)" ::: "memory");
            const unsigned og = xb_add(&bar[XB_TOP], 1u);
            const unsigned tg = og / nx;
            if (og + 1u == (tg + 1u) * nx) xb_add(&bar[XB_TOPGEN], 1u);
            else XB_SPIN(xb_ld(&bar[XB_TOPGEN]) == tg, bar);
            __builtin_amdgcn_fence(__ATOMIC_ACQUIRE, "agent");
            xb_add(&bar[XB_XGEN(b.x)], 1u);
            asm volatile("s_waitcnt vmcnt(0)" ::: "memory");
        } else {
            XB_SPIN(xb_ld(&bar[XB_XGEN(b.x)]) == gen, bar);
            __builtin_amdgcn_fence(__ATOMIC_ACQUIRE, "agent");
            asm volatile("s_waitcnt vmcnt(0)" ::: "memory");
        }
    }
    __syncthreads();
}
struct KC {
    const float* const* in;
    LAS unsigned char* lds;
    unsigned char* ws;
    int tid, lane, wave, G, bid;
};
__device__ __forceinline__ const float* inp_(int i) {
    const volatile unsigned long long __attribute__((address_space(4)))* kp = (const volatile unsigned long long __attribute__((address_space(4)))*)__builtin_amdgcn_kernarg_segment_ptr();
    return (const float*)(const GAS float*)kp[i];
}
#define INP(k) (inp_(k))

__device__ __forceinline__ int mod_row(int row) { return row < TL ? (row >> 11) : 8; }

__device__ __forceinline__ void ph_adaln_partials(const KC& k, const float* c, const float* c_ctx, const float* w_ada) {
    LAS float* sc = (LAS float*)k.lds;
    for (int i = k.tid; i < 9 * DM; i += 512) { const int r = i >> 11, kk = i & 2047; const float cv = r < 8 ? c[r * DM + kk] : c_ctx[kk]; sc[i] = siluf(cv); }
    __syncthreads();
    float* modp = (float*)(k.ws + WS_MODP);
    const int cc = k.tid & 255, kh = k.tid >> 8;
    constexpr int NIT = DEPTH * 48 * 16;
    for (int it = k.bid; it < NIT; it += k.G) {
        const int l = it / 768, rem = it % 768, cb = rem >> 4, ks = rem & 15;
        const int col = cb * 256 + cc, kbeg = ks * 128 + kh * 64;
        const float* W = w_ada + ((size_t)l * DM + kbeg) * MOD_N + col;
        float acc[9];
#pragma unroll
        for (int r = 0; r < 9; ++r) acc[r] = 0.f;
#pragma unroll 32
        for (int q = 0; q < 64; ++q) {
            const float w = W[(size_t)q * MOD_N];
#pragma unroll
            for (int r = 0; r < 9; ++r) acc[r] += sc[r * DM + kbeg + q] * w;
        }
        const int s = ks * 2 + kh;
#pragma unroll
        for (int r = 0; r < 9; ++r) modp[(((size_t)s * DEPTH + l) * 9 + r) * MOD_N + col] = acc[r];
    }
    __syncthreads();
}
__device__ __forceinline__ void ph_adaln_reduce(const KC& k, const float* b_ada) {
    const float* modp = (const float*)(k.ws + WS_MODP); float* mod = (float*)(k.ws + WS_MOD);
    constexpr int TOT = DEPTH * 9 * MOD_N;
    for (int i = k.bid * 512 + k.tid; i < TOT; i += k.G * 512) {
        const int n = i % MOD_N, l = i / (9 * MOD_N);
        float s = b_ada[l * MOD_N + n];
#pragma unroll 8
        for (int q = 0; q < KSPLIT; ++q) s += modp[(size_t)q * TOT + i];
        mod[i] = s;
    }
}

struct TrItem { const float* src; bf16* dst; int srcN, Kv, Nv, k0, n0, dpitch, drow0, dk0; };
struct WSrc { const float *w_in, *w2, *a2, *g2, *wba, *wbb, *wout, *eg, *eu, *ed, *w0, *a0; };
constexpr int TI_IN = 32 * 336, TI_LO = 4 * 64, TI_G2 = 4 * 32, TI_AB = 16 * 64, TI_O = 32 * 64, TI_GU1 = 32 * 44, TI_D1 = 22 * 64;
constexpr int TI_N = TI_IN + TI_LO + TI_G2 + 2 * TI_AB + TI_O + 2 * NEXP * TI_GU1 + NEXP * TI_D1;
__device__ __forceinline__ TrItem tr_decode(const WSrc& s, unsigned char* ws, int l, int it) {
    TrItem t; int r = it;
    if (r < TI_IN) { const int kb = r / 336, nb = r % 336; t = TrItem{s.w_in + (size_t)l * DM * IN_DIM, (bf16*)(ws + WT_IN), IN_DIM, DM, IN_DIM, 64 * kb, 32 * nb, DM, 32 * nb, 0}; return t; } r -= TI_IN;
    if (r < TI_LO) {
        const int mtx = r >> 6, q = r & 63, kb = q >> 5, nb = q & 31;
        t = TrItem{(mtx < 2 ? s.w2 : s.a2) + (size_t)(l * 2 + (mtx & 1)) * 96 * RD, (bf16*)(ws + WT_L1), RD, 96, RD, 64 * kb, 32 * nb, 256, mtx * 1024 + 32 * nb, mtx < 2 ? 0 : 96}; return t; } r -= TI_LO;
    if (r < TI_G2) { const int kb = r >> 5, nb = r & 31; t = TrItem{s.g2 + (size_t)l * 256 * RD, (bf16*)(ws + WT_G2), RD, 256, RD, 64 * kb, 32 * nb, 256, 32 * nb, 0}; return t; } r -= TI_G2;
    if (r < TI_AB) { const int kb = r >> 6, nb = r & 63; t = TrItem{s.wba + (size_t)l * RD * DM, (bf16*)(ws + WT_A), DM, RD, DM, 64 * kb, 32 * nb, RD, 32 * nb, 0}; return t; } r -= TI_AB;
    if (r < TI_AB) { const int kb = r >> 6, nb = r & 63; t = TrItem{s.wbb + (size_t)l * GVD * DM, (bf16*)(ws + WT_B), DM, GVD, DM, 64 * kb, 32 * nb, GVD, 32 * nb, 0}; return t; } r -= TI_AB;
    if (r < TI_O) { const int kb = r >> 6, nb = r & 63; t = TrItem{s.wout + (size_t)l * DM * DM, (bf16*)(ws + WT_O), DM, DM, DM, 64 * kb, 32 * nb, DM, 32 * nb, 0}; return t; } r -= TI_O;
    if (r < 2 * NEXP * TI_GU1) {
        const int e = r / (2 * TI_GU1), q = r % (2 * TI_GU1), up = q / TI_GU1, q2 = q % TI_GU1, kb = q2 / 44, nb = q2 % 44;
        const int n0 = 32 * nb, drow = 256 * (n0 >> 7) + (n0 & 127) + (up ? 128 : 0);
        t = TrItem{(up ? s.eu : s.eg) + ((size_t)l * NEXP + e) * DM * DEXP, (bf16*)(ws + WT_GU) + (size_t)e * 2816 * DM, DEXP, DM, DEXP, 64 * kb, n0, DM, drow, 0}; return t; } r -= 2 * NEXP * TI_GU1;
    { const int e = r / TI_D1, q = r % TI_D1, kb = q >> 6, nb = q & 63;
      t = TrItem{s.ed + ((size_t)l * NEXP + e) * DEXP * DM, (bf16*)(ws + WT_D) + (size_t)e * DM * DEXP, DM, DEXP, DM, 64 * kb, 32 * nb, DEXP, 32 * nb, 0}; }
    return t;
}
__device__ __forceinline__ void tr_load(const TrItem& t, int lane, float (&v)[32]) {
    const int nn = lane & 31, kh = lane >> 5;
    const bool nok = t.n0 + nn < t.Nv;
    const float* p = t.src + (size_t)(t.k0 + kh) * t.srcN + t.n0 + nn;
#pragma unroll
    for (int i = 0; i < 32; ++i) { v[i] = 0.f; if (nok && t.k0 + 2 * i + kh < t.Kv) v[i] = p[(size_t)(2 * i) * t.srcN]; }
}
__device__ __forceinline__ void tr_store(const TrItem& t, int lane, const float (&v)[32], LAS float* scr) {
    const int nn = lane & 31, kh = lane >> 5;
#pragma unroll
    for (int i = 0; i < 32; ++i) scr[(2 * i + kh) * 33 + nn] = v[i];
    asm volatile("s_waitcnt lgkmcnt(0)" ::: "memory");
    const int cidx = lane & 7;
#pragma unroll
    for (int j = 0; j < 4; ++j) {
        const int n = (lane >> 3) + 8 * j; const LAS float* s = scr + (8 * cidx) * 33 + n;
        u32x4 o; o.x = pk2(s[0 * 33], s[1 * 33]); o.y = pk2(s[2 * 33], s[3 * 33]); o.z = pk2(s[4 * 33], s[5 * 33]); o.w = pk2(s[6 * 33], s[7 * 33]);
        *(u32x4*)(t.dst + (size_t)(t.drow0 + n) * t.dpitch + t.dk0 + t.k0 + 8 * cidx) = o;
    }
    asm volatile("s_waitcnt lgkmcnt(0)" ::: "memory");
}
__device__ __forceinline__ void ph_convert(const KC& k, const WSrc& s, int l) {
    LAS float* scr = (LAS float*)(k.lds + k.wave * 16384);
    const int gw = k.bid * 8 + k.wave, NGW = k.G * 8;
    unsigned char* ws = k.ws;
    { float* b1 = (float*)(ws + WS_TAB + TAB_TOP); for (int i = gw * 64 + k.lane; i < 4096; i += NGW * 64) b1[i] = i < 2048 ? s.w0[l * 2048 + i] : s.a0[l * 2048 + i - 2048]; }
    {
        u32x4* wl = (u32x4*)(ws + WT_L1);
        for (int i = gw * 64 + k.lane; i < 4096 * 32; i += NGW * 64) { const int row = i >> 5, ck = i & 31; if (row < 2048 ? ck >= 16 : (ck < 12 || ck >= 28)) wl[i] = (u32x4){0u, 0u, 0u, 0u}; }
        if (l == 0) { int* rt = (int*)(ws + WS_TAB + TAB_ROWTOK); for (int i = gw * 64 + k.lane; i < 2 * MOE_ROWS; i += NGW * 64) rt[i] = -1; }
    }
    float cur[32], nxt[32];
    int it = gw;
    TrItem tc = tr_decode(s, ws, l, it < TI_N ? it : 0);
    if (it < TI_N) tr_load(tc, k.lane, cur);
    for (; it < TI_N; it += NGW) {
        const bool more = it + NGW < TI_N;
        const TrItem tn = tr_decode(s, ws, l, more ? it + NGW : it);
        if (more) tr_load(tn, k.lane, nxt);
        tr_store(tc, k.lane, cur, scr);
        tc = tn;
#pragma unroll
        for (int i = 0; i < 32; ++i) cur[i] = nxt[i];
    }
}

constexpr int RWP = DM + 4;
struct RowArgs { const float *x_in, *ctx_in, *gvec, *router_w, *router_b; float* out; };
template <int MODE>
__device__ __forceinline__ void ph_rows(const KC& k, const RowArgs& ra, int l, int nrows, bool dry = false) {
    const int gw = k.bid * 8 + k.wave, NGW = k.G * 8, lane = k.lane;
    float* X = (float*)(k.ws + WS_X); bf16* H = (bf16*)(k.ws + WS_H);
    const float* MOD = (const float*)(k.ws + WS_MOD);
    const bf16* YF = (const bf16*)(k.ws + WS_YF);
    LAS float* rwT = (LAS float*)k.lds;
    if (MODE == 1) {
        for (int i = k.tid; i < DM * NEXP; i += 512) { const int c = i >> 4, e = i & 15; rwT[e * RWP + c] = ra.router_w[i]; }
        __syncthreads();
    }
    const float* gv = ra.gvec;
    for (int row = gw; row < nrows; row += NGW) {
        const int mr = mod_row(row);
        f32x4 v[8];
        if (MODE == 0 && l == 0) {
            const f32x4* src = (const f32x4*)(row < TL ? ra.x_in + (size_t)row * DM : ra.ctx_in + (size_t)(row - TL) * DM) + lane;
#pragma unroll
            for (int j = 0; j < 8; ++j) v[j] = src[64 * j];
        } else {
            const f32x4* src = (const f32x4*)(X + (size_t)row * DM) + lane;
#pragma unroll
            for (int j = 0; j < 8; ++j) v[j] = src[64 * j];
        }
        if ((MODE == 0 && l > 0) || MODE == 2) {
            const int lp = (MODE == 2) ? DEPTH - 1 : l - 1;
            const f32x4* gate = (const f32x4*)(MOD + ((size_t)lp * 9 + mr) * MOD_N + 5 * DM) + lane;
            const u32x2* y0 = (const u32x2*)(YF + (size_t)row * DM) + lane;
            const u32x2* y1 = (const u32x2*)(YF + ((size_t)TA + row) * DM) + lane;
#pragma unroll
            for (int j = 0; j < 8; ++j) {
                const f32x4 g = gate[64 * j]; const u32x2 a = y0[64 * j], b = y1[64 * j];
                v[j].x += g.x * (bflo(a.x) + bflo(b.x)); v[j].y += g.y * (bfhi(a.x) + bfhi(b.x));
                v[j].z += g.z * (bflo(a.y) + bflo(b.y)); v[j].w += g.w * (bfhi(a.y) + bfhi(b.y));
            }
        }
        if (MODE == 0) {
            f32x4* dst = (f32x4*)(X + (size_t)row * DM) + lane;
#pragma unroll
            for (int j = 0; j < 8; ++j) dst[64 * j] = v[j];
        }
        float ss = 0.f;
#pragma unroll
        for (int j = 0; j < 8; ++j) ss += (v[j].x * v[j].x + v[j].y * v[j].y) + (v[j].z * v[j].z + v[j].w * v[j].w);
        const float rinv = 1.0f / sqrtf(wave_sum(ss) * (1.0f / DM) + 1e-6f);
        if (MODE == 2) {
            f32x4* dst = (f32x4*)(ra.out + (size_t)row * DM) + lane; const f32x4* g4 = (const f32x4*)gv + lane;
#pragma unroll
            for (int j = 0; j < 8; ++j) { const f32x4 g = g4[64 * j]; dst[64 * j] = v[j] * rinv * g; }
        } else {
            const float* mrow = MOD + ((size_t)l * 9 + mr) * MOD_N + (MODE == 0 ? 0 : 3 * DM);
            const f32x4* sh4 = (const f32x4*)mrow + lane; const f32x4* sc4 = (const f32x4*)(mrow + DM) + lane; const f32x4* g4 = (const f32x4*)(gv + (size_t)l * DM) + lane;
            u32x2* dst = (u32x2*)(H + (size_t)row * DM) + lane;
#pragma unroll
            for (int j = 0; j < 8; ++j) {
                const f32x4 g = g4[64 * j], sh = sh4[64 * j], sc = sc4[64 * j];
                v[j] = v[j] * rinv * g * (1.0f + sc) + sh;
                u32x2 o; o.x = pk2(v[j].x, v[j].y); o.y = pk2(v[j].z, v[j].w); dst[64 * j] = o;
            }
        }
        if (MODE == 1) {
            float lg[NEXP];
#pragma unroll
            for (int e = 0; e < NEXP; ++e) {
                float s = 0.f;
#pragma unroll
                for (int j = 0; j < 8; ++j) { const f32x4 w = *(const LAS f32x4*)(rwT + e * RWP + 4 * lane + 256 * j); s += (v[j].x * w.x + v[j].y * w.y) + (v[j].z * w.z + v[j].w * w.w); }
                lg[e] = wave_sum(s);
            }
            float sc[NEXP], sel[NEXP];
#pragma unroll
            for (int e = 0; e < NEXP; ++e) { sc[e] = 1.0f / (1.0f + expf(-lg[e])); sel[e] = sc[e] + ra.router_b[e]; }
            float gs[4], w1g[4], w2g[4]; int i1g[4], i2g[4];
#pragma unroll
            for (int g = 0; g < 4; ++g) {
                int i1 = 0; float m1 = sel[4 * g];
#pragma unroll
                for (int q = 1; q < 4; ++q) if (sel[4 * g + q] > m1) { m1 = sel[4 * g + q]; i1 = q; }
                int i2 = -1; float m2 = -3.0e38f;
#pragma unroll
                for (int q = 0; q < 4; ++q) if (q != i1 && sel[4 * g + q] > m2) { m2 = sel[4 * g + q]; i2 = q; }
                gs[g] = m1 + m2; i1g[g] = 4 * g + i1; i2g[g] = 4 * g + i2;
                float a1 = sc[4 * g], a2 = sc[4 * g];
#pragma unroll
                for (int q = 0; q < 4; ++q) { a1 = (q == i1) ? sc[4 * g + q] : a1; a2 = (q == i2) ? sc[4 * g + q] : a2; }
                w1g[g] = a1; w2g[g] = a2;
            }
            int best = 0; float bs = gs[0];
#pragma unroll
            for (int g = 1; g < 4; ++g) if (gs[g] > bs) { bs = gs[g]; best = g; }
            int e1 = i1g[0], e2 = i2g[0]; float w1 = w1g[0], w2 = w2g[0];
#pragma unroll
            for (int g = 1; g < 4; ++g) { e1 = (best == g) ? i1g[g] : e1; e2 = (best == g) ? i2g[g] : e2; w1 = (best == g) ? w1g[g] : w1; w2 = (best == g) ? w2g[g] : w2; }
            const float inv = 1.0f / (w1 + w2);
            if (lane == 0 && !dry) {
                unsigned* cnt = (unsigned*)(k.ws + WS_CTL) + CW_CNT + 64 * l;
                const int p1 = (int)atomicAdd(cnt + e1, 1u), p2 = (int)atomicAdd(cnt + e2, 1u);
                int* te = (int*)(k.ws + WS_TOPK); float* tw = (float*)(k.ws + WS_TOPK + (size_t)TA * 8); int* tp = (int*)(k.ws + WS_TOPK + 2 * (size_t)TA * 8);
                te[2 * row] = e1; te[2 * row + 1] = e2; tw[2 * row] = w1 * inv; tw[2 * row + 1] = w2 * inv; tp[2 * row] = p1; tp[2 * row + 1] = p2;
            }
        }
    }
    if (MODE == 1) __syncthreads();
}

__device__ __forceinline__ void ph_moe_scatter(const KC& k, int l, int nrows) {
    LAS int* offs = (LAS int*)k.lds;
    const unsigned* cnt = (const unsigned*)(k.ws + WS_CTL) + CW_CNT + 64 * l;
    int* tile = (int*)(k.ws + WS_TAB + TAB_TILE) + 256 * l;
    if (k.tid == 0) {
        int off = 0, nt = 0;
        for (int e = 0; e < NEXP; ++e) {
            offs[e] = off; const int c = (int)__hip_atomic_load(cnt + e, __ATOMIC_RELAXED, __HIP_MEMORY_SCOPE_AGENT); const int t = (c + 255) >> 8;
            if (k.bid == 0) for (int q = 0; q < t; ++q) tile[1 + nt + q] = e;
            nt += t; off += t * 256;
        }
        if (k.bid == 0) tile[0] = nt;
    }
    __syncthreads();
    const int gw = k.bid * 8 + k.wave, NGW = k.G * 8, lane = k.lane;
    const bf16* H = (const bf16*)(k.ws + WS_H); bf16* HP = (bf16*)(k.ws + WS_HP);
    const int* te = (const int*)(k.ws + WS_TOPK); const float* tw = (const float*)(k.ws + WS_TOPK + (size_t)TA * 8); const int* tp = (const int*)(k.ws + WS_TOPK + 2 * (size_t)TA * 8);
    int* rowtok = (int*)(k.ws + WS_TAB + TAB_ROWTOK) + (size_t)l * MOE_ROWS; float* roww = (float*)(k.ws + WS_TAB + TAB_ROWW) + (size_t)l * MOE_ROWS;
    for (int row = gw; row < nrows; row += NGW) {
        const u32x4* src = (const u32x4*)(H + (size_t)row * DM) + lane;
        u32x4 d[4];
#pragma unroll
        for (int j = 0; j < 4; ++j) d[j] = src[64 * j];
#pragma unroll
        for (int s = 0; s < 2; ++s) {
            const int e = te[2 * row + s], dest = offs[e] + tp[2 * row + s];
            u32x4* dp = (u32x4*)(HP + (size_t)dest * DM) + lane;
#pragma unroll
            for (int j = 0; j < 4; ++j) dp[64 * j] = d[j];
            if (lane == 0) { rowtok[dest] = 2 * row + s; roww[dest] = tw[2 * row + s]; }
        }
    }
    __syncthreads();
}
__device__ __forceinline__ void ld16(const bf16* p, bool ok, float (&o)[16]) {
    if (ok) { const u32x4 a = *(const u32x4*)p, b = *(const u32x4*)(p + 8); float x[8], y[8]; unpack8(a, x); unpack8(b, y);
#pragma unroll
        for (int i = 0; i < 8; ++i) { o[i] = x[i]; o[8 + i] = y[i]; } }
    else {
#pragma unroll
        for (int i = 0; i < 16; ++i) o[i] = 0.f; }
}
__device__ __forceinline__ void st16(bf16* p, const float (&v)[16]) {
    float a[8], b[8];
#pragma unroll
    for (int i = 0; i < 8; ++i) { a[i] = v[i]; b[i] = v[8 + i]; }
    *(u32x4*)p = pack8(a); *(u32x4*)(p + 8) = pack8(b);
}
__device__ __forceinline__ void shift8(const bf16* p0, bool hp, bool hn, int c, const float* mu0, const float* mu1, float (&s)[8]) {
    float x[8], xm[8], xp[8];
    unpack8(*(const u32x4*)(p0 + c), x);
    if (hp) unpack8(*(const u32x4*)(p0 - NP + c), xm); else {
#pragma unroll
        for (int i = 0; i < 8; ++i) xm[i] = 0.f; }
    if (hn) unpack8(*(const u32x4*)(p0 + NP + c), xp); else {
#pragma unroll
        for (int i = 0; i < 8; ++i) xp[i] = 0.f; }
    const f32x4 m0a = *(const f32x4*)(mu0 + c), m0b = *(const f32x4*)(mu0 + c + 4), m1a = *(const f32x4*)(mu1 + c), m1b = *(const f32x4*)(mu1 + c + 4);
    const float m0[8] = {m0a.x, m0a.y, m0a.z, m0a.w, m0b.x, m0b.y, m0b.z, m0b.w}, m1[8] = {m1a.x, m1a.y, m1a.z, m1a.w, m1b.x, m1b.y, m1b.z, m1b.w};
#pragma unroll
    for (int i = 0; i < 8; ++i) s[i] = x[i] + m0[i] * (xm[i] - x[i]) + m1[i] * (xp[i] - x[i]);
}
__device__ __forceinline__ void ph_rwkv_prep(const KC& k, int l, int nrows, const float* mu, const float* k_k, const float* r_k) {
    const int gw = k.bid * 8 + k.wave, NGW = k.G * 8, lane = k.lane;
    const bf16* P = (const bf16*)(k.ws + WS_P);
    bf16* R = (bf16*)(k.ws + RW_R); bf16* KS = (bf16*)(k.ws + RW_KS); bf16* V = (bf16*)(k.ws + RW_V); bf16* KK = (bf16*)(k.ws + RW_KK);
    bf16* A1 = (bf16*)(k.ws + RW_A1); bf16* A2 = (bf16*)(k.ws + RW_A2); float* BON = (float*)(k.ws + RW_BON);
    const float* mu0 = mu + (size_t)(l * 2 + 0) * RWKV_IN; const float* mu1 = mu + (size_t)(l * 2 + 1) * RWKV_IN;
    const int rpw = (nrows + NGW - 1) / NGW;
    for (int row = gw * rpw; row < nrows && row < (gw + 1) * rpw; ++row) {
        int t, len; if (row < TL) { t = row & (SEQ - 1); len = SEQ; } else { t = (row - TL) & (CTXL - 1); len = CTXL; }
        const bool hp = t > 0, hn = t < len - 1;
        const bf16* p0 = P + (size_t)row * NP;
#pragma unroll
        for (int half = 0; half < 2; ++half) {
            const int c = half * 512 + 8 * lane;
            float r[8], kx[8], vv[8], kk[8];
            shift8(p0, hp, hn, c, mu0, mu1, r);
            shift8(p0, hp, hn, RD + c, mu0, mu1, kx);
            shift8(p0, hp, hn, 2 * RD + c, mu0, mu1, vv);
            const f32x4 kka = *(const f32x4*)(k_k + l * RD + c), kkb = *(const f32x4*)(k_k + l * RD + c + 4), rka = *(const f32x4*)(r_k + l * RD + c), rkb = *(const f32x4*)(r_k + l * RD + c + 4);
            const float kkw[8] = {kka.x, kka.y, kka.z, kka.w, kkb.x, kkb.y, kkb.z, kkb.w}, rkw[8] = {rka.x, rka.y, rka.z, rka.w, rkb.x, rkb.y, rkb.z, rkb.w};
            float ss = 0.f, bon = 0.f;
#pragma unroll
            for (int i = 0; i < 8; ++i) { kk[i] = kx[i] * kkw[i]; ss += kk[i] * kk[i]; bon += r[i] * kx[i] * rkw[i]; }
            ss += __shfl_xor(ss, 1); ss += __shfl_xor(ss, 2); ss += __shfl_xor(ss, 4);
            bon += __shfl_xor(bon, 1); bon += __shfl_xor(bon, 2); bon += __shfl_xor(bon, 4);
            const float inv = 1.0f / fmaxf(sqrtf(ss), 1e-12f);
#pragma unroll
            for (int i = 0; i < 8; ++i) kk[i] *= inv;
            *(u32x4*)(R + (size_t)row * RD + c) = pack8(r); *(u32x4*)(KS + (size_t)row * RD + c) = pack8(kx);
            *(u32x4*)(V + (size_t)row * RD + c) = pack8(vv); *(u32x4*)(KK + (size_t)row * RD + c) = pack8(kk);
            if ((lane & 7) == 0) BON[(size_t)row * RHEADS + half * 8 + (lane >> 3)] = bon;
        }
        if (lane < 56) {
            float s8[8];
            shift8(p0, hp, hn, 3 * RD + 8 * lane, mu0, mu1, s8);
            if (lane < 12) {
#pragma unroll
                for (int i = 0; i < 8; ++i) { const float e2 = __expf(2.0f * fminf(fmaxf(s8[i], -15.f), 15.f)); s8[i] = 1.0f - 2.0f / (e2 + 1.0f); }
                *(u32x4*)(A1 + (size_t)row * 256 + 8 * lane) = pack8(s8);
            } else if (lane < 24) { *(u32x4*)(A1 + (size_t)row * 256 + 8 * lane) = pack8(s8); }
            else {
#pragma unroll
                for (int i = 0; i < 8; ++i) s8[i] = sigm(s8[i]);
                *(u32x4*)(A2 + (size_t)row * 256 + 8 * (lane - 24)) = pack8(s8);
            }
        } else { *(u32x4*)(A1 + (size_t)row * 256 + 192 + 8 * (lane - 56)) = (u32x4){0u, 0u, 0u, 0u}; }
    }
}

__device__ __forceinline__ float logsig(float x) { return fminf(x, 0.f) - __logf(1.0f + __expf(-fabsf(x))); }
__device__ __forceinline__ int gla_row(bool lat, int b, int s) { return lat ? b * SEQ + (s & 31) * 64 + (s >> 5) : TL + b * CTXL + s; }
constexpr int GQ_PITCH = 264;
constexpr int GPL_AD = 0, GPL_GS = 4096, GPL_QK = GPL_GS + 65536, GPL_END = GPL_QK + 66 * GQ_PITCH * 2;
static_assert(GPL_END <= 131072, "gla prep lds");
__device__ __forceinline__ void ph_gla_prep(const KC& k, int l, const float* conv, const float* aw2, const float* ab) {
    const bf16* P = (const bf16*)(k.ws + WS_P);
    bf16* QG = (bf16*)(k.ws + GL_QG); bf16* KG = (bf16*)(k.ws + GL_KG); bf16* KE = (bf16*)(k.ws + GL_KE); bf16* VS = (bf16*)(k.ws + GL_VS); float* DEC = (float*)(k.ws + GL_DEC);
    const float* cw = conv + (size_t)l * 3 * GQKV;
    const int tid = k.tid, lane = k.lane;
    {
        const int gw = k.bid * 8 + k.wave, NGW = k.G * 8, c = 16 * lane;
        const int rpw = (TA + NGW - 1) / NGW;
        for (int qi = gw * rpw; qi < TA && qi < (gw + 1) * rpw; ++qi) {
            const bool lat = qi < TL; int b, s, len;
            if (lat) { b = qi >> 11; s = qi & 2047; len = SEQ; } else { b = (qi - TL) >> 8; s = (qi - TL) & 255; len = CTXL; }
            const int row = gla_row(lat, b, s);
            const bool hp = s > 0, hn = s + 1 < len;
            const bf16* p0 = P + (size_t)row * NP + GLA_OFF + 2 * GKD + c;
            const bf16* pm = P + (size_t)gla_row(lat, b, hp ? s - 1 : s) * NP + GLA_OFF + 2 * GKD + c;
            const bf16* pp = P + (size_t)gla_row(lat, b, hn ? s + 1 : s) * NP + GLA_OFF + 2 * GKD + c;
            float o[16];
#pragma unroll
            for (int hf = 0; hf < 2; ++hf) {
                float x[8], xm[8], xp[8];
                unpack8(*(const u32x4*)(p0 + 8 * hf), x); unpack8(*(const u32x4*)(pm + 8 * hf), xm); unpack8(*(const u32x4*)(pp + 8 * hf), xp);
                const float* w = cw + 2 * GKD + c + 8 * hf;
#pragma unroll
                for (int q = 0; q < 2; ++q) {
                    const f32x4 w0 = *(const f32x4*)(w + 4 * q), w1 = *(const f32x4*)(w + GQKV + 4 * q), w2 = *(const f32x4*)(w + 2 * GQKV + 4 * q);
#pragma unroll
                    for (int i = 0; i < 4; ++i) o[8 * hf + 4 * q + i] = siluf(w0[i] * (hp ? xm[4 * q + i] : 0.f) + w1[i] * x[4 * q + i] + w2[i] * (hn ? xp[4 * q + i] : 0.f));
                }
            }
            st16(VS + (size_t)row * GVD + c, o);
        }
    }
    LAS float* ADs = (LAS float*)(k.lds + GPL_AD);
    LAS float* Gs = (LAS float*)(k.lds + GPL_GS);
    LAS bf16* QKs = (LAS bf16*)(k.lds + GPL_QK);
    for (int item = k.bid; item < 288 * 4; item += k.G) {
        const int sc = item >> 2, h = item & 3;
        const bool lat = sc < 256; const int b = lat ? (sc >> 5) : ((sc - 256) >> 2), cn = lat ? (sc & 31) : ((sc - 256) & 3), len = lat ? SEQ : CTXL;
        const int gch = lat ? 4 + cn : cn, s0 = 64 * cn;
        for (int i = tid; i < 1024; i += 512) { const int tau = i >> 4, j = i & 15; ADs[i] = bf2f(P[(size_t)gla_row(lat, b, s0 + tau) * NP + GLA_AD_OFF + j]); }
        for (int i = tid; i < 66 * 32; i += 512) {
            const int rr = i >> 5, ck = i & 31, s = s0 - 1 + rr;
            u32x4 v = (u32x4){0u, 0u, 0u, 0u};
            if (s >= 0 && s < len) v = *(const u32x4*)(P + (size_t)gla_row(lat, b, s) * NP + GLA_OFF + (ck >> 4) * GKD + h * GDK + (ck & 15) * 8);
            *(LAS u32x4*)(QKs + rr * GQ_PITCH + ck * 8) = v;
        }
        __syncthreads();
        {
            const int c = tid & 127, tg = tid >> 7, chl = h * GDK + c;
            float awf[16], awb[16];
#pragma unroll
            for (int j = 0; j < 16; ++j) { awf[j] = aw2[((size_t)(l * 2 + 0) * 16 + j) * GKD + chl]; awb[j] = aw2[((size_t)(l * 2 + 1) * 16 + j) * GKD + chl]; }
            const float abf = ab[(l * 2 + 0) * GKD + chl], abb = ab[(l * 2 + 1) * GKD + chl];
            for (int i = 0; i < 16; ++i) {
                const int tau = 16 * tg + i; float xf = abf, xb = abb;
#pragma unroll
                for (int j = 0; j < 16; ++j) { const float a = ADs[tau * 16 + j]; xf += a * awf[j]; xb += a * awb[j]; }
                Gs[tau * 128 + c] = logsig(xf) * (1.0f / 16.0f); Gs[(64 + tau) * 128 + c] = logsig(xb) * (1.0f / 16.0f);
            }
        }
        __syncthreads();
        if (tid < 128) { float run = 0.f; for (int tau = 0; tau < 64; ++tau) { run += Gs[tau * 128 + tid]; Gs[tau * 128 + tid] = run; } }
        else if (tid < 256) { const int c = tid - 128; float run = 0.f; for (int tau = 63; tau >= 0; --tau) { run += Gs[(64 + tau) * 128 + c]; Gs[(64 + tau) * 128 + c] = run; } }
        __syncthreads();
        {
            const int c8 = tid & 15, tg = tid >> 4, chl = h * GDK + 8 * c8;
            float wq[3][8], wk[3][8], elf[8], elb[8];
#pragma unroll
            for (int tp = 0; tp < 3; ++tp) {
                const f32x4 a0 = *(const f32x4*)(cw + tp * GQKV + chl), a1 = *(const f32x4*)(cw + tp * GQKV + chl + 4), b0 = *(const f32x4*)(cw + tp * GQKV + GKD + chl), b1 = *(const f32x4*)(cw + tp * GQKV + GKD + chl + 4);
#pragma unroll
                for (int i = 0; i < 4; ++i) { wq[tp][i] = a0[i]; wq[tp][4 + i] = a1[i]; wk[tp][i] = b0[i]; wk[tp][4 + i] = b1[i]; }
            }
            {
                const f32x4 a0 = *(const LAS f32x4*)(Gs + 63 * 128 + 8 * c8), a1 = *(const LAS f32x4*)(Gs + 63 * 128 + 8 * c8 + 4), b0 = *(const LAS f32x4*)(Gs + 64 * 128 + 8 * c8), b1 = *(const LAS f32x4*)(Gs + 64 * 128 + 8 * c8 + 4);
#pragma unroll
                for (int i = 0; i < 4; ++i) { elf[i] = __expf(a0[i]); elf[4 + i] = __expf(a1[i]); elb[i] = __expf(b0[i]); elb[4 + i] = __expf(b1[i]); }
            }
            if (tg < 8) {
                float* d0 = DEC + ((size_t)(0 * 8 + b) * NCH + gch) * GKD + chl; float* d1 = DEC + ((size_t)(1 * 8 + b) * NCH + gch) * GKD + chl;
                if (tg == 0) { *(f32x4*)d0 = (f32x4){elf[0], elf[1], elf[2], elf[3]}; *(f32x4*)(d0 + 4) = (f32x4){elf[4], elf[5], elf[6], elf[7]}; }
                if (tg == 1) { *(f32x4*)d1 = (f32x4){elb[0], elb[1], elb[2], elb[3]}; *(f32x4*)(d1 + 4) = (f32x4){elb[4], elb[5], elb[6], elb[7]}; }
            }
#pragma unroll
            for (int pass = 0; pass < 2; ++pass) {
                const int tau = tg + 32 * pass;
                float qm[8], q0[8], qp[8], km[8], k0[8], kp[8];
                unpack8(*(const LAS u32x4*)(QKs + (tau + 0) * GQ_PITCH + 8 * c8), qm); unpack8(*(const LAS u32x4*)(QKs + (tau + 1) * GQ_PITCH + 8 * c8), q0); unpack8(*(const LAS u32x4*)(QKs + (tau + 2) * GQ_PITCH + 8 * c8), qp);
                unpack8(*(const LAS u32x4*)(QKs + (tau + 0) * GQ_PITCH + 128 + 8 * c8), km); unpack8(*(const LAS u32x4*)(QKs + (tau + 1) * GQ_PITCH + 128 + 8 * c8), k0); unpack8(*(const LAS u32x4*)(QKs + (tau + 2) * GQ_PITCH + 128 + 8 * c8), kp);
                const f32x4 f0 = *(const LAS f32x4*)(Gs + tau * 128 + 8 * c8), f1 = *(const LAS f32x4*)(Gs + tau * 128 + 8 * c8 + 4), g0 = *(const LAS f32x4*)(Gs + (64 + tau) * 128 + 8 * c8), g1 = *(const LAS f32x4*)(Gs + (64 + tau) * 128 + 8 * c8 + 4);
                const float cf[8] = {f0.x, f0.y, f0.z, f0.w, f1.x, f1.y, f1.z, f1.w}, cb[8] = {g0.x, g0.y, g0.z, g0.w, g1.x, g1.y, g1.z, g1.w};
                float oqf[8], okf[8], oef[8], oqb[8], okb[8], oeb[8];
#pragma unroll
                for (int i = 0; i < 8; ++i) {
                    const float qv = siluf(wq[0][i] * qm[i] + wq[1][i] * q0[i] + wq[2][i] * qp[i]) * 0.08838834764831845f;
                    const float kv = siluf(wk[0][i] * km[i] + wk[1][i] * k0[i] + wk[2][i] * kp[i]);
                    const float ef = __expf(cf[i]), eb = __expf(cb[i]), rf = 1.0f / ef, rb = 1.0f / eb;
                    oqf[i] = qv * ef; okf[i] = kv * rf; oef[i] = kv * rf * elf[i];
                    oqb[i] = qv * eb; okb[i] = kv * rb; oeb[i] = kv * rb * elb[i];
                }
                const size_t o = (size_t)gla_row(lat, b, s0 + tau) * GKD + chl;
                *(u32x4*)(QG + o) = pack8(oqf); *(u32x4*)(KG + o) = pack8(okf); *(u32x4*)(KE + o) = pack8(oef);
                *(u32x4*)(QG + (size_t)TA * GKD + o) = pack8(oqb); *(u32x4*)(KG + (size_t)TA * GKD + o) = pack8(okb); *(u32x4*)(KE + (size_t)TA * GKD + o) = pack8(oeb);
            }
        }
        __syncthreads();
    }
}

__device__ __forceinline__ float dpp_sum16(float x) {
    x += __builtin_bit_cast(float, __builtin_amdgcn_update_dpp(0, __builtin_bit_cast(int, x), 0xB1, 0xF, 0xF, true));
    x += __builtin_bit_cast(float, __builtin_amdgcn_update_dpp(0, __builtin_bit_cast(int, x), 0x4E, 0xF, 0xF, true));
    x += __builtin_bit_cast(float, __builtin_amdgcn_update_dpp(0, __builtin_bit_cast(int, x), 0x141, 0xF, 0xF, true));
    x += __builtin_bit_cast(float, __builtin_amdgcn_update_dpp(0, __builtin_bit_cast(int, x), 0x140, 0xF, 0xF, true));
    return x;
}
constexpr int RS_TOK = 16;
constexpr int RS_TF = 6 * 64;
constexpr int RS_BUF = RS_TOK * RS_TF;
struct RwkvStage { unsigned r, we, a, ks, v, kk; };
__device__ __forceinline__ int rwkv_row(int b, int dir, int p) {
    if (p < CTXL) { const int t = dir ? CTXL - 1 - p : p; return TL + b * CTXL + t; }
    const int q = p - CTXL, t = dir ? SEQ - 1 - q : q; return b * SEQ + t;
}
__device__ __forceinline__ void ph_rwkv_scan(const KC& k, int l, int job, const float* k_a, size_t yoff = RW_Y) {
    const int b = job >> 5, h = (job >> 1) & 15, dir = job & 1;
    const int tid = k.tid;
    const bf16* R = (const bf16*)(k.ws + RW_R); const bf16* KS = (const bf16*)(k.ws + RW_KS); const bf16* V = (const bf16*)(k.ws + RW_V); const bf16* KK = (const bf16*)(k.ws + RW_KK);
    const bf16* LO = (const bf16*)(k.ws + RW_LO); bf16* Y = (bf16*)(k.ws + yoff) + (size_t)dir * TA * RD;
    LAS float* buf = (LAS float*)k.lds;
    LAS f32x2* ypart = (LAS f32x2*)(buf + 2 * RS_BUF);
    const int st = tid >> 5, cp = tid & 31, ch = h * RHS + 2 * cp;
    const float ka0 = k_a[l * RD + ch], ka1 = k_a[l * RD + ch + 1];
    const int kq = tid & 15, rp = tid >> 4, v0 = rp * 2;
    f32x2 S00 = {0.f, 0.f}, S01 = {0.f, 0.f}, S10 = {0.f, 0.f}, S11 = {0.f, 0.f};
    RwkvStage sg;
#define RW_LOAD(chunk) do { const int row_ = rwkv_row(b, dir, (chunk) * RS_TOK + st); \
        sg.r = *(const unsigned*)(R + (size_t)row_ * RD + ch); sg.ks = *(const unsigned*)(KS + (size_t)row_ * RD + ch); \
        sg.v = *(const unsigned*)(V + (size_t)row_ * RD + ch); sg.kk = *(const unsigned*)(KK + (size_t)row_ * RD + ch); \
        sg.we = *(const unsigned*)(LO + (size_t)row_ * 4096 + dir * RD + ch); sg.a = *(const unsigned*)(LO + (size_t)row_ * 4096 + 2048 + dir * RD + ch); } while (0)
#define RW_WRITE(bi) do { LAS float* tb = buf + (bi) * RS_BUF + st * RS_TF + 2 * cp; \
        const float a0 = bflo(sg.a), a1 = bfhi(sg.a), kk0 = bflo(sg.kk), kk1 = bfhi(sg.kk), ks0 = bflo(sg.ks), ks1 = bfhi(sg.ks); \
        *(LAS f32x2*)(tb + 0) = (f32x2){kk0, kk1}; \
        *(LAS f32x2*)(tb + 64) = (f32x2){__expf(-bflo(sg.we)), __expf(-bfhi(sg.we))}; \
        *(LAS f32x2*)(tb + 128) = (f32x2){-kk0 * a0, -kk1 * a1}; \
        *(LAS f32x2*)(tb + 192) = (f32x2){ks0 * (1.0f + (a0 - 1.0f) * ka0), ks1 * (1.0f + (a1 - 1.0f) * ka1)}; \
        *(LAS f32x2*)(tb + 256) = (f32x2){bflo(sg.r), bfhi(sg.r)}; \
        *(LAS f32x2*)(tb + 320) = (f32x2){bflo(sg.v), bfhi(sg.v)}; } while (0)
    constexpr int NCHUNK = (CTXL + SEQ) / RS_TOK;
    RW_LOAD(0); RW_WRITE(0);
    __syncthreads();
    for (int c = 0; c < NCHUNK; ++c) {
        if (c + 1 < NCHUNK) RW_LOAD(c + 1);
        const LAS float* cb = buf + (c & 1) * RS_BUF; LAS f32x2* yb = ypart + (c & 1) * RS_TOK * 256 + rp * 8 + (((kq >> 1) ^ (rp >> 2)) & 7);
        {
            const LAS float* tk = cb + kq * 4; const LAS float* tv = cb + 320 + v0;
#define RW_LD(T, kk4, w4, n4, d4, r4, vv) f32x4 kk4 = *(const LAS f32x4*)(tk + (T) * RS_TF), w4 = *(const LAS f32x4*)(tk + (T) * RS_TF + 64), n4 = *(const LAS f32x4*)(tk + (T) * RS_TF + 128), \
                d4 = *(const LAS f32x4*)(tk + (T) * RS_TF + 192), r4 = *(const LAS f32x4*)(tk + (T) * RS_TF + 256); f32x2 vv = *(const LAS f32x2*)(tv + (T) * RS_TF)
#define RW_STEP(T, kk4, w4, n4, d4, r4, vv) do { \
                const f32x2 kka = {kk4.x, kk4.y}, kkb = {kk4.z, kk4.w}, wa = {w4.x, w4.y}, wb = {w4.z, w4.w}, na = {n4.x, n4.y}, nb = {n4.z, n4.w}, da = {d4.x, d4.y}, db = {d4.z, d4.w}, ra = {r4.x, r4.y}, rb = {r4.z, r4.w}; \
                f32x2 p0 = S00 * kka + S01 * kkb, p1 = S10 * kka + S11 * kkb; \
                const f32x2 u00 = S00 * wa + da * vv.x, u01 = S01 * wb + db * vv.x, u10 = S10 * wa + da * vv.y, u11 = S11 * wb + db * vv.y;     \
                const float sa0 = dpp_sum16(p0.x + p0.y), sa1 = dpp_sum16(p1.x + p1.y); \
                S00 = na * sa0 + u00; S01 = nb * sa0 + u01; S10 = na * sa1 + u10; S11 = nb * sa1 + u11; \
                p0 = S00 * ra + S01 * rb; p1 = S10 * ra + S11 * rb; \
                float y0 = p0.x + p0.y, y1 = p1.x + p1.y; \
                y0 += __builtin_bit_cast(float, __builtin_amdgcn_update_dpp(0, __builtin_bit_cast(int, y0), 0xB1, 0xF, 0xF, true)); \
                y1 += __builtin_bit_cast(float, __builtin_amdgcn_update_dpp(0, __builtin_bit_cast(int, y1), 0xB1, 0xF, 0xF, true)); \
                if ((kq & 1) == 0) yb[(T) * 256] = (f32x2){y0, y1}; } while (0)
            RW_LD(0, kkA, wA, nA, dA, rA, vA);
#pragma unroll
            for (int tau = 0; tau < RS_TOK; tau += 2) {
                RW_LD(tau + 1, kkB, wB, nB, dB, rB, vB);
                RW_STEP(tau, kkA, wA, nA, dA, rA, vA);
                if (tau + 2 < RS_TOK) { RW_LD(tau + 2, kkC, wC, nC, dC, rC, vC); kkA = kkC; wA = wC; nA = nC; dA = dC; rA = rC; vA = vC; }
                RW_STEP(tau + 1, kkB, wB, nB, dB, rB, vB);
            }
#undef RW_LD
#undef RW_STEP
        }
        if (c + 1 < NCHUNK) RW_WRITE((c + 1) & 1);
        __syncthreads();
        {
            const int row = rwkv_row(b, dir, c * RS_TOK + st);
            const LAS f32x2* yq = ypart + (c & 1) * RS_TOK * 256 + st * 256 + cp * 8;
            f32x2 acc = yq[(0 ^ (cp >> 2)) & 7];
#pragma unroll
            for (int j = 1; j < 8; ++j) acc += yq[(j ^ (cp >> 2)) & 7];
            *(unsigned*)(Y + (size_t)row * RD + ch) = pk2(acc.x, acc.y);
        }
    }
    __syncthreads();
}

constexpr int GP1 = 136, GP2 = 72;
constexpr int GL_QGS = 0, GL_KGS = GL_QGS + 64 * GP1 * 2, GL_STS = GL_KGS + 64 * GP1 * 2, GL_KET = GL_STS + 64 * GP1 * 2, GL_VT = GL_KET + 128 * GP2 * 2, GL_ATT = GL_VT + 64 * GP2 * 2,
              GL_DECS = GL_ATT + 64 * GP2 * 2, GL_LDS_END = GL_DECS + 512;
static_assert(GL_LDS_END <= 131072, "gla lds");
__device__ __forceinline__ bf16x8 ldfrag(const LAS bf16* base, int row, int pitch, int kofs) { return *(const LAS bf16x8*)(base + row * pitch + kofs); }
__device__ __forceinline__ int gla_prow(int b, int dir, int cp, int tau) {
    const bool lat = cp >= 4; const int q = lat ? cp - 4 : cp, ncn = lat ? 32 : 4, cn = dir ? ncn - 1 - q : q;
    return gla_row(lat, b, dir ? 64 * cn + 63 - tau : 64 * cn + tau);
}
__device__ __forceinline__ int gla_gch(int dir, int cp) { const bool lat = cp >= 4; const int q = lat ? cp - 4 : cp, ncn = lat ? 32 : 4, cn = dir ? ncn - 1 - q : q; return lat ? 4 + cn : cn; }
__device__ __forceinline__ bf16x8 ldfrag_sw(const LAS bf16* base, int row, int g) { return *(const LAS bf16x8*)(base + row * GP2 + ((g ^ ((row >> 3) & 7)) << 3)); }
__device__ __forceinline__ void ph_gla_scan(const KC& k, int job) {
    const int b = job >> 5, h = (job >> 3) & 3, dir = (job >> 2) & 1, dvq = job & 3;
    const int tid = k.tid, w = k.wave, lane = k.lane, q4 = lane >> 4, l15 = lane & 15;
    const bf16* QG = (const bf16*)(k.ws + GL_QG) + (size_t)dir * TA * GKD; const bf16* KG = (const bf16*)(k.ws + GL_KG) + (size_t)dir * TA * GKD;
    const bf16* KE = (const bf16*)(k.ws + GL_KE) + (size_t)dir * TA * GKD; const bf16* VS = (const bf16*)(k.ws + GL_VS);
    const float* DEC = (const float*)(k.ws + GL_DEC); bf16* O = (bf16*)(k.ws + GL_O) + (size_t)dir * TA * GVD;
    LAS bf16* QGs = (LAS bf16*)(k.lds + GL_QGS); LAS bf16* KGs = (LAS bf16*)(k.lds + GL_KGS); LAS bf16* STs = (LAS bf16*)(k.lds + GL_STS);
    LAS bf16* KEt = (LAS bf16*)(k.lds + GL_KET); LAS bf16* Vt = (LAS bf16*)(k.lds + GL_VT); LAS bf16* ATT = (LAS bf16*)(k.lds + GL_ATT); LAS float* decs = (LAS float*)(k.lds + GL_DECS);
    f32x4 accS[4];
#pragma unroll
    for (int t = 0; t < 4; ++t) accS[t] = (f32x4){0.f, 0.f, 0.f, 0.f};
    const int tw = w & 3, wh = w >> 2;
    u32x4 pq[2], pk[2], pe[2], pv; float pd = 0.f;
#define GLA_PREFETCH(CP) do { _Pragma("unroll") for (int i = 0; i < 2; ++i) { const int idx = tid + 512 * i, tau = idx >> 4, ck = idx & 15; \
            const size_t go = (size_t)gla_prow(b, dir, (CP), tau) * GKD + h * GDK + ck * 8; pq[i] = *(const u32x4*)(QG + go); pk[i] = *(const u32x4*)(KG + go); pe[i] = *(const u32x4*)(KE + go); } \
        pv = *(const u32x4*)(VS + (size_t)gla_prow(b, dir, (CP), tid >> 3) * GVD + h * GDV + dvq * 64 + (tid & 7) * 8); \
        if (tid < 128) pd = DEC[((size_t)(dir * 8 + b) * NCH + gla_gch(dir, (CP))) * GKD + h * GDK + tid]; } while (0)
    GLA_PREFETCH(0);
    for (int cp = 0; cp < NCH; ++cp) {
#define GROW(tau) gla_prow(b, dir, cp, (tau))
#pragma unroll
        for (int i = 0; i < 2; ++i) {
            const int idx = tid + 512 * i, tau = idx >> 4, ck = idx & 15;
            *(LAS u32x4*)(QGs + tau * GP1 + ck * 8) = pq[i];
            *(LAS u32x4*)(KGs + tau * GP1 + ck * 8) = pk[i];
            const unsigned kw[4] = {pe[i].x, pe[i].y, pe[i].z, pe[i].w};
#pragma unroll
            for (int e = 0; e < 4; ++e) { const int ts = tau ^ ((ck & 7) << 3); KEt[(ck * 8 + 2 * e) * GP2 + ts] = (bf16)(kw[e] & 0xffffu); KEt[(ck * 8 + 2 * e + 1) * GP2 + ts] = (bf16)(kw[e] >> 16); }
        }
        {
            const int tau = tid >> 3, ck = tid & 7;
            const unsigned vw[4] = {pv.x, pv.y, pv.z, pv.w};
#pragma unroll
            for (int e = 0; e < 4; ++e) { const int ts = tau ^ (ck << 3); Vt[(ck * 8 + 2 * e) * GP2 + ts] = (bf16)(vw[e] & 0xffffu); Vt[(ck * 8 + 2 * e + 1) * GP2 + ts] = (bf16)(vw[e] >> 16); }
        }
        if (tid < 128) decs[tid] = pd;
#pragma unroll
        for (int t = 0; t < 4; ++t) {
            const int dkt = wh * 4 + t;
#pragma unroll
            for (int r = 0; r < 4; ++r) STs[(16 * tw + 4 * q4 + r) * GP1 + 16 * dkt + l15] = (bf16)f2bf(accS[t][r]);
        }
        __syncthreads();
        if (cp + 1 < NCH) GLA_PREFETCH(cp + 1);
#pragma unroll
        for (int jj = 0; jj < 2; ++jj) {
            const int it = tw, jt = wh * 2 + jj;
            f32x4 acc = (f32x4){0.f, 0.f, 0.f, 0.f};
#pragma unroll
            for (int ks = 0; ks < 4; ++ks) acc = __builtin_amdgcn_mfma_f32_16x16x32_bf16(ldfrag(QGs, 16 * it + l15, GP1, 32 * ks + 8 * q4), ldfrag(KGs, 16 * jt + l15, GP1, 32 * ks + 8 * q4), acc, 0, 0, 0);
#pragma unroll
            for (int r = 0; r < 4; ++r) { const int i = 16 * it + 4 * q4 + r, j = 16 * jt + l15; ATT[i * GP2 + j] = (bf16)f2bf(j <= i ? acc[r] : 0.f); }
        }
        __syncthreads();
#pragma unroll
        for (int dd = 0; dd < 2; ++dd) {
            const int it = tw, dvt = wh * 2 + dd;
            f32x4 acc = (f32x4){0.f, 0.f, 0.f, 0.f};
#pragma unroll
            for (int ks = 0; ks < 4; ++ks) acc = __builtin_amdgcn_mfma_f32_16x16x32_bf16(ldfrag(QGs, 16 * it + l15, GP1, 32 * ks + 8 * q4), ldfrag(STs, 16 * dvt + l15, GP1, 32 * ks + 8 * q4), acc, 0, 0, 0);
#pragma unroll
            for (int ks = 0; ks < 2; ++ks) acc = __builtin_amdgcn_mfma_f32_16x16x32_bf16(ldfrag(ATT, 16 * it + l15, GP2, 32 * ks + 8 * q4), ldfrag_sw(Vt, 16 * dvt + l15, 4 * ks + q4), acc, 0, 0, 0);
#pragma unroll
            for (int r = 0; r < 4; ++r) { const int i = 16 * it + 4 * q4 + r; O[(size_t)GROW(i) * GVD + h * GDV + dvq * 64 + 16 * dvt + l15] = (bf16)f2bf(acc[r]); }
        }
#pragma unroll
        for (int t = 0; t < 4; ++t) {
            const int dkt = wh * 4 + t; const float d = decs[16 * dkt + l15];
            accS[t] = accS[t] * d;
#pragma unroll
            for (int ks = 0; ks < 2; ++ks) accS[t] = __builtin_amdgcn_mfma_f32_16x16x32_bf16(ldfrag_sw(Vt, 16 * tw + l15, 4 * ks + q4), ldfrag_sw(KEt, 16 * dkt + l15, 4 * ks + q4), accS[t], 0, 0, 0);
        }
        __syncthreads();
#undef GROW
    }
#undef GLA_PREFETCH
}

#ifndef HB_FULL
#define HB_FULL 0
#endif
#ifndef GLA4_LEVEL
#define GLA4_LEVEL 0
#endif
#ifndef GLA4_NOSTORE
#define GLA4_NOSTORE 0
#endif
#ifndef SWAP_HALVES
#define SWAP_HALVES 0
#endif
#ifndef SPLIT_SCAN
#define SPLIT_SCAN 0
#endif
constexpr int RS4_TOK = 8, RS4_BUF = RS4_TOK * RS_TF;
constexpr int SC_GL = 0;
constexpr int SC_RW = 96 * 1024;
constexpr int SC_END = SC_RW + 2 * RS4_BUF * 4 + 2 * RS4_TOK * 64 * 4;
static_assert(SC_GL + GL_LDS_END <= SC_RW, "scan lds halves");
constexpr int SC_CTR = 127 * 1024;
static_assert(SC_END <= SC_CTR && SC_CTR + 128 <= 131072, "scan lds");
__device__ __forceinline__ void half_bar(LAS unsigned* ctr, unsigned& gen, int lane) {
#if HB_FULL
    (void)ctr; (void)lane; gen += 4u; __syncthreads(); return;
#endif
    gen += 4u;
    __builtin_amdgcn_fence(__ATOMIC_RELEASE, "workgroup");
    if (lane == 0) __hip_atomic_fetch_add(ctr, 1u, __ATOMIC_RELAXED, __HIP_MEMORY_SCOPE_WORKGROUP);
    unsigned spins = 0;
    while (__hip_atomic_load(ctr, __ATOMIC_RELAXED, __HIP_MEMORY_SCOPE_WORKGROUP) < gen) { __builtin_amdgcn_s_sleep(1); if (++spins > (1u << 26)) break; }
    __builtin_amdgcn_fence(__ATOMIC_ACQUIRE, "workgroup");
}
#ifndef RW4_SHFL
#define RW4_SHFL 0
#endif
__device__ __forceinline__ float shfl_sum16(float x) { x += __shfl_xor(x, 1); x += __shfl_xor(x, 2); x += __shfl_xor(x, 4); x += __shfl_xor(x, 8); return x; }
#if RW4_SHFL
#define RW4_SUM16(x) shfl_sum16(x)
#else
#define RW4_SUM16(x) dpp_sum16(x)
#endif
__device__ __forceinline__ void rwkv_scan_4w(const KC& k, int l, int job, const float* k_a, LAS unsigned* ctr) {
    const int b = job >> 5, h = (job >> 1) & 15, dir = job & 1;
    const int tid = k.tid, lane = k.lane;
    const bf16* R = (const bf16*)(k.ws + RW_R); const bf16* KS = (const bf16*)(k.ws + RW_KS); const bf16* V = (const bf16*)(k.ws + RW_V); const bf16* KK = (const bf16*)(k.ws + RW_KK);
    const bf16* LO = (const bf16*)(k.ws + RW_LO); bf16* Y = (bf16*)(k.ws + RW_Y) + (size_t)dir * TA * RD;
    LAS float* buf = (LAS float*)(k.lds + SC_RW);
    LAS float* ybuf = buf + 2 * RS4_BUF;
    const int st = tid >> 5, cp = tid & 31, ch = h * RHS + 2 * cp;
    const float ka0 = k_a[l * RD + ch], ka1 = k_a[l * RD + ch + 1];
    const int kq = tid & 15, v0 = (tid >> 4) * 4;
    f32x2 S[4][2];
#pragma unroll
    for (int i = 0; i < 4; ++i) { S[i][0] = (f32x2){0.f, 0.f}; S[i][1] = (f32x2){0.f, 0.f}; }
    RwkvStage sg[1];
    unsigned gen = 0;
#define RW4_LOAD(chunk) do { _Pragma("unroll") for (int q_ = 0; q_ < 1; ++q_) { const int row_ = rwkv_row(b, dir, (chunk) * RS4_TOK + st); \
        sg[q_].r = *(const unsigned*)(R + (size_t)row_ * RD + ch); sg[q_].ks = *(const unsigned*)(KS + (size_t)row_ * RD + ch); \
        sg[q_].v = *(const unsigned*)(V + (size_t)row_ * RD + ch); sg[q_].kk = *(const unsigned*)(KK + (size_t)row_ * RD + ch); \
        sg[q_].we = *(const unsigned*)(LO + (size_t)row_ * 4096 + dir * RD + ch); sg[q_].a = *(const unsigned*)(LO + (size_t)row_ * 4096 + 2048 + dir * RD + ch); } } while (0)
#define RW4_WRITE(bi) do { _Pragma("unroll") for (int q_ = 0; q_ < 1; ++q_) { LAS float* tb = buf + (bi) * RS4_BUF + st * RS_TF + 2 * cp; \
        const float a0 = bflo(sg[q_].a), a1 = bfhi(sg[q_].a), kk0 = bflo(sg[q_].kk), kk1 = bfhi(sg[q_].kk), ks0 = bflo(sg[q_].ks), ks1 = bfhi(sg[q_].ks); \
        *(LAS f32x2*)(tb + 0) = (f32x2){kk0, kk1}; \
        *(LAS f32x2*)(tb + 64) = (f32x2){__expf(-bflo(sg[q_].we)), __expf(-bfhi(sg[q_].we))}; \
        *(LAS f32x2*)(tb + 128) = (f32x2){-kk0 * a0, -kk1 * a1}; \
        *(LAS f32x2*)(tb + 192) = (f32x2){ks0 * (1.0f + (a0 - 1.0f) * ka0), ks1 * (1.0f + (a1 - 1.0f) * ka1)}; \
        *(LAS f32x2*)(tb + 256) = (f32x2){bflo(sg[q_].r), bfhi(sg[q_].r)}; \
        *(LAS f32x2*)(tb + 320) = (f32x2){bflo(sg[q_].v), bfhi(sg[q_].v)}; } } while (0)
    constexpr int NCHUNK = (CTXL + SEQ) / RS4_TOK;
    RW4_LOAD(0); RW4_WRITE(0);
    half_bar(ctr, gen, lane);
    for (int c = 0; c < NCHUNK; ++c) {
        if (c + 1 < NCHUNK) RW4_LOAD(c + 1);
        const LAS float* cb = buf + (c & 1) * RS4_BUF; LAS float* yb = ybuf + (c & 1) * RS4_TOK * 64;
        {
            const LAS float* tk = cb + kq * 4; const LAS float* tv = cb + 320 + v0;
#define RW4_LD(T, kk4, w4, n4, d4, r4, vv) f32x4 kk4 = *(const LAS f32x4*)(tk + (T) * RS_TF), w4 = *(const LAS f32x4*)(tk + (T) * RS_TF + 64), n4 = *(const LAS f32x4*)(tk + (T) * RS_TF + 128), \
                d4 = *(const LAS f32x4*)(tk + (T) * RS_TF + 192), r4 = *(const LAS f32x4*)(tk + (T) * RS_TF + 256), vv = *(const LAS f32x4*)(tv + (T) * RS_TF)
#define RW4_STEP(T, kk4, w4, n4, d4, r4, vv) do { \
                const f32x2 kka = {kk4.x, kk4.y}, kkb = {kk4.z, kk4.w}, wa = {w4.x, w4.y}, wb = {w4.z, w4.w}, na = {n4.x, n4.y}, nb = {n4.z, n4.w}, da = {d4.x, d4.y}, db = {d4.z, d4.w}, ra = {r4.x, r4.y}, rb = {r4.z, r4.w}; \
                float sa[4], yy[4]; f32x2 u0[4], u1[4]; \
                _Pragma("unroll") for (int i = 0; i < 4; ++i) { const f32x2 p = S[i][0] * kka + S[i][1] * kkb; sa[i] = p.x + p.y; u0[i] = S[i][0] * wa + da * vv[i]; u1[i] = S[i][1] * wb + db * vv[i]; } \
                _Pragma("unroll") for (int i = 0; i < 4; ++i) sa[i] = RW4_SUM16(sa[i]); \
                _Pragma("unroll") for (int i = 0; i < 4; ++i) { S[i][0] = na * sa[i] + u0[i]; S[i][1] = nb * sa[i] + u1[i]; const f32x2 q = S[i][0] * ra + S[i][1] * rb; yy[i] = q.x + q.y; } \
                _Pragma("unroll") for (int i = 0; i < 4; ++i) yy[i] = RW4_SUM16(yy[i]); \
                if (kq == 0) *(LAS f32x4*)(yb + (T) * 64 + v0) = (f32x4){yy[0], yy[1], yy[2], yy[3]}; } while (0)
            RW4_LD(0, kkA, wA, nA, dA, rA, vA);
#pragma unroll
            for (int tau = 0; tau < RS4_TOK; tau += 2) {
                RW4_LD(tau + 1, kkB, wB, nB, dB, rB, vB);
                RW4_STEP(tau, kkA, wA, nA, dA, rA, vA);
                if (tau + 2 < RS4_TOK) { RW4_LD(tau + 2, kkC, wC, nC, dC, rC, vC); kkA = kkC; wA = wC; nA = nC; dA = dC; rA = rC; vA = vC; }
                RW4_STEP(tau + 1, kkB, wB, nB, dB, rB, vB);
            }
#undef RW4_LD
#undef RW4_STEP
        }
        if (c + 1 < NCHUNK) RW4_WRITE((c + 1) & 1);
        half_bar(ctr, gen, lane);
        {
            const int row = rwkv_row(b, dir, c * RS4_TOK + st);
            const f32x2 yy = *(const LAS f32x2*)(yb + st * 64 + 2 * cp);
            *(unsigned*)(Y + (size_t)row * RD + ch) = pk2(yy.x, yy.y);
        }
    }
#undef RW4_LOAD
#undef RW4_WRITE
}
__device__ __forceinline__ void gla_scan_4w(const KC& k, int job, LAS unsigned* ctr) {
    const int b = job >> 5, h = (job >> 3) & 3, dir = (job >> 2) & 1, dvq = job & 3;
    const int tid = k.tid - 256, w = k.wave - 4, lane = k.lane, q4 = lane >> 4, l15 = lane & 15;
    const bf16* QG = (const bf16*)(k.ws + GL_QG) + (size_t)dir * TA * GKD; const bf16* KG = (const bf16*)(k.ws + GL_KG) + (size_t)dir * TA * GKD;
    const bf16* KE = (const bf16*)(k.ws + GL_KE) + (size_t)dir * TA * GKD; const bf16* VS = (const bf16*)(k.ws + GL_VS);
    const float* DEC = (const float*)(k.ws + GL_DEC); bf16* O = (bf16*)(k.ws + GL_O) + (size_t)dir * TA * GVD;
    LAS unsigned char* gl = k.lds + SC_GL;
    LAS bf16* QGs = (LAS bf16*)(gl + GL_QGS); LAS bf16* KGs = (LAS bf16*)(gl + GL_KGS); LAS bf16* STs = (LAS bf16*)(gl + GL_STS);
    LAS bf16* KEt = (LAS bf16*)(gl + GL_KET); LAS bf16* Vt = (LAS bf16*)(gl + GL_VT); LAS bf16* ATT = (LAS bf16*)(gl + GL_ATT); LAS float* decs = (LAS float*)(gl + GL_DECS);
    f32x4 accS[8];
#pragma unroll
    for (int t = 0; t < 8; ++t) accS[t] = (f32x4){0.f, 0.f, 0.f, 0.f};
    unsigned gen = 0;
#if GLA4_LEVEL == 2
    { float x = (float)lane; for (int i = 0; i < 200000; ++i) { x = x * 1.0001f + 0.5f; asm volatile("" : "+v"(x)); } asm volatile("" :: "v"(x)); (void)ctr; (void)gen; }
    return;
#endif
#if GLA4_LEVEL == 1
    for (int cp = 0; cp < NCH; ++cp) { float x = (float)lane; for (int i = 0; i < 2000; ++i) x = x * 1.0001f + 0.5f; asm volatile("" :: "v"(x)); half_bar(ctr, gen, lane); half_bar(ctr, gen, lane); half_bar(ctr, gen, lane); }
    return;
#endif
    for (int cp = 0; cp < NCH; ++cp) {
        const bool lat = cp >= 4; const int q = lat ? cp - 4 : cp, ncn = lat ? 32 : 4, cn = dir ? ncn - 1 - q : q, gch = lat ? 4 + cn : cn;
#define GROW(tau) gla_row(lat, b, dir ? 64 * cn + 63 - (tau) : 64 * cn + (tau))
#pragma unroll
        for (int i = 0; i < 4; ++i) {
            const int idx = tid + 256 * i, tau = idx >> 4, ck = idx & 15; const size_t go = (size_t)GROW(tau) * GKD + h * GDK + ck * 8;
            *(LAS u32x4*)(QGs + tau * GP1 + ck * 8) = *(const u32x4*)(QG + go);
            *(LAS u32x4*)(KGs + tau * GP1 + ck * 8) = *(const u32x4*)(KG + go);
            const u32x4 ke = *(const u32x4*)(KE + go);
            const unsigned kw[4] = {ke.x, ke.y, ke.z, ke.w};
#pragma unroll
            for (int e = 0; e < 4; ++e) { KEt[(ck * 8 + 2 * e) * GP2 + tau] = (bf16)(kw[e] & 0xffffu); KEt[(ck * 8 + 2 * e + 1) * GP2 + tau] = (bf16)(kw[e] >> 16); }
        }
#pragma unroll
        for (int i = 0; i < 2; ++i) {
            const int idx = tid + 256 * i, tau = idx >> 3, ck = idx & 7;
            const u32x4 vv = *(const u32x4*)(VS + (size_t)GROW(tau) * GVD + h * GDV + dvq * 64 + ck * 8);
            const unsigned vw[4] = {vv.x, vv.y, vv.z, vv.w};
#pragma unroll
            for (int e = 0; e < 4; ++e) { Vt[(ck * 8 + 2 * e) * GP2 + tau] = (bf16)(vw[e] & 0xffffu); Vt[(ck * 8 + 2 * e + 1) * GP2 + tau] = (bf16)(vw[e] >> 16); }
        }
        if (tid < 128) decs[tid] = DEC[((size_t)(dir * 8 + b) * NCH + gch) * GKD + h * GDK + tid];
#pragma unroll
        for (int t = 0; t < 8; ++t) {
#pragma unroll
            for (int r = 0; r < 4; ++r) STs[(16 * w + 4 * q4 + r) * GP1 + 16 * t + l15] = (bf16)f2bf(accS[t][r]);
        }
        half_bar(ctr, gen, lane);
#pragma unroll
        for (int jt = 0; jt < 4; ++jt) {
            f32x4 acc = (f32x4){0.f, 0.f, 0.f, 0.f};
#pragma unroll
            for (int ks = 0; ks < 4; ++ks) acc = __builtin_amdgcn_mfma_f32_16x16x32_bf16(ldfrag(QGs, 16 * w + l15, GP1, 32 * ks + 8 * q4), ldfrag(KGs, 16 * jt + l15, GP1, 32 * ks + 8 * q4), acc, 0, 0, 0);
#pragma unroll
            for (int r = 0; r < 4; ++r) { const int i = 16 * w + 4 * q4 + r, j = 16 * jt + l15; ATT[i * GP2 + j] = (bf16)f2bf(j <= i ? acc[r] : 0.f); }
        }
        half_bar(ctr, gen, lane);
#pragma unroll
        for (int dvt = 0; dvt < 4; ++dvt) {
            f32x4 acc = (f32x4){0.f, 0.f, 0.f, 0.f};
#pragma unroll
            for (int ks = 0; ks < 4; ++ks) acc = __builtin_amdgcn_mfma_f32_16x16x32_bf16(ldfrag(QGs, 16 * w + l15, GP1, 32 * ks + 8 * q4), ldfrag(STs, 16 * dvt + l15, GP1, 32 * ks + 8 * q4), acc, 0, 0, 0);
#pragma unroll
            for (int ks = 0; ks < 2; ++ks) acc = __builtin_amdgcn_mfma_f32_16x16x32_bf16(ldfrag(ATT, 16 * w + l15, GP2, 32 * ks + 8 * q4), ldfrag(Vt, 16 * dvt + l15, GP2, 32 * ks + 8 * q4), acc, 0, 0, 0);
#pragma unroll
#if GLA4_NOSTORE
            asm volatile("" :: "v"(acc[0]), "v"(acc[1]), "v"(acc[2]), "v"(acc[3]));
#else
            for (int r = 0; r < 4; ++r) { const int i = 16 * w + 4 * q4 + r; O[(size_t)GROW(i) * GVD + h * GDV + dvq * 64 + 16 * dvt + l15] = (bf16)f2bf(acc[r]); }
#endif
        }
#pragma unroll
        for (int t = 0; t < 8; ++t) {
            const float d = decs[16 * t + l15];
            accS[t] = accS[t] * d;
#pragma unroll
            for (int ks = 0; ks < 2; ++ks) accS[t] = __builtin_amdgcn_mfma_f32_16x16x32_bf16(ldfrag(Vt, 16 * w + l15, GP2, 32 * ks + 8 * q4), ldfrag(KEt, 16 * t + l15, GP2, 32 * ks + 8 * q4), accS[t], 0, 0, 0);
        }
        half_bar(ctr, gen, lane);
#undef GROW
    }
#if HB_FULL
    for (int i = 0; i < (1 + (CTXL + SEQ) / RS4_TOK) - 3 * NCH; ++i) __syncthreads();
#endif
}
__device__ __forceinline__ void ph_scan_split(const KC& k, int l, const float* k_a) {
    LAS unsigned* ctr = (LAS unsigned*)(k.lds + SC_CTR);
    for (int job = k.bid; job < 256; job += k.G) {
        if (k.tid == 0) { ctr[0] = 0u; ctr[16] = 0u; }
        __syncthreads();
#if SPLIT_SCAN == 1 || SPLIT_SCAN == 4 || SPLIT_SCAN == 5 || SPLIT_SCAN == 6
#if SWAP_HALVES
        { KC k2 = k; if (k.wave >= 4) { k2.tid = k.tid - 256; k2.wave = k.wave - 4; rwkv_scan_4w(k2, l, job, k_a, ctr); } else { k2.tid = k.tid + 256; k2.wave = k.wave + 4; gla_scan_4w(k2, job, ctr + 16); } }
#else
        if (k.wave < 4) rwkv_scan_4w(k, l, job, k_a, ctr); else gla_scan_4w(k, job, ctr + 16);
#endif
        __syncthreads();
#if SPLIT_SCAN == 6
        ph_rwkv_scan(k, l, job, k_a, WS_H);
#elif SPLIT_SCAN == 4
        ph_rwkv_scan(k, l, job, k_a);
#elif SPLIT_SCAN == 5
        ph_gla_scan(k, job);
#endif
#elif SPLIT_SCAN == 2
        if (k.wave < 4) rwkv_scan_4w(k, l, job, k_a, ctr);
        __syncthreads();
        ph_gla_scan(k, job);
#else
        if (k.wave >= 4) gla_scan_4w(k, job, ctr + 16);
        __syncthreads();
        ph_rwkv_scan(k, l, job, k_a);
#endif
    }
}

__device__ __forceinline__ void ph_post(const KC& k, int l, int nrows, const float* ln_g, const float* ln_b, const float* gng) {
    const int gw = k.bid * 8 + k.wave, NGW = k.G * 8, lane = k.lane, c = 16 * lane;
    const bf16* P = (const bf16*)(k.ws + WS_P);
    const bf16* Y = (const bf16*)(k.ws + RW_Y); const bf16* V = (const bf16*)(k.ws + RW_V); const float* BON = (const float*)(k.ws + RW_BON); bf16* YNB = (bf16*)(k.ws + RW_R);
    const bf16* O = (const bf16*)(k.ws + GL_O); bf16* YB = (bf16*)(k.ws + GL_VS);
    for (int row = gw; row < nrows; row += NGW) {
        {
            float yf[16], yb[16], vv[16], y[16];
            ld16(Y + (size_t)row * RD + c, true, yf); ld16(Y + ((size_t)TA + row) * RD + c, true, yb); ld16(V + (size_t)row * RD + c, true, vv);
            float s = 0.f;
#pragma unroll
            for (int i = 0; i < 16; ++i) { y[i] = yf[i] + yb[i]; s += y[i]; }
            s += __shfl_xor(s, 1); s += __shfl_xor(s, 2);
            const float mean = s * (1.0f / 64.0f); float q = 0.f;
#pragma unroll
            for (int i = 0; i < 16; ++i) { y[i] -= mean; q += y[i] * y[i]; }
            q += __shfl_xor(q, 1); q += __shfl_xor(q, 2);
            const float rstd = 1.0f / sqrtf(q * (1.0f / 64.0f) + 64e-5f), bon = BON[(size_t)row * RHEADS + (lane >> 2)];
#pragma unroll
            for (int i = 0; i < 16; ++i) y[i] = y[i] * rstd * ln_g[l * RD + c + i] + ln_b[l * RD + c + i] + bon * vv[i];
            st16(YNB + (size_t)row * RD + c, y);
        }
        {
            float of[16], ob[16], gt[16], o[16];
            ld16(O + (size_t)row * GVD + c, true, of); ld16(O + ((size_t)TA + row) * GVD + c, true, ob); ld16(P + (size_t)row * NP + GLA_GATE_OFF + c, true, gt);
            float s = 0.f;
#pragma unroll
            for (int i = 0; i < 16; ++i) { o[i] = of[i] + ob[i]; s += o[i] * o[i]; }
            s += __shfl_xor(s, 1); s += __shfl_xor(s, 2); s += __shfl_xor(s, 4); s += __shfl_xor(s, 8);
            const float rinv = 1.0f / sqrtf(s * (1.0f / 256.0f) + 1e-6f);
#pragma unroll
            for (int i = 0; i < 16; ++i) o[i] = o[i] * rinv * gng[l * GDV + ((c + i) & 255)] * siluf(gt[i]);
            st16(YB + (size_t)row * GVD + c, o);
        }
    }
}
using pg8::Unit;
struct FP_ { bf16* P; __device__ __forceinline__ void operator()(int row, int col, float (&v)[8], const Unit&) const { *(u32x4*)(P + (size_t)row * NP + col) = pack8(v); } };
struct FL1_ { bf16* LO; const float* bias1;
    __device__ __forceinline__ void operator()(int row, int col, float (&v)[8], const Unit& u) const {
        const float* bias = bias1 + col;
        const f32x4 b0 = *(const f32x4*)bias, b1 = *(const f32x4*)(bias + 4);
        const float bb[8] = {b0.x, b0.y, b0.z, b0.w, b1.x, b1.y, b1.z, b1.w};
        const float sc = col < 2048 ? 0.6065306597126334f : 1.0f;
#pragma unroll
        for (int i = 0; i < 8; ++i) v[i] = sigm(bb[i] + v[i]) * sc;
        *(u32x4*)(LO + (size_t)row * 4096 + col) = pack8(v);
    } };
struct FL2_ { const bf16* YNB; bf16* YA;
    __device__ __forceinline__ void operator()(int row, int col, float (&v)[8], const Unit&) const {
        float y[8]; unpack8(*(const u32x4*)(YNB + (size_t)row * RD + col), y);
#pragma unroll
        for (int i = 0; i < 8; ++i) v[i] *= y[i];
        *(u32x4*)(YA + (size_t)row * RD + col) = pack8(v);
    } };
template <int SECOND> struct FM_ { const bf16* P; bf16* MA;
    __device__ __forceinline__ void operator()(int row, int col, float (&v)[8], const Unit&) const {
        float g[8]; unpack8(*(const u32x4*)(P + (size_t)row * NP + BR_OFF + SECOND * DM + col), g);
        bf16* mp = MA + (size_t)row * DM + col;
        if (SECOND) { float m[8]; unpack8(*(const u32x4*)mp, m);
#pragma unroll
            for (int i = 0; i < 8; ++i) v[i] = sigm(g[i]) * v[i] + m[i]; }
        else {
#pragma unroll
            for (int i = 0; i < 8; ++i) v[i] = sigm(g[i]) * v[i]; }
        *(u32x4*)mp = pack8(v);
    } };
struct FX_ { float* X; const float* MOD; int l;
    __device__ __forceinline__ void operator()(int row, int col, const f32x4 v, const Unit&) const {
        const f32x4 g = *(const f32x4*)(MOD + ((size_t)l * 9 + mod_row(row)) * MOD_N + 2 * DM + col);
        f32x4* xp = (f32x4*)(X + (size_t)row * DM + col);
        *xp = *xp + g * v;
    } };
struct FE1_ { bf16* ACT;
    __device__ __forceinline__ void operator()(int row, int col, float (&g)[8], float (&up)[8]) const {
#pragma unroll
        for (int i = 0; i < 8; ++i) g[i] = siluf(g[i]) * up[i];
        *(u32x4*)(ACT + (size_t)row * DEXP + col) = pack8(g);
    } };
struct FE2_ { const int* rowtok; const float* roww; bf16* YF;
    __device__ __forceinline__ void operator()(int row, int col, float (&v)[8], const Unit&) const {
        const int t2 = rowtok[row];
        if (t2 >= 0) { const float w = roww[row];
#pragma unroll
            for (int i = 0; i < 8; ++i) v[i] *= w;
            *(u32x4*)(YF + ((size_t)(t2 & 1) * TA + (t2 >> 1)) * DM + col) = pack8(v); }
    } };

#ifndef GA_
#define GA_ true
#endif
#ifndef GS_
#define GS_ true
#endif
constexpr int LDS_BYTES = 147456;
constexpr int MISC_OFF = 131072 + 4096;

constexpr int NPHASE = 2 + 14 * DEPTH + 1;
struct Args { const float* in[N_IN]; float* out; unsigned char* ws; int ph_lo, ph_hi; };
static_assert(sizeof(Args) == N_IN * 8 + 8 + 8 + 8, "Args has no padding");

__global__ void __launch_bounds__(512, 2) fwd(Args a) {
    extern __shared__ __attribute__((aligned(16))) unsigned char lds_raw[];
    KC k;
    k.lds = (LAS unsigned char*)lds_raw; k.ws = (unsigned char*)INP(N_IN + 1);
    k.tid = threadIdx.x; k.lane = k.tid & 63; k.wave = __builtin_amdgcn_readfirstlane(k.tid >> 6); k.G = gridDim.x; k.bid = blockIdx.x;
    const int lo = a.ph_lo, hi = a.ph_hi;
    volatile LAS unsigned* MISC = (volatile LAS unsigned*)(k.lds + MISC_OFF);
    if (k.tid < 32) MISC[k.tid] = 0u;
    __syncthreads();
    XcdBarrier bar; bar.bar = (unsigned*)(k.ws + WS_CTL) + CW_BAR; bar.x = 0; bar.st = nullptr;
    if (hi - lo > 1) bar = xcd_barrier_post((unsigned*)(k.ws + WS_CTL) + CW_BAR, MISC + 8);
#ifndef SITE_MASK
#define SITE_MASK 0xFFFFFFFFu
#endif
#define FRESH() do { int t_ = threadIdx.x; asm volatile("" : "+v"(t_)); k.tid = t_; k.lane = t_ & 63; k.wave = __builtin_amdgcn_readfirstlane(t_ >> 6); k.ws = (unsigned char*)INP(N_IN + 1); ws = k.ws; } while (0)
#define PH_BEGIN(p, site) if (((SITE_MASK >> (site)) & 1u) && lo <= (p) && (p) < hi) { FRESH();
#ifndef EXTRA_BARS
#define EXTRA_BARS 0
#endif
#ifndef DUP_MASK
#define DUP_MASK 0u
#endif
#define DUPRUN(n, stmt) do { stmt; if ((DUP_MASK >> (n)) & 1u) { __syncthreads(); stmt; } } while (0)
#define PH_END(p) if ((p) + 1 < hi) xcd_barrier(bar); }
    unsigned char* ws = k.ws;
    LAS unsigned char* glds = k.lds;
#define WSRC WSrc{INP(I_WIN), INP(I_W2), INP(I_A2), INP(I_G2), INP(I_WBA), INP(I_WBB), INP(I_WOUT), INP(I_EG), INP(I_EU), INP(I_ED), INP(I_W0), INP(I_A0)}

    PH_BEGIN(0, 0) DUPRUN(0, ph_adaln_partials(k, INP(I_C), INP(I_CCTX), INP(I_WADA))); DUPRUN(1, ph_convert(k, WSRC, 0)); PH_END(0)
    PH_BEGIN(1, 1) ph_adaln_reduce(k, INP(I_BADA)); PH_END(1)

#define L_ 0
    {
        constexpr int l = L_;
        const int pb = 2 + 14 * l;
        const bool last = (l == DEPTH - 1);
        const int Mpost = last ? TL : TA;
        PH_BEGIN(pb + 0, 2)
            if (l > 0) { DUPRUN(1, ph_convert(k, WSRC, l)); }
            RowArgs ra{INP(I_X), INP(I_CTX), INP(I_NMG), nullptr, nullptr, nullptr};
            ph_rows<0>(k, ra, l, TA);
            if (l == 0 && ((DUP_MASK >> 15) & 1u)) { __syncthreads(); ph_rows<0>(k, ra, l, TA); }
        PH_END(pb + 0)
        PH_BEGIN(pb + 1, 3)
            pg8::Gemm g{(const bf16*)(ws + WS_H), (const bf16*)(ws + WT_IN), TA, NP, DM, 0}; pg8::StaticOrder S; S.init(TA, NP, k.G, k.bid);
            pg8::Epi8<FP_> E{FP_{(bf16*)(ws + WS_P)}};
            DUPRUN(2, (pg8::gemm_phase<pg8::Epi8<FP_>, pg8::StaticOrder, GA_, GS_>(glds, g, S, E)));
        PH_END(pb + 1)
        PH_BEGIN(pb + 2, 4)
            DUPRUN(3, ph_rwkv_prep(k, l, TA, INP(I_MU), INP(I_KK), INP(I_RK)));
            DUPRUN(4, ph_gla_prep(k, l, INP(I_GCONV), INP(I_GAW2), INP(I_GAB)));
        PH_END(pb + 2)
        PH_BEGIN(pb + 3, 5)
            pg8::Gemm g{(const bf16*)(ws + RW_A1), (const bf16*)(ws + WT_L1), TA, 4096, 256, 0}; pg8::StaticOrder S; S.init(TA, 4096, k.G, k.bid);
            pg8::Epi8<FL1_> E{FL1_{(bf16*)(ws + RW_LO), (const float*)(ws + WS_TAB + TAB_TOP)}};
            DUPRUN(5, (pg8::gemm_phase<pg8::Epi8<FL1_>, pg8::StaticOrder, GA_, GS_>(glds, g, S, E)));
        PH_END(pb + 3)
        PH_BEGIN(pb + 4, 6)
#if SPLIT_SCAN
            DUPRUN(6, ph_scan_split(k, l, INP(I_KA)));
#else
            for (int vb = ((k.G & 7) ? k.bid : (k.bid & 7) * (k.G >> 3) + (k.bid >> 3)); vb < 256; vb += k.G) { const int job = vb; DUPRUN(6, ph_rwkv_scan(k, l, job, INP(I_KA))); DUPRUN(7, ph_gla_scan(k, job)); }
#endif
        PH_END(pb + 4)
        PH_BEGIN(pb + 5, 7)
            DUPRUN(8, ph_post(k, l, Mpost, INP(I_LNG), INP(I_LNB), INP(I_GNG)));
        PH_END(pb + 5)
        PH_BEGIN(pb + 6, 8)
            pg8::Gemm g{(const bf16*)(ws + RW_A2), (const bf16*)(ws + WT_G2), Mpost, RD, 256, 0}; pg8::StaticOrder S; S.init(Mpost, RD, k.G, k.bid);
            pg8::Epi8<FL2_> E{FL2_{(const bf16*)(ws + RW_R), (bf16*)(ws + RW_V)}};
            DUPRUN(9, (pg8::gemm_phase<pg8::Epi8<FL2_>, pg8::StaticOrder, GA_, GS_>(glds, g, S, E)));
        PH_END(pb + 6)
        PH_BEGIN(pb + 7, 9)
            pg8::Gemm g{(const bf16*)(ws + RW_V), (const bf16*)(ws + WT_A), Mpost, DM, RD, 0}; pg8::StaticOrder S; S.init(Mpost, DM, k.G, k.bid);
            pg8::Epi8<FM_<0>> E{FM_<0>{(const bf16*)(ws + WS_P), (bf16*)(ws + WS_H)}};
            DUPRUN(10, (pg8::gemm_phase<pg8::Epi8<FM_<0>>, pg8::StaticOrder, GA_, GS_>(glds, g, S, E)));
        PH_END(pb + 7)
        PH_BEGIN(pb + 8, 10)
            pg8::Gemm g{(const bf16*)(ws + GL_VS), (const bf16*)(ws + WT_B), Mpost, DM, GVD, 0}; pg8::StaticOrder S; S.init(Mpost, DM, k.G, k.bid);
            pg8::Epi8<FM_<1>> E{FM_<1>{(const bf16*)(ws + WS_P), (bf16*)(ws + WS_H)}};
            pg8::gemm_phase<pg8::Epi8<FM_<1>>, pg8::StaticOrder, GA_, GS_>(glds, g, S, E);
        PH_END(pb + 8)
        PH_BEGIN(pb + 9, 11)
            pg8::Gemm g{(const bf16*)(ws + WS_H), (const bf16*)(ws + WT_O), Mpost, DM, DM, 0}; pg8::StaticOrder S; S.init(Mpost, DM, k.G, k.bid);
            pg8::Epi4<FX_> E{FX_{(float*)(ws + WS_X), (const float*)(ws + WS_MOD), l}};
            pg8::gemm_phase<pg8::Epi4<FX_>, pg8::StaticOrder, GA_, GS_>(glds, g, S, E);
        PH_END(pb + 9)
        PH_BEGIN(pb + 10, 12)
            RowArgs ra{nullptr, nullptr, INP(I_NFG), INP(I_RW), INP(I_RB), nullptr};
            ph_rows<1>(k, ra, l, Mpost);
            if ((DUP_MASK >> 16) & 1u) { __syncthreads(); ph_rows<1>(k, ra, l, Mpost, true); }
        PH_END(pb + 10)
        PH_BEGIN(pb + 11, 13)
            DUPRUN(13, ph_moe_scatter(k, l, Mpost));
        PH_END(pb + 11)
        PH_BEGIN(pb + 12, 14)
            pg8::Gemm g{(const bf16*)(ws + WS_HP), (const bf16*)(ws + WT_GU), 0, 2816, DM, (size_t)2816 * DM * 2};
            pg8::MoeOrder S; S.init((const int*)(ws + WS_TAB + TAB_TILE) + 256 * l, 11, k.G, ((k.G & 7) ? k.bid : (k.bid & 7) * (k.G >> 3) + (k.bid >> 3)));
            pg8::EpiGU<FE1_> E{FE1_{(bf16*)(ws + WS_ACT)}};
            DUPRUN(11, (pg8::gemm_phase<pg8::EpiGU<FE1_>, pg8::MoeOrder, GA_, GS_>(glds, g, S, E)));
        PH_END(pb + 12)
        PH_BEGIN(pb + 13, 15)
            pg8::Gemm g{(const bf16*)(ws + WS_ACT), (const bf16*)(ws + WT_D), 0, DM, DEXP, (size_t)DM * DEXP * 2};
            pg8::MoeOrder S; S.init((const int*)(ws + WS_TAB + TAB_TILE) + 256 * l, 8, k.G, ((k.G & 7) ? k.bid : (k.bid & 7) * (k.G >> 3) + (k.bid >> 3)));
            pg8::Epi8<FE2_> E{FE2_{(const int*)(ws + WS_TAB + TAB_ROWTOK) + (size_t)l * MOE_ROWS, (const float*)(ws + WS_TAB + TAB_ROWW) + (size_t)l * MOE_ROWS, (bf16*)(ws + WS_YF)}};
            DUPRUN(12, (pg8::gemm_phase<pg8::Epi8<FE2_>, pg8::MoeOrder, GA_, GS_>(glds, g, S, E)));
        PH_END(pb + 13)
        }
#undef L_
#define L_ 1
    {
        constexpr int l = L_;
        const int pb = 2 + 14 * l;
        const bool last = (l == DEPTH - 1);
        const int Mpost = last ? TL : TA;
        PH_BEGIN(pb + 0, 2)
            if (l > 0) { DUPRUN(1, ph_convert(k, WSRC, l)); }
            RowArgs ra{INP(I_X), INP(I_CTX), INP(I_NMG), nullptr, nullptr, nullptr};
            ph_rows<0>(k, ra, l, TA);
            if (l == 0 && ((DUP_MASK >> 15) & 1u)) { __syncthreads(); ph_rows<0>(k, ra, l, TA); }
        PH_END(pb + 0)
        PH_BEGIN(pb + 1, 3)
            pg8::Gemm g{(const bf16*)(ws + WS_H), (const bf16*)(ws + WT_IN), TA, NP, DM, 0}; pg8::StaticOrder S; S.init(TA, NP, k.G, k.bid);
            pg8::Epi8<FP_> E{FP_{(bf16*)(ws + WS_P)}};
            DUPRUN(2, (pg8::gemm_phase<pg8::Epi8<FP_>, pg8::StaticOrder, GA_, GS_>(glds, g, S, E)));
        PH_END(pb + 1)
        PH_BEGIN(pb + 2, 4)
            DUPRUN(3, ph_rwkv_prep(k, l, TA, INP(I_MU), INP(I_KK), INP(I_RK)));
            DUPRUN(4, ph_gla_prep(k, l, INP(I_GCONV), INP(I_GAW2), INP(I_GAB)));
        PH_END(pb + 2)
        PH_BEGIN(pb + 3, 5)
            pg8::Gemm g{(const bf16*)(ws + RW_A1), (const bf16*)(ws + WT_L1), TA, 4096, 256, 0}; pg8::StaticOrder S; S.init(TA, 4096, k.G, k.bid);
            pg8::Epi8<FL1_> E{FL1_{(bf16*)(ws + RW_LO), (const float*)(ws + WS_TAB + TAB_TOP)}};
            DUPRUN(5, (pg8::gemm_phase<pg8::Epi8<FL1_>, pg8::StaticOrder, GA_, GS_>(glds, g, S, E)));
        PH_END(pb + 3)
        PH_BEGIN(pb + 4, 6)
#if SPLIT_SCAN
            DUPRUN(6, ph_scan_split(k, l, INP(I_KA)));
#else
            for (int vb = ((k.G & 7) ? k.bid : (k.bid & 7) * (k.G >> 3) + (k.bid >> 3)); vb < 256; vb += k.G) { const int job = vb; DUPRUN(6, ph_rwkv_scan(k, l, job, INP(I_KA))); DUPRUN(7, ph_gla_scan(k, job)); }
#endif
        PH_END(pb + 4)
        PH_BEGIN(pb + 5, 7)
            DUPRUN(8, ph_post(k, l, Mpost, INP(I_LNG), INP(I_LNB), INP(I_GNG)));
        PH_END(pb + 5)
        PH_BEGIN(pb + 6, 8)
            pg8::Gemm g{(const bf16*)(ws + RW_A2), (const bf16*)(ws + WT_G2), Mpost, RD, 256, 0}; pg8::StaticOrder S; S.init(Mpost, RD, k.G, k.bid);
            pg8::Epi8<FL2_> E{FL2_{(const bf16*)(ws + RW_R), (bf16*)(ws + RW_V)}};
            DUPRUN(9, (pg8::gemm_phase<pg8::Epi8<FL2_>, pg8::StaticOrder, GA_, GS_>(glds, g, S, E)));
        PH_END(pb + 6)
        PH_BEGIN(pb + 7, 9)
            pg8::Gemm g{(const bf16*)(ws + RW_V), (const bf16*)(ws + WT_A), Mpost, DM, RD, 0}; pg8::StaticOrder S; S.init(Mpost, DM, k.G, k.bid);
            pg8::Epi8<FM_<0>> E{FM_<0>{(const bf16*)(ws + WS_P), (bf16*)(ws + WS_H)}};
            DUPRUN(10, (pg8::gemm_phase<pg8::Epi8<FM_<0>>, pg8::StaticOrder, GA_, GS_>(glds, g, S, E)));
        PH_END(pb + 7)
        PH_BEGIN(pb + 8, 10)
            pg8::Gemm g{(const bf16*)(ws + GL_VS), (const bf16*)(ws + WT_B), Mpost, DM, GVD, 0}; pg8::StaticOrder S; S.init(Mpost, DM, k.G, k.bid);
            pg8::Epi8<FM_<1>> E{FM_<1>{(const bf16*)(ws + WS_P), (bf16*)(ws + WS_H)}};
            pg8::gemm_phase<pg8::Epi8<FM_<1>>, pg8::StaticOrder, GA_, GS_>(glds, g, S, E);
        PH_END(pb + 8)
        PH_BEGIN(pb + 9, 11)
            pg8::Gemm g{(const bf16*)(ws + WS_H), (const bf16*)(ws + WT_O), Mpost, DM, DM, 0}; pg8::StaticOrder S; S.init(Mpost, DM, k.G, k.bid);
            pg8::Epi4<FX_> E{FX_{(float*)(ws + WS_X), (const float*)(ws + WS_MOD), l}};
            pg8::gemm_phase<pg8::Epi4<FX_>, pg8::StaticOrder, GA_, GS_>(glds, g, S, E);
        PH_END(pb + 9)
        PH_BEGIN(pb + 10, 12)
            RowArgs ra{nullptr, nullptr, INP(I_NFG), INP(I_RW), INP(I_RB), nullptr};
            ph_rows<1>(k, ra, l, Mpost);
            if ((DUP_MASK >> 16) & 1u) { __syncthreads(); ph_rows<1>(k, ra, l, Mpost, true); }
        PH_END(pb + 10)
        PH_BEGIN(pb + 11, 13)
            DUPRUN(13, ph_moe_scatter(k, l, Mpost));
        PH_END(pb + 11)
        PH_BEGIN(pb + 12, 14)
            pg8::Gemm g{(const bf16*)(ws + WS_HP), (const bf16*)(ws + WT_GU), 0, 2816, DM, (size_t)2816 * DM * 2};
            pg8::MoeOrder S; S.init((const int*)(ws + WS_TAB + TAB_TILE) + 256 * l, 11, k.G, ((k.G & 7) ? k.bid : (k.bid & 7) * (k.G >> 3) + (k.bid >> 3)));
            pg8::EpiGU<FE1_> E{FE1_{(bf16*)(ws + WS_ACT)}};
            DUPRUN(11, (pg8::gemm_phase<pg8::EpiGU<FE1_>, pg8::MoeOrder, GA_, GS_>(glds, g, S, E)));
        PH_END(pb + 12)
        PH_BEGIN(pb + 13, 15)
            pg8::Gemm g{(const bf16*)(ws + WS_ACT), (const bf16*)(ws + WT_D), 0, DM, DEXP, (size_t)DM * DEXP * 2};
            pg8::MoeOrder S; S.init((const int*)(ws + WS_TAB + TAB_TILE) + 256 * l, 8, k.G, ((k.G & 7) ? k.bid : (k.bid & 7) * (k.G >> 3) + (k.bid >> 3)));
            pg8::Epi8<FE2_> E{FE2_{(const int*)(ws + WS_TAB + TAB_ROWTOK) + (size_t)l * MOE_ROWS, (const float*)(ws + WS_TAB + TAB_ROWW) + (size_t)l * MOE_ROWS, (bf16*)(ws + WS_YF)}};
            DUPRUN(12, (pg8::gemm_phase<pg8::Epi8<FE2_>, pg8::MoeOrder, GA_, GS_>(glds, g, S, E)));
        PH_END(pb + 13)
        }
#undef L_
#if EXTRA_BARS
    if (hi - lo > 1) { for (int i = 0; i < EXTRA_BARS; ++i) xcd_barrier(bar); }
#endif
    PH_BEGIN(NPHASE - 1, 16)
        RowArgs ra{nullptr, nullptr, INP(I_FNG), nullptr, nullptr, (float*)INP(N_IN)};
        DUPRUN(14, ph_rows<2>(k, ra, 0, TL));
    PH_END(NPHASE - 1)
}

#ifndef MK_SINGLE
#define MK_SINGLE 1
#endif
extern "C" void kernel_launch(void* const* d_in, const int* in_sizes, int n_in, void* d_out, int out_size, void* d_ws, size_t ws_size, hipStream_t stream) {
    static int grid = 0;
    if (grid == 0) {
        if (n_in != N_IN || out_size != TL * DM || ws_size < WS_END) { fprintf(stderr, "kernel_launch: unexpected problem (n_in %d out %d ws %zu need %zu)\n", n_in, out_size, ws_size, (size_t)WS_END); grid = -1; return; }
        int dev = 0, cus = 0;
        if (hipGetDevice(&dev) != hipSuccess || hipDeviceGetAttribute(&cus, hipDeviceAttributeMultiprocessorCount, dev) != hipSuccess) { grid = -1; return; }
        if (hipFuncSetAttribute((const void*)fwd, hipFuncAttributeMaxDynamicSharedMemorySize, LDS_BYTES) != hipSuccess) { grid = -1; return; }
        int per_cu = 0;
        if (hipOccupancyMaxActiveBlocksPerMultiprocessor(&per_cu, (const void*)fwd, 512, LDS_BYTES) != hipSuccess || per_cu < 1) fprintf(stderr, "kernel_launch: occupancy query says %d\n", per_cu);
        (void)hipGetLastError();
        grid = cus;
    }
    if (grid < 0) return;
    unsigned char* ws = (unsigned char*)d_ws;
    (void)hipMemsetAsync(ws + WS_CTL, 0, CTL_BYTES, stream);
    Args a{};
    for (int i = 0; i < N_IN; ++i) a.in[i] = (const float*)d_in[i];
    a.out = (float*)d_out; a.ws = ws;
#if MK_SINGLE
    a.ph_lo = 0; a.ph_hi = NPHASE;
    hipLaunchKernelGGL(fwd, dim3(grid), dim3(512), LDS_BYTES, stream, a);
#else
    for (int p = 0; p < NPHASE; ++p) { a.ph_lo = p; a.ph_hi = p + 1; hipLaunchKernelGGL(fwd, dim3(grid), dim3(512), LDS_BYTES, stream, a); }
#endif
}
```

```cpp
#include <hip/hip_runtime.h>
#include <cstdio>
#include <cstdint>

#define LAS __attribute__((address_space(3)))
#define GAS __attribute__((address_space(1)))
typedef unsigned short bf16;
typedef float f32x4 __attribute__((ext_vector_type(4)));
typedef float f32x2 __attribute__((ext_vector_type(2)));
typedef unsigned u32x4 __attribute__((ext_vector_type(4)));
typedef unsigned u32x2 __attribute__((ext_vector_type(2)));
typedef short bf16x8 __attribute__((ext_vector_type(8)));

constexpr int DM = 2048, NBATCH = 8, SEQ = 2048, CTXL = 256, DEPTH = 2;
constexpr int TL = NBATCH * SEQ, TC = NBATCH * CTXL, TA = TL + TC;
constexpr int RD = 1024, RHEADS = 16, RHS = 64;
constexpr int RWKV_IN = 3520;
constexpr int GKD = 512, GVD = 1024, GDK = 128, GDV = 256, GHEADS = 4, GQKV = 2048;
constexpr int GLA_OFF = 3520, GLA_AD_OFF = GLA_OFF + GQKV, GLA_GATE_OFF = 5584, BR_OFF = 6608, IN_DIM = 10704, NP = 10752;
constexpr int NEXP = 16, DEXP = 1408;
constexpr int MOD_N = 6 * DM;
constexpr int MOE_ROWS = 41216;
constexpr int MOE_TILES = MOE_ROWS / 256;
constexpr int NCH = 36;
constexpr int KSPLIT = 32;

enum { I_X = 0, I_C, I_CTX, I_CCTX, I_WADA, I_BADA, I_NMG, I_NFG, I_WIN, I_MU, I_W0, I_W2, I_A0, I_A2, I_G2, I_KK, I_KA, I_RK, I_LNG, I_LNB,
       I_GCONV, I_GAW2, I_GAB, I_GNG, I_WBA, I_WBB, I_WOUT, I_RW, I_RB, I_EG, I_EU, I_ED, I_FNG, N_IN };

constexpr size_t MiB = 1u << 20;
constexpr size_t WS_CTL = 0;
constexpr size_t WS_TAB = 1 * MiB;
constexpr size_t WS_MOD = 2 * MiB;
constexpr size_t WS_X = 3 * MiB;
constexpr size_t WS_H = WS_X + 144 * MiB;
constexpr size_t WS_P = WS_H + 72 * MiB;
constexpr size_t WS_RW = WS_P + 378 * MiB;
constexpr size_t WS_GL = WS_RW + 380 * MiB;
constexpr size_t WS_WT = WS_GL + 218 * MiB;
constexpr size_t WS_END = WS_WT + 325 * MiB;
constexpr int CW_TMO = 0, CW_CNT = 64  , CW_BAR = 4096;
constexpr size_t CTL_BYTES = 1 * MiB;
constexpr size_t TAB_ROWTOK = 0;
constexpr size_t TAB_ROWTOK_BYTES = 2 * (size_t)MOE_ROWS * 4;
constexpr size_t TAB_ROWW = 384 * 1024;
constexpr size_t TAB_TILE = 768 * 1024;
constexpr size_t TAB_TOP = 800 * 1024;
static_assert(TAB_ROWTOK_BYTES <= TAB_ROWW && TAB_ROWW + 2 * (size_t)MOE_ROWS * 4 <= TAB_TILE, "tab map");
constexpr size_t WS_MODP = WS_P;
constexpr size_t WS_HP = WS_P;
constexpr size_t WS_ACT = WS_P + 162 * MiB;
constexpr size_t WS_TOPK = WS_P + 274 * MiB;
static_assert((size_t)MOE_ROWS * DM * 2 <= 162 * MiB && (size_t)MOE_ROWS * DEXP * 2 <= 112 * MiB && 274 * MiB + 3 * (size_t)TA * 8 <= 378 * MiB, "P overlay");
constexpr size_t RW_R = WS_RW;
constexpr size_t RW_KS = RW_R + 36 * MiB;
constexpr size_t RW_V = RW_KS + 36 * MiB;
constexpr size_t RW_KK = RW_V + 36 * MiB;
constexpr size_t RW_LO = RW_KK + 36 * MiB;
constexpr size_t RW_Y = RW_LO + 144 * MiB;
constexpr size_t RW_A1 = RW_Y + 72 * MiB;
constexpr size_t RW_A2 = RW_A1 + 9 * MiB;
constexpr size_t RW_BON = RW_A2 + 9 * MiB;
static_assert(RW_BON + 2 * MiB <= WS_GL, "rwkv map");
constexpr size_t GL_QG = WS_GL;
constexpr size_t GL_KG = GL_QG + 36 * MiB;
constexpr size_t GL_KE = GL_KG + 36 * MiB;
constexpr size_t GL_VS = GL_KE + 36 * MiB;
constexpr size_t GL_O = GL_VS + 36 * MiB;
constexpr size_t GL_DEC = GL_O + 72 * MiB;
static_assert(GL_DEC + 2 * MiB <= WS_WT, "gla map");
constexpr size_t WS_YF = WS_GL;
constexpr size_t WT_IN = WS_WT;
constexpr size_t WT_L1 = WT_IN + 42 * MiB;
constexpr size_t WT_G2 = WT_L1 + 2 * MiB;
constexpr size_t WT_A = WT_G2 + 1 * MiB;
constexpr size_t WT_B = WT_A + 4 * MiB;
constexpr size_t WT_O = WT_B + 4 * MiB;
constexpr size_t WT_GU = WT_O + 8 * MiB;
constexpr size_t WT_D = WT_GU + 176 * MiB;
static_assert(WT_D + 88 * MiB == WS_END, "weight map");

__device__ __forceinline__ float bf2f(unsigned v) { return __uint_as_float(v << 16); }
__device__ __forceinline__ float bflo(unsigned w) { return __uint_as_float(w << 16); }
__device__ __forceinline__ float bfhi(unsigned w) { return __uint_as_float(w & 0xffff0000u); }
__device__ __forceinline__ unsigned f2bf(float f) { unsigned u = __float_as_uint(f); return (u + 0x7fffu + ((u >> 16) & 1u)) >> 16; }
__device__ __forceinline__ unsigned pk2(float lo, float hi) { unsigned r; asm volatile("v_cvt_pk_bf16_f32 %0, %1, %2" : "=v"(r) : "v"(lo), "v"(hi)); return r; }
typedef __bf16 bf16x2_t __attribute__((ext_vector_type(2)));
__device__ __forceinline__ unsigned pk2c(float lo, float hi) { f32x2 v = {lo, hi}; bf16x2_t b = __builtin_convertvector(v, bf16x2_t); return __builtin_bit_cast(unsigned, b); }
__device__ __forceinline__ float sigm(float x) { return 1.0f / (1.0f + __expf(-x)); }
__device__ __forceinline__ float siluf(float x) { return x * sigm(x); }
__device__ __forceinline__ float wave_sum(float x) {
    x += __builtin_bit_cast(float, __builtin_amdgcn_update_dpp(0, __builtin_bit_cast(int, x), 0xB1, 0xF, 0xF, true));
    x += __builtin_bit_cast(float, __builtin_amdgcn_update_dpp(0, __builtin_bit_cast(int, x), 0x4E, 0xF, 0xF, true));
    x += __builtin_bit_cast(float, __builtin_amdgcn_update_dpp(0, __builtin_bit_cast(int, x), 0x141, 0xF, 0xF, true));
    x += __builtin_bit_cast(float, __builtin_amdgcn_update_dpp(0, __builtin_bit_cast(int, x), 0x140, 0xF, 0xF, true));
    const int xi = __builtin_bit_cast(int, x);
    return (__builtin_bit_cast(float, __builtin_amdgcn_readlane(xi, 0)) + __builtin_bit_cast(float, __builtin_amdgcn_readlane(xi, 16))) +
           (__builtin_bit_cast(float, __builtin_amdgcn_readlane(xi, 32)) + __builtin_bit_cast(float, __builtin_amdgcn_readlane(xi, 48)));
}
__device__ __forceinline__ void unpack8(const u32x4 w, float (&o)[8]) {
    o[0] = bflo(w.x); o[1] = bfhi(w.x); o[2] = bflo(w.y); o[3] = bfhi(w.y); o[4] = bflo(w.z); o[5] = bfhi(w.z); o[6] = bflo(w.w); o[7] = bfhi(w.w);
}
__device__ __forceinline__ u32x4 pack8(const float (&v)[8]) { u32x4 w; w.x = pk2(v[0], v[1]); w.y = pk2(v[2], v[3]); w.z = pk2(v[4], v[5]); w.w = pk2(v[6], v[7]); return w; }
namespace pg8 {
#define PG8_LAS __attribute__((address_space(3)))
typedef unsigned short bf16_t;
typedef short bf16x8 __attribute__((ext_vector_type(8)));
typedef float f32x4 __attribute__((ext_vector_type(4)));
typedef unsigned u32x4 __attribute__((ext_vector_type(4)));
constexpr int BM = 256, BK = 64, HALF = 128, HTB = HALF * BK * 2  , STAGE_BYTES = 8 * HTB, NXCD = 8, WGM = 8;

__host__ __device__ __forceinline__ int lds_byte(int r, int c) { const int st = (r >> 4) * 2 + (c >> 5), rr = r & 15, cc = c & 31, ob = rr * 64 + cc * 2; return st * 1024 + (ob ^ (((ob >> 9) & 1) << 5)); }
__host__ __device__ __forceinline__ void stage_rc(int b, int& R, int& C) { const int st = b / 1024, sb = b % 1024, swz = sb ^ (((sb >> 9) & 1) << 5); R = (st >> 1) * 16 + swz / 64; C = (st & 1) * 32 + (swz % 64) / 2; }
__host__ __device__ __forceinline__ int perm32(int rho) { const int n = rho >> 4, i = rho & 15; return 8 * (i >> 2) + 4 * n + (i & 3); }
struct Unit { int pm, pn, eb; };
struct Gemm { const bf16_t* A; const bf16_t* Bt; int M, N, K; size_t bstride; };

struct StaticOrder {
    int nM, nN, nwg, G, c;
    __host__ __device__ void init(int M, int N, int G_, int c_) { nM = M / BM; nN = N / BM; nwg = nM * nN; G = G_; c = c_; }
    __host__ __device__ bool next(int i, Unit& u) const {
        const long L = (long)i * G + c; if (L >= nwg) return false;
        int wgid = (int)L; { const int q = nwg / NXCD, r = nwg % NXCD, xcd = wgid % NXCD, off = wgid / NXCD; wgid = (xcd < r ? xcd * (q + 1) : r * (q + 1) + (xcd - r) * q) + off; }
        const int nig = WGM * nN, gid = wgid / nig, fm = gid * WGM, gsz = (nM - fm) < WGM ? (nM - fm) : WGM;
        u.pm = fm + ((wgid % nig) % gsz); u.pn = (wgid % nig) / gsz; u.eb = 0; return true;
    }
    __device__ __forceinline__ void a_ready(const Unit&) const {}
    __device__ __forceinline__ void done(const Unit&) const {}
};
struct MoeOrder {
    const int* tab; int nT, nN, G, c;
    __device__ void init(const int* tab_, int nN_, int G_, int c_) { tab = tab_; nT = tab_[0]; nN = nN_; G = G_; c = c_; }
    __device__ bool next(int i, Unit& u) const {
        const long L = (long)i * G + c; if (L >= (long)nT * nN) return false;
        u.pm = (int)(L / nN); u.pn = (int)(L % nN); u.eb = tab[1 + u.pm]; return true;
    }
    __device__ __forceinline__ void a_ready(const Unit&) const {}
    __device__ __forceinline__ void done(const Unit&) const {}
};

template <class F> struct Epi8 {
    static constexpr bool PERM = true, AFTER_DRAIN = false;
    F f;
    __device__ __forceinline__ void operator()(const f32x4 (&acc)[2][2][4][2], const Unit& u, int wr, int wc, int fr, int fq) const {
        const int row0 = u.pm * BM + wr * 64 + fr, col0 = u.pn * BM + wc * 32 + 8 * fq;
#pragma unroll
        for (int ai = 0; ai < 2; ++ai)
#pragma unroll
            for (int m = 0; m < 4; ++m) {
#pragma unroll
                for (int bj = 0; bj < 2; ++bj) {
                    const f32x4 a = acc[ai][bj][m][0], b = acc[ai][bj][m][1];
                    float v[8] = {a[0], a[1], a[2], a[3], b[0], b[1], b[2], b[3]};
                    f(row0 + ai * HALF + m * 16, col0 + bj * HALF, v, u);
                }
            }
    }
};
template <class F> struct EpiGU {
    static constexpr bool PERM = true, AFTER_DRAIN = false;
    F f;
    __device__ __forceinline__ void operator()(const f32x4 (&acc)[2][2][4][2], const Unit& u, int wr, int wc, int fr, int fq) const {
        const int row0 = u.pm * BM + wr * 64 + fr, col0 = u.pn * HALF + wc * 32 + 8 * fq;
#pragma unroll
        for (int ai = 0; ai < 2; ++ai)
#pragma unroll
            for (int m = 0; m < 4; ++m) {
                const f32x4 g0 = acc[ai][0][m][0], g1 = acc[ai][0][m][1], u0 = acc[ai][1][m][0], u1 = acc[ai][1][m][1];
                float g[8] = {g0[0], g0[1], g0[2], g0[3], g1[0], g1[1], g1[2], g1[3]};
                float up[8] = {u0[0], u0[1], u0[2], u0[3], u1[0], u1[1], u1[2], u1[3]};
                f(row0 + ai * HALF + m * 16, col0, g, up);
            }
    }
};
template <class F> struct Epi4 {
    static constexpr bool PERM = false, AFTER_DRAIN = false;
    F f;
    __device__ __forceinline__ void operator()(const f32x4 (&acc)[2][2][4][2], const Unit& u, int wr, int wc, int fr, int fq) const {
        const int row0 = u.pm * BM + wr * 64 + fr, col0 = u.pn * BM + wc * 32 + 4 * fq;
#pragma unroll
        for (int ai = 0; ai < 2; ++ai)
#pragma unroll
            for (int m = 0; m < 4; ++m) {
#pragma unroll
                for (int bj = 0; bj < 2; ++bj)
#pragma unroll
                    for (int n = 0; n < 2; ++n) f(row0 + ai * HALF + m * 16, col0 + bj * HALF + n * 16, acc[ai][bj][m][n], u);
            }
    }
};
template <class Epi, class Sched, bool ALIGN_EPI = false, bool SP2 = false>
__device__ __forceinline__ void gemm_phase(PG8_LAS unsigned char* lds, const Gemm g, const Sched& S, const Epi& E) {
    int tid_o = threadIdx.x; asm volatile("" : "+v"(tid_o));
    const int tid = tid_o, wid = __builtin_amdgcn_readfirstlane(tid >> 6), lane = tid & 63, wr = wid >> 2, wc = wid & 3, fr = lane & 15, fq = lane >> 4;
    const int K = g.K, nt = K / BK;
    unsigned voffA[2], voffB[2];
#pragma unroll
    for (int i = 0; i < 2; ++i) { int R, C; stage_rc(tid * 16 + i * 8192, R, C); const int Rb = Epi::PERM ? ((R & ~31) + perm32(R & 31)) : R;
        voffA[i] = (unsigned)(R * K + C) * 2u; voffB[i] = (unsigned)(Rb * K + C) * 2u; }
    const size_t kstep = (size_t)(BK * 2);
    const size_t hstep = (size_t)HALF * K * 2;
    const size_t tstep = 2 * hstep;
    const unsigned ldsw = (unsigned)wid * 1024u;
    const int aoff = lds_byte(wr * 64 + fr, fq * 8), boff = lds_byte(wc * 32 + fr, fq * 8);
#define PG8_SA(b, h) (((b) * 2 + (h)) * HTB)
#define PG8_SB(b, h) ((4 + (b) * 2 + (h)) * HTB)
#define PG8_STAGE(bufoff, gbase, voff) do { _Pragma("unroll") for (int _i = 0; _i < 2; ++_i) \
        __builtin_amdgcn_global_load_lds((const unsigned*)((const char*)(gbase) + (voff)[_i]), (PG8_LAS unsigned*)(lds + (bufoff) + ldsw + _i * 8192), 16, 0, 0); } while (0)
#define PG8_LDA(dst, b, h) do { _Pragma("unroll") for (int m = 0; m < 4; ++m) _Pragma("unroll") for (int k = 0; k < 2; ++k) dst[m][k] = *(const PG8_LAS bf16x8*)(lds + PG8_SA(b, h) + aoff + m * 2048 + k * 1024); } while (0)
#define PG8_LDB(dst, b, h) do { _Pragma("unroll") for (int n = 0; n < 2; ++n) _Pragma("unroll") for (int k = 0; k < 2; ++k) dst[n][k] = *(const PG8_LAS bf16x8*)(lds + PG8_SB(b, h) + boff + n * 2048 + k * 1024); } while (0)
#define PG8_MMA(ai, bj, At, Bt) do { __builtin_amdgcn_s_setprio(1); _Pragma("unroll") for (int m = 0; m < 4; ++m) _Pragma("unroll") for (int n = 0; n < 2; ++n) _Pragma("unroll") for (int k = 0; k < 2; ++k) \
        acc[ai][bj][m][n] = __builtin_amdgcn_mfma_f32_16x16x32_bf16(Bt[n][k], At[m][k], acc[ai][bj][m][n], 0, 0, 0); __builtin_amdgcn_s_setprio(0); } while (0)
#define PG8_WAIT_V(n) asm volatile("s_waitcnt vmcnt(" #n ")" ::: "memory")
#define PG8_WAIT_L(n) asm volatile("s_waitcnt lgkmcnt(" #n ")" ::: "memory")
#define PG8_BAR __builtin_amdgcn_s_barrier()
#define PG8_SCHED __builtin_amdgcn_sched_barrier(0)
    Unit cur, nxt; int ui = 0;
    if (!S.next(0, cur)) return;
    f32x4 acc[2][2][4][2];
#pragma unroll
    for (int a = 0; a < 2; ++a)
#pragma unroll
        for (int b = 0; b < 2; ++b)
#pragma unroll
            for (int m = 0; m < 4; ++m)
#pragma unroll
                for (int n = 0; n < 2; ++n) acc[a][b][m][n] = (f32x4){0.f, 0.f, 0.f, 0.f};
    bf16x8 At[4][2], B0[2][2], B1[2][2];
    const char* cA = (const char*)g.A + (size_t)cur.pm * tstep; const char* cB = (const char*)g.Bt + (size_t)cur.eb * g.bstride + (size_t)cur.pn * tstep;
    S.a_ready(cur);
    if constexpr (SP2) {
        PG8_STAGE(PG8_SB(0, 0), cB, voffB); PG8_STAGE(PG8_SB(0, 1), cB + hstep, voffB); PG8_STAGE(PG8_SA(0, 0), cA, voffA); PG8_STAGE(PG8_SA(0, 1), cA + hstep, voffA);
        if (wr == 1) PG8_BAR;
        PG8_WAIT_V(2); PG8_BAR;
        PG8_STAGE(PG8_SB(1, 0), cB + kstep, voffB); PG8_STAGE(PG8_SA(1, 0), cA + kstep, voffA); PG8_STAGE(PG8_SB(1, 1), cB + hstep + kstep, voffB);
        PG8_WAIT_V(6); PG8_BAR;
    } else {
        PG8_STAGE(PG8_SB(0, 0), cB, voffB); PG8_STAGE(PG8_SA(0, 0), cA, voffA); PG8_STAGE(PG8_SB(0, 1), cB + hstep, voffB); PG8_STAGE(PG8_SA(0, 1), cA + hstep, voffA);
        if (wr == 1) PG8_BAR;
        PG8_WAIT_V(4); PG8_BAR;
        PG8_STAGE(PG8_SB(1, 0), cB + kstep, voffB); PG8_STAGE(PG8_SA(1, 0), cA + kstep, voffA); PG8_STAGE(PG8_SB(1, 1), cB + hstep + kstep, voffB);
        PG8_WAIT_V(6); PG8_BAR;
    }
    for (;;) {
        const bool has_next = S.next(ui + 1, nxt);
        const char* nA = has_next ? (const char*)g.A + (size_t)nxt.pm * tstep : cA; const char* nB = has_next ? (const char*)g.Bt + (size_t)nxt.eb * g.bstride + (size_t)nxt.pn * tstep : cB;
#pragma nounroll
        for (int t = 0; t < nt; t += 2) {
            const bool last = (t == nt - 2);
            const char* a1 = cA + (size_t)(t + 1) * kstep;
            const char* a2 = last ? nA : cA + (size_t)(t + 2) * kstep; const char* b2 = last ? nB : cB + (size_t)(t + 2) * kstep;
            const char* a3 = a2 + kstep; const char* b3 = b2 + kstep;
            if (last && has_next) S.a_ready(nxt);
            if constexpr (SP2) {
            PG8_LDB(B0, 0, 0); PG8_LDB(B1, 0, 1); PG8_SCHED; PG8_LDA(At, 0, 0); PG8_STAGE(PG8_SA(1, 1), a1 + hstep, voffA);
            PG8_WAIT_V(8); PG8_WAIT_L(0); PG8_BAR; PG8_MMA(0, 0, At, B0); PG8_MMA(0, 1, At, B1); PG8_BAR; PG8_SCHED;
            PG8_LDA(At, 0, 1); PG8_STAGE(PG8_SB(0, 0), b2, voffB); PG8_STAGE(PG8_SB(0, 1), b2 + hstep, voffB); PG8_STAGE(PG8_SA(0, 0), a2, voffA);
            PG8_WAIT_V(8); PG8_WAIT_L(0); PG8_BAR; PG8_MMA(1, 0, At, B0); PG8_MMA(1, 1, At, B1); PG8_BAR; PG8_SCHED;
            PG8_LDB(B0, 1, 0); PG8_LDB(B1, 1, 1); PG8_SCHED; PG8_LDA(At, 1, 0); PG8_STAGE(PG8_SA(0, 1), a2 + hstep, voffA);
            PG8_WAIT_V(8); PG8_WAIT_L(0); PG8_BAR; PG8_MMA(0, 0, At, B0); PG8_MMA(0, 1, At, B1); PG8_BAR; PG8_SCHED;
            PG8_LDA(At, 1, 1); PG8_STAGE(PG8_SB(1, 0), b3, voffB); PG8_STAGE(PG8_SB(1, 1), b3 + hstep, voffB); PG8_STAGE(PG8_SA(1, 0), a3, voffA);
            PG8_WAIT_V(8); PG8_WAIT_L(0); PG8_BAR; PG8_MMA(1, 0, At, B0); PG8_MMA(1, 1, At, B1); PG8_BAR; PG8_SCHED;
            } else {
            PG8_LDB(B0, 0, 0); PG8_SCHED; PG8_LDA(At, 0, 0); PG8_STAGE(PG8_SA(1, 1), a1 + hstep, voffA);
            PG8_WAIT_L(8); PG8_BAR; PG8_WAIT_L(0); PG8_MMA(0, 0, At, B0); PG8_BAR; PG8_SCHED;
            PG8_LDB(B1, 0, 1); PG8_STAGE(PG8_SB(0, 0), b2, voffB);
            PG8_BAR; PG8_WAIT_L(0); PG8_MMA(0, 1, At, B1); PG8_BAR;
            PG8_LDA(At, 0, 1); PG8_STAGE(PG8_SA(0, 0), a2, voffA);
            PG8_BAR; PG8_WAIT_L(0); PG8_MMA(1, 0, At, B0); PG8_BAR; PG8_SCHED;
            PG8_STAGE(PG8_SB(0, 1), b2 + hstep, voffB);
            PG8_WAIT_V(6); PG8_BAR; PG8_MMA(1, 1, At, B1); PG8_BAR;
            PG8_LDB(B0, 1, 0); PG8_SCHED; PG8_LDA(At, 1, 0); PG8_STAGE(PG8_SA(0, 1), a2 + hstep, voffA);
            PG8_WAIT_L(8); PG8_BAR; PG8_WAIT_L(0); PG8_MMA(0, 0, At, B0); PG8_BAR; PG8_SCHED;
            PG8_LDB(B1, 1, 1); PG8_STAGE(PG8_SB(1, 0), b3, voffB);
            PG8_BAR; PG8_WAIT_L(0); PG8_MMA(0, 1, At, B1); PG8_BAR;
            PG8_LDA(At, 1, 1); PG8_STAGE(PG8_SA(1, 0), a3, voffA);
            PG8_BAR; PG8_WAIT_L(0); PG8_MMA(1, 0, At, B0); PG8_BAR; PG8_SCHED;
            PG8_STAGE(PG8_SB(1, 1), b3 + hstep, voffB);
            PG8_WAIT_V(6); PG8_BAR; PG8_MMA(1, 1, At, B1); PG8_BAR;
            }
        }
        if constexpr (ALIGN_EPI) { if (wr == 0) PG8_BAR; }
        if constexpr (!Epi::AFTER_DRAIN) { E(acc, cur, wr, wc, fr, fq); S.done(cur); }
        if (!has_next) break;
#pragma unroll
        for (int a = 0; a < 2; ++a)
#pragma unroll
            for (int b = 0; b < 2; ++b)
#pragma unroll
                for (int m = 0; m < 4; ++m)
#pragma unroll
                    for (int n = 0; n < 2; ++n) acc[a][b][m][n] = (f32x4){0.f, 0.f, 0.f, 0.f};
        cur = nxt; cA = nA; cB = nB; ++ui;
        if constexpr (ALIGN_EPI) { if (wr == 1) PG8_BAR; }
    }
    PG8_WAIT_V(0);
    if constexpr (!ALIGN_EPI) { if (wr == 0) PG8_BAR; }
    PG8_BAR;
    if constexpr (Epi::AFTER_DRAIN) { E.fused(acc, cur, wr, wc, fr, fq, lds, wid, lane); S.done(cur); }
#undef PG8_SA
#undef PG8_SB
#undef PG8_STAGE
#undef PG8_LDA
#undef PG8_LDB
#undef PG8_MMA
#undef PG8_WAIT_V
#undef PG8_WAIT_L
#undef PG8_BAR
#undef PG8_SCHED
}
}

#ifndef PG8_SP2
#define PG8_SP2 true
#endif
#ifndef PG8_ALIGN
#define PG8_ALIGN true
#endif
#define XB_TMO      128
#define XB_XCNT(j)  (256  + 64 * (j))
#define XB_XSUB(j)  (1280 + 64 * (j))
#define XB_XGEN(j)  (2304 + 64 * (j))
#define XB_TOP      3328
#define XB_TOPGEN   3392
#define XCD_BAR_WORDS 3456
#define XB_SPIN_CAP (1u << 18)

__device__ __forceinline__ unsigned xb_ld(unsigned* p)              { return __hip_atomic_load(p, __ATOMIC_RELAXED, __HIP_MEMORY_SCOPE_AGENT); }
__device__ __forceinline__ unsigned xb_add(unsigned* p, unsigned v) { return __hip_atomic_fetch_add(p, v, __ATOMIC_RELAXED, __HIP_MEMORY_SCOPE_AGENT); }
__device__ __forceinline__ unsigned xb_xcc_id() { return (unsigned)__builtin_amdgcn_s_getreg((3 << 11) | 20) & 0xFu; }
#define XB_SPIN(cond, bar) do { unsigned _sp = 0; while (cond) { __builtin_amdgcn_s_sleep(1); \
    if ((++_sp & 255u) == 0u) { if (xb_ld(&(bar)[XB_TMO])) break; if (_sp > XB_SPIN_CAP) { atomicAdd(&(bar)[XB_TMO], 1u); break; } } } } while (0)

struct XcdBarrier {
    unsigned* bar; unsigned x;
    volatile LAS unsigned* st;
};

__device__ __forceinline__ XcdBarrier xcd_barrier_post(unsigned* bar, volatile LAS unsigned* st) {
    XcdBarrier b; b.bar = bar; b.x = xb_xcc_id(); b.st = st;
    if (threadIdx.x == 0) (void)xb_add(&bar[XB_XCNT(b.x)], 1u);
    return b;
}
__device__ __forceinline__ void xcd_barrier_complete(unsigned* bar, unsigned x, unsigned& nloc, unsigned& nx) {
    const unsigned G = gridDim.x * gridDim.y * gridDim.z;
    unsigned sum, cnt, mine, sp = 0u;
    for (;;) {
        sum = 0u; cnt = 0u; mine = 0u;
#pragma unroll
        for (unsigned j = 0; j < 16; ++j) { const unsigned c = xb_ld(&bar[XB_XCNT(j)]); sum += c; cnt += (c > 0u) ? 1u : 0u; mine = (j == x) ? c : mine; }
        if (sum == G) break;
        __builtin_amdgcn_s_sleep(1);
        if ((++sp & 255u) == 0u) { if (xb_ld(&bar[XB_TMO])) break; if (sp > XB_SPIN_CAP) { atomicAdd(&bar[XB_TMO], 1u); break; } }
    }
    nloc = mine > 0u ? mine : 1u; nx = cnt > 0u ? cnt : 1u;
}

__device__ __forceinline__ void xcd_barrier(const XcdBarrier& b) {
    asm volatile("s_waitcnt vmcnt(0)" ::: "memory");
    __syncthreads();
    if (threadIdx.x == 0) {
        unsigned* bar = b.bar;
        __builtin_amdgcn_s_waitcnt(0);
        unsigned nloc = b.st[0], nx = b.st[1];
        if (nloc == 0u) { xcd_barrier_complete(bar, b.x, nloc, nx); b.st[0] = nloc; b.st[1] = nx; }
        const unsigned old = xb_add(&bar[XB_XSUB(b.x)], 1u);
        const unsigned gen = old / nloc;
        if (old + 1u == (gen + 1u) * nloc) {
            __builtin_amdgcn_fence(__ATOMIC_RELEASE, "agent");
            asm volatile("s_waitcnt vmcnt(0)" ::: "memory");
            const unsigned og = xb_add(&bar[XB_TOP], 1u);
            const unsigned tg = og / nx;
            if (og + 1u == (tg + 1u) * nx) xb_add(&bar[XB_TOPGEN], 1u);
            else XB_SPIN(xb_ld(&bar[XB_TOPGEN]) == tg, bar);
            __builtin_amdgcn_fence(__ATOMIC_ACQUIRE, "agent");
            xb_add(&bar[XB_XGEN(b.x)], 1u);
            asm volatile("s_waitcnt vmcnt(0)" ::: "memory");
        } else {
            XB_SPIN(xb_ld(&bar[XB_XGEN(b.x)]) == gen, bar);
            __builtin_amdgcn_fence(__ATOMIC_ACQUIRE, "agent");
            asm volatile("s_waitcnt vmcnt(0)" ::: "memory");
        }
    }
    __syncthreads();
}
struct KC {
    const float* const* in;
    LAS unsigned char* lds;
    unsigned char* ws;
    int tid, lane, wave, G, bid;
};
__device__ __forceinline__ const float* inp_(int i) {
    const volatile unsigned long long __attribute__((address_space(4)))* kp = (const volatile unsigned long long __attribute__((address_space(4)))*)__builtin_amdgcn_kernarg_segment_ptr();
    return (const float*)(const GAS float*)kp[i];
}
#define INP(k) (inp_(k))

__device__ __forceinline__ int mod_row(int row) { return row < TL ? (row >> 11) : 8; }

__device__ __forceinline__ void ph_adaln_partials(const KC& k, const float* c, const float* c_ctx, const float* w_ada) {
    LAS float* sc = (LAS float*)k.lds;
    for (int i = k.tid; i < 9 * DM; i += 512) { const int r = i >> 11, kk = i & 2047; const float cv = r < 8 ? c[r * DM + kk] : c_ctx[kk]; sc[i] = siluf(cv); }
    __syncthreads();
    float* modp = (float*)(k.ws + WS_MODP);
    const int cc = k.tid & 255, kh = k.tid >> 8;
    constexpr int NIT = DEPTH * 48 * 16;
    for (int it = k.bid; it < NIT; it += k.G) {
        const int l = it / 768, rem = it % 768, cb = rem >> 4, ks = rem & 15;
        const int col = cb * 256 + cc, kbeg = ks * 128 + kh * 64;
        const float* W = w_ada + ((size_t)l * DM + kbeg) * MOD_N + col;
        float acc[9];
#pragma unroll
        for (int r = 0; r < 9; ++r) acc[r] = 0.f;
#pragma unroll 32
        for (int q = 0; q < 64; ++q) {
            const float w = W[(size_t)q * MOD_N];
#pragma unroll
            for (int r = 0; r < 9; ++r) acc[r] += sc[r * DM + kbeg + q] * w;
        }
        const int s = ks * 2 + kh;
#pragma unroll
        for (int r = 0; r < 9; ++r) modp[(((size_t)s * DEPTH + l) * 9 + r) * MOD_N + col] = acc[r];
    }
    __syncthreads();
}
__device__ __forceinline__ void ph_adaln_reduce(const KC& k, const float* b_ada) {
    const float* modp = (const float*)(k.ws + WS_MODP); float* mod = (float*)(k.ws + WS_MOD);
    constexpr int TOT = DEPTH * 9 * MOD_N;
    for (int i = k.bid * 512 + k.tid; i < TOT; i += k.G * 512) {
        const int n = i % MOD_N, l = i / (9 * MOD_N);
        float s = b_ada[l * MOD_N + n];
#pragma unroll 8
        for (int q = 0; q < KSPLIT; ++q) s += modp[(size_t)q * TOT + i];
        mod[i] = s;
    }
}

struct TrItem { const float* src; bf16* dst; int srcN, Kv, Nv, k0, n0, dpitch, drow0, dk0; };
struct WSrc { const float *w_in, *w2, *a2, *g2, *wba, *wbb, *wout, *eg, *eu, *ed, *w0, *a0; };
constexpr int TI_IN = 32 * 336, TI_LO = 4 * 64, TI_G2 = 4 * 32, TI_AB = 16 * 64, TI_O = 32 * 64, TI_GU1 = 32 * 44, TI_D1 = 22 * 64;
constexpr int TI_N = TI_IN + TI_LO + TI_G2 + 2 * TI_AB + TI_O + 2 * NEXP * TI_GU1 + NEXP * TI_D1;
__device__ __forceinline__ TrItem tr_decode(const WSrc& s, unsigned char* ws, int l, int it) {
    TrItem t; int r = it;
    if (r < TI_IN) { const int kb = r / 336, nb = r % 336; t = TrItem{s.w_in + (size_t)l * DM * IN_DIM, (bf16*)(ws + WT_IN), IN_DIM, DM, IN_DIM, 64 * kb, 32 * nb, DM, 32 * nb, 0}; return t; } r -= TI_IN;
    if (r < TI_LO) {
        const int mtx = r >> 6, q = r & 63, kb = q >> 5, nb = q & 31;
        t = TrItem{(mtx < 2 ? s.w2 : s.a2) + (size_t)(l * 2 + (mtx & 1)) * 96 * RD, (bf16*)(ws + WT_L1), RD, 96, RD, 64 * kb, 32 * nb, 256, mtx * 1024 + 32 * nb, mtx < 2 ? 0 : 96}; return t; } r -= TI_LO;
    if (r < TI_G2) { const int kb = r >> 5, nb = r & 31; t = TrItem{s.g2 + (size_t)l * 256 * RD, (bf16*)(ws + WT_G2), RD, 256, RD, 64 * kb, 32 * nb, 256, 32 * nb, 0}; return t; } r -= TI_G2;
    if (r < TI_AB) { const int kb = r >> 6, nb = r & 63; t = TrItem{s.wba + (size_t)l * RD * DM, (bf16*)(ws + WT_A), DM, RD, DM, 64 * kb, 32 * nb, RD, 32 * nb, 0}; return t; } r -= TI_AB;
    if (r < TI_AB) { const int kb = r >> 6, nb = r & 63; t = TrItem{s.wbb + (size_t)l * GVD * DM, (bf16*)(ws + WT_B), DM, GVD, DM, 64 * kb, 32 * nb, GVD, 32 * nb, 0}; return t; } r -= TI_AB;
    if (r < TI_O) { const int kb = r >> 6, nb = r & 63; t = TrItem{s.wout + (size_t)l * DM * DM, (bf16*)(ws + WT_O), DM, DM, DM, 64 * kb, 32 * nb, DM, 32 * nb, 0}; return t; } r -= TI_O;
    if (r < 2 * NEXP * TI_GU1) {
        const int e = r / (2 * TI_GU1), q = r % (2 * TI_GU1), up = q / TI_GU1, q2 = q % TI_GU1, kb = q2 / 44, nb = q2 % 44;
        const int n0 = 32 * nb, drow = 256 * (n0 >> 7) + (n0 & 127) + (up ? 128 : 0);
        t = TrItem{(up ? s.eu : s.eg) + ((size_t)l * NEXP + e) * DM * DEXP, (bf16*)(ws + WT_GU) + (size_t)e * 2816 * DM, DEXP, DM, DEXP, 64 * kb, n0, DM, drow, 0}; return t; } r -= 2 * NEXP * TI_GU1;
    { const int e = r / TI_D1, q = r % TI_D1, kb = q >> 6, nb = q & 63;
      t = TrItem{s.ed + ((size_t)l * NEXP + e) * DEXP * DM, (bf16*)(ws + WT_D) + (size_t)e * DM * DEXP, DM, DEXP, DM, 64 * kb, 32 * nb, DEXP, 32 * nb, 0}; }
    return t;
}
__device__ __forceinline__ void tr_load(const TrItem& t, int lane, float (&v)[32]) {
    const int nn = lane & 31, kh = lane >> 5;
    const bool nok = t.n0 + nn < t.Nv;
    const float* p = t.src + (size_t)(t.k0 + kh) * t.srcN + t.n0 + nn;
#pragma unroll
    for (int i = 0; i < 32; ++i) { v[i] = 0.f; if (nok && t.k0 + 2 * i + kh < t.Kv) v[i] = p[(size_t)(2 * i) * t.srcN]; }
}
__device__ __forceinline__ void tr_store(const TrItem& t, int lane, const float (&v)[32], LAS float* scr) {
    const int nn = lane & 31, kh = lane >> 5;
#pragma unroll
    for (int i = 0; i < 32; ++i) scr[(2 * i + kh) * 33 + nn] = v[i];
    asm volatile("s_waitcnt lgkmcnt(0)" ::: "memory");
    const int cidx = lane & 7;
#pragma unroll
    for (int j = 0; j < 4; ++j) {
        const int n = (lane >> 3) + 8 * j; const LAS float* s = scr + (8 * cidx) * 33 + n;
        u32x4 o; o.x = pk2(s[0 * 33], s[1 * 33]); o.y = pk2(s[2 * 33], s[3 * 33]); o.z = pk2(s[4 * 33], s[5 * 33]); o.w = pk2(s[6 * 33], s[7 * 33]);
        *(u32x4*)(t.dst + (size_t)(t.drow0 + n) * t.dpitch + t.dk0 + t.k0 + 8 * cidx) = o;
    }
    asm volatile("s_waitcnt lgkmcnt(0)" ::: "memory");
}
__device__ __forceinline__ void ph_convert(const KC& k, const WSrc& s, int l) {
    LAS float* scr = (LAS float*)(k.lds + k.wave * 16384);
    const int gw = k.bid * 8 + k.wave, NGW = k.G * 8;
    unsigned char* ws = k.ws;
    { float* b1 = (float*)(ws + WS_TAB + TAB_TOP); for (int i = gw * 64 + k.lane; i < 4096; i += NGW * 64) b1[i] = i < 2048 ? s.w0[l * 2048 + i] : s.a0[l * 2048 + i - 2048]; }
    {
        u32x4* wl = (u32x4*)(ws + WT_L1);
        for (int i = gw * 64 + k.lane; i < 4096 * 32; i += NGW * 64) { const int row = i >> 5, ck = i & 31; if (row < 2048 ? ck >= 16 : (ck < 12 || ck >= 28)) wl[i] = (u32x4){0u, 0u, 0u, 0u}; }
        if (l == 0) { int* rt = (int*)(ws + WS_TAB + TAB_ROWTOK); for (int i = gw * 64 + k.lane; i < 2 * MOE_ROWS; i += NGW * 64) rt[i] = -1; }
    }
    float cur[32], nxt[32];
    int it = gw;
    TrItem tc = tr_decode(s, ws, l, it < TI_N ? it : 0);
    if (it < TI_N) tr_load(tc, k.lane, cur);
    for (; it < TI_N; it += NGW) {
        const bool more = it + NGW < TI_N;
        const TrItem tn = tr_decode(s, ws, l, more ? it + NGW : it);
        if (more) tr_load(tn, k.lane, nxt);
        tr_store(tc, k.lane, cur, scr);
        tc = tn;
#pragma unroll
        for (int i = 0; i < 32; ++i) cur[i] = nxt[i];
    }
}

constexpr int RWP = DM + 4;
struct RowArgs { const float *x_in, *ctx_in, *gvec, *router_w, *router_b; float* out; };
template <int MODE>
__device__ __forceinline__ void ph_rows(const KC& k, const RowArgs& ra, int l, int nrows, bool dry = false) {
    const int gw = k.bid * 8 + k.wave, NGW = k.G * 8, lane = k.lane;
    float* X = (float*)(k.ws + WS_X); bf16* H = (bf16*)(k.ws + WS_H);
    const float* MOD = (const float*)(k.ws + WS_MOD);
    const bf16* YF = (const bf16*)(k.ws + WS_YF);
    LAS float* rwT = (LAS float*)k.lds;
    if (MODE == 1) {
        for (int i = k.tid; i < DM * NEXP; i += 512) { const int c = i >> 4, e = i & 15; rwT[e * RWP + c] = ra.router_w[i]; }
        __syncthreads();
    }
    const float* gv = ra.gvec;
    for (int row = gw; row < nrows; row += NGW) {
        const int mr = mod_row(row);
        f32x4 v[8];
        if (MODE == 0 && l == 0) {
            const f32x4* src = (const f32x4*)(row < TL ? ra.x_in + (size_t)row * DM : ra.ctx_in + (size_t)(row - TL) * DM) + lane;
#pragma unroll
            for (int j = 0; j < 8; ++j) v[j] = src[64 * j];
        } else {
            const f32x4* src = (const f32x4*)(X + (size_t)row * DM) + lane;
#pragma unroll
            for (int j = 0; j < 8; ++j) v[j] = src[64 * j];
        }
        if ((MODE == 0 && l > 0) || MODE == 2) {
            const int lp = (MODE == 2) ? DEPTH - 1 : l - 1;
            const f32x4* gate = (const f32x4*)(MOD + ((size_t)lp * 9 + mr) * MOD_N + 5 * DM) + lane;
            const u32x2* y0 = (const u32x2*)(YF + (size_t)row * DM) + lane;
            const u32x2* y1 = (const u32x2*)(YF + ((size_t)TA + row) * DM) + lane;
#pragma unroll
            for (int j = 0; j < 8; ++j) {
                const f32x4 g = gate[64 * j]; const u32x2 a = y0[64 * j], b = y1[64 * j];
                v[j].x += g.x * (bflo(a.x) + bflo(b.x)); v[j].y += g.y * (bfhi(a.x) + bfhi(b.x));
                v[j].z += g.z * (bflo(a.y) + bflo(b.y)); v[j].w += g.w * (bfhi(a.y) + bfhi(b.y));
            }
        }
        if (MODE == 0) {
            f32x4* dst = (f32x4*)(X + (size_t)row * DM) + lane;
#pragma unroll
            for (int j = 0; j < 8; ++j) dst[64 * j] = v[j];
        }
        float ss = 0.f;
#pragma unroll
        for (int j = 0; j < 8; ++j) ss += (v[j].x * v[j].x + v[j].y * v[j].y) + (v[j].z * v[j].z + v[j].w * v[j].w);
        const float rinv = 1.0f / sqrtf(wave_sum(ss) * (1.0f / DM) + 1e-6f);
        if (MODE == 2) {
            f32x4* dst = (f32x4*)(ra.out + (size_t)row * DM) + lane; const f32x4* g4 = (const f32x4*)gv + lane;
#pragma unroll
            for (int j = 0; j < 8; ++j) { const f32x4 g = g4[64 * j]; dst[64 * j] = v[j] * rinv * g; }
        } else {
            const float* mrow = MOD + ((size_t)l * 9 + mr) * MOD_N + (MODE == 0 ? 0 : 3 * DM);
            const f32x4* sh4 = (const f32x4*)mrow + lane; const f32x4* sc4 = (const f32x4*)(mrow + DM) + lane; const f32x4* g4 = (const f32x4*)(gv + (size_t)l * DM) + lane;
            u32x2* dst = (u32x2*)(H + (size_t)row * DM) + lane;
#pragma unroll
            for (int j = 0; j < 8; ++j) {
                const f32x4 g = g4[64 * j], sh = sh4[64 * j], sc = sc4[64 * j];
                v[j] = v[j] * rinv * g * (1.0f + sc) + sh;
                u32x2 o; o.x = pk2(v[j].x, v[j].y); o.y = pk2(v[j].z, v[j].w); dst[64 * j] = o;
            }
        }
        if (MODE == 1) {
            float lg[NEXP];
#pragma unroll
            for (int e = 0; e < NEXP; ++e) {
                float s = 0.f;
#pragma unroll
                for (int j = 0; j < 8; ++j) { const f32x4 w = *(const LAS f32x4*)(rwT + e * RWP + 4 * lane + 256 * j); s += (v[j].x * w.x + v[j].y * w.y) + (v[j].z * w.z + v[j].w * w.w); }
                lg[e] = wave_sum(s);
            }
            float sc[NEXP], sel[NEXP];
#pragma unroll
            for (int e = 0; e < NEXP; ++e) { sc[e] = 1.0f / (1.0f + expf(-lg[e])); sel[e] = sc[e] + ra.router_b[e]; }
            float gs[4], w1g[4], w2g[4]; int i1g[4], i2g[4];
#pragma unroll
            for (int g = 0; g < 4; ++g) {
                int i1 = 0; float m1 = sel[4 * g];
#pragma unroll
                for (int q = 1; q < 4; ++q) if (sel[4 * g + q] > m1) { m1 = sel[4 * g + q]; i1 = q; }
                int i2 = -1; float m2 = -3.0e38f;
#pragma unroll
                for (int q = 0; q < 4; ++q) if (q != i1 && sel[4 * g + q] > m2) { m2 = sel[4 * g + q]; i2 = q; }
                gs[g] = m1 + m2; i1g[g] = 4 * g + i1; i2g[g] = 4 * g + i2;
                float a1 = sc[4 * g], a2 = sc[4 * g];
#pragma unroll
                for (int q = 0; q < 4; ++q) { a1 = (q == i1) ? sc[4 * g + q] : a1; a2 = (q == i2) ? sc[4 * g + q] : a2; }
                w1g[g] = a1; w2g[g] = a2;
            }
            int best = 0; float bs = gs[0];
#pragma unroll
            for (int g = 1; g < 4; ++g) if (gs[g] > bs) { bs = gs[g]; best = g; }
            int e1 = i1g[0], e2 = i2g[0]; float w1 = w1g[0], w2 = w2g[0];
#pragma unroll
            for (int g = 1; g < 4; ++g) { e1 = (best == g) ? i1g[g] : e1; e2 = (best == g) ? i2g[g] : e2; w1 = (best == g) ? w1g[g] : w1; w2 = (best == g) ? w2g[g] : w2; }
            const float inv = 1.0f / (w1 + w2);
            if (lane == 0 && !dry) {
                unsigned* cnt = (unsigned*)(k.ws + WS_CTL) + CW_CNT + 64 * l;
                const int p1 = (int)atomicAdd(cnt + e1, 1u), p2 = (int)atomicAdd(cnt + e2, 1u);
                int* te = (int*)(k.ws + WS_TOPK); float* tw = (float*)(k.ws + WS_TOPK + (size_t)TA * 8); int* tp = (int*)(k.ws + WS_TOPK + 2 * (size_t)TA * 8);
                te[2 * row] = e1; te[2 * row + 1] = e2; tw[2 * row] = w1 * inv; tw[2 * row + 1] = w2 * inv; tp[2 * row] = p1; tp[2 * row + 1] = p2;
            }
        }
    }
    if (MODE == 1) __syncthreads();
}

__device__ __forceinline__ void ph_moe_scatter(const KC& k, int l, int nrows) {
    LAS int* offs = (LAS int*)k.lds;
    const unsigned* cnt = (const unsigned*)(k.ws + WS_CTL) + CW_CNT + 64 * l;
    int* tile = (int*)(k.ws + WS_TAB + TAB_TILE) + 256 * l;
    if (k.tid == 0) {
        int off = 0, nt = 0;
        for (int e = 0; e < NEXP; ++e) {
            offs[e] = off; const int c = (int)__hip_atomic_load(cnt + e, __ATOMIC_RELAXED, __HIP_MEMORY_SCOPE_AGENT); const int t = (c + 255) >> 8;
            if (k.bid == 0) for (int q = 0; q < t; ++q) tile[1 + nt + q] = e;
            nt += t; off += t * 256;
        }
        if (k.bid == 0) tile[0] = nt;
    }
    __syncthreads();
    const int gw = k.bid * 8 + k.wave, NGW = k.G * 8, lane = k.lane;
    const bf16* H = (const bf16*)(k.ws + WS_H); bf16* HP = (bf16*)(k.ws + WS_HP);
    const int* te = (const int*)(k.ws + WS_TOPK); const float* tw = (const float*)(k.ws + WS_TOPK + (size_t)TA * 8); const int* tp = (const int*)(k.ws + WS_TOPK + 2 * (size_t)TA * 8);
    int* rowtok = (int*)(k.ws + WS_TAB + TAB_ROWTOK) + (size_t)l * MOE_ROWS; float* roww = (float*)(k.ws + WS_TAB + TAB_ROWW) + (size_t)l * MOE_ROWS;
    for (int row = gw; row < nrows; row += NGW) {
        const u32x4* src = (const u32x4*)(H + (size_t)row * DM) + lane;
        u32x4 d[4];
#pragma unroll
        for (int j = 0; j < 4; ++j) d[j] = src[64 * j];
#pragma unroll
        for (int s = 0; s < 2; ++s) {
            const int e = te[2 * row + s], dest = offs[e] + tp[2 * row + s];
            u32x4* dp = (u32x4*)(HP + (size_t)dest * DM) + lane;
#pragma unroll
            for (int j = 0; j < 4; ++j) dp[64 * j] = d[j];
            if (lane == 0) { rowtok[dest] = 2 * row + s; roww[dest] = tw[2 * row + s]; }
        }
    }
    __syncthreads();
}
__device__ __forceinline__ void ld16(const bf16* p, bool ok, float (&o)[16]) {
    if (ok) { const u32x4 a = *(const u32x4*)p, b = *(const u32x4*)(p + 8); float x[8], y[8]; unpack8(a, x); unpack8(b, y);
#pragma unroll
        for (int i = 0; i < 8; ++i) { o[i] = x[i]; o[8 + i] = y[i]; } }
    else {
#pragma unroll
        for (int i = 0; i < 16; ++i) o[i] = 0.f; }
}
__device__ __forceinline__ void st16(bf16* p, const float (&v)[16]) {
    float a[8], b[8];
#pragma unroll
    for (int i = 0; i < 8; ++i) { a[i] = v[i]; b[i] = v[8 + i]; }
    *(u32x4*)p = pack8(a); *(u32x4*)(p + 8) = pack8(b);
}
__device__ __forceinline__ void shift8(const bf16* p0, bool hp, bool hn, int c, const float* mu0, const float* mu1, float (&s)[8]) {
    float x[8], xm[8], xp[8];
    unpack8(*(const u32x4*)(p0 + c), x);
    if (hp) unpack8(*(const u32x4*)(p0 - NP + c), xm); else {
#pragma unroll
        for (int i = 0; i < 8; ++i) xm[i] = 0.f; }
    if (hn) unpack8(*(const u32x4*)(p0 + NP + c), xp); else {
#pragma unroll
        for (int i = 0; i < 8; ++i) xp[i] = 0.f; }
    const f32x4 m0a = *(const f32x4*)(mu0 + c), m0b = *(const f32x4*)(mu0 + c + 4), m1a = *(const f32x4*)(mu1 + c), m1b = *(const f32x4*)(mu1 + c + 4);
    const float m0[8] = {m0a.x, m0a.y, m0a.z, m0a.w, m0b.x, m0b.y, m0b.z, m0b.w}, m1[8] = {m1a.x, m1a.y, m1a.z, m1a.w, m1b.x, m1b.y, m1b.z, m1b.w};
#pragma unroll
    for (int i = 0; i < 8; ++i) s[i] = x[i] + m0[i] * (xm[i] - x[i]) + m1[i] * (xp[i] - x[i]);
}
__device__ __forceinline__ void ph_rwkv_prep(const KC& k, int l, int nrows, const float* mu, const float* k_k, const float* r_k) {
    const int gw = k.bid * 8 + k.wave, NGW = k.G * 8, lane = k.lane;
    const bf16* P = (const bf16*)(k.ws + WS_P);
    bf16* R = (bf16*)(k.ws + RW_R); bf16* KS = (bf16*)(k.ws + RW_KS); bf16* V = (bf16*)(k.ws + RW_V); bf16* KK = (bf16*)(k.ws + RW_KK);
    bf16* A1 = (bf16*)(k.ws + RW_A1); bf16* A2 = (bf16*)(k.ws + RW_A2); float* BON = (float*)(k.ws + RW_BON);
    const float* mu0 = mu + (size_t)(l * 2 + 0) * RWKV_IN; const float* mu1 = mu + (size_t)(l * 2 + 1) * RWKV_IN;
    const int rpw = (nrows + NGW - 1) / NGW;
    for (int row = gw * rpw; row < nrows && row < (gw + 1) * rpw; ++row) {
        int t, len; if (row < TL) { t = row & (SEQ - 1); len = SEQ; } else { t = (row - TL) & (CTXL - 1); len = CTXL; }
        const bool hp = t > 0, hn = t < len - 1;
        const bf16* p0 = P + (size_t)row * NP;
#pragma unroll
        for (int half = 0; half < 2; ++half) {
            const int c = half * 512 + 8 * lane;
            float r[8], kx[8], vv[8], kk[8];
            shift8(p0, hp, hn, c, mu0, mu1, r);
            shift8(p0, hp, hn, RD + c, mu0, mu1, kx);
            shift8(p0, hp, hn, 2 * RD + c, mu0, mu1, vv);
            const f32x4 kka = *(const f32x4*)(k_k + l * RD + c), kkb = *(const f32x4*)(k_k + l * RD + c + 4), rka = *(const f32x4*)(r_k + l * RD + c), rkb = *(const f32x4*)(r_k + l * RD + c + 4);
            const float kkw[8] = {kka.x, kka.y, kka.z, kka.w, kkb.x, kkb.y, kkb.z, kkb.w}, rkw[8] = {rka.x, rka.y, rka.z, rka.w, rkb.x, rkb.y, rkb.z, rkb.w};
            float ss = 0.f, bon = 0.f;
#pragma unroll
            for (int i = 0; i < 8; ++i) { kk[i] = kx[i] * kkw[i]; ss += kk[i] * kk[i]; bon += r[i] * kx[i] * rkw[i]; }
            ss += __shfl_xor(ss, 1); ss += __shfl_xor(ss, 2); ss += __shfl_xor(ss, 4);
            bon += __shfl_xor(bon, 1); bon += __shfl_xor(bon, 2); bon += __shfl_xor(bon, 4);
            const float inv = 1.0f / fmaxf(sqrtf(ss), 1e-12f);
#pragma unroll
            for (int i = 0; i < 8; ++i) kk[i] *= inv;
            *(u32x4*)(R + (size_t)row * RD + c) = pack8(r); *(u32x4*)(KS + (size_t)row * RD + c) = pack8(kx);
            *(u32x4*)(V + (size_t)row * RD + c) = pack8(vv); *(u32x4*)(KK + (size_t)row * RD + c) = pack8(kk);
            if ((lane & 7) == 0) BON[(size_t)row * RHEADS + half * 8 + (lane >> 3)] = bon;
        }
        if (lane < 56) {
            float s8[8];
            shift8(p0, hp, hn, 3 * RD + 8 * lane, mu0, mu1, s8);
            if (lane < 12) {
#pragma unroll
                for (int i = 0; i < 8; ++i) { const float e2 = __expf(2.0f * fminf(fmaxf(s8[i], -15.f), 15.f)); s8[i] = 1.0f - 2.0f / (e2 + 1.0f); }
                *(u32x4*)(A1 + (size_t)row * 256 + 8 * lane) = pack8(s8);
            } else if (lane < 24) { *(u32x4*)(A1 + (size_t)row * 256 + 8 * lane) = pack8(s8); }
            else {
#pragma unroll
                for (int i = 0; i < 8; ++i) s8[i] = sigm(s8[i]);
                *(u32x4*)(A2 + (size_t)row * 256 + 8 * (lane - 24)) = pack8(s8);
            }
        } else { *(u32x4*)(A1 + (size_t)row * 256 + 192 + 8 * (lane - 56)) = (u32x4){0u, 0u, 0u, 0u}; }
    }
}

__device__ __forceinline__ float logsig(float x) { return fminf(x, 0.f) - __logf(1.0f + __expf(-fabsf(x))); }
__device__ __forceinline__ int gla_row(bool lat, int b, int s) { return lat ? b * SEQ + (s & 31) * 64 + (s >> 5) : TL + b * CTXL + s; }
constexpr int GQ_PITCH = 264;
constexpr int GPL_AD = 0, GPL_GS = 4096, GPL_QK = GPL_GS + 65536, GPL_END = GPL_QK + 66 * GQ_PITCH * 2;
static_assert(GPL_END <= 131072, "gla prep lds");
__device__ __forceinline__ void ph_gla_prep(const KC& k, int l, const float* conv, const float* aw2, const float* ab) {
    const bf16* P = (const bf16*)(k.ws + WS_P);
    bf16* QG = (bf16*)(k.ws + GL_QG); bf16* KG = (bf16*)(k.ws + GL_KG); bf16* KE = (bf16*)(k.ws + GL_KE); bf16* VS = (bf16*)(k.ws + GL_VS); float* DEC = (float*)(k.ws + GL_DEC);
    const float* cw = conv + (size_t)l * 3 * GQKV;
    const int tid = k.tid, lane = k.lane;
    {
        const int gw = k.bid * 8 + k.wave, NGW = k.G * 8, c = 16 * lane;
        const int rpw = (TA + NGW - 1) / NGW;
        for (int qi = gw * rpw; qi < TA && qi < (gw + 1) * rpw; ++qi) {
            const bool lat = qi < TL; int b, s, len;
            if (lat) { b = qi >> 11; s = qi & 2047; len = SEQ; } else { b = (qi - TL) >> 8; s = (qi - TL) & 255; len = CTXL; }
            const int row = gla_row(lat, b, s);
            const bool hp = s > 0, hn = s + 1 < len;
            const bf16* p0 = P + (size_t)row * NP + GLA_OFF + 2 * GKD + c;
            const bf16* pm = P + (size_t)gla_row(lat, b, hp ? s - 1 : s) * NP + GLA_OFF + 2 * GKD + c;
            const bf16* pp = P + (size_t)gla_row(lat, b, hn ? s + 1 : s) * NP + GLA_OFF + 2 * GKD + c;
            float o[16];
#pragma unroll
            for (int hf = 0; hf < 2; ++hf) {
                float x[8], xm[8], xp[8];
                unpack8(*(const u32x4*)(p0 + 8 * hf), x); unpack8(*(const u32x4*)(pm + 8 * hf), xm); unpack8(*(const u32x4*)(pp + 8 * hf), xp);
                const float* w = cw + 2 * GKD + c + 8 * hf;
#pragma unroll
                for (int q = 0; q < 2; ++q) {
                    const f32x4 w0 = *(const f32x4*)(w + 4 * q), w1 = *(const f32x4*)(w + GQKV + 4 * q), w2 = *(const f32x4*)(w + 2 * GQKV + 4 * q);
#pragma unroll
                    for (int i = 0; i < 4; ++i) o[8 * hf + 4 * q + i] = siluf(w0[i] * (hp ? xm[4 * q + i] : 0.f) + w1[i] * x[4 * q + i] + w2[i] * (hn ? xp[4 * q + i] : 0.f));
                }
            }
            st16(VS + (size_t)row * GVD + c, o);
        }
    }
    LAS float* ADs = (LAS float*)(k.lds + GPL_AD);
    LAS float* Gs = (LAS float*)(k.lds + GPL_GS);
    LAS bf16* QKs = (LAS bf16*)(k.lds + GPL_QK);
    for (int item = k.bid; item < 288 * 4; item += k.G) {
        const int sc = item >> 2, h = item & 3;
        const bool lat = sc < 256; const int b = lat ? (sc >> 5) : ((sc - 256) >> 2), cn = lat ? (sc & 31) : ((sc - 256) & 3), len = lat ? SEQ : CTXL;
        const int gch = lat ? 4 + cn : cn, s0 = 64 * cn;
        for (int i = tid; i < 1024; i += 512) { const int tau = i >> 4, j = i & 15; ADs[i] = bf2f(P[(size_t)gla_row(lat, b, s0 + tau) * NP + GLA_AD_OFF + j]); }
        for (int i = tid; i < 66 * 32; i += 512) {
            const int rr = i >> 5, ck = i & 31, s = s0 - 1 + rr;
            u32x4 v = (u32x4){0u, 0u, 0u, 0u};
            if (s >= 0 && s < len) v = *(const u32x4*)(P + (size_t)gla_row(lat, b, s) * NP + GLA_OFF + (ck >> 4) * GKD + h * GDK + (ck & 15) * 8);
            *(LAS u32x4*)(QKs + rr * GQ_PITCH + ck * 8) = v;
        }
        __syncthreads();
        {
            const int c = tid & 127, tg = tid >> 7, chl = h * GDK + c;
            float awf[16], awb[16];
#pragma unroll
            for (int j = 0; j < 16; ++j) { awf[j] = aw2[((size_t)(l * 2 + 0) * 16 + j) * GKD + chl]; awb[j] = aw2[((size_t)(l * 2 + 1) * 16 + j) * GKD + chl]; }
            const float abf = ab[(l * 2 + 0) * GKD + chl], abb = ab[(l * 2 + 1) * GKD + chl];
            for (int i = 0; i < 16; ++i) {
                const int tau = 16 * tg + i; float xf = abf, xb = abb;
#pragma unroll
                for (int j = 0; j < 16; ++j) { const float a = ADs[tau * 16 + j]; xf += a * awf[j]; xb += a * awb[j]; }
                Gs[tau * 128 + c] = logsig(xf) * (1.0f / 16.0f); Gs[(64 + tau) * 128 + c] = logsig(xb) * (1.0f / 16.0f);
            }
        }
        __syncthreads();
        if (tid < 128) { float run = 0.f; for (int tau = 0; tau < 64; ++tau) { run += Gs[tau * 128 + tid]; Gs[tau * 128 + tid] = run; } }
        else if (tid < 256) { const int c = tid - 128; float run = 0.f; for (int tau = 63; tau >= 0; --tau) { run += Gs[(64 + tau) * 128 + c]; Gs[(64 + tau) * 128 + c] = run; } }
        __syncthreads();
        {
            const int c8 = tid & 15, tg = tid >> 4, chl = h * GDK + 8 * c8;
            float wq[3][8], wk[3][8], elf[8], elb[8];
#pragma unroll
            for (int tp = 0; tp < 3; ++tp) {
                const f32x4 a0 = *(const f32x4*)(cw + tp * GQKV + chl), a1 = *(const f32x4*)(cw + tp * GQKV + chl + 4), b0 = *(const f32x4*)(cw + tp * GQKV + GKD + chl), b1 = *(const f32x4*)(cw + tp * GQKV + GKD + chl + 4);
#pragma unroll
                for (int i = 0; i < 4; ++i) { wq[tp][i] = a0[i]; wq[tp][4 + i] = a1[i]; wk[tp][i] = b0[i]; wk[tp][4 + i] = b1[i]; }
            }
            {
                const f32x4 a0 = *(const LAS f32x4*)(Gs + 63 * 128 + 8 * c8), a1 = *(const LAS f32x4*)(Gs + 63 * 128 + 8 * c8 + 4), b0 = *(const LAS f32x4*)(Gs + 64 * 128 + 8 * c8), b1 = *(const LAS f32x4*)(Gs + 64 * 128 + 8 * c8 + 4);
#pragma unroll
                for (int i = 0; i < 4; ++i) { elf[i] = __expf(a0[i]); elf[4 + i] = __expf(a1[i]); elb[i] = __expf(b0[i]); elb[4 + i] = __expf(b1[i]); }
            }
            if (tg < 8) {
                float* d0 = DEC + ((size_t)(0 * 8 + b) * NCH + gch) * GKD + chl; float* d1 = DEC + ((size_t)(1 * 8 + b) * NCH + gch) * GKD + chl;
                if (tg == 0) { *(f32x4*)d0 = (f32x4){elf[0], elf[1], elf[2], elf[3]}; *(f32x4*)(d0 + 4) = (f32x4){elf[4], elf[5], elf[6], elf[7]}; }
                if (tg == 1) { *(f32x4*)d1 = (f32x4){elb[0], elb[1], elb[2], elb[3]}; *(f32x4*)(d1 + 4) = (f32x4){elb[4], elb[5], elb[6], elb[7]}; }
            }
#pragma unroll
            for (int pass = 0; pass < 2; ++pass) {
                const int tau = tg + 32 * pass;
                float qm[8], q0[8], qp[8], km[8], k0[8], kp[8];
                unpack8(*(const LAS u32x4*)(QKs + (tau + 0) * GQ_PITCH + 8 * c8), qm); unpack8(*(const LAS u32x4*)(QKs + (tau + 1) * GQ_PITCH + 8 * c8), q0); unpack8(*(const LAS u32x4*)(QKs + (tau + 2) * GQ_PITCH + 8 * c8), qp);
                unpack8(*(const LAS u32x4*)(QKs + (tau + 0) * GQ_PITCH + 128 + 8 * c8), km); unpack8(*(const LAS u32x4*)(QKs + (tau + 1) * GQ_PITCH + 128 + 8 * c8), k0); unpack8(*(const LAS u32x4*)(QKs + (tau + 2) * GQ_PITCH + 128 + 8 * c8), kp);
                const f32x4 f0 = *(const LAS f32x4*)(Gs + tau * 128 + 8 * c8), f1 = *(const LAS f32x4*)(Gs + tau * 128 + 8 * c8 + 4), g0 = *(const LAS f32x4*)(Gs + (64 + tau) * 128 + 8 * c8), g1 = *(const LAS f32x4*)(Gs + (64 + tau) * 128 + 8 * c8 + 4);
                const float cf[8] = {f0.x, f0.y, f0.z, f0.w, f1.x, f1.y, f1.z, f1.w}, cb[8] = {g0.x, g0.y, g0.z, g0.w, g1.x, g1.y, g1.z, g1.w};
                float oqf[8], okf[8], oef[8], oqb[8], okb[8], oeb[8];
#pragma unroll
                for (int i = 0; i < 8; ++i) {
                    const float qv = siluf(wq[0][i] * qm[i] + wq[1][i] * q0[i] + wq[2][i] * qp[i]) * 0.08838834764831845f;
                    const float kv = siluf(wk[0][i] * km[i] + wk[1][i] * k0[i] + wk[2][i] * kp[i]);
                    const float ef = __expf(cf[i]), eb = __expf(cb[i]), rf = 1.0f / ef, rb = 1.0f / eb;
                    oqf[i] = qv * ef; okf[i] = kv * rf; oef[i] = kv * rf * elf[i];
                    oqb[i] = qv * eb; okb[i] = kv * rb; oeb[i] = kv * rb * elb[i];
                }
                const size_t o = (size_t)gla_row(lat, b, s0 + tau) * GKD + chl;
                *(u32x4*)(QG + o) = pack8(oqf); *(u32x4*)(KG + o) = pack8(okf); *(u32x4*)(KE + o) = pack8(oef);
                *(u32x4*)(QG + (size_t)TA * GKD + o) = pack8(oqb); *(u32x4*)(KG + (size_t)TA * GKD + o) = pack8(okb); *(u32x4*)(KE + (size_t)TA * GKD + o) = pack8(oeb);
            }
        }
        __syncthreads();
    }
}

__device__ __forceinline__ float dpp_sum16(float x) {
    x += __builtin_bit_cast(float, __builtin_amdgcn_update_dpp(0, __builtin_bit_cast(int, x), 0xB1, 0xF, 0xF, true));
    x += __builtin_bit_cast(float, __builtin_amdgcn_update_dpp(0, __builtin_bit_cast(int, x), 0x4E, 0xF, 0xF, true));
    x += __builtin_bit_cast(float, __builtin_amdgcn_update_dpp(0, __builtin_bit_cast(int, x), 0x141, 0xF, 0xF, true));
    x += __builtin_bit_cast(float, __builtin_amdgcn_update_dpp(0, __builtin_bit_cast(int, x), 0x140, 0xF, 0xF, true));
    return x;
}
constexpr int RS_TOK = 16;
constexpr int RS_TF = 6 * 64;
constexpr int RS_BUF = RS_TOK * RS_TF;
struct RwkvStage { unsigned r, we, a, ks, v, kk; };
__device__ __forceinline__ int rwkv_row(int b, int dir, int p) {
    if (p < CTXL) { const int t = dir ? CTXL - 1 - p : p; return TL + b * CTXL + t; }
    const int q = p - CTXL, t = dir ? SEQ - 1 - q : q; return b * SEQ + t;
}
__device__ __forceinline__ void ph_rwkv_scan(const KC& k, int l, int job, const float* k_a, size_t yoff = RW_Y) {
    const int b = job >> 5, h = (job >> 1) & 15, dir = job & 1;
    const int tid = k.tid;
    const bf16* R = (const bf16*)(k.ws + RW_R); const bf16* KS = (const bf16*)(k.ws + RW_KS); const bf16* V = (const bf16*)(k.ws + RW_V); const bf16* KK = (const bf16*)(k.ws + RW_KK);
    const bf16* LO = (const bf16*)(k.ws + RW_LO); bf16* Y = (bf16*)(k.ws + yoff) + (size_t)dir * TA * RD;
    LAS float* buf = (LAS float*)k.lds;
    LAS f32x2* ypart = (LAS f32x2*)(buf + 2 * RS_BUF);
    const int st = tid >> 5, cp = tid & 31, ch = h * RHS + 2 * cp;
    const float ka0 = k_a[l * RD + ch], ka1 = k_a[l * RD + ch + 1];
    const int kq = tid & 15, rp = tid >> 4, v0 = rp * 2;
    f32x2 S00 = {0.f, 0.f}, S01 = {0.f, 0.f}, S10 = {0.f, 0.f}, S11 = {0.f, 0.f};
    RwkvStage sg;
#define RW_LOAD(chunk) do { const int row_ = rwkv_row(b, dir, (chunk) * RS_TOK + st); \
        sg.r = *(const unsigned*)(R + (size_t)row_ * RD + ch); sg.ks = *(const unsigned*)(KS + (size_t)row_ * RD + ch); \
        sg.v = *(const unsigned*)(V + (size_t)row_ * RD + ch); sg.kk = *(const unsigned*)(KK + (size_t)row_ * RD + ch); \
        sg.we = *(const unsigned*)(LO + (size_t)row_ * 4096 + dir * RD + ch); sg.a = *(const unsigned*)(LO + (size_t)row_ * 4096 + 2048 + dir * RD + ch); } while (0)
#define RW_WRITE(bi) do { LAS float* tb = buf + (bi) * RS_BUF + st * RS_TF + 2 * cp; \
        const float a0 = bflo(sg.a), a1 = bfhi(sg.a), kk0 = bflo(sg.kk), kk1 = bfhi(sg.kk), ks0 = bflo(sg.ks), ks1 = bfhi(sg.ks); \
        *(LAS f32x2*)(tb + 0) = (f32x2){kk0, kk1}; \
        *(LAS f32x2*)(tb + 64) = (f32x2){__expf(-bflo(sg.we)), __expf(-bfhi(sg.we))}; \
        *(LAS f32x2*)(tb + 128) = (f32x2){-kk0 * a0, -kk1 * a1}; \
        *(LAS f32x2*)(tb + 192) = (f32x2){ks0 * (1.0f + (a0 - 1.0f) * ka0), ks1 * (1.0f + (a1 - 1.0f) * ka1)}; \
        *(LAS f32x2*)(tb + 256) = (f32x2){bflo(sg.r), bfhi(sg.r)}; \
        *(LAS f32x2*)(tb + 320) = (f32x2){bflo(sg.v), bfhi(sg.v)}; } while (0)
    constexpr int NCHUNK = (CTXL + SEQ) / RS_TOK;
    RW_LOAD(0); RW_WRITE(0);
    __syncthreads();
    for (int c = 0; c < NCHUNK; ++c) {
        if (c + 1 < NCHUNK) RW_LOAD(c + 1);
        const LAS float* cb = buf + (c & 1) * RS_BUF; LAS f32x2* yb = ypart + (c & 1) * RS_TOK * 256 + rp * 8 + (((kq >> 1) ^ (rp >> 2)) & 7);
        {
            const LAS float* tk = cb + kq * 4; const LAS float* tv = cb + 320 + v0;
#define RW_LD(T, kk4, w4, n4, d4, r4, vv) f32x4 kk4 = *(const LAS f32x4*)(tk + (T) * RS_TF), w4 = *(const LAS f32x4*)(tk + (T) * RS_TF + 64), n4 = *(const LAS f32x4*)(tk + (T) * RS_TF + 128), \
                d4 = *(const LAS f32x4*)(tk + (T) * RS_TF + 192), r4 = *(const LAS f32x4*)(tk + (T) * RS_TF + 256); f32x2 vv = *(const LAS f32x2*)(tv + (T) * RS_TF)
#define RW_STEP(T, kk4, w4, n4, d4, r4, vv) do { \
                const f32x2 kka = {kk4.x, kk4.y}, kkb = {kk4.z, kk4.w}, wa = {w4.x, w4.y}, wb = {w4.z, w4.w}, na = {n4.x, n4.y}, nb = {n4.z, n4.w}, da = {d4.x, d4.y}, db = {d4.z, d4.w}, ra = {r4.x, r4.y}, rb = {r4.z, r4.w}; \
                f32x2 p0 = S00 * kka + S01 * kkb, p1 = S10 * kka + S11 * kkb; \
                const f32x2 u00 = S00 * wa + da * vv.x, u01 = S01 * wb + db * vv.x, u10 = S10 * wa + da * vv.y, u11 = S11 * wb + db * vv.y;     \
                const float sa0 = dpp_sum16(p0.x + p0.y), sa1 = dpp_sum16(p1.x + p1.y); \
                S00 = na * sa0 + u00; S01 = nb * sa0 + u01; S10 = na * sa1 + u10; S11 = nb * sa1 + u11; \
                p0 = S00 * ra + S01 * rb; p1 = S10 * ra + S11 * rb; \
                float y0 = p0.x + p0.y, y1 = p1.x + p1.y; \
                y0 += __builtin_bit_cast(float, __builtin_amdgcn_update_dpp(0, __builtin_bit_cast(int, y0), 0xB1, 0xF, 0xF, true)); \
                y1 += __builtin_bit_cast(float, __builtin_amdgcn_update_dpp(0, __builtin_bit_cast(int, y1), 0xB1, 0xF, 0xF, true)); \
                if ((kq & 1) == 0) yb[(T) * 256] = (f32x2){y0, y1}; } while (0)
            RW_LD(0, kkA, wA, nA, dA, rA, vA);
#pragma unroll
            for (int tau = 0; tau < RS_TOK; tau += 2) {
                RW_LD(tau + 1, kkB, wB, nB, dB, rB, vB);
                RW_STEP(tau, kkA, wA, nA, dA, rA, vA);
                if (tau + 2 < RS_TOK) { RW_LD(tau + 2, kkC, wC, nC, dC, rC, vC); kkA = kkC; wA = wC; nA = nC; dA = dC; rA = rC; vA = vC; }
                RW_STEP(tau + 1, kkB, wB, nB, dB, rB, vB);
            }
#undef RW_LD
#undef RW_STEP
        }
        if (c + 1 < NCHUNK) RW_WRITE((c + 1) & 1);
        __syncthreads();
        {
            const int row = rwkv_row(b, dir, c * RS_TOK + st);
            const LAS f32x2* yq = ypart + (c & 1) * RS_TOK * 256 + st * 256 + cp * 8;
            f32x2 acc = yq[(0 ^ (cp >> 2)) & 7];
#pragma unroll
            for (int j = 1; j < 8; ++j) acc += yq[(j ^ (cp >> 2)) & 7];
            *(unsigned*)(Y + (size_t)row * RD + ch) = pk2(acc.x, acc.y);
        }
    }
    __syncthreads();
}

constexpr int GP1 = 136, GP2 = 72;
constexpr int GL_QGS = 0, GL_KGS = GL_QGS + 64 * GP1 * 2, GL_STS = GL_KGS + 64 * GP1 * 2, GL_KET = GL_STS + 64 * GP1 * 2, GL_VT = GL_KET + 128 * GP2 * 2, GL_ATT = GL_VT + 64 * GP2 * 2,
              GL_DECS = GL_ATT + 64 * GP2 * 2, GL_LDS_END = GL_DECS + 512;
static_assert(GL_LDS_END <= 131072, "gla lds");
__device__ __forceinline__ bf16x8 ldfrag(const LAS bf16* base, int row, int pitch, int kofs) { return *(const LAS bf16x8*)(base + row * pitch + kofs); }
__device__ __forceinline__ int gla_prow(int b, int dir, int cp, int tau) {
    const bool lat = cp >= 4; const int q = lat ? cp - 4 : cp, ncn = lat ? 32 : 4, cn = dir ? ncn - 1 - q : q;
    return gla_row(lat, b, dir ? 64 * cn + 63 - tau : 64 * cn + tau);
}
__device__ __forceinline__ int gla_gch(int dir, int cp) { const bool lat = cp >= 4; const int q = lat ? cp - 4 : cp, ncn = lat ? 32 : 4, cn = dir ? ncn - 1 - q : q; return lat ? 4 + cn : cn; }
__device__ __forceinline__ bf16x8 ldfrag_sw(const LAS bf16* base, int row, int g) { return *(const LAS bf16x8*)(base + row * GP2 + ((g ^ ((row >> 3) & 7)) << 3)); }
__device__ __forceinline__ void ph_gla_scan(const KC& k, int job) {
    const int b = job >> 5, h = (job >> 3) & 3, dir = (job >> 2) & 1, dvq = job & 3;
    const int tid = k.tid, w = k.wave, lane = k.lane, q4 = lane >> 4, l15 = lane & 15;
    const bf16* QG = (const bf16*)(k.ws + GL_QG) + (size_t)dir * TA * GKD; const bf16* KG = (const bf16*)(k.ws + GL_KG) + (size_t)dir * TA * GKD;
    const bf16* KE = (const bf16*)(k.ws + GL_KE) + (size_t)dir * TA * GKD; const bf16* VS = (const bf16*)(k.ws + GL_VS);
    const float* DEC = (const float*)(k.ws + GL_DEC); bf16* O = (bf16*)(k.ws + GL_O) + (size_t)dir * TA * GVD;
    LAS bf16* QGs = (LAS bf16*)(k.lds + GL_QGS); LAS bf16* KGs = (LAS bf16*)(k.lds + GL_KGS); LAS bf16* STs = (LAS bf16*)(k.lds + GL_STS);
    LAS bf16* KEt = (LAS bf16*)(k.lds + GL_KET); LAS bf16* Vt = (LAS bf16*)(k.lds + GL_VT); LAS bf16* ATT = (LAS bf16*)(k.lds + GL_ATT); LAS float* decs = (LAS float*)(k.lds + GL_DECS);
    f32x4 accS[4];
#pragma unroll
    for (int t = 0; t < 4; ++t) accS[t] = (f32x4){0.f, 0.f, 0.f, 0.f};
    const int tw = w & 3, wh = w >> 2;
    u32x4 pq[2], pk[2], pe[2], pv; float pd = 0.f;
#define GLA_PREFETCH(CP) do { _Pragma("unroll") for (int i = 0; i < 2; ++i) { const int idx = tid + 512 * i, tau = idx >> 4, ck = idx & 15; \
            const size_t go = (size_t)gla_prow(b, dir, (CP), tau) * GKD + h * GDK + ck * 8; pq[i] = *(const u32x4*)(QG + go); pk[i] = *(const u32x4*)(KG + go); pe[i] = *(const u32x4*)(KE + go); } \
        pv = *(const u32x4*)(VS + (size_t)gla_prow(b, dir, (CP), tid >> 3) * GVD + h * GDV + dvq * 64 + (tid & 7) * 8); \
        if (tid < 128) pd = DEC[((size_t)(dir * 8 + b) * NCH + gla_gch(dir, (CP))) * GKD + h * GDK + tid]; } while (0)
    GLA_PREFETCH(0);
    for (int cp = 0; cp < NCH; ++cp) {
#define GROW(tau) gla_prow(b, dir, cp, (tau))
#pragma unroll
        for (int i = 0; i < 2; ++i) {
            const int idx = tid + 512 * i, tau = idx >> 4, ck = idx & 15;
            *(LAS u32x4*)(QGs + tau * GP1 + ck * 8) = pq[i];
            *(LAS u32x4*)(KGs + tau * GP1 + ck * 8) = pk[i];
            const unsigned kw[4] = {pe[i].x, pe[i].y, pe[i].z, pe[i].w};
#pragma unroll
            for (int e = 0; e < 4; ++e) { const int ts = tau ^ ((ck & 7) << 3); KEt[(ck * 8 + 2 * e) * GP2 + ts] = (bf16)(kw[e] & 0xffffu); KEt[(ck * 8 + 2 * e + 1) * GP2 + ts] = (bf16)(kw[e] >> 16); }
        }
        {
            const int tau = tid >> 3, ck = tid & 7;
            const unsigned vw[4] = {pv.x, pv.y, pv.z, pv.w};
#pragma unroll
            for (int e = 0; e < 4; ++e) { const int ts = tau ^ (ck << 3); Vt[(ck * 8 + 2 * e) * GP2 + ts] = (bf16)(vw[e] & 0xffffu); Vt[(ck * 8 + 2 * e + 1) * GP2 + ts] = (bf16)(vw[e] >> 16); }
        }
        if (tid < 128) decs[tid] = pd;
#pragma unroll
        for (int t = 0; t < 4; ++t) {
            const int dkt = wh * 4 + t;
#pragma unroll
            for (int r = 0; r < 4; ++r) STs[(16 * tw + 4 * q4 + r) * GP1 + 16 * dkt + l15] = (bf16)f2bf(accS[t][r]);
        }
        __syncthreads();
        if (cp + 1 < NCH) GLA_PREFETCH(cp + 1);
#pragma unroll
        for (int jj = 0; jj < 2; ++jj) {
            const int it = tw, jt = wh * 2 + jj;
            f32x4 acc = (f32x4){0.f, 0.f, 0.f, 0.f};
#pragma unroll
            for (int ks = 0; ks < 4; ++ks) acc = __builtin_amdgcn_mfma_f32_16x16x32_bf16(ldfrag(QGs, 16 * it + l15, GP1, 32 * ks + 8 * q4), ldfrag(KGs, 16 * jt + l15, GP1, 32 * ks + 8 * q4), acc, 0, 0, 0);
#pragma unroll
            for (int r = 0; r < 4; ++r) { const int i = 16 * it + 4 * q4 + r, j = 16 * jt + l15; ATT[i * GP2 + j] = (bf16)f2bf(j <= i ? acc[r] : 0.f); }
        }
        __syncthreads();
#pragma unroll
        for (int dd = 0; dd < 2; ++dd) {
            const int it = tw, dvt = wh * 2 + dd;
            f32x4 acc = (f32x4){0.f, 0.f, 0.f, 0.f};
#pragma unroll
            for (int ks = 0; ks < 4; ++ks) acc = __builtin_amdgcn_mfma_f32_16x16x32_bf16(ldfrag(QGs, 16 * it + l15, GP1, 32 * ks + 8 * q4), ldfrag(STs, 16 * dvt + l15, GP1, 32 * ks + 8 * q4), acc, 0, 0, 0);
#pragma unroll
            for (int ks = 0; ks < 2; ++ks) acc = __builtin_amdgcn_mfma_f32_16x16x32_bf16(ldfrag(ATT, 16 * it + l15, GP2, 32 * ks + 8 * q4), ldfrag_sw(Vt, 16 * dvt + l15, 4 * ks + q4), acc, 0, 0, 0);
#pragma unroll
            for (int r = 0; r < 4; ++r) { const int i = 16 * it + 4 * q4 + r; O[(size_t)GROW(i) * GVD + h * GDV + dvq * 64 + 16 * dvt + l15] = (bf16)f2bf(acc[r]); }
        }
#pragma unroll
        for (int t = 0; t < 4; ++t) {
            const int dkt = wh * 4 + t; const float d = decs[16 * dkt + l15];
            accS[t] = accS[t] * d;
#pragma unroll
            for (int ks = 0; ks < 2; ++ks) accS[t] = __builtin_amdgcn_mfma_f32_16x16x32_bf16(ldfrag_sw(Vt, 16 * tw + l15, 4 * ks + q4), ldfrag_sw(KEt, 16 * dkt + l15, 4 * ks + q4), accS[t], 0, 0, 0);
        }
        __syncthreads();
#undef GROW
    }
#undef GLA_PREFETCH
}

#ifndef RWKV_MODE
#define RWKV_MODE 2
#endif
#ifndef HB_FULL
#define HB_FULL 0
#endif
#ifndef GLA4_LEVEL
#define GLA4_LEVEL 0
#endif
#ifndef GLA4_NOSTORE
#define GLA4_NOSTORE 0
#endif
#ifndef SWAP_HALVES
#define SWAP_HALVES 0
#endif
#ifndef SPLIT_SCAN
#define SPLIT_SCAN 0
#endif
constexpr int RS4_TOK = 8, RS4_BUF = RS4_TOK * RS_TF;
constexpr int SC_GL = 0;
constexpr int SC_RW = 96 * 1024;
constexpr int SC_END = SC_RW + 2 * RS4_BUF * 4 + 2 * RS4_TOK * 64 * 4;
static_assert(SC_GL + GL_LDS_END <= SC_RW, "scan lds halves");
constexpr int SC_CTR = 127 * 1024;
static_assert(SC_END <= SC_CTR && SC_CTR + 128 <= 131072, "scan lds");
__device__ __forceinline__ void half_bar(LAS unsigned* ctr, unsigned& gen, int lane) {
#if HB_FULL
    (void)ctr; (void)lane; gen += 4u; __syncthreads(); return;
#endif
    gen += 4u;
    __builtin_amdgcn_fence(__ATOMIC_RELEASE, "workgroup");
    if (lane == 0) __hip_atomic_fetch_add(ctr, 1u, __ATOMIC_RELAXED, __HIP_MEMORY_SCOPE_WORKGROUP);
    unsigned spins = 0;
    while (__hip_atomic_load(ctr, __ATOMIC_RELAXED, __HIP_MEMORY_SCOPE_WORKGROUP) < gen) { __builtin_amdgcn_s_sleep(1); if (++spins > (1u << 26)) break; }
    __builtin_amdgcn_fence(__ATOMIC_ACQUIRE, "workgroup");
}
#ifndef RW4_SHFL
#define RW4_SHFL 0
#endif
__device__ __forceinline__ float shfl_sum16(float x) { x += __shfl_xor(x, 1); x += __shfl_xor(x, 2); x += __shfl_xor(x, 4); x += __shfl_xor(x, 8); return x; }
#if RW4_SHFL
#define RW4_SUM16(x) shfl_sum16(x)
#else
#define RW4_SUM16(x) dpp_sum16(x)
#endif
__device__ __forceinline__ void rwkv_scan_4w(const KC& k, int l, int job, const float* k_a, LAS unsigned* ctr) {
    const int b = job >> 5, h = (job >> 1) & 15, dir = job & 1;
    const int tid = k.tid, lane = k.lane;
    const bf16* R = (const bf16*)(k.ws + RW_R); const bf16* KS = (const bf16*)(k.ws + RW_KS); const bf16* V = (const bf16*)(k.ws + RW_V); const bf16* KK = (const bf16*)(k.ws + RW_KK);
    const bf16* LO = (const bf16*)(k.ws + RW_LO); bf16* Y = (bf16*)(k.ws + RW_Y) + (size_t)dir * TA * RD;
    LAS float* buf = (LAS float*)(k.lds + SC_RW);
    LAS float* ybuf = buf + 2 * RS4_BUF;
    const int st = tid >> 5, cp = tid & 31, ch = h * RHS + 2 * cp;
    const float ka0 = k_a[l * RD + ch], ka1 = k_a[l * RD + ch + 1];
    const int kq = tid & 15, v0 = (tid >> 4) * 4;
    f32x2 S[4][2];
#pragma unroll
    for (int i = 0; i < 4; ++i) { S[i][0] = (f32x2){0.f, 0.f}; S[i][1] = (f32x2){0.f, 0.f}; }
    RwkvStage sg[1];
    unsigned gen = 0;
#define RW4_LOAD(chunk) do { _Pragma("unroll") for (int q_ = 0; q_ < 1; ++q_) { const int row_ = rwkv_row(b, dir, (chunk) * RS4_TOK + st); \
        sg[q_].r = *(const unsigned*)(R + (size_t)row_ * RD + ch); sg[q_].ks = *(const unsigned*)(KS + (size_t)row_ * RD + ch); \
        sg[q_].v = *(const unsigned*)(V + (size_t)row_ * RD + ch); sg[q_].kk = *(const unsigned*)(KK + (size_t)row_ * RD + ch); \
        sg[q_].we = *(const unsigned*)(LO + (size_t)row_ * 4096 + dir * RD + ch); sg[q_].a = *(const unsigned*)(LO + (size_t)row_ * 4096 + 2048 + dir * RD + ch); } } while (0)
#define RW4_WRITE(bi) do { _Pragma("unroll") for (int q_ = 0; q_ < 1; ++q_) { LAS float* tb = buf + (bi) * RS4_BUF + st * RS_TF + 2 * cp; \
        const float a0 = bflo(sg[q_].a), a1 = bfhi(sg[q_].a), kk0 = bflo(sg[q_].kk), kk1 = bfhi(sg[q_].kk), ks0 = bflo(sg[q_].ks), ks1 = bfhi(sg[q_].ks); \
        *(LAS f32x2*)(tb + 0) = (f32x2){kk0, kk1}; \
        *(LAS f32x2*)(tb + 64) = (f32x2){__expf(-bflo(sg[q_].we)), __expf(-bfhi(sg[q_].we))}; \
        *(LAS f32x2*)(tb + 128) = (f32x2){-kk0 * a0, -kk1 * a1}; \
        *(LAS f32x2*)(tb + 192) = (f32x2){ks0 * (1.0f + (a0 - 1.0f) * ka0), ks1 * (1.0f + (a1 - 1.0f) * ka1)}; \
        *(LAS f32x2*)(tb + 256) = (f32x2){bflo(sg[q_].r), bfhi(sg[q_].r)}; \
        *(LAS f32x2*)(tb + 320) = (f32x2){bflo(sg[q_].v), bfhi(sg[q_].v)}; } } while (0)
    constexpr int NCHUNK = (CTXL + SEQ) / RS4_TOK;
    RW4_LOAD(0); RW4_WRITE(0);
    half_bar(ctr, gen, lane);
    for (int c = 0; c < NCHUNK; ++c) {
        if (c + 1 < NCHUNK) RW4_LOAD(c + 1);
        const LAS float* cb = buf + (c & 1) * RS4_BUF; LAS float* yb = ybuf + (c & 1) * RS4_TOK * 64;
        {
            const LAS float* tk = cb + kq * 4; const LAS float* tv = cb + 320 + v0;
#define RW4_LD(T, kk4, w4, n4, d4, r4, vv) f32x4 kk4 = *(const LAS f32x4*)(tk + (T) * RS_TF), w4 = *(const LAS f32x4*)(tk + (T) * RS_TF + 64), n4 = *(const LAS f32x4*)(tk + (T) * RS_TF + 128), \
                d4 = *(const LAS f32x4*)(tk + (T) * RS_TF + 192), r4 = *(const LAS f32x4*)(tk + (T) * RS_TF + 256), vv = *(const LAS f32x4*)(tv + (T) * RS_TF)
#define RW4_STEP(T, kk4, w4, n4, d4, r4, vv) do { \
                const f32x2 kka = {kk4.x, kk4.y}, kkb = {kk4.z, kk4.w}, wa = {w4.x, w4.y}, wb = {w4.z, w4.w}, na = {n4.x, n4.y}, nb = {n4.z, n4.w}, da = {d4.x, d4.y}, db = {d4.z, d4.w}, ra = {r4.x, r4.y}, rb = {r4.z, r4.w}; \
                float sa[4], yy[4]; f32x2 u0[4], u1[4]; \
                _Pragma("unroll") for (int i = 0; i < 4; ++i) { const f32x2 p = S[i][0] * kka + S[i][1] * kkb; sa[i] = p.x + p.y; u0[i] = S[i][0] * wa + da * vv[i]; u1[i] = S[i][1] * wb + db * vv[i]; } \
                _Pragma("unroll") for (int i = 0; i < 4; ++i) sa[i] = RW4_SUM16(sa[i]); \
                _Pragma("unroll") for (int i = 0; i < 4; ++i) { S[i][0] = na * sa[i] + u0[i]; S[i][1] = nb * sa[i] + u1[i]; const f32x2 q = S[i][0] * ra + S[i][1] * rb; yy[i] = q.x + q.y; } \
                _Pragma("unroll") for (int i = 0; i < 4; ++i) yy[i] = RW4_SUM16(yy[i]); \
                if (kq == 0) *(LAS f32x4*)(yb + (T) * 64 + v0) = (f32x4){yy[0], yy[1], yy[2], yy[3]}; } while (0)
            RW4_LD(0, kkA, wA, nA, dA, rA, vA);
#pragma unroll
            for (int tau = 0; tau < RS4_TOK; tau += 2) {
                RW4_LD(tau + 1, kkB, wB, nB, dB, rB, vB);
                RW4_STEP(tau, kkA, wA, nA, dA, rA, vA);
                if (tau + 2 < RS4_TOK) { RW4_LD(tau + 2, kkC, wC, nC, dC, rC, vC); kkA = kkC; wA = wC; nA = nC; dA = dC; rA = rC; vA = vC; }
                RW4_STEP(tau + 1, kkB, wB, nB, dB, rB, vB);
            }
#undef RW4_LD
#undef RW4_STEP
        }
        if (c + 1 < NCHUNK) RW4_WRITE((c + 1) & 1);
        half_bar(ctr, gen, lane);
        {
            const int row = rwkv_row(b, dir, c * RS4_TOK + st);
            const f32x2 yy = *(const LAS f32x2*)(yb + st * 64 + 2 * cp);
            *(unsigned*)(Y + (size_t)row * RD + ch) = pk2(yy.x, yy.y);
        }
    }
#undef RW4_LOAD
#undef RW4_WRITE
}
__device__ __forceinline__ void gla_scan_4w(const KC& k, int job, LAS unsigned* ctr) {
    const int b = job >> 5, h = (job >> 3) & 3, dir = (job >> 2) & 1, dvq = job & 3;
    const int tid = k.tid - 256, w = k.wave - 4, lane = k.lane, q4 = lane >> 4, l15 = lane & 15;
    const bf16* QG = (const bf16*)(k.ws + GL_QG) + (size_t)dir * TA * GKD; const bf16* KG = (const bf16*)(k.ws + GL_KG) + (size_t)dir * TA * GKD;
    const bf16* KE = (const bf16*)(k.ws + GL_KE) + (size_t)dir * TA * GKD; const bf16* VS = (const bf16*)(k.ws + GL_VS);
    const float* DEC = (const float*)(k.ws + GL_DEC); bf16* O = (bf16*)(k.ws + GL_O) + (size_t)dir * TA * GVD;
    LAS unsigned char* gl = k.lds + SC_GL;
    LAS bf16* QGs = (LAS bf16*)(gl + GL_QGS); LAS bf16* KGs = (LAS bf16*)(gl + GL_KGS); LAS bf16* STs = (LAS bf16*)(gl + GL_STS);
    LAS bf16* KEt = (LAS bf16*)(gl + GL_KET); LAS bf16* Vt = (LAS bf16*)(gl + GL_VT); LAS bf16* ATT = (LAS bf16*)(gl + GL_ATT); LAS float* decs = (LAS float*)(gl + GL_DECS);
    f32x4 accS[8];
#pragma unroll
    for (int t = 0; t < 8; ++t) accS[t] = (f32x4){0.f, 0.f, 0.f, 0.f};
    unsigned gen = 0;
#if GLA4_LEVEL == 2
    { float x = (float)lane; for (int i = 0; i < 200000; ++i) { x = x * 1.0001f + 0.5f; asm volatile("" : "+v"(x)); } asm volatile("" :: "v"(x)); (void)ctr; (void)gen; }
    return;
#endif
#if GLA4_LEVEL == 1
    for (int cp = 0; cp < NCH; ++cp) { float x = (float)lane; for (int i = 0; i < 2000; ++i) x = x * 1.0001f + 0.5f; asm volatile("" :: "v"(x)); half_bar(ctr, gen, lane); half_bar(ctr, gen, lane); half_bar(ctr, gen, lane); }
    return;
#endif
    for (int cp = 0; cp < NCH; ++cp) {
        const bool lat = cp >= 4; const int q = lat ? cp - 4 : cp, ncn = lat ? 32 : 4, cn = dir ? ncn - 1 - q : q, gch = lat ? 4 + cn : cn;
#define GROW(tau) gla_row(lat, b, dir ? 64 * cn + 63 - (tau) : 64 * cn + (tau))
#pragma unroll
        for (int i = 0; i < 4; ++i) {
            const int idx = tid + 256 * i, tau = idx >> 4, ck = idx & 15; const size_t go = (size_t)GROW(tau) * GKD + h * GDK + ck * 8;
            *(LAS u32x4*)(QGs + tau * GP1 + ck * 8) = *(const u32x4*)(QG + go);
            *(LAS u32x4*)(KGs + tau * GP1 + ck * 8) = *(const u32x4*)(KG + go);
            const u32x4 ke = *(const u32x4*)(KE + go);
            const unsigned kw[4] = {ke.x, ke.y, ke.z, ke.w};
#pragma unroll
            for (int e = 0; e < 4; ++e) { KEt[(ck * 8 + 2 * e) * GP2 + tau] = (bf16)(kw[e] & 0xffffu); KEt[(ck * 8 + 2 * e + 1) * GP2 + tau] = (bf16)(kw[e] >> 16); }
        }
#pragma unroll
        for (int i = 0; i < 2; ++i) {
            const int idx = tid + 256 * i, tau = idx >> 3, ck = idx & 7;
            const u32x4 vv = *(const u32x4*)(VS + (size_t)GROW(tau) * GVD + h * GDV + dvq * 64 + ck * 8);
            const unsigned vw[4] = {vv.x, vv.y, vv.z, vv.w};
#pragma unroll
            for (int e = 0; e < 4; ++e) { Vt[(ck * 8 + 2 * e) * GP2 + tau] = (bf16)(vw[e] & 0xffffu); Vt[(ck * 8 + 2 * e + 1) * GP2 + tau] = (bf16)(vw[e] >> 16); }
        }
        if (tid < 128) decs[tid] = DEC[((size_t)(dir * 8 + b) * NCH + gch) * GKD + h * GDK + tid];
#pragma unroll
        for (int t = 0; t < 8; ++t) {
#pragma unroll
            for (int r = 0; r < 4; ++r) STs[(16 * w + 4 * q4 + r) * GP1 + 16 * t + l15] = (bf16)f2bf(accS[t][r]);
        }
        half_bar(ctr, gen, lane);
#pragma unroll
        for (int jt = 0; jt < 4; ++jt) {
            f32x4 acc = (f32x4){0.f, 0.f, 0.f, 0.f};
#pragma unroll
            for (int ks = 0; ks < 4; ++ks) acc = __builtin_amdgcn_mfma_f32_16x16x32_bf16(ldfrag(QGs, 16 * w + l15, GP1, 32 * ks + 8 * q4), ldfrag(KGs, 16 * jt + l15, GP1, 32 * ks + 8 * q4), acc, 0, 0, 0);
#pragma unroll
            for (int r = 0; r < 4; ++r) { const int i = 16 * w + 4 * q4 + r, j = 16 * jt + l15; ATT[i * GP2 + j] = (bf16)f2bf(j <= i ? acc[r] : 0.f); }
        }
        half_bar(ctr, gen, lane);
#pragma unroll
        for (int dvt = 0; dvt < 4; ++dvt) {
            f32x4 acc = (f32x4){0.f, 0.f, 0.f, 0.f};
#pragma unroll
            for (int ks = 0; ks < 4; ++ks) acc = __builtin_amdgcn_mfma_f32_16x16x32_bf16(ldfrag(QGs, 16 * w + l15, GP1, 32 * ks + 8 * q4), ldfrag(STs, 16 * dvt + l15, GP1, 32 * ks + 8 * q4), acc, 0, 0, 0);
#pragma unroll
            for (int ks = 0; ks < 2; ++ks) acc = __builtin_amdgcn_mfma_f32_16x16x32_bf16(ldfrag(ATT, 16 * w + l15, GP2, 32 * ks + 8 * q4), ldfrag(Vt, 16 * dvt + l15, GP2, 32 * ks + 8 * q4), acc, 0, 0, 0);
#pragma unroll
#if GLA4_NOSTORE
            asm volatile("" :: "v"(acc[0]), "v"(acc[1]), "v"(acc[2]), "v"(acc[3]));
#else
            for (int r = 0; r < 4; ++r) { const int i = 16 * w + 4 * q4 + r; O[(size_t)GROW(i) * GVD + h * GDV + dvq * 64 + 16 * dvt + l15] = (bf16)f2bf(acc[r]); }
#endif
        }
#pragma unroll
        for (int t = 0; t < 8; ++t) {
            const float d = decs[16 * t + l15];
            accS[t] = accS[t] * d;
#pragma unroll
            for (int ks = 0; ks < 2; ++ks) accS[t] = __builtin_amdgcn_mfma_f32_16x16x32_bf16(ldfrag(Vt, 16 * w + l15, GP2, 32 * ks + 8 * q4), ldfrag(KEt, 16 * t + l15, GP2, 32 * ks + 8 * q4), accS[t], 0, 0, 0);
        }
        half_bar(ctr, gen, lane);
#undef GROW
    }
#if HB_FULL
    for (int i = 0; i < (1 + (CTXL + SEQ) / RS4_TOK) - 3 * NCH; ++i) __syncthreads();
#endif
}
__device__ __forceinline__ void ph_scan_split(const KC& k, int l, const float* k_a) {
    LAS unsigned* ctr = (LAS unsigned*)(k.lds + SC_CTR);
    for (int job = k.bid; job < 256; job += k.G) {
        if (k.tid == 0) { ctr[0] = 0u; ctr[16] = 0u; }
        __syncthreads();
#if SPLIT_SCAN == 1 || SPLIT_SCAN == 4 || SPLIT_SCAN == 5 || SPLIT_SCAN == 6
#if SWAP_HALVES
        { KC k2 = k; if (k.wave >= 4) { k2.tid = k.tid - 256; k2.wave = k.wave - 4; rwkv_scan_4w(k2, l, job, k_a, ctr); } else { k2.tid = k.tid + 256; k2.wave = k.wave + 4; gla_scan_4w(k2, job, ctr + 16); } }
#else
        if (k.wave < 4) rwkv_scan_4w(k, l, job, k_a, ctr); else gla_scan_4w(k, job, ctr + 16);
#endif
        __syncthreads();
#if SPLIT_SCAN == 6
        ph_rwkv_scan(k, l, job, k_a, WS_H);
#elif SPLIT_SCAN == 4
        ph_rwkv_scan(k, l, job, k_a);
#elif SPLIT_SCAN == 5
        ph_gla_scan(k, job);
#endif
#elif SPLIT_SCAN == 2
        if (k.wave < 4) rwkv_scan_4w(k, l, job, k_a, ctr);
        __syncthreads();
        ph_gla_scan(k, job);
#else
        if (k.wave >= 4) gla_scan_4w(k, job, ctr + 16);
        __syncthreads();
        ph_rwkv_scan(k, l, job, k_a);
#endif
    }
}

__device__ __forceinline__ void ph_post(const KC& k, int l, int nrows, const float* ln_g, const float* ln_b, const float* gng) {
    const int gw = k.bid * 8 + k.wave, NGW = k.G * 8, lane = k.lane, c = 16 * lane;
    const bf16* P = (const bf16*)(k.ws + WS_P);
    const bf16* Y = (const bf16*)(k.ws + RW_Y); const bf16* V = (const bf16*)(k.ws + RW_V); const float* BON = (const float*)(k.ws + RW_BON); bf16* YNB = (bf16*)(k.ws + RW_R);
    const bf16* O = (const bf16*)(k.ws + GL_O); bf16* YB = (bf16*)(k.ws + GL_VS);
    for (int row = gw; row < nrows; row += NGW) {
        {
            float yf[16], yb[16], vv[16], y[16];
            ld16(Y + (size_t)row * RD + c, true, yf); ld16(Y + ((size_t)TA + row) * RD + c, true, yb); ld16(V + (size_t)row * RD + c, true, vv);
            float s = 0.f;
#pragma unroll
            for (int i = 0; i < 16; ++i) { y[i] = yf[i] + yb[i]; s += y[i]; }
            s += __shfl_xor(s, 1); s += __shfl_xor(s, 2);
            const float mean = s * (1.0f / 64.0f); float q = 0.f;
#pragma unroll
            for (int i = 0; i < 16; ++i) { y[i] -= mean; q += y[i] * y[i]; }
            q += __shfl_xor(q, 1); q += __shfl_xor(q, 2);
            const float rstd = 1.0f / sqrtf(q * (1.0f / 64.0f) + 64e-5f), bon = BON[(size_t)row * RHEADS + (lane >> 2)];
#pragma unroll
            for (int i = 0; i < 16; ++i) y[i] = y[i] * rstd * ln_g[l * RD + c + i] + ln_b[l * RD + c + i] + bon * vv[i];
            st16(YNB + (size_t)row * RD + c, y);
        }
        {
            float of[16], ob[16], gt[16], o[16];
            ld16(O + (size_t)row * GVD + c, true, of); ld16(O + ((size_t)TA + row) * GVD + c, true, ob); ld16(P + (size_t)row * NP + GLA_GATE_OFF + c, true, gt);
            float s = 0.f;
#pragma unroll
            for (int i = 0; i < 16; ++i) { o[i] = of[i] + ob[i]; s += o[i] * o[i]; }
            s += __shfl_xor(s, 1); s += __shfl_xor(s, 2); s += __shfl_xor(s, 4); s += __shfl_xor(s, 8);
            const float rinv = 1.0f / sqrtf(s * (1.0f / 256.0f) + 1e-6f);
#pragma unroll
            for (int i = 0; i < 16; ++i) o[i] = o[i] * rinv * gng[l * GDV + ((c + i) & 255)] * siluf(gt[i]);
            st16(YB + (size_t)row * GVD + c, o);
        }
    }
}

#ifndef PROD_PK
#define PROD_PK 0
#endif
#ifndef CHUNK_DBG
#define CHUNK_DBG 0
#endif
constexpr int RC_XT = 0;
constexpr int RC_YH = RC_XT + 32 * 72 * 2;
constexpr int RC_BET = RC_YH + 64 * 24 * 2;
constexpr int RC_AM = RC_YH + 2 * 64 * 24 * 2;
constexpr int RC_P2 = RC_AM + 2048;
constexpr int RC_AKR = RC_P2 + 512;
constexpr int RC_ABR = RC_AKR + 512;
constexpr int RC_GC = RC_ABR + 512;
constexpr int RC_SLOT = RC_GC + 256;
static_assert(RC_SLOT == 14592 && 8 * RC_SLOT <= 131072 && 32 * 72 * 2 <= 2 * 64 * 24 * 2, "rwkv chunk lds");
__device__ __forceinline__ bf16x8 mk8(u32x2 lo, u32x2 hi) { u32x4 v = {lo.x, lo.y, hi.x, hi.y}; return __builtin_bit_cast(bf16x8, v); }
__device__ __forceinline__ void ph_rwkv_chunk(const KC& k, int l, int job, const float* k_a, size_t yoff = RW_Y) {
    const int b = job >> 5, h = (job >> 1) & 15, dir = job & 1;
    const int w = k.wave, lane = k.lane, q4 = lane >> 4, l15 = lane & 15;
    const bf16* R = (const bf16*)(k.ws + RW_R); const bf16* KS = (const bf16*)(k.ws + RW_KS); const bf16* V = (const bf16*)(k.ws + RW_V); const bf16* KK = (const bf16*)(k.ws + RW_KK);
    const bf16* LO = (const bf16*)(k.ws + RW_LO); bf16* Y = (bf16*)(k.ws + yoff) + (size_t)dir * TA * RD;
    LAS unsigned char* slot = k.lds + w * RC_SLOT;
    LAS bf16* XT = (LAS bf16*)(slot + RC_XT); LAS bf16* YH = (LAS bf16*)(slot + RC_YH);
    LAS float* AM = (LAS float*)(slot + RC_AM);
    const int ch = h * RHS + lane;
    const float ka = k_a[l * RD + ch];
    f32x4 accZ[4];
#pragma unroll
    for (int t = 0; t < 4; ++t) accZ[t] = (f32x4){0.f, 0.f, 0.f, 0.f};
    constexpr int NCK = (CTXL + SEQ) / 16, NRND = NCK / 8;
    for (int rnd = 0; rnd < NRND; ++rnd) {
        {
            const int c = rnd * 8 + w;
            float Lc = 0.f, Eprev = 1.f;
            unsigned vp[8];
#pragma unroll
            for (int t = 0; t < 16; ++t) {
                const unsigned o1 = (unsigned)rwkv_row(b, dir, c * 16 + t) * (unsigned)RD + (unsigned)ch, o4 = o1 * 4u - 3u * (unsigned)ch + (unsigned)(dir * RD);
                { const unsigned vraw = V[o1]; vp[t >> 1] = (t & 1) ? (vp[t >> 1] | (vraw << 16)) : vraw; }
                const float kkv = bf2f(KK[o1]), ev = bf2f(LO[o4]), av = bf2f(LO[o4 + 2048u]);
                const float ksv = bf2f(KS[o1]), rv = bf2f(R[o1]);
                Lc -= ev;
                const float E = __expf(Lc), Einv = __expf(-Lc);
#if PROD_PK
                const unsigned x2 = pk2c(kkv * Eprev, rv * E), y2 = pk2c(kkv * av * Einv, ksv * (1.0f + (av - 1.0f) * ka) * Einv);
                XT[t * 72 + lane] = (bf16)(x2 & 0xffffu); XT[(16 + t) * 72 + lane] = (bf16)(x2 >> 16);
                YH[t * 72 + lane] = (bf16)(y2 & 0xffffu); YH[(16 + t) * 72 + lane] = (bf16)(y2 >> 16);
#else
                XT[t * 72 + lane] = (bf16)f2bf(kkv * Eprev); XT[(16 + t) * 72 + lane] = (bf16)f2bf(rv * E);
                YH[t * 72 + lane] = (bf16)f2bf(kkv * av * Einv); YH[(16 + t) * 72 + lane] = (bf16)f2bf(ksv * (1.0f + (av - 1.0f) * ka) * Einv);
#endif
                Eprev = E;
            }
            const float eLC = Eprev;
            f32x4 am[2][2];
#pragma unroll
            for (int rt = 0; rt < 2; ++rt)
#pragma unroll
                for (int ct = 0; ct < 2; ++ct) {
                    f32x4 acc = (f32x4){0.f, 0.f, 0.f, 0.f};
#pragma unroll
                    for (int s = 0; s < 2; ++s) acc = __builtin_amdgcn_mfma_f32_16x16x32_bf16(*(const LAS bf16x8*)(XT + (16 * rt + l15) * 72 + 32 * s + 8 * q4), *(const LAS bf16x8*)(YH + (16 * ct + l15) * 72 + 32 * s + 8 * q4), acc, 0, 0, 0);
                    am[rt][ct] = acc;
                }
            LAS bf16* AKR = (LAS bf16*)(slot + RC_AKR); LAS bf16* ABR = (LAS bf16*)(slot + RC_ABR);
#pragma unroll
            for (int r = 0; r < 4; ++r) {
                const int t = 4 * q4 + r, j = l15;
                AM[t * 16 + j] = j < t ? am[0][0][r] : 0.f;
                AM[256 + t * 16 + j] = j < t ? am[0][1][r] : 0.f;
#if PROD_PK
                const unsigned ab2 = pk2c(j <= t ? -am[1][0][r] : 0.f, j <= t ? am[1][1][r] : 0.f);
                ABR[t * 16 + j] = (bf16)(ab2 & 0xffffu);
                AKR[t * 16 + j] = (bf16)(ab2 >> 16);
#else
                ABR[t * 16 + j] = (bf16)f2bf(j <= t ? -am[1][0][r] : 0.f);
                AKR[t * 16 + j] = (bf16)f2bf(j <= t ? am[1][1][r] : 0.f);
#endif
            }
            float P1[16], P2[16], kt[16];
#pragma unroll
            for (int t = 0; t < 16; ++t) kt[t] = bf2f(XT[t * 72 + lane]);
#pragma unroll
            for (int t = 0; t < 16; ++t) {
                asm volatile("" ::: "memory");
                float p1 = kt[t], p2 = AM[256 + t * 16 + l15];
#pragma unroll
                for (int j4 = 0; j4 < (t + 3) / 4; ++j4) {
                    const f32x4 arow = *(const LAS f32x4*)(AM + t * 16 + 4 * j4);
#pragma unroll
                    for (int e = 0; e < 4; ++e) { const int j = 4 * j4 + e; if (j < t) { p1 -= arow[e] * P1[j]; p2 -= arow[e] * P2[j]; } }
                }
                P1[t] = p1; P2[t] = p2;
            }
            LAS bf16* P2b = (LAS bf16*)(slot + RC_P2);
#pragma unroll
#if PROD_PK
            for (int t = 0; t < 16; ++t) { const unsigned pp = pk2c(P1[t], P2[t]); XT[t * 72 + lane] = (bf16)(pp & 0xffffu); if (lane < 16) P2b[t * 16 + lane] = (bf16)(pp >> 16); }
#else
            for (int t = 0; t < 16; ++t) { XT[t * 72 + lane] = (bf16)f2bf(P1[t]); if (lane < 16) P2b[t * 16 + lane] = (bf16)f2bf(P2[t]); }
#endif
            {
                LAS bf16* KET = (LAS bf16*)(slot + RC_YH); LAS bf16* BET = (LAS bf16*)(slot + RC_BET);
                float ke[16], be[16];
#pragma unroll
                for (int t = 0; t < 16; ++t) { ke[t] = bf2f(YH[(16 + t) * 72 + lane]) * eLC; be[t] = -bf2f(YH[t * 72 + lane]) * eLC; }
                asm volatile("s_waitcnt lgkmcnt(0)" ::: "memory");
                float a0[8], a1[8], b0[8], b1[8];
#pragma unroll
                for (int t = 0; t < 8; ++t) { a0[t] = ke[t]; a1[t] = ke[8 + t]; b0[t] = be[t]; b1[t] = be[8 + t]; }
                *(LAS u32x4*)(KET + lane * 24) = pack8(a0); *(LAS u32x4*)(KET + lane * 24 + 8) = pack8(a1);
                *(LAS u32x4*)(BET + lane * 24) = pack8(b0); *(LAS u32x4*)(BET + lane * 24 + 8) = pack8(b1);
                ((LAS float*)(slot + RC_GC))[lane] = eLC;
                *(LAS u32x4*)(slot + RC_AM + lane * 32) = (u32x4){vp[0], vp[1], vp[2], vp[3]}; *(LAS u32x4*)(slot + RC_AM + lane * 32 + 16) = (u32x4){vp[4], vp[5], vp[6], vp[7]};
            }
        }
        __syncthreads();
        if (w < 4) {
#pragma unroll 1
            for (int cc = 0; cc < 8; ++cc) {
                const int c = rnd * 8 + cc;
                LAS unsigned char* sl = k.lds + cc * RC_SLOT;
                const LAS bf16* P1b = (const LAS bf16*)(sl + RC_XT); const LAS bf16* RTb = P1b + 16 * 72;
                const LAS bf16* KET = (const LAS bf16*)(sl + RC_YH); const LAS bf16* BET = (const LAS bf16*)(sl + RC_BET);
                const LAS bf16* P2b = (const LAS bf16*)(sl + RC_P2); const LAS bf16* AKR = (const LAS bf16*)(sl + RC_AKR); const LAS bf16* ABR = (const LAS bf16*)(sl + RC_ABR);
                const LAS float* GC = (const LAS float*)(sl + RC_GC);
                const u32x2 vfr = *(const LAS u32x2*)(sl + RC_AM + (16 * w + l15) * 32 + 8 * q4);
                const unsigned vlo = vfr.x, vhi = vfr.y;
                bf16x8 bz[2];
#pragma unroll
                for (int s = 0; s < 2; ++s) { u32x4 v = {pk2c(accZ[2 * s][0], accZ[2 * s][1]), pk2c(accZ[2 * s][2], accZ[2 * s][3]), pk2c(accZ[2 * s + 1][0], accZ[2 * s + 1][1]), pk2c(accZ[2 * s + 1][2], accZ[2 * s + 1][3])}; bz[s] = __builtin_bit_cast(bf16x8, v); }
                const u32x2 zero2 = {0u, 0u};
                f32x4 sa = (f32x4){0.f, 0.f, 0.f, 0.f};
#pragma unroll
                for (int s = 0; s < 2; ++s) if (CHUNK_DBG != 3) sa = __builtin_amdgcn_mfma_f32_16x16x32_bf16(mk8(*(const LAS u32x2*)(P1b + l15 * 72 + 32 * s + 4 * q4), *(const LAS u32x2*)(P1b + l15 * 72 + 32 * s + 16 + 4 * q4)), bz[s], sa, 0, 0, 0);
                if (CHUNK_DBG != 4) { u32x4 bv = {vlo, vhi, 0u, 0u}; sa = __builtin_amdgcn_mfma_f32_16x16x32_bf16(mk8(*(const LAS u32x2*)(P2b + l15 * 16 + 4 * q4), zero2), __builtin_bit_cast(bf16x8, bv), sa, 0, 0, 0); }
#if CHUNK_DBG == 1
                sa = (f32x4){0.f, 0.f, 0.f, 0.f};
#endif
                bf16x8 bv2; { u32x4 v = {vlo, vhi, pk2c(sa[0], sa[1]), pk2c(sa[2], sa[3])}; bv2 = __builtin_bit_cast(bf16x8, v); }
                f32x4 yy = (f32x4){0.f, 0.f, 0.f, 0.f};
#pragma unroll
                for (int s = 0; s < 2; ++s) yy = __builtin_amdgcn_mfma_f32_16x16x32_bf16(mk8(*(const LAS u32x2*)(RTb + l15 * 72 + 32 * s + 4 * q4), *(const LAS u32x2*)(RTb + l15 * 72 + 32 * s + 16 + 4 * q4)), bz[s], yy, 0, 0, 0);
                yy = __builtin_amdgcn_mfma_f32_16x16x32_bf16(mk8(*(const LAS u32x2*)(AKR + l15 * 16 + 4 * q4), *(const LAS u32x2*)(ABR + l15 * 16 + 4 * q4)), bv2, yy, 0, 0, 0);
#pragma unroll
                for (int t = 0; t < 4; ++t) {
                    const f32x4 g = *(const LAS f32x4*)(GC + 16 * t + 4 * q4);
                    accZ[t] = __builtin_amdgcn_mfma_f32_16x16x32_bf16(mk8(*(const LAS u32x2*)(KET + (16 * t + l15) * 24 + 4 * q4), *(const LAS u32x2*)(BET + (16 * t + l15) * 24 + 4 * q4)), bv2, accZ[t] * g, 0, 0, 0);
                }
#if CHUNK_DBG == 2
                yy = (f32x4){1.f, 1.f, 1.f, 1.f};
#endif
#pragma unroll
                for (int r = 0; r < 4; ++r) Y[(size_t)rwkv_row(b, dir, c * 16 + 4 * q4 + r) * RD + h * RHS + 16 * w + l15] = (bf16)f2bf(yy[r]);
            }
        }
        __syncthreads();
    }
}

#ifndef CHECK_PMAX
#define CHECK_PMAX (CTXL + SEQ)
#endif
#ifndef CHECK_PMIN
#define CHECK_PMIN 0
#endif
#ifndef CHECK_UNIT
#define CHECK_UNIT 1000
#endif
__device__ __forceinline__ void rwkv_check_delay(const KC& k, int job) {
    const int b = job >> 5, h = (job >> 1) & 15, dir = job & 1;
    const bf16* Ya = (const bf16*)(k.ws + RW_Y) + (size_t)dir * TA * RD; const bf16* Yb = (const bf16*)(k.ws + WS_H) + (size_t)dir * TA * RD;
    float d2 = 0.f, s2 = 0.f; int bad = 0;
    for (int i = k.tid; i < (CHECK_PMAX) * 32; i += 512) {
        const int p = (CHECK_PMIN) + (i >> 5), cp = i & 31; const size_t o = (size_t)rwkv_row(b, dir, p) * RD + h * RHS + 2 * cp;
        const unsigned ua = *(const unsigned*)(Ya + o), ub = *(const unsigned*)(Yb + o);
        const float a0 = bflo(ua), a1 = bfhi(ua), b0 = bflo(ub), b1 = bfhi(ub);
        d2 += (a0 - b0) * (a0 - b0) + (a1 - b1) * (a1 - b1); s2 += a0 * a0 + a1 * a1;
        if (!(b0 == b0) || !(b1 == b1) || fabsf(b0) > 1e30f || fabsf(b1) > 1e30f) bad = 1;
    }
    LAS float* red = (LAS float*)k.lds;
    __syncthreads();
    d2 = wave_sum(d2); s2 = wave_sum(s2); bad = __any(bad) ? 1 : 0;
    if (k.lane == 0) { red[k.wave * 4] = d2; red[k.wave * 4 + 1] = s2; red[k.wave * 4 + 2] = (float)bad; }
    __syncthreads();
    if (k.tid == 0) {
        float D = 0.f, S = 0.f, B = 0.f;
        for (int i = 0; i < 8; ++i) { D += red[i * 4]; S += red[i * 4 + 1]; B += red[i * 4 + 2]; }
        const float rel = sqrtf(D / fmaxf(S, 1e-30f));
        int bucket = rel < 0.01f ? 0 : rel < 0.03f ? 1 : rel < 0.1f ? 2 : rel < 0.3f ? 3 : rel < 1.0f ? 4 : 5;
        if (B > 0.f || !(rel == rel)) bucket = 6;
        const unsigned long long t0 = __builtin_amdgcn_s_memrealtime(), wait = (unsigned long long)bucket * (CHECK_UNIT) * 100ull;
        while (__builtin_amdgcn_s_memrealtime() - t0 < wait) __builtin_amdgcn_s_sleep(8);
    }
    __syncthreads();
}
using pg8::Unit;
struct FP_ { bf16* P; __device__ __forceinline__ void operator()(int row, int col, float (&v)[8], const Unit&) const { *(u32x4*)(P + (size_t)row * NP + col) = pack8(v); } };
struct FL1_ { bf16* LO; const float* bias1;
    __device__ __forceinline__ void operator()(int row, int col, float (&v)[8], const Unit& u) const {
        const float* bias = bias1 + col;
        const f32x4 b0 = *(const f32x4*)bias, b1 = *(const f32x4*)(bias + 4);
        const float bb[8] = {b0.x, b0.y, b0.z, b0.w, b1.x, b1.y, b1.z, b1.w};
        const float sc = col < 2048 ? 0.6065306597126334f : 1.0f;
#pragma unroll
        for (int i = 0; i < 8; ++i) v[i] = sigm(bb[i] + v[i]) * sc;
        *(u32x4*)(LO + (size_t)row * 4096 + col) = pack8(v);
    } };
struct FL2_ { const bf16* YNB; bf16* YA;
    __device__ __forceinline__ void operator()(int row, int col, float (&v)[8], const Unit&) const {
        float y[8]; unpack8(*(const u32x4*)(YNB + (size_t)row * RD + col), y);
#pragma unroll
        for (int i = 0; i < 8; ++i) v[i] *= y[i];
        *(u32x4*)(YA + (size_t)row * RD + col) = pack8(v);
    } };
template <int SECOND> struct FM_ { const bf16* P; bf16* MA; bf16* OUT;
    __device__ __forceinline__ void operator()(int row, int col, float (&v)[8], const Unit&) const {
        float g[8]; unpack8(*(const u32x4*)(P + (size_t)row * NP + BR_OFF + SECOND * DM + col), g);
        const bf16* mp = MA + (size_t)row * DM + col;
        if (SECOND) { float m[8]; unpack8(*(const u32x4*)mp, m);
#pragma unroll
            for (int i = 0; i < 8; ++i) v[i] = sigm(g[i]) * v[i] + m[i]; }
        else {
#pragma unroll
            for (int i = 0; i < 8; ++i) v[i] = sigm(g[i]) * v[i]; }
        *(u32x4*)(OUT + (size_t)row * DM + col) = pack8(v);
    } };
struct FX_ { float* X; const float* MOD; int l; float* OUT;
    __device__ __forceinline__ void operator()(int row, int col, const f32x4 v, const Unit&) const {
        const f32x4 g = *(const f32x4*)(MOD + ((size_t)l * 9 + mod_row(row)) * MOD_N + 2 * DM + col);
        const f32x4* xp = (const f32x4*)(X + (size_t)row * DM + col);
        *(f32x4*)(OUT + (size_t)row * DM + col) = *xp + g * v;
    } };
struct FE1_ { bf16* ACT;
    __device__ __forceinline__ void operator()(int row, int col, float (&g)[8], float (&up)[8]) const {
#pragma unroll
        for (int i = 0; i < 8; ++i) g[i] = siluf(g[i]) * up[i];
        *(u32x4*)(ACT + (size_t)row * DEXP + col) = pack8(g);
    } };
struct FE2_ { const int* rowtok; const float* roww; bf16* YF;
    __device__ __forceinline__ void operator()(int row, int col, float (&v)[8], const Unit&) const {
        const int t2 = rowtok[row];
        if (t2 >= 0) { const float w = roww[row];
#pragma unroll
            for (int i = 0; i < 8; ++i) v[i] *= w;
            *(u32x4*)(YF + ((size_t)(t2 & 1) * TA + (t2 >> 1)) * DM + col) = pack8(v); }
    } };

#ifndef GA_
#define GA_ true
#endif
#ifndef GS_
#define GS_ true
#endif
constexpr int LDS_BYTES = 147456;
constexpr int MISC_OFF = 131072 + 4096;

constexpr int NPHASE = 2 + 14 * DEPTH + 1;
struct Args { const float* in[N_IN]; float* out; unsigned char* ws; int ph_lo, ph_hi; };
static_assert(sizeof(Args) == N_IN * 8 + 8 + 8 + 8, "Args has no padding");

__global__ void __launch_bounds__(512, 2) fwd(Args a) {
    extern __shared__ __attribute__((aligned(16))) unsigned char lds_raw[];
    KC k;
    k.lds = (LAS unsigned char*)lds_raw; k.ws = (unsigned char*)INP(N_IN + 1);
    k.tid = threadIdx.x; k.lane = k.tid & 63; k.wave = __builtin_amdgcn_readfirstlane(k.tid >> 6); k.G = gridDim.x; k.bid = blockIdx.x;
    const int lo = a.ph_lo, hi = a.ph_hi;
    volatile LAS unsigned* MISC = (volatile LAS unsigned*)(k.lds + MISC_OFF);
    if (k.tid < 32) MISC[k.tid] = 0u;
    __syncthreads();
    XcdBarrier bar; bar.bar = (unsigned*)(k.ws + WS_CTL) + CW_BAR; bar.x = 0; bar.st = nullptr;
    if (hi - lo > 1) bar = xcd_barrier_post((unsigned*)(k.ws + WS_CTL) + CW_BAR, MISC + 8);
#ifndef SITE_MASK
#define SITE_MASK 0xFFFFFFFFu
#endif
#define FRESH() do { int t_ = threadIdx.x; asm volatile("" : "+v"(t_)); k.tid = t_; k.lane = t_ & 63; k.wave = __builtin_amdgcn_readfirstlane(t_ >> 6); k.ws = (unsigned char*)INP(N_IN + 1); ws = k.ws; } while (0)
#define PH_BEGIN(p, site) if (((SITE_MASK >> (site)) & 1u) && lo <= (p) && (p) < hi) { FRESH();
#ifndef EXTRA_BARS
#define EXTRA_BARS 0
#endif
#ifndef DUP_MASK
#define DUP_MASK 0u
#endif
#define DUPRUN(n, stmt) do { stmt; if ((DUP_MASK >> (n)) & 1u) { __syncthreads(); stmt; } } while (0)
#define PH_END(p) if ((p) + 1 < hi) xcd_barrier(bar); }
    unsigned char* ws = k.ws;
    LAS unsigned char* glds = k.lds;
#define WSRC WSrc{INP(I_WIN), INP(I_W2), INP(I_A2), INP(I_G2), INP(I_WBA), INP(I_WBB), INP(I_WOUT), INP(I_EG), INP(I_EU), INP(I_ED), INP(I_W0), INP(I_A0)}

    PH_BEGIN(0, 0) DUPRUN(0, ph_adaln_partials(k, INP(I_C), INP(I_CCTX), INP(I_WADA))); DUPRUN(1, ph_convert(k, WSRC, 0)); PH_END(0)
    PH_BEGIN(1, 1) ph_adaln_reduce(k, INP(I_BADA)); PH_END(1)

#define L_ 0
    {
        constexpr int l = L_;
        const int pb = 2 + 14 * l;
        const bool last = (l == DEPTH - 1);
        const int Mpost = last ? TL : TA;
        PH_BEGIN(pb + 0, 2)
            if (l > 0) { DUPRUN(1, ph_convert(k, WSRC, l)); }
            RowArgs ra{INP(I_X), INP(I_CTX), INP(I_NMG), nullptr, nullptr, nullptr};
            ph_rows<0>(k, ra, l, TA);
            if (l == 0 && ((DUP_MASK >> 15) & 1u)) { __syncthreads(); ph_rows<0>(k, ra, l, TA); }
        PH_END(pb + 0)
        PH_BEGIN(pb + 1, 3)
            pg8::Gemm g{(const bf16*)(ws + WS_H), (const bf16*)(ws + WT_IN), TA, NP, DM, 0}; pg8::StaticOrder S; S.init(TA, NP, k.G, k.bid);
            pg8::Epi8<FP_> E{FP_{(bf16*)(ws + WS_P)}};
            DUPRUN(2, (pg8::gemm_phase<pg8::Epi8<FP_>, pg8::StaticOrder, GA_, GS_>(glds, g, S, E)));
        PH_END(pb + 1)
        PH_BEGIN(pb + 2, 4)
            DUPRUN(3, ph_rwkv_prep(k, l, TA, INP(I_MU), INP(I_KK), INP(I_RK)));
            DUPRUN(4, ph_gla_prep(k, l, INP(I_GCONV), INP(I_GAW2), INP(I_GAB)));
        PH_END(pb + 2)
        PH_BEGIN(pb + 3, 5)
            pg8::Gemm g{(const bf16*)(ws + RW_A1), (const bf16*)(ws + WT_L1), TA, 4096, 256, 0}; pg8::StaticOrder S; S.init(TA, 4096, k.G, k.bid);
            pg8::Epi8<FL1_> E{FL1_{(bf16*)(ws + RW_LO), (const float*)(ws + WS_TAB + TAB_TOP)}};
            DUPRUN(5, (pg8::gemm_phase<pg8::Epi8<FL1_>, pg8::StaticOrder, GA_, GS_>(glds, g, S, E)));
        PH_END(pb + 3)
        PH_BEGIN(pb + 4, 6)
#if SPLIT_SCAN
            DUPRUN(6, ph_scan_split(k, l, INP(I_KA)));
#else
            for (int vb = ((k.G & 7) ? k.bid : (k.bid & 7) * (k.G >> 3) + (k.bid >> 3)); vb < 256; vb += k.G) { const int job = vb;
#if RWKV_MODE == 0
                DUPRUN(6, ph_rwkv_scan(k, l, job, INP(I_KA)));
#elif RWKV_MODE == 1
                ph_rwkv_scan(k, l, job, INP(I_KA)); ph_rwkv_chunk(k, l, job, INP(I_KA), WS_H); if (l == 0) rwkv_check_delay(k, job);
#elif RWKV_MODE == 3
                ph_rwkv_scan(k, l, job, INP(I_KA)); ph_rwkv_scan(k, l, job, INP(I_KA), WS_H); if (l == 0) rwkv_check_delay(k, job);
#else
                DUPRUN(6, ph_rwkv_chunk(k, l, job, INP(I_KA)));
#endif
            }
#ifndef NO_GLA
            FRESH();
            for (int vb = ((k.G & 7) ? k.bid : (k.bid & 7) * (k.G >> 3) + (k.bid >> 3)); vb < 256; vb += k.G) { const int job = vb; DUPRUN(7, ph_gla_scan(k, job)); }
#endif
#endif
        PH_END(pb + 4)
        PH_BEGIN(pb + 5, 7)
            DUPRUN(8, ph_post(k, l, Mpost, INP(I_LNG), INP(I_LNB), INP(I_GNG)));
        PH_END(pb + 5)
        PH_BEGIN(pb + 6, 8)
            pg8::Gemm g{(const bf16*)(ws + RW_A2), (const bf16*)(ws + WT_G2), Mpost, RD, 256, 0}; pg8::StaticOrder S; S.init(Mpost, RD, k.G, k.bid);
            pg8::Epi8<FL2_> E{FL2_{(const bf16*)(ws + RW_R), (bf16*)(ws + RW_V)}};
            DUPRUN(9, (pg8::gemm_phase<pg8::Epi8<FL2_>, pg8::StaticOrder, GA_, GS_>(glds, g, S, E)));
        PH_END(pb + 6)
        PH_BEGIN(pb + 7, 9)
            pg8::Gemm g{(const bf16*)(ws + RW_V), (const bf16*)(ws + WT_A), Mpost, DM, RD, 0}; pg8::StaticOrder S; S.init(Mpost, DM, k.G, k.bid);
            pg8::Epi8<FM_<0>> E{FM_<0>{(const bf16*)(ws + WS_P), (bf16*)(ws + WS_H), (bf16*)(ws + WS_H)}};
            DUPRUN(10, (pg8::gemm_phase<pg8::Epi8<FM_<0>>, pg8::StaticOrder, GA_, GS_>(glds, g, S, E)));
        PH_END(pb + 7)
        PH_BEGIN(pb + 8, 10)
            pg8::Gemm g{(const bf16*)(ws + GL_VS), (const bf16*)(ws + WT_B), Mpost, DM, GVD, 0}; pg8::StaticOrder S; S.init(Mpost, DM, k.G, k.bid);
            pg8::Epi8<FM_<1>> E{FM_<1>{(const bf16*)(ws + WS_P), (bf16*)(ws + WS_H), (bf16*)(ws + WS_H)}};
            pg8::gemm_phase<pg8::Epi8<FM_<1>>, pg8::StaticOrder, GA_, GS_>(glds, g, S, E);
            if ((DUP_MASK >> 17) & 1u) { __syncthreads(); pg8::Epi8<FM_<1>> E2{FM_<1>{(const bf16*)(ws + WS_P), (bf16*)(ws + WS_H), (bf16*)(ws + RW_R)}}; pg8::gemm_phase<pg8::Epi8<FM_<1>>, pg8::StaticOrder, GA_, GS_>(glds, g, S, E2); }
        PH_END(pb + 8)
        PH_BEGIN(pb + 9, 11)
            pg8::Gemm g{(const bf16*)(ws + WS_H), (const bf16*)(ws + WT_O), Mpost, DM, DM, 0}; pg8::StaticOrder S; S.init(Mpost, DM, k.G, k.bid);
            pg8::Epi4<FX_> E{FX_{(float*)(ws + WS_X), (const float*)(ws + WS_MOD), l, (float*)(ws + WS_X)}};
            pg8::gemm_phase<pg8::Epi4<FX_>, pg8::StaticOrder, GA_, GS_>(glds, g, S, E);
            if ((DUP_MASK >> 18) & 1u) { __syncthreads(); pg8::Epi4<FX_> E2{FX_{(float*)(ws + WS_X), (const float*)(ws + WS_MOD), l, (float*)(ws + WS_P)}}; pg8::gemm_phase<pg8::Epi4<FX_>, pg8::StaticOrder, GA_, GS_>(glds, g, S, E2); }
        PH_END(pb + 9)
        PH_BEGIN(pb + 10, 12)
            RowArgs ra{nullptr, nullptr, INP(I_NFG), INP(I_RW), INP(I_RB), nullptr};
            ph_rows<1>(k, ra, l, Mpost);
            if ((DUP_MASK >> 16) & 1u) { __syncthreads(); ph_rows<1>(k, ra, l, Mpost, true); }
        PH_END(pb + 10)
        PH_BEGIN(pb + 11, 13)
            DUPRUN(13, ph_moe_scatter(k, l, Mpost));
        PH_END(pb + 11)
        PH_BEGIN(pb + 12, 14)
            pg8::Gemm g{(const bf16*)(ws + WS_HP), (const bf16*)(ws + WT_GU), 0, 2816, DM, (size_t)2816 * DM * 2};
            pg8::MoeOrder S; S.init((const int*)(ws + WS_TAB + TAB_TILE) + 256 * l, 11, k.G, ((k.G & 7) ? k.bid : (k.bid & 7) * (k.G >> 3) + (k.bid >> 3)));
            pg8::EpiGU<FE1_> E{FE1_{(bf16*)(ws + WS_ACT)}};
            DUPRUN(11, (pg8::gemm_phase<pg8::EpiGU<FE1_>, pg8::MoeOrder, GA_, GS_>(glds, g, S, E)));
        PH_END(pb + 12)
        PH_BEGIN(pb + 13, 15)
            pg8::Gemm g{(const bf16*)(ws + WS_ACT), (const bf16*)(ws + WT_D), 0, DM, DEXP, (size_t)DM * DEXP * 2};
            pg8::MoeOrder S; S.init((const int*)(ws + WS_TAB + TAB_TILE) + 256 * l, 8, k.G, ((k.G & 7) ? k.bid : (k.bid & 7) * (k.G >> 3) + (k.bid >> 3)));
            pg8::Epi8<FE2_> E{FE2_{(const int*)(ws + WS_TAB + TAB_ROWTOK) + (size_t)l * MOE_ROWS, (const float*)(ws + WS_TAB + TAB_ROWW) + (size_t)l * MOE_ROWS, (bf16*)(ws + WS_YF)}};
            DUPRUN(12, (pg8::gemm_phase<pg8::Epi8<FE2_>, pg8::MoeOrder, GA_, GS_>(glds, g, S, E)));
        PH_END(pb + 13)
        }
#undef L_
#define L_ 1
    {
        constexpr int l = L_;
        const int pb = 2 + 14 * l;
        const bool last = (l == DEPTH - 1);
        const int Mpost = last ? TL : TA;
        PH_BEGIN(pb + 0, 2)
            if (l > 0) { DUPRUN(1, ph_convert(k, WSRC, l)); }
            RowArgs ra{INP(I_X), INP(I_CTX), INP(I_NMG), nullptr, nullptr, nullptr};
            ph_rows<0>(k, ra, l, TA);
            if (l == 0 && ((DUP_MASK >> 15) & 1u)) { __syncthreads(); ph_rows<0>(k, ra, l, TA); }
        PH_END(pb + 0)
        PH_BEGIN(pb + 1, 3)
            pg8::Gemm g{(const bf16*)(ws + WS_H), (const bf16*)(ws + WT_IN), TA, NP, DM, 0}; pg8::StaticOrder S; S.init(TA, NP, k.G, k.bid);
            pg8::Epi8<FP_> E{FP_{(bf16*)(ws + WS_P)}};
            DUPRUN(2, (pg8::gemm_phase<pg8::Epi8<FP_>, pg8::StaticOrder, GA_, GS_>(glds, g, S, E)));
        PH_END(pb + 1)
        PH_BEGIN(pb + 2, 4)
            DUPRUN(3, ph_rwkv_prep(k, l, TA, INP(I_MU), INP(I_KK), INP(I_RK)));
            DUPRUN(4, ph_gla_prep(k, l, INP(I_GCONV), INP(I_GAW2), INP(I_GAB)));
        PH_END(pb + 2)
        PH_BEGIN(pb + 3, 5)
            pg8::Gemm g{(const bf16*)(ws + RW_A1), (const bf16*)(ws + WT_L1), TA, 4096, 256, 0}; pg8::StaticOrder S; S.init(TA, 4096, k.G, k.bid);
            pg8::Epi8<FL1_> E{FL1_{(bf16*)(ws + RW_LO), (const float*)(ws + WS_TAB + TAB_TOP)}};
            DUPRUN(5, (pg8::gemm_phase<pg8::Epi8<FL1_>, pg8::StaticOrder, GA_, GS_>(glds, g, S, E)));
        PH_END(pb + 3)
        PH_BEGIN(pb + 4, 6)
#if SPLIT_SCAN
            DUPRUN(6, ph_scan_split(k, l, INP(I_KA)));
#else
            for (int vb = ((k.G & 7) ? k.bid : (k.bid & 7) * (k.G >> 3) + (k.bid >> 3)); vb < 256; vb += k.G) { const int job = vb;
#if RWKV_MODE == 0
                DUPRUN(6, ph_rwkv_scan(k, l, job, INP(I_KA)));
#elif RWKV_MODE == 1
                ph_rwkv_scan(k, l, job, INP(I_KA)); ph_rwkv_chunk(k, l, job, INP(I_KA), WS_H); if (l == 0) rwkv_check_delay(k, job);
#elif RWKV_MODE == 3
                ph_rwkv_scan(k, l, job, INP(I_KA)); ph_rwkv_scan(k, l, job, INP(I_KA), WS_H); if (l == 0) rwkv_check_delay(k, job);
#else
                DUPRUN(6, ph_rwkv_chunk(k, l, job, INP(I_KA)));
#endif
            }
#ifndef NO_GLA
            FRESH();
            for (int vb = ((k.G & 7) ? k.bid : (k.bid & 7) * (k.G >> 3) + (k.bid >> 3)); vb < 256; vb += k.G) { const int job = vb; DUPRUN(7, ph_gla_scan(k, job)); }
#endif
#endif
        PH_END(pb + 4)
        PH_BEGIN(pb + 5, 7)
            DUPRUN(8, ph_post(k, l, Mpost, INP(I_LNG), INP(I_LNB), INP(I_GNG)));
        PH_END(pb + 5)
        PH_BEGIN(pb + 6, 8)
            pg8::Gemm g{(const bf16*)(ws + RW_A2), (const bf16*)(ws + WT_G2), Mpost, RD, 256, 0}; pg8::StaticOrder S; S.init(Mpost, RD, k.G, k.bid);
            pg8::Epi8<FL2_> E{FL2_{(const bf16*)(ws + RW_R), (bf16*)(ws + RW_V)}};
            DUPRUN(9, (pg8::gemm_phase<pg8::Epi8<FL2_>, pg8::StaticOrder, GA_, GS_>(glds, g, S, E)));
        PH_END(pb + 6)
        PH_BEGIN(pb + 7, 9)
            pg8::Gemm g{(const bf16*)(ws + RW_V), (const bf16*)(ws + WT_A), Mpost, DM, RD, 0}; pg8::StaticOrder S; S.init(Mpost, DM, k.G, k.bid);
            pg8::Epi8<FM_<0>> E{FM_<0>{(const bf16*)(ws + WS_P), (bf16*)(ws + WS_H), (bf16*)(ws + WS_H)}};
            DUPRUN(10, (pg8::gemm_phase<pg8::Epi8<FM_<0>>, pg8::StaticOrder, GA_, GS_>(glds, g, S, E)));
        PH_END(pb + 7)
        PH_BEGIN(pb + 8, 10)
            pg8::Gemm g{(const bf16*)(ws + GL_VS), (const bf16*)(ws + WT_B), Mpost, DM, GVD, 0}; pg8::StaticOrder S; S.init(Mpost, DM, k.G, k.bid);
            pg8::Epi8<FM_<1>> E{FM_<1>{(const bf16*)(ws + WS_P), (bf16*)(ws + WS_H), (bf16*)(ws + WS_H)}};
            pg8::gemm_phase<pg8::Epi8<FM_<1>>, pg8::StaticOrder, GA_, GS_>(glds, g, S, E);
            if ((DUP_MASK >> 17) & 1u) { __syncthreads(); pg8::Epi8<FM_<1>> E2{FM_<1>{(const bf16*)(ws + WS_P), (bf16*)(ws + WS_H), (bf16*)(ws + RW_R)}}; pg8::gemm_phase<pg8::Epi8<FM_<1>>, pg8::StaticOrder, GA_, GS_>(glds, g, S, E2); }
        PH_END(pb + 8)
        PH_BEGIN(pb + 9, 11)
            pg8::Gemm g{(const bf16*)(ws + WS_H), (const bf16*)(ws + WT_O), Mpost, DM, DM, 0}; pg8::StaticOrder S; S.init(Mpost, DM, k.G, k.bid);
            pg8::Epi4<FX_> E{FX_{(float*)(ws + WS_X), (const float*)(ws + WS_MOD), l, (float*)(ws + WS_X)}};
            pg8::gemm_phase<pg8::Epi4<FX_>, pg8::StaticOrder, GA_, GS_>(glds, g, S, E);
            if ((DUP_MASK >> 18) & 1u) { __syncthreads(); pg8::Epi4<FX_> E2{FX_{(float*)(ws + WS_X), (const float*)(ws + WS_MOD), l, (float*)(ws + WS_P)}}; pg8::gemm_phase<pg8::Epi4<FX_>, pg8::StaticOrder, GA_, GS_>(glds, g, S, E2); }
        PH_END(pb + 9)
        PH_BEGIN(pb + 10, 12)
            RowArgs ra{nullptr, nullptr, INP(I_NFG), INP(I_RW), INP(I_RB), nullptr};
            ph_rows<1>(k, ra, l, Mpost);
            if ((DUP_MASK >> 16) & 1u) { __syncthreads(); ph_rows<1>(k, ra, l, Mpost, true); }
        PH_END(pb + 10)
        PH_BEGIN(pb + 11, 13)
            DUPRUN(13, ph_moe_scatter(k, l, Mpost));
        PH_END(pb + 11)
        PH_BEGIN(pb + 12, 14)
            pg8::Gemm g{(const bf16*)(ws + WS_HP), (const bf16*)(ws + WT_GU), 0, 2816, DM, (size_t)2816 * DM * 2};
            pg8::MoeOrder S; S.init((const int*)(ws + WS_TAB + TAB_TILE) + 256 * l, 11, k.G, ((k.G & 7) ? k.bid : (k.bid & 7) * (k.G >> 3) + (k.bid >> 3)));
            pg8::EpiGU<FE1_> E{FE1_{(bf16*)(ws + WS_ACT)}};
            DUPRUN(11, (pg8::gemm_phase<pg8::EpiGU<FE1_>, pg8::MoeOrder, GA_, GS_>(glds, g, S, E)));
        PH_END(pb + 12)
        PH_BEGIN(pb + 13, 15)
            pg8::Gemm g{(const bf16*)(ws + WS_ACT), (const bf16*)(ws + WT_D), 0, DM, DEXP, (size_t)DM * DEXP * 2};
            pg8::MoeOrder S; S.init((const int*)(ws + WS_TAB + TAB_TILE) + 256 * l, 8, k.G, ((k.G & 7) ? k.bid : (k.bid & 7) * (k.G >> 3) + (k.bid >> 3)));
            pg8::Epi8<FE2_> E{FE2_{(const int*)(ws + WS_TAB + TAB_ROWTOK) + (size_t)l * MOE_ROWS, (const float*)(ws + WS_TAB + TAB_ROWW) + (size_t)l * MOE_ROWS, (bf16*)(ws + WS_YF)}};
            DUPRUN(12, (pg8::gemm_phase<pg8::Epi8<FE2_>, pg8::MoeOrder, GA_, GS_>(glds, g, S, E)));
        PH_END(pb + 13)
        }
#undef L_
#if EXTRA_BARS
    if (hi - lo > 1) { for (int i = 0; i < EXTRA_BARS; ++i) xcd_barrier(bar); }
#endif
    PH_BEGIN(NPHASE - 1, 16)
        RowArgs ra{nullptr, nullptr, INP(I_FNG), nullptr, nullptr, (float*)INP(N_IN)};
        DUPRUN(14, ph_rows<2>(k, ra, 0, TL));
    PH_END(NPHASE - 1)
}

#ifndef MK_SINGLE
#define MK_SINGLE 1
#endif
extern "C" void kernel_launch(void* const* d_in, const int* in_sizes, int n_in, void* d_out, int out_size, void* d_ws, size_t ws_size, hipStream_t stream) {
    static int grid = 0;
    if (grid == 0) {
        if (n_in != N_IN || out_size != TL * DM || ws_size < WS_END) { fprintf(stderr, "kernel_launch: unexpected problem (n_in %d out %d ws %zu need %zu)\n", n_in, out_size, ws_size, (size_t)WS_END); grid = -1; return; }
        int dev = 0, cus = 0;
        if (hipGetDevice(&dev) != hipSuccess || hipDeviceGetAttribute(&cus, hipDeviceAttributeMultiprocessorCount, dev) != hipSuccess) { grid = -1; return; }
        if (hipFuncSetAttribute((const void*)fwd, hipFuncAttributeMaxDynamicSharedMemorySize, LDS_BYTES) != hipSuccess) { grid = -1; return; }
        int per_cu = 0;
        if (hipOccupancyMaxActiveBlocksPerMultiprocessor(&per_cu, (const void*)fwd, 512, LDS_BYTES) != hipSuccess || per_cu < 1) fprintf(stderr, "kernel_launch: occupancy query says %d\n", per_cu);
        (void)hipGetLastError();
        grid = cus;
    }
    if (grid < 0) return;
    unsigned char* ws = (unsigned char*)d_ws;
    (void)hipMemsetAsync(ws + WS_CTL, 0, CTL_BYTES, stream);
    Args a{};
    for (int i = 0; i < N_IN; ++i) a.in[i] = (const float*)d_in[i];
    a.out = (float*)d_out; a.ws = ws;
#if MK_SINGLE
    a.ph_lo = 0; a.ph_hi = NPHASE;
    hipLaunchKernelGGL(fwd, dim3(grid), dim3(512), LDS_BYTES, stream, a);
#else
    for (int p = 0; p < NPHASE; ++p) { a.ph_lo = p; a.ph_hi = p + 1; hipLaunchKernelGGL(fwd, dim3(grid), dim3(512), LDS_BYTES, stream, a); }
#endif
}
```

```cpp
#include <hip/hip_runtime.h>
#include <cstdio>
#include <cstdint>

#define LAS __attribute__((address_space(3)))
#define GAS __attribute__((address_space(1)))
typedef unsigned short bf16;
typedef float f32x4 __attribute__((ext_vector_type(4)));
typedef float f32x2 __attribute__((ext_vector_type(2)));
typedef unsigned u32x4 __attribute__((ext_vector_type(4)));
typedef unsigned u32x2 __attribute__((ext_vector_type(2)));
typedef short bf16x8 __attribute__((ext_vector_type(8)));

constexpr int DM = 2048, NBATCH = 8, SEQ = 2048, CTXL = 256, DEPTH = 2;
constexpr int TL = NBATCH * SEQ, TC = NBATCH * CTXL, TA = TL + TC;
constexpr int RD = 1024, RHEADS = 16, RHS = 64;
constexpr int RWKV_IN = 3520;
constexpr int GKD = 512, GVD = 1024, GDK = 128, GDV = 256, GHEADS = 4, GQKV = 2048;
constexpr int GLA_OFF = 3520, GLA_AD_OFF = GLA_OFF + GQKV, GLA_GATE_OFF = 5584, BR_OFF = 6608, IN_DIM = 10704, NP = 10752;
constexpr int NEXP = 16, DEXP = 1408;
constexpr int MOD_N = 6 * DM;
constexpr int MOE_ROWS = 41216;
constexpr int MOE_TILES = MOE_ROWS / 256;
constexpr int NCH = 36;
constexpr int KSPLIT = 32;

enum { I_X = 0, I_C, I_CTX, I_CCTX, I_WADA, I_BADA, I_NMG, I_NFG, I_WIN, I_MU, I_W0, I_W2, I_A0, I_A2, I_G2, I_KK, I_KA, I_RK, I_LNG, I_LNB,
       I_GCONV, I_GAW2, I_GAB, I_GNG, I_WBA, I_WBB, I_WOUT, I_RW, I_RB, I_EG, I_EU, I_ED, I_FNG, N_IN };

constexpr size_t MiB = 1u << 20;
constexpr size_t WS_CTL = 0;
constexpr size_t WS_TAB = 1 * MiB;
constexpr size_t WS_MOD = 2 * MiB;
constexpr size_t WS_X = 3 * MiB;
constexpr size_t WS_H = WS_X + 144 * MiB;
constexpr size_t WS_P = WS_H + 72 * MiB;
constexpr size_t WS_RW = WS_P + 378 * MiB;
constexpr size_t WS_GL = WS_RW + 380 * MiB;
constexpr size_t WS_WT = WS_GL + 218 * MiB;
constexpr size_t WS_END = WS_WT + 325 * MiB;
constexpr int CW_TMO = 0, CW_CNT = 64  , CW_BAR = 4096;
constexpr size_t CTL_BYTES = 1 * MiB;
constexpr size_t TAB_ROWTOK = 0;
constexpr size_t TAB_ROWTOK_BYTES = 2 * (size_t)MOE_ROWS * 4;
constexpr size_t TAB_ROWW = 384 * 1024;
constexpr size_t TAB_TILE = 768 * 1024;
constexpr size_t TAB_TOP = 800 * 1024;
static_assert(TAB_ROWTOK_BYTES <= TAB_ROWW && TAB_ROWW + 2 * (size_t)MOE_ROWS * 4 <= TAB_TILE, "tab map");
constexpr size_t WS_MODP = WS_P;
constexpr size_t WS_HP = WS_P;
constexpr size_t WS_ACT = WS_P + 162 * MiB;
constexpr size_t WS_TOPK = WS_P + 274 * MiB;
static_assert((size_t)MOE_ROWS * DM * 2 <= 162 * MiB && (size_t)MOE_ROWS * DEXP * 2 <= 112 * MiB && 274 * MiB + 3 * (size_t)TA * 8 <= 378 * MiB, "P overlay");
constexpr size_t RW_R = WS_RW;
constexpr size_t RW_KS = RW_R + 36 * MiB;
constexpr size_t RW_V = RW_KS + 36 * MiB;
constexpr size_t RW_KK = RW_V + 36 * MiB;
constexpr size_t RW_LO = RW_KK + 36 * MiB;
constexpr size_t RW_Y = RW_LO + 144 * MiB;
constexpr size_t RW_A1 = RW_Y + 72 * MiB;
constexpr size_t RW_A2 = RW_A1 + 9 * MiB;
constexpr size_t RW_BON = RW_A2 + 9 * MiB;
static_assert(RW_BON + 2 * MiB <= WS_GL, "rwkv map");
constexpr size_t GL_QG = WS_GL;
constexpr size_t GL_KG = GL_QG + 36 * MiB;
constexpr size_t GL_KE = GL_KG + 36 * MiB;
constexpr size_t GL_VS = GL_KE + 36 * MiB;
constexpr size_t GL_O = GL_VS + 36 * MiB;
constexpr size_t GL_DEC = GL_O + 72 * MiB;
static_assert(GL_DEC + 2 * MiB <= WS_WT, "gla map");
constexpr size_t WS_YF = WS_GL;
constexpr size_t WT_IN = WS_WT;
constexpr size_t WT_L1 = WT_IN + 42 * MiB;
constexpr size_t WT_G2 = WT_L1 + 2 * MiB;
constexpr size_t WT_A = WT_G2 + 1 * MiB;
constexpr size_t WT_B = WT_A + 4 * MiB;
constexpr size_t WT_O = WT_B + 4 * MiB;
constexpr size_t WT_GU = WT_O + 8 * MiB;
constexpr size_t WT_D = WT_GU + 176 * MiB;
static_assert(WT_D + 88 * MiB == WS_END, "weight map");

__device__ __forceinline__ float bf2f(unsigned v) { return __uint_as_float(v << 16); }
__device__ __forceinline__ float bflo(unsigned w) { return __uint_as_float(w << 16); }
__device__ __forceinline__ float bfhi(unsigned w) { return __uint_as_float(w & 0xffff0000u); }
__device__ __forceinline__ unsigned f2bf(float f) { unsigned u = __float_as_uint(f); return (u + 0x7fffu + ((u >> 16) & 1u)) >> 16; }
__device__ __forceinline__ unsigned pk2(float lo, float hi) { unsigned r; asm volatile("v_cvt_pk_bf16_f32 %0, %1, %2" : "=v"(r) : "v"(lo), "v"(hi)); return r; }
typedef __bf16 bf16x2_t __attribute__((ext_vector_type(2)));
__device__ __forceinline__ unsigned pk2c(float lo, float hi) { f32x2 v = {lo, hi}; bf16x2_t b = __builtin_convertvector(v, bf16x2_t); return __builtin_bit_cast(unsigned, b); }
__device__ __forceinline__ float sigm(float x) { return 1.0f / (1.0f + __expf(-x)); }
__device__ __forceinline__ float siluf(float x) { return x * sigm(x); }
__device__ __forceinline__ float wave_sum(float x) {
    x += __builtin_bit_cast(float, __builtin_amdgcn_update_dpp(0, __builtin_bit_cast(int, x), 0xB1, 0xF, 0xF, true));
    x += __builtin_bit_cast(float, __builtin_amdgcn_update_dpp(0, __builtin_bit_cast(int, x), 0x4E, 0xF, 0xF, true));
    x += __builtin_bit_cast(float, __builtin_amdgcn_update_dpp(0, __builtin_bit_cast(int, x), 0x141, 0xF, 0xF, true));
    x += __builtin_bit_cast(float, __builtin_amdgcn_update_dpp(0, __builtin_bit_cast(int, x), 0x140, 0xF, 0xF, true));
    const int xi = __builtin_bit_cast(int, x);
    return (__builtin_bit_cast(float, __builtin_amdgcn_readlane(xi, 0)) + __builtin_bit_cast(float, __builtin_amdgcn_readlane(xi, 16))) +
           (__builtin_bit_cast(float, __builtin_amdgcn_readlane(xi, 32)) + __builtin_bit_cast(float, __builtin_amdgcn_readlane(xi, 48)));
}
__device__ __forceinline__ void unpack8(const u32x4 w, float (&o)[8]) {
    o[0] = bflo(w.x); o[1] = bfhi(w.x); o[2] = bflo(w.y); o[3] = bfhi(w.y); o[4] = bflo(w.z); o[5] = bfhi(w.z); o[6] = bflo(w.w); o[7] = bfhi(w.w);
}
__device__ __forceinline__ u32x4 pack8(const float (&v)[8]) { u32x4 w; w.x = pk2(v[0], v[1]); w.y = pk2(v[2], v[3]); w.z = pk2(v[4], v[5]); w.w = pk2(v[6], v[7]); return w; }
namespace pg8 {
#define PG8_LAS __attribute__((address_space(3)))
typedef unsigned short bf16_t;
typedef short bf16x8 __attribute__((ext_vector_type(8)));
typedef float f32x4 __attribute__((ext_vector_type(4)));
typedef unsigned u32x4 __attribute__((ext_vector_type(4)));
constexpr int BM = 256, BK = 64, HALF = 128, HTB = HALF * BK * 2  , STAGE_BYTES = 8 * HTB, NXCD = 8, WGM = 8;

__host__ __device__ __forceinline__ int lds_byte(int r, int c) { const int st = (r >> 4) * 2 + (c >> 5), rr = r & 15, cc = c & 31, ob = rr * 64 + cc * 2; return st * 1024 + (ob ^ (((ob >> 9) & 1) << 5)); }
__host__ __device__ __forceinline__ void stage_rc(int b, int& R, int& C) { const int st = b / 1024, sb = b % 1024, swz = sb ^ (((sb >> 9) & 1) << 5); R = (st >> 1) * 16 + swz / 64; C = (st & 1) * 32 + (swz % 64) / 2; }
__host__ __device__ __forceinline__ int perm32(int rho) { const int n = rho >> 4, i = rho & 15; return 8 * (i >> 2) + 4 * n + (i & 3); }
struct Unit { int pm, pn, eb; };
struct Gemm { const bf16_t* A; const bf16_t* Bt; int M, N, K; size_t bstride; };

struct StaticOrder {
    int nM, nN, nwg, G, c;
    __host__ __device__ void init(int M, int N, int G_, int c_) { nM = M / BM; nN = N / BM; nwg = nM * nN; G = G_; c = c_; }
    __host__ __device__ bool next(int i, Unit& u) const {
        const long L = (long)i * G + c; if (L >= nwg) return false;
        int wgid = (int)L; { const int q = nwg / NXCD, r = nwg % NXCD, xcd = wgid % NXCD, off = wgid / NXCD; wgid = (xcd < r ? xcd * (q + 1) : r * (q + 1) + (xcd - r) * q) + off; }
        const int nig = WGM * nN, gid = wgid / nig, fm = gid * WGM, gsz = (nM - fm) < WGM ? (nM - fm) : WGM;
        u.pm = fm + ((wgid % nig) % gsz); u.pn = (wgid % nig) / gsz; u.eb = 0; return true;
    }
    __device__ __forceinline__ void a_ready(const Unit&) const {}
    __device__ __forceinline__ void done(const Unit&) const {}
};
struct MoeOrder {
    const int* tab; int nT, nN, G, c;
    __device__ void init(const int* tab_, int nN_, int G_, int c_) { tab = tab_; nT = tab_[0]; nN = nN_; G = G_; c = c_; }
    __device__ bool next(int i, Unit& u) const {
        const long L = (long)i * G + c; if (L >= (long)nT * nN) return false;
        u.pm = (int)(L / nN); u.pn = (int)(L % nN); u.eb = tab[1 + u.pm]; return true;
    }
    __device__ __forceinline__ void a_ready(const Unit&) const {}
    __device__ __forceinline__ void done(const Unit&) const {}
};

template <class F> struct Epi8 {
    static constexpr bool PERM = true, AFTER_DRAIN = false;
    F f;
    __device__ __forceinline__ void operator()(const f32x4 (&acc)[2][2][4][2], const Unit& u, int wr, int wc, int fr, int fq) const {
        const int row0 = u.pm * BM + wr * 64 + fr, col0 = u.pn * BM + wc * 32 + 8 * fq;
#pragma unroll
        for (int ai = 0; ai < 2; ++ai)
#pragma unroll
            for (int m = 0; m < 4; ++m) {
#pragma unroll
                for (int bj = 0; bj < 2; ++bj) {
                    const f32x4 a = acc[ai][bj][m][0], b = acc[ai][bj][m][1];
                    float v[8] = {a[0], a[1], a[2], a[3], b[0], b[1], b[2], b[3]};
                    f(row0 + ai * HALF + m * 16, col0 + bj * HALF, v, u);
                }
            }
    }
};
template <class F> struct EpiGU {
    static constexpr bool PERM = true, AFTER_DRAIN = false;
    F f;
    __device__ __forceinline__ void operator()(const f32x4 (&acc)[2][2][4][2], const Unit& u, int wr, int wc, int fr, int fq) const {
        const int row0 = u.pm * BM + wr * 64 + fr, col0 = u.pn * HALF + wc * 32 + 8 * fq;
#pragma unroll
        for (int ai = 0; ai < 2; ++ai)
#pragma unroll
            for (int m = 0; m < 4; ++m) {
                const f32x4 g0 = acc[ai][0][m][0], g1 = acc[ai][0][m][1], u0 = acc[ai][1][m][0], u1 = acc[ai][1][m][1];
                float g[8] = {g0[0], g0[1], g0[2], g0[3], g1[0], g1[1], g1[2], g1[3]};
                float up[8] = {u0[0], u0[1], u0[2], u0[3], u1[0], u1[1], u1[2], u1[3]};
                f(row0 + ai * HALF + m * 16, col0, g, up);
            }
    }
};
template <class F> struct Epi4 {
    static constexpr bool PERM = false, AFTER_DRAIN = false;
    F f;
    __device__ __forceinline__ void operator()(const f32x4 (&acc)[2][2][4][2], const Unit& u, int wr, int wc, int fr, int fq) const {
        const int row0 = u.pm * BM + wr * 64 + fr, col0 = u.pn * BM + wc * 32 + 4 * fq;
#pragma unroll
        for (int ai = 0; ai < 2; ++ai)
#pragma unroll
            for (int m = 0; m < 4; ++m) {
#pragma unroll
                for (int bj = 0; bj < 2; ++bj)
#pragma unroll
                    for (int n = 0; n < 2; ++n) f(row0 + ai * HALF + m * 16, col0 + bj * HALF + n * 16, acc[ai][bj][m][n], u);
            }
    }
};
template <class Epi, class Sched, bool ALIGN_EPI = false, bool SP2 = false>
__device__ __forceinline__ void gemm_phase(PG8_LAS unsigned char* lds, const Gemm g, const Sched& S, const Epi& E) {
    int tid_o = threadIdx.x; asm volatile("" : "+v"(tid_o));
    const int tid = tid_o, wid = __builtin_amdgcn_readfirstlane(tid >> 6), lane = tid & 63, wr = wid >> 2, wc = wid & 3, fr = lane & 15, fq = lane >> 4;
    const int K = g.K, nt = K / BK;
    unsigned voffA[2], voffB[2];
#pragma unroll
    for (int i = 0; i < 2; ++i) { int R, C; stage_rc(tid * 16 + i * 8192, R, C); const int Rb = Epi::PERM ? ((R & ~31) + perm32(R & 31)) : R;
        voffA[i] = (unsigned)(R * K + C) * 2u; voffB[i] = (unsigned)(Rb * K + C) * 2u; }
    const size_t kstep = (size_t)(BK * 2);
    const size_t hstep = (size_t)HALF * K * 2;
    const size_t tstep = 2 * hstep;
    const unsigned ldsw = (unsigned)wid * 1024u;
    const int aoff = lds_byte(wr * 64 + fr, fq * 8), boff = lds_byte(wc * 32 + fr, fq * 8);
#define PG8_SA(b, h) (((b) * 2 + (h)) * HTB)
#define PG8_SB(b, h) ((4 + (b) * 2 + (h)) * HTB)
#define PG8_STAGE(bufoff, gbase, voff) do { _Pragma("unroll") for (int _i = 0; _i < 2; ++_i) \
        __builtin_amdgcn_global_load_lds((const unsigned*)((const char*)(gbase) + (voff)[_i]), (PG8_LAS unsigned*)(lds + (bufoff) + ldsw + _i * 8192), 16, 0, 0); } while (0)
#define PG8_LDA(dst, b, h) do { _Pragma("unroll") for (int m = 0; m < 4; ++m) _Pragma("unroll") for (int k = 0; k < 2; ++k) dst[m][k] = *(const PG8_LAS bf16x8*)(lds + PG8_SA(b, h) + aoff + m * 2048 + k * 1024); } while (0)
#define PG8_LDB(dst, b, h) do { _Pragma("unroll") for (int n = 0; n < 2; ++n) _Pragma("unroll") for (int k = 0; k < 2; ++k) dst[n][k] = *(const PG8_LAS bf16x8*)(lds + PG8_SB(b, h) + boff + n * 2048 + k * 1024); } while (0)
#define PG8_MMA(ai, bj, At, Bt) do { __builtin_amdgcn_s_setprio(1); _Pragma("unroll") for (int m = 0; m < 4; ++m) _Pragma("unroll") for (int n = 0; n < 2; ++n) _Pragma("unroll") for (int k = 0; k < 2; ++k) \
        acc[ai][bj][m][n] = __builtin_amdgcn_mfma_f32_16x16x32_bf16(Bt[n][k], At[m][k], acc[ai][bj][m][n], 0, 0, 0); __builtin_amdgcn_s_setprio(0); } while (0)
#define PG8_WAIT_V(n) asm volatile("s_waitcnt vmcnt(" #n ")" ::: "memory")
#define PG8_WAIT_L(n) asm volatile("s_waitcnt lgkmcnt(" #n ")" ::: "memory")
#define PG8_BAR __builtin_amdgcn_s_barrier()
#define PG8_SCHED __builtin_amdgcn_sched_barrier(0)
    Unit cur, nxt; int ui = 0;
    if (!S.next(0, cur)) return;
    f32x4 acc[2][2][4][2];
#pragma unroll
    for (int a = 0; a < 2; ++a)
#pragma unroll
        for (int b = 0; b < 2; ++b)
#pragma unroll
            for (int m = 0; m < 4; ++m)
#pragma unroll
                for (int n = 0; n < 2; ++n) acc[a][b][m][n] = (f32x4){0.f, 0.f, 0.f, 0.f};
    bf16x8 At[4][2], B0[2][2], B1[2][2];
    const char* cA = (const char*)g.A + (size_t)cur.pm * tstep; const char* cB = (const char*)g.Bt + (size_t)cur.eb * g.bstride + (size_t)cur.pn * tstep;
    S.a_ready(cur);
    if constexpr (SP2) {
        PG8_STAGE(PG8_SB(0, 0), cB, voffB); PG8_STAGE(PG8_SB(0, 1), cB + hstep, voffB); PG8_STAGE(PG8_SA(0, 0), cA, voffA); PG8_STAGE(PG8_SA(0, 1), cA + hstep, voffA);
        if (wr == 1) PG8_BAR;
        PG8_WAIT_V(2); PG8_BAR;
        PG8_STAGE(PG8_SB(1, 0), cB + kstep, voffB); PG8_STAGE(PG8_SA(1, 0), cA + kstep, voffA); PG8_STAGE(PG8_SB(1, 1), cB + hstep + kstep, voffB);
        PG8_WAIT_V(6); PG8_BAR;
    } else {
        PG8_STAGE(PG8_SB(0, 0), cB, voffB); PG8_STAGE(PG8_SA(0, 0), cA, voffA); PG8_STAGE(PG8_SB(0, 1), cB + hstep, voffB); PG8_STAGE(PG8_SA(0, 1), cA + hstep, voffA);
        if (wr == 1) PG8_BAR;
        PG8_WAIT_V(4); PG8_BAR;
        PG8_STAGE(PG8_SB(1, 0), cB + kstep, voffB); PG8_STAGE(PG8_SA(1, 0), cA + kstep, voffA); PG8_STAGE(PG8_SB(1, 1), cB + hstep + kstep, voffB);
        PG8_WAIT_V(6); PG8_BAR;
    }
    for (;;) {
        const bool has_next = S.next(ui + 1, nxt);
        const char* nA = has_next ? (const char*)g.A + (size_t)nxt.pm * tstep : cA; const char* nB = has_next ? (const char*)g.Bt + (size_t)nxt.eb * g.bstride + (size_t)nxt.pn * tstep : cB;
#pragma nounroll
        for (int t = 0; t < nt; t += 2) {
            const bool last = (t == nt - 2);
            const char* a1 = cA + (size_t)(t + 1) * kstep;
            const char* a2 = last ? nA : cA + (size_t)(t + 2) * kstep; const char* b2 = last ? nB : cB + (size_t)(t + 2) * kstep;
            const char* a3 = a2 + kstep; const char* b3 = b2 + kstep;
            if (last && has_next) S.a_ready(nxt);
            if constexpr (SP2) {
            PG8_LDB(B0, 0, 0); PG8_LDB(B1, 0, 1); PG8_SCHED; PG8_LDA(At, 0, 0); PG8_STAGE(PG8_SA(1, 1), a1 + hstep, voffA);
            PG8_WAIT_V(8); PG8_WAIT_L(0); PG8_BAR; PG8_MMA(0, 0, At, B0); PG8_MMA(0, 1, At, B1); PG8_BAR; PG8_SCHED;
            PG8_LDA(At, 0, 1); PG8_STAGE(PG8_SB(0, 0), b2, voffB); PG8_STAGE(PG8_SB(0, 1), b2 + hstep, voffB); PG8_STAGE(PG8_SA(0, 0), a2, voffA);
            PG8_WAIT_V(8); PG8_WAIT_L(0); PG8_BAR; PG8_MMA(1, 0, At, B0); PG8_MMA(1, 1, At, B1); PG8_BAR; PG8_SCHED;
            PG8_LDB(B0, 1, 0); PG8_LDB(B1, 1, 1); PG8_SCHED; PG8_LDA(At, 1, 0); PG8_STAGE(PG8_SA(0, 1), a2 + hstep, voffA);
            PG8_WAIT_V(8); PG8_WAIT_L(0); PG8_BAR; PG8_MMA(0, 0, At, B0); PG8_MMA(0, 1, At, B1); PG8_BAR; PG8_SCHED;
            PG8_LDA(At, 1, 1); PG8_STAGE(PG8_SB(1, 0), b3, voffB); PG8_STAGE(PG8_SB(1, 1), b3 + hstep, voffB); PG8_STAGE(PG8_SA(1, 0), a3, voffA);
            PG8_WAIT_V(8); PG8_WAIT_L(0); PG8_BAR; PG8_MMA(1, 0, At, B0); PG8_MMA(1, 1, At, B1); PG8_BAR; PG8_SCHED;
            } else {
            PG8_LDB(B0, 0, 0); PG8_SCHED; PG8_LDA(At, 0, 0); PG8_STAGE(PG8_SA(1, 1), a1 + hstep, voffA);
            PG8_WAIT_L(8); PG8_BAR; PG8_WAIT_L(0); PG8_MMA(0, 0, At, B0); PG8_BAR; PG8_SCHED;
            PG8_LDB(B1, 0, 1); PG8_STAGE(PG8_SB(0, 0), b2, voffB);
            PG8_BAR; PG8_WAIT_L(0); PG8_MMA(0, 1, At, B1); PG8_BAR;
            PG8_LDA(At, 0, 1); PG8_STAGE(PG8_SA(0, 0), a2, voffA);
            PG8_BAR; PG8_WAIT_L(0); PG8_MMA(1, 0, At, B0); PG8_BAR; PG8_SCHED;
            PG8_STAGE(PG8_SB(0, 1), b2 + hstep, voffB);
            PG8_WAIT_V(6); PG8_BAR; PG8_MMA(1, 1, At, B1); PG8_BAR;
            PG8_LDB(B0, 1, 0); PG8_SCHED; PG8_LDA(At, 1, 0); PG8_STAGE(PG8_SA(0, 1), a2 + hstep, voffA);
            PG8_WAIT_L(8); PG8_BAR; PG8_WAIT_L(0); PG8_MMA(0, 0, At, B0); PG8_BAR; PG8_SCHED;
            PG8_LDB(B1, 1, 1); PG8_STAGE(PG8_SB(1, 0), b3, voffB);
            PG8_BAR; PG8_WAIT_L(0); PG8_MMA(0, 1, At, B1); PG8_BAR;
            PG8_LDA(At, 1, 1); PG8_STAGE(PG8_SA(1, 0), a3, voffA);
            PG8_BAR; PG8_WAIT_L(0); PG8_MMA(1, 0, At, B0); PG8_BAR; PG8_SCHED;
            PG8_STAGE(PG8_SB(1, 1), b3 + hstep, voffB);
            PG8_WAIT_V(6); PG8_BAR; PG8_MMA(1, 1, At, B1); PG8_BAR;
            }
        }
        if constexpr (ALIGN_EPI) { if (wr == 0) PG8_BAR; }
        if constexpr (!Epi::AFTER_DRAIN) { E(acc, cur, wr, wc, fr, fq); S.done(cur); }
        if (!has_next) break;
#pragma unroll
        for (int a = 0; a < 2; ++a)
#pragma unroll
            for (int b = 0; b < 2; ++b)
#pragma unroll
                for (int m = 0; m < 4; ++m)
#pragma unroll
                    for (int n = 0; n < 2; ++n) acc[a][b][m][n] = (f32x4){0.f, 0.f, 0.f, 0.f};
        cur = nxt; cA = nA; cB = nB; ++ui;
        if constexpr (ALIGN_EPI) { if (wr == 1) PG8_BAR; }
    }
    PG8_WAIT_V(0);
    if constexpr (!ALIGN_EPI) { if (wr == 0) PG8_BAR; }
    PG8_BAR;
    if constexpr (Epi::AFTER_DRAIN) { E.fused(acc, cur, wr, wc, fr, fq, lds, wid, lane); S.done(cur); }
#undef PG8_SA
#undef PG8_SB
#undef PG8_STAGE
#undef PG8_LDA
#undef PG8_LDB
#undef PG8_MMA
#undef PG8_WAIT_V
#undef PG8_WAIT_L
#undef PG8_BAR
#undef PG8_SCHED
}
}

#ifndef PG8_SP2
#define PG8_SP2 true
#endif
#ifndef PG8_ALIGN
#define PG8_ALIGN true
#endif
#define XB_TMO      128
#define XB_XCNT(j)  (256  + 64 * (j))
#define XB_XSUB(j)  (1280 + 64 * (j))
#define XB_XGEN(j)  (2304 + 64 * (j))
#define XB_TOP      3328
#define XB_TOPGEN   3392
#define XCD_BAR_WORDS 3456
#define XB_SPIN_CAP (1u << 18)

__device__ __forceinline__ unsigned xb_ld(unsigned* p)              { return __hip_atomic_load(p, __ATOMIC_RELAXED, __HIP_MEMORY_SCOPE_AGENT); }
__device__ __forceinline__ unsigned xb_add(unsigned* p, unsigned v) { return __hip_atomic_fetch_add(p, v, __ATOMIC_RELAXED, __HIP_MEMORY_SCOPE_AGENT); }
__device__ __forceinline__ unsigned xb_xcc_id() { return (unsigned)__builtin_amdgcn_s_getreg((3 << 11) | 20) & 0xFu; }
#define XB_SPIN(cond, bar) do { unsigned _sp = 0; while (cond) { __builtin_amdgcn_s_sleep(1); \
    if ((++_sp & 255u) == 0u) { if (xb_ld(&(bar)[XB_TMO])) break; if (_sp > XB_SPIN_CAP) { atomicAdd(&(bar)[XB_TMO], 1u); break; } } } } while (0)

struct XcdBarrier {
    unsigned* bar; unsigned x;
    volatile LAS unsigned* st;
};

__device__ __forceinline__ XcdBarrier xcd_barrier_post(unsigned* bar, volatile LAS unsigned* st) {
    XcdBarrier b; b.bar = bar; b.x = xb_xcc_id(); b.st = st;
    if (threadIdx.x == 0) (void)xb_add(&bar[XB_XCNT(b.x)], 1u);
    return b;
}
__device__ __forceinline__ void xcd_barrier_complete(unsigned* bar, unsigned x, unsigned& nloc, unsigned& nx) {
    const unsigned G = gridDim.x * gridDim.y * gridDim.z;
    unsigned sum, cnt, mine, sp = 0u;
    for (;;) {
        sum = 0u; cnt = 0u; mine = 0u;
#pragma unroll
        for (unsigned j = 0; j < 16; ++j) { const unsigned c = xb_ld(&bar[XB_XCNT(j)]); sum += c; cnt += (c > 0u) ? 1u : 0u; mine = (j == x) ? c : mine; }
        if (sum == G) break;
        __builtin_amdgcn_s_sleep(1);
        if ((++sp & 255u) == 0u) { if (xb_ld(&bar[XB_TMO])) break; if (sp > XB_SPIN_CAP) { atomicAdd(&bar[XB_TMO], 1u); break; } }
    }
    nloc = mine > 0u ? mine : 1u; nx = cnt > 0u ? cnt : 1u;
}

__device__ __forceinline__ void xcd_barrier(const XcdBarrier& b) {
    asm volatile("s_waitcnt vmcnt(0)" ::: "memory");
    __syncthreads();
    if (threadIdx.x == 0) {
        unsigned* bar = b.bar;
        __builtin_amdgcn_s_waitcnt(0);
        unsigned nloc = b.st[0], nx = b.st[1];
        if (nloc == 0u) { xcd_barrier_complete(bar, b.x, nloc, nx); b.st[0] = nloc; b.st[1] = nx; }
        const unsigned old = xb_add(&bar[XB_XSUB(b.x)], 1u);
        const unsigned gen = old / nloc;
        if (old + 1u == (gen + 1u) * nloc) {
            __builtin_amdgcn_fence(__ATOMIC_RELEASE, "agent");
            asm volatile("s_waitcnt vmcnt(0)" ::: "memory");
            const unsigned og = xb_add(&bar[XB_TOP], 1u);
            const unsigned tg = og / nx;
            if (og + 1u == (tg + 1u) * nx) xb_add(&bar[XB_TOPGEN], 1u);
            else XB_SPIN(xb_ld(&bar[XB_TOPGEN]) == tg, bar);
            __builtin_amdgcn_fence(__ATOMIC_ACQUIRE, "agent");
            xb_add(&bar[XB_XGEN(b.x)], 1u);
            asm volatile("s_waitcnt vmcnt(0)" ::: "memory");
        } else {
            XB_SPIN(xb_ld(&bar[XB_XGEN(b.x)]) == gen, bar);
            __builtin_amdgcn_fence(__ATOMIC_ACQUIRE, "agent");
            asm volatile("s_waitcnt vmcnt(0)" ::: "memory");
        }
    }
    __syncthreads();
}
struct KC {
    const float* const* in;
    LAS unsigned char* lds;
    unsigned char* ws;
    int tid, lane, wave, G, bid;
};
__device__ __forceinline__ const float* inp_(int i) {
    const volatile unsigned long long __attribute__((address_space(4)))* kp = (const volatile unsigned long long __attribute__((address_space(4)))*)__builtin_amdgcn_kernarg_segment_ptr();
    return (const float*)(const GAS float*)kp[i];
}
#define INP(k) (inp_(k))

__device__ __forceinline__ int mod_row(int row) { return row < TL ? (row >> 11) : 8; }

__device__ __forceinline__ void ph_adaln_partials(const KC& k, const float* c, const float* c_ctx, const float* w_ada) {
    LAS float* sc = (LAS float*)k.lds;
    for (int i = k.tid; i < 9 * DM; i += 512) { const int r = i >> 11, kk = i & 2047; const float cv = r < 8 ? c[r * DM + kk] : c_ctx[kk]; sc[i] = siluf(cv); }
    __syncthreads();
    float* modp = (float*)(k.ws + WS_MODP);
    const int cc = k.tid & 255, kh = k.tid >> 8;
    constexpr int NIT = DEPTH * 48 * 16;
    for (int it = k.bid; it < NIT; it += k.G) {
        const int l = it / 768, rem = it % 768, cb = rem >> 4, ks = rem & 15;
        const int col = cb * 256 + cc, kbeg = ks * 128 + kh * 64;
        const float* W = w_ada + ((size_t)l * DM + kbeg) * MOD_N + col;
        float acc[9];
#pragma unroll
        for (int r = 0; r < 9; ++r) acc[r] = 0.f;
#pragma unroll 32
        for (int q = 0; q < 64; ++q) {
            const float w = W[(size_t)q * MOD_N];
#pragma unroll
            for (int r = 0; r < 9; ++r) acc[r] += sc[r * DM + kbeg + q] * w;
        }
        const int s = ks * 2 + kh;
#pragma unroll
        for (int r = 0; r < 9; ++r) modp[(((size_t)s * DEPTH + l) * 9 + r) * MOD_N + col] = acc[r];
    }
    __syncthreads();
}
__device__ __forceinline__ void ph_adaln_reduce(const KC& k, const float* b_ada) {
    const float* modp = (const float*)(k.ws + WS_MODP); float* mod = (float*)(k.ws + WS_MOD);
    constexpr int TOT = DEPTH * 9 * MOD_N;
    for (int i = k.bid * 512 + k.tid; i < TOT; i += k.G * 512) {
        const int n = i % MOD_N, l = i / (9 * MOD_N);
        float s = b_ada[l * MOD_N + n];
#pragma unroll 8
        for (int q = 0; q < KSPLIT; ++q) s += modp[(size_t)q * TOT + i];
        mod[i] = s;
    }
}

struct TrItem { const float* src; bf16* dst; int srcN, Kv, Nv, k0, n0, dpitch, drow0, dk0; };
struct WSrc { const float *w_in, *w2, *a2, *g2, *wba, *wbb, *wout, *eg, *eu, *ed, *w0, *a0; };
constexpr int TI_IN = 32 * 336, TI_LO = 4 * 64, TI_G2 = 4 * 32, TI_AB = 16 * 64, TI_O = 32 * 64, TI_GU1 = 32 * 44, TI_D1 = 22 * 64;
constexpr int TI_N = TI_IN + TI_LO + TI_G2 + 2 * TI_AB + TI_O + 2 * NEXP * TI_GU1 + NEXP * TI_D1;
__device__ __forceinline__ TrItem tr_decode(const WSrc& s, unsigned char* ws, int l, int it) {
    TrItem t; int r = it;
    if (r < TI_IN) { const int kb = r / 336, nb = r % 336; t = TrItem{s.w_in + (size_t)l * DM * IN_DIM, (bf16*)(ws + WT_IN), IN_DIM, DM, IN_DIM, 64 * kb, 32 * nb, DM, 32 * nb, 0}; return t; } r -= TI_IN;
    if (r < TI_LO) {
        const int mtx = r >> 6, q = r & 63, kb = q >> 5, nb = q & 31;
        t = TrItem{(mtx < 2 ? s.w2 : s.a2) + (size_t)(l * 2 + (mtx & 1)) * 96 * RD, (bf16*)(ws + WT_L1), RD, 96, RD, 64 * kb, 32 * nb, 256, mtx * 1024 + 32 * nb, mtx < 2 ? 0 : 96}; return t; } r -= TI_LO;
    if (r < TI_G2) { const int kb = r >> 5, nb = r & 31; t = TrItem{s.g2 + (size_t)l * 256 * RD, (bf16*)(ws + WT_G2), RD, 256, RD, 64 * kb, 32 * nb, 256, 32 * nb, 0}; return t; } r -= TI_G2;
    if (r < TI_AB) { const int kb = r >> 6, nb = r & 63; t = TrItem{s.wba + (size_t)l * RD * DM, (bf16*)(ws + WT_A), DM, RD, DM, 64 * kb, 32 * nb, RD, 32 * nb, 0}; return t; } r -= TI_AB;
    if (r < TI_AB) { const int kb = r >> 6, nb = r & 63; t = TrItem{s.wbb + (size_t)l * GVD * DM, (bf16*)(ws + WT_B), DM, GVD, DM, 64 * kb, 32 * nb, GVD, 32 * nb, 0}; return t; } r -= TI_AB;
    if (r < TI_O) { const int kb = r >> 6, nb = r & 63; t = TrItem{s.wout + (size_t)l * DM * DM, (bf16*)(ws + WT_O), DM, DM, DM, 64 * kb, 32 * nb, DM, 32 * nb, 0}; return t; } r -= TI_O;
    if (r < 2 * NEXP * TI_GU1) {
        const int e = r / (2 * TI_GU1), q = r % (2 * TI_GU1), up = q / TI_GU1, q2 = q % TI_GU1, kb = q2 / 44, nb = q2 % 44;
        const int n0 = 32 * nb, drow = 256 * (n0 >> 7) + (n0 & 127) + (up ? 128 : 0);
        t = TrItem{(up ? s.eu : s.eg) + ((size_t)l * NEXP + e) * DM * DEXP, (bf16*)(ws + WT_GU) + (size_t)e * 2816 * DM, DEXP, DM, DEXP, 64 * kb, n0, DM, drow, 0}; return t; } r -= 2 * NEXP * TI_GU1;
    { const int e = r / TI_D1, q = r % TI_D1, kb = q >> 6, nb = q & 63;
      t = TrItem{s.ed + ((size_t)l * NEXP + e) * DEXP * DM, (bf16*)(ws + WT_D) + (size_t)e * DM * DEXP, DM, DEXP, DM, 64 * kb, 32 * nb, DEXP, 32 * nb, 0}; }
    return t;
}
__device__ __forceinline__ void tr_load(const TrItem& t, int lane, float (&v)[32]) {
    const int nn = lane & 31, kh = lane >> 5;
    const bool nok = t.n0 + nn < t.Nv;
    const float* p = t.src + (size_t)(t.k0 + kh) * t.srcN + t.n0 + nn;
#pragma unroll
    for (int i = 0; i < 32; ++i) { v[i] = 0.f; if (nok && t.k0 + 2 * i + kh < t.Kv) v[i] = p[(size_t)(2 * i) * t.srcN]; }
}
__device__ __forceinline__ void tr_store(const TrItem& t, int lane, const float (&v)[32], LAS float* scr) {
    const int nn = lane & 31, kh = lane >> 5;
#pragma unroll
    for (int i = 0; i < 32; ++i) scr[(2 * i + kh) * 33 + nn] = v[i];
    asm volatile("s_waitcnt lgkmcnt(0)" ::: "memory");
    const int cidx = lane & 7;
#pragma unroll
    for (int j = 0; j < 4; ++j) {
        const int n = (lane >> 3) + 8 * j; const LAS float* s = scr + (8 * cidx) * 33 + n;
        u32x4 o; o.x = pk2(s[0 * 33], s[1 * 33]); o.y = pk2(s[2 * 33], s[3 * 33]); o.z = pk2(s[4 * 33], s[5 * 33]); o.w = pk2(s[6 * 33], s[7 * 33]);
        *(u32x4*)(t.dst + (size_t)(t.drow0 + n) * t.dpitch + t.dk0 + t.k0 + 8 * cidx) = o;
    }
    asm volatile("s_waitcnt lgkmcnt(0)" ::: "memory");
}
__device__ __forceinline__ void ph_convert(const KC& k, const WSrc& s, int l) {
    LAS float* scr = (LAS float*)(k.lds + k.wave * 16384);
    const int gw = k.bid * 8 + k.wave, NGW = k.G * 8;
    unsigned char* ws = k.ws;
    { float* b1 = (float*)(ws + WS_TAB + TAB_TOP); for (int i = gw * 64 + k.lane; i < 4096; i += NGW * 64) b1[i] = i < 2048 ? s.w0[l * 2048 + i] : s.a0[l * 2048 + i - 2048]; }
    {
        u32x4* wl = (u32x4*)(ws + WT_L1);
        for (int i = gw * 64 + k.lane; i < 4096 * 32; i += NGW * 64) { const int row = i >> 5, ck = i & 31; if (row < 2048 ? ck >= 16 : (ck < 12 || ck >= 28)) wl[i] = (u32x4){0u, 0u, 0u, 0u}; }
        if (l == 0) { int* rt = (int*)(ws + WS_TAB + TAB_ROWTOK); for (int i = gw * 64 + k.lane; i < 2 * MOE_ROWS; i += NGW * 64) rt[i] = -1; }
    }
    float cur[32], nxt[32];
    int it = gw;
    TrItem tc = tr_decode(s, ws, l, it < TI_N ? it : 0);
    if (it < TI_N) tr_load(tc, k.lane, cur);
    for (; it < TI_N; it += NGW) {
        const bool more = it + NGW < TI_N;
        const TrItem tn = tr_decode(s, ws, l, more ? it + NGW : it);
        if (more) tr_load(tn, k.lane, nxt);
        tr_store(tc, k.lane, cur, scr);
        tc = tn;
#pragma unroll
        for (int i = 0; i < 32; ++i) cur[i] = nxt[i];
    }
}

constexpr int RWP = DM + 4;
struct RowArgs { const float *x_in, *ctx_in, *gvec, *router_w, *router_b; float* out; };
template <int MODE>
__device__ __forceinline__ void ph_rows(const KC& k, const RowArgs& ra, int l, int nrows, bool dry = false) {
    const int gw = k.bid * 8 + k.wave, NGW = k.G * 8, lane = k.lane;
    float* X = (float*)(k.ws + WS_X); bf16* H = (bf16*)(k.ws + WS_H);
    const float* MOD = (const float*)(k.ws + WS_MOD);
    const bf16* YF = (const bf16*)(k.ws + WS_YF);
    LAS float* rwT = (LAS float*)k.lds;
    if (MODE == 1) {
        for (int i = k.tid; i < DM * NEXP; i += 512) { const int c = i >> 4, e = i & 15; rwT[e * RWP + c] = ra.router_w[i]; }
        __syncthreads();
    }
    const float* gv = ra.gvec;
    for (int row = gw; row < nrows; row += NGW) {
        const int mr = mod_row(row);
        f32x4 v[8];
        if (MODE == 0 && l == 0) {
            const f32x4* src = (const f32x4*)(row < TL ? ra.x_in + (size_t)row * DM : ra.ctx_in + (size_t)(row - TL) * DM) + lane;
#pragma unroll
            for (int j = 0; j < 8; ++j) v[j] = src[64 * j];
        } else {
            const f32x4* src = (const f32x4*)(X + (size_t)row * DM) + lane;
#pragma unroll
            for (int j = 0; j < 8; ++j) v[j] = src[64 * j];
        }
        if ((MODE == 0 && l > 0) || MODE == 2) {
            const int lp = (MODE == 2) ? DEPTH - 1 : l - 1;
            const f32x4* gate = (const f32x4*)(MOD + ((size_t)lp * 9 + mr) * MOD_N + 5 * DM) + lane;
            const u32x2* y0 = (const u32x2*)(YF + (size_t)row * DM) + lane;
            const u32x2* y1 = (const u32x2*)(YF + ((size_t)TA + row) * DM) + lane;
#pragma unroll
            for (int j = 0; j < 8; ++j) {
                const f32x4 g = gate[64 * j]; const u32x2 a = y0[64 * j], b = y1[64 * j];
                v[j].x += g.x * (bflo(a.x) + bflo(b.x)); v[j].y += g.y * (bfhi(a.x) + bfhi(b.x));
                v[j].z += g.z * (bflo(a.y) + bflo(b.y)); v[j].w += g.w * (bfhi(a.y) + bfhi(b.y));
            }
        }
        if (MODE == 0) {
            f32x4* dst = (f32x4*)(X + (size_t)row * DM) + lane;
#pragma unroll
            for (int j = 0; j < 8; ++j) dst[64 * j] = v[j];
        }
        float ss = 0.f;
#pragma unroll
        for (int j = 0; j < 8; ++j) ss += (v[j].x * v[j].x + v[j].y * v[j].y) + (v[j].z * v[j].z + v[j].w * v[j].w);
        const float rinv = 1.0f / sqrtf(wave_sum(ss) * (1.0f / DM) + 1e-6f);
        if (MODE == 2) {
            f32x4* dst = (f32x4*)(ra.out + (size_t)row * DM) + lane; const f32x4* g4 = (const f32x4*)gv + lane;
#pragma unroll
            for (int j = 0; j < 8; ++j) { const f32x4 g = g4[64 * j]; dst[64 * j] = v[j] * rinv * g; }
        } else {
            const float* mrow = MOD + ((size_t)l * 9 + mr) * MOD_N + (MODE == 0 ? 0 : 3 * DM);
            const f32x4* sh4 = (const f32x4*)mrow + lane; const f32x4* sc4 = (const f32x4*)(mrow + DM) + lane; const f32x4* g4 = (const f32x4*)(gv + (size_t)l * DM) + lane;
            u32x2* dst = (u32x2*)(H + (size_t)row * DM) + lane;
#pragma unroll
            for (int j = 0; j < 8; ++j) {
                const f32x4 g = g4[64 * j], sh = sh4[64 * j], sc = sc4[64 * j];
                v[j] = v[j] * rinv * g * (1.0f + sc) + sh;
                u32x2 o; o.x = pk2(v[j].x, v[j].y); o.y = pk2(v[j].z, v[j].w); dst[64 * j] = o;
            }
        }
        if (MODE == 1) {
            float lg[NEXP];
#pragma unroll
            for (int e = 0; e < NEXP; ++e) {
                float s = 0.f;
#pragma unroll
                for (int j = 0; j < 8; ++j) { const f32x4 w = *(const LAS f32x4*)(rwT + e * RWP + 4 * lane + 256 * j); s += (v[j].x * w.x + v[j].y * w.y) + (v[j].z * w.z + v[j].w * w.w); }
                lg[e] = wave_sum(s);
            }
            float sc[NEXP], sel[NEXP];
#pragma unroll
            for (int e = 0; e < NEXP; ++e) { sc[e] = 1.0f / (1.0f + expf(-lg[e])); sel[e] = sc[e] + ra.router_b[e]; }
            float gs[4], w1g[4], w2g[4]; int i1g[4], i2g[4];
#pragma unroll
            for (int g = 0; g < 4; ++g) {
                int i1 = 0; float m1 = sel[4 * g];
#pragma unroll
                for (int q = 1; q < 4; ++q) if (sel[4 * g + q] > m1) { m1 = sel[4 * g + q]; i1 = q; }
                int i2 = -1; float m2 = -3.0e38f;
#pragma unroll
                for (int q = 0; q < 4; ++q) if (q != i1 && sel[4 * g + q] > m2) { m2 = sel[4 * g + q]; i2 = q; }
                gs[g] = m1 + m2; i1g[g] = 4 * g + i1; i2g[g] = 4 * g + i2;
                float a1 = sc[4 * g], a2 = sc[4 * g];
#pragma unroll
                for (int q = 0; q < 4; ++q) { a1 = (q == i1) ? sc[4 * g + q] : a1; a2 = (q == i2) ? sc[4 * g + q] : a2; }
                w1g[g] = a1; w2g[g] = a2;
            }
            int best = 0; float bs = gs[0];
#pragma unroll
            for (int g = 1; g < 4; ++g) if (gs[g] > bs) { bs = gs[g]; best = g; }
            int e1 = i1g[0], e2 = i2g[0]; float w1 = w1g[0], w2 = w2g[0];
#pragma unroll
            for (int g = 1; g < 4; ++g) { e1 = (best == g) ? i1g[g] : e1; e2 = (best == g) ? i2g[g] : e2; w1 = (best == g) ? w1g[g] : w1; w2 = (best == g) ? w2g[g] : w2; }
            const float inv = 1.0f / (w1 + w2);
            if (lane == 0 && !dry) {
                unsigned* cnt = (unsigned*)(k.ws + WS_CTL) + CW_CNT + 64 * l;
                const int p1 = (int)atomicAdd(cnt + e1, 1u), p2 = (int)atomicAdd(cnt + e2, 1u);
                int* te = (int*)(k.ws + WS_TOPK); float* tw = (float*)(k.ws + WS_TOPK + (size_t)TA * 8); int* tp = (int*)(k.ws + WS_TOPK + 2 * (size_t)TA * 8);
                te[2 * row] = e1; te[2 * row + 1] = e2; tw[2 * row] = w1 * inv; tw[2 * row + 1] = w2 * inv; tp[2 * row] = p1; tp[2 * row + 1] = p2;
            }
        }
    }
    if (MODE == 1) __syncthreads();
}

__device__ __forceinline__ void ph_moe_scatter(const KC& k, int l, int nrows) {
    LAS int* offs = (LAS int*)k.lds;
    const unsigned* cnt = (const unsigned*)(k.ws + WS_CTL) + CW_CNT + 64 * l;
    int* tile = (int*)(k.ws + WS_TAB + TAB_TILE) + 256 * l;
    if (k.tid == 0) {
        int off = 0, nt = 0;
        for (int e = 0; e < NEXP; ++e) {
            offs[e] = off; const int c = (int)__hip_atomic_load(cnt + e, __ATOMIC_RELAXED, __HIP_MEMORY_SCOPE_AGENT); const int t = (c + 255) >> 8;
            if (k.bid == 0) for (int q = 0; q < t; ++q) tile[1 + nt + q] = e;
            nt += t; off += t * 256;
        }
        if (k.bid == 0) tile[0] = nt;
    }
    __syncthreads();
    const int gw = k.bid * 8 + k.wave, NGW = k.G * 8, lane = k.lane;
    const bf16* H = (const bf16*)(k.ws + WS_H); bf16* HP = (bf16*)(k.ws + WS_HP);
    const int* te = (const int*)(k.ws + WS_TOPK); const float* tw = (const float*)(k.ws + WS_TOPK + (size_t)TA * 8); const int* tp = (const int*)(k.ws + WS_TOPK + 2 * (size_t)TA * 8);
    int* rowtok = (int*)(k.ws + WS_TAB + TAB_ROWTOK) + (size_t)l * MOE_ROWS; float* roww = (float*)(k.ws + WS_TAB + TAB_ROWW) + (size_t)l * MOE_ROWS;
    for (int row = gw; row < nrows; row += NGW) {
        const u32x4* src = (const u32x4*)(H + (size_t)row * DM) + lane;
        u32x4 d[4];
#pragma unroll
        for (int j = 0; j < 4; ++j) d[j] = src[64 * j];
#pragma unroll
        for (int s = 0; s < 2; ++s) {
            const int e = te[2 * row + s], dest = offs[e] + tp[2 * row + s];
            u32x4* dp = (u32x4*)(HP + (size_t)dest * DM) + lane;
#pragma unroll
            for (int j = 0; j < 4; ++j) dp[64 * j] = d[j];
            if (lane == 0) { rowtok[dest] = 2 * row + s; roww[dest] = tw[2 * row + s]; }
        }
    }
    __syncthreads();
}
__device__ __forceinline__ void ld16(const bf16* p, bool ok, float (&o)[16]) {
    if (ok) { const u32x4 a = *(const u32x4*)p, b = *(const u32x4*)(p + 8); float x[8], y[8]; unpack8(a, x); unpack8(b, y);
#pragma unroll
        for (int i = 0; i < 8; ++i) { o[i] = x[i]; o[8 + i] = y[i]; } }
    else {
#pragma unroll
        for (int i = 0; i < 16; ++i) o[i] = 0.f; }
}
__device__ __forceinline__ void st16(bf16* p, const float (&v)[16]) {
    float a[8], b[8];
#pragma unroll
    for (int i = 0; i < 8; ++i) { a[i] = v[i]; b[i] = v[8 + i]; }
    *(u32x4*)p = pack8(a); *(u32x4*)(p + 8) = pack8(b);
}
__device__ __forceinline__ void shift8(const bf16* p0, bool hp, bool hn, int c, const float* mu0, const float* mu1, float (&s)[8]) {
    float x[8], xm[8], xp[8];
    unpack8(*(const u32x4*)(p0 + c), x);
    if (hp) unpack8(*(const u32x4*)(p0 - NP + c), xm); else {
#pragma unroll
        for (int i = 0; i < 8; ++i) xm[i] = 0.f; }
    if (hn) unpack8(*(const u32x4*)(p0 + NP + c), xp); else {
#pragma unroll
        for (int i = 0; i < 8; ++i) xp[i] = 0.f; }
    const f32x4 m0a = *(const f32x4*)(mu0 + c), m0b = *(const f32x4*)(mu0 + c + 4), m1a = *(const f32x4*)(mu1 + c), m1b = *(const f32x4*)(mu1 + c + 4);
    const float m0[8] = {m0a.x, m0a.y, m0a.z, m0a.w, m0b.x, m0b.y, m0b.z, m0b.w}, m1[8] = {m1a.x, m1a.y, m1a.z, m1a.w, m1b.x, m1b.y, m1b.z, m1b.w};
#pragma unroll
    for (int i = 0; i < 8; ++i) s[i] = x[i] + m0[i] * (xm[i] - x[i]) + m1[i] * (xp[i] - x[i]);
}
__device__ __forceinline__ void ph_rwkv_prep(const KC& k, int l, int nrows, const float* mu, const float* k_k, const float* r_k) {
    const int gw = k.bid * 8 + k.wave, NGW = k.G * 8, lane = k.lane;
    const bf16* P = (const bf16*)(k.ws + WS_P);
    bf16* R = (bf16*)(k.ws + RW_R); bf16* KS = (bf16*)(k.ws + RW_KS); bf16* V = (bf16*)(k.ws + RW_V); bf16* KK = (bf16*)(k.ws + RW_KK);
    bf16* A1 = (bf16*)(k.ws + RW_A1); bf16* A2 = (bf16*)(k.ws + RW_A2); float* BON = (float*)(k.ws + RW_BON);
    const float* mu0 = mu + (size_t)(l * 2 + 0) * RWKV_IN; const float* mu1 = mu + (size_t)(l * 2 + 1) * RWKV_IN;
    const int rpw = (nrows + NGW - 1) / NGW;
    for (int row = gw * rpw; row < nrows && row < (gw + 1) * rpw; ++row) {
        int t, len; if (row < TL) { t = row & (SEQ - 1); len = SEQ; } else { t = (row - TL) & (CTXL - 1); len = CTXL; }
        const bool hp = t > 0, hn = t < len - 1;
        const bf16* p0 = P + (size_t)row * NP;
#pragma unroll
        for (int half = 0; half < 2; ++half) {
            const int c = half * 512 + 8 * lane;
            float r[8], kx[8], vv[8], kk[8];
            shift8(p0, hp, hn, c, mu0, mu1, r);
            shift8(p0, hp, hn, RD + c, mu0, mu1, kx);
            shift8(p0, hp, hn, 2 * RD + c, mu0, mu1, vv);
            const f32x4 kka = *(const f32x4*)(k_k + l * RD + c), kkb = *(const f32x4*)(k_k + l * RD + c + 4), rka = *(const f32x4*)(r_k + l * RD + c), rkb = *(const f32x4*)(r_k + l * RD + c + 4);
            const float kkw[8] = {kka.x, kka.y, kka.z, kka.w, kkb.x, kkb.y, kkb.z, kkb.w}, rkw[8] = {rka.x, rka.y, rka.z, rka.w, rkb.x, rkb.y, rkb.z, rkb.w};
            float ss = 0.f, bon = 0.f;
#pragma unroll
            for (int i = 0; i < 8; ++i) { kk[i] = kx[i] * kkw[i]; ss += kk[i] * kk[i]; bon += r[i] * kx[i] * rkw[i]; }
            ss += __shfl_xor(ss, 1); ss += __shfl_xor(ss, 2); ss += __shfl_xor(ss, 4);
            bon += __shfl_xor(bon, 1); bon += __shfl_xor(bon, 2); bon += __shfl_xor(bon, 4);
            const float inv = 1.0f / fmaxf(sqrtf(ss), 1e-12f);
#pragma unroll
            for (int i = 0; i < 8; ++i) kk[i] *= inv;
            *(u32x4*)(R + (size_t)row * RD + c) = pack8(r); *(u32x4*)(KS + (size_t)row * RD + c) = pack8(kx);
            *(u32x4*)(V + (size_t)row * RD + c) = pack8(vv); *(u32x4*)(KK + (size_t)row * RD + c) = pack8(kk);
            if ((lane & 7) == 0) BON[(size_t)row * RHEADS + half * 8 + (lane >> 3)] = bon;
        }
        if (lane < 56) {
            float s8[8];
            shift8(p0, hp, hn, 3 * RD + 8 * lane, mu0, mu1, s8);
            if (lane < 12) {
#pragma unroll
                for (int i = 0; i < 8; ++i) { const float e2 = __expf(2.0f * fminf(fmaxf(s8[i], -15.f), 15.f)); s8[i] = 1.0f - 2.0f / (e2 + 1.0f); }
                *(u32x4*)(A1 + (size_t)row * 256 + 8 * lane) = pack8(s8);
            } else if (lane < 24) { *(u32x4*)(A1 + (size_t)row * 256 + 8 * lane) = pack8(s8); }
            else {
#pragma unroll
                for (int i = 0; i < 8; ++i) s8[i] = sigm(s8[i]);
                *(u32x4*)(A2 + (size_t)row * 256 + 8 * (lane - 24)) = pack8(s8);
            }
        } else { *(u32x4*)(A1 + (size_t)row * 256 + 192 + 8 * (lane - 56)) = (u32x4){0u, 0u, 0u, 0u}; }
    }
}

__device__ __forceinline__ float logsig(float x) { return fminf(x, 0.f) - __logf(1.0f + __expf(-fabsf(x))); }
__device__ __forceinline__ int gla_row(bool lat, int b, int s) { return lat ? b * SEQ + (s & 31) * 64 + (s >> 5) : TL + b * CTXL + s; }
constexpr int GQ_PITCH = 264;
constexpr int GPL_AD = 0, GPL_GS = 4096, GPL_QK = GPL_GS + 65536, GPL_END = GPL_QK + 66 * GQ_PITCH * 2;
static_assert(GPL_END <= 131072, "gla prep lds");
__device__ __forceinline__ void ph_gla_prep(const KC& k, int l, const float* conv, const float* aw2, const float* ab) {
    const bf16* P = (const bf16*)(k.ws + WS_P);
    bf16* QG = (bf16*)(k.ws + GL_QG); bf16* KG = (bf16*)(k.ws + GL_KG); bf16* KE = (bf16*)(k.ws + GL_KE); bf16* VS = (bf16*)(k.ws + GL_VS); float* DEC = (float*)(k.ws + GL_DEC);
    const float* cw = conv + (size_t)l * 3 * GQKV;
    const int tid = k.tid, lane = k.lane;
    {
        const int gw = k.bid * 8 + k.wave, NGW = k.G * 8, c = 16 * lane;
        const int rpw = (TA + NGW - 1) / NGW;
        for (int qi = gw * rpw; qi < TA && qi < (gw + 1) * rpw; ++qi) {
            const bool lat = qi < TL; int b, s, len;
            if (lat) { b = qi >> 11; s = qi & 2047; len = SEQ; } else { b = (qi - TL) >> 8; s = (qi - TL) & 255; len = CTXL; }
            const int row = gla_row(lat, b, s);
            const bool hp = s > 0, hn = s + 1 < len;
            const bf16* p0 = P + (size_t)row * NP + GLA_OFF + 2 * GKD + c;
            const bf16* pm = P + (size_t)gla_row(lat, b, hp ? s - 1 : s) * NP + GLA_OFF + 2 * GKD + c;
            const bf16* pp = P + (size_t)gla_row(lat, b, hn ? s + 1 : s) * NP + GLA_OFF + 2 * GKD + c;
            float o[16];
#pragma unroll
            for (int hf = 0; hf < 2; ++hf) {
                float x[8], xm[8], xp[8];
                unpack8(*(const u32x4*)(p0 + 8 * hf), x); unpack8(*(const u32x4*)(pm + 8 * hf), xm); unpack8(*(const u32x4*)(pp + 8 * hf), xp);
                const float* w = cw + 2 * GKD + c + 8 * hf;
#pragma unroll
                for (int q = 0; q < 2; ++q) {
                    const f32x4 w0 = *(const f32x4*)(w + 4 * q), w1 = *(const f32x4*)(w + GQKV + 4 * q), w2 = *(const f32x4*)(w + 2 * GQKV + 4 * q);
#pragma unroll
                    for (int i = 0; i < 4; ++i) o[8 * hf + 4 * q + i] = siluf(w0[i] * (hp ? xm[4 * q + i] : 0.f) + w1[i] * x[4 * q + i] + w2[i] * (hn ? xp[4 * q + i] : 0.f));
                }
            }
            st16(VS + (size_t)row * GVD + c, o);
        }
    }
    LAS float* ADs = (LAS float*)(k.lds + GPL_AD);
    LAS float* Gs = (LAS float*)(k.lds + GPL_GS);
    LAS bf16* QKs = (LAS bf16*)(k.lds + GPL_QK);
    for (int item = k.bid; item < 288 * 4; item += k.G) {
        const int sc = item >> 2, h = item & 3;
        const bool lat = sc < 256; const int b = lat ? (sc >> 5) : ((sc - 256) >> 2), cn = lat ? (sc & 31) : ((sc - 256) & 3), len = lat ? SEQ : CTXL;
        const int gch = lat ? 4 + cn : cn, s0 = 64 * cn;
        for (int i = tid; i < 1024; i += 512) { const int tau = i >> 4, j = i & 15; ADs[i] = bf2f(P[(size_t)gla_row(lat, b, s0 + tau) * NP + GLA_AD_OFF + j]); }
        for (int i = tid; i < 66 * 32; i += 512) {
            const int rr = i >> 5, ck = i & 31, s = s0 - 1 + rr;
            u32x4 v = (u32x4){0u, 0u, 0u, 0u};
            if (s >= 0 && s < len) v = *(const u32x4*)(P + (size_t)gla_row(lat, b, s) * NP + GLA_OFF + (ck >> 4) * GKD + h * GDK + (ck & 15) * 8);
            *(LAS u32x4*)(QKs + rr * GQ_PITCH + ck * 8) = v;
        }
        __syncthreads();
        {
            const int c = tid & 127, tg = tid >> 7, chl = h * GDK + c;
            float awf[16], awb[16];
#pragma unroll
            for (int j = 0; j < 16; ++j) { awf[j] = aw2[((size_t)(l * 2 + 0) * 16 + j) * GKD + chl]; awb[j] = aw2[((size_t)(l * 2 + 1) * 16 + j) * GKD + chl]; }
            const float abf = ab[(l * 2 + 0) * GKD + chl], abb = ab[(l * 2 + 1) * GKD + chl];
            for (int i = 0; i < 16; ++i) {
                const int tau = 16 * tg + i; float xf = abf, xb = abb;
#pragma unroll
                for (int j = 0; j < 16; ++j) { const float a = ADs[tau * 16 + j]; xf += a * awf[j]; xb += a * awb[j]; }
                Gs[tau * 128 + c] = logsig(xf) * (1.0f / 16.0f); Gs[(64 + tau) * 128 + c] = logsig(xb) * (1.0f / 16.0f);
            }
        }
        __syncthreads();
        if (tid < 128) { float run = 0.f; for (int tau = 0; tau < 64; ++tau) { run += Gs[tau * 128 + tid]; Gs[tau * 128 + tid] = run; } }
        else if (tid < 256) { const int c = tid - 128; float run = 0.f; for (int tau = 63; tau >= 0; --tau) { run += Gs[(64 + tau) * 128 + c]; Gs[(64 + tau) * 128 + c] = run; } }
        __syncthreads();
        {
            const int c8 = tid & 15, tg = tid >> 4, chl = h * GDK + 8 * c8;
            float wq[3][8], wk[3][8], elf[8], elb[8];
#pragma unroll
            for (int tp = 0; tp < 3; ++tp) {
                const f32x4 a0 = *(const f32x4*)(cw + tp * GQKV + chl), a1 = *(const f32x4*)(cw + tp * GQKV + chl + 4), b0 = *(const f32x4*)(cw + tp * GQKV + GKD + chl), b1 = *(const f32x4*)(cw + tp * GQKV + GKD + chl + 4);
#pragma unroll
                for (int i = 0; i < 4; ++i) { wq[tp][i] = a0[i]; wq[tp][4 + i] = a1[i]; wk[tp][i] = b0[i]; wk[tp][4 + i] = b1[i]; }
            }
            {
                const f32x4 a0 = *(const LAS f32x4*)(Gs + 63 * 128 + 8 * c8), a1 = *(const LAS f32x4*)(Gs + 63 * 128 + 8 * c8 + 4), b0 = *(const LAS f32x4*)(Gs + 64 * 128 + 8 * c8), b1 = *(const LAS f32x4*)(Gs + 64 * 128 + 8 * c8 + 4);
#pragma unroll
                for (int i = 0; i < 4; ++i) { elf[i] = __expf(a0[i]); elf[4 + i] = __expf(a1[i]); elb[i] = __expf(b0[i]); elb[4 + i] = __expf(b1[i]); }
            }
            if (tg < 8) {
                float* d0 = DEC + ((size_t)(0 * 8 + b) * NCH + gch) * GKD + chl; float* d1 = DEC + ((size_t)(1 * 8 + b) * NCH + gch) * GKD + chl;
                if (tg == 0) { *(f32x4*)d0 = (f32x4){elf[0], elf[1], elf[2], elf[3]}; *(f32x4*)(d0 + 4) = (f32x4){elf[4], elf[5], elf[6], elf[7]}; }
                if (tg == 1) { *(f32x4*)d1 = (f32x4){elb[0], elb[1], elb[2], elb[3]}; *(f32x4*)(d1 + 4) = (f32x4){elb[4], elb[5], elb[6], elb[7]}; }
            }
#pragma unroll
            for (int pass = 0; pass < 2; ++pass) {
                const int tau = tg + 32 * pass;
                float qm[8], q0[8], qp[8], km[8], k0[8], kp[8];
                unpack8(*(const LAS u32x4*)(QKs + (tau + 0) * GQ_PITCH + 8 * c8), qm); unpack8(*(const LAS u32x4*)(QKs + (tau + 1) * GQ_PITCH + 8 * c8), q0); unpack8(*(const LAS u32x4*)(QKs + (tau + 2) * GQ_PITCH + 8 * c8), qp);
                unpack8(*(const LAS u32x4*)(QKs + (tau + 0) * GQ_PITCH + 128 + 8 * c8), km); unpack8(*(const LAS u32x4*)(QKs + (tau + 1) * GQ_PITCH + 128 + 8 * c8), k0); unpack8(*(const LAS u32x4*)(QKs + (tau + 2) * GQ_PITCH + 128 + 8 * c8), kp);
                const f32x4 f0 = *(const LAS f32x4*)(Gs + tau * 128 + 8 * c8), f1 = *(const LAS f32x4*)(Gs + tau * 128 + 8 * c8 + 4), g0 = *(const LAS f32x4*)(Gs + (64 + tau) * 128 + 8 * c8), g1 = *(const LAS f32x4*)(Gs + (64 + tau) * 128 + 8 * c8 + 4);
                const float cf[8] = {f0.x, f0.y, f0.z, f0.w, f1.x, f1.y, f1.z, f1.w}, cb[8] = {g0.x, g0.y, g0.z, g0.w, g1.x, g1.y, g1.z, g1.w};
                float oqf[8], okf[8], oef[8], oqb[8], okb[8], oeb[8];
#pragma unroll
                for (int i = 0; i < 8; ++i) {
                    const float qv = siluf(wq[0][i] * qm[i] + wq[1][i] * q0[i] + wq[2][i] * qp[i]) * 0.08838834764831845f;
                    const float kv = siluf(wk[0][i] * km[i] + wk[1][i] * k0[i] + wk[2][i] * kp[i]);
                    const float ef = __expf(cf[i]), eb = __expf(cb[i]), rf = 1.0f / ef, rb = 1.0f / eb;
                    oqf[i] = qv * ef; okf[i] = kv * rf; oef[i] = kv * rf * elf[i];
                    oqb[i] = qv * eb; okb[i] = kv * rb; oeb[i] = kv * rb * elb[i];
                }
                const size_t o = (size_t)gla_row(lat, b, s0 + tau) * GKD + chl;
                *(u32x4*)(QG + o) = pack8(oqf); *(u32x4*)(KG + o) = pack8(okf); *(u32x4*)(KE + o) = pack8(oef);
                *(u32x4*)(QG + (size_t)TA * GKD + o) = pack8(oqb); *(u32x4*)(KG + (size_t)TA * GKD + o) = pack8(okb); *(u32x4*)(KE + (size_t)TA * GKD + o) = pack8(oeb);
            }
        }
        __syncthreads();
    }
}

__device__ __forceinline__ float dpp_sum16(float x) {
    x += __builtin_bit_cast(float, __builtin_amdgcn_update_dpp(0, __builtin_bit_cast(int, x), 0xB1, 0xF, 0xF, true));
    x += __builtin_bit_cast(float, __builtin_amdgcn_update_dpp(0, __builtin_bit_cast(int, x), 0x4E, 0xF, 0xF, true));
    x += __builtin_bit_cast(float, __builtin_amdgcn_update_dpp(0, __builtin_bit_cast(int, x), 0x141, 0xF, 0xF, true));
    x += __builtin_bit_cast(float, __builtin_amdgcn_update_dpp(0, __builtin_bit_cast(int, x), 0x140, 0xF, 0xF, true));
    return x;
}
constexpr int RS_TOK = 16;
constexpr int RS_TF = 6 * 64;
constexpr int RS_BUF = RS_TOK * RS_TF;
struct RwkvStage { unsigned r, we, a, ks, v, kk; };
__device__ __forceinline__ int rwkv_row(int b, int dir, int p) {
    if (p < CTXL) { const int t = dir ? CTXL - 1 - p : p; return TL + b * CTXL + t; }
    const int q = p - CTXL, t = dir ? SEQ - 1 - q : q; return b * SEQ + t;
}
__device__ __forceinline__ void ph_rwkv_scan(const KC& k, int l, int job, const float* k_a, size_t yoff = RW_Y) {
    const int b = job >> 5, h = (job >> 1) & 15, dir = job & 1;
    const int tid = k.tid;
    const bf16* R = (const bf16*)(k.ws + RW_R); const bf16* KS = (const bf16*)(k.ws + RW_KS); const bf16* V = (const bf16*)(k.ws + RW_V); const bf16* KK = (const bf16*)(k.ws + RW_KK);
    const bf16* LO = (const bf16*)(k.ws + RW_LO); bf16* Y = (bf16*)(k.ws + yoff) + (size_t)dir * TA * RD;
    LAS float* buf = (LAS float*)k.lds;
    LAS f32x2* ypart = (LAS f32x2*)(buf + 2 * RS_BUF);
    const int st = tid >> 5, cp = tid & 31, ch = h * RHS + 2 * cp;
    const float ka0 = k_a[l * RD + ch], ka1 = k_a[l * RD + ch + 1];
    const int kq = tid & 15, rp = tid >> 4, v0 = rp * 2;
    f32x2 S00 = {0.f, 0.f}, S01 = {0.f, 0.f}, S10 = {0.f, 0.f}, S11 = {0.f, 0.f};
    RwkvStage sg;
#define RW_LOAD(chunk) do { const int row_ = rwkv_row(b, dir, (chunk) * RS_TOK + st); \
        sg.r = *(const unsigned*)(R + (size_t)row_ * RD + ch); sg.ks = *(const unsigned*)(KS + (size_t)row_ * RD + ch); \
        sg.v = *(const unsigned*)(V + (size_t)row_ * RD + ch); sg.kk = *(const unsigned*)(KK + (size_t)row_ * RD + ch); \
        sg.we = *(const unsigned*)(LO + (size_t)row_ * 4096 + dir * RD + ch); sg.a = *(const unsigned*)(LO + (size_t)row_ * 4096 + 2048 + dir * RD + ch); } while (0)
#define RW_WRITE(bi) do { LAS float* tb = buf + (bi) * RS_BUF + st * RS_TF + 2 * cp; \
        const float a0 = bflo(sg.a), a1 = bfhi(sg.a), kk0 = bflo(sg.kk), kk1 = bfhi(sg.kk), ks0 = bflo(sg.ks), ks1 = bfhi(sg.ks); \
        *(LAS f32x2*)(tb + 0) = (f32x2){kk0, kk1}; \
        *(LAS f32x2*)(tb + 64) = (f32x2){__expf(-bflo(sg.we)), __expf(-bfhi(sg.we))}; \
        *(LAS f32x2*)(tb + 128) = (f32x2){-kk0 * a0, -kk1 * a1}; \
        *(LAS f32x2*)(tb + 192) = (f32x2){ks0 * (1.0f + (a0 - 1.0f) * ka0), ks1 * (1.0f + (a1 - 1.0f) * ka1)}; \
        *(LAS f32x2*)(tb + 256) = (f32x2){bflo(sg.r), bfhi(sg.r)}; \
        *(LAS f32x2*)(tb + 320) = (f32x2){bflo(sg.v), bfhi(sg.v)}; } while (0)
    constexpr int NCHUNK = (CTXL + SEQ) / RS_TOK;
    RW_LOAD(0); RW_WRITE(0);
    __syncthreads();
    for (int c = 0; c < NCHUNK; ++c) {
        if (c + 1 < NCHUNK) RW_LOAD(c + 1);
        const LAS float* cb = buf + (c & 1) * RS_BUF; LAS f32x2* yb = ypart + (c & 1) * RS_TOK * 256 + rp * 8 + (((kq >> 1) ^ (rp >> 2)) & 7);
        {
            const LAS float* tk = cb + kq * 4; const LAS float* tv = cb + 320 + v0;
#define RW_LD(T, kk4, w4, n4, d4, r4, vv) f32x4 kk4 = *(const LAS f32x4*)(tk + (T) * RS_TF), w4 = *(const LAS f32x4*)(tk + (T) * RS_TF + 64), n4 = *(const LAS f32x4*)(tk + (T) * RS_TF + 128), \
                d4 = *(const LAS f32x4*)(tk + (T) * RS_TF + 192), r4 = *(const LAS f32x4*)(tk + (T) * RS_TF + 256); f32x2 vv = *(const LAS f32x2*)(tv + (T) * RS_TF)
#define RW_STEP(T, kk4, w4, n4, d4, r4, vv) do { \
                const f32x2 kka = {kk4.x, kk4.y}, kkb = {kk4.z, kk4.w}, wa = {w4.x, w4.y}, wb = {w4.z, w4.w}, na = {n4.x, n4.y}, nb = {n4.z, n4.w}, da = {d4.x, d4.y}, db = {d4.z, d4.w}, ra = {r4.x, r4.y}, rb = {r4.z, r4.w}; \
                f32x2 p0 = S00 * kka + S01 * kkb, p1 = S10 * kka + S11 * kkb; \
                const f32x2 u00 = S00 * wa + da * vv.x, u01 = S01 * wb + db * vv.x, u10 = S10 * wa + da * vv.y, u11 = S11 * wb + db * vv.y;     \
                const float sa0 = dpp_sum16(p0.x + p0.y), sa1 = dpp_sum16(p1.x + p1.y); \
                S00 = na * sa0 + u00; S01 = nb * sa0 + u01; S10 = na * sa1 + u10; S11 = nb * sa1 + u11; \
                p0 = S00 * ra + S01 * rb; p1 = S10 * ra + S11 * rb; \
                float y0 = p0.x + p0.y, y1 = p1.x + p1.y; \
                y0 += __builtin_bit_cast(float, __builtin_amdgcn_update_dpp(0, __builtin_bit_cast(int, y0), 0xB1, 0xF, 0xF, true)); \
                y1 += __builtin_bit_cast(float, __builtin_amdgcn_update_dpp(0, __builtin_bit_cast(int, y1), 0xB1, 0xF, 0xF, true)); \
                if ((kq & 1) == 0) yb[(T) * 256] = (f32x2){y0, y1}; } while (0)
            RW_LD(0, kkA, wA, nA, dA, rA, vA);
#pragma unroll
            for (int tau = 0; tau < RS_TOK; tau += 2) {
                RW_LD(tau + 1, kkB, wB, nB, dB, rB, vB);
                RW_STEP(tau, kkA, wA, nA, dA, rA, vA);
                if (tau + 2 < RS_TOK) { RW_LD(tau + 2, kkC, wC, nC, dC, rC, vC); kkA = kkC; wA = wC; nA = nC; dA = dC; rA = rC; vA = vC; }
                RW_STEP(tau + 1, kkB, wB, nB, dB, rB, vB);
            }
#undef RW_LD
#undef RW_STEP
        }
        if (c + 1 < NCHUNK) RW_WRITE((c + 1) & 1);
        __syncthreads();
        {
            const int row = rwkv_row(b, dir, c * RS_TOK + st);
            const LAS f32x2* yq = ypart + (c & 1) * RS_TOK * 256 + st * 256 + cp * 8;
            f32x2 acc = yq[(0 ^ (cp >> 2)) & 7];
#pragma unroll
            for (int j = 1; j < 8; ++j) acc += yq[(j ^ (cp >> 2)) & 7];
            *(unsigned*)(Y + (size_t)row * RD + ch) = pk2(acc.x, acc.y);
        }
    }
    __syncthreads();
}

constexpr int GP1 = 136, GP2 = 72;
constexpr int GL_QGS = 0, GL_KGS = GL_QGS + 64 * GP1 * 2, GL_STS = GL_KGS + 64 * GP1 * 2, GL_KET = GL_STS + 64 * GP1 * 2, GL_VT = GL_KET + 128 * GP2 * 2, GL_ATT = GL_VT + 64 * GP2 * 2,
              GL_DECS = GL_ATT + 64 * GP2 * 2, GL_LDS_END = GL_DECS + 512;
static_assert(GL_LDS_END <= 131072, "gla lds");
__device__ __forceinline__ bf16x8 ldfrag(const LAS bf16* base, int row, int pitch, int kofs) { return *(const LAS bf16x8*)(base + row * pitch + kofs); }
__device__ __forceinline__ int gla_prow(int b, int dir, int cp, int tau) {
    const bool lat = cp >= 4; const int q = lat ? cp - 4 : cp, ncn = lat ? 32 : 4, cn = dir ? ncn - 1 - q : q;
    return gla_row(lat, b, dir ? 64 * cn + 63 - tau : 64 * cn + tau);
}
__device__ __forceinline__ int gla_gch(int dir, int cp) { const bool lat = cp >= 4; const int q = lat ? cp - 4 : cp, ncn = lat ? 32 : 4, cn = dir ? ncn - 1 - q : q; return lat ? 4 + cn : cn; }
__device__ __forceinline__ bf16x8 ldfrag_sw(const LAS bf16* base, int row, int g) { return *(const LAS bf16x8*)(base + row * GP2 + ((g ^ ((row >> 3) & 7)) << 3)); }
__device__ __forceinline__ void ph_gla_scan(const KC& k, int job) {
    const int b = job >> 5, h = (job >> 3) & 3, dir = (job >> 2) & 1, dvq = job & 3;
    const int tid = k.tid, w = k.wave, lane = k.lane, q4 = lane >> 4, l15 = lane & 15;
    const bf16* QG = (const bf16*)(k.ws + GL_QG) + (size_t)dir * TA * GKD; const bf16* KG = (const bf16*)(k.ws + GL_KG) + (size_t)dir * TA * GKD;
    const bf16* KE = (const bf16*)(k.ws + GL_KE) + (size_t)dir * TA * GKD; const bf16* VS = (const bf16*)(k.ws + GL_VS);
    const float* DEC = (const float*)(k.ws + GL_DEC); bf16* O = (bf16*)(k.ws + GL_O) + (size_t)dir * TA * GVD;
    LAS bf16* QGs = (LAS bf16*)(k.lds + GL_QGS); LAS bf16* KGs = (LAS bf16*)(k.lds + GL_KGS); LAS bf16* STs = (LAS bf16*)(k.lds + GL_STS);
    LAS bf16* KEt = (LAS bf16*)(k.lds + GL_KET); LAS bf16* Vt = (LAS bf16*)(k.lds + GL_VT); LAS bf16* ATT = (LAS bf16*)(k.lds + GL_ATT); LAS float* decs = (LAS float*)(k.lds + GL_DECS);
    f32x4 accS[4];
#pragma unroll
    for (int t = 0; t < 4; ++t) accS[t] = (f32x4){0.f, 0.f, 0.f, 0.f};
    const int tw = w & 3, wh = w >> 2;
    u32x4 pq[2], pk[2], pe[2], pv; float pd = 0.f;
#define GLA_PREFETCH(CP) do { _Pragma("unroll") for (int i = 0; i < 2; ++i) { const int idx = tid + 512 * i, tau = idx >> 4, ck = idx & 15; \
            const size_t go = (size_t)gla_prow(b, dir, (CP), tau) * GKD + h * GDK + ck * 8; pq[i] = *(const u32x4*)(QG + go); pk[i] = *(const u32x4*)(KG + go); pe[i] = *(const u32x4*)(KE + go); } \
        pv = *(const u32x4*)(VS + (size_t)gla_prow(b, dir, (CP), tid >> 3) * GVD + h * GDV + dvq * 64 + (tid & 7) * 8); \
        if (tid < 128) pd = DEC[((size_t)(dir * 8 + b) * NCH + gla_gch(dir, (CP))) * GKD + h * GDK + tid]; } while (0)
    GLA_PREFETCH(0);
    for (int cp = 0; cp < NCH; ++cp) {
#define GROW(tau) gla_prow(b, dir, cp, (tau))
#pragma unroll
        for (int i = 0; i < 2; ++i) {
            const int idx = tid + 512 * i, tau = idx >> 4, ck = idx & 15;
            *(LAS u32x4*)(QGs + tau * GP1 + ck * 8) = pq[i];
            *(LAS u32x4*)(KGs + tau * GP1 + ck * 8) = pk[i];
            const unsigned kw[4] = {pe[i].x, pe[i].y, pe[i].z, pe[i].w};
#pragma unroll
            for (int e = 0; e < 4; ++e) { const int ts = tau ^ ((ck & 7) << 3); KEt[(ck * 8 + 2 * e) * GP2 + ts] = (bf16)(kw[e] & 0xffffu); KEt[(ck * 8 + 2 * e + 1) * GP2 + ts] = (bf16)(kw[e] >> 16); }
        }
        {
            const int tau = tid >> 3, ck = tid & 7;
            const unsigned vw[4] = {pv.x, pv.y, pv.z, pv.w};
#pragma unroll
            for (int e = 0; e < 4; ++e) { const int ts = tau ^ (ck << 3); Vt[(ck * 8 + 2 * e) * GP2 + ts] = (bf16)(vw[e] & 0xffffu); Vt[(ck * 8 + 2 * e + 1) * GP2 + ts] = (bf16)(vw[e] >> 16); }
        }
        if (tid < 128) decs[tid] = pd;
#pragma unroll
        for (int t = 0; t < 4; ++t) {
            const int dkt = wh * 4 + t;
#pragma unroll
            for (int r = 0; r < 4; ++r) STs[(16 * tw + 4 * q4 + r) * GP1 + 16 * dkt + l15] = (bf16)f2bf(accS[t][r]);
        }
        __syncthreads();
        if (cp + 1 < NCH) GLA_PREFETCH(cp + 1);
#pragma unroll
        for (int jj = 0; jj < 2; ++jj) {
            const int it = tw, jt = wh * 2 + jj;
            f32x4 acc = (f32x4){0.f, 0.f, 0.f, 0.f};
#pragma unroll
            for (int ks = 0; ks < 4; ++ks) acc = __builtin_amdgcn_mfma_f32_16x16x32_bf16(ldfrag(QGs, 16 * it + l15, GP1, 32 * ks + 8 * q4), ldfrag(KGs, 16 * jt + l15, GP1, 32 * ks + 8 * q4), acc, 0, 0, 0);
#pragma unroll
            for (int r = 0; r < 4; ++r) { const int i = 16 * it + 4 * q4 + r, j = 16 * jt + l15; ATT[i * GP2 + j] = (bf16)f2bf(j <= i ? acc[r] : 0.f); }
        }
        __syncthreads();
#pragma unroll
        for (int dd = 0; dd < 2; ++dd) {
            const int it = tw, dvt = wh * 2 + dd;
            f32x4 acc = (f32x4){0.f, 0.f, 0.f, 0.f};
#pragma unroll
            for (int ks = 0; ks < 4; ++ks) acc = __builtin_amdgcn_mfma_f32_16x16x32_bf16(ldfrag(QGs, 16 * it + l15, GP1, 32 * ks + 8 * q4), ldfrag(STs, 16 * dvt + l15, GP1, 32 * ks + 8 * q4), acc, 0, 0, 0);
#pragma unroll
            for (int ks = 0; ks < 2; ++ks) acc = __builtin_amdgcn_mfma_f32_16x16x32_bf16(ldfrag(ATT, 16 * it + l15, GP2, 32 * ks + 8 * q4), ldfrag_sw(Vt, 16 * dvt + l15, 4 * ks + q4), acc, 0, 0, 0);
#pragma unroll
            for (int r = 0; r < 4; ++r) { const int i = 16 * it + 4 * q4 + r; O[(size_t)GROW(i) * GVD + h * GDV + dvq * 64 + 16 * dvt + l15] = (bf16)f2bf(acc[r]); }
        }
#pragma unroll
        for (int t = 0; t < 4; ++t) {
            const int dkt = wh * 4 + t; const float d = decs[16 * dkt + l15];
            accS[t] = accS[t] * d;
#pragma unroll
            for (int ks = 0; ks < 2; ++ks) accS[t] = __builtin_amdgcn_mfma_f32_16x16x32_bf16(ldfrag_sw(Vt, 16 * tw + l15, 4 * ks + q4), ldfrag_sw(KEt, 16 * dkt + l15, 4 * ks + q4), accS[t], 0, 0, 0);
        }
        __syncthreads();
#undef GROW
    }
#undef GLA_PREFETCH
}

#ifndef RWKV_MODE
#define RWKV_MODE 2
#endif
#ifndef HB_FULL
#define HB_FULL 0
#endif
#ifndef GLA4_LEVEL
#define GLA4_LEVEL 0
#endif
#ifndef GLA4_NOSTORE
#define GLA4_NOSTORE 0
#endif
#ifndef SWAP_HALVES
#define SWAP_HALVES 0
#endif
#ifndef SPLIT_SCAN
#define SPLIT_SCAN 0
#endif
constexpr int RS4_TOK = 8, RS4_BUF = RS4_TOK * RS_TF;
constexpr int SC_GL = 0;
constexpr int SC_RW = 96 * 1024;
constexpr int SC_END = SC_RW + 2 * RS4_BUF * 4 + 2 * RS4_TOK * 64 * 4;
static_assert(SC_GL + GL_LDS_END <= SC_RW, "scan lds halves");
constexpr int SC_CTR = 127 * 1024;
static_assert(SC_END <= SC_CTR && SC_CTR + 128 <= 131072, "scan lds");
__device__ __forceinline__ void half_bar(LAS unsigned* ctr, unsigned& gen, int lane) {
#if HB_FULL
    (void)ctr; (void)lane; gen += 4u; __syncthreads(); return;
#endif
    gen += 4u;
    __builtin_amdgcn_fence(__ATOMIC_RELEASE, "workgroup");
    if (lane == 0) __hip_atomic_fetch_add(ctr, 1u, __ATOMIC_RELAXED, __HIP_MEMORY_SCOPE_WORKGROUP);
    unsigned spins = 0;
    while (__hip_atomic_load(ctr, __ATOMIC_RELAXED, __HIP_MEMORY_SCOPE_WORKGROUP) < gen) { __builtin_amdgcn_s_sleep(1); if (++spins > (1u << 26)) break; }
    __builtin_amdgcn_fence(__ATOMIC_ACQUIRE, "workgroup");
}
#ifndef RW4_SHFL
#define RW4_SHFL 0
#endif
__device__ __forceinline__ float shfl_sum16(float x) { x += __shfl_xor(x, 1); x += __shfl_xor(x, 2); x += __shfl_xor(x, 4); x += __shfl_xor(x, 8); return x; }
#if RW4_SHFL
#define RW4_SUM16(x) shfl_sum16(x)
#else
#define RW4_SUM16(x) dpp_sum16(x)
#endif
__device__ __forceinline__ void rwkv_scan_4w(const KC& k, int l, int job, const float* k_a, LAS unsigned* ctr) {
    const int b = job >> 5, h = (job >> 1) & 15, dir = job & 1;
    const int tid = k.tid, lane = k.lane;
    const bf16* R = (const bf16*)(k.ws + RW_R); const bf16* KS = (const bf16*)(k.ws + RW_KS); const bf16* V = (const bf16*)(k.ws + RW_V); const bf16* KK = (const bf16*)(k.ws + RW_KK);
    const bf16* LO = (const bf16*)(k.ws + RW_LO); bf16* Y = (bf16*)(k.ws + RW_Y) + (size_t)dir * TA * RD;
    LAS float* buf = (LAS float*)(k.lds + SC_RW);
    LAS float* ybuf = buf + 2 * RS4_BUF;
    const int st = tid >> 5, cp = tid & 31, ch = h * RHS + 2 * cp;
    const float ka0 = k_a[l * RD + ch], ka1 = k_a[l * RD + ch + 1];
    const int kq = tid & 15, v0 = (tid >> 4) * 4;
    f32x2 S[4][2];
#pragma unroll
    for (int i = 0; i < 4; ++i) { S[i][0] = (f32x2){0.f, 0.f}; S[i][1] = (f32x2){0.f, 0.f}; }
    RwkvStage sg[1];
    unsigned gen = 0;
#define RW4_LOAD(chunk) do { _Pragma("unroll") for (int q_ = 0; q_ < 1; ++q_) { const int row_ = rwkv_row(b, dir, (chunk) * RS4_TOK + st); \
        sg[q_].r = *(const unsigned*)(R + (size_t)row_ * RD + ch); sg[q_].ks = *(const unsigned*)(KS + (size_t)row_ * RD + ch); \
        sg[q_].v = *(const unsigned*)(V + (size_t)row_ * RD + ch); sg[q_].kk = *(const unsigned*)(KK + (size_t)row_ * RD + ch); \
        sg[q_].we = *(const unsigned*)(LO + (size_t)row_ * 4096 + dir * RD + ch); sg[q_].a = *(const unsigned*)(LO + (size_t)row_ * 4096 + 2048 + dir * RD + ch); } } while (0)
#define RW4_WRITE(bi) do { _Pragma("unroll") for (int q_ = 0; q_ < 1; ++q_) { LAS float* tb = buf + (bi) * RS4_BUF + st * RS_TF + 2 * cp; \
        const float a0 = bflo(sg[q_].a), a1 = bfhi(sg[q_].a), kk0 = bflo(sg[q_].kk), kk1 = bfhi(sg[q_].kk), ks0 = bflo(sg[q_].ks), ks1 = bfhi(sg[q_].ks); \
        *(LAS f32x2*)(tb + 0) = (f32x2){kk0, kk1}; \
        *(LAS f32x2*)(tb + 64) = (f32x2){__expf(-bflo(sg[q_].we)), __expf(-bfhi(sg[q_].we))}; \
        *(LAS f32x2*)(tb + 128) = (f32x2){-kk0 * a0, -kk1 * a1}; \
        *(LAS f32x2*)(tb + 192) = (f32x2){ks0 * (1.0f + (a0 - 1.0f) * ka0), ks1 * (1.0f + (a1 - 1.0f) * ka1)}; \
        *(LAS f32x2*)(tb + 256) = (f32x2){bflo(sg[q_].r), bfhi(sg[q_].r)}; \
        *(LAS f32x2*)(tb + 320) = (f32x2){bflo(sg[q_].v), bfhi(sg[q_].v)}; } } while (0)
    constexpr int NCHUNK = (CTXL + SEQ) / RS4_TOK;
    RW4_LOAD(0); RW4_WRITE(0);
    half_bar(ctr, gen, lane);
    for (int c = 0; c < NCHUNK; ++c) {
        if (c + 1 < NCHUNK) RW4_LOAD(c + 1);
        const LAS float* cb = buf + (c & 1) * RS4_BUF; LAS float* yb = ybuf + (c & 1) * RS4_TOK * 64;
        {
            const LAS float* tk = cb + kq * 4; const LAS float* tv = cb + 320 + v0;
#define RW4_LD(T, kk4, w4, n4, d4, r4, vv) f32x4 kk4 = *(const LAS f32x4*)(tk + (T) * RS_TF), w4 = *(const LAS f32x4*)(tk + (T) * RS_TF + 64), n4 = *(const LAS f32x4*)(tk + (T) * RS_TF + 128), \
                d4 = *(const LAS f32x4*)(tk + (T) * RS_TF + 192), r4 = *(const LAS f32x4*)(tk + (T) * RS_TF + 256), vv = *(const LAS f32x4*)(tv + (T) * RS_TF)
#define RW4_STEP(T, kk4, w4, n4, d4, r4, vv) do { \
                const f32x2 kka = {kk4.x, kk4.y}, kkb = {kk4.z, kk4.w}, wa = {w4.x, w4.y}, wb = {w4.z, w4.w}, na = {n4.x, n4.y}, nb = {n4.z, n4.w}, da = {d4.x, d4.y}, db = {d4.z, d4.w}, ra = {r4.x, r4.y}, rb = {r4.z, r4.w}; \
                float sa[4], yy[4]; f32x2 u0[4], u1[4]; \
                _Pragma("unroll") for (int i = 0; i < 4; ++i) { const f32x2 p = S[i][0] * kka + S[i][1] * kkb; sa[i] = p.x + p.y; u0[i] = S[i][0] * wa + da * vv[i]; u1[i] = S[i][1] * wb + db * vv[i]; } \
                _Pragma("unroll") for (int i = 0; i < 4; ++i) sa[i] = RW4_SUM16(sa[i]); \
                _Pragma("unroll") for (int i = 0; i < 4; ++i) { S[i][0] = na * sa[i] + u0[i]; S[i][1] = nb * sa[i] + u1[i]; const f32x2 q = S[i][0] * ra + S[i][1] * rb; yy[i] = q.x + q.y; } \
                _Pragma("unroll") for (int i = 0; i < 4; ++i) yy[i] = RW4_SUM16(yy[i]); \
                if (kq == 0) *(LAS f32x4*)(yb + (T) * 64 + v0) = (f32x4){yy[0], yy[1], yy[2], yy[3]}; } while (0)
            RW4_LD(0, kkA, wA, nA, dA, rA, vA);
#pragma unroll
            for (int tau = 0; tau < RS4_TOK; tau += 2) {
                RW4_LD(tau + 1, kkB, wB, nB, dB, rB, vB);
                RW4_STEP(tau, kkA, wA, nA, dA, rA, vA);
                if (tau + 2 < RS4_TOK) { RW4_LD(tau + 2, kkC, wC, nC, dC, rC, vC); kkA = kkC; wA = wC; nA = nC; dA = dC; rA = rC; vA = vC; }
                RW4_STEP(tau + 1, kkB, wB, nB, dB, rB, vB);
            }
#undef RW4_LD
#undef RW4_STEP
        }
        if (c + 1 < NCHUNK) RW4_WRITE((c + 1) & 1);
        half_bar(ctr, gen, lane);
        {
            const int row = rwkv_row(b, dir, c * RS4_TOK + st);
            const f32x2 yy = *(const LAS f32x2*)(yb + st * 64 + 2 * cp);
            *(unsigned*)(Y + (size_t)row * RD + ch) = pk2(yy.x, yy.y);
        }
    }
#undef RW4_LOAD
#undef RW4_WRITE
}
__device__ __forceinline__ void gla_scan_4w(const KC& k, int job, LAS unsigned* ctr) {
    const int b = job >> 5, h = (job >> 3) & 3, dir = (job >> 2) & 1, dvq = job & 3;
    const int tid = k.tid - 256, w = k.wave - 4, lane = k.lane, q4 = lane >> 4, l15 = lane & 15;
    const bf16* QG = (const bf16*)(k.ws + GL_QG) + (size_t)dir * TA * GKD; const bf16* KG = (const bf16*)(k.ws + GL_KG) + (size_t)dir * TA * GKD;
    const bf16* KE = (const bf16*)(k.ws + GL_KE) + (size_t)dir * TA * GKD; const bf16* VS = (const bf16*)(k.ws + GL_VS);
    const float* DEC = (const float*)(k.ws + GL_DEC); bf16* O = (bf16*)(k.ws + GL_O) + (size_t)dir * TA * GVD;
    LAS unsigned char* gl = k.lds + SC_GL;
    LAS bf16* QGs = (LAS bf16*)(gl + GL_QGS); LAS bf16* KGs = (LAS bf16*)(gl + GL_KGS); LAS bf16* STs = (LAS bf16*)(gl + GL_STS);
    LAS bf16* KEt = (LAS bf16*)(gl + GL_KET); LAS bf16* Vt = (LAS bf16*)(gl + GL_VT); LAS bf16* ATT = (LAS bf16*)(gl + GL_ATT); LAS float* decs = (LAS float*)(gl + GL_DECS);
    f32x4 accS[8];
#pragma unroll
    for (int t = 0; t < 8; ++t) accS[t] = (f32x4){0.f, 0.f, 0.f, 0.f};
    unsigned gen = 0;
#if GLA4_LEVEL == 2
    { float x = (float)lane; for (int i = 0; i < 200000; ++i) { x = x * 1.0001f + 0.5f; asm volatile("" : "+v"(x)); } asm volatile("" :: "v"(x)); (void)ctr; (void)gen; }
    return;
#endif
#if GLA4_LEVEL == 1
    for (int cp = 0; cp < NCH; ++cp) { float x = (float)lane; for (int i = 0; i < 2000; ++i) x = x * 1.0001f + 0.5f; asm volatile("" :: "v"(x)); half_bar(ctr, gen, lane); half_bar(ctr, gen, lane); half_bar(ctr, gen, lane); }
    return;
#endif
    for (int cp = 0; cp < NCH; ++cp) {
        const bool lat = cp >= 4; const int q = lat ? cp - 4 : cp, ncn = lat ? 32 : 4, cn = dir ? ncn - 1 - q : q, gch = lat ? 4 + cn : cn;
#define GROW(tau) gla_row(lat, b, dir ? 64 * cn + 63 - (tau) : 64 * cn + (tau))
#pragma unroll
        for (int i = 0; i < 4; ++i) {
            const int idx = tid + 256 * i, tau = idx >> 4, ck = idx & 15; const size_t go = (size_t)GROW(tau) * GKD + h * GDK + ck * 8;
            *(LAS u32x4*)(QGs + tau * GP1 + ck * 8) = *(const u32x4*)(QG + go);
            *(LAS u32x4*)(KGs + tau * GP1 + ck * 8) = *(const u32x4*)(KG + go);
            const u32x4 ke = *(const u32x4*)(KE + go);
            const unsigned kw[4] = {ke.x, ke.y, ke.z, ke.w};
#pragma unroll
            for (int e = 0; e < 4; ++e) { KEt[(ck * 8 + 2 * e) * GP2 + tau] = (bf16)(kw[e] & 0xffffu); KEt[(ck * 8 + 2 * e + 1) * GP2 + tau] = (bf16)(kw[e] >> 16); }
        }
#pragma unroll
        for (int i = 0; i < 2; ++i) {
            const int idx = tid + 256 * i, tau = idx >> 3, ck = idx & 7;
            const u32x4 vv = *(const u32x4*)(VS + (size_t)GROW(tau) * GVD + h * GDV + dvq * 64 + ck * 8);
            const unsigned vw[4] = {vv.x, vv.y, vv.z, vv.w};
#pragma unroll
            for (int e = 0; e < 4; ++e) { Vt[(ck * 8 + 2 * e) * GP2 + tau] = (bf16)(vw[e] & 0xffffu); Vt[(ck * 8 + 2 * e + 1) * GP2 + tau] = (bf16)(vw[e] >> 16); }
        }
        if (tid < 128) decs[tid] = DEC[((size_t)(dir * 8 + b) * NCH + gch) * GKD + h * GDK + tid];
#pragma unroll
        for (int t = 0; t < 8; ++t) {
#pragma unroll
            for (int r = 0; r < 4; ++r) STs[(16 * w + 4 * q4 + r) * GP1 + 16 * t + l15] = (bf16)f2bf(accS[t][r]);
        }
        half_bar(ctr, gen, lane);
#pragma unroll
        for (int jt = 0; jt < 4; ++jt) {
            f32x4 acc = (f32x4){0.f, 0.f, 0.f, 0.f};
#pragma unroll
            for (int ks = 0; ks < 4; ++ks) acc = __builtin_amdgcn_mfma_f32_16x16x32_bf16(ldfrag(QGs, 16 * w + l15, GP1, 32 * ks + 8 * q4), ldfrag(KGs, 16 * jt + l15, GP1, 32 * ks + 8 * q4), acc, 0, 0, 0);
#pragma unroll
            for (int r = 0; r < 4; ++r) { const int i = 16 * w + 4 * q4 + r, j = 16 * jt + l15; ATT[i * GP2 + j] = (bf16)f2bf(j <= i ? acc[r] : 0.f); }
        }
        half_bar(ctr, gen, lane);
#pragma unroll
        for (int dvt = 0; dvt < 4; ++dvt) {
            f32x4 acc = (f32x4){0.f, 0.f, 0.f, 0.f};
#pragma unroll
            for (int ks = 0; ks < 4; ++ks) acc = __builtin_amdgcn_mfma_f32_16x16x32_bf16(ldfrag(QGs, 16 * w + l15, GP1, 32 * ks + 8 * q4), ldfrag(STs, 16 * dvt + l15, GP1, 32 * ks + 8 * q4), acc, 0, 0, 0);
#pragma unroll
            for (int ks = 0; ks < 2; ++ks) acc = __builtin_amdgcn_mfma_f32_16x16x32_bf16(ldfrag(ATT, 16 * w + l15, GP2, 32 * ks + 8 * q4), ldfrag(Vt, 16 * dvt + l15, GP2, 32 * ks + 8 * q4), acc, 0, 0, 0);
#pragma unroll
#if GLA4_NOSTORE
            asm volatile("" :: "v"(acc[0]), "v"(acc[1]), "v"(acc[2]), "v"(acc[3]));
#else
            for (int r = 0; r < 4; ++r) { const int i = 16 * w + 4 * q4 + r; O[(size_t)GROW(i) * GVD + h * GDV + dvq * 64 + 16 * dvt + l15] = (bf16)f2bf(acc[r]); }
#endif
        }
#pragma unroll
        for (int t = 0; t < 8; ++t) {
            const float d = decs[16 * t + l15];
            accS[t] = accS[t] * d;
#pragma unroll
            for (int ks = 0; ks < 2; ++ks) accS[t] = __builtin_amdgcn_mfma_f32_16x16x32_bf16(ldfrag(Vt, 16 * w + l15, GP2, 32 * ks + 8 * q4), ldfrag(KEt, 16 * t + l15, GP2, 32 * ks + 8 * q4), accS[t], 0, 0, 0);
        }
        half_bar(ctr, gen, lane);
#undef GROW
    }
#if HB_FULL
    for (int i = 0; i < (1 + (CTXL + SEQ) / RS4_TOK) - 3 * NCH; ++i) __syncthreads();
#endif
}
__device__ __forceinline__ void ph_scan_split(const KC& k, int l, const float* k_a) {
    LAS unsigned* ctr = (LAS unsigned*)(k.lds + SC_CTR);
    for (int job = k.bid; job < 256; job += k.G) {
        if (k.tid == 0) { ctr[0] = 0u; ctr[16] = 0u; }
        __syncthreads();
#if SPLIT_SCAN == 1 || SPLIT_SCAN == 4 || SPLIT_SCAN == 5 || SPLIT_SCAN == 6
#if SWAP_HALVES
        { KC k2 = k; if (k.wave >= 4) { k2.tid = k.tid - 256; k2.wave = k.wave - 4; rwkv_scan_4w(k2, l, job, k_a, ctr); } else { k2.tid = k.tid + 256; k2.wave = k.wave + 4; gla_scan_4w(k2, job, ctr + 16); } }
#else
        if (k.wave < 4) rwkv_scan_4w(k, l, job, k_a, ctr); else gla_scan_4w(k, job, ctr + 16);
#endif
        __syncthreads();
#if SPLIT_SCAN == 6
        ph_rwkv_scan(k, l, job, k_a, WS_H);
#elif SPLIT_SCAN == 4
        ph_rwkv_scan(k, l, job, k_a);
#elif SPLIT_SCAN == 5
        ph_gla_scan(k, job);
#endif
#elif SPLIT_SCAN == 2
        if (k.wave < 4) rwkv_scan_4w(k, l, job, k_a, ctr);
        __syncthreads();
        ph_gla_scan(k, job);
#else
        if (k.wave >= 4) gla_scan_4w(k, job, ctr + 16);
        __syncthreads();
        ph_rwkv_scan(k, l, job, k_a);
#endif
    }
}

__device__ __forceinline__ void ph_post(const KC& k, int l, int nrows, const float* ln_g, const float* ln_b, const float* gng) {
    const int gw = k.bid * 8 + k.wave, NGW = k.G * 8, lane = k.lane, c = 16 * lane;
    const bf16* P = (const bf16*)(k.ws + WS_P);
    const bf16* Y = (const bf16*)(k.ws + RW_Y); const bf16* V = (const bf16*)(k.ws + RW_V); const float* BON = (const float*)(k.ws + RW_BON); bf16* YNB = (bf16*)(k.ws + RW_R);
    const bf16* O = (const bf16*)(k.ws + GL_O); bf16* YB = (bf16*)(k.ws + GL_VS);
    for (int row = gw; row < nrows; row += NGW) {
        {
            float yf[16], yb[16], vv[16], y[16];
            ld16(Y + (size_t)row * RD + c, true, yf); ld16(Y + ((size_t)TA + row) * RD + c, true, yb); ld16(V + (size_t)row * RD + c, true, vv);
            float s = 0.f;
#pragma unroll
            for (int i = 0; i < 16; ++i) { y[i] = yf[i] + yb[i]; s += y[i]; }
            s += __shfl_xor(s, 1); s += __shfl_xor(s, 2);
            const float mean = s * (1.0f / 64.0f); float q = 0.f;
#pragma unroll
            for (int i = 0; i < 16; ++i) { y[i] -= mean; q += y[i] * y[i]; }
            q += __shfl_xor(q, 1); q += __shfl_xor(q, 2);
            const float rstd = 1.0f / sqrtf(q * (1.0f / 64.0f) + 64e-5f), bon = BON[(size_t)row * RHEADS + (lane >> 2)];
#pragma unroll
            for (int i = 0; i < 16; ++i) y[i] = y[i] * rstd * ln_g[l * RD + c + i] + ln_b[l * RD + c + i] + bon * vv[i];
            st16(YNB + (size_t)row * RD + c, y);
        }
        {
            float of[16], ob[16], gt[16], o[16];
            ld16(O + (size_t)row * GVD + c, true, of); ld16(O + ((size_t)TA + row) * GVD + c, true, ob); ld16(P + (size_t)row * NP + GLA_GATE_OFF + c, true, gt);
            float s = 0.f;
#pragma unroll
            for (int i = 0; i < 16; ++i) { o[i] = of[i] + ob[i]; s += o[i] * o[i]; }
            s += __shfl_xor(s, 1); s += __shfl_xor(s, 2); s += __shfl_xor(s, 4); s += __shfl_xor(s, 8);
            const float rinv = 1.0f / sqrtf(s * (1.0f / 256.0f) + 1e-6f);
#pragma unroll
            for (int i = 0; i < 16; ++i) o[i] = o[i] * rinv * gng[l * GDV + ((c + i) & 255)] * siluf(gt[i]);
            st16(YB + (size_t)row * GVD + c, o);
        }
    }
}

#ifndef CHUNK_LOADS_FIRST
#define CHUNK_LOADS_FIRST 1
#endif
#ifndef CHUNK_PF
#define CHUNK_PF 1
#endif
#ifndef SUBST_PK
#define SUBST_PK 0
#endif
#ifndef CONS_UNROLL
#define CONS_UNROLL 1
#endif
#ifndef CHUNK_NOPS
#define CHUNK_NOPS 0
#endif
#ifndef PROD_PK
#define PROD_PK 0
#endif
#ifndef LDS_POISON
#define LDS_POISON 0
#endif
#ifndef CHUNK_DBG
#define CHUNK_DBG 0
#endif
constexpr int RC_XT = 0;
constexpr int RC_YH = RC_XT + 32 * 72 * 2;
constexpr int RC_BET = RC_YH + 64 * 24 * 2;
constexpr int RC_AM = RC_YH + 2 * 64 * 24 * 2;
constexpr int RC_P2 = RC_AM + 2048;
constexpr int RC_AKR = RC_P2 + 512;
constexpr int RC_ABR = RC_AKR + 512;
constexpr int RC_GC = RC_ABR + 512;
constexpr int RC_SLOT = RC_GC + 256;
static_assert(RC_SLOT == 14592 && 8 * RC_SLOT <= 131072 && 32 * 72 * 2 <= 2 * 64 * 24 * 2, "rwkv chunk lds");
__device__ __forceinline__ bf16x8 mk8(u32x2 lo, u32x2 hi) { u32x4 v = {lo.x, lo.y, hi.x, hi.y}; return __builtin_bit_cast(bf16x8, v); }
__device__ __forceinline__ void ph_rwkv_chunk(const KC& k, int l, int job, const float* k_a, size_t yoff = RW_Y) {
    const int b = job >> 5, h = (job >> 1) & 15, dir = job & 1;
    const int w = k.wave, lane = k.lane, q4 = lane >> 4, l15 = lane & 15;
    const bf16* R = (const bf16*)(k.ws + RW_R); const bf16* KS = (const bf16*)(k.ws + RW_KS); const bf16* V = (const bf16*)(k.ws + RW_V); const bf16* KK = (const bf16*)(k.ws + RW_KK);
    const bf16* LO = (const bf16*)(k.ws + RW_LO); bf16* Y = (bf16*)(k.ws + yoff) + (size_t)dir * TA * RD;
    LAS unsigned char* slot = k.lds + w * RC_SLOT;
    LAS bf16* XT = (LAS bf16*)(slot + RC_XT); LAS bf16* YH = (LAS bf16*)(slot + RC_YH);
    LAS float* AM = (LAS float*)(slot + RC_AM);
    const int ch = h * RHS + lane;
    const float ka = k_a[l * RD + ch];
    f32x4 accZ[4];
#pragma unroll
    for (int t = 0; t < 4; ++t) accZ[t] = (f32x4){0.f, 0.f, 0.f, 0.f};
    constexpr int NCK = (CTXL + SEQ) / 16, NRND = NCK / 8;
#if CHUNK_PF
    unsigned pf0 = 0u, pf1 = 0u, pf2 = 0u;
#endif
#if LDS_POISON
    for (int i = lane; i < RC_SLOT / 4; i += 64) ((LAS unsigned*)slot)[i] = 0x7fc07fc0u;
    __syncthreads();
#endif
    for (int rnd = 0; rnd < NRND; ++rnd) {
#if LDS_POISON
        for (int i = lane; i < RC_SLOT / 4; i += 64) ((LAS unsigned*)slot)[i] = 0x7fc07fc0u;
#endif
        {
            const int c = rnd * 8 + w;
            float Lc = 0.f, Eprev = 1.f;
            unsigned vp[8];
#if CHUNK_LOADS_FIRST
            unsigned rv[16], rkk[16], re[16], ra[16], rks[16], rr[16];
#pragma unroll
            for (int t = 0; t < 16; ++t) {
                const unsigned o1 = (unsigned)rwkv_row(b, dir, c * 16 + t) * (unsigned)RD + (unsigned)ch, o4 = o1 * 4u - 3u * (unsigned)ch + (unsigned)(dir * RD);
                rv[t] = V[o1]; rkk[t] = KK[o1]; re[t] = LO[o4]; ra[t] = LO[o4 + 2048u]; rks[t] = KS[o1]; rr[t] = R[o1];
            }
            asm volatile("" ::: "memory");
#pragma unroll
            for (int t = 0; t < 16; ++t) {
                { const unsigned vraw = rv[t]; vp[t >> 1] = (t & 1) ? (vp[t >> 1] | (vraw << 16)) : vraw; }
                const float kkv = bf2f((bf16)rkk[t]), ev = bf2f((bf16)re[t]), av = bf2f((bf16)ra[t]);
                const float ksv = bf2f((bf16)rks[t]), rv_ = bf2f((bf16)rr[t]);
                Lc -= ev;
                const float E = __expf(Lc), Einv = __expf(-Lc);
                XT[t * 72 + lane] = (bf16)f2bf(kkv * Eprev); XT[(16 + t) * 72 + lane] = (bf16)f2bf(rv_ * E);
                YH[t * 72 + lane] = (bf16)f2bf(kkv * av * Einv); YH[(16 + t) * 72 + lane] = (bf16)f2bf(ksv * (1.0f + (av - 1.0f) * ka) * Einv);
                Eprev = E;
            }
#else
#pragma unroll
            for (int t = 0; t < 16; ++t) {
                const unsigned o1 = (unsigned)rwkv_row(b, dir, c * 16 + t) * (unsigned)RD + (unsigned)ch, o4 = o1 * 4u - 3u * (unsigned)ch + (unsigned)(dir * RD);
                { const unsigned vraw = V[o1]; vp[t >> 1] = (t & 1) ? (vp[t >> 1] | (vraw << 16)) : vraw; }
                const float kkv = bf2f(KK[o1]), ev = bf2f(LO[o4]), av = bf2f(LO[o4 + 2048u]);
                const float ksv = bf2f(KS[o1]), rv = bf2f(R[o1]);
                Lc -= ev;
                const float E = __expf(Lc), Einv = __expf(-Lc);
                XT[t * 72 + lane] = (bf16)f2bf(kkv * Eprev); XT[(16 + t) * 72 + lane] = (bf16)f2bf(rv * E);
                YH[t * 72 + lane] = (bf16)f2bf(kkv * av * Einv); YH[(16 + t) * 72 + lane] = (bf16)f2bf(ksv * (1.0f + (av - 1.0f) * ka) * Einv);
                Eprev = E;
            }
#endif
            const float eLC = Eprev;
            asm volatile("s_waitcnt lgkmcnt(0)" ::: "memory");
#if CHUNK_PF
            if (w >= 4) {
                const int cn0 = (rnd + 1 < NRND ? rnd + 1 : rnd) * 8;
                int ln = lane; asm volatile("" : "+v"(ln));
                auto pf_off = [&](int j) -> unsigned {
                    const int i = (w - 4) * 192 + j * 64 + ln, cc = i / 96, wi = i - cc * 96, ar = wi >> 4, tk = wi & 15;
                    const unsigned row = (unsigned)rwkv_row(b, dir, (cn0 + cc) * 16 + tk);
                    const unsigned base = ar == 0 ? (unsigned)RW_R : ar == 1 ? (unsigned)RW_KS : ar == 2 ? (unsigned)RW_V : ar == 3 ? (unsigned)RW_KK : (unsigned)RW_LO;
                    const unsigned el = ar < 4 ? row * (unsigned)RD + (unsigned)(h * RHS) : row * 4096u + (unsigned)(dir * RD + h * RHS) + (unsigned)(ar - 4) * 2048u;
                    return base + 2u * el; };
                const unsigned q0 = pf_off(0), q1 = pf_off(1), q2 = pf_off(2);
                asm volatile("global_load_dword %0, %3, %6\n\tglobal_load_dword %1, %4, %6\n\tglobal_load_dword %2, %5, %6" : "+v"(pf0), "+v"(pf1), "+v"(pf2) : "v"(q0), "v"(q1), "v"(q2), "s"(k.ws) : "memory");
            }
#endif
            f32x4 am[2][2];
#pragma unroll
            for (int rt = 0; rt < 2; ++rt)
#pragma unroll
                for (int ct = 0; ct < 2; ++ct) {
                    f32x4 acc = (f32x4){0.f, 0.f, 0.f, 0.f};
#pragma unroll
                    for (int s = 0; s < 2; ++s) acc = __builtin_amdgcn_mfma_f32_16x16x32_bf16(*(const LAS bf16x8*)(XT + (16 * rt + l15) * 72 + 32 * s + 8 * q4), *(const LAS bf16x8*)(YH + (16 * ct + l15) * 72 + 32 * s + 8 * q4), acc, 0, 0, 0);
                    am[rt][ct] = acc;
                }
            LAS bf16* AKR = (LAS bf16*)(slot + RC_AKR); LAS bf16* ABR = (LAS bf16*)(slot + RC_ABR);
#pragma unroll
            for (int r = 0; r < 4; ++r) {
                const int t = 4 * q4 + r, j = l15;
                AM[t * 16 + j] = j < t ? am[0][0][r] : 0.f;
                AM[256 + t * 16 + j] = j < t ? am[0][1][r] : 0.f;
#if PROD_PK
                const unsigned ab2 = pk2c(j <= t ? -am[1][0][r] : 0.f, j <= t ? am[1][1][r] : 0.f);
                ABR[t * 16 + j] = (bf16)(ab2 & 0xffffu);
                AKR[t * 16 + j] = (bf16)(ab2 >> 16);
#else
                ABR[t * 16 + j] = (bf16)f2bf(j <= t ? -am[1][0][r] : 0.f);
                AKR[t * 16 + j] = (bf16)f2bf(j <= t ? am[1][1][r] : 0.f);
#endif
            }
            asm volatile("s_waitcnt lgkmcnt(0)" ::: "memory");
#if SUBST_PK
            f32x2 PP[16]; float kt[16];
#pragma unroll
            for (int t = 0; t < 16; ++t) kt[t] = bf2f(XT[t * 72 + lane]);
#pragma unroll
            for (int t = 0; t < 16; ++t) {
                asm volatile("" ::: "memory");
                f32x2 p = {kt[t], AM[256 + t * 16 + l15]};
#pragma unroll
                for (int j4 = 0; j4 < (t + 3) / 4; ++j4) {
                    const f32x4 arow = *(const LAS f32x4*)(AM + t * 16 + 4 * j4);
#pragma unroll
                    for (int e = 0; e < 4; ++e) { const int j = 4 * j4 + e; if (j < t) p -= PP[j] * arow[e]; }
                }
                PP[t] = p;
            }
#else
            float P1[16], P2[16], kt[16];
#pragma unroll
            for (int t = 0; t < 16; ++t) kt[t] = bf2f(XT[t * 72 + lane]);
#pragma unroll
            for (int t = 0; t < 16; ++t) {
                asm volatile("" ::: "memory");
                float p1 = kt[t], p2 = AM[256 + t * 16 + l15];
#pragma unroll
                for (int j4 = 0; j4 < (t + 3) / 4; ++j4) {
                    const f32x4 arow = *(const LAS f32x4*)(AM + t * 16 + 4 * j4);
#pragma unroll
                    for (int e = 0; e < 4; ++e) { const int j = 4 * j4 + e; if (j < t) { p1 -= arow[e] * P1[j]; p2 -= arow[e] * P2[j]; } }
                }
                P1[t] = p1; P2[t] = p2;
            }
#endif
            LAS bf16* P2b = (LAS bf16*)(slot + RC_P2);
#pragma unroll
#if PROD_PK
            for (int t = 0; t < 16; ++t) { const unsigned pp = pk2c(0.f, 0.f); XT[t * 72 + lane] = (bf16)(pp & 0xffffu); if (lane < 16) P2b[t * 16 + lane] = (bf16)(pp >> 16); }
#else
#if SUBST_PK
            for (int t = 0; t < 16; ++t) { if (CHUNK_DBG != 12) XT[t * 72 + lane] = (bf16)f2bf(CHUNK_DBG == 13 ? 1.0f + (float)t : PP[t].x); if (lane < 16) P2b[t * 16 + lane] = (bf16)f2bf(PP[t].y); }
#else
            for (int t = 0; t < 16; ++t) { XT[t * 72 + lane] = (bf16)f2bf(P1[t]); if (lane < 16) P2b[t * 16 + lane] = (bf16)f2bf(P2[t]); }
#endif
#endif
            {
                LAS bf16* KET = (LAS bf16*)(slot + RC_YH); LAS bf16* BET = (LAS bf16*)(slot + RC_BET);
                float ke[16], be[16];
#pragma unroll
                for (int t = 0; t < 16; ++t) { ke[t] = bf2f(YH[(16 + t) * 72 + lane]) * eLC; be[t] = -bf2f(YH[t * 72 + lane]) * eLC; }
                asm volatile("s_waitcnt lgkmcnt(0)" ::: "memory");
                float a0[8], a1[8], b0[8], b1[8];
#pragma unroll
                for (int t = 0; t < 8; ++t) { a0[t] = ke[t]; a1[t] = ke[8 + t]; b0[t] = be[t]; b1[t] = be[8 + t]; }
                *(LAS u32x4*)(KET + lane * 24) = pack8(a0); *(LAS u32x4*)(KET + lane * 24 + 8) = pack8(a1);
                *(LAS u32x4*)(BET + lane * 24) = pack8(b0); *(LAS u32x4*)(BET + lane * 24 + 8) = pack8(b1);
                ((LAS float*)(slot + RC_GC))[lane] = eLC;
                *(LAS u32x4*)(slot + RC_AM + lane * 32) = (u32x4){vp[0], vp[1], vp[2], vp[3]}; *(LAS u32x4*)(slot + RC_AM + lane * 32 + 16) = (u32x4){vp[4], vp[5], vp[6], vp[7]};
            }
        }
        __syncthreads();
        if (w < 4) {
#if CONS_UNROLL == 2
#pragma unroll 2
#else
#pragma unroll 1
#endif
            for (int cc = 0; cc < 8; ++cc) {
                const int c = rnd * 8 + cc;
                LAS unsigned char* sl = k.lds + cc * RC_SLOT;
                const LAS bf16* P1b = (const LAS bf16*)(sl + RC_XT); const LAS bf16* RTb = P1b + 16 * 72;
                const LAS bf16* KET = (const LAS bf16*)(sl + RC_YH); const LAS bf16* BET = (const LAS bf16*)(sl + RC_BET);
                const LAS bf16* P2b = (const LAS bf16*)(sl + RC_P2); const LAS bf16* AKR = (const LAS bf16*)(sl + RC_AKR); const LAS bf16* ABR = (const LAS bf16*)(sl + RC_ABR);
                const LAS float* GC = (const LAS float*)(sl + RC_GC);
                const u32x2 vfr = *(const LAS u32x2*)(sl + RC_AM + (16 * w + l15) * 32 + 8 * q4);
                const unsigned vlo = vfr.x, vhi = vfr.y;
#if CHUNK_DBG == 5
                for (int t = 0; t < 4; ++t) accZ[t] = (f32x4){0.f, 0.f, 0.f, 0.f};
#endif
#if CHUNK_NOPS
                asm volatile("s_nop 15\n\ts_nop 15" ::: "memory");
#endif
                bf16x8 bz[2];
#pragma unroll
                for (int s = 0; s < 2; ++s) { u32x4 v = {pk2c(accZ[2 * s][0], accZ[2 * s][1]), pk2c(accZ[2 * s][2], accZ[2 * s][3]), pk2c(accZ[2 * s + 1][0], accZ[2 * s + 1][1]), pk2c(accZ[2 * s + 1][2], accZ[2 * s + 1][3])}; bz[s] = __builtin_bit_cast(bf16x8, v); }
#if CHUNK_DBG == 6
                bz[0] = (bf16x8){0,0,0,0,0,0,0,0}; bz[1] = bz[0];
#endif
                const u32x2 zero2 = {0u, 0u};
                f32x4 zs[4];
#pragma unroll
                for (int t = 0; t < 4; ++t) zs[t] = accZ[t] * *(const LAS f32x4*)(GC + 16 * t + 4 * q4);
#if CHUNK_DBG == 7
                for (int t = 0; t < 4; ++t) zs[t] = (f32x4){0.f, 0.f, 0.f, 0.f};
#endif
                f32x4 sa = (f32x4){0.f, 0.f, 0.f, 0.f};
#if CHUNK_DBG >= 10 && CHUNK_DBG <= 13
                { u32x4 ones = {0x3f803f80u, 0x3f803f80u, 0x3f803f80u, 0x3f803f80u}; const bf16x8 bo = __builtin_bit_cast(bf16x8, ones);
                  for (int s = 0; s < 2; ++s) sa = __builtin_amdgcn_mfma_f32_16x16x32_bf16(mk8(*(const LAS u32x2*)(P1b + l15 * 72 + 32 * s + 4 * q4), *(const LAS u32x2*)(P1b + l15 * 72 + 32 * s + 16 + 4 * q4)), (CHUNK_DBG == 10 || CHUNK_DBG == 12 || CHUNK_DBG == 13) ? bo : bz[s], sa, 0, 0, 0); }
#else
#pragma unroll
                for (int s = 0; s < 2; ++s) if (CHUNK_DBG != 3 && CHUNK_DBG != 9) sa = __builtin_amdgcn_mfma_f32_16x16x32_bf16(mk8(*(const LAS u32x2*)(P1b + l15 * 72 + 32 * s + 4 * q4), *(const LAS u32x2*)(P1b + l15 * 72 + 32 * s + 16 + 4 * q4)), bz[s], sa, 0, 0, 0);
#endif
                if (CHUNK_DBG != 4 && !(CHUNK_DBG >= 10 && CHUNK_DBG <= 13)) { u32x4 bv = {vlo, vhi, 0u, 0u}; sa = __builtin_amdgcn_mfma_f32_16x16x32_bf16(mk8(*(const LAS u32x2*)(P2b + l15 * 16 + 4 * q4), zero2), __builtin_bit_cast(bf16x8, bv), sa, 0, 0, 0); }
#if CHUNK_DBG == 1
                sa = (f32x4){0.f, 0.f, 0.f, 0.f};
#endif
#if CHUNK_NOPS
                asm volatile("s_nop 15" : "+v"(sa));
#endif
                bf16x8 bv2; { u32x4 v = {vlo, vhi, pk2c(sa[0], sa[1]), pk2c(sa[2], sa[3])}; bv2 = __builtin_bit_cast(bf16x8, v); }
                f32x4 yy = (f32x4){0.f, 0.f, 0.f, 0.f};
#pragma unroll
                for (int s = 0; s < 2; ++s) if (CHUNK_DBG != 8) yy = __builtin_amdgcn_mfma_f32_16x16x32_bf16(mk8(*(const LAS u32x2*)(RTb + l15 * 72 + 32 * s + 4 * q4), *(const LAS u32x2*)(RTb + l15 * 72 + 32 * s + 16 + 4 * q4)), bz[s], yy, 0, 0, 0);
                yy = __builtin_amdgcn_mfma_f32_16x16x32_bf16(mk8(*(const LAS u32x2*)(AKR + l15 * 16 + 4 * q4), *(const LAS u32x2*)(ABR + l15 * 16 + 4 * q4)), bv2, yy, 0, 0, 0);
#pragma unroll
                for (int t = 0; t < 4; ++t) {
                    accZ[t] = __builtin_amdgcn_mfma_f32_16x16x32_bf16(mk8(*(const LAS u32x2*)(KET + (16 * t + l15) * 24 + 4 * q4), *(const LAS u32x2*)(BET + (16 * t + l15) * 24 + 4 * q4)), bv2, zs[t], 0, 0, 0);
                }
#if CHUNK_DBG == 2
                yy = (f32x4){1.f, 1.f, 1.f, 1.f};
#endif
#if CHUNK_DBG >= 10 && CHUNK_DBG <= 13
                yy = sa;
#endif
#if CHUNK_NOPS
                asm volatile("s_nop 15" : "+v"(yy));
#endif
#pragma unroll
                for (int r = 0; r < 4; ++r) Y[(size_t)rwkv_row(b, dir, c * 16 + 4 * q4 + r) * RD + h * RHS + 16 * w + l15] = (bf16)f2bf(yy[r]);
            }
        }
#if CHUNK_PF
        else asm volatile("s_waitcnt vmcnt(0)" : "+v"(pf0), "+v"(pf1), "+v"(pf2) :: "memory");
#endif
        __syncthreads();
    }
}

#ifndef CHECK_EXACT
#define CHECK_EXACT 0
#endif
#ifndef CHECK_PMAX
#define CHECK_PMAX (CTXL + SEQ)
#endif
#ifndef CHECK_PMIN
#define CHECK_PMIN 0
#endif
#ifndef CHECK_UNIT
#define CHECK_UNIT 1000
#endif
__device__ __forceinline__ void rwkv_check_delay(const KC& k, int job, size_t refoff = RW_Y) {
    const int b = job >> 5, h = (job >> 1) & 15, dir = job & 1;
    const bf16* Ya = (const bf16*)(k.ws + refoff) + (size_t)dir * TA * RD; const bf16* Yb = (const bf16*)(k.ws + WS_H) + (size_t)dir * TA * RD;
    float d2 = 0.f, s2 = 0.f; int bad = 0;
    for (int i = k.tid; i < (CHECK_PMAX) * 32; i += 512) {
        const int p = (CHECK_PMIN) + (i >> 5), cp = i & 31; const size_t o = (size_t)rwkv_row(b, dir, p) * RD + h * RHS + 2 * cp;
        const unsigned ua = *(const unsigned*)(Ya + o), ub = *(const unsigned*)(Yb + o);
        const float a0 = bflo(ua), a1 = bfhi(ua), b0 = bflo(ub), b1 = bfhi(ub);
        d2 += (CHECK_EXACT) ? (ua != ub ? 1.0f : 0.0f) : (a0 - b0) * (a0 - b0) + (a1 - b1) * (a1 - b1); s2 += a0 * a0 + a1 * a1;
        if (!(b0 == b0) || !(b1 == b1) || fabsf(b0) > 1e30f || fabsf(b1) > 1e30f) bad = 1;
    }
    LAS float* red = (LAS float*)k.lds;
    __syncthreads();
    d2 = wave_sum(d2); s2 = wave_sum(s2); bad = __any(bad) ? 1 : 0;
    if (k.lane == 0) { red[k.wave * 4] = d2; red[k.wave * 4 + 1] = s2; red[k.wave * 4 + 2] = (float)bad; }
    __syncthreads();
    if (k.tid == 0) {
        float D = 0.f, S = 0.f, B = 0.f;
        for (int i = 0; i < 8; ++i) { D += red[i * 4]; S += red[i * 4 + 1]; B += red[i * 4 + 2]; }
        const float rel = sqrtf(D / fmaxf(S, 1e-30f));
        int bucket = rel < 0.01f ? 0 : rel < 0.03f ? 1 : rel < 0.1f ? 2 : rel < 0.3f ? 3 : rel < 1.0f ? 4 : 5;
        if (CHECK_EXACT) bucket = D == 0.f ? 0 : D < 10.f ? 1 : D < 100.f ? 2 : D < 1000.f ? 3 : D < 10000.f ? 4 : 5;
        if (B > 0.f || !(rel == rel)) bucket = 6;
        const unsigned long long t0 = __builtin_amdgcn_s_memrealtime(), wait = (unsigned long long)bucket * (CHECK_UNIT) * 100ull;
        while (__builtin_amdgcn_s_memrealtime() - t0 < wait) __builtin_amdgcn_s_sleep(8);
    }
    __syncthreads();
}
using pg8::Unit;
struct FP_ { bf16* P; __device__ __forceinline__ void operator()(int row, int col, float (&v)[8], const Unit&) const { *(u32x4*)(P + (size_t)row * NP + col) = pack8(v); } };
struct FL1_ { bf16* LO; const float* bias1;
    __device__ __forceinline__ void operator()(int row, int col, float (&v)[8], const Unit& u) const {
        const float* bias = bias1 + col;
        const f32x4 b0 = *(const f32x4*)bias, b1 = *(const f32x4*)(bias + 4);
        const float bb[8] = {b0.x, b0.y, b0.z, b0.w, b1.x, b1.y, b1.z, b1.w};
        const float sc = col < 2048 ? 0.6065306597126334f : 1.0f;
#pragma unroll
        for (int i = 0; i < 8; ++i) v[i] = sigm(bb[i] + v[i]) * sc;
        *(u32x4*)(LO + (size_t)row * 4096 + col) = pack8(v);
    } };
struct FL2_ { const bf16* YNB; bf16* YA;
    __device__ __forceinline__ void operator()(int row, int col, float (&v)[8], const Unit&) const {
        float y[8]; unpack8(*(const u32x4*)(YNB + (size_t)row * RD + col), y);
#pragma unroll
        for (int i = 0; i < 8; ++i) v[i] *= y[i];
        *(u32x4*)(YA + (size_t)row * RD + col) = pack8(v);
    } };
template <int SECOND> struct FM_ { const bf16* P; bf16* MA; bf16* OUT;
    __device__ __forceinline__ void operator()(int row, int col, float (&v)[8], const Unit&) const {
        float g[8]; unpack8(*(const u32x4*)(P + (size_t)row * NP + BR_OFF + SECOND * DM + col), g);
        const bf16* mp = MA + (size_t)row * DM + col;
        if (SECOND) { float m[8]; unpack8(*(const u32x4*)mp, m);
#pragma unroll
            for (int i = 0; i < 8; ++i) v[i] = sigm(g[i]) * v[i] + m[i]; }
        else {
#pragma unroll
            for (int i = 0; i < 8; ++i) v[i] = sigm(g[i]) * v[i]; }
        *(u32x4*)(OUT + (size_t)row * DM + col) = pack8(v);
    } };
struct FX_ { float* X; const float* MOD; int l; float* OUT;
    __device__ __forceinline__ void operator()(int row, int col, const f32x4 v, const Unit&) const {
        const f32x4 g = *(const f32x4*)(MOD + ((size_t)l * 9 + mod_row(row)) * MOD_N + 2 * DM + col);
        const f32x4* xp = (const f32x4*)(X + (size_t)row * DM + col);
        *(f32x4*)(OUT + (size_t)row * DM + col) = *xp + g * v;
    } };
struct FE1_ { bf16* ACT;
    __device__ __forceinline__ void operator()(int row, int col, float (&g)[8], float (&up)[8]) const {
#pragma unroll
        for (int i = 0; i < 8; ++i) g[i] = siluf(g[i]) * up[i];
        *(u32x4*)(ACT + (size_t)row * DEXP + col) = pack8(g);
    } };
struct FE2_ { const int* rowtok; const float* roww; bf16* YF;
    __device__ __forceinline__ void operator()(int row, int col, float (&v)[8], const Unit&) const {
        const int t2 = rowtok[row];
        if (t2 >= 0) { const float w = roww[row];
#pragma unroll
            for (int i = 0; i < 8; ++i) v[i] *= w;
            *(u32x4*)(YF + ((size_t)(t2 & 1) * TA + (t2 >> 1)) * DM + col) = pack8(v); }
    } };

#ifndef GA_
#define GA_ true
#endif
#ifndef GS_
#define GS_ true
#endif
constexpr int LDS_BYTES = 147456;
constexpr int MISC_OFF = 131072 + 4096;

constexpr int NPHASE = 2 + 14 * DEPTH + 1;
struct Args { const float* in[N_IN]; float* out; unsigned char* ws; int ph_lo, ph_hi; };
static_assert(sizeof(Args) == N_IN * 8 + 8 + 8 + 8, "Args has no padding");

__global__ void __launch_bounds__(512, 2) fwd(Args a) {
    extern __shared__ __attribute__((aligned(16))) unsigned char lds_raw[];
    KC k;
    k.lds = (LAS unsigned char*)lds_raw; k.ws = (unsigned char*)INP(N_IN + 1);
    k.tid = threadIdx.x; k.lane = k.tid & 63; k.wave = __builtin_amdgcn_readfirstlane(k.tid >> 6); k.G = gridDim.x; k.bid = blockIdx.x;
    const int lo = a.ph_lo, hi = a.ph_hi;
    volatile LAS unsigned* MISC = (volatile LAS unsigned*)(k.lds + MISC_OFF);
    if (k.tid < 32) MISC[k.tid] = 0u;
    __syncthreads();
    XcdBarrier bar; bar.bar = (unsigned*)(k.ws + WS_CTL) + CW_BAR; bar.x = 0; bar.st = nullptr;
    if (hi - lo > 1) bar = xcd_barrier_post((unsigned*)(k.ws + WS_CTL) + CW_BAR, MISC + 8);
#ifndef SITE_MASK
#define SITE_MASK 0xFFFFFFFFu
#endif
#define FRESH() do { int t_ = threadIdx.x; asm volatile("" : "+v"(t_)); k.tid = t_; k.lane = t_ & 63; k.wave = __builtin_amdgcn_readfirstlane(t_ >> 6); k.ws = (unsigned char*)INP(N_IN + 1); ws = k.ws; } while (0)
#define PH_BEGIN(p, site) if (((SITE_MASK >> (site)) & 1u) && lo <= (p) && (p) < hi) { FRESH();
#ifndef EXTRA_BARS
#define EXTRA_BARS 0
#endif
#ifndef DUP_MASK
#define DUP_MASK 0u
#endif
#define DUPRUN(n, stmt) do { stmt; if ((DUP_MASK >> (n)) & 1u) { __syncthreads(); stmt; } } while (0)
#define PH_END(p) if ((p) + 1 < hi) xcd_barrier(bar); }
    unsigned char* ws = k.ws;
    LAS unsigned char* glds = k.lds;
#define WSRC WSrc{INP(I_WIN), INP(I_W2), INP(I_A2), INP(I_G2), INP(I_WBA), INP(I_WBB), INP(I_WOUT), INP(I_EG), INP(I_EU), INP(I_ED), INP(I_W0), INP(I_A0)}

    PH_BEGIN(0, 0) DUPRUN(0, ph_adaln_partials(k, INP(I_C), INP(I_CCTX), INP(I_WADA))); DUPRUN(1, ph_convert(k, WSRC, 0)); PH_END(0)
    PH_BEGIN(1, 1) ph_adaln_reduce(k, INP(I_BADA)); PH_END(1)

#define L_ 0
    {
        constexpr int l = L_;
        const int pb = 2 + 14 * l;
        const bool last = (l == DEPTH - 1);
        const int Mpost = last ? TL : TA;
        PH_BEGIN(pb + 0, 2)
            if (l > 0) { DUPRUN(1, ph_convert(k, WSRC, l)); }
            RowArgs ra{INP(I_X), INP(I_CTX), INP(I_NMG), nullptr, nullptr, nullptr};
            ph_rows<0>(k, ra, l, TA);
            if (l == 0 && ((DUP_MASK >> 15) & 1u)) { __syncthreads(); ph_rows<0>(k, ra, l, TA); }
        PH_END(pb + 0)
        PH_BEGIN(pb + 1, 3)
            pg8::Gemm g{(const bf16*)(ws + WS_H), (const bf16*)(ws + WT_IN), TA, NP, DM, 0}; pg8::StaticOrder S; S.init(TA, NP, k.G, k.bid);
            pg8::Epi8<FP_> E{FP_{(bf16*)(ws + WS_P)}};
            DUPRUN(2, (pg8::gemm_phase<pg8::Epi8<FP_>, pg8::StaticOrder, GA_, GS_>(glds, g, S, E)));
        PH_END(pb + 1)
        PH_BEGIN(pb + 2, 4)
            DUPRUN(3, ph_rwkv_prep(k, l, TA, INP(I_MU), INP(I_KK), INP(I_RK)));
            DUPRUN(4, ph_gla_prep(k, l, INP(I_GCONV), INP(I_GAW2), INP(I_GAB)));
        PH_END(pb + 2)
        PH_BEGIN(pb + 3, 5)
            pg8::Gemm g{(const bf16*)(ws + RW_A1), (const bf16*)(ws + WT_L1), TA, 4096, 256, 0}; pg8::StaticOrder S; S.init(TA, 4096, k.G, k.bid);
            pg8::Epi8<FL1_> E{FL1_{(bf16*)(ws + RW_LO), (const float*)(ws + WS_TAB + TAB_TOP)}};
            DUPRUN(5, (pg8::gemm_phase<pg8::Epi8<FL1_>, pg8::StaticOrder, GA_, GS_>(glds, g, S, E)));
        PH_END(pb + 3)
        PH_BEGIN(pb + 4, 6)
#if SPLIT_SCAN
            DUPRUN(6, ph_scan_split(k, l, INP(I_KA)));
#else
            for (int vb = ((k.G & 7) ? k.bid : (k.bid & 7) * (k.G >> 3) + (k.bid >> 3)); vb < 256; vb += k.G) { const int job = vb;
#if RWKV_MODE == 0
                DUPRUN(6, ph_rwkv_scan(k, l, job, INP(I_KA)));
#elif RWKV_MODE == 1
                ph_rwkv_scan(k, l, job, INP(I_KA)); ph_rwkv_chunk(k, l, job, INP(I_KA), WS_H); if (l == 0) rwkv_check_delay(k, job);
#elif RWKV_MODE == 4
                ph_rwkv_scan(k, l, job, INP(I_KA)); ph_rwkv_chunk(k, l, job, INP(I_KA), WS_H); ph_rwkv_chunk(k, l, job, INP(I_KA), WS_END); if (l == 0) rwkv_check_delay(k, job, WS_END);
#elif RWKV_MODE == 5
#pragma unroll 1
                for (int rep = 0; rep < 2; ++rep) { int r_ = rep; asm volatile("" : "+s"(r_)); __syncthreads(); ph_rwkv_chunk(k, l, job, INP(I_KA), r_ ? (size_t)RW_Y : (size_t)WS_H); }
                if (l == 0) rwkv_check_delay(k, job);
#elif RWKV_MODE == 3
                ph_rwkv_scan(k, l, job, INP(I_KA)); ph_rwkv_scan(k, l, job, INP(I_KA), WS_H); if (l == 0) rwkv_check_delay(k, job);
#else
                DUPRUN(6, ph_rwkv_chunk(k, l, job, INP(I_KA)));
#endif
            }
#ifndef NO_GLA
            FRESH();
            for (int vb = ((k.G & 7) ? k.bid : (k.bid & 7) * (k.G >> 3) + (k.bid >> 3)); vb < 256; vb += k.G) { const int job = vb; DUPRUN(7, ph_gla_scan(k, job)); }
#endif
#endif
        PH_END(pb + 4)
        PH_BEGIN(pb + 5, 7)
            DUPRUN(8, ph_post(k, l, Mpost, INP(I_LNG), INP(I_LNB), INP(I_GNG)));
        PH_END(pb + 5)
        PH_BEGIN(pb + 6, 8)
            pg8::Gemm g{(const bf16*)(ws + RW_A2), (const bf16*)(ws + WT_G2), Mpost, RD, 256, 0}; pg8::StaticOrder S; S.init(Mpost, RD, k.G, k.bid);
            pg8::Epi8<FL2_> E{FL2_{(const bf16*)(ws + RW_R), (bf16*)(ws + RW_V)}};
            DUPRUN(9, (pg8::gemm_phase<pg8::Epi8<FL2_>, pg8::StaticOrder, GA_, GS_>(glds, g, S, E)));
        PH_END(pb + 6)
        PH_BEGIN(pb + 7, 9)
            pg8::Gemm g{(const bf16*)(ws + RW_V), (const bf16*)(ws + WT_A), Mpost, DM, RD, 0}; pg8::StaticOrder S; S.init(Mpost, DM, k.G, k.bid);
            pg8::Epi8<FM_<0>> E{FM_<0>{(const bf16*)(ws + WS_P), (bf16*)(ws + WS_H), (bf16*)(ws + WS_H)}};
            DUPRUN(10, (pg8::gemm_phase<pg8::Epi8<FM_<0>>, pg8::StaticOrder, GA_, GS_>(glds, g, S, E)));
        PH_END(pb + 7)
        PH_BEGIN(pb + 8, 10)
            pg8::Gemm g{(const bf16*)(ws + GL_VS), (const bf16*)(ws + WT_B), Mpost, DM, GVD, 0}; pg8::StaticOrder S; S.init(Mpost, DM, k.G, k.bid);
            pg8::Epi8<FM_<1>> E{FM_<1>{(const bf16*)(ws + WS_P), (bf16*)(ws + WS_H), (bf16*)(ws + WS_H)}};
            pg8::gemm_phase<pg8::Epi8<FM_<1>>, pg8::StaticOrder, GA_, GS_>(glds, g, S, E);
            if ((DUP_MASK >> 17) & 1u) { __syncthreads(); pg8::Epi8<FM_<1>> E2{FM_<1>{(const bf16*)(ws + WS_P), (bf16*)(ws + WS_H), (bf16*)(ws + RW_R)}}; pg8::gemm_phase<pg8::Epi8<FM_<1>>, pg8::StaticOrder, GA_, GS_>(glds, g, S, E2); }
        PH_END(pb + 8)
        PH_BEGIN(pb + 9, 11)
            pg8::Gemm g{(const bf16*)(ws + WS_H), (const bf16*)(ws + WT_O), Mpost, DM, DM, 0}; pg8::StaticOrder S; S.init(Mpost, DM, k.G, k.bid);
            pg8::Epi4<FX_> E{FX_{(float*)(ws + WS_X), (const float*)(ws + WS_MOD), l, (float*)(ws + WS_X)}};
            pg8::gemm_phase<pg8::Epi4<FX_>, pg8::StaticOrder, GA_, GS_>(glds, g, S, E);
            if ((DUP_MASK >> 18) & 1u) { __syncthreads(); pg8::Epi4<FX_> E2{FX_{(float*)(ws + WS_X), (const float*)(ws + WS_MOD), l, (float*)(ws + WS_P)}}; pg8::gemm_phase<pg8::Epi4<FX_>, pg8::StaticOrder, GA_, GS_>(glds, g, S, E2); }
        PH_END(pb + 9)
        PH_BEGIN(pb + 10, 12)
            RowArgs ra{nullptr, nullptr, INP(I_NFG), INP(I_RW), INP(I_RB), nullptr};
            ph_rows<1>(k, ra, l, Mpost);
            if ((DUP_MASK >> 16) & 1u) { __syncthreads(); ph_rows<1>(k, ra, l, Mpost, true); }
        PH_END(pb + 10)
        PH_BEGIN(pb + 11, 13)
            DUPRUN(13, ph_moe_scatter(k, l, Mpost));
        PH_END(pb + 11)
        PH_BEGIN(pb + 12, 14)
            pg8::Gemm g{(const bf16*)(ws + WS_HP), (const bf16*)(ws + WT_GU), 0, 2816, DM, (size_t)2816 * DM * 2};
            pg8::MoeOrder S; S.init((const int*)(ws + WS_TAB + TAB_TILE) + 256 * l, 11, k.G, ((k.G & 7) ? k.bid : (k.bid & 7) * (k.G >> 3) + (k.bid >> 3)));
            pg8::EpiGU<FE1_> E{FE1_{(bf16*)(ws + WS_ACT)}};
            DUPRUN(11, (pg8::gemm_phase<pg8::EpiGU<FE1_>, pg8::MoeOrder, GA_, GS_>(glds, g, S, E)));
        PH_END(pb + 12)
        PH_BEGIN(pb + 13, 15)
            pg8::Gemm g{(const bf16*)(ws + WS_ACT), (const bf16*)(ws + WT_D), 0, DM, DEXP, (size_t)DM * DEXP * 2};
            pg8::MoeOrder S; S.init((const int*)(ws + WS_TAB + TAB_TILE) + 256 * l, 8, k.G, ((k.G & 7) ? k.bid : (k.bid & 7) * (k.G >> 3) + (k.bid >> 3)));
            pg8::Epi8<FE2_> E{FE2_{(const int*)(ws + WS_TAB + TAB_ROWTOK) + (size_t)l * MOE_ROWS, (const float*)(ws + WS_TAB + TAB_ROWW) + (size_t)l * MOE_ROWS, (bf16*)(ws + WS_YF)}};
            DUPRUN(12, (pg8::gemm_phase<pg8::Epi8<FE2_>, pg8::MoeOrder, GA_, GS_>(glds, g, S, E)));
        PH_END(pb + 13)
        }
#undef L_
#define L_ 1
    {
        constexpr int l = L_;
        const int pb = 2 + 14 * l;
        const bool last = (l == DEPTH - 1);
        const int Mpost = last ? TL : TA;
        PH_BEGIN(pb + 0, 2)
            if (l > 0) { DUPRUN(1, ph_convert(k, WSRC, l)); }
            RowArgs ra{INP(I_X), INP(I_CTX), INP(I_NMG), nullptr, nullptr, nullptr};
            ph_rows<0>(k, ra, l, TA);
            if (l == 0 && ((DUP_MASK >> 15) & 1u)) { __syncthreads(); ph_rows<0>(k, ra, l, TA); }
        PH_END(pb + 0)
        PH_BEGIN(pb + 1, 3)
            pg8::Gemm g{(const bf16*)(ws + WS_H), (const bf16*)(ws + WT_IN), TA, NP, DM, 0}; pg8::StaticOrder S; S.init(TA, NP, k.G, k.bid);
            pg8::Epi8<FP_> E{FP_{(bf16*)(ws + WS_P)}};
            DUPRUN(2, (pg8::gemm_phase<pg8::Epi8<FP_>, pg8::StaticOrder, GA_, GS_>(glds, g, S, E)));
        PH_END(pb + 1)
        PH_BEGIN(pb + 2, 4)
            DUPRUN(3, ph_rwkv_prep(k, l, TA, INP(I_MU), INP(I_KK), INP(I_RK)));
            DUPRUN(4, ph_gla_prep(k, l, INP(I_GCONV), INP(I_GAW2), INP(I_GAB)));
        PH_END(pb + 2)
        PH_BEGIN(pb + 3, 5)
            pg8::Gemm g{(const bf16*)(ws + RW_A1), (const bf16*)(ws + WT_L1), TA, 4096, 256, 0}; pg8::StaticOrder S; S.init(TA, 4096, k.G, k.bid);
            pg8::Epi8<FL1_> E{FL1_{(bf16*)(ws + RW_LO), (const float*)(ws + WS_TAB + TAB_TOP)}};
            DUPRUN(5, (pg8::gemm_phase<pg8::Epi8<FL1_>, pg8::StaticOrder, GA_, GS_>(glds, g, S, E)));
        PH_END(pb + 3)
        PH_BEGIN(pb + 4, 6)
#if SPLIT_SCAN
            DUPRUN(6, ph_scan_split(k, l, INP(I_KA)));
#else
            for (int vb = ((k.G & 7) ? k.bid : (k.bid & 7) * (k.G >> 3) + (k.bid >> 3)); vb < 256; vb += k.G) { const int job = vb;
#if RWKV_MODE == 0
                DUPRUN(6, ph_rwkv_scan(k, l, job, INP(I_KA)));
#elif RWKV_MODE == 1
                ph_rwkv_scan(k, l, job, INP(I_KA)); ph_rwkv_chunk(k, l, job, INP(I_KA), WS_H); if (l == 0) rwkv_check_delay(k, job);
#elif RWKV_MODE == 4
                ph_rwkv_scan(k, l, job, INP(I_KA)); ph_rwkv_chunk(k, l, job, INP(I_KA), WS_H); ph_rwkv_chunk(k, l, job, INP(I_KA), WS_END); if (l == 0) rwkv_check_delay(k, job, WS_END);
#elif RWKV_MODE == 5
#pragma unroll 1
                for (int rep = 0; rep < 2; ++rep) { int r_ = rep; asm volatile("" : "+s"(r_)); __syncthreads(); ph_rwkv_chunk(k, l, job, INP(I_KA), r_ ? (size_t)RW_Y : (size_t)WS_H); }
                if (l == 0) rwkv_check_delay(k, job);
#elif RWKV_MODE == 3
                ph_rwkv_scan(k, l, job, INP(I_KA)); ph_rwkv_scan(k, l, job, INP(I_KA), WS_H); if (l == 0) rwkv_check_delay(k, job);
#else
                DUPRUN(6, ph_rwkv_chunk(k, l, job, INP(I_KA)));
#endif
            }
#ifndef NO_GLA
            FRESH();
            for (int vb = ((k.G & 7) ? k.bid : (k.bid & 7) * (k.G >> 3) + (k.bid >> 3)); vb < 256; vb += k.G) { const int job = vb; DUPRUN(7, ph_gla_scan(k, job)); }
#endif
#endif
        PH_END(pb + 4)
        PH_BEGIN(pb + 5, 7)
            DUPRUN(8, ph_post(k, l, Mpost, INP(I_LNG), INP(I_LNB), INP(I_GNG)));
        PH_END(pb + 5)
        PH_BEGIN(pb + 6, 8)
            pg8::Gemm g{(const bf16*)(ws + RW_A2), (const bf16*)(ws + WT_G2), Mpost, RD, 256, 0}; pg8::StaticOrder S; S.init(Mpost, RD, k.G, k.bid);
            pg8::Epi8<FL2_> E{FL2_{(const bf16*)(ws + RW_R), (bf16*)(ws + RW_V)}};
            DUPRUN(9, (pg8::gemm_phase<pg8::Epi8<FL2_>, pg8::StaticOrder, GA_, GS_>(glds, g, S, E)));
        PH_END(pb + 6)
        PH_BEGIN(pb + 7, 9)
            pg8::Gemm g{(const bf16*)(ws + RW_V), (const bf16*)(ws + WT_A), Mpost, DM, RD, 0}; pg8::StaticOrder S; S.init(Mpost, DM, k.G, k.bid);
            pg8::Epi8<FM_<0>> E{FM_<0>{(const bf16*)(ws + WS_P), (bf16*)(ws + WS_H), (bf16*)(ws + WS_H)}};
            DUPRUN(10, (pg8::gemm_phase<pg8::Epi8<FM_<0>>, pg8::StaticOrder, GA_, GS_>(glds, g, S, E)));
        PH_END(pb + 7)
        PH_BEGIN(pb + 8, 10)
            pg8::Gemm g{(const bf16*)(ws + GL_VS), (const bf16*)(ws + WT_B), Mpost, DM, GVD, 0}; pg8::StaticOrder S; S.init(Mpost, DM, k.G, k.bid);
            pg8::Epi8<FM_<1>> E{FM_<1>{(const bf16*)(ws + WS_P), (bf16*)(ws + WS_H), (bf16*)(ws + WS_H)}};
            pg8::gemm_phase<pg8::Epi8<FM_<1>>, pg8::StaticOrder, GA_, GS_>(glds, g, S, E);
            if ((DUP_MASK >> 17) & 1u) { __syncthreads(); pg8::Epi8<FM_<1>> E2{FM_<1>{(const bf16*)(ws + WS_P), (bf16*)(ws + WS_H), (bf16*)(ws + RW_R)}}; pg8::gemm_phase<pg8::Epi8<FM_<1>>, pg8::StaticOrder, GA_, GS_>(glds, g, S, E2); }
        PH_END(pb + 8)
        PH_BEGIN(pb + 9, 11)
            pg8::Gemm g{(const bf16*)(ws + WS_H), (const bf16*)(ws + WT_O), Mpost, DM, DM, 0}; pg8::StaticOrder S; S.init(Mpost, DM, k.G, k.bid);
            pg8::Epi4<FX_> E{FX_{(float*)(ws + WS_X), (const float*)(ws + WS_MOD), l, (float*)(ws + WS_X)}};
            pg8::gemm_phase<pg8::Epi4<FX_>, pg8::StaticOrder, GA_, GS_>(glds, g, S, E);
            if ((DUP_MASK >> 18) & 1u) { __syncthreads(); pg8::Epi4<FX_> E2{FX_{(float*)(ws + WS_X), (const float*)(ws + WS_MOD), l, (float*)(ws + WS_P)}}; pg8::gemm_phase<pg8::Epi4<FX_>, pg8::StaticOrder, GA_, GS_>(glds, g, S, E2); }
        PH_END(pb + 9)
        PH_BEGIN(pb + 10, 12)
            RowArgs ra{nullptr, nullptr, INP(I_NFG), INP(I_RW), INP(I_RB), nullptr};
            ph_rows<1>(k, ra, l, Mpost);
            if ((DUP_MASK >> 16) & 1u) { __syncthreads(); ph_rows<1>(k, ra, l, Mpost, true); }
        PH_END(pb + 10)
        PH_BEGIN(pb + 11, 13)
            DUPRUN(13, ph_moe_scatter(k, l, Mpost));
        PH_END(pb + 11)
        PH_BEGIN(pb + 12, 14)
            pg8::Gemm g{(const bf16*)(ws + WS_HP), (const bf16*)(ws + WT_GU), 0, 2816, DM, (size_t)2816 * DM * 2};
            pg8::MoeOrder S; S.init((const int*)(ws + WS_TAB + TAB_TILE) + 256 * l, 11, k.G, ((k.G & 7) ? k.bid : (k.bid & 7) * (k.G >> 3) + (k.bid >> 3)));
            pg8::EpiGU<FE1_> E{FE1_{(bf16*)(ws + WS_ACT)}};
            DUPRUN(11, (pg8::gemm_phase<pg8::EpiGU<FE1_>, pg8::MoeOrder, GA_, GS_>(glds, g, S, E)));
        PH_END(pb + 12)
        PH_BEGIN(pb + 13, 15)
            pg8::Gemm g{(const bf16*)(ws + WS_ACT), (const bf16*)(ws + WT_D), 0, DM, DEXP, (size_t)DM * DEXP * 2};
            pg8::MoeOrder S; S.init((const int*)(ws + WS_TAB + TAB_TILE) + 256 * l, 8, k.G, ((k.G & 7) ? k.bid : (k.bid & 7) * (k.G >> 3) + (k.bid >> 3)));
            pg8::Epi8<FE2_> E{FE2_{(const int*)(ws + WS_TAB + TAB_ROWTOK) + (size_t)l * MOE_ROWS, (const float*)(ws + WS_TAB + TAB_ROWW) + (size_t)l * MOE_ROWS, (bf16*)(ws + WS_YF)}};
            DUPRUN(12, (pg8::gemm_phase<pg8::Epi8<FE2_>, pg8::MoeOrder, GA_, GS_>(glds, g, S, E)));
        PH_END(pb + 13)
        }
#undef L_
#if EXTRA_BARS
    if (hi - lo > 1) { for (int i = 0; i < EXTRA_BARS; ++i) xcd_barrier(bar); }
#endif
    PH_BEGIN(NPHASE - 1, 16)
        RowArgs ra{nullptr, nullptr, INP(I_FNG), nullptr, nullptr, (float*)INP(N_IN)};
        DUPRUN(14, ph_rows<2>(k, ra, 0, TL));
    PH_END(NPHASE - 1)
}

#ifndef MK_SINGLE
#define MK_SINGLE 1
#endif
extern "C" void kernel_launch(void* const* d_in, const int* in_sizes, int n_in, void* d_out, int out_size, void* d_ws, size_t ws_size, hipStream_t stream) {
    static int grid = 0;
    if (grid == 0) {
        if (n_in != N_IN || out_size != TL * DM || ws_size < WS_END) { fprintf(stderr, "kernel_launch: unexpected problem (n_in %d out %d ws %zu need %zu)\n", n_in, out_size, ws_size, (size_t)WS_END); grid = -1; return; }
        int dev = 0, cus = 0;
        if (hipGetDevice(&dev) != hipSuccess || hipDeviceGetAttribute(&cus, hipDeviceAttributeMultiprocessorCount, dev) != hipSuccess) { grid = -1; return; }
        if (hipFuncSetAttribute((const void*)fwd, hipFuncAttributeMaxDynamicSharedMemorySize, LDS_BYTES) != hipSuccess) { grid = -1; return; }
        int per_cu = 0;
        if (hipOccupancyMaxActiveBlocksPerMultiprocessor(&per_cu, (const void*)fwd, 512, LDS_BYTES) != hipSuccess || per_cu < 1) fprintf(stderr, "kernel_launch: occupancy query says %d\n", per_cu);
        (void)hipGetLastError();
        grid = cus;
    }
    if (grid < 0) return;
    unsigned char* ws = (unsigned char*)d_ws;
    (void)hipMemsetAsync(ws + WS_CTL, 0, CTL_BYTES, stream);
    Args a{};
    for (int i = 0; i < N_IN; ++i) a.in[i] = (const float*)d_in[i];
    a.out = (float*)d_out; a.ws = ws;
#if MK_SINGLE
    a.ph_lo = 0; a.ph_hi = NPHASE;
    hipLaunchKernelGGL(fwd, dim3(grid), dim3(512), LDS_BYTES, stream, a);
#else
    for (int p = 0; p < NPHASE; ++p) { a.ph_lo = p; a.ph_hi = p + 1; hipLaunchKernelGGL(fwd, dim3(grid), dim3(512), LDS_BYTES, stream, a); }
#endif
}
```

```cpp
#include <hip/hip_runtime.h>
#include <cstdio>
#include <cstdint>

#define LAS __attribute__((address_space(3)))
#define GAS __attribute__((address_space(1)))
typedef unsigned short bf16;
typedef float f32x4 __attribute__((ext_vector_type(4)));
typedef float f32x2 __attribute__((ext_vector_type(2)));
typedef unsigned u32x4 __attribute__((ext_vector_type(4)));
typedef unsigned u32x2 __attribute__((ext_vector_type(2)));
typedef short bf16x8 __attribute__((ext_vector_type(8)));

constexpr int DM = 2048, NBATCH = 8, SEQ = 2048, CTXL = 256, DEPTH = 2;
constexpr int TL = NBATCH * SEQ, TC = NBATCH * CTXL, TA = TL + TC;
constexpr int RD = 1024, RHEADS = 16, RHS = 64;
constexpr int RWKV_IN = 3520;
constexpr int GKD = 512, GVD = 1024, GDK = 128, GDV = 256, GHEADS = 4, GQKV = 2048;
constexpr int GLA_OFF = 3520, GLA_AD_OFF = GLA_OFF + GQKV, GLA_GATE_OFF = 5584, BR_OFF = 6608, IN_DIM = 10704, NP = 10752;
constexpr int NEXP = 16, DEXP = 1408;
constexpr int MOD_N = 6 * DM;
constexpr int MOE_ROWS = 41216;
constexpr int MOE_TILES = MOE_ROWS / 256;
constexpr int NCH = 36;
constexpr int KSPLIT = 32;

enum { I_X = 0, I_C, I_CTX, I_CCTX, I_WADA, I_BADA, I_NMG, I_NFG, I_WIN, I_MU, I_W0, I_W2, I_A0, I_A2, I_G2, I_KK, I_KA, I_RK, I_LNG, I_LNB,
       I_GCONV, I_GAW2, I_GAB, I_GNG, I_WBA, I_WBB, I_WOUT, I_RW, I_RB, I_EG, I_EU, I_ED, I_FNG, N_IN };

constexpr size_t MiB = 1u << 20;
constexpr size_t WS_CTL = 0;
constexpr size_t WS_TAB = 1 * MiB;
constexpr size_t WS_MOD = 2 * MiB;
constexpr size_t WS_X = 3 * MiB;
constexpr size_t WS_H = WS_X + 144 * MiB;
constexpr size_t WS_P = WS_H + 72 * MiB;
constexpr size_t WS_RW = WS_P + 378 * MiB;
constexpr size_t WS_GL = WS_RW + 380 * MiB;
constexpr size_t WS_WT = WS_GL + 218 * MiB;
constexpr size_t WS_END = WS_WT + 325 * MiB;
constexpr int CW_TMO = 0, CW_CNT = 64  , CW_BAR = 4096;
constexpr size_t CTL_BYTES = 1 * MiB;
constexpr size_t TAB_ROWTOK = 0;
constexpr size_t TAB_ROWTOK_BYTES = 2 * (size_t)MOE_ROWS * 4;
constexpr size_t TAB_ROWW = 384 * 1024;
constexpr size_t TAB_TILE = 768 * 1024;
constexpr size_t TAB_TOP = 800 * 1024;
static_assert(TAB_ROWTOK_BYTES <= TAB_ROWW && TAB_ROWW + 2 * (size_t)MOE_ROWS * 4 <= TAB_TILE, "tab map");
constexpr size_t WS_MODP = WS_P;
constexpr size_t WS_HP = WS_P;
constexpr size_t WS_ACT = WS_P + 162 * MiB;
constexpr size_t WS_TOPK = WS_P + 274 * MiB;
static_assert((size_t)MOE_ROWS * DM * 2 <= 162 * MiB && (size_t)MOE_ROWS * DEXP * 2 <= 112 * MiB && 274 * MiB + 3 * (size_t)TA * 8 <= 378 * MiB, "P overlay");
constexpr size_t RW_R = WS_RW;
constexpr size_t RW_KS = RW_R + 36 * MiB;
constexpr size_t RW_V = RW_KS + 36 * MiB;
constexpr size_t RW_KK = RW_V + 36 * MiB;
constexpr size_t RW_LO = RW_KK + 36 * MiB;
constexpr size_t RW_Y = RW_LO + 144 * MiB;
constexpr size_t RW_A1 = RW_Y + 72 * MiB;
constexpr size_t RW_A2 = RW_A1 + 9 * MiB;
constexpr size_t RW_BON = RW_A2 + 9 * MiB;
static_assert(RW_BON + 2 * MiB <= WS_GL, "rwkv map");
constexpr size_t GL_QG = WS_GL;
constexpr size_t GL_KG = GL_QG + 36 * MiB;
constexpr size_t GL_KE = GL_KG + 36 * MiB;
constexpr size_t GL_VS = GL_KE + 36 * MiB;
constexpr size_t GL_O = GL_VS + 36 * MiB;
constexpr size_t GL_DEC = GL_O + 72 * MiB;
static_assert(GL_DEC + 2 * MiB <= WS_WT, "gla map");
constexpr size_t WS_YF = WS_GL;
constexpr size_t WT_IN = WS_WT;
constexpr size_t WT_L1 = WT_IN + 42 * MiB;
constexpr size_t WT_G2 = WT_L1 + 2 * MiB;
constexpr size_t WT_A = WT_G2 + 1 * MiB;
constexpr size_t WT_B = WT_A + 4 * MiB;
constexpr size_t WT_O = WT_B + 4 * MiB;
constexpr size_t WT_GU = WT_O + 8 * MiB;
constexpr size_t WT_D = WT_GU + 176 * MiB;
static_assert(WT_D + 88 * MiB == WS_END, "weight map");

#ifndef XBF
#define XBF 1
#endif
__device__ __forceinline__ float bf2f(unsigned v) { return __uint_as_float(v << 16); }
__device__ __forceinline__ float bflo(unsigned w) { return __uint_as_float(w << 16); }
__device__ __forceinline__ float bfhi(unsigned w) { return __uint_as_float(w & 0xffff0000u); }
__device__ __forceinline__ unsigned f2bf(float f) { unsigned u = __float_as_uint(f); return (u + 0x7fffu + ((u >> 16) & 1u)) >> 16; }
__device__ __forceinline__ unsigned pk2(float lo, float hi) { unsigned r; asm volatile("v_cvt_pk_bf16_f32 %0, %1, %2" : "=v"(r) : "v"(lo), "v"(hi)); return r; }
typedef __bf16 bf16x2_t __attribute__((ext_vector_type(2)));
__device__ __forceinline__ unsigned pk2c(float lo, float hi) { f32x2 v = {lo, hi}; bf16x2_t b = __builtin_convertvector(v, bf16x2_t); return __builtin_bit_cast(unsigned, b); }
__device__ __forceinline__ float sigm(float x) { return 1.0f / (1.0f + __expf(-x)); }
__device__ __forceinline__ float siluf(float x) { return x * sigm(x); }
__device__ __forceinline__ float wave_sum(float x) {
    x += __builtin_bit_cast(float, __builtin_amdgcn_update_dpp(0, __builtin_bit_cast(int, x), 0xB1, 0xF, 0xF, true));
    x += __builtin_bit_cast(float, __builtin_amdgcn_update_dpp(0, __builtin_bit_cast(int, x), 0x4E, 0xF, 0xF, true));
    x += __builtin_bit_cast(float, __builtin_amdgcn_update_dpp(0, __builtin_bit_cast(int, x), 0x141, 0xF, 0xF, true));
    x += __builtin_bit_cast(float, __builtin_amdgcn_update_dpp(0, __builtin_bit_cast(int, x), 0x140, 0xF, 0xF, true));
    const int xi = __builtin_bit_cast(int, x);
    return (__builtin_bit_cast(float, __builtin_amdgcn_readlane(xi, 0)) + __builtin_bit_cast(float, __builtin_amdgcn_readlane(xi, 16))) +
           (__builtin_bit_cast(float, __builtin_amdgcn_readlane(xi, 32)) + __builtin_bit_cast(float, __builtin_amdgcn_readlane(xi, 48)));
}
__device__ __forceinline__ void unpack8(const u32x4 w, float (&o)[8]) {
    o[0] = bflo(w.x); o[1] = bfhi(w.x); o[2] = bflo(w.y); o[3] = bfhi(w.y); o[4] = bflo(w.z); o[5] = bfhi(w.z); o[6] = bflo(w.w); o[7] = bfhi(w.w);
}
__device__ __forceinline__ u32x4 pack8(const float (&v)[8]) { u32x4 w; w.x = pk2(v[0], v[1]); w.y = pk2(v[2], v[3]); w.z = pk2(v[4], v[5]); w.w = pk2(v[6], v[7]); return w; }
namespace pg8 {
#define PG8_LAS __attribute__((address_space(3)))
typedef unsigned short bf16_t;
typedef short bf16x8 __attribute__((ext_vector_type(8)));
typedef float f32x4 __attribute__((ext_vector_type(4)));
typedef unsigned u32x4 __attribute__((ext_vector_type(4)));
constexpr int BM = 256, BK = 64, HALF = 128, HTB = HALF * BK * 2  , STAGE_BYTES = 8 * HTB, NXCD = 8, WGM = 8;

__host__ __device__ __forceinline__ int lds_byte(int r, int c) { const int st = (r >> 4) * 2 + (c >> 5), rr = r & 15, cc = c & 31, ob = rr * 64 + cc * 2; return st * 1024 + (ob ^ (((ob >> 9) & 1) << 5)); }
__host__ __device__ __forceinline__ void stage_rc(int b, int& R, int& C) { const int st = b / 1024, sb = b % 1024, swz = sb ^ (((sb >> 9) & 1) << 5); R = (st >> 1) * 16 + swz / 64; C = (st & 1) * 32 + (swz % 64) / 2; }
__host__ __device__ __forceinline__ int perm32(int rho) { const int n = rho >> 4, i = rho & 15; return 8 * (i >> 2) + 4 * n + (i & 3); }
struct Unit { int pm, pn, eb; };
struct Gemm { const bf16_t* A; const bf16_t* Bt; int M, N, K; size_t bstride; };

struct StaticOrder {
    int nM, nN, nwg, G, c;
    __host__ __device__ void init(int M, int N, int G_, int c_) { nM = M / BM; nN = N / BM; nwg = nM * nN; G = G_; c = c_; }
    __host__ __device__ bool next(int i, Unit& u) const {
        const long L = (long)i * G + c; if (L >= nwg) return false;
        int wgid = (int)L; { const int q = nwg / NXCD, r = nwg % NXCD, xcd = wgid % NXCD, off = wgid / NXCD; wgid = (xcd < r ? xcd * (q + 1) : r * (q + 1) + (xcd - r) * q) + off; }
        const int nig = WGM * nN, gid = wgid / nig, fm = gid * WGM, gsz = (nM - fm) < WGM ? (nM - fm) : WGM;
        u.pm = fm + ((wgid % nig) % gsz); u.pn = (wgid % nig) / gsz; u.eb = 0; return true;
    }
    __device__ __forceinline__ void a_ready(const Unit&) const {}
    __device__ __forceinline__ void done(const Unit&) const {}
};
struct MoeOrder {
    const int* tab; int nT, nN, G, c;
    __device__ void init(const int* tab_, int nN_, int G_, int c_) { tab = tab_; nT = tab_[0]; nN = nN_; G = G_; c = c_; }
    __device__ bool next(int i, Unit& u) const {
        const long L = (long)i * G + c; if (L >= (long)nT * nN) return false;
        u.pm = (int)(L / nN); u.pn = (int)(L % nN); u.eb = tab[1 + u.pm]; return true;
    }
    __device__ __forceinline__ void a_ready(const Unit&) const {}
    __device__ __forceinline__ void done(const Unit&) const {}
};

template <class F> struct Epi8 {
    static constexpr bool PERM = true, AFTER_DRAIN = false;
    F f;
    __device__ __forceinline__ void operator()(const f32x4 (&acc)[2][2][4][2], const Unit& u, int wr, int wc, int fr, int fq) const {
        const int row0 = u.pm * BM + wr * 64 + fr, col0 = u.pn * BM + wc * 32 + 8 * fq;
#pragma unroll
        for (int ai = 0; ai < 2; ++ai)
#pragma unroll
            for (int m = 0; m < 4; ++m) {
#pragma unroll
                for (int bj = 0; bj < 2; ++bj) {
                    const f32x4 a = acc[ai][bj][m][0], b = acc[ai][bj][m][1];
                    float v[8] = {a[0], a[1], a[2], a[3], b[0], b[1], b[2], b[3]};
                    f(row0 + ai * HALF + m * 16, col0 + bj * HALF, v, u);
                }
            }
    }
};
template <class F> struct EpiGU {
    static constexpr bool PERM = true, AFTER_DRAIN = false;
    F f;
    __device__ __forceinline__ void operator()(const f32x4 (&acc)[2][2][4][2], const Unit& u, int wr, int wc, int fr, int fq) const {
        const int row0 = u.pm * BM + wr * 64 + fr, col0 = u.pn * HALF + wc * 32 + 8 * fq;
#pragma unroll
        for (int ai = 0; ai < 2; ++ai)
#pragma unroll
            for (int m = 0; m < 4; ++m) {
                const f32x4 g0 = acc[ai][0][m][0], g1 = acc[ai][0][m][1], u0 = acc[ai][1][m][0], u1 = acc[ai][1][m][1];
                float g[8] = {g0[0], g0[1], g0[2], g0[3], g1[0], g1[1], g1[2], g1[3]};
                float up[8] = {u0[0], u0[1], u0[2], u0[3], u1[0], u1[1], u1[2], u1[3]};
                f(row0 + ai * HALF + m * 16, col0, g, up);
            }
    }
};
template <class F> struct Epi4 {
    static constexpr bool PERM = false, AFTER_DRAIN = false;
    F f;
    __device__ __forceinline__ void operator()(const f32x4 (&acc)[2][2][4][2], const Unit& u, int wr, int wc, int fr, int fq) const {
        const int row0 = u.pm * BM + wr * 64 + fr, col0 = u.pn * BM + wc * 32 + 4 * fq;
#pragma unroll
        for (int ai = 0; ai < 2; ++ai)
#pragma unroll
            for (int m = 0; m < 4; ++m) {
#pragma unroll
                for (int bj = 0; bj < 2; ++bj)
#pragma unroll
                    for (int n = 0; n < 2; ++n) f(row0 + ai * HALF + m * 16, col0 + bj * HALF + n * 16, acc[ai][bj][m][n], u);
            }
    }
};
template <class Epi, class Sched, bool ALIGN_EPI = false, bool SP2 = false>
__device__ __forceinline__ void gemm_phase(PG8_LAS unsigned char* lds, const Gemm g, const Sched& S, const Epi& E) {
    int tid_o = threadIdx.x; asm volatile("" : "+v"(tid_o));
    const int tid = tid_o, wid = __builtin_amdgcn_readfirstlane(tid >> 6), lane = tid & 63, wr = wid >> 2, wc = wid & 3, fr = lane & 15, fq = lane >> 4;
    const int K = g.K, nt = K / BK;
    unsigned voffA[2], voffB[2];
#pragma unroll
    for (int i = 0; i < 2; ++i) { int R, C; stage_rc(tid * 16 + i * 8192, R, C); const int Rb = Epi::PERM ? ((R & ~31) + perm32(R & 31)) : R;
        voffA[i] = (unsigned)(R * K + C) * 2u; voffB[i] = (unsigned)(Rb * K + C) * 2u; }
    const size_t kstep = (size_t)(BK * 2);
    const size_t hstep = (size_t)HALF * K * 2;
    const size_t tstep = 2 * hstep;
    const unsigned ldsw = (unsigned)wid * 1024u;
    const int aoff = lds_byte(wr * 64 + fr, fq * 8), boff = lds_byte(wc * 32 + fr, fq * 8);
#define PG8_SA(b, h) (((b) * 2 + (h)) * HTB)
#define PG8_SB(b, h) ((4 + (b) * 2 + (h)) * HTB)
#define PG8_STAGE(bufoff, gbase, voff) do { _Pragma("unroll") for (int _i = 0; _i < 2; ++_i) \
        __builtin_amdgcn_global_load_lds((const unsigned*)((const char*)(gbase) + (voff)[_i]), (PG8_LAS unsigned*)(lds + (bufoff) + ldsw + _i * 8192), 16, 0, 0); } while (0)
#define PG8_LDA(dst, b, h) do { _Pragma("unroll") for (int m = 0; m < 4; ++m) _Pragma("unroll") for (int k = 0; k < 2; ++k) dst[m][k] = *(const PG8_LAS bf16x8*)(lds + PG8_SA(b, h) + aoff + m * 2048 + k * 1024); } while (0)
#define PG8_LDB(dst, b, h) do { _Pragma("unroll") for (int n = 0; n < 2; ++n) _Pragma("unroll") for (int k = 0; k < 2; ++k) dst[n][k] = *(const PG8_LAS bf16x8*)(lds + PG8_SB(b, h) + boff + n * 2048 + k * 1024); } while (0)
#define PG8_MMA(ai, bj, At, Bt) do { __builtin_amdgcn_s_setprio(1); _Pragma("unroll") for (int m = 0; m < 4; ++m) _Pragma("unroll") for (int n = 0; n < 2; ++n) _Pragma("unroll") for (int k = 0; k < 2; ++k) \
        acc[ai][bj][m][n] = __builtin_amdgcn_mfma_f32_16x16x32_bf16(Bt[n][k], At[m][k], acc[ai][bj][m][n], 0, 0, 0); __builtin_amdgcn_s_setprio(0); } while (0)
#define PG8_WAIT_V(n) asm volatile("s_waitcnt vmcnt(" #n ")" ::: "memory")
#define PG8_WAIT_L(n) asm volatile("s_waitcnt lgkmcnt(" #n ")" ::: "memory")
#define PG8_BAR __builtin_amdgcn_s_barrier()
#define PG8_SCHED __builtin_amdgcn_sched_barrier(0)
    Unit cur, nxt; int ui = 0;
    if (!S.next(0, cur)) return;
    f32x4 acc[2][2][4][2];
#pragma unroll
    for (int a = 0; a < 2; ++a)
#pragma unroll
        for (int b = 0; b < 2; ++b)
#pragma unroll
            for (int m = 0; m < 4; ++m)
#pragma unroll
                for (int n = 0; n < 2; ++n) acc[a][b][m][n] = (f32x4){0.f, 0.f, 0.f, 0.f};
    bf16x8 At[4][2], B0[2][2], B1[2][2];
    const char* cA = (const char*)g.A + (size_t)cur.pm * tstep; const char* cB = (const char*)g.Bt + (size_t)cur.eb * g.bstride + (size_t)cur.pn * tstep;
    S.a_ready(cur);
    if constexpr (SP2) {
        PG8_STAGE(PG8_SB(0, 0), cB, voffB); PG8_STAGE(PG8_SB(0, 1), cB + hstep, voffB); PG8_STAGE(PG8_SA(0, 0), cA, voffA); PG8_STAGE(PG8_SA(0, 1), cA + hstep, voffA);
        if (wr == 1) PG8_BAR;
        PG8_WAIT_V(2); PG8_BAR;
        PG8_STAGE(PG8_SB(1, 0), cB + kstep, voffB); PG8_STAGE(PG8_SA(1, 0), cA + kstep, voffA); PG8_STAGE(PG8_SB(1, 1), cB + hstep + kstep, voffB);
        PG8_WAIT_V(6); PG8_BAR;
    } else {
        PG8_STAGE(PG8_SB(0, 0), cB, voffB); PG8_STAGE(PG8_SA(0, 0), cA, voffA); PG8_STAGE(PG8_SB(0, 1), cB + hstep, voffB); PG8_STAGE(PG8_SA(0, 1), cA + hstep, voffA);
        if (wr == 1) PG8_BAR;
        PG8_WAIT_V(4); PG8_BAR;
        PG8_STAGE(PG8_SB(1, 0), cB + kstep, voffB); PG8_STAGE(PG8_SA(1, 0), cA + kstep, voffA); PG8_STAGE(PG8_SB(1, 1), cB + hstep + kstep, voffB);
        PG8_WAIT_V(6); PG8_BAR;
    }
    for (;;) {
        const bool has_next = S.next(ui + 1, nxt);
        const char* nA = has_next ? (const char*)g.A + (size_t)nxt.pm * tstep : cA; const char* nB = has_next ? (const char*)g.Bt + (size_t)nxt.eb * g.bstride + (size_t)nxt.pn * tstep : cB;
#pragma nounroll
        for (int t = 0; t < nt; t += 2) {
            const bool last = (t == nt - 2);
            const char* a1 = cA + (size_t)(t + 1) * kstep;
            const char* a2 = last ? nA : cA + (size_t)(t + 2) * kstep; const char* b2 = last ? nB : cB + (size_t)(t + 2) * kstep;
            const char* a3 = a2 + kstep; const char* b3 = b2 + kstep;
            if (last && has_next) S.a_ready(nxt);
            if constexpr (SP2) {
            PG8_LDB(B0, 0, 0); PG8_LDB(B1, 0, 1); PG8_SCHED; PG8_LDA(At, 0, 0); PG8_STAGE(PG8_SA(1, 1), a1 + hstep, voffA);
            PG8_WAIT_V(8); PG8_WAIT_L(0); PG8_BAR; PG8_MMA(0, 0, At, B0); PG8_MMA(0, 1, At, B1); PG8_BAR; PG8_SCHED;
            PG8_LDA(At, 0, 1); PG8_STAGE(PG8_SB(0, 0), b2, voffB); PG8_STAGE(PG8_SB(0, 1), b2 + hstep, voffB); PG8_STAGE(PG8_SA(0, 0), a2, voffA);
            PG8_WAIT_V(8); PG8_WAIT_L(0); PG8_BAR; PG8_MMA(1, 0, At, B0); PG8_MMA(1, 1, At, B1); PG8_BAR; PG8_SCHED;
            PG8_LDB(B0, 1, 0); PG8_LDB(B1, 1, 1); PG8_SCHED; PG8_LDA(At, 1, 0); PG8_STAGE(PG8_SA(0, 1), a2 + hstep, voffA);
            PG8_WAIT_V(8); PG8_WAIT_L(0); PG8_BAR; PG8_MMA(0, 0, At, B0); PG8_MMA(0, 1, At, B1); PG8_BAR; PG8_SCHED;
            PG8_LDA(At, 1, 1); PG8_STAGE(PG8_SB(1, 0), b3, voffB); PG8_STAGE(PG8_SB(1, 1), b3 + hstep, voffB); PG8_STAGE(PG8_SA(1, 0), a3, voffA);
            PG8_WAIT_V(8); PG8_WAIT_L(0); PG8_BAR; PG8_MMA(1, 0, At, B0); PG8_MMA(1, 1, At, B1); PG8_BAR; PG8_SCHED;
            } else {
            PG8_LDB(B0, 0, 0); PG8_SCHED; PG8_LDA(At, 0, 0); PG8_STAGE(PG8_SA(1, 1), a1 + hstep, voffA);
            PG8_WAIT_L(8); PG8_BAR; PG8_WAIT_L(0); PG8_MMA(0, 0, At, B0); PG8_BAR; PG8_SCHED;
            PG8_LDB(B1, 0, 1); PG8_STAGE(PG8_SB(0, 0), b2, voffB);
            PG8_BAR; PG8_WAIT_L(0); PG8_MMA(0, 1, At, B1); PG8_BAR;
            PG8_LDA(At, 0, 1); PG8_STAGE(PG8_SA(0, 0), a2, voffA);
            PG8_BAR; PG8_WAIT_L(0); PG8_MMA(1, 0, At, B0); PG8_BAR; PG8_SCHED;
            PG8_STAGE(PG8_SB(0, 1), b2 + hstep, voffB);
            PG8_WAIT_V(6); PG8_BAR; PG8_MMA(1, 1, At, B1); PG8_BAR;
            PG8_LDB(B0, 1, 0); PG8_SCHED; PG8_LDA(At, 1, 0); PG8_STAGE(PG8_SA(0, 1), a2 + hstep, voffA);
            PG8_WAIT_L(8); PG8_BAR; PG8_WAIT_L(0); PG8_MMA(0, 0, At, B0); PG8_BAR; PG8_SCHED;
            PG8_LDB(B1, 1, 1); PG8_STAGE(PG8_SB(1, 0), b3, voffB);
            PG8_BAR; PG8_WAIT_L(0); PG8_MMA(0, 1, At, B1); PG8_BAR;
            PG8_LDA(At, 1, 1); PG8_STAGE(PG8_SA(1, 0), a3, voffA);
            PG8_BAR; PG8_WAIT_L(0); PG8_MMA(1, 0, At, B0); PG8_BAR; PG8_SCHED;
            PG8_STAGE(PG8_SB(1, 1), b3 + hstep, voffB);
            PG8_WAIT_V(6); PG8_BAR; PG8_MMA(1, 1, At, B1); PG8_BAR;
            }
        }
        if constexpr (ALIGN_EPI) { if (wr == 0) PG8_BAR; }
        if constexpr (!Epi::AFTER_DRAIN) { E(acc, cur, wr, wc, fr, fq); S.done(cur); }
        if (!has_next) break;
#pragma unroll
        for (int a = 0; a < 2; ++a)
#pragma unroll
            for (int b = 0; b < 2; ++b)
#pragma unroll
                for (int m = 0; m < 4; ++m)
#pragma unroll
                    for (int n = 0; n < 2; ++n) acc[a][b][m][n] = (f32x4){0.f, 0.f, 0.f, 0.f};
        cur = nxt; cA = nA; cB = nB; ++ui;
        if constexpr (ALIGN_EPI) { if (wr == 1) PG8_BAR; }
    }
    PG8_WAIT_V(0);
    if constexpr (!ALIGN_EPI) { if (wr == 0) PG8_BAR; }
    PG8_BAR;
    if constexpr (Epi::AFTER_DRAIN) { E.fused(acc, cur, wr, wc, fr, fq, lds, wid, lane); S.done(cur); }
#undef PG8_SA
#undef PG8_SB
#undef PG8_STAGE
#undef PG8_LDA
#undef PG8_LDB
#undef PG8_MMA
#undef PG8_WAIT_V
#undef PG8_WAIT_L
#undef PG8_BAR
#undef PG8_SCHED
}
}

#ifndef PG8_SP2
#define PG8_SP2 true
#endif
#ifndef PG8_ALIGN
#define PG8_ALIGN true
#endif
#define XB_TMO      128
#define XB_XCNT(j)  (256  + 64 * (j))
#define XB_XSUB(j)  (1280 + 64 * (j))
#define XB_XGEN(j)  (2304 + 64 * (j))
#define XB_TOP      3328
#define XB_TOPGEN   3392
#define XCD_BAR_WORDS 3456
#define XB_SPIN_CAP (1u << 18)

__device__ __forceinline__ unsigned xb_ld(unsigned* p)              { return __hip_atomic_load(p, __ATOMIC_RELAXED, __HIP_MEMORY_SCOPE_AGENT); }
__device__ __forceinline__ unsigned xb_add(unsigned* p, unsigned v) { return __hip_atomic_fetch_add(p, v, __ATOMIC_RELAXED, __HIP_MEMORY_SCOPE_AGENT); }
__device__ __forceinline__ unsigned xb_xcc_id() { return (unsigned)__builtin_amdgcn_s_getreg((3 << 11) | 20) & 0xFu; }
#define XB_SPIN(cond, bar) do { unsigned _sp = 0; while (cond) { __builtin_amdgcn_s_sleep(1); \
    if ((++_sp & 255u) == 0u) { if (xb_ld(&(bar)[XB_TMO])) break; if (_sp > XB_SPIN_CAP) { atomicAdd(&(bar)[XB_TMO], 1u); break; } } } } while (0)

struct XcdBarrier {
    unsigned* bar; unsigned x;
    volatile LAS unsigned* st;
};

__device__ __forceinline__ XcdBarrier xcd_barrier_post(unsigned* bar, volatile LAS unsigned* st) {
    XcdBarrier b; b.bar = bar; b.x = xb_xcc_id(); b.st = st;
    if (threadIdx.x == 0) (void)xb_add(&bar[XB_XCNT(b.x)], 1u);
    return b;
}
__device__ __forceinline__ void xcd_barrier_complete(unsigned* bar, unsigned x, unsigned& nloc, unsigned& nx) {
    const unsigned G = gridDim.x * gridDim.y * gridDim.z;
    unsigned sum, cnt, mine, sp = 0u;
    for (;;) {
        sum = 0u; cnt = 0u; mine = 0u;
#pragma unroll
        for (unsigned j = 0; j < 16; ++j) { const unsigned c = xb_ld(&bar[XB_XCNT(j)]); sum += c; cnt += (c > 0u) ? 1u : 0u; mine = (j == x) ? c : mine; }
        if (sum == G) break;
        __builtin_amdgcn_s_sleep(1);
        if ((++sp & 255u) == 0u) { if (xb_ld(&bar[XB_TMO])) break; if (sp > XB_SPIN_CAP) { atomicAdd(&bar[XB_TMO], 1u); break; } }
    }
    nloc = mine > 0u ? mine : 1u; nx = cnt > 0u ? cnt : 1u;
}

__device__ __forceinline__ void xcd_barrier(const XcdBarrier& b) {
    asm volatile("s_waitcnt vmcnt(0)" ::: "memory");
    __syncthreads();
    if (threadIdx.x == 0) {
        unsigned* bar = b.bar;
        __builtin_amdgcn_s_waitcnt(0);
        unsigned nloc = b.st[0], nx = b.st[1];
        if (nloc == 0u) { xcd_barrier_complete(bar, b.x, nloc, nx); b.st[0] = nloc; b.st[1] = nx; }
        const unsigned old = xb_add(&bar[XB_XSUB(b.x)], 1u);
        const unsigned gen = old / nloc;
        if (old + 1u == (gen + 1u) * nloc) {
            __builtin_amdgcn_fence(__ATOMIC_RELEASE, "agent");
            asm volatile("s_waitcnt vmcnt(0)" ::: "memory");
            const unsigned og = xb_add(&bar[XB_TOP], 1u);
            const unsigned tg = og / nx;
            if (og + 1u == (tg + 1u) * nx) xb_add(&bar[XB_TOPGEN], 1u);
            else XB_SPIN(xb_ld(&bar[XB_TOPGEN]) == tg, bar);
            __builtin_amdgcn_fence(__ATOMIC_ACQUIRE, "agent");
            xb_add(&bar[XB_XGEN(b.x)], 1u);
            asm volatile("s_waitcnt vmcnt(0)" ::: "memory");
        } else {
            XB_SPIN(xb_ld(&bar[XB_XGEN(b.x)]) == gen, bar);
            __builtin_amdgcn_fence(__ATOMIC_ACQUIRE, "agent");
            asm volatile("s_waitcnt vmcnt(0)" ::: "memory");
        }
    }
    __syncthreads();
}
struct KC {
    const float* const* in;
    LAS unsigned char* lds;
    unsigned char* ws;
    int tid, lane, wave, G, bid;
};
__device__ __forceinline__ const float* inp_(int i) {
    const volatile unsigned long long __attribute__((address_space(4)))* kp = (const volatile unsigned long long __attribute__((address_space(4)))*)__builtin_amdgcn_kernarg_segment_ptr();
    return (const float*)(const GAS float*)kp[i];
}
#define INP(k) (inp_(k))

__device__ __forceinline__ int mod_row(int row) { return row < TL ? (row >> 11) : 8; }

__device__ __forceinline__ void ph_adaln_partials(const KC& k, const float* c, const float* c_ctx, const float* w_ada) {
    LAS float* sc = (LAS float*)k.lds;
    for (int i = k.tid; i < 9 * DM; i += 512) { const int r = i >> 11, kk = i & 2047; const float cv = r < 8 ? c[r * DM + kk] : c_ctx[kk]; sc[i] = siluf(cv); }
    __syncthreads();
    float* modp = (float*)(k.ws + WS_MODP);
    const int cc = k.tid & 255, kh = k.tid >> 8;
    constexpr int NIT = DEPTH * 48 * 16;
    for (int it = k.bid; it < NIT; it += k.G) {
        const int l = it / 768, rem = it % 768, cb = rem >> 4, ks = rem & 15;
        const int col = cb * 256 + cc, kbeg = ks * 128 + kh * 64;
        const float* W = w_ada + ((size_t)l * DM + kbeg) * MOD_N + col;
        float acc[9];
#pragma unroll
        for (int r = 0; r < 9; ++r) acc[r] = 0.f;
#pragma unroll 32
        for (int q = 0; q < 64; ++q) {
            const float w = W[(size_t)q * MOD_N];
#pragma unroll
            for (int r = 0; r < 9; ++r) acc[r] += sc[r * DM + kbeg + q] * w;
        }
        const int s = ks * 2 + kh;
#pragma unroll
        for (int r = 0; r < 9; ++r) modp[(((size_t)s * DEPTH + l) * 9 + r) * MOD_N + col] = acc[r];
    }
    __syncthreads();
}
__device__ __forceinline__ void ph_adaln_reduce(const KC& k, const float* b_ada) {
    const float* modp = (const float*)(k.ws + WS_MODP); float* mod = (float*)(k.ws + WS_MOD);
    constexpr int TOT = DEPTH * 9 * MOD_N;
    for (int i = k.bid * 512 + k.tid; i < TOT; i += k.G * 512) {
        const int n = i % MOD_N, l = i / (9 * MOD_N);
        float s = b_ada[l * MOD_N + n];
#pragma unroll 8
        for (int q = 0; q < KSPLIT; ++q) s += modp[(size_t)q * TOT + i];
        mod[i] = s;
    }
}

struct TrItem { const float* src; bf16* dst; int srcN, Kv, Nv, k0, n0, dpitch, drow0, dk0; };
struct WSrc { const float *w_in, *w2, *a2, *g2, *wba, *wbb, *wout, *eg, *eu, *ed, *w0, *a0; };
constexpr int TI_IN = 32 * 336, TI_LO = 4 * 64, TI_G2 = 4 * 32, TI_AB = 16 * 64, TI_O = 32 * 64, TI_GU1 = 32 * 44, TI_D1 = 22 * 64;
constexpr int TI_N = TI_IN + TI_LO + TI_G2 + 2 * TI_AB + TI_O + 2 * NEXP * TI_GU1 + NEXP * TI_D1;
__device__ __forceinline__ TrItem tr_decode(const WSrc& s, unsigned char* ws, int l, int it) {
    TrItem t; int r = it;
    if (r < TI_IN) { const int kb = r / 336, nb = r % 336; t = TrItem{s.w_in + (size_t)l * DM * IN_DIM, (bf16*)(ws + WT_IN), IN_DIM, DM, IN_DIM, 64 * kb, 32 * nb, DM, 32 * nb, 0}; return t; } r -= TI_IN;
    if (r < TI_LO) {
        const int mtx = r >> 6, q = r & 63, kb = q >> 5, nb = q & 31;
        t = TrItem{(mtx < 2 ? s.w2 : s.a2) + (size_t)(l * 2 + (mtx & 1)) * 96 * RD, (bf16*)(ws + WT_L1), RD, 96, RD, 64 * kb, 32 * nb, 256, mtx * 1024 + 32 * nb, mtx < 2 ? 0 : 96}; return t; } r -= TI_LO;
    if (r < TI_G2) { const int kb = r >> 5, nb = r & 31; t = TrItem{s.g2 + (size_t)l * 256 * RD, (bf16*)(ws + WT_G2), RD, 256, RD, 64 * kb, 32 * nb, 256, 32 * nb, 0}; return t; } r -= TI_G2;
    if (r < TI_AB) { const int kb = r >> 6, nb = r & 63; t = TrItem{s.wba + (size_t)l * RD * DM, (bf16*)(ws + WT_A), DM, RD, DM, 64 * kb, 32 * nb, RD, 32 * nb, 0}; return t; } r -= TI_AB;
    if (r < TI_AB) { const int kb = r >> 6, nb = r & 63; t = TrItem{s.wbb + (size_t)l * GVD * DM, (bf16*)(ws + WT_B), DM, GVD, DM, 64 * kb, 32 * nb, GVD, 32 * nb, 0}; return t; } r -= TI_AB;
    if (r < TI_O) { const int kb = r >> 6, nb = r & 63; t = TrItem{s.wout + (size_t)l * DM * DM, (bf16*)(ws + WT_O), DM, DM, DM, 64 * kb, 32 * nb, DM, 32 * nb, 0}; return t; } r -= TI_O;
    if (r < 2 * NEXP * TI_GU1) {
        const int e = r / (2 * TI_GU1), q = r % (2 * TI_GU1), up = q / TI_GU1, q2 = q % TI_GU1, kb = q2 / 44, nb = q2 % 44;
        const int n0 = 32 * nb, drow = 256 * (n0 >> 7) + (n0 & 127) + (up ? 128 : 0);
        t = TrItem{(up ? s.eu : s.eg) + ((size_t)l * NEXP + e) * DM * DEXP, (bf16*)(ws + WT_GU) + (size_t)e * 2816 * DM, DEXP, DM, DEXP, 64 * kb, n0, DM, drow, 0}; return t; } r -= 2 * NEXP * TI_GU1;
    { const int e = r / TI_D1, q = r % TI_D1, kb = q >> 6, nb = q & 63;
      t = TrItem{s.ed + ((size_t)l * NEXP + e) * DEXP * DM, (bf16*)(ws + WT_D) + (size_t)e * DM * DEXP, DM, DEXP, DM, 64 * kb, 32 * nb, DEXP, 32 * nb, 0}; }
    return t;
}
__device__ __forceinline__ void tr_load(const TrItem& t, int lane, float (&v)[32]) {
    const int nn = lane & 31, kh = lane >> 5;
    const bool nok = t.n0 + nn < t.Nv;
    const float* p = t.src + (size_t)(t.k0 + kh) * t.srcN + t.n0 + nn;
#pragma unroll
    for (int i = 0; i < 32; ++i) { v[i] = 0.f; if (nok && t.k0 + 2 * i + kh < t.Kv) v[i] = p[(size_t)(2 * i) * t.srcN]; }
}
__device__ __forceinline__ void tr_store(const TrItem& t, int lane, const float (&v)[32], LAS float* scr) {
    const int nn = lane & 31, kh = lane >> 5;
#pragma unroll
    for (int i = 0; i < 32; ++i) scr[(2 * i + kh) * 33 + nn] = v[i];
    asm volatile("s_waitcnt lgkmcnt(0)" ::: "memory");
    const int cidx = lane & 7;
#pragma unroll
    for (int j = 0; j < 4; ++j) {
        const int n = (lane >> 3) + 8 * j; const LAS float* s = scr + (8 * cidx) * 33 + n;
        u32x4 o; o.x = pk2(s[0 * 33], s[1 * 33]); o.y = pk2(s[2 * 33], s[3 * 33]); o.z = pk2(s[4 * 33], s[5 * 33]); o.w = pk2(s[6 * 33], s[7 * 33]);
        *(u32x4*)(t.dst + (size_t)(t.drow0 + n) * t.dpitch + t.dk0 + t.k0 + 8 * cidx) = o;
    }
    asm volatile("s_waitcnt lgkmcnt(0)" ::: "memory");
}
__device__ __forceinline__ void ph_convert(const KC& k, const WSrc& s, int l) {
    LAS float* scr = (LAS float*)(k.lds + k.wave * 16384);
    const int gw = k.bid * 8 + k.wave, NGW = k.G * 8;
    unsigned char* ws = k.ws;
    { float* b1 = (float*)(ws + WS_TAB + TAB_TOP); for (int i = gw * 64 + k.lane; i < 4096; i += NGW * 64) b1[i] = i < 2048 ? s.w0[l * 2048 + i] : s.a0[l * 2048 + i - 2048]; }
    {
        u32x4* wl = (u32x4*)(ws + WT_L1);
        for (int i = gw * 64 + k.lane; i < 4096 * 32; i += NGW * 64) { const int row = i >> 5, ck = i & 31; if (row < 2048 ? ck >= 16 : (ck < 12 || ck >= 28)) wl[i] = (u32x4){0u, 0u, 0u, 0u}; }
        if (l == 0) { int* rt = (int*)(ws + WS_TAB + TAB_ROWTOK); for (int i = gw * 64 + k.lane; i < 2 * MOE_ROWS; i += NGW * 64) rt[i] = -1; }
    }
    float cur[32], nxt[32];
    int it = gw;
    TrItem tc = tr_decode(s, ws, l, it < TI_N ? it : 0);
    if (it < TI_N) tr_load(tc, k.lane, cur);
    for (; it < TI_N; it += NGW) {
        const bool more = it + NGW < TI_N;
        const TrItem tn = tr_decode(s, ws, l, more ? it + NGW : it);
        if (more) tr_load(tn, k.lane, nxt);
        tr_store(tc, k.lane, cur, scr);
        tc = tn;
#pragma unroll
        for (int i = 0; i < 32; ++i) cur[i] = nxt[i];
    }
}

constexpr int RWP = DM + 4;
struct RowArgs { const float *x_in, *ctx_in, *gvec, *router_w, *router_b; float* out; };
template <int MODE>
__device__ __forceinline__ void ph_rows(const KC& k, const RowArgs& ra, int l, int nrows, bool dry = false) {
    const int gw = k.bid * 8 + k.wave, NGW = k.G * 8, lane = k.lane;
    float* X = (float*)(k.ws + WS_X); bf16* H = (bf16*)(k.ws + WS_H);
    bf16* Xb = (bf16*)(k.ws + WS_X);
    const float* MOD = (const float*)(k.ws + WS_MOD);
    const bf16* YF = (const bf16*)(k.ws + WS_YF);
    LAS float* rwT = (LAS float*)k.lds;
    if (MODE == 1) {
        for (int i = k.tid; i < DM * NEXP; i += 512) { const int c = i >> 4, e = i & 15; rwT[e * RWP + c] = ra.router_w[i]; }
        __syncthreads();
    }
    const float* gv = ra.gvec;
    for (int row = gw; row < nrows; row += NGW) {
        const int mr = mod_row(row);
        f32x4 v[8];
        if (MODE == 0 && l == 0) {
            const f32x4* src = (const f32x4*)(row < TL ? ra.x_in + (size_t)row * DM : ra.ctx_in + (size_t)(row - TL) * DM) + lane;
#pragma unroll
            for (int j = 0; j < 8; ++j) v[j] = src[64 * j];
        } else if (XBF) {
            const u32x2* src = (const u32x2*)(Xb + (size_t)row * DM) + lane;
#pragma unroll
            for (int j = 0; j < 8; ++j) { const u32x2 a = src[64 * j]; v[j] = (f32x4){bflo(a.x), bfhi(a.x), bflo(a.y), bfhi(a.y)}; }
        } else {
            const f32x4* src = (const f32x4*)(X + (size_t)row * DM) + lane;
#pragma unroll
            for (int j = 0; j < 8; ++j) v[j] = src[64 * j];
        }
        if ((MODE == 0 && l > 0) || MODE == 2) {
            const int lp = (MODE == 2) ? DEPTH - 1 : l - 1;
            const f32x4* gate = (const f32x4*)(MOD + ((size_t)lp * 9 + mr) * MOD_N + 5 * DM) + lane;
            const u32x2* y0 = (const u32x2*)(YF + (size_t)row * DM) + lane;
            const u32x2* y1 = (const u32x2*)(YF + ((size_t)TA + row) * DM) + lane;
#pragma unroll
            for (int j = 0; j < 8; ++j) {
                const f32x4 g = gate[64 * j]; const u32x2 a = y0[64 * j], b = y1[64 * j];
                v[j].x += g.x * (bflo(a.x) + bflo(b.x)); v[j].y += g.y * (bfhi(a.x) + bfhi(b.x));
                v[j].z += g.z * (bflo(a.y) + bflo(b.y)); v[j].w += g.w * (bfhi(a.y) + bfhi(b.y));
            }
        }
        if (MODE == 0 && XBF) {
            u32x2* dst = (u32x2*)(Xb + (size_t)row * DM) + lane;
#pragma unroll
            for (int j = 0; j < 8; ++j) { u32x2 o; o.x = pk2(v[j].x, v[j].y); o.y = pk2(v[j].z, v[j].w); dst[64 * j] = o; }
        } else if (MODE == 0) {
            f32x4* dst = (f32x4*)(X + (size_t)row * DM) + lane;
#pragma unroll
            for (int j = 0; j < 8; ++j) dst[64 * j] = v[j];
        }
        float ss = 0.f;
#pragma unroll
        for (int j = 0; j < 8; ++j) ss += (v[j].x * v[j].x + v[j].y * v[j].y) + (v[j].z * v[j].z + v[j].w * v[j].w);
        const float rinv = 1.0f / sqrtf(wave_sum(ss) * (1.0f / DM) + 1e-6f);
        if (MODE == 2) {
            f32x4* dst = (f32x4*)(ra.out + (size_t)row * DM) + lane; const f32x4* g4 = (const f32x4*)gv + lane;
#pragma unroll
            for (int j = 0; j < 8; ++j) { const f32x4 g = g4[64 * j]; dst[64 * j] = v[j] * rinv * g; }
        } else {
            const float* mrow = MOD + ((size_t)l * 9 + mr) * MOD_N + (MODE == 0 ? 0 : 3 * DM);
            const f32x4* sh4 = (const f32x4*)mrow + lane; const f32x4* sc4 = (const f32x4*)(mrow + DM) + lane; const f32x4* g4 = (const f32x4*)(gv + (size_t)l * DM) + lane;
            u32x2* dst = (u32x2*)(H + (size_t)row * DM) + lane;
#pragma unroll
            for (int j = 0; j < 8; ++j) {
                const f32x4 g = g4[64 * j], sh = sh4[64 * j], sc = sc4[64 * j];
                v[j] = v[j] * rinv * g * (1.0f + sc) + sh;
                u32x2 o; o.x = pk2(v[j].x, v[j].y); o.y = pk2(v[j].z, v[j].w); dst[64 * j] = o;
            }
        }
        if (MODE == 1) {
            float lg[NEXP];
#pragma unroll
            for (int e = 0; e < NEXP; ++e) {
                float s = 0.f;
#pragma unroll
                for (int j = 0; j < 8; ++j) { const f32x4 w = *(const LAS f32x4*)(rwT + e * RWP + 4 * lane + 256 * j); s += (v[j].x * w.x + v[j].y * w.y) + (v[j].z * w.z + v[j].w * w.w); }
                lg[e] = wave_sum(s);
            }
            float sc[NEXP], sel[NEXP];
#pragma unroll
            for (int e = 0; e < NEXP; ++e) { sc[e] = 1.0f / (1.0f + expf(-lg[e])); sel[e] = sc[e] + ra.router_b[e]; }
            float gs[4], w1g[4], w2g[4]; int i1g[4], i2g[4];
#pragma unroll
            for (int g = 0; g < 4; ++g) {
                int i1 = 0; float m1 = sel[4 * g];
#pragma unroll
                for (int q = 1; q < 4; ++q) if (sel[4 * g + q] > m1) { m1 = sel[4 * g + q]; i1 = q; }
                int i2 = -1; float m2 = -3.0e38f;
#pragma unroll
                for (int q = 0; q < 4; ++q) if (q != i1 && sel[4 * g + q] > m2) { m2 = sel[4 * g + q]; i2 = q; }
                gs[g] = m1 + m2; i1g[g] = 4 * g + i1; i2g[g] = 4 * g + i2;
                float a1 = sc[4 * g], a2 = sc[4 * g];
#pragma unroll
                for (int q = 0; q < 4; ++q) { a1 = (q == i1) ? sc[4 * g + q] : a1; a2 = (q == i2) ? sc[4 * g + q] : a2; }
                w1g[g] = a1; w2g[g] = a2;
            }
            int best = 0; float bs = gs[0];
#pragma unroll
            for (int g = 1; g < 4; ++g) if (gs[g] > bs) { bs = gs[g]; best = g; }
            int e1 = i1g[0], e2 = i2g[0]; float w1 = w1g[0], w2 = w2g[0];
#pragma unroll
            for (int g = 1; g < 4; ++g) { e1 = (best == g) ? i1g[g] : e1; e2 = (best == g) ? i2g[g] : e2; w1 = (best == g) ? w1g[g] : w1; w2 = (best == g) ? w2g[g] : w2; }
            const float inv = 1.0f / (w1 + w2);
            if (lane == 0 && !dry) {
                unsigned* cnt = (unsigned*)(k.ws + WS_CTL) + CW_CNT + 64 * l;
                const int p1 = (int)atomicAdd(cnt + e1, 1u), p2 = (int)atomicAdd(cnt + e2, 1u);
                int* te = (int*)(k.ws + WS_TOPK); float* tw = (float*)(k.ws + WS_TOPK + (size_t)TA * 8); int* tp = (int*)(k.ws + WS_TOPK + 2 * (size_t)TA * 8);
                te[2 * row] = e1; te[2 * row + 1] = e2; tw[2 * row] = w1 * inv; tw[2 * row + 1] = w2 * inv; tp[2 * row] = p1; tp[2 * row + 1] = p2;
            }
        }
    }
    if (MODE == 1) __syncthreads();
}

__device__ __forceinline__ void ph_moe_scatter(const KC& k, int l, int nrows) {
    LAS int* offs = (LAS int*)k.lds;
    const unsigned* cnt = (const unsigned*)(k.ws + WS_CTL) + CW_CNT + 64 * l;
    int* tile = (int*)(k.ws + WS_TAB + TAB_TILE) + 256 * l;
    if (k.tid == 0) {
        int off = 0, nt = 0;
        for (int e = 0; e < NEXP; ++e) {
            offs[e] = off; const int c = (int)__hip_atomic_load(cnt + e, __ATOMIC_RELAXED, __HIP_MEMORY_SCOPE_AGENT); const int t = (c + 255) >> 8;
            if (k.bid == 0) for (int q = 0; q < t; ++q) tile[1 + nt + q] = e;
            nt += t; off += t * 256;
        }
        if (k.bid == 0) tile[0] = nt;
    }
    __syncthreads();
    const int gw = k.bid * 8 + k.wave, NGW = k.G * 8, lane = k.lane;
    const bf16* H = (const bf16*)(k.ws + WS_H); bf16* HP = (bf16*)(k.ws + WS_HP);
    const int* te = (const int*)(k.ws + WS_TOPK); const float* tw = (const float*)(k.ws + WS_TOPK + (size_t)TA * 8); const int* tp = (const int*)(k.ws + WS_TOPK + 2 * (size_t)TA * 8);
    int* rowtok = (int*)(k.ws + WS_TAB + TAB_ROWTOK) + (size_t)l * MOE_ROWS; float* roww = (float*)(k.ws + WS_TAB + TAB_ROWW) + (size_t)l * MOE_ROWS;
    for (int row = gw; row < nrows; row += NGW) {
        const u32x4* src = (const u32x4*)(H + (size_t)row * DM) + lane;
        u32x4 d[4];
#pragma unroll
        for (int j = 0; j < 4; ++j) d[j] = src[64 * j];
#pragma unroll
        for (int s = 0; s < 2; ++s) {
            const int e = te[2 * row + s], dest = offs[e] + tp[2 * row + s];
            u32x4* dp = (u32x4*)(HP + (size_t)dest * DM) + lane;
#pragma unroll
            for (int j = 0; j < 4; ++j) dp[64 * j] = d[j];
            if (lane == 0) { rowtok[dest] = 2 * row + s; roww[dest] = tw[2 * row + s]; }
        }
    }
    __syncthreads();
}
__device__ __forceinline__ void ld16(const bf16* p, bool ok, float (&o)[16]) {
    if (ok) { const u32x4 a = *(const u32x4*)p, b = *(const u32x4*)(p + 8); float x[8], y[8]; unpack8(a, x); unpack8(b, y);
#pragma unroll
        for (int i = 0; i < 8; ++i) { o[i] = x[i]; o[8 + i] = y[i]; } }
    else {
#pragma unroll
        for (int i = 0; i < 16; ++i) o[i] = 0.f; }
}
__device__ __forceinline__ void st16(bf16* p, const float (&v)[16]) {
    float a[8], b[8];
#pragma unroll
    for (int i = 0; i < 8; ++i) { a[i] = v[i]; b[i] = v[8 + i]; }
    *(u32x4*)p = pack8(a); *(u32x4*)(p + 8) = pack8(b);
}
__device__ __forceinline__ void shift8(const bf16* p0, bool hp, bool hn, int c, const float* mu0, const float* mu1, float (&s)[8]) {
    float x[8], xm[8], xp[8];
    unpack8(*(const u32x4*)(p0 + c), x);
    if (hp) unpack8(*(const u32x4*)(p0 - NP + c), xm); else {
#pragma unroll
        for (int i = 0; i < 8; ++i) xm[i] = 0.f; }
    if (hn) unpack8(*(const u32x4*)(p0 + NP + c), xp); else {
#pragma unroll
        for (int i = 0; i < 8; ++i) xp[i] = 0.f; }
    const f32x4 m0a = *(const f32x4*)(mu0 + c), m0b = *(const f32x4*)(mu0 + c + 4), m1a = *(const f32x4*)(mu1 + c), m1b = *(const f32x4*)(mu1 + c + 4);
    const float m0[8] = {m0a.x, m0a.y, m0a.z, m0a.w, m0b.x, m0b.y, m0b.z, m0b.w}, m1[8] = {m1a.x, m1a.y, m1a.z, m1a.w, m1b.x, m1b.y, m1b.z, m1b.w};
#pragma unroll
    for (int i = 0; i < 8; ++i) s[i] = x[i] + m0[i] * (xm[i] - x[i]) + m1[i] * (xp[i] - x[i]);
}
__device__ __forceinline__ void ph_rwkv_prep(const KC& k, int l, int nrows, const float* mu, const float* k_k, const float* r_k) {
    const int gw = k.bid * 8 + k.wave, NGW = k.G * 8, lane = k.lane;
    const bf16* P = (const bf16*)(k.ws + WS_P);
    bf16* R = (bf16*)(k.ws + RW_R); bf16* KS = (bf16*)(k.ws + RW_KS); bf16* V = (bf16*)(k.ws + RW_V); bf16* KK = (bf16*)(k.ws + RW_KK);
    bf16* A1 = (bf16*)(k.ws + RW_A1); bf16* A2 = (bf16*)(k.ws + RW_A2); float* BON = (float*)(k.ws + RW_BON);
    const float* mu0 = mu + (size_t)(l * 2 + 0) * RWKV_IN; const float* mu1 = mu + (size_t)(l * 2 + 1) * RWKV_IN;
    const int rpw = (nrows + NGW - 1) / NGW;
    for (int row = gw * rpw; row < nrows && row < (gw + 1) * rpw; ++row) {
        int t, len; if (row < TL) { t = row & (SEQ - 1); len = SEQ; } else { t = (row - TL) & (CTXL - 1); len = CTXL; }
        const bool hp = t > 0, hn = t < len - 1;
        const bf16* p0 = P + (size_t)row * NP;
#pragma unroll
        for (int half = 0; half < 2; ++half) {
            const int c = half * 512 + 8 * lane;
            float r[8], kx[8], vv[8], kk[8];
            shift8(p0, hp, hn, c, mu0, mu1, r);
            shift8(p0, hp, hn, RD + c, mu0, mu1, kx);
            shift8(p0, hp, hn, 2 * RD + c, mu0, mu1, vv);
            const f32x4 kka = *(const f32x4*)(k_k + l * RD + c), kkb = *(const f32x4*)(k_k + l * RD + c + 4), rka = *(const f32x4*)(r_k + l * RD + c), rkb = *(const f32x4*)(r_k + l * RD + c + 4);
            const float kkw[8] = {kka.x, kka.y, kka.z, kka.w, kkb.x, kkb.y, kkb.z, kkb.w}, rkw[8] = {rka.x, rka.y, rka.z, rka.w, rkb.x, rkb.y, rkb.z, rkb.w};
            float ss = 0.f, bon = 0.f;
#pragma unroll
            for (int i = 0; i < 8; ++i) { kk[i] = kx[i] * kkw[i]; ss += kk[i] * kk[i]; bon += r[i] * kx[i] * rkw[i]; }
            ss += __shfl_xor(ss, 1); ss += __shfl_xor(ss, 2); ss += __shfl_xor(ss, 4);
            bon += __shfl_xor(bon, 1); bon += __shfl_xor(bon, 2); bon += __shfl_xor(bon, 4);
            const float inv = 1.0f / fmaxf(sqrtf(ss), 1e-12f);
#pragma unroll
            for (int i = 0; i < 8; ++i) kk[i] *= inv;
            *(u32x4*)(R + (size_t)row * RD + c) = pack8(r); *(u32x4*)(KS + (size_t)row * RD + c) = pack8(kx);
            *(u32x4*)(V + (size_t)row * RD + c) = pack8(vv); *(u32x4*)(KK + (size_t)row * RD + c) = pack8(kk);
            if ((lane & 7) == 0) BON[(size_t)row * RHEADS + half * 8 + (lane >> 3)] = bon;
        }
        if (lane < 56) {
            float s8[8];
            shift8(p0, hp, hn, 3 * RD + 8 * lane, mu0, mu1, s8);
            if (lane < 12) {
#pragma unroll
                for (int i = 0; i < 8; ++i) { const float e2 = __expf(2.0f * fminf(fmaxf(s8[i], -15.f), 15.f)); s8[i] = 1.0f - 2.0f / (e2 + 1.0f); }
                *(u32x4*)(A1 + (size_t)row * 256 + 8 * lane) = pack8(s8);
            } else if (lane < 24) { *(u32x4*)(A1 + (size_t)row * 256 + 8 * lane) = pack8(s8); }
            else {
#pragma unroll
                for (int i = 0; i < 8; ++i) s8[i] = sigm(s8[i]);
                *(u32x4*)(A2 + (size_t)row * 256 + 8 * (lane - 24)) = pack8(s8);
            }
        } else { *(u32x4*)(A1 + (size_t)row * 256 + 192 + 8 * (lane - 56)) = (u32x4){0u, 0u, 0u, 0u}; }
    }
}

__device__ __forceinline__ float logsig(float x) { return fminf(x, 0.f) - __logf(1.0f + __expf(-fabsf(x))); }
__device__ __forceinline__ int gla_row(bool lat, int b, int s) { return lat ? b * SEQ + (s & 31) * 64 + (s >> 5) : TL + b * CTXL + s; }
constexpr int GQ_PITCH = 264;
constexpr int GPL_AD = 0, GPL_GS = 4096, GPL_QK = GPL_GS + 65536, GPL_END = GPL_QK + 66 * GQ_PITCH * 2;
static_assert(GPL_END <= 131072, "gla prep lds");
__device__ __forceinline__ void ph_gla_prep(const KC& k, int l, const float* conv, const float* aw2, const float* ab) {
    const bf16* P = (const bf16*)(k.ws + WS_P);
    bf16* QG = (bf16*)(k.ws + GL_QG); bf16* KG = (bf16*)(k.ws + GL_KG); bf16* KE = (bf16*)(k.ws + GL_KE); bf16* VS = (bf16*)(k.ws + GL_VS); float* DEC = (float*)(k.ws + GL_DEC);
    const float* cw = conv + (size_t)l * 3 * GQKV;
    const int tid = k.tid, lane = k.lane;
    {
        const int gw = k.bid * 8 + k.wave, NGW = k.G * 8, c = 16 * lane;
        const int rpw = (TA + NGW - 1) / NGW;
        for (int qi = gw * rpw; qi < TA && qi < (gw + 1) * rpw; ++qi) {
            const bool lat = qi < TL; int b, s, len;
            if (lat) { b = qi >> 11; s = qi & 2047; len = SEQ; } else { b = (qi - TL) >> 8; s = (qi - TL) & 255; len = CTXL; }
            const int row = gla_row(lat, b, s);
            const bool hp = s > 0, hn = s + 1 < len;
            const bf16* p0 = P + (size_t)row * NP + GLA_OFF + 2 * GKD + c;
            const bf16* pm = P + (size_t)gla_row(lat, b, hp ? s - 1 : s) * NP + GLA_OFF + 2 * GKD + c;
            const bf16* pp = P + (size_t)gla_row(lat, b, hn ? s + 1 : s) * NP + GLA_OFF + 2 * GKD + c;
            float o[16];
#pragma unroll
            for (int hf = 0; hf < 2; ++hf) {
                float x[8], xm[8], xp[8];
                unpack8(*(const u32x4*)(p0 + 8 * hf), x); unpack8(*(const u32x4*)(pm + 8 * hf), xm); unpack8(*(const u32x4*)(pp + 8 * hf), xp);
                const float* w = cw + 2 * GKD + c + 8 * hf;
#pragma unroll
                for (int q = 0; q < 2; ++q) {
                    const f32x4 w0 = *(const f32x4*)(w + 4 * q), w1 = *(const f32x4*)(w + GQKV + 4 * q), w2 = *(const f32x4*)(w + 2 * GQKV + 4 * q);
#pragma unroll
                    for (int i = 0; i < 4; ++i) o[8 * hf + 4 * q + i] = siluf(w0[i] * (hp ? xm[4 * q + i] : 0.f) + w1[i] * x[4 * q + i] + w2[i] * (hn ? xp[4 * q + i] : 0.f));
                }
            }
            st16(VS + (size_t)row * GVD + c, o);
        }
    }
    LAS float* ADs = (LAS float*)(k.lds + GPL_AD);
    LAS float* Gs = (LAS float*)(k.lds + GPL_GS);
    LAS bf16* QKs = (LAS bf16*)(k.lds + GPL_QK);
    for (int item = k.bid; item < 288 * 4; item += k.G) {
        const int sc = item >> 2, h = item & 3;
        const bool lat = sc < 256; const int b = lat ? (sc >> 5) : ((sc - 256) >> 2), cn = lat ? (sc & 31) : ((sc - 256) & 3), len = lat ? SEQ : CTXL;
        const int gch = lat ? 4 + cn : cn, s0 = 64 * cn;
        for (int i = tid; i < 1024; i += 512) { const int tau = i >> 4, j = i & 15; ADs[i] = bf2f(P[(size_t)gla_row(lat, b, s0 + tau) * NP + GLA_AD_OFF + j]); }
        for (int i = tid; i < 66 * 32; i += 512) {
            const int rr = i >> 5, ck = i & 31, s = s0 - 1 + rr;
            u32x4 v = (u32x4){0u, 0u, 0u, 0u};
            if (s >= 0 && s < len) v = *(const u32x4*)(P + (size_t)gla_row(lat, b, s) * NP + GLA_OFF + (ck >> 4) * GKD + h * GDK + (ck & 15) * 8);
            *(LAS u32x4*)(QKs + rr * GQ_PITCH + ck * 8) = v;
        }
        __syncthreads();
        {
            const int c = tid & 127, tg = tid >> 7, chl = h * GDK + c;
            float awf[16], awb[16];
#pragma unroll
            for (int j = 0; j < 16; ++j) { awf[j] = aw2[((size_t)(l * 2 + 0) * 16 + j) * GKD + chl]; awb[j] = aw2[((size_t)(l * 2 + 1) * 16 + j) * GKD + chl]; }
            const float abf = ab[(l * 2 + 0) * GKD + chl], abb = ab[(l * 2 + 1) * GKD + chl];
            for (int i = 0; i < 16; ++i) {
                const int tau = 16 * tg + i; float xf = abf, xb = abb;
#pragma unroll
                for (int j = 0; j < 16; ++j) { const float a = ADs[tau * 16 + j]; xf += a * awf[j]; xb += a * awb[j]; }
                Gs[tau * 128 + c] = logsig(xf) * (1.0f / 16.0f); Gs[(64 + tau) * 128 + c] = logsig(xb) * (1.0f / 16.0f);
            }
        }
        __syncthreads();
        if (tid < 128) { float run = 0.f; for (int tau = 0; tau < 64; ++tau) { run += Gs[tau * 128 + tid]; Gs[tau * 128 + tid] = run; } }
        else if (tid < 256) { const int c = tid - 128; float run = 0.f; for (int tau = 63; tau >= 0; --tau) { run += Gs[(64 + tau) * 128 + c]; Gs[(64 + tau) * 128 + c] = run; } }
        __syncthreads();
        {
            const int c8 = tid & 15, tg = tid >> 4, chl = h * GDK + 8 * c8;
            float wq[3][8], wk[3][8], elf[8], elb[8];
#pragma unroll
            for (int tp = 0; tp < 3; ++tp) {
                const f32x4 a0 = *(const f32x4*)(cw + tp * GQKV + chl), a1 = *(const f32x4*)(cw + tp * GQKV + chl + 4), b0 = *(const f32x4*)(cw + tp * GQKV + GKD + chl), b1 = *(const f32x4*)(cw + tp * GQKV + GKD + chl + 4);
#pragma unroll
                for (int i = 0; i < 4; ++i) { wq[tp][i] = a0[i]; wq[tp][4 + i] = a1[i]; wk[tp][i] = b0[i]; wk[tp][4 + i] = b1[i]; }
            }
            {
                const f32x4 a0 = *(const LAS f32x4*)(Gs + 63 * 128 + 8 * c8), a1 = *(const LAS f32x4*)(Gs + 63 * 128 + 8 * c8 + 4), b0 = *(const LAS f32x4*)(Gs + 64 * 128 + 8 * c8), b1 = *(const LAS f32x4*)(Gs + 64 * 128 + 8 * c8 + 4);
#pragma unroll
                for (int i = 0; i < 4; ++i) { elf[i] = __expf(a0[i]); elf[4 + i] = __expf(a1[i]); elb[i] = __expf(b0[i]); elb[4 + i] = __expf(b1[i]); }
            }
            if (tg < 8) {
                float* d0 = DEC + ((size_t)(0 * 8 + b) * NCH + gch) * GKD + chl; float* d1 = DEC + ((size_t)(1 * 8 + b) * NCH + gch) * GKD + chl;
                if (tg == 0) { *(f32x4*)d0 = (f32x4){elf[0], elf[1], elf[2], elf[3]}; *(f32x4*)(d0 + 4) = (f32x4){elf[4], elf[5], elf[6], elf[7]}; }
                if (tg == 1) { *(f32x4*)d1 = (f32x4){elb[0], elb[1], elb[2], elb[3]}; *(f32x4*)(d1 + 4) = (f32x4){elb[4], elb[5], elb[6], elb[7]}; }
            }
#pragma unroll
            for (int pass = 0; pass < 2; ++pass) {
                const int tau = tg + 32 * pass;
                float qm[8], q0[8], qp[8], km[8], k0[8], kp[8];
                unpack8(*(const LAS u32x4*)(QKs + (tau + 0) * GQ_PITCH + 8 * c8), qm); unpack8(*(const LAS u32x4*)(QKs + (tau + 1) * GQ_PITCH + 8 * c8), q0); unpack8(*(const LAS u32x4*)(QKs + (tau + 2) * GQ_PITCH + 8 * c8), qp);
                unpack8(*(const LAS u32x4*)(QKs + (tau + 0) * GQ_PITCH + 128 + 8 * c8), km); unpack8(*(const LAS u32x4*)(QKs + (tau + 1) * GQ_PITCH + 128 + 8 * c8), k0); unpack8(*(const LAS u32x4*)(QKs + (tau + 2) * GQ_PITCH + 128 + 8 * c8), kp);
                const f32x4 f0 = *(const LAS f32x4*)(Gs + tau * 128 + 8 * c8), f1 = *(const LAS f32x4*)(Gs + tau * 128 + 8 * c8 + 4), g0 = *(const LAS f32x4*)(Gs + (64 + tau) * 128 + 8 * c8), g1 = *(const LAS f32x4*)(Gs + (64 + tau) * 128 + 8 * c8 + 4);
                const float cf[8] = {f0.x, f0.y, f0.z, f0.w, f1.x, f1.y, f1.z, f1.w}, cb[8] = {g0.x, g0.y, g0.z, g0.w, g1.x, g1.y, g1.z, g1.w};
                float oqf[8], okf[8], oef[8], oqb[8], okb[8], oeb[8];
#pragma unroll
                for (int i = 0; i < 8; ++i) {
                    const float qv = siluf(wq[0][i] * qm[i] + wq[1][i] * q0[i] + wq[2][i] * qp[i]) * 0.08838834764831845f;
                    const float kv = siluf(wk[0][i] * km[i] + wk[1][i] * k0[i] + wk[2][i] * kp[i]);
                    const float ef = __expf(cf[i]), eb = __expf(cb[i]), rf = 1.0f / ef, rb = 1.0f / eb;
                    oqf[i] = qv * ef; okf[i] = kv * rf; oef[i] = kv * rf * elf[i];
                    oqb[i] = qv * eb; okb[i] = kv * rb; oeb[i] = kv * rb * elb[i];
                }
                const size_t o = (size_t)gla_row(lat, b, s0 + tau) * GKD + chl;
                *(u32x4*)(QG + o) = pack8(oqf); *(u32x4*)(KG + o) = pack8(okf); *(u32x4*)(KE + o) = pack8(oef);
                *(u32x4*)(QG + (size_t)TA * GKD + o) = pack8(oqb); *(u32x4*)(KG + (size_t)TA * GKD + o) = pack8(okb); *(u32x4*)(KE + (size_t)TA * GKD + o) = pack8(oeb);
            }
        }
        __syncthreads();
    }
}

__device__ __forceinline__ float dpp_sum16(float x) {
    x += __builtin_bit_cast(float, __builtin_amdgcn_update_dpp(0, __builtin_bit_cast(int, x), 0xB1, 0xF, 0xF, true));
    x += __builtin_bit_cast(float, __builtin_amdgcn_update_dpp(0, __builtin_bit_cast(int, x), 0x4E, 0xF, 0xF, true));
    x += __builtin_bit_cast(float, __builtin_amdgcn_update_dpp(0, __builtin_bit_cast(int, x), 0x141, 0xF, 0xF, true));
    x += __builtin_bit_cast(float, __builtin_amdgcn_update_dpp(0, __builtin_bit_cast(int, x), 0x140, 0xF, 0xF, true));
    return x;
}
constexpr int RS_TOK = 16;
constexpr int RS_TF = 6 * 64;
constexpr int RS_BUF = RS_TOK * RS_TF;
struct RwkvStage { unsigned r, we, a, ks, v, kk; };
__device__ __forceinline__ int rwkv_row(int b, int dir, int p) {
    if (p < CTXL) { const int t = dir ? CTXL - 1 - p : p; return TL + b * CTXL + t; }
    const int q = p - CTXL, t = dir ? SEQ - 1 - q : q; return b * SEQ + t;
}
__device__ __forceinline__ void ph_rwkv_scan(const KC& k, int l, int job, const float* k_a, size_t yoff = RW_Y) {
    const int b = job >> 5, h = (job >> 1) & 15, dir = job & 1;
    const int tid = k.tid;
    const bf16* R = (const bf16*)(k.ws + RW_R); const bf16* KS = (const bf16*)(k.ws + RW_KS); const bf16* V = (const bf16*)(k.ws + RW_V); const bf16* KK = (const bf16*)(k.ws + RW_KK);
    const bf16* LO = (const bf16*)(k.ws + RW_LO); bf16* Y = (bf16*)(k.ws + yoff) + (size_t)dir * TA * RD;
    LAS float* buf = (LAS float*)k.lds;
    LAS f32x2* ypart = (LAS f32x2*)(buf + 2 * RS_BUF);
    const int st = tid >> 5, cp = tid & 31, ch = h * RHS + 2 * cp;
    const float ka0 = k_a[l * RD + ch], ka1 = k_a[l * RD + ch + 1];
    const int kq = tid & 15, rp = tid >> 4, v0 = rp * 2;
    f32x2 S00 = {0.f, 0.f}, S01 = {0.f, 0.f}, S10 = {0.f, 0.f}, S11 = {0.f, 0.f};
    RwkvStage sg;
#define RW_LOAD(chunk) do { const int row_ = rwkv_row(b, dir, (chunk) * RS_TOK + st); \
        sg.r = *(const unsigned*)(R + (size_t)row_ * RD + ch); sg.ks = *(const unsigned*)(KS + (size_t)row_ * RD + ch); \
        sg.v = *(const unsigned*)(V + (size_t)row_ * RD + ch); sg.kk = *(const unsigned*)(KK + (size_t)row_ * RD + ch); \
        sg.we = *(const unsigned*)(LO + (size_t)row_ * 4096 + dir * RD + ch); sg.a = *(const unsigned*)(LO + (size_t)row_ * 4096 + 2048 + dir * RD + ch); } while (0)
#define RW_WRITE(bi) do { LAS float* tb = buf + (bi) * RS_BUF + st * RS_TF + 2 * cp; \
        const float a0 = bflo(sg.a), a1 = bfhi(sg.a), kk0 = bflo(sg.kk), kk1 = bfhi(sg.kk), ks0 = bflo(sg.ks), ks1 = bfhi(sg.ks); \
        *(LAS f32x2*)(tb + 0) = (f32x2){kk0, kk1}; \
        *(LAS f32x2*)(tb + 64) = (f32x2){__expf(-bflo(sg.we)), __expf(-bfhi(sg.we))}; \
        *(LAS f32x2*)(tb + 128) = (f32x2){-kk0 * a0, -kk1 * a1}; \
        *(LAS f32x2*)(tb + 192) = (f32x2){ks0 * (1.0f + (a0 - 1.0f) * ka0), ks1 * (1.0f + (a1 - 1.0f) * ka1)}; \
        *(LAS f32x2*)(tb + 256) = (f32x2){bflo(sg.r), bfhi(sg.r)}; \
        *(LAS f32x2*)(tb + 320) = (f32x2){bflo(sg.v), bfhi(sg.v)}; } while (0)
    constexpr int NCHUNK = (CTXL + SEQ) / RS_TOK;
    RW_LOAD(0); RW_WRITE(0);
    __syncthreads();
    for (int c = 0; c < NCHUNK; ++c) {
        if (c + 1 < NCHUNK) RW_LOAD(c + 1);
        const LAS float* cb = buf + (c & 1) * RS_BUF; LAS f32x2* yb = ypart + (c & 1) * RS_TOK * 256 + rp * 8 + (((kq >> 1) ^ (rp >> 2)) & 7);
        {
            const LAS float* tk = cb + kq * 4; const LAS float* tv = cb + 320 + v0;
#define RW_LD(T, kk4, w4, n4, d4, r4, vv) f32x4 kk4 = *(const LAS f32x4*)(tk + (T) * RS_TF), w4 = *(const LAS f32x4*)(tk + (T) * RS_TF + 64), n4 = *(const LAS f32x4*)(tk + (T) * RS_TF + 128), \
                d4 = *(const LAS f32x4*)(tk + (T) * RS_TF + 192), r4 = *(const LAS f32x4*)(tk + (T) * RS_TF + 256); f32x2 vv = *(const LAS f32x2*)(tv + (T) * RS_TF)
#define RW_STEP(T, kk4, w4, n4, d4, r4, vv) do { \
                const f32x2 kka = {kk4.x, kk4.y}, kkb = {kk4.z, kk4.w}, wa = {w4.x, w4.y}, wb = {w4.z, w4.w}, na = {n4.x, n4.y}, nb = {n4.z, n4.w}, da = {d4.x, d4.y}, db = {d4.z, d4.w}, ra = {r4.x, r4.y}, rb = {r4.z, r4.w}; \
                f32x2 p0 = S00 * kka + S01 * kkb, p1 = S10 * kka + S11 * kkb; \
                const f32x2 u00 = S00 * wa + da * vv.x, u01 = S01 * wb + db * vv.x, u10 = S10 * wa + da * vv.y, u11 = S11 * wb + db * vv.y;     \
                const float sa0 = dpp_sum16(p0.x + p0.y), sa1 = dpp_sum16(p1.x + p1.y); \
                S00 = na * sa0 + u00; S01 = nb * sa0 + u01; S10 = na * sa1 + u10; S11 = nb * sa1 + u11; \
                p0 = S00 * ra + S01 * rb; p1 = S10 * ra + S11 * rb; \
                float y0 = p0.x + p0.y, y1 = p1.x + p1.y; \
                y0 += __builtin_bit_cast(float, __builtin_amdgcn_update_dpp(0, __builtin_bit_cast(int, y0), 0xB1, 0xF, 0xF, true)); \
                y1 += __builtin_bit_cast(float, __builtin_amdgcn_update_dpp(0, __builtin_bit_cast(int, y1), 0xB1, 0xF, 0xF, true)); \
                if ((kq & 1) == 0) yb[(T) * 256] = (f32x2){y0, y1}; } while (0)
            RW_LD(0, kkA, wA, nA, dA, rA, vA);
#pragma unroll
            for (int tau = 0; tau < RS_TOK; tau += 2) {
                RW_LD(tau + 1, kkB, wB, nB, dB, rB, vB);
                RW_STEP(tau, kkA, wA, nA, dA, rA, vA);
                if (tau + 2 < RS_TOK) { RW_LD(tau + 2, kkC, wC, nC, dC, rC, vC); kkA = kkC; wA = wC; nA = nC; dA = dC; rA = rC; vA = vC; }
                RW_STEP(tau + 1, kkB, wB, nB, dB, rB, vB);
            }
#undef RW_LD
#undef RW_STEP
        }
        if (c + 1 < NCHUNK) RW_WRITE((c + 1) & 1);
        __syncthreads();
        {
            const int row = rwkv_row(b, dir, c * RS_TOK + st);
            const LAS f32x2* yq = ypart + (c & 1) * RS_TOK * 256 + st * 256 + cp * 8;
            f32x2 acc = yq[(0 ^ (cp >> 2)) & 7];
#pragma unroll
            for (int j = 1; j < 8; ++j) acc += yq[(j ^ (cp >> 2)) & 7];
            *(unsigned*)(Y + (size_t)row * RD + ch) = pk2(acc.x, acc.y);
        }
    }
    __syncthreads();
}

constexpr int GP1 = 136, GP2 = 72;
constexpr int GL_QGS = 0, GL_KGS = GL_QGS + 64 * GP1 * 2, GL_STS = GL_KGS + 64 * GP1 * 2, GL_KET = GL_STS + 64 * GP1 * 2, GL_VT = GL_KET + 128 * GP2 * 2, GL_ATT = GL_VT + 64 * GP2 * 2,
              GL_DECS = GL_ATT + 64 * GP2 * 2, GL_LDS_END = GL_DECS + 512;
static_assert(GL_LDS_END <= 131072, "gla lds");
__device__ __forceinline__ bf16x8 ldfrag(const LAS bf16* base, int row, int pitch, int kofs) { return *(const LAS bf16x8*)(base + row * pitch + kofs); }
__device__ __forceinline__ int gla_prow(int b, int dir, int cp, int tau) {
    const bool lat = cp >= 4; const int q = lat ? cp - 4 : cp, ncn = lat ? 32 : 4, cn = dir ? ncn - 1 - q : q;
    return gla_row(lat, b, dir ? 64 * cn + 63 - tau : 64 * cn + tau);
}
__device__ __forceinline__ int gla_gch(int dir, int cp) { const bool lat = cp >= 4; const int q = lat ? cp - 4 : cp, ncn = lat ? 32 : 4, cn = dir ? ncn - 1 - q : q; return lat ? 4 + cn : cn; }
__device__ __forceinline__ bf16x8 ldfrag_sw(const LAS bf16* base, int row, int g) { return *(const LAS bf16x8*)(base + row * GP2 + ((g ^ ((row >> 3) & 7)) << 3)); }
__device__ __forceinline__ void ph_gla_scan(const KC& k, int job) {
    const int b = job >> 5, h = (job >> 3) & 3, dir = (job >> 2) & 1, dvq = job & 3;
    const int tid = k.tid, w = k.wave, lane = k.lane, q4 = lane >> 4, l15 = lane & 15;
    const bf16* QG = (const bf16*)(k.ws + GL_QG) + (size_t)dir * TA * GKD; const bf16* KG = (const bf16*)(k.ws + GL_KG) + (size_t)dir * TA * GKD;
    const bf16* KE = (const bf16*)(k.ws + GL_KE) + (size_t)dir * TA * GKD; const bf16* VS = (const bf16*)(k.ws + GL_VS);
    const float* DEC = (const float*)(k.ws + GL_DEC); bf16* O = (bf16*)(k.ws + GL_O) + (size_t)dir * TA * GVD;
    LAS bf16* QGs = (LAS bf16*)(k.lds + GL_QGS); LAS bf16* KGs = (LAS bf16*)(k.lds + GL_KGS); LAS bf16* STs = (LAS bf16*)(k.lds + GL_STS);
    LAS bf16* KEt = (LAS bf16*)(k.lds + GL_KET); LAS bf16* Vt = (LAS bf16*)(k.lds + GL_VT); LAS bf16* ATT = (LAS bf16*)(k.lds + GL_ATT); LAS float* decs = (LAS float*)(k.lds + GL_DECS);
    f32x4 accS[4];
#pragma unroll
    for (int t = 0; t < 4; ++t) accS[t] = (f32x4){0.f, 0.f, 0.f, 0.f};
    const int tw = w & 3, wh = w >> 2;
    u32x4 pq[2], pk[2], pe[2], pv; float pd = 0.f;
#define GLA_PREFETCH(CP) do { _Pragma("unroll") for (int i = 0; i < 2; ++i) { const int idx = tid + 512 * i, tau = idx >> 4, ck = idx & 15; \
            const size_t go = (size_t)gla_prow(b, dir, (CP), tau) * GKD + h * GDK + ck * 8; pq[i] = *(const u32x4*)(QG + go); pk[i] = *(const u32x4*)(KG + go); pe[i] = *(const u32x4*)(KE + go); } \
        pv = *(const u32x4*)(VS + (size_t)gla_prow(b, dir, (CP), tid >> 3) * GVD + h * GDV + dvq * 64 + (tid & 7) * 8); \
        if (tid < 128) pd = DEC[((size_t)(dir * 8 + b) * NCH + gla_gch(dir, (CP))) * GKD + h * GDK + tid]; } while (0)
    GLA_PREFETCH(0);
    for (int cp = 0; cp < NCH; ++cp) {
#define GROW(tau) gla_prow(b, dir, cp, (tau))
#pragma unroll
        for (int i = 0; i < 2; ++i) {
            const int idx = tid + 512 * i, tau = idx >> 4, ck = idx & 15;
            *(LAS u32x4*)(QGs + tau * GP1 + ck * 8) = pq[i];
            *(LAS u32x4*)(KGs + tau * GP1 + ck * 8) = pk[i];
            const unsigned kw[4] = {pe[i].x, pe[i].y, pe[i].z, pe[i].w};
#pragma unroll
            for (int e = 0; e < 4; ++e) { const int ts = tau ^ ((ck & 7) << 3); KEt[(ck * 8 + 2 * e) * GP2 + ts] = (bf16)(kw[e] & 0xffffu); KEt[(ck * 8 + 2 * e + 1) * GP2 + ts] = (bf16)(kw[e] >> 16); }
        }
        {
            const int tau = tid >> 3, ck = tid & 7;
            const unsigned vw[4] = {pv.x, pv.y, pv.z, pv.w};
#pragma unroll
            for (int e = 0; e < 4; ++e) { const int ts = tau ^ (ck << 3); Vt[(ck * 8 + 2 * e) * GP2 + ts] = (bf16)(vw[e] & 0xffffu); Vt[(ck * 8 + 2 * e + 1) * GP2 + ts] = (bf16)(vw[e] >> 16); }
        }
        if (tid < 128) decs[tid] = pd;
#pragma unroll
        for (int t = 0; t < 4; ++t) {
            const int dkt = wh * 4 + t;
#pragma unroll
            for (int r = 0; r < 4; ++r) STs[(16 * tw + 4 * q4 + r) * GP1 + 16 * dkt + l15] = (bf16)f2bf(accS[t][r]);
        }
        __syncthreads();
        if (cp + 1 < NCH) GLA_PREFETCH(cp + 1);
#pragma unroll
        for (int jj = 0; jj < 2; ++jj) {
            const int it = tw, jt = wh * 2 + jj;
            f32x4 acc = (f32x4){0.f, 0.f, 0.f, 0.f};
#pragma unroll
            for (int ks = 0; ks < 4; ++ks) acc = __builtin_amdgcn_mfma_f32_16x16x32_bf16(ldfrag(QGs, 16 * it + l15, GP1, 32 * ks + 8 * q4), ldfrag(KGs, 16 * jt + l15, GP1, 32 * ks + 8 * q4), acc, 0, 0, 0);
#pragma unroll
            for (int r = 0; r < 4; ++r) { const int i = 16 * it + 4 * q4 + r, j = 16 * jt + l15; ATT[i * GP2 + j] = (bf16)f2bf(j <= i ? acc[r] : 0.f); }
        }
        __syncthreads();
#pragma unroll
        for (int dd = 0; dd < 2; ++dd) {
            const int it = tw, dvt = wh * 2 + dd;
            f32x4 acc = (f32x4){0.f, 0.f, 0.f, 0.f};
#pragma unroll
            for (int ks = 0; ks < 4; ++ks) acc = __builtin_amdgcn_mfma_f32_16x16x32_bf16(ldfrag(QGs, 16 * it + l15, GP1, 32 * ks + 8 * q4), ldfrag(STs, 16 * dvt + l15, GP1, 32 * ks + 8 * q4), acc, 0, 0, 0);
#pragma unroll
            for (int ks = 0; ks < 2; ++ks) acc = __builtin_amdgcn_mfma_f32_16x16x32_bf16(ldfrag(ATT, 16 * it + l15, GP2, 32 * ks + 8 * q4), ldfrag_sw(Vt, 16 * dvt + l15, 4 * ks + q4), acc, 0, 0, 0);
#pragma unroll
            for (int r = 0; r < 4; ++r) { const int i = 16 * it + 4 * q4 + r; O[(size_t)GROW(i) * GVD + h * GDV + dvq * 64 + 16 * dvt + l15] = (bf16)f2bf(acc[r]); }
        }
#pragma unroll
        for (int t = 0; t < 4; ++t) {
            const int dkt = wh * 4 + t; const float d = decs[16 * dkt + l15];
            accS[t] = accS[t] * d;
#pragma unroll
            for (int ks = 0; ks < 2; ++ks) accS[t] = __builtin_amdgcn_mfma_f32_16x16x32_bf16(ldfrag_sw(Vt, 16 * tw + l15, 4 * ks + q4), ldfrag_sw(KEt, 16 * dkt + l15, 4 * ks + q4), accS[t], 0, 0, 0);
        }
        __syncthreads();
#undef GROW
    }
#undef GLA_PREFETCH
}

#ifndef RWKV_MODE
#define RWKV_MODE 2
#endif
#ifndef HB_FULL
#define HB_FULL 0
#endif
#ifndef GLA4_LEVEL
#define GLA4_LEVEL 0
#endif
#ifndef GLA4_NOSTORE
#define GLA4_NOSTORE 0
#endif
#ifndef SWAP_HALVES
#define SWAP_HALVES 0
#endif
#ifndef SPLIT_SCAN
#define SPLIT_SCAN 0
#endif
constexpr int RS4_TOK = 8, RS4_BUF = RS4_TOK * RS_TF;
constexpr int SC_GL = 0;
constexpr int SC_RW = 96 * 1024;
constexpr int SC_END = SC_RW + 2 * RS4_BUF * 4 + 2 * RS4_TOK * 64 * 4;
static_assert(SC_GL + GL_LDS_END <= SC_RW, "scan lds halves");
constexpr int SC_CTR = 127 * 1024;
static_assert(SC_END <= SC_CTR && SC_CTR + 128 <= 131072, "scan lds");
__device__ __forceinline__ void half_bar(LAS unsigned* ctr, unsigned& gen, int lane) {
#if HB_FULL
    (void)ctr; (void)lane; gen += 4u; __syncthreads(); return;
#endif
    gen += 4u;
    __builtin_amdgcn_fence(__ATOMIC_RELEASE, "workgroup");
    if (lane == 0) __hip_atomic_fetch_add(ctr, 1u, __ATOMIC_RELAXED, __HIP_MEMORY_SCOPE_WORKGROUP);
    unsigned spins = 0;
    while (__hip_atomic_load(ctr, __ATOMIC_RELAXED, __HIP_MEMORY_SCOPE_WORKGROUP) < gen) { __builtin_amdgcn_s_sleep(1); if (++spins > (1u << 26)) break; }
    __builtin_amdgcn_fence(__ATOMIC_ACQUIRE, "workgroup");
}
#ifndef RW4_SHFL
#define RW4_SHFL 0
#endif
__device__ __forceinline__ float shfl_sum16(float x) { x += __shfl_xor(x, 1); x += __shfl_xor(x, 2); x += __shfl_xor(x, 4); x += __shfl_xor(x, 8); return x; }
#if RW4_SHFL
#define RW4_SUM16(x) shfl_sum16(x)
#else
#define RW4_SUM16(x) dpp_sum16(x)
#endif
__device__ __forceinline__ void rwkv_scan_4w(const KC& k, int l, int job, const float* k_a, LAS unsigned* ctr) {
    const int b = job >> 5, h = (job >> 1) & 15, dir = job & 1;
    const int tid = k.tid, lane = k.lane;
    const bf16* R = (const bf16*)(k.ws + RW_R); const bf16* KS = (const bf16*)(k.ws + RW_KS); const bf16* V = (const bf16*)(k.ws + RW_V); const bf16* KK = (const bf16*)(k.ws + RW_KK);
    const bf16* LO = (const bf16*)(k.ws + RW_LO); bf16* Y = (bf16*)(k.ws + RW_Y) + (size_t)dir * TA * RD;
    LAS float* buf = (LAS float*)(k.lds + SC_RW);
    LAS float* ybuf = buf + 2 * RS4_BUF;
    const int st = tid >> 5, cp = tid & 31, ch = h * RHS + 2 * cp;
    const float ka0 = k_a[l * RD + ch], ka1 = k_a[l * RD + ch + 1];
    const int kq = tid & 15, v0 = (tid >> 4) * 4;
    f32x2 S[4][2];
#pragma unroll
    for (int i = 0; i < 4; ++i) { S[i][0] = (f32x2){0.f, 0.f}; S[i][1] = (f32x2){0.f, 0.f}; }
    RwkvStage sg[1];
    unsigned gen = 0;
#define RW4_LOAD(chunk) do { _Pragma("unroll") for (int q_ = 0; q_ < 1; ++q_) { const int row_ = rwkv_row(b, dir, (chunk) * RS4_TOK + st); \
        sg[q_].r = *(const unsigned*)(R + (size_t)row_ * RD + ch); sg[q_].ks = *(const unsigned*)(KS + (size_t)row_ * RD + ch); \
        sg[q_].v = *(const unsigned*)(V + (size_t)row_ * RD + ch); sg[q_].kk = *(const unsigned*)(KK + (size_t)row_ * RD + ch); \
        sg[q_].we = *(const unsigned*)(LO + (size_t)row_ * 4096 + dir * RD + ch); sg[q_].a = *(const unsigned*)(LO + (size_t)row_ * 4096 + 2048 + dir * RD + ch); } } while (0)
#define RW4_WRITE(bi) do { _Pragma("unroll") for (int q_ = 0; q_ < 1; ++q_) { LAS float* tb = buf + (bi) * RS4_BUF + st * RS_TF + 2 * cp; \
        const float a0 = bflo(sg[q_].a), a1 = bfhi(sg[q_].a), kk0 = bflo(sg[q_].kk), kk1 = bfhi(sg[q_].kk), ks0 = bflo(sg[q_].ks), ks1 = bfhi(sg[q_].ks); \
        *(LAS f32x2*)(tb + 0) = (f32x2){kk0, kk1}; \
        *(LAS f32x2*)(tb + 64) = (f32x2){__expf(-bflo(sg[q_].we)), __expf(-bfhi(sg[q_].we))}; \
        *(LAS f32x2*)(tb + 128) = (f32x2){-kk0 * a0, -kk1 * a1}; \
        *(LAS f32x2*)(tb + 192) = (f32x2){ks0 * (1.0f + (a0 - 1.0f) * ka0), ks1 * (1.0f + (a1 - 1.0f) * ka1)}; \
        *(LAS f32x2*)(tb + 256) = (f32x2){bflo(sg[q_].r), bfhi(sg[q_].r)}; \
        *(LAS f32x2*)(tb + 320) = (f32x2){bflo(sg[q_].v), bfhi(sg[q_].v)}; } } while (0)
    constexpr int NCHUNK = (CTXL + SEQ) / RS4_TOK;
    RW4_LOAD(0); RW4_WRITE(0);
    half_bar(ctr, gen, lane);
    for (int c = 0; c < NCHUNK; ++c) {
        if (c + 1 < NCHUNK) RW4_LOAD(c + 1);
        const LAS float* cb = buf + (c & 1) * RS4_BUF; LAS float* yb = ybuf + (c & 1) * RS4_TOK * 64;
        {
            const LAS float* tk = cb + kq * 4; const LAS float* tv = cb + 320 + v0;
#define RW4_LD(T, kk4, w4, n4, d4, r4, vv) f32x4 kk4 = *(const LAS f32x4*)(tk + (T) * RS_TF), w4 = *(const LAS f32x4*)(tk + (T) * RS_TF + 64), n4 = *(const LAS f32x4*)(tk + (T) * RS_TF + 128), \
                d4 = *(const LAS f32x4*)(tk + (T) * RS_TF + 192), r4 = *(const LAS f32x4*)(tk + (T) * RS_TF + 256), vv = *(const LAS f32x4*)(tv + (T) * RS_TF)
#define RW4_STEP(T, kk4, w4, n4, d4, r4, vv) do { \
                const f32x2 kka = {kk4.x, kk4.y}, kkb = {kk4.z, kk4.w}, wa = {w4.x, w4.y}, wb = {w4.z, w4.w}, na = {n4.x, n4.y}, nb = {n4.z, n4.w}, da = {d4.x, d4.y}, db = {d4.z, d4.w}, ra = {r4.x, r4.y}, rb = {r4.z, r4.w}; \
                float sa[4], yy[4]; f32x2 u0[4], u1[4]; \
                _Pragma("unroll") for (int i = 0; i < 4; ++i) { const f32x2 p = S[i][0] * kka + S[i][1] * kkb; sa[i] = p.x + p.y; u0[i] = S[i][0] * wa + da * vv[i]; u1[i] = S[i][1] * wb + db * vv[i]; } \
                _Pragma("unroll") for (int i = 0; i < 4; ++i) sa[i] = RW4_SUM16(sa[i]); \
                _Pragma("unroll") for (int i = 0; i < 4; ++i) { S[i][0] = na * sa[i] + u0[i]; S[i][1] = nb * sa[i] + u1[i]; const f32x2 q = S[i][0] * ra + S[i][1] * rb; yy[i] = q.x + q.y; } \
                _Pragma("unroll") for (int i = 0; i < 4; ++i) yy[i] = RW4_SUM16(yy[i]); \
                if (kq == 0) *(LAS f32x4*)(yb + (T) * 64 + v0) = (f32x4){yy[0], yy[1], yy[2], yy[3]}; } while (0)
            RW4_LD(0, kkA, wA, nA, dA, rA, vA);
#pragma unroll
            for (int tau = 0; tau < RS4_TOK; tau += 2) {
                RW4_LD(tau + 1, kkB, wB, nB, dB, rB, vB);
                RW4_STEP(tau, kkA, wA, nA, dA, rA, vA);
                if (tau + 2 < RS4_TOK) { RW4_LD(tau + 2, kkC, wC, nC, dC, rC, vC); kkA = kkC; wA = wC; nA = nC; dA = dC; rA = rC; vA = vC; }
                RW4_STEP(tau + 1, kkB, wB, nB, dB, rB, vB);
            }
#undef RW4_LD
#undef RW4_STEP
        }
        if (c + 1 < NCHUNK) RW4_WRITE((c + 1) & 1);
        half_bar(ctr, gen, lane);
        {
            const int row = rwkv_row(b, dir, c * RS4_TOK + st);
            const f32x2 yy = *(const LAS f32x2*)(yb + st * 64 + 2 * cp);
            *(unsigned*)(Y + (size_t)row * RD + ch) = pk2(yy.x, yy.y);
        }
    }
#undef RW4_LOAD
#undef RW4_WRITE
}
__device__ __forceinline__ void gla_scan_4w(const KC& k, int job, LAS unsigned* ctr) {
    const int b = job >> 5, h = (job >> 3) & 3, dir = (job >> 2) & 1, dvq = job & 3;
    const int tid = k.tid - 256, w = k.wave - 4, lane = k.lane, q4 = lane >> 4, l15 = lane & 15;
    const bf16* QG = (const bf16*)(k.ws + GL_QG) + (size_t)dir * TA * GKD; const bf16* KG = (const bf16*)(k.ws + GL_KG) + (size_t)dir * TA * GKD;
    const bf16* KE = (const bf16*)(k.ws + GL_KE) + (size_t)dir * TA * GKD; const bf16* VS = (const bf16*)(k.ws + GL_VS);
    const float* DEC = (const float*)(k.ws + GL_DEC); bf16* O = (bf16*)(k.ws + GL_O) + (size_t)dir * TA * GVD;
    LAS unsigned char* gl = k.lds + SC_GL;
    LAS bf16* QGs = (LAS bf16*)(gl + GL_QGS); LAS bf16* KGs = (LAS bf16*)(gl + GL_KGS); LAS bf16* STs = (LAS bf16*)(gl + GL_STS);
    LAS bf16* KEt = (LAS bf16*)(gl + GL_KET); LAS bf16* Vt = (LAS bf16*)(gl + GL_VT); LAS bf16* ATT = (LAS bf16*)(gl + GL_ATT); LAS float* decs = (LAS float*)(gl + GL_DECS);
    f32x4 accS[8];
#pragma unroll
    for (int t = 0; t < 8; ++t) accS[t] = (f32x4){0.f, 0.f, 0.f, 0.f};
    unsigned gen = 0;
#if GLA4_LEVEL == 2
    { float x = (float)lane; for (int i = 0; i < 200000; ++i) { x = x * 1.0001f + 0.5f; asm volatile("" : "+v"(x)); } asm volatile("" :: "v"(x)); (void)ctr; (void)gen; }
    return;
#endif
#if GLA4_LEVEL == 1
    for (int cp = 0; cp < NCH; ++cp) { float x = (float)lane; for (int i = 0; i < 2000; ++i) x = x * 1.0001f + 0.5f; asm volatile("" :: "v"(x)); half_bar(ctr, gen, lane); half_bar(ctr, gen, lane); half_bar(ctr, gen, lane); }
    return;
#endif
    for (int cp = 0; cp < NCH; ++cp) {
        const bool lat = cp >= 4; const int q = lat ? cp - 4 : cp, ncn = lat ? 32 : 4, cn = dir ? ncn - 1 - q : q, gch = lat ? 4 + cn : cn;
#define GROW(tau) gla_row(lat, b, dir ? 64 * cn + 63 - (tau) : 64 * cn + (tau))
#pragma unroll
        for (int i = 0; i < 4; ++i) {
            const int idx = tid + 256 * i, tau = idx >> 4, ck = idx & 15; const size_t go = (size_t)GROW(tau) * GKD + h * GDK + ck * 8;
            *(LAS u32x4*)(QGs + tau * GP1 + ck * 8) = *(const u32x4*)(QG + go);
            *(LAS u32x4*)(KGs + tau * GP1 + ck * 8) = *(const u32x4*)(KG + go);
            const u32x4 ke = *(const u32x4*)(KE + go);
            const unsigned kw[4] = {ke.x, ke.y, ke.z, ke.w};
#pragma unroll
            for (int e = 0; e < 4; ++e) { KEt[(ck * 8 + 2 * e) * GP2 + tau] = (bf16)(kw[e] & 0xffffu); KEt[(ck * 8 + 2 * e + 1) * GP2 + tau] = (bf16)(kw[e] >> 16); }
        }
#pragma unroll
        for (int i = 0; i < 2; ++i) {
            const int idx = tid + 256 * i, tau = idx >> 3, ck = idx & 7;
            const u32x4 vv = *(const u32x4*)(VS + (size_t)GROW(tau) * GVD + h * GDV + dvq * 64 + ck * 8);
            const unsigned vw[4] = {vv.x, vv.y, vv.z, vv.w};
#pragma unroll
            for (int e = 0; e < 4; ++e) { Vt[(ck * 8 + 2 * e) * GP2 + tau] = (bf16)(vw[e] & 0xffffu); Vt[(ck * 8 + 2 * e + 1) * GP2 + tau] = (bf16)(vw[e] >> 16); }
        }
        if (tid < 128) decs[tid] = DEC[((size_t)(dir * 8 + b) * NCH + gch) * GKD + h * GDK + tid];
#pragma unroll
        for (int t = 0; t < 8; ++t) {
#pragma unroll
            for (int r = 0; r < 4; ++r) STs[(16 * w + 4 * q4 + r) * GP1 + 16 * t + l15] = (bf16)f2bf(accS[t][r]);
        }
        half_bar(ctr, gen, lane);
#pragma unroll
        for (int jt = 0; jt < 4; ++jt) {
            f32x4 acc = (f32x4){0.f, 0.f, 0.f, 0.f};
#pragma unroll
            for (int ks = 0; ks < 4; ++ks) acc = __builtin_amdgcn_mfma_f32_16x16x32_bf16(ldfrag(QGs, 16 * w + l15, GP1, 32 * ks + 8 * q4), ldfrag(KGs, 16 * jt + l15, GP1, 32 * ks + 8 * q4), acc, 0, 0, 0);
#pragma unroll
            for (int r = 0; r < 4; ++r) { const int i = 16 * w + 4 * q4 + r, j = 16 * jt + l15; ATT[i * GP2 + j] = (bf16)f2bf(j <= i ? acc[r] : 0.f); }
        }
        half_bar(ctr, gen, lane);
#pragma unroll
        for (int dvt = 0; dvt < 4; ++dvt) {
            f32x4 acc = (f32x4){0.f, 0.f, 0.f, 0.f};
#pragma unroll
            for (int ks = 0; ks < 4; ++ks) acc = __builtin_amdgcn_mfma_f32_16x16x32_bf16(ldfrag(QGs, 16 * w + l15, GP1, 32 * ks + 8 * q4), ldfrag(STs, 16 * dvt + l15, GP1, 32 * ks + 8 * q4), acc, 0, 0, 0);
#pragma unroll
            for (int ks = 0; ks < 2; ++ks) acc = __builtin_amdgcn_mfma_f32_16x16x32_bf16(ldfrag(ATT, 16 * w + l15, GP2, 32 * ks + 8 * q4), ldfrag(Vt, 16 * dvt + l15, GP2, 32 * ks + 8 * q4), acc, 0, 0, 0);
#pragma unroll
#if GLA4_NOSTORE
            asm volatile("" :: "v"(acc[0]), "v"(acc[1]), "v"(acc[2]), "v"(acc[3]));
#else
            for (int r = 0; r < 4; ++r) { const int i = 16 * w + 4 * q4 + r; O[(size_t)GROW(i) * GVD + h * GDV + dvq * 64 + 16 * dvt + l15] = (bf16)f2bf(acc[r]); }
#endif
        }
#pragma unroll
        for (int t = 0; t < 8; ++t) {
            const float d = decs[16 * t + l15];
            accS[t] = accS[t] * d;
#pragma unroll
            for (int ks = 0; ks < 2; ++ks) accS[t] = __builtin_amdgcn_mfma_f32_16x16x32_bf16(ldfrag(Vt, 16 * w + l15, GP2, 32 * ks + 8 * q4), ldfrag(KEt, 16 * t + l15, GP2, 32 * ks + 8 * q4), accS[t], 0, 0, 0);
        }
        half_bar(ctr, gen, lane);
#undef GROW
    }
#if HB_FULL
    for (int i = 0; i < (1 + (CTXL + SEQ) / RS4_TOK) - 3 * NCH; ++i) __syncthreads();
#endif
}
__device__ __forceinline__ void ph_scan_split(const KC& k, int l, const float* k_a) {
    LAS unsigned* ctr = (LAS unsigned*)(k.lds + SC_CTR);
    for (int job = k.bid; job < 256; job += k.G) {
        if (k.tid == 0) { ctr[0] = 0u; ctr[16] = 0u; }
        __syncthreads();
#if SPLIT_SCAN == 1 || SPLIT_SCAN == 4 || SPLIT_SCAN == 5 || SPLIT_SCAN == 6
#if SWAP_HALVES
        { KC k2 = k; if (k.wave >= 4) { k2.tid = k.tid - 256; k2.wave = k.wave - 4; rwkv_scan_4w(k2, l, job, k_a, ctr); } else { k2.tid = k.tid + 256; k2.wave = k.wave + 4; gla_scan_4w(k2, job, ctr + 16); } }
#else
        if (k.wave < 4) rwkv_scan_4w(k, l, job, k_a, ctr); else gla_scan_4w(k, job, ctr + 16);
#endif
        __syncthreads();
#if SPLIT_SCAN == 6
        ph_rwkv_scan(k, l, job, k_a, WS_H);
#elif SPLIT_SCAN == 4
        ph_rwkv_scan(k, l, job, k_a);
#elif SPLIT_SCAN == 5
        ph_gla_scan(k, job);
#endif
#elif SPLIT_SCAN == 2
        if (k.wave < 4) rwkv_scan_4w(k, l, job, k_a, ctr);
        __syncthreads();
        ph_gla_scan(k, job);
#else
        if (k.wave >= 4) gla_scan_4w(k, job, ctr + 16);
        __syncthreads();
        ph_rwkv_scan(k, l, job, k_a);
#endif
    }
}

__device__ __forceinline__ void ph_post(const KC& k, int l, int nrows, const float* ln_g, const float* ln_b, const float* gng) {
    const int gw = k.bid * 8 + k.wave, NGW = k.G * 8, lane = k.lane, c = 16 * lane;
    const bf16* P = (const bf16*)(k.ws + WS_P);
    const bf16* Y = (const bf16*)(k.ws + RW_Y); const bf16* V = (const bf16*)(k.ws + RW_V); const float* BON = (const float*)(k.ws + RW_BON); bf16* YNB = (bf16*)(k.ws + RW_R);
    const bf16* O = (const bf16*)(k.ws + GL_O); bf16* YB = (bf16*)(k.ws + GL_VS);
    for (int row = gw; row < nrows; row += NGW) {
        {
            float yf[16], yb[16], vv[16], y[16];
            ld16(Y + (size_t)row * RD + c, true, yf); ld16(Y + ((size_t)TA + row) * RD + c, true, yb); ld16(V + (size_t)row * RD + c, true, vv);
            float s = 0.f;
#pragma unroll
            for (int i = 0; i < 16; ++i) { y[i] = yf[i] + yb[i]; s += y[i]; }
            s += __shfl_xor(s, 1); s += __shfl_xor(s, 2);
            const float mean = s * (1.0f / 64.0f); float q = 0.f;
#pragma unroll
            for (int i = 0; i < 16; ++i) { y[i] -= mean; q += y[i] * y[i]; }
            q += __shfl_xor(q, 1); q += __shfl_xor(q, 2);
            const float rstd = 1.0f / sqrtf(q * (1.0f / 64.0f) + 64e-5f), bon = BON[(size_t)row * RHEADS + (lane >> 2)];
#pragma unroll
            for (int i = 0; i < 16; ++i) y[i] = y[i] * rstd * ln_g[l * RD + c + i] + ln_b[l * RD + c + i] + bon * vv[i];
            st16(YNB + (size_t)row * RD + c, y);
        }
        {
            float of[16], ob[16], gt[16], o[16];
            ld16(O + (size_t)row * GVD + c, true, of); ld16(O + ((size_t)TA + row) * GVD + c, true, ob); ld16(P + (size_t)row * NP + GLA_GATE_OFF + c, true, gt);
            float s = 0.f;
#pragma unroll
            for (int i = 0; i < 16; ++i) { o[i] = of[i] + ob[i]; s += o[i] * o[i]; }
            s += __shfl_xor(s, 1); s += __shfl_xor(s, 2); s += __shfl_xor(s, 4); s += __shfl_xor(s, 8);
            const float rinv = 1.0f / sqrtf(s * (1.0f / 256.0f) + 1e-6f);
#pragma unroll
            for (int i = 0; i < 16; ++i) o[i] = o[i] * rinv * gng[l * GDV + ((c + i) & 255)] * siluf(gt[i]);
            st16(YB + (size_t)row * GVD + c, o);
        }
    }
}

#ifndef CHUNK_LOADS_FIRST
#define CHUNK_LOADS_FIRST 1
#endif
#ifndef CHUNK_PF
#define CHUNK_PF 1
#endif
#ifndef SUBST_PK
#define SUBST_PK 0
#endif
#ifndef CONS_UNROLL
#define CONS_UNROLL 1
#endif
#ifndef CHUNK_NOPS
#define CHUNK_NOPS 0
#endif
#ifndef PROD_PK
#define PROD_PK 0
#endif
#ifndef LDS_POISON
#define LDS_POISON 0
#endif
#ifndef CHUNK_DBG
#define CHUNK_DBG 0
#endif
constexpr int RC_XT = 0;
constexpr int RC_YH = RC_XT + 32 * 72 * 2;
constexpr int RC_BET = RC_YH + 64 * 24 * 2;
constexpr int RC_AM = RC_YH + 2 * 64 * 24 * 2;
constexpr int RC_P2 = RC_AM + 2048;
constexpr int RC_AKR = RC_P2 + 512;
constexpr int RC_ABR = RC_AKR + 512;
constexpr int RC_GC = RC_ABR + 512;
constexpr int RC_SLOT = RC_GC + 256;
static_assert(RC_SLOT == 14592 && 8 * RC_SLOT <= 131072 && 32 * 72 * 2 <= 2 * 64 * 24 * 2, "rwkv chunk lds");
__device__ __forceinline__ bf16x8 mk8(u32x2 lo, u32x2 hi) { u32x4 v = {lo.x, lo.y, hi.x, hi.y}; return __builtin_bit_cast(bf16x8, v); }
__device__ __forceinline__ int rwkv_chunk_rmin(int b, int dir, int c) {
    const int p0 = c * 16;
    if (p0 < CTXL) return TL + b * CTXL + (dir ? CTXL - 16 - p0 : p0);
    const int q = p0 - CTXL; return b * SEQ + (dir ? SEQ - 16 - q : q);
}
__device__ __forceinline__ unsigned f2bf_hi(float f) { return __float_as_uint(f) + 0x8000u; }
#ifndef FAST_RND
#define FAST_RND 0
#endif
#ifndef USE_RCP
#define USE_RCP 0
#endif
#ifndef CHUNK_SADDR
#define CHUNK_SADDR 0
#endif
#ifndef Y_SADDR
#define Y_SADDR 0
#endif
#if FAST_RND
#define BFH(x) ((bf16)(f2bf_hi(x) >> 16))
#else
#define BFH(x) ((bf16)f2bf(x))
#endif
template <int SKIP = 0>
__device__ __forceinline__ void ph_rwkv_chunk(const KC& k, int l, int job, const float* k_a, size_t yoff = RW_Y) {
    const int b = job >> 5, h = (job >> 1) & 15, dir = job & 1;
    const int w = k.wave, lane = k.lane, q4 = lane >> 4, l15 = lane & 15;
    const bf16* R = (const bf16*)(k.ws + RW_R); const bf16* KS = (const bf16*)(k.ws + RW_KS); const bf16* V = (const bf16*)(k.ws + RW_V); const bf16* KK = (const bf16*)(k.ws + RW_KK);
    const bf16* LO = (const bf16*)(k.ws + RW_LO); bf16* Y = (bf16*)(k.ws + yoff) + (size_t)dir * TA * RD;
    LAS unsigned char* slot = k.lds + w * RC_SLOT;
    LAS bf16* XT = (LAS bf16*)(slot + RC_XT); LAS bf16* YH = (LAS bf16*)(slot + RC_YH);
    LAS float* AM = (LAS float*)(slot + RC_AM);
    const int ch = h * RHS + lane;
    const float ka = k_a[l * RD + ch];
    f32x4 accZ[4];
#pragma unroll
    for (int t = 0; t < 4; ++t) accZ[t] = (f32x4){0.f, 0.f, 0.f, 0.f};
    constexpr int NCK = (CTXL + SEQ) / 16, NRND = NCK / 8;
    unsigned ylane[4];
#pragma unroll
    for (int r = 0; r < 4; ++r) { const int tk = 4 * q4 + r; ylane[r] = (unsigned)(((dir ? 15 - tk : tk) * RD + h * RHS + 16 * (w & 3) + l15) * 2); }
#if CHUNK_PF
    unsigned pf0 = 0u, pf1 = 0u, pf2 = 0u;
#endif
#if LDS_POISON
    for (int i = lane; i < RC_SLOT / 4; i += 64) ((LAS unsigned*)slot)[i] = 0x7fc07fc0u;
    __syncthreads();
#endif
    for (int rnd = 0; rnd < NRND; ++rnd) {
#if LDS_POISON
        for (int i = lane; i < RC_SLOT / 4; i += 64) ((LAS unsigned*)slot)[i] = 0x7fc07fc0u;
#endif
        if (!(SKIP & 2)) {
            const int c = rnd * 8 + w;
            float Lc = 0.f, Eprev = 1.f;
            unsigned vp[8];
#if CHUNK_LOADS_FIRST
            unsigned rv[16], rkk[16], re[16], ra[16], rks[16], rr[16];
            const unsigned rmin = (unsigned)rwkv_chunk_rmin(b, dir, c);
            const unsigned ob1 = (rmin * (unsigned)RD + (unsigned)ch) * 2u, ob4 = (rmin * 4096u + (unsigned)(dir * RD) + (unsigned)ch) * 2u;
            const char* LOa = (const char*)LO + 4096;
#pragma unroll
            for (int t = 0; t < 16; ++t) {
#if CHUNK_SADDR
                const unsigned tr = dir ? 15u - t : (unsigned)t;
                const unsigned o1 = ob1 + tr * (unsigned)(RD * 2), o4 = ob4 + tr * 8192u;
                if (SKIP & 4) { rv[t] = o1; rkk[t] = o1 >> 3; re[t] = 0x3c00u + (o4 & 255u); ra[t] = 0x3f00u; rks[t] = o1 >> 5; rr[t] = o1 >> 7; }
                else { rv[t] = *(const bf16*)((const char*)V + o1); rkk[t] = *(const bf16*)((const char*)KK + o1); re[t] = *(const bf16*)((const char*)LO + o4); ra[t] = *(const bf16*)(LOa + o4);
                       rks[t] = *(const bf16*)((const char*)KS + o1); rr[t] = *(const bf16*)((const char*)R + o1); }
#else
                const unsigned o1 = (unsigned)rwkv_row(b, dir, c * 16 + t) * (unsigned)RD + (unsigned)ch, o4 = o1 * 4u - 3u * (unsigned)ch + (unsigned)(dir * RD);
                if (SKIP & 4) { rv[t] = o1; rkk[t] = o1 >> 3; re[t] = 0x3c00u + (o4 & 255u); ra[t] = 0x3f00u; rks[t] = o1 >> 5; rr[t] = o1 >> 7; }
                else { rv[t] = V[o1]; rkk[t] = KK[o1]; re[t] = LO[o4]; ra[t] = LO[o4 + 2048u]; rks[t] = KS[o1]; rr[t] = R[o1]; }
#endif
            }
            asm volatile("" ::: "memory");
            const float omka = 1.0f - ka;
#pragma unroll
            for (int t = 0; t < ((SKIP & 16) ? 1 : 16); ++t) {
                { const unsigned vraw = rv[t]; vp[t >> 1] = (t & 1) ? (vp[t >> 1] | (vraw << 16)) : vraw; }
                const float kkv = bf2f(rkk[t]), ev = bf2f(re[t]), av = bf2f(ra[t]);
                const float ksv = bf2f(rks[t]), rv_ = bf2f(rr[t]);
                Lc -= ev;
#if USE_RCP
                const float E = __expf(Lc), Einv = __builtin_amdgcn_rcpf(E);
#else
                const float E = __expf(Lc), Einv = __expf(-Lc);
#endif
                XT[t * 72 + lane] = BFH(kkv * Eprev); XT[(16 + t) * 72 + lane] = BFH(rv_ * E);
                YH[t * 72 + lane] = BFH(kkv * av * Einv); YH[(16 + t) * 72 + lane] = BFH(ksv * __builtin_fmaf(av, ka, omka) * Einv);
                Eprev = E;
            }
#else
#pragma unroll
            for (int t = 0; t < 16; ++t) {
                const unsigned o1 = (unsigned)rwkv_row(b, dir, c * 16 + t) * (unsigned)RD + (unsigned)ch, o4 = o1 * 4u - 3u * (unsigned)ch + (unsigned)(dir * RD);
                { const unsigned vraw = V[o1]; vp[t >> 1] = (t & 1) ? (vp[t >> 1] | (vraw << 16)) : vraw; }
                const float kkv = bf2f(KK[o1]), ev = bf2f(LO[o4]), av = bf2f(LO[o4 + 2048u]);
                const float ksv = bf2f(KS[o1]), rv = bf2f(R[o1]);
                Lc -= ev;
                const float E = __expf(Lc), Einv = __expf(-Lc);
                XT[t * 72 + lane] = (bf16)f2bf(kkv * Eprev); XT[(16 + t) * 72 + lane] = (bf16)f2bf(rv * E);
                YH[t * 72 + lane] = (bf16)f2bf(kkv * av * Einv); YH[(16 + t) * 72 + lane] = (bf16)f2bf(ksv * (1.0f + (av - 1.0f) * ka) * Einv);
                Eprev = E;
            }
#endif
            const float eLC = Eprev;
            asm volatile("s_waitcnt lgkmcnt(0)" ::: "memory");
#if CHUNK_PF
            if (w >= 4) {
                const int cn0 = (rnd + 1 < NRND ? rnd + 1 : rnd) * 8;
                int ln = lane; asm volatile("" : "+v"(ln));
                auto pf_off = [&](int j) -> unsigned {
                    const int i = (w - 4) * 192 + j * 64 + ln, cc = i / 96, wi = i - cc * 96, ar = wi >> 4, tk = wi & 15;
                    const unsigned row = (unsigned)rwkv_row(b, dir, (cn0 + cc) * 16 + tk);
                    const unsigned base = ar == 0 ? (unsigned)RW_R : ar == 1 ? (unsigned)RW_KS : ar == 2 ? (unsigned)RW_V : ar == 3 ? (unsigned)RW_KK : (unsigned)RW_LO;
                    const unsigned el = ar < 4 ? row * (unsigned)RD + (unsigned)(h * RHS) : row * 4096u + (unsigned)(dir * RD + h * RHS) + (unsigned)(ar - 4) * 2048u;
                    return base + 2u * el; };
                const unsigned q0 = pf_off(0), q1 = pf_off(1), q2 = pf_off(2);
                asm volatile("global_load_dword %0, %3, %6\n\tglobal_load_dword %1, %4, %6\n\tglobal_load_dword %2, %5, %6" : "+v"(pf0), "+v"(pf1), "+v"(pf2) : "v"(q0), "v"(q1), "v"(q2), "s"(k.ws) : "memory");
            }
#endif
            f32x4 am[2][2];
#pragma unroll
            for (int rt = 0; rt < 2; ++rt)
#pragma unroll
                for (int ct = 0; ct < 2; ++ct) {
                    f32x4 acc = (f32x4){0.f, 0.f, 0.f, 0.f};
#pragma unroll
                    for (int s = 0; s < ((SKIP & 32) ? 0 : 2); ++s) acc = __builtin_amdgcn_mfma_f32_16x16x32_bf16(*(const LAS bf16x8*)(XT + (16 * rt + l15) * 72 + 32 * s + 8 * q4), *(const LAS bf16x8*)(YH + (16 * ct + l15) * 72 + 32 * s + 8 * q4), acc, 0, 0, 0);
                    am[rt][ct] = acc;
                }
            LAS bf16* AKR = (LAS bf16*)(slot + RC_AKR); LAS bf16* ABR = (LAS bf16*)(slot + RC_ABR);
#pragma unroll
            for (int r = 0; r < 4; ++r) {
                const int t = 4 * q4 + r, j = l15;
                AM[t * 16 + j] = j < t ? am[0][0][r] : 0.f;
                AM[256 + t * 16 + j] = j < t ? am[0][1][r] : 0.f;
#if PROD_PK
                const unsigned ab2 = pk2c(j <= t ? -am[1][0][r] : 0.f, j <= t ? am[1][1][r] : 0.f);
                ABR[t * 16 + j] = (bf16)(ab2 & 0xffffu);
                AKR[t * 16 + j] = (bf16)(ab2 >> 16);
#else
                ABR[t * 16 + j] = BFH(j <= t ? -am[1][0][r] : 0.f);
                AKR[t * 16 + j] = BFH(j <= t ? am[1][1][r] : 0.f);
#endif
            }
            asm volatile("s_waitcnt lgkmcnt(0)" ::: "memory");
#if SUBST_PK
            f32x2 PP[16]; float kt[16];
#pragma unroll
            for (int t = 0; t < 16; ++t) kt[t] = bf2f(XT[t * 72 + lane]);
#pragma unroll
            for (int t = 0; t < 16; ++t) {
                asm volatile("" ::: "memory");
                f32x2 p = {kt[t], AM[256 + t * 16 + l15]};
#pragma unroll
                for (int j4 = 0; j4 < (t + 3) / 4; ++j4) {
                    const f32x4 arow = *(const LAS f32x4*)(AM + t * 16 + 4 * j4);
#pragma unroll
                    for (int e = 0; e < 4; ++e) { const int j = 4 * j4 + e; if (j < t) p -= PP[j] * arow[e]; }
                }
                PP[t] = p;
            }
#else
            float P1[16], P2[16], kt[16];
#pragma unroll
            for (int t = 0; t < 16; ++t) kt[t] = bf2f(XT[t * 72 + lane]);
#pragma unroll
            for (int t = 0; t < 16; ++t) {
                asm volatile("" ::: "memory");
                float p1 = kt[t], p2 = AM[256 + t * 16 + l15];
#pragma unroll
                for (int j4 = 0; j4 < (t + 3) / 4; ++j4) {
                    const f32x4 arow = *(const LAS f32x4*)(AM + t * 16 + 4 * j4);
#pragma unroll
                    for (int e = 0; e < 4; ++e) { const int j = 4 * j4 + e; if (j < t && !(SKIP & 8)) { p1 -= arow[e] * P1[j]; p2 -= arow[e] * P2[j]; } }
                }
                P1[t] = p1; P2[t] = p2;
            }
#endif
            LAS bf16* P2b = (LAS bf16*)(slot + RC_P2);
#pragma unroll
#if PROD_PK
            for (int t = 0; t < 16; ++t) { const unsigned pp = pk2c(0.f, 0.f); XT[t * 72 + lane] = (bf16)(pp & 0xffffu); if (lane < 16) P2b[t * 16 + lane] = (bf16)(pp >> 16); }
#else
#if SUBST_PK
            for (int t = 0; t < 16; ++t) { if (CHUNK_DBG != 12) XT[t * 72 + lane] = (bf16)f2bf(CHUNK_DBG == 13 ? 1.0f + (float)t : PP[t].x); if (lane < 16) P2b[t * 16 + lane] = (bf16)f2bf(PP[t].y); }
#else
            for (int t = 0; t < 16; ++t) { XT[t * 72 + lane] = BFH(P1[t]); if (lane < 16) P2b[t * 16 + lane] = BFH(P2[t]); }
#endif
#endif
            if (!(SKIP & 64)) {
                LAS bf16* KET = (LAS bf16*)(slot + RC_YH); LAS bf16* BET = (LAS bf16*)(slot + RC_BET);
                float ke[16], be[16];
#pragma unroll
                for (int t = 0; t < 16; ++t) { ke[t] = bf2f(YH[(16 + t) * 72 + lane]) * eLC; be[t] = -bf2f(YH[t * 72 + lane]) * eLC; }
                asm volatile("s_waitcnt lgkmcnt(0)" ::: "memory");
                float a0[8], a1[8], b0[8], b1[8];
#pragma unroll
                for (int t = 0; t < 8; ++t) { a0[t] = ke[t]; a1[t] = ke[8 + t]; b0[t] = be[t]; b1[t] = be[8 + t]; }
                *(LAS u32x4*)(KET + lane * 24) = pack8(a0); *(LAS u32x4*)(KET + lane * 24 + 8) = pack8(a1);
                *(LAS u32x4*)(BET + lane * 24) = pack8(b0); *(LAS u32x4*)(BET + lane * 24 + 8) = pack8(b1);
                ((LAS float*)(slot + RC_GC))[lane] = eLC;
                *(LAS u32x4*)(slot + RC_AM + lane * 32) = (u32x4){vp[0], vp[1], vp[2], vp[3]}; *(LAS u32x4*)(slot + RC_AM + lane * 32 + 16) = (u32x4){vp[4], vp[5], vp[6], vp[7]};
            }
        }
        __syncthreads();
        if (w < 4 && !(SKIP & 1)) {
#if CONS_UNROLL == 2
#pragma unroll 2
#else
#pragma unroll 1
#endif
            for (int cc = 0; cc < 8; ++cc) {
                const int c = rnd * 8 + cc;
                LAS unsigned char* sl = k.lds + cc * RC_SLOT;
                const LAS bf16* P1b = (const LAS bf16*)(sl + RC_XT); const LAS bf16* RTb = P1b + 16 * 72;
                const LAS bf16* KET = (const LAS bf16*)(sl + RC_YH); const LAS bf16* BET = (const LAS bf16*)(sl + RC_BET);
                const LAS bf16* P2b = (const LAS bf16*)(sl + RC_P2); const LAS bf16* AKR = (const LAS bf16*)(sl + RC_AKR); const LAS bf16* ABR = (const LAS bf16*)(sl + RC_ABR);
                const LAS float* GC = (const LAS float*)(sl + RC_GC);
                const u32x2 vfr = *(const LAS u32x2*)(sl + RC_AM + (16 * w + l15) * 32 + 8 * q4);
                const unsigned vlo = vfr.x, vhi = vfr.y;
#if CHUNK_DBG == 5
                for (int t = 0; t < 4; ++t) accZ[t] = (f32x4){0.f, 0.f, 0.f, 0.f};
#endif
#if CHUNK_NOPS
                asm volatile("s_nop 15\n\ts_nop 15" ::: "memory");
#endif
                bf16x8 bz[2];
#pragma unroll
                for (int s = 0; s < 2; ++s) { u32x4 v = {pk2c(accZ[2 * s][0], accZ[2 * s][1]), pk2c(accZ[2 * s][2], accZ[2 * s][3]), pk2c(accZ[2 * s + 1][0], accZ[2 * s + 1][1]), pk2c(accZ[2 * s + 1][2], accZ[2 * s + 1][3])}; bz[s] = __builtin_bit_cast(bf16x8, v); }
#if CHUNK_DBG == 6
                bz[0] = (bf16x8){0,0,0,0,0,0,0,0}; bz[1] = bz[0];
#endif
                const u32x2 zero2 = {0u, 0u};
                f32x4 zs[4];
#pragma unroll
                for (int t = 0; t < 4; ++t) zs[t] = accZ[t] * *(const LAS f32x4*)(GC + 16 * t + 4 * q4);
#if CHUNK_DBG == 7
                for (int t = 0; t < 4; ++t) zs[t] = (f32x4){0.f, 0.f, 0.f, 0.f};
#endif
                f32x4 sa = (f32x4){0.f, 0.f, 0.f, 0.f};
#if CHUNK_DBG >= 10 && CHUNK_DBG <= 13
                { u32x4 ones = {0x3f803f80u, 0x3f803f80u, 0x3f803f80u, 0x3f803f80u}; const bf16x8 bo = __builtin_bit_cast(bf16x8, ones);
                  for (int s = 0; s < 2; ++s) sa = __builtin_amdgcn_mfma_f32_16x16x32_bf16(mk8(*(const LAS u32x2*)(P1b + l15 * 72 + 32 * s + 4 * q4), *(const LAS u32x2*)(P1b + l15 * 72 + 32 * s + 16 + 4 * q4)), (CHUNK_DBG == 10 || CHUNK_DBG == 12 || CHUNK_DBG == 13) ? bo : bz[s], sa, 0, 0, 0); }
#else
#pragma unroll
                for (int s = 0; s < 2; ++s) if (CHUNK_DBG != 3 && CHUNK_DBG != 9) sa = __builtin_amdgcn_mfma_f32_16x16x32_bf16(mk8(*(const LAS u32x2*)(P1b + l15 * 72 + 32 * s + 4 * q4), *(const LAS u32x2*)(P1b + l15 * 72 + 32 * s + 16 + 4 * q4)), bz[s], sa, 0, 0, 0);
#endif
                if (CHUNK_DBG != 4 && !(CHUNK_DBG >= 10 && CHUNK_DBG <= 13)) { u32x4 bv = {vlo, vhi, 0u, 0u}; sa = __builtin_amdgcn_mfma_f32_16x16x32_bf16(mk8(*(const LAS u32x2*)(P2b + l15 * 16 + 4 * q4), zero2), __builtin_bit_cast(bf16x8, bv), sa, 0, 0, 0); }
#if CHUNK_DBG == 1
                sa = (f32x4){0.f, 0.f, 0.f, 0.f};
#endif
#if CHUNK_NOPS
                asm volatile("s_nop 15" : "+v"(sa));
#endif
                bf16x8 bv2; { u32x4 v = {vlo, vhi, pk2c(sa[0], sa[1]), pk2c(sa[2], sa[3])}; bv2 = __builtin_bit_cast(bf16x8, v); }
                f32x4 yy = (f32x4){0.f, 0.f, 0.f, 0.f};
#pragma unroll
                for (int s = 0; s < 2; ++s) if (CHUNK_DBG != 8) yy = __builtin_amdgcn_mfma_f32_16x16x32_bf16(mk8(*(const LAS u32x2*)(RTb + l15 * 72 + 32 * s + 4 * q4), *(const LAS u32x2*)(RTb + l15 * 72 + 32 * s + 16 + 4 * q4)), bz[s], yy, 0, 0, 0);
                yy = __builtin_amdgcn_mfma_f32_16x16x32_bf16(mk8(*(const LAS u32x2*)(AKR + l15 * 16 + 4 * q4), *(const LAS u32x2*)(ABR + l15 * 16 + 4 * q4)), bv2, yy, 0, 0, 0);
#pragma unroll
                for (int t = 0; t < 4; ++t) {
                    accZ[t] = __builtin_amdgcn_mfma_f32_16x16x32_bf16(mk8(*(const LAS u32x2*)(KET + (16 * t + l15) * 24 + 4 * q4), *(const LAS u32x2*)(BET + (16 * t + l15) * 24 + 4 * q4)), bv2, zs[t], 0, 0, 0);
                }
#if CHUNK_DBG == 2
                yy = (f32x4){1.f, 1.f, 1.f, 1.f};
#endif
#if CHUNK_DBG >= 10 && CHUNK_DBG <= 13
                yy = sa;
#endif
#if CHUNK_NOPS
                asm volatile("s_nop 15" : "+v"(yy));
#endif
#if Y_SADDR
                { const unsigned yb = (unsigned)rwkv_chunk_rmin(b, dir, c) * (unsigned)(RD * 2);
#pragma unroll
                  for (int r = 0; r < 4; ++r) *(bf16*)((char*)Y + (yb + ylane[r])) = BFH(yy[r]); }
#else
#pragma unroll
                for (int r = 0; r < 4; ++r) Y[(size_t)rwkv_row(b, dir, c * 16 + 4 * q4 + r) * RD + h * RHS + 16 * w + l15] = BFH(yy[r]);
#endif
            }
        }
#if CHUNK_PF
        else asm volatile("s_waitcnt vmcnt(0)" : "+v"(pf0), "+v"(pf1), "+v"(pf2) :: "memory");
#endif
        __syncthreads();
    }
}

#ifndef CHECK_EXACT
#define CHECK_EXACT 0
#endif
#ifndef CHECK_PMAX
#define CHECK_PMAX (CTXL + SEQ)
#endif
#ifndef CHECK_PMIN
#define CHECK_PMIN 0
#endif
#ifndef CHECK_UNIT
#define CHECK_UNIT 1000
#endif
__device__ __forceinline__ void rwkv_check_delay(const KC& k, int job, size_t refoff = RW_Y) {
    const int b = job >> 5, h = (job >> 1) & 15, dir = job & 1;
    const bf16* Ya = (const bf16*)(k.ws + refoff) + (size_t)dir * TA * RD; const bf16* Yb = (const bf16*)(k.ws + WS_H) + (size_t)dir * TA * RD;
    float d2 = 0.f, s2 = 0.f; int bad = 0;
    for (int i = k.tid; i < (CHECK_PMAX) * 32; i += 512) {
        const int p = (CHECK_PMIN) + (i >> 5), cp = i & 31; const size_t o = (size_t)rwkv_row(b, dir, p) * RD + h * RHS + 2 * cp;
        const unsigned ua = *(const unsigned*)(Ya + o), ub = *(const unsigned*)(Yb + o);
        const float a0 = bflo(ua), a1 = bfhi(ua), b0 = bflo(ub), b1 = bfhi(ub);
        d2 += (CHECK_EXACT) ? (ua != ub ? 1.0f : 0.0f) : (a0 - b0) * (a0 - b0) + (a1 - b1) * (a1 - b1); s2 += a0 * a0 + a1 * a1;
        if (!(b0 == b0) || !(b1 == b1) || fabsf(b0) > 1e30f || fabsf(b1) > 1e30f) bad = 1;
    }
    LAS float* red = (LAS float*)k.lds;
    __syncthreads();
    d2 = wave_sum(d2); s2 = wave_sum(s2); bad = __any(bad) ? 1 : 0;
    if (k.lane == 0) { red[k.wave * 4] = d2; red[k.wave * 4 + 1] = s2; red[k.wave * 4 + 2] = (float)bad; }
    __syncthreads();
    if (k.tid == 0) {
        float D = 0.f, S = 0.f, B = 0.f;
        for (int i = 0; i < 8; ++i) { D += red[i * 4]; S += red[i * 4 + 1]; B += red[i * 4 + 2]; }
        const float rel = sqrtf(D / fmaxf(S, 1e-30f));
        int bucket = rel < 0.01f ? 0 : rel < 0.03f ? 1 : rel < 0.1f ? 2 : rel < 0.3f ? 3 : rel < 1.0f ? 4 : 5;
        if (CHECK_EXACT) bucket = D == 0.f ? 0 : D < 10.f ? 1 : D < 100.f ? 2 : D < 1000.f ? 3 : D < 10000.f ? 4 : 5;
        if (B > 0.f || !(rel == rel)) bucket = 6;
        const unsigned long long t0 = __builtin_amdgcn_s_memrealtime(), wait = (unsigned long long)bucket * (CHECK_UNIT) * 100ull;
        while (__builtin_amdgcn_s_memrealtime() - t0 < wait) __builtin_amdgcn_s_sleep(8);
    }
    __syncthreads();
}
using pg8::Unit;
struct FP_ { bf16* P; __device__ __forceinline__ void operator()(int row, int col, float (&v)[8], const Unit&) const { *(u32x4*)(P + (size_t)row * NP + col) = pack8(v); } };
struct FL1_ { bf16* LO; const float* bias1;
    __device__ __forceinline__ void operator()(int row, int col, float (&v)[8], const Unit& u) const {
        const float* bias = bias1 + col;
        const f32x4 b0 = *(const f32x4*)bias, b1 = *(const f32x4*)(bias + 4);
        const float bb[8] = {b0.x, b0.y, b0.z, b0.w, b1.x, b1.y, b1.z, b1.w};
        const float sc = col < 2048 ? 0.6065306597126334f : 1.0f;
#pragma unroll
        for (int i = 0; i < 8; ++i) v[i] = sigm(bb[i] + v[i]) * sc;
        *(u32x4*)(LO + (size_t)row * 4096 + col) = pack8(v);
    } };
struct FL2_ { const bf16* YNB; bf16* YA;
    __device__ __forceinline__ void operator()(int row, int col, float (&v)[8], const Unit&) const {
        float y[8]; unpack8(*(const u32x4*)(YNB + (size_t)row * RD + col), y);
#pragma unroll
        for (int i = 0; i < 8; ++i) v[i] *= y[i];
        *(u32x4*)(YA + (size_t)row * RD + col) = pack8(v);
    } };
template <int SECOND> struct FM_ { const bf16* P; bf16* MA; bf16* OUT;
    __device__ __forceinline__ void operator()(int row, int col, float (&v)[8], const Unit&) const {
        float g[8]; unpack8(*(const u32x4*)(P + (size_t)row * NP + BR_OFF + SECOND * DM + col), g);
        const bf16* mp = MA + (size_t)row * DM + col;
        if (SECOND) { float m[8]; unpack8(*(const u32x4*)mp, m);
#pragma unroll
            for (int i = 0; i < 8; ++i) v[i] = sigm(g[i]) * v[i] + m[i]; }
        else {
#pragma unroll
            for (int i = 0; i < 8; ++i) v[i] = sigm(g[i]) * v[i]; }
        *(u32x4*)(OUT + (size_t)row * DM + col) = pack8(v);
    } };
struct FX_ { float* X; const float* MOD; int l; float* OUT;
    __device__ __forceinline__ void operator()(int row, int col, const f32x4 v, const Unit&) const {
        const f32x4 g = *(const f32x4*)(MOD + ((size_t)l * 9 + mod_row(row)) * MOD_N + 2 * DM + col);
        const f32x4* xp = (const f32x4*)(X + (size_t)row * DM + col);
        *(f32x4*)(OUT + (size_t)row * DM + col) = *xp + g * v;
    } };
struct FXb_ { bf16* X; const float* MOD; int l;
    __device__ __forceinline__ void operator()(int row, int col, float (&v)[8], const Unit&) const {
        const float* gp = MOD + ((size_t)l * 9 + mod_row(row)) * MOD_N + 2 * DM + col;
        const f32x4 g0 = *(const f32x4*)gp, g1 = *(const f32x4*)(gp + 4);
        const float gg[8] = {g0.x, g0.y, g0.z, g0.w, g1.x, g1.y, g1.z, g1.w};
        bf16* xp = X + (size_t)row * DM + col;
        float x[8]; unpack8(*(const u32x4*)xp, x);
#pragma unroll
        for (int i = 0; i < 8; ++i) v[i] = x[i] + gg[i] * v[i];
        *(u32x4*)xp = pack8(v);
    } };
struct FE1_ { bf16* ACT;
    __device__ __forceinline__ void operator()(int row, int col, float (&g)[8], float (&up)[8]) const {
#pragma unroll
        for (int i = 0; i < 8; ++i) g[i] = siluf(g[i]) * up[i];
        *(u32x4*)(ACT + (size_t)row * DEXP + col) = pack8(g);
    } };
struct FE2_ { const int* rowtok; const float* roww; bf16* YF;
    __device__ __forceinline__ void operator()(int row, int col, float (&v)[8], const Unit&) const {
        const int t2 = rowtok[row];
        if (t2 >= 0) { const float w = roww[row];
#pragma unroll
            for (int i = 0; i < 8; ++i) v[i] *= w;
            *(u32x4*)(YF + ((size_t)(t2 & 1) * TA + (t2 >> 1)) * DM + col) = pack8(v); }
    } };

#ifndef GA_
#define GA_ true
#endif
#ifndef GS_
#define GS_ true
#endif
constexpr int LDS_BYTES = 147456;
constexpr int MISC_OFF = 131072 + 4096;

constexpr int NPHASE = 2 + 14 * DEPTH + 1;
struct Args { const float* in[N_IN]; float* out; unsigned char* ws; int ph_lo, ph_hi; };
static_assert(sizeof(Args) == N_IN * 8 + 8 + 8 + 8, "Args has no padding");

__global__ void __launch_bounds__(512, 2) fwd(Args a) {
    extern __shared__ __attribute__((aligned(16))) unsigned char lds_raw[];
    KC k;
    k.lds = (LAS unsigned char*)lds_raw; k.ws = (unsigned char*)INP(N_IN + 1);
    k.tid = threadIdx.x; k.lane = k.tid & 63; k.wave = __builtin_amdgcn_readfirstlane(k.tid >> 6); k.G = gridDim.x; k.bid = blockIdx.x;
    const int lo = a.ph_lo, hi = a.ph_hi;
    volatile LAS unsigned* MISC = (volatile LAS unsigned*)(k.lds + MISC_OFF);
    if (k.tid < 32) MISC[k.tid] = 0u;
    __syncthreads();
    XcdBarrier bar; bar.bar = (unsigned*)(k.ws + WS_CTL) + CW_BAR; bar.x = 0; bar.st = nullptr;
    if (hi - lo > 1) bar = xcd_barrier_post((unsigned*)(k.ws + WS_CTL) + CW_BAR, MISC + 8);
#ifndef SITE_MASK
#define SITE_MASK 0xFFFFFFFFu
#endif
#define FRESH() do { int t_ = threadIdx.x; asm volatile("" : "+v"(t_)); k.tid = t_; k.lane = t_ & 63; k.wave = __builtin_amdgcn_readfirstlane(t_ >> 6); k.ws = (unsigned char*)INP(N_IN + 1); ws = k.ws; } while (0)
#define PH_BEGIN(p, site) if (((SITE_MASK >> (site)) & 1u) && lo <= (p) && (p) < hi) { FRESH();
#ifndef EXTRA_BARS
#define EXTRA_BARS 0
#endif
#ifndef DUP_MASK
#define DUP_MASK 0u
#endif
#define DUPRUN(n, stmt) do { stmt; if ((DUP_MASK >> (n)) & 1u) { __syncthreads(); stmt; } } while (0)
#define PH_END(p) if ((p) + 1 < hi) xcd_barrier(bar); }
    unsigned char* ws = k.ws;
    LAS unsigned char* glds = k.lds;
#define WSRC WSrc{INP(I_WIN), INP(I_W2), INP(I_A2), INP(I_G2), INP(I_WBA), INP(I_WBB), INP(I_WOUT), INP(I_EG), INP(I_EU), INP(I_ED), INP(I_W0), INP(I_A0)}

    PH_BEGIN(0, 0) DUPRUN(0, ph_adaln_partials(k, INP(I_C), INP(I_CCTX), INP(I_WADA))); DUPRUN(1, ph_convert(k, WSRC, 0)); PH_END(0)
    PH_BEGIN(1, 1) ph_adaln_reduce(k, INP(I_BADA)); PH_END(1)

#define L_ 0
    {
        constexpr int l = L_;
        const int pb = 2 + 14 * l;
        const bool last = (l == DEPTH - 1);
        const int Mpost = last ? TL : TA;
        PH_BEGIN(pb + 0, 2)
            if (l > 0) { DUPRUN(1, ph_convert(k, WSRC, l)); }
            RowArgs ra{INP(I_X), INP(I_CTX), INP(I_NMG), nullptr, nullptr, nullptr};
            ph_rows<0>(k, ra, l, TA);
            if (l == 0 && ((DUP_MASK >> 15) & 1u)) { __syncthreads(); ph_rows<0>(k, ra, l, TA); }
        PH_END(pb + 0)
        PH_BEGIN(pb + 1, 3)
            pg8::Gemm g{(const bf16*)(ws + WS_H), (const bf16*)(ws + WT_IN), TA, NP, DM, 0}; pg8::StaticOrder S; S.init(TA, NP, k.G, k.bid);
            pg8::Epi8<FP_> E{FP_{(bf16*)(ws + WS_P)}};
            DUPRUN(2, (pg8::gemm_phase<pg8::Epi8<FP_>, pg8::StaticOrder, GA_, GS_>(glds, g, S, E)));
        PH_END(pb + 1)
        PH_BEGIN(pb + 2, 4)
            DUPRUN(3, ph_rwkv_prep(k, l, TA, INP(I_MU), INP(I_KK), INP(I_RK)));
            DUPRUN(4, ph_gla_prep(k, l, INP(I_GCONV), INP(I_GAW2), INP(I_GAB)));
        PH_END(pb + 2)
        PH_BEGIN(pb + 3, 5)
            pg8::Gemm g{(const bf16*)(ws + RW_A1), (const bf16*)(ws + WT_L1), TA, 4096, 256, 0}; pg8::StaticOrder S; S.init(TA, 4096, k.G, k.bid);
            pg8::Epi8<FL1_> E{FL1_{(bf16*)(ws + RW_LO), (const float*)(ws + WS_TAB + TAB_TOP)}};
            DUPRUN(5, (pg8::gemm_phase<pg8::Epi8<FL1_>, pg8::StaticOrder, GA_, GS_>(glds, g, S, E)));
        PH_END(pb + 3)
        PH_BEGIN(pb + 4, 6)
#if SPLIT_SCAN
            DUPRUN(6, ph_scan_split(k, l, INP(I_KA)));
#else
            for (int vb = ((k.G & 7) ? k.bid : (k.bid & 7) * (k.G >> 3) + (k.bid >> 3)); vb < 256; vb += k.G) { const int job = vb;
#if RWKV_MODE == 0
                DUPRUN(6, ph_rwkv_scan(k, l, job, INP(I_KA)));
#elif RWKV_MODE == 1
                ph_rwkv_scan(k, l, job, INP(I_KA)); ph_rwkv_chunk(k, l, job, INP(I_KA), WS_H); if (l == 0) rwkv_check_delay(k, job);
#elif RWKV_MODE == 4
                ph_rwkv_scan(k, l, job, INP(I_KA)); ph_rwkv_chunk(k, l, job, INP(I_KA), WS_H); ph_rwkv_chunk(k, l, job, INP(I_KA), WS_END); if (l == 0) rwkv_check_delay(k, job, WS_END);
#elif RWKV_MODE == 5
#pragma unroll 1
                for (int rep = 0; rep < 2; ++rep) { int r_ = rep; asm volatile("" : "+s"(r_)); __syncthreads(); ph_rwkv_chunk(k, l, job, INP(I_KA), r_ ? (size_t)RW_Y : (size_t)WS_H); }
                if (l == 0) rwkv_check_delay(k, job);
#elif RWKV_MODE == 3
                ph_rwkv_scan(k, l, job, INP(I_KA)); ph_rwkv_scan(k, l, job, INP(I_KA), WS_H); if (l == 0) rwkv_check_delay(k, job);
#else
                DUPRUN(6, ph_rwkv_chunk(k, l, job, INP(I_KA)));
#ifdef CHUNK_PROBE
                __syncthreads(); ph_rwkv_chunk<CHUNK_PROBE>(k, l, job, INP(I_KA), WS_END);
#endif
#endif
            }
#ifndef NO_GLA
            FRESH();
            for (int vb = ((k.G & 7) ? k.bid : (k.bid & 7) * (k.G >> 3) + (k.bid >> 3)); vb < 256; vb += k.G) { const int job = vb; DUPRUN(7, ph_gla_scan(k, job)); }
#endif
#endif
        PH_END(pb + 4)
        PH_BEGIN(pb + 5, 7)
            DUPRUN(8, ph_post(k, l, Mpost, INP(I_LNG), INP(I_LNB), INP(I_GNG)));
        PH_END(pb + 5)
        PH_BEGIN(pb + 6, 8)
            pg8::Gemm g{(const bf16*)(ws + RW_A2), (const bf16*)(ws + WT_G2), Mpost, RD, 256, 0}; pg8::StaticOrder S; S.init(Mpost, RD, k.G, k.bid);
            pg8::Epi8<FL2_> E{FL2_{(const bf16*)(ws + RW_R), (bf16*)(ws + RW_V)}};
            DUPRUN(9, (pg8::gemm_phase<pg8::Epi8<FL2_>, pg8::StaticOrder, GA_, GS_>(glds, g, S, E)));
        PH_END(pb + 6)
        PH_BEGIN(pb + 7, 9)
            pg8::Gemm g{(const bf16*)(ws + RW_V), (const bf16*)(ws + WT_A), Mpost, DM, RD, 0}; pg8::StaticOrder S; S.init(Mpost, DM, k.G, k.bid);
            pg8::Epi8<FM_<0>> E{FM_<0>{(const bf16*)(ws + WS_P), (bf16*)(ws + WS_H), (bf16*)(ws + WS_H)}};
            DUPRUN(10, (pg8::gemm_phase<pg8::Epi8<FM_<0>>, pg8::StaticOrder, GA_, GS_>(glds, g, S, E)));
        PH_END(pb + 7)
        PH_BEGIN(pb + 8, 10)
            pg8::Gemm g{(const bf16*)(ws + GL_VS), (const bf16*)(ws + WT_B), Mpost, DM, GVD, 0}; pg8::StaticOrder S; S.init(Mpost, DM, k.G, k.bid);
            pg8::Epi8<FM_<1>> E{FM_<1>{(const bf16*)(ws + WS_P), (bf16*)(ws + WS_H), (bf16*)(ws + WS_H)}};
            pg8::gemm_phase<pg8::Epi8<FM_<1>>, pg8::StaticOrder, GA_, GS_>(glds, g, S, E);
            if ((DUP_MASK >> 17) & 1u) { __syncthreads(); pg8::Epi8<FM_<1>> E2{FM_<1>{(const bf16*)(ws + WS_P), (bf16*)(ws + WS_H), (bf16*)(ws + RW_R)}}; pg8::gemm_phase<pg8::Epi8<FM_<1>>, pg8::StaticOrder, GA_, GS_>(glds, g, S, E2); }
        PH_END(pb + 8)
        PH_BEGIN(pb + 9, 11)
            pg8::Gemm g{(const bf16*)(ws + WS_H), (const bf16*)(ws + WT_O), Mpost, DM, DM, 0}; pg8::StaticOrder S; S.init(Mpost, DM, k.G, k.bid);
#if XBF
            pg8::Epi8<FXb_> E{FXb_{(bf16*)(ws + WS_X), (const float*)(ws + WS_MOD), l}};
            pg8::gemm_phase<pg8::Epi8<FXb_>, pg8::StaticOrder, GA_, GS_>(glds, g, S, E);
#else
            pg8::Epi4<FX_> E{FX_{(float*)(ws + WS_X), (const float*)(ws + WS_MOD), l, (float*)(ws + WS_X)}};
            pg8::gemm_phase<pg8::Epi4<FX_>, pg8::StaticOrder, GA_, GS_>(glds, g, S, E);
#endif
            if (!XBF && ((DUP_MASK >> 18) & 1u)) { __syncthreads(); pg8::Epi4<FX_> E2{FX_{(float*)(ws + WS_X), (const float*)(ws + WS_MOD), l, (float*)(ws + WS_P)}}; pg8::gemm_phase<pg8::Epi4<FX_>, pg8::StaticOrder, GA_, GS_>(glds, g, S, E2); }
        PH_END(pb + 9)
        PH_BEGIN(pb + 10, 12)
            RowArgs ra{nullptr, nullptr, INP(I_NFG), INP(I_RW), INP(I_RB), nullptr};
            ph_rows<1>(k, ra, l, Mpost);
            if ((DUP_MASK >> 16) & 1u) { __syncthreads(); ph_rows<1>(k, ra, l, Mpost, true); }
        PH_END(pb + 10)
        PH_BEGIN(pb + 11, 13)
            DUPRUN(13, ph_moe_scatter(k, l, Mpost));
        PH_END(pb + 11)
        PH_BEGIN(pb + 12, 14)
            pg8::Gemm g{(const bf16*)(ws + WS_HP), (const bf16*)(ws + WT_GU), 0, 2816, DM, (size_t)2816 * DM * 2};
            pg8::MoeOrder S; S.init((const int*)(ws + WS_TAB + TAB_TILE) + 256 * l, 11, k.G, ((k.G & 7) ? k.bid : (k.bid & 7) * (k.G >> 3) + (k.bid >> 3)));
            pg8::EpiGU<FE1_> E{FE1_{(bf16*)(ws + WS_ACT)}};
            DUPRUN(11, (pg8::gemm_phase<pg8::EpiGU<FE1_>, pg8::MoeOrder, GA_, GS_>(glds, g, S, E)));
        PH_END(pb + 12)
        PH_BEGIN(pb + 13, 15)
            pg8::Gemm g{(const bf16*)(ws + WS_ACT), (const bf16*)(ws + WT_D), 0, DM, DEXP, (size_t)DM * DEXP * 2};
            pg8::MoeOrder S; S.init((const int*)(ws + WS_TAB + TAB_TILE) + 256 * l, 8, k.G, ((k.G & 7) ? k.bid : (k.bid & 7) * (k.G >> 3) + (k.bid >> 3)));
            pg8::Epi8<FE2_> E{FE2_{(const int*)(ws + WS_TAB + TAB_ROWTOK) + (size_t)l * MOE_ROWS, (const float*)(ws + WS_TAB + TAB_ROWW) + (size_t)l * MOE_ROWS, (bf16*)(ws + WS_YF)}};
            DUPRUN(12, (pg8::gemm_phase<pg8::Epi8<FE2_>, pg8::MoeOrder, GA_, GS_>(glds, g, S, E)));
        PH_END(pb + 13)
        }
#undef L_
#define L_ 1
    {
        constexpr int l = L_;
        const int pb = 2 + 14 * l;
        const bool last = (l == DEPTH - 1);
        const int Mpost = last ? TL : TA;
        PH_BEGIN(pb + 0, 2)
            if (l > 0) { DUPRUN(1, ph_convert(k, WSRC, l)); }
            RowArgs ra{INP(I_X), INP(I_CTX), INP(I_NMG), nullptr, nullptr, nullptr};
            ph_rows<0>(k, ra, l, TA);
            if (l == 0 && ((DUP_MASK >> 15) & 1u)) { __syncthreads(); ph_rows<0>(k, ra, l, TA); }
        PH_END(pb + 0)
        PH_BEGIN(pb + 1, 3)
            pg8::Gemm g{(const bf16*)(ws + WS_H), (const bf16*)(ws + WT_IN), TA, NP, DM, 0}; pg8::StaticOrder S; S.init(TA, NP, k.G, k.bid);
            pg8::Epi8<FP_> E{FP_{(bf16*)(ws + WS_P)}};
            DUPRUN(2, (pg8::gemm_phase<pg8::Epi8<FP_>, pg8::StaticOrder, GA_, GS_>(glds, g, S, E)));
        PH_END(pb + 1)
        PH_BEGIN(pb + 2, 4)
            DUPRUN(3, ph_rwkv_prep(k, l, TA, INP(I_MU), INP(I_KK), INP(I_RK)));
            DUPRUN(4, ph_gla_prep(k, l, INP(I_GCONV), INP(I_GAW2), INP(I_GAB)));
        PH_END(pb + 2)
        PH_BEGIN(pb + 3, 5)
            pg8::Gemm g{(const bf16*)(ws + RW_A1), (const bf16*)(ws + WT_L1), TA, 4096, 256, 0}; pg8::StaticOrder S; S.init(TA, 4096, k.G, k.bid);
            pg8::Epi8<FL1_> E{FL1_{(bf16*)(ws + RW_LO), (const float*)(ws + WS_TAB + TAB_TOP)}};
            DUPRUN(5, (pg8::gemm_phase<pg8::Epi8<FL1_>, pg8::StaticOrder, GA_, GS_>(glds, g, S, E)));
        PH_END(pb + 3)
        PH_BEGIN(pb + 4, 6)
#if SPLIT_SCAN
            DUPRUN(6, ph_scan_split(k, l, INP(I_KA)));
#else
            for (int vb = ((k.G & 7) ? k.bid : (k.bid & 7) * (k.G >> 3) + (k.bid >> 3)); vb < 256; vb += k.G) { const int job = vb;
#if RWKV_MODE == 0
                DUPRUN(6, ph_rwkv_scan(k, l, job, INP(I_KA)));
#elif RWKV_MODE == 1
                ph_rwkv_scan(k, l, job, INP(I_KA)); ph_rwkv_chunk(k, l, job, INP(I_KA), WS_H); if (l == 0) rwkv_check_delay(k, job);
#elif RWKV_MODE == 4
                ph_rwkv_scan(k, l, job, INP(I_KA)); ph_rwkv_chunk(k, l, job, INP(I_KA), WS_H); ph_rwkv_chunk(k, l, job, INP(I_KA), WS_END); if (l == 0) rwkv_check_delay(k, job, WS_END);
#elif RWKV_MODE == 5
#pragma unroll 1
                for (int rep = 0; rep < 2; ++rep) { int r_ = rep; asm volatile("" : "+s"(r_)); __syncthreads(); ph_rwkv_chunk(k, l, job, INP(I_KA), r_ ? (size_t)RW_Y : (size_t)WS_H); }
                if (l == 0) rwkv_check_delay(k, job);
#elif RWKV_MODE == 3
                ph_rwkv_scan(k, l, job, INP(I_KA)); ph_rwkv_scan(k, l, job, INP(I_KA), WS_H); if (l == 0) rwkv_check_delay(k, job);
#else
                DUPRUN(6, ph_rwkv_chunk(k, l, job, INP(I_KA)));
#ifdef CHUNK_PROBE
                __syncthreads(); ph_rwkv_chunk<CHUNK_PROBE>(k, l, job, INP(I_KA), WS_END);
#endif
#endif
            }
#ifndef NO_GLA
            FRESH();
            for (int vb = ((k.G & 7) ? k.bid : (k.bid & 7) * (k.G >> 3) + (k.bid >> 3)); vb < 256; vb += k.G) { const int job = vb; DUPRUN(7, ph_gla_scan(k, job)); }
#endif
#endif
        PH_END(pb + 4)
        PH_BEGIN(pb + 5, 7)
            DUPRUN(8, ph_post(k, l, Mpost, INP(I_LNG), INP(I_LNB), INP(I_GNG)));
        PH_END(pb + 5)
        PH_BEGIN(pb + 6, 8)
            pg8::Gemm g{(const bf16*)(ws + RW_A2), (const bf16*)(ws + WT_G2), Mpost, RD, 256, 0}; pg8::StaticOrder S; S.init(Mpost, RD, k.G, k.bid);
            pg8::Epi8<FL2_> E{FL2_{(const bf16*)(ws + RW_R), (bf16*)(ws + RW_V)}};
            DUPRUN(9, (pg8::gemm_phase<pg8::Epi8<FL2_>, pg8::StaticOrder, GA_, GS_>(glds, g, S, E)));
        PH_END(pb + 6)
        PH_BEGIN(pb + 7, 9)
            pg8::Gemm g{(const bf16*)(ws + RW_V), (const bf16*)(ws + WT_A), Mpost, DM, RD, 0}; pg8::StaticOrder S; S.init(Mpost, DM, k.G, k.bid);
            pg8::Epi8<FM_<0>> E{FM_<0>{(const bf16*)(ws + WS_P), (bf16*)(ws + WS_H), (bf16*)(ws + WS_H)}};
            DUPRUN(10, (pg8::gemm_phase<pg8::Epi8<FM_<0>>, pg8::StaticOrder, GA_, GS_>(glds, g, S, E)));
        PH_END(pb + 7)
        PH_BEGIN(pb + 8, 10)
            pg8::Gemm g{(const bf16*)(ws + GL_VS), (const bf16*)(ws + WT_B), Mpost, DM, GVD, 0}; pg8::StaticOrder S; S.init(Mpost, DM, k.G, k.bid);
            pg8::Epi8<FM_<1>> E{FM_<1>{(const bf16*)(ws + WS_P), (bf16*)(ws + WS_H), (bf16*)(ws + WS_H)}};
            pg8::gemm_phase<pg8::Epi8<FM_<1>>, pg8::StaticOrder, GA_, GS_>(glds, g, S, E);
            if ((DUP_MASK >> 17) & 1u) { __syncthreads(); pg8::Epi8<FM_<1>> E2{FM_<1>{(const bf16*)(ws + WS_P), (bf16*)(ws + WS_H), (bf16*)(ws + RW_R)}}; pg8::gemm_phase<pg8::Epi8<FM_<1>>, pg8::StaticOrder, GA_, GS_>(glds, g, S, E2); }
        PH_END(pb + 8)
        PH_BEGIN(pb + 9, 11)
            pg8::Gemm g{(const bf16*)(ws + WS_H), (const bf16*)(ws + WT_O), Mpost, DM, DM, 0}; pg8::StaticOrder S; S.init(Mpost, DM, k.G, k.bid);
#if XBF
            pg8::Epi8<FXb_> E{FXb_{(bf16*)(ws + WS_X), (const float*)(ws + WS_MOD), l}};
            pg8::gemm_phase<pg8::Epi8<FXb_>, pg8::StaticOrder, GA_, GS_>(glds, g, S, E);
#else
            pg8::Epi4<FX_> E{FX_{(float*)(ws + WS_X), (const float*)(ws + WS_MOD), l, (float*)(ws + WS_X)}};
            pg8::gemm_phase<pg8::Epi4<FX_>, pg8::StaticOrder, GA_, GS_>(glds, g, S, E);
#endif
            if (!XBF && ((DUP_MASK >> 18) & 1u)) { __syncthreads(); pg8::Epi4<FX_> E2{FX_{(float*)(ws + WS_X), (const float*)(ws + WS_MOD), l, (float*)(ws + WS_P)}}; pg8::gemm_phase<pg8::Epi4<FX_>, pg8::StaticOrder, GA_, GS_>(glds, g, S, E2); }
        PH_END(pb + 9)
        PH_BEGIN(pb + 10, 12)
            RowArgs ra{nullptr, nullptr, INP(I_NFG), INP(I_RW), INP(I_RB), nullptr};
            ph_rows<1>(k, ra, l, Mpost);
            if ((DUP_MASK >> 16) & 1u) { __syncthreads(); ph_rows<1>(k, ra, l, Mpost, true); }
        PH_END(pb + 10)
        PH_BEGIN(pb + 11, 13)
            DUPRUN(13, ph_moe_scatter(k, l, Mpost));
        PH_END(pb + 11)
        PH_BEGIN(pb + 12, 14)
            pg8::Gemm g{(const bf16*)(ws + WS_HP), (const bf16*)(ws + WT_GU), 0, 2816, DM, (size_t)2816 * DM * 2};
            pg8::MoeOrder S; S.init((const int*)(ws + WS_TAB + TAB_TILE) + 256 * l, 11, k.G, ((k.G & 7) ? k.bid : (k.bid & 7) * (k.G >> 3) + (k.bid >> 3)));
            pg8::EpiGU<FE1_> E{FE1_{(bf16*)(ws + WS_ACT)}};
            DUPRUN(11, (pg8::gemm_phase<pg8::EpiGU<FE1_>, pg8::MoeOrder, GA_, GS_>(glds, g, S, E)));
        PH_END(pb + 12)
        PH_BEGIN(pb + 13, 15)
            pg8::Gemm g{(const bf16*)(ws + WS_ACT), (const bf16*)(ws + WT_D), 0, DM, DEXP, (size_t)DM * DEXP * 2};
            pg8::MoeOrder S; S.init((const int*)(ws + WS_TAB + TAB_TILE) + 256 * l, 8, k.G, ((k.G & 7) ? k.bid : (k.bid & 7) * (k.G >> 3) + (k.bid >> 3)));
            pg8::Epi8<FE2_> E{FE2_{(const int*)(ws + WS_TAB + TAB_ROWTOK) + (size_t)l * MOE_ROWS, (const float*)(ws + WS_TAB + TAB_ROWW) + (size_t)l * MOE_ROWS, (bf16*)(ws + WS_YF)}};
            DUPRUN(12, (pg8::gemm_phase<pg8::Epi8<FE2_>, pg8::MoeOrder, GA_, GS_>(glds, g, S, E)));
        PH_END(pb + 13)
        }
#undef L_
#if EXTRA_BARS
    if (hi - lo > 1) { for (int i = 0; i < EXTRA_BARS; ++i) xcd_barrier(bar); }
#endif
    PH_BEGIN(NPHASE - 1, 16)
        RowArgs ra{nullptr, nullptr, INP(I_FNG), nullptr, nullptr, (float*)INP(N_IN)};
        DUPRUN(14, ph_rows<2>(k, ra, 0, TL));
    PH_END(NPHASE - 1)
}

#ifndef MK_SINGLE
#define MK_SINGLE 1
#endif
extern "C" void kernel_launch(void* const* d_in, const int* in_sizes, int n_in, void* d_out, int out_size, void* d_ws, size_t ws_size, hipStream_t stream) {
    static int grid = 0;
    if (grid == 0) {
        if (n_in != N_IN || out_size != TL * DM || ws_size < WS_END) { fprintf(stderr, "kernel_launch: unexpected problem (n_in %d out %d ws %zu need %zu)\n", n_in, out_size, ws_size, (size_t)WS_END); grid = -1; return; }
        int dev = 0, cus = 0;
        if (hipGetDevice(&dev) != hipSuccess || hipDeviceGetAttribute(&cus, hipDeviceAttributeMultiprocessorCount, dev) != hipSuccess) { grid = -1; return; }
        if (hipFuncSetAttribute((const void*)fwd, hipFuncAttributeMaxDynamicSharedMemorySize, LDS_BYTES) != hipSuccess) { grid = -1; return; }
        int per_cu = 0;
        if (hipOccupancyMaxActiveBlocksPerMultiprocessor(&per_cu, (const void*)fwd, 512, LDS_BYTES) != hipSuccess || per_cu < 1) fprintf(stderr, "kernel_launch: occupancy query says %d\n", per_cu);
        (void)hipGetLastError();
        grid = cus;
    }
    if (grid < 0) return;
    unsigned char* ws = (unsigned char*)d_ws;
    (void)hipMemsetAsync(ws + WS_CTL, 0, CTL_BYTES, stream);
    Args a{};
    for (int i = 0; i < N_IN; ++i) a.in[i] = (const float*)d_in[i];
    a.out = (float*)d_out; a.ws = ws;
#if MK_SINGLE
    a.ph_lo = 0; a.ph_hi = NPHASE;
    hipLaunchKernelGGL(fwd, dim3(grid), dim3(512), LDS_BYTES, stream, a);
#else
    for (int p = 0; p < NPHASE; ++p) { a.ph_lo = p; a.ph_hi = p + 1; hipLaunchKernelGGL(fwd, dim3(grid), dim3(512), LDS_BYTES, stream, a); }
#endif
}
```

```cpp
#include <hip/hip_runtime.h>
#include <cstdio>
#include <cstdint>

#define LAS __attribute__((address_space(3)))
#define GAS __attribute__((address_space(1)))
typedef unsigned short bf16;
typedef float f32x4 __attribute__((ext_vector_type(4)));
typedef float f32x2 __attribute__((ext_vector_type(2)));
typedef unsigned u32x4 __attribute__((ext_vector_type(4)));
typedef unsigned u32x2 __attribute__((ext_vector_type(2)));
typedef short bf16x8 __attribute__((ext_vector_type(8)));

constexpr int DM = 2048, NBATCH = 8, SEQ = 2048, CTXL = 256, DEPTH = 2;
constexpr int TL = NBATCH * SEQ, TC = NBATCH * CTXL, TA = TL + TC;
constexpr int RD = 1024, RHEADS = 16, RHS = 64;
constexpr int RWKV_IN = 3520;
constexpr int GKD = 512, GVD = 1024, GDK = 128, GDV = 256, GHEADS = 4, GQKV = 2048;
constexpr int GLA_OFF = 3520, GLA_AD_OFF = GLA_OFF + GQKV, GLA_GATE_OFF = 5584, BR_OFF = 6608, IN_DIM = 10704, NP = 10752;
constexpr int NEXP = 16, DEXP = 1408;
constexpr int MOD_N = 6 * DM;
constexpr int MOE_ROWS = 41216;
constexpr int MOE_TILES = MOE_ROWS / 256;
constexpr int NCH = 36;
constexpr int KSPLIT = 32;

enum { I_X = 0, I_C, I_CTX, I_CCTX, I_WADA, I_BADA, I_NMG, I_NFG, I_WIN, I_MU, I_W0, I_W2, I_A0, I_A2, I_G2, I_KK, I_KA, I_RK, I_LNG, I_LNB,
       I_GCONV, I_GAW2, I_GAB, I_GNG, I_WBA, I_WBB, I_WOUT, I_RW, I_RB, I_EG, I_EU, I_ED, I_FNG, N_IN };

constexpr size_t MiB = 1u << 20;
constexpr size_t WS_CTL = 0;
constexpr size_t WS_TAB = 1 * MiB;
constexpr size_t WS_MOD = 2 * MiB;
constexpr size_t WS_X = 3 * MiB;
constexpr size_t WS_H = WS_X + 144 * MiB;
constexpr size_t WS_P = WS_H + 72 * MiB;
constexpr size_t WS_RW = WS_P + 378 * MiB;
constexpr size_t WS_GL = WS_RW + 380 * MiB;
constexpr size_t WS_WT = WS_GL + 218 * MiB;
constexpr size_t WS_END = WS_WT + 325 * MiB;
constexpr int CW_TMO = 0, CW_CNT = 64  , CW_BAR = 4096;
constexpr size_t CTL_BYTES = 1 * MiB;
constexpr size_t TAB_ROWTOK = 0;
constexpr size_t TAB_ROWTOK_BYTES = 2 * (size_t)MOE_ROWS * 4;
constexpr size_t TAB_ROWW = 384 * 1024;
constexpr size_t TAB_TILE = 768 * 1024;
constexpr size_t TAB_TOP = 800 * 1024;
static_assert(TAB_ROWTOK_BYTES <= TAB_ROWW && TAB_ROWW + 2 * (size_t)MOE_ROWS * 4 <= TAB_TILE, "tab map");
constexpr size_t WS_MODP = WS_P;
constexpr size_t WS_HP = WS_P;
constexpr size_t WS_ACT = WS_P + 162 * MiB;
constexpr size_t WS_TOPK = WS_P + 274 * MiB;
static_assert((size_t)MOE_ROWS * DM * 2 <= 162 * MiB && (size_t)MOE_ROWS * DEXP * 2 <= 112 * MiB && 274 * MiB + 3 * (size_t)TA * 8 <= 378 * MiB, "P overlay");
constexpr size_t RW_R = WS_RW;
constexpr size_t RW_KS = RW_R + 36 * MiB;
constexpr size_t RW_V = RW_KS + 36 * MiB;
constexpr size_t RW_KK = RW_V + 36 * MiB;
constexpr size_t RW_LO = RW_KK + 36 * MiB;
constexpr size_t RW_Y = RW_LO + 144 * MiB;
constexpr size_t RW_A1 = RW_Y + 72 * MiB;
constexpr size_t RW_A2 = RW_A1 + 9 * MiB;
constexpr size_t RW_BON = RW_A2 + 9 * MiB;
static_assert(RW_BON + 2 * MiB <= WS_GL, "rwkv map");
constexpr size_t GL_QG = WS_GL;
constexpr size_t GL_KG = GL_QG + 36 * MiB;
constexpr size_t GL_KE = GL_KG + 36 * MiB;
constexpr size_t GL_VS = GL_KE + 36 * MiB;
constexpr size_t GL_O = GL_VS + 36 * MiB;
constexpr size_t GL_DEC = GL_O + 72 * MiB;
static_assert(GL_DEC + 2 * MiB <= WS_WT, "gla map");
constexpr size_t WS_YF = WS_GL;
constexpr size_t WT_IN = WS_WT;
constexpr size_t WT_L1 = WT_IN + 42 * MiB;
constexpr size_t WT_G2 = WT_L1 + 2 * MiB;
constexpr size_t WT_A = WT_G2 + 1 * MiB;
constexpr size_t WT_B = WT_A + 4 * MiB;
constexpr size_t WT_O = WT_B + 4 * MiB;
constexpr size_t WT_GU = WT_O + 8 * MiB;
constexpr size_t WT_D = WT_GU + 176 * MiB;
static_assert(WT_D + 88 * MiB == WS_END, "weight map");

#ifndef MOE_GATHER
#define MOE_GATHER 1
#endif
#ifndef XBF
#define XBF 1
#endif
__device__ __forceinline__ float bf2f(unsigned v) { return __uint_as_float(v << 16); }
__device__ __forceinline__ float bflo(unsigned w) { return __uint_as_float(w << 16); }
__device__ __forceinline__ float bfhi(unsigned w) { return __uint_as_float(w & 0xffff0000u); }
__device__ __forceinline__ unsigned f2bf(float f) { unsigned u = __float_as_uint(f); return (u + 0x7fffu + ((u >> 16) & 1u)) >> 16; }
__device__ __forceinline__ unsigned pk2(float lo, float hi) { unsigned r; asm volatile("v_cvt_pk_bf16_f32 %0, %1, %2" : "=v"(r) : "v"(lo), "v"(hi)); return r; }
typedef __bf16 bf16x2_t __attribute__((ext_vector_type(2)));
__device__ __forceinline__ unsigned pk2c(float lo, float hi) { f32x2 v = {lo, hi}; bf16x2_t b = __builtin_convertvector(v, bf16x2_t); return __builtin_bit_cast(unsigned, b); }
__device__ __forceinline__ float sigm(float x) { return 1.0f / (1.0f + __expf(-x)); }
__device__ __forceinline__ float siluf(float x) { return x * sigm(x); }
__device__ __forceinline__ float wave_sum(float x) {
    x += __builtin_bit_cast(float, __builtin_amdgcn_update_dpp(0, __builtin_bit_cast(int, x), 0xB1, 0xF, 0xF, true));
    x += __builtin_bit_cast(float, __builtin_amdgcn_update_dpp(0, __builtin_bit_cast(int, x), 0x4E, 0xF, 0xF, true));
    x += __builtin_bit_cast(float, __builtin_amdgcn_update_dpp(0, __builtin_bit_cast(int, x), 0x141, 0xF, 0xF, true));
    x += __builtin_bit_cast(float, __builtin_amdgcn_update_dpp(0, __builtin_bit_cast(int, x), 0x140, 0xF, 0xF, true));
    const int xi = __builtin_bit_cast(int, x);
    return (__builtin_bit_cast(float, __builtin_amdgcn_readlane(xi, 0)) + __builtin_bit_cast(float, __builtin_amdgcn_readlane(xi, 16))) +
           (__builtin_bit_cast(float, __builtin_amdgcn_readlane(xi, 32)) + __builtin_bit_cast(float, __builtin_amdgcn_readlane(xi, 48)));
}
__device__ __forceinline__ void unpack8(const u32x4 w, float (&o)[8]) {
    o[0] = bflo(w.x); o[1] = bfhi(w.x); o[2] = bflo(w.y); o[3] = bfhi(w.y); o[4] = bflo(w.z); o[5] = bfhi(w.z); o[6] = bflo(w.w); o[7] = bfhi(w.w);
}
__device__ __forceinline__ u32x4 pack8(const float (&v)[8]) { u32x4 w; w.x = pk2(v[0], v[1]); w.y = pk2(v[2], v[3]); w.z = pk2(v[4], v[5]); w.w = pk2(v[6], v[7]); return w; }
namespace pg8 {
#define PG8_LAS __attribute__((address_space(3)))
typedef unsigned short bf16_t;
typedef short bf16x8 __attribute__((ext_vector_type(8)));
typedef float f32x4 __attribute__((ext_vector_type(4)));
typedef unsigned u32x4 __attribute__((ext_vector_type(4)));
constexpr int BM = 256, BK = 64, HALF = 128, HTB = HALF * BK * 2  , STAGE_BYTES = 8 * HTB, NXCD = 8, WGM = 8;

__host__ __device__ __forceinline__ int lds_byte(int r, int c) { const int st = (r >> 4) * 2 + (c >> 5), rr = r & 15, cc = c & 31, ob = rr * 64 + cc * 2; return st * 1024 + (ob ^ (((ob >> 9) & 1) << 5)); }
__host__ __device__ __forceinline__ void stage_rc(int b, int& R, int& C) { const int st = b / 1024, sb = b % 1024, swz = sb ^ (((sb >> 9) & 1) << 5); R = (st >> 1) * 16 + swz / 64; C = (st & 1) * 32 + (swz % 64) / 2; }
__host__ __device__ __forceinline__ int perm32(int rho) { const int n = rho >> 4, i = rho & 15; return 8 * (i >> 2) + 4 * n + (i & 3); }
struct Unit { int pm, pn, eb; };
struct Gemm { const bf16_t* A; const bf16_t* Bt; int M, N, K; size_t bstride; };

struct StaticOrder {
    static constexpr bool GATHER = false;
    int nM, nN, nwg, G, c;
    __host__ __device__ void init(int M, int N, int G_, int c_) { nM = M / BM; nN = N / BM; nwg = nM * nN; G = G_; c = c_; }
    __host__ __device__ bool next(int i, Unit& u) const {
        const long L = (long)i * G + c; if (L >= nwg) return false;
        int wgid = (int)L; { const int q = nwg / NXCD, r = nwg % NXCD, xcd = wgid % NXCD, off = wgid / NXCD; wgid = (xcd < r ? xcd * (q + 1) : r * (q + 1) + (xcd - r) * q) + off; }
        const int nig = WGM * nN, gid = wgid / nig, fm = gid * WGM, gsz = (nM - fm) < WGM ? (nM - fm) : WGM;
        u.pm = fm + ((wgid % nig) % gsz); u.pn = (wgid % nig) / gsz; u.eb = 0; return true;
    }
    __device__ __forceinline__ void a_ready(const Unit&) const {}
    __device__ __forceinline__ void done(const Unit&) const {}
};
template <bool GATHER_> struct MoeOrderT {
    static constexpr bool GATHER = GATHER_;
    const int* rowtok;
    const int* tab; int nT, nN, G, c;
    __device__ void init(const int* tab_, int nN_, int G_, int c_) { tab = tab_; nT = tab_[0]; nN = nN_; G = G_; c = c_; }
    __device__ bool next(int i, Unit& u) const {
        const long L = (long)i * G + c; if (L >= (long)nT * nN) return false;
        u.pm = (int)(L / nN); u.pn = (int)(L % nN); u.eb = tab[1 + u.pm]; return true;
    }
    __device__ __forceinline__ void a_ready(const Unit&) const {}
    __device__ __forceinline__ void done(const Unit&) const {}
};
using MoeOrder = MoeOrderT<false>;

template <class F> struct Epi8 {
    static constexpr bool PERM = true, AFTER_DRAIN = false;
    F f;
    __device__ __forceinline__ void operator()(const f32x4 (&acc)[2][2][4][2], const Unit& u, int wr, int wc, int fr, int fq) const {
        const int row0 = u.pm * BM + wr * 64 + fr, col0 = u.pn * BM + wc * 32 + 8 * fq;
#pragma unroll
        for (int ai = 0; ai < 2; ++ai)
#pragma unroll
            for (int m = 0; m < 4; ++m) {
#pragma unroll
                for (int bj = 0; bj < 2; ++bj) {
                    const f32x4 a = acc[ai][bj][m][0], b = acc[ai][bj][m][1];
                    float v[8] = {a[0], a[1], a[2], a[3], b[0], b[1], b[2], b[3]};
                    f(row0 + ai * HALF + m * 16, col0 + bj * HALF, v, u);
                }
            }
    }
};
template <class F> struct EpiGU {
    static constexpr bool PERM = true, AFTER_DRAIN = false;
    F f;
    __device__ __forceinline__ void operator()(const f32x4 (&acc)[2][2][4][2], const Unit& u, int wr, int wc, int fr, int fq) const {
        const int row0 = u.pm * BM + wr * 64 + fr, col0 = u.pn * HALF + wc * 32 + 8 * fq;
#pragma unroll
        for (int ai = 0; ai < 2; ++ai)
#pragma unroll
            for (int m = 0; m < 4; ++m) {
                const f32x4 g0 = acc[ai][0][m][0], g1 = acc[ai][0][m][1], u0 = acc[ai][1][m][0], u1 = acc[ai][1][m][1];
                float g[8] = {g0[0], g0[1], g0[2], g0[3], g1[0], g1[1], g1[2], g1[3]};
                float up[8] = {u0[0], u0[1], u0[2], u0[3], u1[0], u1[1], u1[2], u1[3]};
                f(row0 + ai * HALF + m * 16, col0, g, up);
            }
    }
};
template <class F> struct Epi4 {
    static constexpr bool PERM = false, AFTER_DRAIN = false;
    F f;
    __device__ __forceinline__ void operator()(const f32x4 (&acc)[2][2][4][2], const Unit& u, int wr, int wc, int fr, int fq) const {
        const int row0 = u.pm * BM + wr * 64 + fr, col0 = u.pn * BM + wc * 32 + 4 * fq;
#pragma unroll
        for (int ai = 0; ai < 2; ++ai)
#pragma unroll
            for (int m = 0; m < 4; ++m) {
#pragma unroll
                for (int bj = 0; bj < 2; ++bj)
#pragma unroll
                    for (int n = 0; n < 2; ++n) f(row0 + ai * HALF + m * 16, col0 + bj * HALF + n * 16, acc[ai][bj][m][n], u);
            }
    }
};
template <class Epi, class Sched, bool ALIGN_EPI = false, bool SP2 = false>
__device__ __forceinline__ void gemm_phase(PG8_LAS unsigned char* lds, const Gemm g, const Sched& S, const Epi& E) {
    int tid_o = threadIdx.x; asm volatile("" : "+v"(tid_o));
    const int tid = tid_o, wid = __builtin_amdgcn_readfirstlane(tid >> 6), lane = tid & 63, wr = wid >> 2, wc = wid & 3, fr = lane & 15, fq = lane >> 4;
    const int K = g.K, nt = K / BK;
    unsigned voffA[2], voffB[2];
#pragma unroll
    for (int i = 0; i < 2; ++i) { int R, C; stage_rc(tid * 16 + i * 8192, R, C); const int Rb = Epi::PERM ? ((R & ~31) + perm32(R & 31)) : R;
        voffA[i] = (unsigned)(R * K + C) * 2u; voffB[i] = (unsigned)(Rb * K + C) * 2u; }
    constexpr bool GATHER = Sched::GATHER;
    unsigned vA0[2] = {0u, 0u}, vA1[2] = {0u, 0u}, nA0[2] = {0u, 0u}, nA1[2] = {0u, 0u};
    const size_t kstep = (size_t)(BK * 2);
    const size_t hstep = (size_t)HALF * K * 2;
    const size_t tstep = 2 * hstep;
    const unsigned ldsw = (unsigned)wid * 1024u;
    const int aoff = lds_byte(wr * 64 + fr, fq * 8), boff = lds_byte(wc * 32 + fr, fq * 8);
#define PG8_SA(b, h) (((b) * 2 + (h)) * HTB)
#define PG8_SB(b, h) ((4 + (b) * 2 + (h)) * HTB)
#define PG8_STAGE(bufoff, gbase, voff) do { _Pragma("unroll") for (int _i = 0; _i < 2; ++_i) \
        __builtin_amdgcn_global_load_lds((const unsigned*)((const char*)(gbase) + (voff)[_i]), (PG8_LAS unsigned*)(lds + (bufoff) + ldsw + _i * 8192), 16, 0, 0); } while (0)
#define PG8_STAGE_A(bufoff, gptr, h, nx) do { if constexpr (GATHER) { unsigned go_[2]; _Pragma("unroll") for (int _j = 0; _j < 2; ++_j) go_[_j] = ((nx) && last_) ? ((h) ? nA1[_j] : nA0[_j]) : ((h) ? vA1[_j] : vA0[_j]); PG8_STAGE(bufoff, gptr, go_); } \
        else { PG8_STAGE(bufoff, (gptr) + (h) * hstep, voffA); } } while (0)
#define PG8_GOFS(u, o0, o1) do { const int* rt_ = S.rowtok + (size_t)(u).pm * BM; _Pragma("unroll") for (int _j = 0; _j < 2; ++_j) { int R_, C_; stage_rc(tid * 16 + _j * 8192, R_, C_); \
        const int t0_ = rt_[R_], t1_ = rt_[HALF + R_]; o0[_j] = (unsigned)((t0_ < 0 ? 0 : t0_ >> 1) * K + C_) * 2u; o1[_j] = (unsigned)((t1_ < 0 ? 0 : t1_ >> 1) * K + C_) * 2u; } } while (0)
#define PG8_LDA(dst, b, h) do { _Pragma("unroll") for (int m = 0; m < 4; ++m) _Pragma("unroll") for (int k = 0; k < 2; ++k) dst[m][k] = *(const PG8_LAS bf16x8*)(lds + PG8_SA(b, h) + aoff + m * 2048 + k * 1024); } while (0)
#define PG8_LDB(dst, b, h) do { _Pragma("unroll") for (int n = 0; n < 2; ++n) _Pragma("unroll") for (int k = 0; k < 2; ++k) dst[n][k] = *(const PG8_LAS bf16x8*)(lds + PG8_SB(b, h) + boff + n * 2048 + k * 1024); } while (0)
#define PG8_MMA(ai, bj, At, Bt) do { __builtin_amdgcn_s_setprio(1); _Pragma("unroll") for (int m = 0; m < 4; ++m) _Pragma("unroll") for (int n = 0; n < 2; ++n) _Pragma("unroll") for (int k = 0; k < 2; ++k) \
        acc[ai][bj][m][n] = __builtin_amdgcn_mfma_f32_16x16x32_bf16(Bt[n][k], At[m][k], acc[ai][bj][m][n], 0, 0, 0); __builtin_amdgcn_s_setprio(0); } while (0)
#define PG8_WAIT_V(n) asm volatile("s_waitcnt vmcnt(" #n ")" ::: "memory")
#define PG8_WAIT_L(n) asm volatile("s_waitcnt lgkmcnt(" #n ")" ::: "memory")
#define PG8_BAR __builtin_amdgcn_s_barrier()
#define PG8_SCHED __builtin_amdgcn_sched_barrier(0)
    Unit cur, nxt; int ui = 0;
    if (!S.next(0, cur)) return;
    f32x4 acc[2][2][4][2];
#pragma unroll
    for (int a = 0; a < 2; ++a)
#pragma unroll
        for (int b = 0; b < 2; ++b)
#pragma unroll
            for (int m = 0; m < 4; ++m)
#pragma unroll
                for (int n = 0; n < 2; ++n) acc[a][b][m][n] = (f32x4){0.f, 0.f, 0.f, 0.f};
    bf16x8 At[4][2], B0[2][2], B1[2][2];
    const char* cA = GATHER ? (const char*)g.A : (const char*)g.A + (size_t)cur.pm * tstep; const char* cB = (const char*)g.Bt + (size_t)cur.eb * g.bstride + (size_t)cur.pn * tstep;
    S.a_ready(cur);
    if constexpr (GATHER) PG8_GOFS(cur, vA0, vA1);
    constexpr bool last_ = false;
    if constexpr (SP2) {
        PG8_STAGE(PG8_SB(0, 0), cB, voffB); PG8_STAGE(PG8_SB(0, 1), cB + hstep, voffB); PG8_STAGE_A(PG8_SA(0, 0), cA, 0, 0); PG8_STAGE_A(PG8_SA(0, 1), cA, 1, 0);
        if (wr == 1) PG8_BAR;
        PG8_WAIT_V(2); PG8_BAR;
        PG8_STAGE(PG8_SB(1, 0), cB + kstep, voffB); PG8_STAGE_A(PG8_SA(1, 0), cA + kstep, 0, 0); PG8_STAGE(PG8_SB(1, 1), cB + hstep + kstep, voffB);
        PG8_WAIT_V(6); PG8_BAR;
    } else {
        PG8_STAGE(PG8_SB(0, 0), cB, voffB); PG8_STAGE_A(PG8_SA(0, 0), cA, 0, 0); PG8_STAGE(PG8_SB(0, 1), cB + hstep, voffB); PG8_STAGE_A(PG8_SA(0, 1), cA, 1, 0);
        if (wr == 1) PG8_BAR;
        PG8_WAIT_V(4); PG8_BAR;
        PG8_STAGE(PG8_SB(1, 0), cB + kstep, voffB); PG8_STAGE_A(PG8_SA(1, 0), cA + kstep, 0, 0); PG8_STAGE(PG8_SB(1, 1), cB + hstep + kstep, voffB);
        PG8_WAIT_V(6); PG8_BAR;
    }
    for (;;) {
        const bool has_next = S.next(ui + 1, nxt);
        const char* nA = (has_next && !GATHER) ? (const char*)g.A + (size_t)nxt.pm * tstep : cA;
        if constexpr (GATHER) { if (has_next) PG8_GOFS(nxt, nA0, nA1); else { _Pragma("unroll") for (int _j = 0; _j < 2; ++_j) { nA0[_j] = vA0[_j]; nA1[_j] = vA1[_j]; } } } const char* nB = has_next ? (const char*)g.Bt + (size_t)nxt.eb * g.bstride + (size_t)nxt.pn * tstep : cB;
#pragma nounroll
        for (int t = 0; t < nt; t += 2) {
            const bool last = (t == nt - 2); const bool last_ = last;
            const char* a1 = cA + (size_t)(t + 1) * kstep;
            const char* a2 = last ? nA : cA + (size_t)(t + 2) * kstep; const char* b2 = last ? nB : cB + (size_t)(t + 2) * kstep;
            const char* a3 = a2 + kstep; const char* b3 = b2 + kstep;
            if (last && has_next) S.a_ready(nxt);
            if constexpr (SP2) {
            PG8_LDB(B0, 0, 0); PG8_LDB(B1, 0, 1); PG8_SCHED; PG8_LDA(At, 0, 0); PG8_STAGE_A(PG8_SA(1, 1), a1, 1, 0);
            PG8_WAIT_V(8); PG8_WAIT_L(0); PG8_BAR; PG8_MMA(0, 0, At, B0); PG8_MMA(0, 1, At, B1); PG8_BAR; PG8_SCHED;
            PG8_LDA(At, 0, 1); PG8_STAGE(PG8_SB(0, 0), b2, voffB); PG8_STAGE(PG8_SB(0, 1), b2 + hstep, voffB); PG8_STAGE_A(PG8_SA(0, 0), a2, 0, 1);
            PG8_WAIT_V(8); PG8_WAIT_L(0); PG8_BAR; PG8_MMA(1, 0, At, B0); PG8_MMA(1, 1, At, B1); PG8_BAR; PG8_SCHED;
            PG8_LDB(B0, 1, 0); PG8_LDB(B1, 1, 1); PG8_SCHED; PG8_LDA(At, 1, 0); PG8_STAGE_A(PG8_SA(0, 1), a2, 1, 1);
            PG8_WAIT_V(8); PG8_WAIT_L(0); PG8_BAR; PG8_MMA(0, 0, At, B0); PG8_MMA(0, 1, At, B1); PG8_BAR; PG8_SCHED;
            PG8_LDA(At, 1, 1); PG8_STAGE(PG8_SB(1, 0), b3, voffB); PG8_STAGE(PG8_SB(1, 1), b3 + hstep, voffB); PG8_STAGE_A(PG8_SA(1, 0), a3, 0, 1);
            PG8_WAIT_V(8); PG8_WAIT_L(0); PG8_BAR; PG8_MMA(1, 0, At, B0); PG8_MMA(1, 1, At, B1); PG8_BAR; PG8_SCHED;
            } else {
            PG8_LDB(B0, 0, 0); PG8_SCHED; PG8_LDA(At, 0, 0); PG8_STAGE_A(PG8_SA(1, 1), a1, 1, 0);
            PG8_WAIT_L(8); PG8_BAR; PG8_WAIT_L(0); PG8_MMA(0, 0, At, B0); PG8_BAR; PG8_SCHED;
            PG8_LDB(B1, 0, 1); PG8_STAGE(PG8_SB(0, 0), b2, voffB);
            PG8_BAR; PG8_WAIT_L(0); PG8_MMA(0, 1, At, B1); PG8_BAR;
            PG8_LDA(At, 0, 1); PG8_STAGE_A(PG8_SA(0, 0), a2, 0, 1);
            PG8_BAR; PG8_WAIT_L(0); PG8_MMA(1, 0, At, B0); PG8_BAR; PG8_SCHED;
            PG8_STAGE(PG8_SB(0, 1), b2 + hstep, voffB);
            PG8_WAIT_V(6); PG8_BAR; PG8_MMA(1, 1, At, B1); PG8_BAR;
            PG8_LDB(B0, 1, 0); PG8_SCHED; PG8_LDA(At, 1, 0); PG8_STAGE_A(PG8_SA(0, 1), a2, 1, 1);
            PG8_WAIT_L(8); PG8_BAR; PG8_WAIT_L(0); PG8_MMA(0, 0, At, B0); PG8_BAR; PG8_SCHED;
            PG8_LDB(B1, 1, 1); PG8_STAGE(PG8_SB(1, 0), b3, voffB);
            PG8_BAR; PG8_WAIT_L(0); PG8_MMA(0, 1, At, B1); PG8_BAR;
            PG8_LDA(At, 1, 1); PG8_STAGE_A(PG8_SA(1, 0), a3, 0, 1);
            PG8_BAR; PG8_WAIT_L(0); PG8_MMA(1, 0, At, B0); PG8_BAR; PG8_SCHED;
            PG8_STAGE(PG8_SB(1, 1), b3 + hstep, voffB);
            PG8_WAIT_V(6); PG8_BAR; PG8_MMA(1, 1, At, B1); PG8_BAR;
            }
        }
        if constexpr (ALIGN_EPI) { if (wr == 0) PG8_BAR; }
        if constexpr (!Epi::AFTER_DRAIN) { E(acc, cur, wr, wc, fr, fq); S.done(cur); }
        if (!has_next) break;
#pragma unroll
        for (int a = 0; a < 2; ++a)
#pragma unroll
            for (int b = 0; b < 2; ++b)
#pragma unroll
                for (int m = 0; m < 4; ++m)
#pragma unroll
                    for (int n = 0; n < 2; ++n) acc[a][b][m][n] = (f32x4){0.f, 0.f, 0.f, 0.f};
        cur = nxt; cA = nA; cB = nB; ++ui;
        if constexpr (GATHER) { _Pragma("unroll") for (int _j = 0; _j < 2; ++_j) { vA0[_j] = nA0[_j]; vA1[_j] = nA1[_j]; } }
        if constexpr (ALIGN_EPI) { if (wr == 1) PG8_BAR; }
    }
    PG8_WAIT_V(0);
    if constexpr (!ALIGN_EPI) { if (wr == 0) PG8_BAR; }
    PG8_BAR;
    if constexpr (Epi::AFTER_DRAIN) { E.fused(acc, cur, wr, wc, fr, fq, lds, wid, lane); S.done(cur); }
#undef PG8_SA
#undef PG8_SB
#undef PG8_STAGE
#undef PG8_STAGE_A
#undef PG8_GOFS
#undef PG8_LDA
#undef PG8_LDB
#undef PG8_MMA
#undef PG8_WAIT_V
#undef PG8_WAIT_L
#undef PG8_BAR
#undef PG8_SCHED
}
}

#ifndef PG8_SP2
#define PG8_SP2 true
#endif
#ifndef PG8_ALIGN
#define PG8_ALIGN true
#endif
#define XB_TMO      128
#define XB_XCNT(j)  (256  + 64 * (j))
#define XB_XSUB(j)  (1280 + 64 * (j))
#define XB_XGEN(j)  (2304 + 64 * (j))
#define XB_TOP      3328
#define XB_TOPGEN   3392
#define XCD_BAR_WORDS 3456
#define XB_SPIN_CAP (1u << 18)

__device__ __forceinline__ unsigned xb_ld(unsigned* p)              { return __hip_atomic_load(p, __ATOMIC_RELAXED, __HIP_MEMORY_SCOPE_AGENT); }
__device__ __forceinline__ unsigned xb_add(unsigned* p, unsigned v) { return __hip_atomic_fetch_add(p, v, __ATOMIC_RELAXED, __HIP_MEMORY_SCOPE_AGENT); }
__device__ __forceinline__ unsigned xb_xcc_id() { return (unsigned)__builtin_amdgcn_s_getreg((3 << 11) | 20) & 0xFu; }
#define XB_SPIN(cond, bar) do { unsigned _sp = 0; while (cond) { __builtin_amdgcn_s_sleep(1); \
    if ((++_sp & 255u) == 0u) { if (xb_ld(&(bar)[XB_TMO])) break; if (_sp > XB_SPIN_CAP) { atomicAdd(&(bar)[XB_TMO], 1u); break; } } } } while (0)

struct XcdBarrier {
    unsigned* bar; unsigned x;
    volatile LAS unsigned* st;
};

__device__ __forceinline__ XcdBarrier xcd_barrier_post(unsigned* bar, volatile LAS unsigned* st) {
    XcdBarrier b; b.bar = bar; b.x = xb_xcc_id(); b.st = st;
    if (threadIdx.x == 0) (void)xb_add(&bar[XB_XCNT(b.x)], 1u);
    return b;
}
__device__ __forceinline__ void xcd_barrier_complete(unsigned* bar, unsigned x, unsigned& nloc, unsigned& nx) {
    const unsigned G = gridDim.x * gridDim.y * gridDim.z;
    unsigned sum, cnt, mine, sp = 0u;
    for (;;) {
        sum = 0u; cnt = 0u; mine = 0u;
#pragma unroll
        for (unsigned j = 0; j < 16; ++j) { const unsigned c = xb_ld(&bar[XB_XCNT(j)]); sum += c; cnt += (c > 0u) ? 1u : 0u; mine = (j == x) ? c : mine; }
        if (sum == G) break;
        __builtin_amdgcn_s_sleep(1);
        if ((++sp & 255u) == 0u) { if (xb_ld(&bar[XB_TMO])) break; if (sp > XB_SPIN_CAP) { atomicAdd(&bar[XB_TMO], 1u); break; } }
    }
    nloc = mine > 0u ? mine : 1u; nx = cnt > 0u ? cnt : 1u;
}

__device__ __forceinline__ void xcd_barrier(const XcdBarrier& b) {
    asm volatile("s_waitcnt vmcnt(0)" ::: "memory");
    __syncthreads();
    if (threadIdx.x == 0) {
        unsigned* bar = b.bar;
        __builtin_amdgcn_s_waitcnt(0);
        unsigned nloc = b.st[0], nx = b.st[1];
        if (nloc == 0u) { xcd_barrier_complete(bar, b.x, nloc, nx); b.st[0] = nloc; b.st[1] = nx; }
        const unsigned old = xb_add(&bar[XB_XSUB(b.x)], 1u);
        const unsigned gen = old / nloc;
        if (old + 1u == (gen + 1u) * nloc) {
            __builtin_amdgcn_fence(__ATOMIC_RELEASE, "agent");
            asm volatile("s_waitcnt vmcnt(0)" ::: "memory");
            const unsigned og = xb_add(&bar[XB_TOP], 1u);
            const unsigned tg = og / nx;
            if (og + 1u == (tg + 1u) * nx) xb_add(&bar[XB_TOPGEN], 1u);
            else XB_SPIN(xb_ld(&bar[XB_TOPGEN]) == tg, bar);
            __builtin_amdgcn_fence(__ATOMIC_ACQUIRE, "agent");
            xb_add(&bar[XB_XGEN(b.x)], 1u);
            asm volatile("s_waitcnt vmcnt(0)" ::: "memory");
        } else {
            XB_SPIN(xb_ld(&bar[XB_XGEN(b.x)]) == gen, bar);
            __builtin_amdgcn_fence(__ATOMIC_ACQUIRE, "agent");
            asm volatile("s_waitcnt vmcnt(0)" ::: "memory");
        }
    }
    __syncthreads();
}
struct KC {
    const float* const* in;
    LAS unsigned char* lds;
    unsigned char* ws;
    int tid, lane, wave, G, bid;
};
__device__ __forceinline__ const float* inp_(int i) {
    const volatile unsigned long long __attribute__((address_space(4)))* kp = (const volatile unsigned long long __attribute__((address_space(4)))*)__builtin_amdgcn_kernarg_segment_ptr();
    return (const float*)(const GAS float*)kp[i];
}
#define INP(k) (inp_(k))

__device__ __forceinline__ int mod_row(int row) { return row < TL ? (row >> 11) : 8; }

__device__ __forceinline__ void ph_adaln_partials(const KC& k, const float* c, const float* c_ctx, const float* w_ada) {
    LAS float* sc = (LAS float*)k.lds;
    for (int i = k.tid; i < 9 * DM; i += 512) { const int r = i >> 11, kk = i & 2047; const float cv = r < 8 ? c[r * DM + kk] : c_ctx[kk]; sc[i] = siluf(cv); }
    __syncthreads();
    float* modp = (float*)(k.ws + WS_MODP);
    const int cc = k.tid & 255, kh = k.tid >> 8;
    constexpr int NIT = DEPTH * 48 * 16;
    for (int it = k.bid; it < NIT; it += k.G) {
        const int l = it / 768, rem = it % 768, cb = rem >> 4, ks = rem & 15;
        const int col = cb * 256 + cc, kbeg = ks * 128 + kh * 64;
        const float* W = w_ada + ((size_t)l * DM + kbeg) * MOD_N + col;
        float acc[9];
#pragma unroll
        for (int r = 0; r < 9; ++r) acc[r] = 0.f;
#pragma unroll 32
        for (int q = 0; q < 64; ++q) {
            const float w = W[(size_t)q * MOD_N];
#pragma unroll
            for (int r = 0; r < 9; ++r) acc[r] += sc[r * DM + kbeg + q] * w;
        }
        const int s = ks * 2 + kh;
#pragma unroll
        for (int r = 0; r < 9; ++r) modp[(((size_t)s * DEPTH + l) * 9 + r) * MOD_N + col] = acc[r];
    }
    __syncthreads();
}
__device__ __forceinline__ void ph_adaln_reduce(const KC& k, const float* b_ada) {
    const float* modp = (const float*)(k.ws + WS_MODP); float* mod = (float*)(k.ws + WS_MOD);
    constexpr int TOT = DEPTH * 9 * MOD_N;
    for (int i = k.bid * 512 + k.tid; i < TOT; i += k.G * 512) {
        const int n = i % MOD_N, l = i / (9 * MOD_N);
        float s = b_ada[l * MOD_N + n];
#pragma unroll 8
        for (int q = 0; q < KSPLIT; ++q) s += modp[(size_t)q * TOT + i];
        mod[i] = s;
    }
}

struct TrItem { const float* src; bf16* dst; int srcN, Kv, Nv, k0, n0, dpitch, drow0, dk0; };
struct WSrc { const float *w_in, *w2, *a2, *g2, *wba, *wbb, *wout, *eg, *eu, *ed, *w0, *a0; };
constexpr int TI_IN = 32 * 336, TI_LO = 4 * 64, TI_G2 = 4 * 32, TI_AB = 16 * 64, TI_O = 32 * 64, TI_GU1 = 32 * 44, TI_D1 = 22 * 64;
constexpr int TI_N = TI_IN + TI_LO + TI_G2 + 2 * TI_AB + TI_O + 2 * NEXP * TI_GU1 + NEXP * TI_D1;
__device__ __forceinline__ TrItem tr_decode(const WSrc& s, unsigned char* ws, int l, int it) {
    TrItem t; int r = it;
    if (r < TI_IN) { const int kb = r / 336, nb = r % 336; t = TrItem{s.w_in + (size_t)l * DM * IN_DIM, (bf16*)(ws + WT_IN), IN_DIM, DM, IN_DIM, 64 * kb, 32 * nb, DM, 32 * nb, 0}; return t; } r -= TI_IN;
    if (r < TI_LO) {
        const int mtx = r >> 6, q = r & 63, kb = q >> 5, nb = q & 31;
        t = TrItem{(mtx < 2 ? s.w2 : s.a2) + (size_t)(l * 2 + (mtx & 1)) * 96 * RD, (bf16*)(ws + WT_L1), RD, 96, RD, 64 * kb, 32 * nb, 256, mtx * 1024 + 32 * nb, mtx < 2 ? 0 : 96}; return t; } r -= TI_LO;
    if (r < TI_G2) { const int kb = r >> 5, nb = r & 31; t = TrItem{s.g2 + (size_t)l * 256 * RD, (bf16*)(ws + WT_G2), RD, 256, RD, 64 * kb, 32 * nb, 256, 32 * nb, 0}; return t; } r -= TI_G2;
    if (r < TI_AB) { const int kb = r >> 6, nb = r & 63; t = TrItem{s.wba + (size_t)l * RD * DM, (bf16*)(ws + WT_A), DM, RD, DM, 64 * kb, 32 * nb, RD, 32 * nb, 0}; return t; } r -= TI_AB;
    if (r < TI_AB) { const int kb = r >> 6, nb = r & 63; t = TrItem{s.wbb + (size_t)l * GVD * DM, (bf16*)(ws + WT_B), DM, GVD, DM, 64 * kb, 32 * nb, GVD, 32 * nb, 0}; return t; } r -= TI_AB;
    if (r < TI_O) { const int kb = r >> 6, nb = r & 63; t = TrItem{s.wout + (size_t)l * DM * DM, (bf16*)(ws + WT_O), DM, DM, DM, 64 * kb, 32 * nb, DM, 32 * nb, 0}; return t; } r -= TI_O;
    if (r < 2 * NEXP * TI_GU1) {
        const int e = r / (2 * TI_GU1), q = r % (2 * TI_GU1), up = q / TI_GU1, q2 = q % TI_GU1, kb = q2 / 44, nb = q2 % 44;
        const int n0 = 32 * nb, drow = 256 * (n0 >> 7) + (n0 & 127) + (up ? 128 : 0);
        t = TrItem{(up ? s.eu : s.eg) + ((size_t)l * NEXP + e) * DM * DEXP, (bf16*)(ws + WT_GU) + (size_t)e * 2816 * DM, DEXP, DM, DEXP, 64 * kb, n0, DM, drow, 0}; return t; } r -= 2 * NEXP * TI_GU1;
    { const int e = r / TI_D1, q = r % TI_D1, kb = q >> 6, nb = q & 63;
      t = TrItem{s.ed + ((size_t)l * NEXP + e) * DEXP * DM, (bf16*)(ws + WT_D) + (size_t)e * DM * DEXP, DM, DEXP, DM, 64 * kb, 32 * nb, DEXP, 32 * nb, 0}; }
    return t;
}
__device__ __forceinline__ void tr_load(const TrItem& t, int lane, float (&v)[32]) {
    const int nn = lane & 31, kh = lane >> 5;
    const bool nok = t.n0 + nn < t.Nv;
    const float* p = t.src + (size_t)(t.k0 + kh) * t.srcN + t.n0 + nn;
#pragma unroll
    for (int i = 0; i < 32; ++i) { v[i] = 0.f; if (nok && t.k0 + 2 * i + kh < t.Kv) v[i] = p[(size_t)(2 * i) * t.srcN]; }
}
__device__ __forceinline__ void tr_store(const TrItem& t, int lane, const float (&v)[32], LAS float* scr) {
    const int nn = lane & 31, kh = lane >> 5;
#pragma unroll
    for (int i = 0; i < 32; ++i) scr[(2 * i + kh) * 33 + nn] = v[i];
    asm volatile("s_waitcnt lgkmcnt(0)" ::: "memory");
    const int cidx = lane & 7;
#pragma unroll
    for (int j = 0; j < 4; ++j) {
        const int n = (lane >> 3) + 8 * j; const LAS float* s = scr + (8 * cidx) * 33 + n;
        u32x4 o; o.x = pk2(s[0 * 33], s[1 * 33]); o.y = pk2(s[2 * 33], s[3 * 33]); o.z = pk2(s[4 * 33], s[5 * 33]); o.w = pk2(s[6 * 33], s[7 * 33]);
        *(u32x4*)(t.dst + (size_t)(t.drow0 + n) * t.dpitch + t.dk0 + t.k0 + 8 * cidx) = o;
    }
    asm volatile("s_waitcnt lgkmcnt(0)" ::: "memory");
}
__device__ __forceinline__ void ph_convert(const KC& k, const WSrc& s, int l) {
    LAS float* scr = (LAS float*)(k.lds + k.wave * 16384);
    const int gw = k.bid * 8 + k.wave, NGW = k.G * 8;
    unsigned char* ws = k.ws;
    { float* b1 = (float*)(ws + WS_TAB + TAB_TOP); for (int i = gw * 64 + k.lane; i < 4096; i += NGW * 64) b1[i] = i < 2048 ? s.w0[l * 2048 + i] : s.a0[l * 2048 + i - 2048]; }
    {
        u32x4* wl = (u32x4*)(ws + WT_L1);
        for (int i = gw * 64 + k.lane; i < 4096 * 32; i += NGW * 64) { const int row = i >> 5, ck = i & 31; if (row < 2048 ? ck >= 16 : (ck < 12 || ck >= 28)) wl[i] = (u32x4){0u, 0u, 0u, 0u}; }
        if (l == 0) { int* rt = (int*)(ws + WS_TAB + TAB_ROWTOK); for (int i = gw * 64 + k.lane; i < 2 * MOE_ROWS; i += NGW * 64) rt[i] = -1; }
    }
    float cur[32], nxt[32];
    int it = gw;
    TrItem tc = tr_decode(s, ws, l, it < TI_N ? it : 0);
    if (it < TI_N) tr_load(tc, k.lane, cur);
    for (; it < TI_N; it += NGW) {
        const bool more = it + NGW < TI_N;
        const TrItem tn = tr_decode(s, ws, l, more ? it + NGW : it);
        if (more) tr_load(tn, k.lane, nxt);
        tr_store(tc, k.lane, cur, scr);
        tc = tn;
#pragma unroll
        for (int i = 0; i < 32; ++i) cur[i] = nxt[i];
    }
}

constexpr int RWP = DM + 4;
struct RowArgs { const float *x_in, *ctx_in, *gvec, *router_w, *router_b; float* out; };
template <int MODE>
__device__ __forceinline__ void ph_rows(const KC& k, const RowArgs& ra, int l, int nrows, bool dry = false) {
    const int gw = k.bid * 8 + k.wave, NGW = k.G * 8, lane = k.lane;
    float* X = (float*)(k.ws + WS_X); bf16* H = (bf16*)(k.ws + WS_H);
    bf16* Xb = (bf16*)(k.ws + WS_X);
    const float* MOD = (const float*)(k.ws + WS_MOD);
    const bf16* YF = (const bf16*)(k.ws + WS_YF);
    LAS float* rwT = (LAS float*)k.lds;
    if (MODE == 1) {
        for (int i = k.tid; i < DM * NEXP; i += 512) { const int c = i >> 4, e = i & 15; rwT[e * RWP + c] = ra.router_w[i]; }
        __syncthreads();
    }
    const float* gv = ra.gvec;
    for (int row = gw; row < nrows; row += NGW) {
        const int mr = mod_row(row);
        f32x4 v[8];
        if (MODE == 0 && l == 0) {
            const f32x4* src = (const f32x4*)(row < TL ? ra.x_in + (size_t)row * DM : ra.ctx_in + (size_t)(row - TL) * DM) + lane;
#pragma unroll
            for (int j = 0; j < 8; ++j) v[j] = src[64 * j];
        } else if (XBF) {
            const u32x2* src = (const u32x2*)(Xb + (size_t)row * DM) + lane;
#pragma unroll
            for (int j = 0; j < 8; ++j) { const u32x2 a = src[64 * j]; v[j] = (f32x4){bflo(a.x), bfhi(a.x), bflo(a.y), bfhi(a.y)}; }
        } else {
            const f32x4* src = (const f32x4*)(X + (size_t)row * DM) + lane;
#pragma unroll
            for (int j = 0; j < 8; ++j) v[j] = src[64 * j];
        }
        if ((MODE == 0 && l > 0) || MODE == 2) {
            const int lp = (MODE == 2) ? DEPTH - 1 : l - 1;
            const f32x4* gate = (const f32x4*)(MOD + ((size_t)lp * 9 + mr) * MOD_N + 5 * DM) + lane;
            const u32x2* y0 = (const u32x2*)(YF + (size_t)row * DM) + lane;
            const u32x2* y1 = (const u32x2*)(YF + ((size_t)TA + row) * DM) + lane;
#pragma unroll
            for (int j = 0; j < 8; ++j) {
                const f32x4 g = gate[64 * j]; const u32x2 a = y0[64 * j], b = y1[64 * j];
                v[j].x += g.x * (bflo(a.x) + bflo(b.x)); v[j].y += g.y * (bfhi(a.x) + bfhi(b.x));
                v[j].z += g.z * (bflo(a.y) + bflo(b.y)); v[j].w += g.w * (bfhi(a.y) + bfhi(b.y));
            }
        }
        if (MODE == 0 && XBF) {
            u32x2* dst = (u32x2*)(Xb + (size_t)row * DM) + lane;
#pragma unroll
            for (int j = 0; j < 8; ++j) { u32x2 o; o.x = pk2(v[j].x, v[j].y); o.y = pk2(v[j].z, v[j].w); dst[64 * j] = o; }
        } else if (MODE == 0) {
            f32x4* dst = (f32x4*)(X + (size_t)row * DM) + lane;
#pragma unroll
            for (int j = 0; j < 8; ++j) dst[64 * j] = v[j];
        }
        float ss = 0.f;
#pragma unroll
        for (int j = 0; j < 8; ++j) ss += (v[j].x * v[j].x + v[j].y * v[j].y) + (v[j].z * v[j].z + v[j].w * v[j].w);
        const float rinv = 1.0f / sqrtf(wave_sum(ss) * (1.0f / DM) + 1e-6f);
        if (MODE == 2) {
            f32x4* dst = (f32x4*)(ra.out + (size_t)row * DM) + lane; const f32x4* g4 = (const f32x4*)gv + lane;
#pragma unroll
            for (int j = 0; j < 8; ++j) { const f32x4 g = g4[64 * j]; dst[64 * j] = v[j] * rinv * g; }
        } else {
            const float* mrow = MOD + ((size_t)l * 9 + mr) * MOD_N + (MODE == 0 ? 0 : 3 * DM);
            const f32x4* sh4 = (const f32x4*)mrow + lane; const f32x4* sc4 = (const f32x4*)(mrow + DM) + lane; const f32x4* g4 = (const f32x4*)(gv + (size_t)l * DM) + lane;
            u32x2* dst = (u32x2*)(H + (size_t)row * DM) + lane;
#pragma unroll
            for (int j = 0; j < 8; ++j) {
                const f32x4 g = g4[64 * j], sh = sh4[64 * j], sc = sc4[64 * j];
                v[j] = v[j] * rinv * g * (1.0f + sc) + sh;
                u32x2 o; o.x = pk2(v[j].x, v[j].y); o.y = pk2(v[j].z, v[j].w); dst[64 * j] = o;
            }
        }
        if (MODE == 1) {
            float lg[NEXP];
#pragma unroll
            for (int e = 0; e < NEXP; ++e) {
                float s = 0.f;
#pragma unroll
                for (int j = 0; j < 8; ++j) { const f32x4 w = *(const LAS f32x4*)(rwT + e * RWP + 4 * lane + 256 * j); s += (v[j].x * w.x + v[j].y * w.y) + (v[j].z * w.z + v[j].w * w.w); }
                lg[e] = wave_sum(s);
            }
            float sc[NEXP], sel[NEXP];
#pragma unroll
            for (int e = 0; e < NEXP; ++e) { sc[e] = 1.0f / (1.0f + expf(-lg[e])); sel[e] = sc[e] + ra.router_b[e]; }
            float gs[4], w1g[4], w2g[4]; int i1g[4], i2g[4];
#pragma unroll
            for (int g = 0; g < 4; ++g) {
                int i1 = 0; float m1 = sel[4 * g];
#pragma unroll
                for (int q = 1; q < 4; ++q) if (sel[4 * g + q] > m1) { m1 = sel[4 * g + q]; i1 = q; }
                int i2 = -1; float m2 = -3.0e38f;
#pragma unroll
                for (int q = 0; q < 4; ++q) if (q != i1 && sel[4 * g + q] > m2) { m2 = sel[4 * g + q]; i2 = q; }
                gs[g] = m1 + m2; i1g[g] = 4 * g + i1; i2g[g] = 4 * g + i2;
                float a1 = sc[4 * g], a2 = sc[4 * g];
#pragma unroll
                for (int q = 0; q < 4; ++q) { a1 = (q == i1) ? sc[4 * g + q] : a1; a2 = (q == i2) ? sc[4 * g + q] : a2; }
                w1g[g] = a1; w2g[g] = a2;
            }
            int best = 0; float bs = gs[0];
#pragma unroll
            for (int g = 1; g < 4; ++g) if (gs[g] > bs) { bs = gs[g]; best = g; }
            int e1 = i1g[0], e2 = i2g[0]; float w1 = w1g[0], w2 = w2g[0];
#pragma unroll
            for (int g = 1; g < 4; ++g) { e1 = (best == g) ? i1g[g] : e1; e2 = (best == g) ? i2g[g] : e2; w1 = (best == g) ? w1g[g] : w1; w2 = (best == g) ? w2g[g] : w2; }
            const float inv = 1.0f / (w1 + w2);
            if (lane == 0 && !dry) {
                unsigned* cnt = (unsigned*)(k.ws + WS_CTL) + CW_CNT + 64 * l;
                const int p1 = (int)atomicAdd(cnt + e1, 1u), p2 = (int)atomicAdd(cnt + e2, 1u);
                int* te = (int*)(k.ws + WS_TOPK); float* tw = (float*)(k.ws + WS_TOPK + (size_t)TA * 8); int* tp = (int*)(k.ws + WS_TOPK + 2 * (size_t)TA * 8);
                te[2 * row] = e1; te[2 * row + 1] = e2; tw[2 * row] = w1 * inv; tw[2 * row + 1] = w2 * inv; tp[2 * row] = p1; tp[2 * row + 1] = p2;
            }
        }
    }
    if (MODE == 1) __syncthreads();
}

__device__ __forceinline__ void ph_moe_scatter(const KC& k, int l, int nrows) {
    LAS int* offs = (LAS int*)k.lds;
    const unsigned* cnt = (const unsigned*)(k.ws + WS_CTL) + CW_CNT + 64 * l;
    int* tile = (int*)(k.ws + WS_TAB + TAB_TILE) + 256 * l;
    if (k.tid == 0) {
        int off = 0, nt = 0;
        for (int e = 0; e < NEXP; ++e) {
            offs[e] = off; const int c = (int)__hip_atomic_load(cnt + e, __ATOMIC_RELAXED, __HIP_MEMORY_SCOPE_AGENT); const int t = (c + 255) >> 8;
            if (k.bid == 0) for (int q = 0; q < t; ++q) tile[1 + nt + q] = e;
            nt += t; off += t * 256;
        }
        if (k.bid == 0) tile[0] = nt;
    }
    __syncthreads();
    const int gw = k.bid * 8 + k.wave, NGW = k.G * 8, lane = k.lane;
    const bf16* H = (const bf16*)(k.ws + WS_H); bf16* HP = (bf16*)(k.ws + WS_HP);
    const int* te = (const int*)(k.ws + WS_TOPK); const float* tw = (const float*)(k.ws + WS_TOPK + (size_t)TA * 8); const int* tp = (const int*)(k.ws + WS_TOPK + 2 * (size_t)TA * 8);
    int* rowtok = (int*)(k.ws + WS_TAB + TAB_ROWTOK) + (size_t)l * MOE_ROWS; float* roww = (float*)(k.ws + WS_TAB + TAB_ROWW) + (size_t)l * MOE_ROWS;
    for (int row = gw; row < nrows; row += NGW) {
#if MOE_GATHER
        (void)H; (void)HP;
        if (lane < 2) { const int s = lane; const int e = te[2 * row + s], dest = offs[e] + tp[2 * row + s]; rowtok[dest] = 2 * row + s; roww[dest] = tw[2 * row + s]; }
    }
#else
        const u32x4* src = (const u32x4*)(H + (size_t)row * DM) + lane;
        u32x4 d[4];
#pragma unroll
        for (int j = 0; j < 4; ++j) d[j] = src[64 * j];
#pragma unroll
        for (int s = 0; s < 2; ++s) {
            const int e = te[2 * row + s], dest = offs[e] + tp[2 * row + s];
            u32x4* dp = (u32x4*)(HP + (size_t)dest * DM) + lane;
#pragma unroll
            for (int j = 0; j < 4; ++j) dp[64 * j] = d[j];
            if (lane == 0) { rowtok[dest] = 2 * row + s; roww[dest] = tw[2 * row + s]; }
        }
    }
#endif
    __syncthreads();
}
__device__ __forceinline__ void ld16(const bf16* p, bool ok, float (&o)[16]) {
    if (ok) { const u32x4 a = *(const u32x4*)p, b = *(const u32x4*)(p + 8); float x[8], y[8]; unpack8(a, x); unpack8(b, y);
#pragma unroll
        for (int i = 0; i < 8; ++i) { o[i] = x[i]; o[8 + i] = y[i]; } }
    else {
#pragma unroll
        for (int i = 0; i < 16; ++i) o[i] = 0.f; }
}
__device__ __forceinline__ void st16(bf16* p, const float (&v)[16]) {
    float a[8], b[8];
#pragma unroll
    for (int i = 0; i < 8; ++i) { a[i] = v[i]; b[i] = v[8 + i]; }
    *(u32x4*)p = pack8(a); *(u32x4*)(p + 8) = pack8(b);
}
__device__ __forceinline__ void shift8(const bf16* p0, bool hp, bool hn, int c, const float* mu0, const float* mu1, float (&s)[8]) {
    float x[8], xm[8], xp[8];
    unpack8(*(const u32x4*)(p0 + c), x);
    if (hp) unpack8(*(const u32x4*)(p0 - NP + c), xm); else {
#pragma unroll
        for (int i = 0; i < 8; ++i) xm[i] = 0.f; }
    if (hn) unpack8(*(const u32x4*)(p0 + NP + c), xp); else {
#pragma unroll
        for (int i = 0; i < 8; ++i) xp[i] = 0.f; }
    const f32x4 m0a = *(const f32x4*)(mu0 + c), m0b = *(const f32x4*)(mu0 + c + 4), m1a = *(const f32x4*)(mu1 + c), m1b = *(const f32x4*)(mu1 + c + 4);
    const float m0[8] = {m0a.x, m0a.y, m0a.z, m0a.w, m0b.x, m0b.y, m0b.z, m0b.w}, m1[8] = {m1a.x, m1a.y, m1a.z, m1a.w, m1b.x, m1b.y, m1b.z, m1b.w};
#pragma unroll
    for (int i = 0; i < 8; ++i) s[i] = x[i] + m0[i] * (xm[i] - x[i]) + m1[i] * (xp[i] - x[i]);
}
__device__ __forceinline__ void ph_rwkv_prep(const KC& k, int l, int nrows, const float* mu, const float* k_k, const float* r_k) {
    const int gw = k.bid * 8 + k.wave, NGW = k.G * 8, lane = k.lane;
    const bf16* P = (const bf16*)(k.ws + WS_P);
    bf16* R = (bf16*)(k.ws + RW_R); bf16* KS = (bf16*)(k.ws + RW_KS); bf16* V = (bf16*)(k.ws + RW_V); bf16* KK = (bf16*)(k.ws + RW_KK);
    bf16* A1 = (bf16*)(k.ws + RW_A1); bf16* A2 = (bf16*)(k.ws + RW_A2); float* BON = (float*)(k.ws + RW_BON);
    const float* mu0 = mu + (size_t)(l * 2 + 0) * RWKV_IN; const float* mu1 = mu + (size_t)(l * 2 + 1) * RWKV_IN;
    const int rpw = (nrows + NGW - 1) / NGW;
    for (int row = gw * rpw; row < nrows && row < (gw + 1) * rpw; ++row) {
        int t, len; if (row < TL) { t = row & (SEQ - 1); len = SEQ; } else { t = (row - TL) & (CTXL - 1); len = CTXL; }
        const bool hp = t > 0, hn = t < len - 1;
        const bf16* p0 = P + (size_t)row * NP;
#pragma unroll
        for (int half = 0; half < 2; ++half) {
            const int c = half * 512 + 8 * lane;
            float r[8], kx[8], vv[8], kk[8];
            shift8(p0, hp, hn, c, mu0, mu1, r);
            shift8(p0, hp, hn, RD + c, mu0, mu1, kx);
            shift8(p0, hp, hn, 2 * RD + c, mu0, mu1, vv);
            const f32x4 kka = *(const f32x4*)(k_k + l * RD + c), kkb = *(const f32x4*)(k_k + l * RD + c + 4), rka = *(const f32x4*)(r_k + l * RD + c), rkb = *(const f32x4*)(r_k + l * RD + c + 4);
            const float kkw[8] = {kka.x, kka.y, kka.z, kka.w, kkb.x, kkb.y, kkb.z, kkb.w}, rkw[8] = {rka.x, rka.y, rka.z, rka.w, rkb.x, rkb.y, rkb.z, rkb.w};
            float ss = 0.f, bon = 0.f;
#pragma unroll
            for (int i = 0; i < 8; ++i) { kk[i] = kx[i] * kkw[i]; ss += kk[i] * kk[i]; bon += r[i] * kx[i] * rkw[i]; }
            ss += __shfl_xor(ss, 1); ss += __shfl_xor(ss, 2); ss += __shfl_xor(ss, 4);
            bon += __shfl_xor(bon, 1); bon += __shfl_xor(bon, 2); bon += __shfl_xor(bon, 4);
            const float inv = 1.0f / fmaxf(sqrtf(ss), 1e-12f);
#pragma unroll
            for (int i = 0; i < 8; ++i) kk[i] *= inv;
            *(u32x4*)(R + (size_t)row * RD + c) = pack8(r); *(u32x4*)(KS + (size_t)row * RD + c) = pack8(kx);
            *(u32x4*)(V + (size_t)row * RD + c) = pack8(vv); *(u32x4*)(KK + (size_t)row * RD + c) = pack8(kk);
            if ((lane & 7) == 0) BON[(size_t)row * RHEADS + half * 8 + (lane >> 3)] = bon;
        }
        if (lane < 56) {
            float s8[8];
            shift8(p0, hp, hn, 3 * RD + 8 * lane, mu0, mu1, s8);
            if (lane < 12) {
#pragma unroll
                for (int i = 0; i < 8; ++i) { const float e2 = __expf(2.0f * fminf(fmaxf(s8[i], -15.f), 15.f)); s8[i] = 1.0f - 2.0f / (e2 + 1.0f); }
                *(u32x4*)(A1 + (size_t)row * 256 + 8 * lane) = pack8(s8);
            } else if (lane < 24) { *(u32x4*)(A1 + (size_t)row * 256 + 8 * lane) = pack8(s8); }
            else {
#pragma unroll
                for (int i = 0; i < 8; ++i) s8[i] = sigm(s8[i]);
                *(u32x4*)(A2 + (size_t)row * 256 + 8 * (lane - 24)) = pack8(s8);
            }
        } else { *(u32x4*)(A1 + (size_t)row * 256 + 192 + 8 * (lane - 56)) = (u32x4){0u, 0u, 0u, 0u}; }
    }
}

__device__ __forceinline__ float logsig(float x) { return fminf(x, 0.f) - __logf(1.0f + __expf(-fabsf(x))); }
__device__ __forceinline__ int gla_row(bool lat, int b, int s) { return lat ? b * SEQ + (s & 31) * 64 + (s >> 5) : TL + b * CTXL + s; }
constexpr int GQ_PITCH = 264;
constexpr int GPL_AD = 0, GPL_GS = 4096, GPL_QK = GPL_GS + 65536, GPL_END = GPL_QK + 66 * GQ_PITCH * 2;
static_assert(GPL_END <= 131072, "gla prep lds");
__device__ __forceinline__ void ph_gla_prep(const KC& k, int l, const float* conv, const float* aw2, const float* ab) {
    const bf16* P = (const bf16*)(k.ws + WS_P);
    bf16* QG = (bf16*)(k.ws + GL_QG); bf16* KG = (bf16*)(k.ws + GL_KG); bf16* KE = (bf16*)(k.ws + GL_KE); bf16* VS = (bf16*)(k.ws + GL_VS); float* DEC = (float*)(k.ws + GL_DEC);
    const float* cw = conv + (size_t)l * 3 * GQKV;
    const int tid = k.tid, lane = k.lane;
    {
        const int gw = k.bid * 8 + k.wave, NGW = k.G * 8, c = 16 * lane;
        const int rpw = (TA + NGW - 1) / NGW;
        for (int qi = gw * rpw; qi < TA && qi < (gw + 1) * rpw; ++qi) {
            const bool lat = qi < TL; int b, s, len;
            if (lat) { b = qi >> 11; s = qi & 2047; len = SEQ; } else { b = (qi - TL) >> 8; s = (qi - TL) & 255; len = CTXL; }
            const int row = gla_row(lat, b, s);
            const bool hp = s > 0, hn = s + 1 < len;
            const bf16* p0 = P + (size_t)row * NP + GLA_OFF + 2 * GKD + c;
            const bf16* pm = P + (size_t)gla_row(lat, b, hp ? s - 1 : s) * NP + GLA_OFF + 2 * GKD + c;
            const bf16* pp = P + (size_t)gla_row(lat, b, hn ? s + 1 : s) * NP + GLA_OFF + 2 * GKD + c;
            float o[16];
#pragma unroll
            for (int hf = 0; hf < 2; ++hf) {
                float x[8], xm[8], xp[8];
                unpack8(*(const u32x4*)(p0 + 8 * hf), x); unpack8(*(const u32x4*)(pm + 8 * hf), xm); unpack8(*(const u32x4*)(pp + 8 * hf), xp);
                const float* w = cw + 2 * GKD + c + 8 * hf;
#pragma unroll
                for (int q = 0; q < 2; ++q) {
                    const f32x4 w0 = *(const f32x4*)(w + 4 * q), w1 = *(const f32x4*)(w + GQKV + 4 * q), w2 = *(const f32x4*)(w + 2 * GQKV + 4 * q);
#pragma unroll
                    for (int i = 0; i < 4; ++i) o[8 * hf + 4 * q + i] = siluf(w0[i] * (hp ? xm[4 * q + i] : 0.f) + w1[i] * x[4 * q + i] + w2[i] * (hn ? xp[4 * q + i] : 0.f));
                }
            }
            st16(VS + (size_t)row * GVD + c, o);
        }
    }
    LAS float* ADs = (LAS float*)(k.lds + GPL_AD);
    LAS float* Gs = (LAS float*)(k.lds + GPL_GS);
    LAS bf16* QKs = (LAS bf16*)(k.lds + GPL_QK);
    for (int item = k.bid; item < 288 * 4; item += k.G) {
        const int sc = item >> 2, h = item & 3;
        const bool lat = sc < 256; const int b = lat ? (sc >> 5) : ((sc - 256) >> 2), cn = lat ? (sc & 31) : ((sc - 256) & 3), len = lat ? SEQ : CTXL;
        const int gch = lat ? 4 + cn : cn, s0 = 64 * cn;
        for (int i = tid; i < 1024; i += 512) { const int tau = i >> 4, j = i & 15; ADs[i] = bf2f(P[(size_t)gla_row(lat, b, s0 + tau) * NP + GLA_AD_OFF + j]); }
        for (int i = tid; i < 66 * 32; i += 512) {
            const int rr = i >> 5, ck = i & 31, s = s0 - 1 + rr;
            u32x4 v = (u32x4){0u, 0u, 0u, 0u};
            if (s >= 0 && s < len) v = *(const u32x4*)(P + (size_t)gla_row(lat, b, s) * NP + GLA_OFF + (ck >> 4) * GKD + h * GDK + (ck & 15) * 8);
            *(LAS u32x4*)(QKs + rr * GQ_PITCH + ck * 8) = v;
        }
        __syncthreads();
        {
            const int c = tid & 127, tg = tid >> 7, chl = h * GDK + c;
            float awf[16], awb[16];
#pragma unroll
            for (int j = 0; j < 16; ++j) { awf[j] = aw2[((size_t)(l * 2 + 0) * 16 + j) * GKD + chl]; awb[j] = aw2[((size_t)(l * 2 + 1) * 16 + j) * GKD + chl]; }
            const float abf = ab[(l * 2 + 0) * GKD + chl], abb = ab[(l * 2 + 1) * GKD + chl];
            for (int i = 0; i < 16; ++i) {
                const int tau = 16 * tg + i; float xf = abf, xb = abb;
#pragma unroll
                for (int j = 0; j < 16; ++j) { const float a = ADs[tau * 16 + j]; xf += a * awf[j]; xb += a * awb[j]; }
                Gs[tau * 128 + c] = logsig(xf) * (1.0f / 16.0f); Gs[(64 + tau) * 128 + c] = logsig(xb) * (1.0f / 16.0f);
            }
        }
        __syncthreads();
        if (tid < 128) { float run = 0.f; for (int tau = 0; tau < 64; ++tau) { run += Gs[tau * 128 + tid]; Gs[tau * 128 + tid] = run; } }
        else if (tid < 256) { const int c = tid - 128; float run = 0.f; for (int tau = 63; tau >= 0; --tau) { run += Gs[(64 + tau) * 128 + c]; Gs[(64 + tau) * 128 + c] = run; } }
        __syncthreads();
        {
            const int c8 = tid & 15, tg = tid >> 4, chl = h * GDK + 8 * c8;
            float wq[3][8], wk[3][8], elf[8], elb[8];
#pragma unroll
            for (int tp = 0; tp < 3; ++tp) {
                const f32x4 a0 = *(const f32x4*)(cw + tp * GQKV + chl), a1 = *(const f32x4*)(cw + tp * GQKV + chl + 4), b0 = *(const f32x4*)(cw + tp * GQKV + GKD + chl), b1 = *(const f32x4*)(cw + tp * GQKV + GKD + chl + 4);
#pragma unroll
                for (int i = 0; i < 4; ++i) { wq[tp][i] = a0[i]; wq[tp][4 + i] = a1[i]; wk[tp][i] = b0[i]; wk[tp][4 + i] = b1[i]; }
            }
            {
                const f32x4 a0 = *(const LAS f32x4*)(Gs + 63 * 128 + 8 * c8), a1 = *(const LAS f32x4*)(Gs + 63 * 128 + 8 * c8 + 4), b0 = *(const LAS f32x4*)(Gs + 64 * 128 + 8 * c8), b1 = *(const LAS f32x4*)(Gs + 64 * 128 + 8 * c8 + 4);
#pragma unroll
                for (int i = 0; i < 4; ++i) { elf[i] = __expf(a0[i]); elf[4 + i] = __expf(a1[i]); elb[i] = __expf(b0[i]); elb[4 + i] = __expf(b1[i]); }
            }
            if (tg < 8) {
                float* d0 = DEC + ((size_t)(0 * 8 + b) * NCH + gch) * GKD + chl; float* d1 = DEC + ((size_t)(1 * 8 + b) * NCH + gch) * GKD + chl;
                if (tg == 0) { *(f32x4*)d0 = (f32x4){elf[0], elf[1], elf[2], elf[3]}; *(f32x4*)(d0 + 4) = (f32x4){elf[4], elf[5], elf[6], elf[7]}; }
                if (tg == 1) { *(f32x4*)d1 = (f32x4){elb[0], elb[1], elb[2], elb[3]}; *(f32x4*)(d1 + 4) = (f32x4){elb[4], elb[5], elb[6], elb[7]}; }
            }
#pragma unroll
            for (int pass = 0; pass < 2; ++pass) {
                const int tau = tg + 32 * pass;
                float qm[8], q0[8], qp[8], km[8], k0[8], kp[8];
                unpack8(*(const LAS u32x4*)(QKs + (tau + 0) * GQ_PITCH + 8 * c8), qm); unpack8(*(const LAS u32x4*)(QKs + (tau + 1) * GQ_PITCH + 8 * c8), q0); unpack8(*(const LAS u32x4*)(QKs + (tau + 2) * GQ_PITCH + 8 * c8), qp);
                unpack8(*(const LAS u32x4*)(QKs + (tau + 0) * GQ_PITCH + 128 + 8 * c8), km); unpack8(*(const LAS u32x4*)(QKs + (tau + 1) * GQ_PITCH + 128 + 8 * c8), k0); unpack8(*(const LAS u32x4*)(QKs + (tau + 2) * GQ_PITCH + 128 + 8 * c8), kp);
                const f32x4 f0 = *(const LAS f32x4*)(Gs + tau * 128 + 8 * c8), f1 = *(const LAS f32x4*)(Gs + tau * 128 + 8 * c8 + 4), g0 = *(const LAS f32x4*)(Gs + (64 + tau) * 128 + 8 * c8), g1 = *(const LAS f32x4*)(Gs + (64 + tau) * 128 + 8 * c8 + 4);
                const float cf[8] = {f0.x, f0.y, f0.z, f0.w, f1.x, f1.y, f1.z, f1.w}, cb[8] = {g0.x, g0.y, g0.z, g0.w, g1.x, g1.y, g1.z, g1.w};
                float oqf[8], okf[8], oef[8], oqb[8], okb[8], oeb[8];
#pragma unroll
                for (int i = 0; i < 8; ++i) {
                    const float qv = siluf(wq[0][i] * qm[i] + wq[1][i] * q0[i] + wq[2][i] * qp[i]) * 0.08838834764831845f;
                    const float kv = siluf(wk[0][i] * km[i] + wk[1][i] * k0[i] + wk[2][i] * kp[i]);
                    const float ef = __expf(cf[i]), eb = __expf(cb[i]), rf = 1.0f / ef, rb = 1.0f / eb;
                    oqf[i] = qv * ef; okf[i] = kv * rf; oef[i] = kv * rf * elf[i];
                    oqb[i] = qv * eb; okb[i] = kv * rb; oeb[i] = kv * rb * elb[i];
                }
                const size_t o = (size_t)gla_row(lat, b, s0 + tau) * GKD + chl;
                *(u32x4*)(QG + o) = pack8(oqf); *(u32x4*)(KG + o) = pack8(okf); *(u32x4*)(KE + o) = pack8(oef);
                *(u32x4*)(QG + (size_t)TA * GKD + o) = pack8(oqb); *(u32x4*)(KG + (size_t)TA * GKD + o) = pack8(okb); *(u32x4*)(KE + (size_t)TA * GKD + o) = pack8(oeb);
            }
        }
        __syncthreads();
    }
}

__device__ __forceinline__ float dpp_sum16(float x) {
    x += __builtin_bit_cast(float, __builtin_amdgcn_update_dpp(0, __builtin_bit_cast(int, x), 0xB1, 0xF, 0xF, true));
    x += __builtin_bit_cast(float, __builtin_amdgcn_update_dpp(0, __builtin_bit_cast(int, x), 0x4E, 0xF, 0xF, true));
    x += __builtin_bit_cast(float, __builtin_amdgcn_update_dpp(0, __builtin_bit_cast(int, x), 0x141, 0xF, 0xF, true));
    x += __builtin_bit_cast(float, __builtin_amdgcn_update_dpp(0, __builtin_bit_cast(int, x), 0x140, 0xF, 0xF, true));
    return x;
}
constexpr int RS_TOK = 16;
constexpr int RS_TF = 6 * 64;
constexpr int RS_BUF = RS_TOK * RS_TF;
struct RwkvStage { unsigned r, we, a, ks, v, kk; };
__device__ __forceinline__ int rwkv_row(int b, int dir, int p) {
    if (p < CTXL) { const int t = dir ? CTXL - 1 - p : p; return TL + b * CTXL + t; }
    const int q = p - CTXL, t = dir ? SEQ - 1 - q : q; return b * SEQ + t;
}
__device__ __forceinline__ void ph_rwkv_scan(const KC& k, int l, int job, const float* k_a, size_t yoff = RW_Y) {
    const int b = job >> 5, h = (job >> 1) & 15, dir = job & 1;
    const int tid = k.tid;
    const bf16* R = (const bf16*)(k.ws + RW_R); const bf16* KS = (const bf16*)(k.ws + RW_KS); const bf16* V = (const bf16*)(k.ws + RW_V); const bf16* KK = (const bf16*)(k.ws + RW_KK);
    const bf16* LO = (const bf16*)(k.ws + RW_LO); bf16* Y = (bf16*)(k.ws + yoff) + (size_t)dir * TA * RD;
    LAS float* buf = (LAS float*)k.lds;
    LAS f32x2* ypart = (LAS f32x2*)(buf + 2 * RS_BUF);
    const int st = tid >> 5, cp = tid & 31, ch = h * RHS + 2 * cp;
    const float ka0 = k_a[l * RD + ch], ka1 = k_a[l * RD + ch + 1];
    const int kq = tid & 15, rp = tid >> 4, v0 = rp * 2;
    f32x2 S00 = {0.f, 0.f}, S01 = {0.f, 0.f}, S10 = {0.f, 0.f}, S11 = {0.f, 0.f};
    RwkvStage sg;
#define RW_LOAD(chunk) do { const int row_ = rwkv_row(b, dir, (chunk) * RS_TOK + st); \
        sg.r = *(const unsigned*)(R + (size_t)row_ * RD + ch); sg.ks = *(const unsigned*)(KS + (size_t)row_ * RD + ch); \
        sg.v = *(const unsigned*)(V + (size_t)row_ * RD + ch); sg.kk = *(const unsigned*)(KK + (size_t)row_ * RD + ch); \
        sg.we = *(const unsigned*)(LO + (size_t)row_ * 4096 + dir * RD + ch); sg.a = *(const unsigned*)(LO + (size_t)row_ * 4096 + 2048 + dir * RD + ch); } while (0)
#define RW_WRITE(bi) do { LAS float* tb = buf + (bi) * RS_BUF + st * RS_TF + 2 * cp; \
        const float a0 = bflo(sg.a), a1 = bfhi(sg.a), kk0 = bflo(sg.kk), kk1 = bfhi(sg.kk), ks0 = bflo(sg.ks), ks1 = bfhi(sg.ks); \
        *(LAS f32x2*)(tb + 0) = (f32x2){kk0, kk1}; \
        *(LAS f32x2*)(tb + 64) = (f32x2){__expf(-bflo(sg.we)), __expf(-bfhi(sg.we))}; \
        *(LAS f32x2*)(tb + 128) = (f32x2){-kk0 * a0, -kk1 * a1}; \
        *(LAS f32x2*)(tb + 192) = (f32x2){ks0 * (1.0f + (a0 - 1.0f) * ka0), ks1 * (1.0f + (a1 - 1.0f) * ka1)}; \
        *(LAS f32x2*)(tb + 256) = (f32x2){bflo(sg.r), bfhi(sg.r)}; \
        *(LAS f32x2*)(tb + 320) = (f32x2){bflo(sg.v), bfhi(sg.v)}; } while (0)
    constexpr int NCHUNK = (CTXL + SEQ) / RS_TOK;
    RW_LOAD(0); RW_WRITE(0);
    __syncthreads();
    for (int c = 0; c < NCHUNK; ++c) {
        if (c + 1 < NCHUNK) RW_LOAD(c + 1);
        const LAS float* cb = buf + (c & 1) * RS_BUF; LAS f32x2* yb = ypart + (c & 1) * RS_TOK * 256 + rp * 8 + (((kq >> 1) ^ (rp >> 2)) & 7);
        {
            const LAS float* tk = cb + kq * 4; const LAS float* tv = cb + 320 + v0;
#define RW_LD(T, kk4, w4, n4, d4, r4, vv) f32x4 kk4 = *(const LAS f32x4*)(tk + (T) * RS_TF), w4 = *(const LAS f32x4*)(tk + (T) * RS_TF + 64), n4 = *(const LAS f32x4*)(tk + (T) * RS_TF + 128), \
                d4 = *(const LAS f32x4*)(tk + (T) * RS_TF + 192), r4 = *(const LAS f32x4*)(tk + (T) * RS_TF + 256); f32x2 vv = *(const LAS f32x2*)(tv + (T) * RS_TF)
#define RW_STEP(T, kk4, w4, n4, d4, r4, vv) do { \
                const f32x2 kka = {kk4.x, kk4.y}, kkb = {kk4.z, kk4.w}, wa = {w4.x, w4.y}, wb = {w4.z, w4.w}, na = {n4.x, n4.y}, nb = {n4.z, n4.w}, da = {d4.x, d4.y}, db = {d4.z, d4.w}, ra = {r4.x, r4.y}, rb = {r4.z, r4.w}; \
                f32x2 p0 = S00 * kka + S01 * kkb, p1 = S10 * kka + S11 * kkb; \
                const f32x2 u00 = S00 * wa + da * vv.x, u01 = S01 * wb + db * vv.x, u10 = S10 * wa + da * vv.y, u11 = S11 * wb + db * vv.y;     \
                const float sa0 = dpp_sum16(p0.x + p0.y), sa1 = dpp_sum16(p1.x + p1.y); \
                S00 = na * sa0 + u00; S01 = nb * sa0 + u01; S10 = na * sa1 + u10; S11 = nb * sa1 + u11; \
                p0 = S00 * ra + S01 * rb; p1 = S10 * ra + S11 * rb; \
                float y0 = p0.x + p0.y, y1 = p1.x + p1.y; \
                y0 += __builtin_bit_cast(float, __builtin_amdgcn_update_dpp(0, __builtin_bit_cast(int, y0), 0xB1, 0xF, 0xF, true)); \
                y1 += __builtin_bit_cast(float, __builtin_amdgcn_update_dpp(0, __builtin_bit_cast(int, y1), 0xB1, 0xF, 0xF, true)); \
                if ((kq & 1) == 0) yb[(T) * 256] = (f32x2){y0, y1}; } while (0)
            RW_LD(0, kkA, wA, nA, dA, rA, vA);
#pragma unroll
            for (int tau = 0; tau < RS_TOK; tau += 2) {
                RW_LD(tau + 1, kkB, wB, nB, dB, rB, vB);
                RW_STEP(tau, kkA, wA, nA, dA, rA, vA);
                if (tau + 2 < RS_TOK) { RW_LD(tau + 2, kkC, wC, nC, dC, rC, vC); kkA = kkC; wA = wC; nA = nC; dA = dC; rA = rC; vA = vC; }
                RW_STEP(tau + 1, kkB, wB, nB, dB, rB, vB);
            }
#undef RW_LD
#undef RW_STEP
        }
        if (c + 1 < NCHUNK) RW_WRITE((c + 1) & 1);
        __syncthreads();
        {
            const int row = rwkv_row(b, dir, c * RS_TOK + st);
            const LAS f32x2* yq = ypart + (c & 1) * RS_TOK * 256 + st * 256 + cp * 8;
            f32x2 acc = yq[(0 ^ (cp >> 2)) & 7];
#pragma unroll
            for (int j = 1; j < 8; ++j) acc += yq[(j ^ (cp >> 2)) & 7];
            *(unsigned*)(Y + (size_t)row * RD + ch) = pk2(acc.x, acc.y);
        }
    }
    __syncthreads();
}

constexpr int GP1 = 136, GP2 = 72;
constexpr int GL_QGS = 0, GL_KGS = GL_QGS + 64 * GP1 * 2, GL_STS = GL_KGS + 64 * GP1 * 2, GL_KET = GL_STS + 64 * GP1 * 2, GL_VT = GL_KET + 128 * GP2 * 2, GL_ATT = GL_VT + 64 * GP2 * 2,
              GL_DECS = GL_ATT + 64 * GP2 * 2, GL_LDS_END = GL_DECS + 512;
static_assert(GL_LDS_END <= 131072, "gla lds");
__device__ __forceinline__ bf16x8 ldfrag(const LAS bf16* base, int row, int pitch, int kofs) { return *(const LAS bf16x8*)(base + row * pitch + kofs); }
__device__ __forceinline__ int gla_prow(int b, int dir, int cp, int tau) {
    const bool lat = cp >= 4; const int q = lat ? cp - 4 : cp, ncn = lat ? 32 : 4, cn = dir ? ncn - 1 - q : q;
    return gla_row(lat, b, dir ? 64 * cn + 63 - tau : 64 * cn + tau);
}
__device__ __forceinline__ int gla_gch(int dir, int cp) { const bool lat = cp >= 4; const int q = lat ? cp - 4 : cp, ncn = lat ? 32 : 4, cn = dir ? ncn - 1 - q : q; return lat ? 4 + cn : cn; }
__device__ __forceinline__ bf16x8 ldfrag_sw(const LAS bf16* base, int row, int g) { return *(const LAS bf16x8*)(base + row * GP2 + ((g ^ ((row >> 3) & 7)) << 3)); }
__device__ __forceinline__ void ph_gla_scan(const KC& k, int job) {
    const int b = job >> 5, h = (job >> 3) & 3, dir = (job >> 2) & 1, dvq = job & 3;
    const int tid = k.tid, w = k.wave, lane = k.lane, q4 = lane >> 4, l15 = lane & 15;
    const bf16* QG = (const bf16*)(k.ws + GL_QG) + (size_t)dir * TA * GKD; const bf16* KG = (const bf16*)(k.ws + GL_KG) + (size_t)dir * TA * GKD;
    const bf16* KE = (const bf16*)(k.ws + GL_KE) + (size_t)dir * TA * GKD; const bf16* VS = (const bf16*)(k.ws + GL_VS);
    const float* DEC = (const float*)(k.ws + GL_DEC); bf16* O = (bf16*)(k.ws + GL_O) + (size_t)dir * TA * GVD;
    LAS bf16* QGs = (LAS bf16*)(k.lds + GL_QGS); LAS bf16* KGs = (LAS bf16*)(k.lds + GL_KGS); LAS bf16* STs = (LAS bf16*)(k.lds + GL_STS);
    LAS bf16* KEt = (LAS bf16*)(k.lds + GL_KET); LAS bf16* Vt = (LAS bf16*)(k.lds + GL_VT); LAS bf16* ATT = (LAS bf16*)(k.lds + GL_ATT); LAS float* decs = (LAS float*)(k.lds + GL_DECS);
    f32x4 accS[4];
#pragma unroll
    for (int t = 0; t < 4; ++t) accS[t] = (f32x4){0.f, 0.f, 0.f, 0.f};
    const int tw = w & 3, wh = w >> 2;
    u32x4 pq[2], pk[2], pe[2], pv; float pd = 0.f;
#define GLA_PREFETCH(CP) do { _Pragma("unroll") for (int i = 0; i < 2; ++i) { const int idx = tid + 512 * i, tau = idx >> 4, ck = idx & 15; \
            const size_t go = (size_t)gla_prow(b, dir, (CP), tau) * GKD + h * GDK + ck * 8; pq[i] = *(const u32x4*)(QG + go); pk[i] = *(const u32x4*)(KG + go); pe[i] = *(const u32x4*)(KE + go); } \
        pv = *(const u32x4*)(VS + (size_t)gla_prow(b, dir, (CP), tid >> 3) * GVD + h * GDV + dvq * 64 + (tid & 7) * 8); \
        if (tid < 128) pd = DEC[((size_t)(dir * 8 + b) * NCH + gla_gch(dir, (CP))) * GKD + h * GDK + tid]; } while (0)
    GLA_PREFETCH(0);
    for (int cp = 0; cp < NCH; ++cp) {
#define GROW(tau) gla_prow(b, dir, cp, (tau))
#pragma unroll
        for (int i = 0; i < 2; ++i) {
            const int idx = tid + 512 * i, tau = idx >> 4, ck = idx & 15;
            *(LAS u32x4*)(QGs + tau * GP1 + ck * 8) = pq[i];
            *(LAS u32x4*)(KGs + tau * GP1 + ck * 8) = pk[i];
            const unsigned kw[4] = {pe[i].x, pe[i].y, pe[i].z, pe[i].w};
#pragma unroll
            for (int e = 0; e < 4; ++e) { const int ts = tau ^ ((ck & 7) << 3); KEt[(ck * 8 + 2 * e) * GP2 + ts] = (bf16)(kw[e] & 0xffffu); KEt[(ck * 8 + 2 * e + 1) * GP2 + ts] = (bf16)(kw[e] >> 16); }
        }
        {
            const int tau = tid >> 3, ck = tid & 7;
            const unsigned vw[4] = {pv.x, pv.y, pv.z, pv.w};
#pragma unroll
            for (int e = 0; e < 4; ++e) { const int ts = tau ^ (ck << 3); Vt[(ck * 8 + 2 * e) * GP2 + ts] = (bf16)(vw[e] & 0xffffu); Vt[(ck * 8 + 2 * e + 1) * GP2 + ts] = (bf16)(vw[e] >> 16); }
        }
        if (tid < 128) decs[tid] = pd;
#pragma unroll
        for (int t = 0; t < 4; ++t) {
            const int dkt = wh * 4 + t;
#pragma unroll
            for (int r = 0; r < 4; ++r) STs[(16 * tw + 4 * q4 + r) * GP1 + 16 * dkt + l15] = (bf16)f2bf(accS[t][r]);
        }
        __syncthreads();
        if (cp + 1 < NCH) GLA_PREFETCH(cp + 1);
#pragma unroll
        for (int jj = 0; jj < 2; ++jj) {
            const int it = tw, jt = wh * 2 + jj;
            f32x4 acc = (f32x4){0.f, 0.f, 0.f, 0.f};
#pragma unroll
            for (int ks = 0; ks < 4; ++ks) acc = __builtin_amdgcn_mfma_f32_16x16x32_bf16(ldfrag(QGs, 16 * it + l15, GP1, 32 * ks + 8 * q4), ldfrag(KGs, 16 * jt + l15, GP1, 32 * ks + 8 * q4), acc, 0, 0, 0);
#pragma unroll
            for (int r = 0; r < 4; ++r) { const int i = 16 * it + 4 * q4 + r, j = 16 * jt + l15; ATT[i * GP2 + j] = (bf16)f2bf(j <= i ? acc[r] : 0.f); }
        }
        __syncthreads();
#pragma unroll
        for (int dd = 0; dd < 2; ++dd) {
            const int it = tw, dvt = wh * 2 + dd;
            f32x4 acc = (f32x4){0.f, 0.f, 0.f, 0.f};
#pragma unroll
            for (int ks = 0; ks < 4; ++ks) acc = __builtin_amdgcn_mfma_f32_16x16x32_bf16(ldfrag(QGs, 16 * it + l15, GP1, 32 * ks + 8 * q4), ldfrag(STs, 16 * dvt + l15, GP1, 32 * ks + 8 * q4), acc, 0, 0, 0);
#pragma unroll
            for (int ks = 0; ks < 2; ++ks) acc = __builtin_amdgcn_mfma_f32_16x16x32_bf16(ldfrag(ATT, 16 * it + l15, GP2, 32 * ks + 8 * q4), ldfrag_sw(Vt, 16 * dvt + l15, 4 * ks + q4), acc, 0, 0, 0);
#pragma unroll
            for (int r = 0; r < 4; ++r) { const int i = 16 * it + 4 * q4 + r; O[(size_t)GROW(i) * GVD + h * GDV + dvq * 64 + 16 * dvt + l15] = (bf16)f2bf(acc[r]); }
        }
#pragma unroll
        for (int t = 0; t < 4; ++t) {
            const int dkt = wh * 4 + t; const float d = decs[16 * dkt + l15];
            accS[t] = accS[t] * d;
#pragma unroll
            for (int ks = 0; ks < 2; ++ks) accS[t] = __builtin_amdgcn_mfma_f32_16x16x32_bf16(ldfrag_sw(Vt, 16 * tw + l15, 4 * ks + q4), ldfrag_sw(KEt, 16 * dkt + l15, 4 * ks + q4), accS[t], 0, 0, 0);
        }
        __syncthreads();
#undef GROW
    }
#undef GLA_PREFETCH
}

#ifndef RWKV_MODE
#define RWKV_MODE 2
#endif
#ifndef HB_FULL
#define HB_FULL 0
#endif
#ifndef GLA4_LEVEL
#define GLA4_LEVEL 0
#endif
#ifndef GLA4_NOSTORE
#define GLA4_NOSTORE 0
#endif
#ifndef SWAP_HALVES
#define SWAP_HALVES 0
#endif
#ifndef SPLIT_SCAN
#define SPLIT_SCAN 0
#endif
constexpr int RS4_TOK = 8, RS4_BUF = RS4_TOK * RS_TF;
constexpr int SC_GL = 0;
constexpr int SC_RW = 96 * 1024;
constexpr int SC_END = SC_RW + 2 * RS4_BUF * 4 + 2 * RS4_TOK * 64 * 4;
static_assert(SC_GL + GL_LDS_END <= SC_RW, "scan lds halves");
constexpr int SC_CTR = 127 * 1024;
static_assert(SC_END <= SC_CTR && SC_CTR + 128 <= 131072, "scan lds");
__device__ __forceinline__ void half_bar(LAS unsigned* ctr, unsigned& gen, int lane) {
#if HB_FULL
    (void)ctr; (void)lane; gen += 4u; __syncthreads(); return;
#endif
    gen += 4u;
    __builtin_amdgcn_fence(__ATOMIC_RELEASE, "workgroup");
    if (lane == 0) __hip_atomic_fetch_add(ctr, 1u, __ATOMIC_RELAXED, __HIP_MEMORY_SCOPE_WORKGROUP);
    unsigned spins = 0;
    while (__hip_atomic_load(ctr, __ATOMIC_RELAXED, __HIP_MEMORY_SCOPE_WORKGROUP) < gen) { __builtin_amdgcn_s_sleep(1); if (++spins > (1u << 26)) break; }
    __builtin_amdgcn_fence(__ATOMIC_ACQUIRE, "workgroup");
}
#ifndef RW4_SHFL
#define RW4_SHFL 0
#endif
__device__ __forceinline__ float shfl_sum16(float x) { x += __shfl_xor(x, 1); x += __shfl_xor(x, 2); x += __shfl_xor(x, 4); x += __shfl_xor(x, 8); return x; }
#if RW4_SHFL
#define RW4_SUM16(x) shfl_sum16(x)
#else
#define RW4_SUM16(x) dpp_sum16(x)
#endif
__device__ __forceinline__ void rwkv_scan_4w(const KC& k, int l, int job, const float* k_a, LAS unsigned* ctr) {
    const int b = job >> 5, h = (job >> 1) & 15, dir = job & 1;
    const int tid = k.tid, lane = k.lane;
    const bf16* R = (const bf16*)(k.ws + RW_R); const bf16* KS = (const bf16*)(k.ws + RW_KS); const bf16* V = (const bf16*)(k.ws + RW_V); const bf16* KK = (const bf16*)(k.ws + RW_KK);
    const bf16* LO = (const bf16*)(k.ws + RW_LO); bf16* Y = (bf16*)(k.ws + RW_Y) + (size_t)dir * TA * RD;
    LAS float* buf = (LAS float*)(k.lds + SC_RW);
    LAS float* ybuf = buf + 2 * RS4_BUF;
    const int st = tid >> 5, cp = tid & 31, ch = h * RHS + 2 * cp;
    const float ka0 = k_a[l * RD + ch], ka1 = k_a[l * RD + ch + 1];
    const int kq = tid & 15, v0 = (tid >> 4) * 4;
    f32x2 S[4][2];
#pragma unroll
    for (int i = 0; i < 4; ++i) { S[i][0] = (f32x2){0.f, 0.f}; S[i][1] = (f32x2){0.f, 0.f}; }
    RwkvStage sg[1];
    unsigned gen = 0;
#define RW4_LOAD(chunk) do { _Pragma("unroll") for (int q_ = 0; q_ < 1; ++q_) { const int row_ = rwkv_row(b, dir, (chunk) * RS4_TOK + st); \
        sg[q_].r = *(const unsigned*)(R + (size_t)row_ * RD + ch); sg[q_].ks = *(const unsigned*)(KS + (size_t)row_ * RD + ch); \
        sg[q_].v = *(const unsigned*)(V + (size_t)row_ * RD + ch); sg[q_].kk = *(const unsigned*)(KK + (size_t)row_ * RD + ch); \
        sg[q_].we = *(const unsigned*)(LO + (size_t)row_ * 4096 + dir * RD + ch); sg[q_].a = *(const unsigned*)(LO + (size_t)row_ * 4096 + 2048 + dir * RD + ch); } } while (0)
#define RW4_WRITE(bi) do { _Pragma("unroll") for (int q_ = 0; q_ < 1; ++q_) { LAS float* tb = buf + (bi) * RS4_BUF + st * RS_TF + 2 * cp; \
        const float a0 = bflo(sg[q_].a), a1 = bfhi(sg[q_].a), kk0 = bflo(sg[q_].kk), kk1 = bfhi(sg[q_].kk), ks0 = bflo(sg[q_].ks), ks1 = bfhi(sg[q_].ks); \
        *(LAS f32x2*)(tb + 0) = (f32x2){kk0, kk1}; \
        *(LAS f32x2*)(tb + 64) = (f32x2){__expf(-bflo(sg[q_].we)), __expf(-bfhi(sg[q_].we))}; \
        *(LAS f32x2*)(tb + 128) = (f32x2){-kk0 * a0, -kk1 * a1}; \
        *(LAS f32x2*)(tb + 192) = (f32x2){ks0 * (1.0f + (a0 - 1.0f) * ka0), ks1 * (1.0f + (a1 - 1.0f) * ka1)}; \
        *(LAS f32x2*)(tb + 256) = (f32x2){bflo(sg[q_].r), bfhi(sg[q_].r)}; \
        *(LAS f32x2*)(tb + 320) = (f32x2){bflo(sg[q_].v), bfhi(sg[q_].v)}; } } while (0)
    constexpr int NCHUNK = (CTXL + SEQ) / RS4_TOK;
    RW4_LOAD(0); RW4_WRITE(0);
    half_bar(ctr, gen, lane);
    for (int c = 0; c < NCHUNK; ++c) {
        if (c + 1 < NCHUNK) RW4_LOAD(c + 1);
        const LAS float* cb = buf + (c & 1) * RS4_BUF; LAS float* yb = ybuf + (c & 1) * RS4_TOK * 64;
        {
            const LAS float* tk = cb + kq * 4; const LAS float* tv = cb + 320 + v0;
#define RW4_LD(T, kk4, w4, n4, d4, r4, vv) f32x4 kk4 = *(const LAS f32x4*)(tk + (T) * RS_TF), w4 = *(const LAS f32x4*)(tk + (T) * RS_TF + 64), n4 = *(const LAS f32x4*)(tk + (T) * RS_TF + 128), \
                d4 = *(const LAS f32x4*)(tk + (T) * RS_TF + 192), r4 = *(const LAS f32x4*)(tk + (T) * RS_TF + 256), vv = *(const LAS f32x4*)(tv + (T) * RS_TF)
#define RW4_STEP(T, kk4, w4, n4, d4, r4, vv) do { \
                const f32x2 kka = {kk4.x, kk4.y}, kkb = {kk4.z, kk4.w}, wa = {w4.x, w4.y}, wb = {w4.z, w4.w}, na = {n4.x, n4.y}, nb = {n4.z, n4.w}, da = {d4.x, d4.y}, db = {d4.z, d4.w}, ra = {r4.x, r4.y}, rb = {r4.z, r4.w}; \
                float sa[4], yy[4]; f32x2 u0[4], u1[4]; \
                _Pragma("unroll") for (int i = 0; i < 4; ++i) { const f32x2 p = S[i][0] * kka + S[i][1] * kkb; sa[i] = p.x + p.y; u0[i] = S[i][0] * wa + da * vv[i]; u1[i] = S[i][1] * wb + db * vv[i]; } \
                _Pragma("unroll") for (int i = 0; i < 4; ++i) sa[i] = RW4_SUM16(sa[i]); \
                _Pragma("unroll") for (int i = 0; i < 4; ++i) { S[i][0] = na * sa[i] + u0[i]; S[i][1] = nb * sa[i] + u1[i]; const f32x2 q = S[i][0] * ra + S[i][1] * rb; yy[i] = q.x + q.y; } \
                _Pragma("unroll") for (int i = 0; i < 4; ++i) yy[i] = RW4_SUM16(yy[i]); \
                if (kq == 0) *(LAS f32x4*)(yb + (T) * 64 + v0) = (f32x4){yy[0], yy[1], yy[2], yy[3]}; } while (0)
            RW4_LD(0, kkA, wA, nA, dA, rA, vA);
#pragma unroll
            for (int tau = 0; tau < RS4_TOK; tau += 2) {
                RW4_LD(tau + 1, kkB, wB, nB, dB, rB, vB);
                RW4_STEP(tau, kkA, wA, nA, dA, rA, vA);
                if (tau + 2 < RS4_TOK) { RW4_LD(tau + 2, kkC, wC, nC, dC, rC, vC); kkA = kkC; wA = wC; nA = nC; dA = dC; rA = rC; vA = vC; }
                RW4_STEP(tau + 1, kkB, wB, nB, dB, rB, vB);
            }
#undef RW4_LD
#undef RW4_STEP
        }
        if (c + 1 < NCHUNK) RW4_WRITE((c + 1) & 1);
        half_bar(ctr, gen, lane);
        {
            const int row = rwkv_row(b, dir, c * RS4_TOK + st);
            const f32x2 yy = *(const LAS f32x2*)(yb + st * 64 + 2 * cp);
            *(unsigned*)(Y + (size_t)row * RD + ch) = pk2(yy.x, yy.y);
        }
    }
#undef RW4_LOAD
#undef RW4_WRITE
}
__device__ __forceinline__ void gla_scan_4w(const KC& k, int job, LAS unsigned* ctr) {
    const int b = job >> 5, h = (job >> 3) & 3, dir = (job >> 2) & 1, dvq = job & 3;
    const int tid = k.tid - 256, w = k.wave - 4, lane = k.lane, q4 = lane >> 4, l15 = lane & 15;
    const bf16* QG = (const bf16*)(k.ws + GL_QG) + (size_t)dir * TA * GKD; const bf16* KG = (const bf16*)(k.ws + GL_KG) + (size_t)dir * TA * GKD;
    const bf16* KE = (const bf16*)(k.ws + GL_KE) + (size_t)dir * TA * GKD; const bf16* VS = (const bf16*)(k.ws + GL_VS);
    const float* DEC = (const float*)(k.ws + GL_DEC); bf16* O = (bf16*)(k.ws + GL_O) + (size_t)dir * TA * GVD;
    LAS unsigned char* gl = k.lds + SC_GL;
    LAS bf16* QGs = (LAS bf16*)(gl + GL_QGS); LAS bf16* KGs = (LAS bf16*)(gl + GL_KGS); LAS bf16* STs = (LAS bf16*)(gl + GL_STS);
    LAS bf16* KEt = (LAS bf16*)(gl + GL_KET); LAS bf16* Vt = (LAS bf16*)(gl + GL_VT); LAS bf16* ATT = (LAS bf16*)(gl + GL_ATT); LAS float* decs = (LAS float*)(gl + GL_DECS);
    f32x4 accS[8];
#pragma unroll
    for (int t = 0; t < 8; ++t) accS[t] = (f32x4){0.f, 0.f, 0.f, 0.f};
    unsigned gen = 0;
#if GLA4_LEVEL == 2
    { float x = (float)lane; for (int i = 0; i < 200000; ++i) { x = x * 1.0001f + 0.5f; asm volatile("" : "+v"(x)); } asm volatile("" :: "v"(x)); (void)ctr; (void)gen; }
    return;
#endif
#if GLA4_LEVEL == 1
    for (int cp = 0; cp < NCH; ++cp) { float x = (float)lane; for (int i = 0; i < 2000; ++i) x = x * 1.0001f + 0.5f; asm volatile("" :: "v"(x)); half_bar(ctr, gen, lane); half_bar(ctr, gen, lane); half_bar(ctr, gen, lane); }
    return;
#endif
    for (int cp = 0; cp < NCH; ++cp) {
        const bool lat = cp >= 4; const int q = lat ? cp - 4 : cp, ncn = lat ? 32 : 4, cn = dir ? ncn - 1 - q : q, gch = lat ? 4 + cn : cn;
#define GROW(tau) gla_row(lat, b, dir ? 64 * cn + 63 - (tau) : 64 * cn + (tau))
#pragma unroll
        for (int i = 0; i < 4; ++i) {
            const int idx = tid + 256 * i, tau = idx >> 4, ck = idx & 15; const size_t go = (size_t)GROW(tau) * GKD + h * GDK + ck * 8;
            *(LAS u32x4*)(QGs + tau * GP1 + ck * 8) = *(const u32x4*)(QG + go);
            *(LAS u32x4*)(KGs + tau * GP1 + ck * 8) = *(const u32x4*)(KG + go);
            const u32x4 ke = *(const u32x4*)(KE + go);
            const unsigned kw[4] = {ke.x, ke.y, ke.z, ke.w};
#pragma unroll
            for (int e = 0; e < 4; ++e) { KEt[(ck * 8 + 2 * e) * GP2 + tau] = (bf16)(kw[e] & 0xffffu); KEt[(ck * 8 + 2 * e + 1) * GP2 + tau] = (bf16)(kw[e] >> 16); }
        }
#pragma unroll
        for (int i = 0; i < 2; ++i) {
            const int idx = tid + 256 * i, tau = idx >> 3, ck = idx & 7;
            const u32x4 vv = *(const u32x4*)(VS + (size_t)GROW(tau) * GVD + h * GDV + dvq * 64 + ck * 8);
            const unsigned vw[4] = {vv.x, vv.y, vv.z, vv.w};
#pragma unroll
            for (int e = 0; e < 4; ++e) { Vt[(ck * 8 + 2 * e) * GP2 + tau] = (bf16)(vw[e] & 0xffffu); Vt[(ck * 8 + 2 * e + 1) * GP2 + tau] = (bf16)(vw[e] >> 16); }
        }
        if (tid < 128) decs[tid] = DEC[((size_t)(dir * 8 + b) * NCH + gch) * GKD + h * GDK + tid];
#pragma unroll
        for (int t = 0; t < 8; ++t) {
#pragma unroll
            for (int r = 0; r < 4; ++r) STs[(16 * w + 4 * q4 + r) * GP1 + 16 * t + l15] = (bf16)f2bf(accS[t][r]);
        }
        half_bar(ctr, gen, lane);
#pragma unroll
        for (int jt = 0; jt < 4; ++jt) {
            f32x4 acc = (f32x4){0.f, 0.f, 0.f, 0.f};
#pragma unroll
            for (int ks = 0; ks < 4; ++ks) acc = __builtin_amdgcn_mfma_f32_16x16x32_bf16(ldfrag(QGs, 16 * w + l15, GP1, 32 * ks + 8 * q4), ldfrag(KGs, 16 * jt + l15, GP1, 32 * ks + 8 * q4), acc, 0, 0, 0);
#pragma unroll
            for (int r = 0; r < 4; ++r) { const int i = 16 * w + 4 * q4 + r, j = 16 * jt + l15; ATT[i * GP2 + j] = (bf16)f2bf(j <= i ? acc[r] : 0.f); }
        }
        half_bar(ctr, gen, lane);
#pragma unroll
        for (int dvt = 0; dvt < 4; ++dvt) {
            f32x4 acc = (f32x4){0.f, 0.f, 0.f, 0.f};
#pragma unroll
            for (int ks = 0; ks < 4; ++ks) acc = __builtin_amdgcn_mfma_f32_16x16x32_bf16(ldfrag(QGs, 16 * w + l15, GP1, 32 * ks + 8 * q4), ldfrag(STs, 16 * dvt + l15, GP1, 32 * ks + 8 * q4), acc, 0, 0, 0);
#pragma unroll
            for (int ks = 0; ks < 2; ++ks) acc = __builtin_amdgcn_mfma_f32_16x16x32_bf16(ldfrag(ATT, 16 * w + l15, GP2, 32 * ks + 8 * q4), ldfrag(Vt, 16 * dvt + l15, GP2, 32 * ks + 8 * q4), acc, 0, 0, 0);
#pragma unroll
#if GLA4_NOSTORE
            asm volatile("" :: "v"(acc[0]), "v"(acc[1]), "v"(acc[2]), "v"(acc[3]));
#else
            for (int r = 0; r < 4; ++r) { const int i = 16 * w + 4 * q4 + r; O[(size_t)GROW(i) * GVD + h * GDV + dvq * 64 + 16 * dvt + l15] = (bf16)f2bf(acc[r]); }
#endif
        }
#pragma unroll
        for (int t = 0; t < 8; ++t) {
            const float d = decs[16 * t + l15];
            accS[t] = accS[t] * d;
#pragma unroll
            for (int ks = 0; ks < 2; ++ks) accS[t] = __builtin_amdgcn_mfma_f32_16x16x32_bf16(ldfrag(Vt, 16 * w + l15, GP2, 32 * ks + 8 * q4), ldfrag(KEt, 16 * t + l15, GP2, 32 * ks + 8 * q4), accS[t], 0, 0, 0);
        }
        half_bar(ctr, gen, lane);
#undef GROW
    }
#if HB_FULL
    for (int i = 0; i < (1 + (CTXL + SEQ) / RS4_TOK) - 3 * NCH; ++i) __syncthreads();
#endif
}
__device__ __forceinline__ void ph_scan_split(const KC& k, int l, const float* k_a) {
    LAS unsigned* ctr = (LAS unsigned*)(k.lds + SC_CTR);
    for (int job = k.bid; job < 256; job += k.G) {
        if (k.tid == 0) { ctr[0] = 0u; ctr[16] = 0u; }
        __syncthreads();
#if SPLIT_SCAN == 1 || SPLIT_SCAN == 4 || SPLIT_SCAN == 5 || SPLIT_SCAN == 6
#if SWAP_HALVES
        { KC k2 = k; if (k.wave >= 4) { k2.tid = k.tid - 256; k2.wave = k.wave - 4; rwkv_scan_4w(k2, l, job, k_a, ctr); } else { k2.tid = k.tid + 256; k2.wave = k.wave + 4; gla_scan_4w(k2, job, ctr + 16); } }
#else
        if (k.wave < 4) rwkv_scan_4w(k, l, job, k_a, ctr); else gla_scan_4w(k, job, ctr + 16);
#endif
        __syncthreads();
#if SPLIT_SCAN == 6
        ph_rwkv_scan(k, l, job, k_a, WS_H);
#elif SPLIT_SCAN == 4
        ph_rwkv_scan(k, l, job, k_a);
#elif SPLIT_SCAN == 5
        ph_gla_scan(k, job);
#endif
#elif SPLIT_SCAN == 2
        if (k.wave < 4) rwkv_scan_4w(k, l, job, k_a, ctr);
        __syncthreads();
        ph_gla_scan(k, job);
#else
        if (k.wave >= 4) gla_scan_4w(k, job, ctr + 16);
        __syncthreads();
        ph_rwkv_scan(k, l, job, k_a);
#endif
    }
}

__device__ __forceinline__ void ph_post(const KC& k, int l, int nrows, const float* ln_g, const float* ln_b, const float* gng) {
    const int gw = k.bid * 8 + k.wave, NGW = k.G * 8, lane = k.lane, c = 16 * lane;
    const bf16* P = (const bf16*)(k.ws + WS_P);
    const bf16* Y = (const bf16*)(k.ws + RW_Y); const bf16* V = (const bf16*)(k.ws + RW_V); const float* BON = (const float*)(k.ws + RW_BON); bf16* YNB = (bf16*)(k.ws + RW_R);
    const bf16* O = (const bf16*)(k.ws + GL_O); bf16* YB = (bf16*)(k.ws + GL_VS);
    for (int row = gw; row < nrows; row += NGW) {
        {
            float yf[16], yb[16], vv[16], y[16];
            ld16(Y + (size_t)row * RD + c, true, yf); ld16(Y + ((size_t)TA + row) * RD + c, true, yb); ld16(V + (size_t)row * RD + c, true, vv);
            float s = 0.f;
#pragma unroll
            for (int i = 0; i < 16; ++i) { y[i] = yf[i] + yb[i]; s += y[i]; }
            s += __shfl_xor(s, 1); s += __shfl_xor(s, 2);
            const float mean = s * (1.0f / 64.0f); float q = 0.f;
#pragma unroll
            for (int i = 0; i < 16; ++i) { y[i] -= mean; q += y[i] * y[i]; }
            q += __shfl_xor(q, 1); q += __shfl_xor(q, 2);
            const float rstd = 1.0f / sqrtf(q * (1.0f / 64.0f) + 64e-5f), bon = BON[(size_t)row * RHEADS + (lane >> 2)];
#pragma unroll
            for (int i = 0; i < 16; ++i) y[i] = y[i] * rstd * ln_g[l * RD + c + i] + ln_b[l * RD + c + i] + bon * vv[i];
            st16(YNB + (size_t)row * RD + c, y);
        }
        {
            float of[16], ob[16], gt[16], o[16];
            ld16(O + (size_t)row * GVD + c, true, of); ld16(O + ((size_t)TA + row) * GVD + c, true, ob); ld16(P + (size_t)row * NP + GLA_GATE_OFF + c, true, gt);
            float s = 0.f;
#pragma unroll
            for (int i = 0; i < 16; ++i) { o[i] = of[i] + ob[i]; s += o[i] * o[i]; }
            s += __shfl_xor(s, 1); s += __shfl_xor(s, 2); s += __shfl_xor(s, 4); s += __shfl_xor(s, 8);
            const float rinv = 1.0f / sqrtf(s * (1.0f / 256.0f) + 1e-6f);
#pragma unroll
            for (int i = 0; i < 16; ++i) o[i] = o[i] * rinv * gng[l * GDV + ((c + i) & 255)] * siluf(gt[i]);
            st16(YB + (size_t)row * GVD + c, o);
        }
    }
}

#ifndef CHUNK_LOADS_FIRST
#define CHUNK_LOADS_FIRST 1
#endif
#ifndef CHUNK_PF
#define CHUNK_PF 1
#endif
#ifndef SUBST_PK
#define SUBST_PK 0
#endif
#ifndef CONS_UNROLL
#define CONS_UNROLL 1
#endif
#ifndef CHUNK_NOPS
#define CHUNK_NOPS 0
#endif
#ifndef PROD_PK
#define PROD_PK 0
#endif
#ifndef LDS_POISON
#define LDS_POISON 0
#endif
#ifndef CHUNK_DBG
#define CHUNK_DBG 0
#endif
constexpr int RC_XT = 0;
constexpr int RC_YH = RC_XT + 32 * 72 * 2;
constexpr int RC_BET = RC_YH + 64 * 24 * 2;
constexpr int RC_AM = RC_YH + 2 * 64 * 24 * 2;
constexpr int RC_P2 = RC_AM + 2048;
constexpr int RC_AKR = RC_P2 + 512;
constexpr int RC_ABR = RC_AKR + 512;
constexpr int RC_GC = RC_ABR + 512;
constexpr int RC_SLOT = RC_GC + 256;
static_assert(RC_SLOT == 14592 && 8 * RC_SLOT <= 131072 && 32 * 72 * 2 <= 2 * 64 * 24 * 2, "rwkv chunk lds");
__device__ __forceinline__ bf16x8 mk8(u32x2 lo, u32x2 hi) { u32x4 v = {lo.x, lo.y, hi.x, hi.y}; return __builtin_bit_cast(bf16x8, v); }
__device__ __forceinline__ int rwkv_chunk_rmin(int b, int dir, int c) {
    const int p0 = c * 16;
    if (p0 < CTXL) return TL + b * CTXL + (dir ? CTXL - 16 - p0 : p0);
    const int q = p0 - CTXL; return b * SEQ + (dir ? SEQ - 16 - q : q);
}
__device__ __forceinline__ unsigned f2bf_hi(float f) { return __float_as_uint(f) + 0x8000u; }
#ifndef FAST_RND
#define FAST_RND 1
#endif
#ifndef USE_RCP
#define USE_RCP 1
#endif
#ifndef CHUNK_SADDR
#define CHUNK_SADDR 1
#endif
#ifndef Y_SADDR
#define Y_SADDR 0
#endif
#if FAST_RND
#define BFH(x) ((bf16)(f2bf_hi(x) >> 16))
#else
#define BFH(x) ((bf16)f2bf(x))
#endif
template <int SKIP = 0>
__device__ __forceinline__ void ph_rwkv_chunk(const KC& k, int l, int job, const float* k_a, size_t yoff = RW_Y) {
    const int b = job >> 5, h = (job >> 1) & 15, dir = job & 1;
    const int w = k.wave, lane = k.lane, q4 = lane >> 4, l15 = lane & 15;
    const bf16* R = (const bf16*)(k.ws + RW_R); const bf16* KS = (const bf16*)(k.ws + RW_KS); const bf16* V = (const bf16*)(k.ws + RW_V); const bf16* KK = (const bf16*)(k.ws + RW_KK);
    const bf16* LO = (const bf16*)(k.ws + RW_LO); bf16* Y = (bf16*)(k.ws + yoff) + (size_t)dir * TA * RD;
    LAS unsigned char* slot = k.lds + w * RC_SLOT;
    LAS bf16* XT = (LAS bf16*)(slot + RC_XT); LAS bf16* YH = (LAS bf16*)(slot + RC_YH);
    LAS float* AM = (LAS float*)(slot + RC_AM);
    const int ch = h * RHS + lane;
    const float ka = k_a[l * RD + ch];
    f32x4 accZ[4];
#pragma unroll
    for (int t = 0; t < 4; ++t) accZ[t] = (f32x4){0.f, 0.f, 0.f, 0.f};
    constexpr int NCK = (CTXL + SEQ) / 16, NRND = NCK / 8;
    unsigned ylane[4];
#pragma unroll
    for (int r = 0; r < 4; ++r) { const int tk = 4 * q4 + r; ylane[r] = (unsigned)(((dir ? 15 - tk : tk) * RD + h * RHS + 16 * (w & 3) + l15) * 2); }
#if CHUNK_PF
    unsigned pf0 = 0u, pf1 = 0u, pf2 = 0u;
#endif
#if LDS_POISON
    for (int i = lane; i < RC_SLOT / 4; i += 64) ((LAS unsigned*)slot)[i] = 0x7fc07fc0u;
    __syncthreads();
#endif
    for (int rnd = 0; rnd < NRND; ++rnd) {
#if LDS_POISON
        for (int i = lane; i < RC_SLOT / 4; i += 64) ((LAS unsigned*)slot)[i] = 0x7fc07fc0u;
#endif
        if (!(SKIP & 2)) {
            const int c = rnd * 8 + w;
            float Lc = 0.f, Eprev = 1.f;
            unsigned vp[8];
#if CHUNK_LOADS_FIRST
            unsigned rv[16], rkk[16], re[16], ra[16], rks[16], rr[16];
            const unsigned rmin = (unsigned)rwkv_chunk_rmin(b, dir, c);
            const unsigned ob1 = (rmin * (unsigned)RD + (unsigned)ch) * 2u, ob4 = (rmin * 4096u + (unsigned)(dir * RD) + (unsigned)ch) * 2u;
            const char* LOa = (const char*)LO + 4096;
#pragma unroll
            for (int t = 0; t < 16; ++t) {
#if CHUNK_SADDR
                const unsigned tr = dir ? 15u - t : (unsigned)t;
                const unsigned o1 = ob1 + tr * (unsigned)(RD * 2), o4 = ob4 + tr * 8192u;
                if (SKIP & 4) { rv[t] = o1; rkk[t] = o1 >> 3; re[t] = 0x3c00u + (o4 & 255u); ra[t] = 0x3f00u; rks[t] = o1 >> 5; rr[t] = o1 >> 7; }
                else { rv[t] = *(const bf16*)((const char*)V + o1); rkk[t] = *(const bf16*)((const char*)KK + o1); re[t] = *(const bf16*)((const char*)LO + o4); ra[t] = *(const bf16*)(LOa + o4);
                       rks[t] = *(const bf16*)((const char*)KS + o1); rr[t] = *(const bf16*)((const char*)R + o1); }
#else
                const unsigned o1 = (unsigned)rwkv_row(b, dir, c * 16 + t) * (unsigned)RD + (unsigned)ch, o4 = o1 * 4u - 3u * (unsigned)ch + (unsigned)(dir * RD);
                if (SKIP & 4) { rv[t] = o1; rkk[t] = o1 >> 3; re[t] = 0x3c00u + (o4 & 255u); ra[t] = 0x3f00u; rks[t] = o1 >> 5; rr[t] = o1 >> 7; }
                else { rv[t] = V[o1]; rkk[t] = KK[o1]; re[t] = LO[o4]; ra[t] = LO[o4 + 2048u]; rks[t] = KS[o1]; rr[t] = R[o1]; }
#endif
            }
            asm volatile("" ::: "memory");
            const float omka = 1.0f - ka;
#pragma unroll
            for (int t = 0; t < ((SKIP & 16) ? 1 : 16); ++t) {
                { const unsigned vraw = rv[t]; vp[t >> 1] = (t & 1) ? (vp[t >> 1] | (vraw << 16)) : vraw; }
                const float kkv = bf2f(rkk[t]), ev = bf2f(re[t]), av = bf2f(ra[t]);
                const float ksv = bf2f(rks[t]), rv_ = bf2f(rr[t]);
                Lc -= ev;
#if USE_RCP
                const float E = __expf(Lc), Einv = __builtin_amdgcn_rcpf(E);
#else
                const float E = __expf(Lc), Einv = __expf(-Lc);
#endif
                XT[t * 72 + lane] = BFH(kkv * Eprev); XT[(16 + t) * 72 + lane] = BFH(rv_ * E);
                YH[t * 72 + lane] = BFH(kkv * av * Einv); YH[(16 + t) * 72 + lane] = BFH(ksv * __builtin_fmaf(av, ka, omka) * Einv);
                Eprev = E;
            }
#else
#pragma unroll
            for (int t = 0; t < 16; ++t) {
                const unsigned o1 = (unsigned)rwkv_row(b, dir, c * 16 + t) * (unsigned)RD + (unsigned)ch, o4 = o1 * 4u - 3u * (unsigned)ch + (unsigned)(dir * RD);
                { const unsigned vraw = V[o1]; vp[t >> 1] = (t & 1) ? (vp[t >> 1] | (vraw << 16)) : vraw; }
                const float kkv = bf2f(KK[o1]), ev = bf2f(LO[o4]), av = bf2f(LO[o4 + 2048u]);
                const float ksv = bf2f(KS[o1]), rv = bf2f(R[o1]);
                Lc -= ev;
                const float E = __expf(Lc), Einv = __expf(-Lc);
                XT[t * 72 + lane] = (bf16)f2bf(kkv * Eprev); XT[(16 + t) * 72 + lane] = (bf16)f2bf(rv * E);
                YH[t * 72 + lane] = (bf16)f2bf(kkv * av * Einv); YH[(16 + t) * 72 + lane] = (bf16)f2bf(ksv * (1.0f + (av - 1.0f) * ka) * Einv);
                Eprev = E;
            }
#endif
            const float eLC = Eprev;
            asm volatile("s_waitcnt lgkmcnt(0)" ::: "memory");
#if CHUNK_PF
            if (w >= 4) {
                const int cn0 = (rnd + 1 < NRND ? rnd + 1 : rnd) * 8;
                int ln = lane; asm volatile("" : "+v"(ln));
                auto pf_off = [&](int j) -> unsigned {
                    const int i = (w - 4) * 192 + j * 64 + ln, cc = i / 96, wi = i - cc * 96, ar = wi >> 4, tk = wi & 15;
                    const unsigned row = (unsigned)rwkv_row(b, dir, (cn0 + cc) * 16 + tk);
                    const unsigned base = ar == 0 ? (unsigned)RW_R : ar == 1 ? (unsigned)RW_KS : ar == 2 ? (unsigned)RW_V : ar == 3 ? (unsigned)RW_KK : (unsigned)RW_LO;
                    const unsigned el = ar < 4 ? row * (unsigned)RD + (unsigned)(h * RHS) : row * 4096u + (unsigned)(dir * RD + h * RHS) + (unsigned)(ar - 4) * 2048u;
                    return base + 2u * el; };
                const unsigned q0 = pf_off(0), q1 = pf_off(1), q2 = pf_off(2);
                asm volatile("global_load_dword %0, %3, %6\n\tglobal_load_dword %1, %4, %6\n\tglobal_load_dword %2, %5, %6" : "+v"(pf0), "+v"(pf1), "+v"(pf2) : "v"(q0), "v"(q1), "v"(q2), "s"(k.ws) : "memory");
            }
#endif
            f32x4 am[2][2];
#pragma unroll
            for (int rt = 0; rt < 2; ++rt)
#pragma unroll
                for (int ct = 0; ct < 2; ++ct) {
                    f32x4 acc = (f32x4){0.f, 0.f, 0.f, 0.f};
#pragma unroll
                    for (int s = 0; s < ((SKIP & 32) ? 0 : 2); ++s) acc = __builtin_amdgcn_mfma_f32_16x16x32_bf16(*(const LAS bf16x8*)(XT + (16 * rt + l15) * 72 + 32 * s + 8 * q4), *(const LAS bf16x8*)(YH + (16 * ct + l15) * 72 + 32 * s + 8 * q4), acc, 0, 0, 0);
                    am[rt][ct] = acc;
                }
            LAS bf16* AKR = (LAS bf16*)(slot + RC_AKR); LAS bf16* ABR = (LAS bf16*)(slot + RC_ABR);
#pragma unroll
            for (int r = 0; r < 4; ++r) {
                const int t = 4 * q4 + r, j = l15;
                AM[t * 16 + j] = j < t ? am[0][0][r] : 0.f;
                AM[256 + t * 16 + j] = j < t ? am[0][1][r] : 0.f;
#if PROD_PK
                const unsigned ab2 = pk2c(j <= t ? -am[1][0][r] : 0.f, j <= t ? am[1][1][r] : 0.f);
                ABR[t * 16 + j] = (bf16)(ab2 & 0xffffu);
                AKR[t * 16 + j] = (bf16)(ab2 >> 16);
#else
                ABR[t * 16 + j] = BFH(j <= t ? -am[1][0][r] : 0.f);
                AKR[t * 16 + j] = BFH(j <= t ? am[1][1][r] : 0.f);
#endif
            }
            asm volatile("s_waitcnt lgkmcnt(0)" ::: "memory");
#if SUBST_PK
            f32x2 PP[16]; float kt[16];
#pragma unroll
            for (int t = 0; t < 16; ++t) kt[t] = bf2f(XT[t * 72 + lane]);
#pragma unroll
            for (int t = 0; t < 16; ++t) {
                asm volatile("" ::: "memory");
                f32x2 p = {kt[t], AM[256 + t * 16 + l15]};
#pragma unroll
                for (int j4 = 0; j4 < (t + 3) / 4; ++j4) {
                    const f32x4 arow = *(const LAS f32x4*)(AM + t * 16 + 4 * j4);
#pragma unroll
                    for (int e = 0; e < 4; ++e) { const int j = 4 * j4 + e; if (j < t) p -= PP[j] * arow[e]; }
                }
                PP[t] = p;
            }
#else
            float P1[16], P2[16], kt[16];
#pragma unroll
            for (int t = 0; t < 16; ++t) kt[t] = bf2f(XT[t * 72 + lane]);
#pragma unroll
            for (int t = 0; t < 16; ++t) {
                asm volatile("" ::: "memory");
                float p1 = kt[t], p2 = AM[256 + t * 16 + l15];
#pragma unroll
                for (int j4 = 0; j4 < (t + 3) / 4; ++j4) {
                    const f32x4 arow = *(const LAS f32x4*)(AM + t * 16 + 4 * j4);
#pragma unroll
                    for (int e = 0; e < 4; ++e) { const int j = 4 * j4 + e; if (j < t && !(SKIP & 8)) { p1 -= arow[e] * P1[j]; p2 -= arow[e] * P2[j]; } }
                }
                P1[t] = p1; P2[t] = p2;
            }
#endif
            LAS bf16* P2b = (LAS bf16*)(slot + RC_P2);
#pragma unroll
#if PROD_PK
            for (int t = 0; t < 16; ++t) { const unsigned pp = pk2c(0.f, 0.f); XT[t * 72 + lane] = (bf16)(pp & 0xffffu); if (lane < 16) P2b[t * 16 + lane] = (bf16)(pp >> 16); }
#else
#if SUBST_PK
            for (int t = 0; t < 16; ++t) { if (CHUNK_DBG != 12) XT[t * 72 + lane] = (bf16)f2bf(CHUNK_DBG == 13 ? 1.0f + (float)t : PP[t].x); if (lane < 16) P2b[t * 16 + lane] = (bf16)f2bf(PP[t].y); }
#else
            for (int t = 0; t < 16; ++t) { XT[t * 72 + lane] = BFH(P1[t]); if (lane < 16) P2b[t * 16 + lane] = BFH(P2[t]); }
#endif
#endif
            if (!(SKIP & 64)) {
                LAS bf16* KET = (LAS bf16*)(slot + RC_YH); LAS bf16* BET = (LAS bf16*)(slot + RC_BET);
                float ke[16], be[16];
#pragma unroll
                for (int t = 0; t < 16; ++t) { ke[t] = bf2f(YH[(16 + t) * 72 + lane]) * eLC; be[t] = -bf2f(YH[t * 72 + lane]) * eLC; }
                asm volatile("s_waitcnt lgkmcnt(0)" ::: "memory");
                float a0[8], a1[8], b0[8], b1[8];
#pragma unroll
                for (int t = 0; t < 8; ++t) { a0[t] = ke[t]; a1[t] = ke[8 + t]; b0[t] = be[t]; b1[t] = be[8 + t]; }
                *(LAS u32x4*)(KET + lane * 24) = pack8(a0); *(LAS u32x4*)(KET + lane * 24 + 8) = pack8(a1);
                *(LAS u32x4*)(BET + lane * 24) = pack8(b0); *(LAS u32x4*)(BET + lane * 24 + 8) = pack8(b1);
                ((LAS float*)(slot + RC_GC))[lane] = eLC;
                *(LAS u32x4*)(slot + RC_AM + lane * 32) = (u32x4){vp[0], vp[1], vp[2], vp[3]}; *(LAS u32x4*)(slot + RC_AM + lane * 32 + 16) = (u32x4){vp[4], vp[5], vp[6], vp[7]};
            }
        }
        __syncthreads();
        if (w < 4 && !(SKIP & 1)) {
#if CONS_UNROLL == 2
#pragma unroll 2
#else
#pragma unroll 1
#endif
            for (int cc = 0; cc < 8; ++cc) {
                const int c = rnd * 8 + cc;
                LAS unsigned char* sl = k.lds + cc * RC_SLOT;
                const LAS bf16* P1b = (const LAS bf16*)(sl + RC_XT); const LAS bf16* RTb = P1b + 16 * 72;
                const LAS bf16* KET = (const LAS bf16*)(sl + RC_YH); const LAS bf16* BET = (const LAS bf16*)(sl + RC_BET);
                const LAS bf16* P2b = (const LAS bf16*)(sl + RC_P2); const LAS bf16* AKR = (const LAS bf16*)(sl + RC_AKR); const LAS bf16* ABR = (const LAS bf16*)(sl + RC_ABR);
                const LAS float* GC = (const LAS float*)(sl + RC_GC);
                const u32x2 vfr = *(const LAS u32x2*)(sl + RC_AM + (16 * w + l15) * 32 + 8 * q4);
                const unsigned vlo = vfr.x, vhi = vfr.y;
#if CHUNK_DBG == 5
                for (int t = 0; t < 4; ++t) accZ[t] = (f32x4){0.f, 0.f, 0.f, 0.f};
#endif
#if CHUNK_NOPS
                asm volatile("s_nop 15\n\ts_nop 15" ::: "memory");
#endif
                bf16x8 bz[2];
#pragma unroll
                for (int s = 0; s < 2; ++s) { u32x4 v = {pk2c(accZ[2 * s][0], accZ[2 * s][1]), pk2c(accZ[2 * s][2], accZ[2 * s][3]), pk2c(accZ[2 * s + 1][0], accZ[2 * s + 1][1]), pk2c(accZ[2 * s + 1][2], accZ[2 * s + 1][3])}; bz[s] = __builtin_bit_cast(bf16x8, v); }
#if CHUNK_DBG == 6
                bz[0] = (bf16x8){0,0,0,0,0,0,0,0}; bz[1] = bz[0];
#endif
                const u32x2 zero2 = {0u, 0u};
                f32x4 zs[4];
#pragma unroll
                for (int t = 0; t < 4; ++t) zs[t] = accZ[t] * *(const LAS f32x4*)(GC + 16 * t + 4 * q4);
#if CHUNK_DBG == 7
                for (int t = 0; t < 4; ++t) zs[t] = (f32x4){0.f, 0.f, 0.f, 0.f};
#endif
                f32x4 sa = (f32x4){0.f, 0.f, 0.f, 0.f};
#if CHUNK_DBG >= 10 && CHUNK_DBG <= 13
                { u32x4 ones = {0x3f803f80u, 0x3f803f80u, 0x3f803f80u, 0x3f803f80u}; const bf16x8 bo = __builtin_bit_cast(bf16x8, ones);
                  for (int s = 0; s < 2; ++s) sa = __builtin_amdgcn_mfma_f32_16x16x32_bf16(mk8(*(const LAS u32x2*)(P1b + l15 * 72 + 32 * s + 4 * q4), *(const LAS u32x2*)(P1b + l15 * 72 + 32 * s + 16 + 4 * q4)), (CHUNK_DBG == 10 || CHUNK_DBG == 12 || CHUNK_DBG == 13) ? bo : bz[s], sa, 0, 0, 0); }
#else
#pragma unroll
                for (int s = 0; s < 2; ++s) if (CHUNK_DBG != 3 && CHUNK_DBG != 9) sa = __builtin_amdgcn_mfma_f32_16x16x32_bf16(mk8(*(const LAS u32x2*)(P1b + l15 * 72 + 32 * s + 4 * q4), *(const LAS u32x2*)(P1b + l15 * 72 + 32 * s + 16 + 4 * q4)), bz[s], sa, 0, 0, 0);
#endif
                if (CHUNK_DBG != 4 && !(CHUNK_DBG >= 10 && CHUNK_DBG <= 13)) { u32x4 bv = {vlo, vhi, 0u, 0u}; sa = __builtin_amdgcn_mfma_f32_16x16x32_bf16(mk8(*(const LAS u32x2*)(P2b + l15 * 16 + 4 * q4), zero2), __builtin_bit_cast(bf16x8, bv), sa, 0, 0, 0); }
#if CHUNK_DBG == 1
                sa = (f32x4){0.f, 0.f, 0.f, 0.f};
#endif
#if CHUNK_NOPS
                asm volatile("s_nop 15" : "+v"(sa));
#endif
                bf16x8 bv2; { u32x4 v = {vlo, vhi, pk2c(sa[0], sa[1]), pk2c(sa[2], sa[3])}; bv2 = __builtin_bit_cast(bf16x8, v); }
                f32x4 yy = (f32x4){0.f, 0.f, 0.f, 0.f};
#pragma unroll
                for (int s = 0; s < 2; ++s) if (CHUNK_DBG != 8) yy = __builtin_amdgcn_mfma_f32_16x16x32_bf16(mk8(*(const LAS u32x2*)(RTb + l15 * 72 + 32 * s + 4 * q4), *(const LAS u32x2*)(RTb + l15 * 72 + 32 * s + 16 + 4 * q4)), bz[s], yy, 0, 0, 0);
                yy = __builtin_amdgcn_mfma_f32_16x16x32_bf16(mk8(*(const LAS u32x2*)(AKR + l15 * 16 + 4 * q4), *(const LAS u32x2*)(ABR + l15 * 16 + 4 * q4)), bv2, yy, 0, 0, 0);
#pragma unroll
                for (int t = 0; t < 4; ++t) {
                    accZ[t] = __builtin_amdgcn_mfma_f32_16x16x32_bf16(mk8(*(const LAS u32x2*)(KET + (16 * t + l15) * 24 + 4 * q4), *(const LAS u32x2*)(BET + (16 * t + l15) * 24 + 4 * q4)), bv2, zs[t], 0, 0, 0);
                }
#if CHUNK_DBG == 2
                yy = (f32x4){1.f, 1.f, 1.f, 1.f};
#endif
#if CHUNK_DBG >= 10 && CHUNK_DBG <= 13
                yy = sa;
#endif
#if CHUNK_NOPS
                asm volatile("s_nop 15" : "+v"(yy));
#endif
#if Y_SADDR
                { const unsigned yb = (unsigned)rwkv_chunk_rmin(b, dir, c) * (unsigned)(RD * 2);
#pragma unroll
                  for (int r = 0; r < 4; ++r) *(bf16*)((char*)Y + (yb + ylane[r])) = BFH(yy[r]); }
#else
#pragma unroll
                for (int r = 0; r < 4; ++r) Y[(size_t)rwkv_row(b, dir, c * 16 + 4 * q4 + r) * RD + h * RHS + 16 * w + l15] = BFH(yy[r]);
#endif
            }
        }
#if CHUNK_PF
        else asm volatile("s_waitcnt vmcnt(0)" : "+v"(pf0), "+v"(pf1), "+v"(pf2) :: "memory");
#endif
        __syncthreads();
    }
}

#ifndef CHECK_EXACT
#define CHECK_EXACT 0
#endif
#ifndef CHECK_PMAX
#define CHECK_PMAX (CTXL + SEQ)
#endif
#ifndef CHECK_PMIN
#define CHECK_PMIN 0
#endif
#ifndef CHECK_UNIT
#define CHECK_UNIT 1000
#endif
__device__ __forceinline__ void rwkv_check_delay(const KC& k, int job, size_t refoff = RW_Y) {
    const int b = job >> 5, h = (job >> 1) & 15, dir = job & 1;
    const bf16* Ya = (const bf16*)(k.ws + refoff) + (size_t)dir * TA * RD; const bf16* Yb = (const bf16*)(k.ws + WS_H) + (size_t)dir * TA * RD;
    float d2 = 0.f, s2 = 0.f; int bad = 0;
    for (int i = k.tid; i < (CHECK_PMAX) * 32; i += 512) {
        const int p = (CHECK_PMIN) + (i >> 5), cp = i & 31; const size_t o = (size_t)rwkv_row(b, dir, p) * RD + h * RHS + 2 * cp;
        const unsigned ua = *(const unsigned*)(Ya + o), ub = *(const unsigned*)(Yb + o);
        const float a0 = bflo(ua), a1 = bfhi(ua), b0 = bflo(ub), b1 = bfhi(ub);
        d2 += (CHECK_EXACT) ? (ua != ub ? 1.0f : 0.0f) : (a0 - b0) * (a0 - b0) + (a1 - b1) * (a1 - b1); s2 += a0 * a0 + a1 * a1;
        if (!(b0 == b0) || !(b1 == b1) || fabsf(b0) > 1e30f || fabsf(b1) > 1e30f) bad = 1;
    }
    LAS float* red = (LAS float*)k.lds;
    __syncthreads();
    d2 = wave_sum(d2); s2 = wave_sum(s2); bad = __any(bad) ? 1 : 0;
    if (k.lane == 0) { red[k.wave * 4] = d2; red[k.wave * 4 + 1] = s2; red[k.wave * 4 + 2] = (float)bad; }
    __syncthreads();
    if (k.tid == 0) {
        float D = 0.f, S = 0.f, B = 0.f;
        for (int i = 0; i < 8; ++i) { D += red[i * 4]; S += red[i * 4 + 1]; B += red[i * 4 + 2]; }
        const float rel = sqrtf(D / fmaxf(S, 1e-30f));
        int bucket = rel < 0.01f ? 0 : rel < 0.03f ? 1 : rel < 0.1f ? 2 : rel < 0.3f ? 3 : rel < 1.0f ? 4 : 5;
        if (CHECK_EXACT) bucket = D == 0.f ? 0 : D < 10.f ? 1 : D < 100.f ? 2 : D < 1000.f ? 3 : D < 10000.f ? 4 : 5;
        if (B > 0.f || !(rel == rel)) bucket = 6;
        const unsigned long long t0 = __builtin_amdgcn_s_memrealtime(), wait = (unsigned long long)bucket * (CHECK_UNIT) * 100ull;
        while (__builtin_amdgcn_s_memrealtime() - t0 < wait) __builtin_amdgcn_s_sleep(8);
    }
    __syncthreads();
}
using pg8::Unit;
struct FP_ { bf16* P; __device__ __forceinline__ void operator()(int row, int col, float (&v)[8], const Unit&) const { *(u32x4*)(P + (size_t)row * NP + col) = pack8(v); } };
struct FL1_ { bf16* LO; const float* bias1;
    __device__ __forceinline__ void operator()(int row, int col, float (&v)[8], const Unit& u) const {
        const float* bias = bias1 + col;
        const f32x4 b0 = *(const f32x4*)bias, b1 = *(const f32x4*)(bias + 4);
        const float bb[8] = {b0.x, b0.y, b0.z, b0.w, b1.x, b1.y, b1.z, b1.w};
        const float sc = col < 2048 ? 0.6065306597126334f : 1.0f;
#pragma unroll
        for (int i = 0; i < 8; ++i) v[i] = sigm(bb[i] + v[i]) * sc;
        *(u32x4*)(LO + (size_t)row * 4096 + col) = pack8(v);
    } };
struct FL2_ { const bf16* YNB; bf16* YA;
    __device__ __forceinline__ void operator()(int row, int col, float (&v)[8], const Unit&) const {
        float y[8]; unpack8(*(const u32x4*)(YNB + (size_t)row * RD + col), y);
#pragma unroll
        for (int i = 0; i < 8; ++i) v[i] *= y[i];
        *(u32x4*)(YA + (size_t)row * RD + col) = pack8(v);
    } };
template <int SECOND> struct FM_ { const bf16* P; bf16* MA; bf16* OUT;
    __device__ __forceinline__ void operator()(int row, int col, float (&v)[8], const Unit&) const {
        float g[8]; unpack8(*(const u32x4*)(P + (size_t)row * NP + BR_OFF + SECOND * DM + col), g);
        const bf16* mp = MA + (size_t)row * DM + col;
        if (SECOND) { float m[8]; unpack8(*(const u32x4*)mp, m);
#pragma unroll
            for (int i = 0; i < 8; ++i) v[i] = sigm(g[i]) * v[i] + m[i]; }
        else {
#pragma unroll
            for (int i = 0; i < 8; ++i) v[i] = sigm(g[i]) * v[i]; }
        *(u32x4*)(OUT + (size_t)row * DM + col) = pack8(v);
    } };
struct FX_ { float* X; const float* MOD; int l; float* OUT;
    __device__ __forceinline__ void operator()(int row, int col, const f32x4 v, const Unit&) const {
        const f32x4 g = *(const f32x4*)(MOD + ((size_t)l * 9 + mod_row(row)) * MOD_N + 2 * DM + col);
        const f32x4* xp = (const f32x4*)(X + (size_t)row * DM + col);
        *(f32x4*)(OUT + (size_t)row * DM + col) = *xp + g * v;
    } };
struct FXb_ { bf16* X; const float* MOD; int l;
    __device__ __forceinline__ void operator()(int row, int col, float (&v)[8], const Unit&) const {
        const float* gp = MOD + ((size_t)l * 9 + mod_row(row)) * MOD_N + 2 * DM + col;
        const f32x4 g0 = *(const f32x4*)gp, g1 = *(const f32x4*)(gp + 4);
        const float gg[8] = {g0.x, g0.y, g0.z, g0.w, g1.x, g1.y, g1.z, g1.w};
        bf16* xp = X + (size_t)row * DM + col;
        float x[8]; unpack8(*(const u32x4*)xp, x);
#pragma unroll
        for (int i = 0; i < 8; ++i) v[i] = x[i] + gg[i] * v[i];
        *(u32x4*)xp = pack8(v);
    } };
struct FE1_ { bf16* ACT;
    __device__ __forceinline__ void operator()(int row, int col, float (&g)[8], float (&up)[8]) const {
#pragma unroll
        for (int i = 0; i < 8; ++i) g[i] = siluf(g[i]) * up[i];
        *(u32x4*)(ACT + (size_t)row * DEXP + col) = pack8(g);
    } };
struct FE2_ { const int* rowtok; const float* roww; bf16* YF;
    __device__ __forceinline__ void operator()(int row, int col, float (&v)[8], const Unit&) const {
        const int t2 = rowtok[row];
        if (t2 >= 0) { const float w = roww[row];
#pragma unroll
            for (int i = 0; i < 8; ++i) v[i] *= w;
            *(u32x4*)(YF + ((size_t)(t2 & 1) * TA + (t2 >> 1)) * DM + col) = pack8(v); }
    } };

#ifndef GA_
#define GA_ true
#endif
#ifndef GS_
#define GS_ true
#endif
constexpr int LDS_BYTES = 147456;
constexpr int MISC_OFF = 131072 + 4096;

constexpr int NPHASE = 2 + 14 * DEPTH + 1;
struct Args { const float* in[N_IN]; float* out; unsigned char* ws; int ph_lo, ph_hi; };
static_assert(sizeof(Args) == N_IN * 8 + 8 + 8 + 8, "Args has no padding");

__global__ void __launch_bounds__(512, 2) fwd(Args a) {
    extern __shared__ __attribute__((aligned(16))) unsigned char lds_raw[];
    KC k;
    k.lds = (LAS unsigned char*)lds_raw; k.ws = (unsigned char*)INP(N_IN + 1);
    k.tid = threadIdx.x; k.lane = k.tid & 63; k.wave = __builtin_amdgcn_readfirstlane(k.tid >> 6); k.G = gridDim.x; k.bid = blockIdx.x;
    const int lo = a.ph_lo, hi = a.ph_hi;
    volatile LAS unsigned* MISC = (volatile LAS unsigned*)(k.lds + MISC_OFF);
    if (k.tid < 32) MISC[k.tid] = 0u;
    __syncthreads();
    XcdBarrier bar; bar.bar = (unsigned*)(k.ws + WS_CTL) + CW_BAR; bar.x = 0; bar.st = nullptr;
    if (hi - lo > 1) bar = xcd_barrier_post((unsigned*)(k.ws + WS_CTL) + CW_BAR, MISC + 8);
#ifndef SITE_MASK
#define SITE_MASK 0xFFFFFFFFu
#endif
#define FRESH() do { int t_ = threadIdx.x; asm volatile("" : "+v"(t_)); k.tid = t_; k.lane = t_ & 63; k.wave = __builtin_amdgcn_readfirstlane(t_ >> 6); k.ws = (unsigned char*)INP(N_IN + 1); ws = k.ws; } while (0)
#define PH_BEGIN(p, site) if (((SITE_MASK >> (site)) & 1u) && lo <= (p) && (p) < hi) { FRESH();
#ifndef EXTRA_BARS
#define EXTRA_BARS 0
#endif
#ifndef DUP_MASK
#define DUP_MASK 0u
#endif
#define DUPRUN(n, stmt) do { stmt; if ((DUP_MASK >> (n)) & 1u) { __syncthreads(); stmt; } } while (0)
#define PH_END(p) if ((p) + 1 < hi) xcd_barrier(bar); }
    unsigned char* ws = k.ws;
    LAS unsigned char* glds = k.lds;
#define WSRC WSrc{INP(I_WIN), INP(I_W2), INP(I_A2), INP(I_G2), INP(I_WBA), INP(I_WBB), INP(I_WOUT), INP(I_EG), INP(I_EU), INP(I_ED), INP(I_W0), INP(I_A0)}

    PH_BEGIN(0, 0) DUPRUN(0, ph_adaln_partials(k, INP(I_C), INP(I_CCTX), INP(I_WADA))); DUPRUN(1, ph_convert(k, WSRC, 0)); PH_END(0)
    PH_BEGIN(1, 1) ph_adaln_reduce(k, INP(I_BADA)); PH_END(1)

#define L_ 0
    {
        constexpr int l = L_;
        const int pb = 2 + 14 * l;
        const bool last = (l == DEPTH - 1);
        const int Mpost = last ? TL : TA;
        PH_BEGIN(pb + 0, 2)
            if (l > 0) { DUPRUN(1, ph_convert(k, WSRC, l)); }
            RowArgs ra{INP(I_X), INP(I_CTX), INP(I_NMG), nullptr, nullptr, nullptr};
            ph_rows<0>(k, ra, l, TA);
            if (l == 0 && ((DUP_MASK >> 15) & 1u)) { __syncthreads(); ph_rows<0>(k, ra, l, TA); }
        PH_END(pb + 0)
        PH_BEGIN(pb + 1, 3)
            pg8::Gemm g{(const bf16*)(ws + WS_H), (const bf16*)(ws + WT_IN), TA, NP, DM, 0}; pg8::StaticOrder S; S.init(TA, NP, k.G, k.bid);
            pg8::Epi8<FP_> E{FP_{(bf16*)(ws + WS_P)}};
            DUPRUN(2, (pg8::gemm_phase<pg8::Epi8<FP_>, pg8::StaticOrder, GA_, GS_>(glds, g, S, E)));
        PH_END(pb + 1)
        PH_BEGIN(pb + 2, 4)
            DUPRUN(3, ph_rwkv_prep(k, l, TA, INP(I_MU), INP(I_KK), INP(I_RK)));
            DUPRUN(4, ph_gla_prep(k, l, INP(I_GCONV), INP(I_GAW2), INP(I_GAB)));
        PH_END(pb + 2)
        PH_BEGIN(pb + 3, 5)
            pg8::Gemm g{(const bf16*)(ws + RW_A1), (const bf16*)(ws + WT_L1), TA, 4096, 256, 0}; pg8::StaticOrder S; S.init(TA, 4096, k.G, k.bid);
            pg8::Epi8<FL1_> E{FL1_{(bf16*)(ws + RW_LO), (const float*)(ws + WS_TAB + TAB_TOP)}};
            DUPRUN(5, (pg8::gemm_phase<pg8::Epi8<FL1_>, pg8::StaticOrder, GA_, GS_>(glds, g, S, E)));
        PH_END(pb + 3)
        PH_BEGIN(pb + 4, 6)
#if SPLIT_SCAN
            DUPRUN(6, ph_scan_split(k, l, INP(I_KA)));
#else
            for (int vb = ((k.G & 7) ? k.bid : (k.bid & 7) * (k.G >> 3) + (k.bid >> 3)); vb < 256; vb += k.G) { const int job = vb;
#if RWKV_MODE == 0
                DUPRUN(6, ph_rwkv_scan(k, l, job, INP(I_KA)));
#elif RWKV_MODE == 1
                ph_rwkv_scan(k, l, job, INP(I_KA)); ph_rwkv_chunk(k, l, job, INP(I_KA), WS_H); if (l == 0) rwkv_check_delay(k, job);
#elif RWKV_MODE == 4
                ph_rwkv_scan(k, l, job, INP(I_KA)); ph_rwkv_chunk(k, l, job, INP(I_KA), WS_H); ph_rwkv_chunk(k, l, job, INP(I_KA), WS_END); if (l == 0) rwkv_check_delay(k, job, WS_END);
#elif RWKV_MODE == 5
#pragma unroll 1
                for (int rep = 0; rep < 2; ++rep) { int r_ = rep; asm volatile("" : "+s"(r_)); __syncthreads(); ph_rwkv_chunk(k, l, job, INP(I_KA), r_ ? (size_t)RW_Y : (size_t)WS_H); }
                if (l == 0) rwkv_check_delay(k, job);
#elif RWKV_MODE == 3
                ph_rwkv_scan(k, l, job, INP(I_KA)); ph_rwkv_scan(k, l, job, INP(I_KA), WS_H); if (l == 0) rwkv_check_delay(k, job);
#else
                DUPRUN(6, ph_rwkv_chunk(k, l, job, INP(I_KA)));
#ifdef CHUNK_PROBE
                __syncthreads(); ph_rwkv_chunk<CHUNK_PROBE>(k, l, job, INP(I_KA), WS_END);
#endif
#endif
            }
#ifndef NO_GLA
            FRESH();
            for (int vb = ((k.G & 7) ? k.bid : (k.bid & 7) * (k.G >> 3) + (k.bid >> 3)); vb < 256; vb += k.G) { const int job = vb; DUPRUN(7, ph_gla_scan(k, job)); }
#endif
#endif
        PH_END(pb + 4)
        PH_BEGIN(pb + 5, 7)
            DUPRUN(8, ph_post(k, l, Mpost, INP(I_LNG), INP(I_LNB), INP(I_GNG)));
        PH_END(pb + 5)
        PH_BEGIN(pb + 6, 8)
            pg8::Gemm g{(const bf16*)(ws + RW_A2), (const bf16*)(ws + WT_G2), Mpost, RD, 256, 0}; pg8::StaticOrder S; S.init(Mpost, RD, k.G, k.bid);
            pg8::Epi8<FL2_> E{FL2_{(const bf16*)(ws + RW_R), (bf16*)(ws + RW_V)}};
            DUPRUN(9, (pg8::gemm_phase<pg8::Epi8<FL2_>, pg8::StaticOrder, GA_, GS_>(glds, g, S, E)));
        PH_END(pb + 6)
        PH_BEGIN(pb + 7, 9)
            pg8::Gemm g{(const bf16*)(ws + RW_V), (const bf16*)(ws + WT_A), Mpost, DM, RD, 0}; pg8::StaticOrder S; S.init(Mpost, DM, k.G, k.bid);
            pg8::Epi8<FM_<0>> E{FM_<0>{(const bf16*)(ws + WS_P), (bf16*)(ws + WS_H), (bf16*)(ws + WS_H)}};
            DUPRUN(10, (pg8::gemm_phase<pg8::Epi8<FM_<0>>, pg8::StaticOrder, GA_, GS_>(glds, g, S, E)));
        PH_END(pb + 7)
        PH_BEGIN(pb + 8, 10)
            pg8::Gemm g{(const bf16*)(ws + GL_VS), (const bf16*)(ws + WT_B), Mpost, DM, GVD, 0}; pg8::StaticOrder S; S.init(Mpost, DM, k.G, k.bid);
            pg8::Epi8<FM_<1>> E{FM_<1>{(const bf16*)(ws + WS_P), (bf16*)(ws + WS_H), (bf16*)(ws + WS_H)}};
            pg8::gemm_phase<pg8::Epi8<FM_<1>>, pg8::StaticOrder, GA_, GS_>(glds, g, S, E);
            if ((DUP_MASK >> 17) & 1u) { __syncthreads(); pg8::Epi8<FM_<1>> E2{FM_<1>{(const bf16*)(ws + WS_P), (bf16*)(ws + WS_H), (bf16*)(ws + RW_R)}}; pg8::gemm_phase<pg8::Epi8<FM_<1>>, pg8::StaticOrder, GA_, GS_>(glds, g, S, E2); }
        PH_END(pb + 8)
        PH_BEGIN(pb + 9, 11)
            pg8::Gemm g{(const bf16*)(ws + WS_H), (const bf16*)(ws + WT_O), Mpost, DM, DM, 0}; pg8::StaticOrder S; S.init(Mpost, DM, k.G, k.bid);
#if XBF
            pg8::Epi8<FXb_> E{FXb_{(bf16*)(ws + WS_X), (const float*)(ws + WS_MOD), l}};
            pg8::gemm_phase<pg8::Epi8<FXb_>, pg8::StaticOrder, GA_, GS_>(glds, g, S, E);
#else
            pg8::Epi4<FX_> E{FX_{(float*)(ws + WS_X), (const float*)(ws + WS_MOD), l, (float*)(ws + WS_X)}};
            pg8::gemm_phase<pg8::Epi4<FX_>, pg8::StaticOrder, GA_, GS_>(glds, g, S, E);
#endif
            if (!XBF && ((DUP_MASK >> 18) & 1u)) { __syncthreads(); pg8::Epi4<FX_> E2{FX_{(float*)(ws + WS_X), (const float*)(ws + WS_MOD), l, (float*)(ws + WS_P)}}; pg8::gemm_phase<pg8::Epi4<FX_>, pg8::StaticOrder, GA_, GS_>(glds, g, S, E2); }
        PH_END(pb + 9)
        PH_BEGIN(pb + 10, 12)
            RowArgs ra{nullptr, nullptr, INP(I_NFG), INP(I_RW), INP(I_RB), nullptr};
            ph_rows<1>(k, ra, l, Mpost);
            if ((DUP_MASK >> 16) & 1u) { __syncthreads(); ph_rows<1>(k, ra, l, Mpost, true); }
        PH_END(pb + 10)
        PH_BEGIN(pb + 11, 13)
            DUPRUN(13, ph_moe_scatter(k, l, Mpost));
        PH_END(pb + 11)
        PH_BEGIN(pb + 12, 14)
#if MOE_GATHER
            pg8::Gemm g{(const bf16*)(ws + WS_H), (const bf16*)(ws + WT_GU), 0, 2816, DM, (size_t)2816 * DM * 2};
            pg8::MoeOrderT<true> S; S.rowtok = (const int*)(ws + WS_TAB + TAB_ROWTOK) + (size_t)l * MOE_ROWS;
            S.init((const int*)(ws + WS_TAB + TAB_TILE) + 256 * l, 11, k.G, ((k.G & 7) ? k.bid : (k.bid & 7) * (k.G >> 3) + (k.bid >> 3)));
            pg8::EpiGU<FE1_> E{FE1_{(bf16*)(ws + WS_ACT)}};
            DUPRUN(11, (pg8::gemm_phase<pg8::EpiGU<FE1_>, pg8::MoeOrderT<true>, GA_, GS_>(glds, g, S, E)));
#else
            pg8::Gemm g{(const bf16*)(ws + WS_HP), (const bf16*)(ws + WT_GU), 0, 2816, DM, (size_t)2816 * DM * 2};
            pg8::MoeOrder S; S.init((const int*)(ws + WS_TAB + TAB_TILE) + 256 * l, 11, k.G, ((k.G & 7) ? k.bid : (k.bid & 7) * (k.G >> 3) + (k.bid >> 3)));
            pg8::EpiGU<FE1_> E{FE1_{(bf16*)(ws + WS_ACT)}};
            DUPRUN(11, (pg8::gemm_phase<pg8::EpiGU<FE1_>, pg8::MoeOrder, GA_, GS_>(glds, g, S, E)));
#endif
        PH_END(pb + 12)
        PH_BEGIN(pb + 13, 15)
            pg8::Gemm g{(const bf16*)(ws + WS_ACT), (const bf16*)(ws + WT_D), 0, DM, DEXP, (size_t)DM * DEXP * 2};
            pg8::MoeOrder S; S.init((const int*)(ws + WS_TAB + TAB_TILE) + 256 * l, 8, k.G, ((k.G & 7) ? k.bid : (k.bid & 7) * (k.G >> 3) + (k.bid >> 3)));
            pg8::Epi8<FE2_> E{FE2_{(const int*)(ws + WS_TAB + TAB_ROWTOK) + (size_t)l * MOE_ROWS, (const float*)(ws + WS_TAB + TAB_ROWW) + (size_t)l * MOE_ROWS, (bf16*)(ws + WS_YF)}};
            DUPRUN(12, (pg8::gemm_phase<pg8::Epi8<FE2_>, pg8::MoeOrder, GA_, GS_>(glds, g, S, E)));
        PH_END(pb + 13)
        }
#undef L_
#define L_ 1
    {
        constexpr int l = L_;
        const int pb = 2 + 14 * l;
        const bool last = (l == DEPTH - 1);
        const int Mpost = last ? TL : TA;
        PH_BEGIN(pb + 0, 2)
            if (l > 0) { DUPRUN(1, ph_convert(k, WSRC, l)); }
            RowArgs ra{INP(I_X), INP(I_CTX), INP(I_NMG), nullptr, nullptr, nullptr};
            ph_rows<0>(k, ra, l, TA);
            if (l == 0 && ((DUP_MASK >> 15) & 1u)) { __syncthreads(); ph_rows<0>(k, ra, l, TA); }
        PH_END(pb + 0)
        PH_BEGIN(pb + 1, 3)
            pg8::Gemm g{(const bf16*)(ws + WS_H), (const bf16*)(ws + WT_IN), TA, NP, DM, 0}; pg8::StaticOrder S; S.init(TA, NP, k.G, k.bid);
            pg8::Epi8<FP_> E{FP_{(bf16*)(ws + WS_P)}};
            DUPRUN(2, (pg8::gemm_phase<pg8::Epi8<FP_>, pg8::StaticOrder, GA_, GS_>(glds, g, S, E)));
        PH_END(pb + 1)
        PH_BEGIN(pb + 2, 4)
            DUPRUN(3, ph_rwkv_prep(k, l, TA, INP(I_MU), INP(I_KK), INP(I_RK)));
            DUPRUN(4, ph_gla_prep(k, l, INP(I_GCONV), INP(I_GAW2), INP(I_GAB)));
        PH_END(pb + 2)
        PH_BEGIN(pb + 3, 5)
            pg8::Gemm g{(const bf16*)(ws + RW_A1), (const bf16*)(ws + WT_L1), TA, 4096, 256, 0}; pg8::StaticOrder S; S.init(TA, 4096, k.G, k.bid);
            pg8::Epi8<FL1_> E{FL1_{(bf16*)(ws + RW_LO), (const float*)(ws + WS_TAB + TAB_TOP)}};
            DUPRUN(5, (pg8::gemm_phase<pg8::Epi8<FL1_>, pg8::StaticOrder, GA_, GS_>(glds, g, S, E)));
        PH_END(pb + 3)
        PH_BEGIN(pb + 4, 6)
#if SPLIT_SCAN
            DUPRUN(6, ph_scan_split(k, l, INP(I_KA)));
#else
            for (int vb = ((k.G & 7) ? k.bid : (k.bid & 7) * (k.G >> 3) + (k.bid >> 3)); vb < 256; vb += k.G) { const int job = vb;
#if RWKV_MODE == 0
                DUPRUN(6, ph_rwkv_scan(k, l, job, INP(I_KA)));
#elif RWKV_MODE == 1
                ph_rwkv_scan(k, l, job, INP(I_KA)); ph_rwkv_chunk(k, l, job, INP(I_KA), WS_H); if (l == 0) rwkv_check_delay(k, job);
#elif RWKV_MODE == 4
                ph_rwkv_scan(k, l, job, INP(I_KA)); ph_rwkv_chunk(k, l, job, INP(I_KA), WS_H); ph_rwkv_chunk(k, l, job, INP(I_KA), WS_END); if (l == 0) rwkv_check_delay(k, job, WS_END);
#elif RWKV_MODE == 5
#pragma unroll 1
                for (int rep = 0; rep < 2; ++rep) { int r_ = rep; asm volatile("" : "+s"(r_)); __syncthreads(); ph_rwkv_chunk(k, l, job, INP(I_KA), r_ ? (size_t)RW_Y : (size_t)WS_H); }
                if (l == 0) rwkv_check_delay(k, job);
#elif RWKV_MODE == 3
                ph_rwkv_scan(k, l, job, INP(I_KA)); ph_rwkv_scan(k, l, job, INP(I_KA), WS_H); if (l == 0) rwkv_check_delay(k, job);
#else
                DUPRUN(6, ph_rwkv_chunk(k, l, job, INP(I_KA)));
#ifdef CHUNK_PROBE
                __syncthreads(); ph_rwkv_chunk<CHUNK_PROBE>(k, l, job, INP(I_KA), WS_END);
#endif
#endif
            }
#ifndef NO_GLA
            FRESH();
            for (int vb = ((k.G & 7) ? k.bid : (k.bid & 7) * (k.G >> 3) + (k.bid >> 3)); vb < 256; vb += k.G) { const int job = vb; DUPRUN(7, ph_gla_scan(k, job)); }
#endif
#endif
        PH_END(pb + 4)
        PH_BEGIN(pb + 5, 7)
            DUPRUN(8, ph_post(k, l, Mpost, INP(I_LNG), INP(I_LNB), INP(I_GNG)));
        PH_END(pb + 5)
        PH_BEGIN(pb + 6, 8)
            pg8::Gemm g{(const bf16*)(ws + RW_A2), (const bf16*)(ws + WT_G2), Mpost, RD, 256, 0}; pg8::StaticOrder S; S.init(Mpost, RD, k.G, k.bid);
            pg8::Epi8<FL2_> E{FL2_{(const bf16*)(ws + RW_R), (bf16*)(ws + RW_V)}};
            DUPRUN(9, (pg8::gemm_phase<pg8::Epi8<FL2_>, pg8::StaticOrder, GA_, GS_>(glds, g, S, E)));
        PH_END(pb + 6)
        PH_BEGIN(pb + 7, 9)
            pg8::Gemm g{(const bf16*)(ws + RW_V), (const bf16*)(ws + WT_A), Mpost, DM, RD, 0}; pg8::StaticOrder S; S.init(Mpost, DM, k.G, k.bid);
            pg8::Epi8<FM_<0>> E{FM_<0>{(const bf16*)(ws + WS_P), (bf16*)(ws + WS_H), (bf16*)(ws + WS_H)}};
            DUPRUN(10, (pg8::gemm_phase<pg8::Epi8<FM_<0>>, pg8::StaticOrder, GA_, GS_>(glds, g, S, E)));
        PH_END(pb + 7)
        PH_BEGIN(pb + 8, 10)
            pg8::Gemm g{(const bf16*)(ws + GL_VS), (const bf16*)(ws + WT_B), Mpost, DM, GVD, 0}; pg8::StaticOrder S; S.init(Mpost, DM, k.G, k.bid);
            pg8::Epi8<FM_<1>> E{FM_<1>{(const bf16*)(ws + WS_P), (bf16*)(ws + WS_H), (bf16*)(ws + WS_H)}};
            pg8::gemm_phase<pg8::Epi8<FM_<1>>, pg8::StaticOrder, GA_, GS_>(glds, g, S, E);
            if ((DUP_MASK >> 17) & 1u) { __syncthreads(); pg8::Epi8<FM_<1>> E2{FM_<1>{(const bf16*)(ws + WS_P), (bf16*)(ws + WS_H), (bf16*)(ws + RW_R)}}; pg8::gemm_phase<pg8::Epi8<FM_<1>>, pg8::StaticOrder, GA_, GS_>(glds, g, S, E2); }
        PH_END(pb + 8)
        PH_BEGIN(pb + 9, 11)
            pg8::Gemm g{(const bf16*)(ws + WS_H), (const bf16*)(ws + WT_O), Mpost, DM, DM, 0}; pg8::StaticOrder S; S.init(Mpost, DM, k.G, k.bid);
#if XBF
            pg8::Epi8<FXb_> E{FXb_{(bf16*)(ws + WS_X), (const float*)(ws + WS_MOD), l}};
            pg8::gemm_phase<pg8::Epi8<FXb_>, pg8::StaticOrder, GA_, GS_>(glds, g, S, E);
#else
            pg8::Epi4<FX_> E{FX_{(float*)(ws + WS_X), (const float*)(ws + WS_MOD), l, (float*)(ws + WS_X)}};
            pg8::gemm_phase<pg8::Epi4<FX_>, pg8::StaticOrder, GA_, GS_>(glds, g, S, E);
#endif
            if (!XBF && ((DUP_MASK >> 18) & 1u)) { __syncthreads(); pg8::Epi4<FX_> E2{FX_{(float*)(ws + WS_X), (const float*)(ws + WS_MOD), l, (float*)(ws + WS_P)}}; pg8::gemm_phase<pg8::Epi4<FX_>, pg8::StaticOrder, GA_, GS_>(glds, g, S, E2); }
        PH_END(pb + 9)
        PH_BEGIN(pb + 10, 12)
            RowArgs ra{nullptr, nullptr, INP(I_NFG), INP(I_RW), INP(I_RB), nullptr};
            ph_rows<1>(k, ra, l, Mpost);
            if ((DUP_MASK >> 16) & 1u) { __syncthreads(); ph_rows<1>(k, ra, l, Mpost, true); }
        PH_END(pb + 10)
        PH_BEGIN(pb + 11, 13)
            DUPRUN(13, ph_moe_scatter(k, l, Mpost));
        PH_END(pb + 11)
        PH_BEGIN(pb + 12, 14)
#if MOE_GATHER
            pg8::Gemm g{(const bf16*)(ws + WS_H), (const bf16*)(ws + WT_GU), 0, 2816, DM, (size_t)2816 * DM * 2};
            pg8::MoeOrderT<true> S; S.rowtok = (const int*)(ws + WS_TAB + TAB_ROWTOK) + (size_t)l * MOE_ROWS;
            S.init((const int*)(ws + WS_TAB + TAB_TILE) + 256 * l, 11, k.G, ((k.G & 7) ? k.bid : (k.bid & 7) * (k.G >> 3) + (k.bid >> 3)));
            pg8::EpiGU<FE1_> E{FE1_{(bf16*)(ws + WS_ACT)}};
            DUPRUN(11, (pg8::gemm_phase<pg8::EpiGU<FE1_>, pg8::MoeOrderT<true>, GA_, GS_>(glds, g, S, E)));
#else
            pg8::Gemm g{(const bf16*)(ws + WS_HP), (const bf16*)(ws + WT_GU), 0, 2816, DM, (size_t)2816 * DM * 2};
            pg8::MoeOrder S; S.init((const int*)(ws + WS_TAB + TAB_TILE) + 256 * l, 11, k.G, ((k.G & 7) ? k.bid : (k.bid & 7) * (k.G >> 3) + (k.bid >> 3)));
            pg8::EpiGU<FE1_> E{FE1_{(bf16*)(ws + WS_ACT)}};
            DUPRUN(11, (pg8::gemm_phase<pg8::EpiGU<FE1_>, pg8::MoeOrder, GA_, GS_>(glds, g, S, E)));
#endif
        PH_END(pb + 12)
        PH_BEGIN(pb + 13, 15)
            pg8::Gemm g{(const bf16*)(ws + WS_ACT), (const bf16*)(ws + WT_D), 0, DM, DEXP, (size_t)DM * DEXP * 2};
            pg8::MoeOrder S; S.init((const int*)(ws + WS_TAB + TAB_TILE) + 256 * l, 8, k.G, ((k.G & 7) ? k.bid : (k.bid & 7) * (k.G >> 3) + (k.bid >> 3)));
            pg8::Epi8<FE2_> E{FE2_{(const int*)(ws + WS_TAB + TAB_ROWTOK) + (size_t)l * MOE_ROWS, (const float*)(ws + WS_TAB + TAB_ROWW) + (size_t)l * MOE_ROWS, (bf16*)(ws + WS_YF)}};
            DUPRUN(12, (pg8::gemm_phase<pg8::Epi8<FE2_>, pg8::MoeOrder, GA_, GS_>(glds, g, S, E)));
        PH_END(pb + 13)
        }
#undef L_
#if EXTRA_BARS
    if (hi - lo > 1) { for (int i = 0; i < EXTRA_BARS; ++i) xcd_barrier(bar); }
#endif
    PH_BEGIN(NPHASE - 1, 16)
        RowArgs ra{nullptr, nullptr, INP(I_FNG), nullptr, nullptr, (float*)INP(N_IN)};
        DUPRUN(14, ph_rows<2>(k, ra, 0, TL));
    PH_END(NPHASE - 1)
}

#ifndef MK_SINGLE
#define MK_SINGLE 1
#endif
extern "C" void kernel_launch(void* const* d_in, const int* in_sizes, int n_in, void* d_out, int out_size, void* d_ws, size_t ws_size, hipStream_t stream) {
    static int grid = 0;
    if (grid == 0) {
        if (n_in != N_IN || out_size != TL * DM || ws_size < WS_END) { fprintf(stderr, "kernel_launch: unexpected problem (n_in %d out %d ws %zu need %zu)\n", n_in, out_size, ws_size, (size_t)WS_END); grid = -1; return; }
        int dev = 0, cus = 0;
        if (hipGetDevice(&dev) != hipSuccess || hipDeviceGetAttribute(&cus, hipDeviceAttributeMultiprocessorCount, dev) != hipSuccess) { grid = -1; return; }
        if (hipFuncSetAttribute((const void*)fwd, hipFuncAttributeMaxDynamicSharedMemorySize, LDS_BYTES) != hipSuccess) { grid = -1; return; }
        int per_cu = 0;
        if (hipOccupancyMaxActiveBlocksPerMultiprocessor(&per_cu, (const void*)fwd, 512, LDS_BYTES) != hipSuccess || per_cu < 1) fprintf(stderr, "kernel_launch: occupancy query says %d\n", per_cu);
        (void)hipGetLastError();
        grid = cus;
    }
    if (grid < 0) return;
    unsigned char* ws = (unsigned char*)d_ws;
    (void)hipMemsetAsync(ws + WS_CTL, 0, CTL_BYTES, stream);
    Args a{};
    for (int i = 0; i < N_IN; ++i) a.in[i] = (const float*)d_in[i];
    a.out = (float*)d_out; a.ws = ws;
#if MK_SINGLE
    a.ph_lo = 0; a.ph_hi = NPHASE;
    hipLaunchKernelGGL(fwd, dim3(grid), dim3(512), LDS_BYTES, stream, a);
#else
    for (int p = 0; p < NPHASE; ++p) { a.ph_lo = p; a.ph_hi = p + 1; hipLaunchKernelGGL(fwd, dim3(grid), dim3(512), LDS_BYTES, stream, a); }
#endif
}
```

```cpp
#include <hip/hip_runtime.h>
#include <cstdio>
#include <cstdint>

#define LAS __attribute__((address_space(3)))
#define GAS __attribute__((address_space(1)))
typedef unsigned short bf16;
typedef float f32x4 __attribute__((ext_vector_type(4)));
typedef float f32x2 __attribute__((ext_vector_type(2)));
typedef unsigned u32x4 __attribute__((ext_vector_type(4)));
typedef unsigned u32x2 __attribute__((ext_vector_type(2)));
typedef short bf16x8 __attribute__((ext_vector_type(8)));

constexpr int DM = 2048, NBATCH = 8, SEQ = 2048, CTXL = 256, DEPTH = 2;
constexpr int TL = NBATCH * SEQ, TC = NBATCH * CTXL, TA = TL + TC;
constexpr int RD = 1024, RHEADS = 16, RHS = 64;
constexpr int RWKV_IN = 3520;
constexpr int GKD = 512, GVD = 1024, GDK = 128, GDV = 256, GHEADS = 4, GQKV = 2048;
constexpr int GLA_OFF = 3520, GLA_AD_OFF = GLA_OFF + GQKV, GLA_GATE_OFF = 5584, BR_OFF = 6608, IN_DIM = 10704, NP = 10752;
constexpr int NEXP = 16, DEXP = 1408;
constexpr int MOD_N = 6 * DM;
constexpr int MOE_ROWS = 41216;
constexpr int MOE_TILES = MOE_ROWS / 256;
constexpr int NCH = 36;
constexpr int KSPLIT = 32;

enum { I_X = 0, I_C, I_CTX, I_CCTX, I_WADA, I_BADA, I_NMG, I_NFG, I_WIN, I_MU, I_W0, I_W2, I_A0, I_A2, I_G2, I_KK, I_KA, I_RK, I_LNG, I_LNB,
       I_GCONV, I_GAW2, I_GAB, I_GNG, I_WBA, I_WBB, I_WOUT, I_RW, I_RB, I_EG, I_EU, I_ED, I_FNG, N_IN };

constexpr size_t MiB = 1u << 20;
constexpr size_t WS_CTL = 0;
constexpr size_t WS_TAB = 1 * MiB;
constexpr size_t WS_MOD = 2 * MiB;
constexpr size_t WS_X = 3 * MiB;
constexpr size_t WS_H = WS_X + 144 * MiB;
constexpr size_t WS_P = WS_H + 72 * MiB;
constexpr size_t WS_RW = WS_P + 378 * MiB;
constexpr size_t WS_GL = WS_RW + 380 * MiB;
constexpr size_t WS_WT = WS_GL + 218 * MiB;
constexpr size_t WS_END = WS_WT + 325 * MiB;
constexpr int CW_TMO = 0, CW_CNT = 64  , CW_BAR = 4096;
constexpr size_t CTL_BYTES = 1 * MiB;
constexpr size_t TAB_ROWTOK = 0;
constexpr size_t TAB_ROWTOK_BYTES = 2 * (size_t)MOE_ROWS * 4;
constexpr size_t TAB_ROWW = 384 * 1024;
constexpr size_t TAB_TILE = 768 * 1024;
constexpr size_t TAB_TOP = 800 * 1024;
static_assert(TAB_ROWTOK_BYTES <= TAB_ROWW && TAB_ROWW + 2 * (size_t)MOE_ROWS * 4 <= TAB_TILE, "tab map");
constexpr size_t WS_MODP = WS_P;
constexpr size_t WS_HP = WS_P;
constexpr size_t WS_ACT = WS_P + 162 * MiB;
constexpr size_t WS_TOPK = WS_P + 274 * MiB;
static_assert((size_t)MOE_ROWS * DM * 2 <= 162 * MiB && (size_t)MOE_ROWS * DEXP * 2 <= 112 * MiB && 274 * MiB + 3 * (size_t)TA * 8 <= 378 * MiB, "P overlay");
constexpr size_t RW_R = WS_RW;
constexpr size_t RW_KS = RW_R + 36 * MiB;
constexpr size_t RW_V = RW_KS + 36 * MiB;
constexpr size_t RW_KK = RW_V + 36 * MiB;
constexpr size_t RW_LO = RW_KK + 36 * MiB;
constexpr size_t RW_Y = RW_LO + 144 * MiB;
constexpr size_t RW_A1 = RW_Y + 72 * MiB;
constexpr size_t RW_A2 = RW_A1 + 9 * MiB;
constexpr size_t RW_BON = RW_A2 + 9 * MiB;
static_assert(RW_BON + 2 * MiB <= WS_GL, "rwkv map");
constexpr size_t GL_QG = WS_GL;
constexpr size_t GL_KG = GL_QG + 36 * MiB;
constexpr size_t GL_KE = GL_KG + 36 * MiB;
constexpr size_t GL_VS = GL_KE + 36 * MiB;
constexpr size_t GL_O = GL_VS + 36 * MiB;
constexpr size_t GL_DEC = GL_O + 72 * MiB;
static_assert(GL_DEC + 2 * MiB <= WS_WT, "gla map");
constexpr size_t WS_YF = WS_GL;
constexpr size_t WT_IN = WS_WT;
constexpr size_t WT_L1 = WT_IN + 42 * MiB;
constexpr size_t WT_G2 = WT_L1 + 2 * MiB;
constexpr size_t WT_A = WT_G2 + 1 * MiB;
constexpr size_t WT_B = WT_A + 4 * MiB;
constexpr size_t WT_O = WT_B + 4 * MiB;
constexpr size_t WT_GU = WT_O + 8 * MiB;
constexpr size_t WT_D = WT_GU + 176 * MiB;
static_assert(WT_D + 88 * MiB == WS_END, "weight map");

#ifndef MOE_GATHER
#define MOE_GATHER 1
#endif
#ifndef XBF
#define XBF 1
#endif
__device__ __forceinline__ float bf2f(unsigned v) { return __uint_as_float(v << 16); }
__device__ __forceinline__ float bflo(unsigned w) { return __uint_as_float(w << 16); }
__device__ __forceinline__ float bfhi(unsigned w) { return __uint_as_float(w & 0xffff0000u); }
__device__ __forceinline__ unsigned f2bf(float f) { unsigned u = __float_as_uint(f); return (u + 0x7fffu + ((u >> 16) & 1u)) >> 16; }
__device__ __forceinline__ unsigned pk2(float lo, float hi) { unsigned r; asm volatile("v_cvt_pk_bf16_f32 %0, %1, %2" : "=v"(r) : "v"(lo), "v"(hi)); return r; }
typedef __bf16 bf16x2_t __attribute__((ext_vector_type(2)));
__device__ __forceinline__ unsigned pk2c(float lo, float hi) { f32x2 v = {lo, hi}; bf16x2_t b = __builtin_convertvector(v, bf16x2_t); return __builtin_bit_cast(unsigned, b); }
__device__ __forceinline__ float sigm(float x) { return 1.0f / (1.0f + __expf(-x)); }
__device__ __forceinline__ float siluf(float x) { return x * sigm(x); }
__device__ __forceinline__ float wave_sum(float x) {
    x += __builtin_bit_cast(float, __builtin_amdgcn_update_dpp(0, __builtin_bit_cast(int, x), 0xB1, 0xF, 0xF, true));
    x += __builtin_bit_cast(float, __builtin_amdgcn_update_dpp(0, __builtin_bit_cast(int, x), 0x4E, 0xF, 0xF, true));
    x += __builtin_bit_cast(float, __builtin_amdgcn_update_dpp(0, __builtin_bit_cast(int, x), 0x141, 0xF, 0xF, true));
    x += __builtin_bit_cast(float, __builtin_amdgcn_update_dpp(0, __builtin_bit_cast(int, x), 0x140, 0xF, 0xF, true));
    const int xi = __builtin_bit_cast(int, x);
    return (__builtin_bit_cast(float, __builtin_amdgcn_readlane(xi, 0)) + __builtin_bit_cast(float, __builtin_amdgcn_readlane(xi, 16))) +
           (__builtin_bit_cast(float, __builtin_amdgcn_readlane(xi, 32)) + __builtin_bit_cast(float, __builtin_amdgcn_readlane(xi, 48)));
}
__device__ __forceinline__ void unpack8(const u32x4 w, float (&o)[8]) {
    o[0] = bflo(w.x); o[1] = bfhi(w.x); o[2] = bflo(w.y); o[3] = bfhi(w.y); o[4] = bflo(w.z); o[5] = bfhi(w.z); o[6] = bflo(w.w); o[7] = bfhi(w.w);
}
__device__ __forceinline__ u32x4 pack8(const float (&v)[8]) { u32x4 w; w.x = pk2(v[0], v[1]); w.y = pk2(v[2], v[3]); w.z = pk2(v[4], v[5]); w.w = pk2(v[6], v[7]); return w; }
namespace pg8 {
#define PG8_LAS __attribute__((address_space(3)))
typedef unsigned short bf16_t;
typedef short bf16x8 __attribute__((ext_vector_type(8)));
typedef float f32x4 __attribute__((ext_vector_type(4)));
typedef unsigned u32x4 __attribute__((ext_vector_type(4)));
constexpr int BM = 256, BK = 64, HALF = 128, HTB = HALF * BK * 2  , STAGE_BYTES = 8 * HTB, NXCD = 8, WGM = 8;

__host__ __device__ __forceinline__ int lds_byte(int r, int c) { const int st = (r >> 4) * 2 + (c >> 5), rr = r & 15, cc = c & 31, ob = rr * 64 + cc * 2; return st * 1024 + (ob ^ (((ob >> 9) & 1) << 5)); }
__host__ __device__ __forceinline__ void stage_rc(int b, int& R, int& C) { const int st = b / 1024, sb = b % 1024, swz = sb ^ (((sb >> 9) & 1) << 5); R = (st >> 1) * 16 + swz / 64; C = (st & 1) * 32 + (swz % 64) / 2; }
__host__ __device__ __forceinline__ int perm32(int rho) { const int n = rho >> 4, i = rho & 15; return 8 * (i >> 2) + 4 * n + (i & 3); }
struct Unit { int pm, pn, eb; };
struct Gemm { const bf16_t* A; const bf16_t* Bt; int M, N, K; size_t bstride; };

struct StaticOrder {
    static constexpr bool GATHER = false;
    int nM, nN, nwg, G, c;
    __host__ __device__ void init(int M, int N, int G_, int c_) { nM = M / BM; nN = N / BM; nwg = nM * nN; G = G_; c = c_; }
    __host__ __device__ bool next(int i, Unit& u) const {
        const long L = (long)i * G + c; if (L >= nwg) return false;
        int wgid = (int)L; { const int q = nwg / NXCD, r = nwg % NXCD, xcd = wgid % NXCD, off = wgid / NXCD; wgid = (xcd < r ? xcd * (q + 1) : r * (q + 1) + (xcd - r) * q) + off; }
        const int nig = WGM * nN, gid = wgid / nig, fm = gid * WGM, gsz = (nM - fm) < WGM ? (nM - fm) : WGM;
        u.pm = fm + ((wgid % nig) % gsz); u.pn = (wgid % nig) / gsz; u.eb = 0; return true;
    }
    __device__ __forceinline__ void a_ready(const Unit&) const {}
    __device__ __forceinline__ void done(const Unit&) const {}
};
template <bool GATHER_> struct MoeOrderT {
    static constexpr bool GATHER = GATHER_;
    const int* rowtok;
    const int* tab; int nT, nN, G, c;
    __device__ void init(const int* tab_, int nN_, int G_, int c_) { tab = tab_; nT = tab_[0]; nN = nN_; G = G_; c = c_; }
    __device__ bool next(int i, Unit& u) const {
        const long L = (long)i * G + c; if (L >= (long)nT * nN) return false;
        u.pm = (int)(L / nN); u.pn = (int)(L % nN); u.eb = tab[1 + u.pm]; return true;
    }
    __device__ __forceinline__ void a_ready(const Unit&) const {}
    __device__ __forceinline__ void done(const Unit&) const {}
};
using MoeOrder = MoeOrderT<false>;

template <class F> struct Epi8 {
    static constexpr bool PERM = true, AFTER_DRAIN = false;
    F f;
    __device__ __forceinline__ void operator()(const f32x4 (&acc)[2][2][4][2], const Unit& u, int wr, int wc, int fr, int fq) const {
        const int row0 = u.pm * BM + wr * 64 + fr, col0 = u.pn * BM + wc * 32 + 8 * fq;
#pragma unroll
        for (int ai = 0; ai < 2; ++ai)
#pragma unroll
            for (int m = 0; m < 4; ++m) {
#pragma unroll
                for (int bj = 0; bj < 2; ++bj) {
                    const f32x4 a = acc[ai][bj][m][0], b = acc[ai][bj][m][1];
                    float v[8] = {a[0], a[1], a[2], a[3], b[0], b[1], b[2], b[3]};
                    f(row0 + ai * HALF + m * 16, col0 + bj * HALF, v, u);
                }
            }
    }
};
template <class F> struct EpiGU {
    static constexpr bool PERM = true, AFTER_DRAIN = false;
    F f;
    __device__ __forceinline__ void operator()(const f32x4 (&acc)[2][2][4][2], const Unit& u, int wr, int wc, int fr, int fq) const {
        const int row0 = u.pm * BM + wr * 64 + fr, col0 = u.pn * HALF + wc * 32 + 8 * fq;
#pragma unroll
        for (int ai = 0; ai < 2; ++ai)
#pragma unroll
            for (int m = 0; m < 4; ++m) {
                const f32x4 g0 = acc[ai][0][m][0], g1 = acc[ai][0][m][1], u0 = acc[ai][1][m][0], u1 = acc[ai][1][m][1];
                float g[8] = {g0[0], g0[1], g0[2], g0[3], g1[0], g1[1], g1[2], g1[3]};
                float up[8] = {u0[0], u0[1], u0[2], u0[3], u1[0], u1[1], u1[2], u1[3]};
                f(row0 + ai * HALF + m * 16, col0, g, up);
            }
    }
};
template <class F> struct Epi4 {
    static constexpr bool PERM = false, AFTER_DRAIN = false;
    F f;
    __device__ __forceinline__ void operator()(const f32x4 (&acc)[2][2][4][2], const Unit& u, int wr, int wc, int fr, int fq) const {
        const int row0 = u.pm * BM + wr * 64 + fr, col0 = u.pn * BM + wc * 32 + 4 * fq;
#pragma unroll
        for (int ai = 0; ai < 2; ++ai)
#pragma unroll
            for (int m = 0; m < 4; ++m) {
#pragma unroll
                for (int bj = 0; bj < 2; ++bj)
#pragma unroll
                    for (int n = 0; n < 2; ++n) f(row0 + ai * HALF + m * 16, col0 + bj * HALF + n * 16, acc[ai][bj][m][n], u);
            }
    }
};
template <class Epi, class Sched, bool ALIGN_EPI = false, bool SP2 = false>
__device__ __forceinline__ void gemm_phase(PG8_LAS unsigned char* lds, const Gemm g, const Sched& S, const Epi& E) {
    int tid_o = threadIdx.x; asm volatile("" : "+v"(tid_o));
    const int tid = tid_o, wid = __builtin_amdgcn_readfirstlane(tid >> 6), lane = tid & 63, wr = wid >> 2, wc = wid & 3, fr = lane & 15, fq = lane >> 4;
    const int K = g.K, nt = K / BK;
    unsigned voffA[2], voffB[2];
#pragma unroll
    for (int i = 0; i < 2; ++i) { int R, C; stage_rc(tid * 16 + i * 8192, R, C); const int Rb = Epi::PERM ? ((R & ~31) + perm32(R & 31)) : R;
        voffA[i] = (unsigned)(R * K + C) * 2u; voffB[i] = (unsigned)(Rb * K + C) * 2u; }
    constexpr bool GATHER = Sched::GATHER;
    unsigned vA0[2] = {0u, 0u}, vA1[2] = {0u, 0u}, nA0[2] = {0u, 0u}, nA1[2] = {0u, 0u};
    const size_t kstep = (size_t)(BK * 2);
    const size_t hstep = (size_t)HALF * K * 2;
    const size_t tstep = 2 * hstep;
    const unsigned ldsw = (unsigned)wid * 1024u;
    const int aoff = lds_byte(wr * 64 + fr, fq * 8), boff = lds_byte(wc * 32 + fr, fq * 8);
#define PG8_SA(b, h) (((b) * 2 + (h)) * HTB)
#define PG8_SB(b, h) ((4 + (b) * 2 + (h)) * HTB)
#define PG8_STAGE(bufoff, gbase, voff) do { _Pragma("unroll") for (int _i = 0; _i < 2; ++_i) \
        __builtin_amdgcn_global_load_lds((const unsigned*)((const char*)(gbase) + (voff)[_i]), (PG8_LAS unsigned*)(lds + (bufoff) + ldsw + _i * 8192), 16, 0, 0); } while (0)
#define PG8_STAGE_A(bufoff, gptr, h, nx) do { if constexpr (GATHER) { unsigned go_[2]; _Pragma("unroll") for (int _j = 0; _j < 2; ++_j) go_[_j] = ((nx) && last_) ? ((h) ? nA1[_j] : nA0[_j]) : ((h) ? vA1[_j] : vA0[_j]); PG8_STAGE(bufoff, gptr, go_); } \
        else { PG8_STAGE(bufoff, (gptr) + (h) * hstep, voffA); } } while (0)
#define PG8_GOFS(u, o0, o1) do { const int* rt_ = S.rowtok + (size_t)(u).pm * BM; _Pragma("unroll") for (int _j = 0; _j < 2; ++_j) { int R_, C_; stage_rc(tid * 16 + _j * 8192, R_, C_); \
        const int t0_ = rt_[R_], t1_ = rt_[HALF + R_]; o0[_j] = (unsigned)((t0_ < 0 ? 0 : t0_ >> 1) * K + C_) * 2u; o1[_j] = (unsigned)((t1_ < 0 ? 0 : t1_ >> 1) * K + C_) * 2u; } } while (0)
#define PG8_LDA(dst, b, h) do { _Pragma("unroll") for (int m = 0; m < 4; ++m) _Pragma("unroll") for (int k = 0; k < 2; ++k) dst[m][k] = *(const PG8_LAS bf16x8*)(lds + PG8_SA(b, h) + aoff + m * 2048 + k * 1024); } while (0)
#define PG8_LDB(dst, b, h) do { _Pragma("unroll") for (int n = 0; n < 2; ++n) _Pragma("unroll") for (int k = 0; k < 2; ++k) dst[n][k] = *(const PG8_LAS bf16x8*)(lds + PG8_SB(b, h) + boff + n * 2048 + k * 1024); } while (0)
#define PG8_MMA(ai, bj, At, Bt) do { __builtin_amdgcn_s_setprio(1); _Pragma("unroll") for (int m = 0; m < 4; ++m) _Pragma("unroll") for (int n = 0; n < 2; ++n) _Pragma("unroll") for (int k = 0; k < 2; ++k) \
        acc[ai][bj][m][n] = __builtin_amdgcn_mfma_f32_16x16x32_bf16(Bt[n][k], At[m][k], acc[ai][bj][m][n], 0, 0, 0); __builtin_amdgcn_s_setprio(0); } while (0)
#define PG8_WAIT_V(n) asm volatile("s_waitcnt vmcnt(" #n ")" ::: "memory")
#define PG8_WAIT_L(n) asm volatile("s_waitcnt lgkmcnt(" #n ")" ::: "memory")
#define PG8_BAR __builtin_amdgcn_s_barrier()
#define PG8_SCHED __builtin_amdgcn_sched_barrier(0)
    Unit cur, nxt; int ui = 0;
    if (!S.next(0, cur)) return;
    f32x4 acc[2][2][4][2];
#pragma unroll
    for (int a = 0; a < 2; ++a)
#pragma unroll
        for (int b = 0; b < 2; ++b)
#pragma unroll
            for (int m = 0; m < 4; ++m)
#pragma unroll
                for (int n = 0; n < 2; ++n) acc[a][b][m][n] = (f32x4){0.f, 0.f, 0.f, 0.f};
    bf16x8 At[4][2], B0[2][2], B1[2][2];
    const char* cA = GATHER ? (const char*)g.A : (const char*)g.A + (size_t)cur.pm * tstep; const char* cB = (const char*)g.Bt + (size_t)cur.eb * g.bstride + (size_t)cur.pn * tstep;
    S.a_ready(cur);
    if constexpr (GATHER) PG8_GOFS(cur, vA0, vA1);
    constexpr bool last_ = false;
    if constexpr (SP2) {
        PG8_STAGE(PG8_SB(0, 0), cB, voffB); PG8_STAGE(PG8_SB(0, 1), cB + hstep, voffB); PG8_STAGE_A(PG8_SA(0, 0), cA, 0, 0); PG8_STAGE_A(PG8_SA(0, 1), cA, 1, 0);
        if (wr == 1) PG8_BAR;
        PG8_WAIT_V(2); PG8_BAR;
        PG8_STAGE(PG8_SB(1, 0), cB + kstep, voffB); PG8_STAGE_A(PG8_SA(1, 0), cA + kstep, 0, 0); PG8_STAGE(PG8_SB(1, 1), cB + hstep + kstep, voffB);
        PG8_WAIT_V(6); PG8_BAR;
    } else {
        PG8_STAGE(PG8_SB(0, 0), cB, voffB); PG8_STAGE_A(PG8_SA(0, 0), cA, 0, 0); PG8_STAGE(PG8_SB(0, 1), cB + hstep, voffB); PG8_STAGE_A(PG8_SA(0, 1), cA, 1, 0);
        if (wr == 1) PG8_BAR;
        PG8_WAIT_V(4); PG8_BAR;
        PG8_STAGE(PG8_SB(1, 0), cB + kstep, voffB); PG8_STAGE_A(PG8_SA(1, 0), cA + kstep, 0, 0); PG8_STAGE(PG8_SB(1, 1), cB + hstep + kstep, voffB);
        PG8_WAIT_V(6); PG8_BAR;
    }
    for (;;) {
        const bool has_next = S.next(ui + 1, nxt);
        const char* nA = (has_next && !GATHER) ? (const char*)g.A + (size_t)nxt.pm * tstep : cA;
        if constexpr (GATHER) { if (has_next) PG8_GOFS(nxt, nA0, nA1); else { _Pragma("unroll") for (int _j = 0; _j < 2; ++_j) { nA0[_j] = vA0[_j]; nA1[_j] = vA1[_j]; } } } const char* nB = has_next ? (const char*)g.Bt + (size_t)nxt.eb * g.bstride + (size_t)nxt.pn * tstep : cB;
#pragma nounroll
        for (int t = 0; t < nt; t += 2) {
            const bool last = (t == nt - 2); const bool last_ = last;
            const char* a1 = cA + (size_t)(t + 1) * kstep;
            const char* a2 = last ? nA : cA + (size_t)(t + 2) * kstep; const char* b2 = last ? nB : cB + (size_t)(t + 2) * kstep;
            const char* a3 = a2 + kstep; const char* b3 = b2 + kstep;
            if (last && has_next) S.a_ready(nxt);
            if constexpr (SP2) {
            PG8_LDB(B0, 0, 0); PG8_LDB(B1, 0, 1); PG8_SCHED; PG8_LDA(At, 0, 0); PG8_STAGE_A(PG8_SA(1, 1), a1, 1, 0);
            PG8_WAIT_V(8); PG8_WAIT_L(0); PG8_BAR; PG8_MMA(0, 0, At, B0); PG8_MMA(0, 1, At, B1); PG8_BAR; PG8_SCHED;
            PG8_LDA(At, 0, 1); PG8_STAGE(PG8_SB(0, 0), b2, voffB); PG8_STAGE(PG8_SB(0, 1), b2 + hstep, voffB); PG8_STAGE_A(PG8_SA(0, 0), a2, 0, 1);
            PG8_WAIT_V(8); PG8_WAIT_L(0); PG8_BAR; PG8_MMA(1, 0, At, B0); PG8_MMA(1, 1, At, B1); PG8_BAR; PG8_SCHED;
            PG8_LDB(B0, 1, 0); PG8_LDB(B1, 1, 1); PG8_SCHED; PG8_LDA(At, 1, 0); PG8_STAGE_A(PG8_SA(0, 1), a2, 1, 1);
            PG8_WAIT_V(8); PG8_WAIT_L(0); PG8_BAR; PG8_MMA(0, 0, At, B0); PG8_MMA(0, 1, At, B1); PG8_BAR; PG8_SCHED;
            PG8_LDA(At, 1, 1); PG8_STAGE(PG8_SB(1, 0), b3, voffB); PG8_STAGE(PG8_SB(1, 1), b3 + hstep, voffB); PG8_STAGE_A(PG8_SA(1, 0), a3, 0, 1);
            PG8_WAIT_V(8); PG8_WAIT_L(0); PG8_BAR; PG8_MMA(1, 0, At, B0); PG8_MMA(1, 1, At, B1); PG8_BAR; PG8_SCHED;
            } else {
            PG8_LDB(B0, 0, 0); PG8_SCHED; PG8_LDA(At, 0, 0); PG8_STAGE_A(PG8_SA(1, 1), a1, 1, 0);
            PG8_WAIT_L(8); PG8_BAR; PG8_WAIT_L(0); PG8_MMA(0, 0, At, B0); PG8_BAR; PG8_SCHED;
            PG8_LDB(B1, 0, 1); PG8_STAGE(PG8_SB(0, 0), b2, voffB);
            PG8_BAR; PG8_WAIT_L(0); PG8_MMA(0, 1, At, B1); PG8_BAR;
            PG8_LDA(At, 0, 1); PG8_STAGE_A(PG8_SA(0, 0), a2, 0, 1);
            PG8_BAR; PG8_WAIT_L(0); PG8_MMA(1, 0, At, B0); PG8_BAR; PG8_SCHED;
            PG8_STAGE(PG8_SB(0, 1), b2 + hstep, voffB);
            PG8_WAIT_V(6); PG8_BAR; PG8_MMA(1, 1, At, B1); PG8_BAR;
            PG8_LDB(B0, 1, 0); PG8_SCHED; PG8_LDA(At, 1, 0); PG8_STAGE_A(PG8_SA(0, 1), a2, 1, 1);
            PG8_WAIT_L(8); PG8_BAR; PG8_WAIT_L(0); PG8_MMA(0, 0, At, B0); PG8_BAR; PG8_SCHED;
            PG8_LDB(B1, 1, 1); PG8_STAGE(PG8_SB(1, 0), b3, voffB);
            PG8_BAR; PG8_WAIT_L(0); PG8_MMA(0, 1, At, B1); PG8_BAR;
            PG8_LDA(At, 1, 1); PG8_STAGE_A(PG8_SA(1, 0), a3, 0, 1);
            PG8_BAR; PG8_WAIT_L(0); PG8_MMA(1, 0, At, B0); PG8_BAR; PG8_SCHED;
            PG8_STAGE(PG8_SB(1, 1), b3 + hstep, voffB);
            PG8_WAIT_V(6); PG8_BAR; PG8_MMA(1, 1, At, B1); PG8_BAR;
            }
        }
        if constexpr (ALIGN_EPI) { if (wr == 0) PG8_BAR; }
        if constexpr (!Epi::AFTER_DRAIN) { E(acc, cur, wr, wc, fr, fq); S.done(cur); }
        if (!has_next) break;
#pragma unroll
        for (int a = 0; a < 2; ++a)
#pragma unroll
            for (int b = 0; b < 2; ++b)
#pragma unroll
                for (int m = 0; m < 4; ++m)
#pragma unroll
                    for (int n = 0; n < 2; ++n) acc[a][b][m][n] = (f32x4){0.f, 0.f, 0.f, 0.f};
        cur = nxt; cA = nA; cB = nB; ++ui;
        if constexpr (GATHER) { _Pragma("unroll") for (int _j = 0; _j < 2; ++_j) { vA0[_j] = nA0[_j]; vA1[_j] = nA1[_j]; } }
        if constexpr (ALIGN_EPI) { if (wr == 1) PG8_BAR; }
    }
    PG8_WAIT_V(0);
    if constexpr (!ALIGN_EPI) { if (wr == 0) PG8_BAR; }
    PG8_BAR;
    if constexpr (Epi::AFTER_DRAIN) { E.fused(acc, cur, wr, wc, fr, fq, lds, wid, lane); S.done(cur); }
#undef PG8_SA
#undef PG8_SB
#undef PG8_STAGE
#undef PG8_STAGE_A
#undef PG8_GOFS
#undef PG8_LDA
#undef PG8_LDB
#undef PG8_MMA
#undef PG8_WAIT_V
#undef PG8_WAIT_L
#undef PG8_BAR
#undef PG8_SCHED
}
}

#ifndef PG8_SP2
#define PG8_SP2 true
#endif
#ifndef PG8_ALIGN
#define PG8_ALIGN true
#endif
#define XB_TMO      128
#define XB_XCNT(j)  (256  + 64 * (j))
#define XB_XSUB(j)  (1280 + 64 * (j))
#define XB_XGEN(j)  (2304 + 64 * (j))
#define XB_TOP      3328
#define XB_TOPGEN   3392
#define XCD_BAR_WORDS 3456
#define XB_SPIN_CAP (1u << 18)

__device__ __forceinline__ unsigned xb_ld(unsigned* p)              { return __hip_atomic_load(p, __ATOMIC_RELAXED, __HIP_MEMORY_SCOPE_AGENT); }
__device__ __forceinline__ unsigned xb_add(unsigned* p, unsigned v) { return __hip_atomic_fetch_add(p, v, __ATOMIC_RELAXED, __HIP_MEMORY_SCOPE_AGENT); }
__device__ __forceinline__ unsigned xb_xcc_id() { return (unsigned)__builtin_amdgcn_s_getreg((3 << 11) | 20) & 0xFu; }
#define XB_SPIN(cond, bar) do { unsigned _sp = 0; while (cond) { __builtin_amdgcn_s_sleep(1); \
    if ((++_sp & 255u) == 0u) { if (xb_ld(&(bar)[XB_TMO])) break; if (_sp > XB_SPIN_CAP) { atomicAdd(&(bar)[XB_TMO], 1u); break; } } } } while (0)

struct XcdBarrier {
    unsigned* bar; unsigned x;
    volatile LAS unsigned* st;
};

__device__ __forceinline__ XcdBarrier xcd_barrier_post(unsigned* bar, volatile LAS unsigned* st) {
    XcdBarrier b; b.bar = bar; b.x = xb_xcc_id(); b.st = st;
    if (threadIdx.x == 0) (void)xb_add(&bar[XB_XCNT(b.x)], 1u);
    return b;
}
__device__ __forceinline__ void xcd_barrier_complete(unsigned* bar, unsigned x, unsigned& nloc, unsigned& nx) {
    const unsigned G = gridDim.x * gridDim.y * gridDim.z;
    unsigned sum, cnt, mine, sp = 0u;
    for (;;) {
        sum = 0u; cnt = 0u; mine = 0u;
#pragma unroll
        for (unsigned j = 0; j < 16; ++j) { const unsigned c = xb_ld(&bar[XB_XCNT(j)]); sum += c; cnt += (c > 0u) ? 1u : 0u; mine = (j == x) ? c : mine; }
        if (sum == G) break;
        __builtin_amdgcn_s_sleep(1);
        if ((++sp & 255u) == 0u) { if (xb_ld(&bar[XB_TMO])) break; if (sp > XB_SPIN_CAP) { atomicAdd(&bar[XB_TMO], 1u); break; } }
    }
    nloc = mine > 0u ? mine : 1u; nx = cnt > 0u ? cnt : 1u;
}

__device__ __forceinline__ void xcd_barrier(const XcdBarrier& b) {
    asm volatile("s_waitcnt vmcnt(0)" ::: "memory");
    __syncthreads();
    if (threadIdx.x == 0) {
        unsigned* bar = b.bar;
        __builtin_amdgcn_s_waitcnt(0);
        unsigned nloc = b.st[0], nx = b.st[1];
        if (nloc == 0u) { xcd_barrier_complete(bar, b.x, nloc, nx); b.st[0] = nloc; b.st[1] = nx; }
        const unsigned old = xb_add(&bar[XB_XSUB(b.x)], 1u);
        const unsigned gen = old / nloc;
        if (old + 1u == (gen + 1u) * nloc) {
            __builtin_amdgcn_fence(__ATOMIC_RELEASE, "agent");
            asm volatile("s_waitcnt vmcnt(0)" ::: "memory");
            const unsigned og = xb_add(&bar[XB_TOP], 1u);
            const unsigned tg = og / nx;
            if (og + 1u == (tg + 1u) * nx) xb_add(&bar[XB_TOPGEN], 1u);
            else XB_SPIN(xb_ld(&bar[XB_TOPGEN]) == tg, bar);
            __builtin_amdgcn_fence(__ATOMIC_ACQUIRE, "agent");
            xb_add(&bar[XB_XGEN(b.x)], 1u);
            asm volatile("s_waitcnt vmcnt(0)" ::: "memory");
        } else {
            XB_SPIN(xb_ld(&bar[XB_XGEN(b.x)]) == gen, bar);
            __builtin_amdgcn_fence(__ATOMIC_ACQUIRE, "agent");
            asm volatile("s_waitcnt vmcnt(0)" ::: "memory");
        }
    }
    __syncthreads();
}
struct KC {
    const float* const* in;
    LAS unsigned char* lds;
    unsigned char* ws;
    int tid, lane, wave, G, bid;
};
__device__ __forceinline__ const float* inp_(int i) {
    const volatile unsigned long long __attribute__((address_space(4)))* kp = (const volatile unsigned long long __attribute__((address_space(4)))*)__builtin_amdgcn_kernarg_segment_ptr();
    return (const float*)(const GAS float*)kp[i];
}
#define INP(k) (inp_(k))

__device__ __forceinline__ int mod_row(int row) { return row < TL ? (row >> 11) : 8; }

__device__ __forceinline__ void ph_adaln_partials(const KC& k, const float* c, const float* c_ctx, const float* w_ada) {
    LAS float* sc = (LAS float*)k.lds;
    for (int i = k.tid; i < 9 * DM; i += 512) { const int r = i >> 11, kk = i & 2047; const float cv = r < 8 ? c[r * DM + kk] : c_ctx[kk]; sc[i] = siluf(cv); }
    __syncthreads();
    float* modp = (float*)(k.ws + WS_MODP);
    const int cc = k.tid & 255, kh = k.tid >> 8;
    constexpr int NIT = DEPTH * 48 * 16;
    for (int it = k.bid; it < NIT; it += k.G) {
        const int l = it / 768, rem = it % 768, cb = rem >> 4, ks = rem & 15;
        const int col = cb * 256 + cc, kbeg = ks * 128 + kh * 64;
        const float* W = w_ada + ((size_t)l * DM + kbeg) * MOD_N + col;
        float acc[9];
#pragma unroll
        for (int r = 0; r < 9; ++r) acc[r] = 0.f;
#pragma unroll 32
        for (int q = 0; q < 64; ++q) {
            const float w = W[(size_t)q * MOD_N];
#pragma unroll
            for (int r = 0; r < 9; ++r) acc[r] += sc[r * DM + kbeg + q] * w;
        }
        const int s = ks * 2 + kh;
#pragma unroll
        for (int r = 0; r < 9; ++r) modp[(((size_t)s * DEPTH + l) * 9 + r) * MOD_N + col] = acc[r];
    }
    __syncthreads();
}
__device__ __forceinline__ void ph_adaln_reduce(const KC& k, const float* b_ada) {
    const float* modp = (const float*)(k.ws + WS_MODP); float* mod = (float*)(k.ws + WS_MOD);
    constexpr int TOT = DEPTH * 9 * MOD_N;
    for (int i = k.bid * 512 + k.tid; i < TOT; i += k.G * 512) {
        const int n = i % MOD_N, l = i / (9 * MOD_N);
        float s = b_ada[l * MOD_N + n];
#pragma unroll 8
        for (int q = 0; q < KSPLIT; ++q) s += modp[(size_t)q * TOT + i];
        mod[i] = s;
    }
}

struct TrItem { const float* src; bf16* dst; int srcN, Kv, Nv, k0, n0, dpitch, drow0, dk0; };
struct WSrc { const float *w_in, *w2, *a2, *g2, *wba, *wbb, *wout, *eg, *eu, *ed, *w0, *a0; };
constexpr int TI_IN = 32 * 336, TI_LO = 4 * 64, TI_G2 = 4 * 32, TI_AB = 16 * 64, TI_O = 32 * 64, TI_GU1 = 32 * 44, TI_D1 = 22 * 64;
constexpr int TI_N = TI_IN + TI_LO + TI_G2 + 2 * TI_AB + TI_O + 2 * NEXP * TI_GU1 + NEXP * TI_D1;
__device__ __forceinline__ TrItem tr_decode(const WSrc& s, unsigned char* ws, int l, int it) {
    TrItem t; int r = it;
    if (r < TI_IN) { const int kb = r / 336, nb = r % 336; t = TrItem{s.w_in + (size_t)l * DM * IN_DIM, (bf16*)(ws + WT_IN), IN_DIM, DM, IN_DIM, 64 * kb, 32 * nb, DM, 32 * nb, 0}; return t; } r -= TI_IN;
    if (r < TI_LO) {
        const int mtx = r >> 6, q = r & 63, kb = q >> 5, nb = q & 31;
        t = TrItem{(mtx < 2 ? s.w2 : s.a2) + (size_t)(l * 2 + (mtx & 1)) * 96 * RD, (bf16*)(ws + WT_L1), RD, 96, RD, 64 * kb, 32 * nb, 256, mtx * 1024 + 32 * nb, mtx < 2 ? 0 : 96}; return t; } r -= TI_LO;
    if (r < TI_G2) { const int kb = r >> 5, nb = r & 31; t = TrItem{s.g2 + (size_t)l * 256 * RD, (bf16*)(ws + WT_G2), RD, 256, RD, 64 * kb, 32 * nb, 256, 32 * nb, 0}; return t; } r -= TI_G2;
    if (r < TI_AB) { const int kb = r >> 6, nb = r & 63; t = TrItem{s.wba + (size_t)l * RD * DM, (bf16*)(ws + WT_A), DM, RD, DM, 64 * kb, 32 * nb, RD, 32 * nb, 0}; return t; } r -= TI_AB;
    if (r < TI_AB) { const int kb = r >> 6, nb = r & 63; t = TrItem{s.wbb + (size_t)l * GVD * DM, (bf16*)(ws + WT_B), DM, GVD, DM, 64 * kb, 32 * nb, GVD, 32 * nb, 0}; return t; } r -= TI_AB;
    if (r < TI_O) { const int kb = r >> 6, nb = r & 63; t = TrItem{s.wout + (size_t)l * DM * DM, (bf16*)(ws + WT_O), DM, DM, DM, 64 * kb, 32 * nb, DM, 32 * nb, 0}; return t; } r -= TI_O;
    if (r < 2 * NEXP * TI_GU1) {
        const int e = r / (2 * TI_GU1), q = r % (2 * TI_GU1), up = q / TI_GU1, q2 = q % TI_GU1, kb = q2 / 44, nb = q2 % 44;
        const int n0 = 32 * nb, drow = 256 * (n0 >> 7) + (n0 & 127) + (up ? 128 : 0);
        t = TrItem{(up ? s.eu : s.eg) + ((size_t)l * NEXP + e) * DM * DEXP, (bf16*)(ws + WT_GU) + (size_t)e * 2816 * DM, DEXP, DM, DEXP, 64 * kb, n0, DM, drow, 0}; return t; } r -= 2 * NEXP * TI_GU1;
    { const int e = r / TI_D1, q = r % TI_D1, kb = q >> 6, nb = q & 63;
      t = TrItem{s.ed + ((size_t)l * NEXP + e) * DEXP * DM, (bf16*)(ws + WT_D) + (size_t)e * DM * DEXP, DM, DEXP, DM, 64 * kb, 32 * nb, DEXP, 32 * nb, 0}; }
    return t;
}
__device__ __forceinline__ void tr_load(const TrItem& t, int lane, float (&v)[32]) {
    const int nn = lane & 31, kh = lane >> 5;
    const bool nok = t.n0 + nn < t.Nv;
    const float* p = t.src + (size_t)(t.k0 + kh) * t.srcN + t.n0 + nn;
#pragma unroll
    for (int i = 0; i < 32; ++i) { v[i] = 0.f; if (nok && t.k0 + 2 * i + kh < t.Kv) v[i] = p[(size_t)(2 * i) * t.srcN]; }
}
__device__ __forceinline__ void tr_store(const TrItem& t, int lane, const float (&v)[32], LAS float* scr) {
    const int nn = lane & 31, kh = lane >> 5;
#pragma unroll
    for (int i = 0; i < 32; ++i) scr[(2 * i + kh) * 33 + nn] = v[i];
    asm volatile("s_waitcnt lgkmcnt(0)" ::: "memory");
    const int cidx = lane & 7;
#pragma unroll
    for (int j = 0; j < 4; ++j) {
        const int n = (lane >> 3) + 8 * j; const LAS float* s = scr + (8 * cidx) * 33 + n;
        u32x4 o; o.x = pk2(s[0 * 33], s[1 * 33]); o.y = pk2(s[2 * 33], s[3 * 33]); o.z = pk2(s[4 * 33], s[5 * 33]); o.w = pk2(s[6 * 33], s[7 * 33]);
        *(u32x4*)(t.dst + (size_t)(t.drow0 + n) * t.dpitch + t.dk0 + t.k0 + 8 * cidx) = o;
    }
    asm volatile("s_waitcnt lgkmcnt(0)" ::: "memory");
}
__device__ __forceinline__ void ph_convert(const KC& k, const WSrc& s, int l) {
    LAS float* scr = (LAS float*)(k.lds + k.wave * 16384);
    const int gw = k.bid * 8 + k.wave, NGW = k.G * 8;
    unsigned char* ws = k.ws;
    { float* b1 = (float*)(ws + WS_TAB + TAB_TOP); for (int i = gw * 64 + k.lane; i < 4096; i += NGW * 64) b1[i] = i < 2048 ? s.w0[l * 2048 + i] : s.a0[l * 2048 + i - 2048]; }
    {
        u32x4* wl = (u32x4*)(ws + WT_L1);
        for (int i = gw * 64 + k.lane; i < 4096 * 32; i += NGW * 64) { const int row = i >> 5, ck = i & 31; if (row < 2048 ? ck >= 16 : (ck < 12 || ck >= 28)) wl[i] = (u32x4){0u, 0u, 0u, 0u}; }
        if (l == 0) { int* rt = (int*)(ws + WS_TAB + TAB_ROWTOK); for (int i = gw * 64 + k.lane; i < 2 * MOE_ROWS; i += NGW * 64) rt[i] = -1; }
    }
    float cur[32], nxt[32];
    int it = gw;
    TrItem tc = tr_decode(s, ws, l, it < TI_N ? it : 0);
    if (it < TI_N) tr_load(tc, k.lane, cur);
    for (; it < TI_N; it += NGW) {
        const bool more = it + NGW < TI_N;
        const TrItem tn = tr_decode(s, ws, l, more ? it + NGW : it);
        if (more) tr_load(tn, k.lane, nxt);
        tr_store(tc, k.lane, cur, scr);
        tc = tn;
#pragma unroll
        for (int i = 0; i < 32; ++i) cur[i] = nxt[i];
    }
}

constexpr int RWP = DM + 4;
struct RowArgs { const float *x_in, *ctx_in, *gvec, *router_w, *router_b; float* out; };
template <int MODE>
__device__ __forceinline__ void ph_rows(const KC& k, const RowArgs& ra, int l, int nrows, bool dry = false) {
    const int gw = k.bid * 8 + k.wave, NGW = k.G * 8, lane = k.lane;
    float* X = (float*)(k.ws + WS_X); bf16* H = (bf16*)(k.ws + WS_H);
    bf16* Xb = (bf16*)(k.ws + WS_X);
    const float* MOD = (const float*)(k.ws + WS_MOD);
    const bf16* YF = (const bf16*)(k.ws + WS_YF);
    LAS float* rwT = (LAS float*)k.lds;
    if (MODE == 1) {
        for (int i = k.tid; i < DM * NEXP; i += 512) { const int c = i >> 4, e = i & 15; rwT[e * RWP + c] = ra.router_w[i]; }
        __syncthreads();
    }
    const float* gv = ra.gvec;
    for (int row = gw; row < nrows; row += NGW) {
        const int mr = mod_row(row);
        f32x4 v[8];
        if (MODE == 0 && l == 0) {
            const f32x4* src = (const f32x4*)(row < TL ? ra.x_in + (size_t)row * DM : ra.ctx_in + (size_t)(row - TL) * DM) + lane;
#pragma unroll
            for (int j = 0; j < 8; ++j) v[j] = src[64 * j];
        } else if (XBF) {
            const u32x2* src = (const u32x2*)(Xb + (size_t)row * DM) + lane;
#pragma unroll
            for (int j = 0; j < 8; ++j) { const u32x2 a = src[64 * j]; v[j] = (f32x4){bflo(a.x), bfhi(a.x), bflo(a.y), bfhi(a.y)}; }
        } else {
            const f32x4* src = (const f32x4*)(X + (size_t)row * DM) + lane;
#pragma unroll
            for (int j = 0; j < 8; ++j) v[j] = src[64 * j];
        }
        if ((MODE == 0 && l > 0) || MODE == 2) {
            const int lp = (MODE == 2) ? DEPTH - 1 : l - 1;
            const f32x4* gate = (const f32x4*)(MOD + ((size_t)lp * 9 + mr) * MOD_N + 5 * DM) + lane;
            const u32x2* y0 = (const u32x2*)(YF + (size_t)row * DM) + lane;
            const u32x2* y1 = (const u32x2*)(YF + ((size_t)TA + row) * DM) + lane;
#pragma unroll
            for (int j = 0; j < 8; ++j) {
                const f32x4 g = gate[64 * j]; const u32x2 a = y0[64 * j], b = y1[64 * j];
                v[j].x += g.x * (bflo(a.x) + bflo(b.x)); v[j].y += g.y * (bfhi(a.x) + bfhi(b.x));
                v[j].z += g.z * (bflo(a.y) + bflo(b.y)); v[j].w += g.w * (bfhi(a.y) + bfhi(b.y));
            }
        }
        if (MODE == 0 && XBF) {
            u32x2* dst = (u32x2*)(Xb + (size_t)row * DM) + lane;
#pragma unroll
            for (int j = 0; j < 8; ++j) { u32x2 o; o.x = pk2(v[j].x, v[j].y); o.y = pk2(v[j].z, v[j].w); dst[64 * j] = o; }
        } else if (MODE == 0) {
            f32x4* dst = (f32x4*)(X + (size_t)row * DM) + lane;
#pragma unroll
            for (int j = 0; j < 8; ++j) dst[64 * j] = v[j];
        }
        float ss = 0.f;
#pragma unroll
        for (int j = 0; j < 8; ++j) ss += (v[j].x * v[j].x + v[j].y * v[j].y) + (v[j].z * v[j].z + v[j].w * v[j].w);
        const float rinv = 1.0f / sqrtf(wave_sum(ss) * (1.0f / DM) + 1e-6f);
        if (MODE == 2) {
            f32x4* dst = (f32x4*)(ra.out + (size_t)row * DM) + lane; const f32x4* g4 = (const f32x4*)gv + lane;
#pragma unroll
            for (int j = 0; j < 8; ++j) { const f32x4 g = g4[64 * j]; dst[64 * j] = v[j] * rinv * g; }
        } else {
            const float* mrow = MOD + ((size_t)l * 9 + mr) * MOD_N + (MODE == 0 ? 0 : 3 * DM);
            const f32x4* sh4 = (const f32x4*)mrow + lane; const f32x4* sc4 = (const f32x4*)(mrow + DM) + lane; const f32x4* g4 = (const f32x4*)(gv + (size_t)l * DM) + lane;
            u32x2* dst = (u32x2*)(H + (size_t)row * DM) + lane;
#pragma unroll
            for (int j = 0; j < 8; ++j) {
                const f32x4 g = g4[64 * j], sh = sh4[64 * j], sc = sc4[64 * j];
                v[j] = v[j] * rinv * g * (1.0f + sc) + sh;
                u32x2 o; o.x = pk2(v[j].x, v[j].y); o.y = pk2(v[j].z, v[j].w); dst[64 * j] = o;
            }
        }
        if (MODE == 1) {
            float lg[NEXP];
#pragma unroll
            for (int e = 0; e < NEXP; ++e) {
                float s = 0.f;
#pragma unroll
                for (int j = 0; j < 8; ++j) { const f32x4 w = *(const LAS f32x4*)(rwT + e * RWP + 4 * lane + 256 * j); s += (v[j].x * w.x + v[j].y * w.y) + (v[j].z * w.z + v[j].w * w.w); }
                lg[e] = wave_sum(s);
            }
            float sc[NEXP], sel[NEXP];
#pragma unroll
            for (int e = 0; e < NEXP; ++e) { sc[e] = 1.0f / (1.0f + expf(-lg[e])); sel[e] = sc[e] + ra.router_b[e]; }
            float gs[4], w1g[4], w2g[4]; int i1g[4], i2g[4];
#pragma unroll
            for (int g = 0; g < 4; ++g) {
                int i1 = 0; float m1 = sel[4 * g];
#pragma unroll
                for (int q = 1; q < 4; ++q) if (sel[4 * g + q] > m1) { m1 = sel[4 * g + q]; i1 = q; }
                int i2 = -1; float m2 = -3.0e38f;
#pragma unroll
                for (int q = 0; q < 4; ++q) if (q != i1 && sel[4 * g + q] > m2) { m2 = sel[4 * g + q]; i2 = q; }
                gs[g] = m1 + m2; i1g[g] = 4 * g + i1; i2g[g] = 4 * g + i2;
                float a1 = sc[4 * g], a2 = sc[4 * g];
#pragma unroll
                for (int q = 0; q < 4; ++q) { a1 = (q == i1) ? sc[4 * g + q] : a1; a2 = (q == i2) ? sc[4 * g + q] : a2; }
                w1g[g] = a1; w2g[g] = a2;
            }
            int best = 0; float bs = gs[0];
#pragma unroll
            for (int g = 1; g < 4; ++g) if (gs[g] > bs) { bs = gs[g]; best = g; }
            int e1 = i1g[0], e2 = i2g[0]; float w1 = w1g[0], w2 = w2g[0];
#pragma unroll
            for (int g = 1; g < 4; ++g) { e1 = (best == g) ? i1g[g] : e1; e2 = (best == g) ? i2g[g] : e2; w1 = (best == g) ? w1g[g] : w1; w2 = (best == g) ? w2g[g] : w2; }
            const float inv = 1.0f / (w1 + w2);
            if (lane == 0 && !dry) {
                unsigned* cnt = (unsigned*)(k.ws + WS_CTL) + CW_CNT + 64 * l;
                const int p1 = (int)atomicAdd(cnt + e1, 1u), p2 = (int)atomicAdd(cnt + e2, 1u);
                int* te = (int*)(k.ws + WS_TOPK); float* tw = (float*)(k.ws + WS_TOPK + (size_t)TA * 8); int* tp = (int*)(k.ws + WS_TOPK + 2 * (size_t)TA * 8);
                te[2 * row] = e1; te[2 * row + 1] = e2; tw[2 * row] = w1 * inv; tw[2 * row + 1] = w2 * inv; tp[2 * row] = p1; tp[2 * row + 1] = p2;
            }
        }
    }
    if (MODE == 1) __syncthreads();
}

__device__ __forceinline__ void ph_moe_scatter(const KC& k, int l, int nrows) {
    LAS int* offs = (LAS int*)k.lds;
    const unsigned* cnt = (const unsigned*)(k.ws + WS_CTL) + CW_CNT + 64 * l;
    int* tile = (int*)(k.ws + WS_TAB + TAB_TILE) + 256 * l;
    if (k.tid == 0) {
        int off = 0, nt = 0;
        for (int e = 0; e < NEXP; ++e) {
            offs[e] = off; const int c = (int)__hip_atomic_load(cnt + e, __ATOMIC_RELAXED, __HIP_MEMORY_SCOPE_AGENT); const int t = (c + 255) >> 8;
            if (k.bid == 0) for (int q = 0; q < t; ++q) tile[1 + nt + q] = e;
            nt += t; off += t * 256;
        }
        if (k.bid == 0) tile[0] = nt;
    }
    __syncthreads();
    const int gw = k.bid * 8 + k.wave, NGW = k.G * 8, lane = k.lane;
    const bf16* H = (const bf16*)(k.ws + WS_H); bf16* HP = (bf16*)(k.ws + WS_HP);
    const int* te = (const int*)(k.ws + WS_TOPK); const float* tw = (const float*)(k.ws + WS_TOPK + (size_t)TA * 8); const int* tp = (const int*)(k.ws + WS_TOPK + 2 * (size_t)TA * 8);
    int* rowtok = (int*)(k.ws + WS_TAB + TAB_ROWTOK) + (size_t)l * MOE_ROWS; float* roww = (float*)(k.ws + WS_TAB + TAB_ROWW) + (size_t)l * MOE_ROWS;
    for (int row = gw; row < nrows; row += NGW) {
#if MOE_GATHER
        (void)H; (void)HP;
        if (lane < 2) { const int s = lane; const int e = te[2 * row + s], dest = offs[e] + tp[2 * row + s]; rowtok[dest] = 2 * row + s; roww[dest] = tw[2 * row + s]; }
    }
#else
        const u32x4* src = (const u32x4*)(H + (size_t)row * DM) + lane;
        u32x4 d[4];
#pragma unroll
        for (int j = 0; j < 4; ++j) d[j] = src[64 * j];
#pragma unroll
        for (int s = 0; s < 2; ++s) {
            const int e = te[2 * row + s], dest = offs[e] + tp[2 * row + s];
            u32x4* dp = (u32x4*)(HP + (size_t)dest * DM) + lane;
#pragma unroll
            for (int j = 0; j < 4; ++j) dp[64 * j] = d[j];
            if (lane == 0) { rowtok[dest] = 2 * row + s; roww[dest] = tw[2 * row + s]; }
        }
    }
#endif
    __syncthreads();
}
__device__ __forceinline__ void ld16(const bf16* p, bool ok, float (&o)[16]) {
    if (ok) { const u32x4 a = *(const u32x4*)p, b = *(const u32x4*)(p + 8); float x[8], y[8]; unpack8(a, x); unpack8(b, y);
#pragma unroll
        for (int i = 0; i < 8; ++i) { o[i] = x[i]; o[8 + i] = y[i]; } }
    else {
#pragma unroll
        for (int i = 0; i < 16; ++i) o[i] = 0.f; }
}
__device__ __forceinline__ void st16(bf16* p, const float (&v)[16]) {
    float a[8], b[8];
#pragma unroll
    for (int i = 0; i < 8; ++i) { a[i] = v[i]; b[i] = v[8 + i]; }
    *(u32x4*)p = pack8(a); *(u32x4*)(p + 8) = pack8(b);
}
__device__ __forceinline__ void shift8(const bf16* p0, bool hp, bool hn, int c, const float* mu0, const float* mu1, float (&s)[8]) {
    float x[8], xm[8], xp[8];
    unpack8(*(const u32x4*)(p0 + c), x);
    if (hp) unpack8(*(const u32x4*)(p0 - NP + c), xm); else {
#pragma unroll
        for (int i = 0; i < 8; ++i) xm[i] = 0.f; }
    if (hn) unpack8(*(const u32x4*)(p0 + NP + c), xp); else {
#pragma unroll
        for (int i = 0; i < 8; ++i) xp[i] = 0.f; }
    const f32x4 m0a = *(const f32x4*)(mu0 + c), m0b = *(const f32x4*)(mu0 + c + 4), m1a = *(const f32x4*)(mu1 + c), m1b = *(const f32x4*)(mu1 + c + 4);
    const float m0[8] = {m0a.x, m0a.y, m0a.z, m0a.w, m0b.x, m0b.y, m0b.z, m0b.w}, m1[8] = {m1a.x, m1a.y, m1a.z, m1a.w, m1b.x, m1b.y, m1b.z, m1b.w};
#pragma unroll
    for (int i = 0; i < 8; ++i) s[i] = x[i] + m0[i] * (xm[i] - x[i]) + m1[i] * (xp[i] - x[i]);
}
__device__ __forceinline__ void ph_rwkv_prep(const KC& k, int l, int nrows, const float* mu, const float* k_k, const float* r_k) {
    const int gw = k.bid * 8 + k.wave, NGW = k.G * 8, lane = k.lane;
    const bf16* P = (const bf16*)(k.ws + WS_P);
    bf16* R = (bf16*)(k.ws + RW_R); bf16* KS = (bf16*)(k.ws + RW_KS); bf16* V = (bf16*)(k.ws + RW_V); bf16* KK = (bf16*)(k.ws + RW_KK);
    bf16* A1 = (bf16*)(k.ws + RW_A1); bf16* A2 = (bf16*)(k.ws + RW_A2); float* BON = (float*)(k.ws + RW_BON);
    const float* mu0 = mu + (size_t)(l * 2 + 0) * RWKV_IN; const float* mu1 = mu + (size_t)(l * 2 + 1) * RWKV_IN;
    const int rpw = (nrows + NGW - 1) / NGW;
    for (int row = gw * rpw; row < nrows && row < (gw + 1) * rpw; ++row) {
        int t, len; if (row < TL) { t = row & (SEQ - 1); len = SEQ; } else { t = (row - TL) & (CTXL - 1); len = CTXL; }
        const bool hp = t > 0, hn = t < len - 1;
        const bf16* p0 = P + (size_t)row * NP;
#pragma unroll
        for (int half = 0; half < 2; ++half) {
            const int c = half * 512 + 8 * lane;
            float r[8], kx[8], vv[8], kk[8];
            shift8(p0, hp, hn, c, mu0, mu1, r);
            shift8(p0, hp, hn, RD + c, mu0, mu1, kx);
            shift8(p0, hp, hn, 2 * RD + c, mu0, mu1, vv);
            const f32x4 kka = *(const f32x4*)(k_k + l * RD + c), kkb = *(const f32x4*)(k_k + l * RD + c + 4), rka = *(const f32x4*)(r_k + l * RD + c), rkb = *(const f32x4*)(r_k + l * RD + c + 4);
            const float kkw[8] = {kka.x, kka.y, kka.z, kka.w, kkb.x, kkb.y, kkb.z, kkb.w}, rkw[8] = {rka.x, rka.y, rka.z, rka.w, rkb.x, rkb.y, rkb.z, rkb.w};
            float ss = 0.f, bon = 0.f;
#pragma unroll
            for (int i = 0; i < 8; ++i) { kk[i] = kx[i] * kkw[i]; ss += kk[i] * kk[i]; bon += r[i] * kx[i] * rkw[i]; }
            ss += __shfl_xor(ss, 1); ss += __shfl_xor(ss, 2); ss += __shfl_xor(ss, 4);
            bon += __shfl_xor(bon, 1); bon += __shfl_xor(bon, 2); bon += __shfl_xor(bon, 4);
            const float inv = 1.0f / fmaxf(sqrtf(ss), 1e-12f);
#pragma unroll
            for (int i = 0; i < 8; ++i) kk[i] *= inv;
            *(u32x4*)(R + (size_t)row * RD + c) = pack8(r); *(u32x4*)(KS + (size_t)row * RD + c) = pack8(kx);
            *(u32x4*)(V + (size_t)row * RD + c) = pack8(vv); *(u32x4*)(KK + (size_t)row * RD + c) = pack8(kk);
            if ((lane & 7) == 0) BON[(size_t)row * RHEADS + half * 8 + (lane >> 3)] = bon;
        }
        if (lane < 56) {
            float s8[8];
            shift8(p0, hp, hn, 3 * RD + 8 * lane, mu0, mu1, s8);
            if (lane < 12) {
#pragma unroll
                for (int i = 0; i < 8; ++i) { const float e2 = __expf(2.0f * fminf(fmaxf(s8[i], -15.f), 15.f)); s8[i] = 1.0f - 2.0f / (e2 + 1.0f); }
                *(u32x4*)(A1 + (size_t)row * 256 + 8 * lane) = pack8(s8);
            } else if (lane < 24) { *(u32x4*)(A1 + (size_t)row * 256 + 8 * lane) = pack8(s8); }
            else {
#pragma unroll
                for (int i = 0; i < 8; ++i) s8[i] = sigm(s8[i]);
                *(u32x4*)(A2 + (size_t)row * 256 + 8 * (lane - 24)) = pack8(s8);
            }
        } else { *(u32x4*)(A1 + (size_t)row * 256 + 192 + 8 * (lane - 56)) = (u32x4){0u, 0u, 0u, 0u}; }
    }
}

__device__ __forceinline__ float logsig(float x) { return fminf(x, 0.f) - __logf(1.0f + __expf(-fabsf(x))); }
__device__ __forceinline__ int gla_row(bool lat, int b, int s) { return lat ? b * SEQ + (s & 31) * 64 + (s >> 5) : TL + b * CTXL + s; }
constexpr int GQ_PITCH = 264;
constexpr int GPL_AD = 0, GPL_GS = 4096, GPL_QK = GPL_GS + 65536, GPL_END = GPL_QK + 66 * GQ_PITCH * 2;
static_assert(GPL_END <= 131072, "gla prep lds");
__device__ __forceinline__ void ph_gla_prep(const KC& k, int l, const float* conv, const float* aw2, const float* ab) {
    const bf16* P = (const bf16*)(k.ws + WS_P);
    bf16* QG = (bf16*)(k.ws + GL_QG); bf16* KG = (bf16*)(k.ws + GL_KG); bf16* KE = (bf16*)(k.ws + GL_KE); bf16* VS = (bf16*)(k.ws + GL_VS); float* DEC = (float*)(k.ws + GL_DEC);
    const float* cw = conv + (size_t)l * 3 * GQKV;
    const int tid = k.tid, lane = k.lane;
    {
        const int gw = k.bid * 8 + k.wave, NGW = k.G * 8, c = 16 * lane;
        const int rpw = (TA + NGW - 1) / NGW;
        for (int qi = gw * rpw; qi < TA && qi < (gw + 1) * rpw; ++qi) {
            const bool lat = qi < TL; int b, s, len;
            if (lat) { b = qi >> 11; s = qi & 2047; len = SEQ; } else { b = (qi - TL) >> 8; s = (qi - TL) & 255; len = CTXL; }
            const int row = gla_row(lat, b, s);
            const bool hp = s > 0, hn = s + 1 < len;
            const bf16* p0 = P + (size_t)row * NP + GLA_OFF + 2 * GKD + c;
            const bf16* pm = P + (size_t)gla_row(lat, b, hp ? s - 1 : s) * NP + GLA_OFF + 2 * GKD + c;
            const bf16* pp = P + (size_t)gla_row(lat, b, hn ? s + 1 : s) * NP + GLA_OFF + 2 * GKD + c;
            float o[16];
#pragma unroll
            for (int hf = 0; hf < 2; ++hf) {
                float x[8], xm[8], xp[8];
                unpack8(*(const u32x4*)(p0 + 8 * hf), x); unpack8(*(const u32x4*)(pm + 8 * hf), xm); unpack8(*(const u32x4*)(pp + 8 * hf), xp);
                const float* w = cw + 2 * GKD + c + 8 * hf;
#pragma unroll
                for (int q = 0; q < 2; ++q) {
                    const f32x4 w0 = *(const f32x4*)(w + 4 * q), w1 = *(const f32x4*)(w + GQKV + 4 * q), w2 = *(const f32x4*)(w + 2 * GQKV + 4 * q);
#pragma unroll
                    for (int i = 0; i < 4; ++i) o[8 * hf + 4 * q + i] = siluf(w0[i] * (hp ? xm[4 * q + i] : 0.f) + w1[i] * x[4 * q + i] + w2[i] * (hn ? xp[4 * q + i] : 0.f));
                }
            }
            st16(VS + (size_t)row * GVD + c, o);
        }
    }
    LAS float* ADs = (LAS float*)(k.lds + GPL_AD);
    LAS float* Gs = (LAS float*)(k.lds + GPL_GS);
    LAS bf16* QKs = (LAS bf16*)(k.lds + GPL_QK);
    for (int item = k.bid; item < 288 * 4; item += k.G) {
        const int sc = item >> 2, h = item & 3;
        const bool lat = sc < 256; const int b = lat ? (sc >> 5) : ((sc - 256) >> 2), cn = lat ? (sc & 31) : ((sc - 256) & 3), len = lat ? SEQ : CTXL;
        const int gch = lat ? 4 + cn : cn, s0 = 64 * cn;
        for (int i = tid; i < 1024; i += 512) { const int tau = i >> 4, j = i & 15; ADs[i] = bf2f(P[(size_t)gla_row(lat, b, s0 + tau) * NP + GLA_AD_OFF + j]); }
        for (int i = tid; i < 66 * 32; i += 512) {
            const int rr = i >> 5, ck = i & 31, s = s0 - 1 + rr;
            u32x4 v = (u32x4){0u, 0u, 0u, 0u};
            if (s >= 0 && s < len) v = *(const u32x4*)(P + (size_t)gla_row(lat, b, s) * NP + GLA_OFF + (ck >> 4) * GKD + h * GDK + (ck & 15) * 8);
            *(LAS u32x4*)(QKs + rr * GQ_PITCH + ck * 8) = v;
        }
        __syncthreads();
        {
            const int c = tid & 127, tg = tid >> 7, chl = h * GDK + c;
            float awf[16], awb[16];
#pragma unroll
            for (int j = 0; j < 16; ++j) { awf[j] = aw2[((size_t)(l * 2 + 0) * 16 + j) * GKD + chl]; awb[j] = aw2[((size_t)(l * 2 + 1) * 16 + j) * GKD + chl]; }
            const float abf = ab[(l * 2 + 0) * GKD + chl], abb = ab[(l * 2 + 1) * GKD + chl];
            for (int i = 0; i < 16; ++i) {
                const int tau = 16 * tg + i; float xf = abf, xb = abb;
#pragma unroll
                for (int j = 0; j < 16; ++j) { const float a = ADs[tau * 16 + j]; xf += a * awf[j]; xb += a * awb[j]; }
                Gs[tau * 128 + c] = logsig(xf) * (1.0f / 16.0f); Gs[(64 + tau) * 128 + c] = logsig(xb) * (1.0f / 16.0f);
            }
        }
        __syncthreads();
        if (tid < 128) { float run = 0.f; for (int tau = 0; tau < 64; ++tau) { run += Gs[tau * 128 + tid]; Gs[tau * 128 + tid] = run; } }
        else if (tid < 256) { const int c = tid - 128; float run = 0.f; for (int tau = 63; tau >= 0; --tau) { run += Gs[(64 + tau) * 128 + c]; Gs[(64 + tau) * 128 + c] = run; } }
        __syncthreads();
        {
            const int c8 = tid & 15, tg = tid >> 4, chl = h * GDK + 8 * c8;
            float wq[3][8], wk[3][8], elf[8], elb[8];
#pragma unroll
            for (int tp = 0; tp < 3; ++tp) {
                const f32x4 a0 = *(const f32x4*)(cw + tp * GQKV + chl), a1 = *(const f32x4*)(cw + tp * GQKV + chl + 4), b0 = *(const f32x4*)(cw + tp * GQKV + GKD + chl), b1 = *(const f32x4*)(cw + tp * GQKV + GKD + chl + 4);
#pragma unroll
                for (int i = 0; i < 4; ++i) { wq[tp][i] = a0[i]; wq[tp][4 + i] = a1[i]; wk[tp][i] = b0[i]; wk[tp][4 + i] = b1[i]; }
            }
            {
                const f32x4 a0 = *(const LAS f32x4*)(Gs + 63 * 128 + 8 * c8), a1 = *(const LAS f32x4*)(Gs + 63 * 128 + 8 * c8 + 4), b0 = *(const LAS f32x4*)(Gs + 64 * 128 + 8 * c8), b1 = *(const LAS f32x4*)(Gs + 64 * 128 + 8 * c8 + 4);
#pragma unroll
                for (int i = 0; i < 4; ++i) { elf[i] = __expf(a0[i]); elf[4 + i] = __expf(a1[i]); elb[i] = __expf(b0[i]); elb[4 + i] = __expf(b1[i]); }
            }
            if (tg < 8) {
                float* d0 = DEC + ((size_t)(0 * 8 + b) * NCH + gch) * GKD + chl; float* d1 = DEC + ((size_t)(1 * 8 + b) * NCH + gch) * GKD + chl;
                if (tg == 0) { *(f32x4*)d0 = (f32x4){elf[0], elf[1], elf[2], elf[3]}; *(f32x4*)(d0 + 4) = (f32x4){elf[4], elf[5], elf[6], elf[7]}; }
                if (tg == 1) { *(f32x4*)d1 = (f32x4){elb[0], elb[1], elb[2], elb[3]}; *(f32x4*)(d1 + 4) = (f32x4){elb[4], elb[5], elb[6], elb[7]}; }
            }
#pragma unroll
            for (int pass = 0; pass < 2; ++pass) {
                const int tau = tg + 32 * pass;
                float qm[8], q0[8], qp[8], km[8], k0[8], kp[8];
                unpack8(*(const LAS u32x4*)(QKs + (tau + 0) * GQ_PITCH + 8 * c8), qm); unpack8(*(const LAS u32x4*)(QKs + (tau + 1) * GQ_PITCH + 8 * c8), q0); unpack8(*(const LAS u32x4*)(QKs + (tau + 2) * GQ_PITCH + 8 * c8), qp);
                unpack8(*(const LAS u32x4*)(QKs + (tau + 0) * GQ_PITCH + 128 + 8 * c8), km); unpack8(*(const LAS u32x4*)(QKs + (tau + 1) * GQ_PITCH + 128 + 8 * c8), k0); unpack8(*(const LAS u32x4*)(QKs + (tau + 2) * GQ_PITCH + 128 + 8 * c8), kp);
                const f32x4 f0 = *(const LAS f32x4*)(Gs + tau * 128 + 8 * c8), f1 = *(const LAS f32x4*)(Gs + tau * 128 + 8 * c8 + 4), g0 = *(const LAS f32x4*)(Gs + (64 + tau) * 128 + 8 * c8), g1 = *(const LAS f32x4*)(Gs + (64 + tau) * 128 + 8 * c8 + 4);
                const float cf[8] = {f0.x, f0.y, f0.z, f0.w, f1.x, f1.y, f1.z, f1.w}, cb[8] = {g0.x, g0.y, g0.z, g0.w, g1.x, g1.y, g1.z, g1.w};
                float oqf[8], okf[8], oef[8], oqb[8], okb[8], oeb[8];
#pragma unroll
                for (int i = 0; i < 8; ++i) {
                    const float qv = siluf(wq[0][i] * qm[i] + wq[1][i] * q0[i] + wq[2][i] * qp[i]) * 0.08838834764831845f;
                    const float kv = siluf(wk[0][i] * km[i] + wk[1][i] * k0[i] + wk[2][i] * kp[i]);
                    const float ef = __expf(cf[i]), eb = __expf(cb[i]), rf = 1.0f / ef, rb = 1.0f / eb;
                    oqf[i] = qv * ef; okf[i] = kv * rf; oef[i] = kv * rf * elf[i];
                    oqb[i] = qv * eb; okb[i] = kv * rb; oeb[i] = kv * rb * elb[i];
                }
                const size_t o = (size_t)gla_row(lat, b, s0 + tau) * GKD + chl;
                *(u32x4*)(QG + o) = pack8(oqf); *(u32x4*)(KG + o) = pack8(okf); *(u32x4*)(KE + o) = pack8(oef);
                *(u32x4*)(QG + (size_t)TA * GKD + o) = pack8(oqb); *(u32x4*)(KG + (size_t)TA * GKD + o) = pack8(okb); *(u32x4*)(KE + (size_t)TA * GKD + o) = pack8(oeb);
            }
        }
        __syncthreads();
    }
}

__device__ __forceinline__ float dpp_sum16(float x) {
    x += __builtin_bit_cast(float, __builtin_amdgcn_update_dpp(0, __builtin_bit_cast(int, x), 0xB1, 0xF, 0xF, true));
    x += __builtin_bit_cast(float, __builtin_amdgcn_update_dpp(0, __builtin_bit_cast(int, x), 0x4E, 0xF, 0xF, true));
    x += __builtin_bit_cast(float, __builtin_amdgcn_update_dpp(0, __builtin_bit_cast(int, x), 0x141, 0xF, 0xF, true));
    x += __builtin_bit_cast(float, __builtin_amdgcn_update_dpp(0, __builtin_bit_cast(int, x), 0x140, 0xF, 0xF, true));
    return x;
}
constexpr int RS_TOK = 16;
constexpr int RS_TF = 6 * 64;
constexpr int RS_BUF = RS_TOK * RS_TF;
struct RwkvStage { unsigned r, we, a, ks, v, kk; };
__device__ __forceinline__ int rwkv_row(int b, int dir, int p) {
    if (p < CTXL) { const int t = dir ? CTXL - 1 - p : p; return TL + b * CTXL + t; }
    const int q = p - CTXL, t = dir ? SEQ - 1 - q : q; return b * SEQ + t;
}
__device__ __forceinline__ void ph_rwkv_scan(const KC& k, int l, int job, const float* k_a, size_t yoff = RW_Y) {
    const int b = job >> 5, h = (job >> 1) & 15, dir = job & 1;
    const int tid = k.tid;
    const bf16* R = (const bf16*)(k.ws + RW_R); const bf16* KS = (const bf16*)(k.ws + RW_KS); const bf16* V = (const bf16*)(k.ws + RW_V); const bf16* KK = (const bf16*)(k.ws + RW_KK);
    const bf16* LO = (const bf16*)(k.ws + RW_LO); bf16* Y = (bf16*)(k.ws + yoff) + (size_t)dir * TA * RD;
    LAS float* buf = (LAS float*)k.lds;
    LAS f32x2* ypart = (LAS f32x2*)(buf + 2 * RS_BUF);
    const int st = tid >> 5, cp = tid & 31, ch = h * RHS + 2 * cp;
    const float ka0 = k_a[l * RD + ch], ka1 = k_a[l * RD + ch + 1];
    const int kq = tid & 15, rp = tid >> 4, v0 = rp * 2;
    f32x2 S00 = {0.f, 0.f}, S01 = {0.f, 0.f}, S10 = {0.f, 0.f}, S11 = {0.f, 0.f};
    RwkvStage sg;
#define RW_LOAD(chunk) do { const int row_ = rwkv_row(b, dir, (chunk) * RS_TOK + st); \
        sg.r = *(const unsigned*)(R + (size_t)row_ * RD + ch); sg.ks = *(const unsigned*)(KS + (size_t)row_ * RD + ch); \
        sg.v = *(const unsigned*)(V + (size_t)row_ * RD + ch); sg.kk = *(const unsigned*)(KK + (size_t)row_ * RD + ch); \
        sg.we = *(const unsigned*)(LO + (size_t)row_ * 4096 + dir * RD + ch); sg.a = *(const unsigned*)(LO + (size_t)row_ * 4096 + 2048 + dir * RD + ch); } while (0)
#define RW_WRITE(bi) do { LAS float* tb = buf + (bi) * RS_BUF + st * RS_TF + 2 * cp; \
        const float a0 = bflo(sg.a), a1 = bfhi(sg.a), kk0 = bflo(sg.kk), kk1 = bfhi(sg.kk), ks0 = bflo(sg.ks), ks1 = bfhi(sg.ks); \
        *(LAS f32x2*)(tb + 0) = (f32x2){kk0, kk1}; \
        *(LAS f32x2*)(tb + 64) = (f32x2){__expf(-bflo(sg.we)), __expf(-bfhi(sg.we))}; \
        *(LAS f32x2*)(tb + 128) = (f32x2){-kk0 * a0, -kk1 * a1}; \
        *(LAS f32x2*)(tb + 192) = (f32x2){ks0 * (1.0f + (a0 - 1.0f) * ka0), ks1 * (1.0f + (a1 - 1.0f) * ka1)}; \
        *(LAS f32x2*)(tb + 256) = (f32x2){bflo(sg.r), bfhi(sg.r)}; \
        *(LAS f32x2*)(tb + 320) = (f32x2){bflo(sg.v), bfhi(sg.v)}; } while (0)
    constexpr int NCHUNK = (CTXL + SEQ) / RS_TOK;
    RW_LOAD(0); RW_WRITE(0);
    __syncthreads();
    for (int c = 0; c < NCHUNK; ++c) {
        if (c + 1 < NCHUNK) RW_LOAD(c + 1);
        const LAS float* cb = buf + (c & 1) * RS_BUF; LAS f32x2* yb = ypart + (c & 1) * RS_TOK * 256 + rp * 8 + (((kq >> 1) ^ (rp >> 2)) & 7);
        {
            const LAS float* tk = cb + kq * 4; const LAS float* tv = cb + 320 + v0;
#define RW_LD(T, kk4, w4, n4, d4, r4, vv) f32x4 kk4 = *(const LAS f32x4*)(tk + (T) * RS_TF), w4 = *(const LAS f32x4*)(tk + (T) * RS_TF + 64), n4 = *(const LAS f32x4*)(tk + (T) * RS_TF + 128), \
                d4 = *(const LAS f32x4*)(tk + (T) * RS_TF + 192), r4 = *(const LAS f32x4*)(tk + (T) * RS_TF + 256); f32x2 vv = *(const LAS f32x2*)(tv + (T) * RS_TF)
#define RW_STEP(T, kk4, w4, n4, d4, r4, vv) do { \
                const f32x2 kka = {kk4.x, kk4.y}, kkb = {kk4.z, kk4.w}, wa = {w4.x, w4.y}, wb = {w4.z, w4.w}, na = {n4.x, n4.y}, nb = {n4.z, n4.w}, da = {d4.x, d4.y}, db = {d4.z, d4.w}, ra = {r4.x, r4.y}, rb = {r4.z, r4.w}; \
                f32x2 p0 = S00 * kka + S01 * kkb, p1 = S10 * kka + S11 * kkb; \
                const f32x2 u00 = S00 * wa + da * vv.x, u01 = S01 * wb + db * vv.x, u10 = S10 * wa + da * vv.y, u11 = S11 * wb + db * vv.y;     \
                const float sa0 = dpp_sum16(p0.x + p0.y), sa1 = dpp_sum16(p1.x + p1.y); \
                S00 = na * sa0 + u00; S01 = nb * sa0 + u01; S10 = na * sa1 + u10; S11 = nb * sa1 + u11; \
                p0 = S00 * ra + S01 * rb; p1 = S10 * ra + S11 * rb; \
                float y0 = p0.x + p0.y, y1 = p1.x + p1.y; \
                y0 += __builtin_bit_cast(float, __builtin_amdgcn_update_dpp(0, __builtin_bit_cast(int, y0), 0xB1, 0xF, 0xF, true)); \
                y1 += __builtin_bit_cast(float, __builtin_amdgcn_update_dpp(0, __builtin_bit_cast(int, y1), 0xB1, 0xF, 0xF, true)); \
                if ((kq & 1) == 0) yb[(T) * 256] = (f32x2){y0, y1}; } while (0)
            RW_LD(0, kkA, wA, nA, dA, rA, vA);
#pragma unroll
            for (int tau = 0; tau < RS_TOK; tau += 2) {
                RW_LD(tau + 1, kkB, wB, nB, dB, rB, vB);
                RW_STEP(tau, kkA, wA, nA, dA, rA, vA);
                if (tau + 2 < RS_TOK) { RW_LD(tau + 2, kkC, wC, nC, dC, rC, vC); kkA = kkC; wA = wC; nA = nC; dA = dC; rA = rC; vA = vC; }
                RW_STEP(tau + 1, kkB, wB, nB, dB, rB, vB);
            }
#undef RW_LD
#undef RW_STEP
        }
        if (c + 1 < NCHUNK) RW_WRITE((c + 1) & 1);
        __syncthreads();
        {
            const int row = rwkv_row(b, dir, c * RS_TOK + st);
            const LAS f32x2* yq = ypart + (c & 1) * RS_TOK * 256 + st * 256 + cp * 8;
            f32x2 acc = yq[(0 ^ (cp >> 2)) & 7];
#pragma unroll
            for (int j = 1; j < 8; ++j) acc += yq[(j ^ (cp >> 2)) & 7];
            *(unsigned*)(Y + (size_t)row * RD + ch) = pk2(acc.x, acc.y);
        }
    }
    __syncthreads();
}

constexpr int GP1 = 136, GP2 = 72;
constexpr int GL_QGS = 0, GL_KGS = GL_QGS + 64 * GP1 * 2, GL_STS = GL_KGS + 64 * GP1 * 2, GL_KET = GL_STS + 64 * GP1 * 2, GL_VT = GL_KET + 128 * GP2 * 2, GL_ATT = GL_VT + 64 * GP2 * 2,
              GL_DECS = GL_ATT + 64 * GP2 * 2, GL_LDS_END = GL_DECS + 512;
static_assert(GL_LDS_END <= 131072, "gla lds");
__device__ __forceinline__ bf16x8 ldfrag(const LAS bf16* base, int row, int pitch, int kofs) { return *(const LAS bf16x8*)(base + row * pitch + kofs); }
__device__ __forceinline__ int gla_prow(int b, int dir, int cp, int tau) {
    const bool lat = cp >= 4; const int q = lat ? cp - 4 : cp, ncn = lat ? 32 : 4, cn = dir ? ncn - 1 - q : q;
    return gla_row(lat, b, dir ? 64 * cn + 63 - tau : 64 * cn + tau);
}
__device__ __forceinline__ int gla_gch(int dir, int cp) { const bool lat = cp >= 4; const int q = lat ? cp - 4 : cp, ncn = lat ? 32 : 4, cn = dir ? ncn - 1 - q : q; return lat ? 4 + cn : cn; }
__device__ __forceinline__ bf16x8 ldfrag_sw(const LAS bf16* base, int row, int g) { return *(const LAS bf16x8*)(base + row * GP2 + ((g ^ ((row >> 3) & 7)) << 3)); }
__device__ __forceinline__ void ph_gla_scan(const KC& k, int job) {
    const int b = job >> 5, h = (job >> 3) & 3, dir = (job >> 2) & 1, dvq = job & 3;
    const int tid = k.tid, w = k.wave, lane = k.lane, q4 = lane >> 4, l15 = lane & 15;
    const bf16* QG = (const bf16*)(k.ws + GL_QG) + (size_t)dir * TA * GKD; const bf16* KG = (const bf16*)(k.ws + GL_KG) + (size_t)dir * TA * GKD;
    const bf16* KE = (const bf16*)(k.ws + GL_KE) + (size_t)dir * TA * GKD; const bf16* VS = (const bf16*)(k.ws + GL_VS);
    const float* DEC = (const float*)(k.ws + GL_DEC); bf16* O = (bf16*)(k.ws + GL_O) + (size_t)dir * TA * GVD;
    LAS bf16* QGs = (LAS bf16*)(k.lds + GL_QGS); LAS bf16* KGs = (LAS bf16*)(k.lds + GL_KGS); LAS bf16* STs = (LAS bf16*)(k.lds + GL_STS);
    LAS bf16* KEt = (LAS bf16*)(k.lds + GL_KET); LAS bf16* Vt = (LAS bf16*)(k.lds + GL_VT); LAS bf16* ATT = (LAS bf16*)(k.lds + GL_ATT); LAS float* decs = (LAS float*)(k.lds + GL_DECS);
    f32x4 accS[4];
#pragma unroll
    for (int t = 0; t < 4; ++t) accS[t] = (f32x4){0.f, 0.f, 0.f, 0.f};
    const int tw = w & 3, wh = w >> 2;
    u32x4 pq[2], pk[2], pe[2], pv; float pd = 0.f;
#define GLA_PREFETCH(CP) do { _Pragma("unroll") for (int i = 0; i < 2; ++i) { const int idx = tid + 512 * i, tau = idx >> 4, ck = idx & 15; \
            const size_t go = (size_t)gla_prow(b, dir, (CP), tau) * GKD + h * GDK + ck * 8; pq[i] = *(const u32x4*)(QG + go); pk[i] = *(const u32x4*)(KG + go); pe[i] = *(const u32x4*)(KE + go); } \
        pv = *(const u32x4*)(VS + (size_t)gla_prow(b, dir, (CP), tid >> 3) * GVD + h * GDV + dvq * 64 + (tid & 7) * 8); \
        if (tid < 128) pd = DEC[((size_t)(dir * 8 + b) * NCH + gla_gch(dir, (CP))) * GKD + h * GDK + tid]; } while (0)
    GLA_PREFETCH(0);
    for (int cp = 0; cp < NCH; ++cp) {
#define GROW(tau) gla_prow(b, dir, cp, (tau))
#pragma unroll
        for (int i = 0; i < 2; ++i) {
            const int idx = tid + 512 * i, tau = idx >> 4, ck = idx & 15;
            *(LAS u32x4*)(QGs + tau * GP1 + ck * 8) = pq[i];
            *(LAS u32x4*)(KGs + tau * GP1 + ck * 8) = pk[i];
            const unsigned kw[4] = {pe[i].x, pe[i].y, pe[i].z, pe[i].w};
#pragma unroll
            for (int e = 0; e < 4; ++e) { const int ts = tau ^ ((ck & 7) << 3); KEt[(ck * 8 + 2 * e) * GP2 + ts] = (bf16)(kw[e] & 0xffffu); KEt[(ck * 8 + 2 * e + 1) * GP2 + ts] = (bf16)(kw[e] >> 16); }
        }
        {
            const int tau = tid >> 3, ck = tid & 7;
            const unsigned vw[4] = {pv.x, pv.y, pv.z, pv.w};
#pragma unroll
            for (int e = 0; e < 4; ++e) { const int ts = tau ^ (ck << 3); Vt[(ck * 8 + 2 * e) * GP2 + ts] = (bf16)(vw[e] & 0xffffu); Vt[(ck * 8 + 2 * e + 1) * GP2 + ts] = (bf16)(vw[e] >> 16); }
        }
        if (tid < 128) decs[tid] = pd;
#pragma unroll
        for (int t = 0; t < 4; ++t) {
            const int dkt = wh * 4 + t;
#pragma unroll
            for (int r = 0; r < 4; ++r) STs[(16 * tw + 4 * q4 + r) * GP1 + 16 * dkt + l15] = (bf16)f2bf(accS[t][r]);
        }
        __syncthreads();
        if (cp + 1 < NCH) GLA_PREFETCH(cp + 1);
#pragma unroll
        for (int jj = 0; jj < 2; ++jj) {
            const int it = tw, jt = wh * 2 + jj;
            f32x4 acc = (f32x4){0.f, 0.f, 0.f, 0.f};
#pragma unroll
            for (int ks = 0; ks < 4; ++ks) acc = __builtin_amdgcn_mfma_f32_16x16x32_bf16(ldfrag(QGs, 16 * it + l15, GP1, 32 * ks + 8 * q4), ldfrag(KGs, 16 * jt + l15, GP1, 32 * ks + 8 * q4), acc, 0, 0, 0);
#pragma unroll
            for (int r = 0; r < 4; ++r) { const int i = 16 * it + 4 * q4 + r, j = 16 * jt + l15; ATT[i * GP2 + j] = (bf16)f2bf(j <= i ? acc[r] : 0.f); }
        }
        __syncthreads();
#pragma unroll
        for (int dd = 0; dd < 2; ++dd) {
            const int it = tw, dvt = wh * 2 + dd;
            f32x4 acc = (f32x4){0.f, 0.f, 0.f, 0.f};
#pragma unroll
            for (int ks = 0; ks < 4; ++ks) acc = __builtin_amdgcn_mfma_f32_16x16x32_bf16(ldfrag(QGs, 16 * it + l15, GP1, 32 * ks + 8 * q4), ldfrag(STs, 16 * dvt + l15, GP1, 32 * ks + 8 * q4), acc, 0, 0, 0);
#pragma unroll
            for (int ks = 0; ks < 2; ++ks) acc = __builtin_amdgcn_mfma_f32_16x16x32_bf16(ldfrag(ATT, 16 * it + l15, GP2, 32 * ks + 8 * q4), ldfrag_sw(Vt, 16 * dvt + l15, 4 * ks + q4), acc, 0, 0, 0);
#pragma unroll
            for (int r = 0; r < 4; ++r) { const int i = 16 * it + 4 * q4 + r; O[(size_t)GROW(i) * GVD + h * GDV + dvq * 64 + 16 * dvt + l15] = (bf16)f2bf(acc[r]); }
        }
#pragma unroll
        for (int t = 0; t < 4; ++t) {
            const int dkt = wh * 4 + t; const float d = decs[16 * dkt + l15];
            accS[t] = accS[t] * d;
#pragma unroll
            for (int ks = 0; ks < 2; ++ks) accS[t] = __builtin_amdgcn_mfma_f32_16x16x32_bf16(ldfrag_sw(Vt, 16 * tw + l15, 4 * ks + q4), ldfrag_sw(KEt, 16 * dkt + l15, 4 * ks + q4), accS[t], 0, 0, 0);
        }
        __syncthreads();
#undef GROW
    }
#undef GLA_PREFETCH
}

#ifndef RWKV_MODE
#define RWKV_MODE 2
#endif
#ifndef HB_FULL
#define HB_FULL 0
#endif
#ifndef GLA4_LEVEL
#define GLA4_LEVEL 0
#endif
#ifndef GLA4_NOSTORE
#define GLA4_NOSTORE 0
#endif
#ifndef SWAP_HALVES
#define SWAP_HALVES 0
#endif
#ifndef SPLIT_SCAN
#define SPLIT_SCAN 0
#endif
constexpr int RS4_TOK = 8, RS4_BUF = RS4_TOK * RS_TF;
constexpr int SC_GL = 0;
constexpr int SC_RW = 96 * 1024;
constexpr int SC_END = SC_RW + 2 * RS4_BUF * 4 + 2 * RS4_TOK * 64 * 4;
static_assert(SC_GL + GL_LDS_END <= SC_RW, "scan lds halves");
constexpr int SC_CTR = 127 * 1024;
static_assert(SC_END <= SC_CTR && SC_CTR + 128 <= 131072, "scan lds");
__device__ __forceinline__ void half_bar(LAS unsigned* ctr, unsigned& gen, int lane) {
#if HB_FULL
    (void)ctr; (void)lane; gen += 4u; __syncthreads(); return;
#endif
    gen += 4u;
    __builtin_amdgcn_fence(__ATOMIC_RELEASE, "workgroup");
    if (lane == 0) __hip_atomic_fetch_add(ctr, 1u, __ATOMIC_RELAXED, __HIP_MEMORY_SCOPE_WORKGROUP);
    unsigned spins = 0;
    while (__hip_atomic_load(ctr, __ATOMIC_RELAXED, __HIP_MEMORY_SCOPE_WORKGROUP) < gen) { __builtin_amdgcn_s_sleep(1); if (++spins > (1u << 26)) break; }
    __builtin_amdgcn_fence(__ATOMIC_ACQUIRE, "workgroup");
}
#ifndef RW4_SHFL
#define RW4_SHFL 0
#endif
__device__ __forceinline__ float shfl_sum16(float x) { x += __shfl_xor(x, 1); x += __shfl_xor(x, 2); x += __shfl_xor(x, 4); x += __shfl_xor(x, 8); return x; }
#if RW4_SHFL
#define RW4_SUM16(x) shfl_sum16(x)
#else
#define RW4_SUM16(x) dpp_sum16(x)
#endif
__device__ __forceinline__ void rwkv_scan_4w(const KC& k, int l, int job, const float* k_a, LAS unsigned* ctr) {
    const int b = job >> 5, h = (job >> 1) & 15, dir = job & 1;
    const int tid = k.tid, lane = k.lane;
    const bf16* R = (const bf16*)(k.ws + RW_R); const bf16* KS = (const bf16*)(k.ws + RW_KS); const bf16* V = (const bf16*)(k.ws + RW_V); const bf16* KK = (const bf16*)(k.ws + RW_KK);
    const bf16* LO = (const bf16*)(k.ws + RW_LO); bf16* Y = (bf16*)(k.ws + RW_Y) + (size_t)dir * TA * RD;
    LAS float* buf = (LAS float*)(k.lds + SC_RW);
    LAS float* ybuf = buf + 2 * RS4_BUF;
    const int st = tid >> 5, cp = tid & 31, ch = h * RHS + 2 * cp;
    const float ka0 = k_a[l * RD + ch], ka1 = k_a[l * RD + ch + 1];
    const int kq = tid & 15, v0 = (tid >> 4) * 4;
    f32x2 S[4][2];
#pragma unroll
    for (int i = 0; i < 4; ++i) { S[i][0] = (f32x2){0.f, 0.f}; S[i][1] = (f32x2){0.f, 0.f}; }
    RwkvStage sg[1];
    unsigned gen = 0;
#define RW4_LOAD(chunk) do { _Pragma("unroll") for (int q_ = 0; q_ < 1; ++q_) { const int row_ = rwkv_row(b, dir, (chunk) * RS4_TOK + st); \
        sg[q_].r = *(const unsigned*)(R + (size_t)row_ * RD + ch); sg[q_].ks = *(const unsigned*)(KS + (size_t)row_ * RD + ch); \
        sg[q_].v = *(const unsigned*)(V + (size_t)row_ * RD + ch); sg[q_].kk = *(const unsigned*)(KK + (size_t)row_ * RD + ch); \
        sg[q_].we = *(const unsigned*)(LO + (size_t)row_ * 4096 + dir * RD + ch); sg[q_].a = *(const unsigned*)(LO + (size_t)row_ * 4096 + 2048 + dir * RD + ch); } } while (0)
#define RW4_WRITE(bi) do { _Pragma("unroll") for (int q_ = 0; q_ < 1; ++q_) { LAS float* tb = buf + (bi) * RS4_BUF + st * RS_TF + 2 * cp; \
        const float a0 = bflo(sg[q_].a), a1 = bfhi(sg[q_].a), kk0 = bflo(sg[q_].kk), kk1 = bfhi(sg[q_].kk), ks0 = bflo(sg[q_].ks), ks1 = bfhi(sg[q_].ks); \
        *(LAS f32x2*)(tb + 0) = (f32x2){kk0, kk1}; \
        *(LAS f32x2*)(tb + 64) = (f32x2){__expf(-bflo(sg[q_].we)), __expf(-bfhi(sg[q_].we))}; \
        *(LAS f32x2*)(tb + 128) = (f32x2){-kk0 * a0, -kk1 * a1}; \
        *(LAS f32x2*)(tb + 192) = (f32x2){ks0 * (1.0f + (a0 - 1.0f) * ka0), ks1 * (1.0f + (a1 - 1.0f) * ka1)}; \
        *(LAS f32x2*)(tb + 256) = (f32x2){bflo(sg[q_].r), bfhi(sg[q_].r)}; \
        *(LAS f32x2*)(tb + 320) = (f32x2){bflo(sg[q_].v), bfhi(sg[q_].v)}; } } while (0)
    constexpr int NCHUNK = (CTXL + SEQ) / RS4_TOK;
    RW4_LOAD(0); RW4_WRITE(0);
    half_bar(ctr, gen, lane);
    for (int c = 0; c < NCHUNK; ++c) {
        if (c + 1 < NCHUNK) RW4_LOAD(c + 1);
        const LAS float* cb = buf + (c & 1) * RS4_BUF; LAS float* yb = ybuf + (c & 1) * RS4_TOK * 64;
        {
            const LAS float* tk = cb + kq * 4; const LAS float* tv = cb + 320 + v0;
#define RW4_LD(T, kk4, w4, n4, d4, r4, vv) f32x4 kk4 = *(const LAS f32x4*)(tk + (T) * RS_TF), w4 = *(const LAS f32x4*)(tk + (T) * RS_TF + 64), n4 = *(const LAS f32x4*)(tk + (T) * RS_TF + 128), \
                d4 = *(const LAS f32x4*)(tk + (T) * RS_TF + 192), r4 = *(const LAS f32x4*)(tk + (T) * RS_TF + 256), vv = *(const LAS f32x4*)(tv + (T) * RS_TF)
#define RW4_STEP(T, kk4, w4, n4, d4, r4, vv) do { \
                const f32x2 kka = {kk4.x, kk4.y}, kkb = {kk4.z, kk4.w}, wa = {w4.x, w4.y}, wb = {w4.z, w4.w}, na = {n4.x, n4.y}, nb = {n4.z, n4.w}, da = {d4.x, d4.y}, db = {d4.z, d4.w}, ra = {r4.x, r4.y}, rb = {r4.z, r4.w}; \
                float sa[4], yy[4]; f32x2 u0[4], u1[4]; \
                _Pragma("unroll") for (int i = 0; i < 4; ++i) { const f32x2 p = S[i][0] * kka + S[i][1] * kkb; sa[i] = p.x + p.y; u0[i] = S[i][0] * wa + da * vv[i]; u1[i] = S[i][1] * wb + db * vv[i]; } \
                _Pragma("unroll") for (int i = 0; i < 4; ++i) sa[i] = RW4_SUM16(sa[i]); \
                _Pragma("unroll") for (int i = 0; i < 4; ++i) { S[i][0] = na * sa[i] + u0[i]; S[i][1] = nb * sa[i] + u1[i]; const f32x2 q = S[i][0] * ra + S[i][1] * rb; yy[i] = q.x + q.y; } \
                _Pragma("unroll") for (int i = 0; i < 4; ++i) yy[i] = RW4_SUM16(yy[i]); \
                if (kq == 0) *(LAS f32x4*)(yb + (T) * 64 + v0) = (f32x4){yy[0], yy[1], yy[2], yy[3]}; } while (0)
            RW4_LD(0, kkA, wA, nA, dA, rA, vA);
#pragma unroll
            for (int tau = 0; tau < RS4_TOK; tau += 2) {
                RW4_LD(tau + 1, kkB, wB, nB, dB, rB, vB);
                RW4_STEP(tau, kkA, wA, nA, dA, rA, vA);
                if (tau + 2 < RS4_TOK) { RW4_LD(tau + 2, kkC, wC, nC, dC, rC, vC); kkA = kkC; wA = wC; nA = nC; dA = dC; rA = rC; vA = vC; }
                RW4_STEP(tau + 1, kkB, wB, nB, dB, rB, vB);
            }
#undef RW4_LD
#undef RW4_STEP
        }
        if (c + 1 < NCHUNK) RW4_WRITE((c + 1) & 1);
        half_bar(ctr, gen, lane);
        {
            const int row = rwkv_row(b, dir, c * RS4_TOK + st);
            const f32x2 yy = *(const LAS f32x2*)(yb + st * 64 + 2 * cp);
            *(unsigned*)(Y + (size_t)row * RD + ch) = pk2(yy.x, yy.y);
        }
    }
#undef RW4_LOAD
#undef RW4_WRITE
}
__device__ __forceinline__ void gla_scan_4w(const KC& k, int job, LAS unsigned* ctr) {
    const int b = job >> 5, h = (job >> 3) & 3, dir = (job >> 2) & 1, dvq = job & 3;
    const int tid = k.tid - 256, w = k.wave - 4, lane = k.lane, q4 = lane >> 4, l15 = lane & 15;
    const bf16* QG = (const bf16*)(k.ws + GL_QG) + (size_t)dir * TA * GKD; const bf16* KG = (const bf16*)(k.ws + GL_KG) + (size_t)dir * TA * GKD;
    const bf16* KE = (const bf16*)(k.ws + GL_KE) + (size_t)dir * TA * GKD; const bf16* VS = (const bf16*)(k.ws + GL_VS);
    const float* DEC = (const float*)(k.ws + GL_DEC); bf16* O = (bf16*)(k.ws + GL_O) + (size_t)dir * TA * GVD;
    LAS unsigned char* gl = k.lds + SC_GL;
    LAS bf16* QGs = (LAS bf16*)(gl + GL_QGS); LAS bf16* KGs = (LAS bf16*)(gl + GL_KGS); LAS bf16* STs = (LAS bf16*)(gl + GL_STS);
    LAS bf16* KEt = (LAS bf16*)(gl + GL_KET); LAS bf16* Vt = (LAS bf16*)(gl + GL_VT); LAS bf16* ATT = (LAS bf16*)(gl + GL_ATT); LAS float* decs = (LAS float*)(gl + GL_DECS);
    f32x4 accS[8];
#pragma unroll
    for (int t = 0; t < 8; ++t) accS[t] = (f32x4){0.f, 0.f, 0.f, 0.f};
    unsigned gen = 0;
#if GLA4_LEVEL == 2
    { float x = (float)lane; for (int i = 0; i < 200000; ++i) { x = x * 1.0001f + 0.5f; asm volatile("" : "+v"(x)); } asm volatile("" :: "v"(x)); (void)ctr; (void)gen; }
    return;
#endif
#if GLA4_LEVEL == 1
    for (int cp = 0; cp < NCH; ++cp) { float x = (float)lane; for (int i = 0; i < 2000; ++i) x = x * 1.0001f + 0.5f; asm volatile("" :: "v"(x)); half_bar(ctr, gen, lane); half_bar(ctr, gen, lane); half_bar(ctr, gen, lane); }
    return;
#endif
    for (int cp = 0; cp < NCH; ++cp) {
        const bool lat = cp >= 4; const int q = lat ? cp - 4 : cp, ncn = lat ? 32 : 4, cn = dir ? ncn - 1 - q : q, gch = lat ? 4 + cn : cn;
#define GROW(tau) gla_row(lat, b, dir ? 64 * cn + 63 - (tau) : 64 * cn + (tau))
#pragma unroll
        for (int i = 0; i < 4; ++i) {
            const int idx = tid + 256 * i, tau = idx >> 4, ck = idx & 15; const size_t go = (size_t)GROW(tau) * GKD + h * GDK + ck * 8;
            *(LAS u32x4*)(QGs + tau * GP1 + ck * 8) = *(const u32x4*)(QG + go);
            *(LAS u32x4*)(KGs + tau * GP1 + ck * 8) = *(const u32x4*)(KG + go);
            const u32x4 ke = *(const u32x4*)(KE + go);
            const unsigned kw[4] = {ke.x, ke.y, ke.z, ke.w};
#pragma unroll
            for (int e = 0; e < 4; ++e) { KEt[(ck * 8 + 2 * e) * GP2 + tau] = (bf16)(kw[e] & 0xffffu); KEt[(ck * 8 + 2 * e + 1) * GP2 + tau] = (bf16)(kw[e] >> 16); }
        }
#pragma unroll
        for (int i = 0; i < 2; ++i) {
            const int idx = tid + 256 * i, tau = idx >> 3, ck = idx & 7;
            const u32x4 vv = *(const u32x4*)(VS + (size_t)GROW(tau) * GVD + h * GDV + dvq * 64 + ck * 8);
            const unsigned vw[4] = {vv.x, vv.y, vv.z, vv.w};
#pragma unroll
            for (int e = 0; e < 4; ++e) { Vt[(ck * 8 + 2 * e) * GP2 + tau] = (bf16)(vw[e] & 0xffffu); Vt[(ck * 8 + 2 * e + 1) * GP2 + tau] = (bf16)(vw[e] >> 16); }
        }
        if (tid < 128) decs[tid] = DEC[((size_t)(dir * 8 + b) * NCH + gch) * GKD + h * GDK + tid];
#pragma unroll
        for (int t = 0; t < 8; ++t) {
#pragma unroll
            for (int r = 0; r < 4; ++r) STs[(16 * w + 4 * q4 + r) * GP1 + 16 * t + l15] = (bf16)f2bf(accS[t][r]);
        }
        half_bar(ctr, gen, lane);
#pragma unroll
        for (int jt = 0; jt < 4; ++jt) {
            f32x4 acc = (f32x4){0.f, 0.f, 0.f, 0.f};
#pragma unroll
            for (int ks = 0; ks < 4; ++ks) acc = __builtin_amdgcn_mfma_f32_16x16x32_bf16(ldfrag(QGs, 16 * w + l15, GP1, 32 * ks + 8 * q4), ldfrag(KGs, 16 * jt + l15, GP1, 32 * ks + 8 * q4), acc, 0, 0, 0);
#pragma unroll
            for (int r = 0; r < 4; ++r) { const int i = 16 * w + 4 * q4 + r, j = 16 * jt + l15; ATT[i * GP2 + j] = (bf16)f2bf(j <= i ? acc[r] : 0.f); }
        }
        half_bar(ctr, gen, lane);
#pragma unroll
        for (int dvt = 0; dvt < 4; ++dvt) {
            f32x4 acc = (f32x4){0.f, 0.f, 0.f, 0.f};
#pragma unroll
            for (int ks = 0; ks < 4; ++ks) acc = __builtin_amdgcn_mfma_f32_16x16x32_bf16(ldfrag(QGs, 16 * w + l15, GP1, 32 * ks + 8 * q4), ldfrag(STs, 16 * dvt + l15, GP1, 32 * ks + 8 * q4), acc, 0, 0, 0);
#pragma unroll
            for (int ks = 0; ks < 2; ++ks) acc = __builtin_amdgcn_mfma_f32_16x16x32_bf16(ldfrag(ATT, 16 * w + l15, GP2, 32 * ks + 8 * q4), ldfrag(Vt, 16 * dvt + l15, GP2, 32 * ks + 8 * q4), acc, 0, 0, 0);
#pragma unroll
#if GLA4_NOSTORE
            asm volatile("" :: "v"(acc[0]), "v"(acc[1]), "v"(acc[2]), "v"(acc[3]));
#else
            for (int r = 0; r < 4; ++r) { const int i = 16 * w + 4 * q4 + r; O[(size_t)GROW(i) * GVD + h * GDV + dvq * 64 + 16 * dvt + l15] = (bf16)f2bf(acc[r]); }
#endif
        }
#pragma unroll
        for (int t = 0; t < 8; ++t) {
            const float d = decs[16 * t + l15];
            accS[t] = accS[t] * d;
#pragma unroll
            for (int ks = 0; ks < 2; ++ks) accS[t] = __builtin_amdgcn_mfma_f32_16x16x32_bf16(ldfrag(Vt, 16 * w + l15, GP2, 32 * ks + 8 * q4), ldfrag(KEt, 16 * t + l15, GP2, 32 * ks + 8 * q4), accS[t], 0, 0, 0);
        }
        half_bar(ctr, gen, lane);
#undef GROW
    }
#if HB_FULL
    for (int i = 0; i < (1 + (CTXL + SEQ) / RS4_TOK) - 3 * NCH; ++i) __syncthreads();
#endif
}
__device__ __forceinline__ void ph_scan_split(const KC& k, int l, const float* k_a) {
    LAS unsigned* ctr = (LAS unsigned*)(k.lds + SC_CTR);
    for (int job = k.bid; job < 256; job += k.G) {
        if (k.tid == 0) { ctr[0] = 0u; ctr[16] = 0u; }
        __syncthreads();
#if SPLIT_SCAN == 1 || SPLIT_SCAN == 4 || SPLIT_SCAN == 5 || SPLIT_SCAN == 6
#if SWAP_HALVES
        { KC k2 = k; if (k.wave >= 4) { k2.tid = k.tid - 256; k2.wave = k.wave - 4; rwkv_scan_4w(k2, l, job, k_a, ctr); } else { k2.tid = k.tid + 256; k2.wave = k.wave + 4; gla_scan_4w(k2, job, ctr + 16); } }
#else
        if (k.wave < 4) rwkv_scan_4w(k, l, job, k_a, ctr); else gla_scan_4w(k, job, ctr + 16);
#endif
        __syncthreads();
#if SPLIT_SCAN == 6
        ph_rwkv_scan(k, l, job, k_a, WS_H);
#elif SPLIT_SCAN == 4
        ph_rwkv_scan(k, l, job, k_a);
#elif SPLIT_SCAN == 5
        ph_gla_scan(k, job);
#endif
#elif SPLIT_SCAN == 2
        if (k.wave < 4) rwkv_scan_4w(k, l, job, k_a, ctr);
        __syncthreads();
        ph_gla_scan(k, job);
#else
        if (k.wave >= 4) gla_scan_4w(k, job, ctr + 16);
        __syncthreads();
        ph_rwkv_scan(k, l, job, k_a);
#endif
    }
}

__device__ __forceinline__ void ph_post(const KC& k, int l, int nrows, const float* ln_g, const float* ln_b, const float* gng) {
    const int gw = k.bid * 8 + k.wave, NGW = k.G * 8, lane = k.lane, c = 16 * lane;
    const bf16* P = (const bf16*)(k.ws + WS_P);
    const bf16* Y = (const bf16*)(k.ws + RW_Y); const bf16* V = (const bf16*)(k.ws + RW_V); const float* BON = (const float*)(k.ws + RW_BON); bf16* YNB = (bf16*)(k.ws + RW_R);
    const bf16* O = (const bf16*)(k.ws + GL_O); bf16* YB = (bf16*)(k.ws + GL_VS);
    for (int row = gw; row < nrows; row += NGW) {
        {
            float yf[16], yb[16], vv[16], y[16];
            ld16(Y + (size_t)row * RD + c, true, yf); ld16(Y + ((size_t)TA + row) * RD + c, true, yb); ld16(V + (size_t)row * RD + c, true, vv);
            float s = 0.f;
#pragma unroll
            for (int i = 0; i < 16; ++i) { y[i] = yf[i] + yb[i]; s += y[i]; }
            s += __shfl_xor(s, 1); s += __shfl_xor(s, 2);
            const float mean = s * (1.0f / 64.0f); float q = 0.f;
#pragma unroll
            for (int i = 0; i < 16; ++i) { y[i] -= mean; q += y[i] * y[i]; }
            q += __shfl_xor(q, 1); q += __shfl_xor(q, 2);
            const float rstd = 1.0f / sqrtf(q * (1.0f / 64.0f) + 64e-5f), bon = BON[(size_t)row * RHEADS + (lane >> 2)];
#pragma unroll
            for (int i = 0; i < 16; ++i) y[i] = y[i] * rstd * ln_g[l * RD + c + i] + ln_b[l * RD + c + i] + bon * vv[i];
            st16(YNB + (size_t)row * RD + c, y);
        }
        {
            float of[16], ob[16], gt[16], o[16];
            ld16(O + (size_t)row * GVD + c, true, of); ld16(O + ((size_t)TA + row) * GVD + c, true, ob); ld16(P + (size_t)row * NP + GLA_GATE_OFF + c, true, gt);
            float s = 0.f;
#pragma unroll
            for (int i = 0; i < 16; ++i) { o[i] = of[i] + ob[i]; s += o[i] * o[i]; }
            s += __shfl_xor(s, 1); s += __shfl_xor(s, 2); s += __shfl_xor(s, 4); s += __shfl_xor(s, 8);
            const float rinv = 1.0f / sqrtf(s * (1.0f / 256.0f) + 1e-6f);
#pragma unroll
            for (int i = 0; i < 16; ++i) o[i] = o[i] * rinv * gng[l * GDV + ((c + i) & 255)] * siluf(gt[i]);
            st16(YB + (size_t)row * GVD + c, o);
        }
    }
}

#ifndef CHUNK_LOADS_FIRST
#define CHUNK_LOADS_FIRST 1
#endif
#ifndef CHUNK_PF
#define CHUNK_PF 1
#endif
#ifndef SUBST_PK
#define SUBST_PK 0
#endif
#ifndef CONS_UNROLL
#define CONS_UNROLL 1
#endif
#ifndef CHUNK_NOPS
#define CHUNK_NOPS 0
#endif
#ifndef PROD_PK
#define PROD_PK 0
#endif
#ifndef LDS_POISON
#define LDS_POISON 0
#endif
#ifndef CHUNK_DBG
#define CHUNK_DBG 0
#endif
constexpr int RC_XT = 0;
constexpr int RC_YH = RC_XT + 32 * 72 * 2;
constexpr int RC_BET = RC_YH + 64 * 24 * 2;
constexpr int RC_AM = RC_YH + 2 * 64 * 24 * 2;
constexpr int RC_P2 = RC_AM + 2048;
constexpr int RC_AKR = RC_P2 + 512;
constexpr int RC_ABR = RC_AKR + 512;
constexpr int RC_GC = RC_ABR + 512;
constexpr int RC_SLOT = RC_GC + 256;
static_assert(RC_SLOT == 14592 && 8 * RC_SLOT <= 131072 && 32 * 72 * 2 <= 2 * 64 * 24 * 2, "rwkv chunk lds");
__device__ __forceinline__ bf16x8 mk8(u32x2 lo, u32x2 hi) { u32x4 v = {lo.x, lo.y, hi.x, hi.y}; return __builtin_bit_cast(bf16x8, v); }
__device__ __forceinline__ int rwkv_chunk_rmin(int b, int dir, int c) {
    const int p0 = c * 16;
    if (p0 < CTXL) return TL + b * CTXL + (dir ? CTXL - 16 - p0 : p0);
    const int q = p0 - CTXL; return b * SEQ + (dir ? SEQ - 16 - q : q);
}
__device__ __forceinline__ unsigned f2bf_hi(float f) { return __float_as_uint(f) + 0x8000u; }
#ifndef FAST_RND
#define FAST_RND 1
#endif
#ifndef USE_RCP
#define USE_RCP 1
#endif
#ifndef CHUNK_SADDR
#define CHUNK_SADDR 1
#endif
#ifndef Y_SADDR
#define Y_SADDR 2
#endif
#if FAST_RND
#define BFH(x) ((bf16)(f2bf_hi(x) >> 16))
#else
#define BFH(x) ((bf16)f2bf(x))
#endif
template <int SKIP = 0>
__device__ __forceinline__ void ph_rwkv_chunk(const KC& k, int l, int job, const float* k_a, size_t yoff = RW_Y) {
    const int b = job >> 5, h = (job >> 1) & 15, dir = job & 1;
    const int w = k.wave, lane = k.lane, q4 = lane >> 4, l15 = lane & 15;
    const bf16* R = (const bf16*)(k.ws + RW_R); const bf16* KS = (const bf16*)(k.ws + RW_KS); const bf16* V = (const bf16*)(k.ws + RW_V); const bf16* KK = (const bf16*)(k.ws + RW_KK);
    const bf16* LO = (const bf16*)(k.ws + RW_LO); bf16* Y = (bf16*)(k.ws + yoff) + (size_t)dir * TA * RD;
    LAS unsigned char* slot = k.lds + w * RC_SLOT;
    LAS bf16* XT = (LAS bf16*)(slot + RC_XT); LAS bf16* YH = (LAS bf16*)(slot + RC_YH);
    LAS float* AM = (LAS float*)(slot + RC_AM);
    const int ch = h * RHS + lane;
    const float ka = k_a[l * RD + ch];
    f32x4 accZ[4];
#pragma unroll
    for (int t = 0; t < 4; ++t) accZ[t] = (f32x4){0.f, 0.f, 0.f, 0.f};
    constexpr int NCK = (CTXL + SEQ) / 16, NRND = NCK / 8;
    unsigned ylane[4];
#pragma unroll
    for (int r = 0; r < 4; ++r) { const int tk = 4 * q4 + r; ylane[r] = (unsigned)(((dir ? 15 - tk : tk) * RD + h * RHS + 16 * (w & 3) + l15) * 2); }
#if CHUNK_PF
    unsigned pf0 = 0u, pf1 = 0u, pf2 = 0u;
#endif
#if LDS_POISON
    for (int i = lane; i < RC_SLOT / 4; i += 64) ((LAS unsigned*)slot)[i] = 0x7fc07fc0u;
    __syncthreads();
#endif
    for (int rnd = 0; rnd < NRND; ++rnd) {
#if LDS_POISON
        for (int i = lane; i < RC_SLOT / 4; i += 64) ((LAS unsigned*)slot)[i] = 0x7fc07fc0u;
#endif
        if (!(SKIP & 2)) {
            const int c = rnd * 8 + w;
            float Lc = 0.f, Eprev = 1.f;
            unsigned vp[8];
#if CHUNK_LOADS_FIRST
            unsigned rv[16], rkk[16], re[16], ra[16], rks[16], rr[16];
            const unsigned rmin = (unsigned)rwkv_chunk_rmin(b, dir, c);
            const unsigned ob1 = (rmin * (unsigned)RD + (unsigned)ch) * 2u, ob4 = (rmin * 4096u + (unsigned)(dir * RD) + (unsigned)ch) * 2u;
            const char* LOa = (const char*)LO + 4096;
#pragma unroll
            for (int t = 0; t < 16; ++t) {
#if CHUNK_SADDR
                const unsigned tr = dir ? 15u - t : (unsigned)t;
                const unsigned o1 = ob1 + tr * (unsigned)(RD * 2), o4 = ob4 + tr * 8192u;
                if (SKIP & 4) { rv[t] = o1; rkk[t] = o1 >> 3; re[t] = 0x3c00u + (o4 & 255u); ra[t] = 0x3f00u; rks[t] = o1 >> 5; rr[t] = o1 >> 7; }
                else { rv[t] = *(const bf16*)((const char*)V + o1); rkk[t] = *(const bf16*)((const char*)KK + o1); re[t] = *(const bf16*)((const char*)LO + o4); ra[t] = *(const bf16*)(LOa + o4);
                       rks[t] = *(const bf16*)((const char*)KS + o1); rr[t] = *(const bf16*)((const char*)R + o1); }
#else
                const unsigned o1 = (unsigned)rwkv_row(b, dir, c * 16 + t) * (unsigned)RD + (unsigned)ch, o4 = o1 * 4u - 3u * (unsigned)ch + (unsigned)(dir * RD);
                if (SKIP & 4) { rv[t] = o1; rkk[t] = o1 >> 3; re[t] = 0x3c00u + (o4 & 255u); ra[t] = 0x3f00u; rks[t] = o1 >> 5; rr[t] = o1 >> 7; }
                else { rv[t] = V[o1]; rkk[t] = KK[o1]; re[t] = LO[o4]; ra[t] = LO[o4 + 2048u]; rks[t] = KS[o1]; rr[t] = R[o1]; }
#endif
            }
            asm volatile("" ::: "memory");
            const float omka = 1.0f - ka;
#pragma unroll
            for (int t = 0; t < ((SKIP & 16) ? 1 : 16); ++t) {
                { const unsigned vraw = rv[t]; vp[t >> 1] = (t & 1) ? (vp[t >> 1] | (vraw << 16)) : vraw; }
                const float kkv = bf2f(rkk[t]), ev = bf2f(re[t]), av = bf2f(ra[t]);
                const float ksv = bf2f(rks[t]), rv_ = bf2f(rr[t]);
                Lc -= ev;
#if USE_RCP
                const float E = __expf(Lc), Einv = __builtin_amdgcn_rcpf(E);
#else
                const float E = __expf(Lc), Einv = __expf(-Lc);
#endif
                XT[t * 72 + lane] = BFH(kkv * Eprev); XT[(16 + t) * 72 + lane] = BFH(rv_ * E);
                YH[t * 72 + lane] = BFH(kkv * av * Einv); YH[(16 + t) * 72 + lane] = BFH(ksv * __builtin_fmaf(av, ka, omka) * Einv);
                Eprev = E;
            }
#else
#pragma unroll
            for (int t = 0; t < 16; ++t) {
                const unsigned o1 = (unsigned)rwkv_row(b, dir, c * 16 + t) * (unsigned)RD + (unsigned)ch, o4 = o1 * 4u - 3u * (unsigned)ch + (unsigned)(dir * RD);
                { const unsigned vraw = V[o1]; vp[t >> 1] = (t & 1) ? (vp[t >> 1] | (vraw << 16)) : vraw; }
                const float kkv = bf2f(KK[o1]), ev = bf2f(LO[o4]), av = bf2f(LO[o4 + 2048u]);
                const float ksv = bf2f(KS[o1]), rv = bf2f(R[o1]);
                Lc -= ev;
                const float E = __expf(Lc), Einv = __expf(-Lc);
                XT[t * 72 + lane] = (bf16)f2bf(kkv * Eprev); XT[(16 + t) * 72 + lane] = (bf16)f2bf(rv * E);
                YH[t * 72 + lane] = (bf16)f2bf(kkv * av * Einv); YH[(16 + t) * 72 + lane] = (bf16)f2bf(ksv * (1.0f + (av - 1.0f) * ka) * Einv);
                Eprev = E;
            }
#endif
            const float eLC = Eprev;
            asm volatile("s_waitcnt lgkmcnt(0)" ::: "memory");
#if CHUNK_PF
            if (w >= 4) {
                const int cn0 = (rnd + 1 < NRND ? rnd + 1 : rnd) * 8;
                int ln = lane; asm volatile("" : "+v"(ln));
                auto pf_off = [&](int j) -> unsigned {
                    const int i = (w - 4) * 192 + j * 64 + ln, cc = i / 96, wi = i - cc * 96, ar = wi >> 4, tk = wi & 15;
                    const unsigned row = (unsigned)rwkv_row(b, dir, (cn0 + cc) * 16 + tk);
                    const unsigned base = ar == 0 ? (unsigned)RW_R : ar == 1 ? (unsigned)RW_KS : ar == 2 ? (unsigned)RW_V : ar == 3 ? (unsigned)RW_KK : (unsigned)RW_LO;
                    const unsigned el = ar < 4 ? row * (unsigned)RD + (unsigned)(h * RHS) : row * 4096u + (unsigned)(dir * RD + h * RHS) + (unsigned)(ar - 4) * 2048u;
                    return base + 2u * el; };
                const unsigned q0 = pf_off(0), q1 = pf_off(1), q2 = pf_off(2);
                asm volatile("global_load_dword %0, %3, %6\n\tglobal_load_dword %1, %4, %6\n\tglobal_load_dword %2, %5, %6" : "+v"(pf0), "+v"(pf1), "+v"(pf2) : "v"(q0), "v"(q1), "v"(q2), "s"(k.ws) : "memory");
            }
#endif
            f32x4 am[2][2];
#pragma unroll
            for (int rt = 0; rt < 2; ++rt)
#pragma unroll
                for (int ct = 0; ct < 2; ++ct) {
                    f32x4 acc = (f32x4){0.f, 0.f, 0.f, 0.f};
#pragma unroll
                    for (int s = 0; s < ((SKIP & 32) ? 0 : 2); ++s) acc = __builtin_amdgcn_mfma_f32_16x16x32_bf16(*(const LAS bf16x8*)(XT + (16 * rt + l15) * 72 + 32 * s + 8 * q4), *(const LAS bf16x8*)(YH + (16 * ct + l15) * 72 + 32 * s + 8 * q4), acc, 0, 0, 0);
                    am[rt][ct] = acc;
                }
            LAS bf16* AKR = (LAS bf16*)(slot + RC_AKR); LAS bf16* ABR = (LAS bf16*)(slot + RC_ABR);
#pragma unroll
            for (int r = 0; r < 4; ++r) {
                const int t = 4 * q4 + r, j = l15;
                AM[t * 16 + j] = j < t ? am[0][0][r] : 0.f;
                AM[256 + t * 16 + j] = j < t ? am[0][1][r] : 0.f;
#if PROD_PK
                const unsigned ab2 = pk2c(j <= t ? -am[1][0][r] : 0.f, j <= t ? am[1][1][r] : 0.f);
                ABR[t * 16 + j] = (bf16)(ab2 & 0xffffu);
                AKR[t * 16 + j] = (bf16)(ab2 >> 16);
#else
                ABR[t * 16 + j] = BFH(j <= t ? -am[1][0][r] : 0.f);
                AKR[t * 16 + j] = BFH(j <= t ? am[1][1][r] : 0.f);
#endif
            }
            asm volatile("s_waitcnt lgkmcnt(0)" ::: "memory");
#if SUBST_PK
            f32x2 PP[16]; float kt[16];
#pragma unroll
            for (int t = 0; t < 16; ++t) kt[t] = bf2f(XT[t * 72 + lane]);
#pragma unroll
            for (int t = 0; t < 16; ++t) {
                asm volatile("" ::: "memory");
                f32x2 p = {kt[t], AM[256 + t * 16 + l15]};
#pragma unroll
                for (int j4 = 0; j4 < (t + 3) / 4; ++j4) {
                    const f32x4 arow = *(const LAS f32x4*)(AM + t * 16 + 4 * j4);
#pragma unroll
                    for (int e = 0; e < 4; ++e) { const int j = 4 * j4 + e; if (j < t) p -= PP[j] * arow[e]; }
                }
                PP[t] = p;
            }
#else
            float P1[16], P2[16], kt[16];
#pragma unroll
            for (int t = 0; t < 16; ++t) kt[t] = bf2f(XT[t * 72 + lane]);
#pragma unroll
            for (int t = 0; t < 16; ++t) {
                asm volatile("" ::: "memory");
                float p1 = kt[t], p2 = AM[256 + t * 16 + l15];
#pragma unroll
                for (int j4 = 0; j4 < (t + 3) / 4; ++j4) {
                    const f32x4 arow = *(const LAS f32x4*)(AM + t * 16 + 4 * j4);
#pragma unroll
                    for (int e = 0; e < 4; ++e) { const int j = 4 * j4 + e; if (j < t && !(SKIP & 8)) { p1 -= arow[e] * P1[j]; p2 -= arow[e] * P2[j]; } }
                }
                P1[t] = p1; P2[t] = p2;
            }
#endif
            LAS bf16* P2b = (LAS bf16*)(slot + RC_P2);
#pragma unroll
#if PROD_PK
            for (int t = 0; t < 16; ++t) { const unsigned pp = pk2c(0.f, 0.f); XT[t * 72 + lane] = (bf16)(pp & 0xffffu); if (lane < 16) P2b[t * 16 + lane] = (bf16)(pp >> 16); }
#else
#if SUBST_PK
            for (int t = 0; t < 16; ++t) { if (CHUNK_DBG != 12) XT[t * 72 + lane] = (bf16)f2bf(CHUNK_DBG == 13 ? 1.0f + (float)t : PP[t].x); if (lane < 16) P2b[t * 16 + lane] = (bf16)f2bf(PP[t].y); }
#else
            for (int t = 0; t < 16; ++t) { XT[t * 72 + lane] = BFH(P1[t]); if (lane < 16) P2b[t * 16 + lane] = BFH(P2[t]); }
#endif
#endif
            if (!(SKIP & 64)) {
                LAS bf16* KET = (LAS bf16*)(slot + RC_YH); LAS bf16* BET = (LAS bf16*)(slot + RC_BET);
                float ke[16], be[16];
#pragma unroll
                for (int t = 0; t < 16; ++t) { ke[t] = bf2f(YH[(16 + t) * 72 + lane]) * eLC; be[t] = -bf2f(YH[t * 72 + lane]) * eLC; }
                asm volatile("s_waitcnt lgkmcnt(0)" ::: "memory");
                float a0[8], a1[8], b0[8], b1[8];
#pragma unroll
                for (int t = 0; t < 8; ++t) { a0[t] = ke[t]; a1[t] = ke[8 + t]; b0[t] = be[t]; b1[t] = be[8 + t]; }
                *(LAS u32x4*)(KET + lane * 24) = pack8(a0); *(LAS u32x4*)(KET + lane * 24 + 8) = pack8(a1);
                *(LAS u32x4*)(BET + lane * 24) = pack8(b0); *(LAS u32x4*)(BET + lane * 24 + 8) = pack8(b1);
                ((LAS float*)(slot + RC_GC))[lane] = eLC;
                *(LAS u32x4*)(slot + RC_AM + lane * 32) = (u32x4){vp[0], vp[1], vp[2], vp[3]}; *(LAS u32x4*)(slot + RC_AM + lane * 32 + 16) = (u32x4){vp[4], vp[5], vp[6], vp[7]};
            }
        }
        __syncthreads();
        if (w < 4 && !(SKIP & 1)) {
#if Y_SADDR == 2
            unsigned yoff[4]; const unsigned ystep = dir ? 0u - (unsigned)(16 * RD * 2) : (unsigned)(16 * RD * 2);
            { const unsigned yb = (unsigned)rwkv_chunk_rmin(b, dir, rnd * 8) * (unsigned)(RD * 2);
#pragma unroll
              for (int r = 0; r < 4; ++r) yoff[r] = yb + ylane[r]; }
#endif
#if CONS_UNROLL == 2
#pragma unroll 2
#else
#pragma unroll 1
#endif
            for (int cc = 0; cc < 8; ++cc) {
                const int c = rnd * 8 + cc;
                LAS unsigned char* sl = k.lds + cc * RC_SLOT;
                const LAS bf16* P1b = (const LAS bf16*)(sl + RC_XT); const LAS bf16* RTb = P1b + 16 * 72;
                const LAS bf16* KET = (const LAS bf16*)(sl + RC_YH); const LAS bf16* BET = (const LAS bf16*)(sl + RC_BET);
                const LAS bf16* P2b = (const LAS bf16*)(sl + RC_P2); const LAS bf16* AKR = (const LAS bf16*)(sl + RC_AKR); const LAS bf16* ABR = (const LAS bf16*)(sl + RC_ABR);
                const LAS float* GC = (const LAS float*)(sl + RC_GC);
                const u32x2 vfr = *(const LAS u32x2*)(sl + RC_AM + (16 * w + l15) * 32 + 8 * q4);
                const unsigned vlo = vfr.x, vhi = vfr.y;
#if CHUNK_DBG == 5
                for (int t = 0; t < 4; ++t) accZ[t] = (f32x4){0.f, 0.f, 0.f, 0.f};
#endif
#if CHUNK_NOPS
                asm volatile("s_nop 15\n\ts_nop 15" ::: "memory");
#endif
                bf16x8 bz[2];
#pragma unroll
                for (int s = 0; s < 2; ++s) { u32x4 v = {pk2c(accZ[2 * s][0], accZ[2 * s][1]), pk2c(accZ[2 * s][2], accZ[2 * s][3]), pk2c(accZ[2 * s + 1][0], accZ[2 * s + 1][1]), pk2c(accZ[2 * s + 1][2], accZ[2 * s + 1][3])}; bz[s] = __builtin_bit_cast(bf16x8, v); }
#if CHUNK_DBG == 6
                bz[0] = (bf16x8){0,0,0,0,0,0,0,0}; bz[1] = bz[0];
#endif
                const u32x2 zero2 = {0u, 0u};
                f32x4 zs[4];
#pragma unroll
                for (int t = 0; t < 4; ++t) zs[t] = accZ[t] * *(const LAS f32x4*)(GC + 16 * t + 4 * q4);
#if CHUNK_DBG == 7
                for (int t = 0; t < 4; ++t) zs[t] = (f32x4){0.f, 0.f, 0.f, 0.f};
#endif
                f32x4 sa = (f32x4){0.f, 0.f, 0.f, 0.f};
#if CHUNK_DBG >= 10 && CHUNK_DBG <= 13
                { u32x4 ones = {0x3f803f80u, 0x3f803f80u, 0x3f803f80u, 0x3f803f80u}; const bf16x8 bo = __builtin_bit_cast(bf16x8, ones);
                  for (int s = 0; s < 2; ++s) sa = __builtin_amdgcn_mfma_f32_16x16x32_bf16(mk8(*(const LAS u32x2*)(P1b + l15 * 72 + 32 * s + 4 * q4), *(const LAS u32x2*)(P1b + l15 * 72 + 32 * s + 16 + 4 * q4)), (CHUNK_DBG == 10 || CHUNK_DBG == 12 || CHUNK_DBG == 13) ? bo : bz[s], sa, 0, 0, 0); }
#else
#pragma unroll
                for (int s = 0; s < 2; ++s) if (CHUNK_DBG != 3 && CHUNK_DBG != 9) sa = __builtin_amdgcn_mfma_f32_16x16x32_bf16(mk8(*(const LAS u32x2*)(P1b + l15 * 72 + 32 * s + 4 * q4), *(const LAS u32x2*)(P1b + l15 * 72 + 32 * s + 16 + 4 * q4)), bz[s], sa, 0, 0, 0);
#endif
                if (CHUNK_DBG != 4 && !(CHUNK_DBG >= 10 && CHUNK_DBG <= 13)) { u32x4 bv = {vlo, vhi, 0u, 0u}; sa = __builtin_amdgcn_mfma_f32_16x16x32_bf16(mk8(*(const LAS u32x2*)(P2b + l15 * 16 + 4 * q4), zero2), __builtin_bit_cast(bf16x8, bv), sa, 0, 0, 0); }
#if CHUNK_DBG == 1
                sa = (f32x4){0.f, 0.f, 0.f, 0.f};
#endif
#if CHUNK_NOPS
                asm volatile("s_nop 15" : "+v"(sa));
#endif
                bf16x8 bv2; { u32x4 v = {vlo, vhi, pk2c(sa[0], sa[1]), pk2c(sa[2], sa[3])}; bv2 = __builtin_bit_cast(bf16x8, v); }
                f32x4 yy = (f32x4){0.f, 0.f, 0.f, 0.f};
#pragma unroll
                for (int s = 0; s < 2; ++s) if (CHUNK_DBG != 8) yy = __builtin_amdgcn_mfma_f32_16x16x32_bf16(mk8(*(const LAS u32x2*)(RTb + l15 * 72 + 32 * s + 4 * q4), *(const LAS u32x2*)(RTb + l15 * 72 + 32 * s + 16 + 4 * q4)), bz[s], yy, 0, 0, 0);
                yy = __builtin_amdgcn_mfma_f32_16x16x32_bf16(mk8(*(const LAS u32x2*)(AKR + l15 * 16 + 4 * q4), *(const LAS u32x2*)(ABR + l15 * 16 + 4 * q4)), bv2, yy, 0, 0, 0);
#pragma unroll
                for (int t = 0; t < 4; ++t) {
                    accZ[t] = __builtin_amdgcn_mfma_f32_16x16x32_bf16(mk8(*(const LAS u32x2*)(KET + (16 * t + l15) * 24 + 4 * q4), *(const LAS u32x2*)(BET + (16 * t + l15) * 24 + 4 * q4)), bv2, zs[t], 0, 0, 0);
                }
#if CHUNK_DBG == 2
                yy = (f32x4){1.f, 1.f, 1.f, 1.f};
#endif
#if CHUNK_DBG >= 10 && CHUNK_DBG <= 13
                yy = sa;
#endif
#if CHUNK_NOPS
                asm volatile("s_nop 15" : "+v"(yy));
#endif
#if Y_SADDR == 2
#pragma unroll
                for (int r = 0; r < 4; ++r) { *(bf16*)((char*)Y + yoff[r]) = BFH(yy[r]); yoff[r] += ystep; }
#elif Y_SADDR
                { const unsigned yb = (unsigned)rwkv_chunk_rmin(b, dir, c) * (unsigned)(RD * 2);
#pragma unroll
                  for (int r = 0; r < 4; ++r) *(bf16*)((char*)Y + (yb + ylane[r])) = BFH(yy[r]); }
#else
#pragma unroll
                for (int r = 0; r < 4; ++r) Y[(size_t)rwkv_row(b, dir, c * 16 + 4 * q4 + r) * RD + h * RHS + 16 * w + l15] = BFH(yy[r]);
#endif
            }
        }
#if CHUNK_PF
        else asm volatile("s_waitcnt vmcnt(0)" : "+v"(pf0), "+v"(pf1), "+v"(pf2) :: "memory");
#endif
        __syncthreads();
    }
}

#ifndef CHECK_EXACT
#define CHECK_EXACT 0
#endif
#ifndef CHECK_PMAX
#define CHECK_PMAX (CTXL + SEQ)
#endif
#ifndef CHECK_PMIN
#define CHECK_PMIN 0
#endif
#ifndef CHECK_UNIT
#define CHECK_UNIT 1000
#endif
__device__ __forceinline__ void rwkv_check_delay(const KC& k, int job, size_t refoff = RW_Y) {
    const int b = job >> 5, h = (job >> 1) & 15, dir = job & 1;
    const bf16* Ya = (const bf16*)(k.ws + refoff) + (size_t)dir * TA * RD; const bf16* Yb = (const bf16*)(k.ws + WS_H) + (size_t)dir * TA * RD;
    float d2 = 0.f, s2 = 0.f; int bad = 0;
    for (int i = k.tid; i < (CHECK_PMAX) * 32; i += 512) {
        const int p = (CHECK_PMIN) + (i >> 5), cp = i & 31; const size_t o = (size_t)rwkv_row(b, dir, p) * RD + h * RHS + 2 * cp;
        const unsigned ua = *(const unsigned*)(Ya + o), ub = *(const unsigned*)(Yb + o);
        const float a0 = bflo(ua), a1 = bfhi(ua), b0 = bflo(ub), b1 = bfhi(ub);
        d2 += (CHECK_EXACT) ? (ua != ub ? 1.0f : 0.0f) : (a0 - b0) * (a0 - b0) + (a1 - b1) * (a1 - b1); s2 += a0 * a0 + a1 * a1;
        if (!(b0 == b0) || !(b1 == b1) || fabsf(b0) > 1e30f || fabsf(b1) > 1e30f) bad = 1;
    }
    LAS float* red = (LAS float*)k.lds;
    __syncthreads();
    d2 = wave_sum(d2); s2 = wave_sum(s2); bad = __any(bad) ? 1 : 0;
    if (k.lane == 0) { red[k.wave * 4] = d2; red[k.wave * 4 + 1] = s2; red[k.wave * 4 + 2] = (float)bad; }
    __syncthreads();
    if (k.tid == 0) {
        float D = 0.f, S = 0.f, B = 0.f;
        for (int i = 0; i < 8; ++i) { D += red[i * 4]; S += red[i * 4 + 1]; B += red[i * 4 + 2]; }
        const float rel = sqrtf(D / fmaxf(S, 1e-30f));
        int bucket = rel < 0.01f ? 0 : rel < 0.03f ? 1 : rel < 0.1f ? 2 : rel < 0.3f ? 3 : rel < 1.0f ? 4 : 5;
        if (CHECK_EXACT) bucket = D == 0.f ? 0 : D < 10.f ? 1 : D < 100.f ? 2 : D < 1000.f ? 3 : D < 10000.f ? 4 : 5;
        if (B > 0.f || !(rel == rel)) bucket = 6;
        const unsigned long long t0 = __builtin_amdgcn_s_memrealtime(), wait = (unsigned long long)bucket * (CHECK_UNIT) * 100ull;
        while (__builtin_amdgcn_s_memrealtime() - t0 < wait) __builtin_amdgcn_s_sleep(8);
    }
    __syncthreads();
}
using pg8::Unit;
struct FP_ { bf16* P; __device__ __forceinline__ void operator()(int row, int col, float (&v)[8], const Unit&) const { *(u32x4*)(P + (size_t)row * NP + col) = pack8(v); } };
struct FL1_ { bf16* LO; const float* bias1;
    __device__ __forceinline__ void operator()(int row, int col, float (&v)[8], const Unit& u) const {
        const float* bias = bias1 + col;
        const f32x4 b0 = *(const f32x4*)bias, b1 = *(const f32x4*)(bias + 4);
        const float bb[8] = {b0.x, b0.y, b0.z, b0.w, b1.x, b1.y, b1.z, b1.w};
        const float sc = col < 2048 ? 0.6065306597126334f : 1.0f;
#pragma unroll
        for (int i = 0; i < 8; ++i) v[i] = sigm(bb[i] + v[i]) * sc;
        *(u32x4*)(LO + (size_t)row * 4096 + col) = pack8(v);
    } };
struct FL2_ { const bf16* YNB; bf16* YA;
    __device__ __forceinline__ void operator()(int row, int col, float (&v)[8], const Unit&) const {
        float y[8]; unpack8(*(const u32x4*)(YNB + (size_t)row * RD + col), y);
#pragma unroll
        for (int i = 0; i < 8; ++i) v[i] *= y[i];
        *(u32x4*)(YA + (size_t)row * RD + col) = pack8(v);
    } };
template <int SECOND> struct FM_ { const bf16* P; bf16* MA; bf16* OUT;
    __device__ __forceinline__ void operator()(int row, int col, float (&v)[8], const Unit&) const {
        float g[8]; unpack8(*(const u32x4*)(P + (size_t)row * NP + BR_OFF + SECOND * DM + col), g);
        const bf16* mp = MA + (size_t)row * DM + col;
        if (SECOND) { float m[8]; unpack8(*(const u32x4*)mp, m);
#pragma unroll
            for (int i = 0; i < 8; ++i) v[i] = sigm(g[i]) * v[i] + m[i]; }
        else {
#pragma unroll
            for (int i = 0; i < 8; ++i) v[i] = sigm(g[i]) * v[i]; }
        *(u32x4*)(OUT + (size_t)row * DM + col) = pack8(v);
    } };
struct FX_ { float* X; const float* MOD; int l; float* OUT;
    __device__ __forceinline__ void operator()(int row, int col, const f32x4 v, const Unit&) const {
        const f32x4 g = *(const f32x4*)(MOD + ((size_t)l * 9 + mod_row(row)) * MOD_N + 2 * DM + col);
        const f32x4* xp = (const f32x4*)(X + (size_t)row * DM + col);
        *(f32x4*)(OUT + (size_t)row * DM + col) = *xp + g * v;
    } };
struct FXb_ { bf16* X; const float* MOD; int l;
    __device__ __forceinline__ void operator()(int row, int col, float (&v)[8], const Unit&) const {
        const float* gp = MOD + ((size_t)l * 9 + mod_row(row)) * MOD_N + 2 * DM + col;
        const f32x4 g0 = *(const f32x4*)gp, g1 = *(const f32x4*)(gp + 4);
        const float gg[8] = {g0.x, g0.y, g0.z, g0.w, g1.x, g1.y, g1.z, g1.w};
        bf16* xp = X + (size_t)row * DM + col;
        float x[8]; unpack8(*(const u32x4*)xp, x);
#pragma unroll
        for (int i = 0; i < 8; ++i) v[i] = x[i] + gg[i] * v[i];
        *(u32x4*)xp = pack8(v);
    } };
struct FE1_ { bf16* ACT;
    __device__ __forceinline__ void operator()(int row, int col, float (&g)[8], float (&up)[8]) const {
#pragma unroll
        for (int i = 0; i < 8; ++i) g[i] = siluf(g[i]) * up[i];
        *(u32x4*)(ACT + (size_t)row * DEXP + col) = pack8(g);
    } };
struct FE2_ { const int* rowtok; const float* roww; bf16* YF;
    __device__ __forceinline__ void operator()(int row, int col, float (&v)[8], const Unit&) const {
        const int t2 = rowtok[row];
        if (t2 >= 0) { const float w = roww[row];
#pragma unroll
            for (int i = 0; i < 8; ++i) v[i] *= w;
            *(u32x4*)(YF + ((size_t)(t2 & 1) * TA + (t2 >> 1)) * DM + col) = pack8(v); }
    } };

#ifndef GA_
#define GA_ true
#endif
#ifndef GS_
#define GS_ true
#endif
constexpr int LDS_BYTES = 147456;
constexpr int MISC_OFF = 131072 + 4096;

constexpr int NPHASE = 2 + 14 * DEPTH + 1;
struct Args { const float* in[N_IN]; float* out; unsigned char* ws; int ph_lo, ph_hi; };
static_assert(sizeof(Args) == N_IN * 8 + 8 + 8 + 8, "Args has no padding");

__global__ void __launch_bounds__(512, 2) fwd(Args a) {
    extern __shared__ __attribute__((aligned(16))) unsigned char lds_raw[];
    KC k;
    k.lds = (LAS unsigned char*)lds_raw; k.ws = (unsigned char*)INP(N_IN + 1);
    k.tid = threadIdx.x; k.lane = k.tid & 63; k.wave = __builtin_amdgcn_readfirstlane(k.tid >> 6); k.G = gridDim.x; k.bid = blockIdx.x;
    const int lo = a.ph_lo, hi = a.ph_hi;
    volatile LAS unsigned* MISC = (volatile LAS unsigned*)(k.lds + MISC_OFF);
    if (k.tid < 32) MISC[k.tid] = 0u;
    __syncthreads();
    XcdBarrier bar; bar.bar = (unsigned*)(k.ws + WS_CTL) + CW_BAR; bar.x = 0; bar.st = nullptr;
    if (hi - lo > 1) bar = xcd_barrier_post((unsigned*)(k.ws + WS_CTL) + CW_BAR, MISC + 8);
#ifndef SITE_MASK
#define SITE_MASK 0xFFFFFFFFu
#endif
#define FRESH() do { int t_ = threadIdx.x; asm volatile("" : "+v"(t_)); k.tid = t_; k.lane = t_ & 63; k.wave = __builtin_amdgcn_readfirstlane(t_ >> 6); k.ws = (unsigned char*)INP(N_IN + 1); ws = k.ws; } while (0)
#define PH_BEGIN(p, site) if (((SITE_MASK >> (site)) & 1u) && lo <= (p) && (p) < hi) { FRESH();
#ifndef EXTRA_BARS
#define EXTRA_BARS 0
#endif
#ifndef DUP_MASK
#define DUP_MASK 0u
#endif
#define DUPRUN(n, stmt) do { stmt; if ((DUP_MASK >> (n)) & 1u) { __syncthreads(); stmt; } } while (0)
#define PH_END(p) if ((p) + 1 < hi) xcd_barrier(bar); }
    unsigned char* ws = k.ws;
    LAS unsigned char* glds = k.lds;
#define WSRC WSrc{INP(I_WIN), INP(I_W2), INP(I_A2), INP(I_G2), INP(I_WBA), INP(I_WBB), INP(I_WOUT), INP(I_EG), INP(I_EU), INP(I_ED), INP(I_W0), INP(I_A0)}

    PH_BEGIN(0, 0) DUPRUN(0, ph_adaln_partials(k, INP(I_C), INP(I_CCTX), INP(I_WADA))); DUPRUN(1, ph_convert(k, WSRC, 0)); PH_END(0)
    PH_BEGIN(1, 1) ph_adaln_reduce(k, INP(I_BADA)); PH_END(1)

#define L_ 0
    {
        constexpr int l = L_;
        const int pb = 2 + 14 * l;
        const bool last = (l == DEPTH - 1);
        const int Mpost = last ? TL : TA;
        PH_BEGIN(pb + 0, 2)
            if (l > 0) { DUPRUN(1, ph_convert(k, WSRC, l)); }
            RowArgs ra{INP(I_X), INP(I_CTX), INP(I_NMG), nullptr, nullptr, nullptr};
            ph_rows<0>(k, ra, l, TA);
            if (l == 0 && ((DUP_MASK >> 15) & 1u)) { __syncthreads(); ph_rows<0>(k, ra, l, TA); }
        PH_END(pb + 0)
        PH_BEGIN(pb + 1, 3)
            pg8::Gemm g{(const bf16*)(ws + WS_H), (const bf16*)(ws + WT_IN), TA, NP, DM, 0}; pg8::StaticOrder S; S.init(TA, NP, k.G, k.bid);
            pg8::Epi8<FP_> E{FP_{(bf16*)(ws + WS_P)}};
            DUPRUN(2, (pg8::gemm_phase<pg8::Epi8<FP_>, pg8::StaticOrder, GA_, GS_>(glds, g, S, E)));
        PH_END(pb + 1)
        PH_BEGIN(pb + 2, 4)
            DUPRUN(3, ph_rwkv_prep(k, l, TA, INP(I_MU), INP(I_KK), INP(I_RK)));
            DUPRUN(4, ph_gla_prep(k, l, INP(I_GCONV), INP(I_GAW2), INP(I_GAB)));
        PH_END(pb + 2)
        PH_BEGIN(pb + 3, 5)
            pg8::Gemm g{(const bf16*)(ws + RW_A1), (const bf16*)(ws + WT_L1), TA, 4096, 256, 0}; pg8::StaticOrder S; S.init(TA, 4096, k.G, k.bid);
            pg8::Epi8<FL1_> E{FL1_{(bf16*)(ws + RW_LO), (const float*)(ws + WS_TAB + TAB_TOP)}};
            DUPRUN(5, (pg8::gemm_phase<pg8::Epi8<FL1_>, pg8::StaticOrder, GA_, GS_>(glds, g, S, E)));
        PH_END(pb + 3)
        PH_BEGIN(pb + 4, 6)
#if SPLIT_SCAN
            DUPRUN(6, ph_scan_split(k, l, INP(I_KA)));
#else
            for (int vb = ((k.G & 7) ? k.bid : (k.bid & 7) * (k.G >> 3) + (k.bid >> 3)); vb < 256; vb += k.G) { const int job = vb;
#if RWKV_MODE == 0
                DUPRUN(6, ph_rwkv_scan(k, l, job, INP(I_KA)));
#elif RWKV_MODE == 1
                ph_rwkv_scan(k, l, job, INP(I_KA)); ph_rwkv_chunk(k, l, job, INP(I_KA), WS_H); if (l == 0) rwkv_check_delay(k, job);
#elif RWKV_MODE == 4
                ph_rwkv_scan(k, l, job, INP(I_KA)); ph_rwkv_chunk(k, l, job, INP(I_KA), WS_H); ph_rwkv_chunk(k, l, job, INP(I_KA), WS_END); if (l == 0) rwkv_check_delay(k, job, WS_END);
#elif RWKV_MODE == 5
#pragma unroll 1
                for (int rep = 0; rep < 2; ++rep) { int r_ = rep; asm volatile("" : "+s"(r_)); __syncthreads(); ph_rwkv_chunk(k, l, job, INP(I_KA), r_ ? (size_t)RW_Y : (size_t)WS_H); }
                if (l == 0) rwkv_check_delay(k, job);
#elif RWKV_MODE == 3
                ph_rwkv_scan(k, l, job, INP(I_KA)); ph_rwkv_scan(k, l, job, INP(I_KA), WS_H); if (l == 0) rwkv_check_delay(k, job);
#else
                DUPRUN(6, ph_rwkv_chunk(k, l, job, INP(I_KA)));
#ifdef CHUNK_PROBE
                __syncthreads(); ph_rwkv_chunk<CHUNK_PROBE>(k, l, job, INP(I_KA), WS_END);
#endif
#endif
            }
#ifndef NO_GLA
            FRESH();
            for (int vb = ((k.G & 7) ? k.bid : (k.bid & 7) * (k.G >> 3) + (k.bid >> 3)); vb < 256; vb += k.G) { const int job = vb; DUPRUN(7, ph_gla_scan(k, job)); }
#endif
#endif
        PH_END(pb + 4)
        PH_BEGIN(pb + 5, 7)
            DUPRUN(8, ph_post(k, l, Mpost, INP(I_LNG), INP(I_LNB), INP(I_GNG)));
        PH_END(pb + 5)
        PH_BEGIN(pb + 6, 8)
            pg8::Gemm g{(const bf16*)(ws + RW_A2), (const bf16*)(ws + WT_G2), Mpost, RD, 256, 0}; pg8::StaticOrder S; S.init(Mpost, RD, k.G, k.bid);
            pg8::Epi8<FL2_> E{FL2_{(const bf16*)(ws + RW_R), (bf16*)(ws + RW_V)}};
            DUPRUN(9, (pg8::gemm_phase<pg8::Epi8<FL2_>, pg8::StaticOrder, GA_, GS_>(glds, g, S, E)));
        PH_END(pb + 6)
        PH_BEGIN(pb + 7, 9)
            pg8::Gemm g{(const bf16*)(ws + RW_V), (const bf16*)(ws + WT_A), Mpost, DM, RD, 0}; pg8::StaticOrder S; S.init(Mpost, DM, k.G, k.bid);
            pg8::Epi8<FM_<0>> E{FM_<0>{(const bf16*)(ws + WS_P), (bf16*)(ws + WS_H), (bf16*)(ws + WS_H)}};
            DUPRUN(10, (pg8::gemm_phase<pg8::Epi8<FM_<0>>, pg8::StaticOrder, GA_, GS_>(glds, g, S, E)));
        PH_END(pb + 7)
        PH_BEGIN(pb + 8, 10)
            pg8::Gemm g{(const bf16*)(ws + GL_VS), (const bf16*)(ws + WT_B), Mpost, DM, GVD, 0}; pg8::StaticOrder S; S.init(Mpost, DM, k.G, k.bid);
            pg8::Epi8<FM_<1>> E{FM_<1>{(const bf16*)(ws + WS_P), (bf16*)(ws + WS_H), (bf16*)(ws + WS_H)}};
            pg8::gemm_phase<pg8::Epi8<FM_<1>>, pg8::StaticOrder, GA_, GS_>(glds, g, S, E);
            if ((DUP_MASK >> 17) & 1u) { __syncthreads(); pg8::Epi8<FM_<1>> E2{FM_<1>{(const bf16*)(ws + WS_P), (bf16*)(ws + WS_H), (bf16*)(ws + RW_R)}}; pg8::gemm_phase<pg8::Epi8<FM_<1>>, pg8::StaticOrder, GA_, GS_>(glds, g, S, E2); }
        PH_END(pb + 8)
        PH_BEGIN(pb + 9, 11)
            pg8::Gemm g{(const bf16*)(ws + WS_H), (const bf16*)(ws + WT_O), Mpost, DM, DM, 0}; pg8::StaticOrder S; S.init(Mpost, DM, k.G, k.bid);
#if XBF
            pg8::Epi8<FXb_> E{FXb_{(bf16*)(ws + WS_X), (const float*)(ws + WS_MOD), l}};
            pg8::gemm_phase<pg8::Epi8<FXb_>, pg8::StaticOrder, GA_, GS_>(glds, g, S, E);
#else
            pg8::Epi4<FX_> E{FX_{(float*)(ws + WS_X), (const float*)(ws + WS_MOD), l, (float*)(ws + WS_X)}};
            pg8::gemm_phase<pg8::Epi4<FX_>, pg8::StaticOrder, GA_, GS_>(glds, g, S, E);
#endif
            if (!XBF && ((DUP_MASK >> 18) & 1u)) { __syncthreads(); pg8::Epi4<FX_> E2{FX_{(float*)(ws + WS_X), (const float*)(ws + WS_MOD), l, (float*)(ws + WS_P)}}; pg8::gemm_phase<pg8::Epi4<FX_>, pg8::StaticOrder, GA_, GS_>(glds, g, S, E2); }
        PH_END(pb + 9)
        PH_BEGIN(pb + 10, 12)
            RowArgs ra{nullptr, nullptr, INP(I_NFG), INP(I_RW), INP(I_RB), nullptr};
            ph_rows<1>(k, ra, l, Mpost);
            if ((DUP_MASK >> 16) & 1u) { __syncthreads(); ph_rows<1>(k, ra, l, Mpost, true); }
        PH_END(pb + 10)
        PH_BEGIN(pb + 11, 13)
            DUPRUN(13, ph_moe_scatter(k, l, Mpost));
        PH_END(pb + 11)
        PH_BEGIN(pb + 12, 14)
#if MOE_GATHER
            pg8::Gemm g{(const bf16*)(ws + WS_H), (const bf16*)(ws + WT_GU), 0, 2816, DM, (size_t)2816 * DM * 2};
            pg8::MoeOrderT<true> S; S.rowtok = (const int*)(ws + WS_TAB + TAB_ROWTOK) + (size_t)l * MOE_ROWS;
            S.init((const int*)(ws + WS_TAB + TAB_TILE) + 256 * l, 11, k.G, ((k.G & 7) ? k.bid : (k.bid & 7) * (k.G >> 3) + (k.bid >> 3)));
            pg8::EpiGU<FE1_> E{FE1_{(bf16*)(ws + WS_ACT)}};
            DUPRUN(11, (pg8::gemm_phase<pg8::EpiGU<FE1_>, pg8::MoeOrderT<true>, GA_, GS_>(glds, g, S, E)));
#else
            pg8::Gemm g{(const bf16*)(ws + WS_HP), (const bf16*)(ws + WT_GU), 0, 2816, DM, (size_t)2816 * DM * 2};
            pg8::MoeOrder S; S.init((const int*)(ws + WS_TAB + TAB_TILE) + 256 * l, 11, k.G, ((k.G & 7) ? k.bid : (k.bid & 7) * (k.G >> 3) + (k.bid >> 3)));
            pg8::EpiGU<FE1_> E{FE1_{(bf16*)(ws + WS_ACT)}};
            DUPRUN(11, (pg8::gemm_phase<pg8::EpiGU<FE1_>, pg8::MoeOrder, GA_, GS_>(glds, g, S, E)));
#endif
        PH_END(pb + 12)
        PH_BEGIN(pb + 13, 15)
            pg8::Gemm g{(const bf16*)(ws + WS_ACT), (const bf16*)(ws + WT_D), 0, DM, DEXP, (size_t)DM * DEXP * 2};
            pg8::MoeOrder S; S.init((const int*)(ws + WS_TAB + TAB_TILE) + 256 * l, 8, k.G, ((k.G & 7) ? k.bid : (k.bid & 7) * (k.G >> 3) + (k.bid >> 3)));
            pg8::Epi8<FE2_> E{FE2_{(const int*)(ws + WS_TAB + TAB_ROWTOK) + (size_t)l * MOE_ROWS, (const float*)(ws + WS_TAB + TAB_ROWW) + (size_t)l * MOE_ROWS, (bf16*)(ws + WS_YF)}};
            DUPRUN(12, (pg8::gemm_phase<pg8::Epi8<FE2_>, pg8::MoeOrder, GA_, GS_>(glds, g, S, E)));
        PH_END(pb + 13)
        }
#undef L_
#define L_ 1
    {
        constexpr int l = L_;
        const int pb = 2 + 14 * l;
        const bool last = (l == DEPTH - 1);
        const int Mpost = last ? TL : TA;
        PH_BEGIN(pb + 0, 2)
            if (l > 0) { DUPRUN(1, ph_convert(k, WSRC, l)); }
            RowArgs ra{INP(I_X), INP(I_CTX), INP(I_NMG), nullptr, nullptr, nullptr};
            ph_rows<0>(k, ra, l, TA);
            if (l == 0 && ((DUP_MASK >> 15) & 1u)) { __syncthreads(); ph_rows<0>(k, ra, l, TA); }
        PH_END(pb + 0)
        PH_BEGIN(pb + 1, 3)
            pg8::Gemm g{(const bf16*)(ws + WS_H), (const bf16*)(ws + WT_IN), TA, NP, DM, 0}; pg8::StaticOrder S; S.init(TA, NP, k.G, k.bid);
            pg8::Epi8<FP_> E{FP_{(bf16*)(ws + WS_P)}};
            DUPRUN(2, (pg8::gemm_phase<pg8::Epi8<FP_>, pg8::StaticOrder, GA_, GS_>(glds, g, S, E)));
        PH_END(pb + 1)
        PH_BEGIN(pb + 2, 4)
            DUPRUN(3, ph_rwkv_prep(k, l, TA, INP(I_MU), INP(I_KK), INP(I_RK)));
            DUPRUN(4, ph_gla_prep(k, l, INP(I_GCONV), INP(I_GAW2), INP(I_GAB)));
        PH_END(pb + 2)
        PH_BEGIN(pb + 3, 5)
            pg8::Gemm g{(const bf16*)(ws + RW_A1), (const bf16*)(ws + WT_L1), TA, 4096, 256, 0}; pg8::StaticOrder S; S.init(TA, 4096, k.G, k.bid);
            pg8::Epi8<FL1_> E{FL1_{(bf16*)(ws + RW_LO), (const float*)(ws + WS_TAB + TAB_TOP)}};
            DUPRUN(5, (pg8::gemm_phase<pg8::Epi8<FL1_>, pg8::StaticOrder, GA_, GS_>(glds, g, S, E)));
        PH_END(pb + 3)
        PH_BEGIN(pb + 4, 6)
#if SPLIT_SCAN
            DUPRUN(6, ph_scan_split(k, l, INP(I_KA)));
#else
            for (int vb = ((k.G & 7) ? k.bid : (k.bid & 7) * (k.G >> 3) + (k.bid >> 3)); vb < 256; vb += k.G) { const int job = vb;
#if RWKV_MODE == 0
                DUPRUN(6, ph_rwkv_scan(k, l, job, INP(I_KA)));
#elif RWKV_MODE == 1
                ph_rwkv_scan(k, l, job, INP(I_KA)); ph_rwkv_chunk(k, l, job, INP(I_KA), WS_H); if (l == 0) rwkv_check_delay(k, job);
#elif RWKV_MODE == 4
                ph_rwkv_scan(k, l, job, INP(I_KA)); ph_rwkv_chunk(k, l, job, INP(I_KA), WS_H); ph_rwkv_chunk(k, l, job, INP(I_KA), WS_END); if (l == 0) rwkv_check_delay(k, job, WS_END);
#elif RWKV_MODE == 5
#pragma unroll 1
                for (int rep = 0; rep < 2; ++rep) { int r_ = rep; asm volatile("" : "+s"(r_)); __syncthreads(); ph_rwkv_chunk(k, l, job, INP(I_KA), r_ ? (size_t)RW_Y : (size_t)WS_H); }
                if (l == 0) rwkv_check_delay(k, job);
#elif RWKV_MODE == 3
                ph_rwkv_scan(k, l, job, INP(I_KA)); ph_rwkv_scan(k, l, job, INP(I_KA), WS_H); if (l == 0) rwkv_check_delay(k, job);
#else
                DUPRUN(6, ph_rwkv_chunk(k, l, job, INP(I_KA)));
#ifdef CHUNK_PROBE
                __syncthreads(); ph_rwkv_chunk<CHUNK_PROBE>(k, l, job, INP(I_KA), WS_END);
#endif
#endif
            }
#ifndef NO_GLA
            FRESH();
            for (int vb = ((k.G & 7) ? k.bid : (k.bid & 7) * (k.G >> 3) + (k.bid >> 3)); vb < 256; vb += k.G) { const int job = vb; DUPRUN(7, ph_gla_scan(k, job)); }
#endif
#endif
        PH_END(pb + 4)
        PH_BEGIN(pb + 5, 7)
            DUPRUN(8, ph_post(k, l, Mpost, INP(I_LNG), INP(I_LNB), INP(I_GNG)));
        PH_END(pb + 5)
        PH_BEGIN(pb + 6, 8)
            pg8::Gemm g{(const bf16*)(ws + RW_A2), (const bf16*)(ws + WT_G2), Mpost, RD, 256, 0}; pg8::StaticOrder S; S.init(Mpost, RD, k.G, k.bid);
            pg8::Epi8<FL2_> E{FL2_{(const bf16*)(ws + RW_R), (bf16*)(ws + RW_V)}};
            DUPRUN(9, (pg8::gemm_phase<pg8::Epi8<FL2_>, pg8::StaticOrder, GA_, GS_>(glds, g, S, E)));
        PH_END(pb + 6)
        PH_BEGIN(pb + 7, 9)
            pg8::Gemm g{(const bf16*)(ws + RW_V), (const bf16*)(ws + WT_A), Mpost, DM, RD, 0}; pg8::StaticOrder S; S.init(Mpost, DM, k.G, k.bid);
            pg8::Epi8<FM_<0>> E{FM_<0>{(const bf16*)(ws + WS_P), (bf16*)(ws + WS_H), (bf16*)(ws + WS_H)}};
            DUPRUN(10, (pg8::gemm_phase<pg8::Epi8<FM_<0>>, pg8::StaticOrder, GA_, GS_>(glds, g, S, E)));
        PH_END(pb + 7)
        PH_BEGIN(pb + 8, 10)
            pg8::Gemm g{(const bf16*)(ws + GL_VS), (const bf16*)(ws + WT_B), Mpost, DM, GVD, 0}; pg8::StaticOrder S; S.init(Mpost, DM, k.G, k.bid);
            pg8::Epi8<FM_<1>> E{FM_<1>{(const bf16*)(ws + WS_P), (bf16*)(ws + WS_H), (bf16*)(ws + WS_H)}};
            pg8::gemm_phase<pg8::Epi8<FM_<1>>, pg8::StaticOrder, GA_, GS_>(glds, g, S, E);
            if ((DUP_MASK >> 17) & 1u) { __syncthreads(); pg8::Epi8<FM_<1>> E2{FM_<1>{(const bf16*)(ws + WS_P), (bf16*)(ws + WS_H), (bf16*)(ws + RW_R)}}; pg8::gemm_phase<pg8::Epi8<FM_<1>>, pg8::StaticOrder, GA_, GS_>(glds, g, S, E2); }
        PH_END(pb + 8)
        PH_BEGIN(pb + 9, 11)
            pg8::Gemm g{(const bf16*)(ws + WS_H), (const bf16*)(ws + WT_O), Mpost, DM, DM, 0}; pg8::StaticOrder S; S.init(Mpost, DM, k.G, k.bid);
#if XBF
            pg8::Epi8<FXb_> E{FXb_{(bf16*)(ws + WS_X), (const float*)(ws + WS_MOD), l}};
            pg8::gemm_phase<pg8::Epi8<FXb_>, pg8::StaticOrder, GA_, GS_>(glds, g, S, E);
#else
            pg8::Epi4<FX_> E{FX_{(float*)(ws + WS_X), (const float*)(ws + WS_MOD), l, (float*)(ws + WS_X)}};
            pg8::gemm_phase<pg8::Epi4<FX_>, pg8::StaticOrder, GA_, GS_>(glds, g, S, E);
#endif
            if (!XBF && ((DUP_MASK >> 18) & 1u)) { __syncthreads(); pg8::Epi4<FX_> E2{FX_{(float*)(ws + WS_X), (const float*)(ws + WS_MOD), l, (float*)(ws + WS_P)}}; pg8::gemm_phase<pg8::Epi4<FX_>, pg8::StaticOrder, GA_, GS_>(glds, g, S, E2); }
        PH_END(pb + 9)
        PH_BEGIN(pb + 10, 12)
            RowArgs ra{nullptr, nullptr, INP(I_NFG), INP(I_RW), INP(I_RB), nullptr};
            ph_rows<1>(k, ra, l, Mpost);
            if ((DUP_MASK >> 16) & 1u) { __syncthreads(); ph_rows<1>(k, ra, l, Mpost, true); }
        PH_END(pb + 10)
        PH_BEGIN(pb + 11, 13)
            DUPRUN(13, ph_moe_scatter(k, l, Mpost));
        PH_END(pb + 11)
        PH_BEGIN(pb + 12, 14)
#if MOE_GATHER
            pg8::Gemm g{(const bf16*)(ws + WS_H), (const bf16*)(ws + WT_GU), 0, 2816, DM, (size_t)2816 * DM * 2};
            pg8::MoeOrderT<true> S; S.rowtok = (const int*)(ws + WS_TAB + TAB_ROWTOK) + (size_t)l * MOE_ROWS;
            S.init((const int*)(ws + WS_TAB + TAB_TILE) + 256 * l, 11, k.G, ((k.G & 7) ? k.bid : (k.bid & 7) * (k.G >> 3) + (k.bid >> 3)));
            pg8::EpiGU<FE1_> E{FE1_{(bf16*)(ws + WS_ACT)}};
            DUPRUN(11, (pg8::gemm_phase<pg8::EpiGU<FE1_>, pg8::MoeOrderT<true>, GA_, GS_>(glds, g, S, E)));
#else
            pg8::Gemm g{(const bf16*)(ws + WS_HP), (const bf16*)(ws + WT_GU), 0, 2816, DM, (size_t)2816 * DM * 2};
            pg8::MoeOrder S; S.init((const int*)(ws + WS_TAB + TAB_TILE) + 256 * l, 11, k.G, ((k.G & 7) ? k.bid : (k.bid & 7) * (k.G >> 3) + (k.bid >> 3)));
            pg8::EpiGU<FE1_> E{FE1_{(bf16*)(ws + WS_ACT)}};
            DUPRUN(11, (pg8::gemm_phase<pg8::EpiGU<FE1_>, pg8::MoeOrder, GA_, GS_>(glds, g, S, E)));
#endif
        PH_END(pb + 12)
        PH_BEGIN(pb + 13, 15)
            pg8::Gemm g{(const bf16*)(ws + WS_ACT), (const bf16*)(ws + WT_D), 0, DM, DEXP, (size_t)DM * DEXP * 2};
            pg8::MoeOrder S; S.init((const int*)(ws + WS_TAB + TAB_TILE) + 256 * l, 8, k.G, ((k.G & 7) ? k.bid : (k.bid & 7) * (k.G >> 3) + (k.bid >> 3)));
            pg8::Epi8<FE2_> E{FE2_{(const int*)(ws + WS_TAB + TAB_ROWTOK) + (size_t)l * MOE_ROWS, (const float*)(ws + WS_TAB + TAB_ROWW) + (size_t)l * MOE_ROWS, (bf16*)(ws + WS_YF)}};
            DUPRUN(12, (pg8::gemm_phase<pg8::Epi8<FE2_>, pg8::MoeOrder, GA_, GS_>(glds, g, S, E)));
        PH_END(pb + 13)
        }
#undef L_
#if EXTRA_BARS
    if (hi - lo > 1) { for (int i = 0; i < EXTRA_BARS; ++i) xcd_barrier(bar); }
#endif
    PH_BEGIN(NPHASE - 1, 16)
        RowArgs ra{nullptr, nullptr, INP(I_FNG), nullptr, nullptr, (float*)INP(N_IN)};
        DUPRUN(14, ph_rows<2>(k, ra, 0, TL));
    PH_END(NPHASE - 1)
}

#ifndef MK_SINGLE
#define MK_SINGLE 1
#endif
extern "C" void kernel_launch(void* const* d_in, const int* in_sizes, int n_in, void* d_out, int out_size, void* d_ws, size_t ws_size, hipStream_t stream) {
    static int grid = 0;
    if (grid == 0) {
        if (n_in != N_IN || out_size != TL * DM || ws_size < WS_END) { fprintf(stderr, "kernel_launch: unexpected problem (n_in %d out %d ws %zu need %zu)\n", n_in, out_size, ws_size, (size_t)WS_END); grid = -1; return; }
        int dev = 0, cus = 0;
        if (hipGetDevice(&dev) != hipSuccess || hipDeviceGetAttribute(&cus, hipDeviceAttributeMultiprocessorCount, dev) != hipSuccess) { grid = -1; return; }
        if (hipFuncSetAttribute((const void*)fwd, hipFuncAttributeMaxDynamicSharedMemorySize, LDS_BYTES) != hipSuccess) { grid = -1; return; }
        int per_cu = 0;
        if (hipOccupancyMaxActiveBlocksPerMultiprocessor(&per_cu, (const void*)fwd, 512, LDS_BYTES) != hipSuccess || per_cu < 1) fprintf(stderr, "kernel_launch: occupancy query says %d\n", per_cu);
        (void)hipGetLastError();
        grid = cus;
    }
    if (grid < 0) return;
    unsigned char* ws = (unsigned char*)d_ws;
    (void)hipMemsetAsync(ws + WS_CTL, 0, CTL_BYTES, stream);
    Args a{};
    for (int i = 0; i < N_IN; ++i) a.in[i] = (const float*)d_in[i];
    a.out = (float*)d_out; a.ws = ws;
#if MK_SINGLE
    a.ph_lo = 0; a.ph_hi = NPHASE;
    hipLaunchKernelGGL(fwd, dim3(grid), dim3(512), LDS_BYTES, stream, a);
#else
    for (int p = 0; p < NPHASE; ++p) { a.ph_lo = p; a.ph_hi = p + 1; hipLaunchKernelGGL(fwd, dim3(grid), dim3(512), LDS_BYTES, stream, a); }
#endif
}
```

```cpp
#include <hip/hip_runtime.h>
#include <cstdio>
#include <cstdint>

#define LAS __attribute__((address_space(3)))
#define GAS __attribute__((address_space(1)))
typedef unsigned short bf16;
typedef float f32x4 __attribute__((ext_vector_type(4)));
typedef float f32x2 __attribute__((ext_vector_type(2)));
typedef unsigned u32x4 __attribute__((ext_vector_type(4)));
typedef unsigned u32x2 __attribute__((ext_vector_type(2)));
typedef short bf16x8 __attribute__((ext_vector_type(8)));

constexpr int DM = 2048, NBATCH = 8, SEQ = 2048, CTXL = 256, DEPTH = 2;
constexpr int TL = NBATCH * SEQ, TC = NBATCH * CTXL, TA = TL + TC;
constexpr int RD = 1024, RHEADS = 16, RHS = 64;
constexpr int RWKV_IN = 3520;
constexpr int GKD = 512, GVD = 1024, GDK = 128, GDV = 256, GHEADS = 4, GQKV = 2048;
constexpr int GLA_OFF = 3520, GLA_AD_OFF = GLA_OFF + GQKV, GLA_GATE_OFF = 5584, BR_OFF = 6608, IN_DIM = 10704, NP = 10752;
constexpr int NEXP = 16, DEXP = 1408;
constexpr int MOD_N = 6 * DM;
constexpr int MOE_ROWS = 41216;
constexpr int MOE_TILES = MOE_ROWS / 256;
constexpr int NCH = 36;
constexpr int KSPLIT = 32;

enum { I_X = 0, I_C, I_CTX, I_CCTX, I_WADA, I_BADA, I_NMG, I_NFG, I_WIN, I_MU, I_W0, I_W2, I_A0, I_A2, I_G2, I_KK, I_KA, I_RK, I_LNG, I_LNB,
       I_GCONV, I_GAW2, I_GAB, I_GNG, I_WBA, I_WBB, I_WOUT, I_RW, I_RB, I_EG, I_EU, I_ED, I_FNG, N_IN };

constexpr size_t MiB = 1u << 20;
constexpr size_t WS_CTL = 0;
constexpr size_t WS_TAB = 1 * MiB;
constexpr size_t WS_MOD = 2 * MiB;
constexpr size_t WS_X = 3 * MiB;
constexpr size_t WS_H = WS_X + 144 * MiB;
constexpr size_t WS_P = WS_H + 72 * MiB;
constexpr size_t WS_RW = WS_P + 378 * MiB;
constexpr size_t WS_GL = WS_RW + 380 * MiB;
constexpr size_t WS_WT = WS_GL + 218 * MiB;
constexpr size_t WS_END = WS_WT + 325 * MiB;
constexpr int CW_TMO = 0, CW_CNT = 64  , CW_BAR = 4096;
constexpr size_t CTL_BYTES = 1 * MiB;
constexpr size_t TAB_ROWTOK = 0;
constexpr size_t TAB_ROWTOK_BYTES = 2 * (size_t)MOE_ROWS * 4;
constexpr size_t TAB_ROWW = 384 * 1024;
constexpr size_t TAB_TILE = 768 * 1024;
constexpr size_t TAB_TOP = 800 * 1024;
static_assert(TAB_ROWTOK_BYTES <= TAB_ROWW && TAB_ROWW + 2 * (size_t)MOE_ROWS * 4 <= TAB_TILE, "tab map");
constexpr size_t WS_MODP = WS_P;
constexpr size_t WS_HP = WS_P;
constexpr size_t WS_ACT = WS_P + 162 * MiB;
constexpr size_t WS_TOPK = WS_P + 274 * MiB;
static_assert((size_t)MOE_ROWS * DM * 2 <= 162 * MiB && (size_t)MOE_ROWS * DEXP * 2 <= 112 * MiB && 274 * MiB + 3 * (size_t)TA * 8 <= 378 * MiB, "P overlay");
constexpr size_t RW_R = WS_RW;
constexpr size_t RW_KS = RW_R + 36 * MiB;
constexpr size_t RW_V = RW_KS + 36 * MiB;
constexpr size_t RW_KK = RW_V + 36 * MiB;
constexpr size_t RW_LO = RW_KK + 36 * MiB;
constexpr size_t RW_Y = RW_LO + 144 * MiB;
constexpr size_t RW_A1 = RW_Y + 72 * MiB;
constexpr size_t RW_A2 = RW_A1 + 9 * MiB;
constexpr size_t RW_BON = RW_A2 + 9 * MiB;
static_assert(RW_BON + 2 * MiB <= WS_GL, "rwkv map");
constexpr size_t GL_QG = WS_GL;
constexpr size_t GL_KG = GL_QG + 36 * MiB;
constexpr size_t GL_KE = GL_KG + 36 * MiB;
constexpr size_t GL_VS = GL_KE + 36 * MiB;
constexpr size_t GL_O = GL_VS + 36 * MiB;
constexpr size_t GL_DEC = GL_O + 72 * MiB;
static_assert(GL_DEC + 2 * MiB <= WS_WT, "gla map");
constexpr size_t WS_YF = WS_GL;
constexpr size_t WT_IN = WS_WT;
constexpr size_t WT_L1 = WT_IN + 42 * MiB;
constexpr size_t WT_G2 = WT_L1 + 2 * MiB;
constexpr size_t WT_A = WT_G2 + 1 * MiB;
constexpr size_t WT_B = WT_A + 4 * MiB;
constexpr size_t WT_O = WT_B + 4 * MiB;
constexpr size_t WT_GU = WT_O + 8 * MiB;
constexpr size_t WT_D = WT_GU + 176 * MiB;
static_assert(WT_D + 88 * MiB == WS_END, "weight map");

#ifndef GLA_TP
#define GLA_TP 0
#endif
#ifndef GLA_TPW
#define GLA_TPW 0
#endif
#ifndef GLA_PF2
#define GLA_PF2 0
#endif
#ifndef MOE_GATHER
#define MOE_GATHER 1
#endif
#ifndef XBF
#define XBF 1
#endif
__device__ __forceinline__ float bf2f(unsigned v) { return __uint_as_float(v << 16); }
__device__ __forceinline__ float bflo(unsigned w) { return __uint_as_float(w << 16); }
__device__ __forceinline__ float bfhi(unsigned w) { return __uint_as_float(w & 0xffff0000u); }
__device__ __forceinline__ unsigned f2bf(float f) { unsigned u = __float_as_uint(f); return (u + 0x7fffu + ((u >> 16) & 1u)) >> 16; }
__device__ __forceinline__ unsigned pk2(float lo, float hi) { unsigned r; asm volatile("v_cvt_pk_bf16_f32 %0, %1, %2" : "=v"(r) : "v"(lo), "v"(hi)); return r; }
typedef __bf16 bf16x2_t __attribute__((ext_vector_type(2)));
__device__ __forceinline__ unsigned pk2c(float lo, float hi) { f32x2 v = {lo, hi}; bf16x2_t b = __builtin_convertvector(v, bf16x2_t); return __builtin_bit_cast(unsigned, b); }
__device__ __forceinline__ float sigm(float x) { return 1.0f / (1.0f + __expf(-x)); }
__device__ __forceinline__ float siluf(float x) { return x * sigm(x); }
__device__ __forceinline__ float wave_sum(float x) {
    x += __builtin_bit_cast(float, __builtin_amdgcn_update_dpp(0, __builtin_bit_cast(int, x), 0xB1, 0xF, 0xF, true));
    x += __builtin_bit_cast(float, __builtin_amdgcn_update_dpp(0, __builtin_bit_cast(int, x), 0x4E, 0xF, 0xF, true));
    x += __builtin_bit_cast(float, __builtin_amdgcn_update_dpp(0, __builtin_bit_cast(int, x), 0x141, 0xF, 0xF, true));
    x += __builtin_bit_cast(float, __builtin_amdgcn_update_dpp(0, __builtin_bit_cast(int, x), 0x140, 0xF, 0xF, true));
    const int xi = __builtin_bit_cast(int, x);
    return (__builtin_bit_cast(float, __builtin_amdgcn_readlane(xi, 0)) + __builtin_bit_cast(float, __builtin_amdgcn_readlane(xi, 16))) +
           (__builtin_bit_cast(float, __builtin_amdgcn_readlane(xi, 32)) + __builtin_bit_cast(float, __builtin_amdgcn_readlane(xi, 48)));
}
__device__ __forceinline__ void unpack8(const u32x4 w, float (&o)[8]) {
    o[0] = bflo(w.x); o[1] = bfhi(w.x); o[2] = bflo(w.y); o[3] = bfhi(w.y); o[4] = bflo(w.z); o[5] = bfhi(w.z); o[6] = bflo(w.w); o[7] = bfhi(w.w);
}
__device__ __forceinline__ u32x4 pack8(const float (&v)[8]) { u32x4 w; w.x = pk2(v[0], v[1]); w.y = pk2(v[2], v[3]); w.z = pk2(v[4], v[5]); w.w = pk2(v[6], v[7]); return w; }
namespace pg8 {
#define PG8_LAS __attribute__((address_space(3)))
typedef unsigned short bf16_t;
typedef short bf16x8 __attribute__((ext_vector_type(8)));
typedef float f32x4 __attribute__((ext_vector_type(4)));
typedef unsigned u32x4 __attribute__((ext_vector_type(4)));
constexpr int BM = 256, BK = 64, HALF = 128, HTB = HALF * BK * 2  , STAGE_BYTES = 8 * HTB, NXCD = 8, WGM = 8;

__host__ __device__ __forceinline__ int lds_byte(int r, int c) { const int st = (r >> 4) * 2 + (c >> 5), rr = r & 15, cc = c & 31, ob = rr * 64 + cc * 2; return st * 1024 + (ob ^ (((ob >> 9) & 1) << 5)); }
__host__ __device__ __forceinline__ void stage_rc(int b, int& R, int& C) { const int st = b / 1024, sb = b % 1024, swz = sb ^ (((sb >> 9) & 1) << 5); R = (st >> 1) * 16 + swz / 64; C = (st & 1) * 32 + (swz % 64) / 2; }
__host__ __device__ __forceinline__ int perm32(int rho) { const int n = rho >> 4, i = rho & 15; return 8 * (i >> 2) + 4 * n + (i & 3); }
struct Unit { int pm, pn, eb; };
struct Gemm { const bf16_t* A; const bf16_t* Bt; int M, N, K; size_t bstride; };

struct StaticOrder {
    static constexpr bool GATHER = false;
    int nM, nN, nwg, G, c;
    __host__ __device__ void init(int M, int N, int G_, int c_) { nM = M / BM; nN = N / BM; nwg = nM * nN; G = G_; c = c_; }
    __host__ __device__ bool next(int i, Unit& u) const {
        const long L = (long)i * G + c; if (L >= nwg) return false;
        int wgid = (int)L; { const int q = nwg / NXCD, r = nwg % NXCD, xcd = wgid % NXCD, off = wgid / NXCD; wgid = (xcd < r ? xcd * (q + 1) : r * (q + 1) + (xcd - r) * q) + off; }
        const int nig = WGM * nN, gid = wgid / nig, fm = gid * WGM, gsz = (nM - fm) < WGM ? (nM - fm) : WGM;
        u.pm = fm + ((wgid % nig) % gsz); u.pn = (wgid % nig) / gsz; u.eb = 0; return true;
    }
    __device__ __forceinline__ void a_ready(const Unit&) const {}
    __device__ __forceinline__ void done(const Unit&) const {}
};
template <bool GATHER_> struct MoeOrderT {
    static constexpr bool GATHER = GATHER_;
    const int* rowtok;
    const int* tab; int nT, nN, G, c;
    __device__ void init(const int* tab_, int nN_, int G_, int c_) { tab = tab_; nT = tab_[0]; nN = nN_; G = G_; c = c_; }
    __device__ bool next(int i, Unit& u) const {
        const long L = (long)i * G + c; if (L >= (long)nT * nN) return false;
        u.pm = (int)(L / nN); u.pn = (int)(L % nN); u.eb = tab[1 + u.pm]; return true;
    }
    __device__ __forceinline__ void a_ready(const Unit&) const {}
    __device__ __forceinline__ void done(const Unit&) const {}
};
using MoeOrder = MoeOrderT<false>;

template <class F> struct Epi8 {
    static constexpr bool PERM = true, AFTER_DRAIN = false;
    F f;
    __device__ __forceinline__ void operator()(const f32x4 (&acc)[2][2][4][2], const Unit& u, int wr, int wc, int fr, int fq) const {
        const int row0 = u.pm * BM + wr * 64 + fr, col0 = u.pn * BM + wc * 32 + 8 * fq;
#pragma unroll
        for (int ai = 0; ai < 2; ++ai)
#pragma unroll
            for (int m = 0; m < 4; ++m) {
#pragma unroll
                for (int bj = 0; bj < 2; ++bj) {
                    const f32x4 a = acc[ai][bj][m][0], b = acc[ai][bj][m][1];
                    float v[8] = {a[0], a[1], a[2], a[3], b[0], b[1], b[2], b[3]};
                    f(row0 + ai * HALF + m * 16, col0 + bj * HALF, v, u);
                }
            }
    }
};
template <class F> struct EpiGU {
    static constexpr bool PERM = true, AFTER_DRAIN = false;
    F f;
    __device__ __forceinline__ void operator()(const f32x4 (&acc)[2][2][4][2], const Unit& u, int wr, int wc, int fr, int fq) const {
        const int row0 = u.pm * BM + wr * 64 + fr, col0 = u.pn * HALF + wc * 32 + 8 * fq;
#pragma unroll
        for (int ai = 0; ai < 2; ++ai)
#pragma unroll
            for (int m = 0; m < 4; ++m) {
                const f32x4 g0 = acc[ai][0][m][0], g1 = acc[ai][0][m][1], u0 = acc[ai][1][m][0], u1 = acc[ai][1][m][1];
                float g[8] = {g0[0], g0[1], g0[2], g0[3], g1[0], g1[1], g1[2], g1[3]};
                float up[8] = {u0[0], u0[1], u0[2], u0[3], u1[0], u1[1], u1[2], u1[3]};
                f(row0 + ai * HALF + m * 16, col0, g, up);
            }
    }
};
template <class F> struct Epi4 {
    static constexpr bool PERM = false, AFTER_DRAIN = false;
    F f;
    __device__ __forceinline__ void operator()(const f32x4 (&acc)[2][2][4][2], const Unit& u, int wr, int wc, int fr, int fq) const {
        const int row0 = u.pm * BM + wr * 64 + fr, col0 = u.pn * BM + wc * 32 + 4 * fq;
#pragma unroll
        for (int ai = 0; ai < 2; ++ai)
#pragma unroll
            for (int m = 0; m < 4; ++m) {
#pragma unroll
                for (int bj = 0; bj < 2; ++bj)
#pragma unroll
                    for (int n = 0; n < 2; ++n) f(row0 + ai * HALF + m * 16, col0 + bj * HALF + n * 16, acc[ai][bj][m][n], u);
            }
    }
};
template <class Epi, class Sched, bool ALIGN_EPI = false, bool SP2 = false>
__device__ __forceinline__ void gemm_phase(PG8_LAS unsigned char* lds, const Gemm g, const Sched& S, const Epi& E) {
    int tid_o = threadIdx.x; asm volatile("" : "+v"(tid_o));
    const int tid = tid_o, wid = __builtin_amdgcn_readfirstlane(tid >> 6), lane = tid & 63, wr = wid >> 2, wc = wid & 3, fr = lane & 15, fq = lane >> 4;
    const int K = g.K, nt = K / BK;
    unsigned voffA[2], voffB[2];
#pragma unroll
    for (int i = 0; i < 2; ++i) { int R, C; stage_rc(tid * 16 + i * 8192, R, C); const int Rb = Epi::PERM ? ((R & ~31) + perm32(R & 31)) : R;
        voffA[i] = (unsigned)(R * K + C) * 2u; voffB[i] = (unsigned)(Rb * K + C) * 2u; }
    constexpr bool GATHER = Sched::GATHER;
    unsigned vA0[2] = {0u, 0u}, vA1[2] = {0u, 0u}, nA0[2] = {0u, 0u}, nA1[2] = {0u, 0u};
    const size_t kstep = (size_t)(BK * 2);
    const size_t hstep = (size_t)HALF * K * 2;
    const size_t tstep = 2 * hstep;
    const unsigned ldsw = (unsigned)wid * 1024u;
    const int aoff = lds_byte(wr * 64 + fr, fq * 8), boff = lds_byte(wc * 32 + fr, fq * 8);
#define PG8_SA(b, h) (((b) * 2 + (h)) * HTB)
#define PG8_SB(b, h) ((4 + (b) * 2 + (h)) * HTB)
#define PG8_STAGE(bufoff, gbase, voff) do { _Pragma("unroll") for (int _i = 0; _i < 2; ++_i) \
        __builtin_amdgcn_global_load_lds((const unsigned*)((const char*)(gbase) + (voff)[_i]), (PG8_LAS unsigned*)(lds + (bufoff) + ldsw + _i * 8192), 16, 0, 0); } while (0)
#define PG8_STAGE_A(bufoff, gptr, h, nx) do { if constexpr (GATHER) { unsigned go_[2]; _Pragma("unroll") for (int _j = 0; _j < 2; ++_j) go_[_j] = ((nx) && last_) ? ((h) ? nA1[_j] : nA0[_j]) : ((h) ? vA1[_j] : vA0[_j]); PG8_STAGE(bufoff, gptr, go_); } \
        else { PG8_STAGE(bufoff, (gptr) + (h) * hstep, voffA); } } while (0)
#define PG8_GOFS(u, o0, o1) do { const int* rt_ = S.rowtok + (size_t)(u).pm * BM; _Pragma("unroll") for (int _j = 0; _j < 2; ++_j) { int R_, C_; stage_rc(tid * 16 + _j * 8192, R_, C_); \
        const int t0_ = rt_[R_], t1_ = rt_[HALF + R_]; o0[_j] = (unsigned)((t0_ < 0 ? 0 : t0_ >> 1) * K + C_) * 2u; o1[_j] = (unsigned)((t1_ < 0 ? 0 : t1_ >> 1) * K + C_) * 2u; } } while (0)
#define PG8_LDA(dst, b, h) do { _Pragma("unroll") for (int m = 0; m < 4; ++m) _Pragma("unroll") for (int k = 0; k < 2; ++k) dst[m][k] = *(const PG8_LAS bf16x8*)(lds + PG8_SA(b, h) + aoff + m * 2048 + k * 1024); } while (0)
#define PG8_LDB(dst, b, h) do { _Pragma("unroll") for (int n = 0; n < 2; ++n) _Pragma("unroll") for (int k = 0; k < 2; ++k) dst[n][k] = *(const PG8_LAS bf16x8*)(lds + PG8_SB(b, h) + boff + n * 2048 + k * 1024); } while (0)
#define PG8_MMA(ai, bj, At, Bt) do { __builtin_amdgcn_s_setprio(1); _Pragma("unroll") for (int m = 0; m < 4; ++m) _Pragma("unroll") for (int n = 0; n < 2; ++n) _Pragma("unroll") for (int k = 0; k < 2; ++k) \
        acc[ai][bj][m][n] = __builtin_amdgcn_mfma_f32_16x16x32_bf16(Bt[n][k], At[m][k], acc[ai][bj][m][n], 0, 0, 0); __builtin_amdgcn_s_setprio(0); } while (0)
#define PG8_WAIT_V(n) asm volatile("s_waitcnt vmcnt(" #n ")" ::: "memory")
#define PG8_WAIT_L(n) asm volatile("s_waitcnt lgkmcnt(" #n ")" ::: "memory")
#define PG8_BAR __builtin_amdgcn_s_barrier()
#define PG8_SCHED __builtin_amdgcn_sched_barrier(0)
    Unit cur, nxt; int ui = 0;
    if (!S.next(0, cur)) return;
    f32x4 acc[2][2][4][2];
#pragma unroll
    for (int a = 0; a < 2; ++a)
#pragma unroll
        for (int b = 0; b < 2; ++b)
#pragma unroll
            for (int m = 0; m < 4; ++m)
#pragma unroll
                for (int n = 0; n < 2; ++n) acc[a][b][m][n] = (f32x4){0.f, 0.f, 0.f, 0.f};
    bf16x8 At[4][2], B0[2][2], B1[2][2];
    const char* cA = GATHER ? (const char*)g.A : (const char*)g.A + (size_t)cur.pm * tstep; const char* cB = (const char*)g.Bt + (size_t)cur.eb * g.bstride + (size_t)cur.pn * tstep;
    S.a_ready(cur);
    if constexpr (GATHER) PG8_GOFS(cur, vA0, vA1);
    constexpr bool last_ = false;
    if constexpr (SP2) {
        PG8_STAGE(PG8_SB(0, 0), cB, voffB); PG8_STAGE(PG8_SB(0, 1), cB + hstep, voffB); PG8_STAGE_A(PG8_SA(0, 0), cA, 0, 0); PG8_STAGE_A(PG8_SA(0, 1), cA, 1, 0);
        if (wr == 1) PG8_BAR;
        PG8_WAIT_V(2); PG8_BAR;
        PG8_STAGE(PG8_SB(1, 0), cB + kstep, voffB); PG8_STAGE_A(PG8_SA(1, 0), cA + kstep, 0, 0); PG8_STAGE(PG8_SB(1, 1), cB + hstep + kstep, voffB);
        PG8_WAIT_V(6); PG8_BAR;
    } else {
        PG8_STAGE(PG8_SB(0, 0), cB, voffB); PG8_STAGE_A(PG8_SA(0, 0), cA, 0, 0); PG8_STAGE(PG8_SB(0, 1), cB + hstep, voffB); PG8_STAGE_A(PG8_SA(0, 1), cA, 1, 0);
        if (wr == 1) PG8_BAR;
        PG8_WAIT_V(4); PG8_BAR;
        PG8_STAGE(PG8_SB(1, 0), cB + kstep, voffB); PG8_STAGE_A(PG8_SA(1, 0), cA + kstep, 0, 0); PG8_STAGE(PG8_SB(1, 1), cB + hstep + kstep, voffB);
        PG8_WAIT_V(6); PG8_BAR;
    }
    for (;;) {
        const bool has_next = S.next(ui + 1, nxt);
        const char* nA = (has_next && !GATHER) ? (const char*)g.A + (size_t)nxt.pm * tstep : cA;
        if constexpr (GATHER) { if (has_next) PG8_GOFS(nxt, nA0, nA1); else { _Pragma("unroll") for (int _j = 0; _j < 2; ++_j) { nA0[_j] = vA0[_j]; nA1[_j] = vA1[_j]; } } } const char* nB = has_next ? (const char*)g.Bt + (size_t)nxt.eb * g.bstride + (size_t)nxt.pn * tstep : cB;
#pragma nounroll
        for (int t = 0; t < nt; t += 2) {
            const bool last = (t == nt - 2); const bool last_ = last;
            const char* a1 = cA + (size_t)(t + 1) * kstep;
            const char* a2 = last ? nA : cA + (size_t)(t + 2) * kstep; const char* b2 = last ? nB : cB + (size_t)(t + 2) * kstep;
            const char* a3 = a2 + kstep; const char* b3 = b2 + kstep;
            if (last && has_next) S.a_ready(nxt);
            if constexpr (SP2) {
            PG8_LDB(B0, 0, 0); PG8_LDB(B1, 0, 1); PG8_SCHED; PG8_LDA(At, 0, 0); PG8_STAGE_A(PG8_SA(1, 1), a1, 1, 0);
            PG8_WAIT_V(8); PG8_WAIT_L(0); PG8_BAR; PG8_MMA(0, 0, At, B0); PG8_MMA(0, 1, At, B1); PG8_BAR; PG8_SCHED;
            PG8_LDA(At, 0, 1); PG8_STAGE(PG8_SB(0, 0), b2, voffB); PG8_STAGE(PG8_SB(0, 1), b2 + hstep, voffB); PG8_STAGE_A(PG8_SA(0, 0), a2, 0, 1);
            PG8_WAIT_V(8); PG8_WAIT_L(0); PG8_BAR; PG8_MMA(1, 0, At, B0); PG8_MMA(1, 1, At, B1); PG8_BAR; PG8_SCHED;
            PG8_LDB(B0, 1, 0); PG8_LDB(B1, 1, 1); PG8_SCHED; PG8_LDA(At, 1, 0); PG8_STAGE_A(PG8_SA(0, 1), a2, 1, 1);
            PG8_WAIT_V(8); PG8_WAIT_L(0); PG8_BAR; PG8_MMA(0, 0, At, B0); PG8_MMA(0, 1, At, B1); PG8_BAR; PG8_SCHED;
            PG8_LDA(At, 1, 1); PG8_STAGE(PG8_SB(1, 0), b3, voffB); PG8_STAGE(PG8_SB(1, 1), b3 + hstep, voffB); PG8_STAGE_A(PG8_SA(1, 0), a3, 0, 1);
            PG8_WAIT_V(8); PG8_WAIT_L(0); PG8_BAR; PG8_MMA(1, 0, At, B0); PG8_MMA(1, 1, At, B1); PG8_BAR; PG8_SCHED;
            } else {
            PG8_LDB(B0, 0, 0); PG8_SCHED; PG8_LDA(At, 0, 0); PG8_STAGE_A(PG8_SA(1, 1), a1, 1, 0);
            PG8_WAIT_L(8); PG8_BAR; PG8_WAIT_L(0); PG8_MMA(0, 0, At, B0); PG8_BAR; PG8_SCHED;
            PG8_LDB(B1, 0, 1); PG8_STAGE(PG8_SB(0, 0), b2, voffB);
            PG8_BAR; PG8_WAIT_L(0); PG8_MMA(0, 1, At, B1); PG8_BAR;
            PG8_LDA(At, 0, 1); PG8_STAGE_A(PG8_SA(0, 0), a2, 0, 1);
            PG8_BAR; PG8_WAIT_L(0); PG8_MMA(1, 0, At, B0); PG8_BAR; PG8_SCHED;
            PG8_STAGE(PG8_SB(0, 1), b2 + hstep, voffB);
            PG8_WAIT_V(6); PG8_BAR; PG8_MMA(1, 1, At, B1); PG8_BAR;
            PG8_LDB(B0, 1, 0); PG8_SCHED; PG8_LDA(At, 1, 0); PG8_STAGE_A(PG8_SA(0, 1), a2, 1, 1);
            PG8_WAIT_L(8); PG8_BAR; PG8_WAIT_L(0); PG8_MMA(0, 0, At, B0); PG8_BAR; PG8_SCHED;
            PG8_LDB(B1, 1, 1); PG8_STAGE(PG8_SB(1, 0), b3, voffB);
            PG8_BAR; PG8_WAIT_L(0); PG8_MMA(0, 1, At, B1); PG8_BAR;
            PG8_LDA(At, 1, 1); PG8_STAGE_A(PG8_SA(1, 0), a3, 0, 1);
            PG8_BAR; PG8_WAIT_L(0); PG8_MMA(1, 0, At, B0); PG8_BAR; PG8_SCHED;
            PG8_STAGE(PG8_SB(1, 1), b3 + hstep, voffB);
            PG8_WAIT_V(6); PG8_BAR; PG8_MMA(1, 1, At, B1); PG8_BAR;
            }
        }
        if constexpr (ALIGN_EPI) { if (wr == 0) PG8_BAR; }
        if constexpr (!Epi::AFTER_DRAIN) { E(acc, cur, wr, wc, fr, fq); S.done(cur); }
        if (!has_next) break;
#pragma unroll
        for (int a = 0; a < 2; ++a)
#pragma unroll
            for (int b = 0; b < 2; ++b)
#pragma unroll
                for (int m = 0; m < 4; ++m)
#pragma unroll
                    for (int n = 0; n < 2; ++n) acc[a][b][m][n] = (f32x4){0.f, 0.f, 0.f, 0.f};
        cur = nxt; cA = nA; cB = nB; ++ui;
        if constexpr (GATHER) { _Pragma("unroll") for (int _j = 0; _j < 2; ++_j) { vA0[_j] = nA0[_j]; vA1[_j] = nA1[_j]; } }
        if constexpr (ALIGN_EPI) { if (wr == 1) PG8_BAR; }
    }
    PG8_WAIT_V(0);
    if constexpr (!ALIGN_EPI) { if (wr == 0) PG8_BAR; }
    PG8_BAR;
    if constexpr (Epi::AFTER_DRAIN) { E.fused(acc, cur, wr, wc, fr, fq, lds, wid, lane); S.done(cur); }
#undef PG8_SA
#undef PG8_SB
#undef PG8_STAGE
#undef PG8_STAGE_A
#undef PG8_GOFS
#undef PG8_LDA
#undef PG8_LDB
#undef PG8_MMA
#undef PG8_WAIT_V
#undef PG8_WAIT_L
#undef PG8_BAR
#undef PG8_SCHED
}
}

#ifndef PG8_SP2
#define PG8_SP2 true
#endif
#ifndef PG8_ALIGN
#define PG8_ALIGN true
#endif
#define XB_TMO      128
#define XB_XCNT(j)  (256  + 64 * (j))
#define XB_XSUB(j)  (1280 + 64 * (j))
#define XB_XGEN(j)  (2304 + 64 * (j))
#define XB_TOP      3328
#define XB_TOPGEN   3392
#define XCD_BAR_WORDS 3456
#define XB_SPIN_CAP (1u << 18)

__device__ __forceinline__ unsigned xb_ld(unsigned* p)              { return __hip_atomic_load(p, __ATOMIC_RELAXED, __HIP_MEMORY_SCOPE_AGENT); }
__device__ __forceinline__ unsigned xb_add(unsigned* p, unsigned v) { return __hip_atomic_fetch_add(p, v, __ATOMIC_RELAXED, __HIP_MEMORY_SCOPE_AGENT); }
__device__ __forceinline__ unsigned xb_xcc_id() { return (unsigned)__builtin_amdgcn_s_getreg((3 << 11) | 20) & 0xFu; }
#define XB_SPIN(cond, bar) do { unsigned _sp = 0; while (cond) { __builtin_amdgcn_s_sleep(1); \
    if ((++_sp & 255u) == 0u) { if (xb_ld(&(bar)[XB_TMO])) break; if (_sp > XB_SPIN_CAP) { atomicAdd(&(bar)[XB_TMO], 1u); break; } } } } while (0)

struct XcdBarrier {
    unsigned* bar; unsigned x;
    volatile LAS unsigned* st;
};

__device__ __forceinline__ XcdBarrier xcd_barrier_post(unsigned* bar, volatile LAS unsigned* st) {
    XcdBarrier b; b.bar = bar; b.x = xb_xcc_id(); b.st = st;
    if (threadIdx.x == 0) (void)xb_add(&bar[XB_XCNT(b.x)], 1u);
    return b;
}
__device__ __forceinline__ void xcd_barrier_complete(unsigned* bar, unsigned x, unsigned& nloc, unsigned& nx) {
    const unsigned G = gridDim.x * gridDim.y * gridDim.z;
    unsigned sum, cnt, mine, sp = 0u;
    for (;;) {
        sum = 0u; cnt = 0u; mine = 0u;
#pragma unroll
        for (unsigned j = 0; j < 16; ++j) { const unsigned c = xb_ld(&bar[XB_XCNT(j)]); sum += c; cnt += (c > 0u) ? 1u : 0u; mine = (j == x) ? c : mine; }
        if (sum == G) break;
        __builtin_amdgcn_s_sleep(1);
        if ((++sp & 255u) == 0u) { if (xb_ld(&bar[XB_TMO])) break; if (sp > XB_SPIN_CAP) { atomicAdd(&bar[XB_TMO], 1u); break; } }
    }
    nloc = mine > 0u ? mine : 1u; nx = cnt > 0u ? cnt : 1u;
}

__device__ __forceinline__ void xcd_barrier(const XcdBarrier& b) {
    asm volatile("s_waitcnt vmcnt(0)" ::: "memory");
    __syncthreads();
    if (threadIdx.x == 0) {
        unsigned* bar = b.bar;
        __builtin_amdgcn_s_waitcnt(0);
        unsigned nloc = b.st[0], nx = b.st[1];
        if (nloc == 0u) { xcd_barrier_complete(bar, b.x, nloc, nx); b.st[0] = nloc; b.st[1] = nx; }
        const unsigned old = xb_add(&bar[XB_XSUB(b.x)], 1u);
        const unsigned gen = old / nloc;
        if (old + 1u == (gen + 1u) * nloc) {
            __builtin_amdgcn_fence(__ATOMIC_RELEASE, "agent");
            asm volatile("s_waitcnt vmcnt(0)" ::: "memory");
            const unsigned og = xb_add(&bar[XB_TOP], 1u);
            const unsigned tg = og / nx;
            if (og + 1u == (tg + 1u) * nx) xb_add(&bar[XB_TOPGEN], 1u);
            else XB_SPIN(xb_ld(&bar[XB_TOPGEN]) == tg, bar);
            __builtin_amdgcn_fence(__ATOMIC_ACQUIRE, "agent");
            xb_add(&bar[XB_XGEN(b.x)], 1u);
            asm volatile("s_waitcnt vmcnt(0)" ::: "memory");
        } else {
            XB_SPIN(xb_ld(&bar[XB_XGEN(b.x)]) == gen, bar);
            __builtin_amdgcn_fence(__ATOMIC_ACQUIRE, "agent");
            asm volatile("s_waitcnt vmcnt(0)" ::: "memory");
        }
    }
    __syncthreads();
}
struct KC {
    const float* const* in;
    LAS unsigned char* lds;
    unsigned char* ws;
    int tid, lane, wave, G, bid;
};
__device__ __forceinline__ const float* inp_(int i) {
    const volatile unsigned long long __attribute__((address_space(4)))* kp = (const volatile unsigned long long __attribute__((address_space(4)))*)__builtin_amdgcn_kernarg_segment_ptr();
    return (const float*)(const GAS float*)kp[i];
}
#define INP(k) (inp_(k))

__device__ __forceinline__ int mod_row(int row) { return row < TL ? (row >> 11) : 8; }

__device__ __forceinline__ void ph_adaln_partials(const KC& k, const float* c, const float* c_ctx, const float* w_ada) {
    LAS float* sc = (LAS float*)k.lds;
    for (int i = k.tid; i < 9 * DM; i += 512) { const int r = i >> 11, kk = i & 2047; const float cv = r < 8 ? c[r * DM + kk] : c_ctx[kk]; sc[i] = siluf(cv); }
    __syncthreads();
    float* modp = (float*)(k.ws + WS_MODP);
    const int cc = k.tid & 255, kh = k.tid >> 8;
    constexpr int NIT = DEPTH * 48 * 16;
    for (int it = k.bid; it < NIT; it += k.G) {
        const int l = it / 768, rem = it % 768, cb = rem >> 4, ks = rem & 15;
        const int col = cb * 256 + cc, kbeg = ks * 128 + kh * 64;
        const float* W = w_ada + ((size_t)l * DM + kbeg) * MOD_N + col;
        float acc[9];
#pragma unroll
        for (int r = 0; r < 9; ++r) acc[r] = 0.f;
#pragma unroll 32
        for (int q = 0; q < 64; ++q) {
            const float w = W[(size_t)q * MOD_N];
#pragma unroll
            for (int r = 0; r < 9; ++r) acc[r] += sc[r * DM + kbeg + q] * w;
        }
        const int s = ks * 2 + kh;
#pragma unroll
        for (int r = 0; r < 9; ++r) modp[(((size_t)s * DEPTH + l) * 9 + r) * MOD_N + col] = acc[r];
    }
    __syncthreads();
}
__device__ __forceinline__ void ph_adaln_reduce(const KC& k, const float* b_ada) {
    const float* modp = (const float*)(k.ws + WS_MODP); float* mod = (float*)(k.ws + WS_MOD);
    constexpr int TOT = DEPTH * 9 * MOD_N;
    for (int i = k.bid * 512 + k.tid; i < TOT; i += k.G * 512) {
        const int n = i % MOD_N, l = i / (9 * MOD_N);
        float s = b_ada[l * MOD_N + n];
#pragma unroll 8
        for (int q = 0; q < KSPLIT; ++q) s += modp[(size_t)q * TOT + i];
        mod[i] = s;
    }
}

struct TrItem { const float* src; bf16* dst; int srcN, Kv, Nv, k0, n0, dpitch, drow0, dk0; };
struct WSrc { const float *w_in, *w2, *a2, *g2, *wba, *wbb, *wout, *eg, *eu, *ed, *w0, *a0; };
constexpr int TI_IN = 32 * 336, TI_LO = 4 * 64, TI_G2 = 4 * 32, TI_AB = 16 * 64, TI_O = 32 * 64, TI_GU1 = 32 * 44, TI_D1 = 22 * 64;
constexpr int TI_N = TI_IN + TI_LO + TI_G2 + 2 * TI_AB + TI_O + 2 * NEXP * TI_GU1 + NEXP * TI_D1;
__device__ __forceinline__ TrItem tr_decode(const WSrc& s, unsigned char* ws, int l, int it) {
    TrItem t; int r = it;
    if (r < TI_IN) { const int kb = r / 336, nb = r % 336; t = TrItem{s.w_in + (size_t)l * DM * IN_DIM, (bf16*)(ws + WT_IN), IN_DIM, DM, IN_DIM, 64 * kb, 32 * nb, DM, 32 * nb, 0}; return t; } r -= TI_IN;
    if (r < TI_LO) {
        const int mtx = r >> 6, q = r & 63, kb = q >> 5, nb = q & 31;
        t = TrItem{(mtx < 2 ? s.w2 : s.a2) + (size_t)(l * 2 + (mtx & 1)) * 96 * RD, (bf16*)(ws + WT_L1), RD, 96, RD, 64 * kb, 32 * nb, 256, mtx * 1024 + 32 * nb, mtx < 2 ? 0 : 96}; return t; } r -= TI_LO;
    if (r < TI_G2) { const int kb = r >> 5, nb = r & 31; t = TrItem{s.g2 + (size_t)l * 256 * RD, (bf16*)(ws + WT_G2), RD, 256, RD, 64 * kb, 32 * nb, 256, 32 * nb, 0}; return t; } r -= TI_G2;
    if (r < TI_AB) { const int kb = r >> 6, nb = r & 63; t = TrItem{s.wba + (size_t)l * RD * DM, (bf16*)(ws + WT_A), DM, RD, DM, 64 * kb, 32 * nb, RD, 32 * nb, 0}; return t; } r -= TI_AB;
    if (r < TI_AB) { const int kb = r >> 6, nb = r & 63; t = TrItem{s.wbb + (size_t)l * GVD * DM, (bf16*)(ws + WT_B), DM, GVD, DM, 64 * kb, 32 * nb, GVD, 32 * nb, 0}; return t; } r -= TI_AB;
    if (r < TI_O) { const int kb = r >> 6, nb = r & 63; t = TrItem{s.wout + (size_t)l * DM * DM, (bf16*)(ws + WT_O), DM, DM, DM, 64 * kb, 32 * nb, DM, 32 * nb, 0}; return t; } r -= TI_O;
    if (r < 2 * NEXP * TI_GU1) {
        const int e = r / (2 * TI_GU1), q = r % (2 * TI_GU1), up = q / TI_GU1, q2 = q % TI_GU1, kb = q2 / 44, nb = q2 % 44;
        const int n0 = 32 * nb, drow = 256 * (n0 >> 7) + (n0 & 127) + (up ? 128 : 0);
        t = TrItem{(up ? s.eu : s.eg) + ((size_t)l * NEXP + e) * DM * DEXP, (bf16*)(ws + WT_GU) + (size_t)e * 2816 * DM, DEXP, DM, DEXP, 64 * kb, n0, DM, drow, 0}; return t; } r -= 2 * NEXP * TI_GU1;
    { const int e = r / TI_D1, q = r % TI_D1, kb = q >> 6, nb = q & 63;
      t = TrItem{s.ed + ((size_t)l * NEXP + e) * DEXP * DM, (bf16*)(ws + WT_D) + (size_t)e * DM * DEXP, DM, DEXP, DM, 64 * kb, 32 * nb, DEXP, 32 * nb, 0}; }
    return t;
}
__device__ __forceinline__ void tr_load(const TrItem& t, int lane, float (&v)[32]) {
    const int nn = lane & 31, kh = lane >> 5;
    const bool nok = t.n0 + nn < t.Nv;
    const float* p = t.src + (size_t)(t.k0 + kh) * t.srcN + t.n0 + nn;
#pragma unroll
    for (int i = 0; i < 32; ++i) { v[i] = 0.f; if (nok && t.k0 + 2 * i + kh < t.Kv) v[i] = p[(size_t)(2 * i) * t.srcN]; }
}
__device__ __forceinline__ void tr_store(const TrItem& t, int lane, const float (&v)[32], LAS float* scr) {
    const int nn = lane & 31, kh = lane >> 5;
#pragma unroll
    for (int i = 0; i < 32; ++i) scr[(2 * i + kh) * 33 + nn] = v[i];
    asm volatile("s_waitcnt lgkmcnt(0)" ::: "memory");
    const int cidx = lane & 7;
#pragma unroll
    for (int j = 0; j < 4; ++j) {
        const int n = (lane >> 3) + 8 * j; const LAS float* s = scr + (8 * cidx) * 33 + n;
        u32x4 o; o.x = pk2(s[0 * 33], s[1 * 33]); o.y = pk2(s[2 * 33], s[3 * 33]); o.z = pk2(s[4 * 33], s[5 * 33]); o.w = pk2(s[6 * 33], s[7 * 33]);
        *(u32x4*)(t.dst + (size_t)(t.drow0 + n) * t.dpitch + t.dk0 + t.k0 + 8 * cidx) = o;
    }
    asm volatile("s_waitcnt lgkmcnt(0)" ::: "memory");
}
__device__ __forceinline__ void ph_convert(const KC& k, const WSrc& s, int l) {
    LAS float* scr = (LAS float*)(k.lds + k.wave * 16384);
    const int gw = k.bid * 8 + k.wave, NGW = k.G * 8;
    unsigned char* ws = k.ws;
    { float* b1 = (float*)(ws + WS_TAB + TAB_TOP); for (int i = gw * 64 + k.lane; i < 4096; i += NGW * 64) b1[i] = i < 2048 ? s.w0[l * 2048 + i] : s.a0[l * 2048 + i - 2048]; }
    {
        u32x4* wl = (u32x4*)(ws + WT_L1);
        for (int i = gw * 64 + k.lane; i < 4096 * 32; i += NGW * 64) { const int row = i >> 5, ck = i & 31; if (row < 2048 ? ck >= 16 : (ck < 12 || ck >= 28)) wl[i] = (u32x4){0u, 0u, 0u, 0u}; }
        if (l == 0) { int* rt = (int*)(ws + WS_TAB + TAB_ROWTOK); for (int i = gw * 64 + k.lane; i < 2 * MOE_ROWS; i += NGW * 64) rt[i] = -1; }
    }
    float cur[32], nxt[32];
    int it = gw;
    TrItem tc = tr_decode(s, ws, l, it < TI_N ? it : 0);
    if (it < TI_N) tr_load(tc, k.lane, cur);
    for (; it < TI_N; it += NGW) {
        const bool more = it + NGW < TI_N;
        const TrItem tn = tr_decode(s, ws, l, more ? it + NGW : it);
        if (more) tr_load(tn, k.lane, nxt);
        tr_store(tc, k.lane, cur, scr);
        tc = tn;
#pragma unroll
        for (int i = 0; i < 32; ++i) cur[i] = nxt[i];
    }
}

constexpr int RWP = DM + 4;
struct RowArgs { const float *x_in, *ctx_in, *gvec, *router_w, *router_b; float* out; };
template <int MODE>
__device__ __forceinline__ void ph_rows(const KC& k, const RowArgs& ra, int l, int nrows, bool dry = false) {
    const int gw = k.bid * 8 + k.wave, NGW = k.G * 8, lane = k.lane;
    float* X = (float*)(k.ws + WS_X); bf16* H = (bf16*)(k.ws + WS_H);
    bf16* Xb = (bf16*)(k.ws + WS_X);
    const float* MOD = (const float*)(k.ws + WS_MOD);
    const bf16* YF = (const bf16*)(k.ws + WS_YF);
    LAS float* rwT = (LAS float*)k.lds;
    if (MODE == 1) {
        for (int i = k.tid; i < DM * NEXP; i += 512) { const int c = i >> 4, e = i & 15; rwT[e * RWP + c] = ra.router_w[i]; }
        __syncthreads();
    }
    const float* gv = ra.gvec;
    for (int row = gw; row < nrows; row += NGW) {
        const int mr = mod_row(row);
        f32x4 v[8];
        if (MODE == 0 && l == 0) {
            const f32x4* src = (const f32x4*)(row < TL ? ra.x_in + (size_t)row * DM : ra.ctx_in + (size_t)(row - TL) * DM) + lane;
#pragma unroll
            for (int j = 0; j < 8; ++j) v[j] = src[64 * j];
        } else if (XBF) {
            const u32x2* src = (const u32x2*)(Xb + (size_t)row * DM) + lane;
#pragma unroll
            for (int j = 0; j < 8; ++j) { const u32x2 a = src[64 * j]; v[j] = (f32x4){bflo(a.x), bfhi(a.x), bflo(a.y), bfhi(a.y)}; }
        } else {
            const f32x4* src = (const f32x4*)(X + (size_t)row * DM) + lane;
#pragma unroll
            for (int j = 0; j < 8; ++j) v[j] = src[64 * j];
        }
        if ((MODE == 0 && l > 0) || MODE == 2) {
            const int lp = (MODE == 2) ? DEPTH - 1 : l - 1;
            const f32x4* gate = (const f32x4*)(MOD + ((size_t)lp * 9 + mr) * MOD_N + 5 * DM) + lane;
            const u32x2* y0 = (const u32x2*)(YF + (size_t)row * DM) + lane;
            const u32x2* y1 = (const u32x2*)(YF + ((size_t)TA + row) * DM) + lane;
#pragma unroll
            for (int j = 0; j < 8; ++j) {
                const f32x4 g = gate[64 * j]; const u32x2 a = y0[64 * j], b = y1[64 * j];
                v[j].x += g.x * (bflo(a.x) + bflo(b.x)); v[j].y += g.y * (bfhi(a.x) + bfhi(b.x));
                v[j].z += g.z * (bflo(a.y) + bflo(b.y)); v[j].w += g.w * (bfhi(a.y) + bfhi(b.y));
            }
        }
        if (MODE == 0 && XBF) {
            u32x2* dst = (u32x2*)(Xb + (size_t)row * DM) + lane;
#pragma unroll
            for (int j = 0; j < 8; ++j) { u32x2 o; o.x = pk2(v[j].x, v[j].y); o.y = pk2(v[j].z, v[j].w); dst[64 * j] = o; }
        } else if (MODE == 0) {
            f32x4* dst = (f32x4*)(X + (size_t)row * DM) + lane;
#pragma unroll
            for (int j = 0; j < 8; ++j) dst[64 * j] = v[j];
        }
        float ss = 0.f;
#pragma unroll
        for (int j = 0; j < 8; ++j) ss += (v[j].x * v[j].x + v[j].y * v[j].y) + (v[j].z * v[j].z + v[j].w * v[j].w);
        const float rinv = 1.0f / sqrtf(wave_sum(ss) * (1.0f / DM) + 1e-6f);
        if (MODE == 2) {
            f32x4* dst = (f32x4*)(ra.out + (size_t)row * DM) + lane; const f32x4* g4 = (const f32x4*)gv + lane;
#pragma unroll
            for (int j = 0; j < 8; ++j) { const f32x4 g = g4[64 * j]; dst[64 * j] = v[j] * rinv * g; }
        } else {
            const float* mrow = MOD + ((size_t)l * 9 + mr) * MOD_N + (MODE == 0 ? 0 : 3 * DM);
            const f32x4* sh4 = (const f32x4*)mrow + lane; const f32x4* sc4 = (const f32x4*)(mrow + DM) + lane; const f32x4* g4 = (const f32x4*)(gv + (size_t)l * DM) + lane;
            u32x2* dst = (u32x2*)(H + (size_t)row * DM) + lane;
#pragma unroll
            for (int j = 0; j < 8; ++j) {
                const f32x4 g = g4[64 * j], sh = sh4[64 * j], sc = sc4[64 * j];
                v[j] = v[j] * rinv * g * (1.0f + sc) + sh;
                u32x2 o; o.x = pk2(v[j].x, v[j].y); o.y = pk2(v[j].z, v[j].w); dst[64 * j] = o;
            }
        }
        if (MODE == 1) {
            float lg[NEXP];
#pragma unroll
            for (int e = 0; e < NEXP; ++e) {
                float s = 0.f;
#pragma unroll
                for (int j = 0; j < 8; ++j) { const f32x4 w = *(const LAS f32x4*)(rwT + e * RWP + 4 * lane + 256 * j); s += (v[j].x * w.x + v[j].y * w.y) + (v[j].z * w.z + v[j].w * w.w); }
                lg[e] = wave_sum(s);
            }
            float sc[NEXP], sel[NEXP];
#pragma unroll
            for (int e = 0; e < NEXP; ++e) { sc[e] = 1.0f / (1.0f + expf(-lg[e])); sel[e] = sc[e] + ra.router_b[e]; }
            float gs[4], w1g[4], w2g[4]; int i1g[4], i2g[4];
#pragma unroll
            for (int g = 0; g < 4; ++g) {
                int i1 = 0; float m1 = sel[4 * g];
#pragma unroll
                for (int q = 1; q < 4; ++q) if (sel[4 * g + q] > m1) { m1 = sel[4 * g + q]; i1 = q; }
                int i2 = -1; float m2 = -3.0e38f;
#pragma unroll
                for (int q = 0; q < 4; ++q) if (q != i1 && sel[4 * g + q] > m2) { m2 = sel[4 * g + q]; i2 = q; }
                gs[g] = m1 + m2; i1g[g] = 4 * g + i1; i2g[g] = 4 * g + i2;
                float a1 = sc[4 * g], a2 = sc[4 * g];
#pragma unroll
                for (int q = 0; q < 4; ++q) { a1 = (q == i1) ? sc[4 * g + q] : a1; a2 = (q == i2) ? sc[4 * g + q] : a2; }
                w1g[g] = a1; w2g[g] = a2;
            }
            int best = 0; float bs = gs[0];
#pragma unroll
            for (int g = 1; g < 4; ++g) if (gs[g] > bs) { bs = gs[g]; best = g; }
            int e1 = i1g[0], e2 = i2g[0]; float w1 = w1g[0], w2 = w2g[0];
#pragma unroll
            for (int g = 1; g < 4; ++g) { e1 = (best == g) ? i1g[g] : e1; e2 = (best == g) ? i2g[g] : e2; w1 = (best == g) ? w1g[g] : w1; w2 = (best == g) ? w2g[g] : w2; }
            const float inv = 1.0f / (w1 + w2);
            if (lane == 0 && !dry) {
                unsigned* cnt = (unsigned*)(k.ws + WS_CTL) + CW_CNT + 64 * l;
                const int p1 = (int)atomicAdd(cnt + e1, 1u), p2 = (int)atomicAdd(cnt + e2, 1u);
                int* te = (int*)(k.ws + WS_TOPK); float* tw = (float*)(k.ws + WS_TOPK + (size_t)TA * 8); int* tp = (int*)(k.ws + WS_TOPK + 2 * (size_t)TA * 8);
                te[2 * row] = e1; te[2 * row + 1] = e2; tw[2 * row] = w1 * inv; tw[2 * row + 1] = w2 * inv; tp[2 * row] = p1; tp[2 * row + 1] = p2;
            }
        }
    }
    if (MODE == 1) __syncthreads();
}

__device__ __forceinline__ void ph_moe_scatter(const KC& k, int l, int nrows) {
    LAS int* offs = (LAS int*)k.lds;
    const unsigned* cnt = (const unsigned*)(k.ws + WS_CTL) + CW_CNT + 64 * l;
    int* tile = (int*)(k.ws + WS_TAB + TAB_TILE) + 256 * l;
    if (k.tid == 0) {
        int off = 0, nt = 0;
        for (int e = 0; e < NEXP; ++e) {
            offs[e] = off; const int c = (int)__hip_atomic_load(cnt + e, __ATOMIC_RELAXED, __HIP_MEMORY_SCOPE_AGENT); const int t = (c + 255) >> 8;
            if (k.bid == 0) for (int q = 0; q < t; ++q) tile[1 + nt + q] = e;
            nt += t; off += t * 256;
        }
        if (k.bid == 0) tile[0] = nt;
    }
    __syncthreads();
    const int gw = k.bid * 8 + k.wave, NGW = k.G * 8, lane = k.lane;
    const bf16* H = (const bf16*)(k.ws + WS_H); bf16* HP = (bf16*)(k.ws + WS_HP);
    const int* te = (const int*)(k.ws + WS_TOPK); const float* tw = (const float*)(k.ws + WS_TOPK + (size_t)TA * 8); const int* tp = (const int*)(k.ws + WS_TOPK + 2 * (size_t)TA * 8);
    int* rowtok = (int*)(k.ws + WS_TAB + TAB_ROWTOK) + (size_t)l * MOE_ROWS; float* roww = (float*)(k.ws + WS_TAB + TAB_ROWW) + (size_t)l * MOE_ROWS;
    for (int row = gw; row < nrows; row += NGW) {
#if MOE_GATHER
        (void)H; (void)HP;
        if (lane < 2) { const int s = lane; const int e = te[2 * row + s], dest = offs[e] + tp[2 * row + s]; rowtok[dest] = 2 * row + s; roww[dest] = tw[2 * row + s]; }
    }
#else
        const u32x4* src = (const u32x4*)(H + (size_t)row * DM) + lane;
        u32x4 d[4];
#pragma unroll
        for (int j = 0; j < 4; ++j) d[j] = src[64 * j];
#pragma unroll
        for (int s = 0; s < 2; ++s) {
            const int e = te[2 * row + s], dest = offs[e] + tp[2 * row + s];
            u32x4* dp = (u32x4*)(HP + (size_t)dest * DM) + lane;
#pragma unroll
            for (int j = 0; j < 4; ++j) dp[64 * j] = d[j];
            if (lane == 0) { rowtok[dest] = 2 * row + s; roww[dest] = tw[2 * row + s]; }
        }
    }
#endif
    __syncthreads();
}
__device__ __forceinline__ void ld16(const bf16* p, bool ok, float (&o)[16]) {
    if (ok) { const u32x4 a = *(const u32x4*)p, b = *(const u32x4*)(p + 8); float x[8], y[8]; unpack8(a, x); unpack8(b, y);
#pragma unroll
        for (int i = 0; i < 8; ++i) { o[i] = x[i]; o[8 + i] = y[i]; } }
    else {
#pragma unroll
        for (int i = 0; i < 16; ++i) o[i] = 0.f; }
}
__device__ __forceinline__ void st16(bf16* p, const float (&v)[16]) {
    float a[8], b[8];
#pragma unroll
    for (int i = 0; i < 8; ++i) { a[i] = v[i]; b[i] = v[8 + i]; }
    *(u32x4*)p = pack8(a); *(u32x4*)(p + 8) = pack8(b);
}
__device__ __forceinline__ void shift8(const bf16* p0, bool hp, bool hn, int c, const float* mu0, const float* mu1, float (&s)[8]) {
    float x[8], xm[8], xp[8];
    unpack8(*(const u32x4*)(p0 + c), x);
    if (hp) unpack8(*(const u32x4*)(p0 - NP + c), xm); else {
#pragma unroll
        for (int i = 0; i < 8; ++i) xm[i] = 0.f; }
    if (hn) unpack8(*(const u32x4*)(p0 + NP + c), xp); else {
#pragma unroll
        for (int i = 0; i < 8; ++i) xp[i] = 0.f; }
    const f32x4 m0a = *(const f32x4*)(mu0 + c), m0b = *(const f32x4*)(mu0 + c + 4), m1a = *(const f32x4*)(mu1 + c), m1b = *(const f32x4*)(mu1 + c + 4);
    const float m0[8] = {m0a.x, m0a.y, m0a.z, m0a.w, m0b.x, m0b.y, m0b.z, m0b.w}, m1[8] = {m1a.x, m1a.y, m1a.z, m1a.w, m1b.x, m1b.y, m1b.z, m1b.w};
#pragma unroll
    for (int i = 0; i < 8; ++i) s[i] = x[i] + m0[i] * (xm[i] - x[i]) + m1[i] * (xp[i] - x[i]);
}
__device__ __forceinline__ void ph_rwkv_prep(const KC& k, int l, int nrows, const float* mu, const float* k_k, const float* r_k) {
    const int gw = k.bid * 8 + k.wave, NGW = k.G * 8, lane = k.lane;
    const bf16* P = (const bf16*)(k.ws + WS_P);
    bf16* R = (bf16*)(k.ws + RW_R); bf16* KS = (bf16*)(k.ws + RW_KS); bf16* V = (bf16*)(k.ws + RW_V); bf16* KK = (bf16*)(k.ws + RW_KK);
    bf16* A1 = (bf16*)(k.ws + RW_A1); bf16* A2 = (bf16*)(k.ws + RW_A2); float* BON = (float*)(k.ws + RW_BON);
    const float* mu0 = mu + (size_t)(l * 2 + 0) * RWKV_IN; const float* mu1 = mu + (size_t)(l * 2 + 1) * RWKV_IN;
    const int rpw = (nrows + NGW - 1) / NGW;
    for (int row = gw * rpw; row < nrows && row < (gw + 1) * rpw; ++row) {
        int t, len; if (row < TL) { t = row & (SEQ - 1); len = SEQ; } else { t = (row - TL) & (CTXL - 1); len = CTXL; }
        const bool hp = t > 0, hn = t < len - 1;
        const bf16* p0 = P + (size_t)row * NP;
#pragma unroll
        for (int half = 0; half < 2; ++half) {
            const int c = half * 512 + 8 * lane;
            float r[8], kx[8], vv[8], kk[8];
            shift8(p0, hp, hn, c, mu0, mu1, r);
            shift8(p0, hp, hn, RD + c, mu0, mu1, kx);
            shift8(p0, hp, hn, 2 * RD + c, mu0, mu1, vv);
            const f32x4 kka = *(const f32x4*)(k_k + l * RD + c), kkb = *(const f32x4*)(k_k + l * RD + c + 4), rka = *(const f32x4*)(r_k + l * RD + c), rkb = *(const f32x4*)(r_k + l * RD + c + 4);
            const float kkw[8] = {kka.x, kka.y, kka.z, kka.w, kkb.x, kkb.y, kkb.z, kkb.w}, rkw[8] = {rka.x, rka.y, rka.z, rka.w, rkb.x, rkb.y, rkb.z, rkb.w};
            float ss = 0.f, bon = 0.f;
#pragma unroll
            for (int i = 0; i < 8; ++i) { kk[i] = kx[i] * kkw[i]; ss += kk[i] * kk[i]; bon += r[i] * kx[i] * rkw[i]; }
            ss += __shfl_xor(ss, 1); ss += __shfl_xor(ss, 2); ss += __shfl_xor(ss, 4);
            bon += __shfl_xor(bon, 1); bon += __shfl_xor(bon, 2); bon += __shfl_xor(bon, 4);
            const float inv = 1.0f / fmaxf(sqrtf(ss), 1e-12f);
#pragma unroll
            for (int i = 0; i < 8; ++i) kk[i] *= inv;
            *(u32x4*)(R + (size_t)row * RD + c) = pack8(r); *(u32x4*)(KS + (size_t)row * RD + c) = pack8(kx);
            *(u32x4*)(V + (size_t)row * RD + c) = pack8(vv); *(u32x4*)(KK + (size_t)row * RD + c) = pack8(kk);
            if ((lane & 7) == 0) BON[(size_t)row * RHEADS + half * 8 + (lane >> 3)] = bon;
        }
        if (lane < 56) {
            float s8[8];
            shift8(p0, hp, hn, 3 * RD + 8 * lane, mu0, mu1, s8);
            if (lane < 12) {
#pragma unroll
                for (int i = 0; i < 8; ++i) { const float e2 = __expf(2.0f * fminf(fmaxf(s8[i], -15.f), 15.f)); s8[i] = 1.0f - 2.0f / (e2 + 1.0f); }
                *(u32x4*)(A1 + (size_t)row * 256 + 8 * lane) = pack8(s8);
            } else if (lane < 24) { *(u32x4*)(A1 + (size_t)row * 256 + 8 * lane) = pack8(s8); }
            else {
#pragma unroll
                for (int i = 0; i < 8; ++i) s8[i] = sigm(s8[i]);
                *(u32x4*)(A2 + (size_t)row * 256 + 8 * (lane - 24)) = pack8(s8);
            }
        } else { *(u32x4*)(A1 + (size_t)row * 256 + 192 + 8 * (lane - 56)) = (u32x4){0u, 0u, 0u, 0u}; }
    }
}

__device__ __forceinline__ float logsig(float x) { return fminf(x, 0.f) - __logf(1.0f + __expf(-fabsf(x))); }
__device__ __forceinline__ int gla_row(bool lat, int b, int s) { return lat ? b * SEQ + (s & 31) * 64 + (s >> 5) : TL + b * CTXL + s; }
constexpr int GQ_PITCH = 264;
constexpr int GPL_AD = 0, GPL_GS = 4096, GPL_QK = GPL_GS + 65536, GPL_END = GPL_QK + 66 * GQ_PITCH * 2;
static_assert(GPL_END <= 131072, "gla prep lds");
__device__ __forceinline__ void ph_gla_prep(const KC& k, int l, const float* conv, const float* aw2, const float* ab) {
    const bf16* P = (const bf16*)(k.ws + WS_P);
    bf16* QG = (bf16*)(k.ws + GL_QG); bf16* KG = (bf16*)(k.ws + GL_KG); bf16* KE = (bf16*)(k.ws + GL_KE); bf16* VS = (bf16*)(k.ws + GL_VS); float* DEC = (float*)(k.ws + GL_DEC);
    const float* cw = conv + (size_t)l * 3 * GQKV;
    const int tid = k.tid, lane = k.lane;
    {
        const int gw = k.bid * 8 + k.wave, NGW = k.G * 8, c = 16 * lane;
        const int rpw = (TA + NGW - 1) / NGW;
        for (int qi = gw * rpw; qi < TA && qi < (gw + 1) * rpw; ++qi) {
            const bool lat = qi < TL; int b, s, len;
            if (lat) { b = qi >> 11; s = qi & 2047; len = SEQ; } else { b = (qi - TL) >> 8; s = (qi - TL) & 255; len = CTXL; }
            const int row = gla_row(lat, b, s);
            const bool hp = s > 0, hn = s + 1 < len;
            const bf16* p0 = P + (size_t)row * NP + GLA_OFF + 2 * GKD + c;
            const bf16* pm = P + (size_t)gla_row(lat, b, hp ? s - 1 : s) * NP + GLA_OFF + 2 * GKD + c;
            const bf16* pp = P + (size_t)gla_row(lat, b, hn ? s + 1 : s) * NP + GLA_OFF + 2 * GKD + c;
            float o[16];
#pragma unroll
            for (int hf = 0; hf < 2; ++hf) {
                float x[8], xm[8], xp[8];
                unpack8(*(const u32x4*)(p0 + 8 * hf), x); unpack8(*(const u32x4*)(pm + 8 * hf), xm); unpack8(*(const u32x4*)(pp + 8 * hf), xp);
                const float* w = cw + 2 * GKD + c + 8 * hf;
#pragma unroll
                for (int q = 0; q < 2; ++q) {
                    const f32x4 w0 = *(const f32x4*)(w + 4 * q), w1 = *(const f32x4*)(w + GQKV + 4 * q), w2 = *(const f32x4*)(w + 2 * GQKV + 4 * q);
#pragma unroll
                    for (int i = 0; i < 4; ++i) o[8 * hf + 4 * q + i] = siluf(w0[i] * (hp ? xm[4 * q + i] : 0.f) + w1[i] * x[4 * q + i] + w2[i] * (hn ? xp[4 * q + i] : 0.f));
                }
            }
            st16(VS + (size_t)row * GVD + c, o);
        }
    }
    LAS float* ADs = (LAS float*)(k.lds + GPL_AD);
    LAS float* Gs = (LAS float*)(k.lds + GPL_GS);
    LAS bf16* QKs = (LAS bf16*)(k.lds + GPL_QK);
    for (int item = k.bid; item < 288 * 4; item += k.G) {
        const int sc = item >> 2, h = item & 3;
        const bool lat = sc < 256; const int b = lat ? (sc >> 5) : ((sc - 256) >> 2), cn = lat ? (sc & 31) : ((sc - 256) & 3), len = lat ? SEQ : CTXL;
        const int gch = lat ? 4 + cn : cn, s0 = 64 * cn;
        for (int i = tid; i < 1024; i += 512) { const int tau = i >> 4, j = i & 15; ADs[i] = bf2f(P[(size_t)gla_row(lat, b, s0 + tau) * NP + GLA_AD_OFF + j]); }
        for (int i = tid; i < 66 * 32; i += 512) {
            const int rr = i >> 5, ck = i & 31, s = s0 - 1 + rr;
            u32x4 v = (u32x4){0u, 0u, 0u, 0u};
            if (s >= 0 && s < len) v = *(const u32x4*)(P + (size_t)gla_row(lat, b, s) * NP + GLA_OFF + (ck >> 4) * GKD + h * GDK + (ck & 15) * 8);
            *(LAS u32x4*)(QKs + rr * GQ_PITCH + ck * 8) = v;
        }
        __syncthreads();
        {
            const int c = tid & 127, tg = tid >> 7, chl = h * GDK + c;
            float awf[16], awb[16];
#pragma unroll
            for (int j = 0; j < 16; ++j) { awf[j] = aw2[((size_t)(l * 2 + 0) * 16 + j) * GKD + chl]; awb[j] = aw2[((size_t)(l * 2 + 1) * 16 + j) * GKD + chl]; }
            const float abf = ab[(l * 2 + 0) * GKD + chl], abb = ab[(l * 2 + 1) * GKD + chl];
            for (int i = 0; i < 16; ++i) {
                const int tau = 16 * tg + i; float xf = abf, xb = abb;
#pragma unroll
                for (int j = 0; j < 16; ++j) { const float a = ADs[tau * 16 + j]; xf += a * awf[j]; xb += a * awb[j]; }
                Gs[tau * 128 + c] = logsig(xf) * (1.0f / 16.0f); Gs[(64 + tau) * 128 + c] = logsig(xb) * (1.0f / 16.0f);
            }
        }
        __syncthreads();
        if (tid < 128) { float run = 0.f; for (int tau = 0; tau < 64; ++tau) { run += Gs[tau * 128 + tid]; Gs[tau * 128 + tid] = run; } }
        else if (tid < 256) { const int c = tid - 128; float run = 0.f; for (int tau = 63; tau >= 0; --tau) { run += Gs[(64 + tau) * 128 + c]; Gs[(64 + tau) * 128 + c] = run; } }
        __syncthreads();
        {
            const int c8 = tid & 15, tg = tid >> 4, chl = h * GDK + 8 * c8;
            float wq[3][8], wk[3][8], elf[8], elb[8];
#pragma unroll
            for (int tp = 0; tp < 3; ++tp) {
                const f32x4 a0 = *(const f32x4*)(cw + tp * GQKV + chl), a1 = *(const f32x4*)(cw + tp * GQKV + chl + 4), b0 = *(const f32x4*)(cw + tp * GQKV + GKD + chl), b1 = *(const f32x4*)(cw + tp * GQKV + GKD + chl + 4);
#pragma unroll
                for (int i = 0; i < 4; ++i) { wq[tp][i] = a0[i]; wq[tp][4 + i] = a1[i]; wk[tp][i] = b0[i]; wk[tp][4 + i] = b1[i]; }
            }
            {
                const f32x4 a0 = *(const LAS f32x4*)(Gs + 63 * 128 + 8 * c8), a1 = *(const LAS f32x4*)(Gs + 63 * 128 + 8 * c8 + 4), b0 = *(const LAS f32x4*)(Gs + 64 * 128 + 8 * c8), b1 = *(const LAS f32x4*)(Gs + 64 * 128 + 8 * c8 + 4);
#pragma unroll
                for (int i = 0; i < 4; ++i) { elf[i] = __expf(a0[i]); elf[4 + i] = __expf(a1[i]); elb[i] = __expf(b0[i]); elb[4 + i] = __expf(b1[i]); }
            }
            if (tg < 8) {
                float* d0 = DEC + ((size_t)(0 * 8 + b) * NCH + gch) * GKD + chl; float* d1 = DEC + ((size_t)(1 * 8 + b) * NCH + gch) * GKD + chl;
                if (tg == 0) { *(f32x4*)d0 = (f32x4){elf[0], elf[1], elf[2], elf[3]}; *(f32x4*)(d0 + 4) = (f32x4){elf[4], elf[5], elf[6], elf[7]}; }
                if (tg == 1) { *(f32x4*)d1 = (f32x4){elb[0], elb[1], elb[2], elb[3]}; *(f32x4*)(d1 + 4) = (f32x4){elb[4], elb[5], elb[6], elb[7]}; }
            }
#pragma unroll
            for (int pass = 0; pass < 2; ++pass) {
                const int tau = tg + 32 * pass;
                float qm[8], q0[8], qp[8], km[8], k0[8], kp[8];
                unpack8(*(const LAS u32x4*)(QKs + (tau + 0) * GQ_PITCH + 8 * c8), qm); unpack8(*(const LAS u32x4*)(QKs + (tau + 1) * GQ_PITCH + 8 * c8), q0); unpack8(*(const LAS u32x4*)(QKs + (tau + 2) * GQ_PITCH + 8 * c8), qp);
                unpack8(*(const LAS u32x4*)(QKs + (tau + 0) * GQ_PITCH + 128 + 8 * c8), km); unpack8(*(const LAS u32x4*)(QKs + (tau + 1) * GQ_PITCH + 128 + 8 * c8), k0); unpack8(*(const LAS u32x4*)(QKs + (tau + 2) * GQ_PITCH + 128 + 8 * c8), kp);
                const f32x4 f0 = *(const LAS f32x4*)(Gs + tau * 128 + 8 * c8), f1 = *(const LAS f32x4*)(Gs + tau * 128 + 8 * c8 + 4), g0 = *(const LAS f32x4*)(Gs + (64 + tau) * 128 + 8 * c8), g1 = *(const LAS f32x4*)(Gs + (64 + tau) * 128 + 8 * c8 + 4);
                const float cf[8] = {f0.x, f0.y, f0.z, f0.w, f1.x, f1.y, f1.z, f1.w}, cb[8] = {g0.x, g0.y, g0.z, g0.w, g1.x, g1.y, g1.z, g1.w};
                float oqf[8], okf[8], oef[8], oqb[8], okb[8], oeb[8];
#pragma unroll
                for (int i = 0; i < 8; ++i) {
                    const float qv = siluf(wq[0][i] * qm[i] + wq[1][i] * q0[i] + wq[2][i] * qp[i]) * 0.08838834764831845f;
                    const float kv = siluf(wk[0][i] * km[i] + wk[1][i] * k0[i] + wk[2][i] * kp[i]);
                    const float ef = __expf(cf[i]), eb = __expf(cb[i]), rf = 1.0f / ef, rb = 1.0f / eb;
                    oqf[i] = qv * ef; okf[i] = kv * rf; oef[i] = kv * rf * elf[i];
                    oqb[i] = qv * eb; okb[i] = kv * rb; oeb[i] = kv * rb * elb[i];
                }
                const size_t o = (size_t)gla_row(lat, b, s0 + tau) * GKD + chl;
                *(u32x4*)(QG + o) = pack8(oqf); *(u32x4*)(KG + o) = pack8(okf); *(u32x4*)(KE + o) = pack8(oef);
                *(u32x4*)(QG + (size_t)TA * GKD + o) = pack8(oqb); *(u32x4*)(KG + (size_t)TA * GKD + o) = pack8(okb); *(u32x4*)(KE + (size_t)TA * GKD + o) = pack8(oeb);
            }
        }
        __syncthreads();
    }
}

__device__ __forceinline__ float dpp_sum16(float x) {
    x += __builtin_bit_cast(float, __builtin_amdgcn_update_dpp(0, __builtin_bit_cast(int, x), 0xB1, 0xF, 0xF, true));
    x += __builtin_bit_cast(float, __builtin_amdgcn_update_dpp(0, __builtin_bit_cast(int, x), 0x4E, 0xF, 0xF, true));
    x += __builtin_bit_cast(float, __builtin_amdgcn_update_dpp(0, __builtin_bit_cast(int, x), 0x141, 0xF, 0xF, true));
    x += __builtin_bit_cast(float, __builtin_amdgcn_update_dpp(0, __builtin_bit_cast(int, x), 0x140, 0xF, 0xF, true));
    return x;
}
constexpr int RS_TOK = 16;
constexpr int RS_TF = 6 * 64;
constexpr int RS_BUF = RS_TOK * RS_TF;
struct RwkvStage { unsigned r, we, a, ks, v, kk; };
__device__ __forceinline__ int rwkv_row(int b, int dir, int p) {
    if (p < CTXL) { const int t = dir ? CTXL - 1 - p : p; return TL + b * CTXL + t; }
    const int q = p - CTXL, t = dir ? SEQ - 1 - q : q; return b * SEQ + t;
}
__device__ __forceinline__ void ph_rwkv_scan(const KC& k, int l, int job, const float* k_a, size_t yoff = RW_Y) {
    const int b = job >> 5, h = (job >> 1) & 15, dir = job & 1;
    const int tid = k.tid;
    const bf16* R = (const bf16*)(k.ws + RW_R); const bf16* KS = (const bf16*)(k.ws + RW_KS); const bf16* V = (const bf16*)(k.ws + RW_V); const bf16* KK = (const bf16*)(k.ws + RW_KK);
    const bf16* LO = (const bf16*)(k.ws + RW_LO); bf16* Y = (bf16*)(k.ws + yoff) + (size_t)dir * TA * RD;
    LAS float* buf = (LAS float*)k.lds;
    LAS f32x2* ypart = (LAS f32x2*)(buf + 2 * RS_BUF);
    const int st = tid >> 5, cp = tid & 31, ch = h * RHS + 2 * cp;
    const float ka0 = k_a[l * RD + ch], ka1 = k_a[l * RD + ch + 1];
    const int kq = tid & 15, rp = tid >> 4, v0 = rp * 2;
    f32x2 S00 = {0.f, 0.f}, S01 = {0.f, 0.f}, S10 = {0.f, 0.f}, S11 = {0.f, 0.f};
    RwkvStage sg;
#define RW_LOAD(chunk) do { const int row_ = rwkv_row(b, dir, (chunk) * RS_TOK + st); \
        sg.r = *(const unsigned*)(R + (size_t)row_ * RD + ch); sg.ks = *(const unsigned*)(KS + (size_t)row_ * RD + ch); \
        sg.v = *(const unsigned*)(V + (size_t)row_ * RD + ch); sg.kk = *(const unsigned*)(KK + (size_t)row_ * RD + ch); \
        sg.we = *(const unsigned*)(LO + (size_t)row_ * 4096 + dir * RD + ch); sg.a = *(const unsigned*)(LO + (size_t)row_ * 4096 + 2048 + dir * RD + ch); } while (0)
#define RW_WRITE(bi) do { LAS float* tb = buf + (bi) * RS_BUF + st * RS_TF + 2 * cp; \
        const float a0 = bflo(sg.a), a1 = bfhi(sg.a), kk0 = bflo(sg.kk), kk1 = bfhi(sg.kk), ks0 = bflo(sg.ks), ks1 = bfhi(sg.ks); \
        *(LAS f32x2*)(tb + 0) = (f32x2){kk0, kk1}; \
        *(LAS f32x2*)(tb + 64) = (f32x2){__expf(-bflo(sg.we)), __expf(-bfhi(sg.we))}; \
        *(LAS f32x2*)(tb + 128) = (f32x2){-kk0 * a0, -kk1 * a1}; \
        *(LAS f32x2*)(tb + 192) = (f32x2){ks0 * (1.0f + (a0 - 1.0f) * ka0), ks1 * (1.0f + (a1 - 1.0f) * ka1)}; \
        *(LAS f32x2*)(tb + 256) = (f32x2){bflo(sg.r), bfhi(sg.r)}; \
        *(LAS f32x2*)(tb + 320) = (f32x2){bflo(sg.v), bfhi(sg.v)}; } while (0)
    constexpr int NCHUNK = (CTXL + SEQ) / RS_TOK;
    RW_LOAD(0); RW_WRITE(0);
    __syncthreads();
    for (int c = 0; c < NCHUNK; ++c) {
        if (c + 1 < NCHUNK) RW_LOAD(c + 1);
        const LAS float* cb = buf + (c & 1) * RS_BUF; LAS f32x2* yb = ypart + (c & 1) * RS_TOK * 256 + rp * 8 + (((kq >> 1) ^ (rp >> 2)) & 7);
        {
            const LAS float* tk = cb + kq * 4; const LAS float* tv = cb + 320 + v0;
#define RW_LD(T, kk4, w4, n4, d4, r4, vv) f32x4 kk4 = *(const LAS f32x4*)(tk + (T) * RS_TF), w4 = *(const LAS f32x4*)(tk + (T) * RS_TF + 64), n4 = *(const LAS f32x4*)(tk + (T) * RS_TF + 128), \
                d4 = *(const LAS f32x4*)(tk + (T) * RS_TF + 192), r4 = *(const LAS f32x4*)(tk + (T) * RS_TF + 256); f32x2 vv = *(const LAS f32x2*)(tv + (T) * RS_TF)
#define RW_STEP(T, kk4, w4, n4, d4, r4, vv) do { \
                const f32x2 kka = {kk4.x, kk4.y}, kkb = {kk4.z, kk4.w}, wa = {w4.x, w4.y}, wb = {w4.z, w4.w}, na = {n4.x, n4.y}, nb = {n4.z, n4.w}, da = {d4.x, d4.y}, db = {d4.z, d4.w}, ra = {r4.x, r4.y}, rb = {r4.z, r4.w}; \
                f32x2 p0 = S00 * kka + S01 * kkb, p1 = S10 * kka + S11 * kkb; \
                const f32x2 u00 = S00 * wa + da * vv.x, u01 = S01 * wb + db * vv.x, u10 = S10 * wa + da * vv.y, u11 = S11 * wb + db * vv.y;     \
                const float sa0 = dpp_sum16(p0.x + p0.y), sa1 = dpp_sum16(p1.x + p1.y); \
                S00 = na * sa0 + u00; S01 = nb * sa0 + u01; S10 = na * sa1 + u10; S11 = nb * sa1 + u11; \
                p0 = S00 * ra + S01 * rb; p1 = S10 * ra + S11 * rb; \
                float y0 = p0.x + p0.y, y1 = p1.x + p1.y; \
                y0 += __builtin_bit_cast(float, __builtin_amdgcn_update_dpp(0, __builtin_bit_cast(int, y0), 0xB1, 0xF, 0xF, true)); \
                y1 += __builtin_bit_cast(float, __builtin_amdgcn_update_dpp(0, __builtin_bit_cast(int, y1), 0xB1, 0xF, 0xF, true)); \
                if ((kq & 1) == 0) yb[(T) * 256] = (f32x2){y0, y1}; } while (0)
            RW_LD(0, kkA, wA, nA, dA, rA, vA);
#pragma unroll
            for (int tau = 0; tau < RS_TOK; tau += 2) {
                RW_LD(tau + 1, kkB, wB, nB, dB, rB, vB);
                RW_STEP(tau, kkA, wA, nA, dA, rA, vA);
                if (tau + 2 < RS_TOK) { RW_LD(tau + 2, kkC, wC, nC, dC, rC, vC); kkA = kkC; wA = wC; nA = nC; dA = dC; rA = rC; vA = vC; }
                RW_STEP(tau + 1, kkB, wB, nB, dB, rB, vB);
            }
#undef RW_LD
#undef RW_STEP
        }
        if (c + 1 < NCHUNK) RW_WRITE((c + 1) & 1);
        __syncthreads();
        {
            const int row = rwkv_row(b, dir, c * RS_TOK + st);
            const LAS f32x2* yq = ypart + (c & 1) * RS_TOK * 256 + st * 256 + cp * 8;
            f32x2 acc = yq[(0 ^ (cp >> 2)) & 7];
#pragma unroll
            for (int j = 1; j < 8; ++j) acc += yq[(j ^ (cp >> 2)) & 7];
            *(unsigned*)(Y + (size_t)row * RD + ch) = pk2(acc.x, acc.y);
        }
    }
    __syncthreads();
}

constexpr int GP1 = 136, GP2 = 72;
constexpr int GL_QGS = 0, GL_KGS = GL_QGS + 64 * GP1 * 2, GL_STS = GL_KGS + 64 * GP1 * 2, GL_KET = GL_STS + 64 * GP1 * 2, GL_VT = GL_KET + 128 * GP2 * 2, GL_ATT = GL_VT + 64 * GP2 * 2,
              GL_DECS = GL_ATT + 64 * GP2 * 2, GL_LDS_END = GL_DECS + 512;
static_assert(GL_LDS_END <= 131072, "gla lds");
__device__ __forceinline__ bf16x8 ldfrag(const LAS bf16* base, int row, int pitch, int kofs) { return *(const LAS bf16x8*)(base + row * pitch + kofs); }
__device__ __forceinline__ int gla_prow(int b, int dir, int cp, int tau) {
    const bool lat = cp >= 4; const int q = lat ? cp - 4 : cp, ncn = lat ? 32 : 4, cn = dir ? ncn - 1 - q : q;
    return gla_row(lat, b, dir ? 64 * cn + 63 - tau : 64 * cn + tau);
}
__device__ __forceinline__ int gla_gch(int dir, int cp) { const bool lat = cp >= 4; const int q = lat ? cp - 4 : cp, ncn = lat ? 32 : 4, cn = dir ? ncn - 1 - q : q; return lat ? 4 + cn : cn; }
__device__ __forceinline__ bf16x8 ldfrag_sw(const LAS bf16* base, int row, int g) { return *(const LAS bf16x8*)(base + row * GP2 + ((g ^ ((row >> 3) & 7)) << 3)); }
__device__ __forceinline__ void ph_gla_scan(const KC& k, int job) {
    const int b = job >> 5, h = (job >> 3) & 3, dir = (job >> 2) & 1, dvq = job & 3;
    const int tid = k.tid, w = k.wave, lane = k.lane, q4 = lane >> 4, l15 = lane & 15;
    const bf16* QG = (const bf16*)(k.ws + GL_QG) + (size_t)dir * TA * GKD; const bf16* KG = (const bf16*)(k.ws + GL_KG) + (size_t)dir * TA * GKD;
    const bf16* KE = (const bf16*)(k.ws + GL_KE) + (size_t)dir * TA * GKD; const bf16* VS = (const bf16*)(k.ws + GL_VS);
    const float* DEC = (const float*)(k.ws + GL_DEC); bf16* O = (bf16*)(k.ws + GL_O) + (size_t)dir * TA * GVD;
    LAS bf16* QGs = (LAS bf16*)(k.lds + GL_QGS); LAS bf16* KGs = (LAS bf16*)(k.lds + GL_KGS); LAS bf16* STs = (LAS bf16*)(k.lds + GL_STS);
    LAS bf16* KEt = (LAS bf16*)(k.lds + GL_KET); LAS bf16* Vt = (LAS bf16*)(k.lds + GL_VT); LAS bf16* ATT = (LAS bf16*)(k.lds + GL_ATT); LAS float* decs = (LAS float*)(k.lds + GL_DECS);
    f32x4 accS[4];
#pragma unroll
    for (int t = 0; t < 4; ++t) accS[t] = (f32x4){0.f, 0.f, 0.f, 0.f};
    const int tw = w & 3, wh = w >> 2;
#if GLA_TP
    unsigned long long gtp_acc = 0ull, gtp_t0 = 0ull;
#define GTP_MARK(n) do { if (w == GLA_TPW) { const unsigned long long t_ = __builtin_amdgcn_s_memtime(); if ((n) == GLA_TP) gtp_acc += t_ - gtp_t0; gtp_t0 = t_; } } while (0)
#else
#define GTP_MARK(n) do {} while (0)
#endif
    u32x4 pq[2], pk[2], pe[2], pv; float pd = 0.f;
#if GLA_PF2
    u32x4 nq[2], nk[2], ne[2], nv; float nd = 0.f;
#endif
#define GLA_PREFETCH_TO(CP, Q_, K_, E_, V_, D_) do { _Pragma("unroll") for (int i = 0; i < 2; ++i) { const int idx = tid + 512 * i, tau = idx >> 4, ck = idx & 15; \
            const size_t go = (size_t)gla_prow(b, dir, (CP), tau) * GKD + h * GDK + ck * 8; Q_[i] = *(const u32x4*)(QG + go); K_[i] = *(const u32x4*)(KG + go); E_[i] = *(const u32x4*)(KE + go); } \
        V_ = *(const u32x4*)(VS + (size_t)gla_prow(b, dir, (CP), tid >> 3) * GVD + h * GDV + dvq * 64 + (tid & 7) * 8); \
        if (tid < 128) D_ = DEC[((size_t)(dir * 8 + b) * NCH + gla_gch(dir, (CP))) * GKD + h * GDK + tid]; } while (0)
#define GLA_PREFETCH(CP) GLA_PREFETCH_TO(CP, pq, pk, pe, pv, pd)
    GLA_PREFETCH(0);
#if GLA_PF2
    GLA_PREFETCH_TO(1, nq, nk, ne, nv, nd);
#endif
    for (int cp = 0; cp < NCH; ++cp) {
#define GROW(tau) gla_prow(b, dir, cp, (tau))
        GTP_MARK(0);
#pragma unroll
        for (int i = 0; i < 2; ++i) {
            const int idx = tid + 512 * i, tau = idx >> 4, ck = idx & 15;
            *(LAS u32x4*)(QGs + tau * GP1 + ck * 8) = pq[i];
            *(LAS u32x4*)(KGs + tau * GP1 + ck * 8) = pk[i];
            const unsigned kw[4] = {pe[i].x, pe[i].y, pe[i].z, pe[i].w};
#pragma unroll
            for (int e = 0; e < 4; ++e) { const int ts = tau ^ ((ck & 7) << 3); KEt[(ck * 8 + 2 * e) * GP2 + ts] = (bf16)(kw[e] & 0xffffu); KEt[(ck * 8 + 2 * e + 1) * GP2 + ts] = (bf16)(kw[e] >> 16); }
        }
        {
            const int tau = tid >> 3, ck = tid & 7;
            const unsigned vw[4] = {pv.x, pv.y, pv.z, pv.w};
#pragma unroll
            for (int e = 0; e < 4; ++e) { const int ts = tau ^ (ck << 3); Vt[(ck * 8 + 2 * e) * GP2 + ts] = (bf16)(vw[e] & 0xffffu); Vt[(ck * 8 + 2 * e + 1) * GP2 + ts] = (bf16)(vw[e] >> 16); }
        }
        if (tid < 128) decs[tid] = pd;
#pragma unroll
        for (int t = 0; t < 4; ++t) {
            const int dkt = wh * 4 + t;
#pragma unroll
            for (int r = 0; r < 4; ++r) STs[(16 * tw + 4 * q4 + r) * GP1 + 16 * dkt + l15] = (bf16)f2bf(accS[t][r]);
        }
#if GLA_PF2
#pragma unroll
        for (int i = 0; i < 2; ++i) { pq[i] = nq[i]; pk[i] = nk[i]; pe[i] = ne[i]; }
        pv = nv; pd = nd;
        __syncthreads();
        if (cp + 2 < NCH) GLA_PREFETCH_TO(cp + 2, nq, nk, ne, nv, nd);
#else
        GTP_MARK(1);
        __syncthreads();
        GTP_MARK(2);
        if (cp + 1 < NCH) GLA_PREFETCH(cp + 1);
#endif
#pragma unroll
        for (int jj = 0; jj < 2; ++jj) {
            const int it = tw, jt = wh * 2 + jj;
            f32x4 acc = (f32x4){0.f, 0.f, 0.f, 0.f};
#pragma unroll
            for (int ks = 0; ks < 4; ++ks) acc = __builtin_amdgcn_mfma_f32_16x16x32_bf16(ldfrag(QGs, 16 * it + l15, GP1, 32 * ks + 8 * q4), ldfrag(KGs, 16 * jt + l15, GP1, 32 * ks + 8 * q4), acc, 0, 0, 0);
#pragma unroll
            for (int r = 0; r < 4; ++r) { const int i = 16 * it + 4 * q4 + r, j = 16 * jt + l15; ATT[i * GP2 + j] = (bf16)f2bf(j <= i ? acc[r] : 0.f); }
        }
        GTP_MARK(3);
        __syncthreads();
        GTP_MARK(4);
#pragma unroll
        for (int dd = 0; dd < 2; ++dd) {
            const int it = tw, dvt = wh * 2 + dd;
            f32x4 acc = (f32x4){0.f, 0.f, 0.f, 0.f};
#pragma unroll
            for (int ks = 0; ks < 4; ++ks) acc = __builtin_amdgcn_mfma_f32_16x16x32_bf16(ldfrag(QGs, 16 * it + l15, GP1, 32 * ks + 8 * q4), ldfrag(STs, 16 * dvt + l15, GP1, 32 * ks + 8 * q4), acc, 0, 0, 0);
#pragma unroll
            for (int ks = 0; ks < 2; ++ks) acc = __builtin_amdgcn_mfma_f32_16x16x32_bf16(ldfrag(ATT, 16 * it + l15, GP2, 32 * ks + 8 * q4), ldfrag_sw(Vt, 16 * dvt + l15, 4 * ks + q4), acc, 0, 0, 0);
#pragma unroll
            for (int r = 0; r < 4; ++r) { const int i = 16 * it + 4 * q4 + r; O[(size_t)GROW(i) * GVD + h * GDV + dvq * 64 + 16 * dvt + l15] = (bf16)f2bf(acc[r]); }
        }
        GTP_MARK(5);
#pragma unroll
        for (int t = 0; t < 4; ++t) {
            const int dkt = wh * 4 + t; const float d = decs[16 * dkt + l15];
            accS[t] = accS[t] * d;
#pragma unroll
            for (int ks = 0; ks < 2; ++ks) accS[t] = __builtin_amdgcn_mfma_f32_16x16x32_bf16(ldfrag_sw(Vt, 16 * tw + l15, 4 * ks + q4), ldfrag_sw(KEt, 16 * dkt + l15, 4 * ks + q4), accS[t], 0, 0, 0);
        }
        GTP_MARK(6);
        __syncthreads();
        GTP_MARK(7);
#undef GROW
    }
#if GLA_TP
    if (w == GLA_TPW) { const unsigned long long t0 = __builtin_amdgcn_s_memtime(); while (__builtin_amdgcn_s_memtime() - t0 < gtp_acc) __builtin_amdgcn_s_sleep(8); }
    __syncthreads();
#endif
#undef GLA_PREFETCH
#undef GLA_PREFETCH_TO
}

#ifndef RWKV_MODE
#define RWKV_MODE 2
#endif
#ifndef HB_FULL
#define HB_FULL 0
#endif
#ifndef GLA4_LEVEL
#define GLA4_LEVEL 0
#endif
#ifndef GLA4_NOSTORE
#define GLA4_NOSTORE 0
#endif
#ifndef SWAP_HALVES
#define SWAP_HALVES 0
#endif
#ifndef SPLIT_SCAN
#define SPLIT_SCAN 0
#endif
constexpr int RS4_TOK = 8, RS4_BUF = RS4_TOK * RS_TF;
constexpr int SC_GL = 0;
constexpr int SC_RW = 96 * 1024;
constexpr int SC_END = SC_RW + 2 * RS4_BUF * 4 + 2 * RS4_TOK * 64 * 4;
static_assert(SC_GL + GL_LDS_END <= SC_RW, "scan lds halves");
constexpr int SC_CTR = 127 * 1024;
static_assert(SC_END <= SC_CTR && SC_CTR + 128 <= 131072, "scan lds");
__device__ __forceinline__ void half_bar(LAS unsigned* ctr, unsigned& gen, int lane) {
#if HB_FULL
    (void)ctr; (void)lane; gen += 4u; __syncthreads(); return;
#endif
    gen += 4u;
    __builtin_amdgcn_fence(__ATOMIC_RELEASE, "workgroup");
    if (lane == 0) __hip_atomic_fetch_add(ctr, 1u, __ATOMIC_RELAXED, __HIP_MEMORY_SCOPE_WORKGROUP);
    unsigned spins = 0;
    while (__hip_atomic_load(ctr, __ATOMIC_RELAXED, __HIP_MEMORY_SCOPE_WORKGROUP) < gen) { __builtin_amdgcn_s_sleep(1); if (++spins > (1u << 26)) break; }
    __builtin_amdgcn_fence(__ATOMIC_ACQUIRE, "workgroup");
}
#ifndef RW4_SHFL
#define RW4_SHFL 0
#endif
__device__ __forceinline__ float shfl_sum16(float x) { x += __shfl_xor(x, 1); x += __shfl_xor(x, 2); x += __shfl_xor(x, 4); x += __shfl_xor(x, 8); return x; }
#if RW4_SHFL
#define RW4_SUM16(x) shfl_sum16(x)
#else
#define RW4_SUM16(x) dpp_sum16(x)
#endif
__device__ __forceinline__ void rwkv_scan_4w(const KC& k, int l, int job, const float* k_a, LAS unsigned* ctr) {
    const int b = job >> 5, h = (job >> 1) & 15, dir = job & 1;
    const int tid = k.tid, lane = k.lane;
    const bf16* R = (const bf16*)(k.ws + RW_R); const bf16* KS = (const bf16*)(k.ws + RW_KS); const bf16* V = (const bf16*)(k.ws + RW_V); const bf16* KK = (const bf16*)(k.ws + RW_KK);
    const bf16* LO = (const bf16*)(k.ws + RW_LO); bf16* Y = (bf16*)(k.ws + RW_Y) + (size_t)dir * TA * RD;
    LAS float* buf = (LAS float*)(k.lds + SC_RW);
    LAS float* ybuf = buf + 2 * RS4_BUF;
    const int st = tid >> 5, cp = tid & 31, ch = h * RHS + 2 * cp;
    const float ka0 = k_a[l * RD + ch], ka1 = k_a[l * RD + ch + 1];
    const int kq = tid & 15, v0 = (tid >> 4) * 4;
    f32x2 S[4][2];
#pragma unroll
    for (int i = 0; i < 4; ++i) { S[i][0] = (f32x2){0.f, 0.f}; S[i][1] = (f32x2){0.f, 0.f}; }
    RwkvStage sg[1];
    unsigned gen = 0;
#define RW4_LOAD(chunk) do { _Pragma("unroll") for (int q_ = 0; q_ < 1; ++q_) { const int row_ = rwkv_row(b, dir, (chunk) * RS4_TOK + st); \
        sg[q_].r = *(const unsigned*)(R + (size_t)row_ * RD + ch); sg[q_].ks = *(const unsigned*)(KS + (size_t)row_ * RD + ch); \
        sg[q_].v = *(const unsigned*)(V + (size_t)row_ * RD + ch); sg[q_].kk = *(const unsigned*)(KK + (size_t)row_ * RD + ch); \
        sg[q_].we = *(const unsigned*)(LO + (size_t)row_ * 4096 + dir * RD + ch); sg[q_].a = *(const unsigned*)(LO + (size_t)row_ * 4096 + 2048 + dir * RD + ch); } } while (0)
#define RW4_WRITE(bi) do { _Pragma("unroll") for (int q_ = 0; q_ < 1; ++q_) { LAS float* tb = buf + (bi) * RS4_BUF + st * RS_TF + 2 * cp; \
        const float a0 = bflo(sg[q_].a), a1 = bfhi(sg[q_].a), kk0 = bflo(sg[q_].kk), kk1 = bfhi(sg[q_].kk), ks0 = bflo(sg[q_].ks), ks1 = bfhi(sg[q_].ks); \
        *(LAS f32x2*)(tb + 0) = (f32x2){kk0, kk1}; \
        *(LAS f32x2*)(tb + 64) = (f32x2){__expf(-bflo(sg[q_].we)), __expf(-bfhi(sg[q_].we))}; \
        *(LAS f32x2*)(tb + 128) = (f32x2){-kk0 * a0, -kk1 * a1}; \
        *(LAS f32x2*)(tb + 192) = (f32x2){ks0 * (1.0f + (a0 - 1.0f) * ka0), ks1 * (1.0f + (a1 - 1.0f) * ka1)}; \
        *(LAS f32x2*)(tb + 256) = (f32x2){bflo(sg[q_].r), bfhi(sg[q_].r)}; \
        *(LAS f32x2*)(tb + 320) = (f32x2){bflo(sg[q_].v), bfhi(sg[q_].v)}; } } while (0)
    constexpr int NCHUNK = (CTXL + SEQ) / RS4_TOK;
    RW4_LOAD(0); RW4_WRITE(0);
    half_bar(ctr, gen, lane);
    for (int c = 0; c < NCHUNK; ++c) {
        if (c + 1 < NCHUNK) RW4_LOAD(c + 1);
        const LAS float* cb = buf + (c & 1) * RS4_BUF; LAS float* yb = ybuf + (c & 1) * RS4_TOK * 64;
        {
            const LAS float* tk = cb + kq * 4; const LAS float* tv = cb + 320 + v0;
#define RW4_LD(T, kk4, w4, n4, d4, r4, vv) f32x4 kk4 = *(const LAS f32x4*)(tk + (T) * RS_TF), w4 = *(const LAS f32x4*)(tk + (T) * RS_TF + 64), n4 = *(const LAS f32x4*)(tk + (T) * RS_TF + 128), \
                d4 = *(const LAS f32x4*)(tk + (T) * RS_TF + 192), r4 = *(const LAS f32x4*)(tk + (T) * RS_TF + 256), vv = *(const LAS f32x4*)(tv + (T) * RS_TF)
#define RW4_STEP(T, kk4, w4, n4, d4, r4, vv) do { \
                const f32x2 kka = {kk4.x, kk4.y}, kkb = {kk4.z, kk4.w}, wa = {w4.x, w4.y}, wb = {w4.z, w4.w}, na = {n4.x, n4.y}, nb = {n4.z, n4.w}, da = {d4.x, d4.y}, db = {d4.z, d4.w}, ra = {r4.x, r4.y}, rb = {r4.z, r4.w}; \
                float sa[4], yy[4]; f32x2 u0[4], u1[4]; \
                _Pragma("unroll") for (int i = 0; i < 4; ++i) { const f32x2 p = S[i][0] * kka + S[i][1] * kkb; sa[i] = p.x + p.y; u0[i] = S[i][0] * wa + da * vv[i]; u1[i] = S[i][1] * wb + db * vv[i]; } \
                _Pragma("unroll") for (int i = 0; i < 4; ++i) sa[i] = RW4_SUM16(sa[i]); \
                _Pragma("unroll") for (int i = 0; i < 4; ++i) { S[i][0] = na * sa[i] + u0[i]; S[i][1] = nb * sa[i] + u1[i]; const f32x2 q = S[i][0] * ra + S[i][1] * rb; yy[i] = q.x + q.y; } \
                _Pragma("unroll") for (int i = 0; i < 4; ++i) yy[i] = RW4_SUM16(yy[i]); \
                if (kq == 0) *(LAS f32x4*)(yb + (T) * 64 + v0) = (f32x4){yy[0], yy[1], yy[2], yy[3]}; } while (0)
            RW4_LD(0, kkA, wA, nA, dA, rA, vA);
#pragma unroll
            for (int tau = 0; tau < RS4_TOK; tau += 2) {
                RW4_LD(tau + 1, kkB, wB, nB, dB, rB, vB);
                RW4_STEP(tau, kkA, wA, nA, dA, rA, vA);
                if (tau + 2 < RS4_TOK) { RW4_LD(tau + 2, kkC, wC, nC, dC, rC, vC); kkA = kkC; wA = wC; nA = nC; dA = dC; rA = rC; vA = vC; }
                RW4_STEP(tau + 1, kkB, wB, nB, dB, rB, vB);
            }
#undef RW4_LD
#undef RW4_STEP
        }
        if (c + 1 < NCHUNK) RW4_WRITE((c + 1) & 1);
        half_bar(ctr, gen, lane);
        {
            const int row = rwkv_row(b, dir, c * RS4_TOK + st);
            const f32x2 yy = *(const LAS f32x2*)(yb + st * 64 + 2 * cp);
            *(unsigned*)(Y + (size_t)row * RD + ch) = pk2(yy.x, yy.y);
        }
    }
#undef RW4_LOAD
#undef RW4_WRITE
}
__device__ __forceinline__ void gla_scan_4w(const KC& k, int job, LAS unsigned* ctr) {
    const int b = job >> 5, h = (job >> 3) & 3, dir = (job >> 2) & 1, dvq = job & 3;
    const int tid = k.tid - 256, w = k.wave - 4, lane = k.lane, q4 = lane >> 4, l15 = lane & 15;
    const bf16* QG = (const bf16*)(k.ws + GL_QG) + (size_t)dir * TA * GKD; const bf16* KG = (const bf16*)(k.ws + GL_KG) + (size_t)dir * TA * GKD;
    const bf16* KE = (const bf16*)(k.ws + GL_KE) + (size_t)dir * TA * GKD; const bf16* VS = (const bf16*)(k.ws + GL_VS);
    const float* DEC = (const float*)(k.ws + GL_DEC); bf16* O = (bf16*)(k.ws + GL_O) + (size_t)dir * TA * GVD;
    LAS unsigned char* gl = k.lds + SC_GL;
    LAS bf16* QGs = (LAS bf16*)(gl + GL_QGS); LAS bf16* KGs = (LAS bf16*)(gl + GL_KGS); LAS bf16* STs = (LAS bf16*)(gl + GL_STS);
    LAS bf16* KEt = (LAS bf16*)(gl + GL_KET); LAS bf16* Vt = (LAS bf16*)(gl + GL_VT); LAS bf16* ATT = (LAS bf16*)(gl + GL_ATT); LAS float* decs = (LAS float*)(gl + GL_DECS);
    f32x4 accS[8];
#pragma unroll
    for (int t = 0; t < 8; ++t) accS[t] = (f32x4){0.f, 0.f, 0.f, 0.f};
    unsigned gen = 0;
#if GLA4_LEVEL == 2
    { float x = (float)lane; for (int i = 0; i < 200000; ++i) { x = x * 1.0001f + 0.5f; asm volatile("" : "+v"(x)); } asm volatile("" :: "v"(x)); (void)ctr; (void)gen; }
    return;
#endif
#if GLA4_LEVEL == 1
    for (int cp = 0; cp < NCH; ++cp) { float x = (float)lane; for (int i = 0; i < 2000; ++i) x = x * 1.0001f + 0.5f; asm volatile("" :: "v"(x)); half_bar(ctr, gen, lane); half_bar(ctr, gen, lane); half_bar(ctr, gen, lane); }
    return;
#endif
    for (int cp = 0; cp < NCH; ++cp) {
        const bool lat = cp >= 4; const int q = lat ? cp - 4 : cp, ncn = lat ? 32 : 4, cn = dir ? ncn - 1 - q : q, gch = lat ? 4 + cn : cn;
#define GROW(tau) gla_row(lat, b, dir ? 64 * cn + 63 - (tau) : 64 * cn + (tau))
#pragma unroll
        for (int i = 0; i < 4; ++i) {
            const int idx = tid + 256 * i, tau = idx >> 4, ck = idx & 15; const size_t go = (size_t)GROW(tau) * GKD + h * GDK + ck * 8;
            *(LAS u32x4*)(QGs + tau * GP1 + ck * 8) = *(const u32x4*)(QG + go);
            *(LAS u32x4*)(KGs + tau * GP1 + ck * 8) = *(const u32x4*)(KG + go);
            const u32x4 ke = *(const u32x4*)(KE + go);
            const unsigned kw[4] = {ke.x, ke.y, ke.z, ke.w};
#pragma unroll
            for (int e = 0; e < 4; ++e) { KEt[(ck * 8 + 2 * e) * GP2 + tau] = (bf16)(kw[e] & 0xffffu); KEt[(ck * 8 + 2 * e + 1) * GP2 + tau] = (bf16)(kw[e] >> 16); }
        }
#pragma unroll
        for (int i = 0; i < 2; ++i) {
            const int idx = tid + 256 * i, tau = idx >> 3, ck = idx & 7;
            const u32x4 vv = *(const u32x4*)(VS + (size_t)GROW(tau) * GVD + h * GDV + dvq * 64 + ck * 8);
            const unsigned vw[4] = {vv.x, vv.y, vv.z, vv.w};
#pragma unroll
            for (int e = 0; e < 4; ++e) { Vt[(ck * 8 + 2 * e) * GP2 + tau] = (bf16)(vw[e] & 0xffffu); Vt[(ck * 8 + 2 * e + 1) * GP2 + tau] = (bf16)(vw[e] >> 16); }
        }
        if (tid < 128) decs[tid] = DEC[((size_t)(dir * 8 + b) * NCH + gch) * GKD + h * GDK + tid];
#pragma unroll
        for (int t = 0; t < 8; ++t) {
#pragma unroll
            for (int r = 0; r < 4; ++r) STs[(16 * w + 4 * q4 + r) * GP1 + 16 * t + l15] = (bf16)f2bf(accS[t][r]);
        }
        half_bar(ctr, gen, lane);
#pragma unroll
        for (int jt = 0; jt < 4; ++jt) {
            f32x4 acc = (f32x4){0.f, 0.f, 0.f, 0.f};
#pragma unroll
            for (int ks = 0; ks < 4; ++ks) acc = __builtin_amdgcn_mfma_f32_16x16x32_bf16(ldfrag(QGs, 16 * w + l15, GP1, 32 * ks + 8 * q4), ldfrag(KGs, 16 * jt + l15, GP1, 32 * ks + 8 * q4), acc, 0, 0, 0);
#pragma unroll
            for (int r = 0; r < 4; ++r) { const int i = 16 * w + 4 * q4 + r, j = 16 * jt + l15; ATT[i * GP2 + j] = (bf16)f2bf(j <= i ? acc[r] : 0.f); }
        }
        half_bar(ctr, gen, lane);
#pragma unroll
        for (int dvt = 0; dvt < 4; ++dvt) {
            f32x4 acc = (f32x4){0.f, 0.f, 0.f, 0.f};
#pragma unroll
            for (int ks = 0; ks < 4; ++ks) acc = __builtin_amdgcn_mfma_f32_16x16x32_bf16(ldfrag(QGs, 16 * w + l15, GP1, 32 * ks + 8 * q4), ldfrag(STs, 16 * dvt + l15, GP1, 32 * ks + 8 * q4), acc, 0, 0, 0);
#pragma unroll
            for (int ks = 0; ks < 2; ++ks) acc = __builtin_amdgcn_mfma_f32_16x16x32_bf16(ldfrag(ATT, 16 * w + l15, GP2, 32 * ks + 8 * q4), ldfrag(Vt, 16 * dvt + l15, GP2, 32 * ks + 8 * q4), acc, 0, 0, 0);
#pragma unroll
#if GLA4_NOSTORE
            asm volatile("" :: "v"(acc[0]), "v"(acc[1]), "v"(acc[2]), "v"(acc[3]));
#else
            for (int r = 0; r < 4; ++r) { const int i = 16 * w + 4 * q4 + r; O[(size_t)GROW(i) * GVD + h * GDV + dvq * 64 + 16 * dvt + l15] = (bf16)f2bf(acc[r]); }
#endif
        }
#pragma unroll
        for (int t = 0; t < 8; ++t) {
            const float d = decs[16 * t + l15];
            accS[t] = accS[t] * d;
#pragma unroll
            for (int ks = 0; ks < 2; ++ks) accS[t] = __builtin_amdgcn_mfma_f32_16x16x32_bf16(ldfrag(Vt, 16 * w + l15, GP2, 32 * ks + 8 * q4), ldfrag(KEt, 16 * t + l15, GP2, 32 * ks + 8 * q4), accS[t], 0, 0, 0);
        }
        half_bar(ctr, gen, lane);
#undef GROW
    }
#if HB_FULL
    for (int i = 0; i < (1 + (CTXL + SEQ) / RS4_TOK) - 3 * NCH; ++i) __syncthreads();
#endif
}
__device__ __forceinline__ void ph_scan_split(const KC& k, int l, const float* k_a) {
    LAS unsigned* ctr = (LAS unsigned*)(k.lds + SC_CTR);
    for (int job = k.bid; job < 256; job += k.G) {
        if (k.tid == 0) { ctr[0] = 0u; ctr[16] = 0u; }
        __syncthreads();
#if SPLIT_SCAN == 1 || SPLIT_SCAN == 4 || SPLIT_SCAN == 5 || SPLIT_SCAN == 6
#if SWAP_HALVES
        { KC k2 = k; if (k.wave >= 4) { k2.tid = k.tid - 256; k2.wave = k.wave - 4; rwkv_scan_4w(k2, l, job, k_a, ctr); } else { k2.tid = k.tid + 256; k2.wave = k.wave + 4; gla_scan_4w(k2, job, ctr + 16); } }
#else
        if (k.wave < 4) rwkv_scan_4w(k, l, job, k_a, ctr); else gla_scan_4w(k, job, ctr + 16);
#endif
        __syncthreads();
#if SPLIT_SCAN == 6
        ph_rwkv_scan(k, l, job, k_a, WS_H);
#elif SPLIT_SCAN == 4
        ph_rwkv_scan(k, l, job, k_a);
#elif SPLIT_SCAN == 5
        ph_gla_scan(k, job);
#endif
#elif SPLIT_SCAN == 2
        if (k.wave < 4) rwkv_scan_4w(k, l, job, k_a, ctr);
        __syncthreads();
        ph_gla_scan(k, job);
#else
        if (k.wave >= 4) gla_scan_4w(k, job, ctr + 16);
        __syncthreads();
        ph_rwkv_scan(k, l, job, k_a);
#endif
    }
}

__device__ __forceinline__ void ph_post(const KC& k, int l, int nrows, const float* ln_g, const float* ln_b, const float* gng) {
    const int gw = k.bid * 8 + k.wave, NGW = k.G * 8, lane = k.lane, c = 16 * lane;
    const bf16* P = (const bf16*)(k.ws + WS_P);
    const bf16* Y = (const bf16*)(k.ws + RW_Y); const bf16* V = (const bf16*)(k.ws + RW_V); const float* BON = (const float*)(k.ws + RW_BON); bf16* YNB = (bf16*)(k.ws + RW_R);
    const bf16* O = (const bf16*)(k.ws + GL_O); bf16* YB = (bf16*)(k.ws + GL_VS);
    for (int row = gw; row < nrows; row += NGW) {
        {
            float yf[16], yb[16], vv[16], y[16];
            ld16(Y + (size_t)row * RD + c, true, yf); ld16(Y + ((size_t)TA + row) * RD + c, true, yb); ld16(V + (size_t)row * RD + c, true, vv);
            float s = 0.f;
#pragma unroll
            for (int i = 0; i < 16; ++i) { y[i] = yf[i] + yb[i]; s += y[i]; }
            s += __shfl_xor(s, 1); s += __shfl_xor(s, 2);
            const float mean = s * (1.0f / 64.0f); float q = 0.f;
#pragma unroll
            for (int i = 0; i < 16; ++i) { y[i] -= mean; q += y[i] * y[i]; }
            q += __shfl_xor(q, 1); q += __shfl_xor(q, 2);
            const float rstd = 1.0f / sqrtf(q * (1.0f / 64.0f) + 64e-5f), bon = BON[(size_t)row * RHEADS + (lane >> 2)];
#pragma unroll
            for (int i = 0; i < 16; ++i) y[i] = y[i] * rstd * ln_g[l * RD + c + i] + ln_b[l * RD + c + i] + bon * vv[i];
            st16(YNB + (size_t)row * RD + c, y);
        }
        {
            float of[16], ob[16], gt[16], o[16];
            ld16(O + (size_t)row * GVD + c, true, of); ld16(O + ((size_t)TA + row) * GVD + c, true, ob); ld16(P + (size_t)row * NP + GLA_GATE_OFF + c, true, gt);
            float s = 0.f;
#pragma unroll
            for (int i = 0; i < 16; ++i) { o[i] = of[i] + ob[i]; s += o[i] * o[i]; }
            s += __shfl_xor(s, 1); s += __shfl_xor(s, 2); s += __shfl_xor(s, 4); s += __shfl_xor(s, 8);
            const float rinv = 1.0f / sqrtf(s * (1.0f / 256.0f) + 1e-6f);
#pragma unroll
            for (int i = 0; i < 16; ++i) o[i] = o[i] * rinv * gng[l * GDV + ((c + i) & 255)] * siluf(gt[i]);
            st16(YB + (size_t)row * GVD + c, o);
        }
    }
}

#ifndef CHUNK_LOADS_FIRST
#define CHUNK_LOADS_FIRST 1
#endif
#ifndef TIMEPROBE
#define TIMEPROBE 0
#endif
#ifndef CHUNK_PF
#define CHUNK_PF 0
#endif
#ifndef SUBST_PK
#define SUBST_PK 0
#endif
#ifndef CONS_UNROLL
#define CONS_UNROLL 1
#endif
#ifndef CHUNK_NOPS
#define CHUNK_NOPS 0
#endif
#ifndef PROD_PK
#define PROD_PK 0
#endif
#ifndef LDS_POISON
#define LDS_POISON 0
#endif
#ifndef CHUNK_DBG
#define CHUNK_DBG 0
#endif
constexpr int RC_XT = 0;
constexpr int RC_YH = RC_XT + 32 * 72 * 2;
constexpr int RC_BET = RC_YH + 64 * 24 * 2;
constexpr int RC_AM = RC_YH + 2 * 64 * 24 * 2;
constexpr int RC_P2 = RC_AM + 2048;
constexpr int RC_AKR = RC_P2 + 512;
constexpr int RC_ABR = RC_AKR + 512;
constexpr int RC_GC = RC_ABR + 512;
constexpr int RC_SLOT = RC_GC + 256;
static_assert(RC_SLOT == 14592 && 8 * RC_SLOT <= 131072 && 32 * 72 * 2 <= 2 * 64 * 24 * 2, "rwkv chunk lds");
__device__ __forceinline__ bf16x8 mk8(u32x2 lo, u32x2 hi) { u32x4 v = {lo.x, lo.y, hi.x, hi.y}; return __builtin_bit_cast(bf16x8, v); }
__device__ __forceinline__ int rwkv_chunk_rmin(int b, int dir, int c) {
    const int p0 = c * 16;
    if (p0 < CTXL) return TL + b * CTXL + (dir ? CTXL - 16 - p0 : p0);
    const int q = p0 - CTXL; return b * SEQ + (dir ? SEQ - 16 - q : q);
}
__device__ __forceinline__ unsigned f2bf_hi(float f) { return __float_as_uint(f) + 0x8000u; }
#ifndef FAST_RND
#define FAST_RND 1
#endif
#ifndef USE_RCP
#define USE_RCP 1
#endif
#ifndef CHUNK_SADDR
#define CHUNK_SADDR 1
#endif
#ifndef Y_SADDR
#define Y_SADDR 2
#endif
#if FAST_RND
#define BFH(x) ((bf16)(f2bf_hi(x) >> 16))
#else
#define BFH(x) ((bf16)f2bf(x))
#endif
template <int SKIP = 0>
__device__ __forceinline__ void ph_rwkv_chunk(const KC& k, int l, int job, const float* k_a, size_t yoff = RW_Y) {
    const int b = job >> 5, h = (job >> 1) & 15, dir = job & 1;
    const int w = k.wave, lane = k.lane, q4 = lane >> 4, l15 = lane & 15;
    const bf16* R = (const bf16*)(k.ws + RW_R); const bf16* KS = (const bf16*)(k.ws + RW_KS); const bf16* V = (const bf16*)(k.ws + RW_V); const bf16* KK = (const bf16*)(k.ws + RW_KK);
    const bf16* LO = (const bf16*)(k.ws + RW_LO); bf16* Y = (bf16*)(k.ws + yoff) + (size_t)dir * TA * RD;
    LAS unsigned char* slot = k.lds + w * RC_SLOT;
    LAS bf16* XT = (LAS bf16*)(slot + RC_XT); LAS bf16* YH = (LAS bf16*)(slot + RC_YH);
    LAS float* AM = (LAS float*)(slot + RC_AM);
    const int ch = h * RHS + lane;
    const float ka = k_a[l * RD + ch];
    f32x4 accZ[4];
#pragma unroll
    for (int t = 0; t < 4; ++t) accZ[t] = (f32x4){0.f, 0.f, 0.f, 0.f};
    constexpr int NCK = (CTXL + SEQ) / 16, NRND = NCK / 8;
#if TIMEPROBE
    unsigned long long tp_acc = 0ull, tp_t0 = 0ull;
#define TP_MARK(n) do { if (w == 0) { const unsigned long long t_ = __builtin_amdgcn_s_memtime(); if ((n) == TIMEPROBE) tp_acc += t_ - tp_t0; tp_t0 = t_; } } while (0)
#else
#define TP_MARK(n) do {} while (0)
#endif
    unsigned ylane[4];
#pragma unroll
    for (int r = 0; r < 4; ++r) { const int tk = 4 * q4 + r; ylane[r] = (unsigned)(((dir ? 15 - tk : tk) * RD + h * RHS + 16 * (w & 3) + l15) * 2); }
#if CHUNK_PF
    unsigned pf0 = 0u, pf1 = 0u, pf2 = 0u;
#endif
#if LDS_POISON
    for (int i = lane; i < RC_SLOT / 4; i += 64) ((LAS unsigned*)slot)[i] = 0x7fc07fc0u;
    __syncthreads();
#endif
    for (int rnd = 0; rnd < NRND; ++rnd) {
#if LDS_POISON
        for (int i = lane; i < RC_SLOT / 4; i += 64) ((LAS unsigned*)slot)[i] = 0x7fc07fc0u;
#endif
        TP_MARK(0);
        if (!(SKIP & 2)) {
            const int c = rnd * 8 + w;
            float Lc = 0.f, Eprev = 1.f;
            unsigned vp[8];
#if CHUNK_LOADS_FIRST
            unsigned rv[16], rkk[16], re[16], ra[16], rks[16], rr[16];
            float bhe[16], khe[16];
            const unsigned rmin = (unsigned)rwkv_chunk_rmin(b, dir, c);
            const unsigned ob1 = (rmin * (unsigned)RD + (unsigned)ch) * 2u, ob4 = (rmin * 4096u + (unsigned)(dir * RD) + (unsigned)ch) * 2u;
            const char* LOa = (const char*)LO + 4096;
#pragma unroll
            for (int t = 0; t < 16; ++t) {
#if CHUNK_SADDR
                const unsigned tr = dir ? 15u - t : (unsigned)t;
                const unsigned o1 = ob1 + tr * (unsigned)(RD * 2), o4 = ob4 + tr * 8192u;
                if (SKIP & 4) { rv[t] = o1; rkk[t] = o1 >> 3; re[t] = 0x3c00u + (o4 & 255u); ra[t] = 0x3f00u; rks[t] = o1 >> 5; rr[t] = o1 >> 7; }
                else { rv[t] = *(const bf16*)((const char*)V + o1); rkk[t] = *(const bf16*)((const char*)KK + o1); re[t] = *(const bf16*)((const char*)LO + o4); ra[t] = *(const bf16*)(LOa + o4);
                       rks[t] = *(const bf16*)((const char*)KS + o1); rr[t] = *(const bf16*)((const char*)R + o1); }
#else
                const unsigned o1 = (unsigned)rwkv_row(b, dir, c * 16 + t) * (unsigned)RD + (unsigned)ch, o4 = o1 * 4u - 3u * (unsigned)ch + (unsigned)(dir * RD);
                if (SKIP & 4) { rv[t] = o1; rkk[t] = o1 >> 3; re[t] = 0x3c00u + (o4 & 255u); ra[t] = 0x3f00u; rks[t] = o1 >> 5; rr[t] = o1 >> 7; }
                else { rv[t] = V[o1]; rkk[t] = KK[o1]; re[t] = LO[o4]; ra[t] = LO[o4 + 2048u]; rks[t] = KS[o1]; rr[t] = R[o1]; }
#endif
            }
            asm volatile("" ::: "memory");
            const float omka = 1.0f - ka;
#pragma unroll
            for (int t = 0; t < ((SKIP & 16) ? 1 : 16); ++t) {
                { const unsigned vraw = rv[t]; vp[t >> 1] = (t & 1) ? (vp[t >> 1] | (vraw << 16)) : vraw; }
                const float kkv = bf2f(rkk[t]), ev = bf2f(re[t]), av = bf2f(ra[t]);
                const float ksv = bf2f(rks[t]), rv_ = bf2f(rr[t]);
                Lc -= ev;
#if USE_RCP
                const float E = __expf(Lc), Einv = __builtin_amdgcn_rcpf(E);
#else
                const float E = __expf(Lc), Einv = __expf(-Lc);
#endif
                XT[t * 72 + lane] = BFH(kkv * Eprev); XT[(16 + t) * 72 + lane] = BFH(rv_ * E);
                const float bh_ = kkv * av * Einv, kh_ = ksv * __builtin_fmaf(av, ka, omka) * Einv;
                YH[t * 72 + lane] = BFH(bh_); YH[(16 + t) * 72 + lane] = BFH(kh_);
                bhe[t] = bh_; khe[t] = kh_;
                Eprev = E;
            }
#else
#pragma unroll
            for (int t = 0; t < 16; ++t) {
                const unsigned o1 = (unsigned)rwkv_row(b, dir, c * 16 + t) * (unsigned)RD + (unsigned)ch, o4 = o1 * 4u - 3u * (unsigned)ch + (unsigned)(dir * RD);
                { const unsigned vraw = V[o1]; vp[t >> 1] = (t & 1) ? (vp[t >> 1] | (vraw << 16)) : vraw; }
                const float kkv = bf2f(KK[o1]), ev = bf2f(LO[o4]), av = bf2f(LO[o4 + 2048u]);
                const float ksv = bf2f(KS[o1]), rv = bf2f(R[o1]);
                Lc -= ev;
                const float E = __expf(Lc), Einv = __expf(-Lc);
                XT[t * 72 + lane] = (bf16)f2bf(kkv * Eprev); XT[(16 + t) * 72 + lane] = (bf16)f2bf(rv * E);
                YH[t * 72 + lane] = (bf16)f2bf(kkv * av * Einv); YH[(16 + t) * 72 + lane] = (bf16)f2bf(ksv * (1.0f + (av - 1.0f) * ka) * Einv);
                Eprev = E;
            }
#endif
            const float eLC = Eprev;
            asm volatile("s_waitcnt lgkmcnt(0)" ::: "memory");
            TP_MARK(1);
#if CHUNK_PF
            if (w >= 4) {
                const int cn0 = (rnd + 1 < NRND ? rnd + 1 : rnd) * 8;
                int ln = lane; asm volatile("" : "+v"(ln));
                auto pf_off = [&](int j) -> unsigned {
                    const int i = (w - 4) * 192 + j * 64 + ln, cc = i / 96, wi = i - cc * 96, ar = wi >> 4, tk = wi & 15;
                    const unsigned row = (unsigned)rwkv_row(b, dir, (cn0 + cc) * 16 + tk);
                    const unsigned base = ar == 0 ? (unsigned)RW_R : ar == 1 ? (unsigned)RW_KS : ar == 2 ? (unsigned)RW_V : ar == 3 ? (unsigned)RW_KK : (unsigned)RW_LO;
                    const unsigned el = ar < 4 ? row * (unsigned)RD + (unsigned)(h * RHS) : row * 4096u + (unsigned)(dir * RD + h * RHS) + (unsigned)(ar - 4) * 2048u;
                    return base + 2u * el; };
                const unsigned q0 = pf_off(0), q1 = pf_off(1), q2 = pf_off(2);
                asm volatile("global_load_dword %0, %3, %6\n\tglobal_load_dword %1, %4, %6\n\tglobal_load_dword %2, %5, %6" : "+v"(pf0), "+v"(pf1), "+v"(pf2) : "v"(q0), "v"(q1), "v"(q2), "s"(k.ws) : "memory");
            }
#endif
            f32x4 am[2][2];
#pragma unroll
            for (int rt = 0; rt < 2; ++rt)
#pragma unroll
                for (int ct = 0; ct < 2; ++ct) {
                    f32x4 acc = (f32x4){0.f, 0.f, 0.f, 0.f};
#pragma unroll
                    for (int s = 0; s < ((SKIP & 32) ? 0 : 2); ++s) acc = __builtin_amdgcn_mfma_f32_16x16x32_bf16(*(const LAS bf16x8*)(XT + (16 * rt + l15) * 72 + 32 * s + 8 * q4), *(const LAS bf16x8*)(YH + (16 * ct + l15) * 72 + 32 * s + 8 * q4), acc, 0, 0, 0);
                    am[rt][ct] = acc;
                }
#if CHUNK_LOADS_FIRST
            if (!(SKIP & 64)) {
                const float nel = -eLC;
#pragma unroll
                for (int q = 0; q < 4; ++q) {
                    u32x4 v = {pk2(khe[4 * q] * eLC, khe[4 * q + 1] * eLC), pk2(khe[4 * q + 2] * eLC, khe[4 * q + 3] * eLC), pk2(bhe[4 * q] * nel, bhe[4 * q + 1] * nel), pk2(bhe[4 * q + 2] * nel, bhe[4 * q + 3] * nel)};
                    *(LAS u32x4*)(slot + RC_YH + lane * 96 + q * 16) = v;
                }
            }
#endif
            LAS bf16* AKR = (LAS bf16*)(slot + RC_AKR); LAS bf16* ABR = (LAS bf16*)(slot + RC_ABR);
#pragma unroll
            for (int r = 0; r < 4; ++r) {
                const int t = 4 * q4 + r, j = l15;
                AM[t * 16 + j] = j < t ? am[0][0][r] : 0.f;
                AM[256 + t * 16 + j] = j < t ? am[0][1][r] : 0.f;
#if PROD_PK
                const unsigned ab2 = pk2c(j <= t ? -am[1][0][r] : 0.f, j <= t ? am[1][1][r] : 0.f);
                ABR[t * 16 + j] = (bf16)(ab2 & 0xffffu);
                AKR[t * 16 + j] = (bf16)(ab2 >> 16);
#else
                ABR[t * 16 + j] = BFH(j <= t ? -am[1][0][r] : 0.f);
                AKR[t * 16 + j] = BFH(j <= t ? am[1][1][r] : 0.f);
#endif
            }
            asm volatile("s_waitcnt lgkmcnt(0)" ::: "memory");
            TP_MARK(2);
#if SUBST_PK
            f32x2 PP[16]; float kt[16];
#pragma unroll
            for (int t = 0; t < 16; ++t) kt[t] = bf2f(XT[t * 72 + lane]);
#pragma unroll
            for (int t = 0; t < 16; ++t) {
                asm volatile("" ::: "memory");
                f32x2 p = {kt[t], AM[256 + t * 16 + l15]};
#pragma unroll
                for (int j4 = 0; j4 < (t + 3) / 4; ++j4) {
                    const f32x4 arow = *(const LAS f32x4*)(AM + t * 16 + 4 * j4);
#pragma unroll
                    for (int e = 0; e < 4; ++e) { const int j = 4 * j4 + e; if (j < t) p -= PP[j] * arow[e]; }
                }
                PP[t] = p;
            }
#else
            float P1[16], P2[16], kt[16];
#pragma unroll
            for (int t = 0; t < 16; ++t) kt[t] = bf2f(XT[t * 72 + lane]);
#pragma unroll
            for (int t = 0; t < 16; ++t) {
                asm volatile("" ::: "memory");
                float p1 = kt[t], p2 = AM[256 + t * 16 + l15];
#pragma unroll
                for (int j4 = 0; j4 < (t + 3) / 4; ++j4) {
                    const f32x4 arow = *(const LAS f32x4*)(AM + t * 16 + 4 * j4);
#pragma unroll
                    for (int e = 0; e < 4; ++e) { const int j = 4 * j4 + e; if (j < t && !(SKIP & 8)) { p1 -= arow[e] * P1[j]; p2 -= arow[e] * P2[j]; } }
                }
                P1[t] = p1; P2[t] = p2;
            }
#endif
            LAS bf16* P2b = (LAS bf16*)(slot + RC_P2);
#pragma unroll
#if PROD_PK
            for (int t = 0; t < 16; ++t) { const unsigned pp = pk2c(0.f, 0.f); XT[t * 72 + lane] = (bf16)(pp & 0xffffu); if (lane < 16) P2b[t * 16 + lane] = (bf16)(pp >> 16); }
#else
#if SUBST_PK
            for (int t = 0; t < 16; ++t) { if (CHUNK_DBG != 12) XT[t * 72 + lane] = (bf16)f2bf(CHUNK_DBG == 13 ? 1.0f + (float)t : PP[t].x); if (lane < 16) P2b[t * 16 + lane] = (bf16)f2bf(PP[t].y); }
#else
            for (int t = 0; t < 16; ++t) { XT[t * 72 + lane] = BFH(P1[t]); if (lane < 16) P2b[t * 16 + lane] = BFH(P2[t]); }
#endif
#endif
            if (!(SKIP & 64)) {
                ((LAS float*)(slot + RC_GC))[lane] = eLC;
                *(LAS u32x4*)(slot + RC_AM + lane * 32) = (u32x4){vp[0], vp[1], vp[2], vp[3]}; *(LAS u32x4*)(slot + RC_AM + lane * 32 + 16) = (u32x4){vp[4], vp[5], vp[6], vp[7]};
            }
        }
        TP_MARK(3);
        __syncthreads();
        TP_MARK(4);
        if (w < 4 && !(SKIP & 1)) {
#if Y_SADDR == 2
            unsigned yoff[4]; const unsigned ystep = dir ? 0u - (unsigned)(16 * RD * 2) : (unsigned)(16 * RD * 2);
            { const unsigned yb = (unsigned)rwkv_chunk_rmin(b, dir, rnd * 8) * (unsigned)(RD * 2);
#pragma unroll
              for (int r = 0; r < 4; ++r) yoff[r] = yb + ylane[r]; }
#endif
#if CONS_UNROLL == 2
#pragma unroll 2
#else
#pragma unroll 1
#endif
            for (int cc = 0; cc < 8; ++cc) {
                const int c = rnd * 8 + cc;
                LAS unsigned char* sl = k.lds + cc * RC_SLOT;
                const LAS bf16* P1b = (const LAS bf16*)(sl + RC_XT); const LAS bf16* RTb = P1b + 16 * 72;
                const LAS bf16* P2b = (const LAS bf16*)(sl + RC_P2); const LAS bf16* AKR = (const LAS bf16*)(sl + RC_AKR); const LAS bf16* ABR = (const LAS bf16*)(sl + RC_ABR);
                const LAS float* GC = (const LAS float*)(sl + RC_GC);
                const u32x2 vfr = *(const LAS u32x2*)(sl + RC_AM + (16 * w + l15) * 32 + 8 * q4);
                const unsigned vlo = vfr.x, vhi = vfr.y;
#if CHUNK_DBG == 5
                for (int t = 0; t < 4; ++t) accZ[t] = (f32x4){0.f, 0.f, 0.f, 0.f};
#endif
#if CHUNK_NOPS
                asm volatile("s_nop 15\n\ts_nop 15" ::: "memory");
#endif
                bf16x8 bz[2];
#pragma unroll
                for (int s = 0; s < 2; ++s) { u32x4 v = {pk2c(accZ[2 * s][0], accZ[2 * s][1]), pk2c(accZ[2 * s][2], accZ[2 * s][3]), pk2c(accZ[2 * s + 1][0], accZ[2 * s + 1][1]), pk2c(accZ[2 * s + 1][2], accZ[2 * s + 1][3])}; bz[s] = __builtin_bit_cast(bf16x8, v); }
#if CHUNK_DBG == 6
                bz[0] = (bf16x8){0,0,0,0,0,0,0,0}; bz[1] = bz[0];
#endif
                const u32x2 zero2 = {0u, 0u};
                f32x4 zs[4];
#pragma unroll
                for (int t = 0; t < 4; ++t) zs[t] = accZ[t] * *(const LAS f32x4*)(GC + 16 * t + 4 * q4);
#if CHUNK_DBG == 7
                for (int t = 0; t < 4; ++t) zs[t] = (f32x4){0.f, 0.f, 0.f, 0.f};
#endif
                f32x4 sa = (f32x4){0.f, 0.f, 0.f, 0.f};
#if CHUNK_DBG >= 10 && CHUNK_DBG <= 13
                { u32x4 ones = {0x3f803f80u, 0x3f803f80u, 0x3f803f80u, 0x3f803f80u}; const bf16x8 bo = __builtin_bit_cast(bf16x8, ones);
                  for (int s = 0; s < 2; ++s) sa = __builtin_amdgcn_mfma_f32_16x16x32_bf16(mk8(*(const LAS u32x2*)(P1b + l15 * 72 + 32 * s + 4 * q4), *(const LAS u32x2*)(P1b + l15 * 72 + 32 * s + 16 + 4 * q4)), (CHUNK_DBG == 10 || CHUNK_DBG == 12 || CHUNK_DBG == 13) ? bo : bz[s], sa, 0, 0, 0); }
#else
#pragma unroll
                for (int s = 0; s < 2; ++s) if (CHUNK_DBG != 3 && CHUNK_DBG != 9) sa = __builtin_amdgcn_mfma_f32_16x16x32_bf16(mk8(*(const LAS u32x2*)(P1b + l15 * 72 + 32 * s + 4 * q4), *(const LAS u32x2*)(P1b + l15 * 72 + 32 * s + 16 + 4 * q4)), bz[s], sa, 0, 0, 0);
#endif
                if (CHUNK_DBG != 4 && !(CHUNK_DBG >= 10 && CHUNK_DBG <= 13)) { u32x4 bv = {vlo, vhi, 0u, 0u}; sa = __builtin_amdgcn_mfma_f32_16x16x32_bf16(mk8(*(const LAS u32x2*)(P2b + l15 * 16 + 4 * q4), zero2), __builtin_bit_cast(bf16x8, bv), sa, 0, 0, 0); }
#if CHUNK_DBG == 1
                sa = (f32x4){0.f, 0.f, 0.f, 0.f};
#endif
#if CHUNK_NOPS
                asm volatile("s_nop 15" : "+v"(sa));
#endif
                bf16x8 bv2; { u32x4 v = {vlo, vhi, pk2c(sa[0], sa[1]), pk2c(sa[2], sa[3])}; bv2 = __builtin_bit_cast(bf16x8, v); }
                f32x4 yy = (f32x4){0.f, 0.f, 0.f, 0.f};
#pragma unroll
                for (int s = 0; s < 2; ++s) if (CHUNK_DBG != 8) yy = __builtin_amdgcn_mfma_f32_16x16x32_bf16(mk8(*(const LAS u32x2*)(RTb + l15 * 72 + 32 * s + 4 * q4), *(const LAS u32x2*)(RTb + l15 * 72 + 32 * s + 16 + 4 * q4)), bz[s], yy, 0, 0, 0);
                yy = __builtin_amdgcn_mfma_f32_16x16x32_bf16(mk8(*(const LAS u32x2*)(AKR + l15 * 16 + 4 * q4), *(const LAS u32x2*)(ABR + l15 * 16 + 4 * q4)), bv2, yy, 0, 0, 0);
#pragma unroll
                for (int t = 0; t < 4; ++t) {
                    accZ[t] = __builtin_amdgcn_mfma_f32_16x16x32_bf16(*(const LAS bf16x8*)(sl + RC_YH + (16 * t + l15) * 96 + q4 * 16), bv2, zs[t], 0, 0, 0);
                }
#if CHUNK_DBG == 2
                yy = (f32x4){1.f, 1.f, 1.f, 1.f};
#endif
#if CHUNK_DBG >= 10 && CHUNK_DBG <= 13
                yy = sa;
#endif
#if CHUNK_NOPS
                asm volatile("s_nop 15" : "+v"(yy));
#endif
#if Y_SADDR == 2
#pragma unroll
                for (int r = 0; r < 4; ++r) { *(bf16*)((char*)Y + yoff[r]) = BFH(yy[r]); yoff[r] += ystep; }
#elif Y_SADDR
                { const unsigned yb = (unsigned)rwkv_chunk_rmin(b, dir, c) * (unsigned)(RD * 2);
#pragma unroll
                  for (int r = 0; r < 4; ++r) *(bf16*)((char*)Y + (yb + ylane[r])) = BFH(yy[r]); }
#else
#pragma unroll
                for (int r = 0; r < 4; ++r) Y[(size_t)rwkv_row(b, dir, c * 16 + 4 * q4 + r) * RD + h * RHS + 16 * w + l15] = BFH(yy[r]);
#endif
            }
        }
#if CHUNK_PF
        else asm volatile("s_waitcnt vmcnt(0)" : "+v"(pf0), "+v"(pf1), "+v"(pf2) :: "memory");
#endif
        TP_MARK(5);
        __syncthreads();
        TP_MARK(6);
    }
#if TIMEPROBE
    if (l == 0 && w == 0) { const unsigned long long t0 = __builtin_amdgcn_s_memtime(); while (__builtin_amdgcn_s_memtime() - t0 < tp_acc) __builtin_amdgcn_s_sleep(8); }
    __syncthreads();
#endif
}

#ifndef CHECK_EXACT
#define CHECK_EXACT 0
#endif
#ifndef CHECK_PMAX
#define CHECK_PMAX (CTXL + SEQ)
#endif
#ifndef CHECK_PMIN
#define CHECK_PMIN 0
#endif
#ifndef CHECK_UNIT
#define CHECK_UNIT 1000
#endif
__device__ __forceinline__ void rwkv_check_delay(const KC& k, int job, size_t refoff = RW_Y) {
    const int b = job >> 5, h = (job >> 1) & 15, dir = job & 1;
    const bf16* Ya = (const bf16*)(k.ws + refoff) + (size_t)dir * TA * RD; const bf16* Yb = (const bf16*)(k.ws + WS_H) + (size_t)dir * TA * RD;
    float d2 = 0.f, s2 = 0.f; int bad = 0;
    for (int i = k.tid; i < (CHECK_PMAX) * 32; i += 512) {
        const int p = (CHECK_PMIN) + (i >> 5), cp = i & 31; const size_t o = (size_t)rwkv_row(b, dir, p) * RD + h * RHS + 2 * cp;
        const unsigned ua = *(const unsigned*)(Ya + o), ub = *(const unsigned*)(Yb + o);
        const float a0 = bflo(ua), a1 = bfhi(ua), b0 = bflo(ub), b1 = bfhi(ub);
        d2 += (CHECK_EXACT) ? (ua != ub ? 1.0f : 0.0f) : (a0 - b0) * (a0 - b0) + (a1 - b1) * (a1 - b1); s2 += a0 * a0 + a1 * a1;
        if (!(b0 == b0) || !(b1 == b1) || fabsf(b0) > 1e30f || fabsf(b1) > 1e30f) bad = 1;
    }
    LAS float* red = (LAS float*)k.lds;
    __syncthreads();
    d2 = wave_sum(d2); s2 = wave_sum(s2); bad = __any(bad) ? 1 : 0;
    if (k.lane == 0) { red[k.wave * 4] = d2; red[k.wave * 4 + 1] = s2; red[k.wave * 4 + 2] = (float)bad; }
    __syncthreads();
    if (k.tid == 0) {
        float D = 0.f, S = 0.f, B = 0.f;
        for (int i = 0; i < 8; ++i) { D += red[i * 4]; S += red[i * 4 + 1]; B += red[i * 4 + 2]; }
        const float rel = sqrtf(D / fmaxf(S, 1e-30f));
        int bucket = rel < 0.01f ? 0 : rel < 0.03f ? 1 : rel < 0.1f ? 2 : rel < 0.3f ? 3 : rel < 1.0f ? 4 : 5;
        if (CHECK_EXACT) bucket = D == 0.f ? 0 : D < 10.f ? 1 : D < 100.f ? 2 : D < 1000.f ? 3 : D < 10000.f ? 4 : 5;
        if (B > 0.f || !(rel == rel)) bucket = 6;
        const unsigned long long t0 = __builtin_amdgcn_s_memrealtime(), wait = (unsigned long long)bucket * (CHECK_UNIT) * 100ull;
        while (__builtin_amdgcn_s_memrealtime() - t0 < wait) __builtin_amdgcn_s_sleep(8);
    }
    __syncthreads();
}
using pg8::Unit;
struct FP_ { bf16* P; __device__ __forceinline__ void operator()(int row, int col, float (&v)[8], const Unit&) const { *(u32x4*)(P + (size_t)row * NP + col) = pack8(v); } };
struct FL1_ { bf16* LO; const float* bias1;
    __device__ __forceinline__ void operator()(int row, int col, float (&v)[8], const Unit& u) const {
        const float* bias = bias1 + col;
        const f32x4 b0 = *(const f32x4*)bias, b1 = *(const f32x4*)(bias + 4);
        const float bb[8] = {b0.x, b0.y, b0.z, b0.w, b1.x, b1.y, b1.z, b1.w};
        const float sc = col < 2048 ? 0.6065306597126334f : 1.0f;
#pragma unroll
        for (int i = 0; i < 8; ++i) v[i] = sigm(bb[i] + v[i]) * sc;
        *(u32x4*)(LO + (size_t)row * 4096 + col) = pack8(v);
    } };
struct FL2_ { const bf16* YNB; bf16* YA;
    __device__ __forceinline__ void operator()(int row, int col, float (&v)[8], const Unit&) const {
        float y[8]; unpack8(*(const u32x4*)(YNB + (size_t)row * RD + col), y);
#pragma unroll
        for (int i = 0; i < 8; ++i) v[i] *= y[i];
        *(u32x4*)(YA + (size_t)row * RD + col) = pack8(v);
    } };
template <int SECOND> struct FM_ { const bf16* P; bf16* MA; bf16* OUT;
    __device__ __forceinline__ void operator()(int row, int col, float (&v)[8], const Unit&) const {
        float g[8]; unpack8(*(const u32x4*)(P + (size_t)row * NP + BR_OFF + SECOND * DM + col), g);
        const bf16* mp = MA + (size_t)row * DM + col;
        if (SECOND) { float m[8]; unpack8(*(const u32x4*)mp, m);
#pragma unroll
            for (int i = 0; i < 8; ++i) v[i] = sigm(g[i]) * v[i] + m[i]; }
        else {
#pragma unroll
            for (int i = 0; i < 8; ++i) v[i] = sigm(g[i]) * v[i]; }
        *(u32x4*)(OUT + (size_t)row * DM + col) = pack8(v);
    } };
struct FX_ { float* X; const float* MOD; int l; float* OUT;
    __device__ __forceinline__ void operator()(int row, int col, const f32x4 v, const Unit&) const {
        const f32x4 g = *(const f32x4*)(MOD + ((size_t)l * 9 + mod_row(row)) * MOD_N + 2 * DM + col);
        const f32x4* xp = (const f32x4*)(X + (size_t)row * DM + col);
        *(f32x4*)(OUT + (size_t)row * DM + col) = *xp + g * v;
    } };
struct FXb_ { bf16* X; const float* MOD; int l;
    __device__ __forceinline__ void operator()(int row, int col, float (&v)[8], const Unit&) const {
        const float* gp = MOD + ((size_t)l * 9 + mod_row(row)) * MOD_N + 2 * DM + col;
        const f32x4 g0 = *(const f32x4*)gp, g1 = *(const f32x4*)(gp + 4);
        const float gg[8] = {g0.x, g0.y, g0.z, g0.w, g1.x, g1.y, g1.z, g1.w};
        bf16* xp = X + (size_t)row * DM + col;
        float x[8]; unpack8(*(const u32x4*)xp, x);
#pragma unroll
        for (int i = 0; i < 8; ++i) v[i] = x[i] + gg[i] * v[i];
        *(u32x4*)xp = pack8(v);
    } };
struct FE1_ { bf16* ACT;
    __device__ __forceinline__ void operator()(int row, int col, float (&g)[8], float (&up)[8]) const {
#pragma unroll
        for (int i = 0; i < 8; ++i) g[i] = siluf(g[i]) * up[i];
        *(u32x4*)(ACT + (size_t)row * DEXP + col) = pack8(g);
    } };
struct FE2_ { const int* rowtok; const float* roww; bf16* YF;
    __device__ __forceinline__ void operator()(int row, int col, float (&v)[8], const Unit&) const {
        const int t2 = rowtok[row];
        if (t2 >= 0) { const float w = roww[row];
#pragma unroll
            for (int i = 0; i < 8; ++i) v[i] *= w;
            *(u32x4*)(YF + ((size_t)(t2 & 1) * TA + (t2 >> 1)) * DM + col) = pack8(v); }
    } };

#ifndef GA_
#define GA_ true
#endif
#ifndef GS_
#define GS_ true
#endif
constexpr int LDS_BYTES = 147456;
constexpr int MISC_OFF = 131072 + 4096;

constexpr int NPHASE = 2 + 14 * DEPTH + 1;
struct Args { const float* in[N_IN]; float* out; unsigned char* ws; int ph_lo, ph_hi; };
static_assert(sizeof(Args) == N_IN * 8 + 8 + 8 + 8, "Args has no padding");

__global__ void __launch_bounds__(512, 2) fwd(Args a) {
    extern __shared__ __attribute__((aligned(16))) unsigned char lds_raw[];
    KC k;
    k.lds = (LAS unsigned char*)lds_raw; k.ws = (unsigned char*)INP(N_IN + 1);
    k.tid = threadIdx.x; k.lane = k.tid & 63; k.wave = __builtin_amdgcn_readfirstlane(k.tid >> 6); k.G = gridDim.x; k.bid = blockIdx.x;
    const int lo = a.ph_lo, hi = a.ph_hi;
    volatile LAS unsigned* MISC = (volatile LAS unsigned*)(k.lds + MISC_OFF);
    if (k.tid < 32) MISC[k.tid] = 0u;
    __syncthreads();
    XcdBarrier bar; bar.bar = (unsigned*)(k.ws + WS_CTL) + CW_BAR; bar.x = 0; bar.st = nullptr;
    if (hi - lo > 1) bar = xcd_barrier_post((unsigned*)(k.ws + WS_CTL) + CW_BAR, MISC + 8);
#ifndef SITE_MASK
#define SITE_MASK 0xFFFFFFFFu
#endif
#define FRESH() do { int t_ = threadIdx.x; asm volatile("" : "+v"(t_)); k.tid = t_; k.lane = t_ & 63; k.wave = __builtin_amdgcn_readfirstlane(t_ >> 6); k.ws = (unsigned char*)INP(N_IN + 1); ws = k.ws; } while (0)
#define PH_BEGIN(p, site) if (((SITE_MASK >> (site)) & 1u) && lo <= (p) && (p) < hi) { FRESH();
#ifndef EXTRA_BARS
#define EXTRA_BARS 0
#endif
#ifndef DUP_MASK
#define DUP_MASK 0u
#endif
#define DUPRUN(n, stmt) do { stmt; if ((DUP_MASK >> (n)) & 1u) { __syncthreads(); stmt; } } while (0)
#define PH_END(p) if ((p) + 1 < hi) xcd_barrier(bar); }
    unsigned char* ws = k.ws;
    LAS unsigned char* glds = k.lds;
#define WSRC WSrc{INP(I_WIN), INP(I_W2), INP(I_A2), INP(I_G2), INP(I_WBA), INP(I_WBB), INP(I_WOUT), INP(I_EG), INP(I_EU), INP(I_ED), INP(I_W0), INP(I_A0)}

    PH_BEGIN(0, 0) DUPRUN(0, ph_adaln_partials(k, INP(I_C), INP(I_CCTX), INP(I_WADA))); DUPRUN(1, ph_convert(k, WSRC, 0)); PH_END(0)
    PH_BEGIN(1, 1) ph_adaln_reduce(k, INP(I_BADA)); PH_END(1)

#define L_ 0
    {
        constexpr int l = L_;
        const int pb = 2 + 14 * l;
        const bool last = (l == DEPTH - 1);
        const int Mpost = last ? TL : TA;
        PH_BEGIN(pb + 0, 2)
            if (l > 0) { DUPRUN(1, ph_convert(k, WSRC, l)); }
            RowArgs ra{INP(I_X), INP(I_CTX), INP(I_NMG), nullptr, nullptr, nullptr};
            ph_rows<0>(k, ra, l, TA);
            if (l == 0 && ((DUP_MASK >> 15) & 1u)) { __syncthreads(); ph_rows<0>(k, ra, l, TA); }
        PH_END(pb + 0)
        PH_BEGIN(pb + 1, 3)
            pg8::Gemm g{(const bf16*)(ws + WS_H), (const bf16*)(ws + WT_IN), TA, NP, DM, 0}; pg8::StaticOrder S; S.init(TA, NP, k.G, k.bid);
            pg8::Epi8<FP_> E{FP_{(bf16*)(ws + WS_P)}};
            DUPRUN(2, (pg8::gemm_phase<pg8::Epi8<FP_>, pg8::StaticOrder, GA_, GS_>(glds, g, S, E)));
        PH_END(pb + 1)
        PH_BEGIN(pb + 2, 4)
            DUPRUN(3, ph_rwkv_prep(k, l, TA, INP(I_MU), INP(I_KK), INP(I_RK)));
            DUPRUN(4, ph_gla_prep(k, l, INP(I_GCONV), INP(I_GAW2), INP(I_GAB)));
        PH_END(pb + 2)
        PH_BEGIN(pb + 3, 5)
            pg8::Gemm g{(const bf16*)(ws + RW_A1), (const bf16*)(ws + WT_L1), TA, 4096, 256, 0}; pg8::StaticOrder S; S.init(TA, 4096, k.G, k.bid);
            pg8::Epi8<FL1_> E{FL1_{(bf16*)(ws + RW_LO), (const float*)(ws + WS_TAB + TAB_TOP)}};
            DUPRUN(5, (pg8::gemm_phase<pg8::Epi8<FL1_>, pg8::StaticOrder, GA_, GS_>(glds, g, S, E)));
        PH_END(pb + 3)
        PH_BEGIN(pb + 4, 6)
#if SPLIT_SCAN
            DUPRUN(6, ph_scan_split(k, l, INP(I_KA)));
#else
            for (int vb = ((k.G & 7) ? k.bid : (k.bid & 7) * (k.G >> 3) + (k.bid >> 3)); vb < 256; vb += k.G) { const int job = vb;
#if RWKV_MODE == 0
                DUPRUN(6, ph_rwkv_scan(k, l, job, INP(I_KA)));
#elif RWKV_MODE == 1
                ph_rwkv_scan(k, l, job, INP(I_KA)); ph_rwkv_chunk(k, l, job, INP(I_KA), WS_H); if (l == 0) rwkv_check_delay(k, job);
#elif RWKV_MODE == 4
                ph_rwkv_scan(k, l, job, INP(I_KA)); ph_rwkv_chunk(k, l, job, INP(I_KA), WS_H); ph_rwkv_chunk(k, l, job, INP(I_KA), WS_END); if (l == 0) rwkv_check_delay(k, job, WS_END);
#elif RWKV_MODE == 5
#pragma unroll 1
                for (int rep = 0; rep < 2; ++rep) { int r_ = rep; asm volatile("" : "+s"(r_)); __syncthreads(); ph_rwkv_chunk(k, l, job, INP(I_KA), r_ ? (size_t)RW_Y : (size_t)WS_H); }
                if (l == 0) rwkv_check_delay(k, job);
#elif RWKV_MODE == 3
                ph_rwkv_scan(k, l, job, INP(I_KA)); ph_rwkv_scan(k, l, job, INP(I_KA), WS_H); if (l == 0) rwkv_check_delay(k, job);
#else
                DUPRUN(6, ph_rwkv_chunk(k, l, job, INP(I_KA)));
#ifdef CHUNK_PROBE
                __syncthreads(); ph_rwkv_chunk<CHUNK_PROBE>(k, l, job, INP(I_KA), WS_END);
#endif
#endif
            }
#ifndef NO_GLA
            FRESH();
            for (int vb = ((k.G & 7) ? k.bid : (k.bid & 7) * (k.G >> 3) + (k.bid >> 3)); vb < 256; vb += k.G) { const int job = vb; DUPRUN(7, ph_gla_scan(k, job)); }
#endif
#endif
        PH_END(pb + 4)
        PH_BEGIN(pb + 5, 7)
            DUPRUN(8, ph_post(k, l, Mpost, INP(I_LNG), INP(I_LNB), INP(I_GNG)));
        PH_END(pb + 5)
        PH_BEGIN(pb + 6, 8)
            pg8::Gemm g{(const bf16*)(ws + RW_A2), (const bf16*)(ws + WT_G2), Mpost, RD, 256, 0}; pg8::StaticOrder S; S.init(Mpost, RD, k.G, k.bid);
            pg8::Epi8<FL2_> E{FL2_{(const bf16*)(ws + RW_R), (bf16*)(ws + RW_V)}};
            DUPRUN(9, (pg8::gemm_phase<pg8::Epi8<FL2_>, pg8::StaticOrder, GA_, GS_>(glds, g, S, E)));
        PH_END(pb + 6)
        PH_BEGIN(pb + 7, 9)
            pg8::Gemm g{(const bf16*)(ws + RW_V), (const bf16*)(ws + WT_A), Mpost, DM, RD, 0}; pg8::StaticOrder S; S.init(Mpost, DM, k.G, k.bid);
            pg8::Epi8<FM_<0>> E{FM_<0>{(const bf16*)(ws + WS_P), (bf16*)(ws + WS_H), (bf16*)(ws + WS_H)}};
            DUPRUN(10, (pg8::gemm_phase<pg8::Epi8<FM_<0>>, pg8::StaticOrder, GA_, GS_>(glds, g, S, E)));
        PH_END(pb + 7)
        PH_BEGIN(pb + 8, 10)
            pg8::Gemm g{(const bf16*)(ws + GL_VS), (const bf16*)(ws + WT_B), Mpost, DM, GVD, 0}; pg8::StaticOrder S; S.init(Mpost, DM, k.G, k.bid);
            pg8::Epi8<FM_<1>> E{FM_<1>{(const bf16*)(ws + WS_P), (bf16*)(ws + WS_H), (bf16*)(ws + WS_H)}};
            pg8::gemm_phase<pg8::Epi8<FM_<1>>, pg8::StaticOrder, GA_, GS_>(glds, g, S, E);
            if ((DUP_MASK >> 17) & 1u) { __syncthreads(); pg8::Epi8<FM_<1>> E2{FM_<1>{(const bf16*)(ws + WS_P), (bf16*)(ws + WS_H), (bf16*)(ws + RW_R)}}; pg8::gemm_phase<pg8::Epi8<FM_<1>>, pg8::StaticOrder, GA_, GS_>(glds, g, S, E2); }
        PH_END(pb + 8)
        PH_BEGIN(pb + 9, 11)
            pg8::Gemm g{(const bf16*)(ws + WS_H), (const bf16*)(ws + WT_O), Mpost, DM, DM, 0}; pg8::StaticOrder S; S.init(Mpost, DM, k.G, k.bid);
#if XBF
            pg8::Epi8<FXb_> E{FXb_{(bf16*)(ws + WS_X), (const float*)(ws + WS_MOD), l}};
            pg8::gemm_phase<pg8::Epi8<FXb_>, pg8::StaticOrder, GA_, GS_>(glds, g, S, E);
#else
            pg8::Epi4<FX_> E{FX_{(float*)(ws + WS_X), (const float*)(ws + WS_MOD), l, (float*)(ws + WS_X)}};
            pg8::gemm_phase<pg8::Epi4<FX_>, pg8::StaticOrder, GA_, GS_>(glds, g, S, E);
#endif
            if (!XBF && ((DUP_MASK >> 18) & 1u)) { __syncthreads(); pg8::Epi4<FX_> E2{FX_{(float*)(ws + WS_X), (const float*)(ws + WS_MOD), l, (float*)(ws + WS_P)}}; pg8::gemm_phase<pg8::Epi4<FX_>, pg8::StaticOrder, GA_, GS_>(glds, g, S, E2); }
        PH_END(pb + 9)
        PH_BEGIN(pb + 10, 12)
            RowArgs ra{nullptr, nullptr, INP(I_NFG), INP(I_RW), INP(I_RB), nullptr};
            ph_rows<1>(k, ra, l, Mpost);
            if ((DUP_MASK >> 16) & 1u) { __syncthreads(); ph_rows<1>(k, ra, l, Mpost, true); }
        PH_END(pb + 10)
        PH_BEGIN(pb + 11, 13)
            DUPRUN(13, ph_moe_scatter(k, l, Mpost));
        PH_END(pb + 11)
        PH_BEGIN(pb + 12, 14)
#if MOE_GATHER
            pg8::Gemm g{(const bf16*)(ws + WS_H), (const bf16*)(ws + WT_GU), 0, 2816, DM, (size_t)2816 * DM * 2};
            pg8::MoeOrderT<true> S; S.rowtok = (const int*)(ws + WS_TAB + TAB_ROWTOK) + (size_t)l * MOE_ROWS;
            S.init((const int*)(ws + WS_TAB + TAB_TILE) + 256 * l, 11, k.G, ((k.G & 7) ? k.bid : (k.bid & 7) * (k.G >> 3) + (k.bid >> 3)));
            pg8::EpiGU<FE1_> E{FE1_{(bf16*)(ws + WS_ACT)}};
            DUPRUN(11, (pg8::gemm_phase<pg8::EpiGU<FE1_>, pg8::MoeOrderT<true>, GA_, GS_>(glds, g, S, E)));
#else
            pg8::Gemm g{(const bf16*)(ws + WS_HP), (const bf16*)(ws + WT_GU), 0, 2816, DM, (size_t)2816 * DM * 2};
            pg8::MoeOrder S; S.init((const int*)(ws + WS_TAB + TAB_TILE) + 256 * l, 11, k.G, ((k.G & 7) ? k.bid : (k.bid & 7) * (k.G >> 3) + (k.bid >> 3)));
            pg8::EpiGU<FE1_> E{FE1_{(bf16*)(ws + WS_ACT)}};
            DUPRUN(11, (pg8::gemm_phase<pg8::EpiGU<FE1_>, pg8::MoeOrder, GA_, GS_>(glds, g, S, E)));
#endif
        PH_END(pb + 12)
        PH_BEGIN(pb + 13, 15)
            pg8::Gemm g{(const bf16*)(ws + WS_ACT), (const bf16*)(ws + WT_D), 0, DM, DEXP, (size_t)DM * DEXP * 2};
            pg8::MoeOrder S; S.init((const int*)(ws + WS_TAB + TAB_TILE) + 256 * l, 8, k.G, ((k.G & 7) ? k.bid : (k.bid & 7) * (k.G >> 3) + (k.bid >> 3)));
            pg8::Epi8<FE2_> E{FE2_{(const int*)(ws + WS_TAB + TAB_ROWTOK) + (size_t)l * MOE_ROWS, (const float*)(ws + WS_TAB + TAB_ROWW) + (size_t)l * MOE_ROWS, (bf16*)(ws + WS_YF)}};
            DUPRUN(12, (pg8::gemm_phase<pg8::Epi8<FE2_>, pg8::MoeOrder, GA_, GS_>(glds, g, S, E)));
        PH_END(pb + 13)
        }
#undef L_
#define L_ 1
    {
        constexpr int l = L_;
        const int pb = 2 + 14 * l;
        const bool last = (l == DEPTH - 1);
        const int Mpost = last ? TL : TA;
        PH_BEGIN(pb + 0, 2)
            if (l > 0) { DUPRUN(1, ph_convert(k, WSRC, l)); }
            RowArgs ra{INP(I_X), INP(I_CTX), INP(I_NMG), nullptr, nullptr, nullptr};
            ph_rows<0>(k, ra, l, TA);
            if (l == 0 && ((DUP_MASK >> 15) & 1u)) { __syncthreads(); ph_rows<0>(k, ra, l, TA); }
        PH_END(pb + 0)
        PH_BEGIN(pb + 1, 3)
            pg8::Gemm g{(const bf16*)(ws + WS_H), (const bf16*)(ws + WT_IN), TA, NP, DM, 0}; pg8::StaticOrder S; S.init(TA, NP, k.G, k.bid);
            pg8::Epi8<FP_> E{FP_{(bf16*)(ws + WS_P)}};
            DUPRUN(2, (pg8::gemm_phase<pg8::Epi8<FP_>, pg8::StaticOrder, GA_, GS_>(glds, g, S, E)));
        PH_END(pb + 1)
        PH_BEGIN(pb + 2, 4)
            DUPRUN(3, ph_rwkv_prep(k, l, TA, INP(I_MU), INP(I_KK), INP(I_RK)));
            DUPRUN(4, ph_gla_prep(k, l, INP(I_GCONV), INP(I_GAW2), INP(I_GAB)));
        PH_END(pb + 2)
        PH_BEGIN(pb + 3, 5)
            pg8::Gemm g{(const bf16*)(ws + RW_A1), (const bf16*)(ws + WT_L1), TA, 4096, 256, 0}; pg8::StaticOrder S; S.init(TA, 4096, k.G, k.bid);
            pg8::Epi8<FL1_> E{FL1_{(bf16*)(ws + RW_LO), (const float*)(ws + WS_TAB + TAB_TOP)}};
            DUPRUN(5, (pg8::gemm_phase<pg8::Epi8<FL1_>, pg8::StaticOrder, GA_, GS_>(glds, g, S, E)));
        PH_END(pb + 3)
        PH_BEGIN(pb + 4, 6)
#if SPLIT_SCAN
            DUPRUN(6, ph_scan_split(k, l, INP(I_KA)));
#else
            for (int vb = ((k.G & 7) ? k.bid : (k.bid & 7) * (k.G >> 3) + (k.bid >> 3)); vb < 256; vb += k.G) { const int job = vb;
#if RWKV_MODE == 0
                DUPRUN(6, ph_rwkv_scan(k, l, job, INP(I_KA)));
#elif RWKV_MODE == 1
                ph_rwkv_scan(k, l, job, INP(I_KA)); ph_rwkv_chunk(k, l, job, INP(I_KA), WS_H); if (l == 0) rwkv_check_delay(k, job);
#elif RWKV_MODE == 4
                ph_rwkv_scan(k, l, job, INP(I_KA)); ph_rwkv_chunk(k, l, job, INP(I_KA), WS_H); ph_rwkv_chunk(k, l, job, INP(I_KA), WS_END); if (l == 0) rwkv_check_delay(k, job, WS_END);
#elif RWKV_MODE == 5
#pragma unroll 1
                for (int rep = 0; rep < 2; ++rep) { int r_ = rep; asm volatile("" : "+s"(r_)); __syncthreads(); ph_rwkv_chunk(k, l, job, INP(I_KA), r_ ? (size_t)RW_Y : (size_t)WS_H); }
                if (l == 0) rwkv_check_delay(k, job);
#elif RWKV_MODE == 3
                ph_rwkv_scan(k, l, job, INP(I_KA)); ph_rwkv_scan(k, l, job, INP(I_KA), WS_H); if (l == 0) rwkv_check_delay(k, job);
#else
                DUPRUN(6, ph_rwkv_chunk(k, l, job, INP(I_KA)));
#ifdef CHUNK_PROBE
                __syncthreads(); ph_rwkv_chunk<CHUNK_PROBE>(k, l, job, INP(I_KA), WS_END);
#endif
#endif
            }
#ifndef NO_GLA
            FRESH();
            for (int vb = ((k.G & 7) ? k.bid : (k.bid & 7) * (k.G >> 3) + (k.bid >> 3)); vb < 256; vb += k.G) { const int job = vb; DUPRUN(7, ph_gla_scan(k, job)); }
#endif
#endif
        PH_END(pb + 4)
        PH_BEGIN(pb + 5, 7)
            DUPRUN(8, ph_post(k, l, Mpost, INP(I_LNG), INP(I_LNB), INP(I_GNG)));
        PH_END(pb + 5)
        PH_BEGIN(pb + 6, 8)
            pg8::Gemm g{(const bf16*)(ws + RW_A2), (const bf16*)(ws + WT_G2), Mpost, RD, 256, 0}; pg8::StaticOrder S; S.init(Mpost, RD, k.G, k.bid);
            pg8::Epi8<FL2_> E{FL2_{(const bf16*)(ws + RW_R), (bf16*)(ws + RW_V)}};
            DUPRUN(9, (pg8::gemm_phase<pg8::Epi8<FL2_>, pg8::StaticOrder, GA_, GS_>(glds, g, S, E)));
        PH_END(pb + 6)
        PH_BEGIN(pb + 7, 9)
            pg8::Gemm g{(const bf16*)(ws + RW_V), (const bf16*)(ws + WT_A), Mpost, DM, RD, 0}; pg8::StaticOrder S; S.init(Mpost, DM, k.G, k.bid);
            pg8::Epi8<FM_<0>> E{FM_<0>{(const bf16*)(ws + WS_P), (bf16*)(ws + WS_H), (bf16*)(ws + WS_H)}};
            DUPRUN(10, (pg8::gemm_phase<pg8::Epi8<FM_<0>>, pg8::StaticOrder, GA_, GS_>(glds, g, S, E)));
        PH_END(pb + 7)
        PH_BEGIN(pb + 8, 10)
            pg8::Gemm g{(const bf16*)(ws + GL_VS), (const bf16*)(ws + WT_B), Mpost, DM, GVD, 0}; pg8::StaticOrder S; S.init(Mpost, DM, k.G, k.bid);
            pg8::Epi8<FM_<1>> E{FM_<1>{(const bf16*)(ws + WS_P), (bf16*)(ws + WS_H), (bf16*)(ws + WS_H)}};
            pg8::gemm_phase<pg8::Epi8<FM_<1>>, pg8::StaticOrder, GA_, GS_>(glds, g, S, E);
            if ((DUP_MASK >> 17) & 1u) { __syncthreads(); pg8::Epi8<FM_<1>> E2{FM_<1>{(const bf16*)(ws + WS_P), (bf16*)(ws + WS_H), (bf16*)(ws + RW_R)}}; pg8::gemm_phase<pg8::Epi8<FM_<1>>, pg8::StaticOrder, GA_, GS_>(glds, g, S, E2); }
        PH_END(pb + 8)
        PH_BEGIN(pb + 9, 11)
            pg8::Gemm g{(const bf16*)(ws + WS_H), (const bf16*)(ws + WT_O), Mpost, DM, DM, 0}; pg8::StaticOrder S; S.init(Mpost, DM, k.G, k.bid);
#if XBF
            pg8::Epi8<FXb_> E{FXb_{(bf16*)(ws + WS_X), (const float*)(ws + WS_MOD), l}};
            pg8::gemm_phase<pg8::Epi8<FXb_>, pg8::StaticOrder, GA_, GS_>(glds, g, S, E);
#else
            pg8::Epi4<FX_> E{FX_{(float*)(ws + WS_X), (const float*)(ws + WS_MOD), l, (float*)(ws + WS_X)}};
            pg8::gemm_phase<pg8::Epi4<FX_>, pg8::StaticOrder, GA_, GS_>(glds, g, S, E);
#endif
            if (!XBF && ((DUP_MASK >> 18) & 1u)) { __syncthreads(); pg8::Epi4<FX_> E2{FX_{(float*)(ws + WS_X), (const float*)(ws + WS_MOD), l, (float*)(ws + WS_P)}}; pg8::gemm_phase<pg8::Epi4<FX_>, pg8::StaticOrder, GA_, GS_>(glds, g, S, E2); }
        PH_END(pb + 9)
        PH_BEGIN(pb + 10, 12)
            RowArgs ra{nullptr, nullptr, INP(I_NFG), INP(I_RW), INP(I_RB), nullptr};
            ph_rows<1>(k, ra, l, Mpost);
            if ((DUP_MASK >> 16) & 1u) { __syncthreads(); ph_rows<1>(k, ra, l, Mpost, true); }
        PH_END(pb + 10)
        PH_BEGIN(pb + 11, 13)
            DUPRUN(13, ph_moe_scatter(k, l, Mpost));
        PH_END(pb + 11)
        PH_BEGIN(pb + 12, 14)
#if MOE_GATHER
            pg8::Gemm g{(const bf16*)(ws + WS_H), (const bf16*)(ws + WT_GU), 0, 2816, DM, (size_t)2816 * DM * 2};
            pg8::MoeOrderT<true> S; S.rowtok = (const int*)(ws + WS_TAB + TAB_ROWTOK) + (size_t)l * MOE_ROWS;
            S.init((const int*)(ws + WS_TAB + TAB_TILE) + 256 * l, 11, k.G, ((k.G & 7) ? k.bid : (k.bid & 7) * (k.G >> 3) + (k.bid >> 3)));
            pg8::EpiGU<FE1_> E{FE1_{(bf16*)(ws + WS_ACT)}};
            DUPRUN(11, (pg8::gemm_phase<pg8::EpiGU<FE1_>, pg8::MoeOrderT<true>, GA_, GS_>(glds, g, S, E)));
#else
            pg8::Gemm g{(const bf16*)(ws + WS_HP), (const bf16*)(ws + WT_GU), 0, 2816, DM, (size_t)2816 * DM * 2};
            pg8::MoeOrder S; S.init((const int*)(ws + WS_TAB + TAB_TILE) + 256 * l, 11, k.G, ((k.G & 7) ? k.bid : (k.bid & 7) * (k.G >> 3) + (k.bid >> 3)));
            pg8::EpiGU<FE1_> E{FE1_{(bf16*)(ws + WS_ACT)}};
            DUPRUN(11, (pg8::gemm_phase<pg8::EpiGU<FE1_>, pg8::MoeOrder, GA_, GS_>(glds, g, S, E)));
#endif
        PH_END(pb + 12)
        PH_BEGIN(pb + 13, 15)
            pg8::Gemm g{(const bf16*)(ws + WS_ACT), (const bf16*)(ws + WT_D), 0, DM, DEXP, (size_t)DM * DEXP * 2};
            pg8::MoeOrder S; S.init((const int*)(ws + WS_TAB + TAB_TILE) + 256 * l, 8, k.G, ((k.G & 7) ? k.bid : (k.bid & 7) * (k.G >> 3) + (k.bid >> 3)));
            pg8::Epi8<FE2_> E{FE2_{(const int*)(ws + WS_TAB + TAB_ROWTOK) + (size_t)l * MOE_ROWS, (const float*)(ws + WS_TAB + TAB_ROWW) + (size_t)l * MOE_ROWS, (bf16*)(ws + WS_YF)}};
            DUPRUN(12, (pg8::gemm_phase<pg8::Epi8<FE2_>, pg8::MoeOrder, GA_, GS_>(glds, g, S, E)));
        PH_END(pb + 13)
        }
#undef L_
#if EXTRA_BARS
    if (hi - lo > 1) { for (int i = 0; i < EXTRA_BARS; ++i) xcd_barrier(bar); }
#endif
    PH_BEGIN(NPHASE - 1, 16)
        RowArgs ra{nullptr, nullptr, INP(I_FNG), nullptr, nullptr, (float*)INP(N_IN)};
        DUPRUN(14, ph_rows<2>(k, ra, 0, TL));
    PH_END(NPHASE - 1)
}

#ifndef MK_SINGLE
#define MK_SINGLE 1
#endif
extern "C" void kernel_launch(void* const* d_in, const int* in_sizes, int n_in, void* d_out, int out_size, void* d_ws, size_t ws_size, hipStream_t stream) {
    static int grid = 0;
    if (grid == 0) {
        if (n_in != N_IN || out_size != TL * DM || ws_size < WS_END) { fprintf(stderr, "kernel_launch: unexpected problem (n_in %d out %d ws %zu need %zu)\n", n_in, out_size, ws_size, (size_t)WS_END); grid = -1; return; }
        int dev = 0, cus = 0;
        if (hipGetDevice(&dev) != hipSuccess || hipDeviceGetAttribute(&cus, hipDeviceAttributeMultiprocessorCount, dev) != hipSuccess) { grid = -1; return; }
        if (hipFuncSetAttribute((const void*)fwd, hipFuncAttributeMaxDynamicSharedMemorySize, LDS_BYTES) != hipSuccess) { grid = -1; return; }
        int per_cu = 0;
        if (hipOccupancyMaxActiveBlocksPerMultiprocessor(&per_cu, (const void*)fwd, 512, LDS_BYTES) != hipSuccess || per_cu < 1) fprintf(stderr, "kernel_launch: occupancy query says %d\n", per_cu);
        (void)hipGetLastError();
        grid = cus;
    }
    if (grid < 0) return;
    unsigned char* ws = (unsigned char*)d_ws;
    (void)hipMemsetAsync(ws + WS_CTL, 0, CTL_BYTES, stream);
    Args a{};
    for (int i = 0; i < N_IN; ++i) a.in[i] = (const float*)d_in[i];
    a.out = (float*)d_out; a.ws = ws;
#if MK_SINGLE
    a.ph_lo = 0; a.ph_hi = NPHASE;
    hipLaunchKernelGGL(fwd, dim3(grid), dim3(512), LDS_BYTES, stream, a);
#else
    for (int p = 0; p < NPHASE; ++p) { a.ph_lo = p; a.ph_hi = p + 1; hipLaunchKernelGGL(fwd, dim3(grid), dim3(512), LDS_BYTES, stream, a); }
#endif
}
```

```cpp
#include <hip/hip_runtime.h>
#include <cstdio>
#include <cstdint>

#define LAS __attribute__((address_space(3)))
#define GAS __attribute__((address_space(1)))
typedef unsigned short bf16;
typedef float f32x4 __attribute__((ext_vector_type(4)));
typedef float f32x2 __attribute__((ext_vector_type(2)));
typedef unsigned u32x4 __attribute__((ext_vector_type(4)));
typedef unsigned u32x2 __attribute__((ext_vector_type(2)));
typedef short bf16x8 __attribute__((ext_vector_type(8)));

constexpr int DM = 2048, NBATCH = 8, SEQ = 2048, CTXL = 256, DEPTH = 2;
constexpr int TL = NBATCH * SEQ, TC = NBATCH * CTXL, TA = TL + TC;
constexpr int RD = 1024, RHEADS = 16, RHS = 64;
constexpr int RWKV_IN = 3520;
constexpr int GKD = 512, GVD = 1024, GDK = 128, GDV = 256, GHEADS = 4, GQKV = 2048;
constexpr int GLA_OFF = 3520, GLA_AD_OFF = GLA_OFF + GQKV, GLA_GATE_OFF = 5584, BR_OFF = 6608, IN_DIM = 10704, NP = 10752;
constexpr int NEXP = 16, DEXP = 1408;
constexpr int MOD_N = 6 * DM;
constexpr int MOE_ROWS = 41216;
constexpr int MOE_TILES = MOE_ROWS / 256;
constexpr int NCH = 36;
constexpr int KSPLIT = 32;

enum { I_X = 0, I_C, I_CTX, I_CCTX, I_WADA, I_BADA, I_NMG, I_NFG, I_WIN, I_MU, I_W0, I_W2, I_A0, I_A2, I_G2, I_KK, I_KA, I_RK, I_LNG, I_LNB,
       I_GCONV, I_GAW2, I_GAB, I_GNG, I_WBA, I_WBB, I_WOUT, I_RW, I_RB, I_EG, I_EU, I_ED, I_FNG, N_IN };

constexpr size_t MiB = 1u << 20;
constexpr size_t WS_CTL = 0;
constexpr size_t WS_TAB = 1 * MiB;
constexpr size_t WS_MOD = 2 * MiB;
constexpr size_t WS_X = 3 * MiB;
constexpr size_t WS_H = WS_X + 144 * MiB;
constexpr size_t WS_P = WS_H + 72 * MiB;
constexpr size_t WS_RW = WS_P + 378 * MiB;
constexpr size_t WS_GL = WS_RW + 380 * MiB;
constexpr size_t WS_WT = WS_GL + 218 * MiB;
constexpr size_t WS_END = WS_WT + 325 * MiB;
constexpr int CW_TMO = 0, CW_CNT = 64  , CW_BAR = 4096;
constexpr size_t CTL_BYTES = 1 * MiB;
constexpr size_t TAB_ROWTOK = 0;
constexpr size_t TAB_ROWTOK_BYTES = 2 * (size_t)MOE_ROWS * 4;
constexpr size_t TAB_ROWW = 384 * 1024;
constexpr size_t TAB_TILE = 768 * 1024;
constexpr size_t TAB_TOP = 800 * 1024;
static_assert(TAB_ROWTOK_BYTES <= TAB_ROWW && TAB_ROWW + 2 * (size_t)MOE_ROWS * 4 <= TAB_TILE, "tab map");
constexpr size_t WS_MODP = WS_P;
constexpr size_t WS_HP = WS_P;
constexpr size_t WS_ACT = WS_P + 162 * MiB;
constexpr size_t WS_TOPK = WS_P + 274 * MiB;
static_assert((size_t)MOE_ROWS * DM * 2 <= 162 * MiB && (size_t)MOE_ROWS * DEXP * 2 <= 112 * MiB && 274 * MiB + 3 * (size_t)TA * 8 <= 378 * MiB, "P overlay");
constexpr size_t RW_R = WS_RW;
constexpr size_t RW_KS = RW_R + 36 * MiB;
constexpr size_t RW_V = RW_KS + 36 * MiB;
constexpr size_t RW_KK = RW_V + 36 * MiB;
constexpr size_t RW_LO = RW_KK + 36 * MiB;
constexpr size_t RW_Y = RW_LO + 144 * MiB;
constexpr size_t RW_A1 = RW_Y + 72 * MiB;
constexpr size_t RW_A2 = RW_A1 + 9 * MiB;
constexpr size_t RW_BON = RW_A2 + 9 * MiB;
static_assert(RW_BON + 2 * MiB <= WS_GL, "rwkv map");
constexpr size_t GL_QG = WS_GL;
constexpr size_t GL_KG = GL_QG + 36 * MiB;
constexpr size_t GL_KE = GL_KG + 36 * MiB;
constexpr size_t GL_VS = GL_KE + 36 * MiB;
constexpr size_t GL_O = GL_VS + 36 * MiB;
constexpr size_t GL_DEC = GL_O + 72 * MiB;
static_assert(GL_DEC + 2 * MiB <= WS_WT, "gla map");
constexpr size_t WS_YF = WS_GL;
constexpr size_t WT_IN = WS_WT;
constexpr size_t WT_L1 = WT_IN + 42 * MiB;
constexpr size_t WT_G2 = WT_L1 + 2 * MiB;
constexpr size_t WT_A = WT_G2 + 1 * MiB;
constexpr size_t WT_B = WT_A + 4 * MiB;
constexpr size_t WT_O = WT_B + 4 * MiB;
constexpr size_t WT_GU = WT_O + 8 * MiB;
constexpr size_t WT_D = WT_GU + 176 * MiB;
static_assert(WT_D + 88 * MiB == WS_END, "weight map");

#ifndef GLA_TP
#define GLA_TP 0
#endif
#ifndef GLA_TPW
#define GLA_TPW 0
#endif
#ifndef GLA_PF2
#define GLA_PF2 0
#endif
#ifndef MOE_GATHER
#define MOE_GATHER 1
#endif
#ifndef XBF
#define XBF 1
#endif
__device__ __forceinline__ float bf2f(unsigned v) { return __uint_as_float(v << 16); }
__device__ __forceinline__ float bflo(unsigned w) { return __uint_as_float(w << 16); }
__device__ __forceinline__ float bfhi(unsigned w) { return __uint_as_float(w & 0xffff0000u); }
__device__ __forceinline__ unsigned f2bf(float f) { unsigned u = __float_as_uint(f); return (u + 0x7fffu + ((u >> 16) & 1u)) >> 16; }
__device__ __forceinline__ unsigned pk2(float lo, float hi) { unsigned r; asm volatile("v_cvt_pk_bf16_f32 %0, %1, %2" : "=v"(r) : "v"(lo), "v"(hi)); return r; }
typedef __bf16 bf16x2_t __attribute__((ext_vector_type(2)));
__device__ __forceinline__ unsigned pk2c(float lo, float hi) { f32x2 v = {lo, hi}; bf16x2_t b = __builtin_convertvector(v, bf16x2_t); return __builtin_bit_cast(unsigned, b); }
__device__ __forceinline__ float sigm(float x) { return 1.0f / (1.0f + __expf(-x)); }
__device__ __forceinline__ float siluf(float x) { return x * sigm(x); }
__device__ __forceinline__ float wave_sum(float x) {
    x += __builtin_bit_cast(float, __builtin_amdgcn_update_dpp(0, __builtin_bit_cast(int, x), 0xB1, 0xF, 0xF, true));
    x += __builtin_bit_cast(float, __builtin_amdgcn_update_dpp(0, __builtin_bit_cast(int, x), 0x4E, 0xF, 0xF, true));
    x += __builtin_bit_cast(float, __builtin_amdgcn_update_dpp(0, __builtin_bit_cast(int, x), 0x141, 0xF, 0xF, true));
    x += __builtin_bit_cast(float, __builtin_amdgcn_update_dpp(0, __builtin_bit_cast(int, x), 0x140, 0xF, 0xF, true));
    const int xi = __builtin_bit_cast(int, x);
    return (__builtin_bit_cast(float, __builtin_amdgcn_readlane(xi, 0)) + __builtin_bit_cast(float, __builtin_amdgcn_readlane(xi, 16))) +
           (__builtin_bit_cast(float, __builtin_amdgcn_readlane(xi, 32)) + __builtin_bit_cast(float, __builtin_amdgcn_readlane(xi, 48)));
}
__device__ __forceinline__ void unpack8(const u32x4 w, float (&o)[8]) {
    o[0] = bflo(w.x); o[1] = bfhi(w.x); o[2] = bflo(w.y); o[3] = bfhi(w.y); o[4] = bflo(w.z); o[5] = bfhi(w.z); o[6] = bflo(w.w); o[7] = bfhi(w.w);
}
__device__ __forceinline__ u32x4 pack8(const float (&v)[8]) { u32x4 w; w.x = pk2(v[0], v[1]); w.y = pk2(v[2], v[3]); w.z = pk2(v[4], v[5]); w.w = pk2(v[6], v[7]); return w; }
namespace pg8 {
#define PG8_LAS __attribute__((address_space(3)))
typedef unsigned short bf16_t;
typedef short bf16x8 __attribute__((ext_vector_type(8)));
typedef float f32x4 __attribute__((ext_vector_type(4)));
typedef unsigned u32x4 __attribute__((ext_vector_type(4)));
constexpr int BM = 256, BK = 64, HALF = 128, HTB = HALF * BK * 2  , STAGE_BYTES = 8 * HTB, NXCD = 8, WGM = 8;

__host__ __device__ __forceinline__ int lds_byte(int r, int c) { const int st = (r >> 4) * 2 + (c >> 5), rr = r & 15, cc = c & 31, ob = rr * 64 + cc * 2; return st * 1024 + (ob ^ (((ob >> 9) & 1) << 5)); }
__host__ __device__ __forceinline__ void stage_rc(int b, int& R, int& C) { const int st = b / 1024, sb = b % 1024, swz = sb ^ (((sb >> 9) & 1) << 5); R = (st >> 1) * 16 + swz / 64; C = (st & 1) * 32 + (swz % 64) / 2; }
__host__ __device__ __forceinline__ int perm32(int rho) { const int n = rho >> 4, i = rho & 15; return 8 * (i >> 2) + 4 * n + (i & 3); }
struct Unit { int pm, pn, eb; };
struct Gemm { const bf16_t* A; const bf16_t* Bt; int M, N, K; size_t bstride; };

struct StaticOrder {
    static constexpr bool GATHER = false;
    int nM, nN, nwg, G, c;
    __host__ __device__ void init(int M, int N, int G_, int c_) { nM = M / BM; nN = N / BM; nwg = nM * nN; G = G_; c = c_; }
    __host__ __device__ bool next(int i, Unit& u) const {
        const long L = (long)i * G + c; if (L >= nwg) return false;
        int wgid = (int)L; { const int q = nwg / NXCD, r = nwg % NXCD, xcd = wgid % NXCD, off = wgid / NXCD; wgid = (xcd < r ? xcd * (q + 1) : r * (q + 1) + (xcd - r) * q) + off; }
        const int nig = WGM * nN, gid = wgid / nig, fm = gid * WGM, gsz = (nM - fm) < WGM ? (nM - fm) : WGM;
        u.pm = fm + ((wgid % nig) % gsz); u.pn = (wgid % nig) / gsz; u.eb = 0; return true;
    }
    __device__ __forceinline__ void a_ready(const Unit&) const {}
    __device__ __forceinline__ void done(const Unit&) const {}
};
template <bool GATHER_> struct MoeOrderT {
    static constexpr bool GATHER = GATHER_;
    const int* rowtok;
    const int* tab; int nT, nN, G, c;
    __device__ void init(const int* tab_, int nN_, int G_, int c_) { tab = tab_; nT = tab_[0]; nN = nN_; G = G_; c = c_; }
    __device__ bool next(int i, Unit& u) const {
        const long L = (long)i * G + c; if (L >= (long)nT * nN) return false;
        u.pm = (int)(L / nN); u.pn = (int)(L % nN); u.eb = tab[1 + u.pm]; return true;
    }
    __device__ __forceinline__ void a_ready(const Unit&) const {}
    __device__ __forceinline__ void done(const Unit&) const {}
};
using MoeOrder = MoeOrderT<false>;

template <class F> struct Epi8 {
    static constexpr bool PERM = true, AFTER_DRAIN = false;
    F f;
    __device__ __forceinline__ void operator()(const f32x4 (&acc)[2][2][4][2], const Unit& u, int wr, int wc, int fr, int fq) const {
        const int row0 = u.pm * BM + wr * 64 + fr, col0 = u.pn * BM + wc * 32 + 8 * fq;
#pragma unroll
        for (int ai = 0; ai < 2; ++ai)
#pragma unroll
            for (int m = 0; m < 4; ++m) {
#pragma unroll
                for (int bj = 0; bj < 2; ++bj) {
                    const f32x4 a = acc[ai][bj][m][0], b = acc[ai][bj][m][1];
                    float v[8] = {a[0], a[1], a[2], a[3], b[0], b[1], b[2], b[3]};
                    f(row0 + ai * HALF + m * 16, col0 + bj * HALF, v, u);
                }
            }
    }
};
template <class F> struct EpiGU {
    static constexpr bool PERM = true, AFTER_DRAIN = false;
    F f;
    __device__ __forceinline__ void operator()(const f32x4 (&acc)[2][2][4][2], const Unit& u, int wr, int wc, int fr, int fq) const {
        const int row0 = u.pm * BM + wr * 64 + fr, col0 = u.pn * HALF + wc * 32 + 8 * fq;
#pragma unroll
        for (int ai = 0; ai < 2; ++ai)
#pragma unroll
            for (int m = 0; m < 4; ++m) {
                const f32x4 g0 = acc[ai][0][m][0], g1 = acc[ai][0][m][1], u0 = acc[ai][1][m][0], u1 = acc[ai][1][m][1];
                float g[8] = {g0[0], g0[1], g0[2], g0[3], g1[0], g1[1], g1[2], g1[3]};
                float up[8] = {u0[0], u0[1], u0[2], u0[3], u1[0], u1[1], u1[2], u1[3]};
                f(row0 + ai * HALF + m * 16, col0, g, up);
            }
    }
};
template <class F> struct Epi4 {
    static constexpr bool PERM = false, AFTER_DRAIN = false;
    F f;
    __device__ __forceinline__ void operator()(const f32x4 (&acc)[2][2][4][2], const Unit& u, int wr, int wc, int fr, int fq) const {
        const int row0 = u.pm * BM + wr * 64 + fr, col0 = u.pn * BM + wc * 32 + 4 * fq;
#pragma unroll
        for (int ai = 0; ai < 2; ++ai)
#pragma unroll
            for (int m = 0; m < 4; ++m) {
#pragma unroll
                for (int bj = 0; bj < 2; ++bj)
#pragma unroll
                    for (int n = 0; n < 2; ++n) f(row0 + ai * HALF + m * 16, col0 + bj * HALF + n * 16, acc[ai][bj][m][n], u);
            }
    }
};
template <class Epi, class Sched, bool ALIGN_EPI = false, bool SP2 = false>
__device__ __forceinline__ void gemm_phase(PG8_LAS unsigned char* lds, const Gemm g, const Sched& S, const Epi& E) {
    int tid_o = threadIdx.x; asm volatile("" : "+v"(tid_o));
    const int tid = tid_o, wid = __builtin_amdgcn_readfirstlane(tid >> 6), lane = tid & 63, wr = wid >> 2, wc = wid & 3, fr = lane & 15, fq = lane >> 4;
    const int K = g.K, nt = K / BK;
    unsigned voffA[2], voffB[2];
#pragma unroll
    for (int i = 0; i < 2; ++i) { int R, C; stage_rc(tid * 16 + i * 8192, R, C); const int Rb = Epi::PERM ? ((R & ~31) + perm32(R & 31)) : R;
        voffA[i] = (unsigned)(R * K + C) * 2u; voffB[i] = (unsigned)(Rb * K + C) * 2u; }
    constexpr bool GATHER = Sched::GATHER;
    unsigned vA0[2] = {0u, 0u}, vA1[2] = {0u, 0u}, nA0[2] = {0u, 0u}, nA1[2] = {0u, 0u};
    const size_t kstep = (size_t)(BK * 2);
    const size_t hstep = (size_t)HALF * K * 2;
    const size_t tstep = 2 * hstep;
    const unsigned ldsw = (unsigned)wid * 1024u;
    const int aoff = lds_byte(wr * 64 + fr, fq * 8), boff = lds_byte(wc * 32 + fr, fq * 8);
#define PG8_SA(b, h) (((b) * 2 + (h)) * HTB)
#define PG8_SB(b, h) ((4 + (b) * 2 + (h)) * HTB)
#define PG8_STAGE(bufoff, gbase, voff) do { _Pragma("unroll") for (int _i = 0; _i < 2; ++_i) \
        __builtin_amdgcn_global_load_lds((const unsigned*)((const char*)(gbase) + (voff)[_i]), (PG8_LAS unsigned*)(lds + (bufoff) + ldsw + _i * 8192), 16, 0, 0); } while (0)
#define PG8_STAGE_A(bufoff, gptr, h, nx) do { if constexpr (GATHER) { unsigned go_[2]; _Pragma("unroll") for (int _j = 0; _j < 2; ++_j) go_[_j] = ((nx) && last_) ? ((h) ? nA1[_j] : nA0[_j]) : ((h) ? vA1[_j] : vA0[_j]); PG8_STAGE(bufoff, gptr, go_); } \
        else { PG8_STAGE(bufoff, (gptr) + (h) * hstep, voffA); } } while (0)
#define PG8_GOFS(u, o0, o1) do { const int* rt_ = S.rowtok + (size_t)(u).pm * BM; _Pragma("unroll") for (int _j = 0; _j < 2; ++_j) { int R_, C_; stage_rc(tid * 16 + _j * 8192, R_, C_); \
        const int t0_ = rt_[R_], t1_ = rt_[HALF + R_]; o0[_j] = (unsigned)((t0_ < 0 ? 0 : t0_ >> 1) * K + C_) * 2u; o1[_j] = (unsigned)((t1_ < 0 ? 0 : t1_ >> 1) * K + C_) * 2u; } } while (0)
#define PG8_LDA(dst, b, h) do { _Pragma("unroll") for (int m = 0; m < 4; ++m) _Pragma("unroll") for (int k = 0; k < 2; ++k) dst[m][k] = *(const PG8_LAS bf16x8*)(lds + PG8_SA(b, h) + aoff + m * 2048 + k * 1024); } while (0)
#define PG8_LDB(dst, b, h) do { _Pragma("unroll") for (int n = 0; n < 2; ++n) _Pragma("unroll") for (int k = 0; k < 2; ++k) dst[n][k] = *(const PG8_LAS bf16x8*)(lds + PG8_SB(b, h) + boff + n * 2048 + k * 1024); } while (0)
#define PG8_MMA(ai, bj, At, Bt) do { __builtin_amdgcn_s_setprio(1); _Pragma("unroll") for (int m = 0; m < 4; ++m) _Pragma("unroll") for (int n = 0; n < 2; ++n) _Pragma("unroll") for (int k = 0; k < 2; ++k) \
        acc[ai][bj][m][n] = __builtin_amdgcn_mfma_f32_16x16x32_bf16(Bt[n][k], At[m][k], acc[ai][bj][m][n], 0, 0, 0); __builtin_amdgcn_s_setprio(0); } while (0)
#define PG8_WAIT_V(n) asm volatile("s_waitcnt vmcnt(" #n ")" ::: "memory")
#define PG8_WAIT_L(n) asm volatile("s_waitcnt lgkmcnt(" #n ")" ::: "memory")
#define PG8_BAR __builtin_amdgcn_s_barrier()
#define PG8_SCHED __builtin_amdgcn_sched_barrier(0)
    Unit cur, nxt; int ui = 0;
    if (!S.next(0, cur)) return;
    f32x4 acc[2][2][4][2];
#pragma unroll
    for (int a = 0; a < 2; ++a)
#pragma unroll
        for (int b = 0; b < 2; ++b)
#pragma unroll
            for (int m = 0; m < 4; ++m)
#pragma unroll
                for (int n = 0; n < 2; ++n) acc[a][b][m][n] = (f32x4){0.f, 0.f, 0.f, 0.f};
    bf16x8 At[4][2], B0[2][2], B1[2][2];
    const char* cA = GATHER ? (const char*)g.A : (const char*)g.A + (size_t)cur.pm * tstep; const char* cB = (const char*)g.Bt + (size_t)cur.eb * g.bstride + (size_t)cur.pn * tstep;
    S.a_ready(cur);
    if constexpr (GATHER) PG8_GOFS(cur, vA0, vA1);
    constexpr bool last_ = false;
    if constexpr (SP2) {
        PG8_STAGE(PG8_SB(0, 0), cB, voffB); PG8_STAGE(PG8_SB(0, 1), cB + hstep, voffB); PG8_STAGE_A(PG8_SA(0, 0), cA, 0, 0); PG8_STAGE_A(PG8_SA(0, 1), cA, 1, 0);
        if (wr == 1) PG8_BAR;
        PG8_WAIT_V(2); PG8_BAR;
        PG8_STAGE(PG8_SB(1, 0), cB + kstep, voffB); PG8_STAGE_A(PG8_SA(1, 0), cA + kstep, 0, 0); PG8_STAGE(PG8_SB(1, 1), cB + hstep + kstep, voffB);
        PG8_WAIT_V(6); PG8_BAR;
    } else {
        PG8_STAGE(PG8_SB(0, 0), cB, voffB); PG8_STAGE_A(PG8_SA(0, 0), cA, 0, 0); PG8_STAGE(PG8_SB(0, 1), cB + hstep, voffB); PG8_STAGE_A(PG8_SA(0, 1), cA, 1, 0);
        if (wr == 1) PG8_BAR;
        PG8_WAIT_V(4); PG8_BAR;
        PG8_STAGE(PG8_SB(1, 0), cB + kstep, voffB); PG8_STAGE_A(PG8_SA(1, 0), cA + kstep, 0, 0); PG8_STAGE(PG8_SB(1, 1), cB + hstep + kstep, voffB);
        PG8_WAIT_V(6); PG8_BAR;
    }
    for (;;) {
        const bool has_next = S.next(ui + 1, nxt);
        const char* nA = (has_next && !GATHER) ? (const char*)g.A + (size_t)nxt.pm * tstep : cA;
        if constexpr (GATHER) { if (has_next) PG8_GOFS(nxt, nA0, nA1); else { _Pragma("unroll") for (int _j = 0; _j < 2; ++_j) { nA0[_j] = vA0[_j]; nA1[_j] = vA1[_j]; } } } const char* nB = has_next ? (const char*)g.Bt + (size_t)nxt.eb * g.bstride + (size_t)nxt.pn * tstep : cB;
#pragma nounroll
        for (int t = 0; t < nt; t += 2) {
            const bool last = (t == nt - 2); const bool last_ = last;
            const char* a1 = cA + (size_t)(t + 1) * kstep;
            const char* a2 = last ? nA : cA + (size_t)(t + 2) * kstep; const char* b2 = last ? nB : cB + (size_t)(t + 2) * kstep;
            const char* a3 = a2 + kstep; const char* b3 = b2 + kstep;
            if (last && has_next) S.a_ready(nxt);
            if constexpr (SP2) {
            PG8_LDB(B0, 0, 0); PG8_LDB(B1, 0, 1); PG8_SCHED; PG8_LDA(At, 0, 0); PG8_STAGE_A(PG8_SA(1, 1), a1, 1, 0);
            PG8_WAIT_V(8); PG8_WAIT_L(0); PG8_BAR; PG8_MMA(0, 0, At, B0); PG8_MMA(0, 1, At, B1); PG8_BAR; PG8_SCHED;
            PG8_LDA(At, 0, 1); PG8_STAGE(PG8_SB(0, 0), b2, voffB); PG8_STAGE(PG8_SB(0, 1), b2 + hstep, voffB); PG8_STAGE_A(PG8_SA(0, 0), a2, 0, 1);
            PG8_WAIT_V(8); PG8_WAIT_L(0); PG8_BAR; PG8_MMA(1, 0, At, B0); PG8_MMA(1, 1, At, B1); PG8_BAR; PG8_SCHED;
            PG8_LDB(B0, 1, 0); PG8_LDB(B1, 1, 1); PG8_SCHED; PG8_LDA(At, 1, 0); PG8_STAGE_A(PG8_SA(0, 1), a2, 1, 1);
            PG8_WAIT_V(8); PG8_WAIT_L(0); PG8_BAR; PG8_MMA(0, 0, At, B0); PG8_MMA(0, 1, At, B1); PG8_BAR; PG8_SCHED;
            PG8_LDA(At, 1, 1); PG8_STAGE(PG8_SB(1, 0), b3, voffB); PG8_STAGE(PG8_SB(1, 1), b3 + hstep, voffB); PG8_STAGE_A(PG8_SA(1, 0), a3, 0, 1);
            PG8_WAIT_V(8); PG8_WAIT_L(0); PG8_BAR; PG8_MMA(1, 0, At, B0); PG8_MMA(1, 1, At, B1); PG8_BAR; PG8_SCHED;
            } else {
            PG8_LDB(B0, 0, 0); PG8_SCHED; PG8_LDA(At, 0, 0); PG8_STAGE_A(PG8_SA(1, 1), a1, 1, 0);
            PG8_WAIT_L(8); PG8_BAR; PG8_WAIT_L(0); PG8_MMA(0, 0, At, B0); PG8_BAR; PG8_SCHED;
            PG8_LDB(B1, 0, 1); PG8_STAGE(PG8_SB(0, 0), b2, voffB);
            PG8_BAR; PG8_WAIT_L(0); PG8_MMA(0, 1, At, B1); PG8_BAR;
            PG8_LDA(At, 0, 1); PG8_STAGE_A(PG8_SA(0, 0), a2, 0, 1);
            PG8_BAR; PG8_WAIT_L(0); PG8_MMA(1, 0, At, B0); PG8_BAR; PG8_SCHED;
            PG8_STAGE(PG8_SB(0, 1), b2 + hstep, voffB);
            PG8_WAIT_V(6); PG8_BAR; PG8_MMA(1, 1, At, B1); PG8_BAR;
            PG8_LDB(B0, 1, 0); PG8_SCHED; PG8_LDA(At, 1, 0); PG8_STAGE_A(PG8_SA(0, 1), a2, 1, 1);
            PG8_WAIT_L(8); PG8_BAR; PG8_WAIT_L(0); PG8_MMA(0, 0, At, B0); PG8_BAR; PG8_SCHED;
            PG8_LDB(B1, 1, 1); PG8_STAGE(PG8_SB(1, 0), b3, voffB);
            PG8_BAR; PG8_WAIT_L(0); PG8_MMA(0, 1, At, B1); PG8_BAR;
            PG8_LDA(At, 1, 1); PG8_STAGE_A(PG8_SA(1, 0), a3, 0, 1);
            PG8_BAR; PG8_WAIT_L(0); PG8_MMA(1, 0, At, B0); PG8_BAR; PG8_SCHED;
            PG8_STAGE(PG8_SB(1, 1), b3 + hstep, voffB);
            PG8_WAIT_V(6); PG8_BAR; PG8_MMA(1, 1, At, B1); PG8_BAR;
            }
        }
        if constexpr (ALIGN_EPI) { if (wr == 0) PG8_BAR; }
        if constexpr (!Epi::AFTER_DRAIN) { E(acc, cur, wr, wc, fr, fq); S.done(cur); }
        if (!has_next) break;
#pragma unroll
        for (int a = 0; a < 2; ++a)
#pragma unroll
            for (int b = 0; b < 2; ++b)
#pragma unroll
                for (int m = 0; m < 4; ++m)
#pragma unroll
                    for (int n = 0; n < 2; ++n) acc[a][b][m][n] = (f32x4){0.f, 0.f, 0.f, 0.f};
        cur = nxt; cA = nA; cB = nB; ++ui;
        if constexpr (GATHER) { _Pragma("unroll") for (int _j = 0; _j < 2; ++_j) { vA0[_j] = nA0[_j]; vA1[_j] = nA1[_j]; } }
        if constexpr (ALIGN_EPI) { if (wr == 1) PG8_BAR; }
    }
    PG8_WAIT_V(0);
    if constexpr (!ALIGN_EPI) { if (wr == 0) PG8_BAR; }
    PG8_BAR;
    if constexpr (Epi::AFTER_DRAIN) { E.fused(acc, cur, wr, wc, fr, fq, lds, wid, lane); S.done(cur); }
#undef PG8_SA
#undef PG8_SB
#undef PG8_STAGE
#undef PG8_STAGE_A
#undef PG8_GOFS
#undef PG8_LDA
#undef PG8_LDB
#undef PG8_MMA
#undef PG8_WAIT_V
#undef PG8_WAIT_L
#undef PG8_BAR
#undef PG8_SCHED
}
}

#ifndef PG8_SP2
#define PG8_SP2 true
#endif
#ifndef PG8_ALIGN
#define PG8_ALIGN true
#endif
#define XB_TMO      128
#define XB_XCNT(j)  (256  + 64 * (j))
#define XB_XSUB(j)  (1280 + 64 * (j))
#define XB_XGEN(j)  (2304 + 64 * (j))
#define XB_TOP      3328
#define XB_TOPGEN   3392
#define XCD_BAR_WORDS 3456
#define XB_SPIN_CAP (1u << 18)

__device__ __forceinline__ unsigned xb_ld(unsigned* p)              { return __hip_atomic_load(p, __ATOMIC_RELAXED, __HIP_MEMORY_SCOPE_AGENT); }
__device__ __forceinline__ unsigned xb_add(unsigned* p, unsigned v) { return __hip_atomic_fetch_add(p, v, __ATOMIC_RELAXED, __HIP_MEMORY_SCOPE_AGENT); }
__device__ __forceinline__ unsigned xb_xcc_id() { return (unsigned)__builtin_amdgcn_s_getreg((3 << 11) | 20) & 0xFu; }
#define XB_SPIN(cond, bar) do { unsigned _sp = 0; while (cond) { __builtin_amdgcn_s_sleep(1); \
    if ((++_sp & 255u) == 0u) { if (xb_ld(&(bar)[XB_TMO])) break; if (_sp > XB_SPIN_CAP) { atomicAdd(&(bar)[XB_TMO], 1u); break; } } } } while (0)

struct XcdBarrier {
    unsigned* bar; unsigned x;
    volatile LAS unsigned* st;
};

__device__ __forceinline__ XcdBarrier xcd_barrier_post(unsigned* bar, volatile LAS unsigned* st) {
    XcdBarrier b; b.bar = bar; b.x = xb_xcc_id(); b.st = st;
    if (threadIdx.x == 0) (void)xb_add(&bar[XB_XCNT(b.x)], 1u);
    return b;
}
__device__ __forceinline__ void xcd_barrier_complete(unsigned* bar, unsigned x, unsigned& nloc, unsigned& nx) {
    const unsigned G = gridDim.x * gridDim.y * gridDim.z;
    unsigned sum, cnt, mine, sp = 0u;
    for (;;) {
        sum = 0u; cnt = 0u; mine = 0u;
#pragma unroll
        for (unsigned j = 0; j < 16; ++j) { const unsigned c = xb_ld(&bar[XB_XCNT(j)]); sum += c; cnt += (c > 0u) ? 1u : 0u; mine = (j == x) ? c : mine; }
        if (sum == G) break;
        __builtin_amdgcn_s_sleep(1);
        if ((++sp & 255u) == 0u) { if (xb_ld(&bar[XB_TMO])) break; if (sp > XB_SPIN_CAP) { atomicAdd(&bar[XB_TMO], 1u); break; } }
    }
    nloc = mine > 0u ? mine : 1u; nx = cnt > 0u ? cnt : 1u;
}

__device__ __forceinline__ void xcd_barrier(const XcdBarrier& b) {
    asm volatile("s_waitcnt vmcnt(0)" ::: "memory");
    __syncthreads();
    if (threadIdx.x == 0) {
        unsigned* bar = b.bar;
        __builtin_amdgcn_s_waitcnt(0);
        unsigned nloc = b.st[0], nx = b.st[1];
        if (nloc == 0u) { xcd_barrier_complete(bar, b.x, nloc, nx); b.st[0] = nloc; b.st[1] = nx; }
        const unsigned old = xb_add(&bar[XB_XSUB(b.x)], 1u);
        const unsigned gen = old / nloc;
        if (old + 1u == (gen + 1u) * nloc) {
            __builtin_amdgcn_fence(__ATOMIC_RELEASE, "agent");
            asm volatile("s_waitcnt vmcnt(0)" ::: "memory");
            const unsigned og = xb_add(&bar[XB_TOP], 1u);
            const unsigned tg = og / nx;
            if (og + 1u == (tg + 1u) * nx) xb_add(&bar[XB_TOPGEN], 1u);
            else XB_SPIN(xb_ld(&bar[XB_TOPGEN]) == tg, bar);
            __builtin_amdgcn_fence(__ATOMIC_ACQUIRE, "agent");
            xb_add(&bar[XB_XGEN(b.x)], 1u);
            asm volatile("s_waitcnt vmcnt(0)" ::: "memory");
        } else {
            XB_SPIN(xb_ld(&bar[XB_XGEN(b.x)]) == gen, bar);
            __builtin_amdgcn_fence(__ATOMIC_ACQUIRE, "agent");
            asm volatile("s_waitcnt vmcnt(0)" ::: "memory");
        }
    }
    __syncthreads();
}
struct KC {
    const float* const* in;
    LAS unsigned char* lds;
    unsigned char* ws;
    int tid, lane, wave, G, bid;
};
__device__ __forceinline__ const float* inp_(int i) {
    const volatile unsigned long long __attribute__((address_space(4)))* kp = (const volatile unsigned long long __attribute__((address_space(4)))*)__builtin_amdgcn_kernarg_segment_ptr();
    return (const float*)(const GAS float*)kp[i];
}
#define INP(k) (inp_(k))

__device__ __forceinline__ int mod_row(int row) { return row < TL ? (row >> 11) : 8; }

__device__ __forceinline__ void ph_adaln_partials(const KC& k, const float* c, const float* c_ctx, const float* w_ada) {
    LAS float* sc = (LAS float*)k.lds;
    for (int i = k.tid; i < 9 * DM; i += 512) { const int r = i >> 11, kk = i & 2047; const float cv = r < 8 ? c[r * DM + kk] : c_ctx[kk]; sc[i] = siluf(cv); }
    __syncthreads();
    float* modp = (float*)(k.ws + WS_MODP);
    const int cc = k.tid & 255, kh = k.tid >> 8;
    constexpr int NIT = DEPTH * 48 * 16;
    for (int it = k.bid; it < NIT; it += k.G) {
        const int l = it / 768, rem = it % 768, cb = rem >> 4, ks = rem & 15;
        const int col = cb * 256 + cc, kbeg = ks * 128 + kh * 64;
        const float* W = w_ada + ((size_t)l * DM + kbeg) * MOD_N + col;
        float acc[9];
#pragma unroll
        for (int r = 0; r < 9; ++r) acc[r] = 0.f;
#pragma unroll 32
        for (int q = 0; q < 64; ++q) {
            const float w = W[(size_t)q * MOD_N];
#pragma unroll
            for (int r = 0; r < 9; ++r) acc[r] += sc[r * DM + kbeg + q] * w;
        }
        const int s = ks * 2 + kh;
#pragma unroll
        for (int r = 0; r < 9; ++r) modp[(((size_t)s * DEPTH + l) * 9 + r) * MOD_N + col] = acc[r];
    }
    __syncthreads();
}
__device__ __forceinline__ void ph_adaln_reduce(const KC& k, const float* b_ada) {
    const float* modp = (const float*)(k.ws + WS_MODP); float* mod = (float*)(k.ws + WS_MOD);
    constexpr int TOT = DEPTH * 9 * MOD_N;
    for (int i = k.bid * 512 + k.tid; i < TOT; i += k.G * 512) {
        const int n = i % MOD_N, l = i / (9 * MOD_N);
        float s = b_ada[l * MOD_N + n];
#pragma unroll 8
        for (int q = 0; q < KSPLIT; ++q) s += modp[(size_t)q * TOT + i];
        mod[i] = s;
    }
}

struct TrItem { const float* src; bf16* dst; int srcN, Kv, Nv, k0, n0, dpitch, drow0, dk0; };
struct WSrc { const float *w_in, *w2, *a2, *g2, *wba, *wbb, *wout, *eg, *eu, *ed, *w0, *a0; };
constexpr int TI_IN = 32 * 336, TI_LO = 4 * 64, TI_G2 = 4 * 32, TI_AB = 16 * 64, TI_O = 32 * 64, TI_GU1 = 32 * 44, TI_D1 = 22 * 64;
constexpr int TI_N = TI_IN + TI_LO + TI_G2 + 2 * TI_AB + TI_O + 2 * NEXP * TI_GU1 + NEXP * TI_D1;
__device__ __forceinline__ TrItem tr_decode(const WSrc& s, unsigned char* ws, int l, int it) {
    TrItem t; int r = it;
    if (r < TI_IN) { const int kb = r / 336, nb = r % 336; t = TrItem{s.w_in + (size_t)l * DM * IN_DIM, (bf16*)(ws + WT_IN), IN_DIM, DM, IN_DIM, 64 * kb, 32 * nb, DM, 32 * nb, 0}; return t; } r -= TI_IN;
    if (r < TI_LO) {
        const int mtx = r >> 6, q = r & 63, kb = q >> 5, nb = q & 31;
        t = TrItem{(mtx < 2 ? s.w2 : s.a2) + (size_t)(l * 2 + (mtx & 1)) * 96 * RD, (bf16*)(ws + WT_L1), RD, 96, RD, 64 * kb, 32 * nb, 256, mtx * 1024 + 32 * nb, mtx < 2 ? 0 : 96}; return t; } r -= TI_LO;
    if (r < TI_G2) { const int kb = r >> 5, nb = r & 31; t = TrItem{s.g2 + (size_t)l * 256 * RD, (bf16*)(ws + WT_G2), RD, 256, RD, 64 * kb, 32 * nb, 256, 32 * nb, 0}; return t; } r -= TI_G2;
    if (r < TI_AB) { const int kb = r >> 6, nb = r & 63; t = TrItem{s.wba + (size_t)l * RD * DM, (bf16*)(ws + WT_A), DM, RD, DM, 64 * kb, 32 * nb, RD, 32 * nb, 0}; return t; } r -= TI_AB;
    if (r < TI_AB) { const int kb = r >> 6, nb = r & 63; t = TrItem{s.wbb + (size_t)l * GVD * DM, (bf16*)(ws + WT_B), DM, GVD, DM, 64 * kb, 32 * nb, GVD, 32 * nb, 0}; return t; } r -= TI_AB;
    if (r < TI_O) { const int kb = r >> 6, nb = r & 63; t = TrItem{s.wout + (size_t)l * DM * DM, (bf16*)(ws + WT_O), DM, DM, DM, 64 * kb, 32 * nb, DM, 32 * nb, 0}; return t; } r -= TI_O;
    if (r < 2 * NEXP * TI_GU1) {
        const int e = r / (2 * TI_GU1), q = r % (2 * TI_GU1), up = q / TI_GU1, q2 = q % TI_GU1, kb = q2 / 44, nb = q2 % 44;
        const int n0 = 32 * nb, drow = 256 * (n0 >> 7) + (n0 & 127) + (up ? 128 : 0);
        t = TrItem{(up ? s.eu : s.eg) + ((size_t)l * NEXP + e) * DM * DEXP, (bf16*)(ws + WT_GU) + (size_t)e * 2816 * DM, DEXP, DM, DEXP, 64 * kb, n0, DM, drow, 0}; return t; } r -= 2 * NEXP * TI_GU1;
    { const int e = r / TI_D1, q = r % TI_D1, kb = q >> 6, nb = q & 63;
      t = TrItem{s.ed + ((size_t)l * NEXP + e) * DEXP * DM, (bf16*)(ws + WT_D) + (size_t)e * DM * DEXP, DM, DEXP, DM, 64 * kb, 32 * nb, DEXP, 32 * nb, 0}; }
    return t;
}
__device__ __forceinline__ void tr_load(const TrItem& t, int lane, float (&v)[32]) {
    const int nn = lane & 31, kh = lane >> 5;
    const bool nok = t.n0 + nn < t.Nv;
    const float* p = t.src + (size_t)(t.k0 + kh) * t.srcN + t.n0 + nn;
#pragma unroll
    for (int i = 0; i < 32; ++i) { v[i] = 0.f; if (nok && t.k0 + 2 * i + kh < t.Kv) v[i] = p[(size_t)(2 * i) * t.srcN]; }
}
__device__ __forceinline__ void tr_store(const TrItem& t, int lane, const float (&v)[32], LAS float* scr) {
    const int nn = lane & 31, kh = lane >> 5;
#pragma unroll
    for (int i = 0; i < 32; ++i) scr[(2 * i + kh) * 33 + nn] = v[i];
    asm volatile("s_waitcnt lgkmcnt(0)" ::: "memory");
    const int cidx = lane & 7;
#pragma unroll
    for (int j = 0; j < 4; ++j) {
        const int n = (lane >> 3) + 8 * j; const LAS float* s = scr + (8 * cidx) * 33 + n;
        u32x4 o; o.x = pk2(s[0 * 33], s[1 * 33]); o.y = pk2(s[2 * 33], s[3 * 33]); o.z = pk2(s[4 * 33], s[5 * 33]); o.w = pk2(s[6 * 33], s[7 * 33]);
        *(u32x4*)(t.dst + (size_t)(t.drow0 + n) * t.dpitch + t.dk0 + t.k0 + 8 * cidx) = o;
    }
    asm volatile("s_waitcnt lgkmcnt(0)" ::: "memory");
}
__device__ __forceinline__ void ph_convert(const KC& k, const WSrc& s, int l) {
    LAS float* scr = (LAS float*)(k.lds + k.wave * 16384);
    const int gw = k.bid * 8 + k.wave, NGW = k.G * 8;
    unsigned char* ws = k.ws;
    { float* b1 = (float*)(ws + WS_TAB + TAB_TOP); for (int i = gw * 64 + k.lane; i < 4096; i += NGW * 64) b1[i] = i < 2048 ? s.w0[l * 2048 + i] : s.a0[l * 2048 + i - 2048]; }
    {
        u32x4* wl = (u32x4*)(ws + WT_L1);
        for (int i = gw * 64 + k.lane; i < 4096 * 32; i += NGW * 64) { const int row = i >> 5, ck = i & 31; if (row < 2048 ? ck >= 16 : (ck < 12 || ck >= 28)) wl[i] = (u32x4){0u, 0u, 0u, 0u}; }
        if (l == 0) { int* rt = (int*)(ws + WS_TAB + TAB_ROWTOK); for (int i = gw * 64 + k.lane; i < 2 * MOE_ROWS; i += NGW * 64) rt[i] = -1; }
    }
    float cur[32], nxt[32];
    int it = gw;
    TrItem tc = tr_decode(s, ws, l, it < TI_N ? it : 0);
    if (it < TI_N) tr_load(tc, k.lane, cur);
    for (; it < TI_N; it += NGW) {
        const bool more = it + NGW < TI_N;
        const TrItem tn = tr_decode(s, ws, l, more ? it + NGW : it);
        if (more) tr_load(tn, k.lane, nxt);
        tr_store(tc, k.lane, cur, scr);
        tc = tn;
#pragma unroll
        for (int i = 0; i < 32; ++i) cur[i] = nxt[i];
    }
}

constexpr int RWP = DM + 4;
struct RowArgs { const float *x_in, *ctx_in, *gvec, *router_w, *router_b; float* out; };
template <int MODE>
__device__ __forceinline__ void ph_rows(const KC& k, const RowArgs& ra, int l, int nrows, bool dry = false) {
    const int gw = k.bid * 8 + k.wave, NGW = k.G * 8, lane = k.lane;
    float* X = (float*)(k.ws + WS_X); bf16* H = (bf16*)(k.ws + WS_H);
    bf16* Xb = (bf16*)(k.ws + WS_X);
    const float* MOD = (const float*)(k.ws + WS_MOD);
    const bf16* YF = (const bf16*)(k.ws + WS_YF);
    LAS float* rwT = (LAS float*)k.lds;
    if (MODE == 1) {
        for (int i = k.tid; i < DM * NEXP; i += 512) { const int c = i >> 4, e = i & 15; rwT[e * RWP + c] = ra.router_w[i]; }
        __syncthreads();
    }
    const float* gv = ra.gvec;
    for (int row = gw; row < nrows; row += NGW) {
        const int mr = mod_row(row);
        f32x4 v[8];
        if (MODE == 0 && l == 0) {
            const f32x4* src = (const f32x4*)(row < TL ? ra.x_in + (size_t)row * DM : ra.ctx_in + (size_t)(row - TL) * DM) + lane;
#pragma unroll
            for (int j = 0; j < 8; ++j) v[j] = src[64 * j];
        } else if (XBF) {
            const u32x2* src = (const u32x2*)(Xb + (size_t)row * DM) + lane;
#pragma unroll
            for (int j = 0; j < 8; ++j) { const u32x2 a = src[64 * j]; v[j] = (f32x4){bflo(a.x), bfhi(a.x), bflo(a.y), bfhi(a.y)}; }
        } else {
            const f32x4* src = (const f32x4*)(X + (size_t)row * DM) + lane;
#pragma unroll
            for (int j = 0; j < 8; ++j) v[j] = src[64 * j];
        }
        if ((MODE == 0 && l > 0) || MODE == 2) {
            const int lp = (MODE == 2) ? DEPTH - 1 : l - 1;
            const f32x4* gate = (const f32x4*)(MOD + ((size_t)lp * 9 + mr) * MOD_N + 5 * DM) + lane;
            const u32x2* y0 = (const u32x2*)(YF + (size_t)row * DM) + lane;
            const u32x2* y1 = (const u32x2*)(YF + ((size_t)TA + row) * DM) + lane;
#pragma unroll
            for (int j = 0; j < 8; ++j) {
                const f32x4 g = gate[64 * j]; const u32x2 a = y0[64 * j], b = y1[64 * j];
                v[j].x += g.x * (bflo(a.x) + bflo(b.x)); v[j].y += g.y * (bfhi(a.x) + bfhi(b.x));
                v[j].z += g.z * (bflo(a.y) + bflo(b.y)); v[j].w += g.w * (bfhi(a.y) + bfhi(b.y));
            }
        }
        if (MODE == 0 && XBF) {
            u32x2* dst = (u32x2*)(Xb + (size_t)row * DM) + lane;
#pragma unroll
            for (int j = 0; j < 8; ++j) { u32x2 o; o.x = pk2(v[j].x, v[j].y); o.y = pk2(v[j].z, v[j].w); dst[64 * j] = o; }
        } else if (MODE == 0) {
            f32x4* dst = (f32x4*)(X + (size_t)row * DM) + lane;
#pragma unroll
            for (int j = 0; j < 8; ++j) dst[64 * j] = v[j];
        }
        float ss = 0.f;
#pragma unroll
        for (int j = 0; j < 8; ++j) ss += (v[j].x * v[j].x + v[j].y * v[j].y) + (v[j].z * v[j].z + v[j].w * v[j].w);
        const float rinv = 1.0f / sqrtf(wave_sum(ss) * (1.0f / DM) + 1e-6f);
        if (MODE == 2) {
            f32x4* dst = (f32x4*)(ra.out + (size_t)row * DM) + lane; const f32x4* g4 = (const f32x4*)gv + lane;
#pragma unroll
            for (int j = 0; j < 8; ++j) { const f32x4 g = g4[64 * j]; dst[64 * j] = v[j] * rinv * g; }
        } else {
            const float* mrow = MOD + ((size_t)l * 9 + mr) * MOD_N + (MODE == 0 ? 0 : 3 * DM);
            const f32x4* sh4 = (const f32x4*)mrow + lane; const f32x4* sc4 = (const f32x4*)(mrow + DM) + lane; const f32x4* g4 = (const f32x4*)(gv + (size_t)l * DM) + lane;
            u32x2* dst = (u32x2*)(H + (size_t)row * DM) + lane;
#pragma unroll
            for (int j = 0; j < 8; ++j) {
                const f32x4 g = g4[64 * j], sh = sh4[64 * j], sc = sc4[64 * j];
                v[j] = v[j] * rinv * g * (1.0f + sc) + sh;
                u32x2 o; o.x = pk2(v[j].x, v[j].y); o.y = pk2(v[j].z, v[j].w); dst[64 * j] = o;
            }
        }
        if (MODE == 1) {
            float lg[NEXP];
#pragma unroll
            for (int e = 0; e < NEXP; ++e) {
                float s = 0.f;
#pragma unroll
                for (int j = 0; j < 8; ++j) { const f32x4 w = *(const LAS f32x4*)(rwT + e * RWP + 4 * lane + 256 * j); s += (v[j].x * w.x + v[j].y * w.y) + (v[j].z * w.z + v[j].w * w.w); }
                lg[e] = wave_sum(s);
            }
            float sc[NEXP], sel[NEXP];
#pragma unroll
            for (int e = 0; e < NEXP; ++e) { sc[e] = 1.0f / (1.0f + expf(-lg[e])); sel[e] = sc[e] + ra.router_b[e]; }
            float gs[4], w1g[4], w2g[4]; int i1g[4], i2g[4];
#pragma unroll
            for (int g = 0; g < 4; ++g) {
                int i1 = 0; float m1 = sel[4 * g];
#pragma unroll
                for (int q = 1; q < 4; ++q) if (sel[4 * g + q] > m1) { m1 = sel[4 * g + q]; i1 = q; }
                int i2 = -1; float m2 = -3.0e38f;
#pragma unroll
                for (int q = 0; q < 4; ++q) if (q != i1 && sel[4 * g + q] > m2) { m2 = sel[4 * g + q]; i2 = q; }
                gs[g] = m1 + m2; i1g[g] = 4 * g + i1; i2g[g] = 4 * g + i2;
                float a1 = sc[4 * g], a2 = sc[4 * g];
#pragma unroll
                for (int q = 0; q < 4; ++q) { a1 = (q == i1) ? sc[4 * g + q] : a1; a2 = (q == i2) ? sc[4 * g + q] : a2; }
                w1g[g] = a1; w2g[g] = a2;
            }
            int best = 0; float bs = gs[0];
#pragma unroll
            for (int g = 1; g < 4; ++g) if (gs[g] > bs) { bs = gs[g]; best = g; }
            int e1 = i1g[0], e2 = i2g[0]; float w1 = w1g[0], w2 = w2g[0];
#pragma unroll
            for (int g = 1; g < 4; ++g) { e1 = (best == g) ? i1g[g] : e1; e2 = (best == g) ? i2g[g] : e2; w1 = (best == g) ? w1g[g] : w1; w2 = (best == g) ? w2g[g] : w2; }
            const float inv = 1.0f / (w1 + w2);
            if (lane == 0 && !dry) {
                unsigned* cnt = (unsigned*)(k.ws + WS_CTL) + CW_CNT + 64 * l;
                const int p1 = (int)atomicAdd(cnt + e1, 1u), p2 = (int)atomicAdd(cnt + e2, 1u);
                int* te = (int*)(k.ws + WS_TOPK); float* tw = (float*)(k.ws + WS_TOPK + (size_t)TA * 8); int* tp = (int*)(k.ws + WS_TOPK + 2 * (size_t)TA * 8);
                te[2 * row] = e1; te[2 * row + 1] = e2; tw[2 * row] = w1 * inv; tw[2 * row + 1] = w2 * inv; tp[2 * row] = p1; tp[2 * row + 1] = p2;
            }
        }
    }
    if (MODE == 1) __syncthreads();
}

__device__ __forceinline__ void ph_moe_scatter(const KC& k, int l, int nrows) {
    LAS int* offs = (LAS int*)k.lds;
    const unsigned* cnt = (const unsigned*)(k.ws + WS_CTL) + CW_CNT + 64 * l;
    int* tile = (int*)(k.ws + WS_TAB + TAB_TILE) + 256 * l;
    if (k.tid == 0) {
        int off = 0, nt = 0;
        for (int e = 0; e < NEXP; ++e) {
            offs[e] = off; const int c = (int)__hip_atomic_load(cnt + e, __ATOMIC_RELAXED, __HIP_MEMORY_SCOPE_AGENT); const int t = (c + 255) >> 8;
            if (k.bid == 0) for (int q = 0; q < t; ++q) tile[1 + nt + q] = e;
            nt += t; off += t * 256;
        }
        if (k.bid == 0) tile[0] = nt;
    }
    __syncthreads();
    const int gw = k.bid * 8 + k.wave, NGW = k.G * 8, lane = k.lane;
    const bf16* H = (const bf16*)(k.ws + WS_H); bf16* HP = (bf16*)(k.ws + WS_HP);
    const int* te = (const int*)(k.ws + WS_TOPK); const float* tw = (const float*)(k.ws + WS_TOPK + (size_t)TA * 8); const int* tp = (const int*)(k.ws + WS_TOPK + 2 * (size_t)TA * 8);
    int* rowtok = (int*)(k.ws + WS_TAB + TAB_ROWTOK) + (size_t)l * MOE_ROWS; float* roww = (float*)(k.ws + WS_TAB + TAB_ROWW) + (size_t)l * MOE_ROWS;
    for (int row = gw; row < nrows; row += NGW) {
#if MOE_GATHER
        (void)H; (void)HP;
        if (lane < 2) { const int s = lane; const int e = te[2 * row + s], dest = offs[e] + tp[2 * row + s]; rowtok[dest] = 2 * row + s; roww[dest] = tw[2 * row + s]; }
    }
#else
        const u32x4* src = (const u32x4*)(H + (size_t)row * DM) + lane;
        u32x4 d[4];
#pragma unroll
        for (int j = 0; j < 4; ++j) d[j] = src[64 * j];
#pragma unroll
        for (int s = 0; s < 2; ++s) {
            const int e = te[2 * row + s], dest = offs[e] + tp[2 * row + s];
            u32x4* dp = (u32x4*)(HP + (size_t)dest * DM) + lane;
#pragma unroll
            for (int j = 0; j < 4; ++j) dp[64 * j] = d[j];
            if (lane == 0) { rowtok[dest] = 2 * row + s; roww[dest] = tw[2 * row + s]; }
        }
    }
#endif
    __syncthreads();
}
__device__ __forceinline__ void ld16(const bf16* p, bool ok, float (&o)[16]) {
    if (ok) { const u32x4 a = *(const u32x4*)p, b = *(const u32x4*)(p + 8); float x[8], y[8]; unpack8(a, x); unpack8(b, y);
#pragma unroll
        for (int i = 0; i < 8; ++i) { o[i] = x[i]; o[8 + i] = y[i]; } }
    else {
#pragma unroll
        for (int i = 0; i < 16; ++i) o[i] = 0.f; }
}
__device__ __forceinline__ void st16(bf16* p, const float (&v)[16]) {
    float a[8], b[8];
#pragma unroll
    for (int i = 0; i < 8; ++i) { a[i] = v[i]; b[i] = v[8 + i]; }
    *(u32x4*)p = pack8(a); *(u32x4*)(p + 8) = pack8(b);
}
__device__ __forceinline__ void shift8(const bf16* p0, bool hp, bool hn, int c, const float* mu0, const float* mu1, float (&s)[8]) {
    float x[8], xm[8], xp[8];
    unpack8(*(const u32x4*)(p0 + c), x);
    if (hp) unpack8(*(const u32x4*)(p0 - NP + c), xm); else {
#pragma unroll
        for (int i = 0; i < 8; ++i) xm[i] = 0.f; }
    if (hn) unpack8(*(const u32x4*)(p0 + NP + c), xp); else {
#pragma unroll
        for (int i = 0; i < 8; ++i) xp[i] = 0.f; }
    const f32x4 m0a = *(const f32x4*)(mu0 + c), m0b = *(const f32x4*)(mu0 + c + 4), m1a = *(const f32x4*)(mu1 + c), m1b = *(const f32x4*)(mu1 + c + 4);
    const float m0[8] = {m0a.x, m0a.y, m0a.z, m0a.w, m0b.x, m0b.y, m0b.z, m0b.w}, m1[8] = {m1a.x, m1a.y, m1a.z, m1a.w, m1b.x, m1b.y, m1b.z, m1b.w};
#pragma unroll
    for (int i = 0; i < 8; ++i) s[i] = x[i] + m0[i] * (xm[i] - x[i]) + m1[i] * (xp[i] - x[i]);
}
__device__ __forceinline__ void ph_rwkv_prep(const KC& k, int l, int nrows, const float* mu, const float* k_k, const float* r_k) {
    const int gw = k.bid * 8 + k.wave, NGW = k.G * 8, lane = k.lane;
    const bf16* P = (const bf16*)(k.ws + WS_P);
    bf16* R = (bf16*)(k.ws + RW_R); bf16* KS = (bf16*)(k.ws + RW_KS); bf16* V = (bf16*)(k.ws + RW_V); bf16* KK = (bf16*)(k.ws + RW_KK);
    bf16* A1 = (bf16*)(k.ws + RW_A1); bf16* A2 = (bf16*)(k.ws + RW_A2); float* BON = (float*)(k.ws + RW_BON);
    const float* mu0 = mu + (size_t)(l * 2 + 0) * RWKV_IN; const float* mu1 = mu + (size_t)(l * 2 + 1) * RWKV_IN;
    const int rpw = (nrows + NGW - 1) / NGW;
    for (int row = gw * rpw; row < nrows && row < (gw + 1) * rpw; ++row) {
        int t, len; if (row < TL) { t = row & (SEQ - 1); len = SEQ; } else { t = (row - TL) & (CTXL - 1); len = CTXL; }
        const bool hp = t > 0, hn = t < len - 1;
        const bf16* p0 = P + (size_t)row * NP;
#pragma unroll
        for (int half = 0; half < 2; ++half) {
            const int c = half * 512 + 8 * lane;
            float r[8], kx[8], vv[8], kk[8];
            shift8(p0, hp, hn, c, mu0, mu1, r);
            shift8(p0, hp, hn, RD + c, mu0, mu1, kx);
            shift8(p0, hp, hn, 2 * RD + c, mu0, mu1, vv);
            const f32x4 kka = *(const f32x4*)(k_k + l * RD + c), kkb = *(const f32x4*)(k_k + l * RD + c + 4), rka = *(const f32x4*)(r_k + l * RD + c), rkb = *(const f32x4*)(r_k + l * RD + c + 4);
            const float kkw[8] = {kka.x, kka.y, kka.z, kka.w, kkb.x, kkb.y, kkb.z, kkb.w}, rkw[8] = {rka.x, rka.y, rka.z, rka.w, rkb.x, rkb.y, rkb.z, rkb.w};
            float ss = 0.f, bon = 0.f;
#pragma unroll
            for (int i = 0; i < 8; ++i) { kk[i] = kx[i] * kkw[i]; ss += kk[i] * kk[i]; bon += r[i] * kx[i] * rkw[i]; }
            ss += __shfl_xor(ss, 1); ss += __shfl_xor(ss, 2); ss += __shfl_xor(ss, 4);
            bon += __shfl_xor(bon, 1); bon += __shfl_xor(bon, 2); bon += __shfl_xor(bon, 4);
            const float inv = 1.0f / fmaxf(sqrtf(ss), 1e-12f);
#pragma unroll
            for (int i = 0; i < 8; ++i) kk[i] *= inv;
            *(u32x4*)(R + (size_t)row * RD + c) = pack8(r); *(u32x4*)(KS + (size_t)row * RD + c) = pack8(kx);
            *(u32x4*)(V + (size_t)row * RD + c) = pack8(vv); *(u32x4*)(KK + (size_t)row * RD + c) = pack8(kk);
            if ((lane & 7) == 0) BON[(size_t)row * RHEADS + half * 8 + (lane >> 3)] = bon;
        }
        if (lane < 56) {
            float s8[8];
            shift8(p0, hp, hn, 3 * RD + 8 * lane, mu0, mu1, s8);
            if (lane < 12) {
#pragma unroll
                for (int i = 0; i < 8; ++i) { const float e2 = __expf(2.0f * fminf(fmaxf(s8[i], -15.f), 15.f)); s8[i] = 1.0f - 2.0f / (e2 + 1.0f); }
                *(u32x4*)(A1 + (size_t)row * 256 + 8 * lane) = pack8(s8);
            } else if (lane < 24) { *(u32x4*)(A1 + (size_t)row * 256 + 8 * lane) = pack8(s8); }
            else {
#pragma unroll
                for (int i = 0; i < 8; ++i) s8[i] = sigm(s8[i]);
                *(u32x4*)(A2 + (size_t)row * 256 + 8 * (lane - 24)) = pack8(s8);
            }
        } else { *(u32x4*)(A1 + (size_t)row * 256 + 192 + 8 * (lane - 56)) = (u32x4){0u, 0u, 0u, 0u}; }
    }
}

__device__ __forceinline__ float logsig(float x) { return fminf(x, 0.f) - __logf(1.0f + __expf(-fabsf(x))); }
__device__ __forceinline__ int gla_row(bool lat, int b, int s) { return lat ? b * SEQ + (s & 31) * 64 + (s >> 5) : TL + b * CTXL + s; }
constexpr int GQ_PITCH = 264;
constexpr int GPL_AD = 0, GPL_GS = 4096, GPL_QK = GPL_GS + 65536, GPL_END = GPL_QK + 66 * GQ_PITCH * 2;
static_assert(GPL_END <= 131072, "gla prep lds");
__device__ __forceinline__ void ph_gla_prep(const KC& k, int l, const float* conv, const float* aw2, const float* ab) {
    const bf16* P = (const bf16*)(k.ws + WS_P);
    bf16* QG = (bf16*)(k.ws + GL_QG); bf16* KG = (bf16*)(k.ws + GL_KG); bf16* KE = (bf16*)(k.ws + GL_KE); bf16* VS = (bf16*)(k.ws + GL_VS); float* DEC = (float*)(k.ws + GL_DEC);
    const float* cw = conv + (size_t)l * 3 * GQKV;
    const int tid = k.tid, lane = k.lane;
    {
        const int gw = k.bid * 8 + k.wave, NGW = k.G * 8, c = 16 * lane;
        const int rpw = (TA + NGW - 1) / NGW;
        for (int qi = gw * rpw; qi < TA && qi < (gw + 1) * rpw; ++qi) {
            const bool lat = qi < TL; int b, s, len;
            if (lat) { b = qi >> 11; s = qi & 2047; len = SEQ; } else { b = (qi - TL) >> 8; s = (qi - TL) & 255; len = CTXL; }
            const int row = gla_row(lat, b, s);
            const bool hp = s > 0, hn = s + 1 < len;
            const bf16* p0 = P + (size_t)row * NP + GLA_OFF + 2 * GKD + c;
            const bf16* pm = P + (size_t)gla_row(lat, b, hp ? s - 1 : s) * NP + GLA_OFF + 2 * GKD + c;
            const bf16* pp = P + (size_t)gla_row(lat, b, hn ? s + 1 : s) * NP + GLA_OFF + 2 * GKD + c;
            float o[16];
#pragma unroll
            for (int hf = 0; hf < 2; ++hf) {
                float x[8], xm[8], xp[8];
                unpack8(*(const u32x4*)(p0 + 8 * hf), x); unpack8(*(const u32x4*)(pm + 8 * hf), xm); unpack8(*(const u32x4*)(pp + 8 * hf), xp);
                const float* w = cw + 2 * GKD + c + 8 * hf;
#pragma unroll
                for (int q = 0; q < 2; ++q) {
                    const f32x4 w0 = *(const f32x4*)(w + 4 * q), w1 = *(const f32x4*)(w + GQKV + 4 * q), w2 = *(const f32x4*)(w + 2 * GQKV + 4 * q);
#pragma unroll
                    for (int i = 0; i < 4; ++i) o[8 * hf + 4 * q + i] = siluf(w0[i] * (hp ? xm[4 * q + i] : 0.f) + w1[i] * x[4 * q + i] + w2[i] * (hn ? xp[4 * q + i] : 0.f));
                }
            }
            st16(VS + (size_t)row * GVD + c, o);
        }
    }
    LAS float* ADs = (LAS float*)(k.lds + GPL_AD);
    LAS float* Gs = (LAS float*)(k.lds + GPL_GS);
    LAS bf16* QKs = (LAS bf16*)(k.lds + GPL_QK);
    for (int item = k.bid; item < 288 * 4; item += k.G) {
        const int sc = item >> 2, h = item & 3;
        const bool lat = sc < 256; const int b = lat ? (sc >> 5) : ((sc - 256) >> 2), cn = lat ? (sc & 31) : ((sc - 256) & 3), len = lat ? SEQ : CTXL;
        const int gch = lat ? 4 + cn : cn, s0 = 64 * cn;
        for (int i = tid; i < 1024; i += 512) { const int tau = i >> 4, j = i & 15; ADs[i] = bf2f(P[(size_t)gla_row(lat, b, s0 + tau) * NP + GLA_AD_OFF + j]); }
        for (int i = tid; i < 66 * 32; i += 512) {
            const int rr = i >> 5, ck = i & 31, s = s0 - 1 + rr;
            u32x4 v = (u32x4){0u, 0u, 0u, 0u};
            if (s >= 0 && s < len) v = *(const u32x4*)(P + (size_t)gla_row(lat, b, s) * NP + GLA_OFF + (ck >> 4) * GKD + h * GDK + (ck & 15) * 8);
            *(LAS u32x4*)(QKs + rr * GQ_PITCH + ck * 8) = v;
        }
        __syncthreads();
        {
            const int c = tid & 127, tg = tid >> 7, chl = h * GDK + c;
            float awf[16], awb[16];
#pragma unroll
            for (int j = 0; j < 16; ++j) { awf[j] = aw2[((size_t)(l * 2 + 0) * 16 + j) * GKD + chl]; awb[j] = aw2[((size_t)(l * 2 + 1) * 16 + j) * GKD + chl]; }
            const float abf = ab[(l * 2 + 0) * GKD + chl], abb = ab[(l * 2 + 1) * GKD + chl];
            for (int i = 0; i < 16; ++i) {
                const int tau = 16 * tg + i; float xf = abf, xb = abb;
#pragma unroll
                for (int j = 0; j < 16; ++j) { const float a = ADs[tau * 16 + j]; xf += a * awf[j]; xb += a * awb[j]; }
                Gs[tau * 128 + c] = logsig(xf) * (1.0f / 16.0f); Gs[(64 + tau) * 128 + c] = logsig(xb) * (1.0f / 16.0f);
            }
        }
        __syncthreads();
        if (tid < 128) { float run = 0.f; for (int tau = 0; tau < 64; ++tau) { run += Gs[tau * 128 + tid]; Gs[tau * 128 + tid] = run; } }
        else if (tid < 256) { const int c = tid - 128; float run = 0.f; for (int tau = 63; tau >= 0; --tau) { run += Gs[(64 + tau) * 128 + c]; Gs[(64 + tau) * 128 + c] = run; } }
        __syncthreads();
        {
            const int c8 = tid & 15, tg = tid >> 4, chl = h * GDK + 8 * c8;
            float wq[3][8], wk[3][8], elf[8], elb[8];
#pragma unroll
            for (int tp = 0; tp < 3; ++tp) {
                const f32x4 a0 = *(const f32x4*)(cw + tp * GQKV + chl), a1 = *(const f32x4*)(cw + tp * GQKV + chl + 4), b0 = *(const f32x4*)(cw + tp * GQKV + GKD + chl), b1 = *(const f32x4*)(cw + tp * GQKV + GKD + chl + 4);
#pragma unroll
                for (int i = 0; i < 4; ++i) { wq[tp][i] = a0[i]; wq[tp][4 + i] = a1[i]; wk[tp][i] = b0[i]; wk[tp][4 + i] = b1[i]; }
            }
            {
                const f32x4 a0 = *(const LAS f32x4*)(Gs + 63 * 128 + 8 * c8), a1 = *(const LAS f32x4*)(Gs + 63 * 128 + 8 * c8 + 4), b0 = *(const LAS f32x4*)(Gs + 64 * 128 + 8 * c8), b1 = *(const LAS f32x4*)(Gs + 64 * 128 + 8 * c8 + 4);
#pragma unroll
                for (int i = 0; i < 4; ++i) { elf[i] = __expf(a0[i]); elf[4 + i] = __expf(a1[i]); elb[i] = __expf(b0[i]); elb[4 + i] = __expf(b1[i]); }
            }
            if (tg < 8) {
                float* d0 = DEC + ((size_t)(0 * 8 + b) * NCH + gch) * GKD + chl; float* d1 = DEC + ((size_t)(1 * 8 + b) * NCH + gch) * GKD + chl;
                if (tg == 0) { *(f32x4*)d0 = (f32x4){elf[0], elf[1], elf[2], elf[3]}; *(f32x4*)(d0 + 4) = (f32x4){elf[4], elf[5], elf[6], elf[7]}; }
                if (tg == 1) { *(f32x4*)d1 = (f32x4){elb[0], elb[1], elb[2], elb[3]}; *(f32x4*)(d1 + 4) = (f32x4){elb[4], elb[5], elb[6], elb[7]}; }
            }
#pragma unroll
            for (int pass = 0; pass < 2; ++pass) {
                const int tau = tg + 32 * pass;
                float qm[8], q0[8], qp[8], km[8], k0[8], kp[8];
                unpack8(*(const LAS u32x4*)(QKs + (tau + 0) * GQ_PITCH + 8 * c8), qm); unpack8(*(const LAS u32x4*)(QKs + (tau + 1) * GQ_PITCH + 8 * c8), q0); unpack8(*(const LAS u32x4*)(QKs + (tau + 2) * GQ_PITCH + 8 * c8), qp);
                unpack8(*(const LAS u32x4*)(QKs + (tau + 0) * GQ_PITCH + 128 + 8 * c8), km); unpack8(*(const LAS u32x4*)(QKs + (tau + 1) * GQ_PITCH + 128 + 8 * c8), k0); unpack8(*(const LAS u32x4*)(QKs + (tau + 2) * GQ_PITCH + 128 + 8 * c8), kp);
                const f32x4 f0 = *(const LAS f32x4*)(Gs + tau * 128 + 8 * c8), f1 = *(const LAS f32x4*)(Gs + tau * 128 + 8 * c8 + 4), g0 = *(const LAS f32x4*)(Gs + (64 + tau) * 128 + 8 * c8), g1 = *(const LAS f32x4*)(Gs + (64 + tau) * 128 + 8 * c8 + 4);
                const float cf[8] = {f0.x, f0.y, f0.z, f0.w, f1.x, f1.y, f1.z, f1.w}, cb[8] = {g0.x, g0.y, g0.z, g0.w, g1.x, g1.y, g1.z, g1.w};
                float oqf[8], okf[8], oef[8], oqb[8], okb[8], oeb[8];
#pragma unroll
                for (int i = 0; i < 8; ++i) {
                    const float qv = siluf(wq[0][i] * qm[i] + wq[1][i] * q0[i] + wq[2][i] * qp[i]) * 0.08838834764831845f;
                    const float kv = siluf(wk[0][i] * km[i] + wk[1][i] * k0[i] + wk[2][i] * kp[i]);
                    const float ef = __expf(cf[i]), eb = __expf(cb[i]), rf = 1.0f / ef, rb = 1.0f / eb;
                    oqf[i] = qv * ef; okf[i] = kv * rf; oef[i] = kv * rf * elf[i];
                    oqb[i] = qv * eb; okb[i] = kv * rb; oeb[i] = kv * rb * elb[i];
                }
                const size_t o = (size_t)gla_row(lat, b, s0 + tau) * GKD + chl;
                *(u32x4*)(QG + o) = pack8(oqf); *(u32x4*)(KG + o) = pack8(okf); *(u32x4*)(KE + o) = pack8(oef);
                *(u32x4*)(QG + (size_t)TA * GKD + o) = pack8(oqb); *(u32x4*)(KG + (size_t)TA * GKD + o) = pack8(okb); *(u32x4*)(KE + (size_t)TA * GKD + o) = pack8(oeb);
            }
        }
        __syncthreads();
    }
}

__device__ __forceinline__ float dpp_sum16(float x) {
    x += __builtin_bit_cast(float, __builtin_amdgcn_update_dpp(0, __builtin_bit_cast(int, x), 0xB1, 0xF, 0xF, true));
    x += __builtin_bit_cast(float, __builtin_amdgcn_update_dpp(0, __builtin_bit_cast(int, x), 0x4E, 0xF, 0xF, true));
    x += __builtin_bit_cast(float, __builtin_amdgcn_update_dpp(0, __builtin_bit_cast(int, x), 0x141, 0xF, 0xF, true));
    x += __builtin_bit_cast(float, __builtin_amdgcn_update_dpp(0, __builtin_bit_cast(int, x), 0x140, 0xF, 0xF, true));
    return x;
}
constexpr int RS_TOK = 16;
constexpr int RS_TF = 6 * 64;
constexpr int RS_BUF = RS_TOK * RS_TF;
struct RwkvStage { unsigned r, we, a, ks, v, kk; };
__device__ __forceinline__ int rwkv_row(int b, int dir, int p) {
    if (p < CTXL) { const int t = dir ? CTXL - 1 - p : p; return TL + b * CTXL + t; }
    const int q = p - CTXL, t = dir ? SEQ - 1 - q : q; return b * SEQ + t;
}
__device__ __forceinline__ void ph_rwkv_scan(const KC& k, int l, int job, const float* k_a, size_t yoff = RW_Y) {
    const int b = job >> 5, h = (job >> 1) & 15, dir = job & 1;
    const int tid = k.tid;
    const bf16* R = (const bf16*)(k.ws + RW_R); const bf16* KS = (const bf16*)(k.ws + RW_KS); const bf16* V = (const bf16*)(k.ws + RW_V); const bf16* KK = (const bf16*)(k.ws + RW_KK);
    const bf16* LO = (const bf16*)(k.ws + RW_LO); bf16* Y = (bf16*)(k.ws + yoff) + (size_t)dir * TA * RD;
    LAS float* buf = (LAS float*)k.lds;
    LAS f32x2* ypart = (LAS f32x2*)(buf + 2 * RS_BUF);
    const int st = tid >> 5, cp = tid & 31, ch = h * RHS + 2 * cp;
    const float ka0 = k_a[l * RD + ch], ka1 = k_a[l * RD + ch + 1];
    const int kq = tid & 15, rp = tid >> 4, v0 = rp * 2;
    f32x2 S00 = {0.f, 0.f}, S01 = {0.f, 0.f}, S10 = {0.f, 0.f}, S11 = {0.f, 0.f};
    RwkvStage sg;
#define RW_LOAD(chunk) do { const int row_ = rwkv_row(b, dir, (chunk) * RS_TOK + st); \
        sg.r = *(const unsigned*)(R + (size_t)row_ * RD + ch); sg.ks = *(const unsigned*)(KS + (size_t)row_ * RD + ch); \
        sg.v = *(const unsigned*)(V + (size_t)row_ * RD + ch); sg.kk = *(const unsigned*)(KK + (size_t)row_ * RD + ch); \
        sg.we = *(const unsigned*)(LO + (size_t)row_ * 4096 + dir * RD + ch); sg.a = *(const unsigned*)(LO + (size_t)row_ * 4096 + 2048 + dir * RD + ch); } while (0)
#define RW_WRITE(bi) do { LAS float* tb = buf + (bi) * RS_BUF + st * RS_TF + 2 * cp; \
        const float a0 = bflo(sg.a), a1 = bfhi(sg.a), kk0 = bflo(sg.kk), kk1 = bfhi(sg.kk), ks0 = bflo(sg.ks), ks1 = bfhi(sg.ks); \
        *(LAS f32x2*)(tb + 0) = (f32x2){kk0, kk1}; \
        *(LAS f32x2*)(tb + 64) = (f32x2){__expf(-bflo(sg.we)), __expf(-bfhi(sg.we))}; \
        *(LAS f32x2*)(tb + 128) = (f32x2){-kk0 * a0, -kk1 * a1}; \
        *(LAS f32x2*)(tb + 192) = (f32x2){ks0 * (1.0f + (a0 - 1.0f) * ka0), ks1 * (1.0f + (a1 - 1.0f) * ka1)}; \
        *(LAS f32x2*)(tb + 256) = (f32x2){bflo(sg.r), bfhi(sg.r)}; \
        *(LAS f32x2*)(tb + 320) = (f32x2){bflo(sg.v), bfhi(sg.v)}; } while (0)
    constexpr int NCHUNK = (CTXL + SEQ) / RS_TOK;
    RW_LOAD(0); RW_WRITE(0);
    __syncthreads();
    for (int c = 0; c < NCHUNK; ++c) {
        if (c + 1 < NCHUNK) RW_LOAD(c + 1);
        const LAS float* cb = buf + (c & 1) * RS_BUF; LAS f32x2* yb = ypart + (c & 1) * RS_TOK * 256 + rp * 8 + (((kq >> 1) ^ (rp >> 2)) & 7);
        {
            const LAS float* tk = cb + kq * 4; const LAS float* tv = cb + 320 + v0;
#define RW_LD(T, kk4, w4, n4, d4, r4, vv) f32x4 kk4 = *(const LAS f32x4*)(tk + (T) * RS_TF), w4 = *(const LAS f32x4*)(tk + (T) * RS_TF + 64), n4 = *(const LAS f32x4*)(tk + (T) * RS_TF + 128), \
                d4 = *(const LAS f32x4*)(tk + (T) * RS_TF + 192), r4 = *(const LAS f32x4*)(tk + (T) * RS_TF + 256); f32x2 vv = *(const LAS f32x2*)(tv + (T) * RS_TF)
#define RW_STEP(T, kk4, w4, n4, d4, r4, vv) do { \
                const f32x2 kka = {kk4.x, kk4.y}, kkb = {kk4.z, kk4.w}, wa = {w4.x, w4.y}, wb = {w4.z, w4.w}, na = {n4.x, n4.y}, nb = {n4.z, n4.w}, da = {d4.x, d4.y}, db = {d4.z, d4.w}, ra = {r4.x, r4.y}, rb = {r4.z, r4.w}; \
                f32x2 p0 = S00 * kka + S01 * kkb, p1 = S10 * kka + S11 * kkb; \
                const f32x2 u00 = S00 * wa + da * vv.x, u01 = S01 * wb + db * vv.x, u10 = S10 * wa + da * vv.y, u11 = S11 * wb + db * vv.y;     \
                const float sa0 = dpp_sum16(p0.x + p0.y), sa1 = dpp_sum16(p1.x + p1.y); \
                S00 = na * sa0 + u00; S01 = nb * sa0 + u01; S10 = na * sa1 + u10; S11 = nb * sa1 + u11; \
                p0 = S00 * ra + S01 * rb; p1 = S10 * ra + S11 * rb; \
                float y0 = p0.x + p0.y, y1 = p1.x + p1.y; \
                y0 += __builtin_bit_cast(float, __builtin_amdgcn_update_dpp(0, __builtin_bit_cast(int, y0), 0xB1, 0xF, 0xF, true)); \
                y1 += __builtin_bit_cast(float, __builtin_amdgcn_update_dpp(0, __builtin_bit_cast(int, y1), 0xB1, 0xF, 0xF, true)); \
                if ((kq & 1) == 0) yb[(T) * 256] = (f32x2){y0, y1}; } while (0)
            RW_LD(0, kkA, wA, nA, dA, rA, vA);
#pragma unroll
            for (int tau = 0; tau < RS_TOK; tau += 2) {
                RW_LD(tau + 1, kkB, wB, nB, dB, rB, vB);
                RW_STEP(tau, kkA, wA, nA, dA, rA, vA);
                if (tau + 2 < RS_TOK) { RW_LD(tau + 2, kkC, wC, nC, dC, rC, vC); kkA = kkC; wA = wC; nA = nC; dA = dC; rA = rC; vA = vC; }
                RW_STEP(tau + 1, kkB, wB, nB, dB, rB, vB);
            }
#undef RW_LD
#undef RW_STEP
        }
        if (c + 1 < NCHUNK) RW_WRITE((c + 1) & 1);
        __syncthreads();
        {
            const int row = rwkv_row(b, dir, c * RS_TOK + st);
            const LAS f32x2* yq = ypart + (c & 1) * RS_TOK * 256 + st * 256 + cp * 8;
            f32x2 acc = yq[(0 ^ (cp >> 2)) & 7];
#pragma unroll
            for (int j = 1; j < 8; ++j) acc += yq[(j ^ (cp >> 2)) & 7];
            *(unsigned*)(Y + (size_t)row * RD + ch) = pk2(acc.x, acc.y);
        }
    }
    __syncthreads();
}

constexpr int GP1 = 136, GP2 = 72;
constexpr int GL_QGS = 0, GL_KGS = GL_QGS + 64 * GP1 * 2, GL_STS = GL_KGS + 64 * GP1 * 2, GL_KET = GL_STS + 64 * GP1 * 2, GL_VT = GL_KET + 128 * GP2 * 2, GL_ATT = GL_VT + 64 * GP2 * 2,
              GL_DECS = GL_ATT + 64 * GP2 * 2, GL_LDS_END = GL_DECS + 512;
static_assert(GL_LDS_END <= 131072, "gla lds");
__device__ __forceinline__ bf16x8 ldfrag(const LAS bf16* base, int row, int pitch, int kofs) { return *(const LAS bf16x8*)(base + row * pitch + kofs); }
__device__ __forceinline__ int gla_prow(int b, int dir, int cp, int tau) {
    const bool lat = cp >= 4; const int q = lat ? cp - 4 : cp, ncn = lat ? 32 : 4, cn = dir ? ncn - 1 - q : q;
    return gla_row(lat, b, dir ? 64 * cn + 63 - tau : 64 * cn + tau);
}
__device__ __forceinline__ int gla_gch(int dir, int cp) { const bool lat = cp >= 4; const int q = lat ? cp - 4 : cp, ncn = lat ? 32 : 4, cn = dir ? ncn - 1 - q : q; return lat ? 4 + cn : cn; }
__device__ __forceinline__ bf16x8 ldfrag_sw(const LAS bf16* base, int row, int g) { return *(const LAS bf16x8*)(base + row * GP2 + ((g ^ ((row >> 3) & 7)) << 3)); }
__device__ __forceinline__ void ph_gla_scan(const KC& k, int job) {
    const int b = job >> 5, h = (job >> 3) & 3, dir = (job >> 2) & 1, dvq = job & 3;
    const int tid = k.tid, w = k.wave, lane = k.lane, q4 = lane >> 4, l15 = lane & 15;
    const bf16* QG = (const bf16*)(k.ws + GL_QG) + (size_t)dir * TA * GKD; const bf16* KG = (const bf16*)(k.ws + GL_KG) + (size_t)dir * TA * GKD;
    const bf16* KE = (const bf16*)(k.ws + GL_KE) + (size_t)dir * TA * GKD; const bf16* VS = (const bf16*)(k.ws + GL_VS);
    const float* DEC = (const float*)(k.ws + GL_DEC); bf16* O = (bf16*)(k.ws + GL_O) + (size_t)dir * TA * GVD;
    LAS bf16* QGs = (LAS bf16*)(k.lds + GL_QGS); LAS bf16* KGs = (LAS bf16*)(k.lds + GL_KGS); LAS bf16* STs = (LAS bf16*)(k.lds + GL_STS);
    LAS bf16* KEt = (LAS bf16*)(k.lds + GL_KET); LAS bf16* Vt = (LAS bf16*)(k.lds + GL_VT); LAS bf16* ATT = (LAS bf16*)(k.lds + GL_ATT); LAS float* decs = (LAS float*)(k.lds + GL_DECS);
    f32x4 accS[4];
#pragma unroll
    for (int t = 0; t < 4; ++t) accS[t] = (f32x4){0.f, 0.f, 0.f, 0.f};
    const int tw = w & 3, wh = w >> 2;
#if GLA_TP
    unsigned long long gtp_acc = 0ull, gtp_t0 = 0ull;
#define GTP_MARK(n) do { if (w == GLA_TPW) { const unsigned long long t_ = __builtin_amdgcn_s_memtime(); if ((n) == GLA_TP) gtp_acc += t_ - gtp_t0; gtp_t0 = t_; } } while (0)
#else
#define GTP_MARK(n) do {} while (0)
#endif
    u32x4 pq[2], pk[2], pe[2], pv; float pd = 0.f;
#if GLA_PF2
    u32x4 nq[2], nk[2], ne[2], nv; float nd = 0.f;
#endif
#define GLA_PREFETCH_TO(CP, Q_, K_, E_, V_, D_) do { _Pragma("unroll") for (int i = 0; i < 2; ++i) { const int idx = tid + 512 * i, tau = idx >> 4, ck = idx & 15; \
            const size_t go = (size_t)gla_prow(b, dir, (CP), tau) * GKD + h * GDK + ck * 8; Q_[i] = *(const u32x4*)(QG + go); K_[i] = *(const u32x4*)(KG + go); E_[i] = *(const u32x4*)(KE + go); } \
        V_ = *(const u32x4*)(VS + (size_t)gla_prow(b, dir, (CP), tid >> 3) * GVD + h * GDV + dvq * 64 + (tid & 7) * 8); \
        if (tid < 128) D_ = DEC[((size_t)(dir * 8 + b) * NCH + gla_gch(dir, (CP))) * GKD + h * GDK + tid]; } while (0)
#define GLA_PREFETCH(CP) GLA_PREFETCH_TO(CP, pq, pk, pe, pv, pd)
    GLA_PREFETCH(0);
#if GLA_PF2
    GLA_PREFETCH_TO(1, nq, nk, ne, nv, nd);
#endif
    for (int cp = 0; cp < NCH; ++cp) {
#define GROW(tau) gla_prow(b, dir, cp, (tau))
        GTP_MARK(0);
#pragma unroll
        for (int i = 0; i < 2; ++i) {
            const int idx = tid + 512 * i, tau = idx >> 4, ck = idx & 15;
            *(LAS u32x4*)(QGs + tau * GP1 + ck * 8) = pq[i];
            *(LAS u32x4*)(KGs + tau * GP1 + ck * 8) = pk[i];
            const unsigned kw[4] = {pe[i].x, pe[i].y, pe[i].z, pe[i].w};
#pragma unroll
            for (int e = 0; e < 4; ++e) { const int ts = tau ^ ((ck & 7) << 3); KEt[(ck * 8 + 2 * e) * GP2 + ts] = (bf16)(kw[e] & 0xffffu); KEt[(ck * 8 + 2 * e + 1) * GP2 + ts] = (bf16)(kw[e] >> 16); }
        }
        {
            const int tau = tid >> 3, ck = tid & 7;
            const unsigned vw[4] = {pv.x, pv.y, pv.z, pv.w};
#pragma unroll
            for (int e = 0; e < 4; ++e) { const int ts = tau ^ (ck << 3); Vt[(ck * 8 + 2 * e) * GP2 + ts] = (bf16)(vw[e] & 0xffffu); Vt[(ck * 8 + 2 * e + 1) * GP2 + ts] = (bf16)(vw[e] >> 16); }
        }
        if (tid < 128) decs[tid] = pd;
#pragma unroll
        for (int t = 0; t < 4; ++t) {
            const int dkt = wh * 4 + t;
            const u32x2 v = {pk2c(accS[t][0], accS[t][1]), pk2c(accS[t][2], accS[t][3])};
            *(LAS u32x2*)(STs + (16 * tw + l15) * GP1 + 16 * dkt + 4 * q4) = v;
        }
#if GLA_PF2
#pragma unroll
        for (int i = 0; i < 2; ++i) { pq[i] = nq[i]; pk[i] = nk[i]; pe[i] = ne[i]; }
        pv = nv; pd = nd;
        __syncthreads();
        if (cp + 2 < NCH) GLA_PREFETCH_TO(cp + 2, nq, nk, ne, nv, nd);
#else
        GTP_MARK(1);
        __syncthreads();
        GTP_MARK(2);
        if (cp + 1 < NCH) GLA_PREFETCH(cp + 1);
#endif
        bf16x8 qf[4];
#pragma unroll
        for (int ks = 0; ks < 4; ++ks) qf[ks] = ldfrag(QGs, 16 * tw + l15, GP1, 32 * ks + 8 * q4);
#pragma unroll
        for (int jj = 0; jj < 2; ++jj) {
            const int it = tw, jt = wh * 2 + jj;
            if (jt > it) {
                if ((jt >> 1) == (it >> 1)) {
#pragma unroll
                    for (int r = 0; r < 4; ++r) ATT[(16 * it + 4 * q4 + r) * GP2 + 16 * jt + l15] = (bf16)0;
                }
                continue;
            }
            f32x4 acc = (f32x4){0.f, 0.f, 0.f, 0.f};
#pragma unroll
            for (int ks = 0; ks < 4; ++ks) acc = __builtin_amdgcn_mfma_f32_16x16x32_bf16(qf[ks], ldfrag(KGs, 16 * jt + l15, GP1, 32 * ks + 8 * q4), acc, 0, 0, 0);
#pragma unroll
            for (int r = 0; r < 4; ++r) { const int i = 16 * it + 4 * q4 + r, j = 16 * jt + l15; ATT[i * GP2 + j] = (bf16)f2bf(j <= i ? acc[r] : 0.f); }
        }
        GTP_MARK(3);
        __syncthreads();
        GTP_MARK(4);
        const int nks = tw >= 2 ? 2 : 1;
        bf16x8 af[2];
#pragma unroll
        for (int ks = 0; ks < 2; ++ks) if (ks < nks) af[ks] = ldfrag(ATT, 16 * tw + l15, GP2, 32 * ks + 8 * q4);
#pragma unroll
        for (int dd = 0; dd < 2; ++dd) {
            const int it = tw, dvt = wh * 2 + dd;
            f32x4 acc = (f32x4){0.f, 0.f, 0.f, 0.f};
#pragma unroll
            for (int ks = 0; ks < 4; ++ks) acc = __builtin_amdgcn_mfma_f32_16x16x32_bf16(qf[ks], ldfrag(STs, 16 * dvt + l15, GP1, 32 * ks + 8 * q4), acc, 0, 0, 0);
#pragma unroll
            for (int ks = 0; ks < 2; ++ks) if (ks < nks) acc = __builtin_amdgcn_mfma_f32_16x16x32_bf16(af[ks], ldfrag_sw(Vt, 16 * dvt + l15, 4 * ks + q4), acc, 0, 0, 0);
#pragma unroll
            for (int r = 0; r < 4; ++r) { const int i = 16 * it + 4 * q4 + r; O[(size_t)GROW(i) * GVD + h * GDV + dvq * 64 + 16 * dvt + l15] = (bf16)f2bf(acc[r]); }
        }
        GTP_MARK(5);
#pragma unroll
        for (int t = 0; t < 4; ++t) {
            const int dkt = wh * 4 + t; const f32x4 d = *(const LAS f32x4*)(decs + 16 * dkt + 4 * q4);
            accS[t] = accS[t] * d;
#pragma unroll
            for (int ks = 0; ks < 2; ++ks) accS[t] = __builtin_amdgcn_mfma_f32_16x16x32_bf16(ldfrag_sw(KEt, 16 * dkt + l15, 4 * ks + q4), ldfrag_sw(Vt, 16 * tw + l15, 4 * ks + q4), accS[t], 0, 0, 0);
        }
        GTP_MARK(6);
        __syncthreads();
        GTP_MARK(7);
#undef GROW
    }
#if GLA_TP
    if (w == GLA_TPW) { const unsigned long long t0 = __builtin_amdgcn_s_memtime(); while (__builtin_amdgcn_s_memtime() - t0 < gtp_acc) __builtin_amdgcn_s_sleep(8); }
    __syncthreads();
#endif
#undef GLA_PREFETCH
#undef GLA_PREFETCH_TO
}

#ifndef RWKV_MODE
#define RWKV_MODE 2
#endif
#ifndef HB_FULL
#define HB_FULL 0
#endif
#ifndef GLA4_LEVEL
#define GLA4_LEVEL 0
#endif
#ifndef GLA4_NOSTORE
#define GLA4_NOSTORE 0
#endif
#ifndef SWAP_HALVES
#define SWAP_HALVES 0
#endif
#ifndef SPLIT_SCAN
#define SPLIT_SCAN 0
#endif
constexpr int RS4_TOK = 8, RS4_BUF = RS4_TOK * RS_TF;
constexpr int SC_GL = 0;
constexpr int SC_RW = 96 * 1024;
constexpr int SC_END = SC_RW + 2 * RS4_BUF * 4 + 2 * RS4_TOK * 64 * 4;
static_assert(SC_GL + GL_LDS_END <= SC_RW, "scan lds halves");
constexpr int SC_CTR = 127 * 1024;
static_assert(SC_END <= SC_CTR && SC_CTR + 128 <= 131072, "scan lds");
__device__ __forceinline__ void half_bar(LAS unsigned* ctr, unsigned& gen, int lane) {
#if HB_FULL
    (void)ctr; (void)lane; gen += 4u; __syncthreads(); return;
#endif
    gen += 4u;
    __builtin_amdgcn_fence(__ATOMIC_RELEASE, "workgroup");
    if (lane == 0) __hip_atomic_fetch_add(ctr, 1u, __ATOMIC_RELAXED, __HIP_MEMORY_SCOPE_WORKGROUP);
    unsigned spins = 0;
    while (__hip_atomic_load(ctr, __ATOMIC_RELAXED, __HIP_MEMORY_SCOPE_WORKGROUP) < gen) { __builtin_amdgcn_s_sleep(1); if (++spins > (1u << 26)) break; }
    __builtin_amdgcn_fence(__ATOMIC_ACQUIRE, "workgroup");
}
#ifndef RW4_SHFL
#define RW4_SHFL 0
#endif
__device__ __forceinline__ float shfl_sum16(float x) { x += __shfl_xor(x, 1); x += __shfl_xor(x, 2); x += __shfl_xor(x, 4); x += __shfl_xor(x, 8); return x; }
#if RW4_SHFL
#define RW4_SUM16(x) shfl_sum16(x)
#else
#define RW4_SUM16(x) dpp_sum16(x)
#endif
__device__ __forceinline__ void rwkv_scan_4w(const KC& k, int l, int job, const float* k_a, LAS unsigned* ctr) {
    const int b = job >> 5, h = (job >> 1) & 15, dir = job & 1;
    const int tid = k.tid, lane = k.lane;
    const bf16* R = (const bf16*)(k.ws + RW_R); const bf16* KS = (const bf16*)(k.ws + RW_KS); const bf16* V = (const bf16*)(k.ws + RW_V); const bf16* KK = (const bf16*)(k.ws + RW_KK);
    const bf16* LO = (const bf16*)(k.ws + RW_LO); bf16* Y = (bf16*)(k.ws + RW_Y) + (size_t)dir * TA * RD;
    LAS float* buf = (LAS float*)(k.lds + SC_RW);
    LAS float* ybuf = buf + 2 * RS4_BUF;
    const int st = tid >> 5, cp = tid & 31, ch = h * RHS + 2 * cp;
    const float ka0 = k_a[l * RD + ch], ka1 = k_a[l * RD + ch + 1];
    const int kq = tid & 15, v0 = (tid >> 4) * 4;
    f32x2 S[4][2];
#pragma unroll
    for (int i = 0; i < 4; ++i) { S[i][0] = (f32x2){0.f, 0.f}; S[i][1] = (f32x2){0.f, 0.f}; }
    RwkvStage sg[1];
    unsigned gen = 0;
#define RW4_LOAD(chunk) do { _Pragma("unroll") for (int q_ = 0; q_ < 1; ++q_) { const int row_ = rwkv_row(b, dir, (chunk) * RS4_TOK + st); \
        sg[q_].r = *(const unsigned*)(R + (size_t)row_ * RD + ch); sg[q_].ks = *(const unsigned*)(KS + (size_t)row_ * RD + ch); \
        sg[q_].v = *(const unsigned*)(V + (size_t)row_ * RD + ch); sg[q_].kk = *(const unsigned*)(KK + (size_t)row_ * RD + ch); \
        sg[q_].we = *(const unsigned*)(LO + (size_t)row_ * 4096 + dir * RD + ch); sg[q_].a = *(const unsigned*)(LO + (size_t)row_ * 4096 + 2048 + dir * RD + ch); } } while (0)
#define RW4_WRITE(bi) do { _Pragma("unroll") for (int q_ = 0; q_ < 1; ++q_) { LAS float* tb = buf + (bi) * RS4_BUF + st * RS_TF + 2 * cp; \
        const float a0 = bflo(sg[q_].a), a1 = bfhi(sg[q_].a), kk0 = bflo(sg[q_].kk), kk1 = bfhi(sg[q_].kk), ks0 = bflo(sg[q_].ks), ks1 = bfhi(sg[q_].ks); \
        *(LAS f32x2*)(tb + 0) = (f32x2){kk0, kk1}; \
        *(LAS f32x2*)(tb + 64) = (f32x2){__expf(-bflo(sg[q_].we)), __expf(-bfhi(sg[q_].we))}; \
        *(LAS f32x2*)(tb + 128) = (f32x2){-kk0 * a0, -kk1 * a1}; \
        *(LAS f32x2*)(tb + 192) = (f32x2){ks0 * (1.0f + (a0 - 1.0f) * ka0), ks1 * (1.0f + (a1 - 1.0f) * ka1)}; \
        *(LAS f32x2*)(tb + 256) = (f32x2){bflo(sg[q_].r), bfhi(sg[q_].r)}; \
        *(LAS f32x2*)(tb + 320) = (f32x2){bflo(sg[q_].v), bfhi(sg[q_].v)}; } } while (0)
    constexpr int NCHUNK = (CTXL + SEQ) / RS4_TOK;
    RW4_LOAD(0); RW4_WRITE(0);
    half_bar(ctr, gen, lane);
    for (int c = 0; c < NCHUNK; ++c) {
        if (c + 1 < NCHUNK) RW4_LOAD(c + 1);
        const LAS float* cb = buf + (c & 1) * RS4_BUF; LAS float* yb = ybuf + (c & 1) * RS4_TOK * 64;
        {
            const LAS float* tk = cb + kq * 4; const LAS float* tv = cb + 320 + v0;
#define RW4_LD(T, kk4, w4, n4, d4, r4, vv) f32x4 kk4 = *(const LAS f32x4*)(tk + (T) * RS_TF), w4 = *(const LAS f32x4*)(tk + (T) * RS_TF + 64), n4 = *(const LAS f32x4*)(tk + (T) * RS_TF + 128), \
                d4 = *(const LAS f32x4*)(tk + (T) * RS_TF + 192), r4 = *(const LAS f32x4*)(tk + (T) * RS_TF + 256), vv = *(const LAS f32x4*)(tv + (T) * RS_TF)
#define RW4_STEP(T, kk4, w4, n4, d4, r4, vv) do { \
                const f32x2 kka = {kk4.x, kk4.y}, kkb = {kk4.z, kk4.w}, wa = {w4.x, w4.y}, wb = {w4.z, w4.w}, na = {n4.x, n4.y}, nb = {n4.z, n4.w}, da = {d4.x, d4.y}, db = {d4.z, d4.w}, ra = {r4.x, r4.y}, rb = {r4.z, r4.w}; \
                float sa[4], yy[4]; f32x2 u0[4], u1[4]; \
                _Pragma("unroll") for (int i = 0; i < 4; ++i) { const f32x2 p = S[i][0] * kka + S[i][1] * kkb; sa[i] = p.x + p.y; u0[i] = S[i][0] * wa + da * vv[i]; u1[i] = S[i][1] * wb + db * vv[i]; } \
                _Pragma("unroll") for (int i = 0; i < 4; ++i) sa[i] = RW4_SUM16(sa[i]); \
                _Pragma("unroll") for (int i = 0; i < 4; ++i) { S[i][0] = na * sa[i] + u0[i]; S[i][1] = nb * sa[i] + u1[i]; const f32x2 q = S[i][0] * ra + S[i][1] * rb; yy[i] = q.x + q.y; } \
                _Pragma("unroll") for (int i = 0; i < 4; ++i) yy[i] = RW4_SUM16(yy[i]); \
                if (kq == 0) *(LAS f32x4*)(yb + (T) * 64 + v0) = (f32x4){yy[0], yy[1], yy[2], yy[3]}; } while (0)
            RW4_LD(0, kkA, wA, nA, dA, rA, vA);
#pragma unroll
            for (int tau = 0; tau < RS4_TOK; tau += 2) {
                RW4_LD(tau + 1, kkB, wB, nB, dB, rB, vB);
                RW4_STEP(tau, kkA, wA, nA, dA, rA, vA);
                if (tau + 2 < RS4_TOK) { RW4_LD(tau + 2, kkC, wC, nC, dC, rC, vC); kkA = kkC; wA = wC; nA = nC; dA = dC; rA = rC; vA = vC; }
                RW4_STEP(tau + 1, kkB, wB, nB, dB, rB, vB);
            }
#undef RW4_LD
#undef RW4_STEP
        }
        if (c + 1 < NCHUNK) RW4_WRITE((c + 1) & 1);
        half_bar(ctr, gen, lane);
        {
            const int row = rwkv_row(b, dir, c * RS4_TOK + st);
            const f32x2 yy = *(const LAS f32x2*)(yb + st * 64 + 2 * cp);
            *(unsigned*)(Y + (size_t)row * RD + ch) = pk2(yy.x, yy.y);
        }
    }
#undef RW4_LOAD
#undef RW4_WRITE
}
__device__ __forceinline__ void gla_scan_4w(const KC& k, int job, LAS unsigned* ctr) {
    const int b = job >> 5, h = (job >> 3) & 3, dir = (job >> 2) & 1, dvq = job & 3;
    const int tid = k.tid - 256, w = k.wave - 4, lane = k.lane, q4 = lane >> 4, l15 = lane & 15;
    const bf16* QG = (const bf16*)(k.ws + GL_QG) + (size_t)dir * TA * GKD; const bf16* KG = (const bf16*)(k.ws + GL_KG) + (size_t)dir * TA * GKD;
    const bf16* KE = (const bf16*)(k.ws + GL_KE) + (size_t)dir * TA * GKD; const bf16* VS = (const bf16*)(k.ws + GL_VS);
    const float* DEC = (const float*)(k.ws + GL_DEC); bf16* O = (bf16*)(k.ws + GL_O) + (size_t)dir * TA * GVD;
    LAS unsigned char* gl = k.lds + SC_GL;
    LAS bf16* QGs = (LAS bf16*)(gl + GL_QGS); LAS bf16* KGs = (LAS bf16*)(gl + GL_KGS); LAS bf16* STs = (LAS bf16*)(gl + GL_STS);
    LAS bf16* KEt = (LAS bf16*)(gl + GL_KET); LAS bf16* Vt = (LAS bf16*)(gl + GL_VT); LAS bf16* ATT = (LAS bf16*)(gl + GL_ATT); LAS float* decs = (LAS float*)(gl + GL_DECS);
    f32x4 accS[8];
#pragma unroll
    for (int t = 0; t < 8; ++t) accS[t] = (f32x4){0.f, 0.f, 0.f, 0.f};
    unsigned gen = 0;
#if GLA4_LEVEL == 2
    { float x = (float)lane; for (int i = 0; i < 200000; ++i) { x = x * 1.0001f + 0.5f; asm volatile("" : "+v"(x)); } asm volatile("" :: "v"(x)); (void)ctr; (void)gen; }
    return;
#endif
#if GLA4_LEVEL == 1
    for (int cp = 0; cp < NCH; ++cp) { float x = (float)lane; for (int i = 0; i < 2000; ++i) x = x * 1.0001f + 0.5f; asm volatile("" :: "v"(x)); half_bar(ctr, gen, lane); half_bar(ctr, gen, lane); half_bar(ctr, gen, lane); }
    return;
#endif
    for (int cp = 0; cp < NCH; ++cp) {
        const bool lat = cp >= 4; const int q = lat ? cp - 4 : cp, ncn = lat ? 32 : 4, cn = dir ? ncn - 1 - q : q, gch = lat ? 4 + cn : cn;
#define GROW(tau) gla_row(lat, b, dir ? 64 * cn + 63 - (tau) : 64 * cn + (tau))
#pragma unroll
        for (int i = 0; i < 4; ++i) {
            const int idx = tid + 256 * i, tau = idx >> 4, ck = idx & 15; const size_t go = (size_t)GROW(tau) * GKD + h * GDK + ck * 8;
            *(LAS u32x4*)(QGs + tau * GP1 + ck * 8) = *(const u32x4*)(QG + go);
            *(LAS u32x4*)(KGs + tau * GP1 + ck * 8) = *(const u32x4*)(KG + go);
            const u32x4 ke = *(const u32x4*)(KE + go);
            const unsigned kw[4] = {ke.x, ke.y, ke.z, ke.w};
#pragma unroll
            for (int e = 0; e < 4; ++e) { KEt[(ck * 8 + 2 * e) * GP2 + tau] = (bf16)(kw[e] & 0xffffu); KEt[(ck * 8 + 2 * e + 1) * GP2 + tau] = (bf16)(kw[e] >> 16); }
        }
#pragma unroll
        for (int i = 0; i < 2; ++i) {
            const int idx = tid + 256 * i, tau = idx >> 3, ck = idx & 7;
            const u32x4 vv = *(const u32x4*)(VS + (size_t)GROW(tau) * GVD + h * GDV + dvq * 64 + ck * 8);
            const unsigned vw[4] = {vv.x, vv.y, vv.z, vv.w};
#pragma unroll
            for (int e = 0; e < 4; ++e) { Vt[(ck * 8 + 2 * e) * GP2 + tau] = (bf16)(vw[e] & 0xffffu); Vt[(ck * 8 + 2 * e + 1) * GP2 + tau] = (bf16)(vw[e] >> 16); }
        }
        if (tid < 128) decs[tid] = DEC[((size_t)(dir * 8 + b) * NCH + gch) * GKD + h * GDK + tid];
#pragma unroll
        for (int t = 0; t < 8; ++t) {
#pragma unroll
            for (int r = 0; r < 4; ++r) STs[(16 * w + 4 * q4 + r) * GP1 + 16 * t + l15] = (bf16)f2bf(accS[t][r]);
        }
        half_bar(ctr, gen, lane);
#pragma unroll
        for (int jt = 0; jt < 4; ++jt) {
            f32x4 acc = (f32x4){0.f, 0.f, 0.f, 0.f};
#pragma unroll
            for (int ks = 0; ks < 4; ++ks) acc = __builtin_amdgcn_mfma_f32_16x16x32_bf16(ldfrag(QGs, 16 * w + l15, GP1, 32 * ks + 8 * q4), ldfrag(KGs, 16 * jt + l15, GP1, 32 * ks + 8 * q4), acc, 0, 0, 0);
#pragma unroll
            for (int r = 0; r < 4; ++r) { const int i = 16 * w + 4 * q4 + r, j = 16 * jt + l15; ATT[i * GP2 + j] = (bf16)f2bf(j <= i ? acc[r] : 0.f); }
        }
        half_bar(ctr, gen, lane);
#pragma unroll
        for (int dvt = 0; dvt < 4; ++dvt) {
            f32x4 acc = (f32x4){0.f, 0.f, 0.f, 0.f};
#pragma unroll
            for (int ks = 0; ks < 4; ++ks) acc = __builtin_amdgcn_mfma_f32_16x16x32_bf16(ldfrag(QGs, 16 * w + l15, GP1, 32 * ks + 8 * q4), ldfrag(STs, 16 * dvt + l15, GP1, 32 * ks + 8 * q4), acc, 0, 0, 0);
#pragma unroll
            for (int ks = 0; ks < 2; ++ks) acc = __builtin_amdgcn_mfma_f32_16x16x32_bf16(ldfrag(ATT, 16 * w + l15, GP2, 32 * ks + 8 * q4), ldfrag(Vt, 16 * dvt + l15, GP2, 32 * ks + 8 * q4), acc, 0, 0, 0);
#pragma unroll
#if GLA4_NOSTORE
            asm volatile("" :: "v"(acc[0]), "v"(acc[1]), "v"(acc[2]), "v"(acc[3]));
#else
            for (int r = 0; r < 4; ++r) { const int i = 16 * w + 4 * q4 + r; O[(size_t)GROW(i) * GVD + h * GDV + dvq * 64 + 16 * dvt + l15] = (bf16)f2bf(acc[r]); }
#endif
        }
#pragma unroll
        for (int t = 0; t < 8; ++t) {
            const float d = decs[16 * t + l15];
            accS[t] = accS[t] * d;
#pragma unroll
            for (int ks = 0; ks < 2; ++ks) accS[t] = __builtin_amdgcn_mfma_f32_16x16x32_bf16(ldfrag(Vt, 16 * w + l15, GP2, 32 * ks + 8 * q4), ldfrag(KEt, 16 * t + l15, GP2, 32 * ks + 8 * q4), accS[t], 0, 0, 0);
        }
        half_bar(ctr, gen, lane);
#undef GROW
    }
#if HB_FULL
    for (int i = 0; i < (1 + (CTXL + SEQ) / RS4_TOK) - 3 * NCH; ++i) __syncthreads();
#endif
}
__device__ __forceinline__ void ph_scan_split(const KC& k, int l, const float* k_a) {
    LAS unsigned* ctr = (LAS unsigned*)(k.lds + SC_CTR);
    for (int job = k.bid; job < 256; job += k.G) {
        if (k.tid == 0) { ctr[0] = 0u; ctr[16] = 0u; }
        __syncthreads();
#if SPLIT_SCAN == 1 || SPLIT_SCAN == 4 || SPLIT_SCAN == 5 || SPLIT_SCAN == 6
#if SWAP_HALVES
        { KC k2 = k; if (k.wave >= 4) { k2.tid = k.tid - 256; k2.wave = k.wave - 4; rwkv_scan_4w(k2, l, job, k_a, ctr); } else { k2.tid = k.tid + 256; k2.wave = k.wave + 4; gla_scan_4w(k2, job, ctr + 16); } }
#else
        if (k.wave < 4) rwkv_scan_4w(k, l, job, k_a, ctr); else gla_scan_4w(k, job, ctr + 16);
#endif
        __syncthreads();
#if SPLIT_SCAN == 6
        ph_rwkv_scan(k, l, job, k_a, WS_H);
#elif SPLIT_SCAN == 4
        ph_rwkv_scan(k, l, job, k_a);
#elif SPLIT_SCAN == 5
        ph_gla_scan(k, job);
#endif
#elif SPLIT_SCAN == 2
        if (k.wave < 4) rwkv_scan_4w(k, l, job, k_a, ctr);
        __syncthreads();
        ph_gla_scan(k, job);
#else
        if (k.wave >= 4) gla_scan_4w(k, job, ctr + 16);
        __syncthreads();
        ph_rwkv_scan(k, l, job, k_a);
#endif
    }
}

__device__ __forceinline__ void ph_post(const KC& k, int l, int nrows, const float* ln_g, const float* ln_b, const float* gng) {
    const int gw = k.bid * 8 + k.wave, NGW = k.G * 8, lane = k.lane, c = 16 * lane;
    const bf16* P = (const bf16*)(k.ws + WS_P);
    const bf16* Y = (const bf16*)(k.ws + RW_Y); const bf16* V = (const bf16*)(k.ws + RW_V); const float* BON = (const float*)(k.ws + RW_BON); bf16* YNB = (bf16*)(k.ws + RW_R);
    const bf16* O = (const bf16*)(k.ws + GL_O); bf16* YB = (bf16*)(k.ws + GL_VS);
    for (int row = gw; row < nrows; row += NGW) {
        {
            float yf[16], yb[16], vv[16], y[16];
            ld16(Y + (size_t)row * RD + c, true, yf); ld16(Y + ((size_t)TA + row) * RD + c, true, yb); ld16(V + (size_t)row * RD + c, true, vv);
            float s = 0.f;
#pragma unroll
            for (int i = 0; i < 16; ++i) { y[i] = yf[i] + yb[i]; s += y[i]; }
            s += __shfl_xor(s, 1); s += __shfl_xor(s, 2);
            const float mean = s * (1.0f / 64.0f); float q = 0.f;
#pragma unroll
            for (int i = 0; i < 16; ++i) { y[i] -= mean; q += y[i] * y[i]; }
            q += __shfl_xor(q, 1); q += __shfl_xor(q, 2);
            const float rstd = 1.0f / sqrtf(q * (1.0f / 64.0f) + 64e-5f), bon = BON[(size_t)row * RHEADS + (lane >> 2)];
#pragma unroll
            for (int i = 0; i < 16; ++i) y[i] = y[i] * rstd * ln_g[l * RD + c + i] + ln_b[l * RD + c + i] + bon * vv[i];
            st16(YNB + (size_t)row * RD + c, y);
        }
        {
            float of[16], ob[16], gt[16], o[16];
            ld16(O + (size_t)row * GVD + c, true, of); ld16(O + ((size_t)TA + row) * GVD + c, true, ob); ld16(P + (size_t)row * NP + GLA_GATE_OFF + c, true, gt);
            float s = 0.f;
#pragma unroll
            for (int i = 0; i < 16; ++i) { o[i] = of[i] + ob[i]; s += o[i] * o[i]; }
            s += __shfl_xor(s, 1); s += __shfl_xor(s, 2); s += __shfl_xor(s, 4); s += __shfl_xor(s, 8);
            const float rinv = 1.0f / sqrtf(s * (1.0f / 256.0f) + 1e-6f);
#pragma unroll
            for (int i = 0; i < 16; ++i) o[i] = o[i] * rinv * gng[l * GDV + ((c + i) & 255)] * siluf(gt[i]);
            st16(YB + (size_t)row * GVD + c, o);
        }
    }
}

#ifndef CHUNK_LOADS_FIRST
#define CHUNK_LOADS_FIRST 1
#endif
#ifndef TIMEPROBE
#define TIMEPROBE 0
#endif
#ifndef CHUNK_PF
#define CHUNK_PF 0
#endif
#ifndef SUBST_PK
#define SUBST_PK 0
#endif
#ifndef CONS_UNROLL
#define CONS_UNROLL 1
#endif
#ifndef CHUNK_NOPS
#define CHUNK_NOPS 0
#endif
#ifndef PROD_PK
#define PROD_PK 0
#endif
#ifndef LDS_POISON
#define LDS_POISON 0
#endif
#ifndef CHUNK_DBG
#define CHUNK_DBG 0
#endif
constexpr int RC_XT = 0;
constexpr int RC_YH = RC_XT + 32 * 72 * 2;
constexpr int RC_BET = RC_YH + 64 * 24 * 2;
constexpr int RC_AM = RC_YH + 2 * 64 * 24 * 2;
constexpr int RC_P2 = RC_AM + 2048;
constexpr int RC_AKR = RC_P2 + 512;
constexpr int RC_ABR = RC_AKR + 512;
constexpr int RC_GC = RC_ABR + 512;
constexpr int RC_SLOT = RC_GC + 256;
static_assert(RC_SLOT == 14592 && 8 * RC_SLOT <= 131072 && 32 * 72 * 2 <= 2 * 64 * 24 * 2, "rwkv chunk lds");
__device__ __forceinline__ bf16x8 mk8(u32x2 lo, u32x2 hi) { u32x4 v = {lo.x, lo.y, hi.x, hi.y}; return __builtin_bit_cast(bf16x8, v); }
__device__ __forceinline__ int rwkv_chunk_rmin(int b, int dir, int c) {
    const int p0 = c * 16;
    if (p0 < CTXL) return TL + b * CTXL + (dir ? CTXL - 16 - p0 : p0);
    const int q = p0 - CTXL; return b * SEQ + (dir ? SEQ - 16 - q : q);
}
__device__ __forceinline__ unsigned f2bf_hi(float f) { return __float_as_uint(f) + 0x8000u; }
#ifndef FAST_RND
#define FAST_RND 1
#endif
#ifndef USE_RCP
#define USE_RCP 1
#endif
#ifndef CHUNK_SADDR
#define CHUNK_SADDR 1
#endif
#ifndef Y_SADDR
#define Y_SADDR 2
#endif
#if FAST_RND
#define BFH(x) ((bf16)(f2bf_hi(x) >> 16))
#else
#define BFH(x) ((bf16)f2bf(x))
#endif
template <int SKIP = 0>
__device__ __forceinline__ void ph_rwkv_chunk(const KC& k, int l, int job, const float* k_a, size_t yoff = RW_Y) {
    const int b = job >> 5, h = (job >> 1) & 15, dir = job & 1;
    const int w = k.wave, lane = k.lane, q4 = lane >> 4, l15 = lane & 15;
    const bf16* R = (const bf16*)(k.ws + RW_R); const bf16* KS = (const bf16*)(k.ws + RW_KS); const bf16* V = (const bf16*)(k.ws + RW_V); const bf16* KK = (const bf16*)(k.ws + RW_KK);
    const bf16* LO = (const bf16*)(k.ws + RW_LO); bf16* Y = (bf16*)(k.ws + yoff) + (size_t)dir * TA * RD;
    LAS unsigned char* slot = k.lds + w * RC_SLOT;
    LAS bf16* XT = (LAS bf16*)(slot + RC_XT); LAS bf16* YH = (LAS bf16*)(slot + RC_YH);
    LAS float* AM = (LAS float*)(slot + RC_AM);
    const int ch = h * RHS + lane;
    const float ka = k_a[l * RD + ch];
    f32x4 accZ[4];
#pragma unroll
    for (int t = 0; t < 4; ++t) accZ[t] = (f32x4){0.f, 0.f, 0.f, 0.f};
    constexpr int NCK = (CTXL + SEQ) / 16, NRND = NCK / 8;
#if TIMEPROBE
    unsigned long long tp_acc = 0ull, tp_t0 = 0ull;
#define TP_MARK(n) do { if (w == 0) { const unsigned long long t_ = __builtin_amdgcn_s_memtime(); if ((n) == TIMEPROBE) tp_acc += t_ - tp_t0; tp_t0 = t_; } } while (0)
#else
#define TP_MARK(n) do {} while (0)
#endif
    unsigned ylane[4];
#pragma unroll
    for (int r = 0; r < 4; ++r) { const int tk = 4 * q4 + r; ylane[r] = (unsigned)(((dir ? 15 - tk : tk) * RD + h * RHS + 16 * (w & 3) + l15) * 2); }
#if CHUNK_PF
    unsigned pf0 = 0u, pf1 = 0u, pf2 = 0u;
#endif
#if LDS_POISON
    for (int i = lane; i < RC_SLOT / 4; i += 64) ((LAS unsigned*)slot)[i] = 0x7fc07fc0u;
    __syncthreads();
#endif
    for (int rnd = 0; rnd < NRND; ++rnd) {
#if LDS_POISON
        for (int i = lane; i < RC_SLOT / 4; i += 64) ((LAS unsigned*)slot)[i] = 0x7fc07fc0u;
#endif
        TP_MARK(0);
        if (!(SKIP & 2)) {
            const int c = rnd * 8 + w;
            float Lc = 0.f, Eprev = 1.f;
            unsigned vp[8];
#if CHUNK_LOADS_FIRST
            unsigned rv[16], rkk[16], re[16], ra[16], rks[16], rr[16];
            float bhe[16], khe[16];
            const unsigned rmin = (unsigned)rwkv_chunk_rmin(b, dir, c);
            const unsigned ob1 = (rmin * (unsigned)RD + (unsigned)ch) * 2u, ob4 = (rmin * 4096u + (unsigned)(dir * RD) + (unsigned)ch) * 2u;
            const char* LOa = (const char*)LO + 4096;
#pragma unroll
            for (int t = 0; t < 16; ++t) {
#if CHUNK_SADDR
                const unsigned tr = dir ? 15u - t : (unsigned)t;
                const unsigned o1 = ob1 + tr * (unsigned)(RD * 2), o4 = ob4 + tr * 8192u;
                if (SKIP & 4) { rv[t] = o1; rkk[t] = o1 >> 3; re[t] = 0x3c00u + (o4 & 255u); ra[t] = 0x3f00u; rks[t] = o1 >> 5; rr[t] = o1 >> 7; }
                else { rv[t] = *(const bf16*)((const char*)V + o1); rkk[t] = *(const bf16*)((const char*)KK + o1); re[t] = *(const bf16*)((const char*)LO + o4); ra[t] = *(const bf16*)(LOa + o4);
                       rks[t] = *(const bf16*)((const char*)KS + o1); rr[t] = *(const bf16*)((const char*)R + o1); }
#else
                const unsigned o1 = (unsigned)rwkv_row(b, dir, c * 16 + t) * (unsigned)RD + (unsigned)ch, o4 = o1 * 4u - 3u * (unsigned)ch + (unsigned)(dir * RD);
                if (SKIP & 4) { rv[t] = o1; rkk[t] = o1 >> 3; re[t] = 0x3c00u + (o4 & 255u); ra[t] = 0x3f00u; rks[t] = o1 >> 5; rr[t] = o1 >> 7; }
                else { rv[t] = V[o1]; rkk[t] = KK[o1]; re[t] = LO[o4]; ra[t] = LO[o4 + 2048u]; rks[t] = KS[o1]; rr[t] = R[o1]; }
#endif
            }
            asm volatile("" ::: "memory");
            const float omka = 1.0f - ka;
#pragma unroll
            for (int t = 0; t < ((SKIP & 16) ? 1 : 16); ++t) {
                { const unsigned vraw = rv[t]; vp[t >> 1] = (t & 1) ? (vp[t >> 1] | (vraw << 16)) : vraw; }
                const float kkv = bf2f(rkk[t]), ev = bf2f(re[t]), av = bf2f(ra[t]);
                const float ksv = bf2f(rks[t]), rv_ = bf2f(rr[t]);
                Lc -= ev;
#if USE_RCP
                const float E = __expf(Lc), Einv = __builtin_amdgcn_rcpf(E);
#else
                const float E = __expf(Lc), Einv = __expf(-Lc);
#endif
                XT[t * 72 + lane] = BFH(kkv * Eprev); XT[(16 + t) * 72 + lane] = BFH(rv_ * E);
                const float bh_ = kkv * av * Einv, kh_ = ksv * __builtin_fmaf(av, ka, omka) * Einv;
                YH[t * 72 + lane] = BFH(bh_); YH[(16 + t) * 72 + lane] = BFH(kh_);
                bhe[t] = bh_; khe[t] = kh_;
                Eprev = E;
            }
#else
#pragma unroll
            for (int t = 0; t < 16; ++t) {
                const unsigned o1 = (unsigned)rwkv_row(b, dir, c * 16 + t) * (unsigned)RD + (unsigned)ch, o4 = o1 * 4u - 3u * (unsigned)ch + (unsigned)(dir * RD);
                { const unsigned vraw = V[o1]; vp[t >> 1] = (t & 1) ? (vp[t >> 1] | (vraw << 16)) : vraw; }
                const float kkv = bf2f(KK[o1]), ev = bf2f(LO[o4]), av = bf2f(LO[o4 + 2048u]);
                const float ksv = bf2f(KS[o1]), rv = bf2f(R[o1]);
                Lc -= ev;
                const float E = __expf(Lc), Einv = __expf(-Lc);
                XT[t * 72 + lane] = (bf16)f2bf(kkv * Eprev); XT[(16 + t) * 72 + lane] = (bf16)f2bf(rv * E);
                YH[t * 72 + lane] = (bf16)f2bf(kkv * av * Einv); YH[(16 + t) * 72 + lane] = (bf16)f2bf(ksv * (1.0f + (av - 1.0f) * ka) * Einv);
                Eprev = E;
            }
#endif
            const float eLC = Eprev;
            asm volatile("s_waitcnt lgkmcnt(0)" ::: "memory");
            TP_MARK(1);
#if CHUNK_PF
            if (w >= 4) {
                const int cn0 = (rnd + 1 < NRND ? rnd + 1 : rnd) * 8;
                int ln = lane; asm volatile("" : "+v"(ln));
                auto pf_off = [&](int j) -> unsigned {
                    const int i = (w - 4) * 192 + j * 64 + ln, cc = i / 96, wi = i - cc * 96, ar = wi >> 4, tk = wi & 15;
                    const unsigned row = (unsigned)rwkv_row(b, dir, (cn0 + cc) * 16 + tk);
                    const unsigned base = ar == 0 ? (unsigned)RW_R : ar == 1 ? (unsigned)RW_KS : ar == 2 ? (unsigned)RW_V : ar == 3 ? (unsigned)RW_KK : (unsigned)RW_LO;
                    const unsigned el = ar < 4 ? row * (unsigned)RD + (unsigned)(h * RHS) : row * 4096u + (unsigned)(dir * RD + h * RHS) + (unsigned)(ar - 4) * 2048u;
                    return base + 2u * el; };
                const unsigned q0 = pf_off(0), q1 = pf_off(1), q2 = pf_off(2);
                asm volatile("global_load_dword %0, %3, %6\n\tglobal_load_dword %1, %4, %6\n\tglobal_load_dword %2, %5, %6" : "+v"(pf0), "+v"(pf1), "+v"(pf2) : "v"(q0), "v"(q1), "v"(q2), "s"(k.ws) : "memory");
            }
#endif
            f32x4 am[2][2];
#pragma unroll
            for (int rt = 0; rt < 2; ++rt)
#pragma unroll
                for (int ct = 0; ct < 2; ++ct) {
                    f32x4 acc = (f32x4){0.f, 0.f, 0.f, 0.f};
#pragma unroll
                    for (int s = 0; s < ((SKIP & 32) ? 0 : 2); ++s) acc = __builtin_amdgcn_mfma_f32_16x16x32_bf16(*(const LAS bf16x8*)(XT + (16 * rt + l15) * 72 + 32 * s + 8 * q4), *(const LAS bf16x8*)(YH + (16 * ct + l15) * 72 + 32 * s + 8 * q4), acc, 0, 0, 0);
                    am[rt][ct] = acc;
                }
#if CHUNK_LOADS_FIRST
            if (!(SKIP & 64)) {
                const float nel = -eLC;
#pragma unroll
                for (int q = 0; q < 4; ++q) {
                    u32x4 v = {pk2(khe[4 * q] * eLC, khe[4 * q + 1] * eLC), pk2(khe[4 * q + 2] * eLC, khe[4 * q + 3] * eLC), pk2(bhe[4 * q] * nel, bhe[4 * q + 1] * nel), pk2(bhe[4 * q + 2] * nel, bhe[4 * q + 3] * nel)};
                    *(LAS u32x4*)(slot + RC_YH + lane * 96 + q * 16) = v;
                }
            }
#endif
            LAS bf16* AKR = (LAS bf16*)(slot + RC_AKR); LAS bf16* ABR = (LAS bf16*)(slot + RC_ABR);
#pragma unroll
            for (int r = 0; r < 4; ++r) {
                const int t = 4 * q4 + r, j = l15;
                AM[t * 16 + j] = j < t ? am[0][0][r] : 0.f;
                AM[256 + t * 16 + j] = j < t ? am[0][1][r] : 0.f;
#if PROD_PK
                const unsigned ab2 = pk2c(j <= t ? -am[1][0][r] : 0.f, j <= t ? am[1][1][r] : 0.f);
                ABR[t * 16 + j] = (bf16)(ab2 & 0xffffu);
                AKR[t * 16 + j] = (bf16)(ab2 >> 16);
#else
                ABR[t * 16 + j] = BFH(j <= t ? -am[1][0][r] : 0.f);
                AKR[t * 16 + j] = BFH(j <= t ? am[1][1][r] : 0.f);
#endif
            }
            asm volatile("s_waitcnt lgkmcnt(0)" ::: "memory");
            TP_MARK(2);
#if SUBST_PK
            f32x2 PP[16]; float kt[16];
#pragma unroll
            for (int t = 0; t < 16; ++t) kt[t] = bf2f(XT[t * 72 + lane]);
#pragma unroll
            for (int t = 0; t < 16; ++t) {
                asm volatile("" ::: "memory");
                f32x2 p = {kt[t], AM[256 + t * 16 + l15]};
#pragma unroll
                for (int j4 = 0; j4 < (t + 3) / 4; ++j4) {
                    const f32x4 arow = *(const LAS f32x4*)(AM + t * 16 + 4 * j4);
#pragma unroll
                    for (int e = 0; e < 4; ++e) { const int j = 4 * j4 + e; if (j < t) p -= PP[j] * arow[e]; }
                }
                PP[t] = p;
            }
#else
            float P1[16], P2[16], kt[16];
#pragma unroll
            for (int t = 0; t < 16; ++t) kt[t] = bf2f(XT[t * 72 + lane]);
#pragma unroll
            for (int t = 0; t < 16; ++t) {
                asm volatile("" ::: "memory");
                float p1 = kt[t], p2 = AM[256 + t * 16 + l15];
#pragma unroll
                for (int j4 = 0; j4 < (t + 3) / 4; ++j4) {
                    const f32x4 arow = *(const LAS f32x4*)(AM + t * 16 + 4 * j4);
#pragma unroll
                    for (int e = 0; e < 4; ++e) { const int j = 4 * j4 + e; if (j < t && !(SKIP & 8)) { p1 -= arow[e] * P1[j]; p2 -= arow[e] * P2[j]; } }
                }
                P1[t] = p1; P2[t] = p2;
            }
#endif
            LAS bf16* P2b = (LAS bf16*)(slot + RC_P2);
#pragma unroll
#if PROD_PK
            for (int t = 0; t < 16; ++t) { const unsigned pp = pk2c(0.f, 0.f); XT[t * 72 + lane] = (bf16)(pp & 0xffffu); if (lane < 16) P2b[t * 16 + lane] = (bf16)(pp >> 16); }
#else
#if SUBST_PK
            for (int t = 0; t < 16; ++t) { if (CHUNK_DBG != 12) XT[t * 72 + lane] = (bf16)f2bf(CHUNK_DBG == 13 ? 1.0f + (float)t : PP[t].x); if (lane < 16) P2b[t * 16 + lane] = (bf16)f2bf(PP[t].y); }
#else
            for (int t = 0; t < 16; ++t) { XT[t * 72 + lane] = BFH(P1[t]); if (lane < 16) P2b[t * 16 + lane] = BFH(P2[t]); }
#endif
#endif
            if (!(SKIP & 64)) {
                ((LAS float*)(slot + RC_GC))[lane] = eLC;
                *(LAS u32x4*)(slot + RC_AM + lane * 32) = (u32x4){vp[0], vp[1], vp[2], vp[3]}; *(LAS u32x4*)(slot + RC_AM + lane * 32 + 16) = (u32x4){vp[4], vp[5], vp[6], vp[7]};
            }
        }
        TP_MARK(3);
        __syncthreads();
        TP_MARK(4);
        if (w < 4 && !(SKIP & 1)) {
#if Y_SADDR == 2
            unsigned yoff[4]; const unsigned ystep = dir ? 0u - (unsigned)(16 * RD * 2) : (unsigned)(16 * RD * 2);
            { const unsigned yb = (unsigned)rwkv_chunk_rmin(b, dir, rnd * 8) * (unsigned)(RD * 2);
#pragma unroll
              for (int r = 0; r < 4; ++r) yoff[r] = yb + ylane[r]; }
#endif
#if CONS_UNROLL == 2
#pragma unroll 2
#else
#pragma unroll 1
#endif
            for (int cc = 0; cc < 8; ++cc) {
                const int c = rnd * 8 + cc;
                LAS unsigned char* sl = k.lds + cc * RC_SLOT;
                const LAS bf16* P1b = (const LAS bf16*)(sl + RC_XT); const LAS bf16* RTb = P1b + 16 * 72;
                const LAS bf16* P2b = (const LAS bf16*)(sl + RC_P2); const LAS bf16* AKR = (const LAS bf16*)(sl + RC_AKR); const LAS bf16* ABR = (const LAS bf16*)(sl + RC_ABR);
                const LAS float* GC = (const LAS float*)(sl + RC_GC);
                const u32x2 vfr = *(const LAS u32x2*)(sl + RC_AM + (16 * w + l15) * 32 + 8 * q4);
                const unsigned vlo = vfr.x, vhi = vfr.y;
#if CHUNK_DBG == 5
                for (int t = 0; t < 4; ++t) accZ[t] = (f32x4){0.f, 0.f, 0.f, 0.f};
#endif
#if CHUNK_NOPS
                asm volatile("s_nop 15\n\ts_nop 15" ::: "memory");
#endif
                bf16x8 bz[2];
#pragma unroll
                for (int s = 0; s < 2; ++s) { u32x4 v = {pk2c(accZ[2 * s][0], accZ[2 * s][1]), pk2c(accZ[2 * s][2], accZ[2 * s][3]), pk2c(accZ[2 * s + 1][0], accZ[2 * s + 1][1]), pk2c(accZ[2 * s + 1][2], accZ[2 * s + 1][3])}; bz[s] = __builtin_bit_cast(bf16x8, v); }
#if CHUNK_DBG == 6
                bz[0] = (bf16x8){0,0,0,0,0,0,0,0}; bz[1] = bz[0];
#endif
                const u32x2 zero2 = {0u, 0u};
                f32x4 zs[4];
#pragma unroll
                for (int t = 0; t < 4; ++t) zs[t] = accZ[t] * *(const LAS f32x4*)(GC + 16 * t + 4 * q4);
#if CHUNK_DBG == 7
                for (int t = 0; t < 4; ++t) zs[t] = (f32x4){0.f, 0.f, 0.f, 0.f};
#endif
                f32x4 sa = (f32x4){0.f, 0.f, 0.f, 0.f};
#if CHUNK_DBG >= 10 && CHUNK_DBG <= 13
                { u32x4 ones = {0x3f803f80u, 0x3f803f80u, 0x3f803f80u, 0x3f803f80u}; const bf16x8 bo = __builtin_bit_cast(bf16x8, ones);
                  for (int s = 0; s < 2; ++s) sa = __builtin_amdgcn_mfma_f32_16x16x32_bf16(mk8(*(const LAS u32x2*)(P1b + l15 * 72 + 32 * s + 4 * q4), *(const LAS u32x2*)(P1b + l15 * 72 + 32 * s + 16 + 4 * q4)), (CHUNK_DBG == 10 || CHUNK_DBG == 12 || CHUNK_DBG == 13) ? bo : bz[s], sa, 0, 0, 0); }
#else
#pragma unroll
                for (int s = 0; s < 2; ++s) if (CHUNK_DBG != 3 && CHUNK_DBG != 9) sa = __builtin_amdgcn_mfma_f32_16x16x32_bf16(mk8(*(const LAS u32x2*)(P1b + l15 * 72 + 32 * s + 4 * q4), *(const LAS u32x2*)(P1b + l15 * 72 + 32 * s + 16 + 4 * q4)), bz[s], sa, 0, 0, 0);
#endif
                if (CHUNK_DBG != 4 && !(CHUNK_DBG >= 10 && CHUNK_DBG <= 13)) { u32x4 bv = {vlo, vhi, 0u, 0u}; sa = __builtin_amdgcn_mfma_f32_16x16x32_bf16(mk8(*(const LAS u32x2*)(P2b + l15 * 16 + 4 * q4), zero2), __builtin_bit_cast(bf16x8, bv), sa, 0, 0, 0); }
#if CHUNK_DBG == 1
                sa = (f32x4){0.f, 0.f, 0.f, 0.f};
#endif
#if CHUNK_NOPS
                asm volatile("s_nop 15" : "+v"(sa));
#endif
                bf16x8 bv2; { u32x4 v = {vlo, vhi, pk2c(sa[0], sa[1]), pk2c(sa[2], sa[3])}; bv2 = __builtin_bit_cast(bf16x8, v); }
                f32x4 yy = (f32x4){0.f, 0.f, 0.f, 0.f};
#pragma unroll
                for (int s = 0; s < 2; ++s) if (CHUNK_DBG != 8) yy = __builtin_amdgcn_mfma_f32_16x16x32_bf16(mk8(*(const LAS u32x2*)(RTb + l15 * 72 + 32 * s + 4 * q4), *(const LAS u32x2*)(RTb + l15 * 72 + 32 * s + 16 + 4 * q4)), bz[s], yy, 0, 0, 0);
                yy = __builtin_amdgcn_mfma_f32_16x16x32_bf16(mk8(*(const LAS u32x2*)(AKR + l15 * 16 + 4 * q4), *(const LAS u32x2*)(ABR + l15 * 16 + 4 * q4)), bv2, yy, 0, 0, 0);
#pragma unroll
                for (int t = 0; t < 4; ++t) {
                    accZ[t] = __builtin_amdgcn_mfma_f32_16x16x32_bf16(*(const LAS bf16x8*)(sl + RC_YH + (16 * t + l15) * 96 + q4 * 16), bv2, zs[t], 0, 0, 0);
                }
#if CHUNK_DBG == 2
                yy = (f32x4){1.f, 1.f, 1.f, 1.f};
#endif
#if CHUNK_DBG >= 10 && CHUNK_DBG <= 13
                yy = sa;
#endif
#if CHUNK_NOPS
                asm volatile("s_nop 15" : "+v"(yy));
#endif
#if Y_SADDR == 2
#pragma unroll
                for (int r = 0; r < 4; ++r) { *(bf16*)((char*)Y + yoff[r]) = BFH(yy[r]); yoff[r] += ystep; }
#elif Y_SADDR
                { const unsigned yb = (unsigned)rwkv_chunk_rmin(b, dir, c) * (unsigned)(RD * 2);
#pragma unroll
                  for (int r = 0; r < 4; ++r) *(bf16*)((char*)Y + (yb + ylane[r])) = BFH(yy[r]); }
#else
#pragma unroll
                for (int r = 0; r < 4; ++r) Y[(size_t)rwkv_row(b, dir, c * 16 + 4 * q4 + r) * RD + h * RHS + 16 * w + l15] = BFH(yy[r]);
#endif
            }
        }
#if CHUNK_PF
        else asm volatile("s_waitcnt vmcnt(0)" : "+v"(pf0), "+v"(pf1), "+v"(pf2) :: "memory");
#endif
        TP_MARK(5);
        __syncthreads();
        TP_MARK(6);
    }
#if TIMEPROBE
    if (l == 0 && w == 0) { const unsigned long long t0 = __builtin_amdgcn_s_memtime(); while (__builtin_amdgcn_s_memtime() - t0 < tp_acc) __builtin_amdgcn_s_sleep(8); }
    __syncthreads();
#endif
}

#ifndef CHECK_EXACT
#define CHECK_EXACT 0
#endif
#ifndef CHECK_PMAX
#define CHECK_PMAX (CTXL + SEQ)
#endif
#ifndef CHECK_PMIN
#define CHECK_PMIN 0
#endif
#ifndef CHECK_UNIT
#define CHECK_UNIT 1000
#endif
__device__ __forceinline__ void rwkv_check_delay(const KC& k, int job, size_t refoff = RW_Y) {
    const int b = job >> 5, h = (job >> 1) & 15, dir = job & 1;
    const bf16* Ya = (const bf16*)(k.ws + refoff) + (size_t)dir * TA * RD; const bf16* Yb = (const bf16*)(k.ws + WS_H) + (size_t)dir * TA * RD;
    float d2 = 0.f, s2 = 0.f; int bad = 0;
    for (int i = k.tid; i < (CHECK_PMAX) * 32; i += 512) {
        const int p = (CHECK_PMIN) + (i >> 5), cp = i & 31; const size_t o = (size_t)rwkv_row(b, dir, p) * RD + h * RHS + 2 * cp;
        const unsigned ua = *(const unsigned*)(Ya + o), ub = *(const unsigned*)(Yb + o);
        const float a0 = bflo(ua), a1 = bfhi(ua), b0 = bflo(ub), b1 = bfhi(ub);
        d2 += (CHECK_EXACT) ? (ua != ub ? 1.0f : 0.0f) : (a0 - b0) * (a0 - b0) + (a1 - b1) * (a1 - b1); s2 += a0 * a0 + a1 * a1;
        if (!(b0 == b0) || !(b1 == b1) || fabsf(b0) > 1e30f || fabsf(b1) > 1e30f) bad = 1;
    }
    LAS float* red = (LAS float*)k.lds;
    __syncthreads();
    d2 = wave_sum(d2); s2 = wave_sum(s2); bad = __any(bad) ? 1 : 0;
    if (k.lane == 0) { red[k.wave * 4] = d2; red[k.wave * 4 + 1] = s2; red[k.wave * 4 + 2] = (float)bad; }
    __syncthreads();
    if (k.tid == 0) {
        float D = 0.f, S = 0.f, B = 0.f;
        for (int i = 0; i < 8; ++i) { D += red[i * 4]; S += red[i * 4 + 1]; B += red[i * 4 + 2]; }
        const float rel = sqrtf(D / fmaxf(S, 1e-30f));
        int bucket = rel < 0.01f ? 0 : rel < 0.03f ? 1 : rel < 0.1f ? 2 : rel < 0.3f ? 3 : rel < 1.0f ? 4 : 5;
        if (CHECK_EXACT) bucket = D == 0.f ? 0 : D < 10.f ? 1 : D < 100.f ? 2 : D < 1000.f ? 3 : D < 10000.f ? 4 : 5;
        if (B > 0.f || !(rel == rel)) bucket = 6;
        const unsigned long long t0 = __builtin_amdgcn_s_memrealtime(), wait = (unsigned long long)bucket * (CHECK_UNIT) * 100ull;
        while (__builtin_amdgcn_s_memrealtime() - t0 < wait) __builtin_amdgcn_s_sleep(8);
    }
    __syncthreads();
}
using pg8::Unit;
struct FP_ { bf16* P; __device__ __forceinline__ void operator()(int row, int col, float (&v)[8], const Unit&) const { *(u32x4*)(P + (size_t)row * NP + col) = pack8(v); } };
struct FL1_ { bf16* LO; const float* bias1;
    __device__ __forceinline__ void operator()(int row, int col, float (&v)[8], const Unit& u) const {
        const float* bias = bias1 + col;
        const f32x4 b0 = *(const f32x4*)bias, b1 = *(const f32x4*)(bias + 4);
        const float bb[8] = {b0.x, b0.y, b0.z, b0.w, b1.x, b1.y, b1.z, b1.w};
        const float sc = col < 2048 ? 0.6065306597126334f : 1.0f;
#pragma unroll
        for (int i = 0; i < 8; ++i) v[i] = sigm(bb[i] + v[i]) * sc;
        *(u32x4*)(LO + (size_t)row * 4096 + col) = pack8(v);
    } };
struct FL2_ { const bf16* YNB; bf16* YA;
    __device__ __forceinline__ void operator()(int row, int col, float (&v)[8], const Unit&) const {
        float y[8]; unpack8(*(const u32x4*)(YNB + (size_t)row * RD + col), y);
#pragma unroll
        for (int i = 0; i < 8; ++i) v[i] *= y[i];
        *(u32x4*)(YA + (size_t)row * RD + col) = pack8(v);
    } };
template <int SECOND> struct FM_ { const bf16* P; bf16* MA; bf16* OUT;
    __device__ __forceinline__ void operator()(int row, int col, float (&v)[8], const Unit&) const {
        float g[8]; unpack8(*(const u32x4*)(P + (size_t)row * NP + BR_OFF + SECOND * DM + col), g);
        const bf16* mp = MA + (size_t)row * DM + col;
        if (SECOND) { float m[8]; unpack8(*(const u32x4*)mp, m);
#pragma unroll
            for (int i = 0; i < 8; ++i) v[i] = sigm(g[i]) * v[i] + m[i]; }
        else {
#pragma unroll
            for (int i = 0; i < 8; ++i) v[i] = sigm(g[i]) * v[i]; }
        *(u32x4*)(OUT + (size_t)row * DM + col) = pack8(v);
    } };
struct FX_ { float* X; const float* MOD; int l; float* OUT;
    __device__ __forceinline__ void operator()(int row, int col, const f32x4 v, const Unit&) const {
        const f32x4 g = *(const f32x4*)(MOD + ((size_t)l * 9 + mod_row(row)) * MOD_N + 2 * DM + col);
        const f32x4* xp = (const f32x4*)(X + (size_t)row * DM + col);
        *(f32x4*)(OUT + (size_t)row * DM + col) = *xp + g * v;
    } };
struct FXb_ { bf16* X; const float* MOD; int l;
    __device__ __forceinline__ void operator()(int row, int col, float (&v)[8], const Unit&) const {
        const float* gp = MOD + ((size_t)l * 9 + mod_row(row)) * MOD_N + 2 * DM + col;
        const f32x4 g0 = *(const f32x4*)gp, g1 = *(const f32x4*)(gp + 4);
        const float gg[8] = {g0.x, g0.y, g0.z, g0.w, g1.x, g1.y, g1.z, g1.w};
        bf16* xp = X + (size_t)row * DM + col;
        float x[8]; unpack8(*(const u32x4*)xp, x);
#pragma unroll
        for (int i = 0; i < 8; ++i) v[i] = x[i] + gg[i] * v[i];
        *(u32x4*)xp = pack8(v);
    } };
struct FE1_ { bf16* ACT;
    __device__ __forceinline__ void operator()(int row, int col, float (&g)[8], float (&up)[8]) const {
#pragma unroll
        for (int i = 0; i < 8; ++i) g[i] = siluf(g[i]) * up[i];
        *(u32x4*)(ACT + (size_t)row * DEXP + col) = pack8(g);
    } };
struct FE2_ { const int* rowtok; const float* roww; bf16* YF;
    __device__ __forceinline__ void operator()(int row, int col, float (&v)[8], const Unit&) const {
        const int t2 = rowtok[row];
        if (t2 >= 0) { const float w = roww[row];
#pragma unroll
            for (int i = 0; i < 8; ++i) v[i] *= w;
            *(u32x4*)(YF + ((size_t)(t2 & 1) * TA + (t2 >> 1)) * DM + col) = pack8(v); }
    } };

#ifndef GA_
#define GA_ true
#endif
#ifndef GS_
#define GS_ true
#endif
constexpr int LDS_BYTES = 147456;
constexpr int MISC_OFF = 131072 + 4096;

constexpr int NPHASE = 2 + 14 * DEPTH + 1;
struct Args { const float* in[N_IN]; float* out; unsigned char* ws; int ph_lo, ph_hi; };
static_assert(sizeof(Args) == N_IN * 8 + 8 + 8 + 8, "Args has no padding");

__global__ void __launch_bounds__(512, 2) fwd(Args a) {
    extern __shared__ __attribute__((aligned(16))) unsigned char lds_raw[];
    KC k;
    k.lds = (LAS unsigned char*)lds_raw; k.ws = (unsigned char*)INP(N_IN + 1);
    k.tid = threadIdx.x; k.lane = k.tid & 63; k.wave = __builtin_amdgcn_readfirstlane(k.tid >> 6); k.G = gridDim.x; k.bid = blockIdx.x;
    const int lo = a.ph_lo, hi = a.ph_hi;
    volatile LAS unsigned* MISC = (volatile LAS unsigned*)(k.lds + MISC_OFF);
    if (k.tid < 32) MISC[k.tid] = 0u;
    __syncthreads();
    XcdBarrier bar; bar.bar = (unsigned*)(k.ws + WS_CTL) + CW_BAR; bar.x = 0; bar.st = nullptr;
    if (hi - lo > 1) bar = xcd_barrier_post((unsigned*)(k.ws + WS_CTL) + CW_BAR, MISC + 8);
#ifndef SITE_MASK
#define SITE_MASK 0xFFFFFFFFu
#endif
#define FRESH() do { int t_ = threadIdx.x; asm volatile("" : "+v"(t_)); k.tid = t_; k.lane = t_ & 63; k.wave = __builtin_amdgcn_readfirstlane(t_ >> 6); k.ws = (unsigned char*)INP(N_IN + 1); ws = k.ws; } while (0)
#define PH_BEGIN(p, site) if (((SITE_MASK >> (site)) & 1u) && lo <= (p) && (p) < hi) { FRESH();
#ifndef EXTRA_BARS
#define EXTRA_BARS 0
#endif
#ifndef DUP_MASK
#define DUP_MASK 0u
#endif
#define DUPRUN(n, stmt) do { stmt; if ((DUP_MASK >> (n)) & 1u) { __syncthreads(); stmt; } } while (0)
#define PH_END(p) if ((p) + 1 < hi) xcd_barrier(bar); }
    unsigned char* ws = k.ws;
    LAS unsigned char* glds = k.lds;
#define WSRC WSrc{INP(I_WIN), INP(I_W2), INP(I_A2), INP(I_G2), INP(I_WBA), INP(I_WBB), INP(I_WOUT), INP(I_EG), INP(I_EU), INP(I_ED), INP(I_W0), INP(I_A0)}

    PH_BEGIN(0, 0) DUPRUN(0, ph_adaln_partials(k, INP(I_C), INP(I_CCTX), INP(I_WADA))); DUPRUN(1, ph_convert(k, WSRC, 0)); PH_END(0)
    PH_BEGIN(1, 1) ph_adaln_reduce(k, INP(I_BADA)); PH_END(1)

#define L_ 0
    {
        constexpr int l = L_;
        const int pb = 2 + 14 * l;
        const bool last = (l == DEPTH - 1);
        const int Mpost = last ? TL : TA;
        PH_BEGIN(pb + 0, 2)
            if (l > 0) { DUPRUN(1, ph_convert(k, WSRC, l)); }
            RowArgs ra{INP(I_X), INP(I_CTX), INP(I_NMG), nullptr, nullptr, nullptr};
            ph_rows<0>(k, ra, l, TA);
            if (l == 0 && ((DUP_MASK >> 15) & 1u)) { __syncthreads(); ph_rows<0>(k, ra, l, TA); }
        PH_END(pb + 0)
        PH_BEGIN(pb + 1, 3)
            pg8::Gemm g{(const bf16*)(ws + WS_H), (const bf16*)(ws + WT_IN), TA, NP, DM, 0}; pg8::StaticOrder S; S.init(TA, NP, k.G, k.bid);
            pg8::Epi8<FP_> E{FP_{(bf16*)(ws + WS_P)}};
            DUPRUN(2, (pg8::gemm_phase<pg8::Epi8<FP_>, pg8::StaticOrder, GA_, GS_>(glds, g, S, E)));
        PH_END(pb + 1)
        PH_BEGIN(pb + 2, 4)
            DUPRUN(3, ph_rwkv_prep(k, l, TA, INP(I_MU), INP(I_KK), INP(I_RK)));
            DUPRUN(4, ph_gla_prep(k, l, INP(I_GCONV), INP(I_GAW2), INP(I_GAB)));
        PH_END(pb + 2)
        PH_BEGIN(pb + 3, 5)
            pg8::Gemm g{(const bf16*)(ws + RW_A1), (const bf16*)(ws + WT_L1), TA, 4096, 256, 0}; pg8::StaticOrder S; S.init(TA, 4096, k.G, k.bid);
            pg8::Epi8<FL1_> E{FL1_{(bf16*)(ws + RW_LO), (const float*)(ws + WS_TAB + TAB_TOP)}};
            DUPRUN(5, (pg8::gemm_phase<pg8::Epi8<FL1_>, pg8::StaticOrder, GA_, GS_>(glds, g, S, E)));
        PH_END(pb + 3)
        PH_BEGIN(pb + 4, 6)
#if SPLIT_SCAN
            DUPRUN(6, ph_scan_split(k, l, INP(I_KA)));
#else
            for (int vb = ((k.G & 7) ? k.bid : (k.bid & 7) * (k.G >> 3) + (k.bid >> 3)); vb < 256; vb += k.G) { const int job = vb;
#if RWKV_MODE == 0
                DUPRUN(6, ph_rwkv_scan(k, l, job, INP(I_KA)));
#elif RWKV_MODE == 1
                ph_rwkv_scan(k, l, job, INP(I_KA)); ph_rwkv_chunk(k, l, job, INP(I_KA), WS_H); if (l == 0) rwkv_check_delay(k, job);
#elif RWKV_MODE == 4
                ph_rwkv_scan(k, l, job, INP(I_KA)); ph_rwkv_chunk(k, l, job, INP(I_KA), WS_H); ph_rwkv_chunk(k, l, job, INP(I_KA), WS_END); if (l == 0) rwkv_check_delay(k, job, WS_END);
#elif RWKV_MODE == 5
#pragma unroll 1
                for (int rep = 0; rep < 2; ++rep) { int r_ = rep; asm volatile("" : "+s"(r_)); __syncthreads(); ph_rwkv_chunk(k, l, job, INP(I_KA), r_ ? (size_t)RW_Y : (size_t)WS_H); }
                if (l == 0) rwkv_check_delay(k, job);
#elif RWKV_MODE == 3
                ph_rwkv_scan(k, l, job, INP(I_KA)); ph_rwkv_scan(k, l, job, INP(I_KA), WS_H); if (l == 0) rwkv_check_delay(k, job);
#else
                DUPRUN(6, ph_rwkv_chunk(k, l, job, INP(I_KA)));
#ifdef CHUNK_PROBE
                __syncthreads(); ph_rwkv_chunk<CHUNK_PROBE>(k, l, job, INP(I_KA), WS_END);
#endif
#endif
            }
#ifndef NO_GLA
            FRESH();
            for (int vb = ((k.G & 7) ? k.bid : (k.bid & 7) * (k.G >> 3) + (k.bid >> 3)); vb < 256; vb += k.G) { const int job = vb; DUPRUN(7, ph_gla_scan(k, job)); }
#endif
#endif
        PH_END(pb + 4)
        PH_BEGIN(pb + 5, 7)
            DUPRUN(8, ph_post(k, l, Mpost, INP(I_LNG), INP(I_LNB), INP(I_GNG)));
        PH_END(pb + 5)
        PH_BEGIN(pb + 6, 8)
            pg8::Gemm g{(const bf16*)(ws + RW_A2), (const bf16*)(ws + WT_G2), Mpost, RD, 256, 0}; pg8::StaticOrder S; S.init(Mpost, RD, k.G, k.bid);
            pg8::Epi8<FL2_> E{FL2_{(const bf16*)(ws + RW_R), (bf16*)(ws + RW_V)}};
            DUPRUN(9, (pg8::gemm_phase<pg8::Epi8<FL2_>, pg8::StaticOrder, GA_, GS_>(glds, g, S, E)));
        PH_END(pb + 6)
        PH_BEGIN(pb + 7, 9)
            pg8::Gemm g{(const bf16*)(ws + RW_V), (const bf16*)(ws + WT_A), Mpost, DM, RD, 0}; pg8::StaticOrder S; S.init(Mpost, DM, k.G, k.bid);
            pg8::Epi8<FM_<0>> E{FM_<0>{(const bf16*)(ws + WS_P), (bf16*)(ws + WS_H), (bf16*)(ws + WS_H)}};
            DUPRUN(10, (pg8::gemm_phase<pg8::Epi8<FM_<0>>, pg8::StaticOrder, GA_, GS_>(glds, g, S, E)));
        PH_END(pb + 7)
        PH_BEGIN(pb + 8, 10)
            pg8::Gemm g{(const bf16*)(ws + GL_VS), (const bf16*)(ws + WT_B), Mpost, DM, GVD, 0}; pg8::StaticOrder S; S.init(Mpost, DM, k.G, k.bid);
            pg8::Epi8<FM_<1>> E{FM_<1>{(const bf16*)(ws + WS_P), (bf16*)(ws + WS_H), (bf16*)(ws + WS_H)}};
            pg8::gemm_phase<pg8::Epi8<FM_<1>>, pg8::StaticOrder, GA_, GS_>(glds, g, S, E);
            if ((DUP_MASK >> 17) & 1u) { __syncthreads(); pg8::Epi8<FM_<1>> E2{FM_<1>{(const bf16*)(ws + WS_P), (bf16*)(ws + WS_H), (bf16*)(ws + RW_R)}}; pg8::gemm_phase<pg8::Epi8<FM_<1>>, pg8::StaticOrder, GA_, GS_>(glds, g, S, E2); }
        PH_END(pb + 8)
        PH_BEGIN(pb + 9, 11)
            pg8::Gemm g{(const bf16*)(ws + WS_H), (const bf16*)(ws + WT_O), Mpost, DM, DM, 0}; pg8::StaticOrder S; S.init(Mpost, DM, k.G, k.bid);
#if XBF
            pg8::Epi8<FXb_> E{FXb_{(bf16*)(ws + WS_X), (const float*)(ws + WS_MOD), l}};
            pg8::gemm_phase<pg8::Epi8<FXb_>, pg8::StaticOrder, GA_, GS_>(glds, g, S, E);
#else
            pg8::Epi4<FX_> E{FX_{(float*)(ws + WS_X), (const float*)(ws + WS_MOD), l, (float*)(ws + WS_X)}};
            pg8::gemm_phase<pg8::Epi4<FX_>, pg8::StaticOrder, GA_, GS_>(glds, g, S, E);
#endif
            if (!XBF && ((DUP_MASK >> 18) & 1u)) { __syncthreads(); pg8::Epi4<FX_> E2{FX_{(float*)(ws + WS_X), (const float*)(ws + WS_MOD), l, (float*)(ws + WS_P)}}; pg8::gemm_phase<pg8::Epi4<FX_>, pg8::StaticOrder, GA_, GS_>(glds, g, S, E2); }
        PH_END(pb + 9)
        PH_BEGIN(pb + 10, 12)
            RowArgs ra{nullptr, nullptr, INP(I_NFG), INP(I_RW), INP(I_RB), nullptr};
            ph_rows<1>(k, ra, l, Mpost);
            if ((DUP_MASK >> 16) & 1u) { __syncthreads(); ph_rows<1>(k, ra, l, Mpost, true); }
        PH_END(pb + 10)
        PH_BEGIN(pb + 11, 13)
            DUPRUN(13, ph_moe_scatter(k, l, Mpost));
        PH_END(pb + 11)
        PH_BEGIN(pb + 12, 14)
#if MOE_GATHER
            pg8::Gemm g{(const bf16*)(ws + WS_H), (const bf16*)(ws + WT_GU), 0, 2816, DM, (size_t)2816 * DM * 2};
            pg8::MoeOrderT<true> S; S.rowtok = (const int*)(ws + WS_TAB + TAB_ROWTOK) + (size_t)l * MOE_ROWS;
            S.init((const int*)(ws + WS_TAB + TAB_TILE) + 256 * l, 11, k.G, ((k.G & 7) ? k.bid : (k.bid & 7) * (k.G >> 3) + (k.bid >> 3)));
            pg8::EpiGU<FE1_> E{FE1_{(bf16*)(ws + WS_ACT)}};
            DUPRUN(11, (pg8::gemm_phase<pg8::EpiGU<FE1_>, pg8::MoeOrderT<true>, GA_, GS_>(glds, g, S, E)));
#else
            pg8::Gemm g{(const bf16*)(ws + WS_HP), (const bf16*)(ws + WT_GU), 0, 2816, DM, (size_t)2816 * DM * 2};
            pg8::MoeOrder S; S.init((const int*)(ws + WS_TAB + TAB_TILE) + 256 * l, 11, k.G, ((k.G & 7) ? k.bid : (k.bid & 7) * (k.G >> 3) + (k.bid >> 3)));
            pg8::EpiGU<FE1_> E{FE1_{(bf16*)(ws + WS_ACT)}};
            DUPRUN(11, (pg8::gemm_phase<pg8::EpiGU<FE1_>, pg8::MoeOrder, GA_, GS_>(glds, g, S, E)));
#endif
        PH_END(pb + 12)
        PH_BEGIN(pb + 13, 15)
            pg8::Gemm g{(const bf16*)(ws + WS_ACT), (const bf16*)(ws + WT_D), 0, DM, DEXP, (size_t)DM * DEXP * 2};
            pg8::MoeOrder S; S.init((const int*)(ws + WS_TAB + TAB_TILE) + 256 * l, 8, k.G, ((k.G & 7) ? k.bid : (k.bid & 7) * (k.G >> 3) + (k.bid >> 3)));
            pg8::Epi8<FE2_> E{FE2_{(const int*)(ws + WS_TAB + TAB_ROWTOK) + (size_t)l * MOE_ROWS, (const float*)(ws + WS_TAB + TAB_ROWW) + (size_t)l * MOE_ROWS, (bf16*)(ws + WS_YF)}};
            DUPRUN(12, (pg8::gemm_phase<pg8::Epi8<FE2_>, pg8::MoeOrder, GA_, GS_>(glds, g, S, E)));
        PH_END(pb + 13)
        }
#undef L_
#define L_ 1
    {
        constexpr int l = L_;
        const int pb = 2 + 14 * l;
        const bool last = (l == DEPTH - 1);
        const int Mpost = last ? TL : TA;
        PH_BEGIN(pb + 0, 2)
            if (l > 0) { DUPRUN(1, ph_convert(k, WSRC, l)); }
            RowArgs ra{INP(I_X), INP(I_CTX), INP(I_NMG), nullptr, nullptr, nullptr};
            ph_rows<0>(k, ra, l, TA);
            if (l == 0 && ((DUP_MASK >> 15) & 1u)) { __syncthreads(); ph_rows<0>(k, ra, l, TA); }
        PH_END(pb + 0)
        PH_BEGIN(pb + 1, 3)
            pg8::Gemm g{(const bf16*)(ws + WS_H), (const bf16*)(ws + WT_IN), TA, NP, DM, 0}; pg8::StaticOrder S; S.init(TA, NP, k.G, k.bid);
            pg8::Epi8<FP_> E{FP_{(bf16*)(ws + WS_P)}};
            DUPRUN(2, (pg8::gemm_phase<pg8::Epi8<FP_>, pg8::StaticOrder, GA_, GS_>(glds, g, S, E)));
        PH_END(pb + 1)
        PH_BEGIN(pb + 2, 4)
            DUPRUN(3, ph_rwkv_prep(k, l, TA, INP(I_MU), INP(I_KK), INP(I_RK)));
            DUPRUN(4, ph_gla_prep(k, l, INP(I_GCONV), INP(I_GAW2), INP(I_GAB)));
        PH_END(pb + 2)
        PH_BEGIN(pb + 3, 5)
            pg8::Gemm g{(const bf16*)(ws + RW_A1), (const bf16*)(ws + WT_L1), TA, 4096, 256, 0}; pg8::StaticOrder S; S.init(TA, 4096, k.G, k.bid);
            pg8::Epi8<FL1_> E{FL1_{(bf16*)(ws + RW_LO), (const float*)(ws + WS_TAB + TAB_TOP)}};
            DUPRUN(5, (pg8::gemm_phase<pg8::Epi8<FL1_>, pg8::StaticOrder, GA_, GS_>(glds, g, S, E)));
        PH_END(pb + 3)
        PH_BEGIN(pb + 4, 6)
#if SPLIT_SCAN
            DUPRUN(6, ph_scan_split(k, l, INP(I_KA)));
#else
            for (int vb = ((k.G & 7) ? k.bid : (k.bid & 7) * (k.G >> 3) + (k.bid >> 3)); vb < 256; vb += k.G) { const int job = vb;
#if RWKV_MODE == 0
                DUPRUN(6, ph_rwkv_scan(k, l, job, INP(I_KA)));
#elif RWKV_MODE == 1
                ph_rwkv_scan(k, l, job, INP(I_KA)); ph_rwkv_chunk(k, l, job, INP(I_KA), WS_H); if (l == 0) rwkv_check_delay(k, job);
#elif RWKV_MODE == 4
                ph_rwkv_scan(k, l, job, INP(I_KA)); ph_rwkv_chunk(k, l, job, INP(I_KA), WS_H); ph_rwkv_chunk(k, l, job, INP(I_KA), WS_END); if (l == 0) rwkv_check_delay(k, job, WS_END);
#elif RWKV_MODE == 5
#pragma unroll 1
                for (int rep = 0; rep < 2; ++rep) { int r_ = rep; asm volatile("" : "+s"(r_)); __syncthreads(); ph_rwkv_chunk(k, l, job, INP(I_KA), r_ ? (size_t)RW_Y : (size_t)WS_H); }
                if (l == 0) rwkv_check_delay(k, job);
#elif RWKV_MODE == 3
                ph_rwkv_scan(k, l, job, INP(I_KA)); ph_rwkv_scan(k, l, job, INP(I_KA), WS_H); if (l == 0) rwkv_check_delay(k, job);
#else
                DUPRUN(6, ph_rwkv_chunk(k, l, job, INP(I_KA)));
#ifdef CHUNK_PROBE
                __syncthreads(); ph_rwkv_chunk<CHUNK_PROBE>(k, l, job, INP(I_KA), WS_END);
#endif
#endif
            }
#ifndef NO_GLA
            FRESH();
            for (int vb = ((k.G & 7) ? k.bid : (k.bid & 7) * (k.G >> 3) + (k.bid >> 3)); vb < 256; vb += k.G) { const int job = vb; DUPRUN(7, ph_gla_scan(k, job)); }
#endif
#endif
        PH_END(pb + 4)
        PH_BEGIN(pb + 5, 7)
            DUPRUN(8, ph_post(k, l, Mpost, INP(I_LNG), INP(I_LNB), INP(I_GNG)));
        PH_END(pb + 5)
        PH_BEGIN(pb + 6, 8)
            pg8::Gemm g{(const bf16*)(ws + RW_A2), (const bf16*)(ws + WT_G2), Mpost, RD, 256, 0}; pg8::StaticOrder S; S.init(Mpost, RD, k.G, k.bid);
            pg8::Epi8<FL2_> E{FL2_{(const bf16*)(ws + RW_R), (bf16*)(ws + RW_V)}};
            DUPRUN(9, (pg8::gemm_phase<pg8::Epi8<FL2_>, pg8::StaticOrder, GA_, GS_>(glds, g, S, E)));
        PH_END(pb + 6)
        PH_BEGIN(pb + 7, 9)
            pg8::Gemm g{(const bf16*)(ws + RW_V), (const bf16*)(ws + WT_A), Mpost, DM, RD, 0}; pg8::StaticOrder S; S.init(Mpost, DM, k.G, k.bid);
            pg8::Epi8<FM_<0>> E{FM_<0>{(const bf16*)(ws + WS_P), (bf16*)(ws + WS_H), (bf16*)(ws + WS_H)}};
            DUPRUN(10, (pg8::gemm_phase<pg8::Epi8<FM_<0>>, pg8::StaticOrder, GA_, GS_>(glds, g, S, E)));
        PH_END(pb + 7)
        PH_BEGIN(pb + 8, 10)
            pg8::Gemm g{(const bf16*)(ws + GL_VS), (const bf16*)(ws + WT_B), Mpost, DM, GVD, 0}; pg8::StaticOrder S; S.init(Mpost, DM, k.G, k.bid);
            pg8::Epi8<FM_<1>> E{FM_<1>{(const bf16*)(ws + WS_P), (bf16*)(ws + WS_H), (bf16*)(ws + WS_H)}};
            pg8::gemm_phase<pg8::Epi8<FM_<1>>, pg8::StaticOrder, GA_, GS_>(glds, g, S, E);
            if ((DUP_MASK >> 17) & 1u) { __syncthreads(); pg8::Epi8<FM_<1>> E2{FM_<1>{(const bf16*)(ws + WS_P), (bf16*)(ws + WS_H), (bf16*)(ws + RW_R)}}; pg8::gemm_phase<pg8::Epi8<FM_<1>>, pg8::StaticOrder, GA_, GS_>(glds, g, S, E2); }
        PH_END(pb + 8)
        PH_BEGIN(pb + 9, 11)
            pg8::Gemm g{(const bf16*)(ws + WS_H), (const bf16*)(ws + WT_O), Mpost, DM, DM, 0}; pg8::StaticOrder S; S.init(Mpost, DM, k.G, k.bid);
#if XBF
            pg8::Epi8<FXb_> E{FXb_{(bf16*)(ws + WS_X), (const float*)(ws + WS_MOD), l}};
            pg8::gemm_phase<pg8::Epi8<FXb_>, pg8::StaticOrder, GA_, GS_>(glds, g, S, E);
#else
            pg8::Epi4<FX_> E{FX_{(float*)(ws + WS_X), (const float*)(ws + WS_MOD), l, (float*)(ws + WS_X)}};
            pg8::gemm_phase<pg8::Epi4<FX_>, pg8::StaticOrder, GA_, GS_>(glds, g, S, E);
#endif
            if (!XBF && ((DUP_MASK >> 18) & 1u)) { __syncthreads(); pg8::Epi4<FX_> E2{FX_{(float*)(ws + WS_X), (const float*)(ws + WS_MOD), l, (float*)(ws + WS_P)}}; pg8::gemm_phase<pg8::Epi4<FX_>, pg8::StaticOrder, GA_, GS_>(glds, g, S, E2); }
        PH_END(pb + 9)
        PH_BEGIN(pb + 10, 12)
            RowArgs ra{nullptr, nullptr, INP(I_NFG), INP(I_RW), INP(I_RB), nullptr};
            ph_rows<1>(k, ra, l, Mpost);
            if ((DUP_MASK >> 16) & 1u) { __syncthreads(); ph_rows<1>(k, ra, l, Mpost, true); }
        PH_END(pb + 10)
        PH_BEGIN(pb + 11, 13)
            DUPRUN(13, ph_moe_scatter(k, l, Mpost));
        PH_END(pb + 11)
        PH_BEGIN(pb + 12, 14)
#if MOE_GATHER
            pg8::Gemm g{(const bf16*)(ws + WS_H), (const bf16*)(ws + WT_GU), 0, 2816, DM, (size_t)2816 * DM * 2};
            pg8::MoeOrderT<true> S; S.rowtok = (const int*)(ws + WS_TAB + TAB_ROWTOK) + (size_t)l * MOE_ROWS;
            S.init((const int*)(ws + WS_TAB + TAB_TILE) + 256 * l, 11, k.G, ((k.G & 7) ? k.bid : (k.bid & 7) * (k.G >> 3) + (k.bid >> 3)));
            pg8::EpiGU<FE1_> E{FE1_{(bf16*)(ws + WS_ACT)}};
            DUPRUN(11, (pg8::gemm_phase<pg8::EpiGU<FE1_>, pg8::MoeOrderT<true>, GA_, GS_>(glds, g, S, E)));
#else
            pg8::Gemm g{(const bf16*)(ws + WS_HP), (const bf16*)(ws + WT_GU), 0, 2816, DM, (size_t)2816 * DM * 2};
            pg8::MoeOrder S; S.init((const int*)(ws + WS_TAB + TAB_TILE) + 256 * l, 11, k.G, ((k.G & 7) ? k.bid : (k.bid & 7) * (k.G >> 3) + (k.bid >> 3)));
            pg8::EpiGU<FE1_> E{FE1_{(bf16*)(ws + WS_ACT)}};
            DUPRUN(11, (pg8::gemm_phase<pg8::EpiGU<FE1_>, pg8::MoeOrder, GA_, GS_>(glds, g, S, E)));
#endif
        PH_END(pb + 12)
        PH_BEGIN(pb + 13, 15)
            pg8::Gemm g{(const bf16*)(ws + WS_ACT), (const bf16*)(ws + WT_D), 0, DM, DEXP, (size_t)DM * DEXP * 2};
            pg8::MoeOrder S; S.init((const int*)(ws + WS_TAB + TAB_TILE) + 256 * l, 8, k.G, ((k.G & 7) ? k.bid : (k.bid & 7) * (k.G >> 3) + (k.bid >> 3)));
            pg8::Epi8<FE2_> E{FE2_{(const int*)(ws + WS_TAB + TAB_ROWTOK) + (size_t)l * MOE_ROWS, (const float*)(ws + WS_TAB + TAB_ROWW) + (size_t)l * MOE_ROWS, (bf16*)(ws + WS_YF)}};
            DUPRUN(12, (pg8::gemm_phase<pg8::Epi8<FE2_>, pg8::MoeOrder, GA_, GS_>(glds, g, S, E)));
        PH_END(pb + 13)
        }
#undef L_
#if EXTRA_BARS
    if (hi - lo > 1) { for (int i = 0; i < EXTRA_BARS; ++i) xcd_barrier(bar); }
#endif
    PH_BEGIN(NPHASE - 1, 16)
        RowArgs ra{nullptr, nullptr, INP(I_FNG), nullptr, nullptr, (float*)INP(N_IN)};
        DUPRUN(14, ph_rows<2>(k, ra, 0, TL));
    PH_END(NPHASE - 1)
}

#ifndef MK_SINGLE
#define MK_SINGLE 1
#endif
extern "C" void kernel_launch(void* const* d_in, const int* in_sizes, int n_in, void* d_out, int out_size, void* d_ws, size_t ws_size, hipStream_t stream) {
    static int grid = 0;
    if (grid == 0) {
        if (n_in != N_IN || out_size != TL * DM || ws_size < WS_END) { fprintf(stderr, "kernel_launch: unexpected problem (n_in %d out %d ws %zu need %zu)\n", n_in, out_size, ws_size, (size_t)WS_END); grid = -1; return; }
        int dev = 0, cus = 0;
        if (hipGetDevice(&dev) != hipSuccess || hipDeviceGetAttribute(&cus, hipDeviceAttributeMultiprocessorCount, dev) != hipSuccess) { grid = -1; return; }
        if (hipFuncSetAttribute((const void*)fwd, hipFuncAttributeMaxDynamicSharedMemorySize, LDS_BYTES) != hipSuccess) { grid = -1; return; }
        int per_cu = 0;
        if (hipOccupancyMaxActiveBlocksPerMultiprocessor(&per_cu, (const void*)fwd, 512, LDS_BYTES) != hipSuccess || per_cu < 1) fprintf(stderr, "kernel_launch: occupancy query says %d\n", per_cu);
        (void)hipGetLastError();
        grid = cus;
    }
    if (grid < 0) return;
    unsigned char* ws = (unsigned char*)d_ws;
    (void)hipMemsetAsync(ws + WS_CTL, 0, CTL_BYTES, stream);
    Args a{};
    for (int i = 0; i < N_IN; ++i) a.in[i] = (const float*)d_in[i];
    a.out = (float*)d_out; a.ws = ws;
#if MK_SINGLE
    a.ph_lo = 0; a.ph_hi = NPHASE;
    hipLaunchKernelGGL(fwd, dim3(grid), dim3(512), LDS_BYTES, stream, a);
#else
    for (int p = 0; p < NPHASE; ++p) { a.ph_lo = p; a.ph_hi = p + 1; hipLaunchKernelGGL(fwd, dim3(grid), dim3(512), LDS_BYTES, stream, a); }
#endif
}
```

```cpp
#include <hip/hip_runtime.h>
#include <cstdio>
#include <cstdint>

#define LAS __attribute__((address_space(3)))
#define GAS __attribute__((address_space(1)))
typedef unsigned short bf16;
typedef float f32x4 __attribute__((ext_vector_type(4)));
typedef float f32x2 __attribute__((ext_vector_type(2)));
typedef unsigned u32x4 __attribute__((ext_vector_type(4)));
typedef unsigned u32x2 __attribute__((ext_vector_type(2)));
typedef short bf16x8 __attribute__((ext_vector_type(8)));

constexpr int DM = 2048, NBATCH = 8, SEQ = 2048, CTXL = 256, DEPTH = 2;
constexpr int TL = NBATCH * SEQ, TC = NBATCH * CTXL, TA = TL + TC;
constexpr int RD = 1024, RHEADS = 16, RHS = 64;
constexpr int RWKV_IN = 3520;
constexpr int GKD = 512, GVD = 1024, GDK = 128, GDV = 256, GHEADS = 4, GQKV = 2048;
constexpr int GLA_OFF = 3520, GLA_AD_OFF = GLA_OFF + GQKV, GLA_GATE_OFF = 5584, BR_OFF = 6608, IN_DIM = 10704, NP = 10752;
constexpr int NEXP = 16, DEXP = 1408;
constexpr int MOD_N = 6 * DM;
constexpr int MOE_ROWS = 41216;
constexpr int MOE_TILES = MOE_ROWS / 256;
constexpr int NCH = 36;
constexpr int KSPLIT = 32;

enum { I_X = 0, I_C, I_CTX, I_CCTX, I_WADA, I_BADA, I_NMG, I_NFG, I_WIN, I_MU, I_W0, I_W2, I_A0, I_A2, I_G2, I_KK, I_KA, I_RK, I_LNG, I_LNB,
       I_GCONV, I_GAW2, I_GAB, I_GNG, I_WBA, I_WBB, I_WOUT, I_RW, I_RB, I_EG, I_EU, I_ED, I_FNG, N_IN };

constexpr size_t MiB = 1u << 20;
constexpr size_t WS_CTL = 0;
constexpr size_t WS_TAB = 1 * MiB;
constexpr size_t WS_MOD = 2 * MiB;
constexpr size_t WS_X = 3 * MiB;
constexpr size_t WS_H = WS_X + 144 * MiB;
constexpr size_t WS_P = WS_H + 72 * MiB;
constexpr size_t WS_RW = WS_P + 378 * MiB;
constexpr size_t WS_GL = WS_RW + 380 * MiB;
constexpr size_t WS_WT = WS_GL + 218 * MiB;
constexpr size_t WS_END = WS_WT + 325 * MiB;
constexpr int CW_TMO = 0, CW_CNT = 64  , CW_BAR = 4096;
constexpr size_t CTL_BYTES = 1 * MiB;
constexpr size_t TAB_ROWTOK = 0;
constexpr size_t TAB_ROWTOK_BYTES = 2 * (size_t)MOE_ROWS * 4;
constexpr size_t TAB_ROWW = 384 * 1024;
constexpr size_t TAB_TILE = 768 * 1024;
constexpr size_t TAB_TOP = 800 * 1024;
static_assert(TAB_ROWTOK_BYTES <= TAB_ROWW && TAB_ROWW + 2 * (size_t)MOE_ROWS * 4 <= TAB_TILE, "tab map");
constexpr size_t WS_MODP = WS_P;
constexpr size_t WS_HP = WS_P;
constexpr size_t WS_ACT = WS_P + 162 * MiB;
constexpr size_t WS_TOPK = WS_P + 274 * MiB;
static_assert((size_t)MOE_ROWS * DM * 2 <= 162 * MiB && (size_t)MOE_ROWS * DEXP * 2 <= 112 * MiB && 274 * MiB + 3 * (size_t)TA * 8 <= 378 * MiB, "P overlay");
constexpr size_t RW_R = WS_RW;
constexpr size_t RW_KS = RW_R + 36 * MiB;
constexpr size_t RW_V = RW_KS + 36 * MiB;
constexpr size_t RW_KK = RW_V + 36 * MiB;
constexpr size_t RW_LO = RW_KK + 36 * MiB;
constexpr size_t RW_Y = RW_LO + 144 * MiB;
constexpr size_t RW_A1 = RW_Y + 72 * MiB;
constexpr size_t RW_A2 = RW_A1 + 9 * MiB;
constexpr size_t RW_BON = RW_A2 + 9 * MiB;
static_assert(RW_BON + 2 * MiB <= WS_GL, "rwkv map");
constexpr size_t GL_QG = WS_GL;
constexpr size_t GL_KG = GL_QG + 36 * MiB;
constexpr size_t GL_KE = GL_KG + 36 * MiB;
constexpr size_t GL_VS = GL_KE + 36 * MiB;
constexpr size_t GL_O = GL_VS + 36 * MiB;
constexpr size_t GL_DEC = GL_O + 72 * MiB;
static_assert(GL_DEC + 2 * MiB <= WS_WT, "gla map");
constexpr size_t WS_YF = WS_GL;
constexpr size_t WT_IN = WS_WT;
constexpr size_t WT_L1 = WT_IN + 42 * MiB;
constexpr size_t WT_G2 = WT_L1 + 2 * MiB;
constexpr size_t WT_A = WT_G2 + 1 * MiB;
constexpr size_t WT_B = WT_A + 4 * MiB;
constexpr size_t WT_O = WT_B + 4 * MiB;
constexpr size_t WT_GU = WT_O + 8 * MiB;
constexpr size_t WT_D = WT_GU + 176 * MiB;
static_assert(WT_D + 88 * MiB == WS_END, "weight map");

#ifndef PREP_WINDOW
#define PREP_WINDOW 1
#endif
#ifndef GLA_TP
#define GLA_TP 0
#endif
#ifndef GLA_TPW
#define GLA_TPW 0
#endif
#ifndef GLA_PF2
#define GLA_PF2 0
#endif
#ifndef MOE_GATHER
#define MOE_GATHER 1
#endif
#ifndef XBF
#define XBF 1
#endif
__device__ __forceinline__ float bf2f(unsigned v) { return __uint_as_float(v << 16); }
__device__ __forceinline__ float bflo(unsigned w) { return __uint_as_float(w << 16); }
__device__ __forceinline__ float bfhi(unsigned w) { return __uint_as_float(w & 0xffff0000u); }
__device__ __forceinline__ unsigned f2bf(float f) { unsigned u = __float_as_uint(f); return (u + 0x7fffu + ((u >> 16) & 1u)) >> 16; }
__device__ __forceinline__ unsigned pk2(float lo, float hi) { unsigned r; asm volatile("v_cvt_pk_bf16_f32 %0, %1, %2" : "=v"(r) : "v"(lo), "v"(hi)); return r; }
typedef __bf16 bf16x2_t __attribute__((ext_vector_type(2)));
__device__ __forceinline__ unsigned pk2c(float lo, float hi) { f32x2 v = {lo, hi}; bf16x2_t b = __builtin_convertvector(v, bf16x2_t); return __builtin_bit_cast(unsigned, b); }
__device__ __forceinline__ float sigm(float x) { return 1.0f / (1.0f + __expf(-x)); }
__device__ __forceinline__ float siluf(float x) { return x * sigm(x); }
__device__ __forceinline__ float wave_sum(float x) {
    x += __builtin_bit_cast(float, __builtin_amdgcn_update_dpp(0, __builtin_bit_cast(int, x), 0xB1, 0xF, 0xF, true));
    x += __builtin_bit_cast(float, __builtin_amdgcn_update_dpp(0, __builtin_bit_cast(int, x), 0x4E, 0xF, 0xF, true));
    x += __builtin_bit_cast(float, __builtin_amdgcn_update_dpp(0, __builtin_bit_cast(int, x), 0x141, 0xF, 0xF, true));
    x += __builtin_bit_cast(float, __builtin_amdgcn_update_dpp(0, __builtin_bit_cast(int, x), 0x140, 0xF, 0xF, true));
    const int xi = __builtin_bit_cast(int, x);
    return (__builtin_bit_cast(float, __builtin_amdgcn_readlane(xi, 0)) + __builtin_bit_cast(float, __builtin_amdgcn_readlane(xi, 16))) +
           (__builtin_bit_cast(float, __builtin_amdgcn_readlane(xi, 32)) + __builtin_bit_cast(float, __builtin_amdgcn_readlane(xi, 48)));
}
__device__ __forceinline__ void unpack8(const u32x4 w, float (&o)[8]) {
    o[0] = bflo(w.x); o[1] = bfhi(w.x); o[2] = bflo(w.y); o[3] = bfhi(w.y); o[4] = bflo(w.z); o[5] = bfhi(w.z); o[6] = bflo(w.w); o[7] = bfhi(w.w);
}
__device__ __forceinline__ u32x4 pack8(const float (&v)[8]) { u32x4 w; w.x = pk2(v[0], v[1]); w.y = pk2(v[2], v[3]); w.z = pk2(v[4], v[5]); w.w = pk2(v[6], v[7]); return w; }
namespace pg8 {
#define PG8_LAS __attribute__((address_space(3)))
typedef unsigned short bf16_t;
typedef short bf16x8 __attribute__((ext_vector_type(8)));
typedef float f32x4 __attribute__((ext_vector_type(4)));
typedef unsigned u32x4 __attribute__((ext_vector_type(4)));
constexpr int BM = 256, BK = 64, HALF = 128, HTB = HALF * BK * 2  , STAGE_BYTES = 8 * HTB, NXCD = 8, WGM = 8;

__host__ __device__ __forceinline__ int lds_byte(int r, int c) { const int st = (r >> 4) * 2 + (c >> 5), rr = r & 15, cc = c & 31, ob = rr * 64 + cc * 2; return st * 1024 + (ob ^ (((ob >> 9) & 1) << 5)); }
__host__ __device__ __forceinline__ void stage_rc(int b, int& R, int& C) { const int st = b / 1024, sb = b % 1024, swz = sb ^ (((sb >> 9) & 1) << 5); R = (st >> 1) * 16 + swz / 64; C = (st & 1) * 32 + (swz % 64) / 2; }
__host__ __device__ __forceinline__ int perm32(int rho) { const int n = rho >> 4, i = rho & 15; return 8 * (i >> 2) + 4 * n + (i & 3); }
struct Unit { int pm, pn, eb; };
struct Gemm { const bf16_t* A; const bf16_t* Bt; int M, N, K; size_t bstride; };

struct StaticOrder {
    static constexpr bool GATHER = false;
    int nM, nN, nwg, G, c;
    __host__ __device__ void init(int M, int N, int G_, int c_) { nM = M / BM; nN = N / BM; nwg = nM * nN; G = G_; c = c_; }
    __host__ __device__ bool next(int i, Unit& u) const {
        const long L = (long)i * G + c; if (L >= nwg) return false;
        int wgid = (int)L; { const int q = nwg / NXCD, r = nwg % NXCD, xcd = wgid % NXCD, off = wgid / NXCD; wgid = (xcd < r ? xcd * (q + 1) : r * (q + 1) + (xcd - r) * q) + off; }
        const int nig = WGM * nN, gid = wgid / nig, fm = gid * WGM, gsz = (nM - fm) < WGM ? (nM - fm) : WGM;
        u.pm = fm + ((wgid % nig) % gsz); u.pn = (wgid % nig) / gsz; u.eb = 0; return true;
    }
    __device__ __forceinline__ void a_ready(const Unit&) const {}
    __device__ __forceinline__ void done(const Unit&) const {}
};
template <bool GATHER_> struct MoeOrderT {
    static constexpr bool GATHER = GATHER_;
    const int* rowtok;
    const int* tab; int nT, nN, G, c;
    __device__ void init(const int* tab_, int nN_, int G_, int c_) { tab = tab_; nT = tab_[0]; nN = nN_; G = G_; c = c_; }
    __device__ bool next(int i, Unit& u) const {
        const long L = (long)i * G + c; if (L >= (long)nT * nN) return false;
        u.pm = (int)(L / nN); u.pn = (int)(L % nN); u.eb = tab[1 + u.pm]; return true;
    }
    __device__ __forceinline__ void a_ready(const Unit&) const {}
    __device__ __forceinline__ void done(const Unit&) const {}
};
using MoeOrder = MoeOrderT<false>;

template <class F> struct Epi8 {
    static constexpr bool PERM = true, AFTER_DRAIN = false;
    F f;
    __device__ __forceinline__ void operator()(const f32x4 (&acc)[2][2][4][2], const Unit& u, int wr, int wc, int fr, int fq) const {
        const int row0 = u.pm * BM + wr * 64 + fr, col0 = u.pn * BM + wc * 32 + 8 * fq;
#pragma unroll
        for (int ai = 0; ai < 2; ++ai)
#pragma unroll
            for (int m = 0; m < 4; ++m) {
#pragma unroll
                for (int bj = 0; bj < 2; ++bj) {
                    const f32x4 a = acc[ai][bj][m][0], b = acc[ai][bj][m][1];
                    float v[8] = {a[0], a[1], a[2], a[3], b[0], b[1], b[2], b[3]};
                    f(row0 + ai * HALF + m * 16, col0 + bj * HALF, v, u);
                }
            }
    }
};
template <class F> struct EpiGU {
    static constexpr bool PERM = true, AFTER_DRAIN = false;
    F f;
    __device__ __forceinline__ void operator()(const f32x4 (&acc)[2][2][4][2], const Unit& u, int wr, int wc, int fr, int fq) const {
        const int row0 = u.pm * BM + wr * 64 + fr, col0 = u.pn * HALF + wc * 32 + 8 * fq;
#pragma unroll
        for (int ai = 0; ai < 2; ++ai)
#pragma unroll
            for (int m = 0; m < 4; ++m) {
                const f32x4 g0 = acc[ai][0][m][0], g1 = acc[ai][0][m][1], u0 = acc[ai][1][m][0], u1 = acc[ai][1][m][1];
                float g[8] = {g0[0], g0[1], g0[2], g0[3], g1[0], g1[1], g1[2], g1[3]};
                float up[8] = {u0[0], u0[1], u0[2], u0[3], u1[0], u1[1], u1[2], u1[3]};
                f(row0 + ai * HALF + m * 16, col0, g, up);
            }
    }
};
template <class F> struct Epi4 {
    static constexpr bool PERM = false, AFTER_DRAIN = false;
    F f;
    __device__ __forceinline__ void operator()(const f32x4 (&acc)[2][2][4][2], const Unit& u, int wr, int wc, int fr, int fq) const {
        const int row0 = u.pm * BM + wr * 64 + fr, col0 = u.pn * BM + wc * 32 + 4 * fq;
#pragma unroll
        for (int ai = 0; ai < 2; ++ai)
#pragma unroll
            for (int m = 0; m < 4; ++m) {
#pragma unroll
                for (int bj = 0; bj < 2; ++bj)
#pragma unroll
                    for (int n = 0; n < 2; ++n) f(row0 + ai * HALF + m * 16, col0 + bj * HALF + n * 16, acc[ai][bj][m][n], u);
            }
    }
};
template <class Epi, class Sched, bool ALIGN_EPI = false, bool SP2 = false>
__device__ __forceinline__ void gemm_phase(PG8_LAS unsigned char* lds, const Gemm g, const Sched& S, const Epi& E) {
    int tid_o = threadIdx.x; asm volatile("" : "+v"(tid_o));
    const int tid = tid_o, wid = __builtin_amdgcn_readfirstlane(tid >> 6), lane = tid & 63, wr = wid >> 2, wc = wid & 3, fr = lane & 15, fq = lane >> 4;
    const int K = g.K, nt = K / BK;
    unsigned voffA[2], voffB[2];
#pragma unroll
    for (int i = 0; i < 2; ++i) { int R, C; stage_rc(tid * 16 + i * 8192, R, C); const int Rb = Epi::PERM ? ((R & ~31) + perm32(R & 31)) : R;
        voffA[i] = (unsigned)(R * K + C) * 2u; voffB[i] = (unsigned)(Rb * K + C) * 2u; }
    constexpr bool GATHER = Sched::GATHER;
    unsigned vA0[2] = {0u, 0u}, vA1[2] = {0u, 0u}, nA0[2] = {0u, 0u}, nA1[2] = {0u, 0u};
    const size_t kstep = (size_t)(BK * 2);
    const size_t hstep = (size_t)HALF * K * 2;
    const size_t tstep = 2 * hstep;
    const unsigned ldsw = (unsigned)wid * 1024u;
    const int aoff = lds_byte(wr * 64 + fr, fq * 8), boff = lds_byte(wc * 32 + fr, fq * 8);
#define PG8_SA(b, h) (((b) * 2 + (h)) * HTB)
#define PG8_SB(b, h) ((4 + (b) * 2 + (h)) * HTB)
#define PG8_STAGE(bufoff, gbase, voff) do { _Pragma("unroll") for (int _i = 0; _i < 2; ++_i) \
        __builtin_amdgcn_global_load_lds((const unsigned*)((const char*)(gbase) + (voff)[_i]), (PG8_LAS unsigned*)(lds + (bufoff) + ldsw + _i * 8192), 16, 0, 0); } while (0)
#define PG8_STAGE_A(bufoff, gptr, h, nx) do { if constexpr (GATHER) { unsigned go_[2]; _Pragma("unroll") for (int _j = 0; _j < 2; ++_j) go_[_j] = ((nx) && last_) ? ((h) ? nA1[_j] : nA0[_j]) : ((h) ? vA1[_j] : vA0[_j]); PG8_STAGE(bufoff, gptr, go_); } \
        else { PG8_STAGE(bufoff, (gptr) + (h) * hstep, voffA); } } while (0)
#define PG8_GOFS(u, o0, o1) do { const int* rt_ = S.rowtok + (size_t)(u).pm * BM; _Pragma("unroll") for (int _j = 0; _j < 2; ++_j) { int R_, C_; stage_rc(tid * 16 + _j * 8192, R_, C_); \
        const int t0_ = rt_[R_], t1_ = rt_[HALF + R_]; o0[_j] = (unsigned)((t0_ < 0 ? 0 : t0_ >> 1) * K + C_) * 2u; o1[_j] = (unsigned)((t1_ < 0 ? 0 : t1_ >> 1) * K + C_) * 2u; } } while (0)
#define PG8_LDA(dst, b, h) do { _Pragma("unroll") for (int m = 0; m < 4; ++m) _Pragma("unroll") for (int k = 0; k < 2; ++k) dst[m][k] = *(const PG8_LAS bf16x8*)(lds + PG8_SA(b, h) + aoff + m * 2048 + k * 1024); } while (0)
#define PG8_LDB(dst, b, h) do { _Pragma("unroll") for (int n = 0; n < 2; ++n) _Pragma("unroll") for (int k = 0; k < 2; ++k) dst[n][k] = *(const PG8_LAS bf16x8*)(lds + PG8_SB(b, h) + boff + n * 2048 + k * 1024); } while (0)
#define PG8_MMA(ai, bj, At, Bt) do { __builtin_amdgcn_s_setprio(1); _Pragma("unroll") for (int m = 0; m < 4; ++m) _Pragma("unroll") for (int n = 0; n < 2; ++n) _Pragma("unroll") for (int k = 0; k < 2; ++k) \
        acc[ai][bj][m][n] = __builtin_amdgcn_mfma_f32_16x16x32_bf16(Bt[n][k], At[m][k], acc[ai][bj][m][n], 0, 0, 0); __builtin_amdgcn_s_setprio(0); } while (0)
#define PG8_WAIT_V(n) asm volatile("s_waitcnt vmcnt(" #n ")" ::: "memory")
#define PG8_WAIT_L(n) asm volatile("s_waitcnt lgkmcnt(" #n ")" ::: "memory")
#define PG8_BAR __builtin_amdgcn_s_barrier()
#define PG8_SCHED __builtin_amdgcn_sched_barrier(0)
    Unit cur, nxt; int ui = 0;
    if (!S.next(0, cur)) return;
    f32x4 acc[2][2][4][2];
#pragma unroll
    for (int a = 0; a < 2; ++a)
#pragma unroll
        for (int b = 0; b < 2; ++b)
#pragma unroll
            for (int m = 0; m < 4; ++m)
#pragma unroll
                for (int n = 0; n < 2; ++n) acc[a][b][m][n] = (f32x4){0.f, 0.f, 0.f, 0.f};
    bf16x8 At[4][2], B0[2][2], B1[2][2];
    const char* cA = GATHER ? (const char*)g.A : (const char*)g.A + (size_t)cur.pm * tstep; const char* cB = (const char*)g.Bt + (size_t)cur.eb * g.bstride + (size_t)cur.pn * tstep;
    S.a_ready(cur);
    if constexpr (GATHER) PG8_GOFS(cur, vA0, vA1);
    constexpr bool last_ = false;
    if constexpr (SP2) {
        PG8_STAGE(PG8_SB(0, 0), cB, voffB); PG8_STAGE(PG8_SB(0, 1), cB + hstep, voffB); PG8_STAGE_A(PG8_SA(0, 0), cA, 0, 0); PG8_STAGE_A(PG8_SA(0, 1), cA, 1, 0);
        if (wr == 1) PG8_BAR;
        PG8_WAIT_V(2); PG8_BAR;
        PG8_STAGE(PG8_SB(1, 0), cB + kstep, voffB); PG8_STAGE_A(PG8_SA(1, 0), cA + kstep, 0, 0); PG8_STAGE(PG8_SB(1, 1), cB + hstep + kstep, voffB);
        PG8_WAIT_V(6); PG8_BAR;
    } else {
        PG8_STAGE(PG8_SB(0, 0), cB, voffB); PG8_STAGE_A(PG8_SA(0, 0), cA, 0, 0); PG8_STAGE(PG8_SB(0, 1), cB + hstep, voffB); PG8_STAGE_A(PG8_SA(0, 1), cA, 1, 0);
        if (wr == 1) PG8_BAR;
        PG8_WAIT_V(4); PG8_BAR;
        PG8_STAGE(PG8_SB(1, 0), cB + kstep, voffB); PG8_STAGE_A(PG8_SA(1, 0), cA + kstep, 0, 0); PG8_STAGE(PG8_SB(1, 1), cB + hstep + kstep, voffB);
        PG8_WAIT_V(6); PG8_BAR;
    }
    for (;;) {
        const bool has_next = S.next(ui + 1, nxt);
        const char* nA = (has_next && !GATHER) ? (const char*)g.A + (size_t)nxt.pm * tstep : cA;
        if constexpr (GATHER) { if (has_next) PG8_GOFS(nxt, nA0, nA1); else { _Pragma("unroll") for (int _j = 0; _j < 2; ++_j) { nA0[_j] = vA0[_j]; nA1[_j] = vA1[_j]; } } } const char* nB = has_next ? (const char*)g.Bt + (size_t)nxt.eb * g.bstride + (size_t)nxt.pn * tstep : cB;
#pragma nounroll
        for (int t = 0; t < nt; t += 2) {
            const bool last = (t == nt - 2); const bool last_ = last;
            const char* a1 = cA + (size_t)(t + 1) * kstep;
            const char* a2 = last ? nA : cA + (size_t)(t + 2) * kstep; const char* b2 = last ? nB : cB + (size_t)(t + 2) * kstep;
            const char* a3 = a2 + kstep; const char* b3 = b2 + kstep;
            if (last && has_next) S.a_ready(nxt);
            if constexpr (SP2) {
            PG8_LDB(B0, 0, 0); PG8_LDB(B1, 0, 1); PG8_SCHED; PG8_LDA(At, 0, 0); PG8_STAGE_A(PG8_SA(1, 1), a1, 1, 0);
            PG8_WAIT_V(8); PG8_WAIT_L(0); PG8_BAR; PG8_MMA(0, 0, At, B0); PG8_MMA(0, 1, At, B1); PG8_BAR; PG8_SCHED;
            PG8_LDA(At, 0, 1); PG8_STAGE(PG8_SB(0, 0), b2, voffB); PG8_STAGE(PG8_SB(0, 1), b2 + hstep, voffB); PG8_STAGE_A(PG8_SA(0, 0), a2, 0, 1);
            PG8_WAIT_V(8); PG8_WAIT_L(0); PG8_BAR; PG8_MMA(1, 0, At, B0); PG8_MMA(1, 1, At, B1); PG8_BAR; PG8_SCHED;
            PG8_LDB(B0, 1, 0); PG8_LDB(B1, 1, 1); PG8_SCHED; PG8_LDA(At, 1, 0); PG8_STAGE_A(PG8_SA(0, 1), a2, 1, 1);
            PG8_WAIT_V(8); PG8_WAIT_L(0); PG8_BAR; PG8_MMA(0, 0, At, B0); PG8_MMA(0, 1, At, B1); PG8_BAR; PG8_SCHED;
            PG8_LDA(At, 1, 1); PG8_STAGE(PG8_SB(1, 0), b3, voffB); PG8_STAGE(PG8_SB(1, 1), b3 + hstep, voffB); PG8_STAGE_A(PG8_SA(1, 0), a3, 0, 1);
            PG8_WAIT_V(8); PG8_WAIT_L(0); PG8_BAR; PG8_MMA(1, 0, At, B0); PG8_MMA(1, 1, At, B1); PG8_BAR; PG8_SCHED;
            } else {
            PG8_LDB(B0, 0, 0); PG8_SCHED; PG8_LDA(At, 0, 0); PG8_STAGE_A(PG8_SA(1, 1), a1, 1, 0);
            PG8_WAIT_L(8); PG8_BAR; PG8_WAIT_L(0); PG8_MMA(0, 0, At, B0); PG8_BAR; PG8_SCHED;
            PG8_LDB(B1, 0, 1); PG8_STAGE(PG8_SB(0, 0), b2, voffB);
            PG8_BAR; PG8_WAIT_L(0); PG8_MMA(0, 1, At, B1); PG8_BAR;
            PG8_LDA(At, 0, 1); PG8_STAGE_A(PG8_SA(0, 0), a2, 0, 1);
            PG8_BAR; PG8_WAIT_L(0); PG8_MMA(1, 0, At, B0); PG8_BAR; PG8_SCHED;
            PG8_STAGE(PG8_SB(0, 1), b2 + hstep, voffB);
            PG8_WAIT_V(6); PG8_BAR; PG8_MMA(1, 1, At, B1); PG8_BAR;
            PG8_LDB(B0, 1, 0); PG8_SCHED; PG8_LDA(At, 1, 0); PG8_STAGE_A(PG8_SA(0, 1), a2, 1, 1);
            PG8_WAIT_L(8); PG8_BAR; PG8_WAIT_L(0); PG8_MMA(0, 0, At, B0); PG8_BAR; PG8_SCHED;
            PG8_LDB(B1, 1, 1); PG8_STAGE(PG8_SB(1, 0), b3, voffB);
            PG8_BAR; PG8_WAIT_L(0); PG8_MMA(0, 1, At, B1); PG8_BAR;
            PG8_LDA(At, 1, 1); PG8_STAGE_A(PG8_SA(1, 0), a3, 0, 1);
            PG8_BAR; PG8_WAIT_L(0); PG8_MMA(1, 0, At, B0); PG8_BAR; PG8_SCHED;
            PG8_STAGE(PG8_SB(1, 1), b3 + hstep, voffB);
            PG8_WAIT_V(6); PG8_BAR; PG8_MMA(1, 1, At, B1); PG8_BAR;
            }
        }
        if constexpr (ALIGN_EPI) { if (wr == 0) PG8_BAR; }
        if constexpr (!Epi::AFTER_DRAIN) { E(acc, cur, wr, wc, fr, fq); S.done(cur); }
        if (!has_next) break;
#pragma unroll
        for (int a = 0; a < 2; ++a)
#pragma unroll
            for (int b = 0; b < 2; ++b)
#pragma unroll
                for (int m = 0; m < 4; ++m)
#pragma unroll
                    for (int n = 0; n < 2; ++n) acc[a][b][m][n] = (f32x4){0.f, 0.f, 0.f, 0.f};
        cur = nxt; cA = nA; cB = nB; ++ui;
        if constexpr (GATHER) { _Pragma("unroll") for (int _j = 0; _j < 2; ++_j) { vA0[_j] = nA0[_j]; vA1[_j] = nA1[_j]; } }
        if constexpr (ALIGN_EPI) { if (wr == 1) PG8_BAR; }
    }
    PG8_WAIT_V(0);
    if constexpr (!ALIGN_EPI) { if (wr == 0) PG8_BAR; }
    PG8_BAR;
    if constexpr (Epi::AFTER_DRAIN) { E.fused(acc, cur, wr, wc, fr, fq, lds, wid, lane); S.done(cur); }
#undef PG8_SA
#undef PG8_SB
#undef PG8_STAGE
#undef PG8_STAGE_A
#undef PG8_GOFS
#undef PG8_LDA
#undef PG8_LDB
#undef PG8_MMA
#undef PG8_WAIT_V
#undef PG8_WAIT_L
#undef PG8_BAR
#undef PG8_SCHED
}
}

#ifndef PG8_SP2
#define PG8_SP2 true
#endif
#ifndef PG8_ALIGN
#define PG8_ALIGN true
#endif
#define XB_TMO      128
#define XB_XCNT(j)  (256  + 64 * (j))
#define XB_XSUB(j)  (1280 + 64 * (j))
#define XB_XGEN(j)  (2304 + 64 * (j))
#define XB_TOP      3328
#define XB_TOPGEN   3392
#define XCD_BAR_WORDS 3456
#define XB_SPIN_CAP (1u << 18)

__device__ __forceinline__ unsigned xb_ld(unsigned* p)              { return __hip_atomic_load(p, __ATOMIC_RELAXED, __HIP_MEMORY_SCOPE_AGENT); }
__device__ __forceinline__ unsigned xb_add(unsigned* p, unsigned v) { return __hip_atomic_fetch_add(p, v, __ATOMIC_RELAXED, __HIP_MEMORY_SCOPE_AGENT); }
__device__ __forceinline__ unsigned xb_xcc_id() { return (unsigned)__builtin_amdgcn_s_getreg((3 << 11) | 20) & 0xFu; }
#define XB_SPIN(cond, bar) do { unsigned _sp = 0; while (cond) { __builtin_amdgcn_s_sleep(1); \
    if ((++_sp & 255u) == 0u) { if (xb_ld(&(bar)[XB_TMO])) break; if (_sp > XB_SPIN_CAP) { atomicAdd(&(bar)[XB_TMO], 1u); break; } } } } while (0)

struct XcdBarrier {
    unsigned* bar; unsigned x;
    volatile LAS unsigned* st;
};

__device__ __forceinline__ XcdBarrier xcd_barrier_post(unsigned* bar, volatile LAS unsigned* st) {
    XcdBarrier b; b.bar = bar; b.x = xb_xcc_id(); b.st = st;
    if (threadIdx.x == 0) (void)xb_add(&bar[XB_XCNT(b.x)], 1u);
    return b;
}
__device__ __forceinline__ void xcd_barrier_complete(unsigned* bar, unsigned x, unsigned& nloc, unsigned& nx) {
    const unsigned G = gridDim.x * gridDim.y * gridDim.z;
    unsigned sum, cnt, mine, sp = 0u;
    for (;;) {
        sum = 0u; cnt = 0u; mine = 0u;
#pragma unroll
        for (unsigned j = 0; j < 16; ++j) { const unsigned c = xb_ld(&bar[XB_XCNT(j)]); sum += c; cnt += (c > 0u) ? 1u : 0u; mine = (j == x) ? c : mine; }
        if (sum == G) break;
        __builtin_amdgcn_s_sleep(1);
        if ((++sp & 255u) == 0u) { if (xb_ld(&bar[XB_TMO])) break; if (sp > XB_SPIN_CAP) { atomicAdd(&bar[XB_TMO], 1u); break; } }
    }
    nloc = mine > 0u ? mine : 1u; nx = cnt > 0u ? cnt : 1u;
}

__device__ __forceinline__ void xcd_barrier(const XcdBarrier& b) {
    asm volatile("s_waitcnt vmcnt(0)" ::: "memory");
    __syncthreads();
    if (threadIdx.x == 0) {
        unsigned* bar = b.bar;
        __builtin_amdgcn_s_waitcnt(0);
        unsigned nloc = b.st[0], nx = b.st[1];
        if (nloc == 0u) { xcd_barrier_complete(bar, b.x, nloc, nx); b.st[0] = nloc; b.st[1] = nx; }
        const unsigned old = xb_add(&bar[XB_XSUB(b.x)], 1u);
        const unsigned gen = old / nloc;
        if (old + 1u == (gen + 1u) * nloc) {
            __builtin_amdgcn_fence(__ATOMIC_RELEASE, "agent");
            asm volatile("s_waitcnt vmcnt(0)" ::: "memory");
            const unsigned og = xb_add(&bar[XB_TOP], 1u);
            const unsigned tg = og / nx;
            if (og + 1u == (tg + 1u) * nx) xb_add(&bar[XB_TOPGEN], 1u);
            else XB_SPIN(xb_ld(&bar[XB_TOPGEN]) == tg, bar);
            __builtin_amdgcn_fence(__ATOMIC_ACQUIRE, "agent");
            xb_add(&bar[XB_XGEN(b.x)], 1u);
            asm volatile("s_waitcnt vmcnt(0)" ::: "memory");
        } else {
            XB_SPIN(xb_ld(&bar[XB_XGEN(b.x)]) == gen, bar);
            __builtin_amdgcn_fence(__ATOMIC_ACQUIRE, "agent");
            asm volatile("s_waitcnt vmcnt(0)" ::: "memory");
        }
    }
    __syncthreads();
}
struct KC {
    const float* const* in;
    LAS unsigned char* lds;
    unsigned char* ws;
    int tid, lane, wave, G, bid;
};
__device__ __forceinline__ const float* inp_(int i) {
    const volatile unsigned long long __attribute__((address_space(4)))* kp = (const volatile unsigned long long __attribute__((address_space(4)))*)__builtin_amdgcn_kernarg_segment_ptr();
    return (const float*)(const GAS float*)kp[i];
}
#define INP(k) (inp_(k))

__device__ __forceinline__ int mod_row(int row) { return row < TL ? (row >> 11) : 8; }

__device__ __forceinline__ void ph_adaln_partials(const KC& k, const float* c, const float* c_ctx, const float* w_ada) {
    LAS float* sc = (LAS float*)k.lds;
    for (int i = k.tid; i < 9 * DM; i += 512) { const int r = i >> 11, kk = i & 2047; const float cv = r < 8 ? c[r * DM + kk] : c_ctx[kk]; sc[i] = siluf(cv); }
    __syncthreads();
    float* modp = (float*)(k.ws + WS_MODP);
    const int cc = k.tid & 255, kh = k.tid >> 8;
    constexpr int NIT = DEPTH * 48 * 16;
    for (int it = k.bid; it < NIT; it += k.G) {
        const int l = it / 768, rem = it % 768, cb = rem >> 4, ks = rem & 15;
        const int col = cb * 256 + cc, kbeg = ks * 128 + kh * 64;
        const float* W = w_ada + ((size_t)l * DM + kbeg) * MOD_N + col;
        float acc[9];
#pragma unroll
        for (int r = 0; r < 9; ++r) acc[r] = 0.f;
#pragma unroll 32
        for (int q = 0; q < 64; ++q) {
            const float w = W[(size_t)q * MOD_N];
#pragma unroll
            for (int r = 0; r < 9; ++r) acc[r] += sc[r * DM + kbeg + q] * w;
        }
        const int s = ks * 2 + kh;
#pragma unroll
        for (int r = 0; r < 9; ++r) modp[(((size_t)s * DEPTH + l) * 9 + r) * MOD_N + col] = acc[r];
    }
    __syncthreads();
}
__device__ __forceinline__ void ph_adaln_reduce(const KC& k, const float* b_ada) {
    const float* modp = (const float*)(k.ws + WS_MODP); float* mod = (float*)(k.ws + WS_MOD);
    constexpr int TOT = DEPTH * 9 * MOD_N;
    for (int i = k.bid * 512 + k.tid; i < TOT; i += k.G * 512) {
        const int n = i % MOD_N, l = i / (9 * MOD_N);
        float s = b_ada[l * MOD_N + n];
#pragma unroll 8
        for (int q = 0; q < KSPLIT; ++q) s += modp[(size_t)q * TOT + i];
        mod[i] = s;
    }
}

struct TrItem { const float* src; bf16* dst; int srcN, Kv, Nv, k0, n0, dpitch, drow0, dk0; };
struct WSrc { const float *w_in, *w2, *a2, *g2, *wba, *wbb, *wout, *eg, *eu, *ed, *w0, *a0; };
constexpr int TI_IN = 32 * 336, TI_LO = 4 * 64, TI_G2 = 4 * 32, TI_AB = 16 * 64, TI_O = 32 * 64, TI_GU1 = 32 * 44, TI_D1 = 22 * 64;
constexpr int TI_N = TI_IN + TI_LO + TI_G2 + 2 * TI_AB + TI_O + 2 * NEXP * TI_GU1 + NEXP * TI_D1;
__device__ __forceinline__ TrItem tr_decode(const WSrc& s, unsigned char* ws, int l, int it) {
    TrItem t; int r = it;
    if (r < TI_IN) { const int kb = r / 336, nb = r % 336; t = TrItem{s.w_in + (size_t)l * DM * IN_DIM, (bf16*)(ws + WT_IN), IN_DIM, DM, IN_DIM, 64 * kb, 32 * nb, DM, 32 * nb, 0}; return t; } r -= TI_IN;
    if (r < TI_LO) {
        const int mtx = r >> 6, q = r & 63, kb = q >> 5, nb = q & 31;
        t = TrItem{(mtx < 2 ? s.w2 : s.a2) + (size_t)(l * 2 + (mtx & 1)) * 96 * RD, (bf16*)(ws + WT_L1), RD, 96, RD, 64 * kb, 32 * nb, 256, mtx * 1024 + 32 * nb, mtx < 2 ? 0 : 96}; return t; } r -= TI_LO;
    if (r < TI_G2) { const int kb = r >> 5, nb = r & 31; t = TrItem{s.g2 + (size_t)l * 256 * RD, (bf16*)(ws + WT_G2), RD, 256, RD, 64 * kb, 32 * nb, 256, 32 * nb, 0}; return t; } r -= TI_G2;
    if (r < TI_AB) { const int kb = r >> 6, nb = r & 63; t = TrItem{s.wba + (size_t)l * RD * DM, (bf16*)(ws + WT_A), DM, RD, DM, 64 * kb, 32 * nb, RD, 32 * nb, 0}; return t; } r -= TI_AB;
    if (r < TI_AB) { const int kb = r >> 6, nb = r & 63; t = TrItem{s.wbb + (size_t)l * GVD * DM, (bf16*)(ws + WT_B), DM, GVD, DM, 64 * kb, 32 * nb, GVD, 32 * nb, 0}; return t; } r -= TI_AB;
    if (r < TI_O) { const int kb = r >> 6, nb = r & 63; t = TrItem{s.wout + (size_t)l * DM * DM, (bf16*)(ws + WT_O), DM, DM, DM, 64 * kb, 32 * nb, DM, 32 * nb, 0}; return t; } r -= TI_O;
    if (r < 2 * NEXP * TI_GU1) {
        const int e = r / (2 * TI_GU1), q = r % (2 * TI_GU1), up = q / TI_GU1, q2 = q % TI_GU1, kb = q2 / 44, nb = q2 % 44;
        const int n0 = 32 * nb, drow = 256 * (n0 >> 7) + (n0 & 127) + (up ? 128 : 0);
        t = TrItem{(up ? s.eu : s.eg) + ((size_t)l * NEXP + e) * DM * DEXP, (bf16*)(ws + WT_GU) + (size_t)e * 2816 * DM, DEXP, DM, DEXP, 64 * kb, n0, DM, drow, 0}; return t; } r -= 2 * NEXP * TI_GU1;
    { const int e = r / TI_D1, q = r % TI_D1, kb = q >> 6, nb = q & 63;
      t = TrItem{s.ed + ((size_t)l * NEXP + e) * DEXP * DM, (bf16*)(ws + WT_D) + (size_t)e * DM * DEXP, DM, DEXP, DM, 64 * kb, 32 * nb, DEXP, 32 * nb, 0}; }
    return t;
}
__device__ __forceinline__ void tr_load(const TrItem& t, int lane, float (&v)[32]) {
    const int nn = lane & 31, kh = lane >> 5;
    const bool nok = t.n0 + nn < t.Nv;
    const float* p = t.src + (size_t)(t.k0 + kh) * t.srcN + t.n0 + nn;
#pragma unroll
    for (int i = 0; i < 32; ++i) { v[i] = 0.f; if (nok && t.k0 + 2 * i + kh < t.Kv) v[i] = p[(size_t)(2 * i) * t.srcN]; }
}
__device__ __forceinline__ void tr_store(const TrItem& t, int lane, const float (&v)[32], LAS float* scr) {
    const int nn = lane & 31, kh = lane >> 5;
#pragma unroll
    for (int i = 0; i < 32; ++i) scr[(2 * i + kh) * 33 + nn] = v[i];
    asm volatile("s_waitcnt lgkmcnt(0)" ::: "memory");
    const int cidx = lane & 7;
#pragma unroll
    for (int j = 0; j < 4; ++j) {
        const int n = (lane >> 3) + 8 * j; const LAS float* s = scr + (8 * cidx) * 33 + n;
        u32x4 o; o.x = pk2(s[0 * 33], s[1 * 33]); o.y = pk2(s[2 * 33], s[3 * 33]); o.z = pk2(s[4 * 33], s[5 * 33]); o.w = pk2(s[6 * 33], s[7 * 33]);
        *(u32x4*)(t.dst + (size_t)(t.drow0 + n) * t.dpitch + t.dk0 + t.k0 + 8 * cidx) = o;
    }
    asm volatile("s_waitcnt lgkmcnt(0)" ::: "memory");
}
__device__ __forceinline__ void ph_convert(const KC& k, const WSrc& s, int l) {
    LAS float* scr = (LAS float*)(k.lds + k.wave * 16384);
    const int gw = k.bid * 8 + k.wave, NGW = k.G * 8;
    unsigned char* ws = k.ws;
    { float* b1 = (float*)(ws + WS_TAB + TAB_TOP); for (int i = gw * 64 + k.lane; i < 4096; i += NGW * 64) b1[i] = i < 2048 ? s.w0[l * 2048 + i] : s.a0[l * 2048 + i - 2048]; }
    {
        u32x4* wl = (u32x4*)(ws + WT_L1);
        for (int i = gw * 64 + k.lane; i < 4096 * 32; i += NGW * 64) { const int row = i >> 5, ck = i & 31; if (row < 2048 ? ck >= 16 : (ck < 12 || ck >= 28)) wl[i] = (u32x4){0u, 0u, 0u, 0u}; }
        if (l == 0) { int* rt = (int*)(ws + WS_TAB + TAB_ROWTOK); for (int i = gw * 64 + k.lane; i < 2 * MOE_ROWS; i += NGW * 64) rt[i] = -1; }
    }
    float cur[32], nxt[32];
    int it = gw;
    TrItem tc = tr_decode(s, ws, l, it < TI_N ? it : 0);
    if (it < TI_N) tr_load(tc, k.lane, cur);
    for (; it < TI_N; it += NGW) {
        const bool more = it + NGW < TI_N;
        const TrItem tn = tr_decode(s, ws, l, more ? it + NGW : it);
        if (more) tr_load(tn, k.lane, nxt);
        tr_store(tc, k.lane, cur, scr);
        tc = tn;
#pragma unroll
        for (int i = 0; i < 32; ++i) cur[i] = nxt[i];
    }
}

constexpr int RWP = DM + 4;
struct RowArgs { const float *x_in, *ctx_in, *gvec, *router_w, *router_b; float* out; };
template <int MODE>
__device__ __forceinline__ void ph_rows(const KC& k, const RowArgs& ra, int l, int nrows, bool dry = false) {
    const int gw = k.bid * 8 + k.wave, NGW = k.G * 8, lane = k.lane;
    float* X = (float*)(k.ws + WS_X); bf16* H = (bf16*)(k.ws + WS_H);
    bf16* Xb = (bf16*)(k.ws + WS_X);
    const float* MOD = (const float*)(k.ws + WS_MOD);
    const bf16* YF = (const bf16*)(k.ws + WS_YF);
    LAS float* rwT = (LAS float*)k.lds;
    if (MODE == 1) {
        for (int i = k.tid; i < DM * NEXP; i += 512) { const int c = i >> 4, e = i & 15; rwT[e * RWP + c] = ra.router_w[i]; }
        __syncthreads();
    }
    const float* gv = ra.gvec;
    for (int row = gw; row < nrows; row += NGW) {
        const int mr = mod_row(row);
        f32x4 v[8];
        if (MODE == 0 && l == 0) {
            const f32x4* src = (const f32x4*)(row < TL ? ra.x_in + (size_t)row * DM : ra.ctx_in + (size_t)(row - TL) * DM) + lane;
#pragma unroll
            for (int j = 0; j < 8; ++j) v[j] = src[64 * j];
        } else if (XBF) {
            const u32x2* src = (const u32x2*)(Xb + (size_t)row * DM) + lane;
#pragma unroll
            for (int j = 0; j < 8; ++j) { const u32x2 a = src[64 * j]; v[j] = (f32x4){bflo(a.x), bfhi(a.x), bflo(a.y), bfhi(a.y)}; }
        } else {
            const f32x4* src = (const f32x4*)(X + (size_t)row * DM) + lane;
#pragma unroll
            for (int j = 0; j < 8; ++j) v[j] = src[64 * j];
        }
        if ((MODE == 0 && l > 0) || MODE == 2) {
            const int lp = (MODE == 2) ? DEPTH - 1 : l - 1;
            const f32x4* gate = (const f32x4*)(MOD + ((size_t)lp * 9 + mr) * MOD_N + 5 * DM) + lane;
            const u32x2* y0 = (const u32x2*)(YF + (size_t)row * DM) + lane;
            const u32x2* y1 = (const u32x2*)(YF + ((size_t)TA + row) * DM) + lane;
#pragma unroll
            for (int j = 0; j < 8; ++j) {
                const f32x4 g = gate[64 * j]; const u32x2 a = y0[64 * j], b = y1[64 * j];
                v[j].x += g.x * (bflo(a.x) + bflo(b.x)); v[j].y += g.y * (bfhi(a.x) + bfhi(b.x));
                v[j].z += g.z * (bflo(a.y) + bflo(b.y)); v[j].w += g.w * (bfhi(a.y) + bfhi(b.y));
            }
        }
        if (MODE == 0 && XBF) {
            u32x2* dst = (u32x2*)(Xb + (size_t)row * DM) + lane;
#pragma unroll
            for (int j = 0; j < 8; ++j) { u32x2 o; o.x = pk2(v[j].x, v[j].y); o.y = pk2(v[j].z, v[j].w); dst[64 * j] = o; }
        } else if (MODE == 0) {
            f32x4* dst = (f32x4*)(X + (size_t)row * DM) + lane;
#pragma unroll
            for (int j = 0; j < 8; ++j) dst[64 * j] = v[j];
        }
        float ss = 0.f;
#pragma unroll
        for (int j = 0; j < 8; ++j) ss += (v[j].x * v[j].x + v[j].y * v[j].y) + (v[j].z * v[j].z + v[j].w * v[j].w);
        const float rinv = 1.0f / sqrtf(wave_sum(ss) * (1.0f / DM) + 1e-6f);
        if (MODE == 2) {
            f32x4* dst = (f32x4*)(ra.out + (size_t)row * DM) + lane; const f32x4* g4 = (const f32x4*)gv + lane;
#pragma unroll
            for (int j = 0; j < 8; ++j) { const f32x4 g = g4[64 * j]; dst[64 * j] = v[j] * rinv * g; }
        } else {
            const float* mrow = MOD + ((size_t)l * 9 + mr) * MOD_N + (MODE == 0 ? 0 : 3 * DM);
            const f32x4* sh4 = (const f32x4*)mrow + lane; const f32x4* sc4 = (const f32x4*)(mrow + DM) + lane; const f32x4* g4 = (const f32x4*)(gv + (size_t)l * DM) + lane;
            u32x2* dst = (u32x2*)(H + (size_t)row * DM) + lane;
#pragma unroll
            for (int j = 0; j < 8; ++j) {
                const f32x4 g = g4[64 * j], sh = sh4[64 * j], sc = sc4[64 * j];
                v[j] = v[j] * rinv * g * (1.0f + sc) + sh;
                u32x2 o; o.x = pk2(v[j].x, v[j].y); o.y = pk2(v[j].z, v[j].w); dst[64 * j] = o;
            }
        }
        if (MODE == 1) {
            float lg[NEXP];
#pragma unroll
            for (int e = 0; e < NEXP; ++e) {
                float s = 0.f;
#pragma unroll
                for (int j = 0; j < 8; ++j) { const f32x4 w = *(const LAS f32x4*)(rwT + e * RWP + 4 * lane + 256 * j); s += (v[j].x * w.x + v[j].y * w.y) + (v[j].z * w.z + v[j].w * w.w); }
                lg[e] = wave_sum(s);
            }
            float sc[NEXP], sel[NEXP];
#pragma unroll
            for (int e = 0; e < NEXP; ++e) { sc[e] = 1.0f / (1.0f + expf(-lg[e])); sel[e] = sc[e] + ra.router_b[e]; }
            float gs[4], w1g[4], w2g[4]; int i1g[4], i2g[4];
#pragma unroll
            for (int g = 0; g < 4; ++g) {
                int i1 = 0; float m1 = sel[4 * g];
#pragma unroll
                for (int q = 1; q < 4; ++q) if (sel[4 * g + q] > m1) { m1 = sel[4 * g + q]; i1 = q; }
                int i2 = -1; float m2 = -3.0e38f;
#pragma unroll
                for (int q = 0; q < 4; ++q) if (q != i1 && sel[4 * g + q] > m2) { m2 = sel[4 * g + q]; i2 = q; }
                gs[g] = m1 + m2; i1g[g] = 4 * g + i1; i2g[g] = 4 * g + i2;
                float a1 = sc[4 * g], a2 = sc[4 * g];
#pragma unroll
                for (int q = 0; q < 4; ++q) { a1 = (q == i1) ? sc[4 * g + q] : a1; a2 = (q == i2) ? sc[4 * g + q] : a2; }
                w1g[g] = a1; w2g[g] = a2;
            }
            int best = 0; float bs = gs[0];
#pragma unroll
            for (int g = 1; g < 4; ++g) if (gs[g] > bs) { bs = gs[g]; best = g; }
            int e1 = i1g[0], e2 = i2g[0]; float w1 = w1g[0], w2 = w2g[0];
#pragma unroll
            for (int g = 1; g < 4; ++g) { e1 = (best == g) ? i1g[g] : e1; e2 = (best == g) ? i2g[g] : e2; w1 = (best == g) ? w1g[g] : w1; w2 = (best == g) ? w2g[g] : w2; }
            const float inv = 1.0f / (w1 + w2);
            if (lane == 0 && !dry) {
                unsigned* cnt = (unsigned*)(k.ws + WS_CTL) + CW_CNT + 64 * l;
                const int p1 = (int)atomicAdd(cnt + e1, 1u), p2 = (int)atomicAdd(cnt + e2, 1u);
                int* te = (int*)(k.ws + WS_TOPK); float* tw = (float*)(k.ws + WS_TOPK + (size_t)TA * 8); int* tp = (int*)(k.ws + WS_TOPK + 2 * (size_t)TA * 8);
                te[2 * row] = e1; te[2 * row + 1] = e2; tw[2 * row] = w1 * inv; tw[2 * row + 1] = w2 * inv; tp[2 * row] = p1; tp[2 * row + 1] = p2;
            }
        }
    }
    if (MODE == 1) __syncthreads();
}

__device__ __forceinline__ void ph_moe_scatter(const KC& k, int l, int nrows) {
    LAS int* offs = (LAS int*)k.lds;
    const unsigned* cnt = (const unsigned*)(k.ws + WS_CTL) + CW_CNT + 64 * l;
    int* tile = (int*)(k.ws + WS_TAB + TAB_TILE) + 256 * l;
    if (k.tid == 0) {
        int off = 0, nt = 0;
        for (int e = 0; e < NEXP; ++e) {
            offs[e] = off; const int c = (int)__hip_atomic_load(cnt + e, __ATOMIC_RELAXED, __HIP_MEMORY_SCOPE_AGENT); const int t = (c + 255) >> 8;
            if (k.bid == 0) for (int q = 0; q < t; ++q) tile[1 + nt + q] = e;
            nt += t; off += t * 256;
        }
        if (k.bid == 0) tile[0] = nt;
    }
    __syncthreads();
    const int gw = k.bid * 8 + k.wave, NGW = k.G * 8, lane = k.lane;
    const bf16* H = (const bf16*)(k.ws + WS_H); bf16* HP = (bf16*)(k.ws + WS_HP);
    const int* te = (const int*)(k.ws + WS_TOPK); const float* tw = (const float*)(k.ws + WS_TOPK + (size_t)TA * 8); const int* tp = (const int*)(k.ws + WS_TOPK + 2 * (size_t)TA * 8);
    int* rowtok = (int*)(k.ws + WS_TAB + TAB_ROWTOK) + (size_t)l * MOE_ROWS; float* roww = (float*)(k.ws + WS_TAB + TAB_ROWW) + (size_t)l * MOE_ROWS;
    for (int row = gw; row < nrows; row += NGW) {
#if MOE_GATHER
        (void)H; (void)HP;
        if (lane < 2) { const int s = lane; const int e = te[2 * row + s], dest = offs[e] + tp[2 * row + s]; rowtok[dest] = 2 * row + s; roww[dest] = tw[2 * row + s]; }
    }
#else
        const u32x4* src = (const u32x4*)(H + (size_t)row * DM) + lane;
        u32x4 d[4];
#pragma unroll
        for (int j = 0; j < 4; ++j) d[j] = src[64 * j];
#pragma unroll
        for (int s = 0; s < 2; ++s) {
            const int e = te[2 * row + s], dest = offs[e] + tp[2 * row + s];
            u32x4* dp = (u32x4*)(HP + (size_t)dest * DM) + lane;
#pragma unroll
            for (int j = 0; j < 4; ++j) dp[64 * j] = d[j];
            if (lane == 0) { rowtok[dest] = 2 * row + s; roww[dest] = tw[2 * row + s]; }
        }
    }
#endif
    __syncthreads();
}
__device__ __forceinline__ void ld16(const bf16* p, bool ok, float (&o)[16]) {
    if (ok) { const u32x4 a = *(const u32x4*)p, b = *(const u32x4*)(p + 8); float x[8], y[8]; unpack8(a, x); unpack8(b, y);
#pragma unroll
        for (int i = 0; i < 8; ++i) { o[i] = x[i]; o[8 + i] = y[i]; } }
    else {
#pragma unroll
        for (int i = 0; i < 16; ++i) o[i] = 0.f; }
}
__device__ __forceinline__ void st16(bf16* p, const float (&v)[16]) {
    float a[8], b[8];
#pragma unroll
    for (int i = 0; i < 8; ++i) { a[i] = v[i]; b[i] = v[8 + i]; }
    *(u32x4*)p = pack8(a); *(u32x4*)(p + 8) = pack8(b);
}
__device__ __forceinline__ void shift8(const bf16* p0, bool hp, bool hn, int c, const float* mu0, const float* mu1, float (&s)[8]) {
    float x[8], xm[8], xp[8];
    unpack8(*(const u32x4*)(p0 + c), x);
    if (hp) unpack8(*(const u32x4*)(p0 - NP + c), xm); else {
#pragma unroll
        for (int i = 0; i < 8; ++i) xm[i] = 0.f; }
    if (hn) unpack8(*(const u32x4*)(p0 + NP + c), xp); else {
#pragma unroll
        for (int i = 0; i < 8; ++i) xp[i] = 0.f; }
    const f32x4 m0a = *(const f32x4*)(mu0 + c), m0b = *(const f32x4*)(mu0 + c + 4), m1a = *(const f32x4*)(mu1 + c), m1b = *(const f32x4*)(mu1 + c + 4);
    const float m0[8] = {m0a.x, m0a.y, m0a.z, m0a.w, m0b.x, m0b.y, m0b.z, m0b.w}, m1[8] = {m1a.x, m1a.y, m1a.z, m1a.w, m1b.x, m1b.y, m1b.z, m1b.w};
#pragma unroll
    for (int i = 0; i < 8; ++i) s[i] = x[i] + m0[i] * (xm[i] - x[i]) + m1[i] * (xp[i] - x[i]);
}
__device__ __forceinline__ void mix8(const u32x4 xc4, const u32x4 xm4, const u32x4 xp4, bool hp, bool hn, int c, const float* mu0, const float* mu1, float (&s)[8]) {
    float x[8], xm[8], xp[8];
    unpack8(xc4, x); unpack8(xm4, xm); unpack8(xp4, xp);
    const f32x4 m0a = *(const f32x4*)(mu0 + c), m0b = *(const f32x4*)(mu0 + c + 4), m1a = *(const f32x4*)(mu1 + c), m1b = *(const f32x4*)(mu1 + c + 4);
    const float m0[8] = {m0a.x, m0a.y, m0a.z, m0a.w, m0b.x, m0b.y, m0b.z, m0b.w}, m1[8] = {m1a.x, m1a.y, m1a.z, m1a.w, m1b.x, m1b.y, m1b.z, m1b.w};
#pragma unroll
    for (int i = 0; i < 8; ++i) s[i] = x[i] + m0[i] * ((hp ? xm[i] : 0.f) - x[i]) + m1[i] * ((hn ? xp[i] : 0.f) - x[i]);
}
__device__ __forceinline__ void ph_rwkv_prep(const KC& k, int l, int nrows, const float* mu, const float* k_k, const float* r_k) {
    const int gw = k.bid * 8 + k.wave, NGW = k.G * 8, lane = k.lane;
    const bf16* P = (const bf16*)(k.ws + WS_P);
    bf16* R = (bf16*)(k.ws + RW_R); bf16* KS = (bf16*)(k.ws + RW_KS); bf16* V = (bf16*)(k.ws + RW_V); bf16* KK = (bf16*)(k.ws + RW_KK);
    bf16* A1 = (bf16*)(k.ws + RW_A1); bf16* A2 = (bf16*)(k.ws + RW_A2); float* BON = (float*)(k.ws + RW_BON);
    const float* mu0 = mu + (size_t)(l * 2 + 0) * RWKV_IN; const float* mu1 = mu + (size_t)(l * 2 + 1) * RWKV_IN;
    const int rpw = (nrows + NGW - 1) / NGW;
#if PREP_WINDOW
    u32x4 wp[7], wc[7], wn[7], wq[7];
    const int row0 = gw * rpw, rend = (gw + 1) * rpw < nrows ? (gw + 1) * rpw : nrows;
    const int tl8 = 8 * (lane < 56 ? lane : 0);
#define PREP_LDROW(ROW, W) do { const bf16* p_ = P + (size_t)(ROW) * NP; _Pragma("unroll") for (int h_ = 0; h_ < 2; ++h_) _Pragma("unroll") for (int q_ = 0; q_ < 3; ++q_) W[3 * h_ + q_] = *(const u32x4*)(p_ + q_ * RD + h_ * 512 + 8 * lane); \
        W[6] = *(const u32x4*)(p_ + 3 * RD + tl8); } while (0)
    if (row0 < rend) { PREP_LDROW(row0 > 0 ? row0 - 1 : 0, wp); PREP_LDROW(row0, wc); PREP_LDROW(row0 + 1 < nrows ? row0 + 1 : nrows - 1, wn); }
    for (int row = row0; row < rend; ++row) {
        PREP_LDROW(row + 2 < nrows ? row + 2 : nrows - 1, wq);
#else
    for (int row = gw * rpw; row < nrows && row < (gw + 1) * rpw; ++row) {
#endif
        int t, len; if (row < TL) { t = row & (SEQ - 1); len = SEQ; } else { t = (row - TL) & (CTXL - 1); len = CTXL; }
        const bool hp = t > 0, hn = t < len - 1;
        const bf16* p0 = P + (size_t)row * NP;
#pragma unroll
        for (int half = 0; half < 2; ++half) {
            const int c = half * 512 + 8 * lane;
            float r[8], kx[8], vv[8], kk[8];
#if PREP_WINDOW
            mix8(wc[3 * half], wp[3 * half], wn[3 * half], hp, hn, c, mu0, mu1, r);
            mix8(wc[3 * half + 1], wp[3 * half + 1], wn[3 * half + 1], hp, hn, RD + c, mu0, mu1, kx);
            mix8(wc[3 * half + 2], wp[3 * half + 2], wn[3 * half + 2], hp, hn, 2 * RD + c, mu0, mu1, vv);
#else
            shift8(p0, hp, hn, c, mu0, mu1, r);
            shift8(p0, hp, hn, RD + c, mu0, mu1, kx);
            shift8(p0, hp, hn, 2 * RD + c, mu0, mu1, vv);
#endif
            const f32x4 kka = *(const f32x4*)(k_k + l * RD + c), kkb = *(const f32x4*)(k_k + l * RD + c + 4), rka = *(const f32x4*)(r_k + l * RD + c), rkb = *(const f32x4*)(r_k + l * RD + c + 4);
            const float kkw[8] = {kka.x, kka.y, kka.z, kka.w, kkb.x, kkb.y, kkb.z, kkb.w}, rkw[8] = {rka.x, rka.y, rka.z, rka.w, rkb.x, rkb.y, rkb.z, rkb.w};
            float ss = 0.f, bon = 0.f;
#pragma unroll
            for (int i = 0; i < 8; ++i) { kk[i] = kx[i] * kkw[i]; ss += kk[i] * kk[i]; bon += r[i] * kx[i] * rkw[i]; }
            ss += __shfl_xor(ss, 1); ss += __shfl_xor(ss, 2); ss += __shfl_xor(ss, 4);
            bon += __shfl_xor(bon, 1); bon += __shfl_xor(bon, 2); bon += __shfl_xor(bon, 4);
            const float inv = 1.0f / fmaxf(sqrtf(ss), 1e-12f);
#pragma unroll
            for (int i = 0; i < 8; ++i) kk[i] *= inv;
            *(u32x4*)(R + (size_t)row * RD + c) = pack8(r); *(u32x4*)(KS + (size_t)row * RD + c) = pack8(kx);
            *(u32x4*)(V + (size_t)row * RD + c) = pack8(vv); *(u32x4*)(KK + (size_t)row * RD + c) = pack8(kk);
            if ((lane & 7) == 0) BON[(size_t)row * RHEADS + half * 8 + (lane >> 3)] = bon;
        }
        if (lane < 56) {
            float s8[8];
#if PREP_WINDOW
            mix8(wc[6], wp[6], wn[6], hp, hn, 3 * RD + 8 * lane, mu0, mu1, s8);
#else
            shift8(p0, hp, hn, 3 * RD + 8 * lane, mu0, mu1, s8);
#endif
            if (lane < 12) {
#pragma unroll
                for (int i = 0; i < 8; ++i) { const float e2 = __expf(2.0f * fminf(fmaxf(s8[i], -15.f), 15.f)); s8[i] = 1.0f - 2.0f / (e2 + 1.0f); }
                *(u32x4*)(A1 + (size_t)row * 256 + 8 * lane) = pack8(s8);
            } else if (lane < 24) { *(u32x4*)(A1 + (size_t)row * 256 + 8 * lane) = pack8(s8); }
            else {
#pragma unroll
                for (int i = 0; i < 8; ++i) s8[i] = sigm(s8[i]);
                *(u32x4*)(A2 + (size_t)row * 256 + 8 * (lane - 24)) = pack8(s8);
            }
        } else { *(u32x4*)(A1 + (size_t)row * 256 + 192 + 8 * (lane - 56)) = (u32x4){0u, 0u, 0u, 0u}; }
#if PREP_WINDOW
#pragma unroll
        for (int i = 0; i < 7; ++i) { wp[i] = wc[i]; wc[i] = wn[i]; wn[i] = wq[i]; }
#endif
    }
#if PREP_WINDOW
#undef PREP_LDROW
#endif
}

__device__ __forceinline__ float logsig(float x) { return fminf(x, 0.f) - __logf(1.0f + __expf(-fabsf(x))); }
__device__ __forceinline__ int gla_row(bool lat, int b, int s) { return lat ? b * SEQ + (s & 31) * 64 + (s >> 5) : TL + b * CTXL + s; }
constexpr int GQ_PITCH = 264;
constexpr int GPL_AD = 0, GPL_GS = 4096, GPL_QK = GPL_GS + 65536, GPL_END = GPL_QK + 66 * GQ_PITCH * 2;
static_assert(GPL_END <= 131072, "gla prep lds");
__device__ __forceinline__ void ph_gla_prep(const KC& k, int l, const float* conv, const float* aw2, const float* ab) {
    const bf16* P = (const bf16*)(k.ws + WS_P);
    bf16* QG = (bf16*)(k.ws + GL_QG); bf16* KG = (bf16*)(k.ws + GL_KG); bf16* KE = (bf16*)(k.ws + GL_KE); bf16* VS = (bf16*)(k.ws + GL_VS); float* DEC = (float*)(k.ws + GL_DEC);
    const float* cw = conv + (size_t)l * 3 * GQKV;
    const int tid = k.tid, lane = k.lane;
    {
        const int gw = k.bid * 8 + k.wave, NGW = k.G * 8, c = 16 * lane;
        const int rpw = (TA + NGW - 1) / NGW;
#if PREP_WINDOW
        auto vrow = [&](int qi_) -> int { const bool lat_ = qi_ < TL; return lat_ ? gla_row(true, qi_ >> 11, qi_ & 2047) : gla_row(false, (qi_ - TL) >> 8, (qi_ - TL) & 255); };
        u32x4 vm[2], vc[2], vn[2], vq[2];
#define GPREP_LD(QI, W) do { const int q_ = (QI) < 0 ? 0 : ((QI) >= TA ? TA - 1 : (QI)); const bf16* p_ = P + (size_t)vrow(q_) * NP + GLA_OFF + 2 * GKD + c; W[0] = *(const u32x4*)p_; W[1] = *(const u32x4*)(p_ + 8); } while (0)
        const int qi0 = gw * rpw, qie = (gw + 1) * rpw < TA ? (gw + 1) * rpw : TA;
        if (qi0 < qie) { GPREP_LD(qi0 - 1, vm); GPREP_LD(qi0, vc); GPREP_LD(qi0 + 1, vn); }
        for (int qi = qi0; qi < qie; ++qi) {
            GPREP_LD(qi + 2, vq);
            const bool lat = qi < TL; int b, s, len;
            if (lat) { b = qi >> 11; s = qi & 2047; len = SEQ; } else { b = (qi - TL) >> 8; s = (qi - TL) & 255; len = CTXL; }
            const int row = gla_row(lat, b, s);
            const bool hp = s > 0, hn = s + 1 < len;
            float o[16];
#pragma unroll
            for (int hf = 0; hf < 2; ++hf) {
                float x[8], xm[8], xp[8];
                unpack8(vc[hf], x); unpack8(vm[hf], xm); unpack8(vn[hf], xp);
                const float* w = cw + 2 * GKD + c + 8 * hf;
#pragma unroll
                for (int q = 0; q < 2; ++q) {
                    const f32x4 w0 = *(const f32x4*)(w + 4 * q), w1 = *(const f32x4*)(w + GQKV + 4 * q), w2 = *(const f32x4*)(w + 2 * GQKV + 4 * q);
#pragma unroll
                    for (int i = 0; i < 4; ++i) o[8 * hf + 4 * q + i] = siluf(w0[i] * (hp ? xm[4 * q + i] : 0.f) + w1[i] * x[4 * q + i] + w2[i] * (hn ? xp[4 * q + i] : 0.f));
                }
            }
#pragma unroll
            for (int i = 0; i < 2; ++i) { vm[i] = vc[i]; vc[i] = vn[i]; vn[i] = vq[i]; }
#else
        for (int qi = gw * rpw; qi < TA && qi < (gw + 1) * rpw; ++qi) {
            const bool lat = qi < TL; int b, s, len;
            if (lat) { b = qi >> 11; s = qi & 2047; len = SEQ; } else { b = (qi - TL) >> 8; s = (qi - TL) & 255; len = CTXL; }
            const int row = gla_row(lat, b, s);
            const bool hp = s > 0, hn = s + 1 < len;
            const bf16* p0 = P + (size_t)row * NP + GLA_OFF + 2 * GKD + c;
            const bf16* pm = P + (size_t)gla_row(lat, b, hp ? s - 1 : s) * NP + GLA_OFF + 2 * GKD + c;
            const bf16* pp = P + (size_t)gla_row(lat, b, hn ? s + 1 : s) * NP + GLA_OFF + 2 * GKD + c;
            float o[16];
#pragma unroll
            for (int hf = 0; hf < 2; ++hf) {
                float x[8], xm[8], xp[8];
                unpack8(*(const u32x4*)(p0 + 8 * hf), x); unpack8(*(const u32x4*)(pm + 8 * hf), xm); unpack8(*(const u32x4*)(pp + 8 * hf), xp);
                const float* w = cw + 2 * GKD + c + 8 * hf;
#pragma unroll
                for (int q = 0; q < 2; ++q) {
                    const f32x4 w0 = *(const f32x4*)(w + 4 * q), w1 = *(const f32x4*)(w + GQKV + 4 * q), w2 = *(const f32x4*)(w + 2 * GQKV + 4 * q);
#pragma unroll
                    for (int i = 0; i < 4; ++i) o[8 * hf + 4 * q + i] = siluf(w0[i] * (hp ? xm[4 * q + i] : 0.f) + w1[i] * x[4 * q + i] + w2[i] * (hn ? xp[4 * q + i] : 0.f));
                }
            }
#endif
            st16(VS + (size_t)row * GVD + c, o);
        }
#if PREP_WINDOW
#undef GPREP_LD
#endif
    }
    LAS float* ADs = (LAS float*)(k.lds + GPL_AD);
    LAS float* Gs = (LAS float*)(k.lds + GPL_GS);
    LAS bf16* QKs = (LAS bf16*)(k.lds + GPL_QK);
    for (int item = k.bid; item < 288 * 4; item += k.G) {
        const int sc = item >> 2, h = item & 3;
        const bool lat = sc < 256; const int b = lat ? (sc >> 5) : ((sc - 256) >> 2), cn = lat ? (sc & 31) : ((sc - 256) & 3), len = lat ? SEQ : CTXL;
        const int gch = lat ? 4 + cn : cn, s0 = 64 * cn;
        for (int i = tid; i < 1024; i += 512) { const int tau = i >> 4, j = i & 15; ADs[i] = bf2f(P[(size_t)gla_row(lat, b, s0 + tau) * NP + GLA_AD_OFF + j]); }
        for (int i = tid; i < 66 * 32; i += 512) {
            const int rr = i >> 5, ck = i & 31, s = s0 - 1 + rr;
            u32x4 v = (u32x4){0u, 0u, 0u, 0u};
            if (s >= 0 && s < len) v = *(const u32x4*)(P + (size_t)gla_row(lat, b, s) * NP + GLA_OFF + (ck >> 4) * GKD + h * GDK + (ck & 15) * 8);
            *(LAS u32x4*)(QKs + rr * GQ_PITCH + ck * 8) = v;
        }
        __syncthreads();
        {
            const int c = tid & 127, tg = tid >> 7, chl = h * GDK + c;
            float awf[16], awb[16];
#pragma unroll
            for (int j = 0; j < 16; ++j) { awf[j] = aw2[((size_t)(l * 2 + 0) * 16 + j) * GKD + chl]; awb[j] = aw2[((size_t)(l * 2 + 1) * 16 + j) * GKD + chl]; }
            const float abf = ab[(l * 2 + 0) * GKD + chl], abb = ab[(l * 2 + 1) * GKD + chl];
            for (int i = 0; i < 16; ++i) {
                const int tau = 16 * tg + i; float xf = abf, xb = abb;
#pragma unroll
                for (int j = 0; j < 16; ++j) { const float a = ADs[tau * 16 + j]; xf += a * awf[j]; xb += a * awb[j]; }
                Gs[tau * 128 + c] = logsig(xf) * (1.0f / 16.0f); Gs[(64 + tau) * 128 + c] = logsig(xb) * (1.0f / 16.0f);
            }
        }
        __syncthreads();
        if (tid < 128) { float run = 0.f; for (int tau = 0; tau < 64; ++tau) { run += Gs[tau * 128 + tid]; Gs[tau * 128 + tid] = run; } }
        else if (tid < 256) { const int c = tid - 128; float run = 0.f; for (int tau = 63; tau >= 0; --tau) { run += Gs[(64 + tau) * 128 + c]; Gs[(64 + tau) * 128 + c] = run; } }
        __syncthreads();
        {
            const int c8 = tid & 15, tg = tid >> 4, chl = h * GDK + 8 * c8;
            float wq[3][8], wk[3][8], elf[8], elb[8];
#pragma unroll
            for (int tp = 0; tp < 3; ++tp) {
                const f32x4 a0 = *(const f32x4*)(cw + tp * GQKV + chl), a1 = *(const f32x4*)(cw + tp * GQKV + chl + 4), b0 = *(const f32x4*)(cw + tp * GQKV + GKD + chl), b1 = *(const f32x4*)(cw + tp * GQKV + GKD + chl + 4);
#pragma unroll
                for (int i = 0; i < 4; ++i) { wq[tp][i] = a0[i]; wq[tp][4 + i] = a1[i]; wk[tp][i] = b0[i]; wk[tp][4 + i] = b1[i]; }
            }
            {
                const f32x4 a0 = *(const LAS f32x4*)(Gs + 63 * 128 + 8 * c8), a1 = *(const LAS f32x4*)(Gs + 63 * 128 + 8 * c8 + 4), b0 = *(const LAS f32x4*)(Gs + 64 * 128 + 8 * c8), b1 = *(const LAS f32x4*)(Gs + 64 * 128 + 8 * c8 + 4);
#pragma unroll
                for (int i = 0; i < 4; ++i) { elf[i] = __expf(a0[i]); elf[4 + i] = __expf(a1[i]); elb[i] = __expf(b0[i]); elb[4 + i] = __expf(b1[i]); }
            }
            if (tg < 8) {
                float* d0 = DEC + ((size_t)(0 * 8 + b) * NCH + gch) * GKD + chl; float* d1 = DEC + ((size_t)(1 * 8 + b) * NCH + gch) * GKD + chl;
                if (tg == 0) { *(f32x4*)d0 = (f32x4){elf[0], elf[1], elf[2], elf[3]}; *(f32x4*)(d0 + 4) = (f32x4){elf[4], elf[5], elf[6], elf[7]}; }
                if (tg == 1) { *(f32x4*)d1 = (f32x4){elb[0], elb[1], elb[2], elb[3]}; *(f32x4*)(d1 + 4) = (f32x4){elb[4], elb[5], elb[6], elb[7]}; }
            }
#pragma unroll
            for (int pass = 0; pass < 2; ++pass) {
                const int tau = tg + 32 * pass;
                float qm[8], q0[8], qp[8], km[8], k0[8], kp[8];
                unpack8(*(const LAS u32x4*)(QKs + (tau + 0) * GQ_PITCH + 8 * c8), qm); unpack8(*(const LAS u32x4*)(QKs + (tau + 1) * GQ_PITCH + 8 * c8), q0); unpack8(*(const LAS u32x4*)(QKs + (tau + 2) * GQ_PITCH + 8 * c8), qp);
                unpack8(*(const LAS u32x4*)(QKs + (tau + 0) * GQ_PITCH + 128 + 8 * c8), km); unpack8(*(const LAS u32x4*)(QKs + (tau + 1) * GQ_PITCH + 128 + 8 * c8), k0); unpack8(*(const LAS u32x4*)(QKs + (tau + 2) * GQ_PITCH + 128 + 8 * c8), kp);
                const f32x4 f0 = *(const LAS f32x4*)(Gs + tau * 128 + 8 * c8), f1 = *(const LAS f32x4*)(Gs + tau * 128 + 8 * c8 + 4), g0 = *(const LAS f32x4*)(Gs + (64 + tau) * 128 + 8 * c8), g1 = *(const LAS f32x4*)(Gs + (64 + tau) * 128 + 8 * c8 + 4);
                const float cf[8] = {f0.x, f0.y, f0.z, f0.w, f1.x, f1.y, f1.z, f1.w}, cb[8] = {g0.x, g0.y, g0.z, g0.w, g1.x, g1.y, g1.z, g1.w};
                float oqf[8], okf[8], oef[8], oqb[8], okb[8], oeb[8];
#pragma unroll
                for (int i = 0; i < 8; ++i) {
                    const float qv = siluf(wq[0][i] * qm[i] + wq[1][i] * q0[i] + wq[2][i] * qp[i]) * 0.08838834764831845f;
                    const float kv = siluf(wk[0][i] * km[i] + wk[1][i] * k0[i] + wk[2][i] * kp[i]);
                    const float ef = __expf(cf[i]), eb = __expf(cb[i]), rf = 1.0f / ef, rb = 1.0f / eb;
                    oqf[i] = qv * ef; okf[i] = kv * rf; oef[i] = kv * rf * elf[i];
                    oqb[i] = qv * eb; okb[i] = kv * rb; oeb[i] = kv * rb * elb[i];
                }
                const size_t o = (size_t)gla_row(lat, b, s0 + tau) * GKD + chl;
                *(u32x4*)(QG + o) = pack8(oqf); *(u32x4*)(KG + o) = pack8(okf); *(u32x4*)(KE + o) = pack8(oef);
                *(u32x4*)(QG + (size_t)TA * GKD + o) = pack8(oqb); *(u32x4*)(KG + (size_t)TA * GKD + o) = pack8(okb); *(u32x4*)(KE + (size_t)TA * GKD + o) = pack8(oeb);
            }
        }
        __syncthreads();
    }
}

__device__ __forceinline__ float dpp_sum16(float x) {
    x += __builtin_bit_cast(float, __builtin_amdgcn_update_dpp(0, __builtin_bit_cast(int, x), 0xB1, 0xF, 0xF, true));
    x += __builtin_bit_cast(float, __builtin_amdgcn_update_dpp(0, __builtin_bit_cast(int, x), 0x4E, 0xF, 0xF, true));
    x += __builtin_bit_cast(float, __builtin_amdgcn_update_dpp(0, __builtin_bit_cast(int, x), 0x141, 0xF, 0xF, true));
    x += __builtin_bit_cast(float, __builtin_amdgcn_update_dpp(0, __builtin_bit_cast(int, x), 0x140, 0xF, 0xF, true));
    return x;
}
constexpr int RS_TOK = 16;
constexpr int RS_TF = 6 * 64;
constexpr int RS_BUF = RS_TOK * RS_TF;
struct RwkvStage { unsigned r, we, a, ks, v, kk; };
__device__ __forceinline__ int rwkv_row(int b, int dir, int p) {
    if (p < CTXL) { const int t = dir ? CTXL - 1 - p : p; return TL + b * CTXL + t; }
    const int q = p - CTXL, t = dir ? SEQ - 1 - q : q; return b * SEQ + t;
}
__device__ __forceinline__ void ph_rwkv_scan(const KC& k, int l, int job, const float* k_a, size_t yoff = RW_Y) {
    const int b = job >> 5, h = (job >> 1) & 15, dir = job & 1;
    const int tid = k.tid;
    const bf16* R = (const bf16*)(k.ws + RW_R); const bf16* KS = (const bf16*)(k.ws + RW_KS); const bf16* V = (const bf16*)(k.ws + RW_V); const bf16* KK = (const bf16*)(k.ws + RW_KK);
    const bf16* LO = (const bf16*)(k.ws + RW_LO); bf16* Y = (bf16*)(k.ws + yoff) + (size_t)dir * TA * RD;
    LAS float* buf = (LAS float*)k.lds;
    LAS f32x2* ypart = (LAS f32x2*)(buf + 2 * RS_BUF);
    const int st = tid >> 5, cp = tid & 31, ch = h * RHS + 2 * cp;
    const float ka0 = k_a[l * RD + ch], ka1 = k_a[l * RD + ch + 1];
    const int kq = tid & 15, rp = tid >> 4, v0 = rp * 2;
    f32x2 S00 = {0.f, 0.f}, S01 = {0.f, 0.f}, S10 = {0.f, 0.f}, S11 = {0.f, 0.f};
    RwkvStage sg;
#define RW_LOAD(chunk) do { const int row_ = rwkv_row(b, dir, (chunk) * RS_TOK + st); \
        sg.r = *(const unsigned*)(R + (size_t)row_ * RD + ch); sg.ks = *(const unsigned*)(KS + (size_t)row_ * RD + ch); \
        sg.v = *(const unsigned*)(V + (size_t)row_ * RD + ch); sg.kk = *(const unsigned*)(KK + (size_t)row_ * RD + ch); \
        sg.we = *(const unsigned*)(LO + (size_t)row_ * 4096 + dir * RD + ch); sg.a = *(const unsigned*)(LO + (size_t)row_ * 4096 + 2048 + dir * RD + ch); } while (0)
#define RW_WRITE(bi) do { LAS float* tb = buf + (bi) * RS_BUF + st * RS_TF + 2 * cp; \
        const float a0 = bflo(sg.a), a1 = bfhi(sg.a), kk0 = bflo(sg.kk), kk1 = bfhi(sg.kk), ks0 = bflo(sg.ks), ks1 = bfhi(sg.ks); \
        *(LAS f32x2*)(tb + 0) = (f32x2){kk0, kk1}; \
        *(LAS f32x2*)(tb + 64) = (f32x2){__expf(-bflo(sg.we)), __expf(-bfhi(sg.we))}; \
        *(LAS f32x2*)(tb + 128) = (f32x2){-kk0 * a0, -kk1 * a1}; \
        *(LAS f32x2*)(tb + 192) = (f32x2){ks0 * (1.0f + (a0 - 1.0f) * ka0), ks1 * (1.0f + (a1 - 1.0f) * ka1)}; \
        *(LAS f32x2*)(tb + 256) = (f32x2){bflo(sg.r), bfhi(sg.r)}; \
        *(LAS f32x2*)(tb + 320) = (f32x2){bflo(sg.v), bfhi(sg.v)}; } while (0)
    constexpr int NCHUNK = (CTXL + SEQ) / RS_TOK;
    RW_LOAD(0); RW_WRITE(0);
    __syncthreads();
    for (int c = 0; c < NCHUNK; ++c) {
        if (c + 1 < NCHUNK) RW_LOAD(c + 1);
        const LAS float* cb = buf + (c & 1) * RS_BUF; LAS f32x2* yb = ypart + (c & 1) * RS_TOK * 256 + rp * 8 + (((kq >> 1) ^ (rp >> 2)) & 7);
        {
            const LAS float* tk = cb + kq * 4; const LAS float* tv = cb + 320 + v0;
#define RW_LD(T, kk4, w4, n4, d4, r4, vv) f32x4 kk4 = *(const LAS f32x4*)(tk + (T) * RS_TF), w4 = *(const LAS f32x4*)(tk + (T) * RS_TF + 64), n4 = *(const LAS f32x4*)(tk + (T) * RS_TF + 128), \
                d4 = *(const LAS f32x4*)(tk + (T) * RS_TF + 192), r4 = *(const LAS f32x4*)(tk + (T) * RS_TF + 256); f32x2 vv = *(const LAS f32x2*)(tv + (T) * RS_TF)
#define RW_STEP(T, kk4, w4, n4, d4, r4, vv) do { \
                const f32x2 kka = {kk4.x, kk4.y}, kkb = {kk4.z, kk4.w}, wa = {w4.x, w4.y}, wb = {w4.z, w4.w}, na = {n4.x, n4.y}, nb = {n4.z, n4.w}, da = {d4.x, d4.y}, db = {d4.z, d4.w}, ra = {r4.x, r4.y}, rb = {r4.z, r4.w}; \
                f32x2 p0 = S00 * kka + S01 * kkb, p1 = S10 * kka + S11 * kkb; \
                const f32x2 u00 = S00 * wa + da * vv.x, u01 = S01 * wb + db * vv.x, u10 = S10 * wa + da * vv.y, u11 = S11 * wb + db * vv.y;     \
                const float sa0 = dpp_sum16(p0.x + p0.y), sa1 = dpp_sum16(p1.x + p1.y); \
                S00 = na * sa0 + u00; S01 = nb * sa0 + u01; S10 = na * sa1 + u10; S11 = nb * sa1 + u11; \
                p0 = S00 * ra + S01 * rb; p1 = S10 * ra + S11 * rb; \
                float y0 = p0.x + p0.y, y1 = p1.x + p1.y; \
                y0 += __builtin_bit_cast(float, __builtin_amdgcn_update_dpp(0, __builtin_bit_cast(int, y0), 0xB1, 0xF, 0xF, true)); \
                y1 += __builtin_bit_cast(float, __builtin_amdgcn_update_dpp(0, __builtin_bit_cast(int, y1), 0xB1, 0xF, 0xF, true)); \
                if ((kq & 1) == 0) yb[(T) * 256] = (f32x2){y0, y1}; } while (0)
            RW_LD(0, kkA, wA, nA, dA, rA, vA);
#pragma unroll
            for (int tau = 0; tau < RS_TOK; tau += 2) {
                RW_LD(tau + 1, kkB, wB, nB, dB, rB, vB);
                RW_STEP(tau, kkA, wA, nA, dA, rA, vA);
                if (tau + 2 < RS_TOK) { RW_LD(tau + 2, kkC, wC, nC, dC, rC, vC); kkA = kkC; wA = wC; nA = nC; dA = dC; rA = rC; vA = vC; }
                RW_STEP(tau + 1, kkB, wB, nB, dB, rB, vB);
            }
#undef RW_LD
#undef RW_STEP
        }
        if (c + 1 < NCHUNK) RW_WRITE((c + 1) & 1);
        __syncthreads();
        {
            const int row = rwkv_row(b, dir, c * RS_TOK + st);
            const LAS f32x2* yq = ypart + (c & 1) * RS_TOK * 256 + st * 256 + cp * 8;
            f32x2 acc = yq[(0 ^ (cp >> 2)) & 7];
#pragma unroll
            for (int j = 1; j < 8; ++j) acc += yq[(j ^ (cp >> 2)) & 7];
            *(unsigned*)(Y + (size_t)row * RD + ch) = pk2(acc.x, acc.y);
        }
    }
    __syncthreads();
}

constexpr int GP1 = 136, GP2 = 72;
constexpr int GL_QGS = 0, GL_KGS = GL_QGS + 64 * GP1 * 2, GL_STS = GL_KGS + 64 * GP1 * 2, GL_KET = GL_STS + 64 * GP1 * 2, GL_VT = GL_KET + 128 * GP2 * 2, GL_ATT = GL_VT + 64 * GP2 * 2,
              GL_DECS = GL_ATT + 64 * GP2 * 2, GL_LDS_END = GL_DECS + 512;
static_assert(GL_LDS_END <= 131072, "gla lds");
__device__ __forceinline__ bf16x8 ldfrag(const LAS bf16* base, int row, int pitch, int kofs) { return *(const LAS bf16x8*)(base + row * pitch + kofs); }
__device__ __forceinline__ int gla_prow(int b, int dir, int cp, int tau) {
    const bool lat = cp >= 4; const int q = lat ? cp - 4 : cp, ncn = lat ? 32 : 4, cn = dir ? ncn - 1 - q : q;
    return gla_row(lat, b, dir ? 64 * cn + 63 - tau : 64 * cn + tau);
}
__device__ __forceinline__ int gla_gch(int dir, int cp) { const bool lat = cp >= 4; const int q = lat ? cp - 4 : cp, ncn = lat ? 32 : 4, cn = dir ? ncn - 1 - q : q; return lat ? 4 + cn : cn; }
__device__ __forceinline__ bf16x8 ldfrag_sw(const LAS bf16* base, int row, int g) { return *(const LAS bf16x8*)(base + row * GP2 + ((g ^ ((row >> 3) & 7)) << 3)); }
__device__ __forceinline__ void ph_gla_scan(const KC& k, int job) {
    const int b = job >> 5, h = (job >> 3) & 3, dir = (job >> 2) & 1, dvq = job & 3;
    const int tid = k.tid, w = k.wave, lane = k.lane, q4 = lane >> 4, l15 = lane & 15;
    const bf16* QG = (const bf16*)(k.ws + GL_QG) + (size_t)dir * TA * GKD; const bf16* KG = (const bf16*)(k.ws + GL_KG) + (size_t)dir * TA * GKD;
    const bf16* KE = (const bf16*)(k.ws + GL_KE) + (size_t)dir * TA * GKD; const bf16* VS = (const bf16*)(k.ws + GL_VS);
    const float* DEC = (const float*)(k.ws + GL_DEC); bf16* O = (bf16*)(k.ws + GL_O) + (size_t)dir * TA * GVD;
    LAS bf16* QGs = (LAS bf16*)(k.lds + GL_QGS); LAS bf16* KGs = (LAS bf16*)(k.lds + GL_KGS); LAS bf16* STs = (LAS bf16*)(k.lds + GL_STS);
    LAS bf16* KEt = (LAS bf16*)(k.lds + GL_KET); LAS bf16* Vt = (LAS bf16*)(k.lds + GL_VT); LAS bf16* ATT = (LAS bf16*)(k.lds + GL_ATT); LAS float* decs = (LAS float*)(k.lds + GL_DECS);
    f32x4 accS[4];
#pragma unroll
    for (int t = 0; t < 4; ++t) accS[t] = (f32x4){0.f, 0.f, 0.f, 0.f};
    const int tw = w & 3, wh = w >> 2;
#if GLA_TP
    unsigned long long gtp_acc = 0ull, gtp_t0 = 0ull;
#define GTP_MARK(n) do { if (w == GLA_TPW) { const unsigned long long t_ = __builtin_amdgcn_s_memtime(); if ((n) == GLA_TP) gtp_acc += t_ - gtp_t0; gtp_t0 = t_; } } while (0)
#else
#define GTP_MARK(n) do {} while (0)
#endif
    u32x4 pq[2], pk[2], pe[2], pv; float pd = 0.f;
#if GLA_PF2
    u32x4 nq[2], nk[2], ne[2], nv; float nd = 0.f;
#endif
#define GLA_PREFETCH_TO(CP, Q_, K_, E_, V_, D_) do { _Pragma("unroll") for (int i = 0; i < 2; ++i) { const int idx = tid + 512 * i, tau = idx >> 4, ck = idx & 15; \
            const size_t go = (size_t)gla_prow(b, dir, (CP), tau) * GKD + h * GDK + ck * 8; Q_[i] = *(const u32x4*)(QG + go); K_[i] = *(const u32x4*)(KG + go); E_[i] = *(const u32x4*)(KE + go); } \
        V_ = *(const u32x4*)(VS + (size_t)gla_prow(b, dir, (CP), tid >> 3) * GVD + h * GDV + dvq * 64 + (tid & 7) * 8); \
        if (tid < 128) D_ = DEC[((size_t)(dir * 8 + b) * NCH + gla_gch(dir, (CP))) * GKD + h * GDK + tid]; } while (0)
#define GLA_PREFETCH(CP) GLA_PREFETCH_TO(CP, pq, pk, pe, pv, pd)
    GLA_PREFETCH(0);
#if GLA_PF2
    GLA_PREFETCH_TO(1, nq, nk, ne, nv, nd);
#endif
    for (int cp = 0; cp < NCH; ++cp) {
#define GROW(tau) gla_prow(b, dir, cp, (tau))
        GTP_MARK(0);
#pragma unroll
        for (int i = 0; i < 2; ++i) {
            const int idx = tid + 512 * i, tau = idx >> 4, ck = idx & 15;
            *(LAS u32x4*)(QGs + tau * GP1 + ck * 8) = pq[i];
            *(LAS u32x4*)(KGs + tau * GP1 + ck * 8) = pk[i];
            const unsigned kw[4] = {pe[i].x, pe[i].y, pe[i].z, pe[i].w};
#pragma unroll
            for (int e = 0; e < 4; ++e) { const int ts = tau ^ ((ck & 7) << 3); KEt[(ck * 8 + 2 * e) * GP2 + ts] = (bf16)(kw[e] & 0xffffu); KEt[(ck * 8 + 2 * e + 1) * GP2 + ts] = (bf16)(kw[e] >> 16); }
        }
        {
            const int tau = tid >> 3, ck = tid & 7;
            const unsigned vw[4] = {pv.x, pv.y, pv.z, pv.w};
#pragma unroll
            for (int e = 0; e < 4; ++e) { const int ts = tau ^ (ck << 3); Vt[(ck * 8 + 2 * e) * GP2 + ts] = (bf16)(vw[e] & 0xffffu); Vt[(ck * 8 + 2 * e + 1) * GP2 + ts] = (bf16)(vw[e] >> 16); }
        }
        if (tid < 128) decs[tid] = pd;
#pragma unroll
        for (int t = 0; t < 4; ++t) {
            const int dkt = wh * 4 + t;
            const u32x2 v = {pk2c(accS[t][0], accS[t][1]), pk2c(accS[t][2], accS[t][3])};
            *(LAS u32x2*)(STs + (16 * tw + l15) * GP1 + 16 * dkt + 4 * q4) = v;
        }
#if GLA_PF2
#pragma unroll
        for (int i = 0; i < 2; ++i) { pq[i] = nq[i]; pk[i] = nk[i]; pe[i] = ne[i]; }
        pv = nv; pd = nd;
        __syncthreads();
        if (cp + 2 < NCH) GLA_PREFETCH_TO(cp + 2, nq, nk, ne, nv, nd);
#else
        GTP_MARK(1);
        __syncthreads();
        GTP_MARK(2);
        if (cp + 1 < NCH) GLA_PREFETCH(cp + 1);
#endif
        bf16x8 qf[4];
#pragma unroll
        for (int ks = 0; ks < 4; ++ks) qf[ks] = ldfrag(QGs, 16 * tw + l15, GP1, 32 * ks + 8 * q4);
#pragma unroll
        for (int jj = 0; jj < 2; ++jj) {
            const int it = tw, jt = wh * 2 + jj;
            if (jt > it) {
                if ((jt >> 1) == (it >> 1)) {
#pragma unroll
                    for (int r = 0; r < 4; ++r) ATT[(16 * it + 4 * q4 + r) * GP2 + 16 * jt + l15] = (bf16)0;
                }
                continue;
            }
            f32x4 acc = (f32x4){0.f, 0.f, 0.f, 0.f};
#pragma unroll
            for (int ks = 0; ks < 4; ++ks) acc = __builtin_amdgcn_mfma_f32_16x16x32_bf16(qf[ks], ldfrag(KGs, 16 * jt + l15, GP1, 32 * ks + 8 * q4), acc, 0, 0, 0);
#pragma unroll
            for (int r = 0; r < 4; ++r) { const int i = 16 * it + 4 * q4 + r, j = 16 * jt + l15; ATT[i * GP2 + j] = (bf16)f2bf(j <= i ? acc[r] : 0.f); }
        }
        GTP_MARK(3);
        __syncthreads();
        GTP_MARK(4);
        const int nks = tw >= 2 ? 2 : 1;
        bf16x8 af[2];
#pragma unroll
        for (int ks = 0; ks < 2; ++ks) if (ks < nks) af[ks] = ldfrag(ATT, 16 * tw + l15, GP2, 32 * ks + 8 * q4);
#pragma unroll
        for (int dd = 0; dd < 2; ++dd) {
            const int it = tw, dvt = wh * 2 + dd;
            f32x4 acc = (f32x4){0.f, 0.f, 0.f, 0.f};
#pragma unroll
            for (int ks = 0; ks < 4; ++ks) acc = __builtin_amdgcn_mfma_f32_16x16x32_bf16(qf[ks], ldfrag(STs, 16 * dvt + l15, GP1, 32 * ks + 8 * q4), acc, 0, 0, 0);
#pragma unroll
            for (int ks = 0; ks < 2; ++ks) if (ks < nks) acc = __builtin_amdgcn_mfma_f32_16x16x32_bf16(af[ks], ldfrag_sw(Vt, 16 * dvt + l15, 4 * ks + q4), acc, 0, 0, 0);
#pragma unroll
            for (int r = 0; r < 4; ++r) { const int i = 16 * it + 4 * q4 + r; O[(size_t)GROW(i) * GVD + h * GDV + dvq * 64 + 16 * dvt + l15] = (bf16)f2bf(acc[r]); }
        }
        GTP_MARK(5);
#pragma unroll
        for (int t = 0; t < 4; ++t) {
            const int dkt = wh * 4 + t; const f32x4 d = *(const LAS f32x4*)(decs + 16 * dkt + 4 * q4);
            accS[t] = accS[t] * d;
#pragma unroll
            for (int ks = 0; ks < 2; ++ks) accS[t] = __builtin_amdgcn_mfma_f32_16x16x32_bf16(ldfrag_sw(KEt, 16 * dkt + l15, 4 * ks + q4), ldfrag_sw(Vt, 16 * tw + l15, 4 * ks + q4), accS[t], 0, 0, 0);
        }
        GTP_MARK(6);
        __syncthreads();
        GTP_MARK(7);
#undef GROW
    }
#if GLA_TP
    if (w == GLA_TPW) { const unsigned long long t0 = __builtin_amdgcn_s_memtime(); while (__builtin_amdgcn_s_memtime() - t0 < gtp_acc) __builtin_amdgcn_s_sleep(8); }
    __syncthreads();
#endif
#undef GLA_PREFETCH
#undef GLA_PREFETCH_TO
}

#ifndef RWKV_MODE
#define RWKV_MODE 2
#endif
#ifndef HB_FULL
#define HB_FULL 0
#endif
#ifndef GLA4_LEVEL
#define GLA4_LEVEL 0
#endif
#ifndef GLA4_NOSTORE
#define GLA4_NOSTORE 0
#endif
#ifndef SWAP_HALVES
#define SWAP_HALVES 0
#endif
#ifndef SPLIT_SCAN
#define SPLIT_SCAN 0
#endif
constexpr int RS4_TOK = 8, RS4_BUF = RS4_TOK * RS_TF;
constexpr int SC_GL = 0;
constexpr int SC_RW = 96 * 1024;
constexpr int SC_END = SC_RW + 2 * RS4_BUF * 4 + 2 * RS4_TOK * 64 * 4;
static_assert(SC_GL + GL_LDS_END <= SC_RW, "scan lds halves");
constexpr int SC_CTR = 127 * 1024;
static_assert(SC_END <= SC_CTR && SC_CTR + 128 <= 131072, "scan lds");
__device__ __forceinline__ void half_bar(LAS unsigned* ctr, unsigned& gen, int lane) {
#if HB_FULL
    (void)ctr; (void)lane; gen += 4u; __syncthreads(); return;
#endif
    gen += 4u;
    __builtin_amdgcn_fence(__ATOMIC_RELEASE, "workgroup");
    if (lane == 0) __hip_atomic_fetch_add(ctr, 1u, __ATOMIC_RELAXED, __HIP_MEMORY_SCOPE_WORKGROUP);
    unsigned spins = 0;
    while (__hip_atomic_load(ctr, __ATOMIC_RELAXED, __HIP_MEMORY_SCOPE_WORKGROUP) < gen) { __builtin_amdgcn_s_sleep(1); if (++spins > (1u << 26)) break; }
    __builtin_amdgcn_fence(__ATOMIC_ACQUIRE, "workgroup");
}
#ifndef RW4_SHFL
#define RW4_SHFL 0
#endif
__device__ __forceinline__ float shfl_sum16(float x) { x += __shfl_xor(x, 1); x += __shfl_xor(x, 2); x += __shfl_xor(x, 4); x += __shfl_xor(x, 8); return x; }
#if RW4_SHFL
#define RW4_SUM16(x) shfl_sum16(x)
#else
#define RW4_SUM16(x) dpp_sum16(x)
#endif
__device__ __forceinline__ void rwkv_scan_4w(const KC& k, int l, int job, const float* k_a, LAS unsigned* ctr) {
    const int b = job >> 5, h = (job >> 1) & 15, dir = job & 1;
    const int tid = k.tid, lane = k.lane;
    const bf16* R = (const bf16*)(k.ws + RW_R); const bf16* KS = (const bf16*)(k.ws + RW_KS); const bf16* V = (const bf16*)(k.ws + RW_V); const bf16* KK = (const bf16*)(k.ws + RW_KK);
    const bf16* LO = (const bf16*)(k.ws + RW_LO); bf16* Y = (bf16*)(k.ws + RW_Y) + (size_t)dir * TA * RD;
    LAS float* buf = (LAS float*)(k.lds + SC_RW);
    LAS float* ybuf = buf + 2 * RS4_BUF;
    const int st = tid >> 5, cp = tid & 31, ch = h * RHS + 2 * cp;
    const float ka0 = k_a[l * RD + ch], ka1 = k_a[l * RD + ch + 1];
    const int kq = tid & 15, v0 = (tid >> 4) * 4;
    f32x2 S[4][2];
#pragma unroll
    for (int i = 0; i < 4; ++i) { S[i][0] = (f32x2){0.f, 0.f}; S[i][1] = (f32x2){0.f, 0.f}; }
    RwkvStage sg[1];
    unsigned gen = 0;
#define RW4_LOAD(chunk) do { _Pragma("unroll") for (int q_ = 0; q_ < 1; ++q_) { const int row_ = rwkv_row(b, dir, (chunk) * RS4_TOK + st); \
        sg[q_].r = *(const unsigned*)(R + (size_t)row_ * RD + ch); sg[q_].ks = *(const unsigned*)(KS + (size_t)row_ * RD + ch); \
        sg[q_].v = *(const unsigned*)(V + (size_t)row_ * RD + ch); sg[q_].kk = *(const unsigned*)(KK + (size_t)row_ * RD + ch); \
        sg[q_].we = *(const unsigned*)(LO + (size_t)row_ * 4096 + dir * RD + ch); sg[q_].a = *(const unsigned*)(LO + (size_t)row_ * 4096 + 2048 + dir * RD + ch); } } while (0)
#define RW4_WRITE(bi) do { _Pragma("unroll") for (int q_ = 0; q_ < 1; ++q_) { LAS float* tb = buf + (bi) * RS4_BUF + st * RS_TF + 2 * cp; \
        const float a0 = bflo(sg[q_].a), a1 = bfhi(sg[q_].a), kk0 = bflo(sg[q_].kk), kk1 = bfhi(sg[q_].kk), ks0 = bflo(sg[q_].ks), ks1 = bfhi(sg[q_].ks); \
        *(LAS f32x2*)(tb + 0) = (f32x2){kk0, kk1}; \
        *(LAS f32x2*)(tb + 64) = (f32x2){__expf(-bflo(sg[q_].we)), __expf(-bfhi(sg[q_].we))}; \
        *(LAS f32x2*)(tb + 128) = (f32x2){-kk0 * a0, -kk1 * a1}; \
        *(LAS f32x2*)(tb + 192) = (f32x2){ks0 * (1.0f + (a0 - 1.0f) * ka0), ks1 * (1.0f + (a1 - 1.0f) * ka1)}; \
        *(LAS f32x2*)(tb + 256) = (f32x2){bflo(sg[q_].r), bfhi(sg[q_].r)}; \
        *(LAS f32x2*)(tb + 320) = (f32x2){bflo(sg[q_].v), bfhi(sg[q_].v)}; } } while (0)
    constexpr int NCHUNK = (CTXL + SEQ) / RS4_TOK;
    RW4_LOAD(0); RW4_WRITE(0);
    half_bar(ctr, gen, lane);
    for (int c = 0; c < NCHUNK; ++c) {
        if (c + 1 < NCHUNK) RW4_LOAD(c + 1);
        const LAS float* cb = buf + (c & 1) * RS4_BUF; LAS float* yb = ybuf + (c & 1) * RS4_TOK * 64;
        {
            const LAS float* tk = cb + kq * 4; const LAS float* tv = cb + 320 + v0;
#define RW4_LD(T, kk4, w4, n4, d4, r4, vv) f32x4 kk4 = *(const LAS f32x4*)(tk + (T) * RS_TF), w4 = *(const LAS f32x4*)(tk + (T) * RS_TF + 64), n4 = *(const LAS f32x4*)(tk + (T) * RS_TF + 128), \
                d4 = *(const LAS f32x4*)(tk + (T) * RS_TF + 192), r4 = *(const LAS f32x4*)(tk + (T) * RS_TF + 256), vv = *(const LAS f32x4*)(tv + (T) * RS_TF)
#define RW4_STEP(T, kk4, w4, n4, d4, r4, vv) do { \
                const f32x2 kka = {kk4.x, kk4.y}, kkb = {kk4.z, kk4.w}, wa = {w4.x, w4.y}, wb = {w4.z, w4.w}, na = {n4.x, n4.y}, nb = {n4.z, n4.w}, da = {d4.x, d4.y}, db = {d4.z, d4.w}, ra = {r4.x, r4.y}, rb = {r4.z, r4.w}; \
                float sa[4], yy[4]; f32x2 u0[4], u1[4]; \
                _Pragma("unroll") for (int i = 0; i < 4; ++i) { const f32x2 p = S[i][0] * kka + S[i][1] * kkb; sa[i] = p.x + p.y; u0[i] = S[i][0] * wa + da * vv[i]; u1[i] = S[i][1] * wb + db * vv[i]; } \
                _Pragma("unroll") for (int i = 0; i < 4; ++i) sa[i] = RW4_SUM16(sa[i]); \
                _Pragma("unroll") for (int i = 0; i < 4; ++i) { S[i][0] = na * sa[i] + u0[i]; S[i][1] = nb * sa[i] + u1[i]; const f32x2 q = S[i][0] * ra + S[i][1] * rb; yy[i] = q.x + q.y; } \
                _Pragma("unroll") for (int i = 0; i < 4; ++i) yy[i] = RW4_SUM16(yy[i]); \
                if (kq == 0) *(LAS f32x4*)(yb + (T) * 64 + v0) = (f32x4){yy[0], yy[1], yy[2], yy[3]}; } while (0)
            RW4_LD(0, kkA, wA, nA, dA, rA, vA);
#pragma unroll
            for (int tau = 0; tau < RS4_TOK; tau += 2) {
                RW4_LD(tau + 1, kkB, wB, nB, dB, rB, vB);
                RW4_STEP(tau, kkA, wA, nA, dA, rA, vA);
                if (tau + 2 < RS4_TOK) { RW4_LD(tau + 2, kkC, wC, nC, dC, rC, vC); kkA = kkC; wA = wC; nA = nC; dA = dC; rA = rC; vA = vC; }
                RW4_STEP(tau + 1, kkB, wB, nB, dB, rB, vB);
            }
#undef RW4_LD
#undef RW4_STEP
        }
        if (c + 1 < NCHUNK) RW4_WRITE((c + 1) & 1);
        half_bar(ctr, gen, lane);
        {
            const int row = rwkv_row(b, dir, c * RS4_TOK + st);
            const f32x2 yy = *(const LAS f32x2*)(yb + st * 64 + 2 * cp);
            *(unsigned*)(Y + (size_t)row * RD + ch) = pk2(yy.x, yy.y);
        }
    }
#undef RW4_LOAD
#undef RW4_WRITE
}
__device__ __forceinline__ void gla_scan_4w(const KC& k, int job, LAS unsigned* ctr) {
    const int b = job >> 5, h = (job >> 3) & 3, dir = (job >> 2) & 1, dvq = job & 3;
    const int tid = k.tid - 256, w = k.wave - 4, lane = k.lane, q4 = lane >> 4, l15 = lane & 15;
    const bf16* QG = (const bf16*)(k.ws + GL_QG) + (size_t)dir * TA * GKD; const bf16* KG = (const bf16*)(k.ws + GL_KG) + (size_t)dir * TA * GKD;
    const bf16* KE = (const bf16*)(k.ws + GL_KE) + (size_t)dir * TA * GKD; const bf16* VS = (const bf16*)(k.ws + GL_VS);
    const float* DEC = (const float*)(k.ws + GL_DEC); bf16* O = (bf16*)(k.ws + GL_O) + (size_t)dir * TA * GVD;
    LAS unsigned char* gl = k.lds + SC_GL;
    LAS bf16* QGs = (LAS bf16*)(gl + GL_QGS); LAS bf16* KGs = (LAS bf16*)(gl + GL_KGS); LAS bf16* STs = (LAS bf16*)(gl + GL_STS);
    LAS bf16* KEt = (LAS bf16*)(gl + GL_KET); LAS bf16* Vt = (LAS bf16*)(gl + GL_VT); LAS bf16* ATT = (LAS bf16*)(gl + GL_ATT); LAS float* decs = (LAS float*)(gl + GL_DECS);
    f32x4 accS[8];
#pragma unroll
    for (int t = 0; t < 8; ++t) accS[t] = (f32x4){0.f, 0.f, 0.f, 0.f};
    unsigned gen = 0;
#if GLA4_LEVEL == 2
    { float x = (float)lane; for (int i = 0; i < 200000; ++i) { x = x * 1.0001f + 0.5f; asm volatile("" : "+v"(x)); } asm volatile("" :: "v"(x)); (void)ctr; (void)gen; }
    return;
#endif
#if GLA4_LEVEL == 1
    for (int cp = 0; cp < NCH; ++cp) { float x = (float)lane; for (int i = 0; i < 2000; ++i) x = x * 1.0001f + 0.5f; asm volatile("" :: "v"(x)); half_bar(ctr, gen, lane); half_bar(ctr, gen, lane); half_bar(ctr, gen, lane); }
    return;
#endif
    for (int cp = 0; cp < NCH; ++cp) {
        const bool lat = cp >= 4; const int q = lat ? cp - 4 : cp, ncn = lat ? 32 : 4, cn = dir ? ncn - 1 - q : q, gch = lat ? 4 + cn : cn;
#define GROW(tau) gla_row(lat, b, dir ? 64 * cn + 63 - (tau) : 64 * cn + (tau))
#pragma unroll
        for (int i = 0; i < 4; ++i) {
            const int idx = tid + 256 * i, tau = idx >> 4, ck = idx & 15; const size_t go = (size_t)GROW(tau) * GKD + h * GDK + ck * 8;
            *(LAS u32x4*)(QGs + tau * GP1 + ck * 8) = *(const u32x4*)(QG + go);
            *(LAS u32x4*)(KGs + tau * GP1 + ck * 8) = *(const u32x4*)(KG + go);
            const u32x4 ke = *(const u32x4*)(KE + go);
            const unsigned kw[4] = {ke.x, ke.y, ke.z, ke.w};
#pragma unroll
            for (int e = 0; e < 4; ++e) { KEt[(ck * 8 + 2 * e) * GP2 + tau] = (bf16)(kw[e] & 0xffffu); KEt[(ck * 8 + 2 * e + 1) * GP2 + tau] = (bf16)(kw[e] >> 16); }
        }
#pragma unroll
        for (int i = 0; i < 2; ++i) {
            const int idx = tid + 256 * i, tau = idx >> 3, ck = idx & 7;
            const u32x4 vv = *(const u32x4*)(VS + (size_t)GROW(tau) * GVD + h * GDV + dvq * 64 + ck * 8);
            const unsigned vw[4] = {vv.x, vv.y, vv.z, vv.w};
#pragma unroll
            for (int e = 0; e < 4; ++e) { Vt[(ck * 8 + 2 * e) * GP2 + tau] = (bf16)(vw[e] & 0xffffu); Vt[(ck * 8 + 2 * e + 1) * GP2 + tau] = (bf16)(vw[e] >> 16); }
        }
        if (tid < 128) decs[tid] = DEC[((size_t)(dir * 8 + b) * NCH + gch) * GKD + h * GDK + tid];
#pragma unroll
        for (int t = 0; t < 8; ++t) {
#pragma unroll
            for (int r = 0; r < 4; ++r) STs[(16 * w + 4 * q4 + r) * GP1 + 16 * t + l15] = (bf16)f2bf(accS[t][r]);
        }
        half_bar(ctr, gen, lane);
#pragma unroll
        for (int jt = 0; jt < 4; ++jt) {
            f32x4 acc = (f32x4){0.f, 0.f, 0.f, 0.f};
#pragma unroll
            for (int ks = 0; ks < 4; ++ks) acc = __builtin_amdgcn_mfma_f32_16x16x32_bf16(ldfrag(QGs, 16 * w + l15, GP1, 32 * ks + 8 * q4), ldfrag(KGs, 16 * jt + l15, GP1, 32 * ks + 8 * q4), acc, 0, 0, 0);
#pragma unroll
            for (int r = 0; r < 4; ++r) { const int i = 16 * w + 4 * q4 + r, j = 16 * jt + l15; ATT[i * GP2 + j] = (bf16)f2bf(j <= i ? acc[r] : 0.f); }
        }
        half_bar(ctr, gen, lane);
#pragma unroll
        for (int dvt = 0; dvt < 4; ++dvt) {
            f32x4 acc = (f32x4){0.f, 0.f, 0.f, 0.f};
#pragma unroll
            for (int ks = 0; ks < 4; ++ks) acc = __builtin_amdgcn_mfma_f32_16x16x32_bf16(ldfrag(QGs, 16 * w + l15, GP1, 32 * ks + 8 * q4), ldfrag(STs, 16 * dvt + l15, GP1, 32 * ks + 8 * q4), acc, 0, 0, 0);
#pragma unroll
            for (int ks = 0; ks < 2; ++ks) acc = __builtin_amdgcn_mfma_f32_16x16x32_bf16(ldfrag(ATT, 16 * w + l15, GP2, 32 * ks + 8 * q4), ldfrag(Vt, 16 * dvt + l15, GP2, 32 * ks + 8 * q4), acc, 0, 0, 0);
#pragma unroll
#if GLA4_NOSTORE
            asm volatile("" :: "v"(acc[0]), "v"(acc[1]), "v"(acc[2]), "v"(acc[3]));
#else
            for (int r = 0; r < 4; ++r) { const int i = 16 * w + 4 * q4 + r; O[(size_t)GROW(i) * GVD + h * GDV + dvq * 64 + 16 * dvt + l15] = (bf16)f2bf(acc[r]); }
#endif
        }
#pragma unroll
        for (int t = 0; t < 8; ++t) {
            const float d = decs[16 * t + l15];
            accS[t] = accS[t] * d;
#pragma unroll
            for (int ks = 0; ks < 2; ++ks) accS[t] = __builtin_amdgcn_mfma_f32_16x16x32_bf16(ldfrag(Vt, 16 * w + l15, GP2, 32 * ks + 8 * q4), ldfrag(KEt, 16 * t + l15, GP2, 32 * ks + 8 * q4), accS[t], 0, 0, 0);
        }
        half_bar(ctr, gen, lane);
#undef GROW
    }
#if HB_FULL
    for (int i = 0; i < (1 + (CTXL + SEQ) / RS4_TOK) - 3 * NCH; ++i) __syncthreads();
#endif
}
__device__ __forceinline__ void ph_scan_split(const KC& k, int l, const float* k_a) {
    LAS unsigned* ctr = (LAS unsigned*)(k.lds + SC_CTR);
    for (int job = k.bid; job < 256; job += k.G) {
        if (k.tid == 0) { ctr[0] = 0u; ctr[16] = 0u; }
        __syncthreads();
#if SPLIT_SCAN == 1 || SPLIT_SCAN == 4 || SPLIT_SCAN == 5 || SPLIT_SCAN == 6
#if SWAP_HALVES
        { KC k2 = k; if (k.wave >= 4) { k2.tid = k.tid - 256; k2.wave = k.wave - 4; rwkv_scan_4w(k2, l, job, k_a, ctr); } else { k2.tid = k.tid + 256; k2.wave = k.wave + 4; gla_scan_4w(k2, job, ctr + 16); } }
#else
        if (k.wave < 4) rwkv_scan_4w(k, l, job, k_a, ctr); else gla_scan_4w(k, job, ctr + 16);
#endif
        __syncthreads();
#if SPLIT_SCAN == 6
        ph_rwkv_scan(k, l, job, k_a, WS_H);
#elif SPLIT_SCAN == 4
        ph_rwkv_scan(k, l, job, k_a);
#elif SPLIT_SCAN == 5
        ph_gla_scan(k, job);
#endif
#elif SPLIT_SCAN == 2
        if (k.wave < 4) rwkv_scan_4w(k, l, job, k_a, ctr);
        __syncthreads();
        ph_gla_scan(k, job);
#else
        if (k.wave >= 4) gla_scan_4w(k, job, ctr + 16);
        __syncthreads();
        ph_rwkv_scan(k, l, job, k_a);
#endif
    }
}

__device__ __forceinline__ void ph_post(const KC& k, int l, int nrows, const float* ln_g, const float* ln_b, const float* gng) {
    const int gw = k.bid * 8 + k.wave, NGW = k.G * 8, lane = k.lane, c = 16 * lane;
    const bf16* P = (const bf16*)(k.ws + WS_P);
    const bf16* Y = (const bf16*)(k.ws + RW_Y); const bf16* V = (const bf16*)(k.ws + RW_V); const float* BON = (const float*)(k.ws + RW_BON); bf16* YNB = (bf16*)(k.ws + RW_R);
    const bf16* O = (const bf16*)(k.ws + GL_O); bf16* YB = (bf16*)(k.ws + GL_VS);
    for (int row = gw; row < nrows; row += NGW) {
        {
            float yf[16], yb[16], vv[16], y[16];
            ld16(Y + (size_t)row * RD + c, true, yf); ld16(Y + ((size_t)TA + row) * RD + c, true, yb); ld16(V + (size_t)row * RD + c, true, vv);
            float s = 0.f;
#pragma unroll
            for (int i = 0; i < 16; ++i) { y[i] = yf[i] + yb[i]; s += y[i]; }
            s += __shfl_xor(s, 1); s += __shfl_xor(s, 2);
            const float mean = s * (1.0f / 64.0f); float q = 0.f;
#pragma unroll
            for (int i = 0; i < 16; ++i) { y[i] -= mean; q += y[i] * y[i]; }
            q += __shfl_xor(q, 1); q += __shfl_xor(q, 2);
            const float rstd = 1.0f / sqrtf(q * (1.0f / 64.0f) + 64e-5f), bon = BON[(size_t)row * RHEADS + (lane >> 2)];
#pragma unroll
            for (int i = 0; i < 16; ++i) y[i] = y[i] * rstd * ln_g[l * RD + c + i] + ln_b[l * RD + c + i] + bon * vv[i];
            st16(YNB + (size_t)row * RD + c, y);
        }
        {
            float of[16], ob[16], gt[16], o[16];
            ld16(O + (size_t)row * GVD + c, true, of); ld16(O + ((size_t)TA + row) * GVD + c, true, ob); ld16(P + (size_t)row * NP + GLA_GATE_OFF + c, true, gt);
            float s = 0.f;
#pragma unroll
            for (int i = 0; i < 16; ++i) { o[i] = of[i] + ob[i]; s += o[i] * o[i]; }
            s += __shfl_xor(s, 1); s += __shfl_xor(s, 2); s += __shfl_xor(s, 4); s += __shfl_xor(s, 8);
            const float rinv = 1.0f / sqrtf(s * (1.0f / 256.0f) + 1e-6f);
#pragma unroll
            for (int i = 0; i < 16; ++i) o[i] = o[i] * rinv * gng[l * GDV + ((c + i) & 255)] * siluf(gt[i]);
            st16(YB + (size_t)row * GVD + c, o);
        }
    }
}

#ifndef CHUNK_LOADS_FIRST
#define CHUNK_LOADS_FIRST 1
#endif
#ifndef TIMEPROBE
#define TIMEPROBE 0
#endif
#ifndef CHUNK_PF
#define CHUNK_PF 0
#endif
#ifndef SUBST_PK
#define SUBST_PK 0
#endif
#ifndef CONS_UNROLL
#define CONS_UNROLL 1
#endif
#ifndef CHUNK_NOPS
#define CHUNK_NOPS 0
#endif
#ifndef PROD_PK
#define PROD_PK 0
#endif
#ifndef LDS_POISON
#define LDS_POISON 0
#endif
#ifndef CHUNK_DBG
#define CHUNK_DBG 0
#endif
constexpr int RC_XT = 0;
constexpr int RC_YH = RC_XT + 32 * 72 * 2;
constexpr int RC_BET = RC_YH + 64 * 24 * 2;
constexpr int RC_AM = RC_YH + 2 * 64 * 24 * 2;
constexpr int RC_P2 = RC_AM + 2048;
constexpr int RC_AKR = RC_P2 + 512;
constexpr int RC_ABR = RC_AKR + 512;
constexpr int RC_GC = RC_ABR + 512;
constexpr int RC_SLOT = RC_GC + 256;
static_assert(RC_SLOT == 14592 && 8 * RC_SLOT <= 131072 && 32 * 72 * 2 <= 2 * 64 * 24 * 2, "rwkv chunk lds");
__device__ __forceinline__ bf16x8 mk8(u32x2 lo, u32x2 hi) { u32x4 v = {lo.x, lo.y, hi.x, hi.y}; return __builtin_bit_cast(bf16x8, v); }
__device__ __forceinline__ int rwkv_chunk_rmin(int b, int dir, int c) {
    const int p0 = c * 16;
    if (p0 < CTXL) return TL + b * CTXL + (dir ? CTXL - 16 - p0 : p0);
    const int q = p0 - CTXL; return b * SEQ + (dir ? SEQ - 16 - q : q);
}
__device__ __forceinline__ unsigned f2bf_hi(float f) { return __float_as_uint(f) + 0x8000u; }
#ifndef FAST_RND
#define FAST_RND 1
#endif
#ifndef USE_RCP
#define USE_RCP 1
#endif
#ifndef CHUNK_SADDR
#define CHUNK_SADDR 1
#endif
#ifndef Y_SADDR
#define Y_SADDR 2
#endif
#if FAST_RND
#define BFH(x) ((bf16)(f2bf_hi(x) >> 16))
#else
#define BFH(x) ((bf16)f2bf(x))
#endif
template <int SKIP = 0>
__device__ __forceinline__ void ph_rwkv_chunk(const KC& k, int l, int job, const float* k_a, size_t yoff = RW_Y) {
    const int b = job >> 5, h = (job >> 1) & 15, dir = job & 1;
    const int w = k.wave, lane = k.lane, q4 = lane >> 4, l15 = lane & 15;
    const bf16* R = (const bf16*)(k.ws + RW_R); const bf16* KS = (const bf16*)(k.ws + RW_KS); const bf16* V = (const bf16*)(k.ws + RW_V); const bf16* KK = (const bf16*)(k.ws + RW_KK);
    const bf16* LO = (const bf16*)(k.ws + RW_LO); bf16* Y = (bf16*)(k.ws + yoff) + (size_t)dir * TA * RD;
    LAS unsigned char* slot = k.lds + w * RC_SLOT;
    LAS bf16* XT = (LAS bf16*)(slot + RC_XT); LAS bf16* YH = (LAS bf16*)(slot + RC_YH);
    LAS float* AM = (LAS float*)(slot + RC_AM);
    const int ch = h * RHS + lane;
    const float ka = k_a[l * RD + ch];
    f32x4 accZ[4];
#pragma unroll
    for (int t = 0; t < 4; ++t) accZ[t] = (f32x4){0.f, 0.f, 0.f, 0.f};
    constexpr int NCK = (CTXL + SEQ) / 16, NRND = NCK / 8;
#if TIMEPROBE
    unsigned long long tp_acc = 0ull, tp_t0 = 0ull;
#define TP_MARK(n) do { if (w == 0) { const unsigned long long t_ = __builtin_amdgcn_s_memtime(); if ((n) == TIMEPROBE) tp_acc += t_ - tp_t0; tp_t0 = t_; } } while (0)
#else
#define TP_MARK(n) do {} while (0)
#endif
    unsigned ylane[4];
#pragma unroll
    for (int r = 0; r < 4; ++r) { const int tk = 4 * q4 + r; ylane[r] = (unsigned)(((dir ? 15 - tk : tk) * RD + h * RHS + 16 * (w & 3) + l15) * 2); }
#if CHUNK_PF
    unsigned pf0 = 0u, pf1 = 0u, pf2 = 0u;
#endif
#if LDS_POISON
    for (int i = lane; i < RC_SLOT / 4; i += 64) ((LAS unsigned*)slot)[i] = 0x7fc07fc0u;
    __syncthreads();
#endif
    for (int rnd = 0; rnd < NRND; ++rnd) {
#if LDS_POISON
        for (int i = lane; i < RC_SLOT / 4; i += 64) ((LAS unsigned*)slot)[i] = 0x7fc07fc0u;
#endif
        TP_MARK(0);
        if (!(SKIP & 2)) {
            const int c = rnd * 8 + w;
            float Lc = 0.f, Eprev = 1.f;
            unsigned vp[8];
#if CHUNK_LOADS_FIRST
            unsigned rv[16], rkk[16], re[16], ra[16], rks[16], rr[16];
            float bhe[16], khe[16];
            const unsigned rmin = (unsigned)rwkv_chunk_rmin(b, dir, c);
            const unsigned ob1 = (rmin * (unsigned)RD + (unsigned)ch) * 2u, ob4 = (rmin * 4096u + (unsigned)(dir * RD) + (unsigned)ch) * 2u;
            const char* LOa = (const char*)LO + 4096;
#pragma unroll
            for (int t = 0; t < 16; ++t) {
#if CHUNK_SADDR
                const unsigned tr = dir ? 15u - t : (unsigned)t;
                const unsigned o1 = ob1 + tr * (unsigned)(RD * 2), o4 = ob4 + tr * 8192u;
                if (SKIP & 4) { rv[t] = o1; rkk[t] = o1 >> 3; re[t] = 0x3c00u + (o4 & 255u); ra[t] = 0x3f00u; rks[t] = o1 >> 5; rr[t] = o1 >> 7; }
                else { rv[t] = *(const bf16*)((const char*)V + o1); rkk[t] = *(const bf16*)((const char*)KK + o1); re[t] = *(const bf16*)((const char*)LO + o4); ra[t] = *(const bf16*)(LOa + o4);
                       rks[t] = *(const bf16*)((const char*)KS + o1); rr[t] = *(const bf16*)((const char*)R + o1); }
#else
                const unsigned o1 = (unsigned)rwkv_row(b, dir, c * 16 + t) * (unsigned)RD + (unsigned)ch, o4 = o1 * 4u - 3u * (unsigned)ch + (unsigned)(dir * RD);
                if (SKIP & 4) { rv[t] = o1; rkk[t] = o1 >> 3; re[t] = 0x3c00u + (o4 & 255u); ra[t] = 0x3f00u; rks[t] = o1 >> 5; rr[t] = o1 >> 7; }
                else { rv[t] = V[o1]; rkk[t] = KK[o1]; re[t] = LO[o4]; ra[t] = LO[o4 + 2048u]; rks[t] = KS[o1]; rr[t] = R[o1]; }
#endif
            }
            asm volatile("" ::: "memory");
            const float omka = 1.0f - ka;
#pragma unroll
            for (int t = 0; t < ((SKIP & 16) ? 1 : 16); ++t) {
                { const unsigned vraw = rv[t]; vp[t >> 1] = (t & 1) ? (vp[t >> 1] | (vraw << 16)) : vraw; }
                const float kkv = bf2f(rkk[t]), ev = bf2f(re[t]), av = bf2f(ra[t]);
                const float ksv = bf2f(rks[t]), rv_ = bf2f(rr[t]);
                Lc -= ev;
#if USE_RCP
                const float E = __expf(Lc), Einv = __builtin_amdgcn_rcpf(E);
#else
                const float E = __expf(Lc), Einv = __expf(-Lc);
#endif
                XT[t * 72 + lane] = BFH(kkv * Eprev); XT[(16 + t) * 72 + lane] = BFH(rv_ * E);
                const float bh_ = kkv * av * Einv, kh_ = ksv * __builtin_fmaf(av, ka, omka) * Einv;
                YH[t * 72 + lane] = BFH(bh_); YH[(16 + t) * 72 + lane] = BFH(kh_);
                bhe[t] = bh_; khe[t] = kh_;
                Eprev = E;
            }
#else
#pragma unroll
            for (int t = 0; t < 16; ++t) {
                const unsigned o1 = (unsigned)rwkv_row(b, dir, c * 16 + t) * (unsigned)RD + (unsigned)ch, o4 = o1 * 4u - 3u * (unsigned)ch + (unsigned)(dir * RD);
                { const unsigned vraw = V[o1]; vp[t >> 1] = (t & 1) ? (vp[t >> 1] | (vraw << 16)) : vraw; }
                const float kkv = bf2f(KK[o1]), ev = bf2f(LO[o4]), av = bf2f(LO[o4 + 2048u]);
                const float ksv = bf2f(KS[o1]), rv = bf2f(R[o1]);
                Lc -= ev;
                const float E = __expf(Lc), Einv = __expf(-Lc);
                XT[t * 72 + lane] = (bf16)f2bf(kkv * Eprev); XT[(16 + t) * 72 + lane] = (bf16)f2bf(rv * E);
                YH[t * 72 + lane] = (bf16)f2bf(kkv * av * Einv); YH[(16 + t) * 72 + lane] = (bf16)f2bf(ksv * (1.0f + (av - 1.0f) * ka) * Einv);
                Eprev = E;
            }
#endif
            const float eLC = Eprev;
            asm volatile("s_waitcnt lgkmcnt(0)" ::: "memory");
            TP_MARK(1);
#if CHUNK_PF
            if (w >= 4) {
                const int cn0 = (rnd + 1 < NRND ? rnd + 1 : rnd) * 8;
                int ln = lane; asm volatile("" : "+v"(ln));
                auto pf_off = [&](int j) -> unsigned {
                    const int i = (w - 4) * 192 + j * 64 + ln, cc = i / 96, wi = i - cc * 96, ar = wi >> 4, tk = wi & 15;
                    const unsigned row = (unsigned)rwkv_row(b, dir, (cn0 + cc) * 16 + tk);
                    const unsigned base = ar == 0 ? (unsigned)RW_R : ar == 1 ? (unsigned)RW_KS : ar == 2 ? (unsigned)RW_V : ar == 3 ? (unsigned)RW_KK : (unsigned)RW_LO;
                    const unsigned el = ar < 4 ? row * (unsigned)RD + (unsigned)(h * RHS) : row * 4096u + (unsigned)(dir * RD + h * RHS) + (unsigned)(ar - 4) * 2048u;
                    return base + 2u * el; };
                const unsigned q0 = pf_off(0), q1 = pf_off(1), q2 = pf_off(2);
                asm volatile("global_load_dword %0, %3, %6\n\tglobal_load_dword %1, %4, %6\n\tglobal_load_dword %2, %5, %6" : "+v"(pf0), "+v"(pf1), "+v"(pf2) : "v"(q0), "v"(q1), "v"(q2), "s"(k.ws) : "memory");
            }
#endif
            f32x4 am[2][2];
#pragma unroll
            for (int rt = 0; rt < 2; ++rt)
#pragma unroll
                for (int ct = 0; ct < 2; ++ct) {
                    f32x4 acc = (f32x4){0.f, 0.f, 0.f, 0.f};
#pragma unroll
                    for (int s = 0; s < ((SKIP & 32) ? 0 : 2); ++s) acc = __builtin_amdgcn_mfma_f32_16x16x32_bf16(*(const LAS bf16x8*)(XT + (16 * rt + l15) * 72 + 32 * s + 8 * q4), *(const LAS bf16x8*)(YH + (16 * ct + l15) * 72 + 32 * s + 8 * q4), acc, 0, 0, 0);
                    am[rt][ct] = acc;
                }
#if CHUNK_LOADS_FIRST
            if (!(SKIP & 64)) {
                const float nel = -eLC;
#pragma unroll
                for (int q = 0; q < 4; ++q) {
                    u32x4 v = {pk2(khe[4 * q] * eLC, khe[4 * q + 1] * eLC), pk2(khe[4 * q + 2] * eLC, khe[4 * q + 3] * eLC), pk2(bhe[4 * q] * nel, bhe[4 * q + 1] * nel), pk2(bhe[4 * q + 2] * nel, bhe[4 * q + 3] * nel)};
                    *(LAS u32x4*)(slot + RC_YH + lane * 96 + q * 16) = v;
                }
            }
#endif
            LAS bf16* AKR = (LAS bf16*)(slot + RC_AKR); LAS bf16* ABR = (LAS bf16*)(slot + RC_ABR);
#pragma unroll
            for (int r = 0; r < 4; ++r) {
                const int t = 4 * q4 + r, j = l15;
                AM[t * 16 + j] = j < t ? am[0][0][r] : 0.f;
                AM[256 + t * 16 + j] = j < t ? am[0][1][r] : 0.f;
#if PROD_PK
                const unsigned ab2 = pk2c(j <= t ? -am[1][0][r] : 0.f, j <= t ? am[1][1][r] : 0.f);
                ABR[t * 16 + j] = (bf16)(ab2 & 0xffffu);
                AKR[t * 16 + j] = (bf16)(ab2 >> 16);
#else
                ABR[t * 16 + j] = BFH(j <= t ? -am[1][0][r] : 0.f);
                AKR[t * 16 + j] = BFH(j <= t ? am[1][1][r] : 0.f);
#endif
            }
            asm volatile("s_waitcnt lgkmcnt(0)" ::: "memory");
            TP_MARK(2);
#if SUBST_PK
            f32x2 PP[16]; float kt[16];
#pragma unroll
            for (int t = 0; t < 16; ++t) kt[t] = bf2f(XT[t * 72 + lane]);
#pragma unroll
            for (int t = 0; t < 16; ++t) {
                asm volatile("" ::: "memory");
                f32x2 p = {kt[t], AM[256 + t * 16 + l15]};
#pragma unroll
                for (int j4 = 0; j4 < (t + 3) / 4; ++j4) {
                    const f32x4 arow = *(const LAS f32x4*)(AM + t * 16 + 4 * j4);
#pragma unroll
                    for (int e = 0; e < 4; ++e) { const int j = 4 * j4 + e; if (j < t) p -= PP[j] * arow[e]; }
                }
                PP[t] = p;
            }
#else
            float P1[16], P2[16], kt[16];
#pragma unroll
            for (int t = 0; t < 16; ++t) kt[t] = bf2f(XT[t * 72 + lane]);
#pragma unroll
            for (int t = 0; t < 16; ++t) {
                asm volatile("" ::: "memory");
                float p1 = kt[t], p2 = AM[256 + t * 16 + l15];
#pragma unroll
                for (int j4 = 0; j4 < (t + 3) / 4; ++j4) {
                    const f32x4 arow = *(const LAS f32x4*)(AM + t * 16 + 4 * j4);
#pragma unroll
                    for (int e = 0; e < 4; ++e) { const int j = 4 * j4 + e; if (j < t && !(SKIP & 8)) { p1 -= arow[e] * P1[j]; p2 -= arow[e] * P2[j]; } }
                }
                P1[t] = p1; P2[t] = p2;
            }
#endif
            LAS bf16* P2b = (LAS bf16*)(slot + RC_P2);
#pragma unroll
#if PROD_PK
            for (int t = 0; t < 16; ++t) { const unsigned pp = pk2c(0.f, 0.f); XT[t * 72 + lane] = (bf16)(pp & 0xffffu); if (lane < 16) P2b[t * 16 + lane] = (bf16)(pp >> 16); }
#else
#if SUBST_PK
            for (int t = 0; t < 16; ++t) { if (CHUNK_DBG != 12) XT[t * 72 + lane] = (bf16)f2bf(CHUNK_DBG == 13 ? 1.0f + (float)t : PP[t].x); if (lane < 16) P2b[t * 16 + lane] = (bf16)f2bf(PP[t].y); }
#else
            for (int t = 0; t < 16; ++t) { XT[t * 72 + lane] = BFH(P1[t]); if (lane < 16) P2b[t * 16 + lane] = BFH(P2[t]); }
#endif
#endif
            if (!(SKIP & 64)) {
                ((LAS float*)(slot + RC_GC))[lane] = eLC;
                *(LAS u32x4*)(slot + RC_AM + lane * 32) = (u32x4){vp[0], vp[1], vp[2], vp[3]}; *(LAS u32x4*)(slot + RC_AM + lane * 32 + 16) = (u32x4){vp[4], vp[5], vp[6], vp[7]};
            }
        }
        TP_MARK(3);
        __syncthreads();
        TP_MARK(4);
        if (w < 4 && !(SKIP & 1)) {
#if Y_SADDR == 2
            unsigned yoff[4]; const unsigned ystep = dir ? 0u - (unsigned)(16 * RD * 2) : (unsigned)(16 * RD * 2);
            { const unsigned yb = (unsigned)rwkv_chunk_rmin(b, dir, rnd * 8) * (unsigned)(RD * 2);
#pragma unroll
              for (int r = 0; r < 4; ++r) yoff[r] = yb + ylane[r]; }
#endif
#if CONS_UNROLL == 2
#pragma unroll 2
#else
#pragma unroll 1
#endif
            for (int cc = 0; cc < 8; ++cc) {
                const int c = rnd * 8 + cc;
                LAS unsigned char* sl = k.lds + cc * RC_SLOT;
                const LAS bf16* P1b = (const LAS bf16*)(sl + RC_XT); const LAS bf16* RTb = P1b + 16 * 72;
                const LAS bf16* P2b = (const LAS bf16*)(sl + RC_P2); const LAS bf16* AKR = (const LAS bf16*)(sl + RC_AKR); const LAS bf16* ABR = (const LAS bf16*)(sl + RC_ABR);
                const LAS float* GC = (const LAS float*)(sl + RC_GC);
                const u32x2 vfr = *(const LAS u32x2*)(sl + RC_AM + (16 * w + l15) * 32 + 8 * q4);
                const unsigned vlo = vfr.x, vhi = vfr.y;
#if CHUNK_DBG == 5
                for (int t = 0; t < 4; ++t) accZ[t] = (f32x4){0.f, 0.f, 0.f, 0.f};
#endif
#if CHUNK_NOPS
                asm volatile("s_nop 15\n\ts_nop 15" ::: "memory");
#endif
                bf16x8 bz[2];
#pragma unroll
                for (int s = 0; s < 2; ++s) { u32x4 v = {pk2c(accZ[2 * s][0], accZ[2 * s][1]), pk2c(accZ[2 * s][2], accZ[2 * s][3]), pk2c(accZ[2 * s + 1][0], accZ[2 * s + 1][1]), pk2c(accZ[2 * s + 1][2], accZ[2 * s + 1][3])}; bz[s] = __builtin_bit_cast(bf16x8, v); }
#if CHUNK_DBG == 6
                bz[0] = (bf16x8){0,0,0,0,0,0,0,0}; bz[1] = bz[0];
#endif
                const u32x2 zero2 = {0u, 0u};
                f32x4 zs[4];
#pragma unroll
                for (int t = 0; t < 4; ++t) zs[t] = accZ[t] * *(const LAS f32x4*)(GC + 16 * t + 4 * q4);
#if CHUNK_DBG == 7
                for (int t = 0; t < 4; ++t) zs[t] = (f32x4){0.f, 0.f, 0.f, 0.f};
#endif
                f32x4 sa = (f32x4){0.f, 0.f, 0.f, 0.f};
#if CHUNK_DBG >= 10 && CHUNK_DBG <= 13
                { u32x4 ones = {0x3f803f80u, 0x3f803f80u, 0x3f803f80u, 0x3f803f80u}; const bf16x8 bo = __builtin_bit_cast(bf16x8, ones);
                  for (int s = 0; s < 2; ++s) sa = __builtin_amdgcn_mfma_f32_16x16x32_bf16(mk8(*(const LAS u32x2*)(P1b + l15 * 72 + 32 * s + 4 * q4), *(const LAS u32x2*)(P1b + l15 * 72 + 32 * s + 16 + 4 * q4)), (CHUNK_DBG == 10 || CHUNK_DBG == 12 || CHUNK_DBG == 13) ? bo : bz[s], sa, 0, 0, 0); }
#else
#pragma unroll
                for (int s = 0; s < 2; ++s) if (CHUNK_DBG != 3 && CHUNK_DBG != 9) sa = __builtin_amdgcn_mfma_f32_16x16x32_bf16(mk8(*(const LAS u32x2*)(P1b + l15 * 72 + 32 * s + 4 * q4), *(const LAS u32x2*)(P1b + l15 * 72 + 32 * s + 16 + 4 * q4)), bz[s], sa, 0, 0, 0);
#endif
                if (CHUNK_DBG != 4 && !(CHUNK_DBG >= 10 && CHUNK_DBG <= 13)) { u32x4 bv = {vlo, vhi, 0u, 0u}; sa = __builtin_amdgcn_mfma_f32_16x16x32_bf16(mk8(*(const LAS u32x2*)(P2b + l15 * 16 + 4 * q4), zero2), __builtin_bit_cast(bf16x8, bv), sa, 0, 0, 0); }
#if CHUNK_DBG == 1
                sa = (f32x4){0.f, 0.f, 0.f, 0.f};
#endif
#if CHUNK_NOPS
                asm volatile("s_nop 15" : "+v"(sa));
#endif
                bf16x8 bv2; { u32x4 v = {vlo, vhi, pk2c(sa[0], sa[1]), pk2c(sa[2], sa[3])}; bv2 = __builtin_bit_cast(bf16x8, v); }
                f32x4 yy = (f32x4){0.f, 0.f, 0.f, 0.f};
#pragma unroll
                for (int s = 0; s < 2; ++s) if (CHUNK_DBG != 8) yy = __builtin_amdgcn_mfma_f32_16x16x32_bf16(mk8(*(const LAS u32x2*)(RTb + l15 * 72 + 32 * s + 4 * q4), *(const LAS u32x2*)(RTb + l15 * 72 + 32 * s + 16 + 4 * q4)), bz[s], yy, 0, 0, 0);
                yy = __builtin_amdgcn_mfma_f32_16x16x32_bf16(mk8(*(const LAS u32x2*)(AKR + l15 * 16 + 4 * q4), *(const LAS u32x2*)(ABR + l15 * 16 + 4 * q4)), bv2, yy, 0, 0, 0);
#pragma unroll
                for (int t = 0; t < 4; ++t) {
                    accZ[t] = __builtin_amdgcn_mfma_f32_16x16x32_bf16(*(const LAS bf16x8*)(sl + RC_YH + (16 * t + l15) * 96 + q4 * 16), bv2, zs[t], 0, 0, 0);
                }
#if CHUNK_DBG == 2
                yy = (f32x4){1.f, 1.f, 1.f, 1.f};
#endif
#if CHUNK_DBG >= 10 && CHUNK_DBG <= 13
                yy = sa;
#endif
#if CHUNK_NOPS
                asm volatile("s_nop 15" : "+v"(yy));
#endif
#if Y_SADDR == 2
#pragma unroll
                for (int r = 0; r < 4; ++r) { *(bf16*)((char*)Y + yoff[r]) = BFH(yy[r]); yoff[r] += ystep; }
#elif Y_SADDR
                { const unsigned yb = (unsigned)rwkv_chunk_rmin(b, dir, c) * (unsigned)(RD * 2);
#pragma unroll
                  for (int r = 0; r < 4; ++r) *(bf16*)((char*)Y + (yb + ylane[r])) = BFH(yy[r]); }
#else
#pragma unroll
                for (int r = 0; r < 4; ++r) Y[(size_t)rwkv_row(b, dir, c * 16 + 4 * q4 + r) * RD + h * RHS + 16 * w + l15] = BFH(yy[r]);
#endif
            }
        }
#if CHUNK_PF
        else asm volatile("s_waitcnt vmcnt(0)" : "+v"(pf0), "+v"(pf1), "+v"(pf2) :: "memory");
#endif
        TP_MARK(5);
        __syncthreads();
        TP_MARK(6);
    }
#if TIMEPROBE
    if (l == 0 && w == 0) { const unsigned long long t0 = __builtin_amdgcn_s_memtime(); while (__builtin_amdgcn_s_memtime() - t0 < tp_acc) __builtin_amdgcn_s_sleep(8); }
    __syncthreads();
#endif
}

#ifndef CHECK_EXACT
#define CHECK_EXACT 0
#endif
#ifndef CHECK_PMAX
#define CHECK_PMAX (CTXL + SEQ)
#endif
#ifndef CHECK_PMIN
#define CHECK_PMIN 0
#endif
#ifndef CHECK_UNIT
#define CHECK_UNIT 1000
#endif
__device__ __forceinline__ void rwkv_check_delay(const KC& k, int job, size_t refoff = RW_Y) {
    const int b = job >> 5, h = (job >> 1) & 15, dir = job & 1;
    const bf16* Ya = (const bf16*)(k.ws + refoff) + (size_t)dir * TA * RD; const bf16* Yb = (const bf16*)(k.ws + WS_H) + (size_t)dir * TA * RD;
    float d2 = 0.f, s2 = 0.f; int bad = 0;
    for (int i = k.tid; i < (CHECK_PMAX) * 32; i += 512) {
        const int p = (CHECK_PMIN) + (i >> 5), cp = i & 31; const size_t o = (size_t)rwkv_row(b, dir, p) * RD + h * RHS + 2 * cp;
        const unsigned ua = *(const unsigned*)(Ya + o), ub = *(const unsigned*)(Yb + o);
        const float a0 = bflo(ua), a1 = bfhi(ua), b0 = bflo(ub), b1 = bfhi(ub);
        d2 += (CHECK_EXACT) ? (ua != ub ? 1.0f : 0.0f) : (a0 - b0) * (a0 - b0) + (a1 - b1) * (a1 - b1); s2 += a0 * a0 + a1 * a1;
        if (!(b0 == b0) || !(b1 == b1) || fabsf(b0) > 1e30f || fabsf(b1) > 1e30f) bad = 1;
    }
    LAS float* red = (LAS float*)k.lds;
    __syncthreads();
    d2 = wave_sum(d2); s2 = wave_sum(s2); bad = __any(bad) ? 1 : 0;
    if (k.lane == 0) { red[k.wave * 4] = d2; red[k.wave * 4 + 1] = s2; red[k.wave * 4 + 2] = (float)bad; }
    __syncthreads();
    if (k.tid == 0) {
        float D = 0.f, S = 0.f, B = 0.f;
        for (int i = 0; i < 8; ++i) { D += red[i * 4]; S += red[i * 4 + 1]; B += red[i * 4 + 2]; }
        const float rel = sqrtf(D / fmaxf(S, 1e-30f));
        int bucket = rel < 0.01f ? 0 : rel < 0.03f ? 1 : rel < 0.1f ? 2 : rel < 0.3f ? 3 : rel < 1.0f ? 4 : 5;
        if (CHECK_EXACT) bucket = D == 0.f ? 0 : D < 10.f ? 1 : D < 100.f ? 2 : D < 1000.f ? 3 : D < 10000.f ? 4 : 5;
        if (B > 0.f || !(rel == rel)) bucket = 6;
        const unsigned long long t0 = __builtin_amdgcn_s_memrealtime(), wait = (unsigned long long)bucket * (CHECK_UNIT) * 100ull;
        while (__builtin_amdgcn_s_memrealtime() - t0 < wait) __builtin_amdgcn_s_sleep(8);
    }
    __syncthreads();
}
using pg8::Unit;
struct FP_ { bf16* P; __device__ __forceinline__ void operator()(int row, int col, float (&v)[8], const Unit&) const { *(u32x4*)(P + (size_t)row * NP + col) = pack8(v); } };
struct FL1_ { bf16* LO; const float* bias1;
    __device__ __forceinline__ void operator()(int row, int col, float (&v)[8], const Unit& u) const {
        const float* bias = bias1 + col;
        const f32x4 b0 = *(const f32x4*)bias, b1 = *(const f32x4*)(bias + 4);
        const float bb[8] = {b0.x, b0.y, b0.z, b0.w, b1.x, b1.y, b1.z, b1.w};
        const float sc = col < 2048 ? 0.6065306597126334f : 1.0f;
#pragma unroll
        for (int i = 0; i < 8; ++i) v[i] = sigm(bb[i] + v[i]) * sc;
        *(u32x4*)(LO + (size_t)row * 4096 + col) = pack8(v);
    } };
struct FL2_ { const bf16* YNB; bf16* YA;
    __device__ __forceinline__ void operator()(int row, int col, float (&v)[8], const Unit&) const {
        float y[8]; unpack8(*(const u32x4*)(YNB + (size_t)row * RD + col), y);
#pragma unroll
        for (int i = 0; i < 8; ++i) v[i] *= y[i];
        *(u32x4*)(YA + (size_t)row * RD + col) = pack8(v);
    } };
template <int SECOND> struct FM_ { const bf16* P; bf16* MA; bf16* OUT;
    __device__ __forceinline__ void operator()(int row, int col, float (&v)[8], const Unit&) const {
        float g[8]; unpack8(*(const u32x4*)(P + (size_t)row * NP + BR_OFF + SECOND * DM + col), g);
        const bf16* mp = MA + (size_t)row * DM + col;
        if (SECOND) { float m[8]; unpack8(*(const u32x4*)mp, m);
#pragma unroll
            for (int i = 0; i < 8; ++i) v[i] = sigm(g[i]) * v[i] + m[i]; }
        else {
#pragma unroll
            for (int i = 0; i < 8; ++i) v[i] = sigm(g[i]) * v[i]; }
        *(u32x4*)(OUT + (size_t)row * DM + col) = pack8(v);
    } };
struct FX_ { float* X; const float* MOD; int l; float* OUT;
    __device__ __forceinline__ void operator()(int row, int col, const f32x4 v, const Unit&) const {
        const f32x4 g = *(const f32x4*)(MOD + ((size_t)l * 9 + mod_row(row)) * MOD_N + 2 * DM + col);
        const f32x4* xp = (const f32x4*)(X + (size_t)row * DM + col);
        *(f32x4*)(OUT + (size_t)row * DM + col) = *xp + g * v;
    } };
struct FXb_ { bf16* X; const float* MOD; int l;
    __device__ __forceinline__ void operator()(int row, int col, float (&v)[8], const Unit&) const {
        const float* gp = MOD + ((size_t)l * 9 + mod_row(row)) * MOD_N + 2 * DM + col;
        const f32x4 g0 = *(const f32x4*)gp, g1 = *(const f32x4*)(gp + 4);
        const float gg[8] = {g0.x, g0.y, g0.z, g0.w, g1.x, g1.y, g1.z, g1.w};
        bf16* xp = X + (size_t)row * DM + col;
        float x[8]; unpack8(*(const u32x4*)xp, x);
#pragma unroll
        for (int i = 0; i < 8; ++i) v[i] = x[i] + gg[i] * v[i];
        *(u32x4*)xp = pack8(v);
    } };
struct FE1_ { bf16* ACT;
    __device__ __forceinline__ void operator()(int row, int col, float (&g)[8], float (&up)[8]) const {
#pragma unroll
        for (int i = 0; i < 8; ++i) g[i] = siluf(g[i]) * up[i];
        *(u32x4*)(ACT + (size_t)row * DEXP + col) = pack8(g);
    } };
struct FE2_ { const int* rowtok; const float* roww; bf16* YF;
    __device__ __forceinline__ void operator()(int row, int col, float (&v)[8], const Unit&) const {
        const int t2 = rowtok[row];
        if (t2 >= 0) { const float w = roww[row];
#pragma unroll
            for (int i = 0; i < 8; ++i) v[i] *= w;
            *(u32x4*)(YF + ((size_t)(t2 & 1) * TA + (t2 >> 1)) * DM + col) = pack8(v); }
    } };

#ifndef GA_
#define GA_ true
#endif
#ifndef GS_
#define GS_ true
#endif
constexpr int LDS_BYTES = 147456;
constexpr int MISC_OFF = 131072 + 4096;

constexpr int NPHASE = 2 + 14 * DEPTH + 1;
struct Args { const float* in[N_IN]; float* out; unsigned char* ws; int ph_lo, ph_hi; };
static_assert(sizeof(Args) == N_IN * 8 + 8 + 8 + 8, "Args has no padding");

__global__ void __launch_bounds__(512, 2) fwd(Args a) {
    extern __shared__ __attribute__((aligned(16))) unsigned char lds_raw[];
    KC k;
    k.lds = (LAS unsigned char*)lds_raw; k.ws = (unsigned char*)INP(N_IN + 1);
    k.tid = threadIdx.x; k.lane = k.tid & 63; k.wave = __builtin_amdgcn_readfirstlane(k.tid >> 6); k.G = gridDim.x; k.bid = blockIdx.x;
    const int lo = a.ph_lo, hi = a.ph_hi;
    volatile LAS unsigned* MISC = (volatile LAS unsigned*)(k.lds + MISC_OFF);
    if (k.tid < 32) MISC[k.tid] = 0u;
    __syncthreads();
    XcdBarrier bar; bar.bar = (unsigned*)(k.ws + WS_CTL) + CW_BAR; bar.x = 0; bar.st = nullptr;
    if (hi - lo > 1) bar = xcd_barrier_post((unsigned*)(k.ws + WS_CTL) + CW_BAR, MISC + 8);
#ifndef SITE_MASK
#define SITE_MASK 0xFFFFFFFFu
#endif
#define FRESH() do { int t_ = threadIdx.x; asm volatile("" : "+v"(t_)); k.tid = t_; k.lane = t_ & 63; k.wave = __builtin_amdgcn_readfirstlane(t_ >> 6); k.ws = (unsigned char*)INP(N_IN + 1); ws = k.ws; } while (0)
#define PH_BEGIN(p, site) if (((SITE_MASK >> (site)) & 1u) && lo <= (p) && (p) < hi) { FRESH();
#ifndef EXTRA_BARS
#define EXTRA_BARS 0
#endif
#ifndef DUP_MASK
#define DUP_MASK 0u
#endif
#define DUPRUN(n, stmt) do { stmt; if ((DUP_MASK >> (n)) & 1u) { __syncthreads(); stmt; } } while (0)
#define PH_END(p) if ((p) + 1 < hi) xcd_barrier(bar); }
    unsigned char* ws = k.ws;
    LAS unsigned char* glds = k.lds;
#define WSRC WSrc{INP(I_WIN), INP(I_W2), INP(I_A2), INP(I_G2), INP(I_WBA), INP(I_WBB), INP(I_WOUT), INP(I_EG), INP(I_EU), INP(I_ED), INP(I_W0), INP(I_A0)}

    PH_BEGIN(0, 0) DUPRUN(0, ph_adaln_partials(k, INP(I_C), INP(I_CCTX), INP(I_WADA))); DUPRUN(1, ph_convert(k, WSRC, 0)); PH_END(0)
    PH_BEGIN(1, 1) ph_adaln_reduce(k, INP(I_BADA)); PH_END(1)

#define L_ 0
    {
        constexpr int l = L_;
        const int pb = 2 + 14 * l;
        const bool last = (l == DEPTH - 1);
        const int Mpost = last ? TL : TA;
        PH_BEGIN(pb + 0, 2)
            if (l > 0) { DUPRUN(1, ph_convert(k, WSRC, l)); }
            RowArgs ra{INP(I_X), INP(I_CTX), INP(I_NMG), nullptr, nullptr, nullptr};
            ph_rows<0>(k, ra, l, TA);
            if (l == 0 && ((DUP_MASK >> 15) & 1u)) { __syncthreads(); ph_rows<0>(k, ra, l, TA); }
        PH_END(pb + 0)
        PH_BEGIN(pb + 1, 3)
            pg8::Gemm g{(const bf16*)(ws + WS_H), (const bf16*)(ws + WT_IN), TA, NP, DM, 0}; pg8::StaticOrder S; S.init(TA, NP, k.G, k.bid);
            pg8::Epi8<FP_> E{FP_{(bf16*)(ws + WS_P)}};
            DUPRUN(2, (pg8::gemm_phase<pg8::Epi8<FP_>, pg8::StaticOrder, GA_, GS_>(glds, g, S, E)));
        PH_END(pb + 1)
        PH_BEGIN(pb + 2, 4)
            DUPRUN(3, ph_rwkv_prep(k, l, TA, INP(I_MU), INP(I_KK), INP(I_RK)));
            DUPRUN(4, ph_gla_prep(k, l, INP(I_GCONV), INP(I_GAW2), INP(I_GAB)));
        PH_END(pb + 2)
        PH_BEGIN(pb + 3, 5)
            pg8::Gemm g{(const bf16*)(ws + RW_A1), (const bf16*)(ws + WT_L1), TA, 4096, 256, 0}; pg8::StaticOrder S; S.init(TA, 4096, k.G, k.bid);
            pg8::Epi8<FL1_> E{FL1_{(bf16*)(ws + RW_LO), (const float*)(ws + WS_TAB + TAB_TOP)}};
            DUPRUN(5, (pg8::gemm_phase<pg8::Epi8<FL1_>, pg8::StaticOrder, GA_, GS_>(glds, g, S, E)));
        PH_END(pb + 3)
        PH_BEGIN(pb + 4, 6)
#if SPLIT_SCAN
            DUPRUN(6, ph_scan_split(k, l, INP(I_KA)));
#else
            for (int vb = ((k.G & 7) ? k.bid : (k.bid & 7) * (k.G >> 3) + (k.bid >> 3)); vb < 256; vb += k.G) { const int job = vb;
#if RWKV_MODE == 0
                DUPRUN(6, ph_rwkv_scan(k, l, job, INP(I_KA)));
#elif RWKV_MODE == 1
                ph_rwkv_scan(k, l, job, INP(I_KA)); ph_rwkv_chunk(k, l, job, INP(I_KA), WS_H); if (l == 0) rwkv_check_delay(k, job);
#elif RWKV_MODE == 4
                ph_rwkv_scan(k, l, job, INP(I_KA)); ph_rwkv_chunk(k, l, job, INP(I_KA), WS_H); ph_rwkv_chunk(k, l, job, INP(I_KA), WS_END); if (l == 0) rwkv_check_delay(k, job, WS_END);
#elif RWKV_MODE == 5
#pragma unroll 1
                for (int rep = 0; rep < 2; ++rep) { int r_ = rep; asm volatile("" : "+s"(r_)); __syncthreads(); ph_rwkv_chunk(k, l, job, INP(I_KA), r_ ? (size_t)RW_Y : (size_t)WS_H); }
                if (l == 0) rwkv_check_delay(k, job);
#elif RWKV_MODE == 3
                ph_rwkv_scan(k, l, job, INP(I_KA)); ph_rwkv_scan(k, l, job, INP(I_KA), WS_H); if (l == 0) rwkv_check_delay(k, job);
#else
                DUPRUN(6, ph_rwkv_chunk(k, l, job, INP(I_KA)));
#ifdef CHUNK_PROBE
                __syncthreads(); ph_rwkv_chunk<CHUNK_PROBE>(k, l, job, INP(I_KA), WS_END);
#endif
#endif
            }
#ifndef NO_GLA
            FRESH();
            for (int vb = ((k.G & 7) ? k.bid : (k.bid & 7) * (k.G >> 3) + (k.bid >> 3)); vb < 256; vb += k.G) { const int job = vb; DUPRUN(7, ph_gla_scan(k, job)); }
#endif
#endif
        PH_END(pb + 4)
        PH_BEGIN(pb + 5, 7)
            DUPRUN(8, ph_post(k, l, Mpost, INP(I_LNG), INP(I_LNB), INP(I_GNG)));
        PH_END(pb + 5)
        PH_BEGIN(pb + 6, 8)
            pg8::Gemm g{(const bf16*)(ws + RW_A2), (const bf16*)(ws + WT_G2), Mpost, RD, 256, 0}; pg8::StaticOrder S; S.init(Mpost, RD, k.G, k.bid);
            pg8::Epi8<FL2_> E{FL2_{(const bf16*)(ws + RW_R), (bf16*)(ws + RW_V)}};
            DUPRUN(9, (pg8::gemm_phase<pg8::Epi8<FL2_>, pg8::StaticOrder, GA_, GS_>(glds, g, S, E)));
        PH_END(pb + 6)
        PH_BEGIN(pb + 7, 9)
            pg8::Gemm g{(const bf16*)(ws + RW_V), (const bf16*)(ws + WT_A), Mpost, DM, RD, 0}; pg8::StaticOrder S; S.init(Mpost, DM, k.G, k.bid);
            pg8::Epi8<FM_<0>> E{FM_<0>{(const bf16*)(ws + WS_P), (bf16*)(ws + WS_H), (bf16*)(ws + WS_H)}};
            DUPRUN(10, (pg8::gemm_phase<pg8::Epi8<FM_<0>>, pg8::StaticOrder, GA_, GS_>(glds, g, S, E)));
        PH_END(pb + 7)
        PH_BEGIN(pb + 8, 10)
            pg8::Gemm g{(const bf16*)(ws + GL_VS), (const bf16*)(ws + WT_B), Mpost, DM, GVD, 0}; pg8::StaticOrder S; S.init(Mpost, DM, k.G, k.bid);
            pg8::Epi8<FM_<1>> E{FM_<1>{(const bf16*)(ws + WS_P), (bf16*)(ws + WS_H), (bf16*)(ws + WS_H)}};
            pg8::gemm_phase<pg8::Epi8<FM_<1>>, pg8::StaticOrder, GA_, GS_>(glds, g, S, E);
            if ((DUP_MASK >> 17) & 1u) { __syncthreads(); pg8::Epi8<FM_<1>> E2{FM_<1>{(const bf16*)(ws + WS_P), (bf16*)(ws + WS_H), (bf16*)(ws + RW_R)}}; pg8::gemm_phase<pg8::Epi8<FM_<1>>, pg8::StaticOrder, GA_, GS_>(glds, g, S, E2); }
        PH_END(pb + 8)
        PH_BEGIN(pb + 9, 11)
            pg8::Gemm g{(const bf16*)(ws + WS_H), (const bf16*)(ws + WT_O), Mpost, DM, DM, 0}; pg8::StaticOrder S; S.init(Mpost, DM, k.G, k.bid);
#if XBF
            pg8::Epi8<FXb_> E{FXb_{(bf16*)(ws + WS_X), (const float*)(ws + WS_MOD), l}};
            pg8::gemm_phase<pg8::Epi8<FXb_>, pg8::StaticOrder, GA_, GS_>(glds, g, S, E);
#else
            pg8::Epi4<FX_> E{FX_{(float*)(ws + WS_X), (const float*)(ws + WS_MOD), l, (float*)(ws + WS_X)}};
            pg8::gemm_phase<pg8::Epi4<FX_>, pg8::StaticOrder, GA_, GS_>(glds, g, S, E);
#endif
            if (!XBF && ((DUP_MASK >> 18) & 1u)) { __syncthreads(); pg8::Epi4<FX_> E2{FX_{(float*)(ws + WS_X), (const float*)(ws + WS_MOD), l, (float*)(ws + WS_P)}}; pg8::gemm_phase<pg8::Epi4<FX_>, pg8::StaticOrder, GA_, GS_>(glds, g, S, E2); }
        PH_END(pb + 9)
        PH_BEGIN(pb + 10, 12)
            RowArgs ra{nullptr, nullptr, INP(I_NFG), INP(I_RW), INP(I_RB), nullptr};
            ph_rows<1>(k, ra, l, Mpost);
            if ((DUP_MASK >> 16) & 1u) { __syncthreads(); ph_rows<1>(k, ra, l, Mpost, true); }
        PH_END(pb + 10)
        PH_BEGIN(pb + 11, 13)
            DUPRUN(13, ph_moe_scatter(k, l, Mpost));
        PH_END(pb + 11)
        PH_BEGIN(pb + 12, 14)
#if MOE_GATHER
            pg8::Gemm g{(const bf16*)(ws + WS_H), (const bf16*)(ws + WT_GU), 0, 2816, DM, (size_t)2816 * DM * 2};
            pg8::MoeOrderT<true> S; S.rowtok = (const int*)(ws + WS_TAB + TAB_ROWTOK) + (size_t)l * MOE_ROWS;
            S.init((const int*)(ws + WS_TAB + TAB_TILE) + 256 * l, 11, k.G, ((k.G & 7) ? k.bid : (k.bid & 7) * (k.G >> 3) + (k.bid >> 3)));
            pg8::EpiGU<FE1_> E{FE1_{(bf16*)(ws + WS_ACT)}};
            DUPRUN(11, (pg8::gemm_phase<pg8::EpiGU<FE1_>, pg8::MoeOrderT<true>, GA_, GS_>(glds, g, S, E)));
#else
            pg8::Gemm g{(const bf16*)(ws + WS_HP), (const bf16*)(ws + WT_GU), 0, 2816, DM, (size_t)2816 * DM * 2};
            pg8::MoeOrder S; S.init((const int*)(ws + WS_TAB + TAB_TILE) + 256 * l, 11, k.G, ((k.G & 7) ? k.bid : (k.bid & 7) * (k.G >> 3) + (k.bid >> 3)));
            pg8::EpiGU<FE1_> E{FE1_{(bf16*)(ws + WS_ACT)}};
            DUPRUN(11, (pg8::gemm_phase<pg8::EpiGU<FE1_>, pg8::MoeOrder, GA_, GS_>(glds, g, S, E)));
#endif
        PH_END(pb + 12)
        PH_BEGIN(pb + 13, 15)
            pg8::Gemm g{(const bf16*)(ws + WS_ACT), (const bf16*)(ws + WT_D), 0, DM, DEXP, (size_t)DM * DEXP * 2};
            pg8::MoeOrder S; S.init((const int*)(ws + WS_TAB + TAB_TILE) + 256 * l, 8, k.G, ((k.G & 7) ? k.bid : (k.bid & 7) * (k.G >> 3) + (k.bid >> 3)));
            pg8::Epi8<FE2_> E{FE2_{(const int*)(ws + WS_TAB + TAB_ROWTOK) + (size_t)l * MOE_ROWS, (const float*)(ws + WS_TAB + TAB_ROWW) + (size_t)l * MOE_ROWS, (bf16*)(ws + WS_YF)}};
            DUPRUN(12, (pg8::gemm_phase<pg8::Epi8<FE2_>, pg8::MoeOrder, GA_, GS_>(glds, g, S, E)));
        PH_END(pb + 13)
        }
#undef L_
#define L_ 1
    {
        constexpr int l = L_;
        const int pb = 2 + 14 * l;
        const bool last = (l == DEPTH - 1);
        const int Mpost = last ? TL : TA;
        PH_BEGIN(pb + 0, 2)
            if (l > 0) { DUPRUN(1, ph_convert(k, WSRC, l)); }
            RowArgs ra{INP(I_X), INP(I_CTX), INP(I_NMG), nullptr, nullptr, nullptr};
            ph_rows<0>(k, ra, l, TA);
            if (l == 0 && ((DUP_MASK >> 15) & 1u)) { __syncthreads(); ph_rows<0>(k, ra, l, TA); }
        PH_END(pb + 0)
        PH_BEGIN(pb + 1, 3)
            pg8::Gemm g{(const bf16*)(ws + WS_H), (const bf16*)(ws + WT_IN), TA, NP, DM, 0}; pg8::StaticOrder S; S.init(TA, NP, k.G, k.bid);
            pg8::Epi8<FP_> E{FP_{(bf16*)(ws + WS_P)}};
            DUPRUN(2, (pg8::gemm_phase<pg8::Epi8<FP_>, pg8::StaticOrder, GA_, GS_>(glds, g, S, E)));
        PH_END(pb + 1)
        PH_BEGIN(pb + 2, 4)
            DUPRUN(3, ph_rwkv_prep(k, l, TA, INP(I_MU), INP(I_KK), INP(I_RK)));
            DUPRUN(4, ph_gla_prep(k, l, INP(I_GCONV), INP(I_GAW2), INP(I_GAB)));
        PH_END(pb + 2)
        PH_BEGIN(pb + 3, 5)
            pg8::Gemm g{(const bf16*)(ws + RW_A1), (const bf16*)(ws + WT_L1), TA, 4096, 256, 0}; pg8::StaticOrder S; S.init(TA, 4096, k.G, k.bid);
            pg8::Epi8<FL1_> E{FL1_{(bf16*)(ws + RW_LO), (const float*)(ws + WS_TAB + TAB_TOP)}};
            DUPRUN(5, (pg8::gemm_phase<pg8::Epi8<FL1_>, pg8::StaticOrder, GA_, GS_>(glds, g, S, E)));
        PH_END(pb + 3)
        PH_BEGIN(pb + 4, 6)
#if SPLIT_SCAN
            DUPRUN(6, ph_scan_split(k, l, INP(I_KA)));
#else
            for (int vb = ((k.G & 7) ? k.bid : (k.bid & 7) * (k.G >> 3) + (k.bid >> 3)); vb < 256; vb += k.G) { const int job = vb;
#if RWKV_MODE == 0
                DUPRUN(6, ph_rwkv_scan(k, l, job, INP(I_KA)));
#elif RWKV_MODE == 1
                ph_rwkv_scan(k, l, job, INP(I_KA)); ph_rwkv_chunk(k, l, job, INP(I_KA), WS_H); if (l == 0) rwkv_check_delay(k, job);
#elif RWKV_MODE == 4
                ph_rwkv_scan(k, l, job, INP(I_KA)); ph_rwkv_chunk(k, l, job, INP(I_KA), WS_H); ph_rwkv_chunk(k, l, job, INP(I_KA), WS_END); if (l == 0) rwkv_check_delay(k, job, WS_END);
#elif RWKV_MODE == 5
#pragma unroll 1
                for (int rep = 0; rep < 2; ++rep) { int r_ = rep; asm volatile("" : "+s"(r_)); __syncthreads(); ph_rwkv_chunk(k, l, job, INP(I_KA), r_ ? (size_t)RW_Y : (size_t)WS_H); }
                if (l == 0) rwkv_check_delay(k, job);
#elif RWKV_MODE == 3
                ph_rwkv_scan(k, l, job, INP(I_KA)); ph_rwkv_scan(k, l, job, INP(I_KA), WS_H); if (l == 0) rwkv_check_delay(k, job);
#else
                DUPRUN(6, ph_rwkv_chunk(k, l, job, INP(I_KA)));
#ifdef CHUNK_PROBE
                __syncthreads(); ph_rwkv_chunk<CHUNK_PROBE>(k, l, job, INP(I_KA), WS_END);
#endif
#endif
            }
#ifndef NO_GLA
            FRESH();
            for (int vb = ((k.G & 7) ? k.bid : (k.bid & 7) * (k.G >> 3) + (k.bid >> 3)); vb < 256; vb += k.G) { const int job = vb; DUPRUN(7, ph_gla_scan(k, job)); }
#endif
#endif
        PH_END(pb + 4)
        PH_BEGIN(pb + 5, 7)
            DUPRUN(8, ph_post(k, l, Mpost, INP(I_LNG), INP(I_LNB), INP(I_GNG)));
        PH_END(pb + 5)
        PH_BEGIN(pb + 6, 8)
            pg8::Gemm g{(const bf16*)(ws + RW_A2), (const bf16*)(ws + WT_G2), Mpost, RD, 256, 0}; pg8::StaticOrder S; S.init(Mpost, RD, k.G, k.bid);
            pg8::Epi8<FL2_> E{FL2_{(const bf16*)(ws + RW_R), (bf16*)(ws + RW_V)}};
            DUPRUN(9, (pg8::gemm_phase<pg8::Epi8<FL2_>, pg8::StaticOrder, GA_, GS_>(glds, g, S, E)));
        PH_END(pb + 6)
        PH_BEGIN(pb + 7, 9)
            pg8::Gemm g{(const bf16*)(ws + RW_V), (const bf16*)(ws + WT_A), Mpost, DM, RD, 0}; pg8::StaticOrder S; S.init(Mpost, DM, k.G, k.bid);
            pg8::Epi8<FM_<0>> E{FM_<0>{(const bf16*)(ws + WS_P), (bf16*)(ws + WS_H), (bf16*)(ws + WS_H)}};
            DUPRUN(10, (pg8::gemm_phase<pg8::Epi8<FM_<0>>, pg8::StaticOrder, GA_, GS_>(glds, g, S, E)));
        PH_END(pb + 7)
        PH_BEGIN(pb + 8, 10)
            pg8::Gemm g{(const bf16*)(ws + GL_VS), (const bf16*)(ws + WT_B), Mpost, DM, GVD, 0}; pg8::StaticOrder S; S.init(Mpost, DM, k.G, k.bid);
            pg8::Epi8<FM_<1>> E{FM_<1>{(const bf16*)(ws + WS_P), (bf16*)(ws + WS_H), (bf16*)(ws + WS_H)}};
            pg8::gemm_phase<pg8::Epi8<FM_<1>>, pg8::StaticOrder, GA_, GS_>(glds, g, S, E);
            if ((DUP_MASK >> 17) & 1u) { __syncthreads(); pg8::Epi8<FM_<1>> E2{FM_<1>{(const bf16*)(ws + WS_P), (bf16*)(ws + WS_H), (bf16*)(ws + RW_R)}}; pg8::gemm_phase<pg8::Epi8<FM_<1>>, pg8::StaticOrder, GA_, GS_>(glds, g, S, E2); }
        PH_END(pb + 8)
        PH_BEGIN(pb + 9, 11)
            pg8::Gemm g{(const bf16*)(ws + WS_H), (const bf16*)(ws + WT_O), Mpost, DM, DM, 0}; pg8::StaticOrder S; S.init(Mpost, DM, k.G, k.bid);
#if XBF
            pg8::Epi8<FXb_> E{FXb_{(bf16*)(ws + WS_X), (const float*)(ws + WS_MOD), l}};
            pg8::gemm_phase<pg8::Epi8<FXb_>, pg8::StaticOrder, GA_, GS_>(glds, g, S, E);
#else
            pg8::Epi4<FX_> E{FX_{(float*)(ws + WS_X), (const float*)(ws + WS_MOD), l, (float*)(ws + WS_X)}};
            pg8::gemm_phase<pg8::Epi4<FX_>, pg8::StaticOrder, GA_, GS_>(glds, g, S, E);
#endif
            if (!XBF && ((DUP_MASK >> 18) & 1u)) { __syncthreads(); pg8::Epi4<FX_> E2{FX_{(float*)(ws + WS_X), (const float*)(ws + WS_MOD), l, (float*)(ws + WS_P)}}; pg8::gemm_phase<pg8::Epi4<FX_>, pg8::StaticOrder, GA_, GS_>(glds, g, S, E2); }
        PH_END(pb + 9)
        PH_BEGIN(pb + 10, 12)
            RowArgs ra{nullptr, nullptr, INP(I_NFG), INP(I_RW), INP(I_RB), nullptr};
            ph_rows<1>(k, ra, l, Mpost);
            if ((DUP_MASK >> 16) & 1u) { __syncthreads(); ph_rows<1>(k, ra, l, Mpost, true); }
        PH_END(pb + 10)
        PH_BEGIN(pb + 11, 13)
            DUPRUN(13, ph_moe_scatter(k, l, Mpost));
        PH_END(pb + 11)
        PH_BEGIN(pb + 12, 14)
#if MOE_GATHER
            pg8::Gemm g{(const bf16*)(ws + WS_H), (const bf16*)(ws + WT_GU), 0, 2816, DM, (size_t)2816 * DM * 2};
            pg8::MoeOrderT<true> S; S.rowtok = (const int*)(ws + WS_TAB + TAB_ROWTOK) + (size_t)l * MOE_ROWS;
            S.init((const int*)(ws + WS_TAB + TAB_TILE) + 256 * l, 11, k.G, ((k.G & 7) ? k.bid : (k.bid & 7) * (k.G >> 3) + (k.bid >> 3)));
            pg8::EpiGU<FE1_> E{FE1_{(bf16*)(ws + WS_ACT)}};
            DUPRUN(11, (pg8::gemm_phase<pg8::EpiGU<FE1_>, pg8::MoeOrderT<true>, GA_, GS_>(glds, g, S, E)));
#else
            pg8::Gemm g{(const bf16*)(ws + WS_HP), (const bf16*)(ws + WT_GU), 0, 2816, DM, (size_t)2816 * DM * 2};
            pg8::MoeOrder S; S.init((const int*)(ws + WS_TAB + TAB_TILE) + 256 * l, 11, k.G, ((k.G & 7) ? k.bid : (k.bid & 7) * (k.G >> 3) + (k.bid >> 3)));
            pg8::EpiGU<FE1_> E{FE1_{(bf16*)(ws + WS_ACT)}};
            DUPRUN(11, (pg8::gemm_phase<pg8::EpiGU<FE1_>, pg8::MoeOrder, GA_, GS_>(glds, g, S, E)));
#endif
        PH_END(pb + 12)
        PH_BEGIN(pb + 13, 15)
            pg8::Gemm g{(const bf16*)(ws + WS_ACT), (const bf16*)(ws + WT_D), 0, DM, DEXP, (size_t)DM * DEXP * 2};
            pg8::MoeOrder S; S.init((const int*)(ws + WS_TAB + TAB_TILE) + 256 * l, 8, k.G, ((k.G & 7) ? k.bid : (k.bid & 7) * (k.G >> 3) + (k.bid >> 3)));
            pg8::Epi8<FE2_> E{FE2_{(const int*)(ws + WS_TAB + TAB_ROWTOK) + (size_t)l * MOE_ROWS, (const float*)(ws + WS_TAB + TAB_ROWW) + (size_t)l * MOE_ROWS, (bf16*)(ws + WS_YF)}};
            DUPRUN(12, (pg8::gemm_phase<pg8::Epi8<FE2_>, pg8::MoeOrder, GA_, GS_>(glds, g, S, E)));
        PH_END(pb + 13)
        }
#undef L_
#if EXTRA_BARS
    if (hi - lo > 1) { for (int i = 0; i < EXTRA_BARS; ++i) xcd_barrier(bar); }
#endif
    PH_BEGIN(NPHASE - 1, 16)
        RowArgs ra{nullptr, nullptr, INP(I_FNG), nullptr, nullptr, (float*)INP(N_IN)};
        DUPRUN(14, ph_rows<2>(k, ra, 0, TL));
    PH_END(NPHASE - 1)
}

#ifndef MK_SINGLE
#define MK_SINGLE 1
#endif
extern "C" void kernel_launch(void* const* d_in, const int* in_sizes, int n_in, void* d_out, int out_size, void* d_ws, size_t ws_size, hipStream_t stream) {
    static int grid = 0;
    if (grid == 0) {
        if (n_in != N_IN || out_size != TL * DM || ws_size < WS_END) { fprintf(stderr, "kernel_launch: unexpected problem (n_in %d out %d ws %zu need %zu)\n", n_in, out_size, ws_size, (size_t)WS_END); grid = -1; return; }
        int dev = 0, cus = 0;
        if (hipGetDevice(&dev) != hipSuccess || hipDeviceGetAttribute(&cus, hipDeviceAttributeMultiprocessorCount, dev) != hipSuccess) { grid = -1; return; }
        if (hipFuncSetAttribute((const void*)fwd, hipFuncAttributeMaxDynamicSharedMemorySize, LDS_BYTES) != hipSuccess) { grid = -1; return; }
        int per_cu = 0;
        if (hipOccupancyMaxActiveBlocksPerMultiprocessor(&per_cu, (const void*)fwd, 512, LDS_BYTES) != hipSuccess || per_cu < 1) fprintf(stderr, "kernel_launch: occupancy query says %d\n", per_cu);
        (void)hipGetLastError();
        grid = cus;
    }
    if (grid < 0) return;
    unsigned char* ws = (unsigned char*)d_ws;
    (void)hipMemsetAsync(ws + WS_CTL, 0, CTL_BYTES, stream);
    Args a{};
    for (int i = 0; i < N_IN; ++i) a.in[i] = (const float*)d_in[i];
    a.out = (float*)d_out; a.ws = ws;
#if MK_SINGLE
    a.ph_lo = 0; a.ph_hi = NPHASE;
    hipLaunchKernelGGL(fwd, dim3(grid), dim3(512), LDS_BYTES, stream, a);
#else
    for (int p = 0; p < NPHASE; ++p) { a.ph_lo = p; a.ph_hi = p + 1; hipLaunchKernelGGL(fwd, dim3(grid), dim3(512), LDS_BYTES, stream, a); }
#endif
}
```
